# Optimizing an MI355X kernel written in HIP

```python
import math
import jax, jax.numpy as jnp
from jax import lax
import numpy as np

D_MODEL = 1024
BATCH = 8
SEQ = 2048
DEPTH = 2

R_HEADS = 4
R_DK = 64
R_DV = 128
R_CHUNK = 128
ROPE_BASE = 10000.0
G_HEADS = 4
G_DK = 128
G_DV = 128
G_CHUNK = 64
CONV_K = 4
CONV_CH = 2 * G_HEADS * G_DK + G_HEADS * G_DV
IN_SIZES = (R_HEADS * R_DK, R_HEADS * R_DK, R_HEADS * R_DV, R_HEADS * R_DV,
            CONV_CH, G_HEADS * G_DV, G_HEADS, G_HEADS)
IN_COLS = 3592
MIX_WIDTH = R_HEADS * R_DV + G_HEADS * G_DV
D_FF = 2816
N_EXPERTS = 8
TOP_K = 2
D_FF_EXPERT = 3584
N_DENSE = (DEPTH + 1) // 2
N_MOE = DEPTH // 2
ALPHA = (2 * DEPTH) ** 0.25
BETA_INIT = (8 * DEPTH) ** -0.25
LN_EPS = 1e-5
NORM_EPS = 1e-6

kernel_name = 'hybrid_retnet_gdn_deepnorm_moe'


def layer_norm(x, g, b):
    xf = x.astype(jnp.float32)
    mu = jnp.mean(xf, axis=-1, keepdims=True)
    var = jnp.mean(jnp.square(xf - mu), axis=-1, keepdims=True)
    y = (xf - mu) * lax.rsqrt(var + LN_EPS) * g.astype(jnp.float32) + b.astype(jnp.float32)
    return y.astype(x.dtype)


def to_chunks(t, c):
    b, tl = t.shape[:2]
    t = t.reshape(b, tl // c, c, *t.shape[2:])
    return jnp.moveaxis(t, 2, 3)


def from_chunks(t):
    t = jnp.moveaxis(t, 3, 2)
    return t.reshape(t.shape[0], -1, *t.shape[3:])


def rope(t, pos):
    d = t.shape[-1]
    inv = ROPE_BASE ** (-jnp.arange(0, d, 2, dtype=jnp.float32) / d)
    ang = pos[:, None] * inv[None, :]
    cos = jnp.cos(ang)[:, None, :]
    sin = jnp.sin(ang)[:, None, :]
    t1, t2 = t[..., : d // 2], t[..., d // 2:]
    return jnp.concatenate([t1 * cos - t2 * sin, t1 * sin + t2 * cos], axis=-1)


def retention(q, k, v):
    b, tl, h, dk = q.shape
    dv = v.shape[-1]
    c = R_CHUNK
    log_g = jnp.log(1.0 - 2.0 ** (-5.0 - jnp.arange(h, dtype=jnp.float32)))
    idx = jnp.arange(c, dtype=jnp.float32)
    causal = jnp.tril(jnp.ones((c, c), dtype=bool))
    dmat = jnp.exp(jnp.where(causal, (idx[:, None] - idx[None, :])[None] * log_g[:, None, None], -jnp.inf))
    qc, kc, vc = to_chunks(q, c), to_chunks(k, c), to_chunks(v, c)
    scores = jnp.einsum('bnhid,bnhjd->bnhij', qc, kc) * dmat
    o_intra = jnp.einsum('bnhij,bnhje->bnhie', scores, vc)
    zeta = jnp.exp((c - 1.0 - idx)[None, :] * log_g[:, None])
    xi = jnp.exp((idx + 1.0)[None, :] * log_g[:, None])
    kv = jnp.einsum('bnhcd,bnhce->nbhde', kc * zeta[:, :, None], vc)
    chunk_decay = jnp.exp(c * log_g)[:, None, None]

    def step(s, kv_n):
        return s * chunk_decay + kv_n, s

    _, s_prev = lax.scan(step, jnp.zeros((b, h, dk, dv), jnp.float32), kv)
    o_inter = jnp.einsum('bnhcd,nbhde->bnhce', qc * xi[:, :, None], s_prev)
    return from_chunks(o_intra + o_inter)


def gated_delta_rule(q, k, v, g, beta):
    b, tl, h, dk = q.shape
    dv = v.shape[-1]
    c = G_CHUNK
    qc, kc, vc = to_chunks(q, c), to_chunks(k, c), to_chunks(v, c)
    gc = jnp.cumsum(to_chunks(g, c), axis=-1)
    bc = to_chunks(beta, c)[..., None]
    causal = jnp.tril(jnp.ones((c, c), dtype=bool))
    strict = jnp.tril(jnp.ones((c, c), dtype=bool), -1)
    decay = jnp.exp(jnp.where(causal, gc[..., :, None] - gc[..., None, :], -jnp.inf))
    kb = kc * bc
    a = jnp.where(strict, jnp.einsum('bnhid,bnhjd->bnhij', kb, kc) * decay, 0.0)
    rhs = jnp.concatenate([vc * bc, kb * jnp.exp(gc)[..., None]], axis=-1)
    sol = lax.linalg.triangular_solve(a, rhs, left_side=True, lower=True, unit_diagonal=True)
    u, w = sol[..., :dv], sol[..., dv:]
    qk = jnp.where(causal, jnp.einsum('bnhid,bnhjd->bnhij', qc, kc) * decay, 0.0)
    q_dec = qc * jnp.exp(gc)[..., None]
    k_dec = kc * jnp.exp(gc[..., -1:] - gc)[..., None]
    cd = jnp.exp(gc[..., -1])[..., None, None]
    xs = (jnp.moveaxis(u, 1, 0), jnp.moveaxis(w, 1, 0), jnp.moveaxis(qk, 1, 0),
          jnp.moveaxis(q_dec, 1, 0), jnp.moveaxis(k_dec, 1, 0), jnp.moveaxis(cd, 1, 0))

    def step(s, xs_n):
        u_n, w_n, qk_n, qd_n, kd_n, cd_n = xs_n
        v_new = u_n - jnp.einsum('bhcd,bhde->bhce', w_n, s)
        o_n = jnp.einsum('bhcd,bhde->bhce', qd_n, s) + jnp.einsum('bhij,bhje->bhie', qk_n, v_new)
        s = s * cd_n + jnp.einsum('bhcd,bhce->bhde', kd_n, v_new)
        return s, o_n

    _, o = lax.scan(step, jnp.zeros((b, h, dk, dv), jnp.float32), xs)
    return from_chunks(jnp.moveaxis(o, 0, 1))


def causal_conv(x, w):
    return lax.conv_general_dilated(x, w[:, None, :], window_strides=(1,), padding=((CONV_K - 1, 0),),
                                    dimension_numbers=('NWC', 'WIO', 'NWC'),
                                    feature_group_count=x.shape[-1])


def l2norm(t):
    return t * lax.rsqrt(jnp.sum(jnp.square(t), axis=-1, keepdims=True) + NORM_EPS)


def hybrid_mixer(x, w_in, conv_w, a_log, dt_bias, gdn_norm_w, w_o):
    b, tl, _ = x.shape
    f32 = jnp.float32
    hproj = x @ w_in
    splits = np.cumsum(IN_SIZES)[:-1].tolist()
    rq, rk, rv, rg, gqkv, gg, ga, gb = jnp.split(hproj, splits, axis=-1)
    pos = jnp.arange(tl, dtype=f32)
    rq = rope(rq.reshape(b, tl, R_HEADS, R_DK).astype(f32), pos)
    rk = rope(rk.reshape(b, tl, R_HEADS, R_DK).astype(f32), pos) * (R_DK ** -0.5)
    rv = rv.reshape(b, tl, R_HEADS, R_DV).astype(f32)
    ro = retention(rq, rk, rv)
    mu = jnp.mean(ro, axis=-1, keepdims=True)
    var = jnp.mean(jnp.square(ro - mu), axis=-1, keepdims=True)
    ro = (ro - mu) * lax.rsqrt(var + LN_EPS) * jax.nn.silu(rg.reshape(b, tl, R_HEADS, R_DV).astype(f32))
    gqkv = jax.nn.silu(causal_conv(gqkv, conv_w)).astype(f32)
    gq, gk, gv = jnp.split(gqkv, [G_HEADS * G_DK, 2 * G_HEADS * G_DK], axis=-1)
    gq = l2norm(gq.reshape(b, tl, G_HEADS, G_DK)) * (G_DK ** -0.5)
    gk = l2norm(gk.reshape(b, tl, G_HEADS, G_DK))
    gv = gv.reshape(b, tl, G_HEADS, G_DV)
    g = -jnp.exp(a_log.astype(f32)) * jax.nn.softplus(ga.astype(f32) + dt_bias.astype(f32))
    beta = jax.nn.sigmoid(gb.astype(f32))
    go = gated_delta_rule(gq, gk, gv, g, beta)
    go = go * lax.rsqrt(jnp.mean(jnp.square(go), axis=-1, keepdims=True) + NORM_EPS)
    go = go * gdn_norm_w.astype(f32) * jax.nn.silu(gg.reshape(b, tl, G_HEADS, G_DV).astype(f32))
    o = jnp.concatenate([ro.reshape(b, tl, -1), go.reshape(b, tl, -1)], axis=-1).astype(x.dtype)
    return o @ w_o


def swiglu(x, w_gate, w_up, w_down):
    return (jax.nn.silu(x @ w_gate) * (x @ w_up)) @ w_down


def moe_swiglu(x, router_w, w_gate, w_up, w_down):
    logits = (x @ router_w).astype(jnp.float32)
    top_vals, top_idx = lax.top_k(logits, TOP_K)
    gates = jax.nn.softmax(top_vals, axis=-1)
    combine = jnp.sum(jax.nn.one_hot(top_idx, N_EXPERTS, dtype=jnp.float32) * gates[..., None], axis=-2)
    combine = combine.astype(x.dtype)
    y = jnp.zeros_like(x)
    for e in range(N_EXPERTS):
        y = y + combine[..., e:e + 1] * swiglu(x, w_gate[e], w_up[e], w_down[e])
    return y


def setup_inputs(seed: int = 0) -> dict:
    key = jax.random.key(seed)
    ks = jax.random.split(key, 18)
    f32 = jnp.float32

    def nrm(k, shape, scale):
        return jax.random.normal(k, shape, f32) * scale

    x = nrm(ks[0], (BATCH, SEQ, D_MODEL), 1.0)
    w_in = nrm(ks[1], (DEPTH, D_MODEL, IN_COLS), D_MODEL ** -0.5)
    conv_w = nrm(ks[2], (DEPTH, CONV_K, CONV_CH), CONV_K ** -0.5)
    a_log = jnp.log(jax.random.uniform(ks[3], (DEPTH, G_HEADS), f32, 1.0, 16.0))
    dt = jnp.exp(jax.random.uniform(ks[4], (DEPTH, G_HEADS), f32, math.log(1e-3), math.log(1e-1)))
    dt_bias = dt + jnp.log(-jnp.expm1(-dt))
    gdn_norm_w = 1.0 + nrm(ks[5], (DEPTH, G_DV), 0.02)
    w_o = nrm(ks[6], (DEPTH, MIX_WIDTH, D_MODEL), BETA_INIT * MIX_WIDTH ** -0.5)
    ln1_g = 1.0 + nrm(ks[7], (DEPTH, D_MODEL), 0.02)
    ln1_b = nrm(ks[8], (DEPTH, D_MODEL), 0.02)
    ln2_g = 1.0 + nrm(ks[9], (DEPTH, D_MODEL), 0.02)
    ln2_b = nrm(ks[10], (DEPTH, D_MODEL), 0.02)
    ffn_w_gate = nrm(ks[11], (N_DENSE, D_MODEL, D_FF), D_MODEL ** -0.5)
    ffn_w_up = nrm(ks[12], (N_DENSE, D_MODEL, D_FF), D_MODEL ** -0.5)
    ffn_w_down = nrm(ks[13], (N_DENSE, D_FF, D_MODEL), BETA_INIT * D_FF ** -0.5)
    router_w = nrm(ks[14], (N_MOE, D_MODEL, N_EXPERTS), D_MODEL ** -0.5)
    moe_w_gate = nrm(ks[15], (N_MOE, N_EXPERTS, D_MODEL, D_FF_EXPERT), D_MODEL ** -0.5)
    moe_w_up = nrm(ks[16], (N_MOE, N_EXPERTS, D_MODEL, D_FF_EXPERT), D_MODEL ** -0.5)
    moe_w_down = nrm(ks[17], (N_MOE, N_EXPERTS, D_FF_EXPERT, D_MODEL), BETA_INIT * D_FF_EXPERT ** -0.5)
    return {'x': x, 'w_in': w_in, 'conv_w': conv_w, 'a_log': a_log, 'dt_bias': dt_bias,
            'gdn_norm_w': gdn_norm_w, 'w_o': w_o, 'ln1_g': ln1_g, 'ln1_b': ln1_b,
            'ln2_g': ln2_g, 'ln2_b': ln2_b, 'ffn_w_gate': ffn_w_gate, 'ffn_w_up': ffn_w_up,
            'ffn_w_down': ffn_w_down, 'router_w': router_w, 'moe_w_gate': moe_w_gate,
            'moe_w_up': moe_w_up, 'moe_w_down': moe_w_down}


def reference(x, w_in, conv_w, a_log, dt_bias, gdn_norm_w, w_o, ln1_g, ln1_b, ln2_g, ln2_b,
              ffn_w_gate, ffn_w_up, ffn_w_down, router_w, moe_w_gate, moe_w_up, moe_w_down):
    for l in range(DEPTH):
        mix = hybrid_mixer(x, w_in[l], conv_w[l], a_log[l], dt_bias[l], gdn_norm_w[l], w_o[l])
        x = layer_norm(ALPHA * x + mix, ln1_g[l], ln1_b[l])
        if l % 2 == 0:
            f = swiglu(x, ffn_w_gate[l // 2], ffn_w_up[l // 2], ffn_w_down[l // 2])
        else:
            f = moe_swiglu(x, router_w[l // 2], moe_w_gate[l // 2], moe_w_up[l // 2], moe_w_down[l // 2])
        x = layer_norm(ALPHA * x + f, ln2_g[l], ln2_b[l])
    return x
```

```cpp
#define REP_SCAN 2
#include <hip/hip_runtime.h>
#include <cstdio>
#include <cstdint>

#ifndef ONE_LAUNCH
#define ONE_LAUNCH 1
#endif

#define GAS __attribute__((address_space(1)))
#define LAS __attribute__((address_space(3)))
typedef unsigned short bf16;
typedef unsigned v4u __attribute__((ext_vector_type(4)));
typedef unsigned v2u __attribute__((ext_vector_type(2)));
typedef float f32x4 __attribute__((ext_vector_type(4)));
typedef float f32x2 __attribute__((ext_vector_type(2)));
#define RLX_AGENT __ATOMIC_RELAXED, __HIP_MEMORY_SCOPE_AGENT
#define LDS_WAIT() asm volatile("s_waitcnt lgkmcnt(0)" ::: "memory")
#define VM_WAIT() asm volatile("s_waitcnt vmcnt(0)" ::: "memory")

__device__ __forceinline__ unsigned f2bf(float f) { unsigned u = __builtin_bit_cast(unsigned, f); return (u + 0x7fffu + ((u >> 16) & 1u)) >> 16; }
__device__ __forceinline__ unsigned pk2(float lo, float hi) { return f2bf(lo) | (f2bf(hi) << 16); }
__device__ __forceinline__ float bf2f(unsigned short u) { return __builtin_bit_cast(float, (unsigned)u << 16); }
__device__ __forceinline__ float bflo(unsigned u) { return __builtin_bit_cast(float, u << 16); }
__device__ __forceinline__ float bfhi(unsigned u) { return __builtin_bit_cast(float, u & 0xffff0000u); }
__device__ __forceinline__ float siluf(float x) { return x / (1.f + __expf(-x)); }
__device__ __forceinline__ float sigmf(float x) { return 1.f / (1.f + __expf(-x)); }
__device__ __forceinline__ float wave_sum(float v) {
#pragma unroll
    for (int o = 1; o < 64; o <<= 1) v += __shfl_xor(v, o);
    return v;
}

constexpr int NWAVES = 8;
constexpr int M = 16384, D = 1024, SEQ = 2048, NB = 8;
constexpr int IN_COLS = 3592, NIN_PAD = 3840, HP_LD = 3584;
constexpr int FF = 2816, FE = 3584, NE = 8;
constexpr int COL_RQ = 0, COL_RK = 256, COL_RV = 512, COL_RG = 1024, COL_GQ = 1536, COL_GK = 2048, COL_GV = 2560, COL_GG = 3072;
constexpr float ALPHA = 1.41421356237f;
constexpr float LN_EPS = 1e-5f, NORM_EPS = 1e-6f;
constexpr int MOE_ROWS = 16384 + 16 * 256;

__host__ __device__ __forceinline__ int fragoff(int i, int d, int nkt) {
    return ((((i >> 5) * nkt + (d >> 5)) * 2 + ((d >> 4) & 1)) * 512) + ((((d >> 2) & 1) * 32 + (i & 31)) * 8) + ((((d >> 3) & 1) << 2) | (d & 3));
}
__host__ __device__ __forceinline__ int uoff(int i, int e) {
    const int reg = (i & 3) | (((i & 31) >> 3) << 2);
    return (((((e >> 5) * 2 + (i >> 5)) * 2 + (reg >> 3)) * 64 + (((i >> 2) & 1) * 32 + (e & 31))) * 8) + (reg & 7);
}
namespace pg8 {
#define PG8_LAS __attribute__((address_space(3)))
typedef unsigned short bf16_t;
typedef short bf16x8 __attribute__((ext_vector_type(8)));
typedef float f32x4 __attribute__((ext_vector_type(4)));
typedef unsigned u32x4 __attribute__((ext_vector_type(4)));
constexpr int BM = 256, BK = 64, HALF = 128, HTB = HALF * BK * 2  , STAGE_BYTES = 8 * HTB, NXCD = 8, WGM = 8;

__host__ __device__ __forceinline__ int lds_byte(int r, int c) { const int st = (r >> 4) * 2 + (c >> 5), rr = r & 15, cc = c & 31, ob = rr * 64 + cc * 2; return st * 1024 + (ob ^ (((ob >> 9) & 1) << 5)); }
__host__ __device__ __forceinline__ void stage_rc(int b, int& R, int& C) { const int st = b / 1024, sb = b % 1024, swz = sb ^ (((sb >> 9) & 1) << 5); R = (st >> 1) * 16 + swz / 64; C = (st & 1) * 32 + (swz % 64) / 2; }
__host__ __device__ __forceinline__ int perm32(int rho) { const int n = rho >> 4, i = rho & 15; return 8 * (i >> 2) + 4 * n + (i & 3); }

struct Unit { int pm, pn, aux; };
struct Gemm { const bf16_t* A; const bf16_t* Bt; int M, N, K; };

struct StaticOrder {
    int nM, nN, nwg, G, c;
    __host__ __device__ void init(int M, int N, int G_, int c_) { nM = M / BM; nN = N / BM; nwg = nM * nN; G = G_; c = c_; }
    __host__ __device__ bool next(int i, Unit& u) const {
        const long L = (long)i * G + c; if (L >= nwg) return false;
        int wgid = (int)L; { const int q = nwg / NXCD, r = nwg % NXCD, xcd = wgid % NXCD, off = wgid / NXCD; wgid = (xcd < r ? xcd * (q + 1) : r * (q + 1) + (xcd - r) * q) + off; }
        const int nig = WGM * nN, gid = wgid / nig, fm = gid * WGM, gsz = (nM - fm) < WGM ? (nM - fm) : WGM;
        u.pm = fm + ((wgid % nig) % gsz); u.pn = (wgid % nig) / gsz; u.aux = 0; return true;
    }
    __device__ __forceinline__ const char* aptr(const Gemm& g, const Unit& u) const { return (const char*)g.A + (size_t)u.pm * ((size_t)BM * g.K * 2); }
    __device__ __forceinline__ const char* bptr(const Gemm& g, const Unit& u) const { return (const char*)g.Bt + (size_t)u.pn * ((size_t)BM * g.K * 2); }
    __device__ __forceinline__ void a_ready(const Unit&) const {}
    __device__ __forceinline__ void done(const Unit&) const {}
};

template <class Epi, class Sched, bool ALIGN_EPI = false, bool SP2 = false>
__device__ __forceinline__ void gemm_phase(PG8_LAS unsigned char* lds, const Gemm g, const Sched& S, const Epi& E) {
    int tid = threadIdx.x; asm volatile("" : "+v"(tid)); const int wid = __builtin_amdgcn_readfirstlane(tid >> 6), lane = tid & 63, wr = wid >> 2, wc = wid & 3, fr = lane & 15, fq = lane >> 4;
    const int K = g.K, nt = K / BK;
    unsigned voffA[2], voffB[2];
#pragma unroll
    for (int i = 0; i < 2; ++i) { int R, C; stage_rc(tid * 16 + i * 8192, R, C); const int Rb = Epi::PERM ? ((R & ~31) + perm32(R & 31)) : R;
        voffA[i] = (unsigned)(R * K + C) * 2u; voffB[i] = (unsigned)(Rb * K + C) * 2u; }
    const size_t kstep = (size_t)(BK * 2);
    const size_t hstep = (size_t)HALF * K * 2;
    const size_t tstep = 2 * hstep;
    const unsigned ldsw = (unsigned)wid * 1024u;
    const int aoff = lds_byte(wr * 64 + fr, fq * 8), boff = lds_byte(wc * 32 + fr, fq * 8);
#define PG8_SA(b, h) (((b) * 2 + (h)) * HTB)
#define PG8_SB(b, h) ((4 + (b) * 2 + (h)) * HTB)
#define PG8_STAGE(bufoff, gbase, voff) do { _Pragma("unroll") for (int _i = 0; _i < 2; ++_i) \
        __builtin_amdgcn_global_load_lds((const unsigned*)((const char*)(gbase) + (voff)[_i]), (PG8_LAS unsigned*)(lds + (bufoff) + ldsw + _i * 8192), 16, 0, 0); } while (0)
#define PG8_LDA(dst, b, h) do { _Pragma("unroll") for (int m = 0; m < 4; ++m) _Pragma("unroll") for (int k = 0; k < 2; ++k) dst[m][k] = *(const PG8_LAS bf16x8*)(lds + PG8_SA(b, h) + aoff + m * 2048 + k * 1024); } while (0)
#define PG8_LDB(dst, b, h) do { _Pragma("unroll") for (int n = 0; n < 2; ++n) _Pragma("unroll") for (int k = 0; k < 2; ++k) dst[n][k] = *(const PG8_LAS bf16x8*)(lds + PG8_SB(b, h) + boff + n * 2048 + k * 1024); } while (0)
#define PG8_MMA(ai, bj, At, Bt) do { __builtin_amdgcn_s_setprio(1); _Pragma("unroll") for (int m = 0; m < 4; ++m) _Pragma("unroll") for (int n = 0; n < 2; ++n) _Pragma("unroll") for (int k = 0; k < 2; ++k) \
        acc[ai][bj][m][n] = __builtin_amdgcn_mfma_f32_16x16x32_bf16(Bt[n][k], At[m][k], acc[ai][bj][m][n], 0, 0, 0); __builtin_amdgcn_s_setprio(0); } while (0)
#define PG8_WAIT_V(n) asm volatile("s_waitcnt vmcnt(" #n ")" ::: "memory")
#define PG8_WAIT_L(n) asm volatile("s_waitcnt lgkmcnt(" #n ")" ::: "memory")
#define PG8_BAR __builtin_amdgcn_s_barrier()
#define PG8_SCHED __builtin_amdgcn_sched_barrier(0)
    Unit cur, nxt; int ui = 0;
    if (!S.next(0, cur)) return;
    f32x4 acc[2][2][4][2];
#pragma unroll
    for (int a = 0; a < 2; ++a)
#pragma unroll
        for (int b = 0; b < 2; ++b)
#pragma unroll
            for (int m = 0; m < 4; ++m)
#pragma unroll
                for (int n = 0; n < 2; ++n) acc[a][b][m][n] = (f32x4){0.f, 0.f, 0.f, 0.f};
    bf16x8 At[4][2], B0[2][2], B1[2][2];
    const char* cA = S.aptr(g, cur); const char* cB = S.bptr(g, cur);
    S.a_ready(cur);
    if constexpr (SP2) {
        PG8_STAGE(PG8_SB(0, 0), cB, voffB); PG8_STAGE(PG8_SB(0, 1), cB + hstep, voffB); PG8_STAGE(PG8_SA(0, 0), cA, voffA); PG8_STAGE(PG8_SA(0, 1), cA + hstep, voffA);
        if (wr == 1) PG8_BAR;
        PG8_WAIT_V(2); PG8_BAR;
        PG8_STAGE(PG8_SB(1, 0), cB + kstep, voffB); PG8_STAGE(PG8_SA(1, 0), cA + kstep, voffA); PG8_STAGE(PG8_SB(1, 1), cB + hstep + kstep, voffB);
        PG8_WAIT_V(6); PG8_BAR;
    } else {
        PG8_STAGE(PG8_SB(0, 0), cB, voffB); PG8_STAGE(PG8_SA(0, 0), cA, voffA); PG8_STAGE(PG8_SB(0, 1), cB + hstep, voffB); PG8_STAGE(PG8_SA(0, 1), cA + hstep, voffA);
        if (wr == 1) PG8_BAR;
        PG8_WAIT_V(4); PG8_BAR;
        PG8_STAGE(PG8_SB(1, 0), cB + kstep, voffB); PG8_STAGE(PG8_SA(1, 0), cA + kstep, voffA); PG8_STAGE(PG8_SB(1, 1), cB + hstep + kstep, voffB);
        PG8_WAIT_V(6); PG8_BAR;
    }
    for (;;) {
        const bool has_next = S.next(ui + 1, nxt);
        const char* nA = has_next ? S.aptr(g, nxt) : cA; const char* nB = has_next ? S.bptr(g, nxt) : cB;
        for (int t = 0; t < nt; t += 2) {
            const bool last = (t == nt - 2);
            const char* a1 = cA + (size_t)(t + 1) * kstep;
            const char* a2 = last ? nA : cA + (size_t)(t + 2) * kstep; const char* b2 = last ? nB : cB + (size_t)(t + 2) * kstep;
            const char* a3 = a2 + kstep; const char* b3 = b2 + kstep;
            if (last && has_next) S.a_ready(nxt);
            if constexpr (SP2) {
            PG8_LDB(B0, 0, 0); PG8_LDB(B1, 0, 1); PG8_SCHED; PG8_LDA(At, 0, 0); PG8_STAGE(PG8_SA(1, 1), a1 + hstep, voffA);
            PG8_WAIT_V(8); PG8_WAIT_L(0); PG8_BAR; PG8_MMA(0, 0, At, B0); PG8_MMA(0, 1, At, B1); PG8_BAR; PG8_SCHED;
            PG8_LDA(At, 0, 1); PG8_STAGE(PG8_SB(0, 0), b2, voffB); PG8_STAGE(PG8_SB(0, 1), b2 + hstep, voffB); PG8_STAGE(PG8_SA(0, 0), a2, voffA);
            PG8_WAIT_V(8); PG8_WAIT_L(0); PG8_BAR; PG8_MMA(1, 0, At, B0); PG8_MMA(1, 1, At, B1); PG8_BAR; PG8_SCHED;
            PG8_LDB(B0, 1, 0); PG8_LDB(B1, 1, 1); PG8_SCHED; PG8_LDA(At, 1, 0); PG8_STAGE(PG8_SA(0, 1), a2 + hstep, voffA);
            PG8_WAIT_V(8); PG8_WAIT_L(0); PG8_BAR; PG8_MMA(0, 0, At, B0); PG8_MMA(0, 1, At, B1); PG8_BAR; PG8_SCHED;
            PG8_LDA(At, 1, 1); PG8_STAGE(PG8_SB(1, 0), b3, voffB); PG8_STAGE(PG8_SB(1, 1), b3 + hstep, voffB); PG8_STAGE(PG8_SA(1, 0), a3, voffA);
            PG8_WAIT_V(8); PG8_WAIT_L(0); PG8_BAR; PG8_MMA(1, 0, At, B0); PG8_MMA(1, 1, At, B1); PG8_BAR; PG8_SCHED;
            } else {
            PG8_LDB(B0, 0, 0); PG8_SCHED; PG8_LDA(At, 0, 0); PG8_STAGE(PG8_SA(1, 1), a1 + hstep, voffA);
            PG8_WAIT_L(8); PG8_BAR; PG8_WAIT_L(0); PG8_MMA(0, 0, At, B0); PG8_BAR; PG8_SCHED;
            PG8_LDB(B1, 0, 1); PG8_STAGE(PG8_SB(0, 0), b2, voffB);
            PG8_BAR; PG8_WAIT_L(0); PG8_MMA(0, 1, At, B1); PG8_BAR;
            PG8_LDA(At, 0, 1); PG8_STAGE(PG8_SA(0, 0), a2, voffA);
            PG8_BAR; PG8_WAIT_L(0); PG8_MMA(1, 0, At, B0); PG8_BAR; PG8_SCHED;
            PG8_STAGE(PG8_SB(0, 1), b2 + hstep, voffB);
            PG8_WAIT_V(6); PG8_BAR; PG8_MMA(1, 1, At, B1); PG8_BAR;
            PG8_LDB(B0, 1, 0); PG8_SCHED; PG8_LDA(At, 1, 0); PG8_STAGE(PG8_SA(0, 1), a2 + hstep, voffA);
            PG8_WAIT_L(8); PG8_BAR; PG8_WAIT_L(0); PG8_MMA(0, 0, At, B0); PG8_BAR; PG8_SCHED;
            PG8_LDB(B1, 1, 1); PG8_STAGE(PG8_SB(1, 0), b3, voffB);
            PG8_BAR; PG8_WAIT_L(0); PG8_MMA(0, 1, At, B1); PG8_BAR;
            PG8_LDA(At, 1, 1); PG8_STAGE(PG8_SA(1, 0), a3, voffA);
            PG8_BAR; PG8_WAIT_L(0); PG8_MMA(1, 0, At, B0); PG8_BAR; PG8_SCHED;
            PG8_STAGE(PG8_SB(1, 1), b3 + hstep, voffB);
            PG8_WAIT_V(6); PG8_BAR; PG8_MMA(1, 1, At, B1); PG8_BAR;
            }
        }
        if constexpr (ALIGN_EPI) { if (wr == 0) PG8_BAR; }
        if constexpr (!Epi::AFTER_DRAIN) { E(acc, cur, wr, wc, fr, fq); S.done(cur); }
        if (!has_next) break;
#pragma unroll
        for (int a = 0; a < 2; ++a)
#pragma unroll
            for (int b = 0; b < 2; ++b)
#pragma unroll
                for (int m = 0; m < 4; ++m)
#pragma unroll
                    for (int n = 0; n < 2; ++n) acc[a][b][m][n] = (f32x4){0.f, 0.f, 0.f, 0.f};
        cur = nxt; cA = nA; cB = nB; ++ui;
        if constexpr (ALIGN_EPI) { if (wr == 1) PG8_BAR; }
    }
    PG8_WAIT_V(0);
    if constexpr (!ALIGN_EPI) { if (wr == 0) PG8_BAR; }
    PG8_BAR;
    if constexpr (Epi::AFTER_DRAIN) { E.fused(acc, cur, wr, wc, fr, fq, lds, wid, lane); S.done(cur); }
#undef PG8_SA
#undef PG8_SB
#undef PG8_STAGE
#undef PG8_LDA
#undef PG8_LDB
#undef PG8_MMA
#undef PG8_WAIT_V
#undef PG8_WAIT_L
#undef PG8_BAR
#undef PG8_SCHED
}
}

namespace pg8 {
__device__ __forceinline__ unsigned cvt_pk_bf16(float lo, float hi) { unsigned r; asm volatile("v_cvt_pk_bf16_f32 %0, %1, %2" : "=v"(r) : "v"(lo), "v"(hi)); return r; }

struct EpiHproj {
    static constexpr bool PERM = true, AFTER_DRAIN = false;
    bf16_t* HP; float* GAB;
    __device__ __forceinline__ void operator()(const f32x4 (&acc)[2][2][4][2], const Unit& u, int wr, int wc, int fr, int fq) const {
        const int row0 = u.pm * BM + wr * 64 + fr;
        if (u.pn < 14) {
            const int col0 = u.pn * BM + wc * 32 + 8 * fq;
#pragma unroll
            for (int ai = 0; ai < 2; ++ai)
#pragma unroll
                for (int m = 0; m < 4; ++m) { bf16_t* rowp = HP + (size_t)(row0 + ai * HALF + m * 16) * 3584 + col0;
#pragma unroll
                    for (int bj = 0; bj < 2; ++bj) { const f32x4 v0 = acc[ai][bj][m][0], v1 = acc[ai][bj][m][1];
                        u32x4 w; w.x = cvt_pk_bf16(v0[0], v0[1]); w.y = cvt_pk_bf16(v0[2], v0[3]); w.z = cvt_pk_bf16(v1[0], v1[1]); w.w = cvt_pk_bf16(v1[2], v1[3]);
                        *(u32x4*)(rowp + bj * HALF) = w; } }
        } else if (wc == 0 && fq == 0) {
#pragma unroll
            for (int ai = 0; ai < 2; ++ai)
#pragma unroll
                for (int m = 0; m < 4; ++m) { float* rowp = GAB + (size_t)(row0 + ai * HALF + m * 16) * 8;
                    *(f32x4*)(rowp) = acc[ai][0][m][0]; *(f32x4*)(rowp + 4) = acc[ai][0][m][1]; }
        }
    }
};
struct EpiF32 {
    static constexpr bool PERM = false, AFTER_DRAIN = false;
    float* O; int ldc;
    __device__ __forceinline__ void operator()(const f32x4 (&acc)[2][2][4][2], const Unit& u, int wr, int wc, int fr, int fq) const {
        const int row0 = u.pm * BM + wr * 64 + fr, col0 = u.pn * BM + wc * 32 + 4 * fq;
#pragma unroll
        for (int ai = 0; ai < 2; ++ai)
#pragma unroll
            for (int m = 0; m < 4; ++m) { float* rowp = O + (size_t)(row0 + ai * HALF + m * 16) * ldc + col0;
#pragma unroll
                for (int bj = 0; bj < 2; ++bj)
#pragma unroll
                    for (int n = 0; n < 2; ++n) *(f32x4*)(rowp + bj * HALF + n * 16) = acc[ai][bj][m][n]; }
    }
};
struct EpiSwiglu {
    static constexpr bool PERM = true, AFTER_DRAIN = false;
    bf16_t* H; int ldh;
    __device__ __forceinline__ void operator()(const f32x4 (&acc)[2][2][4][2], const Unit& u, int wr, int wc, int fr, int fq) const {
        const int row0 = u.pm * BM + wr * 64 + fr, col0 = u.pn * HALF + wc * 32 + 8 * fq;
#pragma unroll
        for (int ai = 0; ai < 2; ++ai)
#pragma unroll
            for (int m = 0; m < 4; ++m) { bf16_t* rowp = H + (size_t)(row0 + ai * HALF + m * 16) * ldh + col0;
                float h[8];
#pragma unroll
                for (int n = 0; n < 2; ++n)
#pragma unroll
                    for (int i = 0; i < 4; ++i) { const float gt = acc[ai][0][m][n][i], up = acc[ai][1][m][n][i]; h[n * 4 + i] = gt * up * __builtin_amdgcn_rcpf(1.f + __expf(-gt)); }
                u32x4 w; w.x = cvt_pk_bf16(h[0], h[1]); w.y = cvt_pk_bf16(h[2], h[3]); w.z = cvt_pk_bf16(h[4], h[5]); w.w = cvt_pk_bf16(h[6], h[7]);
                *(u32x4*)(rowp) = w; }
    }
};
struct EpiMoeDown {
    static constexpr bool PERM = false, AFTER_DRAIN = false;
    float* XF; const int* list; const float* gate; int cnt[8], cum[8];
    __device__ __forceinline__ void operator()(const f32x4 (&acc)[2][2][4][2], const Unit& u, int wr, int wc, int fr, int fq) const {
        int e = u.aux, c_e = 0, t_e = 0;
#pragma unroll
        for (int k = 0; k < 8; ++k) { if (k == e) { c_e = cnt[k]; t_e = cum[k]; } }
        const int s0 = (u.pm - t_e) * BM + wr * 64 + fr, col0 = u.pn * BM + wc * 32 + 4 * fq;
        const int* lp = list + e * 16384;
        int tok[8]; float gt[8];
#pragma unroll
        for (int q = 0; q < 8; ++q) { const int s = s0 + (q >> 2) * HALF + (q & 3) * 16; tok[q] = (s < c_e) ? lp[s] : -1; }
#pragma unroll
        for (int q = 0; q < 8; ++q) gt[q] = (tok[q] >= 0) ? gate[tok[q]] : 0.f;
#pragma unroll
        for (int ai = 0; ai < 2; ++ai) {
            f32x4 o[4][2][2];
#pragma unroll
            for (int m = 0; m < 4; ++m) { const float* rowp = XF + (size_t)(tok[ai * 4 + m] >= 0 ? tok[ai * 4 + m] : 0) * 1024 + col0;
#pragma unroll
                for (int bj = 0; bj < 2; ++bj)
#pragma unroll
                    for (int n = 0; n < 2; ++n) o[m][bj][n] = *(const f32x4*)(rowp + bj * HALF + n * 16); }
#pragma unroll
            for (int m = 0; m < 4; ++m) { if (tok[ai * 4 + m] >= 0) { float* rowp = XF + (size_t)tok[ai * 4 + m] * 1024 + col0; const float g1 = gt[ai * 4 + m];
#pragma unroll
                for (int bj = 0; bj < 2; ++bj)
#pragma unroll
                    for (int n = 0; n < 2; ++n) *(f32x4*)(rowp + bj * HALF + n * 16) = o[m][bj][n] + acc[ai][bj][m][n] * g1; } }
        }
    }
};
struct MoeOrder {
    int T, nN, nwg, G, c; int cum[8]; size_t bstride;
    __device__ void init(const int* cnt, int nN_, int G_, int c_, size_t bstride_) {
        int t = 0;
#pragma unroll
        for (int e = 0; e < 8; ++e) { cum[e] = t; t += (cnt[e] + 255) >> 8; }
        T = t; nN = nN_; nwg = T * nN; G = G_; c = c_; bstride = bstride_;
    }
    __device__ bool next(int i, Unit& u) const {
        const long L = (long)i * G + c; if (L >= nwg) return false;
        int wgid = (int)L; { const int q = nwg / NXCD, r = nwg % NXCD, xcd = wgid % NXCD, off = wgid / NXCD; wgid = (xcd < r ? xcd * (q + 1) : r * (q + 1) + (xcd - r) * q) + off; }
        const int nig = WGM * nN, gid = wgid / nig, fm = gid * WGM, gsz = (T - fm) < WGM ? (T - fm) : WGM;
        u.pm = fm + ((wgid % nig) % gsz); u.pn = (wgid % nig) / gsz;
        int e = 0;
#pragma unroll
        for (int k = 1; k < 8; ++k) e += (u.pm >= cum[k]) ? 1 : 0;
        u.aux = e; return true;
    }
    __device__ __forceinline__ const char* aptr(const Gemm& g, const Unit& u) const { return (const char*)g.A + (size_t)u.pm * ((size_t)BM * g.K * 2); }
    __device__ __forceinline__ const char* bptr(const Gemm& g, const Unit& u) const { return (const char*)g.Bt + (size_t)u.aux * bstride + (size_t)u.pn * ((size_t)BM * g.K * 2); }
    __device__ __forceinline__ void a_ready(const Unit&) const {}
    __device__ __forceinline__ void done(const Unit&) const {}
};
}
#ifndef PG8_SP2
#define PG8_SP2 true
#endif
#ifndef PG8_ALIGN
#define PG8_ALIGN true
#endif

constexpr size_t MiB = 1u << 20;
constexpr size_t WS_CTL = 0, CTL_BYTES = 256 * 1024;
constexpr size_t WS_ROPE = 256 * 1024;
constexpr size_t WS_WIN = 1 * MiB;
constexpr size_t WS_WO = 16 * MiB;
constexpr size_t WS_WGU = 20 * MiB;
constexpr size_t WS_WD = 31 * MiB;
constexpr size_t WS_XB = 37 * MiB;
constexpr size_t WS_GAB = 69 * MiB;
constexpr size_t WS_LIST = WS_GAB + 512 * 1024;
constexpr size_t WS_GATE = WS_LIST + 1 * MiB;
constexpr size_t WS_CD = WS_GATE + 128 * 1024;
constexpr size_t WS_R = 71 * MiB;
constexpr size_t R_HP = 0, R_OB = 112 * MiB, R_U = 144 * MiB, R_WN = 176 * MiB, R_QD = 192 * MiB, R_KDT = 208 * MiB, R_QK = 224 * MiB, R_KV = 232 * MiB;
constexpr size_t R_MIX = 0, R_H = 64 * MiB;
constexpr size_t R_HM = 0, R_WMGU = 140 * MiB, R_WMD = 252 * MiB, R_XG = 308 * MiB;
constexpr size_t WS_END = WS_R + 348 * MiB;
constexpr int CW_TMO = 0, CW_BAR = 4096, CW_MOE = 16384;

constexpr int RING_BYTES = 131072, LDS_BYTES = 147456, LDSCTL_OFF = LDS_BYTES - 512, MISC_OFF = LDSCTL_OFF + 320;

constexpr int PH_PRO = 0;
constexpr int PH_L(int l, int k) { return 1 + 16 * l + k; }
constexpr int K_IN = 0, K_PREP = 1, K_SCAN = 2, K_OUT = 3, K_LN1 = 4, K_GU = 5, K_DN = 6, K_LN2 = 7;
constexpr int K_G0 = 5, K_GU0 = 6, K_DN0 = 7, K_G1 = 8, K_GU1 = 9, K_DN1 = 10, K_LNF = 11;
constexpr int PH_END = PH_L(1, K_LNF) + 1;

struct Args { const float* in[18]; float* out; unsigned char* ws; int ph_lo, ph_hi; };
typedef const __attribute__((address_space(4))) Args* KArgs;
__device__ __forceinline__ KArgs kargs() { KArgs p = (KArgs)__builtin_amdgcn_kernarg_segment_ptr(); asm volatile("" : "+s"(p)); return p; }
__device__ __forceinline__ int tidx() { int t = threadIdx.x; asm volatile("" : "+v"(t)); return t; }

constexpr int TR_SCR = 64 * 65 * 4;
__device__ __forceinline__ void tr_item(const float* W, int N, int k0, int n0, bf16* WT, size_t ldk, int dst_row0, LAS float* scr, int lane) {
    const int nq = 4 * (lane & 15), n = n0 + nq, kr = lane >> 4;
    f32x4 v[16];
#pragma unroll
    for (int i = 0; i < 16; ++i) v[i] = (n < N) ? *(const f32x4*)(W + (size_t)(k0 + 4 * i + kr) * N + n) : (f32x4){0.f, 0.f, 0.f, 0.f};
#pragma unroll
    for (int i = 0; i < 16; ++i) { LAS float* d = scr + (4 * i + kr) * 65 + nq; d[0] = v[i].x; d[1] = v[i].y; d[2] = v[i].z; d[3] = v[i].w; }
    LDS_WAIT(); asm volatile("" ::: "memory");
    const int c = lane & 7;
#pragma unroll
    for (int j = 0; j < 8; ++j) { const int nn = (lane >> 3) + 8 * j; const LAS float* s = scr + (8 * c) * 65 + nn;
        v4u o; o.x = pk2(s[0 * 65], s[1 * 65]); o.y = pk2(s[2 * 65], s[3 * 65]); o.z = pk2(s[4 * 65], s[5 * 65]); o.w = pk2(s[6 * 65], s[7 * 65]);
        *(v4u*)(WT + (size_t)(dst_row0 + nn) * ldk + k0 + 8 * c) = o; }
    LDS_WAIT(); asm volatile("" ::: "memory");
}

__device__ __forceinline__ void ph_prologue(KArgs a, LAS unsigned char* lds, int wave, int lane, int gw, int NGW, int gtid, int NT) {
    unsigned char* ws = a->ws;
    LAS float* scr = (LAS float*)(lds + wave * TR_SCR);
    constexpr int I_IN = 16 * 57, I_O = 16 * 16, I_L = I_IN + I_O, I_G = 16 * 44, I_D = 44 * 16, NIT = 2 * I_L + 2 * I_G + I_D;
    for (int it = gw; it < NIT; it += NGW) {
        int r = it;
        if (r < 2 * I_L) { const int l = r / I_L; r -= l * I_L;
            if (r < I_IN) { const int kb = r / 57, nb = r % 57; tr_item(a->in[1] + (size_t)l * 1024 * IN_COLS, IN_COLS, 64 * kb, 64 * nb, (bf16*)(ws + WS_WIN) + (size_t)l * NIN_PAD * 1024, 1024, 64 * nb, scr, lane); }
            else { r -= I_IN; const int kb = r / 16, nb = r % 16; tr_item(a->in[6] + (size_t)l * 1024 * 1024, 1024, 64 * kb, 64 * nb, (bf16*)(ws + WS_WO) + (size_t)l * 1024 * 1024, 1024, 64 * nb, scr, lane); }
            continue; }
        r -= 2 * I_L;
        if (r < 2 * I_G) { const int up = r / I_G; r -= up * I_G; const int kb = r / 44, nb = r % 44, n0 = 64 * nb;
            tr_item(up ? a->in[12] : a->in[11], FF, 64 * kb, n0, (bf16*)(ws + WS_WGU), 1024, 256 * (n0 >> 7) + (n0 & 127) + 128 * up, scr, lane); continue; }
        r -= 2 * I_G;
        { const int kb = r / 16, nb = r % 16; tr_item(a->in[13], 1024, 64 * kb, 64 * nb, (bf16*)(ws + WS_WD), FF, 64 * nb, scr, lane); }
    }
    for (int i = gtid; i < 2 * 192 * 128; i += NT) { const int l = i / (192 * 128), r = i % (192 * 128);
        ((v4u*)((bf16*)(ws + WS_WIN) + (size_t)l * NIN_PAD * 1024 + (size_t)3648 * 1024))[r] = (v4u){0u, 0u, 0u, 0u}; }
    for (int i = gtid; i < M * D / 8; i += NT) { const f32x4 p = ((const f32x4*)a->in[0])[2 * i], q = ((const f32x4*)a->in[0])[2 * i + 1];
        v4u o; o.x = pk2(p.x, p.y); o.y = pk2(p.z, p.w); o.z = pk2(q.x, q.y); o.w = pk2(q.z, q.w); ((v4u*)(ws + WS_XB))[i] = o; }
    for (int i = gtid; i < SEQ * 32; i += NT) { const int pos = i >> 5, k = i & 31;
        const float inv = powf(10000.0f, -(float)(2 * k) / 64.0f); const float ang = (float)pos * inv;
        double rev = (double)ang * 0.15915494309189535; rev -= floor(rev); const float rf = (float)rev;
        float* R = (float*)(ws + WS_ROPE) + (size_t)pos * 64; R[k] = __builtin_amdgcn_cosf(rf); R[32 + k] = __builtin_amdgcn_sinf(rf); }
}

__device__ __forceinline__ void moe_convert(KArgs a, LAS unsigned char* lds, int wave, int lane, int gw, int NGW) {
    unsigned char* ws = a->ws;
    LAS float* scr = (LAS float*)(lds + wave * TR_SCR);
    constexpr int I_G = 16 * 56, I_D = 56 * 16, I_E = 2 * I_G + I_D;
    for (int it = gw; it < 8 * I_E; it += NGW) {
        const int e = it / I_E; int r = it - e * I_E;
        if (r < 2 * I_G) { const int up = r / I_G; r -= up * I_G; const int kb = r / 56, nb = r % 56, n0 = 64 * nb;
            tr_item((up ? a->in[16] : a->in[15]) + (size_t)e * 1024 * FE, FE, 64 * kb, n0, (bf16*)(ws + WS_R + R_WMGU) + (size_t)e * 7168 * 1024, 1024, 256 * (n0 >> 7) + (n0 & 127) + 128 * up, scr, lane); }
        else { r -= 2 * I_G; const int kb = r / 16, nb = r % 16; tr_item(a->in[17] + (size_t)e * FE * 1024, 1024, 64 * kb, 64 * nb, (bf16*)(ws + WS_R + R_WMD) + (size_t)e * 1024 * FE, FE, 64 * nb, scr, lane); }
    }
}

template <bool ROUTE>
__device__ __forceinline__ void ln_rows(const float* res, float ares, const float* mix, const float* g, const float* bta, float* xf, float oscale, bf16* xb,
                                        const float* router, unsigned* cntw, int* list, float* gate, int lane, int gw, int NGW) {
    f32x4 gv[4], bv[4];
#pragma unroll
    for (int j = 0; j < 4; ++j) { gv[j] = ((const f32x4*)g)[lane + 64 * j]; bv[j] = ((const f32x4*)bta)[lane + 64 * j]; }
    for (int row = gw; row < M; row += NGW) {
        const f32x4* rr = (const f32x4*)(res + (size_t)row * D) + lane;
        f32x4 v[4]; float s = 0.f;
#pragma unroll
        for (int j = 0; j < 4; ++j) { v[j] = rr[64 * j] * ares; }
        if (mix) { const f32x4* mr = (const f32x4*)(mix + (size_t)row * D) + lane;
#pragma unroll
            for (int j = 0; j < 4; ++j) v[j] = v[j] + mr[64 * j]; }
#pragma unroll
        for (int j = 0; j < 4; ++j) s += (v[j].x + v[j].y) + (v[j].z + v[j].w);
        const float mean = wave_sum(s) * (1.f / D); float s2 = 0.f;
#pragma unroll
        for (int j = 0; j < 4; ++j) { v[j] = v[j] - mean; s2 += (v[j].x * v[j].x + v[j].y * v[j].y) + (v[j].z * v[j].z + v[j].w * v[j].w); }
        const float rstd = 1.f / sqrtf(wave_sum(s2) * (1.f / D) + LN_EPS);
#pragma unroll
        for (int j = 0; j < 4; ++j) v[j] = v[j] * rstd * gv[j] + bv[j];
        f32x4* xo = (f32x4*)(xf + (size_t)row * D) + lane;
#pragma unroll
        for (int j = 0; j < 4; ++j) xo[64 * j] = v[j] * oscale;
        if (xb) { v2u* bo = (v2u*)(xb + (size_t)row * D) + lane;
#pragma unroll
            for (int j = 0; j < 4; ++j) { v2u o; o.x = pk2(v[j].x, v[j].y); o.y = pk2(v[j].z, v[j].w); bo[64 * j] = o; } }
        if (ROUTE) {
            float lg[8];
#pragma unroll
            for (int e = 0; e < 8; ++e) lg[e] = 0.f;
#pragma unroll
            for (int j = 0; j < 4; ++j)
#pragma unroll
                for (int i = 0; i < 4; ++i) { const int c = 4 * lane + 256 * j + i; const f32x4 r0 = *(const f32x4*)(router + c * 8), r1 = *(const f32x4*)(router + c * 8 + 4); const float y = v[j][i];
                    lg[0] += y * r0.x; lg[1] += y * r0.y; lg[2] += y * r0.z; lg[3] += y * r0.w; lg[4] += y * r1.x; lg[5] += y * r1.y; lg[6] += y * r1.z; lg[7] += y * r1.w; }
#pragma unroll
            for (int e = 0; e < 8; ++e) lg[e] = wave_sum(lg[e]);
            if (lane == 0) {
                int e0 = 0; float v0 = lg[0];
#pragma unroll
                for (int e = 1; e < 8; ++e) if (lg[e] > v0) { v0 = lg[e]; e0 = e; }
                int e1 = -1; float v1 = -3.0e38f;
#pragma unroll
                for (int e = 0; e < 8; ++e) if (e != e0 && lg[e] > v1) { v1 = lg[e]; e1 = e; }
                const float p1 = __expf(v1 - v0), g0 = 1.f / (1.f + p1), g1 = p1 / (1.f + p1);
                const unsigned s0 = __hip_atomic_fetch_add(cntw + 64 * e0, 1u, RLX_AGENT), s1 = __hip_atomic_fetch_add(cntw + 64 * (8 + e1), 1u, RLX_AGENT);
                list[(size_t)e0 * 16384 + s0] = row; list[(size_t)(8 + e1) * 16384 + s1] = row; gate[row] = g0; gate[16384 + row] = g1;
            }
        }
    }
}

__device__ __forceinline__ void moe_gather(KArgs a, int j, int lane, int gw, int NGW) {
    unsigned char* ws = a->ws; const unsigned* cntw = (const unsigned*)(ws + WS_CTL) + CW_MOE + 64 * (j * 8);
    int pre[8], cum[8]; { int p = 0, t = 0;
#pragma unroll
        for (int e = 0; e < 8; ++e) { const int c = (int)cntw[64 * e]; pre[e] = p; cum[e] = t; p += c; t += (c + 255) >> 8; } }
    const int* list = (const int*)(ws + WS_LIST) + (size_t)j * 8 * 16384;
    for (int r0 = gw; r0 < M; r0 += 8 * NGW) {
        int tok[8], drow[8];
#pragma unroll
        for (int q = 0; q < 8; ++q) { const int r = r0 + q * NGW; tok[q] = -1; drow[q] = 0;
            if (r < M) { int e = 0;
#pragma unroll
                for (int k = 1; k < 8; ++k) e += (r >= pre[k]) ? 1 : 0;
                int pe = 0, ce = 0;
#pragma unroll
                for (int k = 0; k < 8; ++k) if (k == e) { pe = pre[k]; ce = cum[k]; }
                const int s = r - pe; tok[q] = list[(size_t)e * 16384 + s]; drow[q] = ce * 256 + s; } }
        v4u x0[8], x1[8];
#pragma unroll
        for (int q = 0; q < 8; ++q) { const v4u* src = (const v4u*)((const bf16*)(ws + WS_XB) + (size_t)(tok[q] >= 0 ? tok[q] : 0) * 1024); x0[q] = src[lane]; x1[q] = src[lane + 64]; }
#pragma unroll
        for (int q = 0; q < 8; ++q) if (tok[q] >= 0) { v4u* dst = (v4u*)((bf16*)(ws + WS_R + R_XG) + (size_t)drow[q] * 1024); dst[lane] = x0[q]; dst[lane + 64] = x1[q]; }
    }
}

__device__ __forceinline__ void gdn_prep_unit(KArgs a, int l, int unit, LAS unsigned char* lds, int tid, int lane, int wave) {
    unsigned char* ws = a->ws;
    const int n = unit & 31, bh = unit >> 5, h = bh & 3, b = bh >> 2;
    const int t0 = b * SEQ + n * 64;
    LAS float* Q = (LAS float*)lds; LAS float* K = Q + 8192; LAS float* V = K + 8192; LAS float* A = V + 8192; LAS float* gc = A + 4096; LAS float* bt = gc + 64;
    const bf16* HP = (const bf16*)(ws + WS_R + R_HP);
    const float* cw = a->in[2] + (size_t)l * 4 * 1536;
    __syncthreads();
    for (int idx = tid; idx < 64 * 384; idx += 512) { const int i = idx / 384, c = idx % 384, which = c >> 7, d = c & 127;
        const int col = COL_GQ + which * 512 + h * 128 + d, cc = which * 512 + h * 128 + d; float acc = 0.f;
#pragma unroll
        for (int j = 0; j < 4; ++j) { const int s = n * 64 + i - 3 + j; if (s >= 0) acc += cw[j * 1536 + cc] * bf2f(HP[(size_t)(b * SEQ + s) * HP_LD + col]); }
        const float y = siluf(acc); LAS float* dst = which == 0 ? Q : (which == 1 ? K : V); dst[i * 128 + d] = y; }
    if (tid < 64) { const float* gab = (const float*)(ws + WS_GAB) + (size_t)(t0 + tid) * 8; const float x = gab[h] + a->in[4][l * 4 + h];
        const float sp = fmaxf(x, 0.f) + log1pf(__expf(-fabsf(x))); gc[tid] = -__expf(a->in[3][l * 4 + h]) * sp; bt[tid] = sigmf(gab[4 + h]); }
    __syncthreads();
#pragma unroll 1
    for (int r = 0; r < 8; ++r) { const int i = wave * 8 + r;
        float q0 = Q[i * 128 + lane], q1 = Q[i * 128 + lane + 64], k0 = K[i * 128 + lane], k1 = K[i * 128 + lane + 64];
        const float sq = wave_sum(q0 * q0 + q1 * q1), sk = wave_sum(k0 * k0 + k1 * k1);
        const float fq = rsqrtf(sq + NORM_EPS) * 0.08838834764831845f, fk = rsqrtf(sk + NORM_EPS);
        Q[i * 128 + lane] = q0 * fq; Q[i * 128 + lane + 64] = q1 * fq; K[i * 128 + lane] = k0 * fk; K[i * 128 + lane + 64] = k1 * fk; }
    if (tid == 0) { float c = 0.f; for (int i = 0; i < 64; ++i) { c += gc[i]; gc[i] = c; } }
    __syncthreads();
    bf16* QKg = (bf16*)(ws + WS_R + R_QK) + (size_t)unit * 4096; bf16* QDg = (bf16*)(ws + WS_R + R_QD) + (size_t)unit * 8192; bf16* KDTg = (bf16*)(ws + WS_R + R_KDT) + (size_t)unit * 8192;
    bf16* WNg = (bf16*)(ws + WS_R + R_WN) + (size_t)unit * 8192; bf16* Ug = (bf16*)(ws + WS_R + R_U) + (size_t)unit * 8192;
    for (int idx = tid; idx < 4096; idx += 512) { const int i = idx >> 6, j = idx & 63; float dqk = 0.f, dkk = 0.f;
        for (int dd = 0; dd < 128; ++dd) { const int d = (dd + j) & 127; const float kj = K[j * 128 + d]; dqk += Q[i * 128 + d] * kj; dkk += K[i * 128 + d] * kj; }
        const float dec = __expf(gc[i] - gc[j]);
        A[i * 64 + j] = (j < i) ? bt[i] * dkk * dec : 0.f;
        QKg[fragoff(i, j, 2)] = (bf16)f2bf((j <= i) ? dqk * dec : 0.f); }
    const float gl = gc[63];
    for (int idx = tid; idx < 8192; idx += 512) { const int i = idx >> 7, d = idx & 127;
        QDg[fragoff(i, d, 4)] = (bf16)f2bf(Q[i * 128 + d] * __expf(gc[i]));
        KDTg[fragoff(d, i, 2)] = (bf16)f2bf(K[i * 128 + d] * __expf(gl - gc[i])); }
    if (tid == 0) ((float*)(ws + WS_CD))[unit] = __expf(gl);
    __syncthreads();
    for (int idx = tid; idx < 8192; idx += 512) { const int i = idx >> 7; const float bi = bt[i]; V[idx] *= bi; Q[idx] = bi * __expf(gc[i]) * K[idx]; }
    __syncthreads();
    if (tid < 256) { LAS float* buf = (tid < 128 ? V : Q) + (tid & 127);
        for (int i = 1; i < 64; ++i) { float acc = buf[i * 128]; for (int m = 0; m < i; ++m) acc -= A[i * 64 + m] * buf[m * 128]; buf[i * 128] = acc; } }
    __syncthreads();
    for (int idx = tid; idx < 8192; idx += 512) { const int i = idx >> 7, d = idx & 127; Ug[uoff(i, d)] = (bf16)f2bf(V[idx]); WNg[fragoff(i, d, 4)] = (bf16)f2bf(-Q[idx]); }
}

__device__ __forceinline__ void gdn_scan_naive(KArgs a, int l, int bh, LAS unsigned char* lds, int tid, int lane, int wave) {
    unsigned char* ws = a->ws;
    LAS float* S = (LAS float*)lds; LAS float* VN = S + 16384; LAS float* O = VN + 8192;
    const int h = bh & 3, b = bh >> 2, e = tid & 127, ig = tid >> 7;
    const bf16* HP = (const bf16*)(ws + WS_R + R_HP); bf16* OB = (bf16*)(ws + WS_R + R_OB);
    const float* nw = a->in[5] + l * 128;
    __syncthreads();
    for (int idx = tid; idx < 16384; idx += 512) S[idx] = 0.f;
    __syncthreads();
#pragma unroll 1
    for (int n = 0; n < 32; ++n) {
        const int unit = bh * 32 + n;
        const bf16* Ug = (const bf16*)(ws + WS_R + R_U) + (size_t)unit * 8192; const bf16* WNg = (const bf16*)(ws + WS_R + R_WN) + (size_t)unit * 8192;
        const bf16* QDg = (const bf16*)(ws + WS_R + R_QD) + (size_t)unit * 8192; const bf16* KDTg = (const bf16*)(ws + WS_R + R_KDT) + (size_t)unit * 8192;
        const bf16* QKg = (const bf16*)(ws + WS_R + R_QK) + (size_t)unit * 4096; const float cd = ((const float*)(ws + WS_CD))[unit];
#pragma unroll 1
        for (int r = 0; r < 16; ++r) { const int i = ig + 4 * r; float acc = bf2f(Ug[uoff(i, e)]);
#pragma unroll 2
            for (int d0 = 0; d0 < 128; d0 += 4) { const v2u w = *(const v2u*)(WNg + fragoff(i, d0, 4));
                acc += bflo(w.x) * S[d0 * 128 + e] + bfhi(w.x) * S[(d0 + 1) * 128 + e] + bflo(w.y) * S[(d0 + 2) * 128 + e] + bfhi(w.y) * S[(d0 + 3) * 128 + e]; }
            VN[i * 128 + e] = acc; }
        __syncthreads();
#pragma unroll 1
        for (int r = 0; r < 16; ++r) { const int i = ig + 4 * r; float acc = 0.f;
#pragma unroll 2
            for (int d0 = 0; d0 < 128; d0 += 4) { const v2u w = *(const v2u*)(QDg + fragoff(i, d0, 4));
                acc += bflo(w.x) * S[d0 * 128 + e] + bfhi(w.x) * S[(d0 + 1) * 128 + e] + bflo(w.y) * S[(d0 + 2) * 128 + e] + bfhi(w.y) * S[(d0 + 3) * 128 + e]; }
#pragma unroll 2
            for (int j0 = 0; j0 < 64; j0 += 4) { const v2u w = *(const v2u*)(QKg + fragoff(i, j0, 2));
                acc += bflo(w.x) * VN[j0 * 128 + e] + bfhi(w.x) * VN[(j0 + 1) * 128 + e] + bflo(w.y) * VN[(j0 + 2) * 128 + e] + bfhi(w.y) * VN[(j0 + 3) * 128 + e]; }
            O[i * 128 + e] = acc; }
        __syncthreads();
#pragma unroll 1
        for (int r = 0; r < 32; ++r) { const int d = ig + 4 * r; float acc = S[d * 128 + e] * cd;
#pragma unroll 2
            for (int i0 = 0; i0 < 64; i0 += 4) { const v2u w = *(const v2u*)(KDTg + fragoff(d, i0, 2));
                acc += bflo(w.x) * VN[i0 * 128 + e] + bfhi(w.x) * VN[(i0 + 1) * 128 + e] + bflo(w.y) * VN[(i0 + 2) * 128 + e] + bfhi(w.y) * VN[(i0 + 3) * 128 + e]; }
            S[d * 128 + e] = acc; }
#pragma unroll 1
        for (int r = 0; r < 8; ++r) { const int i = wave * 8 + r; const float v0 = O[i * 128 + lane], v1 = O[i * 128 + lane + 64];
            const float rs = rsqrtf(wave_sum(v0 * v0 + v1 * v1) * (1.f / 128.f) + NORM_EPS);
            const size_t t = (size_t)b * SEQ + n * 64 + i; const bf16* gp = HP + t * HP_LD + COL_GG + h * 128; bf16* op = OB + t * 1024 + 512 + h * 128;
            op[lane] = (bf16)f2bf(v0 * rs * nw[lane] * siluf(bf2f(gp[lane]))); op[lane + 64] = (bf16)f2bf(v1 * rs * nw[lane + 64] * siluf(bf2f(gp[lane + 64]))); }
        __syncthreads();
    }
}

__device__ __forceinline__ void ret_unit_naive(KArgs a, int unit, LAS unsigned char* lds, int tid, int lane, int wave) {
    unsigned char* ws = a->ws;
    LAS float* Qs = (LAS float*)lds; LAS float* Ks = Qs + 64 * 65; LAS float* Vs = Ks + 64 * 65; LAS float* Sc = Vs + 8192;
    const int qb = unit & 31, bh = unit >> 5, h = bh & 3, b = bh >> 2, e = tid & 127, ig = tid >> 7;
    const bf16* HP = (const bf16*)(ws + WS_R + R_HP); bf16* OB = (bf16*)(ws + WS_R + R_OB); const float* RT = (const float*)(ws + WS_ROPE);
    const float log2g = log2f(1.0f - exp2f(-5.0f - (float)h));
    __syncthreads();
    for (int idx = tid; idx < 4096; idx += 512) { const int i = idx >> 6, d = idx & 63, dd = d & 31, pos = qb * 64 + i; const size_t t = (size_t)b * SEQ + pos;
        const float c = RT[pos * 64 + dd], s = RT[pos * 64 + 32 + dd]; const float x1 = bf2f(HP[t * HP_LD + COL_RQ + h * 64 + dd]), x2 = bf2f(HP[t * HP_LD + COL_RQ + h * 64 + dd + 32]);
        Qs[i * 65 + d] = d < 32 ? x1 * c - x2 * s : x1 * s + x2 * c; }
    float acc[16];
#pragma unroll
    for (int r = 0; r < 16; ++r) acc[r] = 0.f;
#pragma unroll 1
    for (int kb = 0; kb <= qb; ++kb) {
        __syncthreads();
        for (int idx = tid; idx < 4096; idx += 512) { const int i = idx >> 6, d = idx & 63, dd = d & 31, pos = kb * 64 + i; const size_t t = (size_t)b * SEQ + pos;
            const float c = RT[pos * 64 + dd], s = RT[pos * 64 + 32 + dd]; const float x1 = bf2f(HP[t * HP_LD + COL_RK + h * 64 + dd]), x2 = bf2f(HP[t * HP_LD + COL_RK + h * 64 + dd + 32]);
            Ks[i * 65 + d] = 0.125f * (d < 32 ? x1 * c - x2 * s : x1 * s + x2 * c); }
        for (int idx = tid; idx < 8192; idx += 512) { const int i = idx >> 7, d = idx & 127; Vs[idx] = bf2f(HP[((size_t)b * SEQ + kb * 64 + i) * HP_LD + COL_RV + h * 128 + d]); }
        __syncthreads();
        { const int j = tid & 63, ig8 = tid >> 6;
#pragma unroll 1
          for (int r = 0; r < 8; ++r) { const int i = ig8 + 8 * r; float dot = 0.f;
#pragma unroll 8
              for (int d = 0; d < 64; ++d) dot += Qs[i * 65 + d] * Ks[j * 65 + d];
              const int delta = (qb - kb) * 64 + i - j; Sc[i * 65 + j] = delta >= 0 ? dot * exp2f((float)delta * log2g) : 0.f; } }
        __syncthreads();
#pragma unroll 2
        for (int j = 0; j < 64; ++j) { const float vv = Vs[j * 128 + e];
#pragma unroll
            for (int r = 0; r < 16; ++r) acc[r] += Sc[(ig + 4 * r) * 65 + j] * vv; }
    }
    __syncthreads();
#pragma unroll
    for (int r = 0; r < 16; ++r) Vs[(ig + 4 * r) * 128 + e] = acc[r];
    __syncthreads();
#pragma unroll 1
    for (int r = 0; r < 8; ++r) { const int i = wave * 8 + r; const float v0 = Vs[i * 128 + lane], v1 = Vs[i * 128 + lane + 64];
        const float mean = wave_sum(v0 + v1) * (1.f / 128.f), d0 = v0 - mean, d1 = v1 - mean; const float rs = rsqrtf(wave_sum(d0 * d0 + d1 * d1) * (1.f / 128.f) + LN_EPS);
        const size_t t = (size_t)b * SEQ + qb * 64 + i; const bf16* gp = HP + t * HP_LD + COL_RG + h * 128; bf16* op = OB + t * 1024 + h * 128;
        op[lane] = (bf16)f2bf(d0 * rs * siluf(bf2f(gp[lane]))); op[lane + 64] = (bf16)f2bf(d1 * rs * siluf(bf2f(gp[lane + 64]))); }
}

typedef float f32x16 __attribute__((ext_vector_type(16)));
typedef float f32x8 __attribute__((ext_vector_type(8)));
typedef __bf16 bf8v __attribute__((ext_vector_type(8)));
typedef short bf16x8 __attribute__((ext_vector_type(8)));
#define MFMA32(a, b, c) __builtin_amdgcn_mfma_f32_32x32x16_bf16((a), (b), (c), 0, 0, 0)
__device__ __forceinline__ bf16x8 pack8(const f32x16& x, int s) {
    f32x8 v;
#pragma unroll
    for (int j = 0; j < 8; ++j) v[j] = x[8 * s + j];
    return __builtin_bit_cast(bf16x8, __builtin_convertvector(v, bf8v));
}

__device__ __forceinline__ unsigned short bfc(float x) { return __builtin_bit_cast(unsigned short, (__bf16)x); }
__device__ __forceinline__ unsigned bfc2(float lo, float hi) { return (unsigned)bfc(lo) | ((unsigned)bfc(hi) << 16); }

#define GDN_BAR() do { asm volatile("s_waitcnt lgkmcnt(0)" ::: "memory"); __builtin_amdgcn_s_barrier(); asm volatile("" ::: "memory"); } while (0)
__device__ __forceinline__ void gdn_scan_fast(KArgs a, int l, int bh, LAS unsigned char* lds, int tid, int lane, int wave) {
    unsigned char* ws = a->ws;
    constexpr int FB_WN = 0, FB_QD = 16384, FB_KDT = 32768, FB_QK = 49152, FB_U = 57344, FB_BYTES = 73728;
    LAS float* OL = (LAS float*)(lds + FB_BYTES);
    constexpr int OLS = 64 * 132;
    const int h = bh & 3, b = bh >> 2, c = lane & 31, hh = lane >> 5;
    const bf16* HP = (const bf16*)(ws + WS_R + R_HP); bf16* OB = (bf16*)(ws + WS_R + R_OB);
    const float* nw = a->in[5] + l * 128;
    const unsigned char* gWN = (const unsigned char*)(ws + WS_R + R_WN) + (size_t)bh * 32 * 16384; const unsigned char* gQD = (const unsigned char*)(ws + WS_R + R_QD) + (size_t)bh * 32 * 16384;
    const unsigned char* gKDT = (const unsigned char*)(ws + WS_R + R_KDT) + (size_t)bh * 32 * 16384; const unsigned char* gQK = (const unsigned char*)(ws + WS_R + R_QK) + (size_t)bh * 32 * 8192;
    const unsigned char* gU = (const unsigned char*)(ws + WS_R + R_U) + (size_t)bh * 32 * 16384;
    const int et = tid - 256;
#define GDN_FETCH(pf, nn) do { _Pragma("unroll") for (int k = 0; k < 18; ++k) { const unsigned char* src_ = k < 4 ? gWN + (size_t)(nn) * 16384 + k * 4096 : k < 8 ? gQD + (size_t)(nn) * 16384 + (k - 4) * 4096 : \
        k < 12 ? gKDT + (size_t)(nn) * 16384 + (k - 8) * 4096 : k < 14 ? gQK + (size_t)(nn) * 8192 + (k - 12) * 4096 : gU + (size_t)(nn) * 16384 + (k - 14) * 4096; pf[k] = *(const v4u*)(src_ + et * 16); } } while (0)
#define GDN_STORE(pf) do { _Pragma("unroll") for (int k = 0; k < 18; ++k) *(LAS v4u*)(lds + k * 4096 + et * 16) = pf[k]; } while (0)
    __syncthreads();
    if (wave < 4) {
        f32x16 S[4];
#pragma unroll
        for (int t = 0; t < 4; ++t)
#pragma unroll
            for (int i = 0; i < 16; ++i) S[t][i] = 0.f;
        GDN_BAR();
        const int q = wave;
        const LAS bf16x8* WNf = (const LAS bf16x8*)(lds + FB_WN) + lane; const LAS bf16x8* QDf = (const LAS bf16x8*)(lds + FB_QD) + lane;
        const LAS bf16x8* KDTf = (const LAS bf16x8*)(lds + FB_KDT) + lane; const LAS bf16x8* QKf = (const LAS bf16x8*)(lds + FB_QK) + lane;
        const LAS v4u* Uf = (const LAS v4u*)(lds + FB_U) + (q * 2) * 128 + lane;
#pragma unroll 1
        for (int n = 0; n < 32; ++n) {
            const float cd = ((const float*)(ws + WS_CD))[bh * 32 + n];
            bf16x8 A0[8], A1[8];
#define GDN_LD_MTS(A, F, g) do { _Pragma("unroll") for (int k = 0; k < 8; ++k) { const int m_ = k & 1, s_ = (k >> 1) & 1, t_ = 2 * (g) + (k >> 2); A[k] = F[((m_ * 4 + t_) * 2 + s_) * 64]; } } while (0)
#define GDN_LD_TMS(A, F, g) do { _Pragma("unroll") for (int k = 0; k < 8; ++k) { const int s_ = k & 1, m_ = (k >> 1) & 1, t_ = 2 * (g) + (k >> 2); A[k] = F[((t_ * 2 + m_) * 2 + s_) * 64]; } } while (0)
            GDN_LD_MTS(A0, WNf, 0); GDN_LD_MTS(A1, WNf, 1);
            f32x16 av[2];
#pragma unroll
            for (int m = 0; m < 2; ++m)
#pragma unroll
                for (int hf = 0; hf < 2; ++hf) { const v4u u4 = Uf[(m * 2 + hf) * 64];
#pragma unroll
                    for (int k = 0; k < 4; ++k) { av[m][8 * hf + 2 * k] = bflo(u4[k]); av[m][8 * hf + 2 * k + 1] = bfhi(u4[k]); } }
            bf16x8 Sb[4][2];
#pragma unroll
            for (int t = 0; t < 4; ++t) { Sb[t][0] = pack8(S[t], 0); Sb[t][1] = pack8(S[t], 1); }
#pragma unroll
            for (int k = 0; k < 8; ++k) { const int m_ = k & 1, s_ = (k >> 1) & 1, t_ = (k >> 2); av[m_] = MFMA32(A0[k], Sb[t_][s_], av[m_]); }
            GDN_LD_MTS(A0, QDf, 0);
#pragma unroll
            for (int k = 0; k < 8; ++k) { const int m_ = k & 1, s_ = (k >> 1) & 1, t_ = 2 + (k >> 2); av[m_] = MFMA32(A1[k], Sb[t_][s_], av[m_]); }
            GDN_LD_MTS(A1, QDf, 1);
            f32x16 ao[2];
#pragma unroll
            for (int m = 0; m < 2; ++m)
#pragma unroll
                for (int i = 0; i < 16; ++i) ao[m][i] = 0.f;
#pragma unroll
            for (int k = 0; k < 8; ++k) { const int m_ = k & 1, s_ = (k >> 1) & 1, t_ = (k >> 2); ao[m_] = MFMA32(A0[k], Sb[t_][s_], ao[m_]); }
#pragma unroll
            for (int k = 0; k < 6; ++k) { const int s_ = k & 1, m_ = k >= 2 ? 1 : 0, mp_ = k >= 4 ? 1 : 0; A0[k] = QKf[((m_ * 2 + mp_) * 2 + s_) * 64]; }
#pragma unroll
            for (int k = 0; k < 8; ++k) { const int m_ = k & 1, s_ = (k >> 1) & 1, t_ = 2 + (k >> 2); ao[m_] = MFMA32(A1[k], Sb[t_][s_], ao[m_]); }
            GDN_LD_TMS(A1, KDTf, 0);
            bf16x8 Vb[2][2];
#pragma unroll
            for (int m = 0; m < 2; ++m) { Vb[m][0] = pack8(av[m], 0); Vb[m][1] = pack8(av[m], 1); }
#pragma unroll
            for (int k = 0; k < 6; ++k) { const int s_ = k & 1, m_ = k >= 2 ? 1 : 0, mp_ = k >= 4 ? 1 : 0; ao[m_] = MFMA32(A0[k], Vb[mp_][s_], ao[m_]); }
            GDN_LD_TMS(A0, KDTf, 1);
            {   LAS float* Ob = OL + (n & 1) * OLS + 32 * wave + c;
#pragma unroll
                for (int m = 0; m < 2; ++m)
#pragma unroll
                    for (int i = 0; i < 16; ++i) Ob[(32 * m + (i & 3) + 8 * (i >> 2) + 4 * hh) * 132] = ao[m][i]; }
#pragma unroll
            for (int t = 0; t < 4; ++t)
#pragma unroll
                for (int i = 0; i < 16; ++i) S[t][i] *= cd;
#pragma unroll
            for (int k = 0; k < 8; ++k) { const int s_ = k & 1, m_ = (k >> 1) & 1, t_ = (k >> 2); S[t_] = MFMA32(A1[k], Vb[m_][s_], S[t_]); }
#pragma unroll
            for (int k = 0; k < 8; ++k) { const int s_ = k & 1, m_ = (k >> 1) & 1, t_ = 2 + (k >> 2); S[t_] = MFMA32(A0[k], Vb[m_][s_], S[t_]); }
#undef GDN_LD_MTS
#undef GDN_LD_TMS
            GDN_BAR();
            GDN_BAR();
        }
        GDN_BAR(); GDN_BAR();
    } else {
        v4u pfA[18], pfB[18];
        LAS float* NWl = OL + 2 * OLS;
        if (et < 128) NWl[et] = nw[et];
        GDN_FETCH(pfB, 0); GDN_FETCH(pfA, 1); GDN_STORE(pfB);
        GDN_BAR();
        const int i = et >> 2, qd = et & 3;
#define GDN_LOADER_ITER(n, PF_FETCH, PF_STORE) do { \
            if ((n) + 2 < 32) GDN_FETCH(PF_FETCH, (n) + 2); \
            if ((n) > 0) { \
                const LAS float* Ob = OL + (((n) - 1) & 1) * OLS + i * 132 + 32 * qd; \
                float ss = 0.f; \
                _Pragma("unroll") for (int k = 0; k < 8; ++k) { const f32x4 v_ = *(const LAS f32x4*)(Ob + 4 * k); ss += (v_.x * v_.x + v_.y * v_.y) + (v_.z * v_.z + v_.w * v_.w); } \
                ss += __shfl_xor(ss, 1); ss += __shfl_xor(ss, 2); \
                const float rs = rsqrtf(ss * (1.f / 128.f) + NORM_EPS); \
                bf16* op = OB + ((size_t)b * SEQ + ((n) - 1) * 64 + i) * 1024 + 512 + h * 128 + 32 * qd; \
                _Pragma("unroll") for (int k = 0; k < 4; ++k) { const f32x4 w0 = *(const LAS f32x4*)(NWl + 32 * qd + 8 * k), w1 = *(const LAS f32x4*)(NWl + 32 * qd + 8 * k + 4); const v4u gg = gq[k]; \
                    const f32x4 a0 = *(const LAS f32x4*)(Ob + 8 * k), a1 = *(const LAS f32x4*)(Ob + 8 * k + 4); \
                    v4u o; o.x = bfc2(a0.x * rs * w0.x * siluf(bflo(gg.x)), a0.y * rs * w0.y * siluf(bfhi(gg.x))); o.y = bfc2(a0.z * rs * w0.z * siluf(bflo(gg.y)), a0.w * rs * w0.w * siluf(bfhi(gg.y))); \
                    o.z = bfc2(a1.x * rs * w1.x * siluf(bflo(gg.z)), a1.y * rs * w1.y * siluf(bfhi(gg.z))); o.w = bfc2(a1.z * rs * w1.z * siluf(bflo(gg.w)), a1.w * rs * w1.w * siluf(bfhi(gg.w))); \
                    *(v4u*)(op + 8 * k) = o; } \
            } \
            asm volatile("" ::: "memory"); \
            if ((n) < 32) { const bf16* gp = HP + ((size_t)b * SEQ + (n) * 64 + i) * HP_LD + COL_GG + h * 128 + 32 * qd;     \
                _Pragma("unroll") for (int k = 0; k < 4; ++k) gq[k] = *(const v4u*)(gp + 8 * k); } \
            GDN_BAR();            \
            if ((n) + 1 < 32) GDN_STORE(PF_STORE); \
            GDN_BAR();            \
        } while (0)
        v4u gq[4];
#pragma unroll
        for (int k = 0; k < 4; ++k) gq[k] = (v4u){0u, 0u, 0u, 0u};
#pragma unroll
        for (int n = 0; n < 32; n += 2) {
            GDN_LOADER_ITER(n, pfB, pfA);
            GDN_LOADER_ITER(n + 1, pfA, pfB);
        }
        GDN_LOADER_ITER(32, pfB, pfA);
#undef GDN_LOADER_ITER
    }
#undef GDN_FETCH
#undef GDN_STORE
}

struct RetLds {
    static constexpr int QS = 72, JS = 136;
    static constexpr int P = 0, Q1 = 34816, K1 = 53248, OL = 0, K1T = 71680, VT = 89088, ST = 123904;
};
template <bool WANT_Q, bool WANT_K1, bool WANT_K1T>
__device__ __forceinline__ void ret_stage(const bf16* HP, const float* RT, int b, int h, int n, float lg, LAS unsigned char* lds, int tid) {
    constexpr int QS = RetLds::QS, JS = RetLds::JS;
    LAS bf16* Q1 = (LAS bf16*)(lds + RetLds::Q1); LAS bf16* K1 = (LAS bf16*)(lds + RetLds::K1); LAS bf16* K1T = (LAS bf16*)(lds + RetLds::K1T); LAS bf16* VT = (LAS bf16*)(lds + RetLds::VT);
    const int i = tid >> 2, dd = (tid & 3) * 8, pos = n * 128 + i; const size_t t = (size_t)b * SEQ + pos;
    const bf16* hp = HP + t * HP_LD;
    const f32x4 c0 = *(const f32x4*)(RT + pos * 64 + dd), c1 = *(const f32x4*)(RT + pos * 64 + dd + 4), s0 = *(const f32x4*)(RT + pos * 64 + 32 + dd), s1 = *(const f32x4*)(RT + pos * 64 + 32 + dd + 4);
    const float cs[8] = {c0.x, c0.y, c0.z, c0.w, c1.x, c1.y, c1.z, c1.w}, sn[8] = {s0.x, s0.y, s0.z, s0.w, s1.x, s1.y, s1.z, s1.w};
    const float sq = exp2f((float)i * lg), sk = 0.125f * exp2f(-(float)i * lg);
    v4u xv[4];
#pragma unroll
    for (int p = 0; p < 4; ++p) { const int idx = tid + 512 * p, j = idx >> 4, e0 = (idx & 15) * 8; xv[p] = *(const v4u*)(HP + ((size_t)b * SEQ + n * 128 + j) * HP_LD + COL_RV + h * 128 + e0); }
#pragma unroll
    for (int which = (WANT_Q ? 0 : 1); which < 2; ++which) {
        const bf16* src = hp + (which == 0 ? COL_RQ : COL_RK) + h * 64 + dd;
        const v4u x1 = *(const v4u*)src, x2 = *(const v4u*)(src + 32);
        const float sc = which == 0 ? sq : sk;
        float lo[8], hi[8];
#pragma unroll
        for (int k = 0; k < 4; ++k) { const float a0 = bflo(x1[k]), a1 = bfhi(x1[k]), b0 = bflo(x2[k]), b1 = bfhi(x2[k]);
            lo[2 * k] = (a0 * cs[2 * k] - b0 * sn[2 * k]) * sc; lo[2 * k + 1] = (a1 * cs[2 * k + 1] - b1 * sn[2 * k + 1]) * sc;
            hi[2 * k] = (a0 * sn[2 * k] + b0 * cs[2 * k]) * sc; hi[2 * k + 1] = (a1 * sn[2 * k + 1] + b1 * cs[2 * k + 1]) * sc; }
        v4u wl, wh;
#pragma unroll
        for (int k = 0; k < 4; ++k) { wl[k] = bfc2(lo[2 * k], lo[2 * k + 1]); wh[k] = bfc2(hi[2 * k], hi[2 * k + 1]); }
        if (which == 0 || WANT_K1) { LAS bf16* dst = (which == 0 ? Q1 : K1) + i * QS + dd; *(LAS v4u*)dst = wl; *(LAS v4u*)(dst + 32) = wh; }
        if (which == 1 && WANT_K1T) {
#pragma unroll
            for (int k = 0; k < 4; ++k) { K1T[(dd + 2 * k) * JS + i] = (bf16)(wl[k] & 0xffffu); K1T[(dd + 2 * k + 1) * JS + i] = (bf16)(wl[k] >> 16);
                K1T[(32 + dd + 2 * k) * JS + i] = (bf16)(wh[k] & 0xffffu); K1T[(32 + dd + 2 * k + 1) * JS + i] = (bf16)(wh[k] >> 16); }
        }
    }
#pragma unroll
    for (int p = 0; p < 4; ++p) { const int idx = tid + 512 * p, j = idx >> 4, e0 = (idx & 15) * 8;
#pragma unroll
        for (int k = 0; k < 4; ++k) { VT[(e0 + 2 * k) * JS + j] = (bf16)(xv[p][k] & 0xffffu); VT[(e0 + 2 * k + 1) * JS + j] = (bf16)(xv[p][k] >> 16); } }
}
__device__ __forceinline__ void ret_kv_unit(KArgs a, int unit, LAS unsigned char* lds, int tid, int lane, int wave) {
    unsigned char* ws = a->ws;
    constexpr int JS = RetLds::JS;
    const int n = unit & 15, bh = unit >> 4, h = bh & 3, b = bh >> 2, c = lane & 31, hh = lane >> 5;
    const bf16* HP = (const bf16*)(ws + WS_R + R_HP); const float* RT = (const float*)(ws + WS_ROPE);
    const float gam = 1.0f - exp2f(-5.0f - (float)h), lg = log2f(gam), g127 = exp2f(127.f * lg);
    LAS bf16* K1T = (LAS bf16*)(lds + RetLds::K1T); LAS bf16* VT = (LAS bf16*)(lds + RetLds::VT);
    __syncthreads();
    ret_stage<false, false, true>(HP, RT, b, h, n, lg, lds, tid);
    __syncthreads();
    const int td = wave >> 2, te = wave & 3;
    f32x16 kv;
#pragma unroll
    for (int i = 0; i < 16; ++i) kv[i] = 0.f;
#pragma unroll
    for (int ks = 0; ks < 8; ++ks) kv = MFMA32(*(const LAS bf16x8*)(K1T + (32 * td + c) * JS + 16 * ks + 8 * hh), *(const LAS bf16x8*)(VT + (32 * te + c) * JS + 16 * ks + 8 * hh), kv);
    float* dst = (float*)(ws + WS_R + R_KV) + ((size_t)(unit * 8 + wave) * 64 + lane) * 16;
#pragma unroll
    for (int g = 0; g < 4; ++g) *(f32x4*)(dst + 4 * g) = (f32x4){kv[4 * g] * g127, kv[4 * g + 1] * g127, kv[4 * g + 2] * g127, kv[4 * g + 3] * g127};
}
__device__ __forceinline__ void ret_out_unit(KArgs a, int unit, LAS unsigned char* lds, int tid, int lane, int wave) {
    unsigned char* ws = a->ws;
    constexpr int QS = RetLds::QS, JS = RetLds::JS;
    LAS bf16* P = (LAS bf16*)(lds + RetLds::P); LAS bf16* Q1 = (LAS bf16*)(lds + RetLds::Q1); LAS bf16* K1 = (LAS bf16*)(lds + RetLds::K1); LAS float* OL = (LAS float*)(lds + RetLds::OL);
    LAS bf16* VT = (LAS bf16*)(lds + RetLds::VT); LAS bf16* ST = (LAS bf16*)(lds + RetLds::ST);
    const int n = unit & 15, bh = unit >> 4, h = bh & 3, b = bh >> 2, c = lane & 31, hh = lane >> 5;
    const bf16* HP = (const bf16*)(ws + WS_R + R_HP); bf16* OB = (bf16*)(ws + WS_R + R_OB); const float* RT = (const float*)(ws + WS_ROPE);
    const float gam = 1.0f - exp2f(-5.0f - (float)h), lg = log2f(gam), g128 = exp2f(128.f * lg);
    __syncthreads();
    const int ei = tid >> 2, eq = tid & 3; const size_t et = (size_t)b * SEQ + n * 128 + ei;
    v4u gg[4];
    { const bf16* gp = HP + et * HP_LD + COL_RG + h * 128 + 32 * eq;
#pragma unroll
      for (int k = 0; k < 4; ++k) gg[k] = *(const v4u*)(gp + 8 * k); }
    {
        const int td = wave >> 2, te = wave & 3;
        f32x16 S;
#pragma unroll
        for (int i = 0; i < 16; ++i) S[i] = 0.f;
        const float* src = (const float*)(ws + WS_R + R_KV) + ((size_t)((bh * 16) * 8 + wave) * 64 + lane) * 16;
#pragma unroll 2
        for (int m = 0; m < n; ++m) { const f32x4* p4 = (const f32x4*)(src + (size_t)m * 8 * 64 * 16);
#pragma unroll
            for (int g = 0; g < 4; ++g) { const f32x4 v = p4[g]; S[4 * g] = S[4 * g] * g128 + v.x; S[4 * g + 1] = S[4 * g + 1] * g128 + v.y; S[4 * g + 2] = S[4 * g + 2] * g128 + v.z; S[4 * g + 3] = S[4 * g + 3] * g128 + v.w; } }
#pragma unroll
        for (int g = 0; g < 4; ++g) { v2u w; w.x = bfc2(S[4 * g], S[4 * g + 1]); w.y = bfc2(S[4 * g + 2], S[4 * g + 3]); *(LAS v2u*)(ST + (32 * te + c) * QS + 32 * td + 8 * g + 4 * hh) = w; }
    }
    ret_stage<true, true, false>(HP, RT, b, h, n, lg, lds, tid);
    __syncthreads();
#pragma unroll 1
    for (int rep = 0; rep < 2; ++rep) { const int idx = wave + 8 * rep;
        if (idx < 10) { const int ti = (idx >= 1) + (idx >= 3) + (idx >= 6), tj = idx - ti * (ti + 1) / 2;
            f32x16 acc;
#pragma unroll
            for (int i = 0; i < 16; ++i) acc[i] = 0.f;
#pragma unroll
            for (int s2 = 0; s2 < 4; ++s2) acc = MFMA32(*(const LAS bf16x8*)(Q1 + (32 * ti + c) * QS + 16 * s2 + 8 * hh), *(const LAS bf16x8*)(K1 + (32 * tj + c) * QS + 16 * s2 + 8 * hh), acc);
#pragma unroll
            for (int i = 0; i < 16; ++i) { const int il = (i & 3) + 8 * (i >> 2) + 4 * hh; float v = acc[i]; if (ti == tj && il < c) v = 0.f; P[(32 * ti + il) * JS + 32 * tj + c] = bfc(v); } } }
    __syncthreads();
    const int ti = wave >> 1, te0 = 2 * (wave & 1);
    f32x16 ao[2];
#pragma unroll
    for (int u = 0; u < 2; ++u)
#pragma unroll
        for (int i = 0; i < 16; ++i) ao[u][i] = 0.f;
#pragma unroll
    for (int s2 = 0; s2 < 4; ++s2) { const bf16x8 A = *(const LAS bf16x8*)(Q1 + (32 * ti + c) * QS + 16 * s2 + 8 * hh);
#pragma unroll
        for (int u = 0; u < 2; ++u) ao[u] = MFMA32(A, *(const LAS bf16x8*)(ST + (32 * (te0 + u) + c) * QS + 16 * s2 + 8 * hh), ao[u]); }
#pragma unroll
    for (int u = 0; u < 2; ++u)
#pragma unroll
        for (int i = 0; i < 16; ++i) ao[u][i] *= gam;
#pragma unroll 1
    for (int tj = 0; tj <= ti; ++tj)
#pragma unroll
        for (int s2 = 0; s2 < 2; ++s2) { const bf16x8 A = *(const LAS bf16x8*)(P + (32 * ti + c) * JS + 32 * tj + 16 * s2 + 8 * hh);
#pragma unroll
            for (int u = 0; u < 2; ++u) ao[u] = MFMA32(A, *(const LAS bf16x8*)(VT + (32 * (te0 + u) + c) * JS + 32 * tj + 16 * s2 + 8 * hh), ao[u]); }
    __syncthreads();
#pragma unroll
    for (int u = 0; u < 2; ++u)
#pragma unroll
        for (int i = 0; i < 16; ++i) OL[(32 * ti + (i & 3) + 8 * (i >> 2) + 4 * hh) * 132 + 32 * (te0 + u) + c] = ao[u][i];
    __syncthreads();
    {
        const LAS float* Ob = OL + ei * 132 + 32 * eq; bf16* op = OB + et * 1024 + h * 128 + 32 * eq;
        f32x4 v[8]; float sm = 0.f;
#pragma unroll
        for (int k = 0; k < 8; ++k) { v[k] = *(const LAS f32x4*)(Ob + 4 * k); sm += (v[k].x + v[k].y) + (v[k].z + v[k].w); }
        sm += __shfl_xor(sm, 1); sm += __shfl_xor(sm, 2);
        const float mean = sm * (1.f / 128.f); float sq = 0.f;
#pragma unroll
        for (int k = 0; k < 8; ++k) { v[k] = v[k] - mean; sq += (v[k].x * v[k].x + v[k].y * v[k].y) + (v[k].z * v[k].z + v[k].w * v[k].w); }
        sq += __shfl_xor(sq, 1); sq += __shfl_xor(sq, 2);
        const float rs = rsqrtf(sq * (1.f / 128.f) + LN_EPS);
#pragma unroll
        for (int k = 0; k < 4; ++k) { const v4u g4 = gg[k]; const f32x4 a0 = v[2 * k], a1 = v[2 * k + 1];
            v4u o; o.x = bfc2(a0.x * rs * siluf(bflo(g4.x)), a0.y * rs * siluf(bfhi(g4.x))); o.y = bfc2(a0.z * rs * siluf(bflo(g4.y)), a0.w * rs * siluf(bfhi(g4.y)));
            o.z = bfc2(a1.x * rs * siluf(bflo(g4.z)), a1.y * rs * siluf(bfhi(g4.z))); o.w = bfc2(a1.z * rs * siluf(bflo(g4.w)), a1.w * rs * siluf(bfhi(g4.w)));
            *(v4u*)(op + 8 * k) = o; }
    }
}

__device__ __forceinline__ void gdn_prep_fast(KArgs a, int l, int unit, LAS unsigned char* lds, int tid, int lane, int wave) {
    unsigned char* ws = a->ws;
    constexpr int KS = 136;
    LAS bf16* Kb = (LAS bf16*)lds;
    LAS bf16* Qb = (LAS bf16*)(lds + 17408);
    LAS float* A = (LAS float*)(lds + 34816);
    LAS float* V = (LAS float*)(lds + 51200);
    LAS float* KW = (LAS float*)(lds + 83968);
    LAS float* gc = (LAS float*)(lds + 116736);
    LAS float* bt = gc + 64;
    LAS bf16* KDs = (LAS bf16*)(lds + 117248);
    const int n = unit & 31, bh = unit >> 5, h = bh & 3, b = bh >> 2, t0 = b * SEQ + n * 64, c = lane & 31, hh = lane >> 5;
    const bf16* HP = (const bf16*)(ws + WS_R + R_HP);
    bf16* QKg = (bf16*)(ws + WS_R + R_QK) + (size_t)unit * 4096; bf16* QDg = (bf16*)(ws + WS_R + R_QD) + (size_t)unit * 8192; bf16* KDTg = (bf16*)(ws + WS_R + R_KDT) + (size_t)unit * 8192;
    bf16* WNg = (bf16*)(ws + WS_R + R_WN) + (size_t)unit * 8192; bf16* Ug = (bf16*)(ws + WS_R + R_U) + (size_t)unit * 8192;
    __syncthreads();
    if (wave == 0) {
        const float* gab = (const float*)(ws + WS_GAB) + (size_t)(t0 + lane) * 8; const float x = gab[h] + a->in[4][l * 4 + h];
        const float sp = fmaxf(x, 0.f) + log1pf(__expf(-fabsf(x))); float g = -__expf(a->in[3][l * 4 + h]) * sp;
#pragma unroll
        for (int o = 1; o < 64; o <<= 1) { const float up = __shfl_up(g, o); if (lane >= o) g += up; }
        gc[lane] = g; bt[lane] = sigmf(gab[4 + h]);
        if (lane == 63) ((float*)(ws + WS_CD))[unit] = __expf(g);
    }
    __syncthreads();
#ifndef PREP_NO_CONV
    if (wave < 6) {
        const int cg = tid % 48, rb = tid / 48, which = cg >> 4, dd = (cg & 15) * 8, col = COL_GQ + which * 512 + h * 128 + dd, cc = which * 512 + h * 128 + dd;
        const float* cw = a->in[2] + (size_t)l * 4 * 1536 + cc;
        float w[4][8];
#pragma unroll
        for (int j = 0; j < 4; ++j) { const f32x4 w0 = *(const f32x4*)(cw + j * 1536), w1 = *(const f32x4*)(cw + j * 1536 + 4); w[j][0] = w0.x; w[j][1] = w0.y; w[j][2] = w0.z; w[j][3] = w0.w; w[j][4] = w1.x; w[j][5] = w1.y; w[j][6] = w1.z; w[j][7] = w1.w; }
        float x0[8], x1[8], x2[8], x3[8];
        const int sbase = n * 64 + 8 * rb - 3;
        const bf16* hpc = HP + (size_t)(b * SEQ) * HP_LD + col;
#define PREP_LDROW(dst, s_) do { v4u raw_ = (v4u){0u, 0u, 0u, 0u}; if ((s_) >= 0) raw_ = *(const v4u*)(hpc + (size_t)(s_) * HP_LD); \
        _Pragma("unroll") for (int k_ = 0; k_ < 4; ++k_) { dst[2 * k_] = bflo(raw_[k_]); dst[2 * k_ + 1] = bfhi(raw_[k_]); } } while (0)
        PREP_LDROW(x0, sbase); PREP_LDROW(x1, sbase + 1); PREP_LDROW(x2, sbase + 2);
        const float gl = gc[63];
#pragma unroll 1
        for (int r = 0; r < 8; ++r) { const int i = 8 * rb + r; float y[8]; float ss = 0.f;
            PREP_LDROW(x3, sbase + 3 + r);
#pragma unroll
            for (int k = 0; k < 8; ++k) { const float acc = w[0][k] * x0[k] + w[1][k] * x1[k] + w[2][k] * x2[k] + w[3][k] * x3[k]; y[k] = siluf(acc); ss += y[k] * y[k]; x0[k] = x1[k]; x1[k] = x2[k]; x2[k] = x3[k]; }
            ss += __shfl_xor(ss, 1); ss += __shfl_xor(ss, 2); ss += __shfl_xor(ss, 4); ss += __shfl_xor(ss, 8);
            const float gi = gc[i], bi = bt[i];
            if (which == 0) { const float f = rsqrtf(ss + NORM_EPS) * 0.08838834764831845f, eg = __expf(gi);
                v4u p, pd;
#pragma unroll
                for (int k = 0; k < 4; ++k) { p[k] = bfc2(y[2 * k] * f, y[2 * k + 1] * f); pd[k] = bfc2(y[2 * k] * f * eg, y[2 * k + 1] * f * eg); }
                *(LAS v4u*)(Qb + i * KS + dd) = p;
                bf16* qd = QDg + (((i >> 5) * 4 + (dd >> 5)) * 2 + ((dd >> 4) & 1)) * 512 + (i & 31) * 8 + ((dd >> 3) & 1) * 4;
                *(v2u*)qd = (v2u){pd[0], pd[1]}; *(v2u*)(qd + 256) = (v2u){pd[2], pd[3]};
            } else if (which == 1) { const float f = rsqrtf(ss + NORM_EPS), fw = f * bi * __expf(gi), fd = f * __expf(gl - gi);
                v4u p;
#pragma unroll
                for (int k = 0; k < 4; ++k) p[k] = bfc2(y[2 * k] * f, y[2 * k + 1] * f);
                *(LAS v4u*)(Kb + i * KS + dd) = p;
#pragma unroll
                for (int k = 0; k < 8; ++k) { KW[i * 128 + dd + k] = y[k] * fw; KDs[(dd + k) * 72 + i] = bfc(y[k] * fd); }
            } else {
#pragma unroll
                for (int k = 0; k < 8; ++k) V[i * 128 + dd + k] = y[k] * bi;
            }
        }
#undef PREP_LDROW
    }
#endif
    __syncthreads();
    {
        const int ti = (wave >> 1) & 1, tj = wave & 1;
        if (wave < 4) {
            if (tj <= ti) {
                f32x16 acc;
#pragma unroll
                for (int i = 0; i < 16; ++i) acc[i] = 0.f;
#pragma unroll
                for (int s = 0; s < 8; ++s) acc = MFMA32(*(const LAS bf16x8*)(Kb + (32 * ti + c) * KS + 16 * s + 8 * hh), *(const LAS bf16x8*)(Kb + (32 * tj + c) * KS + 16 * s + 8 * hh), acc);
                const int j = 32 * tj + c; const float gj = gc[j];
#pragma unroll
                for (int r = 0; r < 16; ++r) { const int i = 32 * ti + (r & 3) + 8 * (r >> 2) + 4 * hh; A[i * 64 + j] = (j < i) ? bt[i] * acc[r] * __expf(gc[i] - gj) : 0.f; }
            } else {
#pragma unroll
                for (int r = 0; r < 16; ++r) { const int i = 32 * ti + (r & 3) + 8 * (r >> 2) + 4 * hh; A[i * 64 + 32 * tj + c] = 0.f; }
            }
        } else {
            const int kt = ti, qt = tj;
            if (kt <= qt) {
                f32x16 acc;
#pragma unroll
                for (int i = 0; i < 16; ++i) acc[i] = 0.f;
#pragma unroll
                for (int s = 0; s < 8; ++s) acc = MFMA32(*(const LAS bf16x8*)(Kb + (32 * kt + c) * KS + 16 * s + 8 * hh), *(const LAS bf16x8*)(Qb + (32 * qt + c) * KS + 16 * s + 8 * hh), acc);
                const int i = 32 * qt + c; const float gi = gc[i];
#pragma unroll
                for (int r = 0; r < 16; ++r) { const int j = 32 * kt + (r & 3) + 8 * (r >> 2) + 4 * hh; acc[r] = (j <= i) ? acc[r] * __expf(gi - gc[j]) : 0.f; }
                bf16x8* qf = (bf16x8*)QKg + lane;
                qf[((qt * 2 + kt) * 2 + 0) * 64] = pack8(acc, 0); qf[((qt * 2 + kt) * 2 + 1) * 64] = pack8(acc, 1);
            }
        }
    }
    __syncthreads();
#ifndef PREP_NO_SOLVE
    if (wave < 4) {
        const int col = tid & 127; LAS float* rhs = (tid < 128 ? V : KW) + col;
        float x[64];
#pragma unroll
        for (int i = 0; i < 64; ++i) {
            float s0 = rhs[i * 128], s1 = 0.f, s2 = 0.f, s3 = 0.f;
#pragma unroll
            for (int m4 = 0; m4 < (i + 3) / 4; ++m4) { const f32x4 a4 = *(const LAS f32x4*)(A + i * 64 + 4 * m4);
                if (4 * m4 < i) s0 -= a4.x * x[4 * m4];
                if (4 * m4 + 1 < i) s1 -= a4.y * x[4 * m4 + 1];
                if (4 * m4 + 2 < i) s2 -= a4.z * x[4 * m4 + 2];
                if (4 * m4 + 3 < i) s3 -= a4.w * x[4 * m4 + 3]; }
            x[i] = (s0 + s1) + (s2 + s3);
        }
        if (tid < 128) {
#pragma unroll
            for (int m = 0; m < 2; ++m)
#pragma unroll
                for (int hx = 0; hx < 2; ++hx)
#pragma unroll
                    for (int hf = 0; hf < 2; ++hf) { const int i0 = 32 * m + 16 * hf + 4 * hx;
                        v4u w; w.x = bfc2(x[i0], x[i0 + 1]); w.y = bfc2(x[i0 + 2], x[i0 + 3]); w.z = bfc2(x[i0 + 8], x[i0 + 9]); w.w = bfc2(x[i0 + 10], x[i0 + 11]);
                        *(v4u*)(Ug + uoff(i0, col)) = w; }
        } else {
#pragma unroll
            for (int i = 0; i < 64; ++i) Qb[i * KS + col] = bfc(-x[i]);
        }
    }
#endif
    __syncthreads();
#pragma unroll
    for (int p = 0; p < 4; ++p) { const int idx = tid + 512 * p, i = idx >> 5, d = (idx & 31) * 4;
        *(v2u*)(WNg + fragoff(i, d, 4)) = *(const LAS v2u*)(Qb + i * KS + d); }
#pragma unroll
    for (int p = 0; p < 4; ++p) { const int idx = tid + 512 * p, d = idx >> 4, i = (idx & 15) * 4;
        *(v2u*)(KDTg + fragoff(d, i, 2)) = *(const LAS v2u*)(KDs + d * 72 + i); }
}
#define XB_TMO      128
#define XB_XCNT(j)  (256  + 64 * (j))
#define XB_XSUB(j)  (1280 + 64 * (j))
#define XB_XGEN(j)  (2304 + 64 * (j))
#define XB_TOP      3328
#define XB_TOPGEN   3392
#define XCD_BAR_WORDS 3456
#define XB_SPIN_CAP (1u << 18)

__device__ __forceinline__ unsigned xb_ld(unsigned* p)              { return __hip_atomic_load(p, __ATOMIC_RELAXED, __HIP_MEMORY_SCOPE_AGENT); }
__device__ __forceinline__ unsigned xb_add(unsigned* p, unsigned v) { return __hip_atomic_fetch_add(p, v, __ATOMIC_RELAXED, __HIP_MEMORY_SCOPE_AGENT); }
__device__ __forceinline__ unsigned xb_xcc_id() { return (unsigned)__builtin_amdgcn_s_getreg((3 << 11) | 20) & 0xFu; }
#define XB_SPIN(cond, bar) do { unsigned _sp = 0; while (cond) { __builtin_amdgcn_s_sleep(1); \
    if ((++_sp & 255u) == 0u) { if (xb_ld(&(bar)[XB_TMO])) break; if (_sp > XB_SPIN_CAP) { atomicAdd(&(bar)[XB_TMO], 1u); break; } } } } while (0)

struct XcdBarrier {
    unsigned* bar; unsigned x;
    volatile LAS unsigned* st;
};

__device__ __forceinline__ XcdBarrier xcd_barrier_post(unsigned* bar, volatile LAS unsigned* st) {
    XcdBarrier b; b.bar = bar; b.x = xb_xcc_id(); b.st = st;
    if (threadIdx.x == 0) (void)xb_add(&bar[XB_XCNT(b.x)], 1u);
    return b;
}
__device__ __forceinline__ void xcd_barrier_complete(unsigned* bar, unsigned x, unsigned& nloc, unsigned& nx) {
    const unsigned G = gridDim.x * gridDim.y * gridDim.z;
    unsigned sum, cnt, mine, sp = 0u;
    for (;;) {
        sum = 0u; cnt = 0u; mine = 0u;
#pragma unroll
        for (unsigned j = 0; j < 16; ++j) { const unsigned c = xb_ld(&bar[XB_XCNT(j)]); sum += c; cnt += (c > 0u) ? 1u : 0u; mine = (j == x) ? c : mine; }
        if (sum == G) break;
        __builtin_amdgcn_s_sleep(1);
        if ((++sp & 255u) == 0u) { if (xb_ld(&bar[XB_TMO])) break; if (sp > XB_SPIN_CAP) { atomicAdd(&bar[XB_TMO], 1u); break; } }
    }
    nloc = mine > 0u ? mine : 1u; nx = cnt > 0u ? cnt : 1u;
}

__device__ __forceinline__ void xcd_barrier(const XcdBarrier& b) {
    asm volatile("s_waitcnt vmcnt(0)" ::: "memory");
    __syncthreads();
    if (threadIdx.x == 0) {
        unsigned* bar = b.bar;
        __builtin_amdgcn_s_waitcnt(0);
        unsigned nloc = b.st[0], nx = b.st[1];
        if (nloc == 0u) { xcd_barrier_complete(bar, b.x, nloc, nx); b.st[0] = nloc; b.st[1] = nx; }
        const unsigned old = xb_add(&bar[XB_XSUB(b.x)], 1u);
        const unsigned gen = old / nloc;
        if (old + 1u == (gen + 1u) * nloc) {
            __builtin_amdgcn_fence(__ATOMIC_RELEASE, "agent");
            asm volatile("s_waitcnt vmcnt(0)" ::: "memory");
            const unsigned og = xb_add(&bar[XB_TOP], 1u);
            const unsigned tg = og / nx;
            if (og + 1u == (tg + 1u) * nx) xb_add(&bar[XB_TOPGEN], 1u);
            else XB_SPIN(xb_ld(&bar[XB_TOPGEN]) == tg, bar);
            __builtin_amdgcn_fence(__ATOMIC_ACQUIRE, "agent");
            xb_add(&bar[XB_XGEN(b.x)], 1u);
            asm volatile("s_waitcnt vmcnt(0)" ::: "memory");
        } else {
            XB_SPIN(xb_ld(&bar[XB_XGEN(b.x)]) == gen, bar);
            __builtin_amdgcn_fence(__ATOMIC_ACQUIRE, "agent");
            asm volatile("s_waitcnt vmcnt(0)" ::: "memory");
        }
    }
    __syncthreads();
}
#ifndef REP_PRO
#define REP_PRO 1
#endif
#ifndef REP_IN
#define REP_IN 1
#endif
#ifndef REP_PREP
#define REP_PREP 1
#endif
#ifndef REP_SCAN
#define REP_SCAN 1
#endif
#ifndef REP_OUT
#define REP_OUT 1
#endif
#ifndef REP_GU
#define REP_GU 1
#endif
#ifndef REP_DN
#define REP_DN 1
#endif
#ifndef REP_MGU
#define REP_MGU 1
#endif
#ifndef REP_GDN
#define REP_GDN 1
#endif
#ifndef REP_RET
#define REP_RET 1
#endif
#ifndef FAST_SCAN
#define FAST_SCAN 1
#endif
#ifndef FAST_RET
#define FAST_RET 1
#endif
#ifndef FAST_PREP
#define FAST_PREP 1
#endif
#ifndef EN_PRO
#define EN_PRO 1
#endif
#ifndef EN_IN
#define EN_IN 1
#endif
#ifndef EN_PREP
#define EN_PREP 1
#endif
#ifndef EN_SCAN
#define EN_SCAN 1
#endif
#ifndef EN_OUT
#define EN_OUT 1
#endif
#ifndef EN_LN1
#define EN_LN1 1
#endif
#ifndef EN_FFN0
#define EN_FFN0 1
#endif
#ifndef EN_MOE
#define EN_MOE 1
#endif

__global__ void __launch_bounds__(NWAVES * 64, 2) fwd(Args a_unused) {
    extern __shared__ __attribute__((aligned(16))) unsigned char lds_raw[];
    LAS unsigned char* lds = (LAS unsigned char*)lds_raw;
    { const int tid0 = threadIdx.x; for (int u = tid0; u < (LDS_BYTES - LDSCTL_OFF) / 4; u += NWAVES * 64) ((LAS unsigned*)(lds + LDSCTL_OFF))[u] = 0u; }
    __syncthreads();
#if ONE_LAUNCH
    XcdBarrier bar = xcd_barrier_post((unsigned*)(kargs()->ws + WS_CTL) + CW_BAR, (volatile LAS unsigned*)(lds + MISC_OFF) + 8);
#define SEAM() xcd_barrier(bar)
#else
#define SEAM() do {} while (0)
#endif
    const int lo = kargs()->ph_lo, hi = kargs()->ph_hi;
#define IN(k) (lo <= (k) && (k) < hi)
#define BOTH(k) (IN(k) && ((k) + 1) < hi)
#define PH_LOCALS KArgs a = kargs(); unsigned char* ws = a->ws; int G = gridDim.x, bid = blockIdx.x; asm volatile("" : "+s"(G), "+s"(bid)); const int tid = tidx(), lane = tid & 63, wave = __builtin_amdgcn_readfirstlane(tid >> 6), gw = bid * NWAVES + wave, NGW = G * NWAVES; (void)ws; (void)lane; (void)gw; (void)NGW;

    if (EN_PRO && IN(PH_PRO)) { _Pragma("unroll 1") for (int rep_ = 0; rep_ < REP_PRO; ++rep_) { if (rep_) SEAM(); PH_LOCALS; ph_prologue(a, lds, wave, lane, gw, NGW, bid * (NWAVES * 64) + tid, G * NWAVES * 64); } if (BOTH(PH_PRO)) SEAM(); }

#pragma unroll 1
    for (int l = 0; l < 2; ++l) {
        if (EN_IN && IN(PH_L(l, K_IN))) {
            _Pragma("unroll 1") for (int rep_ = 0; rep_ < REP_IN; ++rep_) { if (rep_) SEAM(); PH_LOCALS;
            pg8::Gemm g{(const pg8::bf16_t*)(ws + WS_XB), (const pg8::bf16_t*)(ws + WS_WIN) + (size_t)l * NIN_PAD * 1024, M, NIN_PAD, 1024}; pg8::StaticOrder S; S.init(M, NIN_PAD, G, bid);
            pg8::EpiHproj E{(pg8::bf16_t*)(ws + WS_R + R_HP), (float*)(ws + WS_GAB)};
            pg8::gemm_phase<pg8::EpiHproj, pg8::StaticOrder, PG8_ALIGN, PG8_SP2>(lds, g, S, E); }
            if (BOTH(PH_L(l, K_IN))) SEAM();
        }
        if (EN_PREP && IN(PH_L(l, K_PREP))) {
            _Pragma("unroll 1") for (int rep_ = 0; rep_ < REP_PREP; ++rep_) { if (rep_) SEAM(); PH_LOCALS; for (int u = bid; u < 1024; u += G) { if (FAST_PREP) gdn_prep_fast(a, l, u, lds, tid, lane, wave); else gdn_prep_unit(a, l, u, lds, tid, lane, wave); }
              if (FAST_RET) for (int u = bid; u < 512; u += G) ret_kv_unit(a, u, lds, tid, lane, wave); }
            if (BOTH(PH_L(l, K_PREP))) SEAM();
        }
        if (EN_SCAN && IN(PH_L(l, K_SCAN))) {
            _Pragma("unroll 1") for (int rep_ = 0; rep_ < REP_SCAN; ++rep_) { if (rep_) SEAM(); PH_LOCALS;
            if (G >= 64) {
                if (bid < 32) { for (int rg_ = 0; rg_ < REP_GDN; ++rg_) { if (FAST_SCAN) gdn_scan_fast(a, l, bid, lds, tid, lane, wave); else gdn_scan_naive(a, l, bid, lds, tid, lane, wave); } }
                else if (FAST_RET) { for (int rr_ = 0; rr_ < REP_RET; ++rr_) for (int u = bid - 32; u < 512; u += G - 32) ret_out_unit(a, u, lds, tid, lane, wave); }
                else for (int u = bid - 32; u < 1024; u += G - 32) ret_unit_naive(a, u, lds, tid, lane, wave);
            } else {
                for (int u = bid; u < 32; u += G) gdn_scan_naive(a, l, u, lds, tid, lane, wave);
                for (int u = bid; u < 1024; u += G) ret_unit_naive(a, u, lds, tid, lane, wave);
            } }
            if (BOTH(PH_L(l, K_SCAN))) SEAM();
        }
        if (EN_OUT && IN(PH_L(l, K_OUT))) {
            _Pragma("unroll 1") for (int rep_ = 0; rep_ < REP_OUT; ++rep_) { if (rep_) SEAM(); PH_LOCALS;
            pg8::Gemm g{(const pg8::bf16_t*)(ws + WS_R + R_OB), (const pg8::bf16_t*)(ws + WS_WO) + (size_t)l * 1024 * 1024, M, 1024, 1024}; pg8::StaticOrder S; S.init(M, 1024, G, bid);
            pg8::EpiF32 E{(float*)(ws + WS_R + R_MIX), 1024};
            pg8::gemm_phase<pg8::EpiF32, pg8::StaticOrder, PG8_ALIGN, PG8_SP2>(lds, g, S, E); }
            if (BOTH(PH_L(l, K_OUT))) SEAM();
        }
        if (EN_LN1 && IN(PH_L(l, K_LN1))) {
            { PH_LOCALS;
            if (l == 0) ln_rows<false>(a->in[0], ALPHA, (const float*)(ws + WS_R + R_MIX), a->in[7], a->in[8], a->out, 1.0f, (bf16*)(ws + WS_XB), nullptr, nullptr, nullptr, nullptr, lane, gw, NGW);
            else { ln_rows<true>(a->out, ALPHA, (const float*)(ws + WS_R + R_MIX), a->in[7] + 1024, a->in[8] + 1024, a->out, ALPHA, (bf16*)(ws + WS_XB), a->in[14], (unsigned*)(ws + WS_CTL) + CW_MOE, (int*)(ws + WS_LIST), (float*)(ws + WS_GATE), lane, gw, NGW);
                   moe_convert(a, lds, wave, lane, gw, NGW); } }
            if (BOTH(PH_L(l, K_LN1))) SEAM();
        }
        if (l == 0) {
            if (EN_FFN0 && IN(PH_L(0, K_GU))) {
                _Pragma("unroll 1") for (int rep_ = 0; rep_ < REP_GU; ++rep_) { if (rep_) SEAM(); PH_LOCALS;
                pg8::Gemm g{(const pg8::bf16_t*)(ws + WS_XB), (const pg8::bf16_t*)(ws + WS_WGU), M, 2 * FF, 1024}; pg8::StaticOrder S; S.init(M, 2 * FF, G, bid);
                pg8::EpiSwiglu E{(pg8::bf16_t*)(ws + WS_R + R_H), FF};
                pg8::gemm_phase<pg8::EpiSwiglu, pg8::StaticOrder, PG8_ALIGN, PG8_SP2>(lds, g, S, E); }
                if (BOTH(PH_L(0, K_GU))) SEAM();
            }
            if (EN_FFN0 && IN(PH_L(0, K_DN))) {
                _Pragma("unroll 1") for (int rep_ = 0; rep_ < REP_DN; ++rep_) { if (rep_) SEAM(); PH_LOCALS;
                pg8::Gemm g{(const pg8::bf16_t*)(ws + WS_R + R_H), (const pg8::bf16_t*)(ws + WS_WD), M, 1024, FF}; pg8::StaticOrder S; S.init(M, 1024, G, bid);
                pg8::EpiF32 E{(float*)(ws + WS_R + R_MIX), 1024};
                pg8::gemm_phase<pg8::EpiF32, pg8::StaticOrder, PG8_ALIGN, PG8_SP2>(lds, g, S, E); }
                if (BOTH(PH_L(0, K_DN))) SEAM();
            }
            if (EN_LN1 && IN(PH_L(0, K_LN2))) {
                { PH_LOCALS;
                ln_rows<false>(a->out, ALPHA, (const float*)(ws + WS_R + R_MIX), a->in[9], a->in[10], a->out, 1.0f, (bf16*)(ws + WS_XB), nullptr, nullptr, nullptr, nullptr, lane, gw, NGW); }
                if (BOTH(PH_L(0, K_LN2))) SEAM();
            }
        } else {
#pragma unroll 1
            for (int j = 0; j < 2; ++j) {
                const int kg = K_G0 + 3 * j;
                if (EN_MOE && IN(PH_L(1, kg))) { { PH_LOCALS; moe_gather(a, j, lane, gw, NGW); } if (BOTH(PH_L(1, kg))) SEAM(); }
                if (EN_MOE && IN(PH_L(1, kg + 1))) {
                    _Pragma("unroll 1") for (int rep_ = 0; rep_ < REP_MGU; ++rep_) { if (rep_) SEAM(); PH_LOCALS;
                    int cnt[8];
#pragma unroll
                    for (int e = 0; e < 8; ++e) cnt[e] = (int)((const unsigned*)(ws + WS_CTL))[CW_MOE + 64 * (j * 8 + e)];
                    pg8::Gemm g{(const pg8::bf16_t*)(ws + WS_R + R_XG), (const pg8::bf16_t*)(ws + WS_R + R_WMGU), MOE_ROWS, 2 * FE, 1024}; pg8::MoeOrder S; S.init(cnt, 2 * FE / 256, G, bid, (size_t)2 * FE * 1024 * 2);
                    pg8::EpiSwiglu E{(pg8::bf16_t*)(ws + WS_R + R_HM), FE};
                    pg8::gemm_phase<pg8::EpiSwiglu, pg8::MoeOrder, PG8_ALIGN, PG8_SP2>(lds, g, S, E); }
                    if (BOTH(PH_L(1, kg + 1))) SEAM();
                }
                if (EN_MOE && IN(PH_L(1, kg + 2))) {
                    { PH_LOCALS;
                    int cnt[8];
#pragma unroll
                    for (int e = 0; e < 8; ++e) cnt[e] = (int)((const unsigned*)(ws + WS_CTL))[CW_MOE + 64 * (j * 8 + e)];
                    pg8::Gemm g{(const pg8::bf16_t*)(ws + WS_R + R_HM), (const pg8::bf16_t*)(ws + WS_R + R_WMD), MOE_ROWS, 1024, FE}; pg8::MoeOrder S; S.init(cnt, 4, G, bid, (size_t)1024 * FE * 2);
                    pg8::EpiMoeDown E; E.XF = a->out; E.list = (const int*)(ws + WS_LIST) + (size_t)j * 8 * 16384; E.gate = (const float*)(ws + WS_GATE) + (size_t)j * 16384;
#pragma unroll
                    for (int e = 0; e < 8; ++e) { E.cnt[e] = cnt[e]; E.cum[e] = S.cum[e]; }
                    pg8::gemm_phase<pg8::EpiMoeDown, pg8::MoeOrder, PG8_ALIGN, PG8_SP2>(lds, g, S, E); }
                    if (BOTH(PH_L(1, kg + 2))) SEAM();
                }
            }
            if (EN_LN1 && IN(PH_L(1, K_LNF))) {
                PH_LOCALS;
                ln_rows<false>(a->out, 1.0f, nullptr, a->in[9] + 1024, a->in[10] + 1024, a->out, 1.0f, nullptr, nullptr, nullptr, nullptr, nullptr, lane, gw, NGW);
            }
        }
    }
#undef IN
#undef BOTH
}

extern "C" void kernel_launch(void* const* d_in, const int* in_sizes, int n_in, void* d_out, int out_size, void* d_ws, size_t ws_size, hipStream_t stream) {
    static int grid = 0;
    if (grid == 0) {
        if (n_in != 18 || in_sizes[0] != M * D || out_size != M * D || ws_size < WS_END) { fprintf(stderr, "kernel_launch: unexpected shapes or workspace (%zu < %zu); nothing launched\n", ws_size, (size_t)WS_END); grid = -1; return; }
        int dev = 0, cus = 0, per_cu = 0;
        if (hipGetDevice(&dev) != hipSuccess || hipDeviceGetAttribute(&cus, hipDeviceAttributeMultiprocessorCount, dev) != hipSuccess) { grid = -1; return; }
        if (hipFuncSetAttribute((const void*)fwd, hipFuncAttributeMaxDynamicSharedMemorySize, LDS_BYTES) != hipSuccess) { fprintf(stderr, "kernel_launch: hipFuncSetAttribute failed\n"); grid = -1; return; }
        if (hipOccupancyMaxActiveBlocksPerMultiprocessor(&per_cu, (const void*)fwd, NWAVES * 64, LDS_BYTES) != hipSuccess || per_cu < 1) fprintf(stderr, "kernel_launch: occupancy query reports %d\n", per_cu);
        (void)hipGetLastError();
        grid = cus;
    }
    if (grid < 0) return;
    if (hipMemsetAsync((char*)d_ws + WS_CTL, 0, CTL_BYTES, stream) != hipSuccess) return;
    Args a{};
    for (int i = 0; i < 18; ++i) a.in[i] = (const float*)d_in[i];
    a.out = (float*)d_out; a.ws = (unsigned char*)d_ws;
#if ONE_LAUNCH
    a.ph_lo = 0; a.ph_hi = PH_END;
    hipLaunchKernelGGL(fwd, dim3(grid), dim3(NWAVES * 64), LDS_BYTES, stream, a);
#else
    static const int phases[] = {PH_PRO,
        PH_L(0, K_IN), PH_L(0, K_PREP), PH_L(0, K_SCAN), PH_L(0, K_OUT), PH_L(0, K_LN1), PH_L(0, K_GU), PH_L(0, K_DN), PH_L(0, K_LN2),
        PH_L(1, K_IN), PH_L(1, K_PREP), PH_L(1, K_SCAN), PH_L(1, K_OUT), PH_L(1, K_LN1),
        PH_L(1, K_G0), PH_L(1, K_GU0), PH_L(1, K_DN0), PH_L(1, K_G1), PH_L(1, K_GU1), PH_L(1, K_DN1), PH_L(1, K_LNF)};
    for (unsigned i = 0; i < sizeof(phases) / sizeof(phases[0]); ++i) {
        a.ph_lo = phases[i]; a.ph_hi = phases[i] + 1;
        hipLaunchKernelGGL(fwd, dim3(grid), dim3(NWAVES * 64), LDS_BYTES, stream, a);
    }
#endif
}
```

```cpp
#include <hip/hip_runtime.h>
#include <cstdio>
#include <cstdint>

#ifndef ONE_LAUNCH
#define ONE_LAUNCH 1
#endif

#define GAS __attribute__((address_space(1)))
#define LAS __attribute__((address_space(3)))
typedef unsigned short bf16;
typedef unsigned v4u __attribute__((ext_vector_type(4)));
typedef unsigned v2u __attribute__((ext_vector_type(2)));
typedef float f32x4 __attribute__((ext_vector_type(4)));
typedef float f32x2 __attribute__((ext_vector_type(2)));
#define RLX_AGENT __ATOMIC_RELAXED, __HIP_MEMORY_SCOPE_AGENT
#define LDS_WAIT() asm volatile("s_waitcnt lgkmcnt(0)" ::: "memory")
#define VM_WAIT() asm volatile("s_waitcnt vmcnt(0)" ::: "memory")

__device__ __forceinline__ unsigned f2bf(float f) { unsigned u = __builtin_bit_cast(unsigned, f); return (u + 0x7fffu + ((u >> 16) & 1u)) >> 16; }
__device__ __forceinline__ unsigned pk2(float lo, float hi) { return f2bf(lo) | (f2bf(hi) << 16); }
__device__ __forceinline__ float bf2f(unsigned short u) { return __builtin_bit_cast(float, (unsigned)u << 16); }
__device__ __forceinline__ float bflo(unsigned u) { return __builtin_bit_cast(float, u << 16); }
__device__ __forceinline__ float bfhi(unsigned u) { return __builtin_bit_cast(float, u & 0xffff0000u); }
__device__ __forceinline__ float siluf(float x) { return x / (1.f + __expf(-x)); }
__device__ __forceinline__ float sigmf(float x) { return 1.f / (1.f + __expf(-x)); }
__device__ __forceinline__ float wave_sum(float v) {
#pragma unroll
    for (int o = 1; o < 64; o <<= 1) v += __shfl_xor(v, o);
    return v;
}

constexpr int NWAVES = 8;
constexpr int M = 16384, D = 1024, SEQ = 2048, NB = 8;
constexpr int IN_COLS = 3592, NIN_PAD = 3840, HP_LD = 3584;
constexpr int FF = 2816, FE = 3584, NE = 8;
constexpr int COL_RQ = 0, COL_RK = 256, COL_RV = 512, COL_RG = 1024, COL_GQ = 1536, COL_GK = 2048, COL_GV = 2560, COL_GG = 3072;
constexpr float ALPHA = 1.41421356237f;
constexpr float LN_EPS = 1e-5f, NORM_EPS = 1e-6f;
constexpr int MOE_ROWS = 72 * 256;

__host__ __device__ __forceinline__ int fragoff(int i, int d, int nkt) {
    return ((((i >> 5) * nkt + (d >> 5)) * 2 + ((d >> 4) & 1)) * 512) + ((((d >> 2) & 1) * 32 + (i & 31)) * 8) + ((((d >> 3) & 1) << 2) | (d & 3));
}
__host__ __device__ __forceinline__ int uoff(int i, int e) {
    const int reg = (i & 3) | (((i & 31) >> 3) << 2);
    return (((((e >> 5) * 2 + (i >> 5)) * 2 + (reg >> 3)) * 64 + (((i >> 2) & 1) * 32 + (e & 31))) * 8) + (reg & 7);
}
namespace pg8 {
#define PG8_LAS __attribute__((address_space(3)))
typedef unsigned short bf16_t;
typedef short bf16x8 __attribute__((ext_vector_type(8)));
typedef float f32x4 __attribute__((ext_vector_type(4)));
typedef unsigned u32x4 __attribute__((ext_vector_type(4)));
constexpr int BM = 256, BK = 64, HALF = 128, HTB = HALF * BK * 2  , STAGE_BYTES = 8 * HTB, NXCD = 8, WGM = 8;

__host__ __device__ __forceinline__ int lds_byte(int r, int c) { const int st = (r >> 4) * 2 + (c >> 5), rr = r & 15, cc = c & 31, ob = rr * 64 + cc * 2; return st * 1024 + (ob ^ (((ob >> 9) & 1) << 5)); }
__host__ __device__ __forceinline__ void stage_rc(int b, int& R, int& C) { const int st = b / 1024, sb = b % 1024, swz = sb ^ (((sb >> 9) & 1) << 5); R = (st >> 1) * 16 + swz / 64; C = (st & 1) * 32 + (swz % 64) / 2; }
__host__ __device__ __forceinline__ int perm32(int rho) { const int n = rho >> 4, i = rho & 15; return 8 * (i >> 2) + 4 * n + (i & 3); }

struct Unit { int pm, pn, aux; };
struct Gemm { const bf16_t* A; const bf16_t* Bt; int M, N, K; };

struct StaticOrder {
    int nM, nN, nwg, G, c;
    __host__ __device__ void init(int M, int N, int G_, int c_) { nM = M / BM; nN = N / BM; nwg = nM * nN; G = G_; c = c_; }
    __host__ __device__ bool next(int i, Unit& u) const {
        const long L = (long)i * G + c; if (L >= nwg) return false;
        int wgid = (int)L; { const int q = nwg / NXCD, r = nwg % NXCD, xcd = wgid % NXCD, off = wgid / NXCD; wgid = (xcd < r ? xcd * (q + 1) : r * (q + 1) + (xcd - r) * q) + off; }
        const int nig = WGM * nN, gid = wgid / nig, fm = gid * WGM, gsz = (nM - fm) < WGM ? (nM - fm) : WGM;
        u.pm = fm + ((wgid % nig) % gsz); u.pn = (wgid % nig) / gsz; u.aux = 0; return true;
    }
    __device__ __forceinline__ const char* aptr(const Gemm& g, const Unit& u) const { return (const char*)g.A + (size_t)u.pm * ((size_t)BM * g.K * 2); }
    __device__ __forceinline__ const char* bptr(const Gemm& g, const Unit& u) const { return (const char*)g.Bt + (size_t)u.pn * ((size_t)BM * g.K * 2); }
    __device__ __forceinline__ void a_ready(const Unit&) const {}
    __device__ __forceinline__ void done(const Unit&) const {}
};

template <class Epi, class Sched, bool ALIGN_EPI = false, bool SP2 = false>
__device__ __forceinline__ void gemm_phase(PG8_LAS unsigned char* lds, const Gemm g, const Sched& S, const Epi& E) {
    int tid = threadIdx.x; asm volatile("" : "+v"(tid)); const int wid = __builtin_amdgcn_readfirstlane(tid >> 6), lane = tid & 63, wr = wid >> 2, wc = wid & 3, fr = lane & 15, fq = lane >> 4;
    const int K = g.K, nt = K / BK;
    unsigned voffA[2], voffB[2];
#pragma unroll
    for (int i = 0; i < 2; ++i) { int R, C; stage_rc(tid * 16 + i * 8192, R, C); const int Rb = Epi::PERM ? ((R & ~31) + perm32(R & 31)) : R;
        voffA[i] = (unsigned)(R * K + C) * 2u; voffB[i] = (unsigned)(Rb * K + C) * 2u; }
    const size_t kstep = (size_t)(BK * 2);
    const size_t hstep = (size_t)HALF * K * 2;
    const size_t tstep = 2 * hstep;
    const unsigned ldsw = (unsigned)wid * 1024u;
    const int aoff = lds_byte(wr * 64 + fr, fq * 8), boff = lds_byte(wc * 32 + fr, fq * 8);
#define PG8_SA(b, h) (((b) * 2 + (h)) * HTB)
#define PG8_SB(b, h) ((4 + (b) * 2 + (h)) * HTB)
#define PG8_STAGE(bufoff, gbase, voff) do { _Pragma("unroll") for (int _i = 0; _i < 2; ++_i) \
        __builtin_amdgcn_global_load_lds((const unsigned*)((const char*)(gbase) + (voff)[_i]), (PG8_LAS unsigned*)(lds + (bufoff) + ldsw + _i * 8192), 16, 0, 0); } while (0)
#define PG8_LDA(dst, b, h) do { _Pragma("unroll") for (int m = 0; m < 4; ++m) _Pragma("unroll") for (int k = 0; k < 2; ++k) dst[m][k] = *(const PG8_LAS bf16x8*)(lds + PG8_SA(b, h) + aoff + m * 2048 + k * 1024); } while (0)
#define PG8_LDB(dst, b, h) do { _Pragma("unroll") for (int n = 0; n < 2; ++n) _Pragma("unroll") for (int k = 0; k < 2; ++k) dst[n][k] = *(const PG8_LAS bf16x8*)(lds + PG8_SB(b, h) + boff + n * 2048 + k * 1024); } while (0)
#define PG8_MMA(ai, bj, At, Bt) do { __builtin_amdgcn_s_setprio(1); _Pragma("unroll") for (int m = 0; m < 4; ++m) _Pragma("unroll") for (int n = 0; n < 2; ++n) _Pragma("unroll") for (int k = 0; k < 2; ++k) \
        acc[ai][bj][m][n] = __builtin_amdgcn_mfma_f32_16x16x32_bf16(Bt[n][k], At[m][k], acc[ai][bj][m][n], 0, 0, 0); __builtin_amdgcn_s_setprio(0); } while (0)
#define PG8_WAIT_V(n) asm volatile("s_waitcnt vmcnt(" #n ")" ::: "memory")
#define PG8_WAIT_L(n) asm volatile("s_waitcnt lgkmcnt(" #n ")" ::: "memory")
#define PG8_BAR __builtin_amdgcn_s_barrier()
#define PG8_SCHED __builtin_amdgcn_sched_barrier(0)
    Unit cur, nxt; int ui = 0;
    if (!S.next(0, cur)) return;
    f32x4 acc[2][2][4][2];
#pragma unroll
    for (int a = 0; a < 2; ++a)
#pragma unroll
        for (int b = 0; b < 2; ++b)
#pragma unroll
            for (int m = 0; m < 4; ++m)
#pragma unroll
                for (int n = 0; n < 2; ++n) acc[a][b][m][n] = (f32x4){0.f, 0.f, 0.f, 0.f};
    bf16x8 At[4][2], B0[2][2], B1[2][2];
    const char* cA = S.aptr(g, cur); const char* cB = S.bptr(g, cur);
    S.a_ready(cur);
    if constexpr (SP2) {
        PG8_STAGE(PG8_SB(0, 0), cB, voffB); PG8_STAGE(PG8_SB(0, 1), cB + hstep, voffB); PG8_STAGE(PG8_SA(0, 0), cA, voffA); PG8_STAGE(PG8_SA(0, 1), cA + hstep, voffA);
        if (wr == 1) PG8_BAR;
        PG8_WAIT_V(2); PG8_BAR;
        PG8_STAGE(PG8_SB(1, 0), cB + kstep, voffB); PG8_STAGE(PG8_SA(1, 0), cA + kstep, voffA); PG8_STAGE(PG8_SB(1, 1), cB + hstep + kstep, voffB);
        PG8_WAIT_V(6); PG8_BAR;
    } else {
        PG8_STAGE(PG8_SB(0, 0), cB, voffB); PG8_STAGE(PG8_SA(0, 0), cA, voffA); PG8_STAGE(PG8_SB(0, 1), cB + hstep, voffB); PG8_STAGE(PG8_SA(0, 1), cA + hstep, voffA);
        if (wr == 1) PG8_BAR;
        PG8_WAIT_V(4); PG8_BAR;
        PG8_STAGE(PG8_SB(1, 0), cB + kstep, voffB); PG8_STAGE(PG8_SA(1, 0), cA + kstep, voffA); PG8_STAGE(PG8_SB(1, 1), cB + hstep + kstep, voffB);
        PG8_WAIT_V(6); PG8_BAR;
    }
    for (;;) {
        const bool has_next = S.next(ui + 1, nxt);
        const char* nA = has_next ? S.aptr(g, nxt) : cA; const char* nB = has_next ? S.bptr(g, nxt) : cB;
        for (int t = 0; t < nt; t += 2) {
            const bool last = (t == nt - 2);
            const char* a1 = cA + (size_t)(t + 1) * kstep;
            const char* a2 = last ? nA : cA + (size_t)(t + 2) * kstep; const char* b2 = last ? nB : cB + (size_t)(t + 2) * kstep;
            const char* a3 = a2 + kstep; const char* b3 = b2 + kstep;
            if (last && has_next) S.a_ready(nxt);
            if constexpr (SP2) {
            PG8_LDB(B0, 0, 0); PG8_LDB(B1, 0, 1); PG8_SCHED; PG8_LDA(At, 0, 0); PG8_STAGE(PG8_SA(1, 1), a1 + hstep, voffA);
            PG8_WAIT_V(8); PG8_WAIT_L(0); PG8_BAR; PG8_MMA(0, 0, At, B0); PG8_MMA(0, 1, At, B1); PG8_BAR; PG8_SCHED;
            PG8_LDA(At, 0, 1); PG8_STAGE(PG8_SB(0, 0), b2, voffB); PG8_STAGE(PG8_SB(0, 1), b2 + hstep, voffB); PG8_STAGE(PG8_SA(0, 0), a2, voffA);
            PG8_WAIT_V(8); PG8_WAIT_L(0); PG8_BAR; PG8_MMA(1, 0, At, B0); PG8_MMA(1, 1, At, B1); PG8_BAR; PG8_SCHED;
            PG8_LDB(B0, 1, 0); PG8_LDB(B1, 1, 1); PG8_SCHED; PG8_LDA(At, 1, 0); PG8_STAGE(PG8_SA(0, 1), a2 + hstep, voffA);
            PG8_WAIT_V(8); PG8_WAIT_L(0); PG8_BAR; PG8_MMA(0, 0, At, B0); PG8_MMA(0, 1, At, B1); PG8_BAR; PG8_SCHED;
            PG8_LDA(At, 1, 1); PG8_STAGE(PG8_SB(1, 0), b3, voffB); PG8_STAGE(PG8_SB(1, 1), b3 + hstep, voffB); PG8_STAGE(PG8_SA(1, 0), a3, voffA);
            PG8_WAIT_V(8); PG8_WAIT_L(0); PG8_BAR; PG8_MMA(1, 0, At, B0); PG8_MMA(1, 1, At, B1); PG8_BAR; PG8_SCHED;
            } else {
            PG8_LDB(B0, 0, 0); PG8_SCHED; PG8_LDA(At, 0, 0); PG8_STAGE(PG8_SA(1, 1), a1 + hstep, voffA);
            PG8_WAIT_L(8); PG8_BAR; PG8_WAIT_L(0); PG8_MMA(0, 0, At, B0); PG8_BAR; PG8_SCHED;
            PG8_LDB(B1, 0, 1); PG8_STAGE(PG8_SB(0, 0), b2, voffB);
            PG8_BAR; PG8_WAIT_L(0); PG8_MMA(0, 1, At, B1); PG8_BAR;
            PG8_LDA(At, 0, 1); PG8_STAGE(PG8_SA(0, 0), a2, voffA);
            PG8_BAR; PG8_WAIT_L(0); PG8_MMA(1, 0, At, B0); PG8_BAR; PG8_SCHED;
            PG8_STAGE(PG8_SB(0, 1), b2 + hstep, voffB);
            PG8_WAIT_V(6); PG8_BAR; PG8_MMA(1, 1, At, B1); PG8_BAR;
            PG8_LDB(B0, 1, 0); PG8_SCHED; PG8_LDA(At, 1, 0); PG8_STAGE(PG8_SA(0, 1), a2 + hstep, voffA);
            PG8_WAIT_L(8); PG8_BAR; PG8_WAIT_L(0); PG8_MMA(0, 0, At, B0); PG8_BAR; PG8_SCHED;
            PG8_LDB(B1, 1, 1); PG8_STAGE(PG8_SB(1, 0), b3, voffB);
            PG8_BAR; PG8_WAIT_L(0); PG8_MMA(0, 1, At, B1); PG8_BAR;
            PG8_LDA(At, 1, 1); PG8_STAGE(PG8_SA(1, 0), a3, voffA);
            PG8_BAR; PG8_WAIT_L(0); PG8_MMA(1, 0, At, B0); PG8_BAR; PG8_SCHED;
            PG8_STAGE(PG8_SB(1, 1), b3 + hstep, voffB);
            PG8_WAIT_V(6); PG8_BAR; PG8_MMA(1, 1, At, B1); PG8_BAR;
            }
        }
        if constexpr (ALIGN_EPI) { if (wr == 0) PG8_BAR; }
        if constexpr (!Epi::AFTER_DRAIN) { E(acc, cur, wr, wc, fr, fq); S.done(cur); }
        if (!has_next) break;
#pragma unroll
        for (int a = 0; a < 2; ++a)
#pragma unroll
            for (int b = 0; b < 2; ++b)
#pragma unroll
                for (int m = 0; m < 4; ++m)
#pragma unroll
                    for (int n = 0; n < 2; ++n) acc[a][b][m][n] = (f32x4){0.f, 0.f, 0.f, 0.f};
        cur = nxt; cA = nA; cB = nB; ++ui;
        if constexpr (ALIGN_EPI) { if (wr == 1) PG8_BAR; }
    }
    PG8_WAIT_V(0);
    if constexpr (!ALIGN_EPI) { if (wr == 0) PG8_BAR; }
    PG8_BAR;
    if constexpr (Epi::AFTER_DRAIN) { E.fused(acc, cur, wr, wc, fr, fq, lds, wid, lane); S.done(cur); }
#undef PG8_SA
#undef PG8_SB
#undef PG8_STAGE
#undef PG8_LDA
#undef PG8_LDB
#undef PG8_MMA
#undef PG8_WAIT_V
#undef PG8_WAIT_L
#undef PG8_BAR
#undef PG8_SCHED
}
}

namespace pg8 {
__device__ __forceinline__ unsigned cvt_pk_bf16(float lo, float hi) { unsigned r; asm volatile("v_cvt_pk_bf16_f32 %0, %1, %2" : "=v"(r) : "v"(lo), "v"(hi)); return r; }

struct EpiHproj {
    static constexpr bool PERM = true, AFTER_DRAIN = false;
    bf16_t* HP; float* GAB;
    __device__ __forceinline__ void operator()(const f32x4 (&acc)[2][2][4][2], const Unit& u, int wr, int wc, int fr, int fq) const {
        const int row0 = u.pm * BM + wr * 64 + fr;
        if (u.pn < 14) {
            const int col0 = u.pn * BM + wc * 32 + 8 * fq;
#pragma unroll
            for (int ai = 0; ai < 2; ++ai)
#pragma unroll
                for (int m = 0; m < 4; ++m) { bf16_t* rowp = HP + (size_t)(row0 + ai * HALF + m * 16) * 3584 + col0;
#pragma unroll
                    for (int bj = 0; bj < 2; ++bj) { const f32x4 v0 = acc[ai][bj][m][0], v1 = acc[ai][bj][m][1];
                        u32x4 w; w.x = cvt_pk_bf16(v0[0], v0[1]); w.y = cvt_pk_bf16(v0[2], v0[3]); w.z = cvt_pk_bf16(v1[0], v1[1]); w.w = cvt_pk_bf16(v1[2], v1[3]);
                        *(u32x4*)(rowp + bj * HALF) = w; } }
        } else if (wc == 0 && fq == 0) {
#pragma unroll
            for (int ai = 0; ai < 2; ++ai)
#pragma unroll
                for (int m = 0; m < 4; ++m) { float* rowp = GAB + (size_t)(row0 + ai * HALF + m * 16) * 8;
                    *(f32x4*)(rowp) = acc[ai][0][m][0]; *(f32x4*)(rowp + 4) = acc[ai][0][m][1]; }
        }
    }
};
struct EpiF32 {
    static constexpr bool PERM = false, AFTER_DRAIN = false;
    float* O; int ldc;
    __device__ __forceinline__ void operator()(const f32x4 (&acc)[2][2][4][2], const Unit& u, int wr, int wc, int fr, int fq) const {
        const int row0 = u.pm * BM + wr * 64 + fr, col0 = u.pn * BM + wc * 32 + 4 * fq;
#pragma unroll
        for (int ai = 0; ai < 2; ++ai)
#pragma unroll
            for (int m = 0; m < 4; ++m) { float* rowp = O + (size_t)(row0 + ai * HALF + m * 16) * ldc + col0;
#pragma unroll
                for (int bj = 0; bj < 2; ++bj)
#pragma unroll
                    for (int n = 0; n < 2; ++n) *(f32x4*)(rowp + bj * HALF + n * 16) = acc[ai][bj][m][n]; }
    }
};
struct EpiSwiglu {
    static constexpr bool PERM = true, AFTER_DRAIN = false;
    bf16_t* H; int ldh;
    __device__ __forceinline__ void operator()(const f32x4 (&acc)[2][2][4][2], const Unit& u, int wr, int wc, int fr, int fq) const {
        const int row0 = u.pm * BM + wr * 64 + fr, col0 = u.pn * HALF + wc * 32 + 8 * fq;
#pragma unroll
        for (int ai = 0; ai < 2; ++ai)
#pragma unroll
            for (int m = 0; m < 4; ++m) { bf16_t* rowp = H + (size_t)(row0 + ai * HALF + m * 16) * ldh + col0;
                float h[8];
#pragma unroll
                for (int n = 0; n < 2; ++n)
#pragma unroll
                    for (int i = 0; i < 4; ++i) { const float gt = acc[ai][0][m][n][i], up = acc[ai][1][m][n][i]; h[n * 4 + i] = gt * up * __builtin_amdgcn_rcpf(1.f + __expf(-gt)); }
                u32x4 w; w.x = cvt_pk_bf16(h[0], h[1]); w.y = cvt_pk_bf16(h[2], h[3]); w.z = cvt_pk_bf16(h[4], h[5]); w.w = cvt_pk_bf16(h[6], h[7]);
                *(u32x4*)(rowp) = w; }
    }
};
struct EpiMoeDown {
    static constexpr bool PERM = false, AFTER_DRAIN = false;
    float* XF; const int* list; const float* gate; int cnt[8], cum[8];
    __device__ __forceinline__ void operator()(const f32x4 (&acc)[2][2][4][2], const Unit& u, int wr, int wc, int fr, int fq) const {
        int e = u.aux, c_e = 0, t_e = 0;
#pragma unroll
        for (int k = 0; k < 8; ++k) { if (k == e) { c_e = cnt[k]; t_e = cum[k]; } }
        const int s0 = (u.pm - t_e) * BM + wr * 64 + fr, col0 = u.pn * BM + wc * 32 + 4 * fq;
        const int* lp = list + e * 16384;
        int tok[8]; float gt[8];
#pragma unroll
        for (int q = 0; q < 8; ++q) { const int s = s0 + (q >> 2) * HALF + (q & 3) * 16; tok[q] = (s < c_e) ? lp[s] : -1; }
#pragma unroll
        for (int q = 0; q < 8; ++q) gt[q] = (tok[q] >= 0) ? gate[tok[q]] : 0.f;
#pragma unroll
        for (int ai = 0; ai < 2; ++ai) {
            f32x4 o[4][2][2];
#pragma unroll
            for (int m = 0; m < 4; ++m) { const float* rowp = XF + (size_t)(tok[ai * 4 + m] >= 0 ? tok[ai * 4 + m] : 0) * 1024 + col0;
#pragma unroll
                for (int bj = 0; bj < 2; ++bj)
#pragma unroll
                    for (int n = 0; n < 2; ++n) o[m][bj][n] = *(const f32x4*)(rowp + bj * HALF + n * 16); }
#pragma unroll
            for (int m = 0; m < 4; ++m) { if (tok[ai * 4 + m] >= 0) { float* rowp = XF + (size_t)tok[ai * 4 + m] * 1024 + col0; const float g1 = gt[ai * 4 + m];
#pragma unroll
                for (int bj = 0; bj < 2; ++bj)
#pragma unroll
                    for (int n = 0; n < 2; ++n) *(f32x4*)(rowp + bj * HALF + n * 16) = o[m][bj][n] + acc[ai][bj][m][n] * g1; } }
        }
    }
};
struct MoeOrder {
    int T, nN, nwg, G, c; int cum[8]; size_t bstride;
    __device__ void init(const int* cnt, int nN_, int G_, int c_, size_t bstride_) {
        int t = 0;
#pragma unroll
        for (int e = 0; e < 8; ++e) { cum[e] = t; t += (cnt[e] + 255) >> 8; }
        T = t; nN = nN_; nwg = T * nN; G = G_; c = c_; bstride = bstride_;
    }
    __device__ bool next(int i, Unit& u) const {
        const long L = (long)i * G + c; if (L >= nwg) return false;
        int wgid = (int)L; { const int q = nwg / NXCD, r = nwg % NXCD, xcd = wgid % NXCD, off = wgid / NXCD; wgid = (xcd < r ? xcd * (q + 1) : r * (q + 1) + (xcd - r) * q) + off; }
        const int nig = WGM * nN, gid = wgid / nig, fm = gid * WGM, gsz = (T - fm) < WGM ? (T - fm) : WGM;
        u.pm = fm + ((wgid % nig) % gsz); u.pn = (wgid % nig) / gsz;
        int e = 0;
#pragma unroll
        for (int k = 1; k < 8; ++k) e += (u.pm >= cum[k]) ? 1 : 0;
        u.aux = e; return true;
    }
    __device__ __forceinline__ const char* aptr(const Gemm& g, const Unit& u) const { return (const char*)g.A + (size_t)u.pm * ((size_t)BM * g.K * 2); }
    __device__ __forceinline__ const char* bptr(const Gemm& g, const Unit& u) const { return (const char*)g.Bt + (size_t)u.aux * bstride + (size_t)u.pn * ((size_t)BM * g.K * 2); }
    __device__ __forceinline__ void a_ready(const Unit&) const {}
    __device__ __forceinline__ void done(const Unit&) const {}
};
}
#ifndef PG8_SP2
#define PG8_SP2 true
#endif
#ifndef PG8_ALIGN
#define PG8_ALIGN true
#endif

constexpr size_t MiB = 1u << 20;
constexpr size_t WS_CTL = 0, CTL_BYTES = 256 * 1024;
constexpr size_t WS_ROPE = 256 * 1024;
constexpr size_t WS_WIN = 1 * MiB;
constexpr size_t WS_WO = 16 * MiB;
constexpr size_t WS_WGU = 20 * MiB;
constexpr size_t WS_WD = 31 * MiB;
constexpr size_t WS_XB = 37 * MiB;
constexpr size_t WS_GAB = 69 * MiB;
constexpr size_t WS_LIST = WS_GAB + 512 * 1024;
constexpr size_t WS_GATE = WS_LIST + 1 * MiB;
constexpr size_t WS_CD = WS_GATE + 128 * 1024;
constexpr size_t WS_WMGU = 71 * MiB, WS_WMD = 183 * MiB;
constexpr size_t WS_R = 239 * MiB;
constexpr size_t R_HP = 0, R_OB = 112 * MiB, R_U = 144 * MiB, R_WN = 160 * MiB, R_QD = 176 * MiB, R_KDT = 192 * MiB, R_QK = 208 * MiB;
constexpr size_t WS_KV = WS_XB;
constexpr size_t R_MIX = 0, R_H = 64 * MiB;
constexpr size_t R_HM = 0, R_XG = 126 * MiB, XG_PASS = 36 * MiB;
constexpr size_t WS_END = WS_R + 216 * MiB;
constexpr int CW_TMO = 0, CW_BAR = 4096, CW_MOE = 16384;

constexpr int RING_BYTES = 131072, LDS_BYTES = 147456, LDSCTL_OFF = LDS_BYTES - 512, MISC_OFF = LDSCTL_OFF + 320;

constexpr int PH_PRO = 0;
constexpr int PH_L(int l, int k) { return 1 + 16 * l + k; }
constexpr int K_IN = 0, K_PREP = 1, K_SCAN = 2, K_OUT = 3, K_LN1 = 4, K_GU = 5, K_DN = 6, K_LN2 = 7;
constexpr int K_G0 = 5, K_GU0 = 6, K_DN0 = 7, K_G1 = 8, K_GU1 = 9, K_DN1 = 10, K_LNF = 11;
constexpr int PH_END = PH_L(1, K_LNF) + 1;

struct Args { const float* in[18]; float* out; unsigned char* ws; int ph_lo, ph_hi; };
typedef const __attribute__((address_space(4))) Args* KArgs;
__device__ __forceinline__ KArgs kargs() { KArgs p = (KArgs)__builtin_amdgcn_kernarg_segment_ptr(); asm volatile("" : "+s"(p)); return p; }
__device__ __forceinline__ int tidx() { int t = threadIdx.x; asm volatile("" : "+v"(t)); return t; }

constexpr int TR_SCR = 64 * 65 * 4;
__device__ __forceinline__ void tr_item(const float* W, int N, int k0, int n0, bf16* WT, size_t ldk, int dst_row0, LAS float* scr, int lane) {
    const int nq = 4 * (lane & 15), n = n0 + nq, kr = lane >> 4;
    f32x4 v[16];
#pragma unroll
    for (int i = 0; i < 16; ++i) v[i] = (n < N) ? *(const f32x4*)(W + (size_t)(k0 + 4 * i + kr) * N + n) : (f32x4){0.f, 0.f, 0.f, 0.f};
#pragma unroll
    for (int i = 0; i < 16; ++i) { LAS float* d = scr + (4 * i + kr) * 65 + nq; d[0] = v[i].x; d[1] = v[i].y; d[2] = v[i].z; d[3] = v[i].w; }
    LDS_WAIT(); asm volatile("" ::: "memory");
    const int c = lane & 7;
#pragma unroll
    for (int j = 0; j < 8; ++j) { const int nn = (lane >> 3) + 8 * j; const LAS float* s = scr + (8 * c) * 65 + nn;
        v4u o; o.x = pk2(s[0 * 65], s[1 * 65]); o.y = pk2(s[2 * 65], s[3 * 65]); o.z = pk2(s[4 * 65], s[5 * 65]); o.w = pk2(s[6 * 65], s[7 * 65]);
        *(v4u*)(WT + (size_t)(dst_row0 + nn) * ldk + k0 + 8 * c) = o; }
    LDS_WAIT(); asm volatile("" ::: "memory");
}

__device__ __forceinline__ void ph_prologue(KArgs a, LAS unsigned char* lds, int wave, int lane, int gw, int NGW, int gtid, int NT) {
    unsigned char* ws = a->ws;
    LAS float* scr = (LAS float*)(lds + wave * TR_SCR);
    constexpr int I_IN = 16 * 57, I_O = 16 * 16, I_L = I_IN + I_O, I_G = 16 * 44, I_D = 44 * 16, NIT = 2 * I_L + 2 * I_G + I_D;
    for (int it = gw; it < NIT; it += NGW) {
        int r = it;
        if (r < 2 * I_L) { const int l = r / I_L; r -= l * I_L;
            if (r < I_IN) { const int kb = r / 57, nb = r % 57; tr_item(a->in[1] + (size_t)l * 1024 * IN_COLS, IN_COLS, 64 * kb, 64 * nb, (bf16*)(ws + WS_WIN) + (size_t)l * NIN_PAD * 1024, 1024, 64 * nb, scr, lane); }
            else { r -= I_IN; const int kb = r / 16, nb = r % 16; tr_item(a->in[6] + (size_t)l * 1024 * 1024, 1024, 64 * kb, 64 * nb, (bf16*)(ws + WS_WO) + (size_t)l * 1024 * 1024, 1024, 64 * nb, scr, lane); }
            continue; }
        r -= 2 * I_L;
        if (r < 2 * I_G) { const int up = r / I_G; r -= up * I_G; const int kb = r / 44, nb = r % 44, n0 = 64 * nb;
            tr_item(up ? a->in[12] : a->in[11], FF, 64 * kb, n0, (bf16*)(ws + WS_WGU), 1024, 256 * (n0 >> 7) + (n0 & 127) + 128 * up, scr, lane); continue; }
        r -= 2 * I_G;
        { const int kb = r / 16, nb = r % 16; tr_item(a->in[13], 1024, 64 * kb, 64 * nb, (bf16*)(ws + WS_WD), FF, 64 * nb, scr, lane); }
    }
    for (int i = gtid; i < 2 * 192 * 128; i += NT) { const int l = i / (192 * 128), r = i % (192 * 128);
        ((v4u*)((bf16*)(ws + WS_WIN) + (size_t)l * NIN_PAD * 1024 + (size_t)3648 * 1024))[r] = (v4u){0u, 0u, 0u, 0u}; }
    for (int i = gtid; i < M * D / 8; i += NT) { const f32x4 p = ((const f32x4*)a->in[0])[2 * i], q = ((const f32x4*)a->in[0])[2 * i + 1];
        v4u o; o.x = pk2(p.x, p.y); o.y = pk2(p.z, p.w); o.z = pk2(q.x, q.y); o.w = pk2(q.z, q.w); ((v4u*)(ws + WS_XB))[i] = o; }
    for (int i = gtid; i < SEQ * 32; i += NT) { const int pos = i >> 5, k = i & 31;
        const float inv = powf(10000.0f, -(float)(2 * k) / 64.0f); const float ang = (float)pos * inv;
        double rev = (double)ang * 0.15915494309189535; rev -= floor(rev); const float rf = (float)rev;
        float* R = (float*)(ws + WS_ROPE) + (size_t)pos * 64; R[k] = __builtin_amdgcn_cosf(rf); R[32 + k] = __builtin_amdgcn_sinf(rf); }
}

__device__ __forceinline__ void moe_convert(KArgs a, LAS unsigned char* lds, int wave, int lane, int gw, int NGW, int e_lo, int e_hi) {
    unsigned char* ws = a->ws;
    LAS float* scr = (LAS float*)(lds + wave * TR_SCR);
    constexpr int I_G = 16 * 56, I_D = 56 * 16, I_E = 2 * I_G + I_D;
    for (int it = e_lo * I_E + gw; it < e_hi * I_E; it += NGW) {
        const int e = it / I_E; int r = it - e * I_E;
        if (r < 2 * I_G) { const int up = r / I_G; r -= up * I_G; const int kb = r / 56, nb = r % 56, n0 = 64 * nb;
            tr_item((up ? a->in[16] : a->in[15]) + (size_t)e * 1024 * FE, FE, 64 * kb, n0, (bf16*)(ws + WS_WMGU) + (size_t)e * 7168 * 1024, 1024, 256 * (n0 >> 7) + (n0 & 127) + 128 * up, scr, lane); }
        else { r -= 2 * I_G; const int kb = r / 16, nb = r % 16; tr_item(a->in[17] + (size_t)e * FE * 1024, 1024, 64 * kb, 64 * nb, (bf16*)(ws + WS_WMD) + (size_t)e * 1024 * FE, FE, 64 * nb, scr, lane); }
    }
}

template <bool ROUTE>
__device__ __forceinline__ void ln_rows(const float* res, float ares, const float* mix, const float* g, const float* bta, float* xf, float oscale, bf16* xb,
                                        const float* router, unsigned* cntw, int* list, float* gate, int lane, int gw, int NGW) {
    f32x4 gv[4], bv[4];
#pragma unroll
    for (int j = 0; j < 4; ++j) { gv[j] = ((const f32x4*)g)[lane + 64 * j]; bv[j] = ((const f32x4*)bta)[lane + 64 * j]; }
    for (int row = gw; row < M; row += NGW) {
        const f32x4* rr = (const f32x4*)(res + (size_t)row * D) + lane;
        f32x4 v[4]; float s = 0.f;
#pragma unroll
        for (int j = 0; j < 4; ++j) { v[j] = rr[64 * j] * ares; }
        if (mix) { const f32x4* mr = (const f32x4*)(mix + (size_t)row * D) + lane;
#pragma unroll
            for (int j = 0; j < 4; ++j) v[j] = v[j] + mr[64 * j]; }
#pragma unroll
        for (int j = 0; j < 4; ++j) s += (v[j].x + v[j].y) + (v[j].z + v[j].w);
        const float mean = wave_sum(s) * (1.f / D); float s2 = 0.f;
#pragma unroll
        for (int j = 0; j < 4; ++j) { v[j] = v[j] - mean; s2 += (v[j].x * v[j].x + v[j].y * v[j].y) + (v[j].z * v[j].z + v[j].w * v[j].w); }
        const float rstd = 1.f / sqrtf(wave_sum(s2) * (1.f / D) + LN_EPS);
#pragma unroll
        for (int j = 0; j < 4; ++j) v[j] = v[j] * rstd * gv[j] + bv[j];
        f32x4* xo = (f32x4*)(xf + (size_t)row * D) + lane;
#pragma unroll
        for (int j = 0; j < 4; ++j) xo[64 * j] = v[j] * oscale;
        if (xb) { v2u* bo = (v2u*)(xb + (size_t)row * D) + lane;
#pragma unroll
            for (int j = 0; j < 4; ++j) { v2u o; o.x = pk2(v[j].x, v[j].y); o.y = pk2(v[j].z, v[j].w); bo[64 * j] = o; } }
        if (ROUTE) {
            float lg[8];
#pragma unroll
            for (int e = 0; e < 8; ++e) lg[e] = 0.f;
#pragma unroll
            for (int j = 0; j < 4; ++j)
#pragma unroll
                for (int i = 0; i < 4; ++i) { const int c = 4 * lane + 256 * j + i; const f32x4 r0 = *(const f32x4*)(router + c * 8), r1 = *(const f32x4*)(router + c * 8 + 4); const float y = v[j][i];
                    lg[0] += y * r0.x; lg[1] += y * r0.y; lg[2] += y * r0.z; lg[3] += y * r0.w; lg[4] += y * r1.x; lg[5] += y * r1.y; lg[6] += y * r1.z; lg[7] += y * r1.w; }
#pragma unroll
            for (int e = 0; e < 8; ++e) lg[e] = wave_sum(lg[e]);
            if (lane == 0) {
                int e0 = 0; float v0 = lg[0];
#pragma unroll
                for (int e = 1; e < 8; ++e) if (lg[e] > v0) { v0 = lg[e]; e0 = e; }
                int e1 = -1; float v1 = -3.0e38f;
#pragma unroll
                for (int e = 0; e < 8; ++e) if (e != e0 && lg[e] > v1) { v1 = lg[e]; e1 = e; }
                const float p1 = __expf(v1 - v0), g0 = 1.f / (1.f + p1), g1 = p1 / (1.f + p1);
                const unsigned s0 = __hip_atomic_fetch_add(cntw + 64 * e0, 1u, RLX_AGENT), s1 = __hip_atomic_fetch_add(cntw + 64 * (8 + e1), 1u, RLX_AGENT);
                list[(size_t)e0 * 16384 + s0] = row; list[(size_t)(8 + e1) * 16384 + s1] = row; gate[row] = g0; gate[16384 + row] = g1;
            }
        }
    }
}

__device__ __forceinline__ void moe_gather(KArgs a, int j, int lane, int gw, int NGW) {
    unsigned char* ws = a->ws; const unsigned* cntw = (const unsigned*)(ws + WS_CTL) + CW_MOE + 64 * (j * 8);
    int pre[8], cum[8]; { int p = 0, t = 0;
#pragma unroll
        for (int e = 0; e < 8; ++e) { const int c = (int)cntw[64 * e]; pre[e] = p; cum[e] = t; p += c; t += (c + 255) >> 8; } }
    const int* list = (const int*)(ws + WS_LIST) + (size_t)j * 8 * 16384;
    for (int r0 = gw; r0 < M; r0 += 8 * NGW) {
        int tok[8], drow[8];
#pragma unroll
        for (int q = 0; q < 8; ++q) { const int r = r0 + q * NGW; tok[q] = -1; drow[q] = 0;
            if (r < M) { int e = 0;
#pragma unroll
                for (int k = 1; k < 8; ++k) e += (r >= pre[k]) ? 1 : 0;
                int pe = 0, ce = 0;
#pragma unroll
                for (int k = 0; k < 8; ++k) if (k == e) { pe = pre[k]; ce = cum[k]; }
                const int s = r - pe; tok[q] = list[(size_t)e * 16384 + s]; drow[q] = ce * 256 + s; } }
        v4u x0[8], x1[8];
#pragma unroll
        for (int q = 0; q < 8; ++q) { const v4u* src = (const v4u*)((const bf16*)(ws + WS_XB) + (size_t)(tok[q] >= 0 ? tok[q] : 0) * 1024); x0[q] = src[lane]; x1[q] = src[lane + 64]; }
#pragma unroll
        for (int q = 0; q < 8; ++q) if (tok[q] >= 0) { v4u* dst = (v4u*)((bf16*)(ws + WS_R + R_XG + (size_t)j * XG_PASS) + (size_t)drow[q] * 1024); dst[lane] = x0[q]; dst[lane + 64] = x1[q]; }
    }
}

__device__ __forceinline__ void gdn_prep_unit(KArgs a, int l, int unit, LAS unsigned char* lds, int tid, int lane, int wave) {
    unsigned char* ws = a->ws;
    const int n = unit & 31, bh = unit >> 5, h = bh & 3, b = bh >> 2;
    const int t0 = b * SEQ + n * 64;
    LAS float* Q = (LAS float*)lds; LAS float* K = Q + 8192; LAS float* V = K + 8192; LAS float* A = V + 8192; LAS float* gc = A + 4096; LAS float* bt = gc + 64;
    const bf16* HP = (const bf16*)(ws + WS_R + R_HP);
    const float* cw = a->in[2] + (size_t)l * 4 * 1536;
    __syncthreads();
    for (int idx = tid; idx < 64 * 384; idx += 512) { const int i = idx / 384, c = idx % 384, which = c >> 7, d = c & 127;
        const int col = COL_GQ + which * 512 + h * 128 + d, cc = which * 512 + h * 128 + d; float acc = 0.f;
#pragma unroll
        for (int j = 0; j < 4; ++j) { const int s = n * 64 + i - 3 + j; if (s >= 0) acc += cw[j * 1536 + cc] * bf2f(HP[(size_t)(b * SEQ + s) * HP_LD + col]); }
        const float y = siluf(acc); LAS float* dst = which == 0 ? Q : (which == 1 ? K : V); dst[i * 128 + d] = y; }
    if (tid < 64) { const float* gab = (const float*)(ws + WS_GAB) + (size_t)(t0 + tid) * 8; const float x = gab[h] + a->in[4][l * 4 + h];
        const float sp = fmaxf(x, 0.f) + log1pf(__expf(-fabsf(x))); gc[tid] = -__expf(a->in[3][l * 4 + h]) * sp; bt[tid] = sigmf(gab[4 + h]); }
    __syncthreads();
#pragma unroll 1
    for (int r = 0; r < 8; ++r) { const int i = wave * 8 + r;
        float q0 = Q[i * 128 + lane], q1 = Q[i * 128 + lane + 64], k0 = K[i * 128 + lane], k1 = K[i * 128 + lane + 64];
        const float sq = wave_sum(q0 * q0 + q1 * q1), sk = wave_sum(k0 * k0 + k1 * k1);
        const float fq = rsqrtf(sq + NORM_EPS) * 0.08838834764831845f, fk = rsqrtf(sk + NORM_EPS);
        Q[i * 128 + lane] = q0 * fq; Q[i * 128 + lane + 64] = q1 * fq; K[i * 128 + lane] = k0 * fk; K[i * 128 + lane + 64] = k1 * fk; }
    if (tid == 0) { float c = 0.f; for (int i = 0; i < 64; ++i) { c += gc[i]; gc[i] = c; } }
    __syncthreads();
    bf16* QKg = (bf16*)(ws + WS_R + R_QK) + (size_t)unit * 4096; bf16* QDg = (bf16*)(ws + WS_R + R_QD) + (size_t)unit * 8192; bf16* KDTg = (bf16*)(ws + WS_R + R_KDT) + (size_t)unit * 8192;
    bf16* WNg = (bf16*)(ws + WS_R + R_WN) + (size_t)unit * 8192; bf16* Ug = (bf16*)(ws + WS_R + R_U) + (size_t)unit * 8192;
    for (int idx = tid; idx < 4096; idx += 512) { const int i = idx >> 6, j = idx & 63; float dqk = 0.f, dkk = 0.f;
        for (int dd = 0; dd < 128; ++dd) { const int d = (dd + j) & 127; const float kj = K[j * 128 + d]; dqk += Q[i * 128 + d] * kj; dkk += K[i * 128 + d] * kj; }
        const float dec = __expf(gc[i] - gc[j]);
        A[i * 64 + j] = (j < i) ? bt[i] * dkk * dec : 0.f;
        QKg[fragoff(i, j, 2)] = (bf16)f2bf((j <= i) ? dqk * dec : 0.f); }
    const float gl = gc[63];
    for (int idx = tid; idx < 8192; idx += 512) { const int i = idx >> 7, d = idx & 127;
        QDg[fragoff(i, d, 4)] = (bf16)f2bf(Q[i * 128 + d] * __expf(gc[i]));
        KDTg[fragoff(d, i, 2)] = (bf16)f2bf(K[i * 128 + d] * __expf(gl - gc[i])); }
    if (tid == 0) ((float*)(ws + WS_CD))[unit] = __expf(gl);
    __syncthreads();
    for (int idx = tid; idx < 8192; idx += 512) { const int i = idx >> 7; const float bi = bt[i]; V[idx] *= bi; Q[idx] = bi * __expf(gc[i]) * K[idx]; }
    __syncthreads();
    if (tid < 256) { LAS float* buf = (tid < 128 ? V : Q) + (tid & 127);
        for (int i = 1; i < 64; ++i) { float acc = buf[i * 128]; for (int m = 0; m < i; ++m) acc -= A[i * 64 + m] * buf[m * 128]; buf[i * 128] = acc; } }
    __syncthreads();
    for (int idx = tid; idx < 8192; idx += 512) { const int i = idx >> 7, d = idx & 127; Ug[uoff(i, d)] = (bf16)f2bf(V[idx]); WNg[fragoff(i, d, 4)] = (bf16)f2bf(-Q[idx]); }
}

__device__ __forceinline__ void gdn_scan_naive(KArgs a, int l, int bh, LAS unsigned char* lds, int tid, int lane, int wave) {
    unsigned char* ws = a->ws;
    LAS float* S = (LAS float*)lds; LAS float* VN = S + 16384; LAS float* O = VN + 8192;
    const int h = bh & 3, b = bh >> 2, e = tid & 127, ig = tid >> 7;
    const bf16* HP = (const bf16*)(ws + WS_R + R_HP); bf16* OB = (bf16*)(ws + WS_R + R_OB);
    const float* nw = a->in[5] + l * 128;
    __syncthreads();
    for (int idx = tid; idx < 16384; idx += 512) S[idx] = 0.f;
    __syncthreads();
#pragma unroll 1
    for (int n = 0; n < 32; ++n) {
        const int unit = bh * 32 + n;
        const bf16* Ug = (const bf16*)(ws + WS_R + R_U) + (size_t)unit * 8192; const bf16* WNg = (const bf16*)(ws + WS_R + R_WN) + (size_t)unit * 8192;
        const bf16* QDg = (const bf16*)(ws + WS_R + R_QD) + (size_t)unit * 8192; const bf16* KDTg = (const bf16*)(ws + WS_R + R_KDT) + (size_t)unit * 8192;
        const bf16* QKg = (const bf16*)(ws + WS_R + R_QK) + (size_t)unit * 4096; const float cd = ((const float*)(ws + WS_CD))[unit];
#pragma unroll 1
        for (int r = 0; r < 16; ++r) { const int i = ig + 4 * r; float acc = bf2f(Ug[uoff(i, e)]);
#pragma unroll 2
            for (int d0 = 0; d0 < 128; d0 += 4) { const v2u w = *(const v2u*)(WNg + fragoff(i, d0, 4));
                acc += bflo(w.x) * S[d0 * 128 + e] + bfhi(w.x) * S[(d0 + 1) * 128 + e] + bflo(w.y) * S[(d0 + 2) * 128 + e] + bfhi(w.y) * S[(d0 + 3) * 128 + e]; }
            VN[i * 128 + e] = acc; }
        __syncthreads();
#pragma unroll 1
        for (int r = 0; r < 16; ++r) { const int i = ig + 4 * r; float acc = 0.f;
#pragma unroll 2
            for (int d0 = 0; d0 < 128; d0 += 4) { const v2u w = *(const v2u*)(QDg + fragoff(i, d0, 4));
                acc += bflo(w.x) * S[d0 * 128 + e] + bfhi(w.x) * S[(d0 + 1) * 128 + e] + bflo(w.y) * S[(d0 + 2) * 128 + e] + bfhi(w.y) * S[(d0 + 3) * 128 + e]; }
#pragma unroll 2
            for (int j0 = 0; j0 < 64; j0 += 4) { const v2u w = *(const v2u*)(QKg + fragoff(i, j0, 2));
                acc += bflo(w.x) * VN[j0 * 128 + e] + bfhi(w.x) * VN[(j0 + 1) * 128 + e] + bflo(w.y) * VN[(j0 + 2) * 128 + e] + bfhi(w.y) * VN[(j0 + 3) * 128 + e]; }
            O[i * 128 + e] = acc; }
        __syncthreads();
#pragma unroll 1
        for (int r = 0; r < 32; ++r) { const int d = ig + 4 * r; float acc = S[d * 128 + e] * cd;
#pragma unroll 2
            for (int i0 = 0; i0 < 64; i0 += 4) { const v2u w = *(const v2u*)(KDTg + fragoff(d, i0, 2));
                acc += bflo(w.x) * VN[i0 * 128 + e] + bfhi(w.x) * VN[(i0 + 1) * 128 + e] + bflo(w.y) * VN[(i0 + 2) * 128 + e] + bfhi(w.y) * VN[(i0 + 3) * 128 + e]; }
            S[d * 128 + e] = acc; }
#pragma unroll 1
        for (int r = 0; r < 8; ++r) { const int i = wave * 8 + r; const float v0 = O[i * 128 + lane], v1 = O[i * 128 + lane + 64];
            const float rs = rsqrtf(wave_sum(v0 * v0 + v1 * v1) * (1.f / 128.f) + NORM_EPS);
            const size_t t = (size_t)b * SEQ + n * 64 + i; const bf16* gp = HP + t * HP_LD + COL_GG + h * 128; bf16* op = OB + t * 1024 + 512 + h * 128;
            op[lane] = (bf16)f2bf(v0 * rs * nw[lane] * siluf(bf2f(gp[lane]))); op[lane + 64] = (bf16)f2bf(v1 * rs * nw[lane + 64] * siluf(bf2f(gp[lane + 64]))); }
        __syncthreads();
    }
}

__device__ __forceinline__ void ret_unit_naive(KArgs a, int unit, LAS unsigned char* lds, int tid, int lane, int wave) {
    unsigned char* ws = a->ws;
    LAS float* Qs = (LAS float*)lds; LAS float* Ks = Qs + 64 * 65; LAS float* Vs = Ks + 64 * 65; LAS float* Sc = Vs + 8192;
    const int qb = unit & 31, bh = unit >> 5, h = bh & 3, b = bh >> 2, e = tid & 127, ig = tid >> 7;
    const bf16* HP = (const bf16*)(ws + WS_R + R_HP); bf16* OB = (bf16*)(ws + WS_R + R_OB); const float* RT = (const float*)(ws + WS_ROPE);
    const float log2g = log2f(1.0f - exp2f(-5.0f - (float)h));
    __syncthreads();
    for (int idx = tid; idx < 4096; idx += 512) { const int i = idx >> 6, d = idx & 63, dd = d & 31, pos = qb * 64 + i; const size_t t = (size_t)b * SEQ + pos;
        const float c = RT[pos * 64 + dd], s = RT[pos * 64 + 32 + dd]; const float x1 = bf2f(HP[t * HP_LD + COL_RQ + h * 64 + dd]), x2 = bf2f(HP[t * HP_LD + COL_RQ + h * 64 + dd + 32]);
        Qs[i * 65 + d] = d < 32 ? x1 * c - x2 * s : x1 * s + x2 * c; }
    float acc[16];
#pragma unroll
    for (int r = 0; r < 16; ++r) acc[r] = 0.f;
#pragma unroll 1
    for (int kb = 0; kb <= qb; ++kb) {
        __syncthreads();
        for (int idx = tid; idx < 4096; idx += 512) { const int i = idx >> 6, d = idx & 63, dd = d & 31, pos = kb * 64 + i; const size_t t = (size_t)b * SEQ + pos;
            const float c = RT[pos * 64 + dd], s = RT[pos * 64 + 32 + dd]; const float x1 = bf2f(HP[t * HP_LD + COL_RK + h * 64 + dd]), x2 = bf2f(HP[t * HP_LD + COL_RK + h * 64 + dd + 32]);
            Ks[i * 65 + d] = 0.125f * (d < 32 ? x1 * c - x2 * s : x1 * s + x2 * c); }
        for (int idx = tid; idx < 8192; idx += 512) { const int i = idx >> 7, d = idx & 127; Vs[idx] = bf2f(HP[((size_t)b * SEQ + kb * 64 + i) * HP_LD + COL_RV + h * 128 + d]); }
        __syncthreads();
        { const int j = tid & 63, ig8 = tid >> 6;
#pragma unroll 1
          for (int r = 0; r < 8; ++r) { const int i = ig8 + 8 * r; float dot = 0.f;
#pragma unroll 8
              for (int d = 0; d < 64; ++d) dot += Qs[i * 65 + d] * Ks[j * 65 + d];
              const int delta = (qb - kb) * 64 + i - j; Sc[i * 65 + j] = delta >= 0 ? dot * exp2f((float)delta * log2g) : 0.f; } }
        __syncthreads();
#pragma unroll 2
        for (int j = 0; j < 64; ++j) { const float vv = Vs[j * 128 + e];
#pragma unroll
            for (int r = 0; r < 16; ++r) acc[r] += Sc[(ig + 4 * r) * 65 + j] * vv; }
    }
    __syncthreads();
#pragma unroll
    for (int r = 0; r < 16; ++r) Vs[(ig + 4 * r) * 128 + e] = acc[r];
    __syncthreads();
#pragma unroll 1
    for (int r = 0; r < 8; ++r) { const int i = wave * 8 + r; const float v0 = Vs[i * 128 + lane], v1 = Vs[i * 128 + lane + 64];
        const float mean = wave_sum(v0 + v1) * (1.f / 128.f), d0 = v0 - mean, d1 = v1 - mean; const float rs = rsqrtf(wave_sum(d0 * d0 + d1 * d1) * (1.f / 128.f) + LN_EPS);
        const size_t t = (size_t)b * SEQ + qb * 64 + i; const bf16* gp = HP + t * HP_LD + COL_RG + h * 128; bf16* op = OB + t * 1024 + h * 128;
        op[lane] = (bf16)f2bf(d0 * rs * siluf(bf2f(gp[lane]))); op[lane + 64] = (bf16)f2bf(d1 * rs * siluf(bf2f(gp[lane + 64]))); }
}

typedef float f32x16 __attribute__((ext_vector_type(16)));
typedef float f32x8 __attribute__((ext_vector_type(8)));
typedef __bf16 bf8v __attribute__((ext_vector_type(8)));
typedef short bf16x8 __attribute__((ext_vector_type(8)));
#define MFMA32(a, b, c) __builtin_amdgcn_mfma_f32_32x32x16_bf16((a), (b), (c), 0, 0, 0)
__device__ __forceinline__ bf16x8 pack8(const f32x16& x, int s) {
    f32x8 v;
#pragma unroll
    for (int j = 0; j < 8; ++j) v[j] = x[8 * s + j];
    return __builtin_bit_cast(bf16x8, __builtin_convertvector(v, bf8v));
}

__device__ __forceinline__ unsigned short bfc(float x) { return __builtin_bit_cast(unsigned short, (__bf16)x); }
__device__ __forceinline__ unsigned bfc2(float lo, float hi) { return (unsigned)bfc(lo) | ((unsigned)bfc(hi) << 16); }

#define GDN_BAR() do { asm volatile("s_waitcnt lgkmcnt(0)" ::: "memory"); __builtin_amdgcn_s_barrier(); asm volatile("" ::: "memory"); } while (0)
__device__ __forceinline__ void gdn_scan_fast(KArgs a, int l, int bh, LAS unsigned char* lds, int tid, int lane, int wave) {
    unsigned char* ws = a->ws;
    constexpr int FB_WN = 0, FB_QD = 16384, FB_KDT = 32768, FB_QK = 49152, FB_U = 57344, FB_BYTES = 73728;
    LAS float* OL = (LAS float*)(lds + FB_BYTES);
    constexpr int OLS = 64 * 132;
    const int h = bh & 3, b = bh >> 2, c = lane & 31, hh = lane >> 5;
    const bf16* HP = (const bf16*)(ws + WS_R + R_HP); bf16* OB = (bf16*)(ws + WS_R + R_OB);
    const float* nw = a->in[5] + l * 128;
    const unsigned char* gWN = (const unsigned char*)(ws + WS_R + R_WN) + (size_t)bh * 32 * 16384; const unsigned char* gQD = (const unsigned char*)(ws + WS_R + R_QD) + (size_t)bh * 32 * 16384;
    const unsigned char* gKDT = (const unsigned char*)(ws + WS_R + R_KDT) + (size_t)bh * 32 * 16384; const unsigned char* gQK = (const unsigned char*)(ws + WS_R + R_QK) + (size_t)bh * 32 * 8192;
    const unsigned char* gU = (const unsigned char*)(ws + WS_R + R_U) + (size_t)bh * 32 * 16384;
    const int et = tid - 256;
#define GDN_FETCH(pf, nn) do { _Pragma("unroll") for (int k = 0; k < 18; ++k) { const unsigned char* src_ = k < 4 ? gWN + (size_t)(nn) * 16384 + k * 4096 : k < 8 ? gQD + (size_t)(nn) * 16384 + (k - 4) * 4096 : \
        k < 12 ? gKDT + (size_t)(nn) * 16384 + (k - 8) * 4096 : k < 14 ? gQK + (size_t)(nn) * 8192 + (k - 12) * 4096 : gU + (size_t)(nn) * 16384 + (k - 14) * 4096; pf[k] = *(const v4u*)(src_ + et * 16); } } while (0)
#define GDN_STORE(pf) do { _Pragma("unroll") for (int k = 0; k < 18; ++k) *(LAS v4u*)(lds + k * 4096 + et * 16) = pf[k]; } while (0)
    __syncthreads();
    if (wave < 4) {
        f32x16 S[4];
#pragma unroll
        for (int t = 0; t < 4; ++t)
#pragma unroll
            for (int i = 0; i < 16; ++i) S[t][i] = 0.f;
        GDN_BAR();
        const int q = wave;
        const LAS bf16x8* WNf = (const LAS bf16x8*)(lds + FB_WN) + lane; const LAS bf16x8* QDf = (const LAS bf16x8*)(lds + FB_QD) + lane;
        const LAS bf16x8* KDTf = (const LAS bf16x8*)(lds + FB_KDT) + lane; const LAS bf16x8* QKf = (const LAS bf16x8*)(lds + FB_QK) + lane;
        const LAS v4u* Uf = (const LAS v4u*)(lds + FB_U) + (q * 2) * 128 + lane;
#pragma unroll 1
        for (int n = 0; n < 32; ++n) {
            const float cd = ((const float*)(ws + WS_CD))[bh * 32 + n];
            bf16x8 A0[8], A1[8];
#define GDN_LD_MTS(A, F, g) do { _Pragma("unroll") for (int k = 0; k < 8; ++k) { const int m_ = k & 1, s_ = (k >> 1) & 1, t_ = 2 * (g) + (k >> 2); A[k] = F[((m_ * 4 + t_) * 2 + s_) * 64]; } } while (0)
#define GDN_LD_TMS(A, F, g) do { _Pragma("unroll") for (int k = 0; k < 8; ++k) { const int s_ = k & 1, m_ = (k >> 1) & 1, t_ = 2 * (g) + (k >> 2); A[k] = F[((t_ * 2 + m_) * 2 + s_) * 64]; } } while (0)
            GDN_LD_MTS(A0, WNf, 0); GDN_LD_MTS(A1, WNf, 1);
            f32x16 av[2];
#pragma unroll
            for (int m = 0; m < 2; ++m)
#pragma unroll
                for (int hf = 0; hf < 2; ++hf) { const v4u u4 = Uf[(m * 2 + hf) * 64];
#pragma unroll
                    for (int k = 0; k < 4; ++k) { av[m][8 * hf + 2 * k] = bflo(u4[k]); av[m][8 * hf + 2 * k + 1] = bfhi(u4[k]); } }
            bf16x8 Sb[4][2];
#pragma unroll
            for (int t = 0; t < 4; ++t) { Sb[t][0] = pack8(S[t], 0); Sb[t][1] = pack8(S[t], 1); }
#pragma unroll
            for (int k = 0; k < 8; ++k) { const int m_ = k & 1, s_ = (k >> 1) & 1, t_ = (k >> 2); av[m_] = MFMA32(A0[k], Sb[t_][s_], av[m_]); }
            GDN_LD_MTS(A0, QDf, 0);
#pragma unroll
            for (int k = 0; k < 8; ++k) { const int m_ = k & 1, s_ = (k >> 1) & 1, t_ = 2 + (k >> 2); av[m_] = MFMA32(A1[k], Sb[t_][s_], av[m_]); }
            GDN_LD_MTS(A1, QDf, 1);
            f32x16 ao[2];
#pragma unroll
            for (int m = 0; m < 2; ++m)
#pragma unroll
                for (int i = 0; i < 16; ++i) ao[m][i] = 0.f;
#pragma unroll
            for (int k = 0; k < 8; ++k) { const int m_ = k & 1, s_ = (k >> 1) & 1, t_ = (k >> 2); ao[m_] = MFMA32(A0[k], Sb[t_][s_], ao[m_]); }
#pragma unroll
            for (int k = 0; k < 6; ++k) { const int s_ = k & 1, m_ = k >= 2 ? 1 : 0, mp_ = k >= 4 ? 1 : 0; A0[k] = QKf[((m_ * 2 + mp_) * 2 + s_) * 64]; }
#pragma unroll
            for (int k = 0; k < 8; ++k) { const int m_ = k & 1, s_ = (k >> 1) & 1, t_ = 2 + (k >> 2); ao[m_] = MFMA32(A1[k], Sb[t_][s_], ao[m_]); }
            GDN_LD_TMS(A1, KDTf, 0);
            bf16x8 Vb[2][2];
#pragma unroll
            for (int m = 0; m < 2; ++m) { Vb[m][0] = pack8(av[m], 0); Vb[m][1] = pack8(av[m], 1); }
#pragma unroll
            for (int k = 0; k < 6; ++k) { const int s_ = k & 1, m_ = k >= 2 ? 1 : 0, mp_ = k >= 4 ? 1 : 0; ao[m_] = MFMA32(A0[k], Vb[mp_][s_], ao[m_]); }
            GDN_LD_TMS(A0, KDTf, 1);
            {   LAS float* Ob = OL + (n & 1) * OLS + 32 * wave + c;
#pragma unroll
                for (int m = 0; m < 2; ++m)
#pragma unroll
                    for (int i = 0; i < 16; ++i) Ob[(32 * m + (i & 3) + 8 * (i >> 2) + 4 * hh) * 132] = ao[m][i]; }
#pragma unroll
            for (int t = 0; t < 4; ++t)
#pragma unroll
                for (int i = 0; i < 16; ++i) S[t][i] *= cd;
#pragma unroll
            for (int k = 0; k < 8; ++k) { const int s_ = k & 1, m_ = (k >> 1) & 1, t_ = (k >> 2); S[t_] = MFMA32(A1[k], Vb[m_][s_], S[t_]); }
#pragma unroll
            for (int k = 0; k < 8; ++k) { const int s_ = k & 1, m_ = (k >> 1) & 1, t_ = 2 + (k >> 2); S[t_] = MFMA32(A0[k], Vb[m_][s_], S[t_]); }
#undef GDN_LD_MTS
#undef GDN_LD_TMS
            GDN_BAR();
            GDN_BAR();
        }
        GDN_BAR(); GDN_BAR();
    } else {
        v4u pfA[18], pfB[18];
        LAS float* NWl = OL + 2 * OLS;
        if (et < 128) NWl[et] = nw[et];
        GDN_FETCH(pfB, 0); GDN_FETCH(pfA, 1); GDN_STORE(pfB);
        GDN_BAR();
        const int i = et >> 2, qd = et & 3;
#define GDN_LOADER_ITER(n, PF_FETCH, PF_STORE) do { \
            if ((n) + 2 < 32) GDN_FETCH(PF_FETCH, (n) + 2); \
            if ((n) > 0) { \
                const LAS float* Ob = OL + (((n) - 1) & 1) * OLS + i * 132 + 32 * qd; \
                float ss = 0.f; \
                _Pragma("unroll") for (int k = 0; k < 8; ++k) { const f32x4 v_ = *(const LAS f32x4*)(Ob + 4 * k); ss += (v_.x * v_.x + v_.y * v_.y) + (v_.z * v_.z + v_.w * v_.w); } \
                ss += __shfl_xor(ss, 1); ss += __shfl_xor(ss, 2); \
                const float rs = rsqrtf(ss * (1.f / 128.f) + NORM_EPS); \
                bf16* op = OB + ((size_t)b * SEQ + ((n) - 1) * 64 + i) * 1024 + 512 + h * 128 + 32 * qd; \
                _Pragma("unroll") for (int k = 0; k < 4; ++k) { const f32x4 w0 = *(const LAS f32x4*)(NWl + 32 * qd + 8 * k), w1 = *(const LAS f32x4*)(NWl + 32 * qd + 8 * k + 4); const v4u gg = gq[k]; \
                    const f32x4 a0 = *(const LAS f32x4*)(Ob + 8 * k), a1 = *(const LAS f32x4*)(Ob + 8 * k + 4); \
                    v4u o; o.x = bfc2(a0.x * rs * w0.x * siluf(bflo(gg.x)), a0.y * rs * w0.y * siluf(bfhi(gg.x))); o.y = bfc2(a0.z * rs * w0.z * siluf(bflo(gg.y)), a0.w * rs * w0.w * siluf(bfhi(gg.y))); \
                    o.z = bfc2(a1.x * rs * w1.x * siluf(bflo(gg.z)), a1.y * rs * w1.y * siluf(bfhi(gg.z))); o.w = bfc2(a1.z * rs * w1.z * siluf(bflo(gg.w)), a1.w * rs * w1.w * siluf(bfhi(gg.w))); \
                    *(v4u*)(op + 8 * k) = o; } \
            } \
            asm volatile("" ::: "memory"); \
            if ((n) < 32) { const bf16* gp = HP + ((size_t)b * SEQ + (n) * 64 + i) * HP_LD + COL_GG + h * 128 + 32 * qd;     \
                _Pragma("unroll") for (int k = 0; k < 4; ++k) gq[k] = *(const v4u*)(gp + 8 * k); } \
            GDN_BAR();            \
            if ((n) + 1 < 32) GDN_STORE(PF_STORE); \
            GDN_BAR();            \
        } while (0)
        v4u gq[4];
#pragma unroll
        for (int k = 0; k < 4; ++k) gq[k] = (v4u){0u, 0u, 0u, 0u};
#pragma unroll
        for (int n = 0; n < 32; n += 2) {
            GDN_LOADER_ITER(n, pfB, pfA);
            GDN_LOADER_ITER(n + 1, pfA, pfB);
        }
        GDN_LOADER_ITER(32, pfB, pfA);
#undef GDN_LOADER_ITER
    }
#undef GDN_FETCH
#undef GDN_STORE
}

struct RetLds {
    static constexpr int QS = 72, JS = 136;
    static constexpr int P = 0, Q1 = 34816, K1 = 53248, OL = 0, K1T = 71680, VT = 89088, ST = 123904;
};
template <bool WANT_Q, bool WANT_K1, bool WANT_K1T>
__device__ __forceinline__ void ret_stage(const bf16* HP, const float* RT, int b, int h, int n, float lg, LAS unsigned char* lds, int tid) {
    constexpr int QS = RetLds::QS, JS = RetLds::JS;
    LAS bf16* Q1 = (LAS bf16*)(lds + RetLds::Q1); LAS bf16* K1 = (LAS bf16*)(lds + RetLds::K1); LAS bf16* K1T = (LAS bf16*)(lds + RetLds::K1T); LAS bf16* VT = (LAS bf16*)(lds + RetLds::VT);
    const int i = tid >> 2, dd = (tid & 3) * 8, pos = n * 128 + i; const size_t t = (size_t)b * SEQ + pos;
    const bf16* hp = HP + t * HP_LD;
    const f32x4 c0 = *(const f32x4*)(RT + pos * 64 + dd), c1 = *(const f32x4*)(RT + pos * 64 + dd + 4), s0 = *(const f32x4*)(RT + pos * 64 + 32 + dd), s1 = *(const f32x4*)(RT + pos * 64 + 32 + dd + 4);
    const float cs[8] = {c0.x, c0.y, c0.z, c0.w, c1.x, c1.y, c1.z, c1.w}, sn[8] = {s0.x, s0.y, s0.z, s0.w, s1.x, s1.y, s1.z, s1.w};
    const float sq = exp2f((float)i * lg), sk = 0.125f * exp2f(-(float)i * lg);
    v4u xv[4];
#pragma unroll
    for (int p = 0; p < 4; ++p) { const int idx = tid + 512 * p, j = idx >> 4, e0 = (idx & 15) * 8; xv[p] = *(const v4u*)(HP + ((size_t)b * SEQ + n * 128 + j) * HP_LD + COL_RV + h * 128 + e0); }
#pragma unroll
    for (int which = (WANT_Q ? 0 : 1); which < 2; ++which) {
        const bf16* src = hp + (which == 0 ? COL_RQ : COL_RK) + h * 64 + dd;
        const v4u x1 = *(const v4u*)src, x2 = *(const v4u*)(src + 32);
        const float sc = which == 0 ? sq : sk;
        float lo[8], hi[8];
#pragma unroll
        for (int k = 0; k < 4; ++k) { const float a0 = bflo(x1[k]), a1 = bfhi(x1[k]), b0 = bflo(x2[k]), b1 = bfhi(x2[k]);
            lo[2 * k] = (a0 * cs[2 * k] - b0 * sn[2 * k]) * sc; lo[2 * k + 1] = (a1 * cs[2 * k + 1] - b1 * sn[2 * k + 1]) * sc;
            hi[2 * k] = (a0 * sn[2 * k] + b0 * cs[2 * k]) * sc; hi[2 * k + 1] = (a1 * sn[2 * k + 1] + b1 * cs[2 * k + 1]) * sc; }
        v4u wl, wh;
#pragma unroll
        for (int k = 0; k < 4; ++k) { wl[k] = bfc2(lo[2 * k], lo[2 * k + 1]); wh[k] = bfc2(hi[2 * k], hi[2 * k + 1]); }
        if (which == 0 || WANT_K1) { LAS bf16* dst = (which == 0 ? Q1 : K1) + i * QS + dd; *(LAS v4u*)dst = wl; *(LAS v4u*)(dst + 32) = wh; }
        if (which == 1 && WANT_K1T) {
#pragma unroll
            for (int k = 0; k < 4; ++k) { K1T[(dd + 2 * k) * JS + i] = (bf16)(wl[k] & 0xffffu); K1T[(dd + 2 * k + 1) * JS + i] = (bf16)(wl[k] >> 16);
                K1T[(32 + dd + 2 * k) * JS + i] = (bf16)(wh[k] & 0xffffu); K1T[(32 + dd + 2 * k + 1) * JS + i] = (bf16)(wh[k] >> 16); }
        }
    }
#pragma unroll
    for (int p = 0; p < 4; ++p) { const int idx = tid + 512 * p, j = idx >> 4, e0 = (idx & 15) * 8;
#pragma unroll
        for (int k = 0; k < 4; ++k) { VT[(e0 + 2 * k) * JS + j] = (bf16)(xv[p][k] & 0xffffu); VT[(e0 + 2 * k + 1) * JS + j] = (bf16)(xv[p][k] >> 16); } }
}
__device__ __forceinline__ void ret_kv_unit(KArgs a, int unit, LAS unsigned char* lds, int tid, int lane, int wave) {
    unsigned char* ws = a->ws;
    constexpr int JS = RetLds::JS;
    const int n = unit & 15, bh = unit >> 4, h = bh & 3, b = bh >> 2, c = lane & 31, hh = lane >> 5;
    const bf16* HP = (const bf16*)(ws + WS_R + R_HP); const float* RT = (const float*)(ws + WS_ROPE);
    const float gam = 1.0f - exp2f(-5.0f - (float)h), lg = log2f(gam), g127 = exp2f(127.f * lg);
    LAS bf16* K1T = (LAS bf16*)(lds + RetLds::K1T); LAS bf16* VT = (LAS bf16*)(lds + RetLds::VT);
    __syncthreads();
    ret_stage<false, false, true>(HP, RT, b, h, n, lg, lds, tid);
    __syncthreads();
    const int td = wave >> 2, te = wave & 3;
    f32x16 kv;
#pragma unroll
    for (int i = 0; i < 16; ++i) kv[i] = 0.f;
#pragma unroll
    for (int ks = 0; ks < 8; ++ks) kv = MFMA32(*(const LAS bf16x8*)(K1T + (32 * td + c) * JS + 16 * ks + 8 * hh), *(const LAS bf16x8*)(VT + (32 * te + c) * JS + 16 * ks + 8 * hh), kv);
    float* dst = (float*)(ws + WS_KV) + ((size_t)(unit * 8 + wave) * 64 + lane) * 16;
#pragma unroll
    for (int g = 0; g < 4; ++g) *(f32x4*)(dst + 4 * g) = (f32x4){kv[4 * g] * g127, kv[4 * g + 1] * g127, kv[4 * g + 2] * g127, kv[4 * g + 3] * g127};
}
__device__ __forceinline__ void ret_out_unit(KArgs a, int unit, LAS unsigned char* lds, int tid, int lane, int wave) {
    unsigned char* ws = a->ws;
    constexpr int QS = RetLds::QS, JS = RetLds::JS;
    LAS bf16* P = (LAS bf16*)(lds + RetLds::P); LAS bf16* Q1 = (LAS bf16*)(lds + RetLds::Q1); LAS bf16* K1 = (LAS bf16*)(lds + RetLds::K1); LAS float* OL = (LAS float*)(lds + RetLds::OL);
    LAS bf16* VT = (LAS bf16*)(lds + RetLds::VT); LAS bf16* ST = (LAS bf16*)(lds + RetLds::ST);
    const int n = unit & 15, bh = unit >> 4, h = bh & 3, b = bh >> 2, c = lane & 31, hh = lane >> 5;
    const bf16* HP = (const bf16*)(ws + WS_R + R_HP); bf16* OB = (bf16*)(ws + WS_R + R_OB); const float* RT = (const float*)(ws + WS_ROPE);
    const float gam = 1.0f - exp2f(-5.0f - (float)h), lg = log2f(gam), g128 = exp2f(128.f * lg);
    __syncthreads();
    const int ei = tid >> 2, eq = tid & 3; const size_t et = (size_t)b * SEQ + n * 128 + ei;
    v4u gg[4];
    { const bf16* gp = HP + et * HP_LD + COL_RG + h * 128 + 32 * eq;
#pragma unroll
      for (int k = 0; k < 4; ++k) gg[k] = *(const v4u*)(gp + 8 * k); }
    {
        const int td = wave >> 2, te = wave & 3;
        f32x16 S;
#pragma unroll
        for (int i = 0; i < 16; ++i) S[i] = 0.f;
        const float* src = (const float*)(ws + WS_KV) + ((size_t)((bh * 16) * 8 + wave) * 64 + lane) * 16;
#pragma unroll 2
        for (int m = 0; m < n; ++m) { const f32x4* p4 = (const f32x4*)(src + (size_t)m * 8 * 64 * 16);
#pragma unroll
            for (int g = 0; g < 4; ++g) { const f32x4 v = p4[g]; S[4 * g] = S[4 * g] * g128 + v.x; S[4 * g + 1] = S[4 * g + 1] * g128 + v.y; S[4 * g + 2] = S[4 * g + 2] * g128 + v.z; S[4 * g + 3] = S[4 * g + 3] * g128 + v.w; } }
#pragma unroll
        for (int g = 0; g < 4; ++g) { v2u w; w.x = bfc2(S[4 * g], S[4 * g + 1]); w.y = bfc2(S[4 * g + 2], S[4 * g + 3]); *(LAS v2u*)(ST + (32 * te + c) * QS + 32 * td + 8 * g + 4 * hh) = w; }
    }
    ret_stage<true, true, false>(HP, RT, b, h, n, lg, lds, tid);
    __syncthreads();
#pragma unroll 1
    for (int rep = 0; rep < 2; ++rep) { const int idx = wave + 8 * rep;
        if (idx < 10) { const int ti = (idx >= 1) + (idx >= 3) + (idx >= 6), tj = idx - ti * (ti + 1) / 2;
            f32x16 acc;
#pragma unroll
            for (int i = 0; i < 16; ++i) acc[i] = 0.f;
#pragma unroll
            for (int s2 = 0; s2 < 4; ++s2) acc = MFMA32(*(const LAS bf16x8*)(Q1 + (32 * ti + c) * QS + 16 * s2 + 8 * hh), *(const LAS bf16x8*)(K1 + (32 * tj + c) * QS + 16 * s2 + 8 * hh), acc);
#pragma unroll
            for (int i = 0; i < 16; ++i) { const int il = (i & 3) + 8 * (i >> 2) + 4 * hh; float v = acc[i]; if (ti == tj && il < c) v = 0.f; P[(32 * ti + il) * JS + 32 * tj + c] = bfc(v); } } }
    __syncthreads();
    const int ti = wave >> 1, te0 = 2 * (wave & 1);
    f32x16 ao[2];
#pragma unroll
    for (int u = 0; u < 2; ++u)
#pragma unroll
        for (int i = 0; i < 16; ++i) ao[u][i] = 0.f;
#pragma unroll
    for (int s2 = 0; s2 < 4; ++s2) { const bf16x8 A = *(const LAS bf16x8*)(Q1 + (32 * ti + c) * QS + 16 * s2 + 8 * hh);
#pragma unroll
        for (int u = 0; u < 2; ++u) ao[u] = MFMA32(A, *(const LAS bf16x8*)(ST + (32 * (te0 + u) + c) * QS + 16 * s2 + 8 * hh), ao[u]); }
#pragma unroll
    for (int u = 0; u < 2; ++u)
#pragma unroll
        for (int i = 0; i < 16; ++i) ao[u][i] *= gam;
#pragma unroll 1
    for (int tj = 0; tj <= ti; ++tj)
#pragma unroll
        for (int s2 = 0; s2 < 2; ++s2) { const bf16x8 A = *(const LAS bf16x8*)(P + (32 * ti + c) * JS + 32 * tj + 16 * s2 + 8 * hh);
#pragma unroll
            for (int u = 0; u < 2; ++u) ao[u] = MFMA32(A, *(const LAS bf16x8*)(VT + (32 * (te0 + u) + c) * JS + 32 * tj + 16 * s2 + 8 * hh), ao[u]); }
    __syncthreads();
#pragma unroll
    for (int u = 0; u < 2; ++u)
#pragma unroll
        for (int i = 0; i < 16; ++i) OL[(32 * ti + (i & 3) + 8 * (i >> 2) + 4 * hh) * 132 + 32 * (te0 + u) + c] = ao[u][i];
    __syncthreads();
    {
        const LAS float* Ob = OL + ei * 132 + 32 * eq; bf16* op = OB + et * 1024 + h * 128 + 32 * eq;
        f32x4 v[8]; float sm = 0.f;
#pragma unroll
        for (int k = 0; k < 8; ++k) { v[k] = *(const LAS f32x4*)(Ob + 4 * k); sm += (v[k].x + v[k].y) + (v[k].z + v[k].w); }
        sm += __shfl_xor(sm, 1); sm += __shfl_xor(sm, 2);
        const float mean = sm * (1.f / 128.f); float sq = 0.f;
#pragma unroll
        for (int k = 0; k < 8; ++k) { v[k] = v[k] - mean; sq += (v[k].x * v[k].x + v[k].y * v[k].y) + (v[k].z * v[k].z + v[k].w * v[k].w); }
        sq += __shfl_xor(sq, 1); sq += __shfl_xor(sq, 2);
        const float rs = rsqrtf(sq * (1.f / 128.f) + LN_EPS);
#pragma unroll
        for (int k = 0; k < 4; ++k) { const v4u g4 = gg[k]; const f32x4 a0 = v[2 * k], a1 = v[2 * k + 1];
            v4u o; o.x = bfc2(a0.x * rs * siluf(bflo(g4.x)), a0.y * rs * siluf(bfhi(g4.x))); o.y = bfc2(a0.z * rs * siluf(bflo(g4.y)), a0.w * rs * siluf(bfhi(g4.y)));
            o.z = bfc2(a1.x * rs * siluf(bflo(g4.z)), a1.y * rs * siluf(bfhi(g4.z))); o.w = bfc2(a1.z * rs * siluf(bflo(g4.w)), a1.w * rs * siluf(bfhi(g4.w)));
            *(v4u*)(op + 8 * k) = o; }
    }
}

__device__ __forceinline__ void gdn_prep_fast(KArgs a, int l, int unit, LAS unsigned char* lds, int tid, int lane, int wave) {
    unsigned char* ws = a->ws;
    constexpr int KS = 136;
    LAS bf16* Kb = (LAS bf16*)lds;
    LAS bf16* Qb = (LAS bf16*)(lds + 17408);
    LAS float* A = (LAS float*)(lds + 34816);
    LAS float* V = (LAS float*)(lds + 51200);
    LAS float* KW = (LAS float*)(lds + 83968);
    LAS float* gc = (LAS float*)(lds + 116736);
    LAS float* bt = gc + 64;
    LAS bf16* KDs = (LAS bf16*)(lds + 117248);
    const int n = unit & 31, bh = unit >> 5, h = bh & 3, b = bh >> 2, t0 = b * SEQ + n * 64, c = lane & 31, hh = lane >> 5;
    const bf16* HP = (const bf16*)(ws + WS_R + R_HP);
    bf16* QKg = (bf16*)(ws + WS_R + R_QK) + (size_t)unit * 4096; bf16* QDg = (bf16*)(ws + WS_R + R_QD) + (size_t)unit * 8192; bf16* KDTg = (bf16*)(ws + WS_R + R_KDT) + (size_t)unit * 8192;
    bf16* WNg = (bf16*)(ws + WS_R + R_WN) + (size_t)unit * 8192; bf16* Ug = (bf16*)(ws + WS_R + R_U) + (size_t)unit * 8192;
    __syncthreads();
    if (wave == 0) {
        const float* gab = (const float*)(ws + WS_GAB) + (size_t)(t0 + lane) * 8; const float x = gab[h] + a->in[4][l * 4 + h];
        const float sp = fmaxf(x, 0.f) + log1pf(__expf(-fabsf(x))); float g = -__expf(a->in[3][l * 4 + h]) * sp;
#pragma unroll
        for (int o = 1; o < 64; o <<= 1) { const float up = __shfl_up(g, o); if (lane >= o) g += up; }
        gc[lane] = g; bt[lane] = sigmf(gab[4 + h]);
        if (lane == 63) ((float*)(ws + WS_CD))[unit] = __expf(g);
    }
    __syncthreads();
#ifndef PREP_NO_CONV
    if (wave < 6) {
        const int cg = tid % 48, rb = tid / 48, which = cg >> 4, dd = (cg & 15) * 8, col = COL_GQ + which * 512 + h * 128 + dd, cc = which * 512 + h * 128 + dd;
        const float* cw = a->in[2] + (size_t)l * 4 * 1536 + cc;
        float w[4][8];
#pragma unroll
        for (int j = 0; j < 4; ++j) { const f32x4 w0 = *(const f32x4*)(cw + j * 1536), w1 = *(const f32x4*)(cw + j * 1536 + 4); w[j][0] = w0.x; w[j][1] = w0.y; w[j][2] = w0.z; w[j][3] = w0.w; w[j][4] = w1.x; w[j][5] = w1.y; w[j][6] = w1.z; w[j][7] = w1.w; }
        float x0[8], x1[8], x2[8], x3[8];
        const int sbase = n * 64 + 8 * rb - 3;
        const bf16* hpc = HP + (size_t)(b * SEQ) * HP_LD + col;
#define PREP_LDROW(dst, s_) do { v4u raw_ = (v4u){0u, 0u, 0u, 0u}; if ((s_) >= 0) raw_ = *(const v4u*)(hpc + (size_t)(s_) * HP_LD); \
        _Pragma("unroll") for (int k_ = 0; k_ < 4; ++k_) { dst[2 * k_] = bflo(raw_[k_]); dst[2 * k_ + 1] = bfhi(raw_[k_]); } } while (0)
        PREP_LDROW(x0, sbase); PREP_LDROW(x1, sbase + 1); PREP_LDROW(x2, sbase + 2);
        const float gl = gc[63];
#pragma unroll 1
        for (int r = 0; r < 8; ++r) { const int i = 8 * rb + r; float y[8]; float ss = 0.f;
            PREP_LDROW(x3, sbase + 3 + r);
#pragma unroll
            for (int k = 0; k < 8; ++k) { const float acc = w[0][k] * x0[k] + w[1][k] * x1[k] + w[2][k] * x2[k] + w[3][k] * x3[k]; y[k] = siluf(acc); ss += y[k] * y[k]; x0[k] = x1[k]; x1[k] = x2[k]; x2[k] = x3[k]; }
            ss += __shfl_xor(ss, 1); ss += __shfl_xor(ss, 2); ss += __shfl_xor(ss, 4); ss += __shfl_xor(ss, 8);
            const float gi = gc[i], bi = bt[i];
            if (which == 0) { const float f = rsqrtf(ss + NORM_EPS) * 0.08838834764831845f, eg = __expf(gi);
                v4u p, pd;
#pragma unroll
                for (int k = 0; k < 4; ++k) { p[k] = bfc2(y[2 * k] * f, y[2 * k + 1] * f); pd[k] = bfc2(y[2 * k] * f * eg, y[2 * k + 1] * f * eg); }
                *(LAS v4u*)(Qb + i * KS + dd) = p;
                bf16* qd = QDg + (((i >> 5) * 4 + (dd >> 5)) * 2 + ((dd >> 4) & 1)) * 512 + (i & 31) * 8 + ((dd >> 3) & 1) * 4;
                *(v2u*)qd = (v2u){pd[0], pd[1]}; *(v2u*)(qd + 256) = (v2u){pd[2], pd[3]};
            } else if (which == 1) { const float f = rsqrtf(ss + NORM_EPS), fw = f * bi * __expf(gi), fd = f * __expf(gl - gi);
                v4u p;
#pragma unroll
                for (int k = 0; k < 4; ++k) p[k] = bfc2(y[2 * k] * f, y[2 * k + 1] * f);
                *(LAS v4u*)(Kb + i * KS + dd) = p;
#pragma unroll
                for (int k = 0; k < 8; ++k) { KW[i * 128 + dd + k] = y[k] * fw; KDs[(dd + k) * 72 + i] = bfc(y[k] * fd); }
            } else {
#pragma unroll
                for (int k = 0; k < 8; ++k) V[i * 128 + dd + k] = y[k] * bi;
            }
        }
#undef PREP_LDROW
    }
#endif
    __syncthreads();
    {
        const int ti = (wave >> 1) & 1, tj = wave & 1;
        if (wave < 4) {
            if (tj <= ti) {
                f32x16 acc;
#pragma unroll
                for (int i = 0; i < 16; ++i) acc[i] = 0.f;
#pragma unroll
                for (int s = 0; s < 8; ++s) acc = MFMA32(*(const LAS bf16x8*)(Kb + (32 * ti + c) * KS + 16 * s + 8 * hh), *(const LAS bf16x8*)(Kb + (32 * tj + c) * KS + 16 * s + 8 * hh), acc);
                const int j = 32 * tj + c; const float gj = gc[j];
#pragma unroll
                for (int r = 0; r < 16; ++r) { const int i = 32 * ti + (r & 3) + 8 * (r >> 2) + 4 * hh; A[i * 64 + j] = (j < i) ? bt[i] * acc[r] * __expf(gc[i] - gj) : 0.f; }
            } else {
#pragma unroll
                for (int r = 0; r < 16; ++r) { const int i = 32 * ti + (r & 3) + 8 * (r >> 2) + 4 * hh; A[i * 64 + 32 * tj + c] = 0.f; }
            }
        } else {
            const int kt = ti, qt = tj;
            if (kt <= qt) {
                f32x16 acc;
#pragma unroll
                for (int i = 0; i < 16; ++i) acc[i] = 0.f;
#pragma unroll
                for (int s = 0; s < 8; ++s) acc = MFMA32(*(const LAS bf16x8*)(Kb + (32 * kt + c) * KS + 16 * s + 8 * hh), *(const LAS bf16x8*)(Qb + (32 * qt + c) * KS + 16 * s + 8 * hh), acc);
                const int i = 32 * qt + c; const float gi = gc[i];
#pragma unroll
                for (int r = 0; r < 16; ++r) { const int j = 32 * kt + (r & 3) + 8 * (r >> 2) + 4 * hh; acc[r] = (j <= i) ? acc[r] * __expf(gi - gc[j]) : 0.f; }
                bf16x8* qf = (bf16x8*)QKg + lane;
                qf[((qt * 2 + kt) * 2 + 0) * 64] = pack8(acc, 0); qf[((qt * 2 + kt) * 2 + 1) * 64] = pack8(acc, 1);
            }
        }
    }
    __syncthreads();
#ifndef PREP_NO_SOLVE
    if (wave < 4) {
        const int col = tid & 127; LAS float* rhs = (tid < 128 ? V : KW) + col;
        float x[64];
#pragma unroll
        for (int i = 0; i < 64; ++i) {
            float s0 = rhs[i * 128], s1 = 0.f, s2 = 0.f, s3 = 0.f;
#pragma unroll
            for (int m4 = 0; m4 < (i + 3) / 4; ++m4) { const f32x4 a4 = *(const LAS f32x4*)(A + i * 64 + 4 * m4);
                if (4 * m4 < i) s0 -= a4.x * x[4 * m4];
                if (4 * m4 + 1 < i) s1 -= a4.y * x[4 * m4 + 1];
                if (4 * m4 + 2 < i) s2 -= a4.z * x[4 * m4 + 2];
                if (4 * m4 + 3 < i) s3 -= a4.w * x[4 * m4 + 3]; }
            x[i] = (s0 + s1) + (s2 + s3);
        }
        if (tid < 128) {
#pragma unroll
            for (int m = 0; m < 2; ++m)
#pragma unroll
                for (int hx = 0; hx < 2; ++hx)
#pragma unroll
                    for (int hf = 0; hf < 2; ++hf) { const int i0 = 32 * m + 16 * hf + 4 * hx;
                        v4u w; w.x = bfc2(x[i0], x[i0 + 1]); w.y = bfc2(x[i0 + 2], x[i0 + 3]); w.z = bfc2(x[i0 + 8], x[i0 + 9]); w.w = bfc2(x[i0 + 10], x[i0 + 11]);
                        *(v4u*)(Ug + uoff(i0, col)) = w; }
        } else {
#pragma unroll
            for (int i = 0; i < 64; ++i) Qb[i * KS + col] = bfc(-x[i]);
        }
    }
#endif
    __syncthreads();
#pragma unroll
    for (int p = 0; p < 4; ++p) { const int idx = tid + 512 * p, i = idx >> 5, d = (idx & 31) * 4;
        *(v2u*)(WNg + fragoff(i, d, 4)) = *(const LAS v2u*)(Qb + i * KS + d); }
#pragma unroll
    for (int p = 0; p < 4; ++p) { const int idx = tid + 512 * p, d = idx >> 4, i = (idx & 15) * 4;
        *(v2u*)(KDTg + fragoff(d, i, 2)) = *(const LAS v2u*)(KDs + d * 72 + i); }
}
#define XB_TMO      128
#define XB_XCNT(j)  (256  + 64 * (j))
#define XB_XSUB(j)  (1280 + 64 * (j))
#define XB_XGEN(j)  (2304 + 64 * (j))
#define XB_TOP      3328
#define XB_TOPGEN   3392
#define XCD_BAR_WORDS 3456
#define XB_SPIN_CAP (1u << 18)

__device__ __forceinline__ unsigned xb_ld(unsigned* p)              { return __hip_atomic_load(p, __ATOMIC_RELAXED, __HIP_MEMORY_SCOPE_AGENT); }
__device__ __forceinline__ unsigned xb_add(unsigned* p, unsigned v) { return __hip_atomic_fetch_add(p, v, __ATOMIC_RELAXED, __HIP_MEMORY_SCOPE_AGENT); }
__device__ __forceinline__ unsigned xb_xcc_id() { return (unsigned)__builtin_amdgcn_s_getreg((3 << 11) | 20) & 0xFu; }
#define XB_SPIN(cond, bar) do { unsigned _sp = 0; while (cond) { __builtin_amdgcn_s_sleep(1); \
    if ((++_sp & 255u) == 0u) { if (xb_ld(&(bar)[XB_TMO])) break; if (_sp > XB_SPIN_CAP) { atomicAdd(&(bar)[XB_TMO], 1u); break; } } } } while (0)

struct XcdBarrier {
    unsigned* bar; unsigned x;
    volatile LAS unsigned* st;
};

__device__ __forceinline__ XcdBarrier xcd_barrier_post(unsigned* bar, volatile LAS unsigned* st) {
    XcdBarrier b; b.bar = bar; b.x = xb_xcc_id(); b.st = st;
    if (threadIdx.x == 0) (void)xb_add(&bar[XB_XCNT(b.x)], 1u);
    return b;
}
__device__ __forceinline__ void xcd_barrier_complete(unsigned* bar, unsigned x, unsigned& nloc, unsigned& nx) {
    const unsigned G = gridDim.x * gridDim.y * gridDim.z;
    unsigned sum, cnt, mine, sp = 0u;
    for (;;) {
        sum = 0u; cnt = 0u; mine = 0u;
#pragma unroll
        for (unsigned j = 0; j < 16; ++j) { const unsigned c = xb_ld(&bar[XB_XCNT(j)]); sum += c; cnt += (c > 0u) ? 1u : 0u; mine = (j == x) ? c : mine; }
        if (sum == G) break;
        __builtin_amdgcn_s_sleep(1);
        if ((++sp & 255u) == 0u) { if (xb_ld(&bar[XB_TMO])) break; if (sp > XB_SPIN_CAP) { atomicAdd(&bar[XB_TMO], 1u); break; } }
    }
    nloc = mine > 0u ? mine : 1u; nx = cnt > 0u ? cnt : 1u;
}

__device__ __forceinline__ void xcd_barrier(const XcdBarrier& b) {
    asm volatile("s_waitcnt vmcnt(0)" ::: "memory");
    __syncthreads();
    if (threadIdx.x == 0) {
        unsigned* bar = b.bar;
        __builtin_amdgcn_s_waitcnt(0);
        unsigned nloc = b.st[0], nx = b.st[1];
        if (nloc == 0u) { xcd_barrier_complete(bar, b.x, nloc, nx); b.st[0] = nloc; b.st[1] = nx; }
        const unsigned old = xb_add(&bar[XB_XSUB(b.x)], 1u);
        const unsigned gen = old / nloc;
        if (old + 1u == (gen + 1u) * nloc) {
            __builtin_amdgcn_fence(__ATOMIC_RELEASE, "agent");
            asm volatile("s_waitcnt vmcnt(0)" ::: "memory");
            const unsigned og = xb_add(&bar[XB_TOP], 1u);
            const unsigned tg = og / nx;
            if (og + 1u == (tg + 1u) * nx) xb_add(&bar[XB_TOPGEN], 1u);
            else XB_SPIN(xb_ld(&bar[XB_TOPGEN]) == tg, bar);
            __builtin_amdgcn_fence(__ATOMIC_ACQUIRE, "agent");
            xb_add(&bar[XB_XGEN(b.x)], 1u);
            asm volatile("s_waitcnt vmcnt(0)" ::: "memory");
        } else {
            XB_SPIN(xb_ld(&bar[XB_XGEN(b.x)]) == gen, bar);
            __builtin_amdgcn_fence(__ATOMIC_ACQUIRE, "agent");
            asm volatile("s_waitcnt vmcnt(0)" ::: "memory");
        }
    }
    __syncthreads();
}
#ifndef REP_PRO
#define REP_PRO 1
#endif
#ifndef REP_IN
#define REP_IN 1
#endif
#ifndef REP_PREP
#define REP_PREP 1
#endif
#ifndef REP_SCAN
#define REP_SCAN 1
#endif
#ifndef REP_OUT
#define REP_OUT 1
#endif
#ifndef REP_GU
#define REP_GU 1
#endif
#ifndef REP_DN
#define REP_DN 1
#endif
#ifndef REP_MGU
#define REP_MGU 1
#endif
#ifndef REP_GDN
#define REP_GDN 1
#endif
#ifndef REP_RET
#define REP_RET 1
#endif
#ifndef FAST_SCAN
#define FAST_SCAN 1
#endif
#ifndef FAST_RET
#define FAST_RET 1
#endif
#ifndef FAST_PREP
#define FAST_PREP 1
#endif
#ifndef EN_PRO
#define EN_PRO 1
#endif
#ifndef EN_IN
#define EN_IN 1
#endif
#ifndef EN_PREP
#define EN_PREP 1
#endif
#ifndef EN_SCAN
#define EN_SCAN 1
#endif
#ifndef EN_OUT
#define EN_OUT 1
#endif
#ifndef EN_LN1
#define EN_LN1 1
#endif
#ifndef EN_FFN0
#define EN_FFN0 1
#endif
#ifndef EN_MOE
#define EN_MOE 1
#endif

__global__ void __launch_bounds__(NWAVES * 64, 2) fwd(Args a_unused) {
    extern __shared__ __attribute__((aligned(16))) unsigned char lds_raw[];
    LAS unsigned char* lds = (LAS unsigned char*)lds_raw;
    { const int tid0 = threadIdx.x; for (int u = tid0; u < (LDS_BYTES - LDSCTL_OFF) / 4; u += NWAVES * 64) ((LAS unsigned*)(lds + LDSCTL_OFF))[u] = 0u; }
    __syncthreads();
#if ONE_LAUNCH
    XcdBarrier bar = xcd_barrier_post((unsigned*)(kargs()->ws + WS_CTL) + CW_BAR, (volatile LAS unsigned*)(lds + MISC_OFF) + 8);
#define SEAM() xcd_barrier(bar)
#else
#define SEAM() do {} while (0)
#endif
#define IN(k) (kargs()->ph_lo <= (k) && (k) < kargs()->ph_hi)
#define BOTH(k) (IN(k) && ((k) + 1) < kargs()->ph_hi)
#define PH_LOCALS KArgs a = kargs(); unsigned char* ws = a->ws; int G = gridDim.x, bid = blockIdx.x; asm volatile("" : "+s"(G), "+s"(bid)); const int tid = tidx(), lane = tid & 63, wave = __builtin_amdgcn_readfirstlane(tid >> 6), gw = bid * NWAVES + wave, NGW = G * NWAVES; (void)ws; (void)lane; (void)gw; (void)NGW;

    if (EN_PRO && IN(PH_PRO)) { _Pragma("unroll 1") for (int rep_ = 0; rep_ < REP_PRO; ++rep_) { if (rep_) SEAM(); PH_LOCALS; ph_prologue(a, lds, wave, lane, gw, NGW, bid * (NWAVES * 64) + tid, G * NWAVES * 64); } if (BOTH(PH_PRO)) SEAM(); }

#pragma unroll 1
    for (int l = 0; l < 2; ++l) {
        if (EN_IN && IN(PH_L(l, K_IN))) {
            _Pragma("unroll 1") for (int rep_ = 0; rep_ < REP_IN; ++rep_) { if (rep_) SEAM(); PH_LOCALS;
            pg8::Gemm g{(const pg8::bf16_t*)(ws + WS_XB), (const pg8::bf16_t*)(ws + WS_WIN) + (size_t)l * NIN_PAD * 1024, M, NIN_PAD, 1024}; pg8::StaticOrder S; S.init(M, NIN_PAD, G, bid);
            pg8::EpiHproj E{(pg8::bf16_t*)(ws + WS_R + R_HP), (float*)(ws + WS_GAB)};
            pg8::gemm_phase<pg8::EpiHproj, pg8::StaticOrder, PG8_ALIGN, PG8_SP2>(lds, g, S, E); }
            if (BOTH(PH_L(l, K_IN))) SEAM();
        }
        if (EN_PREP && IN(PH_L(l, K_PREP))) {
            _Pragma("unroll 1") for (int rep_ = 0; rep_ < REP_PREP; ++rep_) { if (rep_) SEAM(); PH_LOCALS; for (int u = bid; u < 1024; u += G) { if (FAST_PREP) gdn_prep_fast(a, l, u, lds, tid, lane, wave); else gdn_prep_unit(a, l, u, lds, tid, lane, wave); }
              if (FAST_RET) for (int u = bid; u < 512; u += G) ret_kv_unit(a, u, lds, tid, lane, wave); }
            if (BOTH(PH_L(l, K_PREP))) SEAM();
        }
        if (EN_SCAN && IN(PH_L(l, K_SCAN))) {
            _Pragma("unroll 1") for (int rep_ = 0; rep_ < REP_SCAN; ++rep_) { if (rep_) SEAM(); PH_LOCALS;
            if (bid < 32) { const int t1 = tidx(), w1 = __builtin_amdgcn_readfirstlane(t1 >> 6); for (int rg_ = 0; rg_ < REP_GDN; ++rg_) gdn_scan_fast(a, l, bid, lds, t1, t1 & 63, w1); }
            else {
                { const int t1 = tidx(), w1 = __builtin_amdgcn_readfirstlane(t1 >> 6);
                  for (int rr_ = 0; rr_ < REP_RET; ++rr_) for (int u = bid - 32; u < 512; u += G - 32) ret_out_unit(a, u, lds, t1, t1 & 63, w1); }
                __syncthreads();
                { const int t2 = tidx(), w2 = __builtin_amdgcn_readfirstlane(t2 >> 6);
                  moe_convert(kargs(), lds, w2, t2 & 63, (bid - 32) * NWAVES + w2, (G - 32) * NWAVES, 4 * l, 4 * l + 4); }
            } }
            if (BOTH(PH_L(l, K_SCAN))) SEAM();
        }
        if (EN_OUT && IN(PH_L(l, K_OUT))) {
            _Pragma("unroll 1") for (int rep_ = 0; rep_ < REP_OUT; ++rep_) { if (rep_) SEAM(); PH_LOCALS;
            pg8::Gemm g{(const pg8::bf16_t*)(ws + WS_R + R_OB), (const pg8::bf16_t*)(ws + WS_WO) + (size_t)l * 1024 * 1024, M, 1024, 1024}; pg8::StaticOrder S; S.init(M, 1024, G, bid);
            pg8::EpiF32 E{(float*)(ws + WS_R + R_MIX), 1024};
            pg8::gemm_phase<pg8::EpiF32, pg8::StaticOrder, PG8_ALIGN, PG8_SP2>(lds, g, S, E); }
            if (BOTH(PH_L(l, K_OUT))) SEAM();
        }
        if (EN_LN1 && IN(PH_L(l, K_LN1))) {
            { PH_LOCALS;
            if (l == 0) ln_rows<false>(a->in[0], ALPHA, (const float*)(ws + WS_R + R_MIX), a->in[7], a->in[8], a->out, 1.0f, (bf16*)(ws + WS_XB), nullptr, nullptr, nullptr, nullptr, lane, gw, NGW);
            else { ln_rows<true>(a->out, ALPHA, (const float*)(ws + WS_R + R_MIX), a->in[7] + 1024, a->in[8] + 1024, a->out, ALPHA, (bf16*)(ws + WS_XB), a->in[14], (unsigned*)(ws + WS_CTL) + CW_MOE, (int*)(ws + WS_LIST), (float*)(ws + WS_GATE), lane, gw, NGW);
                 } }
            if (BOTH(PH_L(l, K_LN1))) SEAM();
        }
        if (l == 0) {
            if (EN_FFN0 && IN(PH_L(0, K_GU))) {
                _Pragma("unroll 1") for (int rep_ = 0; rep_ < REP_GU; ++rep_) { if (rep_) SEAM(); PH_LOCALS;
                pg8::Gemm g{(const pg8::bf16_t*)(ws + WS_XB), (const pg8::bf16_t*)(ws + WS_WGU), M, 2 * FF, 1024}; pg8::StaticOrder S; S.init(M, 2 * FF, G, bid);
                pg8::EpiSwiglu E{(pg8::bf16_t*)(ws + WS_R + R_H), FF};
                pg8::gemm_phase<pg8::EpiSwiglu, pg8::StaticOrder, PG8_ALIGN, PG8_SP2>(lds, g, S, E); }
                if (BOTH(PH_L(0, K_GU))) SEAM();
            }
            if (EN_FFN0 && IN(PH_L(0, K_DN))) {
                _Pragma("unroll 1") for (int rep_ = 0; rep_ < REP_DN; ++rep_) { if (rep_) SEAM(); PH_LOCALS;
                pg8::Gemm g{(const pg8::bf16_t*)(ws + WS_R + R_H), (const pg8::bf16_t*)(ws + WS_WD), M, 1024, FF}; pg8::StaticOrder S; S.init(M, 1024, G, bid);
                pg8::EpiF32 E{(float*)(ws + WS_R + R_MIX), 1024};
                pg8::gemm_phase<pg8::EpiF32, pg8::StaticOrder, PG8_ALIGN, PG8_SP2>(lds, g, S, E); }
                if (BOTH(PH_L(0, K_DN))) SEAM();
            }
            if (EN_LN1 && IN(PH_L(0, K_LN2))) {
                { PH_LOCALS;
                ln_rows<false>(a->out, ALPHA, (const float*)(ws + WS_R + R_MIX), a->in[9], a->in[10], a->out, 1.0f, (bf16*)(ws + WS_XB), nullptr, nullptr, nullptr, nullptr, lane, gw, NGW); }
                if (BOTH(PH_L(0, K_LN2))) SEAM();
            }
        } else {
#pragma unroll 1
            for (int j = 0; j < 2; ++j) {
                const int kg = K_G0 + 3 * j;
                if (EN_MOE && j == 0 && IN(PH_L(1, kg))) { { PH_LOCALS; moe_gather(a, 0, lane, gw, NGW); moe_gather(a, 1, lane, gw, NGW); } if (BOTH(PH_L(1, kg))) SEAM(); }
                if (EN_MOE && IN(PH_L(1, kg + 1))) {
                    _Pragma("unroll 1") for (int rep_ = 0; rep_ < REP_MGU; ++rep_) { if (rep_) SEAM(); PH_LOCALS;
                    int cnt[8];
#pragma unroll
                    for (int e = 0; e < 8; ++e) cnt[e] = (int)((const unsigned*)(ws + WS_CTL))[CW_MOE + 64 * (j * 8 + e)];
                    pg8::Gemm g{(const pg8::bf16_t*)(ws + WS_R + R_XG + (size_t)j * XG_PASS), (const pg8::bf16_t*)(ws + WS_WMGU), MOE_ROWS, 2 * FE, 1024}; pg8::MoeOrder S; S.init(cnt, 2 * FE / 256, G, bid, (size_t)2 * FE * 1024 * 2);
                    pg8::EpiSwiglu E{(pg8::bf16_t*)(ws + WS_R + R_HM), FE};
                    pg8::gemm_phase<pg8::EpiSwiglu, pg8::MoeOrder, PG8_ALIGN, PG8_SP2>(lds, g, S, E); }
                    if (BOTH(PH_L(1, kg + 1))) SEAM();
                }
                if (EN_MOE && IN(PH_L(1, kg + 2))) {
                    { PH_LOCALS;
                    int cnt[8];
#pragma unroll
                    for (int e = 0; e < 8; ++e) cnt[e] = (int)((const unsigned*)(ws + WS_CTL))[CW_MOE + 64 * (j * 8 + e)];
                    pg8::Gemm g{(const pg8::bf16_t*)(ws + WS_R + R_HM), (const pg8::bf16_t*)(ws + WS_WMD), MOE_ROWS, 1024, FE}; pg8::MoeOrder S; S.init(cnt, 4, G, bid, (size_t)1024 * FE * 2);
                    pg8::EpiMoeDown E; E.XF = a->out; E.list = (const int*)(ws + WS_LIST) + (size_t)j * 8 * 16384; E.gate = (const float*)(ws + WS_GATE) + (size_t)j * 16384;
#pragma unroll
                    for (int e = 0; e < 8; ++e) { E.cnt[e] = cnt[e]; E.cum[e] = S.cum[e]; }
                    pg8::gemm_phase<pg8::EpiMoeDown, pg8::MoeOrder, PG8_ALIGN, PG8_SP2>(lds, g, S, E); }
                    if (BOTH(PH_L(1, kg + 2))) SEAM();
                }
            }
            if (EN_LN1 && IN(PH_L(1, K_LNF))) {
                PH_LOCALS;
                ln_rows<false>(a->out, 1.0f, nullptr, a->in[9] + 1024, a->in[10] + 1024, a->out, 1.0f, nullptr, nullptr, nullptr, nullptr, nullptr, lane, gw, NGW);
            }
        }
    }
#undef IN
#undef BOTH
}

extern "C" void kernel_launch(void* const* d_in, const int* in_sizes, int n_in, void* d_out, int out_size, void* d_ws, size_t ws_size, hipStream_t stream) {
    static int grid = 0;
    if (grid == 0) {
        if (n_in != 18 || in_sizes[0] != M * D || out_size != M * D || ws_size < WS_END) { fprintf(stderr, "kernel_launch: unexpected shapes or workspace (%zu < %zu); nothing launched\n", ws_size, (size_t)WS_END); grid = -1; return; }
        int dev = 0, cus = 0, per_cu = 0;
        if (hipGetDevice(&dev) != hipSuccess || hipDeviceGetAttribute(&cus, hipDeviceAttributeMultiprocessorCount, dev) != hipSuccess) { grid = -1; return; }
        if (hipFuncSetAttribute((const void*)fwd, hipFuncAttributeMaxDynamicSharedMemorySize, LDS_BYTES) != hipSuccess) { fprintf(stderr, "kernel_launch: hipFuncSetAttribute failed\n"); grid = -1; return; }
        if (hipOccupancyMaxActiveBlocksPerMultiprocessor(&per_cu, (const void*)fwd, NWAVES * 64, LDS_BYTES) != hipSuccess || per_cu < 1) fprintf(stderr, "kernel_launch: occupancy query reports %d\n", per_cu);
        (void)hipGetLastError();
        grid = cus;
    }
    if (grid < 0) return;
    if (hipMemsetAsync((char*)d_ws + WS_CTL, 0, CTL_BYTES, stream) != hipSuccess) return;
    Args a{};
    for (int i = 0; i < 18; ++i) a.in[i] = (const float*)d_in[i];
    a.out = (float*)d_out; a.ws = (unsigned char*)d_ws;
#if ONE_LAUNCH
    a.ph_lo = 0; a.ph_hi = PH_END;
    hipLaunchKernelGGL(fwd, dim3(grid), dim3(NWAVES * 64), LDS_BYTES, stream, a);
#else
    static const int phases[] = {PH_PRO,
        PH_L(0, K_IN), PH_L(0, K_PREP), PH_L(0, K_SCAN), PH_L(0, K_OUT), PH_L(0, K_LN1), PH_L(0, K_GU), PH_L(0, K_DN), PH_L(0, K_LN2),
        PH_L(1, K_IN), PH_L(1, K_PREP), PH_L(1, K_SCAN), PH_L(1, K_OUT), PH_L(1, K_LN1),
        PH_L(1, K_G0), PH_L(1, K_GU0), PH_L(1, K_DN0), PH_L(1, K_G1), PH_L(1, K_GU1), PH_L(1, K_DN1), PH_L(1, K_LNF)};
    for (unsigned i = 0; i < sizeof(phases) / sizeof(phases[0]); ++i) {
        a.ph_lo = phases[i]; a.ph_hi = phases[i] + 1;
        hipLaunchKernelGGL(fwd, dim3(grid), dim3(NWAVES * 64), LDS_BYTES, stream, a);
    }
#endif
}
```

```cpp
#include <hip/hip_runtime.h>
#include <cstdio>
#include <cstdint>

#ifndef ONE_LAUNCH
#define ONE_LAUNCH 1
#endif

#define GAS __attribute__((address_space(1)))
#define LAS __attribute__((address_space(3)))
typedef unsigned short bf16;
typedef unsigned v4u __attribute__((ext_vector_type(4)));
typedef unsigned v2u __attribute__((ext_vector_type(2)));
typedef float f32x4 __attribute__((ext_vector_type(4)));
typedef float f32x2 __attribute__((ext_vector_type(2)));
#define RLX_AGENT __ATOMIC_RELAXED, __HIP_MEMORY_SCOPE_AGENT
#define LDS_WAIT() asm volatile("s_waitcnt lgkmcnt(0)" ::: "memory")
#define VM_WAIT() asm volatile("s_waitcnt vmcnt(0)" ::: "memory")

__device__ __forceinline__ unsigned f2bf(float f) { unsigned u = __builtin_bit_cast(unsigned, f); return (u + 0x7fffu + ((u >> 16) & 1u)) >> 16; }
__device__ __forceinline__ unsigned pk2(float lo, float hi) { return f2bf(lo) | (f2bf(hi) << 16); }
__device__ __forceinline__ float bf2f(unsigned short u) { return __builtin_bit_cast(float, (unsigned)u << 16); }
__device__ __forceinline__ float bflo(unsigned u) { return __builtin_bit_cast(float, u << 16); }
__device__ __forceinline__ float bfhi(unsigned u) { return __builtin_bit_cast(float, u & 0xffff0000u); }
__device__ __forceinline__ float siluf(float x) { return x / (1.f + __expf(-x)); }
__device__ __forceinline__ float sigmf(float x) { return 1.f / (1.f + __expf(-x)); }
__device__ __forceinline__ float wave_sum(float v) {
#pragma unroll
    for (int o = 1; o < 64; o <<= 1) v += __shfl_xor(v, o);
    return v;
}

constexpr int NWAVES = 8;
constexpr int M = 16384, D = 1024, SEQ = 2048, NB = 8;
constexpr int IN_COLS = 3592, NIN_PAD = 3840, HP_LD = 3584;
constexpr int FF = 2816, FE = 3584, NE = 8;
constexpr int COL_RQ = 0, COL_RK = 256, COL_RV = 512, COL_RG = 1024, COL_GQ = 1536, COL_GK = 2048, COL_GV = 2560, COL_GG = 3072;
constexpr float ALPHA = 1.41421356237f;
constexpr float LN_EPS = 1e-5f, NORM_EPS = 1e-6f;
constexpr int MOE_ROWS = 72 * 256;

__host__ __device__ __forceinline__ int fragoff(int i, int d, int nkt) {
    return ((((i >> 5) * nkt + (d >> 5)) * 2 + ((d >> 4) & 1)) * 512) + ((((d >> 2) & 1) * 32 + (i & 31)) * 8) + ((((d >> 3) & 1) << 2) | (d & 3));
}
__host__ __device__ __forceinline__ int uoff(int i, int e) {
    const int reg = (i & 3) | (((i & 31) >> 3) << 2);
    return (((((e >> 5) * 2 + (i >> 5)) * 2 + (reg >> 3)) * 64 + (((i >> 2) & 1) * 32 + (e & 31))) * 8) + (reg & 7);
}
namespace pg8 {
#define PG8_LAS __attribute__((address_space(3)))
typedef unsigned short bf16_t;
typedef short bf16x8 __attribute__((ext_vector_type(8)));
typedef float f32x4 __attribute__((ext_vector_type(4)));
typedef unsigned u32x4 __attribute__((ext_vector_type(4)));
constexpr int BM = 256, BK = 64, HALF = 128, HTB = HALF * BK * 2  , STAGE_BYTES = 8 * HTB, NXCD = 8, WGM = 8;

__host__ __device__ __forceinline__ int lds_byte(int r, int c) { const int st = (r >> 4) * 2 + (c >> 5), rr = r & 15, cc = c & 31, ob = rr * 64 + cc * 2; return st * 1024 + (ob ^ (((ob >> 9) & 1) << 5)); }
__host__ __device__ __forceinline__ void stage_rc(int b, int& R, int& C) { const int st = b / 1024, sb = b % 1024, swz = sb ^ (((sb >> 9) & 1) << 5); R = (st >> 1) * 16 + swz / 64; C = (st & 1) * 32 + (swz % 64) / 2; }
__host__ __device__ __forceinline__ int perm32(int rho) { const int n = rho >> 4, i = rho & 15; return 8 * (i >> 2) + 4 * n + (i & 3); }

struct Unit { int pm, pn, aux; };
struct Gemm { const bf16_t* A; const bf16_t* Bt; int M, N, K; };

struct StaticOrder {
    int nM, nN, nwg, G, c;
    __host__ __device__ void init(int M, int N, int G_, int c_) { nM = M / BM; nN = N / BM; nwg = nM * nN; G = G_; c = c_; }
    __host__ __device__ bool next(int i, Unit& u) const {
        const long L = (long)i * G + c; if (L >= nwg) return false;
        int wgid = (int)L; { const int q = nwg / NXCD, r = nwg % NXCD, xcd = wgid % NXCD, off = wgid / NXCD; wgid = (xcd < r ? xcd * (q + 1) : r * (q + 1) + (xcd - r) * q) + off; }
        const int nig = WGM * nN, gid = wgid / nig, fm = gid * WGM, gsz = (nM - fm) < WGM ? (nM - fm) : WGM;
        u.pm = fm + ((wgid % nig) % gsz); u.pn = (wgid % nig) / gsz; u.aux = 0; return true;
    }
    __device__ __forceinline__ const char* aptr(const Gemm& g, const Unit& u) const { return (const char*)g.A + (size_t)u.pm * ((size_t)BM * g.K * 2); }
    __device__ __forceinline__ const char* bptr(const Gemm& g, const Unit& u) const { return (const char*)g.Bt + (size_t)u.pn * ((size_t)BM * g.K * 2); }
    __device__ __forceinline__ void a_ready(const Unit&) const {}
    __device__ __forceinline__ void done(const Unit&) const {}
};

template <class Epi, class Sched, bool ALIGN_EPI = false, bool SP2 = false>
__device__ __forceinline__ void gemm_phase(PG8_LAS unsigned char* lds, const Gemm g, const Sched& S, const Epi& E) {
    int tid = threadIdx.x; asm volatile("" : "+v"(tid)); const int wid = __builtin_amdgcn_readfirstlane(tid >> 6), lane = tid & 63, wr = wid >> 2, wc = wid & 3, fr = lane & 15, fq = lane >> 4;
    const int K = g.K, nt = K / BK;
    unsigned voffA[2], voffB[2];
#pragma unroll
    for (int i = 0; i < 2; ++i) { int R, C; stage_rc(tid * 16 + i * 8192, R, C); const int Rb = Epi::PERM ? ((R & ~31) + perm32(R & 31)) : R;
        voffA[i] = (unsigned)(R * K + C) * 2u; voffB[i] = (unsigned)(Rb * K + C) * 2u; }
    const size_t kstep = (size_t)(BK * 2);
    const size_t hstep = (size_t)HALF * K * 2;
    const size_t tstep = 2 * hstep;
    const unsigned ldsw = (unsigned)wid * 1024u;
    const int aoff = lds_byte(wr * 64 + fr, fq * 8), boff = lds_byte(wc * 32 + fr, fq * 8);
#define PG8_SA(b, h) (((b) * 2 + (h)) * HTB)
#define PG8_SB(b, h) ((4 + (b) * 2 + (h)) * HTB)
#define PG8_STAGE(bufoff, gbase, voff) do { _Pragma("unroll") for (int _i = 0; _i < 2; ++_i) \
        __builtin_amdgcn_global_load_lds((const unsigned*)((const char*)(gbase) + (voff)[_i]), (PG8_LAS unsigned*)(lds + (bufoff) + ldsw + _i * 8192), 16, 0, 0); } while (0)
#define PG8_LDA(dst, b, h) do { _Pragma("unroll") for (int m = 0; m < 4; ++m) _Pragma("unroll") for (int k = 0; k < 2; ++k) dst[m][k] = *(const PG8_LAS bf16x8*)(lds + PG8_SA(b, h) + aoff + m * 2048 + k * 1024); } while (0)
#define PG8_LDB(dst, b, h) do { _Pragma("unroll") for (int n = 0; n < 2; ++n) _Pragma("unroll") for (int k = 0; k < 2; ++k) dst[n][k] = *(const PG8_LAS bf16x8*)(lds + PG8_SB(b, h) + boff + n * 2048 + k * 1024); } while (0)
#define PG8_MMA(ai, bj, At, Bt) do { __builtin_amdgcn_s_setprio(1); _Pragma("unroll") for (int m = 0; m < 4; ++m) _Pragma("unroll") for (int n = 0; n < 2; ++n) _Pragma("unroll") for (int k = 0; k < 2; ++k) \
        acc[ai][bj][m][n] = __builtin_amdgcn_mfma_f32_16x16x32_bf16(Bt[n][k], At[m][k], acc[ai][bj][m][n], 0, 0, 0); __builtin_amdgcn_s_setprio(0); } while (0)
#define PG8_WAIT_V(n) asm volatile("s_waitcnt vmcnt(" #n ")" ::: "memory")
#define PG8_WAIT_L(n) asm volatile("s_waitcnt lgkmcnt(" #n ")" ::: "memory")
#define PG8_BAR __builtin_amdgcn_s_barrier()
#define PG8_SCHED __builtin_amdgcn_sched_barrier(0)
    Unit cur, nxt; int ui = 0;
    if (!S.next(0, cur)) return;
    f32x4 acc[2][2][4][2];
#pragma unroll
    for (int a = 0; a < 2; ++a)
#pragma unroll
        for (int b = 0; b < 2; ++b)
#pragma unroll
            for (int m = 0; m < 4; ++m)
#pragma unroll
                for (int n = 0; n < 2; ++n) acc[a][b][m][n] = (f32x4){0.f, 0.f, 0.f, 0.f};
    bf16x8 At[4][2], B0[2][2], B1[2][2];
    const char* cA = S.aptr(g, cur); const char* cB = S.bptr(g, cur);
    S.a_ready(cur);
    if constexpr (SP2) {
        PG8_STAGE(PG8_SB(0, 0), cB, voffB); PG8_STAGE(PG8_SB(0, 1), cB + hstep, voffB); PG8_STAGE(PG8_SA(0, 0), cA, voffA); PG8_STAGE(PG8_SA(0, 1), cA + hstep, voffA);
        if (wr == 1) PG8_BAR;
        PG8_WAIT_V(2); PG8_BAR;
        PG8_STAGE(PG8_SB(1, 0), cB + kstep, voffB); PG8_STAGE(PG8_SA(1, 0), cA + kstep, voffA); PG8_STAGE(PG8_SB(1, 1), cB + hstep + kstep, voffB);
        PG8_WAIT_V(6); PG8_BAR;
    } else {
        PG8_STAGE(PG8_SB(0, 0), cB, voffB); PG8_STAGE(PG8_SA(0, 0), cA, voffA); PG8_STAGE(PG8_SB(0, 1), cB + hstep, voffB); PG8_STAGE(PG8_SA(0, 1), cA + hstep, voffA);
        if (wr == 1) PG8_BAR;
        PG8_WAIT_V(4); PG8_BAR;
        PG8_STAGE(PG8_SB(1, 0), cB + kstep, voffB); PG8_STAGE(PG8_SA(1, 0), cA + kstep, voffA); PG8_STAGE(PG8_SB(1, 1), cB + hstep + kstep, voffB);
        PG8_WAIT_V(6); PG8_BAR;
    }
    for (;;) {
        const bool has_next = S.next(ui + 1, nxt);
        const char* nA = has_next ? S.aptr(g, nxt) : cA; const char* nB = has_next ? S.bptr(g, nxt) : cB;
        for (int t = 0; t < nt; t += 2) {
            const bool last = (t == nt - 2);
            const char* a1 = cA + (size_t)(t + 1) * kstep;
            const char* a2 = last ? nA : cA + (size_t)(t + 2) * kstep; const char* b2 = last ? nB : cB + (size_t)(t + 2) * kstep;
            const char* a3 = a2 + kstep; const char* b3 = b2 + kstep;
            if (last && has_next) S.a_ready(nxt);
            if constexpr (SP2) {
            PG8_LDB(B0, 0, 0); PG8_LDB(B1, 0, 1); PG8_SCHED; PG8_LDA(At, 0, 0); PG8_STAGE(PG8_SA(1, 1), a1 + hstep, voffA);
            PG8_WAIT_V(8); PG8_WAIT_L(0); PG8_BAR; PG8_MMA(0, 0, At, B0); PG8_MMA(0, 1, At, B1); PG8_BAR; PG8_SCHED;
            PG8_LDA(At, 0, 1); PG8_STAGE(PG8_SB(0, 0), b2, voffB); PG8_STAGE(PG8_SB(0, 1), b2 + hstep, voffB); PG8_STAGE(PG8_SA(0, 0), a2, voffA);
            PG8_WAIT_V(8); PG8_WAIT_L(0); PG8_BAR; PG8_MMA(1, 0, At, B0); PG8_MMA(1, 1, At, B1); PG8_BAR; PG8_SCHED;
            PG8_LDB(B0, 1, 0); PG8_LDB(B1, 1, 1); PG8_SCHED; PG8_LDA(At, 1, 0); PG8_STAGE(PG8_SA(0, 1), a2 + hstep, voffA);
            PG8_WAIT_V(8); PG8_WAIT_L(0); PG8_BAR; PG8_MMA(0, 0, At, B0); PG8_MMA(0, 1, At, B1); PG8_BAR; PG8_SCHED;
            PG8_LDA(At, 1, 1); PG8_STAGE(PG8_SB(1, 0), b3, voffB); PG8_STAGE(PG8_SB(1, 1), b3 + hstep, voffB); PG8_STAGE(PG8_SA(1, 0), a3, voffA);
            PG8_WAIT_V(8); PG8_WAIT_L(0); PG8_BAR; PG8_MMA(1, 0, At, B0); PG8_MMA(1, 1, At, B1); PG8_BAR; PG8_SCHED;
            } else {
            PG8_LDB(B0, 0, 0); PG8_SCHED; PG8_LDA(At, 0, 0); PG8_STAGE(PG8_SA(1, 1), a1 + hstep, voffA);
            PG8_WAIT_L(8); PG8_BAR; PG8_WAIT_L(0); PG8_MMA(0, 0, At, B0); PG8_BAR; PG8_SCHED;
            PG8_LDB(B1, 0, 1); PG8_STAGE(PG8_SB(0, 0), b2, voffB);
            PG8_BAR; PG8_WAIT_L(0); PG8_MMA(0, 1, At, B1); PG8_BAR;
            PG8_LDA(At, 0, 1); PG8_STAGE(PG8_SA(0, 0), a2, voffA);
            PG8_BAR; PG8_WAIT_L(0); PG8_MMA(1, 0, At, B0); PG8_BAR; PG8_SCHED;
            PG8_STAGE(PG8_SB(0, 1), b2 + hstep, voffB);
            PG8_WAIT_V(6); PG8_BAR; PG8_MMA(1, 1, At, B1); PG8_BAR;
            PG8_LDB(B0, 1, 0); PG8_SCHED; PG8_LDA(At, 1, 0); PG8_STAGE(PG8_SA(0, 1), a2 + hstep, voffA);
            PG8_WAIT_L(8); PG8_BAR; PG8_WAIT_L(0); PG8_MMA(0, 0, At, B0); PG8_BAR; PG8_SCHED;
            PG8_LDB(B1, 1, 1); PG8_STAGE(PG8_SB(1, 0), b3, voffB);
            PG8_BAR; PG8_WAIT_L(0); PG8_MMA(0, 1, At, B1); PG8_BAR;
            PG8_LDA(At, 1, 1); PG8_STAGE(PG8_SA(1, 0), a3, voffA);
            PG8_BAR; PG8_WAIT_L(0); PG8_MMA(1, 0, At, B0); PG8_BAR; PG8_SCHED;
            PG8_STAGE(PG8_SB(1, 1), b3 + hstep, voffB);
            PG8_WAIT_V(6); PG8_BAR; PG8_MMA(1, 1, At, B1); PG8_BAR;
            }
        }
        if constexpr (ALIGN_EPI) { if (wr == 0) PG8_BAR; }
        if constexpr (!Epi::AFTER_DRAIN) { E(acc, cur, wr, wc, fr, fq); S.done(cur); }
        if (!has_next) break;
#pragma unroll
        for (int a = 0; a < 2; ++a)
#pragma unroll
            for (int b = 0; b < 2; ++b)
#pragma unroll
                for (int m = 0; m < 4; ++m)
#pragma unroll
                    for (int n = 0; n < 2; ++n) acc[a][b][m][n] = (f32x4){0.f, 0.f, 0.f, 0.f};
        cur = nxt; cA = nA; cB = nB; ++ui;
        if constexpr (ALIGN_EPI) { if (wr == 1) PG8_BAR; }
    }
    PG8_WAIT_V(0);
    if constexpr (!ALIGN_EPI) { if (wr == 0) PG8_BAR; }
    PG8_BAR;
    if constexpr (Epi::AFTER_DRAIN) { E.fused(acc, cur, wr, wc, fr, fq, lds, wid, lane); S.done(cur); }
#undef PG8_SA
#undef PG8_SB
#undef PG8_STAGE
#undef PG8_LDA
#undef PG8_LDB
#undef PG8_MMA
#undef PG8_WAIT_V
#undef PG8_WAIT_L
#undef PG8_BAR
#undef PG8_SCHED
}
}

namespace pg8 {
__device__ __forceinline__ unsigned cvt_pk_bf16(float lo, float hi) { unsigned r; asm volatile("v_cvt_pk_bf16_f32 %0, %1, %2" : "=v"(r) : "v"(lo), "v"(hi)); return r; }

struct EpiHproj {
    static constexpr bool PERM = true, AFTER_DRAIN = false;
    bf16_t* HP; float* GAB;
    __device__ __forceinline__ void operator()(const f32x4 (&acc)[2][2][4][2], const Unit& u, int wr, int wc, int fr, int fq) const {
        const int row0 = u.pm * BM + wr * 64 + fr;
        if (u.pn < 14) {
            const int col0 = u.pn * BM + wc * 32 + 8 * fq;
#pragma unroll
            for (int ai = 0; ai < 2; ++ai)
#pragma unroll
                for (int m = 0; m < 4; ++m) { bf16_t* rowp = HP + (size_t)(row0 + ai * HALF + m * 16) * 3584 + col0;
#pragma unroll
                    for (int bj = 0; bj < 2; ++bj) { const f32x4 v0 = acc[ai][bj][m][0], v1 = acc[ai][bj][m][1];
                        u32x4 w; w.x = cvt_pk_bf16(v0[0], v0[1]); w.y = cvt_pk_bf16(v0[2], v0[3]); w.z = cvt_pk_bf16(v1[0], v1[1]); w.w = cvt_pk_bf16(v1[2], v1[3]);
                        *(u32x4*)(rowp + bj * HALF) = w; } }
        } else if (wc == 0 && fq == 0) {
#pragma unroll
            for (int ai = 0; ai < 2; ++ai)
#pragma unroll
                for (int m = 0; m < 4; ++m) { float* rowp = GAB + (size_t)(row0 + ai * HALF + m * 16) * 8;
                    *(f32x4*)(rowp) = acc[ai][0][m][0]; *(f32x4*)(rowp + 4) = acc[ai][0][m][1]; }
        }
    }
};
struct EpiBf16Out {
    static constexpr bool PERM = true, AFTER_DRAIN = false;
    bf16_t* O; int ldc;
    __device__ __forceinline__ void operator()(const f32x4 (&acc)[2][2][4][2], const Unit& u, int wr, int wc, int fr, int fq) const {
        const int row0 = u.pm * BM + wr * 64 + fr, col0 = u.pn * BM + wc * 32 + 8 * fq;
#pragma unroll
        for (int ai = 0; ai < 2; ++ai)
#pragma unroll
            for (int m = 0; m < 4; ++m) { bf16_t* rowp = O + (size_t)(row0 + ai * HALF + m * 16) * ldc + col0;
#pragma unroll
                for (int bj = 0; bj < 2; ++bj) { const f32x4 v0 = acc[ai][bj][m][0], v1 = acc[ai][bj][m][1];
                    u32x4 w; w.x = cvt_pk_bf16(v0[0], v0[1]); w.y = cvt_pk_bf16(v0[2], v0[3]); w.z = cvt_pk_bf16(v1[0], v1[1]); w.w = cvt_pk_bf16(v1[2], v1[3]);
                    *(u32x4*)(rowp + bj * HALF) = w; } }
    }
};
struct EpiF32 {
    static constexpr bool PERM = false, AFTER_DRAIN = false;
    float* O; int ldc;
    __device__ __forceinline__ void operator()(const f32x4 (&acc)[2][2][4][2], const Unit& u, int wr, int wc, int fr, int fq) const {
        const int row0 = u.pm * BM + wr * 64 + fr, col0 = u.pn * BM + wc * 32 + 4 * fq;
#pragma unroll
        for (int ai = 0; ai < 2; ++ai)
#pragma unroll
            for (int m = 0; m < 4; ++m) { float* rowp = O + (size_t)(row0 + ai * HALF + m * 16) * ldc + col0;
#pragma unroll
                for (int bj = 0; bj < 2; ++bj)
#pragma unroll
                    for (int n = 0; n < 2; ++n) *(f32x4*)(rowp + bj * HALF + n * 16) = acc[ai][bj][m][n]; }
    }
};
struct EpiSwiglu {
    static constexpr bool PERM = true, AFTER_DRAIN = false;
    bf16_t* H; int ldh;
    __device__ __forceinline__ void operator()(const f32x4 (&acc)[2][2][4][2], const Unit& u, int wr, int wc, int fr, int fq) const {
        const int row0 = u.pm * BM + wr * 64 + fr, col0 = u.pn * HALF + wc * 32 + 8 * fq;
#pragma unroll
        for (int ai = 0; ai < 2; ++ai)
#pragma unroll
            for (int m = 0; m < 4; ++m) { bf16_t* rowp = H + (size_t)(row0 + ai * HALF + m * 16) * ldh + col0;
                float h[8];
#pragma unroll
                for (int n = 0; n < 2; ++n)
#pragma unroll
                    for (int i = 0; i < 4; ++i) { const float gt = acc[ai][0][m][n][i], up = acc[ai][1][m][n][i]; h[n * 4 + i] = gt * up * __builtin_amdgcn_rcpf(1.f + __expf(-gt)); }
                u32x4 w; w.x = cvt_pk_bf16(h[0], h[1]); w.y = cvt_pk_bf16(h[2], h[3]); w.z = cvt_pk_bf16(h[4], h[5]); w.w = cvt_pk_bf16(h[6], h[7]);
                *(u32x4*)(rowp) = w; }
    }
};
struct EpiMoeDown {
    static constexpr bool PERM = false, AFTER_DRAIN = false;
    float* XF; const int* list; const float* gate; int cnt[8], cum[8];
    __device__ __forceinline__ void operator()(const f32x4 (&acc)[2][2][4][2], const Unit& u, int wr, int wc, int fr, int fq) const {
        int e = u.aux, c_e = 0, t_e = 0;
#pragma unroll
        for (int k = 0; k < 8; ++k) { if (k == e) { c_e = cnt[k]; t_e = cum[k]; } }
        const int s0 = (u.pm - t_e) * BM + wr * 64 + fr, col0 = u.pn * BM + wc * 32 + 4 * fq;
        const int* lp = list + e * 16384;
        int tok[8]; float gt[8];
#pragma unroll
        for (int q = 0; q < 8; ++q) { const int s = s0 + (q >> 2) * HALF + (q & 3) * 16; tok[q] = (s < c_e) ? lp[s] : -1; }
#pragma unroll
        for (int q = 0; q < 8; ++q) gt[q] = (tok[q] >= 0) ? gate[tok[q]] : 0.f;
#pragma unroll
        for (int ai = 0; ai < 2; ++ai) {
            f32x4 o[4][2][2];
#pragma unroll
            for (int m = 0; m < 4; ++m) { const float* rowp = XF + (size_t)(tok[ai * 4 + m] >= 0 ? tok[ai * 4 + m] : 0) * 1024 + col0;
#pragma unroll
                for (int bj = 0; bj < 2; ++bj)
#pragma unroll
                    for (int n = 0; n < 2; ++n) o[m][bj][n] = *(const f32x4*)(rowp + bj * HALF + n * 16); }
#pragma unroll
            for (int m = 0; m < 4; ++m) { if (tok[ai * 4 + m] >= 0) { float* rowp = XF + (size_t)tok[ai * 4 + m] * 1024 + col0; const float g1 = gt[ai * 4 + m];
#pragma unroll
                for (int bj = 0; bj < 2; ++bj)
#pragma unroll
                    for (int n = 0; n < 2; ++n) *(f32x4*)(rowp + bj * HALF + n * 16) = o[m][bj][n] + acc[ai][bj][m][n] * g1; } }
        }
    }
};
struct MoeOrder {
    int T, nN, nwg, G, c; int cum[8]; size_t bstride;
    __device__ void init(const int* cnt, int nN_, int G_, int c_, size_t bstride_) {
        int t = 0;
#pragma unroll
        for (int e = 0; e < 8; ++e) { cum[e] = t; t += (cnt[e] + 255) >> 8; }
        T = t; nN = nN_; nwg = T * nN; G = G_; c = c_; bstride = bstride_;
    }
    __device__ bool next(int i, Unit& u) const {
        const long L = (long)i * G + c; if (L >= nwg) return false;
        int wgid = (int)L; { const int q = nwg / NXCD, r = nwg % NXCD, xcd = wgid % NXCD, off = wgid / NXCD; wgid = (xcd < r ? xcd * (q + 1) : r * (q + 1) + (xcd - r) * q) + off; }
        const int nig = WGM * nN, gid = wgid / nig, fm = gid * WGM, gsz = (T - fm) < WGM ? (T - fm) : WGM;
        u.pm = fm + ((wgid % nig) % gsz); u.pn = (wgid % nig) / gsz;
        int e = 0;
#pragma unroll
        for (int k = 1; k < 8; ++k) e += (u.pm >= cum[k]) ? 1 : 0;
        u.aux = e; return true;
    }
    __device__ __forceinline__ const char* aptr(const Gemm& g, const Unit& u) const { return (const char*)g.A + (size_t)u.pm * ((size_t)BM * g.K * 2); }
    __device__ __forceinline__ const char* bptr(const Gemm& g, const Unit& u) const { return (const char*)g.Bt + (size_t)u.aux * bstride + (size_t)u.pn * ((size_t)BM * g.K * 2); }
    __device__ __forceinline__ void a_ready(const Unit&) const {}
    __device__ __forceinline__ void done(const Unit&) const {}
};
}
#ifndef PG8_SP2
#define PG8_SP2 true
#endif
#ifndef PG8_ALIGN
#define PG8_ALIGN true
#endif

constexpr size_t MiB = 1u << 20;
constexpr size_t WS_CTL = 0, CTL_BYTES = 256 * 1024;
constexpr size_t WS_ROPE = 256 * 1024;
constexpr size_t WS_WIN = 1 * MiB;
constexpr size_t WS_WO = 16 * MiB;
constexpr size_t WS_WGU = 20 * MiB;
constexpr size_t WS_WD = 31 * MiB;
constexpr size_t WS_XB = 37 * MiB;
constexpr size_t WS_GAB = 69 * MiB;
constexpr size_t WS_LIST = WS_GAB + 512 * 1024;
constexpr size_t WS_GATE = WS_LIST + 1 * MiB;
constexpr size_t WS_CD = WS_GATE + 128 * 1024;
constexpr size_t WS_WMGU = 71 * MiB, WS_WMD = 183 * MiB;
constexpr size_t WS_R = 239 * MiB;
constexpr size_t R_HP = 0, R_OB = 112 * MiB, R_U = 144 * MiB, R_WN = 160 * MiB, R_QD = 176 * MiB, R_KDT = 192 * MiB, R_QK = 208 * MiB;
constexpr size_t WS_KV = WS_XB;
constexpr size_t R_MIX = 0, R_H = 64 * MiB;
constexpr size_t R_HM = 0, R_XG = 126 * MiB, XG_PASS = 36 * MiB;
constexpr size_t WS_END = WS_R + 216 * MiB;
constexpr int CW_TMO = 0, CW_BAR = 4096, CW_MOE = 16384;

constexpr int RING_BYTES = 131072, LDS_BYTES = 147456, LDSCTL_OFF = LDS_BYTES - 512, MISC_OFF = LDSCTL_OFF + 320;

constexpr int PH_PRO = 0;
constexpr int PH_L(int l, int k) { return 1 + 16 * l + k; }
constexpr int K_IN = 0, K_PREP = 1, K_SCAN = 2, K_OUT = 3, K_LN1 = 4, K_GU = 5, K_DN = 6, K_LN2 = 7;
constexpr int K_G0 = 5, K_GU0 = 6, K_DN0 = 7, K_G1 = 8, K_GU1 = 9, K_DN1 = 10, K_LNF = 11;
constexpr int PH_END = PH_L(1, K_LNF) + 1;

struct Args { const float* in[18]; float* out; unsigned char* ws; int ph_lo, ph_hi; };
typedef const __attribute__((address_space(4))) Args* KArgs;
__device__ __forceinline__ KArgs kargs() { KArgs p = (KArgs)__builtin_amdgcn_kernarg_segment_ptr(); asm volatile("" : "+s"(p)); return p; }
__device__ __forceinline__ int tidx() { int t = threadIdx.x; asm volatile("" : "+v"(t)); return t; }

constexpr int TR_SCR = 64 * 65 * 4;
__device__ __forceinline__ void tr_item(const float* W, int N, int k0, int n0, bf16* WT, size_t ldk, int dst_row0, LAS float* scr, int lane) {
    const int nq = 4 * (lane & 15), n = n0 + nq, kr = lane >> 4;
    f32x4 v[16];
#pragma unroll
    for (int i = 0; i < 16; ++i) v[i] = (n < N) ? *(const f32x4*)(W + (size_t)(k0 + 4 * i + kr) * N + n) : (f32x4){0.f, 0.f, 0.f, 0.f};
#pragma unroll
    for (int i = 0; i < 16; ++i) { LAS float* d = scr + (4 * i + kr) * 65 + nq; d[0] = v[i].x; d[1] = v[i].y; d[2] = v[i].z; d[3] = v[i].w; }
    LDS_WAIT(); asm volatile("" ::: "memory");
    const int c = lane & 7;
#pragma unroll
    for (int j = 0; j < 8; ++j) { const int nn = (lane >> 3) + 8 * j; const LAS float* s = scr + (8 * c) * 65 + nn;
        v4u o; o.x = pk2(s[0 * 65], s[1 * 65]); o.y = pk2(s[2 * 65], s[3 * 65]); o.z = pk2(s[4 * 65], s[5 * 65]); o.w = pk2(s[6 * 65], s[7 * 65]);
        *(v4u*)(WT + (size_t)(dst_row0 + nn) * ldk + k0 + 8 * c) = o; }
    LDS_WAIT(); asm volatile("" ::: "memory");
}

__device__ __forceinline__ void ph_prologue(KArgs a, LAS unsigned char* lds, int wave, int lane, int gw, int NGW, int gtid, int NT) {
    unsigned char* ws = a->ws;
    LAS float* scr = (LAS float*)(lds + wave * TR_SCR);
    constexpr int I_IN = 16 * 57, I_O = 16 * 16, I_L = I_IN + I_O, I_G = 16 * 44, I_D = 44 * 16, NIT = 2 * I_L + 2 * I_G + I_D;
    for (int it = gw; it < NIT; it += NGW) {
        int r = it;
        if (r < 2 * I_L) { const int l = r / I_L; r -= l * I_L;
            if (r < I_IN) { const int kb = r / 57, nb = r % 57; tr_item(a->in[1] + (size_t)l * 1024 * IN_COLS, IN_COLS, 64 * kb, 64 * nb, (bf16*)(ws + WS_WIN) + (size_t)l * NIN_PAD * 1024, 1024, 64 * nb, scr, lane); }
            else { r -= I_IN; const int kb = r / 16, nb = r % 16; tr_item(a->in[6] + (size_t)l * 1024 * 1024, 1024, 64 * kb, 64 * nb, (bf16*)(ws + WS_WO) + (size_t)l * 1024 * 1024, 1024, 64 * nb, scr, lane); }
            continue; }
        r -= 2 * I_L;
        if (r < 2 * I_G) { const int up = r / I_G; r -= up * I_G; const int kb = r / 44, nb = r % 44, n0 = 64 * nb;
            tr_item(up ? a->in[12] : a->in[11], FF, 64 * kb, n0, (bf16*)(ws + WS_WGU), 1024, 256 * (n0 >> 7) + (n0 & 127) + 128 * up, scr, lane); continue; }
        r -= 2 * I_G;
        { const int kb = r / 16, nb = r % 16; tr_item(a->in[13], 1024, 64 * kb, 64 * nb, (bf16*)(ws + WS_WD), FF, 64 * nb, scr, lane); }
    }
    for (int i = gtid; i < 2 * 192 * 128; i += NT) { const int l = i / (192 * 128), r = i % (192 * 128);
        ((v4u*)((bf16*)(ws + WS_WIN) + (size_t)l * NIN_PAD * 1024 + (size_t)3648 * 1024))[r] = (v4u){0u, 0u, 0u, 0u}; }
    for (int i = gtid; i < M * D / 8; i += NT) { const f32x4 p = ((const f32x4*)a->in[0])[2 * i], q = ((const f32x4*)a->in[0])[2 * i + 1];
        v4u o; o.x = pk2(p.x, p.y); o.y = pk2(p.z, p.w); o.z = pk2(q.x, q.y); o.w = pk2(q.z, q.w); ((v4u*)(ws + WS_XB))[i] = o; }
    for (int i = gtid; i < SEQ * 32; i += NT) { const int pos = i >> 5, k = i & 31;
        const float inv = powf(10000.0f, -(float)(2 * k) / 64.0f); const float ang = (float)pos * inv;
        double rev = (double)ang * 0.15915494309189535; rev -= floor(rev); const float rf = (float)rev;
        float* R = (float*)(ws + WS_ROPE) + (size_t)pos * 64; R[k] = __builtin_amdgcn_cosf(rf); R[32 + k] = __builtin_amdgcn_sinf(rf); }
}

__device__ __forceinline__ void moe_convert(KArgs a, LAS unsigned char* lds, int wave, int lane, int gw, int NGW, int e_lo, int e_hi) {
    unsigned char* ws = a->ws;
    LAS float* scr = (LAS float*)(lds + wave * TR_SCR);
    constexpr int I_G = 16 * 56, I_D = 56 * 16, I_E = 2 * I_G + I_D;
    for (int it = e_lo * I_E + gw; it < e_hi * I_E; it += NGW) {
        const int e = it / I_E; int r = it - e * I_E;
        if (r < 2 * I_G) { const int up = r / I_G; r -= up * I_G; const int kb = r / 56, nb = r % 56, n0 = 64 * nb;
            tr_item((up ? a->in[16] : a->in[15]) + (size_t)e * 1024 * FE, FE, 64 * kb, n0, (bf16*)(ws + WS_WMGU) + (size_t)e * 7168 * 1024, 1024, 256 * (n0 >> 7) + (n0 & 127) + 128 * up, scr, lane); }
        else { r -= 2 * I_G; const int kb = r / 16, nb = r % 16; tr_item(a->in[17] + (size_t)e * FE * 1024, 1024, 64 * kb, 64 * nb, (bf16*)(ws + WS_WMD) + (size_t)e * 1024 * FE, FE, 64 * nb, scr, lane); }
    }
}

template <bool ROUTE>
__device__ __forceinline__ void ln_rows(const float* res, float ares, const bf16* mix, const float* g, const float* bta, float* xf, float oscale, bf16* xb,
                                        const float* router, unsigned* cntw, int* list, float* gate, int lane, int gw, int NGW) {
    f32x4 gv[4], bv[4];
#pragma unroll
    for (int j = 0; j < 4; ++j) { gv[j] = ((const f32x4*)g)[lane + 64 * j]; bv[j] = ((const f32x4*)bta)[lane + 64 * j]; }
    for (int row = gw; row < M; row += NGW) {
        const f32x4* rr = (const f32x4*)(res + (size_t)row * D) + lane;
        f32x4 v[4]; float s = 0.f;
#pragma unroll
        for (int j = 0; j < 4; ++j) { v[j] = rr[64 * j] * ares; }
        if (mix) { const v2u* mr = (const v2u*)(mix + (size_t)row * D) + lane;
#pragma unroll
            for (int j = 0; j < 4; ++j) { const v2u m2 = mr[64 * j]; v[j] = v[j] + (f32x4){bflo(m2.x), bfhi(m2.x), bflo(m2.y), bfhi(m2.y)}; } }
#pragma unroll
        for (int j = 0; j < 4; ++j) s += (v[j].x + v[j].y) + (v[j].z + v[j].w);
        const float mean = wave_sum(s) * (1.f / D); float s2 = 0.f;
#pragma unroll
        for (int j = 0; j < 4; ++j) { v[j] = v[j] - mean; s2 += (v[j].x * v[j].x + v[j].y * v[j].y) + (v[j].z * v[j].z + v[j].w * v[j].w); }
        const float rstd = 1.f / sqrtf(wave_sum(s2) * (1.f / D) + LN_EPS);
#pragma unroll
        for (int j = 0; j < 4; ++j) v[j] = v[j] * rstd * gv[j] + bv[j];
        f32x4* xo = (f32x4*)(xf + (size_t)row * D) + lane;
#pragma unroll
        for (int j = 0; j < 4; ++j) xo[64 * j] = v[j] * oscale;
        if (xb) { v2u* bo = (v2u*)(xb + (size_t)row * D) + lane;
#pragma unroll
            for (int j = 0; j < 4; ++j) { v2u o; o.x = pk2(v[j].x, v[j].y); o.y = pk2(v[j].z, v[j].w); bo[64 * j] = o; } }
        if (ROUTE) {
            float lg[8];
#pragma unroll
            for (int e = 0; e < 8; ++e) lg[e] = 0.f;
#pragma unroll
            for (int j = 0; j < 4; ++j)
#pragma unroll
                for (int i = 0; i < 4; ++i) { const int c = 4 * lane + 256 * j + i; const f32x4 r0 = *(const f32x4*)(router + c * 8), r1 = *(const f32x4*)(router + c * 8 + 4); const float y = v[j][i];
                    lg[0] += y * r0.x; lg[1] += y * r0.y; lg[2] += y * r0.z; lg[3] += y * r0.w; lg[4] += y * r1.x; lg[5] += y * r1.y; lg[6] += y * r1.z; lg[7] += y * r1.w; }
#pragma unroll
            for (int e = 0; e < 8; ++e) lg[e] = wave_sum(lg[e]);
            if (lane == 0) {
                int e0 = 0; float v0 = lg[0];
#pragma unroll
                for (int e = 1; e < 8; ++e) if (lg[e] > v0) { v0 = lg[e]; e0 = e; }
                int e1 = -1; float v1 = -3.0e38f;
#pragma unroll
                for (int e = 0; e < 8; ++e) if (e != e0 && lg[e] > v1) { v1 = lg[e]; e1 = e; }
                const float p1 = __expf(v1 - v0), g0 = 1.f / (1.f + p1), g1 = p1 / (1.f + p1);
                const unsigned s0 = __hip_atomic_fetch_add(cntw + 64 * e0, 1u, RLX_AGENT), s1 = __hip_atomic_fetch_add(cntw + 64 * (8 + e1), 1u, RLX_AGENT);
                list[(size_t)e0 * 16384 + s0] = row; list[(size_t)(8 + e1) * 16384 + s1] = row; gate[row] = g0; gate[16384 + row] = g1;
            }
        }
    }
}

__device__ __forceinline__ void moe_gather(KArgs a, int j, int lane, int gw, int NGW) {
    unsigned char* ws = a->ws; const unsigned* cntw = (const unsigned*)(ws + WS_CTL) + CW_MOE + 64 * (j * 8);
    int pre[8], cum[8]; { int p = 0, t = 0;
#pragma unroll
        for (int e = 0; e < 8; ++e) { const int c = (int)cntw[64 * e]; pre[e] = p; cum[e] = t; p += c; t += (c + 255) >> 8; } }
    const int* list = (const int*)(ws + WS_LIST) + (size_t)j * 8 * 16384;
    for (int r0 = gw; r0 < M; r0 += 8 * NGW) {
        int tok[8], drow[8];
#pragma unroll
        for (int q = 0; q < 8; ++q) { const int r = r0 + q * NGW; tok[q] = -1; drow[q] = 0;
            if (r < M) { int e = 0;
#pragma unroll
                for (int k = 1; k < 8; ++k) e += (r >= pre[k]) ? 1 : 0;
                int pe = 0, ce = 0;
#pragma unroll
                for (int k = 0; k < 8; ++k) if (k == e) { pe = pre[k]; ce = cum[k]; }
                const int s = r - pe; tok[q] = list[(size_t)e * 16384 + s]; drow[q] = ce * 256 + s; } }
        v4u x0[8], x1[8];
#pragma unroll
        for (int q = 0; q < 8; ++q) { const v4u* src = (const v4u*)((const bf16*)(ws + WS_XB) + (size_t)(tok[q] >= 0 ? tok[q] : 0) * 1024); x0[q] = src[lane]; x1[q] = src[lane + 64]; }
#pragma unroll
        for (int q = 0; q < 8; ++q) if (tok[q] >= 0) { v4u* dst = (v4u*)((bf16*)(ws + WS_R + R_XG + (size_t)j * XG_PASS) + (size_t)drow[q] * 1024); dst[lane] = x0[q]; dst[lane + 64] = x1[q]; }
    }
}

__device__ __forceinline__ void gdn_prep_unit(KArgs a, int l, int unit, LAS unsigned char* lds, int tid, int lane, int wave) {
    unsigned char* ws = a->ws;
    const int n = unit & 31, bh = unit >> 5, h = bh & 3, b = bh >> 2;
    const int t0 = b * SEQ + n * 64;
    LAS float* Q = (LAS float*)lds; LAS float* K = Q + 8192; LAS float* V = K + 8192; LAS float* A = V + 8192; LAS float* gc = A + 4096; LAS float* bt = gc + 64;
    const bf16* HP = (const bf16*)(ws + WS_R + R_HP);
    const float* cw = a->in[2] + (size_t)l * 4 * 1536;
    __syncthreads();
    for (int idx = tid; idx < 64 * 384; idx += 512) { const int i = idx / 384, c = idx % 384, which = c >> 7, d = c & 127;
        const int col = COL_GQ + which * 512 + h * 128 + d, cc = which * 512 + h * 128 + d; float acc = 0.f;
#pragma unroll
        for (int j = 0; j < 4; ++j) { const int s = n * 64 + i - 3 + j; if (s >= 0) acc += cw[j * 1536 + cc] * bf2f(HP[(size_t)(b * SEQ + s) * HP_LD + col]); }
        const float y = siluf(acc); LAS float* dst = which == 0 ? Q : (which == 1 ? K : V); dst[i * 128 + d] = y; }
    if (tid < 64) { const float* gab = (const float*)(ws + WS_GAB) + (size_t)(t0 + tid) * 8; const float x = gab[h] + a->in[4][l * 4 + h];
        const float sp = fmaxf(x, 0.f) + log1pf(__expf(-fabsf(x))); gc[tid] = -__expf(a->in[3][l * 4 + h]) * sp; bt[tid] = sigmf(gab[4 + h]); }
    __syncthreads();
#pragma unroll 1
    for (int r = 0; r < 8; ++r) { const int i = wave * 8 + r;
        float q0 = Q[i * 128 + lane], q1 = Q[i * 128 + lane + 64], k0 = K[i * 128 + lane], k1 = K[i * 128 + lane + 64];
        const float sq = wave_sum(q0 * q0 + q1 * q1), sk = wave_sum(k0 * k0 + k1 * k1);
        const float fq = rsqrtf(sq + NORM_EPS) * 0.08838834764831845f, fk = rsqrtf(sk + NORM_EPS);
        Q[i * 128 + lane] = q0 * fq; Q[i * 128 + lane + 64] = q1 * fq; K[i * 128 + lane] = k0 * fk; K[i * 128 + lane + 64] = k1 * fk; }
    if (tid == 0) { float c = 0.f; for (int i = 0; i < 64; ++i) { c += gc[i]; gc[i] = c; } }
    __syncthreads();
    bf16* QKg = (bf16*)(ws + WS_R + R_QK) + (size_t)unit * 4096; bf16* QDg = (bf16*)(ws + WS_R + R_QD) + (size_t)unit * 8192; bf16* KDTg = (bf16*)(ws + WS_R + R_KDT) + (size_t)unit * 8192;
    bf16* WNg = (bf16*)(ws + WS_R + R_WN) + (size_t)unit * 8192; bf16* Ug = (bf16*)(ws + WS_R + R_U) + (size_t)unit * 8192;
    for (int idx = tid; idx < 4096; idx += 512) { const int i = idx >> 6, j = idx & 63; float dqk = 0.f, dkk = 0.f;
        for (int dd = 0; dd < 128; ++dd) { const int d = (dd + j) & 127; const float kj = K[j * 128 + d]; dqk += Q[i * 128 + d] * kj; dkk += K[i * 128 + d] * kj; }
        const float dec = __expf(gc[i] - gc[j]);
        A[i * 64 + j] = (j < i) ? bt[i] * dkk * dec : 0.f;
        QKg[fragoff(i, j, 2)] = (bf16)f2bf((j <= i) ? dqk * dec : 0.f); }
    const float gl = gc[63];
    for (int idx = tid; idx < 8192; idx += 512) { const int i = idx >> 7, d = idx & 127;
        QDg[fragoff(i, d, 4)] = (bf16)f2bf(Q[i * 128 + d] * __expf(gc[i]));
        KDTg[fragoff(d, i, 2)] = (bf16)f2bf(K[i * 128 + d] * __expf(gl - gc[i])); }
    if (tid == 0) ((float*)(ws + WS_CD))[unit] = __expf(gl);
    __syncthreads();
    for (int idx = tid; idx < 8192; idx += 512) { const int i = idx >> 7; const float bi = bt[i]; V[idx] *= bi; Q[idx] = bi * __expf(gc[i]) * K[idx]; }
    __syncthreads();
    if (tid < 256) { LAS float* buf = (tid < 128 ? V : Q) + (tid & 127);
        for (int i = 1; i < 64; ++i) { float acc = buf[i * 128]; for (int m = 0; m < i; ++m) acc -= A[i * 64 + m] * buf[m * 128]; buf[i * 128] = acc; } }
    __syncthreads();
    for (int idx = tid; idx < 8192; idx += 512) { const int i = idx >> 7, d = idx & 127; Ug[uoff(i, d)] = (bf16)f2bf(V[idx]); WNg[fragoff(i, d, 4)] = (bf16)f2bf(-Q[idx]); }
}

__device__ __forceinline__ void gdn_scan_naive(KArgs a, int l, int bh, LAS unsigned char* lds, int tid, int lane, int wave) {
    unsigned char* ws = a->ws;
    LAS float* S = (LAS float*)lds; LAS float* VN = S + 16384; LAS float* O = VN + 8192;
    const int h = bh & 3, b = bh >> 2, e = tid & 127, ig = tid >> 7;
    const bf16* HP = (const bf16*)(ws + WS_R + R_HP); bf16* OB = (bf16*)(ws + WS_R + R_OB);
    const float* nw = a->in[5] + l * 128;
    __syncthreads();
    for (int idx = tid; idx < 16384; idx += 512) S[idx] = 0.f;
    __syncthreads();
#pragma unroll 1
    for (int n = 0; n < 32; ++n) {
        const int unit = bh * 32 + n;
        const bf16* Ug = (const bf16*)(ws + WS_R + R_U) + (size_t)unit * 8192; const bf16* WNg = (const bf16*)(ws + WS_R + R_WN) + (size_t)unit * 8192;
        const bf16* QDg = (const bf16*)(ws + WS_R + R_QD) + (size_t)unit * 8192; const bf16* KDTg = (const bf16*)(ws + WS_R + R_KDT) + (size_t)unit * 8192;
        const bf16* QKg = (const bf16*)(ws + WS_R + R_QK) + (size_t)unit * 4096; const float cd = ((const float*)(ws + WS_CD))[unit];
#pragma unroll 1
        for (int r = 0; r < 16; ++r) { const int i = ig + 4 * r; float acc = bf2f(Ug[uoff(i, e)]);
#pragma unroll 2
            for (int d0 = 0; d0 < 128; d0 += 4) { const v2u w = *(const v2u*)(WNg + fragoff(i, d0, 4));
                acc += bflo(w.x) * S[d0 * 128 + e] + bfhi(w.x) * S[(d0 + 1) * 128 + e] + bflo(w.y) * S[(d0 + 2) * 128 + e] + bfhi(w.y) * S[(d0 + 3) * 128 + e]; }
            VN[i * 128 + e] = acc; }
        __syncthreads();
#pragma unroll 1
        for (int r = 0; r < 16; ++r) { const int i = ig + 4 * r; float acc = 0.f;
#pragma unroll 2
            for (int d0 = 0; d0 < 128; d0 += 4) { const v2u w = *(const v2u*)(QDg + fragoff(i, d0, 4));
                acc += bflo(w.x) * S[d0 * 128 + e] + bfhi(w.x) * S[(d0 + 1) * 128 + e] + bflo(w.y) * S[(d0 + 2) * 128 + e] + bfhi(w.y) * S[(d0 + 3) * 128 + e]; }
#pragma unroll 2
            for (int j0 = 0; j0 < 64; j0 += 4) { const v2u w = *(const v2u*)(QKg + fragoff(i, j0, 2));
                acc += bflo(w.x) * VN[j0 * 128 + e] + bfhi(w.x) * VN[(j0 + 1) * 128 + e] + bflo(w.y) * VN[(j0 + 2) * 128 + e] + bfhi(w.y) * VN[(j0 + 3) * 128 + e]; }
            O[i * 128 + e] = acc; }
        __syncthreads();
#pragma unroll 1
        for (int r = 0; r < 32; ++r) { const int d = ig + 4 * r; float acc = S[d * 128 + e] * cd;
#pragma unroll 2
            for (int i0 = 0; i0 < 64; i0 += 4) { const v2u w = *(const v2u*)(KDTg + fragoff(d, i0, 2));
                acc += bflo(w.x) * VN[i0 * 128 + e] + bfhi(w.x) * VN[(i0 + 1) * 128 + e] + bflo(w.y) * VN[(i0 + 2) * 128 + e] + bfhi(w.y) * VN[(i0 + 3) * 128 + e]; }
            S[d * 128 + e] = acc; }
#pragma unroll 1
        for (int r = 0; r < 8; ++r) { const int i = wave * 8 + r; const float v0 = O[i * 128 + lane], v1 = O[i * 128 + lane + 64];
            const float rs = rsqrtf(wave_sum(v0 * v0 + v1 * v1) * (1.f / 128.f) + NORM_EPS);
            const size_t t = (size_t)b * SEQ + n * 64 + i; const bf16* gp = HP + t * HP_LD + COL_GG + h * 128; bf16* op = OB + t * 1024 + 512 + h * 128;
            op[lane] = (bf16)f2bf(v0 * rs * nw[lane] * siluf(bf2f(gp[lane]))); op[lane + 64] = (bf16)f2bf(v1 * rs * nw[lane + 64] * siluf(bf2f(gp[lane + 64]))); }
        __syncthreads();
    }
}

__device__ __forceinline__ void ret_unit_naive(KArgs a, int unit, LAS unsigned char* lds, int tid, int lane, int wave) {
    unsigned char* ws = a->ws;
    LAS float* Qs = (LAS float*)lds; LAS float* Ks = Qs + 64 * 65; LAS float* Vs = Ks + 64 * 65; LAS float* Sc = Vs + 8192;
    const int qb = unit & 31, bh = unit >> 5, h = bh & 3, b = bh >> 2, e = tid & 127, ig = tid >> 7;
    const bf16* HP = (const bf16*)(ws + WS_R + R_HP); bf16* OB = (bf16*)(ws + WS_R + R_OB); const float* RT = (const float*)(ws + WS_ROPE);
    const float log2g = log2f(1.0f - exp2f(-5.0f - (float)h));
    __syncthreads();
    for (int idx = tid; idx < 4096; idx += 512) { const int i = idx >> 6, d = idx & 63, dd = d & 31, pos = qb * 64 + i; const size_t t = (size_t)b * SEQ + pos;
        const float c = RT[pos * 64 + dd], s = RT[pos * 64 + 32 + dd]; const float x1 = bf2f(HP[t * HP_LD + COL_RQ + h * 64 + dd]), x2 = bf2f(HP[t * HP_LD + COL_RQ + h * 64 + dd + 32]);
        Qs[i * 65 + d] = d < 32 ? x1 * c - x2 * s : x1 * s + x2 * c; }
    float acc[16];
#pragma unroll
    for (int r = 0; r < 16; ++r) acc[r] = 0.f;
#pragma unroll 1
    for (int kb = 0; kb <= qb; ++kb) {
        __syncthreads();
        for (int idx = tid; idx < 4096; idx += 512) { const int i = idx >> 6, d = idx & 63, dd = d & 31, pos = kb * 64 + i; const size_t t = (size_t)b * SEQ + pos;
            const float c = RT[pos * 64 + dd], s = RT[pos * 64 + 32 + dd]; const float x1 = bf2f(HP[t * HP_LD + COL_RK + h * 64 + dd]), x2 = bf2f(HP[t * HP_LD + COL_RK + h * 64 + dd + 32]);
            Ks[i * 65 + d] = 0.125f * (d < 32 ? x1 * c - x2 * s : x1 * s + x2 * c); }
        for (int idx = tid; idx < 8192; idx += 512) { const int i = idx >> 7, d = idx & 127; Vs[idx] = bf2f(HP[((size_t)b * SEQ + kb * 64 + i) * HP_LD + COL_RV + h * 128 + d]); }
        __syncthreads();
        { const int j = tid & 63, ig8 = tid >> 6;
#pragma unroll 1
          for (int r = 0; r < 8; ++r) { const int i = ig8 + 8 * r; float dot = 0.f;
#pragma unroll 8
              for (int d = 0; d < 64; ++d) dot += Qs[i * 65 + d] * Ks[j * 65 + d];
              const int delta = (qb - kb) * 64 + i - j; Sc[i * 65 + j] = delta >= 0 ? dot * exp2f((float)delta * log2g) : 0.f; } }
        __syncthreads();
#pragma unroll 2
        for (int j = 0; j < 64; ++j) { const float vv = Vs[j * 128 + e];
#pragma unroll
            for (int r = 0; r < 16; ++r) acc[r] += Sc[(ig + 4 * r) * 65 + j] * vv; }
    }
    __syncthreads();
#pragma unroll
    for (int r = 0; r < 16; ++r) Vs[(ig + 4 * r) * 128 + e] = acc[r];
    __syncthreads();
#pragma unroll 1
    for (int r = 0; r < 8; ++r) { const int i = wave * 8 + r; const float v0 = Vs[i * 128 + lane], v1 = Vs[i * 128 + lane + 64];
        const float mean = wave_sum(v0 + v1) * (1.f / 128.f), d0 = v0 - mean, d1 = v1 - mean; const float rs = rsqrtf(wave_sum(d0 * d0 + d1 * d1) * (1.f / 128.f) + LN_EPS);
        const size_t t = (size_t)b * SEQ + qb * 64 + i; const bf16* gp = HP + t * HP_LD + COL_RG + h * 128; bf16* op = OB + t * 1024 + h * 128;
        op[lane] = (bf16)f2bf(d0 * rs * siluf(bf2f(gp[lane]))); op[lane + 64] = (bf16)f2bf(d1 * rs * siluf(bf2f(gp[lane + 64]))); }
}

typedef float f32x16 __attribute__((ext_vector_type(16)));
typedef float f32x8 __attribute__((ext_vector_type(8)));
typedef __bf16 bf8v __attribute__((ext_vector_type(8)));
typedef short bf16x8 __attribute__((ext_vector_type(8)));
#define MFMA32(a, b, c) __builtin_amdgcn_mfma_f32_32x32x16_bf16((a), (b), (c), 0, 0, 0)
__device__ __forceinline__ bf16x8 pack8(const f32x16& x, int s) {
    f32x8 v;
#pragma unroll
    for (int j = 0; j < 8; ++j) v[j] = x[8 * s + j];
    return __builtin_bit_cast(bf16x8, __builtin_convertvector(v, bf8v));
}

__device__ __forceinline__ unsigned short bfc(float x) { return __builtin_bit_cast(unsigned short, (__bf16)x); }
__device__ __forceinline__ unsigned bfc2(float lo, float hi) { return (unsigned)bfc(lo) | ((unsigned)bfc(hi) << 16); }

#define GDN_BAR() do { asm volatile("s_waitcnt lgkmcnt(0)" ::: "memory"); __builtin_amdgcn_s_barrier(); asm volatile("" ::: "memory"); } while (0)
__device__ __forceinline__ void gdn_scan_fast(KArgs a, int l, int bh, LAS unsigned char* lds, int tid, int lane, int wave) {
    unsigned char* ws = a->ws;
    constexpr int FB_WN = 0, FB_QD = 16384, FB_KDT = 32768, FB_QK = 49152, FB_U = 57344, FB_BYTES = 73728;
    LAS float* OL = (LAS float*)(lds + FB_BYTES);
    constexpr int OLS = 64 * 132;
    const int h = bh & 3, b = bh >> 2, c = lane & 31, hh = lane >> 5;
    const bf16* HP = (const bf16*)(ws + WS_R + R_HP); bf16* OB = (bf16*)(ws + WS_R + R_OB);
    const float* nw = a->in[5] + l * 128;
    const unsigned char* gWN = (const unsigned char*)(ws + WS_R + R_WN) + (size_t)bh * 32 * 16384; const unsigned char* gQD = (const unsigned char*)(ws + WS_R + R_QD) + (size_t)bh * 32 * 16384;
    const unsigned char* gKDT = (const unsigned char*)(ws + WS_R + R_KDT) + (size_t)bh * 32 * 16384; const unsigned char* gQK = (const unsigned char*)(ws + WS_R + R_QK) + (size_t)bh * 32 * 8192;
    const unsigned char* gU = (const unsigned char*)(ws + WS_R + R_U) + (size_t)bh * 32 * 16384;
    const int et = tid - 256;
#define GDN_FETCH(pf, nn) do { _Pragma("unroll") for (int k = 0; k < 18; ++k) { const unsigned char* src_ = k < 4 ? gWN + (size_t)(nn) * 16384 + k * 4096 : k < 8 ? gQD + (size_t)(nn) * 16384 + (k - 4) * 4096 : \
        k < 12 ? gKDT + (size_t)(nn) * 16384 + (k - 8) * 4096 : k < 14 ? gQK + (size_t)(nn) * 8192 + (k - 12) * 4096 : gU + (size_t)(nn) * 16384 + (k - 14) * 4096; pf[k] = *(const v4u*)(src_ + et * 16); } } while (0)
#define GDN_STORE(pf) do { _Pragma("unroll") for (int k = 0; k < 18; ++k) *(LAS v4u*)(lds + k * 4096 + et * 16) = pf[k]; } while (0)
    __syncthreads();
    if (wave < 4) {
        f32x16 S[4];
#pragma unroll
        for (int t = 0; t < 4; ++t)
#pragma unroll
            for (int i = 0; i < 16; ++i) S[t][i] = 0.f;
        GDN_BAR();
        const int q = wave;
        const LAS bf16x8* WNf = (const LAS bf16x8*)(lds + FB_WN) + lane; const LAS bf16x8* QDf = (const LAS bf16x8*)(lds + FB_QD) + lane;
        const LAS bf16x8* KDTf = (const LAS bf16x8*)(lds + FB_KDT) + lane; const LAS bf16x8* QKf = (const LAS bf16x8*)(lds + FB_QK) + lane;
        const LAS v4u* Uf = (const LAS v4u*)(lds + FB_U) + (q * 2) * 128 + lane;
#pragma unroll 1
        for (int n = 0; n < 32; ++n) {
            const float cd = ((const float*)(ws + WS_CD))[bh * 32 + n];
            bf16x8 A0[8], A1[8];
#define GDN_LD_MTS(A, F, g) do { _Pragma("unroll") for (int k = 0; k < 8; ++k) { const int m_ = k & 1, s_ = (k >> 1) & 1, t_ = 2 * (g) + (k >> 2); A[k] = F[((m_ * 4 + t_) * 2 + s_) * 64]; } } while (0)
#define GDN_LD_TMS(A, F, g) do { _Pragma("unroll") for (int k = 0; k < 8; ++k) { const int s_ = k & 1, m_ = (k >> 1) & 1, t_ = 2 * (g) + (k >> 2); A[k] = F[((t_ * 2 + m_) * 2 + s_) * 64]; } } while (0)
            GDN_LD_MTS(A0, WNf, 0); GDN_LD_MTS(A1, WNf, 1);
            f32x16 av[2];
#pragma unroll
            for (int m = 0; m < 2; ++m)
#pragma unroll
                for (int hf = 0; hf < 2; ++hf) { const v4u u4 = Uf[(m * 2 + hf) * 64];
#pragma unroll
                    for (int k = 0; k < 4; ++k) { av[m][8 * hf + 2 * k] = bflo(u4[k]); av[m][8 * hf + 2 * k + 1] = bfhi(u4[k]); } }
            bf16x8 Sb[4][2];
#pragma unroll
            for (int t = 0; t < 4; ++t) { Sb[t][0] = pack8(S[t], 0); Sb[t][1] = pack8(S[t], 1); }
#pragma unroll
            for (int k = 0; k < 8; ++k) { const int m_ = k & 1, s_ = (k >> 1) & 1, t_ = (k >> 2); av[m_] = MFMA32(A0[k], Sb[t_][s_], av[m_]); }
            GDN_LD_MTS(A0, QDf, 0);
#pragma unroll
            for (int k = 0; k < 8; ++k) { const int m_ = k & 1, s_ = (k >> 1) & 1, t_ = 2 + (k >> 2); av[m_] = MFMA32(A1[k], Sb[t_][s_], av[m_]); }
            GDN_LD_MTS(A1, QDf, 1);
            f32x16 ao[2];
#pragma unroll
            for (int m = 0; m < 2; ++m)
#pragma unroll
                for (int i = 0; i < 16; ++i) ao[m][i] = 0.f;
#pragma unroll
            for (int k = 0; k < 8; ++k) { const int m_ = k & 1, s_ = (k >> 1) & 1, t_ = (k >> 2); ao[m_] = MFMA32(A0[k], Sb[t_][s_], ao[m_]); }
#pragma unroll
            for (int k = 0; k < 6; ++k) { const int s_ = k & 1, m_ = k >= 2 ? 1 : 0, mp_ = k >= 4 ? 1 : 0; A0[k] = QKf[((m_ * 2 + mp_) * 2 + s_) * 64]; }
#pragma unroll
            for (int k = 0; k < 8; ++k) { const int m_ = k & 1, s_ = (k >> 1) & 1, t_ = 2 + (k >> 2); ao[m_] = MFMA32(A1[k], Sb[t_][s_], ao[m_]); }
            GDN_LD_TMS(A1, KDTf, 0);
            bf16x8 Vb[2][2];
#pragma unroll
            for (int m = 0; m < 2; ++m) { Vb[m][0] = pack8(av[m], 0); Vb[m][1] = pack8(av[m], 1); }
#pragma unroll
            for (int k = 0; k < 6; ++k) { const int s_ = k & 1, m_ = k >= 2 ? 1 : 0, mp_ = k >= 4 ? 1 : 0; ao[m_] = MFMA32(A0[k], Vb[mp_][s_], ao[m_]); }
            GDN_LD_TMS(A0, KDTf, 1);
            {   LAS float* Ob = OL + (n & 1) * OLS + 32 * wave + c;
#pragma unroll
                for (int m = 0; m < 2; ++m)
#pragma unroll
                    for (int i = 0; i < 16; ++i) Ob[(32 * m + (i & 3) + 8 * (i >> 2) + 4 * hh) * 132] = ao[m][i]; }
#pragma unroll
            for (int t = 0; t < 4; ++t)
#pragma unroll
                for (int i = 0; i < 16; ++i) S[t][i] *= cd;
#pragma unroll
            for (int k = 0; k < 8; ++k) { const int s_ = k & 1, m_ = (k >> 1) & 1, t_ = (k >> 2); S[t_] = MFMA32(A1[k], Vb[m_][s_], S[t_]); }
#pragma unroll
            for (int k = 0; k < 8; ++k) { const int s_ = k & 1, m_ = (k >> 1) & 1, t_ = 2 + (k >> 2); S[t_] = MFMA32(A0[k], Vb[m_][s_], S[t_]); }
#undef GDN_LD_MTS
#undef GDN_LD_TMS
            GDN_BAR();
            GDN_BAR();
        }
        GDN_BAR(); GDN_BAR();
    } else {
        v4u pfA[18], pfB[18];
        LAS float* NWl = OL + 2 * OLS;
        if (et < 128) NWl[et] = nw[et];
        GDN_FETCH(pfB, 0); GDN_FETCH(pfA, 1); GDN_STORE(pfB);
        GDN_BAR();
        const int i = et >> 2, qd = et & 3;
#define GDN_LOADER_ITER(n, PF_FETCH, PF_STORE) do { \
            if ((n) + 2 < 32) GDN_FETCH(PF_FETCH, (n) + 2); \
            if ((n) > 0) { \
                const LAS float* Ob = OL + (((n) - 1) & 1) * OLS + i * 132 + 32 * qd; \
                float ss = 0.f; \
                _Pragma("unroll") for (int k = 0; k < 8; ++k) { const f32x4 v_ = *(const LAS f32x4*)(Ob + 4 * k); ss += (v_.x * v_.x + v_.y * v_.y) + (v_.z * v_.z + v_.w * v_.w); } \
                ss += __shfl_xor(ss, 1); ss += __shfl_xor(ss, 2); \
                const float rs = rsqrtf(ss * (1.f / 128.f) + NORM_EPS); \
                bf16* op = OB + ((size_t)b * SEQ + ((n) - 1) * 64 + i) * 1024 + 512 + h * 128 + 32 * qd; \
                _Pragma("unroll") for (int k = 0; k < 4; ++k) { const f32x4 w0 = *(const LAS f32x4*)(NWl + 32 * qd + 8 * k), w1 = *(const LAS f32x4*)(NWl + 32 * qd + 8 * k + 4); const v4u gg = gq[k]; \
                    const f32x4 a0 = *(const LAS f32x4*)(Ob + 8 * k), a1 = *(const LAS f32x4*)(Ob + 8 * k + 4); \
                    v4u o; o.x = bfc2(a0.x * rs * w0.x * siluf(bflo(gg.x)), a0.y * rs * w0.y * siluf(bfhi(gg.x))); o.y = bfc2(a0.z * rs * w0.z * siluf(bflo(gg.y)), a0.w * rs * w0.w * siluf(bfhi(gg.y))); \
                    o.z = bfc2(a1.x * rs * w1.x * siluf(bflo(gg.z)), a1.y * rs * w1.y * siluf(bfhi(gg.z))); o.w = bfc2(a1.z * rs * w1.z * siluf(bflo(gg.w)), a1.w * rs * w1.w * siluf(bfhi(gg.w))); \
                    *(v4u*)(op + 8 * k) = o; } \
            } \
            asm volatile("" ::: "memory"); \
            if ((n) < 32) { const bf16* gp = HP + ((size_t)b * SEQ + (n) * 64 + i) * HP_LD + COL_GG + h * 128 + 32 * qd;     \
                _Pragma("unroll") for (int k = 0; k < 4; ++k) gq[k] = *(const v4u*)(gp + 8 * k); } \
            GDN_BAR();            \
            if ((n) + 1 < 32) GDN_STORE(PF_STORE); \
            GDN_BAR();            \
        } while (0)
        v4u gq[4];
#pragma unroll
        for (int k = 0; k < 4; ++k) gq[k] = (v4u){0u, 0u, 0u, 0u};
#pragma unroll
        for (int n = 0; n < 32; n += 2) {
            GDN_LOADER_ITER(n, pfB, pfA);
            GDN_LOADER_ITER(n + 1, pfA, pfB);
        }
        GDN_LOADER_ITER(32, pfB, pfA);
#undef GDN_LOADER_ITER
    }
#undef GDN_FETCH
#undef GDN_STORE
}

struct RetLds {
    static constexpr int QS = 72, JS = 136;
    static constexpr int P = 0, Q1 = 34816, K1 = 53248, OL = 0, K1T = 71680, VT = 89088, ST = 123904;
};
template <bool WANT_Q, bool WANT_K1, bool WANT_K1T>
__device__ __forceinline__ void ret_stage(const bf16* HP, const float* RT, int b, int h, int n, float lg, LAS unsigned char* lds, int tid) {
    constexpr int QS = RetLds::QS, JS = RetLds::JS;
    LAS bf16* Q1 = (LAS bf16*)(lds + RetLds::Q1); LAS bf16* K1 = (LAS bf16*)(lds + RetLds::K1); LAS bf16* K1T = (LAS bf16*)(lds + RetLds::K1T); LAS bf16* VT = (LAS bf16*)(lds + RetLds::VT);
    const int i = tid >> 2, dd = (tid & 3) * 8, pos = n * 128 + i; const size_t t = (size_t)b * SEQ + pos;
    const bf16* hp = HP + t * HP_LD;
    const f32x4 c0 = *(const f32x4*)(RT + pos * 64 + dd), c1 = *(const f32x4*)(RT + pos * 64 + dd + 4), s0 = *(const f32x4*)(RT + pos * 64 + 32 + dd), s1 = *(const f32x4*)(RT + pos * 64 + 32 + dd + 4);
    const float cs[8] = {c0.x, c0.y, c0.z, c0.w, c1.x, c1.y, c1.z, c1.w}, sn[8] = {s0.x, s0.y, s0.z, s0.w, s1.x, s1.y, s1.z, s1.w};
    const float sq = exp2f((float)i * lg), sk = 0.125f * exp2f(-(float)i * lg);
    v4u xv[4];
#pragma unroll
    for (int p = 0; p < 4; ++p) { const int idx = tid + 512 * p, j = idx >> 4, e0 = (idx & 15) * 8; xv[p] = *(const v4u*)(HP + ((size_t)b * SEQ + n * 128 + j) * HP_LD + COL_RV + h * 128 + e0); }
#pragma unroll
    for (int which = (WANT_Q ? 0 : 1); which < 2; ++which) {
        const bf16* src = hp + (which == 0 ? COL_RQ : COL_RK) + h * 64 + dd;
        const v4u x1 = *(const v4u*)src, x2 = *(const v4u*)(src + 32);
        const float sc = which == 0 ? sq : sk;
        float lo[8], hi[8];
#pragma unroll
        for (int k = 0; k < 4; ++k) { const float a0 = bflo(x1[k]), a1 = bfhi(x1[k]), b0 = bflo(x2[k]), b1 = bfhi(x2[k]);
            lo[2 * k] = (a0 * cs[2 * k] - b0 * sn[2 * k]) * sc; lo[2 * k + 1] = (a1 * cs[2 * k + 1] - b1 * sn[2 * k + 1]) * sc;
            hi[2 * k] = (a0 * sn[2 * k] + b0 * cs[2 * k]) * sc; hi[2 * k + 1] = (a1 * sn[2 * k + 1] + b1 * cs[2 * k + 1]) * sc; }
        v4u wl, wh;
#pragma unroll
        for (int k = 0; k < 4; ++k) { wl[k] = bfc2(lo[2 * k], lo[2 * k + 1]); wh[k] = bfc2(hi[2 * k], hi[2 * k + 1]); }
        if (which == 0 || WANT_K1) { LAS bf16* dst = (which == 0 ? Q1 : K1) + i * QS + dd; *(LAS v4u*)dst = wl; *(LAS v4u*)(dst + 32) = wh; }
        if (which == 1 && WANT_K1T) {
#pragma unroll
            for (int k = 0; k < 4; ++k) { K1T[(dd + 2 * k) * JS + i] = (bf16)(wl[k] & 0xffffu); K1T[(dd + 2 * k + 1) * JS + i] = (bf16)(wl[k] >> 16);
                K1T[(32 + dd + 2 * k) * JS + i] = (bf16)(wh[k] & 0xffffu); K1T[(32 + dd + 2 * k + 1) * JS + i] = (bf16)(wh[k] >> 16); }
        }
    }
#pragma unroll
    for (int p = 0; p < 4; ++p) { const int idx = tid + 512 * p, j = idx >> 4, e0 = (idx & 15) * 8;
#pragma unroll
        for (int k = 0; k < 4; ++k) { VT[(e0 + 2 * k) * JS + j] = (bf16)(xv[p][k] & 0xffffu); VT[(e0 + 2 * k + 1) * JS + j] = (bf16)(xv[p][k] >> 16); } }
}
__device__ __forceinline__ void ret_kv_unit(KArgs a, int unit, LAS unsigned char* lds, int tid, int lane, int wave) {
    unsigned char* ws = a->ws;
    constexpr int JS = RetLds::JS;
    const int n = unit & 15, bh = unit >> 4, h = bh & 3, b = bh >> 2, c = lane & 31, hh = lane >> 5;
    const bf16* HP = (const bf16*)(ws + WS_R + R_HP); const float* RT = (const float*)(ws + WS_ROPE);
    const float gam = 1.0f - exp2f(-5.0f - (float)h), lg = log2f(gam), g127 = exp2f(127.f * lg);
    LAS bf16* K1T = (LAS bf16*)(lds + RetLds::K1T); LAS bf16* VT = (LAS bf16*)(lds + RetLds::VT);
    __syncthreads();
    ret_stage<false, false, true>(HP, RT, b, h, n, lg, lds, tid);
    __syncthreads();
    const int td = wave >> 2, te = wave & 3;
    f32x16 kv;
#pragma unroll
    for (int i = 0; i < 16; ++i) kv[i] = 0.f;
#pragma unroll
    for (int ks = 0; ks < 8; ++ks) kv = MFMA32(*(const LAS bf16x8*)(K1T + (32 * td + c) * JS + 16 * ks + 8 * hh), *(const LAS bf16x8*)(VT + (32 * te + c) * JS + 16 * ks + 8 * hh), kv);
    float* dst = (float*)(ws + WS_KV) + ((size_t)(unit * 8 + wave) * 64 + lane) * 16;
#pragma unroll
    for (int g = 0; g < 4; ++g) *(f32x4*)(dst + 4 * g) = (f32x4){kv[4 * g] * g127, kv[4 * g + 1] * g127, kv[4 * g + 2] * g127, kv[4 * g + 3] * g127};
}
__device__ __forceinline__ void ret_out_unit(KArgs a, int unit, LAS unsigned char* lds, int tid, int lane, int wave) {
    unsigned char* ws = a->ws;
    constexpr int QS = RetLds::QS, JS = RetLds::JS;
    LAS bf16* P = (LAS bf16*)(lds + RetLds::P); LAS bf16* Q1 = (LAS bf16*)(lds + RetLds::Q1); LAS bf16* K1 = (LAS bf16*)(lds + RetLds::K1); LAS float* OL = (LAS float*)(lds + RetLds::OL);
    LAS bf16* VT = (LAS bf16*)(lds + RetLds::VT); LAS bf16* ST = (LAS bf16*)(lds + RetLds::ST);
    const int n = unit & 15, bh = unit >> 4, h = bh & 3, b = bh >> 2, c = lane & 31, hh = lane >> 5;
    const bf16* HP = (const bf16*)(ws + WS_R + R_HP); bf16* OB = (bf16*)(ws + WS_R + R_OB); const float* RT = (const float*)(ws + WS_ROPE);
    const float gam = 1.0f - exp2f(-5.0f - (float)h), lg = log2f(gam), g128 = exp2f(128.f * lg);
    __syncthreads();
    const int ei = tid >> 2, eq = tid & 3; const size_t et = (size_t)b * SEQ + n * 128 + ei;
    v4u gg[4];
    { const bf16* gp = HP + et * HP_LD + COL_RG + h * 128 + 32 * eq;
#pragma unroll
      for (int k = 0; k < 4; ++k) gg[k] = *(const v4u*)(gp + 8 * k); }
    {
        const int td = wave >> 2, te = wave & 3;
        f32x16 S;
#pragma unroll
        for (int i = 0; i < 16; ++i) S[i] = 0.f;
        const float* src = (const float*)(ws + WS_KV) + ((size_t)((bh * 16) * 8 + wave) * 64 + lane) * 16;
#pragma unroll 2
        for (int m = 0; m < n; ++m) { const f32x4* p4 = (const f32x4*)(src + (size_t)m * 8 * 64 * 16);
#pragma unroll
            for (int g = 0; g < 4; ++g) { const f32x4 v = p4[g]; S[4 * g] = S[4 * g] * g128 + v.x; S[4 * g + 1] = S[4 * g + 1] * g128 + v.y; S[4 * g + 2] = S[4 * g + 2] * g128 + v.z; S[4 * g + 3] = S[4 * g + 3] * g128 + v.w; } }
#pragma unroll
        for (int g = 0; g < 4; ++g) { v2u w; w.x = bfc2(S[4 * g], S[4 * g + 1]); w.y = bfc2(S[4 * g + 2], S[4 * g + 3]); *(LAS v2u*)(ST + (32 * te + c) * QS + 32 * td + 8 * g + 4 * hh) = w; }
    }
    ret_stage<true, true, false>(HP, RT, b, h, n, lg, lds, tid);
    __syncthreads();
#pragma unroll 1
    for (int rep = 0; rep < 2; ++rep) { const int idx = wave + 8 * rep;
        if (idx < 10) { const int ti = (idx >= 1) + (idx >= 3) + (idx >= 6), tj = idx - ti * (ti + 1) / 2;
            f32x16 acc;
#pragma unroll
            for (int i = 0; i < 16; ++i) acc[i] = 0.f;
#pragma unroll
            for (int s2 = 0; s2 < 4; ++s2) acc = MFMA32(*(const LAS bf16x8*)(Q1 + (32 * ti + c) * QS + 16 * s2 + 8 * hh), *(const LAS bf16x8*)(K1 + (32 * tj + c) * QS + 16 * s2 + 8 * hh), acc);
#pragma unroll
            for (int i = 0; i < 16; ++i) { const int il = (i & 3) + 8 * (i >> 2) + 4 * hh; float v = acc[i]; if (ti == tj && il < c) v = 0.f; P[(32 * ti + il) * JS + 32 * tj + c] = bfc(v); } } }
    __syncthreads();
    const int ti = wave >> 1, te0 = 2 * (wave & 1);
    f32x16 ao[2];
#pragma unroll
    for (int u = 0; u < 2; ++u)
#pragma unroll
        for (int i = 0; i < 16; ++i) ao[u][i] = 0.f;
#pragma unroll
    for (int s2 = 0; s2 < 4; ++s2) { const bf16x8 A = *(const LAS bf16x8*)(Q1 + (32 * ti + c) * QS + 16 * s2 + 8 * hh);
#pragma unroll
        for (int u = 0; u < 2; ++u) ao[u] = MFMA32(A, *(const LAS bf16x8*)(ST + (32 * (te0 + u) + c) * QS + 16 * s2 + 8 * hh), ao[u]); }
#pragma unroll
    for (int u = 0; u < 2; ++u)
#pragma unroll
        for (int i = 0; i < 16; ++i) ao[u][i] *= gam;
#pragma unroll 1
    for (int tj = 0; tj <= ti; ++tj)
#pragma unroll
        for (int s2 = 0; s2 < 2; ++s2) { const bf16x8 A = *(const LAS bf16x8*)(P + (32 * ti + c) * JS + 32 * tj + 16 * s2 + 8 * hh);
#pragma unroll
            for (int u = 0; u < 2; ++u) ao[u] = MFMA32(A, *(const LAS bf16x8*)(VT + (32 * (te0 + u) + c) * JS + 32 * tj + 16 * s2 + 8 * hh), ao[u]); }
    __syncthreads();
#pragma unroll
    for (int u = 0; u < 2; ++u)
#pragma unroll
        for (int i = 0; i < 16; ++i) OL[(32 * ti + (i & 3) + 8 * (i >> 2) + 4 * hh) * 132 + 32 * (te0 + u) + c] = ao[u][i];
    __syncthreads();
    {
        const LAS float* Ob = OL + ei * 132 + 32 * eq; bf16* op = OB + et * 1024 + h * 128 + 32 * eq;
        f32x4 v[8]; float sm = 0.f;
#pragma unroll
        for (int k = 0; k < 8; ++k) { v[k] = *(const LAS f32x4*)(Ob + 4 * k); sm += (v[k].x + v[k].y) + (v[k].z + v[k].w); }
        sm += __shfl_xor(sm, 1); sm += __shfl_xor(sm, 2);
        const float mean = sm * (1.f / 128.f); float sq = 0.f;
#pragma unroll
        for (int k = 0; k < 8; ++k) { v[k] = v[k] - mean; sq += (v[k].x * v[k].x + v[k].y * v[k].y) + (v[k].z * v[k].z + v[k].w * v[k].w); }
        sq += __shfl_xor(sq, 1); sq += __shfl_xor(sq, 2);
        const float rs = rsqrtf(sq * (1.f / 128.f) + LN_EPS);
#pragma unroll
        for (int k = 0; k < 4; ++k) { const v4u g4 = gg[k]; const f32x4 a0 = v[2 * k], a1 = v[2 * k + 1];
            v4u o; o.x = bfc2(a0.x * rs * siluf(bflo(g4.x)), a0.y * rs * siluf(bfhi(g4.x))); o.y = bfc2(a0.z * rs * siluf(bflo(g4.y)), a0.w * rs * siluf(bfhi(g4.y)));
            o.z = bfc2(a1.x * rs * siluf(bflo(g4.z)), a1.y * rs * siluf(bfhi(g4.z))); o.w = bfc2(a1.z * rs * siluf(bflo(g4.w)), a1.w * rs * siluf(bfhi(g4.w)));
            *(v4u*)(op + 8 * k) = o; }
    }
}

__device__ __forceinline__ void gdn_prep_fast(KArgs a, int l, int unit, LAS unsigned char* lds, int tid, int lane, int wave) {
    unsigned char* ws = a->ws;
    constexpr int KS = 136;
    LAS bf16* Kb = (LAS bf16*)lds;
    LAS bf16* Qb = (LAS bf16*)(lds + 17408);
    LAS float* A = (LAS float*)(lds + 34816);
    LAS float* V = (LAS float*)(lds + 51200);
    LAS float* KW = (LAS float*)(lds + 83968);
    LAS float* gc = (LAS float*)(lds + 116736);
    LAS float* bt = gc + 64;
    LAS bf16* KDs = (LAS bf16*)(lds + 117248);
    const int n = unit & 31, bh = unit >> 5, h = bh & 3, b = bh >> 2, t0 = b * SEQ + n * 64, c = lane & 31, hh = lane >> 5;
    const bf16* HP = (const bf16*)(ws + WS_R + R_HP);
    bf16* QKg = (bf16*)(ws + WS_R + R_QK) + (size_t)unit * 4096; bf16* QDg = (bf16*)(ws + WS_R + R_QD) + (size_t)unit * 8192; bf16* KDTg = (bf16*)(ws + WS_R + R_KDT) + (size_t)unit * 8192;
    bf16* WNg = (bf16*)(ws + WS_R + R_WN) + (size_t)unit * 8192; bf16* Ug = (bf16*)(ws + WS_R + R_U) + (size_t)unit * 8192;
    __syncthreads();
    if (wave == 0) {
        const float* gab = (const float*)(ws + WS_GAB) + (size_t)(t0 + lane) * 8; const float x = gab[h] + a->in[4][l * 4 + h];
        const float sp = fmaxf(x, 0.f) + log1pf(__expf(-fabsf(x))); float g = -__expf(a->in[3][l * 4 + h]) * sp;
#pragma unroll
        for (int o = 1; o < 64; o <<= 1) { const float up = __shfl_up(g, o); if (lane >= o) g += up; }
        gc[lane] = g; bt[lane] = sigmf(gab[4 + h]);
        if (lane == 63) ((float*)(ws + WS_CD))[unit] = __expf(g);
    }
    __syncthreads();
#ifndef PREP_NO_CONV
    if (wave < 6) {
        const int cg = tid % 48, rb = tid / 48, which = cg >> 4, dd = (cg & 15) * 8, col = COL_GQ + which * 512 + h * 128 + dd, cc = which * 512 + h * 128 + dd;
        const float* cw = a->in[2] + (size_t)l * 4 * 1536 + cc;
        float w[4][8];
#pragma unroll
        for (int j = 0; j < 4; ++j) { const f32x4 w0 = *(const f32x4*)(cw + j * 1536), w1 = *(const f32x4*)(cw + j * 1536 + 4); w[j][0] = w0.x; w[j][1] = w0.y; w[j][2] = w0.z; w[j][3] = w0.w; w[j][4] = w1.x; w[j][5] = w1.y; w[j][6] = w1.z; w[j][7] = w1.w; }
        float x0[8], x1[8], x2[8], x3[8];
        const int sbase = n * 64 + 8 * rb - 3;
        const bf16* hpc = HP + (size_t)(b * SEQ) * HP_LD + col;
#define PREP_LDROW(dst, s_) do { v4u raw_ = (v4u){0u, 0u, 0u, 0u}; if ((s_) >= 0) raw_ = *(const v4u*)(hpc + (size_t)(s_) * HP_LD); \
        _Pragma("unroll") for (int k_ = 0; k_ < 4; ++k_) { dst[2 * k_] = bflo(raw_[k_]); dst[2 * k_ + 1] = bfhi(raw_[k_]); } } while (0)
        PREP_LDROW(x0, sbase); PREP_LDROW(x1, sbase + 1); PREP_LDROW(x2, sbase + 2);
        const float gl = gc[63];
#pragma unroll 1
        for (int r = 0; r < 8; ++r) { const int i = 8 * rb + r; float y[8]; float ss = 0.f;
            PREP_LDROW(x3, sbase + 3 + r);
#pragma unroll
            for (int k = 0; k < 8; ++k) { const float acc = w[0][k] * x0[k] + w[1][k] * x1[k] + w[2][k] * x2[k] + w[3][k] * x3[k]; y[k] = siluf(acc); ss += y[k] * y[k]; x0[k] = x1[k]; x1[k] = x2[k]; x2[k] = x3[k]; }
            ss += __shfl_xor(ss, 1); ss += __shfl_xor(ss, 2); ss += __shfl_xor(ss, 4); ss += __shfl_xor(ss, 8);
            const float gi = gc[i], bi = bt[i];
            if (which == 0) { const float f = rsqrtf(ss + NORM_EPS) * 0.08838834764831845f, eg = __expf(gi);
                v4u p, pd;
#pragma unroll
                for (int k = 0; k < 4; ++k) { p[k] = bfc2(y[2 * k] * f, y[2 * k + 1] * f); pd[k] = bfc2(y[2 * k] * f * eg, y[2 * k + 1] * f * eg); }
                *(LAS v4u*)(Qb + i * KS + dd) = p;
                bf16* qd = QDg + (((i >> 5) * 4 + (dd >> 5)) * 2 + ((dd >> 4) & 1)) * 512 + (i & 31) * 8 + ((dd >> 3) & 1) * 4;
                *(v2u*)qd = (v2u){pd[0], pd[1]}; *(v2u*)(qd + 256) = (v2u){pd[2], pd[3]};
            } else if (which == 1) { const float f = rsqrtf(ss + NORM_EPS), fw = f * bi * __expf(gi), fd = f * __expf(gl - gi);
                v4u p;
#pragma unroll
                for (int k = 0; k < 4; ++k) p[k] = bfc2(y[2 * k] * f, y[2 * k + 1] * f);
                *(LAS v4u*)(Kb + i * KS + dd) = p;
#pragma unroll
                for (int k = 0; k < 8; ++k) { KW[i * 128 + dd + k] = y[k] * fw; KDs[(dd + k) * 72 + i] = bfc(y[k] * fd); }
            } else {
#pragma unroll
                for (int k = 0; k < 8; ++k) V[i * 128 + dd + k] = y[k] * bi;
            }
        }
#undef PREP_LDROW
    }
#endif
    __syncthreads();
    {
        const int ti = (wave >> 1) & 1, tj = wave & 1;
        if (wave < 4) {
            if (tj <= ti) {
                f32x16 acc;
#pragma unroll
                for (int i = 0; i < 16; ++i) acc[i] = 0.f;
#pragma unroll
                for (int s = 0; s < 8; ++s) acc = MFMA32(*(const LAS bf16x8*)(Kb + (32 * ti + c) * KS + 16 * s + 8 * hh), *(const LAS bf16x8*)(Kb + (32 * tj + c) * KS + 16 * s + 8 * hh), acc);
                const int j = 32 * tj + c; const float gj = gc[j];
#pragma unroll
                for (int r = 0; r < 16; ++r) { const int i = 32 * ti + (r & 3) + 8 * (r >> 2) + 4 * hh; A[i * 64 + j] = (j < i) ? bt[i] * acc[r] * __expf(gc[i] - gj) : 0.f; }
            } else {
#pragma unroll
                for (int r = 0; r < 16; ++r) { const int i = 32 * ti + (r & 3) + 8 * (r >> 2) + 4 * hh; A[i * 64 + 32 * tj + c] = 0.f; }
            }
        } else {
            const int kt = ti, qt = tj;
            if (kt <= qt) {
                f32x16 acc;
#pragma unroll
                for (int i = 0; i < 16; ++i) acc[i] = 0.f;
#pragma unroll
                for (int s = 0; s < 8; ++s) acc = MFMA32(*(const LAS bf16x8*)(Kb + (32 * kt + c) * KS + 16 * s + 8 * hh), *(const LAS bf16x8*)(Qb + (32 * qt + c) * KS + 16 * s + 8 * hh), acc);
                const int i = 32 * qt + c; const float gi = gc[i];
#pragma unroll
                for (int r = 0; r < 16; ++r) { const int j = 32 * kt + (r & 3) + 8 * (r >> 2) + 4 * hh; acc[r] = (j <= i) ? acc[r] * __expf(gi - gc[j]) : 0.f; }
                bf16x8* qf = (bf16x8*)QKg + lane;
                qf[((qt * 2 + kt) * 2 + 0) * 64] = pack8(acc, 0); qf[((qt * 2 + kt) * 2 + 1) * 64] = pack8(acc, 1);
            }
        }
    }
    __syncthreads();
#ifndef PREP_NO_SOLVE
    if (wave < 4) {
        const int col = tid & 127; LAS float* rhs = (tid < 128 ? V : KW) + col;
        float x[64];
#pragma unroll
        for (int i = 0; i < 64; ++i) {
            float s0 = rhs[i * 128], s1 = 0.f, s2 = 0.f, s3 = 0.f;
#pragma unroll
            for (int m4 = 0; m4 < (i + 3) / 4; ++m4) { const f32x4 a4 = *(const LAS f32x4*)(A + i * 64 + 4 * m4);
                if (4 * m4 < i) s0 -= a4.x * x[4 * m4];
                if (4 * m4 + 1 < i) s1 -= a4.y * x[4 * m4 + 1];
                if (4 * m4 + 2 < i) s2 -= a4.z * x[4 * m4 + 2];
                if (4 * m4 + 3 < i) s3 -= a4.w * x[4 * m4 + 3]; }
            x[i] = (s0 + s1) + (s2 + s3);
        }
        if (tid < 128) {
#pragma unroll
            for (int m = 0; m < 2; ++m)
#pragma unroll
                for (int hx = 0; hx < 2; ++hx)
#pragma unroll
                    for (int hf = 0; hf < 2; ++hf) { const int i0 = 32 * m + 16 * hf + 4 * hx;
                        v4u w; w.x = bfc2(x[i0], x[i0 + 1]); w.y = bfc2(x[i0 + 2], x[i0 + 3]); w.z = bfc2(x[i0 + 8], x[i0 + 9]); w.w = bfc2(x[i0 + 10], x[i0 + 11]);
                        *(v4u*)(Ug + uoff(i0, col)) = w; }
        } else {
#pragma unroll
            for (int i = 0; i < 64; ++i) Qb[i * KS + col] = bfc(-x[i]);
        }
    }
#endif
    __syncthreads();
#pragma unroll
    for (int p = 0; p < 4; ++p) { const int idx = tid + 512 * p, i = idx >> 5, d = (idx & 31) * 4;
        *(v2u*)(WNg + fragoff(i, d, 4)) = *(const LAS v2u*)(Qb + i * KS + d); }
#pragma unroll
    for (int p = 0; p < 4; ++p) { const int idx = tid + 512 * p, d = idx >> 4, i = (idx & 15) * 4;
        *(v2u*)(KDTg + fragoff(d, i, 2)) = *(const LAS v2u*)(KDs + d * 72 + i); }
}
#define XB_TMO      128
#define XB_XCNT(j)  (256  + 64 * (j))
#define XB_XSUB(j)  (1280 + 64 * (j))
#define XB_XGEN(j)  (2304 + 64 * (j))
#define XB_TOP      3328
#define XB_TOPGEN   3392
#define XCD_BAR_WORDS 3456
#define XB_SPIN_CAP (1u << 18)

__device__ __forceinline__ unsigned xb_ld(unsigned* p)              { return __hip_atomic_load(p, __ATOMIC_RELAXED, __HIP_MEMORY_SCOPE_AGENT); }
__device__ __forceinline__ unsigned xb_add(unsigned* p, unsigned v) { return __hip_atomic_fetch_add(p, v, __ATOMIC_RELAXED, __HIP_MEMORY_SCOPE_AGENT); }
__device__ __forceinline__ unsigned xb_xcc_id() { return (unsigned)__builtin_amdgcn_s_getreg((3 << 11) | 20) & 0xFu; }
#define XB_SPIN(cond, bar) do { unsigned _sp = 0; while (cond) { __builtin_amdgcn_s_sleep(1); \
    if ((++_sp & 255u) == 0u) { if (xb_ld(&(bar)[XB_TMO])) break; if (_sp > XB_SPIN_CAP) { atomicAdd(&(bar)[XB_TMO], 1u); break; } } } } while (0)

struct XcdBarrier {
    unsigned* bar; unsigned x;
    volatile LAS unsigned* st;
};

__device__ __forceinline__ XcdBarrier xcd_barrier_post(unsigned* bar, volatile LAS unsigned* st) {
    XcdBarrier b; b.bar = bar; b.x = xb_xcc_id(); b.st = st;
    if (threadIdx.x == 0) (void)xb_add(&bar[XB_XCNT(b.x)], 1u);
    return b;
}
__device__ __forceinline__ void xcd_barrier_complete(unsigned* bar, unsigned x, unsigned& nloc, unsigned& nx) {
    const unsigned G = gridDim.x * gridDim.y * gridDim.z;
    unsigned sum, cnt, mine, sp = 0u;
    for (;;) {
        sum = 0u; cnt = 0u; mine = 0u;
#pragma unroll
        for (unsigned j = 0; j < 16; ++j) { const unsigned c = xb_ld(&bar[XB_XCNT(j)]); sum += c; cnt += (c > 0u) ? 1u : 0u; mine = (j == x) ? c : mine; }
        if (sum == G) break;
        __builtin_amdgcn_s_sleep(1);
        if ((++sp & 255u) == 0u) { if (xb_ld(&bar[XB_TMO])) break; if (sp > XB_SPIN_CAP) { atomicAdd(&bar[XB_TMO], 1u); break; } }
    }
    nloc = mine > 0u ? mine : 1u; nx = cnt > 0u ? cnt : 1u;
}

__device__ __forceinline__ void xcd_barrier(const XcdBarrier& b) {
    asm volatile("s_waitcnt vmcnt(0)" ::: "memory");
    __syncthreads();
    if (threadIdx.x == 0) {
        unsigned* bar = b.bar;
        __builtin_amdgcn_s_waitcnt(0);
        unsigned nloc = b.st[0], nx = b.st[1];
        if (nloc == 0u) { xcd_barrier_complete(bar, b.x, nloc, nx); b.st[0] = nloc; b.st[1] = nx; }
        const unsigned old = xb_add(&bar[XB_XSUB(b.x)], 1u);
        const unsigned gen = old / nloc;
        if (old + 1u == (gen + 1u) * nloc) {
            __builtin_amdgcn_fence(__ATOMIC_RELEASE, "agent");
            asm volatile("s_waitcnt vmcnt(0)" ::: "memory");
            const unsigned og = xb_add(&bar[XB_TOP], 1u);
            const unsigned tg = og / nx;
            if (og + 1u == (tg + 1u) * nx) xb_add(&bar[XB_TOPGEN], 1u);
            else XB_SPIN(xb_ld(&bar[XB_TOPGEN]) == tg, bar);
            __builtin_amdgcn_fence(__ATOMIC_ACQUIRE, "agent");
            xb_add(&bar[XB_XGEN(b.x)], 1u);
            asm volatile("s_waitcnt vmcnt(0)" ::: "memory");
        } else {
            XB_SPIN(xb_ld(&bar[XB_XGEN(b.x)]) == gen, bar);
            __builtin_amdgcn_fence(__ATOMIC_ACQUIRE, "agent");
            asm volatile("s_waitcnt vmcnt(0)" ::: "memory");
        }
    }
    __syncthreads();
}
#ifndef REP_PRO
#define REP_PRO 1
#endif
#ifndef REP_IN
#define REP_IN 1
#endif
#ifndef REP_PREP
#define REP_PREP 1
#endif
#ifndef REP_SCAN
#define REP_SCAN 1
#endif
#ifndef REP_OUT
#define REP_OUT 1
#endif
#ifndef REP_GU
#define REP_GU 1
#endif
#ifndef REP_DN
#define REP_DN 1
#endif
#ifndef REP_MGU
#define REP_MGU 1
#endif
#ifndef REP_GDN
#define REP_GDN 1
#endif
#ifndef REP_RET
#define REP_RET 1
#endif
#ifndef FAST_SCAN
#define FAST_SCAN 1
#endif
#ifndef FAST_RET
#define FAST_RET 1
#endif
#ifndef FAST_PREP
#define FAST_PREP 1
#endif
#ifndef EN_PRO
#define EN_PRO 1
#endif
#ifndef EN_IN
#define EN_IN 1
#endif
#ifndef EN_PREP
#define EN_PREP 1
#endif
#ifndef EN_SCAN
#define EN_SCAN 1
#endif
#ifndef EN_OUT
#define EN_OUT 1
#endif
#ifndef EN_LN1
#define EN_LN1 1
#endif
#ifndef EN_FFN0
#define EN_FFN0 1
#endif
#ifndef EN_MOE
#define EN_MOE 1
#endif

__global__ void __launch_bounds__(NWAVES * 64, 2) fwd(Args a_unused) {
    extern __shared__ __attribute__((aligned(16))) unsigned char lds_raw[];
    LAS unsigned char* lds = (LAS unsigned char*)lds_raw;
    { const int tid0 = threadIdx.x; for (int u = tid0; u < (LDS_BYTES - LDSCTL_OFF) / 4; u += NWAVES * 64) ((LAS unsigned*)(lds + LDSCTL_OFF))[u] = 0u; }
    __syncthreads();
#if ONE_LAUNCH
    XcdBarrier bar = xcd_barrier_post((unsigned*)(kargs()->ws + WS_CTL) + CW_BAR, (volatile LAS unsigned*)(lds + MISC_OFF) + 8);
#define SEAM() xcd_barrier(bar)
#else
#define SEAM() do {} while (0)
#endif
#define IN(k) (kargs()->ph_lo <= (k) && (k) < kargs()->ph_hi)
#define BOTH(k) (IN(k) && ((k) + 1) < kargs()->ph_hi)
#define PH_LOCALS KArgs a = kargs(); unsigned char* ws = a->ws; int G = gridDim.x, bid = blockIdx.x; asm volatile("" : "+s"(G), "+s"(bid)); const int tid = tidx(), lane = tid & 63, wave = __builtin_amdgcn_readfirstlane(tid >> 6), gw = bid * NWAVES + wave, NGW = G * NWAVES; (void)ws; (void)lane; (void)gw; (void)NGW;

    if (EN_PRO && IN(PH_PRO)) { _Pragma("unroll 1") for (int rep_ = 0; rep_ < REP_PRO; ++rep_) { if (rep_) SEAM(); PH_LOCALS; ph_prologue(a, lds, wave, lane, gw, NGW, bid * (NWAVES * 64) + tid, G * NWAVES * 64); } if (BOTH(PH_PRO)) SEAM(); }

#pragma unroll 1
    for (int l = 0; l < 2; ++l) {
        if (EN_IN && IN(PH_L(l, K_IN))) {
            _Pragma("unroll 1") for (int rep_ = 0; rep_ < REP_IN; ++rep_) { if (rep_) SEAM(); PH_LOCALS;
            pg8::Gemm g{(const pg8::bf16_t*)(ws + WS_XB), (const pg8::bf16_t*)(ws + WS_WIN) + (size_t)l * NIN_PAD * 1024, M, NIN_PAD, 1024}; pg8::StaticOrder S; S.init(M, NIN_PAD, G, bid);
            pg8::EpiHproj E{(pg8::bf16_t*)(ws + WS_R + R_HP), (float*)(ws + WS_GAB)};
            pg8::gemm_phase<pg8::EpiHproj, pg8::StaticOrder, PG8_ALIGN, PG8_SP2>(lds, g, S, E); }
            if (BOTH(PH_L(l, K_IN))) SEAM();
        }
        if (EN_PREP && IN(PH_L(l, K_PREP))) {
            _Pragma("unroll 1") for (int rep_ = 0; rep_ < REP_PREP; ++rep_) { if (rep_) SEAM(); PH_LOCALS; for (int u = bid; u < 1024; u += G) { if (FAST_PREP) gdn_prep_fast(a, l, u, lds, tid, lane, wave); else gdn_prep_unit(a, l, u, lds, tid, lane, wave); }
              if (FAST_RET) for (int u = bid; u < 512; u += G) ret_kv_unit(a, u, lds, tid, lane, wave); }
            if (BOTH(PH_L(l, K_PREP))) SEAM();
        }
        if (EN_SCAN && IN(PH_L(l, K_SCAN))) {
            _Pragma("unroll 1") for (int rep_ = 0; rep_ < REP_SCAN; ++rep_) { if (rep_) SEAM(); PH_LOCALS;
            if (bid < 32) { const int t1 = tidx(), w1 = __builtin_amdgcn_readfirstlane(t1 >> 6); for (int rg_ = 0; rg_ < REP_GDN; ++rg_) gdn_scan_fast(a, l, bid, lds, t1, t1 & 63, w1); }
            else {
                { const int t1 = tidx(), w1 = __builtin_amdgcn_readfirstlane(t1 >> 6);
                  for (int rr_ = 0; rr_ < REP_RET; ++rr_) for (int u = bid - 32; u < 512; u += G - 32) ret_out_unit(a, u, lds, t1, t1 & 63, w1); }
                __syncthreads();
                { const int t2 = tidx(), w2 = __builtin_amdgcn_readfirstlane(t2 >> 6);
                  moe_convert(kargs(), lds, w2, t2 & 63, (bid - 32) * NWAVES + w2, (G - 32) * NWAVES, 4 * l, 4 * l + 4); }
            } }
            if (BOTH(PH_L(l, K_SCAN))) SEAM();
        }
        if (EN_OUT && IN(PH_L(l, K_OUT))) {
            _Pragma("unroll 1") for (int rep_ = 0; rep_ < REP_OUT; ++rep_) { if (rep_) SEAM(); PH_LOCALS;
            pg8::Gemm g{(const pg8::bf16_t*)(ws + WS_R + R_OB), (const pg8::bf16_t*)(ws + WS_WO) + (size_t)l * 1024 * 1024, M, 1024, 1024}; pg8::StaticOrder S; S.init(M, 1024, G, bid);
            pg8::EpiBf16Out E{(pg8::bf16_t*)(ws + WS_R + R_MIX), 1024};
            pg8::gemm_phase<pg8::EpiBf16Out, pg8::StaticOrder, PG8_ALIGN, PG8_SP2>(lds, g, S, E); }
            if (BOTH(PH_L(l, K_OUT))) SEAM();
        }
        if (EN_LN1 && IN(PH_L(l, K_LN1))) {
            { PH_LOCALS;
            if (l == 0) ln_rows<false>(a->in[0], ALPHA, (const bf16*)(ws + WS_R + R_MIX), a->in[7], a->in[8], a->out, 1.0f, (bf16*)(ws + WS_XB), nullptr, nullptr, nullptr, nullptr, lane, gw, NGW);
            else { ln_rows<true>(a->out, ALPHA, (const bf16*)(ws + WS_R + R_MIX), a->in[7] + 1024, a->in[8] + 1024, a->out, ALPHA, (bf16*)(ws + WS_XB), a->in[14], (unsigned*)(ws + WS_CTL) + CW_MOE, (int*)(ws + WS_LIST), (float*)(ws + WS_GATE), lane, gw, NGW);
                 } }
            if (BOTH(PH_L(l, K_LN1))) SEAM();
        }
        if (l == 0) {
            if (EN_FFN0 && IN(PH_L(0, K_GU))) {
                _Pragma("unroll 1") for (int rep_ = 0; rep_ < REP_GU; ++rep_) { if (rep_) SEAM(); PH_LOCALS;
                pg8::Gemm g{(const pg8::bf16_t*)(ws + WS_XB), (const pg8::bf16_t*)(ws + WS_WGU), M, 2 * FF, 1024}; pg8::StaticOrder S; S.init(M, 2 * FF, G, bid);
                pg8::EpiSwiglu E{(pg8::bf16_t*)(ws + WS_R + R_H), FF};
                pg8::gemm_phase<pg8::EpiSwiglu, pg8::StaticOrder, PG8_ALIGN, PG8_SP2>(lds, g, S, E); }
                if (BOTH(PH_L(0, K_GU))) SEAM();
            }
            if (EN_FFN0 && IN(PH_L(0, K_DN))) {
                _Pragma("unroll 1") for (int rep_ = 0; rep_ < REP_DN; ++rep_) { if (rep_) SEAM(); PH_LOCALS;
                pg8::Gemm g{(const pg8::bf16_t*)(ws + WS_R + R_H), (const pg8::bf16_t*)(ws + WS_WD), M, 1024, FF}; pg8::StaticOrder S; S.init(M, 1024, G, bid);
                pg8::EpiBf16Out E{(pg8::bf16_t*)(ws + WS_R + R_MIX), 1024};
                pg8::gemm_phase<pg8::EpiBf16Out, pg8::StaticOrder, PG8_ALIGN, PG8_SP2>(lds, g, S, E); }
                if (BOTH(PH_L(0, K_DN))) SEAM();
            }
            if (EN_LN1 && IN(PH_L(0, K_LN2))) {
                { PH_LOCALS;
                ln_rows<false>(a->out, ALPHA, (const bf16*)(ws + WS_R + R_MIX), a->in[9], a->in[10], a->out, 1.0f, (bf16*)(ws + WS_XB), nullptr, nullptr, nullptr, nullptr, lane, gw, NGW); }
                if (BOTH(PH_L(0, K_LN2))) SEAM();
            }
        } else {
#pragma unroll 1
            for (int j = 0; j < 2; ++j) {
                const int kg = K_G0 + 3 * j;
                if (EN_MOE && j == 0 && IN(PH_L(1, kg))) { { PH_LOCALS; moe_gather(a, 0, lane, gw, NGW); moe_gather(a, 1, lane, gw, NGW); } if (BOTH(PH_L(1, kg))) SEAM(); }
                if (EN_MOE && IN(PH_L(1, kg + 1))) {
                    _Pragma("unroll 1") for (int rep_ = 0; rep_ < REP_MGU; ++rep_) { if (rep_) SEAM(); PH_LOCALS;
                    int cnt[8];
#pragma unroll
                    for (int e = 0; e < 8; ++e) cnt[e] = (int)((const unsigned*)(ws + WS_CTL))[CW_MOE + 64 * (j * 8 + e)];
                    pg8::Gemm g{(const pg8::bf16_t*)(ws + WS_R + R_XG + (size_t)j * XG_PASS), (const pg8::bf16_t*)(ws + WS_WMGU), MOE_ROWS, 2 * FE, 1024}; pg8::MoeOrder S; S.init(cnt, 2 * FE / 256, G, bid, (size_t)2 * FE * 1024 * 2);
                    pg8::EpiSwiglu E{(pg8::bf16_t*)(ws + WS_R + R_HM), FE};
                    pg8::gemm_phase<pg8::EpiSwiglu, pg8::MoeOrder, PG8_ALIGN, PG8_SP2>(lds, g, S, E); }
                    if (BOTH(PH_L(1, kg + 1))) SEAM();
                }
                if (EN_MOE && IN(PH_L(1, kg + 2))) {
                    { PH_LOCALS;
                    int cnt[8];
#pragma unroll
                    for (int e = 0; e < 8; ++e) cnt[e] = (int)((const unsigned*)(ws + WS_CTL))[CW_MOE + 64 * (j * 8 + e)];
                    pg8::Gemm g{(const pg8::bf16_t*)(ws + WS_R + R_HM), (const pg8::bf16_t*)(ws + WS_WMD), MOE_ROWS, 1024, FE}; pg8::MoeOrder S; S.init(cnt, 4, G, bid, (size_t)1024 * FE * 2);
                    pg8::EpiMoeDown E; E.XF = a->out; E.list = (const int*)(ws + WS_LIST) + (size_t)j * 8 * 16384; E.gate = (const float*)(ws + WS_GATE) + (size_t)j * 16384;
#pragma unroll
                    for (int e = 0; e < 8; ++e) { E.cnt[e] = cnt[e]; E.cum[e] = S.cum[e]; }
                    pg8::gemm_phase<pg8::EpiMoeDown, pg8::MoeOrder, PG8_ALIGN, PG8_SP2>(lds, g, S, E); }
                    if (BOTH(PH_L(1, kg + 2))) SEAM();
                }
            }
            if (EN_LN1 && IN(PH_L(1, K_LNF))) {
                PH_LOCALS;
                ln_rows<false>(a->out, 1.0f, nullptr, a->in[9] + 1024, a->in[10] + 1024, a->out, 1.0f, nullptr, nullptr, nullptr, nullptr, nullptr, lane, gw, NGW);
            }
        }
    }
#undef IN
#undef BOTH
}

extern "C" void kernel_launch(void* const* d_in, const int* in_sizes, int n_in, void* d_out, int out_size, void* d_ws, size_t ws_size, hipStream_t stream) {
    static int grid = 0;
    if (grid == 0) {
        if (n_in != 18 || in_sizes[0] != M * D || out_size != M * D || ws_size < WS_END) { fprintf(stderr, "kernel_launch: unexpected shapes or workspace (%zu < %zu); nothing launched\n", ws_size, (size_t)WS_END); grid = -1; return; }
        int dev = 0, cus = 0, per_cu = 0;
        if (hipGetDevice(&dev) != hipSuccess || hipDeviceGetAttribute(&cus, hipDeviceAttributeMultiprocessorCount, dev) != hipSuccess) { grid = -1; return; }
        if (hipFuncSetAttribute((const void*)fwd, hipFuncAttributeMaxDynamicSharedMemorySize, LDS_BYTES) != hipSuccess) { fprintf(stderr, "kernel_launch: hipFuncSetAttribute failed\n"); grid = -1; return; }
        if (hipOccupancyMaxActiveBlocksPerMultiprocessor(&per_cu, (const void*)fwd, NWAVES * 64, LDS_BYTES) != hipSuccess || per_cu < 1) fprintf(stderr, "kernel_launch: occupancy query reports %d\n", per_cu);
        (void)hipGetLastError();
        grid = cus;
    }
    if (grid < 0) return;
    if (hipMemsetAsync((char*)d_ws + WS_CTL, 0, CTL_BYTES, stream) != hipSuccess) return;
    Args a{};
    for (int i = 0; i < 18; ++i) a.in[i] = (const float*)d_in[i];
    a.out = (float*)d_out; a.ws = (unsigned char*)d_ws;
#if ONE_LAUNCH
    a.ph_lo = 0; a.ph_hi = PH_END;
    hipLaunchKernelGGL(fwd, dim3(grid), dim3(NWAVES * 64), LDS_BYTES, stream, a);
#else
    static const int phases[] = {PH_PRO,
        PH_L(0, K_IN), PH_L(0, K_PREP), PH_L(0, K_SCAN), PH_L(0, K_OUT), PH_L(0, K_LN1), PH_L(0, K_GU), PH_L(0, K_DN), PH_L(0, K_LN2),
        PH_L(1, K_IN), PH_L(1, K_PREP), PH_L(1, K_SCAN), PH_L(1, K_OUT), PH_L(1, K_LN1),
        PH_L(1, K_G0), PH_L(1, K_GU0), PH_L(1, K_DN0), PH_L(1, K_G1), PH_L(1, K_GU1), PH_L(1, K_DN1), PH_L(1, K_LNF)};
    for (unsigned i = 0; i < sizeof(phases) / sizeof(phases[0]); ++i) {
        a.ph_lo = phases[i]; a.ph_hi = phases[i] + 1;
        hipLaunchKernelGGL(fwd, dim3(grid), dim3(NWAVES * 64), LDS_BYTES, stream, a);
    }
#endif
}
```

```cpp
#include <hip/hip_runtime.h>
#include <cstdio>
#include <cstdint>

#ifndef ONE_LAUNCH
#define ONE_LAUNCH 1
#endif

#define GAS __attribute__((address_space(1)))
#define LAS __attribute__((address_space(3)))
typedef unsigned short bf16;
typedef unsigned v4u __attribute__((ext_vector_type(4)));
typedef unsigned v2u __attribute__((ext_vector_type(2)));
typedef float f32x4 __attribute__((ext_vector_type(4)));
typedef float f32x2 __attribute__((ext_vector_type(2)));
#define RLX_AGENT __ATOMIC_RELAXED, __HIP_MEMORY_SCOPE_AGENT
#define LDS_WAIT() asm volatile("s_waitcnt lgkmcnt(0)" ::: "memory")
#define VM_WAIT() asm volatile("s_waitcnt vmcnt(0)" ::: "memory")

__device__ __forceinline__ unsigned f2bf(float f) { unsigned u = __builtin_bit_cast(unsigned, f); return (u + 0x7fffu + ((u >> 16) & 1u)) >> 16; }
__device__ __forceinline__ unsigned pk2(float lo, float hi) { return f2bf(lo) | (f2bf(hi) << 16); }
__device__ __forceinline__ float bf2f(unsigned short u) { return __builtin_bit_cast(float, (unsigned)u << 16); }
__device__ __forceinline__ float bflo(unsigned u) { return __builtin_bit_cast(float, u << 16); }
__device__ __forceinline__ float bfhi(unsigned u) { return __builtin_bit_cast(float, u & 0xffff0000u); }
__device__ __forceinline__ float siluf(float x) { return x / (1.f + __expf(-x)); }
__device__ __forceinline__ float sigmf(float x) { return 1.f / (1.f + __expf(-x)); }
__device__ __forceinline__ float wave_sum(float v) {
#pragma unroll
    for (int o = 1; o < 64; o <<= 1) v += __shfl_xor(v, o);
    return v;
}

constexpr int NWAVES = 8;
constexpr int M = 16384, D = 1024, SEQ = 2048, NB = 8;
constexpr int IN_COLS = 3592, NIN_PAD = 3840, HP_LD = 3584;
constexpr int FF = 2816, FE = 3584, NE = 8;
constexpr int COL_RQ = 0, COL_RK = 256, COL_RV = 512, COL_RG = 1024, COL_GQ = 1536, COL_GK = 2048, COL_GV = 2560, COL_GG = 3072;
constexpr float ALPHA = 1.41421356237f;
constexpr float LN_EPS = 1e-5f, NORM_EPS = 1e-6f;
constexpr int MOE_ROWS = 72 * 256;

__host__ __device__ __forceinline__ int fragoff(int i, int d, int nkt) {
    return ((((i >> 5) * nkt + (d >> 5)) * 2 + ((d >> 4) & 1)) * 512) + ((((d >> 2) & 1) * 32 + (i & 31)) * 8) + ((((d >> 3) & 1) << 2) | (d & 3));
}
__host__ __device__ __forceinline__ int uoff(int i, int e) {
    const int reg = (i & 3) | (((i & 31) >> 3) << 2);
    return (((((e >> 5) * 2 + (i >> 5)) * 2 + (reg >> 3)) * 64 + (((i >> 2) & 1) * 32 + (e & 31))) * 8) + (reg & 7);
}
namespace pg8 {
#define PG8_LAS __attribute__((address_space(3)))
typedef unsigned short bf16_t;
typedef short bf16x8 __attribute__((ext_vector_type(8)));
typedef float f32x4 __attribute__((ext_vector_type(4)));
typedef unsigned u32x4 __attribute__((ext_vector_type(4)));
constexpr int BM = 256, BK = 64, HALF = 128, HTB = HALF * BK * 2  , STAGE_BYTES = 8 * HTB, NXCD = 8, WGM = 8;

__host__ __device__ __forceinline__ int lds_byte(int r, int c) { const int st = (r >> 4) * 2 + (c >> 5), rr = r & 15, cc = c & 31, ob = rr * 64 + cc * 2; return st * 1024 + (ob ^ (((ob >> 9) & 1) << 5)); }
__host__ __device__ __forceinline__ void stage_rc(int b, int& R, int& C) { const int st = b / 1024, sb = b % 1024, swz = sb ^ (((sb >> 9) & 1) << 5); R = (st >> 1) * 16 + swz / 64; C = (st & 1) * 32 + (swz % 64) / 2; }
__host__ __device__ __forceinline__ int perm32(int rho) { const int n = rho >> 4, i = rho & 15; return 8 * (i >> 2) + 4 * n + (i & 3); }

struct Unit { int pm, pn, aux; };
struct Gemm { const bf16_t* A; const bf16_t* Bt; int M, N, K; };

struct StaticOrder {
    int nM, nN, nwg, G, c;
    __host__ __device__ void init(int M, int N, int G_, int c_) { nM = M / BM; nN = N / BM; nwg = nM * nN; G = G_; c = c_; }
    __host__ __device__ bool next(int i, Unit& u) const {
        const long L = (long)i * G + c; if (L >= nwg) return false;
        int wgid = (int)L; { const int q = nwg / NXCD, r = nwg % NXCD, xcd = wgid % NXCD, off = wgid / NXCD; wgid = (xcd < r ? xcd * (q + 1) : r * (q + 1) + (xcd - r) * q) + off; }
        const int nig = WGM * nN, gid = wgid / nig, fm = gid * WGM, gsz = (nM - fm) < WGM ? (nM - fm) : WGM;
        u.pm = fm + ((wgid % nig) % gsz); u.pn = (wgid % nig) / gsz; u.aux = 0; return true;
    }
    __device__ __forceinline__ const char* aptr(const Gemm& g, const Unit& u) const { return (const char*)g.A + (size_t)u.pm * ((size_t)BM * g.K * 2); }
    __device__ __forceinline__ const char* bptr(const Gemm& g, const Unit& u) const { return (const char*)g.Bt + (size_t)u.pn * ((size_t)BM * g.K * 2); }
    __device__ __forceinline__ void a_ready(const Unit&) const {}
    __device__ __forceinline__ void done(const Unit&) const {}
};

template <class Epi, class Sched, bool ALIGN_EPI = false, bool SP2 = false>
__device__ __forceinline__ void gemm_phase(PG8_LAS unsigned char* lds, const Gemm g, const Sched& S, const Epi& E) {
    int tid = threadIdx.x; asm volatile("" : "+v"(tid)); const int wid = __builtin_amdgcn_readfirstlane(tid >> 6), lane = tid & 63, wr = wid >> 2, wc = wid & 3, fr = lane & 15, fq = lane >> 4;
    const int K = g.K, nt = K / BK;
    unsigned voffA[2], voffB[2];
#pragma unroll
    for (int i = 0; i < 2; ++i) { int R, C; stage_rc(tid * 16 + i * 8192, R, C); const int Rb = Epi::PERM ? ((R & ~31) + perm32(R & 31)) : R;
        voffA[i] = (unsigned)(R * K + C) * 2u; voffB[i] = (unsigned)(Rb * K + C) * 2u; }
    const size_t kstep = (size_t)(BK * 2);
    const size_t hstep = (size_t)HALF * K * 2;
    const size_t tstep = 2 * hstep;
    const unsigned ldsw = (unsigned)wid * 1024u;
    const int aoff = lds_byte(wr * 64 + fr, fq * 8), boff = lds_byte(wc * 32 + fr, fq * 8);
#define PG8_SA(b, h) (((b) * 2 + (h)) * HTB)
#define PG8_SB(b, h) ((4 + (b) * 2 + (h)) * HTB)
#define PG8_STAGE(bufoff, gbase, voff) do { _Pragma("unroll") for (int _i = 0; _i < 2; ++_i) \
        __builtin_amdgcn_global_load_lds((const unsigned*)((const char*)(gbase) + (voff)[_i]), (PG8_LAS unsigned*)(lds + (bufoff) + ldsw + _i * 8192), 16, 0, 0); } while (0)
#define PG8_LDA(dst, b, h) do { _Pragma("unroll") for (int m = 0; m < 4; ++m) _Pragma("unroll") for (int k = 0; k < 2; ++k) dst[m][k] = *(const PG8_LAS bf16x8*)(lds + PG8_SA(b, h) + aoff + m * 2048 + k * 1024); } while (0)
#define PG8_LDB(dst, b, h) do { _Pragma("unroll") for (int n = 0; n < 2; ++n) _Pragma("unroll") for (int k = 0; k < 2; ++k) dst[n][k] = *(const PG8_LAS bf16x8*)(lds + PG8_SB(b, h) + boff + n * 2048 + k * 1024); } while (0)
#define PG8_MMA(ai, bj, At, Bt) do { __builtin_amdgcn_s_setprio(1); _Pragma("unroll") for (int m = 0; m < 4; ++m) _Pragma("unroll") for (int n = 0; n < 2; ++n) _Pragma("unroll") for (int k = 0; k < 2; ++k) \
        acc[ai][bj][m][n] = __builtin_amdgcn_mfma_f32_16x16x32_bf16(Bt[n][k], At[m][k], acc[ai][bj][m][n], 0, 0, 0); __builtin_amdgcn_s_setprio(0); } while (0)
#define PG8_WAIT_V(n) asm volatile("s_waitcnt vmcnt(" #n ")" ::: "memory")
#define PG8_WAIT_L(n) asm volatile("s_waitcnt lgkmcnt(" #n ")" ::: "memory")
#define PG8_BAR __builtin_amdgcn_s_barrier()
#define PG8_SCHED __builtin_amdgcn_sched_barrier(0)
    Unit cur, nxt; int ui = 0;
    if (!S.next(0, cur)) return;
    f32x4 acc[2][2][4][2];
#pragma unroll
    for (int a = 0; a < 2; ++a)
#pragma unroll
        for (int b = 0; b < 2; ++b)
#pragma unroll
            for (int m = 0; m < 4; ++m)
#pragma unroll
                for (int n = 0; n < 2; ++n) acc[a][b][m][n] = (f32x4){0.f, 0.f, 0.f, 0.f};
    bf16x8 At[4][2], B0[2][2], B1[2][2];
    const char* cA = S.aptr(g, cur); const char* cB = S.bptr(g, cur);
    S.a_ready(cur);
    if constexpr (SP2) {
        PG8_STAGE(PG8_SB(0, 0), cB, voffB); PG8_STAGE(PG8_SB(0, 1), cB + hstep, voffB); PG8_STAGE(PG8_SA(0, 0), cA, voffA); PG8_STAGE(PG8_SA(0, 1), cA + hstep, voffA);
        if (wr == 1) PG8_BAR;
        PG8_WAIT_V(2); PG8_BAR;
        PG8_STAGE(PG8_SB(1, 0), cB + kstep, voffB); PG8_STAGE(PG8_SA(1, 0), cA + kstep, voffA); PG8_STAGE(PG8_SB(1, 1), cB + hstep + kstep, voffB);
        PG8_WAIT_V(6); PG8_BAR;
    } else {
        PG8_STAGE(PG8_SB(0, 0), cB, voffB); PG8_STAGE(PG8_SA(0, 0), cA, voffA); PG8_STAGE(PG8_SB(0, 1), cB + hstep, voffB); PG8_STAGE(PG8_SA(0, 1), cA + hstep, voffA);
        if (wr == 1) PG8_BAR;
        PG8_WAIT_V(4); PG8_BAR;
        PG8_STAGE(PG8_SB(1, 0), cB + kstep, voffB); PG8_STAGE(PG8_SA(1, 0), cA + kstep, voffA); PG8_STAGE(PG8_SB(1, 1), cB + hstep + kstep, voffB);
        PG8_WAIT_V(6); PG8_BAR;
    }
    for (;;) {
        const bool has_next = S.next(ui + 1, nxt);
        const char* nA = has_next ? S.aptr(g, nxt) : cA; const char* nB = has_next ? S.bptr(g, nxt) : cB;
        for (int t = 0; t < nt; t += 2) {
            const bool last = (t == nt - 2);
            const char* a1 = cA + (size_t)(t + 1) * kstep;
            const char* a2 = last ? nA : cA + (size_t)(t + 2) * kstep; const char* b2 = last ? nB : cB + (size_t)(t + 2) * kstep;
            const char* a3 = a2 + kstep; const char* b3 = b2 + kstep;
            if (last && has_next) S.a_ready(nxt);
            if constexpr (SP2) {
            PG8_LDB(B0, 0, 0); PG8_LDB(B1, 0, 1); PG8_SCHED; PG8_LDA(At, 0, 0); PG8_STAGE(PG8_SA(1, 1), a1 + hstep, voffA);
            PG8_WAIT_V(8); PG8_WAIT_L(0); PG8_BAR; PG8_MMA(0, 0, At, B0); PG8_MMA(0, 1, At, B1); PG8_BAR; PG8_SCHED;
            PG8_LDA(At, 0, 1); PG8_STAGE(PG8_SB(0, 0), b2, voffB); PG8_STAGE(PG8_SB(0, 1), b2 + hstep, voffB); PG8_STAGE(PG8_SA(0, 0), a2, voffA);
            PG8_WAIT_V(8); PG8_WAIT_L(0); PG8_BAR; PG8_MMA(1, 0, At, B0); PG8_MMA(1, 1, At, B1); PG8_BAR; PG8_SCHED;
            PG8_LDB(B0, 1, 0); PG8_LDB(B1, 1, 1); PG8_SCHED; PG8_LDA(At, 1, 0); PG8_STAGE(PG8_SA(0, 1), a2 + hstep, voffA);
            PG8_WAIT_V(8); PG8_WAIT_L(0); PG8_BAR; PG8_MMA(0, 0, At, B0); PG8_MMA(0, 1, At, B1); PG8_BAR; PG8_SCHED;
            PG8_LDA(At, 1, 1); PG8_STAGE(PG8_SB(1, 0), b3, voffB); PG8_STAGE(PG8_SB(1, 1), b3 + hstep, voffB); PG8_STAGE(PG8_SA(1, 0), a3, voffA);
            PG8_WAIT_V(8); PG8_WAIT_L(0); PG8_BAR; PG8_MMA(1, 0, At, B0); PG8_MMA(1, 1, At, B1); PG8_BAR; PG8_SCHED;
            } else {
            PG8_LDB(B0, 0, 0); PG8_SCHED; PG8_LDA(At, 0, 0); PG8_STAGE(PG8_SA(1, 1), a1 + hstep, voffA);
            PG8_WAIT_L(8); PG8_BAR; PG8_WAIT_L(0); PG8_MMA(0, 0, At, B0); PG8_BAR; PG8_SCHED;
            PG8_LDB(B1, 0, 1); PG8_STAGE(PG8_SB(0, 0), b2, voffB);
            PG8_BAR; PG8_WAIT_L(0); PG8_MMA(0, 1, At, B1); PG8_BAR;
            PG8_LDA(At, 0, 1); PG8_STAGE(PG8_SA(0, 0), a2, voffA);
            PG8_BAR; PG8_WAIT_L(0); PG8_MMA(1, 0, At, B0); PG8_BAR; PG8_SCHED;
            PG8_STAGE(PG8_SB(0, 1), b2 + hstep, voffB);
            PG8_WAIT_V(6); PG8_BAR; PG8_MMA(1, 1, At, B1); PG8_BAR;
            PG8_LDB(B0, 1, 0); PG8_SCHED; PG8_LDA(At, 1, 0); PG8_STAGE(PG8_SA(0, 1), a2 + hstep, voffA);
            PG8_WAIT_L(8); PG8_BAR; PG8_WAIT_L(0); PG8_MMA(0, 0, At, B0); PG8_BAR; PG8_SCHED;
            PG8_LDB(B1, 1, 1); PG8_STAGE(PG8_SB(1, 0), b3, voffB);
            PG8_BAR; PG8_WAIT_L(0); PG8_MMA(0, 1, At, B1); PG8_BAR;
            PG8_LDA(At, 1, 1); PG8_STAGE(PG8_SA(1, 0), a3, voffA);
            PG8_BAR; PG8_WAIT_L(0); PG8_MMA(1, 0, At, B0); PG8_BAR; PG8_SCHED;
            PG8_STAGE(PG8_SB(1, 1), b3 + hstep, voffB);
            PG8_WAIT_V(6); PG8_BAR; PG8_MMA(1, 1, At, B1); PG8_BAR;
            }
        }
        if constexpr (ALIGN_EPI) { if (wr == 0) PG8_BAR; }
        if constexpr (!Epi::AFTER_DRAIN) { E(acc, cur, wr, wc, fr, fq); S.done(cur); }
        if (!has_next) break;
#pragma unroll
        for (int a = 0; a < 2; ++a)
#pragma unroll
            for (int b = 0; b < 2; ++b)
#pragma unroll
                for (int m = 0; m < 4; ++m)
#pragma unroll
                    for (int n = 0; n < 2; ++n) acc[a][b][m][n] = (f32x4){0.f, 0.f, 0.f, 0.f};
        cur = nxt; cA = nA; cB = nB; ++ui;
        if constexpr (ALIGN_EPI) { if (wr == 1) PG8_BAR; }
    }
    PG8_WAIT_V(0);
    if constexpr (!ALIGN_EPI) { if (wr == 0) PG8_BAR; }
    PG8_BAR;
    if constexpr (Epi::AFTER_DRAIN) { E.fused(acc, cur, wr, wc, fr, fq, lds, wid, lane); S.done(cur); }
#undef PG8_SA
#undef PG8_SB
#undef PG8_STAGE
#undef PG8_LDA
#undef PG8_LDB
#undef PG8_MMA
#undef PG8_WAIT_V
#undef PG8_WAIT_L
#undef PG8_BAR
#undef PG8_SCHED
}
}

namespace pg8 {
__device__ __forceinline__ unsigned cvt_pk_bf16(float lo, float hi) { unsigned r; asm volatile("v_cvt_pk_bf16_f32 %0, %1, %2" : "=v"(r) : "v"(lo), "v"(hi)); return r; }

struct EpiHproj {
    static constexpr bool PERM = true, AFTER_DRAIN = false;
    bf16_t* HP; float* GAB;
    __device__ __forceinline__ void operator()(const f32x4 (&acc)[2][2][4][2], const Unit& u, int wr, int wc, int fr, int fq) const {
        const int row0 = u.pm * BM + wr * 64 + fr;
        if (u.pn < 14) {
            const int col0 = u.pn * BM + wc * 32 + 8 * fq;
#pragma unroll
            for (int ai = 0; ai < 2; ++ai)
#pragma unroll
                for (int m = 0; m < 4; ++m) { bf16_t* rowp = HP + (size_t)(row0 + ai * HALF + m * 16) * 3584 + col0;
#pragma unroll
                    for (int bj = 0; bj < 2; ++bj) { const f32x4 v0 = acc[ai][bj][m][0], v1 = acc[ai][bj][m][1];
                        u32x4 w; w.x = cvt_pk_bf16(v0[0], v0[1]); w.y = cvt_pk_bf16(v0[2], v0[3]); w.z = cvt_pk_bf16(v1[0], v1[1]); w.w = cvt_pk_bf16(v1[2], v1[3]);
                        *(u32x4*)(rowp + bj * HALF) = w; } }
        } else if (wc == 0 && fq == 0) {
#pragma unroll
            for (int ai = 0; ai < 2; ++ai)
#pragma unroll
                for (int m = 0; m < 4; ++m) { float* rowp = GAB + (size_t)(row0 + ai * HALF + m * 16) * 8;
                    *(f32x4*)(rowp) = acc[ai][0][m][0]; *(f32x4*)(rowp + 4) = acc[ai][0][m][1]; }
        }
    }
};
struct EpiBf16Out {
    static constexpr bool PERM = true, AFTER_DRAIN = false;
    bf16_t* O; int ldc;
    __device__ __forceinline__ void operator()(const f32x4 (&acc)[2][2][4][2], const Unit& u, int wr, int wc, int fr, int fq) const {
        const int row0 = u.pm * BM + wr * 64 + fr, col0 = u.pn * BM + wc * 32 + 8 * fq;
#pragma unroll
        for (int ai = 0; ai < 2; ++ai)
#pragma unroll
            for (int m = 0; m < 4; ++m) { bf16_t* rowp = O + (size_t)(row0 + ai * HALF + m * 16) * ldc + col0;
#pragma unroll
                for (int bj = 0; bj < 2; ++bj) { const f32x4 v0 = acc[ai][bj][m][0], v1 = acc[ai][bj][m][1];
                    u32x4 w; w.x = cvt_pk_bf16(v0[0], v0[1]); w.y = cvt_pk_bf16(v0[2], v0[3]); w.z = cvt_pk_bf16(v1[0], v1[1]); w.w = cvt_pk_bf16(v1[2], v1[3]);
                    *(u32x4*)(rowp + bj * HALF) = w; } }
    }
};
struct EpiF32 {
    static constexpr bool PERM = false, AFTER_DRAIN = false;
    float* O; int ldc;
    __device__ __forceinline__ void operator()(const f32x4 (&acc)[2][2][4][2], const Unit& u, int wr, int wc, int fr, int fq) const {
        const int row0 = u.pm * BM + wr * 64 + fr, col0 = u.pn * BM + wc * 32 + 4 * fq;
#pragma unroll
        for (int ai = 0; ai < 2; ++ai)
#pragma unroll
            for (int m = 0; m < 4; ++m) { float* rowp = O + (size_t)(row0 + ai * HALF + m * 16) * ldc + col0;
#pragma unroll
                for (int bj = 0; bj < 2; ++bj)
#pragma unroll
                    for (int n = 0; n < 2; ++n) *(f32x4*)(rowp + bj * HALF + n * 16) = acc[ai][bj][m][n]; }
    }
};
struct EpiSwiglu {
    static constexpr bool PERM = true, AFTER_DRAIN = false;
    bf16_t* H; int ldh;
    __device__ __forceinline__ void operator()(const f32x4 (&acc)[2][2][4][2], const Unit& u, int wr, int wc, int fr, int fq) const {
        const int row0 = u.pm * BM + wr * 64 + fr, col0 = u.pn * HALF + wc * 32 + 8 * fq;
#pragma unroll
        for (int ai = 0; ai < 2; ++ai)
#pragma unroll
            for (int m = 0; m < 4; ++m) { bf16_t* rowp = H + (size_t)(row0 + ai * HALF + m * 16) * ldh + col0;
                float h[8];
#pragma unroll
                for (int n = 0; n < 2; ++n)
#pragma unroll
                    for (int i = 0; i < 4; ++i) { const float gt = acc[ai][0][m][n][i], up = acc[ai][1][m][n][i]; h[n * 4 + i] = gt * up * __builtin_amdgcn_rcpf(1.f + __expf(-gt)); }
                u32x4 w; w.x = cvt_pk_bf16(h[0], h[1]); w.y = cvt_pk_bf16(h[2], h[3]); w.z = cvt_pk_bf16(h[4], h[5]); w.w = cvt_pk_bf16(h[6], h[7]);
                *(u32x4*)(rowp) = w; }
    }
};
struct EpiMoeDown {
    static constexpr bool PERM = false, AFTER_DRAIN = false;
    float* XF; const int* list; const float* gate; int cnt[8], cum[8];
    __device__ __forceinline__ void operator()(const f32x4 (&acc)[2][2][4][2], const Unit& u, int wr, int wc, int fr, int fq) const {
        int e = u.aux, c_e = 0, t_e = 0;
#pragma unroll
        for (int k = 0; k < 8; ++k) { if (k == e) { c_e = cnt[k]; t_e = cum[k]; } }
        const int s0 = (u.pm - t_e) * BM + wr * 64 + fr, col0 = u.pn * BM + wc * 32 + 4 * fq;
        const int* lp = list + e * 16384;
        int tok[8]; float gt[8];
#pragma unroll
        for (int q = 0; q < 8; ++q) { const int s = s0 + (q >> 2) * HALF + (q & 3) * 16; tok[q] = (s < c_e) ? lp[s] : -1; }
#pragma unroll
        for (int q = 0; q < 8; ++q) gt[q] = (tok[q] >= 0) ? gate[tok[q]] : 0.f;
#pragma unroll
        for (int ai = 0; ai < 2; ++ai) {
            f32x4 o[4][2][2];
#pragma unroll
            for (int m = 0; m < 4; ++m) { const float* rowp = XF + (size_t)(tok[ai * 4 + m] >= 0 ? tok[ai * 4 + m] : 0) * 1024 + col0;
#pragma unroll
                for (int bj = 0; bj < 2; ++bj)
#pragma unroll
                    for (int n = 0; n < 2; ++n) o[m][bj][n] = *(const f32x4*)(rowp + bj * HALF + n * 16); }
#pragma unroll
            for (int m = 0; m < 4; ++m) { if (tok[ai * 4 + m] >= 0) { float* rowp = XF + (size_t)tok[ai * 4 + m] * 1024 + col0; const float g1 = gt[ai * 4 + m];
#pragma unroll
                for (int bj = 0; bj < 2; ++bj)
#pragma unroll
                    for (int n = 0; n < 2; ++n) *(f32x4*)(rowp + bj * HALF + n * 16) = o[m][bj][n] + acc[ai][bj][m][n] * g1; } }
        }
    }
};
struct MoeOrder {
    int T, nN, nwg, G, c; int cum[8]; size_t bstride;
    __device__ void init(const int* cnt, int nN_, int G_, int c_, size_t bstride_) {
        int t = 0;
#pragma unroll
        for (int e = 0; e < 8; ++e) { cum[e] = t; t += (cnt[e] + 255) >> 8; }
        T = t; nN = nN_; nwg = T * nN; G = G_; c = c_; bstride = bstride_;
    }
    __device__ bool next(int i, Unit& u) const {
        const long L = (long)i * G + c; if (L >= nwg) return false;
        int wgid = (int)L; { const int q = nwg / NXCD, r = nwg % NXCD, xcd = wgid % NXCD, off = wgid / NXCD; wgid = (xcd < r ? xcd * (q + 1) : r * (q + 1) + (xcd - r) * q) + off; }
        const int nig = WGM * nN, gid = wgid / nig, fm = gid * WGM, gsz = (T - fm) < WGM ? (T - fm) : WGM;
        u.pm = fm + ((wgid % nig) % gsz); u.pn = (wgid % nig) / gsz;
        int e = 0;
#pragma unroll
        for (int k = 1; k < 8; ++k) e += (u.pm >= cum[k]) ? 1 : 0;
        u.aux = e; return true;
    }
    __device__ __forceinline__ const char* aptr(const Gemm& g, const Unit& u) const { return (const char*)g.A + (size_t)u.pm * ((size_t)BM * g.K * 2); }
    __device__ __forceinline__ const char* bptr(const Gemm& g, const Unit& u) const { return (const char*)g.Bt + (size_t)u.aux * bstride + (size_t)u.pn * ((size_t)BM * g.K * 2); }
    __device__ __forceinline__ void a_ready(const Unit&) const {}
    __device__ __forceinline__ void done(const Unit&) const {}
};
}
#ifndef PG8_SP2
#define PG8_SP2 true
#endif
#ifndef PG8_ALIGN
#define PG8_ALIGN true
#endif

constexpr size_t MiB = 1u << 20;
constexpr size_t WS_CTL = 0, CTL_BYTES = 256 * 1024;
constexpr size_t WS_ROPE = 256 * 1024;
constexpr size_t WS_WIN = 1 * MiB;
constexpr size_t WS_WO = 16 * MiB;
constexpr size_t WS_WGU = 20 * MiB;
constexpr size_t WS_WD = 31 * MiB;
constexpr size_t WS_XB = 37 * MiB;
constexpr size_t WS_GAB = 69 * MiB;
constexpr size_t WS_LIST = WS_GAB + 512 * 1024;
constexpr size_t WS_GATE = WS_LIST + 1 * MiB;
constexpr size_t WS_CD = WS_GATE + 128 * 1024;
constexpr size_t WS_RWT = WS_CD + 8 * 1024;
constexpr size_t WS_WMGU = 71 * MiB, WS_WMD = 183 * MiB;
constexpr size_t WS_R = 239 * MiB;
constexpr size_t R_HP = 0, R_OB = 112 * MiB, R_U = 144 * MiB, R_WN = 160 * MiB, R_QD = 176 * MiB, R_KDT = 192 * MiB, R_QK = 208 * MiB;
constexpr size_t WS_KV = WS_XB;
constexpr size_t R_MIX = 0, R_H = 64 * MiB;
constexpr size_t R_HM = 0, R_XG = 126 * MiB, XG_PASS = 36 * MiB;
constexpr size_t WS_END = WS_R + 216 * MiB;
constexpr int CW_TMO = 0, CW_BAR = 4096, CW_MOE = 16384;

constexpr int RING_BYTES = 131072, LDS_BYTES = 147456, LDSCTL_OFF = LDS_BYTES - 512, MISC_OFF = LDSCTL_OFF + 320;

constexpr int PH_PRO = 0;
constexpr int PH_L(int l, int k) { return 1 + 16 * l + k; }
constexpr int K_IN = 0, K_PREP = 1, K_SCAN = 2, K_OUT = 3, K_LN1 = 4, K_GU = 5, K_DN = 6, K_LN2 = 7;
constexpr int K_G0 = 5, K_GU0 = 6, K_DN0 = 7, K_G1 = 8, K_GU1 = 9, K_DN1 = 10, K_LNF = 11;
constexpr int PH_END = PH_L(1, K_LNF) + 1;

struct Args { const float* in[18]; float* out; unsigned char* ws; int ph_lo, ph_hi; };
typedef const __attribute__((address_space(4))) Args* KArgs;
__device__ __forceinline__ KArgs kargs() { KArgs p = (KArgs)__builtin_amdgcn_kernarg_segment_ptr(); asm volatile("" : "+s"(p)); return p; }
__device__ __forceinline__ int tidx() { int t = threadIdx.x; asm volatile("" : "+v"(t)); return t; }

constexpr int TR_SCR = 64 * 65 * 4;
__device__ __forceinline__ void tr_item(const float* W, int N, int k0, int n0, bf16* WT, size_t ldk, int dst_row0, LAS float* scr, int lane) {
    const int nq = 4 * (lane & 15), n = n0 + nq, kr = lane >> 4;
    f32x4 v[16];
#pragma unroll
    for (int i = 0; i < 16; ++i) v[i] = (n < N) ? *(const f32x4*)(W + (size_t)(k0 + 4 * i + kr) * N + n) : (f32x4){0.f, 0.f, 0.f, 0.f};
#pragma unroll
    for (int i = 0; i < 16; ++i) { LAS float* d = scr + (4 * i + kr) * 65 + nq; d[0] = v[i].x; d[1] = v[i].y; d[2] = v[i].z; d[3] = v[i].w; }
    LDS_WAIT(); asm volatile("" ::: "memory");
    const int c = lane & 7;
#pragma unroll
    for (int j = 0; j < 8; ++j) { const int nn = (lane >> 3) + 8 * j; const LAS float* s = scr + (8 * c) * 65 + nn;
        v4u o; o.x = pk2(s[0 * 65], s[1 * 65]); o.y = pk2(s[2 * 65], s[3 * 65]); o.z = pk2(s[4 * 65], s[5 * 65]); o.w = pk2(s[6 * 65], s[7 * 65]);
        *(v4u*)(WT + (size_t)(dst_row0 + nn) * ldk + k0 + 8 * c) = o; }
    LDS_WAIT(); asm volatile("" ::: "memory");
}

constexpr int PRO_I_IN = 16 * 57, PRO_NIT = 2 * (16 * 57 + 16 * 16) + 2 * (16 * 44) + 44 * 16;
__device__ __forceinline__ void ph_prologue(KArgs a, LAS unsigned char* lds, int wave, int lane, int gw, int NGW, int gtid, int NT, int it_lo, int it_hi, bool misc) {
    unsigned char* ws = a->ws;
    LAS float* scr = (LAS float*)(lds + wave * TR_SCR);
    constexpr int I_IN = 16 * 57, I_O = 16 * 16, I_L = I_IN + I_O, I_G = 16 * 44, I_D = 44 * 16, NIT = 2 * I_L + 2 * I_G + I_D;
    static_assert(NIT == PRO_NIT && I_IN == PRO_I_IN, "prologue item counts");
    for (int it = it_lo + gw; it < it_hi; it += NGW) {
        int r = it;
        if (r < 2 * I_L) { const int l = r / I_L; r -= l * I_L;
            if (r < I_IN) { const int kb = r / 57, nb = r % 57; tr_item(a->in[1] + (size_t)l * 1024 * IN_COLS, IN_COLS, 64 * kb, 64 * nb, (bf16*)(ws + WS_WIN) + (size_t)l * NIN_PAD * 1024, 1024, 64 * nb, scr, lane); }
            else { r -= I_IN; const int kb = r / 16, nb = r % 16; tr_item(a->in[6] + (size_t)l * 1024 * 1024, 1024, 64 * kb, 64 * nb, (bf16*)(ws + WS_WO) + (size_t)l * 1024 * 1024, 1024, 64 * nb, scr, lane); }
            continue; }
        r -= 2 * I_L;
        if (r < 2 * I_G) { const int up = r / I_G; r -= up * I_G; const int kb = r / 44, nb = r % 44, n0 = 64 * nb;
            tr_item(up ? a->in[12] : a->in[11], FF, 64 * kb, n0, (bf16*)(ws + WS_WGU), 1024, 256 * (n0 >> 7) + (n0 & 127) + 128 * up, scr, lane); continue; }
        r -= 2 * I_G;
        { const int kb = r / 16, nb = r % 16; tr_item(a->in[13], 1024, 64 * kb, 64 * nb, (bf16*)(ws + WS_WD), FF, 64 * nb, scr, lane); }
    }
    if (!misc) return;
    for (int i = gtid; i < 2 * 192 * 128; i += NT) { const int l = i / (192 * 128), r = i % (192 * 128);
        ((v4u*)((bf16*)(ws + WS_WIN) + (size_t)l * NIN_PAD * 1024 + (size_t)3648 * 1024))[r] = (v4u){0u, 0u, 0u, 0u}; }
    for (int i = gtid; i < M * D / 8; i += NT) { const f32x4 p = ((const f32x4*)a->in[0])[2 * i], q = ((const f32x4*)a->in[0])[2 * i + 1];
        v4u o; o.x = pk2(p.x, p.y); o.y = pk2(p.z, p.w); o.z = pk2(q.x, q.y); o.w = pk2(q.z, q.w); ((v4u*)(ws + WS_XB))[i] = o; }
    for (int i = gtid; i < 8192; i += NT) ((float*)(ws + WS_RWT))[(i & 7) * 1024 + (i >> 3)] = a->in[14][i];
    for (int i = gtid; i < SEQ * 32; i += NT) { const int pos = i >> 5, k = i & 31;
        const float inv = powf(10000.0f, -(float)(2 * k) / 64.0f); const float ang = (float)pos * inv;
        double rev = (double)ang * 0.15915494309189535; rev -= floor(rev); const float rf = (float)rev;
        float* R = (float*)(ws + WS_ROPE) + (size_t)pos * 64; R[k] = __builtin_amdgcn_cosf(rf); R[32 + k] = __builtin_amdgcn_sinf(rf); }
}

__device__ __forceinline__ void moe_convert(KArgs a, LAS unsigned char* lds, int wave, int lane, int gw, int NGW, int e_lo, int e_hi) {
    unsigned char* ws = a->ws;
    LAS float* scr = (LAS float*)(lds + wave * TR_SCR);
    constexpr int I_G = 16 * 56, I_D = 56 * 16, I_E = 2 * I_G + I_D;
    for (int it = e_lo * I_E + gw; it < e_hi * I_E; it += NGW) {
        const int e = it / I_E; int r = it - e * I_E;
        if (r < 2 * I_G) { const int up = r / I_G; r -= up * I_G; const int kb = r / 56, nb = r % 56, n0 = 64 * nb;
            tr_item((up ? a->in[16] : a->in[15]) + (size_t)e * 1024 * FE, FE, 64 * kb, n0, (bf16*)(ws + WS_WMGU) + (size_t)e * 7168 * 1024, 1024, 256 * (n0 >> 7) + (n0 & 127) + 128 * up, scr, lane); }
        else { r -= 2 * I_G; const int kb = r / 16, nb = r % 16; tr_item(a->in[17] + (size_t)e * FE * 1024, 1024, 64 * kb, 64 * nb, (bf16*)(ws + WS_WMD) + (size_t)e * 1024 * FE, FE, 64 * nb, scr, lane); }
    }
}

template <bool ROUTE>
__device__ __forceinline__ void ln_rows(const float* res, float ares, const bf16* mix, const float* g, const float* bta, float* xf, float oscale, bf16* xb,
                                        const float* router, unsigned* cntw, int* list, float* gate, int lane, int gw, int NGW) {
    f32x4 gv[4], bv[4];
#pragma unroll
    for (int j = 0; j < 4; ++j) { gv[j] = ((const f32x4*)g)[lane + 64 * j]; bv[j] = ((const f32x4*)bta)[lane + 64 * j]; }
    for (int row = gw; row < M; row += NGW) {
        const f32x4* rr = (const f32x4*)(res + (size_t)row * D) + lane;
        f32x4 v[4]; float s = 0.f;
#pragma unroll
        for (int j = 0; j < 4; ++j) { v[j] = rr[64 * j] * ares; }
        if (mix) { const v2u* mr = (const v2u*)(mix + (size_t)row * D) + lane;
#pragma unroll
            for (int j = 0; j < 4; ++j) { const v2u m2 = mr[64 * j]; v[j] = v[j] + (f32x4){bflo(m2.x), bfhi(m2.x), bflo(m2.y), bfhi(m2.y)}; } }
#pragma unroll
        for (int j = 0; j < 4; ++j) s += (v[j].x + v[j].y) + (v[j].z + v[j].w);
        const float mean = wave_sum(s) * (1.f / D); float s2 = 0.f;
#pragma unroll
        for (int j = 0; j < 4; ++j) { v[j] = v[j] - mean; s2 += (v[j].x * v[j].x + v[j].y * v[j].y) + (v[j].z * v[j].z + v[j].w * v[j].w); }
        const float rstd = 1.f / sqrtf(wave_sum(s2) * (1.f / D) + LN_EPS);
#pragma unroll
        for (int j = 0; j < 4; ++j) v[j] = v[j] * rstd * gv[j] + bv[j];
        f32x4* xo = (f32x4*)(xf + (size_t)row * D) + lane;
#pragma unroll
        for (int j = 0; j < 4; ++j) xo[64 * j] = v[j] * oscale;
        if (xb) { v2u* bo = (v2u*)(xb + (size_t)row * D) + lane;
#pragma unroll
            for (int j = 0; j < 4; ++j) { v2u o; o.x = pk2(v[j].x, v[j].y); o.y = pk2(v[j].z, v[j].w); bo[64 * j] = o; } }
        if (ROUTE) {
            float lg[8];
#pragma unroll
            for (int e = 0; e < 8; ++e) lg[e] = 0.f;
#pragma unroll
            for (int e = 0; e < 8; ++e)
#pragma unroll
                for (int j = 0; j < 4; ++j) { const f32x4 r4 = ((const f32x4*)(router + e * 1024))[lane + 64 * j]; lg[e] += (v[j].x * r4.x + v[j].y * r4.y) + (v[j].z * r4.z + v[j].w * r4.w); }
#pragma unroll
            for (int e = 0; e < 8; ++e) lg[e] = wave_sum(lg[e]);
            if (lane == 0) {
                int e0 = 0; float v0 = lg[0];
#pragma unroll
                for (int e = 1; e < 8; ++e) if (lg[e] > v0) { v0 = lg[e]; e0 = e; }
                int e1 = -1; float v1 = -3.0e38f;
#pragma unroll
                for (int e = 0; e < 8; ++e) if (e != e0 && lg[e] > v1) { v1 = lg[e]; e1 = e; }
                const float p1 = __expf(v1 - v0), g0 = 1.f / (1.f + p1), g1 = p1 / (1.f + p1);
                const unsigned s0 = __hip_atomic_fetch_add(cntw + 64 * e0, 1u, RLX_AGENT), s1 = __hip_atomic_fetch_add(cntw + 64 * (8 + e1), 1u, RLX_AGENT);
                list[(size_t)e0 * 16384 + s0] = row; list[(size_t)(8 + e1) * 16384 + s1] = row; gate[row] = g0; gate[16384 + row] = g1;
            }
        }
    }
}

__device__ __forceinline__ void moe_gather(KArgs a, int j, int lane, int gw, int NGW) {
    unsigned char* ws = a->ws; const unsigned* cntw = (const unsigned*)(ws + WS_CTL) + CW_MOE + 64 * (j * 8);
    int pre[8], cum[8]; { int p = 0, t = 0;
#pragma unroll
        for (int e = 0; e < 8; ++e) { const int c = (int)cntw[64 * e]; pre[e] = p; cum[e] = t; p += c; t += (c + 255) >> 8; } }
    const int* list = (const int*)(ws + WS_LIST) + (size_t)j * 8 * 16384;
    for (int r0 = gw; r0 < M; r0 += 8 * NGW) {
        int tok[8], drow[8];
#pragma unroll
        for (int q = 0; q < 8; ++q) { const int r = r0 + q * NGW; tok[q] = -1; drow[q] = 0;
            if (r < M) { int e = 0;
#pragma unroll
                for (int k = 1; k < 8; ++k) e += (r >= pre[k]) ? 1 : 0;
                int pe = 0, ce = 0;
#pragma unroll
                for (int k = 0; k < 8; ++k) if (k == e) { pe = pre[k]; ce = cum[k]; }
                const int s = r - pe; tok[q] = list[(size_t)e * 16384 + s]; drow[q] = ce * 256 + s; } }
        v4u x0[8], x1[8];
#pragma unroll
        for (int q = 0; q < 8; ++q) { const v4u* src = (const v4u*)((const bf16*)(ws + WS_XB) + (size_t)(tok[q] >= 0 ? tok[q] : 0) * 1024); x0[q] = src[lane]; x1[q] = src[lane + 64]; }
#pragma unroll
        for (int q = 0; q < 8; ++q) if (tok[q] >= 0) { v4u* dst = (v4u*)((bf16*)(ws + WS_R + R_XG + (size_t)j * XG_PASS) + (size_t)drow[q] * 1024); dst[lane] = x0[q]; dst[lane + 64] = x1[q]; }
    }
}

__device__ __forceinline__ void gdn_prep_unit(KArgs a, int l, int unit, LAS unsigned char* lds, int tid, int lane, int wave) {
    unsigned char* ws = a->ws;
    const int n = unit & 31, bh = unit >> 5, h = bh & 3, b = bh >> 2;
    const int t0 = b * SEQ + n * 64;
    LAS float* Q = (LAS float*)lds; LAS float* K = Q + 8192; LAS float* V = K + 8192; LAS float* A = V + 8192; LAS float* gc = A + 4096; LAS float* bt = gc + 64;
    const bf16* HP = (const bf16*)(ws + WS_R + R_HP);
    const float* cw = a->in[2] + (size_t)l * 4 * 1536;
    __syncthreads();
    for (int idx = tid; idx < 64 * 384; idx += 512) { const int i = idx / 384, c = idx % 384, which = c >> 7, d = c & 127;
        const int col = COL_GQ + which * 512 + h * 128 + d, cc = which * 512 + h * 128 + d; float acc = 0.f;
#pragma unroll
        for (int j = 0; j < 4; ++j) { const int s = n * 64 + i - 3 + j; if (s >= 0) acc += cw[j * 1536 + cc] * bf2f(HP[(size_t)(b * SEQ + s) * HP_LD + col]); }
        const float y = siluf(acc); LAS float* dst = which == 0 ? Q : (which == 1 ? K : V); dst[i * 128 + d] = y; }
    if (tid < 64) { const float* gab = (const float*)(ws + WS_GAB) + (size_t)(t0 + tid) * 8; const float x = gab[h] + a->in[4][l * 4 + h];
        const float sp = fmaxf(x, 0.f) + log1pf(__expf(-fabsf(x))); gc[tid] = -__expf(a->in[3][l * 4 + h]) * sp; bt[tid] = sigmf(gab[4 + h]); }
    __syncthreads();
#pragma unroll 1
    for (int r = 0; r < 8; ++r) { const int i = wave * 8 + r;
        float q0 = Q[i * 128 + lane], q1 = Q[i * 128 + lane + 64], k0 = K[i * 128 + lane], k1 = K[i * 128 + lane + 64];
        const float sq = wave_sum(q0 * q0 + q1 * q1), sk = wave_sum(k0 * k0 + k1 * k1);
        const float fq = rsqrtf(sq + NORM_EPS) * 0.08838834764831845f, fk = rsqrtf(sk + NORM_EPS);
        Q[i * 128 + lane] = q0 * fq; Q[i * 128 + lane + 64] = q1 * fq; K[i * 128 + lane] = k0 * fk; K[i * 128 + lane + 64] = k1 * fk; }
    if (tid == 0) { float c = 0.f; for (int i = 0; i < 64; ++i) { c += gc[i]; gc[i] = c; } }
    __syncthreads();
    bf16* QKg = (bf16*)(ws + WS_R + R_QK) + (size_t)unit * 4096; bf16* QDg = (bf16*)(ws + WS_R + R_QD) + (size_t)unit * 8192; bf16* KDTg = (bf16*)(ws + WS_R + R_KDT) + (size_t)unit * 8192;
    bf16* WNg = (bf16*)(ws + WS_R + R_WN) + (size_t)unit * 8192; bf16* Ug = (bf16*)(ws + WS_R + R_U) + (size_t)unit * 8192;
    for (int idx = tid; idx < 4096; idx += 512) { const int i = idx >> 6, j = idx & 63; float dqk = 0.f, dkk = 0.f;
        for (int dd = 0; dd < 128; ++dd) { const int d = (dd + j) & 127; const float kj = K[j * 128 + d]; dqk += Q[i * 128 + d] * kj; dkk += K[i * 128 + d] * kj; }
        const float dec = __expf(gc[i] - gc[j]);
        A[i * 64 + j] = (j < i) ? bt[i] * dkk * dec : 0.f;
        QKg[fragoff(i, j, 2)] = (bf16)f2bf((j <= i) ? dqk * dec : 0.f); }
    const float gl = gc[63];
    for (int idx = tid; idx < 8192; idx += 512) { const int i = idx >> 7, d = idx & 127;
        QDg[fragoff(i, d, 4)] = (bf16)f2bf(Q[i * 128 + d] * __expf(gc[i]));
        KDTg[fragoff(d, i, 2)] = (bf16)f2bf(K[i * 128 + d] * __expf(gl - gc[i])); }
    if (tid == 0) ((float*)(ws + WS_CD))[unit] = __expf(gl);
    __syncthreads();
    for (int idx = tid; idx < 8192; idx += 512) { const int i = idx >> 7; const float bi = bt[i]; V[idx] *= bi; Q[idx] = bi * __expf(gc[i]) * K[idx]; }
    __syncthreads();
    if (tid < 256) { LAS float* buf = (tid < 128 ? V : Q) + (tid & 127);
        for (int i = 1; i < 64; ++i) { float acc = buf[i * 128]; for (int m = 0; m < i; ++m) acc -= A[i * 64 + m] * buf[m * 128]; buf[i * 128] = acc; } }
    __syncthreads();
    for (int idx = tid; idx < 8192; idx += 512) { const int i = idx >> 7, d = idx & 127; Ug[uoff(i, d)] = (bf16)f2bf(V[idx]); WNg[fragoff(i, d, 4)] = (bf16)f2bf(-Q[idx]); }
}

__device__ __forceinline__ void gdn_scan_naive(KArgs a, int l, int bh, LAS unsigned char* lds, int tid, int lane, int wave) {
    unsigned char* ws = a->ws;
    LAS float* S = (LAS float*)lds; LAS float* VN = S + 16384; LAS float* O = VN + 8192;
    const int h = bh & 3, b = bh >> 2, e = tid & 127, ig = tid >> 7;
    const bf16* HP = (const bf16*)(ws + WS_R + R_HP); bf16* OB = (bf16*)(ws + WS_R + R_OB);
    const float* nw = a->in[5] + l * 128;
    __syncthreads();
    for (int idx = tid; idx < 16384; idx += 512) S[idx] = 0.f;
    __syncthreads();
#pragma unroll 1
    for (int n = 0; n < 32; ++n) {
        const int unit = bh * 32 + n;
        const bf16* Ug = (const bf16*)(ws + WS_R + R_U) + (size_t)unit * 8192; const bf16* WNg = (const bf16*)(ws + WS_R + R_WN) + (size_t)unit * 8192;
        const bf16* QDg = (const bf16*)(ws + WS_R + R_QD) + (size_t)unit * 8192; const bf16* KDTg = (const bf16*)(ws + WS_R + R_KDT) + (size_t)unit * 8192;
        const bf16* QKg = (const bf16*)(ws + WS_R + R_QK) + (size_t)unit * 4096; const float cd = ((const float*)(ws + WS_CD))[unit];
#pragma unroll 1
        for (int r = 0; r < 16; ++r) { const int i = ig + 4 * r; float acc = bf2f(Ug[uoff(i, e)]);
#pragma unroll 2
            for (int d0 = 0; d0 < 128; d0 += 4) { const v2u w = *(const v2u*)(WNg + fragoff(i, d0, 4));
                acc += bflo(w.x) * S[d0 * 128 + e] + bfhi(w.x) * S[(d0 + 1) * 128 + e] + bflo(w.y) * S[(d0 + 2) * 128 + e] + bfhi(w.y) * S[(d0 + 3) * 128 + e]; }
            VN[i * 128 + e] = acc; }
        __syncthreads();
#pragma unroll 1
        for (int r = 0; r < 16; ++r) { const int i = ig + 4 * r; float acc = 0.f;
#pragma unroll 2
            for (int d0 = 0; d0 < 128; d0 += 4) { const v2u w = *(const v2u*)(QDg + fragoff(i, d0, 4));
                acc += bflo(w.x) * S[d0 * 128 + e] + bfhi(w.x) * S[(d0 + 1) * 128 + e] + bflo(w.y) * S[(d0 + 2) * 128 + e] + bfhi(w.y) * S[(d0 + 3) * 128 + e]; }
#pragma unroll 2
            for (int j0 = 0; j0 < 64; j0 += 4) { const v2u w = *(const v2u*)(QKg + fragoff(i, j0, 2));
                acc += bflo(w.x) * VN[j0 * 128 + e] + bfhi(w.x) * VN[(j0 + 1) * 128 + e] + bflo(w.y) * VN[(j0 + 2) * 128 + e] + bfhi(w.y) * VN[(j0 + 3) * 128 + e]; }
            O[i * 128 + e] = acc; }
        __syncthreads();
#pragma unroll 1
        for (int r = 0; r < 32; ++r) { const int d = ig + 4 * r; float acc = S[d * 128 + e] * cd;
#pragma unroll 2
            for (int i0 = 0; i0 < 64; i0 += 4) { const v2u w = *(const v2u*)(KDTg + fragoff(d, i0, 2));
                acc += bflo(w.x) * VN[i0 * 128 + e] + bfhi(w.x) * VN[(i0 + 1) * 128 + e] + bflo(w.y) * VN[(i0 + 2) * 128 + e] + bfhi(w.y) * VN[(i0 + 3) * 128 + e]; }
            S[d * 128 + e] = acc; }
#pragma unroll 1
        for (int r = 0; r < 8; ++r) { const int i = wave * 8 + r; const float v0 = O[i * 128 + lane], v1 = O[i * 128 + lane + 64];
            const float rs = rsqrtf(wave_sum(v0 * v0 + v1 * v1) * (1.f / 128.f) + NORM_EPS);
            const size_t t = (size_t)b * SEQ + n * 64 + i; const bf16* gp = HP + t * HP_LD + COL_GG + h * 128; bf16* op = OB + t * 1024 + 512 + h * 128;
            op[lane] = (bf16)f2bf(v0 * rs * nw[lane] * siluf(bf2f(gp[lane]))); op[lane + 64] = (bf16)f2bf(v1 * rs * nw[lane + 64] * siluf(bf2f(gp[lane + 64]))); }
        __syncthreads();
    }
}

__device__ __forceinline__ void ret_unit_naive(KArgs a, int unit, LAS unsigned char* lds, int tid, int lane, int wave) {
    unsigned char* ws = a->ws;
    LAS float* Qs = (LAS float*)lds; LAS float* Ks = Qs + 64 * 65; LAS float* Vs = Ks + 64 * 65; LAS float* Sc = Vs + 8192;
    const int qb = unit & 31, bh = unit >> 5, h = bh & 3, b = bh >> 2, e = tid & 127, ig = tid >> 7;
    const bf16* HP = (const bf16*)(ws + WS_R + R_HP); bf16* OB = (bf16*)(ws + WS_R + R_OB); const float* RT = (const float*)(ws + WS_ROPE);
    const float log2g = log2f(1.0f - exp2f(-5.0f - (float)h));
    __syncthreads();
    for (int idx = tid; idx < 4096; idx += 512) { const int i = idx >> 6, d = idx & 63, dd = d & 31, pos = qb * 64 + i; const size_t t = (size_t)b * SEQ + pos;
        const float c = RT[pos * 64 + dd], s = RT[pos * 64 + 32 + dd]; const float x1 = bf2f(HP[t * HP_LD + COL_RQ + h * 64 + dd]), x2 = bf2f(HP[t * HP_LD + COL_RQ + h * 64 + dd + 32]);
        Qs[i * 65 + d] = d < 32 ? x1 * c - x2 * s : x1 * s + x2 * c; }
    float acc[16];
#pragma unroll
    for (int r = 0; r < 16; ++r) acc[r] = 0.f;
#pragma unroll 1
    for (int kb = 0; kb <= qb; ++kb) {
        __syncthreads();
        for (int idx = tid; idx < 4096; idx += 512) { const int i = idx >> 6, d = idx & 63, dd = d & 31, pos = kb * 64 + i; const size_t t = (size_t)b * SEQ + pos;
            const float c = RT[pos * 64 + dd], s = RT[pos * 64 + 32 + dd]; const float x1 = bf2f(HP[t * HP_LD + COL_RK + h * 64 + dd]), x2 = bf2f(HP[t * HP_LD + COL_RK + h * 64 + dd + 32]);
            Ks[i * 65 + d] = 0.125f * (d < 32 ? x1 * c - x2 * s : x1 * s + x2 * c); }
        for (int idx = tid; idx < 8192; idx += 512) { const int i = idx >> 7, d = idx & 127; Vs[idx] = bf2f(HP[((size_t)b * SEQ + kb * 64 + i) * HP_LD + COL_RV + h * 128 + d]); }
        __syncthreads();
        { const int j = tid & 63, ig8 = tid >> 6;
#pragma unroll 1
          for (int r = 0; r < 8; ++r) { const int i = ig8 + 8 * r; float dot = 0.f;
#pragma unroll 8
              for (int d = 0; d < 64; ++d) dot += Qs[i * 65 + d] * Ks[j * 65 + d];
              const int delta = (qb - kb) * 64 + i - j; Sc[i * 65 + j] = delta >= 0 ? dot * exp2f((float)delta * log2g) : 0.f; } }
        __syncthreads();
#pragma unroll 2
        for (int j = 0; j < 64; ++j) { const float vv = Vs[j * 128 + e];
#pragma unroll
            for (int r = 0; r < 16; ++r) acc[r] += Sc[(ig + 4 * r) * 65 + j] * vv; }
    }
    __syncthreads();
#pragma unroll
    for (int r = 0; r < 16; ++r) Vs[(ig + 4 * r) * 128 + e] = acc[r];
    __syncthreads();
#pragma unroll 1
    for (int r = 0; r < 8; ++r) { const int i = wave * 8 + r; const float v0 = Vs[i * 128 + lane], v1 = Vs[i * 128 + lane + 64];
        const float mean = wave_sum(v0 + v1) * (1.f / 128.f), d0 = v0 - mean, d1 = v1 - mean; const float rs = rsqrtf(wave_sum(d0 * d0 + d1 * d1) * (1.f / 128.f) + LN_EPS);
        const size_t t = (size_t)b * SEQ + qb * 64 + i; const bf16* gp = HP + t * HP_LD + COL_RG + h * 128; bf16* op = OB + t * 1024 + h * 128;
        op[lane] = (bf16)f2bf(d0 * rs * siluf(bf2f(gp[lane]))); op[lane + 64] = (bf16)f2bf(d1 * rs * siluf(bf2f(gp[lane + 64]))); }
}

typedef float f32x16 __attribute__((ext_vector_type(16)));
typedef float f32x8 __attribute__((ext_vector_type(8)));
typedef __bf16 bf8v __attribute__((ext_vector_type(8)));
typedef short bf16x8 __attribute__((ext_vector_type(8)));
#define MFMA32(a, b, c) __builtin_amdgcn_mfma_f32_32x32x16_bf16((a), (b), (c), 0, 0, 0)
__device__ __forceinline__ bf16x8 pack8(const f32x16& x, int s) {
    f32x8 v;
#pragma unroll
    for (int j = 0; j < 8; ++j) v[j] = x[8 * s + j];
    return __builtin_bit_cast(bf16x8, __builtin_convertvector(v, bf8v));
}

__device__ __forceinline__ unsigned short bfc(float x) { return __builtin_bit_cast(unsigned short, (__bf16)x); }
__device__ __forceinline__ unsigned bfc2(float lo, float hi) { return (unsigned)bfc(lo) | ((unsigned)bfc(hi) << 16); }

#define GDN_BAR() do { asm volatile("s_waitcnt lgkmcnt(0)" ::: "memory"); __builtin_amdgcn_s_barrier(); asm volatile("" ::: "memory"); } while (0)
__device__ __forceinline__ void gdn_scan_fast(KArgs a, int l, int bh, LAS unsigned char* lds, int tid, int lane, int wave) {
    unsigned char* ws = a->ws;
    constexpr int FB_WN = 0, FB_QD = 16384, FB_KDT = 32768, FB_QK = 49152, FB_U = 57344, FB_BYTES = 73728;
    LAS float* OL = (LAS float*)(lds + FB_BYTES);
    constexpr int OLS = 64 * 132;
    const int h = bh & 3, b = bh >> 2, c = lane & 31, hh = lane >> 5;
    const bf16* HP = (const bf16*)(ws + WS_R + R_HP); bf16* OB = (bf16*)(ws + WS_R + R_OB);
    const float* nw = a->in[5] + l * 128;
    const unsigned char* gWN = (const unsigned char*)(ws + WS_R + R_WN) + (size_t)bh * 32 * 16384; const unsigned char* gQD = (const unsigned char*)(ws + WS_R + R_QD) + (size_t)bh * 32 * 16384;
    const unsigned char* gKDT = (const unsigned char*)(ws + WS_R + R_KDT) + (size_t)bh * 32 * 16384; const unsigned char* gQK = (const unsigned char*)(ws + WS_R + R_QK) + (size_t)bh * 32 * 8192;
    const unsigned char* gU = (const unsigned char*)(ws + WS_R + R_U) + (size_t)bh * 32 * 16384;
    const int et = tid - 256;
#define GDN_FETCH(pf, nn) do { _Pragma("unroll") for (int k = 0; k < 18; ++k) { const unsigned char* src_ = k < 4 ? gWN + (size_t)(nn) * 16384 + k * 4096 : k < 8 ? gQD + (size_t)(nn) * 16384 + (k - 4) * 4096 : \
        k < 12 ? gKDT + (size_t)(nn) * 16384 + (k - 8) * 4096 : k < 14 ? gQK + (size_t)(nn) * 8192 + (k - 12) * 4096 : gU + (size_t)(nn) * 16384 + (k - 14) * 4096; pf[k] = *(const v4u*)(src_ + et * 16); } } while (0)
#define GDN_STORE(pf) do { _Pragma("unroll") for (int k = 0; k < 18; ++k) *(LAS v4u*)(lds + k * 4096 + et * 16) = pf[k]; } while (0)
    __syncthreads();
    if (wave < 4) {
        f32x16 S[4];
#pragma unroll
        for (int t = 0; t < 4; ++t)
#pragma unroll
            for (int i = 0; i < 16; ++i) S[t][i] = 0.f;
        GDN_BAR();
        const int q = wave;
        const LAS bf16x8* WNf = (const LAS bf16x8*)(lds + FB_WN) + lane; const LAS bf16x8* QDf = (const LAS bf16x8*)(lds + FB_QD) + lane;
        const LAS bf16x8* KDTf = (const LAS bf16x8*)(lds + FB_KDT) + lane; const LAS bf16x8* QKf = (const LAS bf16x8*)(lds + FB_QK) + lane;
        const LAS v4u* Uf = (const LAS v4u*)(lds + FB_U) + (q * 2) * 128 + lane;
#pragma unroll 1
        for (int n = 0; n < 32; ++n) {
            const float cd = ((const float*)(ws + WS_CD))[bh * 32 + n];
            bf16x8 A0[8], A1[8];
#define GDN_LD_MTS(A, F, g) do { _Pragma("unroll") for (int k = 0; k < 8; ++k) { const int m_ = k & 1, s_ = (k >> 1) & 1, t_ = 2 * (g) + (k >> 2); A[k] = F[((m_ * 4 + t_) * 2 + s_) * 64]; } } while (0)
#define GDN_LD_TMS(A, F, g) do { _Pragma("unroll") for (int k = 0; k < 8; ++k) { const int s_ = k & 1, m_ = (k >> 1) & 1, t_ = 2 * (g) + (k >> 2); A[k] = F[((t_ * 2 + m_) * 2 + s_) * 64]; } } while (0)
            GDN_LD_MTS(A0, WNf, 0); GDN_LD_MTS(A1, WNf, 1);
            f32x16 av[2];
#pragma unroll
            for (int m = 0; m < 2; ++m)
#pragma unroll
                for (int hf = 0; hf < 2; ++hf) { const v4u u4 = Uf[(m * 2 + hf) * 64];
#pragma unroll
                    for (int k = 0; k < 4; ++k) { av[m][8 * hf + 2 * k] = bflo(u4[k]); av[m][8 * hf + 2 * k + 1] = bfhi(u4[k]); } }
            bf16x8 Sb[4][2];
#pragma unroll
            for (int t = 0; t < 4; ++t) { Sb[t][0] = pack8(S[t], 0); Sb[t][1] = pack8(S[t], 1); }
#pragma unroll
            for (int k = 0; k < 8; ++k) { const int m_ = k & 1, s_ = (k >> 1) & 1, t_ = (k >> 2); av[m_] = MFMA32(A0[k], Sb[t_][s_], av[m_]); }
            GDN_LD_MTS(A0, QDf, 0);
#pragma unroll
            for (int k = 0; k < 8; ++k) { const int m_ = k & 1, s_ = (k >> 1) & 1, t_ = 2 + (k >> 2); av[m_] = MFMA32(A1[k], Sb[t_][s_], av[m_]); }
            GDN_LD_MTS(A1, QDf, 1);
            f32x16 ao[2];
#pragma unroll
            for (int m = 0; m < 2; ++m)
#pragma unroll
                for (int i = 0; i < 16; ++i) ao[m][i] = 0.f;
#pragma unroll
            for (int k = 0; k < 8; ++k) { const int m_ = k & 1, s_ = (k >> 1) & 1, t_ = (k >> 2); ao[m_] = MFMA32(A0[k], Sb[t_][s_], ao[m_]); }
#pragma unroll
            for (int k = 0; k < 6; ++k) { const int s_ = k & 1, m_ = k >= 2 ? 1 : 0, mp_ = k >= 4 ? 1 : 0; A0[k] = QKf[((m_ * 2 + mp_) * 2 + s_) * 64]; }
#pragma unroll
            for (int k = 0; k < 8; ++k) { const int m_ = k & 1, s_ = (k >> 1) & 1, t_ = 2 + (k >> 2); ao[m_] = MFMA32(A1[k], Sb[t_][s_], ao[m_]); }
            GDN_LD_TMS(A1, KDTf, 0);
            bf16x8 Vb[2][2];
#pragma unroll
            for (int m = 0; m < 2; ++m) { Vb[m][0] = pack8(av[m], 0); Vb[m][1] = pack8(av[m], 1); }
#pragma unroll
            for (int k = 0; k < 6; ++k) { const int s_ = k & 1, m_ = k >= 2 ? 1 : 0, mp_ = k >= 4 ? 1 : 0; ao[m_] = MFMA32(A0[k], Vb[mp_][s_], ao[m_]); }
            GDN_LD_TMS(A0, KDTf, 1);
            {   LAS float* Ob = OL + (n & 1) * OLS + 32 * wave + c;
#pragma unroll
                for (int m = 0; m < 2; ++m)
#pragma unroll
                    for (int i = 0; i < 16; ++i) Ob[(32 * m + (i & 3) + 8 * (i >> 2) + 4 * hh) * 132] = ao[m][i]; }
#pragma unroll
            for (int t = 0; t < 4; ++t)
#pragma unroll
                for (int i = 0; i < 16; ++i) S[t][i] *= cd;
#pragma unroll
            for (int k = 0; k < 8; ++k) { const int s_ = k & 1, m_ = (k >> 1) & 1, t_ = (k >> 2); S[t_] = MFMA32(A1[k], Vb[m_][s_], S[t_]); }
#pragma unroll
            for (int k = 0; k < 8; ++k) { const int s_ = k & 1, m_ = (k >> 1) & 1, t_ = 2 + (k >> 2); S[t_] = MFMA32(A0[k], Vb[m_][s_], S[t_]); }
#undef GDN_LD_MTS
#undef GDN_LD_TMS
            GDN_BAR();
            GDN_BAR();
        }
        GDN_BAR(); GDN_BAR();
    } else {
        v4u pfA[18], pfB[18];
        LAS float* NWl = OL + 2 * OLS;
        if (et < 128) NWl[et] = nw[et];
        GDN_FETCH(pfB, 0); GDN_FETCH(pfA, 1); GDN_STORE(pfB);
        GDN_BAR();
        const int i = et >> 2, qd = et & 3;
#define GDN_LOADER_ITER(n, PF_FETCH, PF_STORE) do { \
            if ((n) + 2 < 32) GDN_FETCH(PF_FETCH, (n) + 2); \
            if ((n) > 0) { \
                const LAS float* Ob = OL + (((n) - 1) & 1) * OLS + i * 132 + 32 * qd; \
                float ss = 0.f; \
                _Pragma("unroll") for (int k = 0; k < 8; ++k) { const f32x4 v_ = *(const LAS f32x4*)(Ob + 4 * k); ss += (v_.x * v_.x + v_.y * v_.y) + (v_.z * v_.z + v_.w * v_.w); } \
                ss += __shfl_xor(ss, 1); ss += __shfl_xor(ss, 2); \
                const float rs = rsqrtf(ss * (1.f / 128.f) + NORM_EPS); \
                bf16* op = OB + ((size_t)b * SEQ + ((n) - 1) * 64 + i) * 1024 + 512 + h * 128 + 32 * qd; \
                _Pragma("unroll") for (int k = 0; k < 4; ++k) { const f32x4 w0 = *(const LAS f32x4*)(NWl + 32 * qd + 8 * k), w1 = *(const LAS f32x4*)(NWl + 32 * qd + 8 * k + 4); const v4u gg = gq[k]; \
                    const f32x4 a0 = *(const LAS f32x4*)(Ob + 8 * k), a1 = *(const LAS f32x4*)(Ob + 8 * k + 4); \
                    v4u o; o.x = bfc2(a0.x * rs * w0.x * siluf(bflo(gg.x)), a0.y * rs * w0.y * siluf(bfhi(gg.x))); o.y = bfc2(a0.z * rs * w0.z * siluf(bflo(gg.y)), a0.w * rs * w0.w * siluf(bfhi(gg.y))); \
                    o.z = bfc2(a1.x * rs * w1.x * siluf(bflo(gg.z)), a1.y * rs * w1.y * siluf(bfhi(gg.z))); o.w = bfc2(a1.z * rs * w1.z * siluf(bflo(gg.w)), a1.w * rs * w1.w * siluf(bfhi(gg.w))); \
                    *(v4u*)(op + 8 * k) = o; } \
            } \
            asm volatile("" ::: "memory"); \
            if ((n) < 32) { const bf16* gp = HP + ((size_t)b * SEQ + (n) * 64 + i) * HP_LD + COL_GG + h * 128 + 32 * qd;     \
                _Pragma("unroll") for (int k = 0; k < 4; ++k) gq[k] = *(const v4u*)(gp + 8 * k); } \
            GDN_BAR();            \
            if ((n) + 1 < 32) GDN_STORE(PF_STORE); \
            GDN_BAR();            \
        } while (0)
        v4u gq[4];
#pragma unroll
        for (int k = 0; k < 4; ++k) gq[k] = (v4u){0u, 0u, 0u, 0u};
#pragma unroll
        for (int n = 0; n < 32; n += 2) {
            GDN_LOADER_ITER(n, pfB, pfA);
            GDN_LOADER_ITER(n + 1, pfA, pfB);
        }
        GDN_LOADER_ITER(32, pfB, pfA);
#undef GDN_LOADER_ITER
    }
#undef GDN_FETCH
#undef GDN_STORE
}

struct RetLds {
    static constexpr int QS = 72, JS = 136;
    static constexpr int P = 0, Q1 = 34816, K1 = 53248, OL = 0, K1T = 71680, VT = 89088, ST = 123904;
};
template <bool WANT_Q, bool WANT_K1, bool WANT_K1T>
__device__ __forceinline__ void ret_stage(const bf16* HP, const float* RT, int b, int h, int n, float lg, LAS unsigned char* lds, int tid) {
    constexpr int QS = RetLds::QS, JS = RetLds::JS;
    LAS bf16* Q1 = (LAS bf16*)(lds + RetLds::Q1); LAS bf16* K1 = (LAS bf16*)(lds + RetLds::K1); LAS bf16* K1T = (LAS bf16*)(lds + RetLds::K1T); LAS bf16* VT = (LAS bf16*)(lds + RetLds::VT);
    const int i = tid >> 2, dd = (tid & 3) * 8, pos = n * 128 + i; const size_t t = (size_t)b * SEQ + pos;
    const bf16* hp = HP + t * HP_LD;
    const f32x4 c0 = *(const f32x4*)(RT + pos * 64 + dd), c1 = *(const f32x4*)(RT + pos * 64 + dd + 4), s0 = *(const f32x4*)(RT + pos * 64 + 32 + dd), s1 = *(const f32x4*)(RT + pos * 64 + 32 + dd + 4);
    const float cs[8] = {c0.x, c0.y, c0.z, c0.w, c1.x, c1.y, c1.z, c1.w}, sn[8] = {s0.x, s0.y, s0.z, s0.w, s1.x, s1.y, s1.z, s1.w};
    const float sq = exp2f((float)i * lg), sk = 0.125f * exp2f(-(float)i * lg);
    v4u xv[4];
#pragma unroll
    for (int p = 0; p < 4; ++p) { const int idx = tid + 512 * p, j = idx >> 4, e0 = (idx & 15) * 8; xv[p] = *(const v4u*)(HP + ((size_t)b * SEQ + n * 128 + j) * HP_LD + COL_RV + h * 128 + e0); }
#pragma unroll
    for (int which = (WANT_Q ? 0 : 1); which < 2; ++which) {
        const bf16* src = hp + (which == 0 ? COL_RQ : COL_RK) + h * 64 + dd;
        const v4u x1 = *(const v4u*)src, x2 = *(const v4u*)(src + 32);
        const float sc = which == 0 ? sq : sk;
        float lo[8], hi[8];
#pragma unroll
        for (int k = 0; k < 4; ++k) { const float a0 = bflo(x1[k]), a1 = bfhi(x1[k]), b0 = bflo(x2[k]), b1 = bfhi(x2[k]);
            lo[2 * k] = (a0 * cs[2 * k] - b0 * sn[2 * k]) * sc; lo[2 * k + 1] = (a1 * cs[2 * k + 1] - b1 * sn[2 * k + 1]) * sc;
            hi[2 * k] = (a0 * sn[2 * k] + b0 * cs[2 * k]) * sc; hi[2 * k + 1] = (a1 * sn[2 * k + 1] + b1 * cs[2 * k + 1]) * sc; }
        v4u wl, wh;
#pragma unroll
        for (int k = 0; k < 4; ++k) { wl[k] = bfc2(lo[2 * k], lo[2 * k + 1]); wh[k] = bfc2(hi[2 * k], hi[2 * k + 1]); }
        if (which == 0 || WANT_K1) { LAS bf16* dst = (which == 0 ? Q1 : K1) + i * QS + dd; *(LAS v4u*)dst = wl; *(LAS v4u*)(dst + 32) = wh; }
        if (which == 1 && WANT_K1T) {
#pragma unroll
            for (int k = 0; k < 4; ++k) { K1T[(dd + 2 * k) * JS + i] = (bf16)(wl[k] & 0xffffu); K1T[(dd + 2 * k + 1) * JS + i] = (bf16)(wl[k] >> 16);
                K1T[(32 + dd + 2 * k) * JS + i] = (bf16)(wh[k] & 0xffffu); K1T[(32 + dd + 2 * k + 1) * JS + i] = (bf16)(wh[k] >> 16); }
        }
    }
#pragma unroll
    for (int p = 0; p < 4; ++p) { const int idx = tid + 512 * p, j = idx >> 4, e0 = (idx & 15) * 8;
#pragma unroll
        for (int k = 0; k < 4; ++k) { VT[(e0 + 2 * k) * JS + j] = (bf16)(xv[p][k] & 0xffffu); VT[(e0 + 2 * k + 1) * JS + j] = (bf16)(xv[p][k] >> 16); } }
}
__device__ __forceinline__ void ret_kv_unit(KArgs a, int unit, LAS unsigned char* lds, int tid, int lane, int wave) {
    unsigned char* ws = a->ws;
    constexpr int JS = RetLds::JS;
    const int n = unit & 15, bh = unit >> 4, h = bh & 3, b = bh >> 2, c = lane & 31, hh = lane >> 5;
    const bf16* HP = (const bf16*)(ws + WS_R + R_HP); const float* RT = (const float*)(ws + WS_ROPE);
    const float gam = 1.0f - exp2f(-5.0f - (float)h), lg = log2f(gam), g127 = exp2f(127.f * lg);
    LAS bf16* K1T = (LAS bf16*)(lds + RetLds::K1T); LAS bf16* VT = (LAS bf16*)(lds + RetLds::VT);
    __syncthreads();
    ret_stage<false, false, true>(HP, RT, b, h, n, lg, lds, tid);
    __syncthreads();
    const int td = wave >> 2, te = wave & 3;
    f32x16 kv;
#pragma unroll
    for (int i = 0; i < 16; ++i) kv[i] = 0.f;
#pragma unroll
    for (int ks = 0; ks < 8; ++ks) kv = MFMA32(*(const LAS bf16x8*)(K1T + (32 * td + c) * JS + 16 * ks + 8 * hh), *(const LAS bf16x8*)(VT + (32 * te + c) * JS + 16 * ks + 8 * hh), kv);
    float* dst = (float*)(ws + WS_KV) + ((size_t)(unit * 8 + wave) * 64 + lane) * 16;
#pragma unroll
    for (int g = 0; g < 4; ++g) *(f32x4*)(dst + 4 * g) = (f32x4){kv[4 * g] * g127, kv[4 * g + 1] * g127, kv[4 * g + 2] * g127, kv[4 * g + 3] * g127};
}
__device__ __forceinline__ void ret_out_unit(KArgs a, int unit, LAS unsigned char* lds, int tid, int lane, int wave) {
    unsigned char* ws = a->ws;
    constexpr int QS = RetLds::QS, JS = RetLds::JS;
    LAS bf16* P = (LAS bf16*)(lds + RetLds::P); LAS bf16* Q1 = (LAS bf16*)(lds + RetLds::Q1); LAS bf16* K1 = (LAS bf16*)(lds + RetLds::K1); LAS float* OL = (LAS float*)(lds + RetLds::OL);
    LAS bf16* VT = (LAS bf16*)(lds + RetLds::VT); LAS bf16* ST = (LAS bf16*)(lds + RetLds::ST);
    const int n = unit & 15, bh = unit >> 4, h = bh & 3, b = bh >> 2, c = lane & 31, hh = lane >> 5;
    const bf16* HP = (const bf16*)(ws + WS_R + R_HP); bf16* OB = (bf16*)(ws + WS_R + R_OB); const float* RT = (const float*)(ws + WS_ROPE);
    const float gam = 1.0f - exp2f(-5.0f - (float)h), lg = log2f(gam), g128 = exp2f(128.f * lg);
    __syncthreads();
    const int ei = tid >> 2, eq = tid & 3; const size_t et = (size_t)b * SEQ + n * 128 + ei;
    v4u gg[4];
    { const bf16* gp = HP + et * HP_LD + COL_RG + h * 128 + 32 * eq;
#pragma unroll
      for (int k = 0; k < 4; ++k) gg[k] = *(const v4u*)(gp + 8 * k); }
    {
        const int td = wave >> 2, te = wave & 3;
        f32x16 S;
#pragma unroll
        for (int i = 0; i < 16; ++i) S[i] = 0.f;
        const float* src = (const float*)(ws + WS_KV) + ((size_t)((bh * 16) * 8 + wave) * 64 + lane) * 16;
#pragma unroll 2
        for (int m = 0; m < n; ++m) { const f32x4* p4 = (const f32x4*)(src + (size_t)m * 8 * 64 * 16);
#pragma unroll
            for (int g = 0; g < 4; ++g) { const f32x4 v = p4[g]; S[4 * g] = S[4 * g] * g128 + v.x; S[4 * g + 1] = S[4 * g + 1] * g128 + v.y; S[4 * g + 2] = S[4 * g + 2] * g128 + v.z; S[4 * g + 3] = S[4 * g + 3] * g128 + v.w; } }
#pragma unroll
        for (int g = 0; g < 4; ++g) { v2u w; w.x = bfc2(S[4 * g], S[4 * g + 1]); w.y = bfc2(S[4 * g + 2], S[4 * g + 3]); *(LAS v2u*)(ST + (32 * te + c) * QS + 32 * td + 8 * g + 4 * hh) = w; }
    }
    ret_stage<true, true, false>(HP, RT, b, h, n, lg, lds, tid);
    __syncthreads();
#pragma unroll 1
    for (int rep = 0; rep < 2; ++rep) { const int idx = wave + 8 * rep;
        if (idx < 10) { const int ti = (idx >= 1) + (idx >= 3) + (idx >= 6), tj = idx - ti * (ti + 1) / 2;
            f32x16 acc;
#pragma unroll
            for (int i = 0; i < 16; ++i) acc[i] = 0.f;
#pragma unroll
            for (int s2 = 0; s2 < 4; ++s2) acc = MFMA32(*(const LAS bf16x8*)(Q1 + (32 * ti + c) * QS + 16 * s2 + 8 * hh), *(const LAS bf16x8*)(K1 + (32 * tj + c) * QS + 16 * s2 + 8 * hh), acc);
#pragma unroll
            for (int i = 0; i < 16; ++i) { const int il = (i & 3) + 8 * (i >> 2) + 4 * hh; float v = acc[i]; if (ti == tj && il < c) v = 0.f; P[(32 * ti + il) * JS + 32 * tj + c] = bfc(v); } } }
    __syncthreads();
    const int ti = wave >> 1, te0 = 2 * (wave & 1);
    f32x16 ao[2];
#pragma unroll
    for (int u = 0; u < 2; ++u)
#pragma unroll
        for (int i = 0; i < 16; ++i) ao[u][i] = 0.f;
#pragma unroll
    for (int s2 = 0; s2 < 4; ++s2) { const bf16x8 A = *(const LAS bf16x8*)(Q1 + (32 * ti + c) * QS + 16 * s2 + 8 * hh);
#pragma unroll
        for (int u = 0; u < 2; ++u) ao[u] = MFMA32(A, *(const LAS bf16x8*)(ST + (32 * (te0 + u) + c) * QS + 16 * s2 + 8 * hh), ao[u]); }
#pragma unroll
    for (int u = 0; u < 2; ++u)
#pragma unroll
        for (int i = 0; i < 16; ++i) ao[u][i] *= gam;
#pragma unroll 1
    for (int tj = 0; tj <= ti; ++tj)
#pragma unroll
        for (int s2 = 0; s2 < 2; ++s2) { const bf16x8 A = *(const LAS bf16x8*)(P + (32 * ti + c) * JS + 32 * tj + 16 * s2 + 8 * hh);
#pragma unroll
            for (int u = 0; u < 2; ++u) ao[u] = MFMA32(A, *(const LAS bf16x8*)(VT + (32 * (te0 + u) + c) * JS + 32 * tj + 16 * s2 + 8 * hh), ao[u]); }
    __syncthreads();
#pragma unroll
    for (int u = 0; u < 2; ++u)
#pragma unroll
        for (int i = 0; i < 16; ++i) OL[(32 * ti + (i & 3) + 8 * (i >> 2) + 4 * hh) * 132 + 32 * (te0 + u) + c] = ao[u][i];
    __syncthreads();
    {
        const LAS float* Ob = OL + ei * 132 + 32 * eq; bf16* op = OB + et * 1024 + h * 128 + 32 * eq;
        f32x4 v[8]; float sm = 0.f;
#pragma unroll
        for (int k = 0; k < 8; ++k) { v[k] = *(const LAS f32x4*)(Ob + 4 * k); sm += (v[k].x + v[k].y) + (v[k].z + v[k].w); }
        sm += __shfl_xor(sm, 1); sm += __shfl_xor(sm, 2);
        const float mean = sm * (1.f / 128.f); float sq = 0.f;
#pragma unroll
        for (int k = 0; k < 8; ++k) { v[k] = v[k] - mean; sq += (v[k].x * v[k].x + v[k].y * v[k].y) + (v[k].z * v[k].z + v[k].w * v[k].w); }
        sq += __shfl_xor(sq, 1); sq += __shfl_xor(sq, 2);
        const float rs = rsqrtf(sq * (1.f / 128.f) + LN_EPS);
#pragma unroll
        for (int k = 0; k < 4; ++k) { const v4u g4 = gg[k]; const f32x4 a0 = v[2 * k], a1 = v[2 * k + 1];
            v4u o; o.x = bfc2(a0.x * rs * siluf(bflo(g4.x)), a0.y * rs * siluf(bfhi(g4.x))); o.y = bfc2(a0.z * rs * siluf(bflo(g4.y)), a0.w * rs * siluf(bfhi(g4.y)));
            o.z = bfc2(a1.x * rs * siluf(bflo(g4.z)), a1.y * rs * siluf(bfhi(g4.z))); o.w = bfc2(a1.z * rs * siluf(bflo(g4.w)), a1.w * rs * siluf(bfhi(g4.w)));
            *(v4u*)(op + 8 * k) = o; }
    }
}

__device__ __forceinline__ void gdn_prep_fast(KArgs a, int l, int unit, LAS unsigned char* lds, int tid, int lane, int wave) {
    unsigned char* ws = a->ws;
    constexpr int KS = 136;
    LAS bf16* Kb = (LAS bf16*)lds;
    LAS bf16* Qb = (LAS bf16*)(lds + 17408);
    LAS float* A = (LAS float*)(lds + 34816);
    LAS float* V = (LAS float*)(lds + 51200);
    LAS float* KW = (LAS float*)(lds + 83968);
    LAS float* gc = (LAS float*)(lds + 116736);
    LAS float* bt = gc + 64;
    LAS bf16* KDs = (LAS bf16*)(lds + 117248);
    const int n = unit & 31, bh = unit >> 5, h = bh & 3, b = bh >> 2, t0 = b * SEQ + n * 64, c = lane & 31, hh = lane >> 5;
    const bf16* HP = (const bf16*)(ws + WS_R + R_HP);
    bf16* QKg = (bf16*)(ws + WS_R + R_QK) + (size_t)unit * 4096; bf16* QDg = (bf16*)(ws + WS_R + R_QD) + (size_t)unit * 8192; bf16* KDTg = (bf16*)(ws + WS_R + R_KDT) + (size_t)unit * 8192;
    bf16* WNg = (bf16*)(ws + WS_R + R_WN) + (size_t)unit * 8192; bf16* Ug = (bf16*)(ws + WS_R + R_U) + (size_t)unit * 8192;
    __syncthreads();
    if (wave == 0) {
        const float* gab = (const float*)(ws + WS_GAB) + (size_t)(t0 + lane) * 8; const float x = gab[h] + a->in[4][l * 4 + h];
        const float sp = fmaxf(x, 0.f) + log1pf(__expf(-fabsf(x))); float g = -__expf(a->in[3][l * 4 + h]) * sp;
#pragma unroll
        for (int o = 1; o < 64; o <<= 1) { const float up = __shfl_up(g, o); if (lane >= o) g += up; }
        gc[lane] = g; bt[lane] = sigmf(gab[4 + h]);
        if (lane == 63) ((float*)(ws + WS_CD))[unit] = __expf(g);
    }
    __syncthreads();
#ifndef PREP_NO_CONV
    if (wave < 6) {
        const int cg = tid % 48, rb = tid / 48, which = cg >> 4, dd = (cg & 15) * 8, col = COL_GQ + which * 512 + h * 128 + dd, cc = which * 512 + h * 128 + dd;
        const float* cw = a->in[2] + (size_t)l * 4 * 1536 + cc;
        float w[4][8];
#pragma unroll
        for (int j = 0; j < 4; ++j) { const f32x4 w0 = *(const f32x4*)(cw + j * 1536), w1 = *(const f32x4*)(cw + j * 1536 + 4); w[j][0] = w0.x; w[j][1] = w0.y; w[j][2] = w0.z; w[j][3] = w0.w; w[j][4] = w1.x; w[j][5] = w1.y; w[j][6] = w1.z; w[j][7] = w1.w; }
        float x0[8], x1[8], x2[8], x3[8];
        const int sbase = n * 64 + 8 * rb - 3;
        const bf16* hpc = HP + (size_t)(b * SEQ) * HP_LD + col;
#define PREP_LDROW(dst, s_) do { v4u raw_ = (v4u){0u, 0u, 0u, 0u}; if ((s_) >= 0) raw_ = *(const v4u*)(hpc + (size_t)(s_) * HP_LD); \
        _Pragma("unroll") for (int k_ = 0; k_ < 4; ++k_) { dst[2 * k_] = bflo(raw_[k_]); dst[2 * k_ + 1] = bfhi(raw_[k_]); } } while (0)
        PREP_LDROW(x0, sbase); PREP_LDROW(x1, sbase + 1); PREP_LDROW(x2, sbase + 2);
        const float gl = gc[63];
#pragma unroll 1
        for (int r = 0; r < 8; ++r) { const int i = 8 * rb + r; float y[8]; float ss = 0.f;
            PREP_LDROW(x3, sbase + 3 + r);
#pragma unroll
            for (int k = 0; k < 8; ++k) { const float acc = w[0][k] * x0[k] + w[1][k] * x1[k] + w[2][k] * x2[k] + w[3][k] * x3[k]; y[k] = siluf(acc); ss += y[k] * y[k]; x0[k] = x1[k]; x1[k] = x2[k]; x2[k] = x3[k]; }
            ss += __shfl_xor(ss, 1); ss += __shfl_xor(ss, 2); ss += __shfl_xor(ss, 4); ss += __shfl_xor(ss, 8);
            const float gi = gc[i], bi = bt[i];
            if (which == 0) { const float f = rsqrtf(ss + NORM_EPS) * 0.08838834764831845f, eg = __expf(gi);
                v4u p, pd;
#pragma unroll
                for (int k = 0; k < 4; ++k) { p[k] = bfc2(y[2 * k] * f, y[2 * k + 1] * f); pd[k] = bfc2(y[2 * k] * f * eg, y[2 * k + 1] * f * eg); }
                *(LAS v4u*)(Qb + i * KS + dd) = p;
                bf16* qd = QDg + (((i >> 5) * 4 + (dd >> 5)) * 2 + ((dd >> 4) & 1)) * 512 + (i & 31) * 8 + ((dd >> 3) & 1) * 4;
                *(v2u*)qd = (v2u){pd[0], pd[1]}; *(v2u*)(qd + 256) = (v2u){pd[2], pd[3]};
            } else if (which == 1) { const float f = rsqrtf(ss + NORM_EPS), fw = f * bi * __expf(gi), fd = f * __expf(gl - gi);
                v4u p;
#pragma unroll
                for (int k = 0; k < 4; ++k) p[k] = bfc2(y[2 * k] * f, y[2 * k + 1] * f);
                *(LAS v4u*)(Kb + i * KS + dd) = p;
#pragma unroll
                for (int k = 0; k < 8; ++k) { KW[i * 128 + dd + k] = y[k] * fw; KDs[(dd + k) * 72 + i] = bfc(y[k] * fd); }
            } else {
#pragma unroll
                for (int k = 0; k < 8; ++k) V[i * 128 + dd + k] = y[k] * bi;
            }
        }
#undef PREP_LDROW
    }
#endif
    __syncthreads();
    {
        const int ti = (wave >> 1) & 1, tj = wave & 1;
        if (wave < 4) {
            if (tj <= ti) {
                f32x16 acc;
#pragma unroll
                for (int i = 0; i < 16; ++i) acc[i] = 0.f;
#pragma unroll
                for (int s = 0; s < 8; ++s) acc = MFMA32(*(const LAS bf16x8*)(Kb + (32 * ti + c) * KS + 16 * s + 8 * hh), *(const LAS bf16x8*)(Kb + (32 * tj + c) * KS + 16 * s + 8 * hh), acc);
                const int j = 32 * tj + c; const float gj = gc[j];
#pragma unroll
                for (int r = 0; r < 16; ++r) { const int i = 32 * ti + (r & 3) + 8 * (r >> 2) + 4 * hh; A[i * 64 + j] = (j < i) ? bt[i] * acc[r] * __expf(gc[i] - gj) : 0.f; }
            } else {
#pragma unroll
                for (int r = 0; r < 16; ++r) { const int i = 32 * ti + (r & 3) + 8 * (r >> 2) + 4 * hh; A[i * 64 + 32 * tj + c] = 0.f; }
            }
        } else {
            const int kt = ti, qt = tj;
            if (kt <= qt) {
                f32x16 acc;
#pragma unroll
                for (int i = 0; i < 16; ++i) acc[i] = 0.f;
#pragma unroll
                for (int s = 0; s < 8; ++s) acc = MFMA32(*(const LAS bf16x8*)(Kb + (32 * kt + c) * KS + 16 * s + 8 * hh), *(const LAS bf16x8*)(Qb + (32 * qt + c) * KS + 16 * s + 8 * hh), acc);
                const int i = 32 * qt + c; const float gi = gc[i];
#pragma unroll
                for (int r = 0; r < 16; ++r) { const int j = 32 * kt + (r & 3) + 8 * (r >> 2) + 4 * hh; acc[r] = (j <= i) ? acc[r] * __expf(gi - gc[j]) : 0.f; }
                bf16x8* qf = (bf16x8*)QKg + lane;
                qf[((qt * 2 + kt) * 2 + 0) * 64] = pack8(acc, 0); qf[((qt * 2 + kt) * 2 + 1) * 64] = pack8(acc, 1);
            }
        }
    }
    __syncthreads();
#ifndef PREP_NO_SOLVE
    if (wave < 4) {
        const int col = tid & 127; LAS float* rhs = (tid < 128 ? V : KW) + col;
        float x[64];
#pragma unroll
        for (int i = 0; i < 64; ++i) {
            float s0 = rhs[i * 128], s1 = 0.f, s2 = 0.f, s3 = 0.f;
#pragma unroll
            for (int m4 = 0; m4 < (i + 3) / 4; ++m4) { const f32x4 a4 = *(const LAS f32x4*)(A + i * 64 + 4 * m4);
                if (4 * m4 < i) s0 -= a4.x * x[4 * m4];
                if (4 * m4 + 1 < i) s1 -= a4.y * x[4 * m4 + 1];
                if (4 * m4 + 2 < i) s2 -= a4.z * x[4 * m4 + 2];
                if (4 * m4 + 3 < i) s3 -= a4.w * x[4 * m4 + 3]; }
            x[i] = (s0 + s1) + (s2 + s3);
        }
        if (tid < 128) {
#pragma unroll
            for (int m = 0; m < 2; ++m)
#pragma unroll
                for (int hx = 0; hx < 2; ++hx)
#pragma unroll
                    for (int hf = 0; hf < 2; ++hf) { const int i0 = 32 * m + 16 * hf + 4 * hx;
                        v4u w; w.x = bfc2(x[i0], x[i0 + 1]); w.y = bfc2(x[i0 + 2], x[i0 + 3]); w.z = bfc2(x[i0 + 8], x[i0 + 9]); w.w = bfc2(x[i0 + 10], x[i0 + 11]);
                        *(v4u*)(Ug + uoff(i0, col)) = w; }
        } else {
#pragma unroll
            for (int i = 0; i < 64; ++i) Qb[i * KS + col] = bfc(-x[i]);
        }
    }
#endif
    __syncthreads();
#pragma unroll
    for (int p = 0; p < 4; ++p) { const int idx = tid + 512 * p, i = idx >> 5, d = (idx & 31) * 4;
        *(v2u*)(WNg + fragoff(i, d, 4)) = *(const LAS v2u*)(Qb + i * KS + d); }
#pragma unroll
    for (int p = 0; p < 4; ++p) { const int idx = tid + 512 * p, d = idx >> 4, i = (idx & 15) * 4;
        *(v2u*)(KDTg + fragoff(d, i, 2)) = *(const LAS v2u*)(KDs + d * 72 + i); }
}
#define XB_TMO      128
#define XB_XCNT(j)  (256  + 64 * (j))
#define XB_XSUB(j)  (1280 + 64 * (j))
#define XB_XGEN(j)  (2304 + 64 * (j))
#define XB_TOP      3328
#define XB_TOPGEN   3392
#define XCD_BAR_WORDS 3456
#define XB_SPIN_CAP (1u << 18)

__device__ __forceinline__ unsigned xb_ld(unsigned* p)              { return __hip_atomic_load(p, __ATOMIC_RELAXED, __HIP_MEMORY_SCOPE_AGENT); }
__device__ __forceinline__ unsigned xb_add(unsigned* p, unsigned v) { return __hip_atomic_fetch_add(p, v, __ATOMIC_RELAXED, __HIP_MEMORY_SCOPE_AGENT); }
__device__ __forceinline__ unsigned xb_xcc_id() { return (unsigned)__builtin_amdgcn_s_getreg((3 << 11) | 20) & 0xFu; }
#define XB_SPIN(cond, bar) do { unsigned _sp = 0; while (cond) { __builtin_amdgcn_s_sleep(1); \
    if ((++_sp & 255u) == 0u) { if (xb_ld(&(bar)[XB_TMO])) break; if (_sp > XB_SPIN_CAP) { atomicAdd(&(bar)[XB_TMO], 1u); break; } } } } while (0)

struct XcdBarrier {
    unsigned* bar; unsigned x;
    volatile LAS unsigned* st;
};

__device__ __forceinline__ XcdBarrier xcd_barrier_post(unsigned* bar, volatile LAS unsigned* st) {
    XcdBarrier b; b.bar = bar; b.x = xb_xcc_id(); b.st = st;
    if (threadIdx.x == 0) (void)xb_add(&bar[XB_XCNT(b.x)], 1u);
    return b;
}
__device__ __forceinline__ void xcd_barrier_complete(unsigned* bar, unsigned x, unsigned& nloc, unsigned& nx) {
    const unsigned G = gridDim.x * gridDim.y * gridDim.z;
    unsigned sum, cnt, mine, sp = 0u;
    for (;;) {
        sum = 0u; cnt = 0u; mine = 0u;
#pragma unroll
        for (unsigned j = 0; j < 16; ++j) { const unsigned c = xb_ld(&bar[XB_XCNT(j)]); sum += c; cnt += (c > 0u) ? 1u : 0u; mine = (j == x) ? c : mine; }
        if (sum == G) break;
        __builtin_amdgcn_s_sleep(1);
        if ((++sp & 255u) == 0u) { if (xb_ld(&bar[XB_TMO])) break; if (sp > XB_SPIN_CAP) { atomicAdd(&bar[XB_TMO], 1u); break; } }
    }
    nloc = mine > 0u ? mine : 1u; nx = cnt > 0u ? cnt : 1u;
}

__device__ __forceinline__ void xcd_barrier(const XcdBarrier& b) {
    asm volatile("s_waitcnt vmcnt(0)" ::: "memory");
    __syncthreads();
    if (threadIdx.x == 0) {
        unsigned* bar = b.bar;
        __builtin_amdgcn_s_waitcnt(0);
        unsigned nloc = b.st[0], nx = b.st[1];
        if (nloc == 0u) { xcd_barrier_complete(bar, b.x, nloc, nx); b.st[0] = nloc; b.st[1] = nx; }
        const unsigned old = xb_add(&bar[XB_XSUB(b.x)], 1u);
        const unsigned gen = old / nloc;
        if (old + 1u == (gen + 1u) * nloc) {
            __builtin_amdgcn_fence(__ATOMIC_RELEASE, "agent");
            asm volatile("s_waitcnt vmcnt(0)" ::: "memory");
            const unsigned og = xb_add(&bar[XB_TOP], 1u);
            const unsigned tg = og / nx;
            if (og + 1u == (tg + 1u) * nx) xb_add(&bar[XB_TOPGEN], 1u);
            else XB_SPIN(xb_ld(&bar[XB_TOPGEN]) == tg, bar);
            __builtin_amdgcn_fence(__ATOMIC_ACQUIRE, "agent");
            xb_add(&bar[XB_XGEN(b.x)], 1u);
            asm volatile("s_waitcnt vmcnt(0)" ::: "memory");
        } else {
            XB_SPIN(xb_ld(&bar[XB_XGEN(b.x)]) == gen, bar);
            __builtin_amdgcn_fence(__ATOMIC_ACQUIRE, "agent");
            asm volatile("s_waitcnt vmcnt(0)" ::: "memory");
        }
    }
    __syncthreads();
}
#ifndef REP_PRO
#define REP_PRO 1
#endif
#ifndef REP_IN
#define REP_IN 1
#endif
#ifndef REP_PREP
#define REP_PREP 1
#endif
#ifndef REP_SCAN
#define REP_SCAN 1
#endif
#ifndef REP_OUT
#define REP_OUT 1
#endif
#ifndef REP_GU
#define REP_GU 1
#endif
#ifndef REP_DN
#define REP_DN 1
#endif
#ifndef REP_MGU
#define REP_MGU 1
#endif
#ifndef REP_GDN
#define REP_GDN 1
#endif
#ifndef REP_RET
#define REP_RET 1
#endif
#ifndef FAST_SCAN
#define FAST_SCAN 1
#endif
#ifndef FAST_RET
#define FAST_RET 1
#endif
#ifndef FAST_PREP
#define FAST_PREP 1
#endif
#ifndef EN_PRO
#define EN_PRO 1
#endif
#ifndef EN_IN
#define EN_IN 1
#endif
#ifndef EN_PREP
#define EN_PREP 1
#endif
#ifndef EN_SCAN
#define EN_SCAN 1
#endif
#ifndef EN_OUT
#define EN_OUT 1
#endif
#ifndef EN_LN1
#define EN_LN1 1
#endif
#ifndef EN_FFN0
#define EN_FFN0 1
#endif
#ifndef EN_MOE
#define EN_MOE 1
#endif

__global__ void __launch_bounds__(NWAVES * 64, 2) fwd(Args a_unused) {
    extern __shared__ __attribute__((aligned(16))) unsigned char lds_raw[];
    LAS unsigned char* lds = (LAS unsigned char*)lds_raw;
    { const int tid0 = threadIdx.x; for (int u = tid0; u < (LDS_BYTES - LDSCTL_OFF) / 4; u += NWAVES * 64) ((LAS unsigned*)(lds + LDSCTL_OFF))[u] = 0u; }
    __syncthreads();
#if ONE_LAUNCH
    XcdBarrier bar = xcd_barrier_post((unsigned*)(kargs()->ws + WS_CTL) + CW_BAR, (volatile LAS unsigned*)(lds + MISC_OFF) + 8);
#define SEAM() xcd_barrier(bar)
#else
#define SEAM() do {} while (0)
#endif
#define IN(k) (kargs()->ph_lo <= (k) && (k) < kargs()->ph_hi)
#define BOTH(k) (IN(k) && ((k) + 1) < kargs()->ph_hi)
#define PH_LOCALS KArgs a = kargs(); unsigned char* ws = a->ws; int G = gridDim.x, bid = blockIdx.x; asm volatile("" : "+s"(G), "+s"(bid)); const int tid = tidx(), lane = tid & 63, wave = __builtin_amdgcn_readfirstlane(tid >> 6), gw = bid * NWAVES + wave, NGW = G * NWAVES; (void)ws; (void)lane; (void)gw; (void)NGW;

    if (EN_PRO && IN(PH_PRO)) { _Pragma("unroll 1") for (int rep_ = 0; rep_ < REP_PRO; ++rep_) { if (rep_) SEAM(); PH_LOCALS; ph_prologue(a, lds, wave, lane, gw, NGW, bid * (NWAVES * 64) + tid, G * NWAVES * 64, 0, PRO_I_IN, true); } if (BOTH(PH_PRO)) SEAM(); }

#pragma unroll 1
    for (int l = 0; l < 2; ++l) {
        if (EN_IN && IN(PH_L(l, K_IN))) {
            _Pragma("unroll 1") for (int rep_ = 0; rep_ < REP_IN; ++rep_) { if (rep_) SEAM(); PH_LOCALS;
            pg8::Gemm g{(const pg8::bf16_t*)(ws + WS_XB), (const pg8::bf16_t*)(ws + WS_WIN) + (size_t)l * NIN_PAD * 1024, M, NIN_PAD, 1024}; pg8::StaticOrder S; S.init(M, NIN_PAD, G, bid);
            pg8::EpiHproj E{(pg8::bf16_t*)(ws + WS_R + R_HP), (float*)(ws + WS_GAB)};
            pg8::gemm_phase<pg8::EpiHproj, pg8::StaticOrder, PG8_ALIGN, PG8_SP2>(lds, g, S, E); }
            if (BOTH(PH_L(l, K_IN))) SEAM();
        }
        if (EN_PREP && IN(PH_L(l, K_PREP))) {
            _Pragma("unroll 1") for (int rep_ = 0; rep_ < REP_PREP; ++rep_) { if (rep_) SEAM(); PH_LOCALS; for (int u = bid; u < 1024; u += G) { if (FAST_PREP) gdn_prep_fast(a, l, u, lds, tid, lane, wave); else gdn_prep_unit(a, l, u, lds, tid, lane, wave); }
              if (FAST_RET) for (int u = bid; u < 512; u += G) ret_kv_unit(a, u, lds, tid, lane, wave); }
            if (BOTH(PH_L(l, K_PREP))) SEAM();
        }
        if (EN_SCAN && IN(PH_L(l, K_SCAN))) {
            _Pragma("unroll 1") for (int rep_ = 0; rep_ < REP_SCAN; ++rep_) { if (rep_) SEAM(); PH_LOCALS;
            if (bid < 32) { const int t1 = tidx(), w1 = __builtin_amdgcn_readfirstlane(t1 >> 6); for (int rg_ = 0; rg_ < REP_GDN; ++rg_) gdn_scan_fast(a, l, bid, lds, t1, t1 & 63, w1); }
            else {
                { const int t1 = tidx(), w1 = __builtin_amdgcn_readfirstlane(t1 >> 6);
                  for (int rr_ = 0; rr_ < REP_RET; ++rr_) for (int u = bid - 32; u < 512; u += G - 32) ret_out_unit(a, u, lds, t1, t1 & 63, w1); }
                __syncthreads();
                { const int t2 = tidx(), w2 = __builtin_amdgcn_readfirstlane(t2 >> 6);
                  moe_convert(kargs(), lds, w2, t2 & 63, (bid - 32) * NWAVES + w2, (G - 32) * NWAVES, 4 * l, 4 * l + 4);
                  if (l == 0) ph_prologue(kargs(), lds, w2, t2 & 63, (bid - 32) * NWAVES + w2, (G - 32) * NWAVES, 0, 0, PRO_I_IN, PRO_NIT, false); }
            } }
            if (BOTH(PH_L(l, K_SCAN))) SEAM();
        }
        if (EN_OUT && IN(PH_L(l, K_OUT))) {
            _Pragma("unroll 1") for (int rep_ = 0; rep_ < REP_OUT; ++rep_) { if (rep_) SEAM(); PH_LOCALS;
            pg8::Gemm g{(const pg8::bf16_t*)(ws + WS_R + R_OB), (const pg8::bf16_t*)(ws + WS_WO) + (size_t)l * 1024 * 1024, M, 1024, 1024}; pg8::StaticOrder S; S.init(M, 1024, G, bid);
            pg8::EpiBf16Out E{(pg8::bf16_t*)(ws + WS_R + R_MIX), 1024};
            pg8::gemm_phase<pg8::EpiBf16Out, pg8::StaticOrder, PG8_ALIGN, PG8_SP2>(lds, g, S, E); }
            if (BOTH(PH_L(l, K_OUT))) SEAM();
        }
        if (EN_LN1 && IN(PH_L(l, K_LN1))) {
            { PH_LOCALS;
            if (l == 0) ln_rows<false>(a->in[0], ALPHA, (const bf16*)(ws + WS_R + R_MIX), a->in[7], a->in[8], a->out, 1.0f, (bf16*)(ws + WS_XB), nullptr, nullptr, nullptr, nullptr, lane, gw, NGW);
            else { ln_rows<true>(a->out, ALPHA, (const bf16*)(ws + WS_R + R_MIX), a->in[7] + 1024, a->in[8] + 1024, a->out, ALPHA, (bf16*)(ws + WS_XB), (const float*)(ws + WS_RWT), (unsigned*)(ws + WS_CTL) + CW_MOE, (int*)(ws + WS_LIST), (float*)(ws + WS_GATE), lane, gw, NGW);
                 } }
            if (BOTH(PH_L(l, K_LN1))) SEAM();
        }
        if (l == 0) {
            if (EN_FFN0 && IN(PH_L(0, K_GU))) {
                _Pragma("unroll 1") for (int rep_ = 0; rep_ < REP_GU; ++rep_) { if (rep_) SEAM(); PH_LOCALS;
                pg8::Gemm g{(const pg8::bf16_t*)(ws + WS_XB), (const pg8::bf16_t*)(ws + WS_WGU), M, 2 * FF, 1024}; pg8::StaticOrder S; S.init(M, 2 * FF, G, bid);
                pg8::EpiSwiglu E{(pg8::bf16_t*)(ws + WS_R + R_H), FF};
                pg8::gemm_phase<pg8::EpiSwiglu, pg8::StaticOrder, PG8_ALIGN, PG8_SP2>(lds, g, S, E); }
                if (BOTH(PH_L(0, K_GU))) SEAM();
            }
            if (EN_FFN0 && IN(PH_L(0, K_DN))) {
                _Pragma("unroll 1") for (int rep_ = 0; rep_ < REP_DN; ++rep_) { if (rep_) SEAM(); PH_LOCALS;
                pg8::Gemm g{(const pg8::bf16_t*)(ws + WS_R + R_H), (const pg8::bf16_t*)(ws + WS_WD), M, 1024, FF}; pg8::StaticOrder S; S.init(M, 1024, G, bid);
                pg8::EpiBf16Out E{(pg8::bf16_t*)(ws + WS_R + R_MIX), 1024};
                pg8::gemm_phase<pg8::EpiBf16Out, pg8::StaticOrder, PG8_ALIGN, PG8_SP2>(lds, g, S, E); }
                if (BOTH(PH_L(0, K_DN))) SEAM();
            }
            if (EN_LN1 && IN(PH_L(0, K_LN2))) {
                { PH_LOCALS;
                ln_rows<false>(a->out, ALPHA, (const bf16*)(ws + WS_R + R_MIX), a->in[9], a->in[10], a->out, 1.0f, (bf16*)(ws + WS_XB), nullptr, nullptr, nullptr, nullptr, lane, gw, NGW); }
                if (BOTH(PH_L(0, K_LN2))) SEAM();
            }
        } else {
#pragma unroll 1
            for (int j = 0; j < 2; ++j) {
                const int kg = K_G0 + 3 * j;
                if (EN_MOE && j == 0 && IN(PH_L(1, kg))) { { PH_LOCALS; moe_gather(a, 0, lane, gw, NGW); moe_gather(a, 1, lane, gw, NGW); } if (BOTH(PH_L(1, kg))) SEAM(); }
                if (EN_MOE && IN(PH_L(1, kg + 1))) {
                    _Pragma("unroll 1") for (int rep_ = 0; rep_ < REP_MGU; ++rep_) { if (rep_) SEAM(); PH_LOCALS;
                    int cnt[8];
#pragma unroll
                    for (int e = 0; e < 8; ++e) cnt[e] = (int)((const unsigned*)(ws + WS_CTL))[CW_MOE + 64 * (j * 8 + e)];
                    pg8::Gemm g{(const pg8::bf16_t*)(ws + WS_R + R_XG + (size_t)j * XG_PASS), (const pg8::bf16_t*)(ws + WS_WMGU), MOE_ROWS, 2 * FE, 1024}; pg8::MoeOrder S; S.init(cnt, 2 * FE / 256, G, bid, (size_t)2 * FE * 1024 * 2);
                    pg8::EpiSwiglu E{(pg8::bf16_t*)(ws + WS_R + R_HM), FE};
                    pg8::gemm_phase<pg8::EpiSwiglu, pg8::MoeOrder, PG8_ALIGN, PG8_SP2>(lds, g, S, E); }
                    if (BOTH(PH_L(1, kg + 1))) SEAM();
                }
                if (EN_MOE && IN(PH_L(1, kg + 2))) {
                    { PH_LOCALS;
                    int cnt[8];
#pragma unroll
                    for (int e = 0; e < 8; ++e) cnt[e] = (int)((const unsigned*)(ws + WS_CTL))[CW_MOE + 64 * (j * 8 + e)];
                    pg8::Gemm g{(const pg8::bf16_t*)(ws + WS_R + R_HM), (const pg8::bf16_t*)(ws + WS_WMD), MOE_ROWS, 1024, FE}; pg8::MoeOrder S; S.init(cnt, 4, G, bid, (size_t)1024 * FE * 2);
                    pg8::EpiMoeDown E; E.XF = a->out; E.list = (const int*)(ws + WS_LIST) + (size_t)j * 8 * 16384; E.gate = (const float*)(ws + WS_GATE) + (size_t)j * 16384;
#pragma unroll
                    for (int e = 0; e < 8; ++e) { E.cnt[e] = cnt[e]; E.cum[e] = S.cum[e]; }
                    pg8::gemm_phase<pg8::EpiMoeDown, pg8::MoeOrder, PG8_ALIGN, PG8_SP2>(lds, g, S, E); }
                    if (BOTH(PH_L(1, kg + 2))) SEAM();
                }
            }
            if (EN_LN1 && IN(PH_L(1, K_LNF))) {
                PH_LOCALS;
                ln_rows<false>(a->out, 1.0f, nullptr, a->in[9] + 1024, a->in[10] + 1024, a->out, 1.0f, nullptr, nullptr, nullptr, nullptr, nullptr, lane, gw, NGW);
            }
        }
    }
#undef IN
#undef BOTH
}

extern "C" void kernel_launch(void* const* d_in, const int* in_sizes, int n_in, void* d_out, int out_size, void* d_ws, size_t ws_size, hipStream_t stream) {
    static int grid = 0;
    if (grid == 0) {
        if (n_in != 18 || in_sizes[0] != M * D || out_size != M * D || ws_size < WS_END) { fprintf(stderr, "kernel_launch: unexpected shapes or workspace (%zu < %zu); nothing launched\n", ws_size, (size_t)WS_END); grid = -1; return; }
        int dev = 0, cus = 0, per_cu = 0;
        if (hipGetDevice(&dev) != hipSuccess || hipDeviceGetAttribute(&cus, hipDeviceAttributeMultiprocessorCount, dev) != hipSuccess) { grid = -1; return; }
        if (hipFuncSetAttribute((const void*)fwd, hipFuncAttributeMaxDynamicSharedMemorySize, LDS_BYTES) != hipSuccess) { fprintf(stderr, "kernel_launch: hipFuncSetAttribute failed\n"); grid = -1; return; }
        if (hipOccupancyMaxActiveBlocksPerMultiprocessor(&per_cu, (const void*)fwd, NWAVES * 64, LDS_BYTES) != hipSuccess || per_cu < 1) fprintf(stderr, "kernel_launch: occupancy query reports %d\n", per_cu);
        (void)hipGetLastError();
        grid = cus;
    }
    if (grid < 0) return;
    if (hipMemsetAsync((char*)d_ws + WS_CTL, 0, CTL_BYTES, stream) != hipSuccess) return;
    Args a{};
    for (int i = 0; i < 18; ++i) a.in[i] = (const float*)d_in[i];
    a.out = (float*)d_out; a.ws = (unsigned char*)d_ws;
#if ONE_LAUNCH
    a.ph_lo = 0; a.ph_hi = PH_END;
    hipLaunchKernelGGL(fwd, dim3(grid), dim3(NWAVES * 64), LDS_BYTES, stream, a);
#else
    static const int phases[] = {PH_PRO,
        PH_L(0, K_IN), PH_L(0, K_PREP), PH_L(0, K_SCAN), PH_L(0, K_OUT), PH_L(0, K_LN1), PH_L(0, K_GU), PH_L(0, K_DN), PH_L(0, K_LN2),
        PH_L(1, K_IN), PH_L(1, K_PREP), PH_L(1, K_SCAN), PH_L(1, K_OUT), PH_L(1, K_LN1),
        PH_L(1, K_G0), PH_L(1, K_GU0), PH_L(1, K_DN0), PH_L(1, K_G1), PH_L(1, K_GU1), PH_L(1, K_DN1), PH_L(1, K_LNF)};
    for (unsigned i = 0; i < sizeof(phases) / sizeof(phases[0]); ++i) {
        a.ph_lo = phases[i]; a.ph_hi = phases[i] + 1;
        hipLaunchKernelGGL(fwd, dim3(grid), dim3(NWAVES * 64), LDS_BYTES, stream, a);
    }
#endif
}
```

```cpp
#include <hip/hip_runtime.h>
#include <cstdio>
#include <cstdint>

#ifndef ONE_LAUNCH
#define ONE_LAUNCH 1
#endif

#define GAS __attribute__((address_space(1)))
#define LAS __attribute__((address_space(3)))
typedef unsigned short bf16;
typedef unsigned v4u __attribute__((ext_vector_type(4)));
typedef unsigned v2u __attribute__((ext_vector_type(2)));
typedef float f32x4 __attribute__((ext_vector_type(4)));
typedef float f32x2 __attribute__((ext_vector_type(2)));
#define RLX_AGENT __ATOMIC_RELAXED, __HIP_MEMORY_SCOPE_AGENT
#define LDS_WAIT() asm volatile("s_waitcnt lgkmcnt(0)" ::: "memory")
#define VM_WAIT() asm volatile("s_waitcnt vmcnt(0)" ::: "memory")

__device__ __forceinline__ unsigned f2bf(float f) { unsigned u = __builtin_bit_cast(unsigned, f); return (u + 0x7fffu + ((u >> 16) & 1u)) >> 16; }
__device__ __forceinline__ unsigned pk2(float lo, float hi) { return f2bf(lo) | (f2bf(hi) << 16); }
__device__ __forceinline__ float bf2f(unsigned short u) { return __builtin_bit_cast(float, (unsigned)u << 16); }
__device__ __forceinline__ float bflo(unsigned u) { return __builtin_bit_cast(float, u << 16); }
__device__ __forceinline__ float bfhi(unsigned u) { return __builtin_bit_cast(float, u & 0xffff0000u); }
__device__ __forceinline__ float siluf(float x) { return x / (1.f + __expf(-x)); }
__device__ __forceinline__ float sigmf(float x) { return 1.f / (1.f + __expf(-x)); }
__device__ __forceinline__ float wave_sum(float v) {
#pragma unroll
    for (int o = 1; o < 64; o <<= 1) v += __shfl_xor(v, o);
    return v;
}

constexpr int NWAVES = 8;
constexpr int M = 16384, D = 1024, SEQ = 2048, NB = 8;
constexpr int IN_COLS = 3592, NIN_PAD = 3840, HP_LD = 3584;
constexpr int FF = 2816, FE = 3584, NE = 8;
constexpr int COL_RQ = 0, COL_RK = 256, COL_RV = 512, COL_RG = 1024, COL_GQ = 1536, COL_GK = 2048, COL_GV = 2560, COL_GG = 3072;
constexpr float ALPHA = 1.41421356237f;
constexpr float LN_EPS = 1e-5f, NORM_EPS = 1e-6f;
constexpr int MOE_ROWS = 72 * 256;

__host__ __device__ __forceinline__ int fragoff(int i, int d, int nkt) {
    return ((((i >> 5) * nkt + (d >> 5)) * 2 + ((d >> 4) & 1)) * 512) + ((((d >> 2) & 1) * 32 + (i & 31)) * 8) + ((((d >> 3) & 1) << 2) | (d & 3));
}
__host__ __device__ __forceinline__ int uoff(int i, int e) {
    const int reg = (i & 3) | (((i & 31) >> 3) << 2);
    return (((((e >> 5) * 2 + (i >> 5)) * 2 + (reg >> 3)) * 64 + (((i >> 2) & 1) * 32 + (e & 31))) * 8) + (reg & 7);
}
namespace pg8 {
#define PG8_LAS __attribute__((address_space(3)))
typedef unsigned short bf16_t;
typedef short bf16x8 __attribute__((ext_vector_type(8)));
typedef float f32x4 __attribute__((ext_vector_type(4)));
typedef unsigned u32x4 __attribute__((ext_vector_type(4)));
constexpr int BM = 256, BK = 64, HALF = 128, HTB = HALF * BK * 2  , STAGE_BYTES = 8 * HTB, NXCD = 8, WGM = 8;

__host__ __device__ __forceinline__ int lds_byte(int r, int c) { const int st = (r >> 4) * 2 + (c >> 5), rr = r & 15, cc = c & 31, ob = rr * 64 + cc * 2; return st * 1024 + (ob ^ (((ob >> 9) & 1) << 5)); }
__host__ __device__ __forceinline__ void stage_rc(int b, int& R, int& C) { const int st = b / 1024, sb = b % 1024, swz = sb ^ (((sb >> 9) & 1) << 5); R = (st >> 1) * 16 + swz / 64; C = (st & 1) * 32 + (swz % 64) / 2; }
__host__ __device__ __forceinline__ int perm32(int rho) { const int n = rho >> 4, i = rho & 15; return 8 * (i >> 2) + 4 * n + (i & 3); }

struct Unit { int pm, pn, aux; };
struct Gemm { const bf16_t* A; const bf16_t* Bt; int M, N, K; };

struct StaticOrder {
    int nM, nN, nwg, G, c;
    __host__ __device__ void init(int M, int N, int G_, int c_) { nM = M / BM; nN = N / BM; nwg = nM * nN; G = G_; c = c_; }
    __host__ __device__ bool next(int i, Unit& u) const {
        const long L = (long)i * G + c; if (L >= nwg) return false;
        int wgid = (int)L; { const int q = nwg / NXCD, r = nwg % NXCD, xcd = wgid % NXCD, off = wgid / NXCD; wgid = (xcd < r ? xcd * (q + 1) : r * (q + 1) + (xcd - r) * q) + off; }
        const int nig = WGM * nN, gid = wgid / nig, fm = gid * WGM, gsz = (nM - fm) < WGM ? (nM - fm) : WGM;
        u.pm = fm + ((wgid % nig) % gsz); u.pn = (wgid % nig) / gsz; u.aux = 0; return true;
    }
    __device__ __forceinline__ const char* aptr(const Gemm& g, const Unit& u) const { return (const char*)g.A + (size_t)u.pm * ((size_t)BM * g.K * 2); }
    __device__ __forceinline__ const char* bptr(const Gemm& g, const Unit& u) const { return (const char*)g.Bt + (size_t)u.pn * ((size_t)BM * g.K * 2); }
    __device__ __forceinline__ void a_ready(const Unit&) const {}
    __device__ __forceinline__ void done(const Unit&) const {}
};

template <class Epi, class Sched, bool ALIGN_EPI = false, bool SP2 = false>
__device__ __forceinline__ void gemm_phase(PG8_LAS unsigned char* lds, const Gemm g, const Sched& S, const Epi& E) {
    int tid = threadIdx.x; asm volatile("" : "+v"(tid)); const int wid = __builtin_amdgcn_readfirstlane(tid >> 6), lane = tid & 63, wr = wid >> 2, wc = wid & 3, fr = lane & 15, fq = lane >> 4;
    const int K = g.K, nt = K / BK;
    unsigned voffA[2], voffB[2];
#pragma unroll
    for (int i = 0; i < 2; ++i) { int R, C; stage_rc(tid * 16 + i * 8192, R, C); const int Rb = Epi::PERM ? ((R & ~31) + perm32(R & 31)) : R;
        voffA[i] = (unsigned)(R * K + C) * 2u; voffB[i] = (unsigned)(Rb * K + C) * 2u; }
    const size_t kstep = (size_t)(BK * 2);
    const size_t hstep = (size_t)HALF * K * 2;
    const size_t tstep = 2 * hstep;
    const unsigned ldsw = (unsigned)wid * 1024u;
    const int aoff = lds_byte(wr * 64 + fr, fq * 8), boff = lds_byte(wc * 32 + fr, fq * 8);
#define PG8_SA(b, h) (((b) * 2 + (h)) * HTB)
#define PG8_SB(b, h) ((4 + (b) * 2 + (h)) * HTB)
#define PG8_STAGE(bufoff, gbase, voff) do { _Pragma("unroll") for (int _i = 0; _i < 2; ++_i) \
        __builtin_amdgcn_global_load_lds((const unsigned*)((const char*)(gbase) + (voff)[_i]), (PG8_LAS unsigned*)(lds + (bufoff) + ldsw + _i * 8192), 16, 0, 0); } while (0)
#define PG8_LDA(dst, b, h) do { _Pragma("unroll") for (int m = 0; m < 4; ++m) _Pragma("unroll") for (int k = 0; k < 2; ++k) dst[m][k] = *(const PG8_LAS bf16x8*)(lds + PG8_SA(b, h) + aoff + m * 2048 + k * 1024); } while (0)
#define PG8_LDB(dst, b, h) do { _Pragma("unroll") for (int n = 0; n < 2; ++n) _Pragma("unroll") for (int k = 0; k < 2; ++k) dst[n][k] = *(const PG8_LAS bf16x8*)(lds + PG8_SB(b, h) + boff + n * 2048 + k * 1024); } while (0)
#define PG8_MMA(ai, bj, At, Bt) do { __builtin_amdgcn_s_setprio(1); _Pragma("unroll") for (int m = 0; m < 4; ++m) _Pragma("unroll") for (int n = 0; n < 2; ++n) _Pragma("unroll") for (int k = 0; k < 2; ++k) \
        acc[ai][bj][m][n] = __builtin_amdgcn_mfma_f32_16x16x32_bf16(Bt[n][k], At[m][k], acc[ai][bj][m][n], 0, 0, 0); __builtin_amdgcn_s_setprio(0); } while (0)
#define PG8_WAIT_V(n) asm volatile("s_waitcnt vmcnt(" #n ")" ::: "memory")
#define PG8_WAIT_L(n) asm volatile("s_waitcnt lgkmcnt(" #n ")" ::: "memory")
#define PG8_BAR __builtin_amdgcn_s_barrier()
#define PG8_SCHED __builtin_amdgcn_sched_barrier(0)
    Unit cur, nxt; int ui = 0;
    if (!S.next(0, cur)) return;
    f32x4 acc[2][2][4][2];
#pragma unroll
    for (int a = 0; a < 2; ++a)
#pragma unroll
        for (int b = 0; b < 2; ++b)
#pragma unroll
            for (int m = 0; m < 4; ++m)
#pragma unroll
                for (int n = 0; n < 2; ++n) acc[a][b][m][n] = (f32x4){0.f, 0.f, 0.f, 0.f};
    bf16x8 At[4][2], B0[2][2], B1[2][2];
    const char* cA = S.aptr(g, cur); const char* cB = S.bptr(g, cur);
    S.a_ready(cur);
    if constexpr (SP2) {
        PG8_STAGE(PG8_SB(0, 0), cB, voffB); PG8_STAGE(PG8_SB(0, 1), cB + hstep, voffB); PG8_STAGE(PG8_SA(0, 0), cA, voffA); PG8_STAGE(PG8_SA(0, 1), cA + hstep, voffA);
        if (wr == 1) PG8_BAR;
        PG8_WAIT_V(2); PG8_BAR;
        PG8_STAGE(PG8_SB(1, 0), cB + kstep, voffB); PG8_STAGE(PG8_SA(1, 0), cA + kstep, voffA); PG8_STAGE(PG8_SB(1, 1), cB + hstep + kstep, voffB);
        PG8_WAIT_V(6); PG8_BAR;
    } else {
        PG8_STAGE(PG8_SB(0, 0), cB, voffB); PG8_STAGE(PG8_SA(0, 0), cA, voffA); PG8_STAGE(PG8_SB(0, 1), cB + hstep, voffB); PG8_STAGE(PG8_SA(0, 1), cA + hstep, voffA);
        if (wr == 1) PG8_BAR;
        PG8_WAIT_V(4); PG8_BAR;
        PG8_STAGE(PG8_SB(1, 0), cB + kstep, voffB); PG8_STAGE(PG8_SA(1, 0), cA + kstep, voffA); PG8_STAGE(PG8_SB(1, 1), cB + hstep + kstep, voffB);
        PG8_WAIT_V(6); PG8_BAR;
    }
    for (;;) {
        const bool has_next = S.next(ui + 1, nxt);
        const char* nA = has_next ? S.aptr(g, nxt) : cA; const char* nB = has_next ? S.bptr(g, nxt) : cB;
        for (int t = 0; t < nt; t += 2) {
            const bool last = (t == nt - 2);
            const char* a1 = cA + (size_t)(t + 1) * kstep;
            const char* a2 = last ? nA : cA + (size_t)(t + 2) * kstep; const char* b2 = last ? nB : cB + (size_t)(t + 2) * kstep;
            const char* a3 = a2 + kstep; const char* b3 = b2 + kstep;
            if (last && has_next) S.a_ready(nxt);
            if constexpr (SP2) {
            PG8_LDB(B0, 0, 0); PG8_LDB(B1, 0, 1); PG8_SCHED; PG8_LDA(At, 0, 0); PG8_STAGE(PG8_SA(1, 1), a1 + hstep, voffA);
            PG8_WAIT_V(8); PG8_WAIT_L(0); PG8_BAR; PG8_MMA(0, 0, At, B0); PG8_MMA(0, 1, At, B1); PG8_BAR; PG8_SCHED;
            PG8_LDA(At, 0, 1); PG8_STAGE(PG8_SB(0, 0), b2, voffB); PG8_STAGE(PG8_SB(0, 1), b2 + hstep, voffB); PG8_STAGE(PG8_SA(0, 0), a2, voffA);
            PG8_WAIT_V(8); PG8_WAIT_L(0); PG8_BAR; PG8_MMA(1, 0, At, B0); PG8_MMA(1, 1, At, B1); PG8_BAR; PG8_SCHED;
            PG8_LDB(B0, 1, 0); PG8_LDB(B1, 1, 1); PG8_SCHED; PG8_LDA(At, 1, 0); PG8_STAGE(PG8_SA(0, 1), a2 + hstep, voffA);
            PG8_WAIT_V(8); PG8_WAIT_L(0); PG8_BAR; PG8_MMA(0, 0, At, B0); PG8_MMA(0, 1, At, B1); PG8_BAR; PG8_SCHED;
            PG8_LDA(At, 1, 1); PG8_STAGE(PG8_SB(1, 0), b3, voffB); PG8_STAGE(PG8_SB(1, 1), b3 + hstep, voffB); PG8_STAGE(PG8_SA(1, 0), a3, voffA);
            PG8_WAIT_V(8); PG8_WAIT_L(0); PG8_BAR; PG8_MMA(1, 0, At, B0); PG8_MMA(1, 1, At, B1); PG8_BAR; PG8_SCHED;
            } else {
            PG8_LDB(B0, 0, 0); PG8_SCHED; PG8_LDA(At, 0, 0); PG8_STAGE(PG8_SA(1, 1), a1 + hstep, voffA);
            PG8_WAIT_L(8); PG8_BAR; PG8_WAIT_L(0); PG8_MMA(0, 0, At, B0); PG8_BAR; PG8_SCHED;
            PG8_LDB(B1, 0, 1); PG8_STAGE(PG8_SB(0, 0), b2, voffB);
            PG8_BAR; PG8_WAIT_L(0); PG8_MMA(0, 1, At, B1); PG8_BAR;
            PG8_LDA(At, 0, 1); PG8_STAGE(PG8_SA(0, 0), a2, voffA);
            PG8_BAR; PG8_WAIT_L(0); PG8_MMA(1, 0, At, B0); PG8_BAR; PG8_SCHED;
            PG8_STAGE(PG8_SB(0, 1), b2 + hstep, voffB);
            PG8_WAIT_V(6); PG8_BAR; PG8_MMA(1, 1, At, B1); PG8_BAR;
            PG8_LDB(B0, 1, 0); PG8_SCHED; PG8_LDA(At, 1, 0); PG8_STAGE(PG8_SA(0, 1), a2 + hstep, voffA);
            PG8_WAIT_L(8); PG8_BAR; PG8_WAIT_L(0); PG8_MMA(0, 0, At, B0); PG8_BAR; PG8_SCHED;
            PG8_LDB(B1, 1, 1); PG8_STAGE(PG8_SB(1, 0), b3, voffB);
            PG8_BAR; PG8_WAIT_L(0); PG8_MMA(0, 1, At, B1); PG8_BAR;
            PG8_LDA(At, 1, 1); PG8_STAGE(PG8_SA(1, 0), a3, voffA);
            PG8_BAR; PG8_WAIT_L(0); PG8_MMA(1, 0, At, B0); PG8_BAR; PG8_SCHED;
            PG8_STAGE(PG8_SB(1, 1), b3 + hstep, voffB);
            PG8_WAIT_V(6); PG8_BAR; PG8_MMA(1, 1, At, B1); PG8_BAR;
            }
        }
        if constexpr (ALIGN_EPI) { if (wr == 0) PG8_BAR; }
        if constexpr (!Epi::AFTER_DRAIN) { E(acc, cur, wr, wc, fr, fq); S.done(cur); }
        if (!has_next) break;
#pragma unroll
        for (int a = 0; a < 2; ++a)
#pragma unroll
            for (int b = 0; b < 2; ++b)
#pragma unroll
                for (int m = 0; m < 4; ++m)
#pragma unroll
                    for (int n = 0; n < 2; ++n) acc[a][b][m][n] = (f32x4){0.f, 0.f, 0.f, 0.f};
        cur = nxt; cA = nA; cB = nB; ++ui;
        if constexpr (ALIGN_EPI) { if (wr == 1) PG8_BAR; }
    }
    PG8_WAIT_V(0);
    if constexpr (!ALIGN_EPI) { if (wr == 0) PG8_BAR; }
    PG8_BAR;
    if constexpr (Epi::AFTER_DRAIN) { E.fused(acc, cur, wr, wc, fr, fq, lds, wid, lane); S.done(cur); }
#undef PG8_SA
#undef PG8_SB
#undef PG8_STAGE
#undef PG8_LDA
#undef PG8_LDB
#undef PG8_MMA
#undef PG8_WAIT_V
#undef PG8_WAIT_L
#undef PG8_BAR
#undef PG8_SCHED
}
}

namespace pg8 {
__device__ __forceinline__ unsigned cvt_pk_bf16(float lo, float hi) { unsigned r; asm volatile("v_cvt_pk_bf16_f32 %0, %1, %2" : "=v"(r) : "v"(lo), "v"(hi)); return r; }

struct EpiHproj {
    static constexpr bool PERM = true, AFTER_DRAIN = false;
    bf16_t* HP; float* GAB;
    __device__ __forceinline__ void operator()(const f32x4 (&acc)[2][2][4][2], const Unit& u, int wr, int wc, int fr, int fq) const {
        const int row0 = u.pm * BM + wr * 64 + fr;
        if (u.pn < 14) {
            const int col0 = u.pn * BM + wc * 32 + 8 * fq;
#pragma unroll
            for (int ai = 0; ai < 2; ++ai)
#pragma unroll
                for (int m = 0; m < 4; ++m) { bf16_t* rowp = HP + (size_t)(row0 + ai * HALF + m * 16) * 3584 + col0;
#pragma unroll
                    for (int bj = 0; bj < 2; ++bj) { const f32x4 v0 = acc[ai][bj][m][0], v1 = acc[ai][bj][m][1];
                        u32x4 w; w.x = cvt_pk_bf16(v0[0], v0[1]); w.y = cvt_pk_bf16(v0[2], v0[3]); w.z = cvt_pk_bf16(v1[0], v1[1]); w.w = cvt_pk_bf16(v1[2], v1[3]);
                        *(u32x4*)(rowp + bj * HALF) = w; } }
        } else if (wc == 0 && fq == 0) {
#pragma unroll
            for (int ai = 0; ai < 2; ++ai)
#pragma unroll
                for (int m = 0; m < 4; ++m) { float* rowp = GAB + (size_t)(row0 + ai * HALF + m * 16) * 8;
                    *(f32x4*)(rowp) = acc[ai][0][m][0]; *(f32x4*)(rowp + 4) = acc[ai][0][m][1]; }
        }
    }
};
struct EpiBf16Out {
    static constexpr bool PERM = true, AFTER_DRAIN = false;
    bf16_t* O; int ldc;
    __device__ __forceinline__ void operator()(const f32x4 (&acc)[2][2][4][2], const Unit& u, int wr, int wc, int fr, int fq) const {
        const int row0 = u.pm * BM + wr * 64 + fr, col0 = u.pn * BM + wc * 32 + 8 * fq;
#pragma unroll
        for (int ai = 0; ai < 2; ++ai)
#pragma unroll
            for (int m = 0; m < 4; ++m) { bf16_t* rowp = O + (size_t)(row0 + ai * HALF + m * 16) * ldc + col0;
#pragma unroll
                for (int bj = 0; bj < 2; ++bj) { const f32x4 v0 = acc[ai][bj][m][0], v1 = acc[ai][bj][m][1];
                    u32x4 w; w.x = cvt_pk_bf16(v0[0], v0[1]); w.y = cvt_pk_bf16(v0[2], v0[3]); w.z = cvt_pk_bf16(v1[0], v1[1]); w.w = cvt_pk_bf16(v1[2], v1[3]);
                    *(u32x4*)(rowp + bj * HALF) = w; } }
    }
};
struct EpiF32 {
    static constexpr bool PERM = false, AFTER_DRAIN = false;
    float* O; int ldc;
    __device__ __forceinline__ void operator()(const f32x4 (&acc)[2][2][4][2], const Unit& u, int wr, int wc, int fr, int fq) const {
        const int row0 = u.pm * BM + wr * 64 + fr, col0 = u.pn * BM + wc * 32 + 4 * fq;
#pragma unroll
        for (int ai = 0; ai < 2; ++ai)
#pragma unroll
            for (int m = 0; m < 4; ++m) { float* rowp = O + (size_t)(row0 + ai * HALF + m * 16) * ldc + col0;
#pragma unroll
                for (int bj = 0; bj < 2; ++bj)
#pragma unroll
                    for (int n = 0; n < 2; ++n) *(f32x4*)(rowp + bj * HALF + n * 16) = acc[ai][bj][m][n]; }
    }
};
struct EpiSwiglu {
    static constexpr bool PERM = true, AFTER_DRAIN = false;
    bf16_t* H; int ldh;
    __device__ __forceinline__ void operator()(const f32x4 (&acc)[2][2][4][2], const Unit& u, int wr, int wc, int fr, int fq) const {
        const int row0 = u.pm * BM + wr * 64 + fr, col0 = u.pn * HALF + wc * 32 + 8 * fq;
#pragma unroll
        for (int ai = 0; ai < 2; ++ai)
#pragma unroll
            for (int m = 0; m < 4; ++m) { bf16_t* rowp = H + (size_t)(row0 + ai * HALF + m * 16) * ldh + col0;
                float h[8];
#pragma unroll
                for (int n = 0; n < 2; ++n)
#pragma unroll
                    for (int i = 0; i < 4; ++i) { const float gt = acc[ai][0][m][n][i], up = acc[ai][1][m][n][i]; h[n * 4 + i] = gt * up * __builtin_amdgcn_rcpf(1.f + __expf(-gt)); }
                u32x4 w; w.x = cvt_pk_bf16(h[0], h[1]); w.y = cvt_pk_bf16(h[2], h[3]); w.z = cvt_pk_bf16(h[4], h[5]); w.w = cvt_pk_bf16(h[6], h[7]);
                *(u32x4*)(rowp) = w; }
    }
};
struct EpiMoeDown {
    static constexpr bool PERM = false, AFTER_DRAIN = false;
    float* XF; const int* list; const float* gate; int cnt[8], cum[8];
    __device__ __forceinline__ void operator()(const f32x4 (&acc)[2][2][4][2], const Unit& u, int wr, int wc, int fr, int fq) const {
        int e = u.aux, c_e = 0, t_e = 0;
#pragma unroll
        for (int k = 0; k < 8; ++k) { if (k == e) { c_e = cnt[k]; t_e = cum[k]; } }
        const int s0 = (u.pm - t_e) * BM + wr * 64 + fr, col0 = u.pn * BM + wc * 32 + 4 * fq;
        const int* lp = list + e * 16384;
        int tok[8]; float gt[8];
#pragma unroll
        for (int q = 0; q < 8; ++q) { const int s = s0 + (q >> 2) * HALF + (q & 3) * 16; tok[q] = (s < c_e) ? lp[s] : -1; }
#pragma unroll
        for (int q = 0; q < 8; ++q) gt[q] = (tok[q] >= 0) ? gate[tok[q]] : 0.f;
#pragma unroll
        for (int ai = 0; ai < 2; ++ai) {
            f32x4 o[4][2][2];
#pragma unroll
            for (int m = 0; m < 4; ++m) { const float* rowp = XF + (size_t)(tok[ai * 4 + m] >= 0 ? tok[ai * 4 + m] : 0) * 1024 + col0;
#pragma unroll
                for (int bj = 0; bj < 2; ++bj)
#pragma unroll
                    for (int n = 0; n < 2; ++n) o[m][bj][n] = *(const f32x4*)(rowp + bj * HALF + n * 16); }
#pragma unroll
            for (int m = 0; m < 4; ++m) { if (tok[ai * 4 + m] >= 0) { float* rowp = XF + (size_t)tok[ai * 4 + m] * 1024 + col0; const float g1 = gt[ai * 4 + m];
#pragma unroll
                for (int bj = 0; bj < 2; ++bj)
#pragma unroll
                    for (int n = 0; n < 2; ++n) *(f32x4*)(rowp + bj * HALF + n * 16) = o[m][bj][n] + acc[ai][bj][m][n] * g1; } }
        }
    }
};
struct MoeOrder {
    int T, nN, nwg, G, c; int cum[8]; size_t bstride;
    __device__ void init(const int* cnt, int nN_, int G_, int c_, size_t bstride_) {
        int t = 0;
#pragma unroll
        for (int e = 0; e < 8; ++e) { cum[e] = t; t += (cnt[e] + 255) >> 8; }
        T = t; nN = nN_; nwg = T * nN; G = G_; c = c_; bstride = bstride_;
    }
    __device__ bool next(int i, Unit& u) const {
        const long L = (long)i * G + c; if (L >= nwg) return false;
        int wgid = (int)L; { const int q = nwg / NXCD, r = nwg % NXCD, xcd = wgid % NXCD, off = wgid / NXCD; wgid = (xcd < r ? xcd * (q + 1) : r * (q + 1) + (xcd - r) * q) + off; }
        const int nig = WGM * nN, gid = wgid / nig, fm = gid * WGM, gsz = (T - fm) < WGM ? (T - fm) : WGM;
        u.pm = fm + ((wgid % nig) % gsz); u.pn = (wgid % nig) / gsz;
        int e = 0;
#pragma unroll
        for (int k = 1; k < 8; ++k) e += (u.pm >= cum[k]) ? 1 : 0;
        u.aux = e; return true;
    }
    __device__ __forceinline__ const char* aptr(const Gemm& g, const Unit& u) const { return (const char*)g.A + (size_t)u.pm * ((size_t)BM * g.K * 2); }
    __device__ __forceinline__ const char* bptr(const Gemm& g, const Unit& u) const { return (const char*)g.Bt + (size_t)u.aux * bstride + (size_t)u.pn * ((size_t)BM * g.K * 2); }
    __device__ __forceinline__ void a_ready(const Unit&) const {}
    __device__ __forceinline__ void done(const Unit&) const {}
};
}
#ifndef PG8_SP2
#define PG8_SP2 true
#endif
#ifndef PG8_ALIGN
#define PG8_ALIGN true
#endif

constexpr size_t MiB = 1u << 20;
constexpr size_t WS_CTL = 0, CTL_BYTES = 256 * 1024;
constexpr size_t WS_ROPE = 256 * 1024;
constexpr size_t WS_WIN = 1 * MiB;
constexpr size_t WS_WO = 16 * MiB;
constexpr size_t WS_WGU = 20 * MiB;
constexpr size_t WS_WD = 31 * MiB;
constexpr size_t WS_XB = 37 * MiB;
constexpr size_t WS_GAB = 69 * MiB;
constexpr size_t WS_LIST = WS_GAB + 512 * 1024;
constexpr size_t WS_GATE = WS_LIST + 1 * MiB;
constexpr size_t WS_CD = WS_GATE + 128 * 1024;
constexpr size_t WS_RWT = WS_CD + 8 * 1024;
constexpr size_t WS_WMGU = 71 * MiB, WS_WMD = 183 * MiB;
constexpr size_t WS_R = 239 * MiB;
constexpr size_t R_HP = 0, R_OB = 112 * MiB, R_U = 144 * MiB, R_WN = 160 * MiB, R_QD = 176 * MiB, R_KDT = 192 * MiB, R_QK = 208 * MiB;
constexpr size_t WS_KV = WS_XB;
constexpr size_t R_MIX = 0, R_H = 64 * MiB;
constexpr size_t R_HM = 0, R_XG = 126 * MiB, XG_PASS = 36 * MiB;
constexpr size_t WS_END = WS_R + 216 * MiB;
constexpr int CW_TMO = 0, CW_BAR = 4096, CW_MOE = 16384;

constexpr int RING_BYTES = 131072, LDS_BYTES = 147456, LDSCTL_OFF = LDS_BYTES - 512, MISC_OFF = LDSCTL_OFF + 320;

constexpr int PH_PRO = 0;
constexpr int PH_L(int l, int k) { return 1 + 16 * l + k; }
constexpr int K_IN = 0, K_PREP = 1, K_SCAN = 2, K_OUT = 3, K_LN1 = 4, K_GU = 5, K_DN = 6, K_LN2 = 7;
constexpr int K_G0 = 5, K_GU0 = 6, K_DN0 = 7, K_G1 = 8, K_GU1 = 9, K_DN1 = 10, K_LNF = 11;
constexpr int PH_END = PH_L(1, K_LNF) + 1;

struct Args { const float* in[18]; float* out; unsigned char* ws; int ph_lo, ph_hi; };
typedef const __attribute__((address_space(4))) Args* KArgs;
__device__ __forceinline__ KArgs kargs() { KArgs p = (KArgs)__builtin_amdgcn_kernarg_segment_ptr(); asm volatile("" : "+s"(p)); return p; }
__device__ __forceinline__ int tidx() { int t = threadIdx.x; asm volatile("" : "+v"(t)); return t; }

constexpr int TR_SCR = 64 * 65 * 4;
__device__ __forceinline__ void tr_item(const float* W, int N, int k0, int n0, bf16* WT, size_t ldk, int dst_row0, LAS float* scr, int lane) {
    const int nq = 4 * (lane & 15), n = n0 + nq, kr = lane >> 4;
    f32x4 v[16];
#pragma unroll
    for (int i = 0; i < 16; ++i) v[i] = (n < N) ? *(const f32x4*)(W + (size_t)(k0 + 4 * i + kr) * N + n) : (f32x4){0.f, 0.f, 0.f, 0.f};
#pragma unroll
    for (int i = 0; i < 16; ++i) { LAS float* d = scr + (4 * i + kr) * 65 + nq; d[0] = v[i].x; d[1] = v[i].y; d[2] = v[i].z; d[3] = v[i].w; }
    LDS_WAIT(); asm volatile("" ::: "memory");
    const int c = lane & 7;
#pragma unroll
    for (int j = 0; j < 8; ++j) { const int nn = (lane >> 3) + 8 * j; const LAS float* s = scr + (8 * c) * 65 + nn;
        v4u o; o.x = pk2(s[0 * 65], s[1 * 65]); o.y = pk2(s[2 * 65], s[3 * 65]); o.z = pk2(s[4 * 65], s[5 * 65]); o.w = pk2(s[6 * 65], s[7 * 65]);
        *(v4u*)(WT + (size_t)(dst_row0 + nn) * ldk + k0 + 8 * c) = o; }
    LDS_WAIT(); asm volatile("" ::: "memory");
}

constexpr int PRO_I_IN = 16 * 57, PRO_NIT = 2 * (16 * 57 + 16 * 16) + 2 * (16 * 44) + 44 * 16;
__device__ __forceinline__ void ph_prologue(KArgs a, LAS unsigned char* lds, int wave, int lane, int gw, int NGW, int gtid, int NT, int it_lo, int it_hi, bool misc) {
    unsigned char* ws = a->ws;
    LAS float* scr = (LAS float*)(lds + wave * TR_SCR);
    constexpr int I_IN = 16 * 57, I_O = 16 * 16, I_L = I_IN + I_O, I_G = 16 * 44, I_D = 44 * 16, NIT = 2 * I_L + 2 * I_G + I_D;
    static_assert(NIT == PRO_NIT && I_IN == PRO_I_IN, "prologue item counts");
    for (int it = it_lo + gw; it < it_hi; it += NGW) {
        int r = it;
        if (r < 2 * I_L) { const int l = r / I_L; r -= l * I_L;
            if (r < I_IN) { const int kb = r / 57, nb = r % 57; tr_item(a->in[1] + (size_t)l * 1024 * IN_COLS, IN_COLS, 64 * kb, 64 * nb, (bf16*)(ws + WS_WIN) + (size_t)l * NIN_PAD * 1024, 1024, 64 * nb, scr, lane); }
            else { r -= I_IN; const int kb = r / 16, nb = r % 16; tr_item(a->in[6] + (size_t)l * 1024 * 1024, 1024, 64 * kb, 64 * nb, (bf16*)(ws + WS_WO) + (size_t)l * 1024 * 1024, 1024, 64 * nb, scr, lane); }
            continue; }
        r -= 2 * I_L;
        if (r < 2 * I_G) { const int up = r / I_G; r -= up * I_G; const int kb = r / 44, nb = r % 44, n0 = 64 * nb;
            tr_item(up ? a->in[12] : a->in[11], FF, 64 * kb, n0, (bf16*)(ws + WS_WGU), 1024, 256 * (n0 >> 7) + (n0 & 127) + 128 * up, scr, lane); continue; }
        r -= 2 * I_G;
        { const int kb = r / 16, nb = r % 16; tr_item(a->in[13], 1024, 64 * kb, 64 * nb, (bf16*)(ws + WS_WD), FF, 64 * nb, scr, lane); }
    }
    if (!misc) return;
    for (int i = gtid; i < 2 * 192 * 128; i += NT) { const int l = i / (192 * 128), r = i % (192 * 128);
        ((v4u*)((bf16*)(ws + WS_WIN) + (size_t)l * NIN_PAD * 1024 + (size_t)3648 * 1024))[r] = (v4u){0u, 0u, 0u, 0u}; }
    for (int i = gtid; i < M * D / 8; i += NT) { const f32x4 p = ((const f32x4*)a->in[0])[2 * i], q = ((const f32x4*)a->in[0])[2 * i + 1];
        v4u o; o.x = pk2(p.x, p.y); o.y = pk2(p.z, p.w); o.z = pk2(q.x, q.y); o.w = pk2(q.z, q.w); ((v4u*)(ws + WS_XB))[i] = o; }
    for (int i = gtid; i < 8192; i += NT) ((float*)(ws + WS_RWT))[(i & 7) * 1024 + (i >> 3)] = a->in[14][i];
    for (int i = gtid; i < SEQ * 32; i += NT) { const int pos = i >> 5, k = i & 31;
        const float inv = powf(10000.0f, -(float)(2 * k) / 64.0f); const float ang = (float)pos * inv;
        double rev = (double)ang * 0.15915494309189535; rev -= floor(rev); const float rf = (float)rev;
        float* R = (float*)(ws + WS_ROPE) + (size_t)pos * 64; R[k] = __builtin_amdgcn_cosf(rf); R[32 + k] = __builtin_amdgcn_sinf(rf); }
}

__device__ __forceinline__ void moe_convert(KArgs a, LAS unsigned char* lds, int wave, int lane, int gw, int NGW, int e_lo, int e_hi) {
    unsigned char* ws = a->ws;
    LAS float* scr = (LAS float*)(lds + wave * TR_SCR);
    constexpr int I_G = 16 * 56, I_D = 56 * 16, I_E = 2 * I_G + I_D;
    for (int it = e_lo * I_E + gw; it < e_hi * I_E; it += NGW) {
        const int e = it / I_E; int r = it - e * I_E;
        if (r < 2 * I_G) { const int up = r / I_G; r -= up * I_G; const int kb = r / 56, nb = r % 56, n0 = 64 * nb;
            tr_item((up ? a->in[16] : a->in[15]) + (size_t)e * 1024 * FE, FE, 64 * kb, n0, (bf16*)(ws + WS_WMGU) + (size_t)e * 7168 * 1024, 1024, 256 * (n0 >> 7) + (n0 & 127) + 128 * up, scr, lane); }
        else { r -= 2 * I_G; const int kb = r / 16, nb = r % 16; tr_item(a->in[17] + (size_t)e * FE * 1024, 1024, 64 * kb, 64 * nb, (bf16*)(ws + WS_WMD) + (size_t)e * 1024 * FE, FE, 64 * nb, scr, lane); }
    }
}

template <bool ROUTE>
__device__ __forceinline__ void ln_rows(const float* res, float ares, const bf16* mix, const float* g, const float* bta, float* xf, float oscale, bf16* xb,
                                        const float* router, unsigned* cntw, int* list, float* gate, int lane, int gw, int NGW) {
    f32x4 gv[4], bv[4];
#pragma unroll
    for (int j = 0; j < 4; ++j) { gv[j] = ((const f32x4*)g)[lane + 64 * j]; bv[j] = ((const f32x4*)bta)[lane + 64 * j]; }
    for (int row = gw; row < M; row += NGW) {
        const f32x4* rr = (const f32x4*)(res + (size_t)row * D) + lane;
        f32x4 v[4]; float s = 0.f;
#pragma unroll
        for (int j = 0; j < 4; ++j) { v[j] = rr[64 * j] * ares; }
        if (mix) { const v2u* mr = (const v2u*)(mix + (size_t)row * D) + lane;
#pragma unroll
            for (int j = 0; j < 4; ++j) { const v2u m2 = mr[64 * j]; v[j] = v[j] + (f32x4){bflo(m2.x), bfhi(m2.x), bflo(m2.y), bfhi(m2.y)}; } }
#pragma unroll
        for (int j = 0; j < 4; ++j) s += (v[j].x + v[j].y) + (v[j].z + v[j].w);
        const float mean = wave_sum(s) * (1.f / D); float s2 = 0.f;
#pragma unroll
        for (int j = 0; j < 4; ++j) { v[j] = v[j] - mean; s2 += (v[j].x * v[j].x + v[j].y * v[j].y) + (v[j].z * v[j].z + v[j].w * v[j].w); }
        const float rstd = 1.f / sqrtf(wave_sum(s2) * (1.f / D) + LN_EPS);
#pragma unroll
        for (int j = 0; j < 4; ++j) v[j] = v[j] * rstd * gv[j] + bv[j];
        f32x4* xo = (f32x4*)(xf + (size_t)row * D) + lane;
#pragma unroll
        for (int j = 0; j < 4; ++j) xo[64 * j] = v[j] * oscale;
        if (xb) { v2u* bo = (v2u*)(xb + (size_t)row * D) + lane;
#pragma unroll
            for (int j = 0; j < 4; ++j) { v2u o; o.x = pk2(v[j].x, v[j].y); o.y = pk2(v[j].z, v[j].w); bo[64 * j] = o; } }
        if (ROUTE) {
            float lg[8];
#pragma unroll
            for (int e = 0; e < 8; ++e) lg[e] = 0.f;
#pragma unroll
            for (int e = 0; e < 8; ++e)
#pragma unroll
                for (int j = 0; j < 4; ++j) { const f32x4 r4 = ((const f32x4*)(router + e * 1024))[lane + 64 * j]; lg[e] += (v[j].x * r4.x + v[j].y * r4.y) + (v[j].z * r4.z + v[j].w * r4.w); }
#pragma unroll
            for (int e = 0; e < 8; ++e) lg[e] = wave_sum(lg[e]);
            if (lane == 0) {
                int e0 = 0; float v0 = lg[0];
#pragma unroll
                for (int e = 1; e < 8; ++e) if (lg[e] > v0) { v0 = lg[e]; e0 = e; }
                int e1 = -1; float v1 = -3.0e38f;
#pragma unroll
                for (int e = 0; e < 8; ++e) if (e != e0 && lg[e] > v1) { v1 = lg[e]; e1 = e; }
                const float p1 = __expf(v1 - v0), g0 = 1.f / (1.f + p1), g1 = p1 / (1.f + p1);
                const unsigned s0 = __hip_atomic_fetch_add(cntw + 64 * e0, 1u, RLX_AGENT), s1 = __hip_atomic_fetch_add(cntw + 64 * (8 + e1), 1u, RLX_AGENT);
                list[(size_t)e0 * 16384 + s0] = row; list[(size_t)(8 + e1) * 16384 + s1] = row; gate[row] = g0; gate[16384 + row] = g1;
            }
        }
    }
}

__device__ __forceinline__ void moe_gather(KArgs a, int j, int lane, int gw, int NGW) {
    unsigned char* ws = a->ws; const unsigned* cntw = (const unsigned*)(ws + WS_CTL) + CW_MOE + 64 * (j * 8);
    int pre[8], cum[8]; { int p = 0, t = 0;
#pragma unroll
        for (int e = 0; e < 8; ++e) { const int c = (int)cntw[64 * e]; pre[e] = p; cum[e] = t; p += c; t += (c + 255) >> 8; } }
    const int* list = (const int*)(ws + WS_LIST) + (size_t)j * 8 * 16384;
    for (int r0 = gw; r0 < M; r0 += 8 * NGW) {
        int tok[8], drow[8];
#pragma unroll
        for (int q = 0; q < 8; ++q) { const int r = r0 + q * NGW; tok[q] = -1; drow[q] = 0;
            if (r < M) { int e = 0;
#pragma unroll
                for (int k = 1; k < 8; ++k) e += (r >= pre[k]) ? 1 : 0;
                int pe = 0, ce = 0;
#pragma unroll
                for (int k = 0; k < 8; ++k) if (k == e) { pe = pre[k]; ce = cum[k]; }
                const int s = r - pe; tok[q] = list[(size_t)e * 16384 + s]; drow[q] = ce * 256 + s; } }
        v4u x0[8], x1[8];
#pragma unroll
        for (int q = 0; q < 8; ++q) { const v4u* src = (const v4u*)((const bf16*)(ws + WS_XB) + (size_t)(tok[q] >= 0 ? tok[q] : 0) * 1024); x0[q] = src[lane]; x1[q] = src[lane + 64]; }
#pragma unroll
        for (int q = 0; q < 8; ++q) if (tok[q] >= 0) { v4u* dst = (v4u*)((bf16*)(ws + WS_R + R_XG + (size_t)j * XG_PASS) + (size_t)drow[q] * 1024); dst[lane] = x0[q]; dst[lane + 64] = x1[q]; }
    }
}

__device__ __forceinline__ void gdn_prep_unit(KArgs a, int l, int unit, LAS unsigned char* lds, int tid, int lane, int wave) {
    unsigned char* ws = a->ws;
    const int n = unit & 31, bh = unit >> 5, h = bh & 3, b = bh >> 2;
    const int t0 = b * SEQ + n * 64;
    LAS float* Q = (LAS float*)lds; LAS float* K = Q + 8192; LAS float* V = K + 8192; LAS float* A = V + 8192; LAS float* gc = A + 4096; LAS float* bt = gc + 64;
    const bf16* HP = (const bf16*)(ws + WS_R + R_HP);
    const float* cw = a->in[2] + (size_t)l * 4 * 1536;
    __syncthreads();
    for (int idx = tid; idx < 64 * 384; idx += 512) { const int i = idx / 384, c = idx % 384, which = c >> 7, d = c & 127;
        const int col = COL_GQ + which * 512 + h * 128 + d, cc = which * 512 + h * 128 + d; float acc = 0.f;
#pragma unroll
        for (int j = 0; j < 4; ++j) { const int s = n * 64 + i - 3 + j; if (s >= 0) acc += cw[j * 1536 + cc] * bf2f(HP[(size_t)(b * SEQ + s) * HP_LD + col]); }
        const float y = siluf(acc); LAS float* dst = which == 0 ? Q : (which == 1 ? K : V); dst[i * 128 + d] = y; }
    if (tid < 64) { const float* gab = (const float*)(ws + WS_GAB) + (size_t)(t0 + tid) * 8; const float x = gab[h] + a->in[4][l * 4 + h];
        const float sp = fmaxf(x, 0.f) + log1pf(__expf(-fabsf(x))); gc[tid] = -__expf(a->in[3][l * 4 + h]) * sp; bt[tid] = sigmf(gab[4 + h]); }
    __syncthreads();
#pragma unroll 1
    for (int r = 0; r < 8; ++r) { const int i = wave * 8 + r;
        float q0 = Q[i * 128 + lane], q1 = Q[i * 128 + lane + 64], k0 = K[i * 128 + lane], k1 = K[i * 128 + lane + 64];
        const float sq = wave_sum(q0 * q0 + q1 * q1), sk = wave_sum(k0 * k0 + k1 * k1);
        const float fq = rsqrtf(sq + NORM_EPS) * 0.08838834764831845f, fk = rsqrtf(sk + NORM_EPS);
        Q[i * 128 + lane] = q0 * fq; Q[i * 128 + lane + 64] = q1 * fq; K[i * 128 + lane] = k0 * fk; K[i * 128 + lane + 64] = k1 * fk; }
    if (tid == 0) { float c = 0.f; for (int i = 0; i < 64; ++i) { c += gc[i]; gc[i] = c; } }
    __syncthreads();
    bf16* QKg = (bf16*)(ws + WS_R + R_QK) + (size_t)unit * 4096; bf16* QDg = (bf16*)(ws + WS_R + R_QD) + (size_t)unit * 8192; bf16* KDTg = (bf16*)(ws + WS_R + R_KDT) + (size_t)unit * 8192;
    bf16* WNg = (bf16*)(ws + WS_R + R_WN) + (size_t)unit * 8192; bf16* Ug = (bf16*)(ws + WS_R + R_U) + (size_t)unit * 8192;
    for (int idx = tid; idx < 4096; idx += 512) { const int i = idx >> 6, j = idx & 63; float dqk = 0.f, dkk = 0.f;
        for (int dd = 0; dd < 128; ++dd) { const int d = (dd + j) & 127; const float kj = K[j * 128 + d]; dqk += Q[i * 128 + d] * kj; dkk += K[i * 128 + d] * kj; }
        const float dec = __expf(gc[i] - gc[j]);
        A[i * 64 + j] = (j < i) ? bt[i] * dkk * dec : 0.f;
        QKg[fragoff(i, j, 2)] = (bf16)f2bf((j <= i) ? dqk * dec : 0.f); }
    const float gl = gc[63];
    for (int idx = tid; idx < 8192; idx += 512) { const int i = idx >> 7, d = idx & 127;
        QDg[fragoff(i, d, 4)] = (bf16)f2bf(Q[i * 128 + d] * __expf(gc[i]));
        KDTg[fragoff(d, i, 2)] = (bf16)f2bf(K[i * 128 + d] * __expf(gl - gc[i])); }
    if (tid == 0) ((float*)(ws + WS_CD))[unit] = __expf(gl);
    __syncthreads();
    for (int idx = tid; idx < 8192; idx += 512) { const int i = idx >> 7; const float bi = bt[i]; V[idx] *= bi; Q[idx] = bi * __expf(gc[i]) * K[idx]; }
    __syncthreads();
    if (tid < 256) { LAS float* buf = (tid < 128 ? V : Q) + (tid & 127);
        for (int i = 1; i < 64; ++i) { float acc = buf[i * 128]; for (int m = 0; m < i; ++m) acc -= A[i * 64 + m] * buf[m * 128]; buf[i * 128] = acc; } }
    __syncthreads();
    for (int idx = tid; idx < 8192; idx += 512) { const int i = idx >> 7, d = idx & 127; Ug[uoff(i, d)] = (bf16)f2bf(V[idx]); WNg[fragoff(i, d, 4)] = (bf16)f2bf(-Q[idx]); }
}

__device__ __forceinline__ void gdn_scan_naive(KArgs a, int l, int bh, LAS unsigned char* lds, int tid, int lane, int wave) {
    unsigned char* ws = a->ws;
    LAS float* S = (LAS float*)lds; LAS float* VN = S + 16384; LAS float* O = VN + 8192;
    const int h = bh & 3, b = bh >> 2, e = tid & 127, ig = tid >> 7;
    const bf16* HP = (const bf16*)(ws + WS_R + R_HP); bf16* OB = (bf16*)(ws + WS_R + R_OB);
    const float* nw = a->in[5] + l * 128;
    __syncthreads();
    for (int idx = tid; idx < 16384; idx += 512) S[idx] = 0.f;
    __syncthreads();
#pragma unroll 1
    for (int n = 0; n < 32; ++n) {
        const int unit = bh * 32 + n;
        const bf16* Ug = (const bf16*)(ws + WS_R + R_U) + (size_t)unit * 8192; const bf16* WNg = (const bf16*)(ws + WS_R + R_WN) + (size_t)unit * 8192;
        const bf16* QDg = (const bf16*)(ws + WS_R + R_QD) + (size_t)unit * 8192; const bf16* KDTg = (const bf16*)(ws + WS_R + R_KDT) + (size_t)unit * 8192;
        const bf16* QKg = (const bf16*)(ws + WS_R + R_QK) + (size_t)unit * 4096; const float cd = ((const float*)(ws + WS_CD))[unit];
#pragma unroll 1
        for (int r = 0; r < 16; ++r) { const int i = ig + 4 * r; float acc = bf2f(Ug[uoff(i, e)]);
#pragma unroll 2
            for (int d0 = 0; d0 < 128; d0 += 4) { const v2u w = *(const v2u*)(WNg + fragoff(i, d0, 4));
                acc += bflo(w.x) * S[d0 * 128 + e] + bfhi(w.x) * S[(d0 + 1) * 128 + e] + bflo(w.y) * S[(d0 + 2) * 128 + e] + bfhi(w.y) * S[(d0 + 3) * 128 + e]; }
            VN[i * 128 + e] = acc; }
        __syncthreads();
#pragma unroll 1
        for (int r = 0; r < 16; ++r) { const int i = ig + 4 * r; float acc = 0.f;
#pragma unroll 2
            for (int d0 = 0; d0 < 128; d0 += 4) { const v2u w = *(const v2u*)(QDg + fragoff(i, d0, 4));
                acc += bflo(w.x) * S[d0 * 128 + e] + bfhi(w.x) * S[(d0 + 1) * 128 + e] + bflo(w.y) * S[(d0 + 2) * 128 + e] + bfhi(w.y) * S[(d0 + 3) * 128 + e]; }
#pragma unroll 2
            for (int j0 = 0; j0 < 64; j0 += 4) { const v2u w = *(const v2u*)(QKg + fragoff(i, j0, 2));
                acc += bflo(w.x) * VN[j0 * 128 + e] + bfhi(w.x) * VN[(j0 + 1) * 128 + e] + bflo(w.y) * VN[(j0 + 2) * 128 + e] + bfhi(w.y) * VN[(j0 + 3) * 128 + e]; }
            O[i * 128 + e] = acc; }
        __syncthreads();
#pragma unroll 1
        for (int r = 0; r < 32; ++r) { const int d = ig + 4 * r; float acc = S[d * 128 + e] * cd;
#pragma unroll 2
            for (int i0 = 0; i0 < 64; i0 += 4) { const v2u w = *(const v2u*)(KDTg + fragoff(d, i0, 2));
                acc += bflo(w.x) * VN[i0 * 128 + e] + bfhi(w.x) * VN[(i0 + 1) * 128 + e] + bflo(w.y) * VN[(i0 + 2) * 128 + e] + bfhi(w.y) * VN[(i0 + 3) * 128 + e]; }
            S[d * 128 + e] = acc; }
#pragma unroll 1
        for (int r = 0; r < 8; ++r) { const int i = wave * 8 + r; const float v0 = O[i * 128 + lane], v1 = O[i * 128 + lane + 64];
            const float rs = rsqrtf(wave_sum(v0 * v0 + v1 * v1) * (1.f / 128.f) + NORM_EPS);
            const size_t t = (size_t)b * SEQ + n * 64 + i; const bf16* gp = HP + t * HP_LD + COL_GG + h * 128; bf16* op = OB + t * 1024 + 512 + h * 128;
            op[lane] = (bf16)f2bf(v0 * rs * nw[lane] * siluf(bf2f(gp[lane]))); op[lane + 64] = (bf16)f2bf(v1 * rs * nw[lane + 64] * siluf(bf2f(gp[lane + 64]))); }
        __syncthreads();
    }
}

__device__ __forceinline__ void ret_unit_naive(KArgs a, int unit, LAS unsigned char* lds, int tid, int lane, int wave) {
    unsigned char* ws = a->ws;
    LAS float* Qs = (LAS float*)lds; LAS float* Ks = Qs + 64 * 65; LAS float* Vs = Ks + 64 * 65; LAS float* Sc = Vs + 8192;
    const int qb = unit & 31, bh = unit >> 5, h = bh & 3, b = bh >> 2, e = tid & 127, ig = tid >> 7;
    const bf16* HP = (const bf16*)(ws + WS_R + R_HP); bf16* OB = (bf16*)(ws + WS_R + R_OB); const float* RT = (const float*)(ws + WS_ROPE);
    const float log2g = log2f(1.0f - exp2f(-5.0f - (float)h));
    __syncthreads();
    for (int idx = tid; idx < 4096; idx += 512) { const int i = idx >> 6, d = idx & 63, dd = d & 31, pos = qb * 64 + i; const size_t t = (size_t)b * SEQ + pos;
        const float c = RT[pos * 64 + dd], s = RT[pos * 64 + 32 + dd]; const float x1 = bf2f(HP[t * HP_LD + COL_RQ + h * 64 + dd]), x2 = bf2f(HP[t * HP_LD + COL_RQ + h * 64 + dd + 32]);
        Qs[i * 65 + d] = d < 32 ? x1 * c - x2 * s : x1 * s + x2 * c; }
    float acc[16];
#pragma unroll
    for (int r = 0; r < 16; ++r) acc[r] = 0.f;
#pragma unroll 1
    for (int kb = 0; kb <= qb; ++kb) {
        __syncthreads();
        for (int idx = tid; idx < 4096; idx += 512) { const int i = idx >> 6, d = idx & 63, dd = d & 31, pos = kb * 64 + i; const size_t t = (size_t)b * SEQ + pos;
            const float c = RT[pos * 64 + dd], s = RT[pos * 64 + 32 + dd]; const float x1 = bf2f(HP[t * HP_LD + COL_RK + h * 64 + dd]), x2 = bf2f(HP[t * HP_LD + COL_RK + h * 64 + dd + 32]);
            Ks[i * 65 + d] = 0.125f * (d < 32 ? x1 * c - x2 * s : x1 * s + x2 * c); }
        for (int idx = tid; idx < 8192; idx += 512) { const int i = idx >> 7, d = idx & 127; Vs[idx] = bf2f(HP[((size_t)b * SEQ + kb * 64 + i) * HP_LD + COL_RV + h * 128 + d]); }
        __syncthreads();
        { const int j = tid & 63, ig8 = tid >> 6;
#pragma unroll 1
          for (int r = 0; r < 8; ++r) { const int i = ig8 + 8 * r; float dot = 0.f;
#pragma unroll 8
              for (int d = 0; d < 64; ++d) dot += Qs[i * 65 + d] * Ks[j * 65 + d];
              const int delta = (qb - kb) * 64 + i - j; Sc[i * 65 + j] = delta >= 0 ? dot * exp2f((float)delta * log2g) : 0.f; } }
        __syncthreads();
#pragma unroll 2
        for (int j = 0; j < 64; ++j) { const float vv = Vs[j * 128 + e];
#pragma unroll
            for (int r = 0; r < 16; ++r) acc[r] += Sc[(ig + 4 * r) * 65 + j] * vv; }
    }
    __syncthreads();
#pragma unroll
    for (int r = 0; r < 16; ++r) Vs[(ig + 4 * r) * 128 + e] = acc[r];
    __syncthreads();
#pragma unroll 1
    for (int r = 0; r < 8; ++r) { const int i = wave * 8 + r; const float v0 = Vs[i * 128 + lane], v1 = Vs[i * 128 + lane + 64];
        const float mean = wave_sum(v0 + v1) * (1.f / 128.f), d0 = v0 - mean, d1 = v1 - mean; const float rs = rsqrtf(wave_sum(d0 * d0 + d1 * d1) * (1.f / 128.f) + LN_EPS);
        const size_t t = (size_t)b * SEQ + qb * 64 + i; const bf16* gp = HP + t * HP_LD + COL_RG + h * 128; bf16* op = OB + t * 1024 + h * 128;
        op[lane] = (bf16)f2bf(d0 * rs * siluf(bf2f(gp[lane]))); op[lane + 64] = (bf16)f2bf(d1 * rs * siluf(bf2f(gp[lane + 64]))); }
}

typedef float f32x16 __attribute__((ext_vector_type(16)));
typedef float f32x8 __attribute__((ext_vector_type(8)));
typedef __bf16 bf8v __attribute__((ext_vector_type(8)));
typedef short bf16x8 __attribute__((ext_vector_type(8)));
#define MFMA32(a, b, c) __builtin_amdgcn_mfma_f32_32x32x16_bf16((a), (b), (c), 0, 0, 0)
__device__ __forceinline__ bf16x8 pack8(const f32x16& x, int s) {
    f32x8 v;
#pragma unroll
    for (int j = 0; j < 8; ++j) v[j] = x[8 * s + j];
    return __builtin_bit_cast(bf16x8, __builtin_convertvector(v, bf8v));
}

__device__ __forceinline__ unsigned short bfc(float x) { return __builtin_bit_cast(unsigned short, (__bf16)x); }
__device__ __forceinline__ unsigned bfc2(float lo, float hi) { return (unsigned)bfc(lo) | ((unsigned)bfc(hi) << 16); }

#define GDN_BAR() do { asm volatile("s_waitcnt lgkmcnt(0)" ::: "memory"); __builtin_amdgcn_s_barrier(); asm volatile("" ::: "memory"); } while (0)
__device__ __forceinline__ void gdn_scan_fast(KArgs a, int l, int bh, LAS unsigned char* lds, int tid, int lane, int wave) {
    unsigned char* ws = a->ws;
    constexpr int FB_WN = 0, FB_QD = 16384, FB_KDT = 32768, FB_QK = 49152, FB_U = 57344, FB_BYTES = 73728;
    LAS float* OL = (LAS float*)(lds + FB_BYTES);
    constexpr int OLS = 64 * 132;
    const int h = bh & 3, b = bh >> 2, c = lane & 31, hh = lane >> 5;
    const bf16* HP = (const bf16*)(ws + WS_R + R_HP); bf16* OB = (bf16*)(ws + WS_R + R_OB);
    const float* nw = a->in[5] + l * 128;
    const unsigned char* gWN = (const unsigned char*)(ws + WS_R + R_WN) + (size_t)bh * 32 * 16384; const unsigned char* gQD = (const unsigned char*)(ws + WS_R + R_QD) + (size_t)bh * 32 * 16384;
    const unsigned char* gKDT = (const unsigned char*)(ws + WS_R + R_KDT) + (size_t)bh * 32 * 16384; const unsigned char* gQK = (const unsigned char*)(ws + WS_R + R_QK) + (size_t)bh * 32 * 8192;
    const unsigned char* gU = (const unsigned char*)(ws + WS_R + R_U) + (size_t)bh * 32 * 16384;
    const int et = tid - 256;
#define GDN_FETCH(pf, nn) do { _Pragma("unroll") for (int k = 0; k < 18; ++k) { const unsigned char* src_ = k < 4 ? gWN + (size_t)(nn) * 16384 + k * 4096 : k < 8 ? gQD + (size_t)(nn) * 16384 + (k - 4) * 4096 : \
        k < 12 ? gKDT + (size_t)(nn) * 16384 + (k - 8) * 4096 : k < 14 ? gQK + (size_t)(nn) * 8192 + (k - 12) * 4096 : gU + (size_t)(nn) * 16384 + (k - 14) * 4096; pf[k] = *(const v4u*)(src_ + et * 16); } } while (0)
#define GDN_STORE(pf) do { _Pragma("unroll") for (int k = 0; k < 18; ++k) *(LAS v4u*)(lds + k * 4096 + et * 16) = pf[k]; } while (0)
    __syncthreads();
    if (wave < 4) {
        f32x16 S[4];
#pragma unroll
        for (int t = 0; t < 4; ++t)
#pragma unroll
            for (int i = 0; i < 16; ++i) S[t][i] = 0.f;
        GDN_BAR();
        const int q = wave;
        const LAS bf16x8* WNf = (const LAS bf16x8*)(lds + FB_WN) + lane; const LAS bf16x8* QDf = (const LAS bf16x8*)(lds + FB_QD) + lane;
        const LAS bf16x8* KDTf = (const LAS bf16x8*)(lds + FB_KDT) + lane; const LAS bf16x8* QKf = (const LAS bf16x8*)(lds + FB_QK) + lane;
        const LAS v4u* Uf = (const LAS v4u*)(lds + FB_U) + (q * 2) * 128 + lane;
#pragma unroll 1
        for (int n = 0; n < 32; ++n) {
            const float cd = ((const float*)(ws + WS_CD))[bh * 32 + n];
            bf16x8 A0[8], A1[8];
#define GDN_LD_MTS(A, F, g) do { _Pragma("unroll") for (int k = 0; k < 8; ++k) { const int m_ = k & 1, s_ = (k >> 1) & 1, t_ = 2 * (g) + (k >> 2); A[k] = F[((m_ * 4 + t_) * 2 + s_) * 64]; } } while (0)
#define GDN_LD_TMS(A, F, g) do { _Pragma("unroll") for (int k = 0; k < 8; ++k) { const int s_ = k & 1, m_ = (k >> 1) & 1, t_ = 2 * (g) + (k >> 2); A[k] = F[((t_ * 2 + m_) * 2 + s_) * 64]; } } while (0)
            GDN_LD_MTS(A0, WNf, 0); GDN_LD_MTS(A1, WNf, 1);
            f32x16 av[2];
#pragma unroll
            for (int m = 0; m < 2; ++m)
#pragma unroll
                for (int hf = 0; hf < 2; ++hf) { const v4u u4 = Uf[(m * 2 + hf) * 64];
#pragma unroll
                    for (int k = 0; k < 4; ++k) { av[m][8 * hf + 2 * k] = bflo(u4[k]); av[m][8 * hf + 2 * k + 1] = bfhi(u4[k]); } }
            bf16x8 Sb[4][2];
#pragma unroll
            for (int t = 0; t < 4; ++t) { Sb[t][0] = pack8(S[t], 0); Sb[t][1] = pack8(S[t], 1); }
#pragma unroll
            for (int k = 0; k < 8; ++k) { const int m_ = k & 1, s_ = (k >> 1) & 1, t_ = (k >> 2); av[m_] = MFMA32(A0[k], Sb[t_][s_], av[m_]); }
            GDN_LD_MTS(A0, QDf, 0);
#pragma unroll
            for (int k = 0; k < 8; ++k) { const int m_ = k & 1, s_ = (k >> 1) & 1, t_ = 2 + (k >> 2); av[m_] = MFMA32(A1[k], Sb[t_][s_], av[m_]); }
            GDN_LD_MTS(A1, QDf, 1);
            f32x16 ao[2];
#pragma unroll
            for (int m = 0; m < 2; ++m)
#pragma unroll
                for (int i = 0; i < 16; ++i) ao[m][i] = 0.f;
#pragma unroll
            for (int k = 0; k < 8; ++k) { const int m_ = k & 1, s_ = (k >> 1) & 1, t_ = (k >> 2); ao[m_] = MFMA32(A0[k], Sb[t_][s_], ao[m_]); }
#pragma unroll
            for (int k = 0; k < 6; ++k) { const int s_ = k & 1, m_ = k >= 2 ? 1 : 0, mp_ = k >= 4 ? 1 : 0; A0[k] = QKf[((m_ * 2 + mp_) * 2 + s_) * 64]; }
#pragma unroll
            for (int k = 0; k < 8; ++k) { const int m_ = k & 1, s_ = (k >> 1) & 1, t_ = 2 + (k >> 2); ao[m_] = MFMA32(A1[k], Sb[t_][s_], ao[m_]); }
            GDN_LD_TMS(A1, KDTf, 0);
            bf16x8 Vb[2][2];
#pragma unroll
            for (int m = 0; m < 2; ++m) { Vb[m][0] = pack8(av[m], 0); Vb[m][1] = pack8(av[m], 1); }
#pragma unroll
            for (int k = 0; k < 6; ++k) { const int s_ = k & 1, m_ = k >= 2 ? 1 : 0, mp_ = k >= 4 ? 1 : 0; ao[m_] = MFMA32(A0[k], Vb[mp_][s_], ao[m_]); }
            GDN_LD_TMS(A0, KDTf, 1);
            {   LAS float* Ob = OL + (n & 1) * OLS + 32 * wave + c;
#pragma unroll
                for (int m = 0; m < 2; ++m)
#pragma unroll
                    for (int i = 0; i < 16; ++i) Ob[(32 * m + (i & 3) + 8 * (i >> 2) + 4 * hh) * 132] = ao[m][i]; }
#pragma unroll
            for (int t = 0; t < 4; ++t)
#pragma unroll
                for (int i = 0; i < 16; ++i) S[t][i] *= cd;
#pragma unroll
            for (int k = 0; k < 8; ++k) { const int s_ = k & 1, m_ = (k >> 1) & 1, t_ = (k >> 2); S[t_] = MFMA32(A1[k], Vb[m_][s_], S[t_]); }
#pragma unroll
            for (int k = 0; k < 8; ++k) { const int s_ = k & 1, m_ = (k >> 1) & 1, t_ = 2 + (k >> 2); S[t_] = MFMA32(A0[k], Vb[m_][s_], S[t_]); }
#undef GDN_LD_MTS
#undef GDN_LD_TMS
            GDN_BAR();
            GDN_BAR();
        }
        GDN_BAR(); GDN_BAR();
    } else {
        v4u pfA[18], pfB[18];
        LAS float* NWl = OL + 2 * OLS;
        if (et < 128) NWl[et] = nw[et];
        GDN_FETCH(pfB, 0); GDN_FETCH(pfA, 1); GDN_STORE(pfB);
        GDN_BAR();
        const int i = et >> 2, qd = et & 3;
#define GDN_LOADER_ITER(n, PF_FETCH, PF_STORE) do { \
            if ((n) + 2 < 32) GDN_FETCH(PF_FETCH, (n) + 2); \
            if ((n) > 0) { \
                const LAS float* Ob = OL + (((n) - 1) & 1) * OLS + i * 132 + 32 * qd; \
                float ss = 0.f; \
                _Pragma("unroll") for (int k = 0; k < 8; ++k) { const f32x4 v_ = *(const LAS f32x4*)(Ob + 4 * k); ss += (v_.x * v_.x + v_.y * v_.y) + (v_.z * v_.z + v_.w * v_.w); } \
                ss += __shfl_xor(ss, 1); ss += __shfl_xor(ss, 2); \
                const float rs = rsqrtf(ss * (1.f / 128.f) + NORM_EPS); \
                bf16* op = OB + ((size_t)b * SEQ + ((n) - 1) * 64 + i) * 1024 + 512 + h * 128 + 32 * qd; \
                _Pragma("unroll") for (int k = 0; k < 4; ++k) { const f32x4 w0 = *(const LAS f32x4*)(NWl + 32 * qd + 8 * k), w1 = *(const LAS f32x4*)(NWl + 32 * qd + 8 * k + 4); const v4u gg = gq[k]; \
                    const f32x4 a0 = *(const LAS f32x4*)(Ob + 8 * k), a1 = *(const LAS f32x4*)(Ob + 8 * k + 4); \
                    v4u o; o.x = bfc2(a0.x * rs * w0.x * siluf(bflo(gg.x)), a0.y * rs * w0.y * siluf(bfhi(gg.x))); o.y = bfc2(a0.z * rs * w0.z * siluf(bflo(gg.y)), a0.w * rs * w0.w * siluf(bfhi(gg.y))); \
                    o.z = bfc2(a1.x * rs * w1.x * siluf(bflo(gg.z)), a1.y * rs * w1.y * siluf(bfhi(gg.z))); o.w = bfc2(a1.z * rs * w1.z * siluf(bflo(gg.w)), a1.w * rs * w1.w * siluf(bfhi(gg.w))); \
                    *(v4u*)(op + 8 * k) = o; } \
            } \
            asm volatile("" ::: "memory"); \
            if ((n) < 32) { const bf16* gp = HP + ((size_t)b * SEQ + (n) * 64 + i) * HP_LD + COL_GG + h * 128 + 32 * qd;     \
                _Pragma("unroll") for (int k = 0; k < 4; ++k) gq[k] = *(const v4u*)(gp + 8 * k); } \
            GDN_BAR();            \
            if ((n) + 1 < 32) GDN_STORE(PF_STORE); \
            GDN_BAR();            \
        } while (0)
        v4u gq[4];
#pragma unroll
        for (int k = 0; k < 4; ++k) gq[k] = (v4u){0u, 0u, 0u, 0u};
#pragma unroll
        for (int n = 0; n < 32; n += 2) {
            GDN_LOADER_ITER(n, pfB, pfA);
            GDN_LOADER_ITER(n + 1, pfA, pfB);
        }
        GDN_LOADER_ITER(32, pfB, pfA);
#undef GDN_LOADER_ITER
    }
#undef GDN_FETCH
#undef GDN_STORE
}

struct RetLds {
    static constexpr int QS = 72, JS = 136;
    static constexpr int P = 0, Q1 = 34816, K1 = 53248, OL = 0, K1T = 71680, VT = 89088, ST = 123904;
};
template <bool WANT_Q, bool WANT_K1, bool WANT_K1T>
__device__ __forceinline__ void ret_stage(const bf16* HP, const float* RT, int b, int h, int n, float lg, LAS unsigned char* lds, int tid) {
    constexpr int QS = RetLds::QS, JS = RetLds::JS;
    LAS bf16* Q1 = (LAS bf16*)(lds + RetLds::Q1); LAS bf16* K1 = (LAS bf16*)(lds + RetLds::K1); LAS bf16* K1T = (LAS bf16*)(lds + RetLds::K1T); LAS bf16* VT = (LAS bf16*)(lds + RetLds::VT);
    const int i = tid >> 2, dd = (tid & 3) * 8, pos = n * 128 + i; const size_t t = (size_t)b * SEQ + pos;
    const bf16* hp = HP + t * HP_LD;
    const f32x4 c0 = *(const f32x4*)(RT + pos * 64 + dd), c1 = *(const f32x4*)(RT + pos * 64 + dd + 4), s0 = *(const f32x4*)(RT + pos * 64 + 32 + dd), s1 = *(const f32x4*)(RT + pos * 64 + 32 + dd + 4);
    const float cs[8] = {c0.x, c0.y, c0.z, c0.w, c1.x, c1.y, c1.z, c1.w}, sn[8] = {s0.x, s0.y, s0.z, s0.w, s1.x, s1.y, s1.z, s1.w};
    const float sq = exp2f((float)i * lg), sk = 0.125f * exp2f(-(float)i * lg);
    v4u xv[4];
#pragma unroll
    for (int p = 0; p < 4; ++p) { const int idx = tid + 512 * p, j = idx >> 4, e0 = (idx & 15) * 8; xv[p] = *(const v4u*)(HP + ((size_t)b * SEQ + n * 128 + j) * HP_LD + COL_RV + h * 128 + e0); }
#pragma unroll
    for (int which = (WANT_Q ? 0 : 1); which < 2; ++which) {
        const bf16* src = hp + (which == 0 ? COL_RQ : COL_RK) + h * 64 + dd;
        const v4u x1 = *(const v4u*)src, x2 = *(const v4u*)(src + 32);
        const float sc = which == 0 ? sq : sk;
        float lo[8], hi[8];
#pragma unroll
        for (int k = 0; k < 4; ++k) { const float a0 = bflo(x1[k]), a1 = bfhi(x1[k]), b0 = bflo(x2[k]), b1 = bfhi(x2[k]);
            lo[2 * k] = (a0 * cs[2 * k] - b0 * sn[2 * k]) * sc; lo[2 * k + 1] = (a1 * cs[2 * k + 1] - b1 * sn[2 * k + 1]) * sc;
            hi[2 * k] = (a0 * sn[2 * k] + b0 * cs[2 * k]) * sc; hi[2 * k + 1] = (a1 * sn[2 * k + 1] + b1 * cs[2 * k + 1]) * sc; }
        v4u wl, wh;
#pragma unroll
        for (int k = 0; k < 4; ++k) { wl[k] = bfc2(lo[2 * k], lo[2 * k + 1]); wh[k] = bfc2(hi[2 * k], hi[2 * k + 1]); }
        if (which == 0 || WANT_K1) { LAS bf16* dst = (which == 0 ? Q1 : K1) + i * QS + dd; *(LAS v4u*)dst = wl; *(LAS v4u*)(dst + 32) = wh; }
        if (which == 1 && WANT_K1T) {
#pragma unroll
            for (int k = 0; k < 4; ++k) { K1T[(dd + 2 * k) * JS + i] = (bf16)(wl[k] & 0xffffu); K1T[(dd + 2 * k + 1) * JS + i] = (bf16)(wl[k] >> 16);
                K1T[(32 + dd + 2 * k) * JS + i] = (bf16)(wh[k] & 0xffffu); K1T[(32 + dd + 2 * k + 1) * JS + i] = (bf16)(wh[k] >> 16); }
        }
    }
#pragma unroll
    for (int p = 0; p < 4; ++p) { const int idx = tid + 512 * p, j = idx >> 4, e0 = (idx & 15) * 8;
#pragma unroll
        for (int k = 0; k < 4; ++k) { VT[(e0 + 2 * k) * JS + j] = (bf16)(xv[p][k] & 0xffffu); VT[(e0 + 2 * k + 1) * JS + j] = (bf16)(xv[p][k] >> 16); } }
}
__device__ __forceinline__ void ret_kv_unit(KArgs a, int unit, LAS unsigned char* lds, int tid, int lane, int wave) {
    unsigned char* ws = a->ws;
    constexpr int JS = RetLds::JS;
    const int n = unit & 15, bh = unit >> 4, h = bh & 3, b = bh >> 2, c = lane & 31, hh = lane >> 5;
    const bf16* HP = (const bf16*)(ws + WS_R + R_HP); const float* RT = (const float*)(ws + WS_ROPE);
    const float gam = 1.0f - exp2f(-5.0f - (float)h), lg = log2f(gam), g127 = exp2f(127.f * lg);
    LAS bf16* K1T = (LAS bf16*)(lds + RetLds::K1T); LAS bf16* VT = (LAS bf16*)(lds + RetLds::VT);
    __syncthreads();
    ret_stage<false, false, true>(HP, RT, b, h, n, lg, lds, tid);
    __syncthreads();
    const int td = wave >> 2, te = wave & 3;
    f32x16 kv;
#pragma unroll
    for (int i = 0; i < 16; ++i) kv[i] = 0.f;
#pragma unroll
    for (int ks = 0; ks < 8; ++ks) kv = MFMA32(*(const LAS bf16x8*)(K1T + (32 * td + c) * JS + 16 * ks + 8 * hh), *(const LAS bf16x8*)(VT + (32 * te + c) * JS + 16 * ks + 8 * hh), kv);
    float* dst = (float*)(ws + WS_KV) + ((size_t)(unit * 8 + wave) * 64 + lane) * 16;
#pragma unroll
    for (int g = 0; g < 4; ++g) *(f32x4*)(dst + 4 * g) = (f32x4){kv[4 * g] * g127, kv[4 * g + 1] * g127, kv[4 * g + 2] * g127, kv[4 * g + 3] * g127};
}
__device__ __forceinline__ void ret_out_unit(KArgs a, int unit, LAS unsigned char* lds, int tid, int lane, int wave) {
    unsigned char* ws = a->ws;
    constexpr int QS = RetLds::QS, JS = RetLds::JS;
    LAS bf16* P = (LAS bf16*)(lds + RetLds::P); LAS bf16* Q1 = (LAS bf16*)(lds + RetLds::Q1); LAS bf16* K1 = (LAS bf16*)(lds + RetLds::K1); LAS float* OL = (LAS float*)(lds + RetLds::OL);
    LAS bf16* VT = (LAS bf16*)(lds + RetLds::VT); LAS bf16* ST = (LAS bf16*)(lds + RetLds::ST);
    const int n = unit & 15, bh = unit >> 4, h = bh & 3, b = bh >> 2, c = lane & 31, hh = lane >> 5;
    const bf16* HP = (const bf16*)(ws + WS_R + R_HP); bf16* OB = (bf16*)(ws + WS_R + R_OB); const float* RT = (const float*)(ws + WS_ROPE);
    const float gam = 1.0f - exp2f(-5.0f - (float)h), lg = log2f(gam), g128 = exp2f(128.f * lg);
    __syncthreads();
    const int ei = tid >> 2, eq = tid & 3; const size_t et = (size_t)b * SEQ + n * 128 + ei;
    v4u gg[4];
    { const bf16* gp = HP + et * HP_LD + COL_RG + h * 128 + 32 * eq;
#pragma unroll
      for (int k = 0; k < 4; ++k) gg[k] = *(const v4u*)(gp + 8 * k); }
    {
        const int td = wave >> 2, te = wave & 3;
        f32x16 S;
#pragma unroll
        for (int i = 0; i < 16; ++i) S[i] = 0.f;
        const float* src = (const float*)(ws + WS_KV) + ((size_t)((bh * 16) * 8 + wave) * 64 + lane) * 16;
#pragma unroll 2
        for (int m = 0; m < n; ++m) { const f32x4* p4 = (const f32x4*)(src + (size_t)m * 8 * 64 * 16);
#pragma unroll
            for (int g = 0; g < 4; ++g) { const f32x4 v = p4[g]; S[4 * g] = S[4 * g] * g128 + v.x; S[4 * g + 1] = S[4 * g + 1] * g128 + v.y; S[4 * g + 2] = S[4 * g + 2] * g128 + v.z; S[4 * g + 3] = S[4 * g + 3] * g128 + v.w; } }
#pragma unroll
        for (int g = 0; g < 4; ++g) { v2u w; w.x = bfc2(S[4 * g], S[4 * g + 1]); w.y = bfc2(S[4 * g + 2], S[4 * g + 3]); *(LAS v2u*)(ST + (32 * te + c) * QS + 32 * td + 8 * g + 4 * hh) = w; }
    }
    ret_stage<true, true, false>(HP, RT, b, h, n, lg, lds, tid);
    __syncthreads();
#pragma unroll 1
    for (int rep = 0; rep < 2; ++rep) { const int idx = wave + 8 * rep;
        if (idx < 10) { const int ti = (idx >= 1) + (idx >= 3) + (idx >= 6), tj = idx - ti * (ti + 1) / 2;
            f32x16 acc;
#pragma unroll
            for (int i = 0; i < 16; ++i) acc[i] = 0.f;
#pragma unroll
            for (int s2 = 0; s2 < 4; ++s2) acc = MFMA32(*(const LAS bf16x8*)(Q1 + (32 * ti + c) * QS + 16 * s2 + 8 * hh), *(const LAS bf16x8*)(K1 + (32 * tj + c) * QS + 16 * s2 + 8 * hh), acc);
#pragma unroll
            for (int i = 0; i < 16; ++i) { const int il = (i & 3) + 8 * (i >> 2) + 4 * hh; float v = acc[i]; if (ti == tj && il < c) v = 0.f; P[(32 * ti + il) * JS + 32 * tj + c] = bfc(v); } } }
    __syncthreads();
    const int ti = wave >> 1, te0 = 2 * (wave & 1);
    f32x16 ao[2];
#pragma unroll
    for (int u = 0; u < 2; ++u)
#pragma unroll
        for (int i = 0; i < 16; ++i) ao[u][i] = 0.f;
#pragma unroll
    for (int s2 = 0; s2 < 4; ++s2) { const bf16x8 A = *(const LAS bf16x8*)(Q1 + (32 * ti + c) * QS + 16 * s2 + 8 * hh);
#pragma unroll
        for (int u = 0; u < 2; ++u) ao[u] = MFMA32(A, *(const LAS bf16x8*)(ST + (32 * (te0 + u) + c) * QS + 16 * s2 + 8 * hh), ao[u]); }
#pragma unroll
    for (int u = 0; u < 2; ++u)
#pragma unroll
        for (int i = 0; i < 16; ++i) ao[u][i] *= gam;
#pragma unroll 1
    for (int tj = 0; tj <= ti; ++tj)
#pragma unroll
        for (int s2 = 0; s2 < 2; ++s2) { const bf16x8 A = *(const LAS bf16x8*)(P + (32 * ti + c) * JS + 32 * tj + 16 * s2 + 8 * hh);
#pragma unroll
            for (int u = 0; u < 2; ++u) ao[u] = MFMA32(A, *(const LAS bf16x8*)(VT + (32 * (te0 + u) + c) * JS + 32 * tj + 16 * s2 + 8 * hh), ao[u]); }
    __syncthreads();
#pragma unroll
    for (int u = 0; u < 2; ++u)
#pragma unroll
        for (int i = 0; i < 16; ++i) OL[(32 * ti + (i & 3) + 8 * (i >> 2) + 4 * hh) * 132 + 32 * (te0 + u) + c] = ao[u][i];
    __syncthreads();
    {
        const LAS float* Ob = OL + ei * 132 + 32 * eq; bf16* op = OB + et * 1024 + h * 128 + 32 * eq;
        f32x4 v[8]; float sm = 0.f;
#pragma unroll
        for (int k = 0; k < 8; ++k) { v[k] = *(const LAS f32x4*)(Ob + 4 * k); sm += (v[k].x + v[k].y) + (v[k].z + v[k].w); }
        sm += __shfl_xor(sm, 1); sm += __shfl_xor(sm, 2);
        const float mean = sm * (1.f / 128.f); float sq = 0.f;
#pragma unroll
        for (int k = 0; k < 8; ++k) { v[k] = v[k] - mean; sq += (v[k].x * v[k].x + v[k].y * v[k].y) + (v[k].z * v[k].z + v[k].w * v[k].w); }
        sq += __shfl_xor(sq, 1); sq += __shfl_xor(sq, 2);
        const float rs = rsqrtf(sq * (1.f / 128.f) + LN_EPS);
#pragma unroll
        for (int k = 0; k < 4; ++k) { const v4u g4 = gg[k]; const f32x4 a0 = v[2 * k], a1 = v[2 * k + 1];
            v4u o; o.x = bfc2(a0.x * rs * siluf(bflo(g4.x)), a0.y * rs * siluf(bfhi(g4.x))); o.y = bfc2(a0.z * rs * siluf(bflo(g4.y)), a0.w * rs * siluf(bfhi(g4.y)));
            o.z = bfc2(a1.x * rs * siluf(bflo(g4.z)), a1.y * rs * siluf(bfhi(g4.z))); o.w = bfc2(a1.z * rs * siluf(bflo(g4.w)), a1.w * rs * siluf(bfhi(g4.w)));
            *(v4u*)(op + 8 * k) = o; }
    }
}

__device__ __forceinline__ void gdn_prep_fast(KArgs a, int l, int unit, LAS unsigned char* lds, int tid, int lane, int wave) {
    unsigned char* ws = a->ws;
    constexpr int KS = 136;
    LAS bf16* Kb = (LAS bf16*)lds;
    LAS bf16* Qb = (LAS bf16*)(lds + 17408);
    LAS float* A = (LAS float*)(lds + 34816);
    LAS float* V = (LAS float*)(lds + 51200);
    LAS float* KW = (LAS float*)(lds + 83968);
    LAS float* gc = (LAS float*)(lds + 116736);
    LAS float* bt = gc + 64;
    LAS bf16* KDs = (LAS bf16*)(lds + 117248);
    const int n = unit & 31, bh = unit >> 5, h = bh & 3, b = bh >> 2, t0 = b * SEQ + n * 64, c = lane & 31, hh = lane >> 5;
    const bf16* HP = (const bf16*)(ws + WS_R + R_HP);
    bf16* QKg = (bf16*)(ws + WS_R + R_QK) + (size_t)unit * 4096; bf16* QDg = (bf16*)(ws + WS_R + R_QD) + (size_t)unit * 8192; bf16* KDTg = (bf16*)(ws + WS_R + R_KDT) + (size_t)unit * 8192;
    bf16* WNg = (bf16*)(ws + WS_R + R_WN) + (size_t)unit * 8192; bf16* Ug = (bf16*)(ws + WS_R + R_U) + (size_t)unit * 8192;
    __syncthreads();
    if (wave == 0) {
        const float* gab = (const float*)(ws + WS_GAB) + (size_t)(t0 + lane) * 8; const float x = gab[h] + a->in[4][l * 4 + h];
        const float sp = fmaxf(x, 0.f) + log1pf(__expf(-fabsf(x))); float g = -__expf(a->in[3][l * 4 + h]) * sp;
#pragma unroll
        for (int o = 1; o < 64; o <<= 1) { const float up = __shfl_up(g, o); if (lane >= o) g += up; }
        gc[lane] = g; bt[lane] = sigmf(gab[4 + h]);
        if (lane == 63) ((float*)(ws + WS_CD))[unit] = __expf(g);
    }
    __syncthreads();
#ifndef PREP_NO_CONV
    if (wave < 6) {
        const int cg = tid % 48, rb = tid / 48, which = cg >> 4, dd = (cg & 15) * 8, col = COL_GQ + which * 512 + h * 128 + dd, cc = which * 512 + h * 128 + dd;
        const float* cw = a->in[2] + (size_t)l * 4 * 1536 + cc;
        float w[4][8];
#pragma unroll
        for (int j = 0; j < 4; ++j) { const f32x4 w0 = *(const f32x4*)(cw + j * 1536), w1 = *(const f32x4*)(cw + j * 1536 + 4); w[j][0] = w0.x; w[j][1] = w0.y; w[j][2] = w0.z; w[j][3] = w0.w; w[j][4] = w1.x; w[j][5] = w1.y; w[j][6] = w1.z; w[j][7] = w1.w; }
        float x0[8], x1[8], x2[8], x3[8];
        const int sbase = n * 64 + 8 * rb - 3;
        const bf16* hpc = HP + (size_t)(b * SEQ) * HP_LD + col;
#define PREP_LDROW(dst, s_) do { v4u raw_ = (v4u){0u, 0u, 0u, 0u}; if ((s_) >= 0) raw_ = *(const v4u*)(hpc + (size_t)(s_) * HP_LD); \
        _Pragma("unroll") for (int k_ = 0; k_ < 4; ++k_) { dst[2 * k_] = bflo(raw_[k_]); dst[2 * k_ + 1] = bfhi(raw_[k_]); } } while (0)
        PREP_LDROW(x0, sbase); PREP_LDROW(x1, sbase + 1); PREP_LDROW(x2, sbase + 2);
        const float gl = gc[63];
#pragma unroll 4
        for (int r = 0; r < 8; ++r) { const int i = 8 * rb + r; float y[8]; float ss = 0.f;
            PREP_LDROW(x3, sbase + 3 + r);
#pragma unroll
            for (int k = 0; k < 8; ++k) { const float acc = w[0][k] * x0[k] + w[1][k] * x1[k] + w[2][k] * x2[k] + w[3][k] * x3[k]; y[k] = siluf(acc); ss += y[k] * y[k]; x0[k] = x1[k]; x1[k] = x2[k]; x2[k] = x3[k]; }
            ss += __shfl_xor(ss, 1); ss += __shfl_xor(ss, 2); ss += __shfl_xor(ss, 4); ss += __shfl_xor(ss, 8);
            const float gi = gc[i], bi = bt[i];
            if (which == 0) { const float f = rsqrtf(ss + NORM_EPS) * 0.08838834764831845f, eg = __expf(gi);
                v4u p, pd;
#pragma unroll
                for (int k = 0; k < 4; ++k) { p[k] = bfc2(y[2 * k] * f, y[2 * k + 1] * f); pd[k] = bfc2(y[2 * k] * f * eg, y[2 * k + 1] * f * eg); }
                *(LAS v4u*)(Qb + i * KS + dd) = p;
                bf16* qd = QDg + (((i >> 5) * 4 + (dd >> 5)) * 2 + ((dd >> 4) & 1)) * 512 + (i & 31) * 8 + ((dd >> 3) & 1) * 4;
                *(v2u*)qd = (v2u){pd[0], pd[1]}; *(v2u*)(qd + 256) = (v2u){pd[2], pd[3]};
            } else if (which == 1) { const float f = rsqrtf(ss + NORM_EPS), fw = f * bi * __expf(gi), fd = f * __expf(gl - gi);
                v4u p;
#pragma unroll
                for (int k = 0; k < 4; ++k) p[k] = bfc2(y[2 * k] * f, y[2 * k + 1] * f);
                *(LAS v4u*)(Kb + i * KS + dd) = p;
#pragma unroll
                for (int k = 0; k < 8; ++k) { KW[i * 128 + dd + k] = y[k] * fw; KDs[(dd + k) * 72 + i] = bfc(y[k] * fd); }
            } else {
#pragma unroll
                for (int k = 0; k < 8; ++k) V[i * 128 + dd + k] = y[k] * bi;
            }
        }
#undef PREP_LDROW
    }
#endif
    __syncthreads();
    {
        const int ti = (wave >> 1) & 1, tj = wave & 1;
        if (wave < 4) {
            if (tj <= ti) {
                f32x16 acc;
#pragma unroll
                for (int i = 0; i < 16; ++i) acc[i] = 0.f;
#pragma unroll
                for (int s = 0; s < 8; ++s) acc = MFMA32(*(const LAS bf16x8*)(Kb + (32 * ti + c) * KS + 16 * s + 8 * hh), *(const LAS bf16x8*)(Kb + (32 * tj + c) * KS + 16 * s + 8 * hh), acc);
                const int j = 32 * tj + c; const float gj = gc[j];
#pragma unroll
                for (int r = 0; r < 16; ++r) { const int i = 32 * ti + (r & 3) + 8 * (r >> 2) + 4 * hh; A[i * 64 + j] = (j < i) ? bt[i] * acc[r] * __expf(gc[i] - gj) : 0.f; }
            } else {
#pragma unroll
                for (int r = 0; r < 16; ++r) { const int i = 32 * ti + (r & 3) + 8 * (r >> 2) + 4 * hh; A[i * 64 + 32 * tj + c] = 0.f; }
            }
        } else {
            const int kt = ti, qt = tj;
            if (kt <= qt) {
                f32x16 acc;
#pragma unroll
                for (int i = 0; i < 16; ++i) acc[i] = 0.f;
#pragma unroll
                for (int s = 0; s < 8; ++s) acc = MFMA32(*(const LAS bf16x8*)(Kb + (32 * kt + c) * KS + 16 * s + 8 * hh), *(const LAS bf16x8*)(Qb + (32 * qt + c) * KS + 16 * s + 8 * hh), acc);
                const int i = 32 * qt + c; const float gi = gc[i];
#pragma unroll
                for (int r = 0; r < 16; ++r) { const int j = 32 * kt + (r & 3) + 8 * (r >> 2) + 4 * hh; acc[r] = (j <= i) ? acc[r] * __expf(gi - gc[j]) : 0.f; }
                bf16x8* qf = (bf16x8*)QKg + lane;
                qf[((qt * 2 + kt) * 2 + 0) * 64] = pack8(acc, 0); qf[((qt * 2 + kt) * 2 + 1) * 64] = pack8(acc, 1);
            }
        }
    }
    __syncthreads();
#ifndef PREP_NO_SOLVE
    if (wave < 4) {
        const int col = tid & 127; LAS float* rhs = (tid < 128 ? V : KW) + col;
        float x[64];
#pragma unroll
        for (int i = 0; i < 64; ++i) {
            float s0 = rhs[i * 128], s1 = 0.f, s2 = 0.f, s3 = 0.f;
#pragma unroll
            for (int m4 = 0; m4 < (i + 3) / 4; ++m4) { const f32x4 a4 = *(const LAS f32x4*)(A + i * 64 + 4 * m4);
                if (4 * m4 < i) s0 -= a4.x * x[4 * m4];
                if (4 * m4 + 1 < i) s1 -= a4.y * x[4 * m4 + 1];
                if (4 * m4 + 2 < i) s2 -= a4.z * x[4 * m4 + 2];
                if (4 * m4 + 3 < i) s3 -= a4.w * x[4 * m4 + 3]; }
            x[i] = (s0 + s1) + (s2 + s3);
        }
        if (tid < 128) {
#pragma unroll
            for (int m = 0; m < 2; ++m)
#pragma unroll
                for (int hx = 0; hx < 2; ++hx)
#pragma unroll
                    for (int hf = 0; hf < 2; ++hf) { const int i0 = 32 * m + 16 * hf + 4 * hx;
                        v4u w; w.x = bfc2(x[i0], x[i0 + 1]); w.y = bfc2(x[i0 + 2], x[i0 + 3]); w.z = bfc2(x[i0 + 8], x[i0 + 9]); w.w = bfc2(x[i0 + 10], x[i0 + 11]);
                        *(v4u*)(Ug + uoff(i0, col)) = w; }
        } else {
#pragma unroll
            for (int i = 0; i < 64; ++i) Qb[i * KS + col] = bfc(-x[i]);
        }
    }
#endif
    __syncthreads();
#pragma unroll
    for (int p = 0; p < 4; ++p) { const int idx = tid + 512 * p, i = idx >> 5, d = (idx & 31) * 4;
        *(v2u*)(WNg + fragoff(i, d, 4)) = *(const LAS v2u*)(Qb + i * KS + d); }
#pragma unroll
    for (int p = 0; p < 4; ++p) { const int idx = tid + 512 * p, d = idx >> 4, i = (idx & 15) * 4;
        *(v2u*)(KDTg + fragoff(d, i, 2)) = *(const LAS v2u*)(KDs + d * 72 + i); }
}
#define XB_TMO      128
#define XB_XCNT(j)  (256  + 64 * (j))
#define XB_XSUB(j)  (1280 + 64 * (j))
#define XB_XGEN(j)  (2304 + 64 * (j))
#define XB_TOP      3328
#define XB_TOPGEN   3392
#define XCD_BAR_WORDS 3456
#define XB_SPIN_CAP (1u << 18)

__device__ __forceinline__ unsigned xb_ld(unsigned* p)              { return __hip_atomic_load(p, __ATOMIC_RELAXED, __HIP_MEMORY_SCOPE_AGENT); }
__device__ __forceinline__ unsigned xb_add(unsigned* p, unsigned v) { return __hip_atomic_fetch_add(p, v, __ATOMIC_RELAXED, __HIP_MEMORY_SCOPE_AGENT); }
__device__ __forceinline__ unsigned xb_xcc_id() { return (unsigned)__builtin_amdgcn_s_getreg((3 << 11) | 20) & 0xFu; }
#define XB_SPIN(cond, bar) do { unsigned _sp = 0; while (cond) { __builtin_amdgcn_s_sleep(1); \
    if ((++_sp & 255u) == 0u) { if (xb_ld(&(bar)[XB_TMO])) break; if (_sp > XB_SPIN_CAP) { atomicAdd(&(bar)[XB_TMO], 1u); break; } } } } while (0)

struct XcdBarrier {
    unsigned* bar; unsigned x;
    volatile LAS unsigned* st;
};

__device__ __forceinline__ XcdBarrier xcd_barrier_post(unsigned* bar, volatile LAS unsigned* st) {
    XcdBarrier b; b.bar = bar; b.x = xb_xcc_id(); b.st = st;
    if (threadIdx.x == 0) (void)xb_add(&bar[XB_XCNT(b.x)], 1u);
    return b;
}
__device__ __forceinline__ void xcd_barrier_complete(unsigned* bar, unsigned x, unsigned& nloc, unsigned& nx) {
    const unsigned G = gridDim.x * gridDim.y * gridDim.z;
    unsigned sum, cnt, mine, sp = 0u;
    for (;;) {
        sum = 0u; cnt = 0u; mine = 0u;
#pragma unroll
        for (unsigned j = 0; j < 16; ++j) { const unsigned c = xb_ld(&bar[XB_XCNT(j)]); sum += c; cnt += (c > 0u) ? 1u : 0u; mine = (j == x) ? c : mine; }
        if (sum == G) break;
        __builtin_amdgcn_s_sleep(1);
        if ((++sp & 255u) == 0u) { if (xb_ld(&bar[XB_TMO])) break; if (sp > XB_SPIN_CAP) { atomicAdd(&bar[XB_TMO], 1u); break; } }
    }
    nloc = mine > 0u ? mine : 1u; nx = cnt > 0u ? cnt : 1u;
}

__device__ __forceinline__ void xcd_barrier(const XcdBarrier& b) {
    asm volatile("s_waitcnt vmcnt(0)" ::: "memory");
    __syncthreads();
    if (threadIdx.x == 0) {
        unsigned* bar = b.bar;
        __builtin_amdgcn_s_waitcnt(0);
        unsigned nloc = b.st[0], nx = b.st[1];
        if (nloc == 0u) { xcd_barrier_complete(bar, b.x, nloc, nx); b.st[0] = nloc; b.st[1] = nx; }
        const unsigned old = xb_add(&bar[XB_XSUB(b.x)], 1u);
        const unsigned gen = old / nloc;
        if (old + 1u == (gen + 1u) * nloc) {
            __builtin_amdgcn_fence(__ATOMIC_RELEASE, "agent");
            asm volatile("s_waitcnt vmcnt(0)" ::: "memory");
            const unsigned og = xb_add(&bar[XB_TOP], 1u);
            const unsigned tg = og / nx;
            if (og + 1u == (tg + 1u) * nx) xb_add(&bar[XB_TOPGEN], 1u);
            else XB_SPIN(xb_ld(&bar[XB_TOPGEN]) == tg, bar);
            __builtin_amdgcn_fence(__ATOMIC_ACQUIRE, "agent");
            xb_add(&bar[XB_XGEN(b.x)], 1u);
            asm volatile("s_waitcnt vmcnt(0)" ::: "memory");
        } else {
            XB_SPIN(xb_ld(&bar[XB_XGEN(b.x)]) == gen, bar);
            __builtin_amdgcn_fence(__ATOMIC_ACQUIRE, "agent");
            asm volatile("s_waitcnt vmcnt(0)" ::: "memory");
        }
    }
    __syncthreads();
}
#ifndef REP_PRO
#define REP_PRO 1
#endif
#ifndef REP_IN
#define REP_IN 1
#endif
#ifndef REP_PREP
#define REP_PREP 1
#endif
#ifndef REP_SCAN
#define REP_SCAN 1
#endif
#ifndef REP_OUT
#define REP_OUT 1
#endif
#ifndef REP_GU
#define REP_GU 1
#endif
#ifndef REP_DN
#define REP_DN 1
#endif
#ifndef REP_MGU
#define REP_MGU 1
#endif
#ifndef REP_GDN
#define REP_GDN 1
#endif
#ifndef REP_RET
#define REP_RET 1
#endif
#ifndef FAST_SCAN
#define FAST_SCAN 1
#endif
#ifndef FAST_RET
#define FAST_RET 1
#endif
#ifndef FAST_PREP
#define FAST_PREP 1
#endif
#ifndef EN_PRO
#define EN_PRO 1
#endif
#ifndef EN_IN
#define EN_IN 1
#endif
#ifndef EN_PREP
#define EN_PREP 1
#endif
#ifndef EN_SCAN
#define EN_SCAN 1
#endif
#ifndef EN_OUT
#define EN_OUT 1
#endif
#ifndef EN_LN1
#define EN_LN1 1
#endif
#ifndef EN_FFN0
#define EN_FFN0 1
#endif
#ifndef EN_MOE
#define EN_MOE 1
#endif

__global__ void __launch_bounds__(NWAVES * 64, 2) fwd(Args a_unused) {
    extern __shared__ __attribute__((aligned(16))) unsigned char lds_raw[];
    LAS unsigned char* lds = (LAS unsigned char*)lds_raw;
    { const int tid0 = threadIdx.x; for (int u = tid0; u < (LDS_BYTES - LDSCTL_OFF) / 4; u += NWAVES * 64) ((LAS unsigned*)(lds + LDSCTL_OFF))[u] = 0u; }
    __syncthreads();
#if ONE_LAUNCH
    XcdBarrier bar = xcd_barrier_post((unsigned*)(kargs()->ws + WS_CTL) + CW_BAR, (volatile LAS unsigned*)(lds + MISC_OFF) + 8);
#define SEAM() xcd_barrier(bar)
#else
#define SEAM() do {} while (0)
#endif
#define IN(k) (kargs()->ph_lo <= (k) && (k) < kargs()->ph_hi)
#define BOTH(k) (IN(k) && ((k) + 1) < kargs()->ph_hi)
#define PH_LOCALS KArgs a = kargs(); unsigned char* ws = a->ws; int G = gridDim.x, bid = blockIdx.x; asm volatile("" : "+s"(G), "+s"(bid)); const int tid = tidx(), lane = tid & 63, wave = __builtin_amdgcn_readfirstlane(tid >> 6), gw = bid * NWAVES + wave, NGW = G * NWAVES; (void)ws; (void)lane; (void)gw; (void)NGW;

    if (EN_PRO && IN(PH_PRO)) { _Pragma("unroll 1") for (int rep_ = 0; rep_ < REP_PRO; ++rep_) { if (rep_) SEAM(); PH_LOCALS; ph_prologue(a, lds, wave, lane, gw, NGW, bid * (NWAVES * 64) + tid, G * NWAVES * 64, 0, PRO_I_IN, true); } if (BOTH(PH_PRO)) SEAM(); }

#pragma unroll 1
    for (int l = 0; l < 2; ++l) {
        if (EN_IN && IN(PH_L(l, K_IN))) {
            _Pragma("unroll 1") for (int rep_ = 0; rep_ < REP_IN; ++rep_) { if (rep_) SEAM(); PH_LOCALS;
            pg8::Gemm g{(const pg8::bf16_t*)(ws + WS_XB), (const pg8::bf16_t*)(ws + WS_WIN) + (size_t)l * NIN_PAD * 1024, M, NIN_PAD, 1024}; pg8::StaticOrder S; S.init(M, NIN_PAD, G, bid);
            pg8::EpiHproj E{(pg8::bf16_t*)(ws + WS_R + R_HP), (float*)(ws + WS_GAB)};
            pg8::gemm_phase<pg8::EpiHproj, pg8::StaticOrder, PG8_ALIGN, PG8_SP2>(lds, g, S, E); }
            if (BOTH(PH_L(l, K_IN))) SEAM();
        }
        if (EN_PREP && IN(PH_L(l, K_PREP))) {
            _Pragma("unroll 1") for (int rep_ = 0; rep_ < REP_PREP; ++rep_) { if (rep_) SEAM(); PH_LOCALS; for (int u = bid; u < 1024; u += G) { if (FAST_PREP) gdn_prep_fast(a, l, u, lds, tid, lane, wave); else gdn_prep_unit(a, l, u, lds, tid, lane, wave); }
              if (FAST_RET) for (int u = bid; u < 512; u += G) ret_kv_unit(a, u, lds, tid, lane, wave); }
            if (BOTH(PH_L(l, K_PREP))) SEAM();
        }
        if (EN_SCAN && IN(PH_L(l, K_SCAN))) {
            _Pragma("unroll 1") for (int rep_ = 0; rep_ < REP_SCAN; ++rep_) { if (rep_) SEAM(); PH_LOCALS;
            if (bid < 32) { const int t1 = tidx(), w1 = __builtin_amdgcn_readfirstlane(t1 >> 6); for (int rg_ = 0; rg_ < REP_GDN; ++rg_) gdn_scan_fast(a, l, bid, lds, t1, t1 & 63, w1); }
            else {
                { const int t1 = tidx(), w1 = __builtin_amdgcn_readfirstlane(t1 >> 6);
                  for (int rr_ = 0; rr_ < REP_RET; ++rr_) for (int u = bid - 32; u < 512; u += G - 32) ret_out_unit(a, u, lds, t1, t1 & 63, w1); }
                __syncthreads();
                { const int t2 = tidx(), w2 = __builtin_amdgcn_readfirstlane(t2 >> 6);
                  moe_convert(kargs(), lds, w2, t2 & 63, (bid - 32) * NWAVES + w2, (G - 32) * NWAVES, 4 * l, 4 * l + 4);
                  if (l == 0) ph_prologue(kargs(), lds, w2, t2 & 63, (bid - 32) * NWAVES + w2, (G - 32) * NWAVES, 0, 0, PRO_I_IN, PRO_NIT, false); }
            } }
            if (BOTH(PH_L(l, K_SCAN))) SEAM();
        }
        if (EN_OUT && IN(PH_L(l, K_OUT))) {
            _Pragma("unroll 1") for (int rep_ = 0; rep_ < REP_OUT; ++rep_) { if (rep_) SEAM(); PH_LOCALS;
            pg8::Gemm g{(const pg8::bf16_t*)(ws + WS_R + R_OB), (const pg8::bf16_t*)(ws + WS_WO) + (size_t)l * 1024 * 1024, M, 1024, 1024}; pg8::StaticOrder S; S.init(M, 1024, G, bid);
            pg8::EpiBf16Out E{(pg8::bf16_t*)(ws + WS_R + R_MIX), 1024};
            pg8::gemm_phase<pg8::EpiBf16Out, pg8::StaticOrder, PG8_ALIGN, PG8_SP2>(lds, g, S, E); }
            if (BOTH(PH_L(l, K_OUT))) SEAM();
        }
        if (EN_LN1 && IN(PH_L(l, K_LN1))) {
            { PH_LOCALS;
            if (l == 0) ln_rows<false>(a->in[0], ALPHA, (const bf16*)(ws + WS_R + R_MIX), a->in[7], a->in[8], a->out, 1.0f, (bf16*)(ws + WS_XB), nullptr, nullptr, nullptr, nullptr, lane, gw, NGW);
            else { ln_rows<true>(a->out, ALPHA, (const bf16*)(ws + WS_R + R_MIX), a->in[7] + 1024, a->in[8] + 1024, a->out, ALPHA, (bf16*)(ws + WS_XB), (const float*)(ws + WS_RWT), (unsigned*)(ws + WS_CTL) + CW_MOE, (int*)(ws + WS_LIST), (float*)(ws + WS_GATE), lane, gw, NGW);
                 } }
            if (BOTH(PH_L(l, K_LN1))) SEAM();
        }
        if (l == 0) {
            if (EN_FFN0 && IN(PH_L(0, K_GU))) {
                _Pragma("unroll 1") for (int rep_ = 0; rep_ < REP_GU; ++rep_) { if (rep_) SEAM(); PH_LOCALS;
                pg8::Gemm g{(const pg8::bf16_t*)(ws + WS_XB), (const pg8::bf16_t*)(ws + WS_WGU), M, 2 * FF, 1024}; pg8::StaticOrder S; S.init(M, 2 * FF, G, bid);
                pg8::EpiSwiglu E{(pg8::bf16_t*)(ws + WS_R + R_H), FF};
                pg8::gemm_phase<pg8::EpiSwiglu, pg8::StaticOrder, PG8_ALIGN, PG8_SP2>(lds, g, S, E); }
                if (BOTH(PH_L(0, K_GU))) SEAM();
            }
            if (EN_FFN0 && IN(PH_L(0, K_DN))) {
                _Pragma("unroll 1") for (int rep_ = 0; rep_ < REP_DN; ++rep_) { if (rep_) SEAM(); PH_LOCALS;
                pg8::Gemm g{(const pg8::bf16_t*)(ws + WS_R + R_H), (const pg8::bf16_t*)(ws + WS_WD), M, 1024, FF}; pg8::StaticOrder S; S.init(M, 1024, G, bid);
                pg8::EpiBf16Out E{(pg8::bf16_t*)(ws + WS_R + R_MIX), 1024};
                pg8::gemm_phase<pg8::EpiBf16Out, pg8::StaticOrder, PG8_ALIGN, PG8_SP2>(lds, g, S, E); }
                if (BOTH(PH_L(0, K_DN))) SEAM();
            }
            if (EN_LN1 && IN(PH_L(0, K_LN2))) {
                { PH_LOCALS;
                ln_rows<false>(a->out, ALPHA, (const bf16*)(ws + WS_R + R_MIX), a->in[9], a->in[10], a->out, 1.0f, (bf16*)(ws + WS_XB), nullptr, nullptr, nullptr, nullptr, lane, gw, NGW); }
                if (BOTH(PH_L(0, K_LN2))) SEAM();
            }
        } else {
#pragma unroll 1
            for (int j = 0; j < 2; ++j) {
                const int kg = K_G0 + 3 * j;
                if (EN_MOE && j == 0 && IN(PH_L(1, kg))) { { PH_LOCALS; moe_gather(a, 0, lane, gw, NGW); moe_gather(a, 1, lane, gw, NGW); } if (BOTH(PH_L(1, kg))) SEAM(); }
                if (EN_MOE && IN(PH_L(1, kg + 1))) {
                    _Pragma("unroll 1") for (int rep_ = 0; rep_ < REP_MGU; ++rep_) { if (rep_) SEAM(); PH_LOCALS;
                    int cnt[8];
#pragma unroll
                    for (int e = 0; e < 8; ++e) cnt[e] = (int)((const unsigned*)(ws + WS_CTL))[CW_MOE + 64 * (j * 8 + e)];
                    pg8::Gemm g{(const pg8::bf16_t*)(ws + WS_R + R_XG + (size_t)j * XG_PASS), (const pg8::bf16_t*)(ws + WS_WMGU), MOE_ROWS, 2 * FE, 1024}; pg8::MoeOrder S; S.init(cnt, 2 * FE / 256, G, bid, (size_t)2 * FE * 1024 * 2);
                    pg8::EpiSwiglu E{(pg8::bf16_t*)(ws + WS_R + R_HM), FE};
                    pg8::gemm_phase<pg8::EpiSwiglu, pg8::MoeOrder, PG8_ALIGN, PG8_SP2>(lds, g, S, E); }
                    if (BOTH(PH_L(1, kg + 1))) SEAM();
                }
                if (EN_MOE && IN(PH_L(1, kg + 2))) {
                    { PH_LOCALS;
                    int cnt[8];
#pragma unroll
                    for (int e = 0; e < 8; ++e) cnt[e] = (int)((const unsigned*)(ws + WS_CTL))[CW_MOE + 64 * (j * 8 + e)];
                    pg8::Gemm g{(const pg8::bf16_t*)(ws + WS_R + R_HM), (const pg8::bf16_t*)(ws + WS_WMD), MOE_ROWS, 1024, FE}; pg8::MoeOrder S; S.init(cnt, 4, G, bid, (size_t)1024 * FE * 2);
                    pg8::EpiMoeDown E; E.XF = a->out; E.list = (const int*)(ws + WS_LIST) + (size_t)j * 8 * 16384; E.gate = (const float*)(ws + WS_GATE) + (size_t)j * 16384;
#pragma unroll
                    for (int e = 0; e < 8; ++e) { E.cnt[e] = cnt[e]; E.cum[e] = S.cum[e]; }
                    pg8::gemm_phase<pg8::EpiMoeDown, pg8::MoeOrder, PG8_ALIGN, PG8_SP2>(lds, g, S, E); }
                    if (BOTH(PH_L(1, kg + 2))) SEAM();
                }
            }
            if (EN_LN1 && IN(PH_L(1, K_LNF))) {
                PH_LOCALS;
                ln_rows<false>(a->out, 1.0f, nullptr, a->in[9] + 1024, a->in[10] + 1024, a->out, 1.0f, nullptr, nullptr, nullptr, nullptr, nullptr, lane, gw, NGW);
            }
        }
    }
#undef IN
#undef BOTH
}

extern "C" void kernel_launch(void* const* d_in, const int* in_sizes, int n_in, void* d_out, int out_size, void* d_ws, size_t ws_size, hipStream_t stream) {
    static int grid = 0;
    if (grid == 0) {
        if (n_in != 18 || in_sizes[0] != M * D || out_size != M * D || ws_size < WS_END) { fprintf(stderr, "kernel_launch: unexpected shapes or workspace (%zu < %zu); nothing launched\n", ws_size, (size_t)WS_END); grid = -1; return; }
        int dev = 0, cus = 0, per_cu = 0;
        if (hipGetDevice(&dev) != hipSuccess || hipDeviceGetAttribute(&cus, hipDeviceAttributeMultiprocessorCount, dev) != hipSuccess) { grid = -1; return; }
        if (hipFuncSetAttribute((const void*)fwd, hipFuncAttributeMaxDynamicSharedMemorySize, LDS_BYTES) != hipSuccess) { fprintf(stderr, "kernel_launch: hipFuncSetAttribute failed\n"); grid = -1; return; }
        if (hipOccupancyMaxActiveBlocksPerMultiprocessor(&per_cu, (const void*)fwd, NWAVES * 64, LDS_BYTES) != hipSuccess || per_cu < 1) fprintf(stderr, "kernel_launch: occupancy query reports %d\n", per_cu);
        (void)hipGetLastError();
        grid = cus;
    }
    if (grid < 0) return;
    if (hipMemsetAsync((char*)d_ws + WS_CTL, 0, CTL_BYTES, stream) != hipSuccess) return;
    Args a{};
    for (int i = 0; i < 18; ++i) a.in[i] = (const float*)d_in[i];
    a.out = (float*)d_out; a.ws = (unsigned char*)d_ws;
#if ONE_LAUNCH
    a.ph_lo = 0; a.ph_hi = PH_END;
    hipLaunchKernelGGL(fwd, dim3(grid), dim3(NWAVES * 64), LDS_BYTES, stream, a);
#else
    static const int phases[] = {PH_PRO,
        PH_L(0, K_IN), PH_L(0, K_PREP), PH_L(0, K_SCAN), PH_L(0, K_OUT), PH_L(0, K_LN1), PH_L(0, K_GU), PH_L(0, K_DN), PH_L(0, K_LN2),
        PH_L(1, K_IN), PH_L(1, K_PREP), PH_L(1, K_SCAN), PH_L(1, K_OUT), PH_L(1, K_LN1),
        PH_L(1, K_G0), PH_L(1, K_GU0), PH_L(1, K_DN0), PH_L(1, K_G1), PH_L(1, K_GU1), PH_L(1, K_DN1), PH_L(1, K_LNF)};
    for (unsigned i = 0; i < sizeof(phases) / sizeof(phases[0]); ++i) {
        a.ph_lo = phases[i]; a.ph_hi = phases[i] + 1;
        hipLaunchKernelGGL(fwd, dim3(grid), dim3(NWAVES * 64), LDS_BYTES, stream, a);
    }
#endif
}
```

```cpp
#include <hip/hip_runtime.h>
#include <cstdio>
#include <cstdint>

#ifndef ONE_LAUNCH
#define ONE_LAUNCH 1
#endif

#define GAS __attribute__((address_space(1)))
#define LAS __attribute__((address_space(3)))
typedef unsigned short bf16;
typedef unsigned v4u __attribute__((ext_vector_type(4)));
typedef unsigned v2u __attribute__((ext_vector_type(2)));
typedef float f32x4 __attribute__((ext_vector_type(4)));
typedef float f32x2 __attribute__((ext_vector_type(2)));
#define RLX_AGENT __ATOMIC_RELAXED, __HIP_MEMORY_SCOPE_AGENT
#define LDS_WAIT() asm volatile("s_waitcnt lgkmcnt(0)" ::: "memory")
#define VM_WAIT() asm volatile("s_waitcnt vmcnt(0)" ::: "memory")

__device__ __forceinline__ unsigned f2bf(float f) { unsigned u = __builtin_bit_cast(unsigned, f); return (u + 0x7fffu + ((u >> 16) & 1u)) >> 16; }
__device__ __forceinline__ unsigned pk2(float lo, float hi) { return f2bf(lo) | (f2bf(hi) << 16); }
__device__ __forceinline__ float bf2f(unsigned short u) { return __builtin_bit_cast(float, (unsigned)u << 16); }
__device__ __forceinline__ float bflo(unsigned u) { return __builtin_bit_cast(float, u << 16); }
__device__ __forceinline__ float bfhi(unsigned u) { return __builtin_bit_cast(float, u & 0xffff0000u); }
__device__ __forceinline__ float siluf(float x) { return x / (1.f + __expf(-x)); }
__device__ __forceinline__ float sigmf(float x) { return 1.f / (1.f + __expf(-x)); }
__device__ __forceinline__ float wave_sum(float v) {
#pragma unroll
    for (int o = 1; o < 64; o <<= 1) v += __shfl_xor(v, o);
    return v;
}

constexpr int NWAVES = 8;
constexpr int M = 16384, D = 1024, SEQ = 2048, NB = 8;
constexpr int IN_COLS = 3592, NIN_PAD = 3840, HP_LD = 3584;
constexpr int FF = 2816, FE = 3584, NE = 8;
constexpr int COL_RQ = 0, COL_RK = 256, COL_RV = 512, COL_RG = 1024, COL_GQ = 1536, COL_GK = 2048, COL_GV = 2560, COL_GG = 3072;
constexpr float ALPHA = 1.41421356237f;
constexpr float LN_EPS = 1e-5f, NORM_EPS = 1e-6f;
constexpr int MOE_ROWS = 72 * 256;

__host__ __device__ __forceinline__ int fragoff(int i, int d, int nkt) {
    return ((((i >> 5) * nkt + (d >> 5)) * 2 + ((d >> 4) & 1)) * 512) + ((((d >> 2) & 1) * 32 + (i & 31)) * 8) + ((((d >> 3) & 1) << 2) | (d & 3));
}
__host__ __device__ __forceinline__ int uoff(int i, int e) {
    const int reg = (i & 3) | (((i & 31) >> 3) << 2);
    return (((((e >> 5) * 2 + (i >> 5)) * 2 + (reg >> 3)) * 64 + (((i >> 2) & 1) * 32 + (e & 31))) * 8) + (reg & 7);
}
namespace pg8 {
#define PG8_LAS __attribute__((address_space(3)))
typedef unsigned short bf16_t;
typedef short bf16x8 __attribute__((ext_vector_type(8)));
typedef float f32x4 __attribute__((ext_vector_type(4)));
typedef unsigned u32x4 __attribute__((ext_vector_type(4)));
constexpr int BM = 256, BK = 64, HALF = 128, HTB = HALF * BK * 2  , STAGE_BYTES = 8 * HTB, NXCD = 8, WGM = 8;

__host__ __device__ __forceinline__ int lds_byte(int r, int c) { const int st = (r >> 4) * 2 + (c >> 5), rr = r & 15, cc = c & 31, ob = rr * 64 + cc * 2; return st * 1024 + (ob ^ (((ob >> 9) & 1) << 5)); }
__host__ __device__ __forceinline__ void stage_rc(int b, int& R, int& C) { const int st = b / 1024, sb = b % 1024, swz = sb ^ (((sb >> 9) & 1) << 5); R = (st >> 1) * 16 + swz / 64; C = (st & 1) * 32 + (swz % 64) / 2; }
__host__ __device__ __forceinline__ int perm32(int rho) { const int n = rho >> 4, i = rho & 15; return 8 * (i >> 2) + 4 * n + (i & 3); }

struct Unit { int pm, pn, aux; };
struct Gemm { const bf16_t* A; const bf16_t* Bt; int M, N, K; };

struct StaticOrder {
    int nM, nN, nwg, G, c;
    __host__ __device__ void init(int M, int N, int G_, int c_) { nM = M / BM; nN = N / BM; nwg = nM * nN; G = G_; c = c_; }
    __host__ __device__ bool next(int i, Unit& u) const {
        const long L = (long)i * G + c; if (L >= nwg) return false;
        int wgid = (int)L; { const int q = nwg / NXCD, r = nwg % NXCD, xcd = wgid % NXCD, off = wgid / NXCD; wgid = (xcd < r ? xcd * (q + 1) : r * (q + 1) + (xcd - r) * q) + off; }
        const int nig = WGM * nN, gid = wgid / nig, fm = gid * WGM, gsz = (nM - fm) < WGM ? (nM - fm) : WGM;
        u.pm = fm + ((wgid % nig) % gsz); u.pn = (wgid % nig) / gsz; u.aux = 0; return true;
    }
    __device__ __forceinline__ const char* aptr(const Gemm& g, const Unit& u) const { return (const char*)g.A + (size_t)u.pm * ((size_t)BM * g.K * 2); }
    __device__ __forceinline__ const char* bptr(const Gemm& g, const Unit& u) const { return (const char*)g.Bt + (size_t)u.pn * ((size_t)BM * g.K * 2); }
    __device__ __forceinline__ void a_ready(const Unit&) const {}
    __device__ __forceinline__ void done(const Unit&) const {}
};

template <class Epi, class Sched, bool ALIGN_EPI = false, bool SP2 = false>
__device__ __forceinline__ void gemm_phase(PG8_LAS unsigned char* lds, const Gemm g, const Sched& S, const Epi& E) {
    int tid = threadIdx.x; asm volatile("" : "+v"(tid)); const int wid = __builtin_amdgcn_readfirstlane(tid >> 6), lane = tid & 63, wr = wid >> 2, wc = wid & 3, fr = lane & 15, fq = lane >> 4;
    const int K = g.K, nt = K / BK;
    unsigned voffA[2], voffB[2];
#pragma unroll
    for (int i = 0; i < 2; ++i) { int R, C; stage_rc(tid * 16 + i * 8192, R, C); const int Rb = Epi::PERM ? ((R & ~31) + perm32(R & 31)) : R;
        voffA[i] = (unsigned)(R * K + C) * 2u; voffB[i] = (unsigned)(Rb * K + C) * 2u; }
    const size_t kstep = (size_t)(BK * 2);
    const size_t hstep = (size_t)HALF * K * 2;
    const size_t tstep = 2 * hstep;
    const unsigned ldsw = (unsigned)wid * 1024u;
    const int aoff = lds_byte(wr * 64 + fr, fq * 8), boff = lds_byte(wc * 32 + fr, fq * 8);
#define PG8_SA(b, h) (((b) * 2 + (h)) * HTB)
#define PG8_SB(b, h) ((4 + (b) * 2 + (h)) * HTB)
#define PG8_STAGE(bufoff, gbase, voff) do { _Pragma("unroll") for (int _i = 0; _i < 2; ++_i) \
        __builtin_amdgcn_global_load_lds((const unsigned*)((const char*)(gbase) + (voff)[_i]), (PG8_LAS unsigned*)(lds + (bufoff) + ldsw + _i * 8192), 16, 0, 0); } while (0)
#define PG8_LDA(dst, b, h) do { _Pragma("unroll") for (int m = 0; m < 4; ++m) _Pragma("unroll") for (int k = 0; k < 2; ++k) dst[m][k] = *(const PG8_LAS bf16x8*)(lds + PG8_SA(b, h) + aoff + m * 2048 + k * 1024); } while (0)
#define PG8_LDB(dst, b, h) do { _Pragma("unroll") for (int n = 0; n < 2; ++n) _Pragma("unroll") for (int k = 0; k < 2; ++k) dst[n][k] = *(const PG8_LAS bf16x8*)(lds + PG8_SB(b, h) + boff + n * 2048 + k * 1024); } while (0)
#define PG8_MMA(ai, bj, At, Bt) do { __builtin_amdgcn_s_setprio(1); _Pragma("unroll") for (int m = 0; m < 4; ++m) _Pragma("unroll") for (int n = 0; n < 2; ++n) _Pragma("unroll") for (int k = 0; k < 2; ++k) \
        acc[ai][bj][m][n] = __builtin_amdgcn_mfma_f32_16x16x32_bf16(Bt[n][k], At[m][k], acc[ai][bj][m][n], 0, 0, 0); __builtin_amdgcn_s_setprio(0); } while (0)
#define PG8_WAIT_V(n) asm volatile("s_waitcnt vmcnt(" #n ")" ::: "memory")
#define PG8_WAIT_L(n) asm volatile("s_waitcnt lgkmcnt(" #n ")" ::: "memory")
#define PG8_BAR __builtin_amdgcn_s_barrier()
#define PG8_SCHED __builtin_amdgcn_sched_barrier(0)
    Unit cur, nxt; int ui = 0;
    if (!S.next(0, cur)) return;
    f32x4 acc[2][2][4][2];
#pragma unroll
    for (int a = 0; a < 2; ++a)
#pragma unroll
        for (int b = 0; b < 2; ++b)
#pragma unroll
            for (int m = 0; m < 4; ++m)
#pragma unroll
                for (int n = 0; n < 2; ++n) acc[a][b][m][n] = (f32x4){0.f, 0.f, 0.f, 0.f};
    bf16x8 At[4][2], B0[2][2], B1[2][2];
    const char* cA = S.aptr(g, cur); const char* cB = S.bptr(g, cur);
    S.a_ready(cur);
    if constexpr (SP2) {
        PG8_STAGE(PG8_SB(0, 0), cB, voffB); PG8_STAGE(PG8_SB(0, 1), cB + hstep, voffB); PG8_STAGE(PG8_SA(0, 0), cA, voffA); PG8_STAGE(PG8_SA(0, 1), cA + hstep, voffA);
        if (wr == 1) PG8_BAR;
        PG8_WAIT_V(2); PG8_BAR;
        PG8_STAGE(PG8_SB(1, 0), cB + kstep, voffB); PG8_STAGE(PG8_SA(1, 0), cA + kstep, voffA); PG8_STAGE(PG8_SB(1, 1), cB + hstep + kstep, voffB);
        PG8_WAIT_V(6); PG8_BAR;
    } else {
        PG8_STAGE(PG8_SB(0, 0), cB, voffB); PG8_STAGE(PG8_SA(0, 0), cA, voffA); PG8_STAGE(PG8_SB(0, 1), cB + hstep, voffB); PG8_STAGE(PG8_SA(0, 1), cA + hstep, voffA);
        if (wr == 1) PG8_BAR;
        PG8_WAIT_V(4); PG8_BAR;
        PG8_STAGE(PG8_SB(1, 0), cB + kstep, voffB); PG8_STAGE(PG8_SA(1, 0), cA + kstep, voffA); PG8_STAGE(PG8_SB(1, 1), cB + hstep + kstep, voffB);
        PG8_WAIT_V(6); PG8_BAR;
    }
    for (;;) {
        const bool has_next = S.next(ui + 1, nxt);
        const char* nA = has_next ? S.aptr(g, nxt) : cA; const char* nB = has_next ? S.bptr(g, nxt) : cB;
        for (int t = 0; t < nt; t += 2) {
            const bool last = (t == nt - 2);
            const char* a1 = cA + (size_t)(t + 1) * kstep;
            const char* a2 = last ? nA : cA + (size_t)(t + 2) * kstep; const char* b2 = last ? nB : cB + (size_t)(t + 2) * kstep;
            const char* a3 = a2 + kstep; const char* b3 = b2 + kstep;
            if (last && has_next) S.a_ready(nxt);
            if constexpr (SP2) {
            PG8_LDB(B0, 0, 0); PG8_LDB(B1, 0, 1); PG8_SCHED; PG8_LDA(At, 0, 0); PG8_STAGE(PG8_SA(1, 1), a1 + hstep, voffA);
            PG8_WAIT_V(8); PG8_WAIT_L(0); PG8_BAR; PG8_MMA(0, 0, At, B0); PG8_MMA(0, 1, At, B1); PG8_BAR; PG8_SCHED;
            PG8_LDA(At, 0, 1); PG8_STAGE(PG8_SB(0, 0), b2, voffB); PG8_STAGE(PG8_SB(0, 1), b2 + hstep, voffB); PG8_STAGE(PG8_SA(0, 0), a2, voffA);
            PG8_WAIT_V(8); PG8_WAIT_L(0); PG8_BAR; PG8_MMA(1, 0, At, B0); PG8_MMA(1, 1, At, B1); PG8_BAR; PG8_SCHED;
            PG8_LDB(B0, 1, 0); PG8_LDB(B1, 1, 1); PG8_SCHED; PG8_LDA(At, 1, 0); PG8_STAGE(PG8_SA(0, 1), a2 + hstep, voffA);
            PG8_WAIT_V(8); PG8_WAIT_L(0); PG8_BAR; PG8_MMA(0, 0, At, B0); PG8_MMA(0, 1, At, B1); PG8_BAR; PG8_SCHED;
            PG8_LDA(At, 1, 1); PG8_STAGE(PG8_SB(1, 0), b3, voffB); PG8_STAGE(PG8_SB(1, 1), b3 + hstep, voffB); PG8_STAGE(PG8_SA(1, 0), a3, voffA);
            PG8_WAIT_V(8); PG8_WAIT_L(0); PG8_BAR; PG8_MMA(1, 0, At, B0); PG8_MMA(1, 1, At, B1); PG8_BAR; PG8_SCHED;
            } else {
            PG8_LDB(B0, 0, 0); PG8_SCHED; PG8_LDA(At, 0, 0); PG8_STAGE(PG8_SA(1, 1), a1 + hstep, voffA);
            PG8_WAIT_L(8); PG8_BAR; PG8_WAIT_L(0); PG8_MMA(0, 0, At, B0); PG8_BAR; PG8_SCHED;
            PG8_LDB(B1, 0, 1); PG8_STAGE(PG8_SB(0, 0), b2, voffB);
            PG8_BAR; PG8_WAIT_L(0); PG8_MMA(0, 1, At, B1); PG8_BAR;
            PG8_LDA(At, 0, 1); PG8_STAGE(PG8_SA(0, 0), a2, voffA);
            PG8_BAR; PG8_WAIT_L(0); PG8_MMA(1, 0, At, B0); PG8_BAR; PG8_SCHED;
            PG8_STAGE(PG8_SB(0, 1), b2 + hstep, voffB);
            PG8_WAIT_V(6); PG8_BAR; PG8_MMA(1, 1, At, B1); PG8_BAR;
            PG8_LDB(B0, 1, 0); PG8_SCHED; PG8_LDA(At, 1, 0); PG8_STAGE(PG8_SA(0, 1), a2 + hstep, voffA);
            PG8_WAIT_L(8); PG8_BAR; PG8_WAIT_L(0); PG8_MMA(0, 0, At, B0); PG8_BAR; PG8_SCHED;
            PG8_LDB(B1, 1, 1); PG8_STAGE(PG8_SB(1, 0), b3, voffB);
            PG8_BAR; PG8_WAIT_L(0); PG8_MMA(0, 1, At, B1); PG8_BAR;
            PG8_LDA(At, 1, 1); PG8_STAGE(PG8_SA(1, 0), a3, voffA);
            PG8_BAR; PG8_WAIT_L(0); PG8_MMA(1, 0, At, B0); PG8_BAR; PG8_SCHED;
            PG8_STAGE(PG8_SB(1, 1), b3 + hstep, voffB);
            PG8_WAIT_V(6); PG8_BAR; PG8_MMA(1, 1, At, B1); PG8_BAR;
            }
        }
        if constexpr (ALIGN_EPI) { if (wr == 0) PG8_BAR; }
        if constexpr (!Epi::AFTER_DRAIN) { E(acc, cur, wr, wc, fr, fq); S.done(cur); }
        if (!has_next) break;
#pragma unroll
        for (int a = 0; a < 2; ++a)
#pragma unroll
            for (int b = 0; b < 2; ++b)
#pragma unroll
                for (int m = 0; m < 4; ++m)
#pragma unroll
                    for (int n = 0; n < 2; ++n) acc[a][b][m][n] = (f32x4){0.f, 0.f, 0.f, 0.f};
        cur = nxt; cA = nA; cB = nB; ++ui;
        if constexpr (ALIGN_EPI) { if (wr == 1) PG8_BAR; }
    }
    PG8_WAIT_V(0);
    if constexpr (!ALIGN_EPI) { if (wr == 0) PG8_BAR; }
    PG8_BAR;
    if constexpr (Epi::AFTER_DRAIN) { E.fused(acc, cur, wr, wc, fr, fq, lds, wid, lane); S.done(cur); }
#undef PG8_SA
#undef PG8_SB
#undef PG8_STAGE
#undef PG8_LDA
#undef PG8_LDB
#undef PG8_MMA
#undef PG8_WAIT_V
#undef PG8_WAIT_L
#undef PG8_BAR
#undef PG8_SCHED
}
}

namespace pg8 {
__device__ __forceinline__ unsigned cvt_pk_bf16(float lo, float hi) { unsigned r; asm volatile("v_cvt_pk_bf16_f32 %0, %1, %2" : "=v"(r) : "v"(lo), "v"(hi)); return r; }

struct EpiHproj {
    static constexpr bool PERM = true, AFTER_DRAIN = false;
    bf16_t* HP; float* GAB;
    __device__ __forceinline__ void operator()(const f32x4 (&acc)[2][2][4][2], const Unit& u, int wr, int wc, int fr, int fq) const {
        const int row0 = u.pm * BM + wr * 64 + fr;
        if (u.pn < 14) {
            const int col0 = u.pn * BM + wc * 32 + 8 * fq;
#pragma unroll
            for (int ai = 0; ai < 2; ++ai)
#pragma unroll
                for (int m = 0; m < 4; ++m) { bf16_t* rowp = HP + (size_t)(row0 + ai * HALF + m * 16) * 3584 + col0;
#pragma unroll
                    for (int bj = 0; bj < 2; ++bj) { const f32x4 v0 = acc[ai][bj][m][0], v1 = acc[ai][bj][m][1];
                        u32x4 w; w.x = cvt_pk_bf16(v0[0], v0[1]); w.y = cvt_pk_bf16(v0[2], v0[3]); w.z = cvt_pk_bf16(v1[0], v1[1]); w.w = cvt_pk_bf16(v1[2], v1[3]);
                        *(u32x4*)(rowp + bj * HALF) = w; } }
        } else if (wc == 0 && fq == 0) {
#pragma unroll
            for (int ai = 0; ai < 2; ++ai)
#pragma unroll
                for (int m = 0; m < 4; ++m) { float* rowp = GAB + (size_t)(row0 + ai * HALF + m * 16) * 8;
                    *(f32x4*)(rowp) = acc[ai][0][m][0]; *(f32x4*)(rowp + 4) = acc[ai][0][m][1]; }
        }
    }
};
struct EpiBf16Out {
    static constexpr bool PERM = true, AFTER_DRAIN = false;
    bf16_t* O; int ldc;
    __device__ __forceinline__ void operator()(const f32x4 (&acc)[2][2][4][2], const Unit& u, int wr, int wc, int fr, int fq) const {
        const int row0 = u.pm * BM + wr * 64 + fr, col0 = u.pn * BM + wc * 32 + 8 * fq;
#pragma unroll
        for (int ai = 0; ai < 2; ++ai)
#pragma unroll
            for (int m = 0; m < 4; ++m) { bf16_t* rowp = O + (size_t)(row0 + ai * HALF + m * 16) * ldc + col0;
#pragma unroll
                for (int bj = 0; bj < 2; ++bj) { const f32x4 v0 = acc[ai][bj][m][0], v1 = acc[ai][bj][m][1];
                    u32x4 w; w.x = cvt_pk_bf16(v0[0], v0[1]); w.y = cvt_pk_bf16(v0[2], v0[3]); w.z = cvt_pk_bf16(v1[0], v1[1]); w.w = cvt_pk_bf16(v1[2], v1[3]);
                    *(u32x4*)(rowp + bj * HALF) = w; } }
    }
};
struct EpiF32 {
    static constexpr bool PERM = false, AFTER_DRAIN = false;
    float* O; int ldc;
    __device__ __forceinline__ void operator()(const f32x4 (&acc)[2][2][4][2], const Unit& u, int wr, int wc, int fr, int fq) const {
        const int row0 = u.pm * BM + wr * 64 + fr, col0 = u.pn * BM + wc * 32 + 4 * fq;
#pragma unroll
        for (int ai = 0; ai < 2; ++ai)
#pragma unroll
            for (int m = 0; m < 4; ++m) { float* rowp = O + (size_t)(row0 + ai * HALF + m * 16) * ldc + col0;
#pragma unroll
                for (int bj = 0; bj < 2; ++bj)
#pragma unroll
                    for (int n = 0; n < 2; ++n) *(f32x4*)(rowp + bj * HALF + n * 16) = acc[ai][bj][m][n]; }
    }
};
struct EpiSwiglu {
    static constexpr bool PERM = true, AFTER_DRAIN = false;
    bf16_t* H; int ldh;
    __device__ __forceinline__ void operator()(const f32x4 (&acc)[2][2][4][2], const Unit& u, int wr, int wc, int fr, int fq) const {
        const int row0 = u.pm * BM + wr * 64 + fr, col0 = u.pn * HALF + wc * 32 + 8 * fq;
#pragma unroll
        for (int ai = 0; ai < 2; ++ai)
#pragma unroll
            for (int m = 0; m < 4; ++m) { bf16_t* rowp = H + (size_t)(row0 + ai * HALF + m * 16) * ldh + col0;
                float h[8];
#pragma unroll
                for (int n = 0; n < 2; ++n)
#pragma unroll
                    for (int i = 0; i < 4; ++i) { const float gt = acc[ai][0][m][n][i], up = acc[ai][1][m][n][i]; h[n * 4 + i] = gt * up * __builtin_amdgcn_rcpf(1.f + __expf(-gt)); }
                u32x4 w; w.x = cvt_pk_bf16(h[0], h[1]); w.y = cvt_pk_bf16(h[2], h[3]); w.z = cvt_pk_bf16(h[4], h[5]); w.w = cvt_pk_bf16(h[6], h[7]);
                *(u32x4*)(rowp) = w; }
    }
};
struct EpiMoeDown {
    static constexpr bool PERM = false, AFTER_DRAIN = false;
    float* XF; const int* list; const float* gate; int cnt[8], cum[8];
    __device__ __forceinline__ void operator()(const f32x4 (&acc)[2][2][4][2], const Unit& u, int wr, int wc, int fr, int fq) const {
        int e = u.aux, c_e = 0, t_e = 0;
#pragma unroll
        for (int k = 0; k < 8; ++k) { if (k == e) { c_e = cnt[k]; t_e = cum[k]; } }
        const int s0 = (u.pm - t_e) * BM + wr * 64 + fr, col0 = u.pn * BM + wc * 32 + 4 * fq;
        const int* lp = list + e * 16384;
        int tok[8]; float gt[8];
#pragma unroll
        for (int q = 0; q < 8; ++q) { const int s = s0 + (q >> 2) * HALF + (q & 3) * 16; tok[q] = (s < c_e) ? lp[s] : -1; }
#pragma unroll
        for (int q = 0; q < 8; ++q) gt[q] = (tok[q] >= 0) ? gate[tok[q]] : 0.f;
#pragma unroll
        for (int ai = 0; ai < 2; ++ai) {
            f32x4 o[4][2][2];
#pragma unroll
            for (int m = 0; m < 4; ++m) { const float* rowp = XF + (size_t)(tok[ai * 4 + m] >= 0 ? tok[ai * 4 + m] : 0) * 1024 + col0;
#pragma unroll
                for (int bj = 0; bj < 2; ++bj)
#pragma unroll
                    for (int n = 0; n < 2; ++n) o[m][bj][n] = *(const f32x4*)(rowp + bj * HALF + n * 16); }
#pragma unroll
            for (int m = 0; m < 4; ++m) { if (tok[ai * 4 + m] >= 0) { float* rowp = XF + (size_t)tok[ai * 4 + m] * 1024 + col0; const float g1 = gt[ai * 4 + m];
#pragma unroll
                for (int bj = 0; bj < 2; ++bj)
#pragma unroll
                    for (int n = 0; n < 2; ++n) *(f32x4*)(rowp + bj * HALF + n * 16) = o[m][bj][n] + acc[ai][bj][m][n] * g1; } }
        }
    }
};
struct MoeOrder {
    int T, nN, nwg, G, c; int cum[8]; size_t bstride;
    __device__ void init(const int* cnt, int nN_, int G_, int c_, size_t bstride_) {
        int t = 0;
#pragma unroll
        for (int e = 0; e < 8; ++e) { cum[e] = t; t += (cnt[e] + 255) >> 8; }
        T = t; nN = nN_; nwg = T * nN; G = G_; c = c_; bstride = bstride_;
    }
    __device__ bool next(int i, Unit& u) const {
        const long L = (long)i * G + c; if (L >= nwg) return false;
        int wgid = (int)L; { const int q = nwg / NXCD, r = nwg % NXCD, xcd = wgid % NXCD, off = wgid / NXCD; wgid = (xcd < r ? xcd * (q + 1) : r * (q + 1) + (xcd - r) * q) + off; }
        const int nig = WGM * nN, gid = wgid / nig, fm = gid * WGM, gsz = (T - fm) < WGM ? (T - fm) : WGM;
        u.pm = fm + ((wgid % nig) % gsz); u.pn = (wgid % nig) / gsz;
        int e = 0;
#pragma unroll
        for (int k = 1; k < 8; ++k) e += (u.pm >= cum[k]) ? 1 : 0;
        u.aux = e; return true;
    }
    __device__ __forceinline__ const char* aptr(const Gemm& g, const Unit& u) const { return (const char*)g.A + (size_t)u.pm * ((size_t)BM * g.K * 2); }
    __device__ __forceinline__ const char* bptr(const Gemm& g, const Unit& u) const { return (const char*)g.Bt + (size_t)u.aux * bstride + (size_t)u.pn * ((size_t)BM * g.K * 2); }
    __device__ __forceinline__ void a_ready(const Unit&) const {}
    __device__ __forceinline__ void done(const Unit&) const {}
};
}
#ifndef PG8_SP2
#define PG8_SP2 true
#endif
#ifndef PG8_ALIGN
#define PG8_ALIGN true
#endif

constexpr size_t MiB = 1u << 20;
constexpr size_t WS_CTL = 0, CTL_BYTES = 256 * 1024;
constexpr size_t WS_ROPE = 256 * 1024;
constexpr size_t WS_WIN = 1 * MiB;
constexpr size_t WS_WO = 16 * MiB;
constexpr size_t WS_WGU = 20 * MiB;
constexpr size_t WS_WD = 31 * MiB;
constexpr size_t WS_XB = 37 * MiB;
constexpr size_t WS_GAB = 69 * MiB;
constexpr size_t WS_LIST = WS_GAB + 512 * 1024;
constexpr size_t WS_GATE = WS_LIST + 1 * MiB;
constexpr size_t WS_CD = WS_GATE + 128 * 1024;
constexpr size_t WS_RWT = WS_CD + 8 * 1024;
constexpr size_t WS_WMGU = 71 * MiB, WS_WMD = 183 * MiB;
constexpr size_t WS_R = 239 * MiB;
constexpr size_t R_HP = 0, R_OB = 112 * MiB, R_U = 144 * MiB, R_WN = 160 * MiB, R_QD = 176 * MiB, R_KDT = 192 * MiB, R_QK = 208 * MiB;
constexpr size_t WS_KV = WS_XB;
constexpr size_t R_MIX = 0, R_H = 64 * MiB;
constexpr size_t R_HM = 0, R_XG = 126 * MiB, XG_PASS = 36 * MiB;
constexpr size_t WS_END = WS_R + 216 * MiB;
constexpr int CW_TMO = 0, CW_BAR = 4096, CW_MOE = 16384;

constexpr int RING_BYTES = 131072, LDS_BYTES = 147456, LDSCTL_OFF = LDS_BYTES - 512, MISC_OFF = LDSCTL_OFF + 320;

constexpr int PH_PRO = 0;
constexpr int PH_L(int l, int k) { return 1 + 16 * l + k; }
constexpr int K_IN = 0, K_PREP = 1, K_SCAN = 2, K_OUT = 3, K_LN1 = 4, K_GU = 5, K_DN = 6, K_LN2 = 7;
constexpr int K_G0 = 5, K_GU0 = 6, K_DN0 = 7, K_G1 = 8, K_GU1 = 9, K_DN1 = 10, K_LNF = 11;
constexpr int PH_END = PH_L(1, K_LNF) + 1;

struct Args { const float* in[18]; float* out; unsigned char* ws; int ph_lo, ph_hi; };
typedef const __attribute__((address_space(4))) Args* KArgs;
__device__ __forceinline__ KArgs kargs() { KArgs p = (KArgs)__builtin_amdgcn_kernarg_segment_ptr(); asm volatile("" : "+s"(p)); return p; }
__device__ __forceinline__ int tidx() { int t = threadIdx.x; asm volatile("" : "+v"(t)); return t; }

constexpr int TR_SCR = 64 * 65 * 4;
__device__ __forceinline__ void tr_item(const float* W, int N, int k0, int n0, bf16* WT, size_t ldk, int dst_row0, LAS float* scr, int lane) {
    const int nq = 4 * (lane & 15), n = n0 + nq, kr = lane >> 4;
    f32x4 v[16];
#pragma unroll
    for (int i = 0; i < 16; ++i) v[i] = (n < N) ? *(const f32x4*)(W + (size_t)(k0 + 4 * i + kr) * N + n) : (f32x4){0.f, 0.f, 0.f, 0.f};
#pragma unroll
    for (int i = 0; i < 16; ++i) { LAS float* d = scr + (4 * i + kr) * 65 + nq; d[0] = v[i].x; d[1] = v[i].y; d[2] = v[i].z; d[3] = v[i].w; }
    LDS_WAIT(); asm volatile("" ::: "memory");
    const int c = lane & 7;
#pragma unroll
    for (int j = 0; j < 8; ++j) { const int nn = (lane >> 3) + 8 * j; const LAS float* s = scr + (8 * c) * 65 + nn;
        v4u o; o.x = pk2(s[0 * 65], s[1 * 65]); o.y = pk2(s[2 * 65], s[3 * 65]); o.z = pk2(s[4 * 65], s[5 * 65]); o.w = pk2(s[6 * 65], s[7 * 65]);
        *(v4u*)(WT + (size_t)(dst_row0 + nn) * ldk + k0 + 8 * c) = o; }
    LDS_WAIT(); asm volatile("" ::: "memory");
}

constexpr int PRO_I_IN = 16 * 57, PRO_NIT = 2 * (16 * 57 + 16 * 16) + 2 * (16 * 44) + 44 * 16;
__device__ __forceinline__ void ph_prologue(KArgs a, LAS unsigned char* lds, int wave, int lane, int gw, int NGW, int gtid, int NT, int it_lo, int it_hi, bool misc) {
    unsigned char* ws = a->ws;
    LAS float* scr = (LAS float*)(lds + wave * TR_SCR);
    constexpr int I_IN = 16 * 57, I_O = 16 * 16, I_L = I_IN + I_O, I_G = 16 * 44, I_D = 44 * 16, NIT = 2 * I_L + 2 * I_G + I_D;
    static_assert(NIT == PRO_NIT && I_IN == PRO_I_IN, "prologue item counts");
    for (int it = it_lo + gw; it < it_hi; it += NGW) {
        int r = it;
        if (r < 2 * I_L) { const int l = r / I_L; r -= l * I_L;
            if (r < I_IN) { const int kb = r / 57, nb = r % 57; tr_item(a->in[1] + (size_t)l * 1024 * IN_COLS, IN_COLS, 64 * kb, 64 * nb, (bf16*)(ws + WS_WIN) + (size_t)l * NIN_PAD * 1024, 1024, 64 * nb, scr, lane); }
            else { r -= I_IN; const int kb = r / 16, nb = r % 16; tr_item(a->in[6] + (size_t)l * 1024 * 1024, 1024, 64 * kb, 64 * nb, (bf16*)(ws + WS_WO) + (size_t)l * 1024 * 1024, 1024, 64 * nb, scr, lane); }
            continue; }
        r -= 2 * I_L;
        if (r < 2 * I_G) { const int up = r / I_G; r -= up * I_G; const int kb = r / 44, nb = r % 44, n0 = 64 * nb;
            tr_item(up ? a->in[12] : a->in[11], FF, 64 * kb, n0, (bf16*)(ws + WS_WGU), 1024, 256 * (n0 >> 7) + (n0 & 127) + 128 * up, scr, lane); continue; }
        r -= 2 * I_G;
        { const int kb = r / 16, nb = r % 16; tr_item(a->in[13], 1024, 64 * kb, 64 * nb, (bf16*)(ws + WS_WD), FF, 64 * nb, scr, lane); }
    }
    if (!misc) return;
    for (int i = gtid; i < 2 * 192 * 128; i += NT) { const int l = i / (192 * 128), r = i % (192 * 128);
        ((v4u*)((bf16*)(ws + WS_WIN) + (size_t)l * NIN_PAD * 1024 + (size_t)3648 * 1024))[r] = (v4u){0u, 0u, 0u, 0u}; }
    for (int i = gtid; i < M * D / 8; i += NT) { const f32x4 p = ((const f32x4*)a->in[0])[2 * i], q = ((const f32x4*)a->in[0])[2 * i + 1];
        v4u o; o.x = pk2(p.x, p.y); o.y = pk2(p.z, p.w); o.z = pk2(q.x, q.y); o.w = pk2(q.z, q.w); ((v4u*)(ws + WS_XB))[i] = o; }
    for (int i = gtid; i < 8192; i += NT) ((float*)(ws + WS_RWT))[(i & 7) * 1024 + (i >> 3)] = a->in[14][i];
    for (int i = gtid; i < SEQ * 32; i += NT) { const int pos = i >> 5, k = i & 31;
        const float inv = powf(10000.0f, -(float)(2 * k) / 64.0f); const float ang = (float)pos * inv;
        double rev = (double)ang * 0.15915494309189535; rev -= floor(rev); const float rf = (float)rev;
        float* R = (float*)(ws + WS_ROPE) + (size_t)pos * 64; R[k] = __builtin_amdgcn_cosf(rf); R[32 + k] = __builtin_amdgcn_sinf(rf); }
}

__device__ __forceinline__ void moe_convert(KArgs a, LAS unsigned char* lds, int wave, int lane, int gw, int NGW, int e_lo, int e_hi) {
    unsigned char* ws = a->ws;
    LAS float* scr = (LAS float*)(lds + wave * TR_SCR);
    constexpr int I_G = 16 * 56, I_D = 56 * 16, I_E = 2 * I_G + I_D;
    for (int it = e_lo * I_E + gw; it < e_hi * I_E; it += NGW) {
        const int e = it / I_E; int r = it - e * I_E;
        if (r < 2 * I_G) { const int up = r / I_G; r -= up * I_G; const int kb = r / 56, nb = r % 56, n0 = 64 * nb;
            tr_item((up ? a->in[16] : a->in[15]) + (size_t)e * 1024 * FE, FE, 64 * kb, n0, (bf16*)(ws + WS_WMGU) + (size_t)e * 7168 * 1024, 1024, 256 * (n0 >> 7) + (n0 & 127) + 128 * up, scr, lane); }
        else { r -= 2 * I_G; const int kb = r / 16, nb = r % 16; tr_item(a->in[17] + (size_t)e * FE * 1024, 1024, 64 * kb, 64 * nb, (bf16*)(ws + WS_WMD) + (size_t)e * 1024 * FE, FE, 64 * nb, scr, lane); }
    }
}

template <bool ROUTE>
__device__ __forceinline__ void ln_rows(const float* res, float ares, const bf16* mix, const float* g, const float* bta, float* xf, float oscale, bf16* xb,
                                        const float* router, unsigned* cntw, int* list, float* gate, int lane, int gw, int NGW) {
    f32x4 gv[4], bv[4];
#pragma unroll
    for (int j = 0; j < 4; ++j) { gv[j] = ((const f32x4*)g)[lane + 64 * j]; bv[j] = ((const f32x4*)bta)[lane + 64 * j]; }
    f32x4 rn[4]; v2u mn[4];
#define LN_FETCH(r_) do { const f32x4* rr_ = (const f32x4*)(res + (size_t)(r_) * D) + lane; _Pragma("unroll") for (int j = 0; j < 4; ++j) rn[j] = rr_[64 * j]; \
        if (mix) { const v2u* mr_ = (const v2u*)(mix + (size_t)(r_) * D) + lane; _Pragma("unroll") for (int j = 0; j < 4; ++j) mn[j] = mr_[64 * j]; } } while (0)
#pragma unroll
    for (int j = 0; j < 4; ++j) { rn[j] = (f32x4){0.f, 0.f, 0.f, 0.f}; mn[j] = (v2u){0u, 0u}; }
    if (gw < M) LN_FETCH(gw);
    for (int row = gw; row < M; row += NGW) {
        f32x4 v[4]; float s = 0.f;
#pragma unroll
        for (int j = 0; j < 4; ++j) { v[j] = rn[j] * ares; if (mix) v[j] = v[j] + (f32x4){bflo(mn[j].x), bfhi(mn[j].x), bflo(mn[j].y), bfhi(mn[j].y)}; }
        if (row + NGW < M) LN_FETCH(row + NGW);
#pragma unroll
        for (int j = 0; j < 4; ++j) s += (v[j].x + v[j].y) + (v[j].z + v[j].w);
        const float mean = wave_sum(s) * (1.f / D); float s2 = 0.f;
#pragma unroll
        for (int j = 0; j < 4; ++j) { v[j] = v[j] - mean; s2 += (v[j].x * v[j].x + v[j].y * v[j].y) + (v[j].z * v[j].z + v[j].w * v[j].w); }
        const float rstd = 1.f / sqrtf(wave_sum(s2) * (1.f / D) + LN_EPS);
#pragma unroll
        for (int j = 0; j < 4; ++j) v[j] = v[j] * rstd * gv[j] + bv[j];
        f32x4* xo = (f32x4*)(xf + (size_t)row * D) + lane;
#pragma unroll
        for (int j = 0; j < 4; ++j) xo[64 * j] = v[j] * oscale;
        if (xb) { v2u* bo = (v2u*)(xb + (size_t)row * D) + lane;
#pragma unroll
            for (int j = 0; j < 4; ++j) { v2u o; o.x = pk2(v[j].x, v[j].y); o.y = pk2(v[j].z, v[j].w); bo[64 * j] = o; } }
        if (ROUTE) {
            float lg[8];
#pragma unroll
            for (int e = 0; e < 8; ++e) lg[e] = 0.f;
#pragma unroll
            for (int e = 0; e < 8; ++e)
#pragma unroll
                for (int j = 0; j < 4; ++j) { const f32x4 r4 = ((const f32x4*)(router + e * 1024))[lane + 64 * j]; lg[e] += (v[j].x * r4.x + v[j].y * r4.y) + (v[j].z * r4.z + v[j].w * r4.w); }
#pragma unroll
            for (int e = 0; e < 8; ++e) lg[e] = wave_sum(lg[e]);
            if (lane == 0) {
                int e0 = 0; float v0 = lg[0];
#pragma unroll
                for (int e = 1; e < 8; ++e) if (lg[e] > v0) { v0 = lg[e]; e0 = e; }
                int e1 = -1; float v1 = -3.0e38f;
#pragma unroll
                for (int e = 0; e < 8; ++e) if (e != e0 && lg[e] > v1) { v1 = lg[e]; e1 = e; }
                const float p1 = __expf(v1 - v0), g0 = 1.f / (1.f + p1), g1 = p1 / (1.f + p1);
                const unsigned s0 = __hip_atomic_fetch_add(cntw + 64 * e0, 1u, RLX_AGENT), s1 = __hip_atomic_fetch_add(cntw + 64 * (8 + e1), 1u, RLX_AGENT);
                list[(size_t)e0 * 16384 + s0] = row; list[(size_t)(8 + e1) * 16384 + s1] = row; gate[row] = g0; gate[16384 + row] = g1;
            }
        }
    }
}

__device__ __forceinline__ void moe_gather(KArgs a, int j, int lane, int gw, int NGW) {
    unsigned char* ws = a->ws; const unsigned* cntw = (const unsigned*)(ws + WS_CTL) + CW_MOE + 64 * (j * 8);
    int pre[8], cum[8]; { int p = 0, t = 0;
#pragma unroll
        for (int e = 0; e < 8; ++e) { const int c = (int)cntw[64 * e]; pre[e] = p; cum[e] = t; p += c; t += (c + 255) >> 8; } }
    const int* list = (const int*)(ws + WS_LIST) + (size_t)j * 8 * 16384;
    for (int r0 = gw; r0 < M; r0 += 8 * NGW) {
        int tok[8], drow[8];
#pragma unroll
        for (int q = 0; q < 8; ++q) { const int r = r0 + q * NGW; tok[q] = -1; drow[q] = 0;
            if (r < M) { int e = 0;
#pragma unroll
                for (int k = 1; k < 8; ++k) e += (r >= pre[k]) ? 1 : 0;
                int pe = 0, ce = 0;
#pragma unroll
                for (int k = 0; k < 8; ++k) if (k == e) { pe = pre[k]; ce = cum[k]; }
                const int s = r - pe; tok[q] = list[(size_t)e * 16384 + s]; drow[q] = ce * 256 + s; } }
        v4u x0[8], x1[8];
#pragma unroll
        for (int q = 0; q < 8; ++q) { const v4u* src = (const v4u*)((const bf16*)(ws + WS_XB) + (size_t)(tok[q] >= 0 ? tok[q] : 0) * 1024); x0[q] = src[lane]; x1[q] = src[lane + 64]; }
#pragma unroll
        for (int q = 0; q < 8; ++q) if (tok[q] >= 0) { v4u* dst = (v4u*)((bf16*)(ws + WS_R + R_XG + (size_t)j * XG_PASS) + (size_t)drow[q] * 1024); dst[lane] = x0[q]; dst[lane + 64] = x1[q]; }
    }
}

__device__ __forceinline__ void gdn_prep_unit(KArgs a, int l, int unit, LAS unsigned char* lds, int tid, int lane, int wave) {
    unsigned char* ws = a->ws;
    const int n = unit & 31, bh = unit >> 5, h = bh & 3, b = bh >> 2;
    const int t0 = b * SEQ + n * 64;
    LAS float* Q = (LAS float*)lds; LAS float* K = Q + 8192; LAS float* V = K + 8192; LAS float* A = V + 8192; LAS float* gc = A + 4096; LAS float* bt = gc + 64;
    const bf16* HP = (const bf16*)(ws + WS_R + R_HP);
    const float* cw = a->in[2] + (size_t)l * 4 * 1536;
    __syncthreads();
    for (int idx = tid; idx < 64 * 384; idx += 512) { const int i = idx / 384, c = idx % 384, which = c >> 7, d = c & 127;
        const int col = COL_GQ + which * 512 + h * 128 + d, cc = which * 512 + h * 128 + d; float acc = 0.f;
#pragma unroll
        for (int j = 0; j < 4; ++j) { const int s = n * 64 + i - 3 + j; if (s >= 0) acc += cw[j * 1536 + cc] * bf2f(HP[(size_t)(b * SEQ + s) * HP_LD + col]); }
        const float y = siluf(acc); LAS float* dst = which == 0 ? Q : (which == 1 ? K : V); dst[i * 128 + d] = y; }
    if (tid < 64) { const float* gab = (const float*)(ws + WS_GAB) + (size_t)(t0 + tid) * 8; const float x = gab[h] + a->in[4][l * 4 + h];
        const float sp = fmaxf(x, 0.f) + log1pf(__expf(-fabsf(x))); gc[tid] = -__expf(a->in[3][l * 4 + h]) * sp; bt[tid] = sigmf(gab[4 + h]); }
    __syncthreads();
#pragma unroll 1
    for (int r = 0; r < 8; ++r) { const int i = wave * 8 + r;
        float q0 = Q[i * 128 + lane], q1 = Q[i * 128 + lane + 64], k0 = K[i * 128 + lane], k1 = K[i * 128 + lane + 64];
        const float sq = wave_sum(q0 * q0 + q1 * q1), sk = wave_sum(k0 * k0 + k1 * k1);
        const float fq = rsqrtf(sq + NORM_EPS) * 0.08838834764831845f, fk = rsqrtf(sk + NORM_EPS);
        Q[i * 128 + lane] = q0 * fq; Q[i * 128 + lane + 64] = q1 * fq; K[i * 128 + lane] = k0 * fk; K[i * 128 + lane + 64] = k1 * fk; }
    if (tid == 0) { float c = 0.f; for (int i = 0; i < 64; ++i) { c += gc[i]; gc[i] = c; } }
    __syncthreads();
    bf16* QKg = (bf16*)(ws + WS_R + R_QK) + (size_t)unit * 4096; bf16* QDg = (bf16*)(ws + WS_R + R_QD) + (size_t)unit * 8192; bf16* KDTg = (bf16*)(ws + WS_R + R_KDT) + (size_t)unit * 8192;
    bf16* WNg = (bf16*)(ws + WS_R + R_WN) + (size_t)unit * 8192; bf16* Ug = (bf16*)(ws + WS_R + R_U) + (size_t)unit * 8192;
    for (int idx = tid; idx < 4096; idx += 512) { const int i = idx >> 6, j = idx & 63; float dqk = 0.f, dkk = 0.f;
        for (int dd = 0; dd < 128; ++dd) { const int d = (dd + j) & 127; const float kj = K[j * 128 + d]; dqk += Q[i * 128 + d] * kj; dkk += K[i * 128 + d] * kj; }
        const float dec = __expf(gc[i] - gc[j]);
        A[i * 64 + j] = (j < i) ? bt[i] * dkk * dec : 0.f;
        QKg[fragoff(i, j, 2)] = (bf16)f2bf((j <= i) ? dqk * dec : 0.f); }
    const float gl = gc[63];
    for (int idx = tid; idx < 8192; idx += 512) { const int i = idx >> 7, d = idx & 127;
        QDg[fragoff(i, d, 4)] = (bf16)f2bf(Q[i * 128 + d] * __expf(gc[i]));
        KDTg[fragoff(d, i, 2)] = (bf16)f2bf(K[i * 128 + d] * __expf(gl - gc[i])); }
    if (tid == 0) ((float*)(ws + WS_CD))[unit] = __expf(gl);
    __syncthreads();
    for (int idx = tid; idx < 8192; idx += 512) { const int i = idx >> 7; const float bi = bt[i]; V[idx] *= bi; Q[idx] = bi * __expf(gc[i]) * K[idx]; }
    __syncthreads();
    if (tid < 256) { LAS float* buf = (tid < 128 ? V : Q) + (tid & 127);
        for (int i = 1; i < 64; ++i) { float acc = buf[i * 128]; for (int m = 0; m < i; ++m) acc -= A[i * 64 + m] * buf[m * 128]; buf[i * 128] = acc; } }
    __syncthreads();
    for (int idx = tid; idx < 8192; idx += 512) { const int i = idx >> 7, d = idx & 127; Ug[uoff(i, d)] = (bf16)f2bf(V[idx]); WNg[fragoff(i, d, 4)] = (bf16)f2bf(-Q[idx]); }
}

__device__ __forceinline__ void gdn_scan_naive(KArgs a, int l, int bh, LAS unsigned char* lds, int tid, int lane, int wave) {
    unsigned char* ws = a->ws;
    LAS float* S = (LAS float*)lds; LAS float* VN = S + 16384; LAS float* O = VN + 8192;
    const int h = bh & 3, b = bh >> 2, e = tid & 127, ig = tid >> 7;
    const bf16* HP = (const bf16*)(ws + WS_R + R_HP); bf16* OB = (bf16*)(ws + WS_R + R_OB);
    const float* nw = a->in[5] + l * 128;
    __syncthreads();
    for (int idx = tid; idx < 16384; idx += 512) S[idx] = 0.f;
    __syncthreads();
#pragma unroll 1
    for (int n = 0; n < 32; ++n) {
        const int unit = bh * 32 + n;
        const bf16* Ug = (const bf16*)(ws + WS_R + R_U) + (size_t)unit * 8192; const bf16* WNg = (const bf16*)(ws + WS_R + R_WN) + (size_t)unit * 8192;
        const bf16* QDg = (const bf16*)(ws + WS_R + R_QD) + (size_t)unit * 8192; const bf16* KDTg = (const bf16*)(ws + WS_R + R_KDT) + (size_t)unit * 8192;
        const bf16* QKg = (const bf16*)(ws + WS_R + R_QK) + (size_t)unit * 4096; const float cd = ((const float*)(ws + WS_CD))[unit];
#pragma unroll 1
        for (int r = 0; r < 16; ++r) { const int i = ig + 4 * r; float acc = bf2f(Ug[uoff(i, e)]);
#pragma unroll 2
            for (int d0 = 0; d0 < 128; d0 += 4) { const v2u w = *(const v2u*)(WNg + fragoff(i, d0, 4));
                acc += bflo(w.x) * S[d0 * 128 + e] + bfhi(w.x) * S[(d0 + 1) * 128 + e] + bflo(w.y) * S[(d0 + 2) * 128 + e] + bfhi(w.y) * S[(d0 + 3) * 128 + e]; }
            VN[i * 128 + e] = acc; }
        __syncthreads();
#pragma unroll 1
        for (int r = 0; r < 16; ++r) { const int i = ig + 4 * r; float acc = 0.f;
#pragma unroll 2
            for (int d0 = 0; d0 < 128; d0 += 4) { const v2u w = *(const v2u*)(QDg + fragoff(i, d0, 4));
                acc += bflo(w.x) * S[d0 * 128 + e] + bfhi(w.x) * S[(d0 + 1) * 128 + e] + bflo(w.y) * S[(d0 + 2) * 128 + e] + bfhi(w.y) * S[(d0 + 3) * 128 + e]; }
#pragma unroll 2
            for (int j0 = 0; j0 < 64; j0 += 4) { const v2u w = *(const v2u*)(QKg + fragoff(i, j0, 2));
                acc += bflo(w.x) * VN[j0 * 128 + e] + bfhi(w.x) * VN[(j0 + 1) * 128 + e] + bflo(w.y) * VN[(j0 + 2) * 128 + e] + bfhi(w.y) * VN[(j0 + 3) * 128 + e]; }
            O[i * 128 + e] = acc; }
        __syncthreads();
#pragma unroll 1
        for (int r = 0; r < 32; ++r) { const int d = ig + 4 * r; float acc = S[d * 128 + e] * cd;
#pragma unroll 2
            for (int i0 = 0; i0 < 64; i0 += 4) { const v2u w = *(const v2u*)(KDTg + fragoff(d, i0, 2));
                acc += bflo(w.x) * VN[i0 * 128 + e] + bfhi(w.x) * VN[(i0 + 1) * 128 + e] + bflo(w.y) * VN[(i0 + 2) * 128 + e] + bfhi(w.y) * VN[(i0 + 3) * 128 + e]; }
            S[d * 128 + e] = acc; }
#pragma unroll 1
        for (int r = 0; r < 8; ++r) { const int i = wave * 8 + r; const float v0 = O[i * 128 + lane], v1 = O[i * 128 + lane + 64];
            const float rs = rsqrtf(wave_sum(v0 * v0 + v1 * v1) * (1.f / 128.f) + NORM_EPS);
            const size_t t = (size_t)b * SEQ + n * 64 + i; const bf16* gp = HP + t * HP_LD + COL_GG + h * 128; bf16* op = OB + t * 1024 + 512 + h * 128;
            op[lane] = (bf16)f2bf(v0 * rs * nw[lane] * siluf(bf2f(gp[lane]))); op[lane + 64] = (bf16)f2bf(v1 * rs * nw[lane + 64] * siluf(bf2f(gp[lane + 64]))); }
        __syncthreads();
    }
}

__device__ __forceinline__ void ret_unit_naive(KArgs a, int unit, LAS unsigned char* lds, int tid, int lane, int wave) {
    unsigned char* ws = a->ws;
    LAS float* Qs = (LAS float*)lds; LAS float* Ks = Qs + 64 * 65; LAS float* Vs = Ks + 64 * 65; LAS float* Sc = Vs + 8192;
    const int qb = unit & 31, bh = unit >> 5, h = bh & 3, b = bh >> 2, e = tid & 127, ig = tid >> 7;
    const bf16* HP = (const bf16*)(ws + WS_R + R_HP); bf16* OB = (bf16*)(ws + WS_R + R_OB); const float* RT = (const float*)(ws + WS_ROPE);
    const float log2g = log2f(1.0f - exp2f(-5.0f - (float)h));
    __syncthreads();
    for (int idx = tid; idx < 4096; idx += 512) { const int i = idx >> 6, d = idx & 63, dd = d & 31, pos = qb * 64 + i; const size_t t = (size_t)b * SEQ + pos;
        const float c = RT[pos * 64 + dd], s = RT[pos * 64 + 32 + dd]; const float x1 = bf2f(HP[t * HP_LD + COL_RQ + h * 64 + dd]), x2 = bf2f(HP[t * HP_LD + COL_RQ + h * 64 + dd + 32]);
        Qs[i * 65 + d] = d < 32 ? x1 * c - x2 * s : x1 * s + x2 * c; }
    float acc[16];
#pragma unroll
    for (int r = 0; r < 16; ++r) acc[r] = 0.f;
#pragma unroll 1
    for (int kb = 0; kb <= qb; ++kb) {
        __syncthreads();
        for (int idx = tid; idx < 4096; idx += 512) { const int i = idx >> 6, d = idx & 63, dd = d & 31, pos = kb * 64 + i; const size_t t = (size_t)b * SEQ + pos;
            const float c = RT[pos * 64 + dd], s = RT[pos * 64 + 32 + dd]; const float x1 = bf2f(HP[t * HP_LD + COL_RK + h * 64 + dd]), x2 = bf2f(HP[t * HP_LD + COL_RK + h * 64 + dd + 32]);
            Ks[i * 65 + d] = 0.125f * (d < 32 ? x1 * c - x2 * s : x1 * s + x2 * c); }
        for (int idx = tid; idx < 8192; idx += 512) { const int i = idx >> 7, d = idx & 127; Vs[idx] = bf2f(HP[((size_t)b * SEQ + kb * 64 + i) * HP_LD + COL_RV + h * 128 + d]); }
        __syncthreads();
        { const int j = tid & 63, ig8 = tid >> 6;
#pragma unroll 1
          for (int r = 0; r < 8; ++r) { const int i = ig8 + 8 * r; float dot = 0.f;
#pragma unroll 8
              for (int d = 0; d < 64; ++d) dot += Qs[i * 65 + d] * Ks[j * 65 + d];
              const int delta = (qb - kb) * 64 + i - j; Sc[i * 65 + j] = delta >= 0 ? dot * exp2f((float)delta * log2g) : 0.f; } }
        __syncthreads();
#pragma unroll 2
        for (int j = 0; j < 64; ++j) { const float vv = Vs[j * 128 + e];
#pragma unroll
            for (int r = 0; r < 16; ++r) acc[r] += Sc[(ig + 4 * r) * 65 + j] * vv; }
    }
    __syncthreads();
#pragma unroll
    for (int r = 0; r < 16; ++r) Vs[(ig + 4 * r) * 128 + e] = acc[r];
    __syncthreads();
#pragma unroll 1
    for (int r = 0; r < 8; ++r) { const int i = wave * 8 + r; const float v0 = Vs[i * 128 + lane], v1 = Vs[i * 128 + lane + 64];
        const float mean = wave_sum(v0 + v1) * (1.f / 128.f), d0 = v0 - mean, d1 = v1 - mean; const float rs = rsqrtf(wave_sum(d0 * d0 + d1 * d1) * (1.f / 128.f) + LN_EPS);
        const size_t t = (size_t)b * SEQ + qb * 64 + i; const bf16* gp = HP + t * HP_LD + COL_RG + h * 128; bf16* op = OB + t * 1024 + h * 128;
        op[lane] = (bf16)f2bf(d0 * rs * siluf(bf2f(gp[lane]))); op[lane + 64] = (bf16)f2bf(d1 * rs * siluf(bf2f(gp[lane + 64]))); }
}

typedef float f32x16 __attribute__((ext_vector_type(16)));
typedef float f32x8 __attribute__((ext_vector_type(8)));
typedef __bf16 bf8v __attribute__((ext_vector_type(8)));
typedef short bf16x8 __attribute__((ext_vector_type(8)));
#define MFMA32(a, b, c) __builtin_amdgcn_mfma_f32_32x32x16_bf16((a), (b), (c), 0, 0, 0)
__device__ __forceinline__ bf16x8 pack8(const f32x16& x, int s) {
    f32x8 v;
#pragma unroll
    for (int j = 0; j < 8; ++j) v[j] = x[8 * s + j];
    return __builtin_bit_cast(bf16x8, __builtin_convertvector(v, bf8v));
}

__device__ __forceinline__ unsigned short bfc(float x) { return __builtin_bit_cast(unsigned short, (__bf16)x); }
__device__ __forceinline__ unsigned bfc2(float lo, float hi) { return (unsigned)bfc(lo) | ((unsigned)bfc(hi) << 16); }

#define GDN_BAR() do { asm volatile("s_waitcnt lgkmcnt(0)" ::: "memory"); __builtin_amdgcn_s_barrier(); asm volatile("" ::: "memory"); } while (0)
__device__ __forceinline__ void gdn_scan_fast(KArgs a, int l, int bh, LAS unsigned char* lds, int tid, int lane, int wave) {
    unsigned char* ws = a->ws;
    constexpr int FB_WN = 0, FB_QD = 16384, FB_KDT = 32768, FB_QK = 49152, FB_U = 57344, FB_BYTES = 73728;
    LAS float* OL = (LAS float*)(lds + FB_BYTES);
    constexpr int OLS = 64 * 132;
    const int h = bh & 3, b = bh >> 2, c = lane & 31, hh = lane >> 5;
    const bf16* HP = (const bf16*)(ws + WS_R + R_HP); bf16* OB = (bf16*)(ws + WS_R + R_OB);
    const float* nw = a->in[5] + l * 128;
    const unsigned char* gWN = (const unsigned char*)(ws + WS_R + R_WN) + (size_t)bh * 32 * 16384; const unsigned char* gQD = (const unsigned char*)(ws + WS_R + R_QD) + (size_t)bh * 32 * 16384;
    const unsigned char* gKDT = (const unsigned char*)(ws + WS_R + R_KDT) + (size_t)bh * 32 * 16384; const unsigned char* gQK = (const unsigned char*)(ws + WS_R + R_QK) + (size_t)bh * 32 * 8192;
    const unsigned char* gU = (const unsigned char*)(ws + WS_R + R_U) + (size_t)bh * 32 * 16384;
    const int et = tid - 256;
#define GDN_FETCH(pf, nn) do { _Pragma("unroll") for (int k = 0; k < 18; ++k) { const unsigned char* src_ = k < 4 ? gWN + (size_t)(nn) * 16384 + k * 4096 : k < 8 ? gQD + (size_t)(nn) * 16384 + (k - 4) * 4096 : \
        k < 12 ? gKDT + (size_t)(nn) * 16384 + (k - 8) * 4096 : k < 14 ? gQK + (size_t)(nn) * 8192 + (k - 12) * 4096 : gU + (size_t)(nn) * 16384 + (k - 14) * 4096; pf[k] = *(const v4u*)(src_ + et * 16); } } while (0)
#define GDN_STORE(pf) do { _Pragma("unroll") for (int k = 0; k < 18; ++k) *(LAS v4u*)(lds + k * 4096 + et * 16) = pf[k]; } while (0)
    __syncthreads();
    if (wave < 4) {
        f32x16 S[4];
#pragma unroll
        for (int t = 0; t < 4; ++t)
#pragma unroll
            for (int i = 0; i < 16; ++i) S[t][i] = 0.f;
        GDN_BAR();
        const int q = wave;
        const LAS bf16x8* WNf = (const LAS bf16x8*)(lds + FB_WN) + lane; const LAS bf16x8* QDf = (const LAS bf16x8*)(lds + FB_QD) + lane;
        const LAS bf16x8* KDTf = (const LAS bf16x8*)(lds + FB_KDT) + lane; const LAS bf16x8* QKf = (const LAS bf16x8*)(lds + FB_QK) + lane;
        const LAS v4u* Uf = (const LAS v4u*)(lds + FB_U) + (q * 2) * 128 + lane;
#pragma unroll 1
        for (int n = 0; n < 32; ++n) {
            const float cd = ((const float*)(ws + WS_CD))[bh * 32 + n];
            bf16x8 A0[8], A1[8];
#define GDN_LD_MTS(A, F, g) do { _Pragma("unroll") for (int k = 0; k < 8; ++k) { const int m_ = k & 1, s_ = (k >> 1) & 1, t_ = 2 * (g) + (k >> 2); A[k] = F[((m_ * 4 + t_) * 2 + s_) * 64]; } } while (0)
#define GDN_LD_TMS(A, F, g) do { _Pragma("unroll") for (int k = 0; k < 8; ++k) { const int s_ = k & 1, m_ = (k >> 1) & 1, t_ = 2 * (g) + (k >> 2); A[k] = F[((t_ * 2 + m_) * 2 + s_) * 64]; } } while (0)
            GDN_LD_MTS(A0, WNf, 0); GDN_LD_MTS(A1, WNf, 1);
            f32x16 av[2];
#pragma unroll
            for (int m = 0; m < 2; ++m)
#pragma unroll
                for (int hf = 0; hf < 2; ++hf) { const v4u u4 = Uf[(m * 2 + hf) * 64];
#pragma unroll
                    for (int k = 0; k < 4; ++k) { av[m][8 * hf + 2 * k] = bflo(u4[k]); av[m][8 * hf + 2 * k + 1] = bfhi(u4[k]); } }
            bf16x8 Sb[4][2];
#pragma unroll
            for (int t = 0; t < 4; ++t) { Sb[t][0] = pack8(S[t], 0); Sb[t][1] = pack8(S[t], 1); }
#pragma unroll
            for (int k = 0; k < 8; ++k) { const int m_ = k & 1, s_ = (k >> 1) & 1, t_ = (k >> 2); av[m_] = MFMA32(A0[k], Sb[t_][s_], av[m_]); }
            GDN_LD_MTS(A0, QDf, 0);
#pragma unroll
            for (int k = 0; k < 8; ++k) { const int m_ = k & 1, s_ = (k >> 1) & 1, t_ = 2 + (k >> 2); av[m_] = MFMA32(A1[k], Sb[t_][s_], av[m_]); }
            GDN_LD_MTS(A1, QDf, 1);
            f32x16 ao[2];
#pragma unroll
            for (int m = 0; m < 2; ++m)
#pragma unroll
                for (int i = 0; i < 16; ++i) ao[m][i] = 0.f;
#pragma unroll
            for (int k = 0; k < 8; ++k) { const int m_ = k & 1, s_ = (k >> 1) & 1, t_ = (k >> 2); ao[m_] = MFMA32(A0[k], Sb[t_][s_], ao[m_]); }
#pragma unroll
            for (int k = 0; k < 6; ++k) { const int s_ = k & 1, m_ = k >= 2 ? 1 : 0, mp_ = k >= 4 ? 1 : 0; A0[k] = QKf[((m_ * 2 + mp_) * 2 + s_) * 64]; }
#pragma unroll
            for (int k = 0; k < 8; ++k) { const int m_ = k & 1, s_ = (k >> 1) & 1, t_ = 2 + (k >> 2); ao[m_] = MFMA32(A1[k], Sb[t_][s_], ao[m_]); }
            GDN_LD_TMS(A1, KDTf, 0);
            bf16x8 Vb[2][2];
#pragma unroll
            for (int m = 0; m < 2; ++m) { Vb[m][0] = pack8(av[m], 0); Vb[m][1] = pack8(av[m], 1); }
#pragma unroll
            for (int k = 0; k < 6; ++k) { const int s_ = k & 1, m_ = k >= 2 ? 1 : 0, mp_ = k >= 4 ? 1 : 0; ao[m_] = MFMA32(A0[k], Vb[mp_][s_], ao[m_]); }
            GDN_LD_TMS(A0, KDTf, 1);
            {   LAS float* Ob = OL + (n & 1) * OLS + 32 * wave + c;
#pragma unroll
                for (int m = 0; m < 2; ++m)
#pragma unroll
                    for (int i = 0; i < 16; ++i) Ob[(32 * m + (i & 3) + 8 * (i >> 2) + 4 * hh) * 132] = ao[m][i]; }
#pragma unroll
            for (int t = 0; t < 4; ++t)
#pragma unroll
                for (int i = 0; i < 16; ++i) S[t][i] *= cd;
#pragma unroll
            for (int k = 0; k < 8; ++k) { const int s_ = k & 1, m_ = (k >> 1) & 1, t_ = (k >> 2); S[t_] = MFMA32(A1[k], Vb[m_][s_], S[t_]); }
#pragma unroll
            for (int k = 0; k < 8; ++k) { const int s_ = k & 1, m_ = (k >> 1) & 1, t_ = 2 + (k >> 2); S[t_] = MFMA32(A0[k], Vb[m_][s_], S[t_]); }
#undef GDN_LD_MTS
#undef GDN_LD_TMS
            GDN_BAR();
            GDN_BAR();
        }
        GDN_BAR(); GDN_BAR();
    } else {
        v4u pfA[18], pfB[18];
        LAS float* NWl = OL + 2 * OLS;
        if (et < 128) NWl[et] = nw[et];
        GDN_FETCH(pfB, 0); GDN_FETCH(pfA, 1); GDN_STORE(pfB);
        GDN_BAR();
        const int i = et >> 2, qd = et & 3;
#define GDN_LOADER_ITER(n, PF_FETCH, PF_STORE) do { \
            if ((n) + 2 < 32) GDN_FETCH(PF_FETCH, (n) + 2); \
            if ((n) > 0) { \
                const LAS float* Ob = OL + (((n) - 1) & 1) * OLS + i * 132 + 32 * qd; \
                float ss = 0.f; \
                _Pragma("unroll") for (int k = 0; k < 8; ++k) { const f32x4 v_ = *(const LAS f32x4*)(Ob + 4 * k); ss += (v_.x * v_.x + v_.y * v_.y) + (v_.z * v_.z + v_.w * v_.w); } \
                ss += __shfl_xor(ss, 1); ss += __shfl_xor(ss, 2); \
                const float rs = rsqrtf(ss * (1.f / 128.f) + NORM_EPS); \
                bf16* op = OB + ((size_t)b * SEQ + ((n) - 1) * 64 + i) * 1024 + 512 + h * 128 + 32 * qd; \
                _Pragma("unroll") for (int k = 0; k < 4; ++k) { const f32x4 w0 = *(const LAS f32x4*)(NWl + 32 * qd + 8 * k), w1 = *(const LAS f32x4*)(NWl + 32 * qd + 8 * k + 4); const v4u gg = gq[k]; \
                    const f32x4 a0 = *(const LAS f32x4*)(Ob + 8 * k), a1 = *(const LAS f32x4*)(Ob + 8 * k + 4); \
                    v4u o; o.x = bfc2(a0.x * rs * w0.x * siluf(bflo(gg.x)), a0.y * rs * w0.y * siluf(bfhi(gg.x))); o.y = bfc2(a0.z * rs * w0.z * siluf(bflo(gg.y)), a0.w * rs * w0.w * siluf(bfhi(gg.y))); \
                    o.z = bfc2(a1.x * rs * w1.x * siluf(bflo(gg.z)), a1.y * rs * w1.y * siluf(bfhi(gg.z))); o.w = bfc2(a1.z * rs * w1.z * siluf(bflo(gg.w)), a1.w * rs * w1.w * siluf(bfhi(gg.w))); \
                    *(v4u*)(op + 8 * k) = o; } \
            } \
            asm volatile("" ::: "memory"); \
            if ((n) < 32) { const bf16* gp = HP + ((size_t)b * SEQ + (n) * 64 + i) * HP_LD + COL_GG + h * 128 + 32 * qd;     \
                _Pragma("unroll") for (int k = 0; k < 4; ++k) gq[k] = *(const v4u*)(gp + 8 * k); } \
            GDN_BAR();            \
            if ((n) + 1 < 32) GDN_STORE(PF_STORE); \
            GDN_BAR();            \
        } while (0)
        v4u gq[4];
#pragma unroll
        for (int k = 0; k < 4; ++k) gq[k] = (v4u){0u, 0u, 0u, 0u};
#pragma unroll
        for (int n = 0; n < 32; n += 2) {
            GDN_LOADER_ITER(n, pfB, pfA);
            GDN_LOADER_ITER(n + 1, pfA, pfB);
        }
        GDN_LOADER_ITER(32, pfB, pfA);
#undef GDN_LOADER_ITER
    }
#undef GDN_FETCH
#undef GDN_STORE
}

struct RetLds {
    static constexpr int QS = 72, JS = 136;
    static constexpr int P = 0, Q1 = 34816, K1 = 53248, OL = 0, K1T = 71680, VT = 89088, ST = 123904;
};
template <bool WANT_Q, bool WANT_K1, bool WANT_K1T>
__device__ __forceinline__ void ret_stage(const bf16* HP, const float* RT, int b, int h, int n, float lg, LAS unsigned char* lds, int tid) {
    constexpr int QS = RetLds::QS, JS = RetLds::JS;
    LAS bf16* Q1 = (LAS bf16*)(lds + RetLds::Q1); LAS bf16* K1 = (LAS bf16*)(lds + RetLds::K1); LAS bf16* K1T = (LAS bf16*)(lds + RetLds::K1T); LAS bf16* VT = (LAS bf16*)(lds + RetLds::VT);
    const int i = tid >> 2, dd = (tid & 3) * 8, pos = n * 128 + i; const size_t t = (size_t)b * SEQ + pos;
    const bf16* hp = HP + t * HP_LD;
    const f32x4 c0 = *(const f32x4*)(RT + pos * 64 + dd), c1 = *(const f32x4*)(RT + pos * 64 + dd + 4), s0 = *(const f32x4*)(RT + pos * 64 + 32 + dd), s1 = *(const f32x4*)(RT + pos * 64 + 32 + dd + 4);
    const float cs[8] = {c0.x, c0.y, c0.z, c0.w, c1.x, c1.y, c1.z, c1.w}, sn[8] = {s0.x, s0.y, s0.z, s0.w, s1.x, s1.y, s1.z, s1.w};
    const float sq = exp2f((float)i * lg), sk = 0.125f * exp2f(-(float)i * lg);
    v4u xv[4];
#pragma unroll
    for (int p = 0; p < 4; ++p) { const int idx = tid + 512 * p, j = idx >> 4, e0 = (idx & 15) * 8; xv[p] = *(const v4u*)(HP + ((size_t)b * SEQ + n * 128 + j) * HP_LD + COL_RV + h * 128 + e0); }
#pragma unroll
    for (int which = (WANT_Q ? 0 : 1); which < 2; ++which) {
        const bf16* src = hp + (which == 0 ? COL_RQ : COL_RK) + h * 64 + dd;
        const v4u x1 = *(const v4u*)src, x2 = *(const v4u*)(src + 32);
        const float sc = which == 0 ? sq : sk;
        float lo[8], hi[8];
#pragma unroll
        for (int k = 0; k < 4; ++k) { const float a0 = bflo(x1[k]), a1 = bfhi(x1[k]), b0 = bflo(x2[k]), b1 = bfhi(x2[k]);
            lo[2 * k] = (a0 * cs[2 * k] - b0 * sn[2 * k]) * sc; lo[2 * k + 1] = (a1 * cs[2 * k + 1] - b1 * sn[2 * k + 1]) * sc;
            hi[2 * k] = (a0 * sn[2 * k] + b0 * cs[2 * k]) * sc; hi[2 * k + 1] = (a1 * sn[2 * k + 1] + b1 * cs[2 * k + 1]) * sc; }
        v4u wl, wh;
#pragma unroll
        for (int k = 0; k < 4; ++k) { wl[k] = bfc2(lo[2 * k], lo[2 * k + 1]); wh[k] = bfc2(hi[2 * k], hi[2 * k + 1]); }
        if (which == 0 || WANT_K1) { LAS bf16* dst = (which == 0 ? Q1 : K1) + i * QS + dd; *(LAS v4u*)dst = wl; *(LAS v4u*)(dst + 32) = wh; }
        if (which == 1 && WANT_K1T) {
#pragma unroll
            for (int k = 0; k < 4; ++k) { K1T[(dd + 2 * k) * JS + i] = (bf16)(wl[k] & 0xffffu); K1T[(dd + 2 * k + 1) * JS + i] = (bf16)(wl[k] >> 16);
                K1T[(32 + dd + 2 * k) * JS + i] = (bf16)(wh[k] & 0xffffu); K1T[(32 + dd + 2 * k + 1) * JS + i] = (bf16)(wh[k] >> 16); }
        }
    }
#pragma unroll
    for (int p = 0; p < 4; ++p) { const int idx = tid + 512 * p, j = idx >> 4, e0 = (idx & 15) * 8;
#pragma unroll
        for (int k = 0; k < 4; ++k) { VT[(e0 + 2 * k) * JS + j] = (bf16)(xv[p][k] & 0xffffu); VT[(e0 + 2 * k + 1) * JS + j] = (bf16)(xv[p][k] >> 16); } }
}
__device__ __forceinline__ void ret_kv_unit(KArgs a, int unit, LAS unsigned char* lds, int tid, int lane, int wave) {
    unsigned char* ws = a->ws;
    constexpr int JS = RetLds::JS;
    const int n = unit & 15, bh = unit >> 4, h = bh & 3, b = bh >> 2, c = lane & 31, hh = lane >> 5;
    const bf16* HP = (const bf16*)(ws + WS_R + R_HP); const float* RT = (const float*)(ws + WS_ROPE);
    const float gam = 1.0f - exp2f(-5.0f - (float)h), lg = log2f(gam), g127 = exp2f(127.f * lg);
    LAS bf16* K1T = (LAS bf16*)(lds + RetLds::K1T); LAS bf16* VT = (LAS bf16*)(lds + RetLds::VT);
    __syncthreads();
    ret_stage<false, false, true>(HP, RT, b, h, n, lg, lds, tid);
    __syncthreads();
    const int td = wave >> 2, te = wave & 3;
    f32x16 kv;
#pragma unroll
    for (int i = 0; i < 16; ++i) kv[i] = 0.f;
#pragma unroll
    for (int ks = 0; ks < 8; ++ks) kv = MFMA32(*(const LAS bf16x8*)(K1T + (32 * td + c) * JS + 16 * ks + 8 * hh), *(const LAS bf16x8*)(VT + (32 * te + c) * JS + 16 * ks + 8 * hh), kv);
    float* dst = (float*)(ws + WS_KV) + ((size_t)(unit * 8 + wave) * 64 + lane) * 16;
#pragma unroll
    for (int g = 0; g < 4; ++g) *(f32x4*)(dst + 4 * g) = (f32x4){kv[4 * g] * g127, kv[4 * g + 1] * g127, kv[4 * g + 2] * g127, kv[4 * g + 3] * g127};
}
__device__ __forceinline__ void ret_out_unit(KArgs a, int unit, LAS unsigned char* lds, int tid, int lane, int wave) {
    unsigned char* ws = a->ws;
    constexpr int QS = RetLds::QS, JS = RetLds::JS;
    LAS bf16* P = (LAS bf16*)(lds + RetLds::P); LAS bf16* Q1 = (LAS bf16*)(lds + RetLds::Q1); LAS bf16* K1 = (LAS bf16*)(lds + RetLds::K1); LAS float* OL = (LAS float*)(lds + RetLds::OL);
    LAS bf16* VT = (LAS bf16*)(lds + RetLds::VT); LAS bf16* ST = (LAS bf16*)(lds + RetLds::ST);
    const int n = unit & 15, bh = unit >> 4, h = bh & 3, b = bh >> 2, c = lane & 31, hh = lane >> 5;
    const bf16* HP = (const bf16*)(ws + WS_R + R_HP); bf16* OB = (bf16*)(ws + WS_R + R_OB); const float* RT = (const float*)(ws + WS_ROPE);
    const float gam = 1.0f - exp2f(-5.0f - (float)h), lg = log2f(gam), g128 = exp2f(128.f * lg);
    __syncthreads();
    const int ei = tid >> 2, eq = tid & 3; const size_t et = (size_t)b * SEQ + n * 128 + ei;
    v4u gg[4];
    { const bf16* gp = HP + et * HP_LD + COL_RG + h * 128 + 32 * eq;
#pragma unroll
      for (int k = 0; k < 4; ++k) gg[k] = *(const v4u*)(gp + 8 * k); }
    {
        const int td = wave >> 2, te = wave & 3;
        f32x16 S;
#pragma unroll
        for (int i = 0; i < 16; ++i) S[i] = 0.f;
        const float* src = (const float*)(ws + WS_KV) + ((size_t)((bh * 16) * 8 + wave) * 64 + lane) * 16;
#pragma unroll 2
        for (int m = 0; m < n; ++m) { const f32x4* p4 = (const f32x4*)(src + (size_t)m * 8 * 64 * 16);
#pragma unroll
            for (int g = 0; g < 4; ++g) { const f32x4 v = p4[g]; S[4 * g] = S[4 * g] * g128 + v.x; S[4 * g + 1] = S[4 * g + 1] * g128 + v.y; S[4 * g + 2] = S[4 * g + 2] * g128 + v.z; S[4 * g + 3] = S[4 * g + 3] * g128 + v.w; } }
#pragma unroll
        for (int g = 0; g < 4; ++g) { v2u w; w.x = bfc2(S[4 * g], S[4 * g + 1]); w.y = bfc2(S[4 * g + 2], S[4 * g + 3]); *(LAS v2u*)(ST + (32 * te + c) * QS + 32 * td + 8 * g + 4 * hh) = w; }
    }
    ret_stage<true, true, false>(HP, RT, b, h, n, lg, lds, tid);
    __syncthreads();
#pragma unroll 1
    for (int rep = 0; rep < 2; ++rep) { const int idx = wave + 8 * rep;
        if (idx < 10) { const int ti = (idx >= 1) + (idx >= 3) + (idx >= 6), tj = idx - ti * (ti + 1) / 2;
            f32x16 acc;
#pragma unroll
            for (int i = 0; i < 16; ++i) acc[i] = 0.f;
#pragma unroll
            for (int s2 = 0; s2 < 4; ++s2) acc = MFMA32(*(const LAS bf16x8*)(Q1 + (32 * ti + c) * QS + 16 * s2 + 8 * hh), *(const LAS bf16x8*)(K1 + (32 * tj + c) * QS + 16 * s2 + 8 * hh), acc);
#pragma unroll
            for (int i = 0; i < 16; ++i) { const int il = (i & 3) + 8 * (i >> 2) + 4 * hh; float v = acc[i]; if (ti == tj && il < c) v = 0.f; P[(32 * ti + il) * JS + 32 * tj + c] = bfc(v); } } }
    __syncthreads();
    const int ti = wave >> 1, te0 = 2 * (wave & 1);
    f32x16 ao[2];
#pragma unroll
    for (int u = 0; u < 2; ++u)
#pragma unroll
        for (int i = 0; i < 16; ++i) ao[u][i] = 0.f;
#pragma unroll
    for (int s2 = 0; s2 < 4; ++s2) { const bf16x8 A = *(const LAS bf16x8*)(Q1 + (32 * ti + c) * QS + 16 * s2 + 8 * hh);
#pragma unroll
        for (int u = 0; u < 2; ++u) ao[u] = MFMA32(A, *(const LAS bf16x8*)(ST + (32 * (te0 + u) + c) * QS + 16 * s2 + 8 * hh), ao[u]); }
#pragma unroll
    for (int u = 0; u < 2; ++u)
#pragma unroll
        for (int i = 0; i < 16; ++i) ao[u][i] *= gam;
#pragma unroll 1
    for (int tj = 0; tj <= ti; ++tj)
#pragma unroll
        for (int s2 = 0; s2 < 2; ++s2) { const bf16x8 A = *(const LAS bf16x8*)(P + (32 * ti + c) * JS + 32 * tj + 16 * s2 + 8 * hh);
#pragma unroll
            for (int u = 0; u < 2; ++u) ao[u] = MFMA32(A, *(const LAS bf16x8*)(VT + (32 * (te0 + u) + c) * JS + 32 * tj + 16 * s2 + 8 * hh), ao[u]); }
    __syncthreads();
#pragma unroll
    for (int u = 0; u < 2; ++u)
#pragma unroll
        for (int i = 0; i < 16; ++i) OL[(32 * ti + (i & 3) + 8 * (i >> 2) + 4 * hh) * 132 + 32 * (te0 + u) + c] = ao[u][i];
    __syncthreads();
    {
        const LAS float* Ob = OL + ei * 132 + 32 * eq; bf16* op = OB + et * 1024 + h * 128 + 32 * eq;
        f32x4 v[8]; float sm = 0.f;
#pragma unroll
        for (int k = 0; k < 8; ++k) { v[k] = *(const LAS f32x4*)(Ob + 4 * k); sm += (v[k].x + v[k].y) + (v[k].z + v[k].w); }
        sm += __shfl_xor(sm, 1); sm += __shfl_xor(sm, 2);
        const float mean = sm * (1.f / 128.f); float sq = 0.f;
#pragma unroll
        for (int k = 0; k < 8; ++k) { v[k] = v[k] - mean; sq += (v[k].x * v[k].x + v[k].y * v[k].y) + (v[k].z * v[k].z + v[k].w * v[k].w); }
        sq += __shfl_xor(sq, 1); sq += __shfl_xor(sq, 2);
        const float rs = rsqrtf(sq * (1.f / 128.f) + LN_EPS);
#pragma unroll
        for (int k = 0; k < 4; ++k) { const v4u g4 = gg[k]; const f32x4 a0 = v[2 * k], a1 = v[2 * k + 1];
            v4u o; o.x = bfc2(a0.x * rs * siluf(bflo(g4.x)), a0.y * rs * siluf(bfhi(g4.x))); o.y = bfc2(a0.z * rs * siluf(bflo(g4.y)), a0.w * rs * siluf(bfhi(g4.y)));
            o.z = bfc2(a1.x * rs * siluf(bflo(g4.z)), a1.y * rs * siluf(bfhi(g4.z))); o.w = bfc2(a1.z * rs * siluf(bflo(g4.w)), a1.w * rs * siluf(bfhi(g4.w)));
            *(v4u*)(op + 8 * k) = o; }
    }
}

__device__ __forceinline__ void gdn_prep_fast(KArgs a, int l, int unit, LAS unsigned char* lds, int tid, int lane, int wave) {
    unsigned char* ws = a->ws;
    constexpr int KS = 136;
    LAS bf16* Kb = (LAS bf16*)lds;
    LAS bf16* Qb = (LAS bf16*)(lds + 17408);
    LAS float* A = (LAS float*)(lds + 34816);
    LAS float* V = (LAS float*)(lds + 51200);
    LAS float* KW = (LAS float*)(lds + 83968);
    LAS float* gc = (LAS float*)(lds + 116736);
    LAS float* bt = gc + 64;
    LAS bf16* KDs = (LAS bf16*)(lds + 117248);
    const int n = unit & 31, bh = unit >> 5, h = bh & 3, b = bh >> 2, t0 = b * SEQ + n * 64, c = lane & 31, hh = lane >> 5;
    const bf16* HP = (const bf16*)(ws + WS_R + R_HP);
    bf16* QKg = (bf16*)(ws + WS_R + R_QK) + (size_t)unit * 4096; bf16* QDg = (bf16*)(ws + WS_R + R_QD) + (size_t)unit * 8192; bf16* KDTg = (bf16*)(ws + WS_R + R_KDT) + (size_t)unit * 8192;
    bf16* WNg = (bf16*)(ws + WS_R + R_WN) + (size_t)unit * 8192; bf16* Ug = (bf16*)(ws + WS_R + R_U) + (size_t)unit * 8192;
    __syncthreads();
    if (wave == 0) {
        const float* gab = (const float*)(ws + WS_GAB) + (size_t)(t0 + lane) * 8; const float x = gab[h] + a->in[4][l * 4 + h];
        const float sp = fmaxf(x, 0.f) + log1pf(__expf(-fabsf(x))); float g = -__expf(a->in[3][l * 4 + h]) * sp;
#pragma unroll
        for (int o = 1; o < 64; o <<= 1) { const float up = __shfl_up(g, o); if (lane >= o) g += up; }
        gc[lane] = g; bt[lane] = sigmf(gab[4 + h]);
        if (lane == 63) ((float*)(ws + WS_CD))[unit] = __expf(g);
    }
    __syncthreads();
#ifndef PREP_NO_CONV
    if (wave < 6) {
        const int cg = tid % 48, rb = tid / 48, which = cg >> 4, dd = (cg & 15) * 8, col = COL_GQ + which * 512 + h * 128 + dd, cc = which * 512 + h * 128 + dd;
        const float* cw = a->in[2] + (size_t)l * 4 * 1536 + cc;
        float w[4][8];
#pragma unroll
        for (int j = 0; j < 4; ++j) { const f32x4 w0 = *(const f32x4*)(cw + j * 1536), w1 = *(const f32x4*)(cw + j * 1536 + 4); w[j][0] = w0.x; w[j][1] = w0.y; w[j][2] = w0.z; w[j][3] = w0.w; w[j][4] = w1.x; w[j][5] = w1.y; w[j][6] = w1.z; w[j][7] = w1.w; }
        float x0[8], x1[8], x2[8], x3[8];
        const int sbase = n * 64 + 8 * rb - 3;
        const bf16* hpc = HP + (size_t)(b * SEQ) * HP_LD + col;
#define PREP_LDROW(dst, s_) do { v4u raw_ = (v4u){0u, 0u, 0u, 0u}; if ((s_) >= 0) raw_ = *(const v4u*)(hpc + (size_t)(s_) * HP_LD); \
        _Pragma("unroll") for (int k_ = 0; k_ < 4; ++k_) { dst[2 * k_] = bflo(raw_[k_]); dst[2 * k_ + 1] = bfhi(raw_[k_]); } } while (0)
        PREP_LDROW(x0, sbase); PREP_LDROW(x1, sbase + 1); PREP_LDROW(x2, sbase + 2);
        const float gl = gc[63];
#pragma unroll 4
        for (int r = 0; r < 8; ++r) { const int i = 8 * rb + r; float y[8]; float ss = 0.f;
            PREP_LDROW(x3, sbase + 3 + r);
#pragma unroll
            for (int k = 0; k < 8; ++k) { const float acc = w[0][k] * x0[k] + w[1][k] * x1[k] + w[2][k] * x2[k] + w[3][k] * x3[k]; y[k] = siluf(acc); ss += y[k] * y[k]; x0[k] = x1[k]; x1[k] = x2[k]; x2[k] = x3[k]; }
            ss += __shfl_xor(ss, 1); ss += __shfl_xor(ss, 2); ss += __shfl_xor(ss, 4); ss += __shfl_xor(ss, 8);
            const float gi = gc[i], bi = bt[i];
            if (which == 0) { const float f = rsqrtf(ss + NORM_EPS) * 0.08838834764831845f, eg = __expf(gi);
                v4u p, pd;
#pragma unroll
                for (int k = 0; k < 4; ++k) { p[k] = bfc2(y[2 * k] * f, y[2 * k + 1] * f); pd[k] = bfc2(y[2 * k] * f * eg, y[2 * k + 1] * f * eg); }
                *(LAS v4u*)(Qb + i * KS + dd) = p;
                bf16* qd = QDg + (((i >> 5) * 4 + (dd >> 5)) * 2 + ((dd >> 4) & 1)) * 512 + (i & 31) * 8 + ((dd >> 3) & 1) * 4;
                *(v2u*)qd = (v2u){pd[0], pd[1]}; *(v2u*)(qd + 256) = (v2u){pd[2], pd[3]};
            } else if (which == 1) { const float f = rsqrtf(ss + NORM_EPS), fw = f * bi * __expf(gi), fd = f * __expf(gl - gi);
                v4u p;
#pragma unroll
                for (int k = 0; k < 4; ++k) p[k] = bfc2(y[2 * k] * f, y[2 * k + 1] * f);
                *(LAS v4u*)(Kb + i * KS + dd) = p;
#pragma unroll
                for (int k = 0; k < 8; ++k) { KW[i * 128 + dd + k] = y[k] * fw; KDs[(dd + k) * 72 + i] = bfc(y[k] * fd); }
            } else {
#pragma unroll
                for (int k = 0; k < 8; ++k) V[i * 128 + dd + k] = y[k] * bi;
            }
        }
#undef PREP_LDROW
    }
#endif
    __syncthreads();
    {
        const int ti = (wave >> 1) & 1, tj = wave & 1;
        if (wave < 4) {
            if (tj <= ti) {
                f32x16 acc;
#pragma unroll
                for (int i = 0; i < 16; ++i) acc[i] = 0.f;
#pragma unroll
                for (int s = 0; s < 8; ++s) acc = MFMA32(*(const LAS bf16x8*)(Kb + (32 * ti + c) * KS + 16 * s + 8 * hh), *(const LAS bf16x8*)(Kb + (32 * tj + c) * KS + 16 * s + 8 * hh), acc);
                const int j = 32 * tj + c; const float gj = gc[j];
#pragma unroll
                for (int r = 0; r < 16; ++r) { const int i = 32 * ti + (r & 3) + 8 * (r >> 2) + 4 * hh; A[i * 64 + j] = (j < i) ? bt[i] * acc[r] * __expf(gc[i] - gj) : 0.f; }
            } else {
#pragma unroll
                for (int r = 0; r < 16; ++r) { const int i = 32 * ti + (r & 3) + 8 * (r >> 2) + 4 * hh; A[i * 64 + 32 * tj + c] = 0.f; }
            }
        } else {
            const int kt = ti, qt = tj;
            if (kt <= qt) {
                f32x16 acc;
#pragma unroll
                for (int i = 0; i < 16; ++i) acc[i] = 0.f;
#pragma unroll
                for (int s = 0; s < 8; ++s) acc = MFMA32(*(const LAS bf16x8*)(Kb + (32 * kt + c) * KS + 16 * s + 8 * hh), *(const LAS bf16x8*)(Qb + (32 * qt + c) * KS + 16 * s + 8 * hh), acc);
                const int i = 32 * qt + c; const float gi = gc[i];
#pragma unroll
                for (int r = 0; r < 16; ++r) { const int j = 32 * kt + (r & 3) + 8 * (r >> 2) + 4 * hh; acc[r] = (j <= i) ? acc[r] * __expf(gi - gc[j]) : 0.f; }
                bf16x8* qf = (bf16x8*)QKg + lane;
                qf[((qt * 2 + kt) * 2 + 0) * 64] = pack8(acc, 0); qf[((qt * 2 + kt) * 2 + 1) * 64] = pack8(acc, 1);
            }
        }
    }
    __syncthreads();
#ifndef PREP_NO_SOLVE
    if (wave < 4) {
        const int col = tid & 127; LAS float* rhs = (tid < 128 ? V : KW) + col;
        float x[64];
#pragma unroll
        for (int i = 0; i < 64; ++i) {
            float s0 = rhs[i * 128], s1 = 0.f, s2 = 0.f, s3 = 0.f;
#pragma unroll
            for (int m4 = 0; m4 < (i + 3) / 4; ++m4) { const f32x4 a4 = *(const LAS f32x4*)(A + i * 64 + 4 * m4);
                if (4 * m4 < i) s0 -= a4.x * x[4 * m4];
                if (4 * m4 + 1 < i) s1 -= a4.y * x[4 * m4 + 1];
                if (4 * m4 + 2 < i) s2 -= a4.z * x[4 * m4 + 2];
                if (4 * m4 + 3 < i) s3 -= a4.w * x[4 * m4 + 3]; }
            x[i] = (s0 + s1) + (s2 + s3);
        }
        if (tid < 128) {
#pragma unroll
            for (int m = 0; m < 2; ++m)
#pragma unroll
                for (int hx = 0; hx < 2; ++hx)
#pragma unroll
                    for (int hf = 0; hf < 2; ++hf) { const int i0 = 32 * m + 16 * hf + 4 * hx;
                        v4u w; w.x = bfc2(x[i0], x[i0 + 1]); w.y = bfc2(x[i0 + 2], x[i0 + 3]); w.z = bfc2(x[i0 + 8], x[i0 + 9]); w.w = bfc2(x[i0 + 10], x[i0 + 11]);
                        *(v4u*)(Ug + uoff(i0, col)) = w; }
        } else {
#pragma unroll
            for (int i = 0; i < 64; ++i) Qb[i * KS + col] = bfc(-x[i]);
        }
    }
#endif
    __syncthreads();
#pragma unroll
    for (int p = 0; p < 4; ++p) { const int idx = tid + 512 * p, i = idx >> 5, d = (idx & 31) * 4;
        *(v2u*)(WNg + fragoff(i, d, 4)) = *(const LAS v2u*)(Qb + i * KS + d); }
#pragma unroll
    for (int p = 0; p < 4; ++p) { const int idx = tid + 512 * p, d = idx >> 4, i = (idx & 15) * 4;
        *(v2u*)(KDTg + fragoff(d, i, 2)) = *(const LAS v2u*)(KDs + d * 72 + i); }
}
#define XB_TMO      128
#define XB_XCNT(j)  (256  + 64 * (j))
#define XB_XSUB(j)  (1280 + 64 * (j))
#define XB_XGEN(j)  (2304 + 64 * (j))
#define XB_TOP      3328
#define XB_TOPGEN   3392
#define XCD_BAR_WORDS 3456
#define XB_SPIN_CAP (1u << 18)

__device__ __forceinline__ unsigned xb_ld(unsigned* p)              { return __hip_atomic_load(p, __ATOMIC_RELAXED, __HIP_MEMORY_SCOPE_AGENT); }
__device__ __forceinline__ unsigned xb_add(unsigned* p, unsigned v) { return __hip_atomic_fetch_add(p, v, __ATOMIC_RELAXED, __HIP_MEMORY_SCOPE_AGENT); }
__device__ __forceinline__ unsigned xb_xcc_id() { return (unsigned)__builtin_amdgcn_s_getreg((3 << 11) | 20) & 0xFu; }
#define XB_SPIN(cond, bar) do { unsigned _sp = 0; while (cond) { __builtin_amdgcn_s_sleep(1); \
    if ((++_sp & 255u) == 0u) { if (xb_ld(&(bar)[XB_TMO])) break; if (_sp > XB_SPIN_CAP) { atomicAdd(&(bar)[XB_TMO], 1u); break; } } } } while (0)

struct XcdBarrier {
    unsigned* bar; unsigned x;
    volatile LAS unsigned* st;
};

__device__ __forceinline__ XcdBarrier xcd_barrier_post(unsigned* bar, volatile LAS unsigned* st) {
    XcdBarrier b; b.bar = bar; b.x = xb_xcc_id(); b.st = st;
    if (threadIdx.x == 0) (void)xb_add(&bar[XB_XCNT(b.x)], 1u);
    return b;
}
__device__ __forceinline__ void xcd_barrier_complete(unsigned* bar, unsigned x, unsigned& nloc, unsigned& nx) {
    const unsigned G = gridDim.x * gridDim.y * gridDim.z;
    unsigned sum, cnt, mine, sp = 0u;
    for (;;) {
        sum = 0u; cnt = 0u; mine = 0u;
#pragma unroll
        for (unsigned j = 0; j < 16; ++j) { const unsigned c = xb_ld(&bar[XB_XCNT(j)]); sum += c; cnt += (c > 0u) ? 1u : 0u; mine = (j == x) ? c : mine; }
        if (sum == G) break;
        __builtin_amdgcn_s_sleep(1);
        if ((++sp & 255u) == 0u) { if (xb_ld(&bar[XB_TMO])) break; if (sp > XB_SPIN_CAP) { atomicAdd(&bar[XB_TMO], 1u); break; } }
    }
    nloc = mine > 0u ? mine : 1u; nx = cnt > 0u ? cnt : 1u;
}

__device__ __forceinline__ void xcd_barrier(const XcdBarrier& b) {
    asm volatile("s_waitcnt vmcnt(0)" ::: "memory");
    __syncthreads();
    if (threadIdx.x == 0) {
        unsigned* bar = b.bar;
        __builtin_amdgcn_s_waitcnt(0);
        unsigned nloc = b.st[0], nx = b.st[1];
        if (nloc == 0u) { xcd_barrier_complete(bar, b.x, nloc, nx); b.st[0] = nloc; b.st[1] = nx; }
        const unsigned old = xb_add(&bar[XB_XSUB(b.x)], 1u);
        const unsigned gen = old / nloc;
        if (old + 1u == (gen + 1u) * nloc) {
            __builtin_amdgcn_fence(__ATOMIC_RELEASE, "agent");
            asm volatile("s_waitcnt vmcnt(0)" ::: "memory");
            const unsigned og = xb_add(&bar[XB_TOP], 1u);
            const unsigned tg = og / nx;
            if (og + 1u == (tg + 1u) * nx) xb_add(&bar[XB_TOPGEN], 1u);
            else XB_SPIN(xb_ld(&bar[XB_TOPGEN]) == tg, bar);
            __builtin_amdgcn_fence(__ATOMIC_ACQUIRE, "agent");
            xb_add(&bar[XB_XGEN(b.x)], 1u);
            asm volatile("s_waitcnt vmcnt(0)" ::: "memory");
        } else {
            XB_SPIN(xb_ld(&bar[XB_XGEN(b.x)]) == gen, bar);
            __builtin_amdgcn_fence(__ATOMIC_ACQUIRE, "agent");
            asm volatile("s_waitcnt vmcnt(0)" ::: "memory");
        }
    }
    __syncthreads();
}
#ifndef REP_PRO
#define REP_PRO 1
#endif
#ifndef REP_IN
#define REP_IN 1
#endif
#ifndef REP_PREP
#define REP_PREP 1
#endif
#ifndef REP_SCAN
#define REP_SCAN 1
#endif
#ifndef REP_OUT
#define REP_OUT 1
#endif
#ifndef REP_GU
#define REP_GU 1
#endif
#ifndef REP_DN
#define REP_DN 1
#endif
#ifndef REP_MGU
#define REP_MGU 1
#endif
#ifndef REP_GDN
#define REP_GDN 1
#endif
#ifndef REP_RET
#define REP_RET 1
#endif
#ifndef FAST_SCAN
#define FAST_SCAN 1
#endif
#ifndef FAST_RET
#define FAST_RET 1
#endif
#ifndef FAST_PREP
#define FAST_PREP 1
#endif
#ifndef EN_PRO
#define EN_PRO 1
#endif
#ifndef EN_IN
#define EN_IN 1
#endif
#ifndef EN_PREP
#define EN_PREP 1
#endif
#ifndef EN_SCAN
#define EN_SCAN 1
#endif
#ifndef EN_OUT
#define EN_OUT 1
#endif
#ifndef EN_LN1
#define EN_LN1 1
#endif
#ifndef EN_FFN0
#define EN_FFN0 1
#endif
#ifndef EN_MOE
#define EN_MOE 1
#endif

__global__ void __launch_bounds__(NWAVES * 64, 2) fwd(Args a_unused) {
    extern __shared__ __attribute__((aligned(16))) unsigned char lds_raw[];
    LAS unsigned char* lds = (LAS unsigned char*)lds_raw;
    { const int tid0 = threadIdx.x; for (int u = tid0; u < (LDS_BYTES - LDSCTL_OFF) / 4; u += NWAVES * 64) ((LAS unsigned*)(lds + LDSCTL_OFF))[u] = 0u; }
    __syncthreads();
#if ONE_LAUNCH
    XcdBarrier bar = xcd_barrier_post((unsigned*)(kargs()->ws + WS_CTL) + CW_BAR, (volatile LAS unsigned*)(lds + MISC_OFF) + 8);
#define SEAM() xcd_barrier(bar)
#else
#define SEAM() do {} while (0)
#endif
#define IN(k) (kargs()->ph_lo <= (k) && (k) < kargs()->ph_hi)
#define BOTH(k) (IN(k) && ((k) + 1) < kargs()->ph_hi)
#define PH_LOCALS KArgs a = kargs(); unsigned char* ws = a->ws; int G = gridDim.x, bid = blockIdx.x; asm volatile("" : "+s"(G), "+s"(bid)); const int tid = tidx(), lane = tid & 63, wave = __builtin_amdgcn_readfirstlane(tid >> 6), gw = bid * NWAVES + wave, NGW = G * NWAVES; (void)ws; (void)lane; (void)gw; (void)NGW;

    if (EN_PRO && IN(PH_PRO)) { _Pragma("unroll 1") for (int rep_ = 0; rep_ < REP_PRO; ++rep_) { if (rep_) SEAM(); PH_LOCALS; ph_prologue(a, lds, wave, lane, gw, NGW, bid * (NWAVES * 64) + tid, G * NWAVES * 64, 0, PRO_I_IN, true); } if (BOTH(PH_PRO)) SEAM(); }

#pragma unroll 1
    for (int l = 0; l < 2; ++l) {
        if (EN_IN && IN(PH_L(l, K_IN))) {
            _Pragma("unroll 1") for (int rep_ = 0; rep_ < REP_IN; ++rep_) { if (rep_) SEAM(); PH_LOCALS;
            pg8::Gemm g{(const pg8::bf16_t*)(ws + WS_XB), (const pg8::bf16_t*)(ws + WS_WIN) + (size_t)l * NIN_PAD * 1024, M, NIN_PAD, 1024}; pg8::StaticOrder S; S.init(M, NIN_PAD, G, bid);
            pg8::EpiHproj E{(pg8::bf16_t*)(ws + WS_R + R_HP), (float*)(ws + WS_GAB)};
            pg8::gemm_phase<pg8::EpiHproj, pg8::StaticOrder, PG8_ALIGN, PG8_SP2>(lds, g, S, E); }
            if (BOTH(PH_L(l, K_IN))) SEAM();
        }
        if (EN_PREP && IN(PH_L(l, K_PREP))) {
            _Pragma("unroll 1") for (int rep_ = 0; rep_ < REP_PREP; ++rep_) { if (rep_) SEAM(); PH_LOCALS; for (int u = bid; u < 1024; u += G) { if (FAST_PREP) gdn_prep_fast(a, l, u, lds, tid, lane, wave); else gdn_prep_unit(a, l, u, lds, tid, lane, wave); }
              if (FAST_RET) for (int u = bid; u < 512; u += G) ret_kv_unit(a, u, lds, tid, lane, wave); }
            if (BOTH(PH_L(l, K_PREP))) SEAM();
        }
        if (EN_SCAN && IN(PH_L(l, K_SCAN))) {
            _Pragma("unroll 1") for (int rep_ = 0; rep_ < REP_SCAN; ++rep_) { if (rep_) SEAM(); PH_LOCALS;
            if (bid < 32) { const int t1 = tidx(), w1 = __builtin_amdgcn_readfirstlane(t1 >> 6); for (int rg_ = 0; rg_ < REP_GDN; ++rg_) gdn_scan_fast(a, l, bid, lds, t1, t1 & 63, w1); }
            else {
                { const int t1 = tidx(), w1 = __builtin_amdgcn_readfirstlane(t1 >> 6);
                  for (int rr_ = 0; rr_ < REP_RET; ++rr_) for (int u = bid - 32; u < 512; u += G - 32) ret_out_unit(a, u, lds, t1, t1 & 63, w1); }
                __syncthreads();
                { const int t2 = tidx(), w2 = __builtin_amdgcn_readfirstlane(t2 >> 6);
                  moe_convert(kargs(), lds, w2, t2 & 63, (bid - 32) * NWAVES + w2, (G - 32) * NWAVES, 4 * l, 4 * l + 4);
                  if (l == 0) ph_prologue(kargs(), lds, w2, t2 & 63, (bid - 32) * NWAVES + w2, (G - 32) * NWAVES, 0, 0, PRO_I_IN, PRO_NIT, false); }
            } }
            if (BOTH(PH_L(l, K_SCAN))) SEAM();
        }
        if (EN_OUT && IN(PH_L(l, K_OUT))) {
            _Pragma("unroll 1") for (int rep_ = 0; rep_ < REP_OUT; ++rep_) { if (rep_) SEAM(); PH_LOCALS;
            pg8::Gemm g{(const pg8::bf16_t*)(ws + WS_R + R_OB), (const pg8::bf16_t*)(ws + WS_WO) + (size_t)l * 1024 * 1024, M, 1024, 1024}; pg8::StaticOrder S; S.init(M, 1024, G, bid);
            pg8::EpiBf16Out E{(pg8::bf16_t*)(ws + WS_R + R_MIX), 1024};
            pg8::gemm_phase<pg8::EpiBf16Out, pg8::StaticOrder, PG8_ALIGN, PG8_SP2>(lds, g, S, E); }
            if (BOTH(PH_L(l, K_OUT))) SEAM();
        }
        if (EN_LN1 && IN(PH_L(l, K_LN1))) {
            { PH_LOCALS;
            if (l == 0) ln_rows<false>(a->in[0], ALPHA, (const bf16*)(ws + WS_R + R_MIX), a->in[7], a->in[8], a->out, 1.0f, (bf16*)(ws + WS_XB), nullptr, nullptr, nullptr, nullptr, lane, gw, NGW);
            else { ln_rows<true>(a->out, ALPHA, (const bf16*)(ws + WS_R + R_MIX), a->in[7] + 1024, a->in[8] + 1024, a->out, ALPHA, (bf16*)(ws + WS_XB), (const float*)(ws + WS_RWT), (unsigned*)(ws + WS_CTL) + CW_MOE, (int*)(ws + WS_LIST), (float*)(ws + WS_GATE), lane, gw, NGW);
                 } }
            if (BOTH(PH_L(l, K_LN1))) SEAM();
        }
        if (l == 0) {
            if (EN_FFN0 && IN(PH_L(0, K_GU))) {
                _Pragma("unroll 1") for (int rep_ = 0; rep_ < REP_GU; ++rep_) { if (rep_) SEAM(); PH_LOCALS;
                pg8::Gemm g{(const pg8::bf16_t*)(ws + WS_XB), (const pg8::bf16_t*)(ws + WS_WGU), M, 2 * FF, 1024}; pg8::StaticOrder S; S.init(M, 2 * FF, G, bid);
                pg8::EpiSwiglu E{(pg8::bf16_t*)(ws + WS_R + R_H), FF};
                pg8::gemm_phase<pg8::EpiSwiglu, pg8::StaticOrder, PG8_ALIGN, PG8_SP2>(lds, g, S, E); }
                if (BOTH(PH_L(0, K_GU))) SEAM();
            }
            if (EN_FFN0 && IN(PH_L(0, K_DN))) {
                _Pragma("unroll 1") for (int rep_ = 0; rep_ < REP_DN; ++rep_) { if (rep_) SEAM(); PH_LOCALS;
                pg8::Gemm g{(const pg8::bf16_t*)(ws + WS_R + R_H), (const pg8::bf16_t*)(ws + WS_WD), M, 1024, FF}; pg8::StaticOrder S; S.init(M, 1024, G, bid);
                pg8::EpiBf16Out E{(pg8::bf16_t*)(ws + WS_R + R_MIX), 1024};
                pg8::gemm_phase<pg8::EpiBf16Out, pg8::StaticOrder, PG8_ALIGN, PG8_SP2>(lds, g, S, E); }
                if (BOTH(PH_L(0, K_DN))) SEAM();
            }
            if (EN_LN1 && IN(PH_L(0, K_LN2))) {
                { PH_LOCALS;
                ln_rows<false>(a->out, ALPHA, (const bf16*)(ws + WS_R + R_MIX), a->in[9], a->in[10], a->out, 1.0f, (bf16*)(ws + WS_XB), nullptr, nullptr, nullptr, nullptr, lane, gw, NGW); }
                if (BOTH(PH_L(0, K_LN2))) SEAM();
            }
        } else {
#pragma unroll 1
            for (int j = 0; j < 2; ++j) {
                const int kg = K_G0 + 3 * j;
                if (EN_MOE && j == 0 && IN(PH_L(1, kg))) { { PH_LOCALS; moe_gather(a, 0, lane, gw, NGW); moe_gather(a, 1, lane, gw, NGW); } if (BOTH(PH_L(1, kg))) SEAM(); }
                if (EN_MOE && IN(PH_L(1, kg + 1))) {
                    _Pragma("unroll 1") for (int rep_ = 0; rep_ < REP_MGU; ++rep_) { if (rep_) SEAM(); PH_LOCALS;
                    int cnt[8];
#pragma unroll
                    for (int e = 0; e < 8; ++e) cnt[e] = (int)((const unsigned*)(ws + WS_CTL))[CW_MOE + 64 * (j * 8 + e)];
                    pg8::Gemm g{(const pg8::bf16_t*)(ws + WS_R + R_XG + (size_t)j * XG_PASS), (const pg8::bf16_t*)(ws + WS_WMGU), MOE_ROWS, 2 * FE, 1024}; pg8::MoeOrder S; S.init(cnt, 2 * FE / 256, G, bid, (size_t)2 * FE * 1024 * 2);
                    pg8::EpiSwiglu E{(pg8::bf16_t*)(ws + WS_R + R_HM), FE};
                    pg8::gemm_phase<pg8::EpiSwiglu, pg8::MoeOrder, PG8_ALIGN, PG8_SP2>(lds, g, S, E); }
                    if (BOTH(PH_L(1, kg + 1))) SEAM();
                }
                if (EN_MOE && IN(PH_L(1, kg + 2))) {
                    { PH_LOCALS;
                    int cnt[8];
#pragma unroll
                    for (int e = 0; e < 8; ++e) cnt[e] = (int)((const unsigned*)(ws + WS_CTL))[CW_MOE + 64 * (j * 8 + e)];
                    pg8::Gemm g{(const pg8::bf16_t*)(ws + WS_R + R_HM), (const pg8::bf16_t*)(ws + WS_WMD), MOE_ROWS, 1024, FE}; pg8::MoeOrder S; S.init(cnt, 4, G, bid, (size_t)1024 * FE * 2);
                    pg8::EpiMoeDown E; E.XF = a->out; E.list = (const int*)(ws + WS_LIST) + (size_t)j * 8 * 16384; E.gate = (const float*)(ws + WS_GATE) + (size_t)j * 16384;
#pragma unroll
                    for (int e = 0; e < 8; ++e) { E.cnt[e] = cnt[e]; E.cum[e] = S.cum[e]; }
                    pg8::gemm_phase<pg8::EpiMoeDown, pg8::MoeOrder, PG8_ALIGN, PG8_SP2>(lds, g, S, E); }
                    if (BOTH(PH_L(1, kg + 2))) SEAM();
                }
            }
            if (EN_LN1 && IN(PH_L(1, K_LNF))) {
                PH_LOCALS;
                ln_rows<false>(a->out, 1.0f, nullptr, a->in[9] + 1024, a->in[10] + 1024, a->out, 1.0f, nullptr, nullptr, nullptr, nullptr, nullptr, lane, gw, NGW);
            }
        }
    }
#undef IN
#undef BOTH
}

extern "C" void kernel_launch(void* const* d_in, const int* in_sizes, int n_in, void* d_out, int out_size, void* d_ws, size_t ws_size, hipStream_t stream) {
    static int grid = 0;
    if (grid == 0) {
        if (n_in != 18 || in_sizes[0] != M * D || out_size != M * D || ws_size < WS_END) { fprintf(stderr, "kernel_launch: unexpected shapes or workspace (%zu < %zu); nothing launched\n", ws_size, (size_t)WS_END); grid = -1; return; }
        int dev = 0, cus = 0, per_cu = 0;
        if (hipGetDevice(&dev) != hipSuccess || hipDeviceGetAttribute(&cus, hipDeviceAttributeMultiprocessorCount, dev) != hipSuccess) { grid = -1; return; }
        if (hipFuncSetAttribute((const void*)fwd, hipFuncAttributeMaxDynamicSharedMemorySize, LDS_BYTES) != hipSuccess) { fprintf(stderr, "kernel_launch: hipFuncSetAttribute failed\n"); grid = -1; return; }
        if (hipOccupancyMaxActiveBlocksPerMultiprocessor(&per_cu, (const void*)fwd, NWAVES * 64, LDS_BYTES) != hipSuccess || per_cu < 1) fprintf(stderr, "kernel_launch: occupancy query reports %d\n", per_cu);
        (void)hipGetLastError();
        grid = cus;
    }
    if (grid < 0) return;
    if (hipMemsetAsync((char*)d_ws + WS_CTL, 0, CTL_BYTES, stream) != hipSuccess) return;
    Args a{};
    for (int i = 0; i < 18; ++i) a.in[i] = (const float*)d_in[i];
    a.out = (float*)d_out; a.ws = (unsigned char*)d_ws;
#if ONE_LAUNCH
    a.ph_lo = 0; a.ph_hi = PH_END;
    hipLaunchKernelGGL(fwd, dim3(grid), dim3(NWAVES * 64), LDS_BYTES, stream, a);
#else
    static const int phases[] = {PH_PRO,
        PH_L(0, K_IN), PH_L(0, K_PREP), PH_L(0, K_SCAN), PH_L(0, K_OUT), PH_L(0, K_LN1), PH_L(0, K_GU), PH_L(0, K_DN), PH_L(0, K_LN2),
        PH_L(1, K_IN), PH_L(1, K_PREP), PH_L(1, K_SCAN), PH_L(1, K_OUT), PH_L(1, K_LN1),
        PH_L(1, K_G0), PH_L(1, K_GU0), PH_L(1, K_DN0), PH_L(1, K_G1), PH_L(1, K_GU1), PH_L(1, K_DN1), PH_L(1, K_LNF)};
    for (unsigned i = 0; i < sizeof(phases) / sizeof(phases[0]); ++i) {
        a.ph_lo = phases[i]; a.ph_hi = phases[i] + 1;
        hipLaunchKernelGGL(fwd, dim3(grid), dim3(NWAVES * 64), LDS_BYTES, stream, a);
    }
#endif
}
```

```cpp
#include <hip/hip_runtime.h>
#include <cstdio>
#include <cstdint>

#ifndef ONE_LAUNCH
#define ONE_LAUNCH 1
#endif

#define GAS __attribute__((address_space(1)))
#define LAS __attribute__((address_space(3)))
typedef unsigned short bf16;
typedef unsigned v4u __attribute__((ext_vector_type(4)));
typedef unsigned v2u __attribute__((ext_vector_type(2)));
typedef float f32x4 __attribute__((ext_vector_type(4)));
typedef float f32x2 __attribute__((ext_vector_type(2)));
#define RLX_AGENT __ATOMIC_RELAXED, __HIP_MEMORY_SCOPE_AGENT
#define LDS_WAIT() asm volatile("s_waitcnt lgkmcnt(0)" ::: "memory")
#define VM_WAIT() asm volatile("s_waitcnt vmcnt(0)" ::: "memory")

__device__ __forceinline__ unsigned f2bf(float f) { unsigned u = __builtin_bit_cast(unsigned, f); return (u + 0x7fffu + ((u >> 16) & 1u)) >> 16; }
__device__ __forceinline__ unsigned pk2(float lo, float hi) { return f2bf(lo) | (f2bf(hi) << 16); }
__device__ __forceinline__ float bf2f(unsigned short u) { return __builtin_bit_cast(float, (unsigned)u << 16); }
__device__ __forceinline__ float bflo(unsigned u) { return __builtin_bit_cast(float, u << 16); }
__device__ __forceinline__ float bfhi(unsigned u) { return __builtin_bit_cast(float, u & 0xffff0000u); }
__device__ __forceinline__ float siluf(float x) { return x * __builtin_amdgcn_rcpf(1.f + __expf(-x)); }
__device__ __forceinline__ float sigmf(float x) { return 1.f / (1.f + __expf(-x)); }
__device__ __forceinline__ float wave_sum(float v) {
    v += __builtin_bit_cast(float, __builtin_amdgcn_update_dpp(0, __builtin_bit_cast(int, v), 0xB1, 0xF, 0xF, true));
    v += __builtin_bit_cast(float, __builtin_amdgcn_update_dpp(0, __builtin_bit_cast(int, v), 0x4E, 0xF, 0xF, true));
    v += __builtin_bit_cast(float, __builtin_amdgcn_update_dpp(0, __builtin_bit_cast(int, v), 0x141, 0xF, 0xF, true));
    v += __builtin_bit_cast(float, __builtin_amdgcn_update_dpp(0, __builtin_bit_cast(int, v), 0x140, 0xF, 0xF, true));
    v += __builtin_bit_cast(float, __builtin_amdgcn_update_dpp(0, __builtin_bit_cast(int, v), 0x142, 0xA, 0xF, false));
    v += __builtin_bit_cast(float, __builtin_amdgcn_update_dpp(0, __builtin_bit_cast(int, v), 0x143, 0xC, 0xF, false));
    return __builtin_bit_cast(float, __builtin_amdgcn_readlane(__builtin_bit_cast(int, v), 63));
}

constexpr int NWAVES = 8;
constexpr int M = 16384, D = 1024, SEQ = 2048, NB = 8;
constexpr int IN_COLS = 3592, NIN_PAD = 3840, HP_LD = 3584;
constexpr int FF = 2816, FE = 3584, NE = 8;
constexpr int COL_RQ = 0, COL_RK = 256, COL_RV = 512, COL_RG = 1024, COL_GQ = 1536, COL_GK = 2048, COL_GV = 2560, COL_GG = 3072;
constexpr float ALPHA = 1.41421356237f;
constexpr float LN_EPS = 1e-5f, NORM_EPS = 1e-6f;
constexpr int MOE_ROWS = 72 * 256;

__host__ __device__ __forceinline__ int fragoff(int i, int d, int nkt) {
    return ((((i >> 5) * nkt + (d >> 5)) * 2 + ((d >> 4) & 1)) * 512) + ((((d >> 2) & 1) * 32 + (i & 31)) * 8) + ((((d >> 3) & 1) << 2) | (d & 3));
}
__host__ __device__ __forceinline__ int uoff(int i, int e) {
    const int reg = (i & 3) | (((i & 31) >> 3) << 2);
    return (((((e >> 5) * 2 + (i >> 5)) * 2 + (reg >> 3)) * 64 + (((i >> 2) & 1) * 32 + (e & 31))) * 8) + (reg & 7);
}
namespace pg8 {
#define PG8_LAS __attribute__((address_space(3)))
typedef unsigned short bf16_t;
typedef short bf16x8 __attribute__((ext_vector_type(8)));
typedef float f32x4 __attribute__((ext_vector_type(4)));
typedef unsigned u32x4 __attribute__((ext_vector_type(4)));
constexpr int BM = 256, BK = 64, HALF = 128, HTB = HALF * BK * 2  , STAGE_BYTES = 8 * HTB, NXCD = 8, WGM = 8;

__host__ __device__ __forceinline__ int lds_byte(int r, int c) { const int st = (r >> 4) * 2 + (c >> 5), rr = r & 15, cc = c & 31, ob = rr * 64 + cc * 2; return st * 1024 + (ob ^ (((ob >> 9) & 1) << 5)); }
__host__ __device__ __forceinline__ void stage_rc(int b, int& R, int& C) { const int st = b / 1024, sb = b % 1024, swz = sb ^ (((sb >> 9) & 1) << 5); R = (st >> 1) * 16 + swz / 64; C = (st & 1) * 32 + (swz % 64) / 2; }
__host__ __device__ __forceinline__ int perm32(int rho) { const int n = rho >> 4, i = rho & 15; return 8 * (i >> 2) + 4 * n + (i & 3); }

struct Unit { int pm, pn, aux, am, sel; };
struct Gemm { const bf16_t* A; const bf16_t* Bt; int M, N, K, blk; };

struct StaticOrder {
    int nM, nN, nwg, G, c;
    __host__ __device__ void init(int M, int N, int G_, int c_) { nM = M / BM; nN = N / BM; nwg = nM * nN; G = G_; c = c_; }
    __host__ __device__ bool next(int i, Unit& u) const {
        const long L = (long)i * G + c; if (L >= nwg) return false;
        int wgid = (int)L; { const int q = nwg / NXCD, r = nwg % NXCD, xcd = wgid % NXCD, off = wgid / NXCD; wgid = (xcd < r ? xcd * (q + 1) : r * (q + 1) + (xcd - r) * q) + off; }
        const int nig = WGM * nN, gid = wgid / nig, fm = gid * WGM, gsz = (nM - fm) < WGM ? (nM - fm) : WGM;
        u.pm = fm + ((wgid % nig) % gsz); u.pn = (wgid % nig) / gsz; u.aux = 0; u.am = u.pm; u.sel = 0; return true;
    }
    __device__ __forceinline__ const char* aptr(const Gemm& g, const Unit& u) const { return (const char*)g.A + (size_t)u.pm * ((size_t)BM * g.K * 2); }
    __device__ __forceinline__ const char* bptr(const Gemm& g, const Unit& u) const { return (const char*)g.Bt + (size_t)u.pn * ((size_t)BM * g.K * 2); }
    __device__ __forceinline__ void a_ready(const Unit&) const {}
    __device__ __forceinline__ void done(const Unit&) const {}
};

template <class Epi, class Sched, bool ALIGN_EPI = false, bool SP2 = false>
__device__ __forceinline__ void gemm_phase(PG8_LAS unsigned char* lds, const Gemm g, const Sched& S, const Epi& E) {
    int tid = threadIdx.x; asm volatile("" : "+v"(tid)); const int wid = __builtin_amdgcn_readfirstlane(tid >> 6), lane = tid & 63, wr = wid >> 2, wc = wid & 3, fr = lane & 15, fq = lane >> 4;
    const int K = g.K, nt = K / BK;
    unsigned voffA[2], voffB[2];
#pragma unroll
    for (int i = 0; i < 2; ++i) { int R, C; stage_rc(tid * 16 + i * 8192, R, C); const int Rb = Epi::PERM ? ((R & ~31) + perm32(R & 31)) : R;
        voffA[i] = (unsigned)(R * (g.blk ? 64 : K) + C) * 2u; voffB[i] = (unsigned)(Rb * (g.blk ? 64 : K) + C) * 2u; }
    const size_t kstep = g.blk ? (size_t)(256 * 64 * 2) : (size_t)(BK * 2);
    const size_t hstep = g.blk ? (size_t)(HALF * 64 * 2) : (size_t)HALF * K * 2;
    const size_t tstep = 2 * hstep;
    const unsigned ldsw = (unsigned)wid * 1024u;
    const int aoff = lds_byte(wr * 64 + fr, fq * 8), boff = lds_byte(wc * 32 + fr, fq * 8);
#define PG8_SA(b, h) (((b) * 2 + (h)) * HTB)
#define PG8_SB(b, h) ((4 + (b) * 2 + (h)) * HTB)
#define PG8_STAGE(bufoff, gbase, voff) do { _Pragma("unroll") for (int _i = 0; _i < 2; ++_i) \
        __builtin_amdgcn_global_load_lds((const unsigned*)((const char*)(gbase) + (voff)[_i]), (PG8_LAS unsigned*)(lds + (bufoff) + ldsw + _i * 8192), 16, 0, 0); } while (0)
#define PG8_LDA(dst, b, h) do { _Pragma("unroll") for (int m = 0; m < 4; ++m) _Pragma("unroll") for (int k = 0; k < 2; ++k) dst[m][k] = *(const PG8_LAS bf16x8*)(lds + PG8_SA(b, h) + aoff + m * 2048 + k * 1024); } while (0)
#define PG8_LDB(dst, b, h) do { _Pragma("unroll") for (int n = 0; n < 2; ++n) _Pragma("unroll") for (int k = 0; k < 2; ++k) dst[n][k] = *(const PG8_LAS bf16x8*)(lds + PG8_SB(b, h) + boff + n * 2048 + k * 1024); } while (0)
#define PG8_MMA(ai, bj, At, Bt) do { __builtin_amdgcn_s_setprio(1); _Pragma("unroll") for (int m = 0; m < 4; ++m) _Pragma("unroll") for (int n = 0; n < 2; ++n) _Pragma("unroll") for (int k = 0; k < 2; ++k) \
        acc[ai][bj][m][n] = __builtin_amdgcn_mfma_f32_16x16x32_bf16(Bt[n][k], At[m][k], acc[ai][bj][m][n], 0, 0, 0); __builtin_amdgcn_s_setprio(0); } while (0)
#define PG8_WAIT_V(n) asm volatile("s_waitcnt vmcnt(" #n ")" ::: "memory")
#define PG8_WAIT_L(n) asm volatile("s_waitcnt lgkmcnt(" #n ")" ::: "memory")
#define PG8_BAR __builtin_amdgcn_s_barrier()
#define PG8_SCHED __builtin_amdgcn_sched_barrier(0)
    Unit cur, nxt; int ui = 0;
    if (!S.next(0, cur)) return;
    f32x4 acc[2][2][4][2];
#pragma unroll
    for (int a = 0; a < 2; ++a)
#pragma unroll
        for (int b = 0; b < 2; ++b)
#pragma unroll
            for (int m = 0; m < 4; ++m)
#pragma unroll
                for (int n = 0; n < 2; ++n) acc[a][b][m][n] = (f32x4){0.f, 0.f, 0.f, 0.f};
    bf16x8 At[4][2], B0[2][2], B1[2][2];
    const char* cA = S.aptr(g, cur); const char* cB = S.bptr(g, cur);
    S.a_ready(cur);
    if constexpr (SP2) {
        PG8_STAGE(PG8_SB(0, 0), cB, voffB); PG8_STAGE(PG8_SB(0, 1), cB + hstep, voffB); PG8_STAGE(PG8_SA(0, 0), cA, voffA); PG8_STAGE(PG8_SA(0, 1), cA + hstep, voffA);
        if (wr == 1) PG8_BAR;
        PG8_WAIT_V(2); PG8_BAR;
        PG8_STAGE(PG8_SB(1, 0), cB + kstep, voffB); PG8_STAGE(PG8_SA(1, 0), cA + kstep, voffA); PG8_STAGE(PG8_SB(1, 1), cB + hstep + kstep, voffB);
        PG8_WAIT_V(6); PG8_BAR;
    } else {
        PG8_STAGE(PG8_SB(0, 0), cB, voffB); PG8_STAGE(PG8_SA(0, 0), cA, voffA); PG8_STAGE(PG8_SB(0, 1), cB + hstep, voffB); PG8_STAGE(PG8_SA(0, 1), cA + hstep, voffA);
        if (wr == 1) PG8_BAR;
        PG8_WAIT_V(4); PG8_BAR;
        PG8_STAGE(PG8_SB(1, 0), cB + kstep, voffB); PG8_STAGE(PG8_SA(1, 0), cA + kstep, voffA); PG8_STAGE(PG8_SB(1, 1), cB + hstep + kstep, voffB);
        PG8_WAIT_V(6); PG8_BAR;
    }
    for (;;) {
        const bool has_next = S.next(ui + 1, nxt);
        const char* nA = has_next ? S.aptr(g, nxt) : cA; const char* nB = has_next ? S.bptr(g, nxt) : cB;
        for (int t = 0; t < nt; t += 2) {
            const bool last = (t == nt - 2);
            const char* a1 = cA + (size_t)(t + 1) * kstep;
            const char* a2 = last ? nA : cA + (size_t)(t + 2) * kstep; const char* b2 = last ? nB : cB + (size_t)(t + 2) * kstep;
            const char* a3 = a2 + kstep; const char* b3 = b2 + kstep;
            if (last && has_next) S.a_ready(nxt);
            if constexpr (SP2) {
            PG8_LDB(B0, 0, 0); PG8_LDB(B1, 0, 1); PG8_SCHED; PG8_LDA(At, 0, 0); PG8_STAGE(PG8_SA(1, 1), a1 + hstep, voffA);
            PG8_WAIT_V(8); PG8_WAIT_L(0); PG8_BAR; PG8_MMA(0, 0, At, B0); PG8_MMA(0, 1, At, B1); PG8_BAR; PG8_SCHED;
            PG8_LDA(At, 0, 1); PG8_STAGE(PG8_SB(0, 0), b2, voffB); PG8_STAGE(PG8_SB(0, 1), b2 + hstep, voffB); PG8_STAGE(PG8_SA(0, 0), a2, voffA);
            PG8_WAIT_V(8); PG8_WAIT_L(0); PG8_BAR; PG8_MMA(1, 0, At, B0); PG8_MMA(1, 1, At, B1); PG8_BAR; PG8_SCHED;
            PG8_LDB(B0, 1, 0); PG8_LDB(B1, 1, 1); PG8_SCHED; PG8_LDA(At, 1, 0); PG8_STAGE(PG8_SA(0, 1), a2 + hstep, voffA);
            PG8_WAIT_V(8); PG8_WAIT_L(0); PG8_BAR; PG8_MMA(0, 0, At, B0); PG8_MMA(0, 1, At, B1); PG8_BAR; PG8_SCHED;
            PG8_LDA(At, 1, 1); PG8_STAGE(PG8_SB(1, 0), b3, voffB); PG8_STAGE(PG8_SB(1, 1), b3 + hstep, voffB); PG8_STAGE(PG8_SA(1, 0), a3, voffA);
            PG8_WAIT_V(8); PG8_WAIT_L(0); PG8_BAR; PG8_MMA(1, 0, At, B0); PG8_MMA(1, 1, At, B1); PG8_BAR; PG8_SCHED;
            } else {
            PG8_LDB(B0, 0, 0); PG8_SCHED; PG8_LDA(At, 0, 0); PG8_STAGE(PG8_SA(1, 1), a1 + hstep, voffA);
            PG8_WAIT_L(8); PG8_BAR; PG8_WAIT_L(0); PG8_MMA(0, 0, At, B0); PG8_BAR; PG8_SCHED;
            PG8_LDB(B1, 0, 1); PG8_STAGE(PG8_SB(0, 0), b2, voffB);
            PG8_BAR; PG8_WAIT_L(0); PG8_MMA(0, 1, At, B1); PG8_BAR;
            PG8_LDA(At, 0, 1); PG8_STAGE(PG8_SA(0, 0), a2, voffA);
            PG8_BAR; PG8_WAIT_L(0); PG8_MMA(1, 0, At, B0); PG8_BAR; PG8_SCHED;
            PG8_STAGE(PG8_SB(0, 1), b2 + hstep, voffB);
            PG8_WAIT_V(6); PG8_BAR; PG8_MMA(1, 1, At, B1); PG8_BAR;
            PG8_LDB(B0, 1, 0); PG8_SCHED; PG8_LDA(At, 1, 0); PG8_STAGE(PG8_SA(0, 1), a2 + hstep, voffA);
            PG8_WAIT_L(8); PG8_BAR; PG8_WAIT_L(0); PG8_MMA(0, 0, At, B0); PG8_BAR; PG8_SCHED;
            PG8_LDB(B1, 1, 1); PG8_STAGE(PG8_SB(1, 0), b3, voffB);
            PG8_BAR; PG8_WAIT_L(0); PG8_MMA(0, 1, At, B1); PG8_BAR;
            PG8_LDA(At, 1, 1); PG8_STAGE(PG8_SA(1, 0), a3, voffA);
            PG8_BAR; PG8_WAIT_L(0); PG8_MMA(1, 0, At, B0); PG8_BAR; PG8_SCHED;
            PG8_STAGE(PG8_SB(1, 1), b3 + hstep, voffB);
            PG8_WAIT_V(6); PG8_BAR; PG8_MMA(1, 1, At, B1); PG8_BAR;
            }
        }
        if constexpr (ALIGN_EPI) { if (wr == 0) PG8_BAR; }
        if constexpr (!Epi::AFTER_DRAIN) { E(acc, cur, wr, wc, fr, fq); S.done(cur); }
        if (!has_next) break;
#pragma unroll
        for (int a = 0; a < 2; ++a)
#pragma unroll
            for (int b = 0; b < 2; ++b)
#pragma unroll
                for (int m = 0; m < 4; ++m)
#pragma unroll
                    for (int n = 0; n < 2; ++n) acc[a][b][m][n] = (f32x4){0.f, 0.f, 0.f, 0.f};
        cur = nxt; cA = nA; cB = nB; ++ui;
        if constexpr (ALIGN_EPI) { if (wr == 1) PG8_BAR; }
    }
    PG8_WAIT_V(0);
    if constexpr (!ALIGN_EPI) { if (wr == 0) PG8_BAR; }
    PG8_BAR;
    if constexpr (Epi::AFTER_DRAIN) { E.fused(acc, cur, wr, wc, fr, fq, lds, wid, lane); S.done(cur); }
#undef PG8_SA
#undef PG8_SB
#undef PG8_STAGE
#undef PG8_LDA
#undef PG8_LDB
#undef PG8_MMA
#undef PG8_WAIT_V
#undef PG8_WAIT_L
#undef PG8_BAR
#undef PG8_SCHED
}
}

namespace pg8 {
__device__ __forceinline__ unsigned cvt_pk_bf16(float lo, float hi) { unsigned r; asm volatile("v_cvt_pk_bf16_f32 %0, %1, %2" : "=v"(r) : "v"(lo), "v"(hi)); return r; }

struct EpiHproj {
    static constexpr bool PERM = true, AFTER_DRAIN = false;
    bf16_t* HP; float* GAB;
    __device__ __forceinline__ void operator()(const f32x4 (&acc)[2][2][4][2], const Unit& u, int wr, int wc, int fr, int fq) const {
        const int row0 = u.pm * BM + wr * 64 + fr;
        if (u.pn < 14) {
            const int col0 = u.pn * BM + wc * 32 + 8 * fq;
#pragma unroll
            for (int ai = 0; ai < 2; ++ai)
#pragma unroll
                for (int m = 0; m < 4; ++m) { bf16_t* rowp = HP + (size_t)(row0 + ai * HALF + m * 16) * 3584 + col0;
#pragma unroll
                    for (int bj = 0; bj < 2; ++bj) { const f32x4 v0 = acc[ai][bj][m][0], v1 = acc[ai][bj][m][1];
                        u32x4 w; w.x = cvt_pk_bf16(v0[0], v0[1]); w.y = cvt_pk_bf16(v0[2], v0[3]); w.z = cvt_pk_bf16(v1[0], v1[1]); w.w = cvt_pk_bf16(v1[2], v1[3]);
                        *(u32x4*)(rowp + bj * HALF) = w; } }
        } else if (wc == 0 && fq == 0) {
#pragma unroll
            for (int ai = 0; ai < 2; ++ai)
#pragma unroll
                for (int m = 0; m < 4; ++m) { float* rowp = GAB + (size_t)(row0 + ai * HALF + m * 16) * 8;
                    *(f32x4*)(rowp) = acc[ai][0][m][0]; *(f32x4*)(rowp + 4) = acc[ai][0][m][1]; }
        }
    }
};
struct EpiBf16Out {
    static constexpr bool PERM = true, AFTER_DRAIN = false;
    bf16_t* O; int ldc;
    __device__ __forceinline__ void operator()(const f32x4 (&acc)[2][2][4][2], const Unit& u, int wr, int wc, int fr, int fq) const {
        const int row0 = u.pm * BM + wr * 64 + fr, col0 = u.pn * BM + wc * 32 + 8 * fq;
#pragma unroll
        for (int ai = 0; ai < 2; ++ai)
#pragma unroll
            for (int m = 0; m < 4; ++m) { bf16_t* rowp = O + (size_t)(row0 + ai * HALF + m * 16) * ldc + col0;
#pragma unroll
                for (int bj = 0; bj < 2; ++bj) { const f32x4 v0 = acc[ai][bj][m][0], v1 = acc[ai][bj][m][1];
                    u32x4 w; w.x = cvt_pk_bf16(v0[0], v0[1]); w.y = cvt_pk_bf16(v0[2], v0[3]); w.z = cvt_pk_bf16(v1[0], v1[1]); w.w = cvt_pk_bf16(v1[2], v1[3]);
                    *(u32x4*)(rowp + bj * HALF) = w; } }
    }
};
struct EpiF32 {
    static constexpr bool PERM = false, AFTER_DRAIN = false;
    float* O; int ldc;
    __device__ __forceinline__ void operator()(const f32x4 (&acc)[2][2][4][2], const Unit& u, int wr, int wc, int fr, int fq) const {
        const int row0 = u.pm * BM + wr * 64 + fr, col0 = u.pn * BM + wc * 32 + 4 * fq;
#pragma unroll
        for (int ai = 0; ai < 2; ++ai)
#pragma unroll
            for (int m = 0; m < 4; ++m) { float* rowp = O + (size_t)(row0 + ai * HALF + m * 16) * ldc + col0;
#pragma unroll
                for (int bj = 0; bj < 2; ++bj)
#pragma unroll
                    for (int n = 0; n < 2; ++n) *(f32x4*)(rowp + bj * HALF + n * 16) = acc[ai][bj][m][n]; }
    }
};
struct EpiSwiglu {
    static constexpr bool PERM = true, AFTER_DRAIN = false;
    bf16_t* H; int ldh; int blk;
    __device__ __forceinline__ void operator()(const f32x4 (&acc)[2][2][4][2], const Unit& u, int wr, int wc, int fr, int fq) const {
        const int rt = wr * 64 + fr, col0 = u.pn * HALF + wc * 32 + 8 * fq;
        bf16_t* tb = H + (size_t)u.pm * BM * ldh;
#pragma unroll
        for (int ai = 0; ai < 2; ++ai)
#pragma unroll
            for (int m = 0; m < 4; ++m) { const int r = rt + ai * HALF + m * 16;
                bf16_t* rowp = blk ? tb + (size_t)(col0 >> 6) * (BM * 64) + r * 64 + (col0 & 63) : tb + (size_t)r * ldh + col0;
                float h[8];
#pragma unroll
                for (int n = 0; n < 2; ++n)
#pragma unroll
                    for (int i = 0; i < 4; ++i) { const float gt = acc[ai][0][m][n][i], up = acc[ai][1][m][n][i]; h[n * 4 + i] = gt * up * __builtin_amdgcn_rcpf(1.f + __expf(-gt)); }
                u32x4 w; w.x = cvt_pk_bf16(h[0], h[1]); w.y = cvt_pk_bf16(h[2], h[3]); w.z = cvt_pk_bf16(h[4], h[5]); w.w = cvt_pk_bf16(h[6], h[7]);
                *(u32x4*)(rowp) = w; }
    }
};
constexpr int MOE_TAB_OFF = 131072 + 1024;
__device__ __forceinline__ void moe_table(PG8_LAS unsigned char* lds, const unsigned* cntw, int tid) {
    PG8_LAS int* tab = (PG8_LAS int*)(lds + MOE_TAB_OFF);
    __syncthreads();
    if (tid < 2) { const int j = tid; int t = 0;
        for (int e = 0; e < 8; ++e) { const int c = (int)cntw[64 * (j * 8 + e)]; tab[j * 8 + e] = t; tab[16 + j * 8 + e] = c; t += (c + 255) >> 8; }
        tab[32 + j] = t; }
    __syncthreads();
}
__device__ __forceinline__ int moe_T(PG8_LAS unsigned char* lds, int j) { return __builtin_amdgcn_readfirstlane(((const PG8_LAS int*)(lds + MOE_TAB_OFF))[32 + j]); }
__device__ __forceinline__ int moe_expert(const PG8_LAS int* tab, int j, int t) { int e = 0;
#pragma unroll
    for (int k = 1; k < 8; ++k) e += (t >= tab[j * 8 + k]) ? 1 : 0;
    return __builtin_amdgcn_readfirstlane(e); }
__device__ __forceinline__ int moe_hphys(int j, int t) { return (j == 1 && t >= 64) ? t + 8 : t; }
struct EpiMoeDown {
    static constexpr bool PERM = false, AFTER_DRAIN = false;
    float* XF; const int* list; const float* gate; const PG8_LAS int* tab;
    __device__ __forceinline__ void operator()(const f32x4 (&acc)[2][2][4][2], const Unit& u, int wr, int wc, int fr, int fq) const {
        const int e = u.aux, j = u.sel, c_e = tab[16 + j * 8 + e], t_e = tab[j * 8 + e];
        const int s0 = (u.pm - t_e) * BM + wr * 64 + fr, col0 = u.pn * BM + wc * 32 + 4 * fq;
        const int* lp = list + (size_t)(j * 8 + e) * 16384; const float* gp = gate + (size_t)j * 16384;
        int tok[8]; float gt[8];
#pragma unroll
        for (int q = 0; q < 8; ++q) { const int s = s0 + (q >> 2) * HALF + (q & 3) * 16; tok[q] = (s < c_e) ? lp[s] : -1; }
#pragma unroll
        for (int q = 0; q < 8; ++q) gt[q] = (tok[q] >= 0) ? gp[tok[q]] : 0.f;
#pragma unroll
        for (int ai = 0; ai < 2; ++ai) {
            f32x4 o[4][2][2];
#pragma unroll
            for (int m = 0; m < 4; ++m) { const float* rowp = XF + (size_t)(tok[ai * 4 + m] >= 0 ? tok[ai * 4 + m] : 0) * 1024 + col0;
#pragma unroll
                for (int bj = 0; bj < 2; ++bj)
#pragma unroll
                    for (int n = 0; n < 2; ++n) o[m][bj][n] = *(const f32x4*)(rowp + bj * HALF + n * 16); }
#pragma unroll
            for (int m = 0; m < 4; ++m) { if (tok[ai * 4 + m] >= 0) { float* rowp = XF + (size_t)tok[ai * 4 + m] * 1024 + col0; const float g1 = gt[ai * 4 + m];
#pragma unroll
                for (int bj = 0; bj < 2; ++bj)
#pragma unroll
                    for (int n = 0; n < 2; ++n) *(f32x4*)(rowp + bj * HALF + n * 16) = o[m][bj][n] + acc[ai][bj][m][n] * g1; } }
        }
    }
};
template <bool DOWN>
struct MoeSched {
    int mode, n0, a0, j0, n1, a1, j1, G, c; const PG8_LAS int* tab;
    static constexpr int nN = DOWN ? 4 : 28;
    __device__ bool next(int i, Unit& u) const {
        int j, t;
        if (mode != 0) { if (i != 0 || mode == 2) return false; j = j0; t = a0; u.pn = c; }
        else {
            const int V = n0 + n1, nwg = V * nN; const long L = (long)i * G + c; if (L >= nwg) return false;
            int wgid = (int)L; { const int q = nwg / NXCD, r = nwg % NXCD, xcd = wgid % NXCD, off = wgid / NXCD; wgid = (xcd < r ? xcd * (q + 1) : r * (q + 1) + (xcd - r) * q) + off; }
            const int nig = WGM * nN, gid = wgid / nig, fm = gid * WGM, gsz = (V - fm) < WGM ? (V - fm) : WGM;
            const int vm = fm + ((wgid % nig) % gsz); u.pn = (wgid % nig) / gsz;
            if (vm < n0) { j = j0; t = a0 + vm; } else { j = j1; t = a1 + (vm - n0); }
        }
        u.aux = moe_expert(tab, j, t); u.sel = j;
        if (DOWN) { u.pm = t; u.am = moe_hphys(j, t); } else { u.pm = moe_hphys(j, t); u.am = t; }
        return true;
    }
    __device__ __forceinline__ const char* aptr(const Gemm& g, const Unit& u) const { return (const char*)g.A + (DOWN ? (size_t)0 : (size_t)u.sel * (size_t)(36u << 20)) + (size_t)u.am * ((size_t)BM * g.K * 2); }
    __device__ __forceinline__ const char* bptr(const Gemm& g, const Unit& u) const { return (const char*)g.Bt + (size_t)u.aux * ((size_t)g.N * g.K * 2) + (size_t)u.pn * ((size_t)BM * g.K * 2); }
    __device__ __forceinline__ void a_ready(const Unit&) const {}
    __device__ __forceinline__ void done(const Unit&) const {}
};
}
#ifndef PG8_SP2
#define PG8_SP2 true
#endif
#ifndef PG8_ALIGN
#define PG8_ALIGN true
#endif

constexpr size_t MiB = 1u << 20;
constexpr size_t WS_CTL = 0, CTL_BYTES = 256 * 1024;
constexpr size_t WS_ROPE = 256 * 1024;
constexpr size_t WS_WIN = 1 * MiB;
constexpr size_t WS_WO = 16 * MiB;
constexpr size_t WS_WGU = 20 * MiB;
constexpr size_t WS_WD = 31 * MiB;
constexpr size_t WS_XB = 37 * MiB;
constexpr size_t WS_GAB = 69 * MiB;
constexpr size_t WS_LIST = WS_GAB + 512 * 1024;
constexpr size_t WS_GATE = WS_LIST + 1 * MiB;
constexpr size_t WS_CD = WS_GATE + 128 * 1024;
constexpr size_t WS_RWT = WS_CD + 8 * 1024;
constexpr size_t WS_WMGU = 71 * MiB, WS_WMD = 183 * MiB;
constexpr size_t WS_R = 239 * MiB;
constexpr size_t R_HP = 0, R_OB = 112 * MiB, R_U = 144 * MiB, R_WN = 160 * MiB, R_QD = 176 * MiB, R_KDT = 192 * MiB, R_QK = 208 * MiB;
constexpr size_t WS_SSQ = WS_XB + 16 * MiB;
constexpr size_t WS_KV = WS_XB;
constexpr size_t R_MIX = 0, R_H = 64 * MiB;
constexpr size_t R_HM = 0, R_XG = 140 * MiB, XG_PASS = 36 * MiB;
constexpr size_t WS_END = WS_R + 216 * MiB;
constexpr int CW_TMO = 0, CW_BAR = 4096, CW_MOE = 16384, CW_WQ = 24576, CW_SUB = 28672;

constexpr int RING_BYTES = 131072, LDS_BYTES = 147456, LDSCTL_OFF = LDS_BYTES - 512, MISC_OFF = LDSCTL_OFF + 320;

constexpr int PH_PRO = 0;
constexpr int PH_L(int l, int k) { return 1 + 16 * l + k; }
constexpr int K_IN = 0, K_PREP = 1, K_SCAN = 2, K_OUT = 3, K_LN1 = 4, K_GU = 5, K_DN = 6, K_LN2 = 7;
constexpr int K_FIN = 12;
constexpr int K_G0 = 5, K_GU0 = 6, K_DN0 = 7, K_G1 = 8, K_GU1 = 9, K_DN1 = 10, K_LNF = 11;
constexpr int PH_END = 1 + 16 * 2;

struct Args { const float* in[18]; float* out; unsigned char* ws; int ph_lo, ph_hi; };
typedef const __attribute__((address_space(4))) Args* KArgs;
__device__ __forceinline__ KArgs kargs() { KArgs p = (KArgs)__builtin_amdgcn_kernarg_segment_ptr(); asm volatile("" : "+s"(p)); return p; }
__device__ __forceinline__ int tidx() { int t = threadIdx.x; asm volatile("" : "+v"(t)); return t; }

constexpr int TR_SCR = 64 * 65 * 4;
__device__ __forceinline__ void tr_item(const float* W, int N, int k0, int n0, bf16* WT, size_t ldk, int dst_row0, LAS float* scr, int lane, bool blk = false) {
    const int nq = 4 * (lane & 15), n = n0 + nq, kr = lane >> 4;
    f32x4 v[16];
#pragma unroll
    for (int i = 0; i < 16; ++i) v[i] = (n < N) ? *(const f32x4*)(W + (size_t)(k0 + 4 * i + kr) * N + n) : (f32x4){0.f, 0.f, 0.f, 0.f};
#pragma unroll
    for (int i = 0; i < 16; ++i) { LAS float* d = scr + (4 * i + kr) * 65 + nq; d[0] = v[i].x; d[1] = v[i].y; d[2] = v[i].z; d[3] = v[i].w; }
    LDS_WAIT(); asm volatile("" ::: "memory");
    const int c = lane & 7;
#pragma unroll
    for (int j = 0; j < 8; ++j) { const int nn = (lane >> 3) + 8 * j; const LAS float* s = scr + (8 * c) * 65 + nn;
        v4u o; o.x = pk2(s[0 * 65], s[1 * 65]); o.y = pk2(s[2 * 65], s[3 * 65]); o.z = pk2(s[4 * 65], s[5 * 65]); o.w = pk2(s[6 * 65], s[7 * 65]);
        const int dr = dst_row0 + nn;
        bf16* dp = blk ? WT + ((size_t)(dr >> 8) * (ldk >> 6) + (k0 >> 6)) * (256 * 64) + (dr & 255) * 64 + 8 * c : WT + (size_t)dr * ldk + k0 + 8 * c;
        *(v4u*)dp = o; }
    LDS_WAIT(); asm volatile("" ::: "memory");
}

constexpr int PRO_I_IN = 16 * 57, PRO_NIT = 2 * (16 * 57 + 16 * 16) + 2 * (16 * 44) + 44 * 16;
__device__ __forceinline__ void ph_prologue(KArgs a, LAS unsigned char* lds, int wave, int lane, int gw, int NGW, int gtid, int NT, int it_lo, int it_hi, bool misc) {
    unsigned char* ws = a->ws;
    LAS float* scr = (LAS float*)(lds + wave * TR_SCR);
    constexpr int I_IN = 16 * 57, I_O = 16 * 16, I_L = I_IN + I_O, I_G = 16 * 44, I_D = 44 * 16, NIT = 2 * I_L + 2 * I_G + I_D;
    static_assert(NIT == PRO_NIT && I_IN == PRO_I_IN, "prologue item counts");
    for (int it = it_lo + gw; it < it_hi; it += NGW) {
        int r = it;
        if (r < 2 * I_L) { const int l = r / I_L; r -= l * I_L;
            if (r < I_IN) { const int kb = r / 57, nb = r % 57; tr_item(a->in[1] + (size_t)l * 1024 * IN_COLS, IN_COLS, 64 * kb, 64 * nb, (bf16*)(ws + WS_WIN) + (size_t)l * NIN_PAD * 1024, 1024, 64 * nb, scr, lane); }
            else { r -= I_IN; const int kb = r / 16, nb = r % 16; tr_item(a->in[6] + (size_t)l * 1024 * 1024, 1024, 64 * kb, 64 * nb, (bf16*)(ws + WS_WO) + (size_t)l * 1024 * 1024, 1024, 64 * nb, scr, lane); }
            continue; }
        r -= 2 * I_L;
        if (r < 2 * I_G) { const int up = r / I_G; r -= up * I_G; const int kb = r / 44, nb = r % 44, n0 = 64 * nb;
            tr_item(up ? a->in[12] : a->in[11], FF, 64 * kb, n0, (bf16*)(ws + WS_WGU), 1024, 256 * (n0 >> 7) + (n0 & 127) + 128 * up, scr, lane); continue; }
        r -= 2 * I_G;
        { const int kb = r / 16, nb = r % 16; tr_item(a->in[13], 1024, 64 * kb, 64 * nb, (bf16*)(ws + WS_WD), FF, 64 * nb, scr, lane); }
    }
    if (!misc) return;
    for (int i = gtid; i < 2 * 192 * 128; i += NT) { const int l = i / (192 * 128), r = i % (192 * 128);
        ((v4u*)((bf16*)(ws + WS_WIN) + (size_t)l * NIN_PAD * 1024 + (size_t)3648 * 1024))[r] = (v4u){0u, 0u, 0u, 0u}; }
    for (int i = gtid; i < M * D / 8; i += NT) { const f32x4 p = ((const f32x4*)a->in[0])[2 * i], q = ((const f32x4*)a->in[0])[2 * i + 1];
        v4u o; o.x = pk2(p.x, p.y); o.y = pk2(p.z, p.w); o.z = pk2(q.x, q.y); o.w = pk2(q.z, q.w); ((v4u*)(ws + WS_XB))[i] = o; }
    for (int i = gtid; i < 8192; i += NT) ((float*)(ws + WS_RWT))[(i & 7) * 1024 + (i >> 3)] = a->in[14][i];
    for (int i = gtid; i < SEQ * 32; i += NT) { const int pos = i >> 5, k = i & 31;
        const float inv = powf(10000.0f, -(float)(2 * k) / 64.0f); const float ang = (float)pos * inv;
        double rev = (double)ang * 0.15915494309189535; rev -= floor(rev); const float rf = (float)rev;
        float* R = (float*)(ws + WS_ROPE) + (size_t)pos * 64; R[k] = __builtin_amdgcn_cosf(rf); R[32 + k] = __builtin_amdgcn_sinf(rf); }
}

__device__ __forceinline__ void moe_convert(KArgs a, LAS unsigned char* lds, int wave, int lane, int gw, int NGW, int e_lo, int e_hi, int item = -1) {
    unsigned char* ws = a->ws;
    LAS float* scr = (LAS float*)(lds + wave * TR_SCR);
    constexpr int I_G = 16 * 56, I_D = 56 * 16, I_E = 2 * I_G + I_D;
    for (int it = (item >= 0 ? item : e_lo * I_E + gw); it < (item >= 0 ? item + 1 : e_hi * I_E); it += NGW) {
        const int e = it / I_E; int r = it - e * I_E;
        if (r < 2 * I_G) { const int up = r / I_G; r -= up * I_G; const int kb = r / 56, nb = r % 56, n0 = 64 * nb;
            tr_item((up ? a->in[16] : a->in[15]) + (size_t)e * 1024 * FE, FE, 64 * kb, n0, (bf16*)(ws + WS_WMGU) + (size_t)e * 7168 * 1024, 1024, 256 * (n0 >> 7) + (n0 & 127) + 128 * up, scr, lane); }
        else { r -= 2 * I_G; const int kb = r / 16, nb = r % 16; tr_item(a->in[17] + (size_t)e * FE * 1024, 1024, 64 * kb, 64 * nb, (bf16*)(ws + WS_WMD) + (size_t)e * 1024 * FE, FE, 64 * nb, scr, lane, true); }
    }
}

__device__ __forceinline__ void conv_queue(KArgs a, LAS unsigned char* lds, int wave, int lane, int l) {
    unsigned char* ws = a->ws;
    LAS float* scr = (LAS float*)(lds + wave * TR_SCR);
    unsigned* head = (unsigned*)(ws + WS_CTL) + CW_WQ + 64 * l;
    constexpr int I_G = 16 * 56, I_D = 56 * 16, I_E = 2 * I_G + I_D;
    const int e_lo = (l == 0 ? 0 : 3), n_moe = (l == 0 ? 3 : 5) * I_E, n_all = n_moe + (l == 0 ? PRO_NIT - PRO_I_IN : 0);
    for (;;) {
        unsigned it0 = 0; if (lane == 0) it0 = __hip_atomic_fetch_add(head, 8u, RLX_AGENT);
        it0 = __builtin_amdgcn_readfirstlane(it0);
        if ((int)it0 >= n_all) break;
#pragma unroll 1
        for (int k = 0; k < 8; ++k) { const int it = (int)it0 + k; if (it >= n_all) break;
            if (it < n_moe) moe_convert(a, lds, wave, lane, 0, 1 << 30, 0, 0, e_lo * I_E + it);
            else ph_prologue(a, lds, wave, lane, 0, 1 << 30, 0, 0, PRO_I_IN + (it - n_moe), PRO_I_IN + (it - n_moe) + 1, false); }
    }
}

__device__ __forceinline__ void conv_range(KArgs a, LAS unsigned char* lds, int wave, int lane, int l, int lo, int hi, int gw, int NGW) {
    constexpr int I_G = 16 * 56, I_D = 56 * 16, I_E = 2 * I_G + I_D;
    const int n_moe = 4 * I_E;
    for (int it = lo + gw; it < hi; it += NGW) {
        if (it < n_moe) moe_convert(a, lds, wave, lane, 0, 1 << 30, 0, 0, 4 * l * I_E + it);
        else ph_prologue(a, lds, wave, lane, 0, 1 << 30, 0, 0, PRO_I_IN + (it - n_moe), PRO_I_IN + (it - n_moe) + 1, false);
    }
}
constexpr int CONV_N_MOE = 4 * (2 * 16 * 56 + 56 * 16);

template <bool ROUTE>
__device__ __forceinline__ void ln_rows(const float* res, float ares, const bf16* mix, const float* g, const float* bta, float* xf, float oscale, bf16* xb,
                                        const float* router, unsigned* cntw, int* list, float* gate, int lane, int gw, int NGW, LAS unsigned char* lds = nullptr, int tid = 0) {
    LAS unsigned* lcnt = (LAS unsigned*)lds; LAS unsigned* lbase = lcnt + 16; LAS unsigned* rec = lcnt + 32;
    int nrec = 0;
    if (ROUTE) { __syncthreads(); if (tid < 16) lcnt[tid] = 0u; __syncthreads(); }
    f32x4 gv[4], bv[4];
#pragma unroll
    for (int j = 0; j < 4; ++j) { gv[j] = ((const f32x4*)g)[lane + 64 * j]; bv[j] = ((const f32x4*)bta)[lane + 64 * j]; }
    f32x4 rn[4]; v2u mn[4];
#define LN_FETCH(r_) do { const f32x4* rr_ = (const f32x4*)(res + (size_t)(r_) * D) + lane; _Pragma("unroll") for (int j = 0; j < 4; ++j) rn[j] = rr_[64 * j]; \
        if (mix) { const v2u* mr_ = (const v2u*)(mix + (size_t)(r_) * D) + lane; _Pragma("unroll") for (int j = 0; j < 4; ++j) mn[j] = mr_[64 * j]; } } while (0)
#pragma unroll
    for (int j = 0; j < 4; ++j) { rn[j] = (f32x4){0.f, 0.f, 0.f, 0.f}; mn[j] = (v2u){0u, 0u}; }
    if (gw < M) LN_FETCH(gw);
    for (int row = gw; row < M; row += NGW) {
        f32x4 v[4]; float s = 0.f;
#pragma unroll
        for (int j = 0; j < 4; ++j) { v[j] = rn[j] * ares; if (mix) v[j] = v[j] + (f32x4){bflo(mn[j].x), bfhi(mn[j].x), bflo(mn[j].y), bfhi(mn[j].y)}; }
        if (row + NGW < M) LN_FETCH(row + NGW);
#pragma unroll
        for (int j = 0; j < 4; ++j) s += (v[j].x + v[j].y) + (v[j].z + v[j].w);
        const float mean = wave_sum(s) * (1.f / D); float s2 = 0.f;
#pragma unroll
        for (int j = 0; j < 4; ++j) { v[j] = v[j] - mean; s2 += (v[j].x * v[j].x + v[j].y * v[j].y) + (v[j].z * v[j].z + v[j].w * v[j].w); }
        const float rstd = 1.f / sqrtf(wave_sum(s2) * (1.f / D) + LN_EPS);
#pragma unroll
        for (int j = 0; j < 4; ++j) v[j] = v[j] * rstd * gv[j] + bv[j];
        f32x4* xo = (f32x4*)(xf + (size_t)row * D) + lane;
#pragma unroll
        for (int j = 0; j < 4; ++j) xo[64 * j] = v[j] * oscale;
        if (xb) { v2u* bo = (v2u*)(xb + (size_t)row * D) + lane;
#pragma unroll
            for (int j = 0; j < 4; ++j) { v2u o; o.x = pk2(v[j].x, v[j].y); o.y = pk2(v[j].z, v[j].w); bo[64 * j] = o; } }
        if (ROUTE) {
            float lg[8];
#pragma unroll
            for (int e = 0; e < 8; ++e) lg[e] = 0.f;
#pragma unroll
            for (int e = 0; e < 8; ++e)
#pragma unroll
                for (int j = 0; j < 4; ++j) { const f32x4 r4 = ((const f32x4*)(router + e * 1024))[lane + 64 * j]; lg[e] += (v[j].x * r4.x + v[j].y * r4.y) + (v[j].z * r4.z + v[j].w * r4.w); }
#pragma unroll
            for (int e = 0; e < 8; ++e) lg[e] = wave_sum(lg[e]);
            if (lane == 0) {
                int e0 = 0; float v0 = lg[0];
#pragma unroll
                for (int e = 1; e < 8; ++e) if (lg[e] > v0) { v0 = lg[e]; e0 = e; }
                int e1 = -1; float v1 = -3.0e38f;
#pragma unroll
                for (int e = 0; e < 8; ++e) if (e != e0 && lg[e] > v1) { v1 = lg[e]; e1 = e; }
                const float p1 = __expf(v1 - v0), g0 = 1.f / (1.f + p1), g1 = p1 / (1.f + p1);
                const int wv = (int)(tid >> 6), k = nrec++;
                const unsigned l0 = __hip_atomic_fetch_add(lcnt + e0, 1u, __ATOMIC_RELAXED, __HIP_MEMORY_SCOPE_WORKGROUP), l1 = __hip_atomic_fetch_add(lcnt + 8 + e1, 1u, __ATOMIC_RELAXED, __HIP_MEMORY_SCOPE_WORKGROUP);
                rec[(wv * 16 + k) * 4 + 0] = (unsigned)row; rec[(wv * 16 + k) * 4 + 1] = (unsigned)e0 | ((unsigned)e1 << 8); rec[(wv * 16 + k) * 4 + 2] = l0; rec[(wv * 16 + k) * 4 + 3] = l1;
                gate[row] = g0; gate[16384 + row] = g1;
            }
        }
    }
    if (ROUTE) {
        __syncthreads();
        if (tid < 16) { const unsigned c = lcnt[tid]; lbase[tid] = c ? __hip_atomic_fetch_add(cntw + 64 * tid, c, RLX_AGENT) : 0u; }
        __syncthreads();
        if (lane == 0) { const int wv = (int)(tid >> 6);
            for (int k = 0; k < nrec; ++k) { const unsigned row = rec[(wv * 16 + k) * 4], ee = rec[(wv * 16 + k) * 4 + 1], l0 = rec[(wv * 16 + k) * 4 + 2], l1 = rec[(wv * 16 + k) * 4 + 3];
                const unsigned e0 = ee & 255u, e1 = ee >> 8;
                list[(size_t)e0 * 16384 + lbase[e0] + l0] = (int)row; list[(size_t)(8 + e1) * 16384 + lbase[8 + e1] + l1] = (int)row; } }
    }
}

__device__ __forceinline__ void moe_gather(KArgs a, int j, int lane, int gw, int NGW) {
    unsigned char* ws = a->ws; const unsigned* cntw = (const unsigned*)(ws + WS_CTL) + CW_MOE + 64 * (j * 8);
    int pre[8], cum[8]; { int p = 0, t = 0;
#pragma unroll
        for (int e = 0; e < 8; ++e) { const int c = (int)cntw[64 * e]; pre[e] = p; cum[e] = t; p += c; t += (c + 255) >> 8; } }
    const int* list = (const int*)(ws + WS_LIST) + (size_t)j * 8 * 16384;
    for (int r0 = gw; r0 < M; r0 += 8 * NGW) {
        int tok[8], drow[8];
#pragma unroll
        for (int q = 0; q < 8; ++q) { const int r = r0 + q * NGW; tok[q] = -1; drow[q] = 0;
            if (r < M) { int e = 0;
#pragma unroll
                for (int k = 1; k < 8; ++k) e += (r >= pre[k]) ? 1 : 0;
                int pe = 0, ce = 0;
#pragma unroll
                for (int k = 0; k < 8; ++k) if (k == e) { pe = pre[k]; ce = cum[k]; }
                const int s = r - pe; tok[q] = list[(size_t)e * 16384 + s]; drow[q] = ce * 256 + s; } }
        v4u x0[8], x1[8];
#pragma unroll
        for (int q = 0; q < 8; ++q) { const v4u* src = (const v4u*)((const bf16*)(ws + WS_XB) + (size_t)(tok[q] >= 0 ? tok[q] : 0) * 1024); x0[q] = src[lane]; x1[q] = src[lane + 64]; }
#pragma unroll
        for (int q = 0; q < 8; ++q) if (tok[q] >= 0) { v4u* dst = (v4u*)((bf16*)(ws + WS_R + R_XG + (size_t)j * XG_PASS) + (size_t)drow[q] * 1024); dst[lane] = x0[q]; dst[lane + 64] = x1[q]; }
    }
}

__device__ __forceinline__ void gdn_prep_unit(KArgs a, int l, int unit, LAS unsigned char* lds, int tid, int lane, int wave) {
    unsigned char* ws = a->ws;
    const int n = unit & 31, bh = unit >> 5, h = bh & 3, b = bh >> 2;
    const int t0 = b * SEQ + n * 64;
    LAS float* Q = (LAS float*)lds; LAS float* K = Q + 8192; LAS float* V = K + 8192; LAS float* A = V + 8192; LAS float* gc = A + 4096; LAS float* bt = gc + 64;
    const bf16* HP = (const bf16*)(ws + WS_R + R_HP);
    const float* cw = a->in[2] + (size_t)l * 4 * 1536;
    __syncthreads();
    for (int idx = tid; idx < 64 * 384; idx += 512) { const int i = idx / 384, c = idx % 384, which = c >> 7, d = c & 127;
        const int col = COL_GQ + which * 512 + h * 128 + d, cc = which * 512 + h * 128 + d; float acc = 0.f;
#pragma unroll
        for (int j = 0; j < 4; ++j) { const int s = n * 64 + i - 3 + j; if (s >= 0) acc += cw[j * 1536 + cc] * bf2f(HP[(size_t)(b * SEQ + s) * HP_LD + col]); }
        const float y = siluf(acc); LAS float* dst = which == 0 ? Q : (which == 1 ? K : V); dst[i * 128 + d] = y; }
    if (tid < 64) { const float* gab = (const float*)(ws + WS_GAB) + (size_t)(t0 + tid) * 8; const float x = gab[h] + a->in[4][l * 4 + h];
        const float sp = fmaxf(x, 0.f) + log1pf(__expf(-fabsf(x))); gc[tid] = -__expf(a->in[3][l * 4 + h]) * sp; bt[tid] = sigmf(gab[4 + h]); }
    __syncthreads();
#pragma unroll 1
    for (int r = 0; r < 8; ++r) { const int i = wave * 8 + r;
        float q0 = Q[i * 128 + lane], q1 = Q[i * 128 + lane + 64], k0 = K[i * 128 + lane], k1 = K[i * 128 + lane + 64];
        const float sq = wave_sum(q0 * q0 + q1 * q1), sk = wave_sum(k0 * k0 + k1 * k1);
        const float fq = rsqrtf(sq + NORM_EPS) * 0.08838834764831845f, fk = rsqrtf(sk + NORM_EPS);
        Q[i * 128 + lane] = q0 * fq; Q[i * 128 + lane + 64] = q1 * fq; K[i * 128 + lane] = k0 * fk; K[i * 128 + lane + 64] = k1 * fk; }
    if (tid == 0) { float c = 0.f; for (int i = 0; i < 64; ++i) { c += gc[i]; gc[i] = c; } }
    __syncthreads();
    bf16* QKg = (bf16*)(ws + WS_R + R_QK) + (size_t)unit * 4096; bf16* QDg = (bf16*)(ws + WS_R + R_QD) + (size_t)unit * 8192; bf16* KDTg = (bf16*)(ws + WS_R + R_KDT) + (size_t)unit * 8192;
    bf16* WNg = (bf16*)(ws + WS_R + R_WN) + (size_t)unit * 8192; bf16* Ug = (bf16*)(ws + WS_R + R_U) + (size_t)unit * 8192;
    for (int idx = tid; idx < 4096; idx += 512) { const int i = idx >> 6, j = idx & 63; float dqk = 0.f, dkk = 0.f;
        for (int dd = 0; dd < 128; ++dd) { const int d = (dd + j) & 127; const float kj = K[j * 128 + d]; dqk += Q[i * 128 + d] * kj; dkk += K[i * 128 + d] * kj; }
        const float dec = __expf(gc[i] - gc[j]);
        A[i * 64 + j] = (j < i) ? bt[i] * dkk * dec : 0.f;
        QKg[fragoff(i, j, 2)] = (bf16)f2bf((j <= i) ? dqk * dec : 0.f); }
    const float gl = gc[63];
    for (int idx = tid; idx < 8192; idx += 512) { const int i = idx >> 7, d = idx & 127;
        QDg[fragoff(i, d, 4)] = (bf16)f2bf(Q[i * 128 + d] * __expf(gc[i]));
        KDTg[fragoff(d, i, 2)] = (bf16)f2bf(K[i * 128 + d] * __expf(gl - gc[i])); }
    if (tid == 0) ((float*)(ws + WS_CD))[unit] = __expf(gl);
    __syncthreads();
    for (int idx = tid; idx < 8192; idx += 512) { const int i = idx >> 7; const float bi = bt[i]; V[idx] *= bi; Q[idx] = bi * __expf(gc[i]) * K[idx]; }
    __syncthreads();
    if (tid < 256) { LAS float* buf = (tid < 128 ? V : Q) + (tid & 127);
        for (int i = 1; i < 64; ++i) { float acc = buf[i * 128]; for (int m = 0; m < i; ++m) acc -= A[i * 64 + m] * buf[m * 128]; buf[i * 128] = acc; } }
    __syncthreads();
    for (int idx = tid; idx < 8192; idx += 512) { const int i = idx >> 7, d = idx & 127; Ug[uoff(i, d)] = (bf16)f2bf(V[idx]); WNg[fragoff(i, d, 4)] = (bf16)f2bf(-Q[idx]); }
}

__device__ __forceinline__ void gdn_scan_naive(KArgs a, int l, int bh, LAS unsigned char* lds, int tid, int lane, int wave) {
    unsigned char* ws = a->ws;
    LAS float* S = (LAS float*)lds; LAS float* VN = S + 16384; LAS float* O = VN + 8192;
    const int h = bh & 3, b = bh >> 2, e = tid & 127, ig = tid >> 7;
    const bf16* HP = (const bf16*)(ws + WS_R + R_HP); bf16* OB = (bf16*)(ws + WS_R + R_OB);
    const float* nw = a->in[5] + l * 128;
    __syncthreads();
    for (int idx = tid; idx < 16384; idx += 512) S[idx] = 0.f;
    __syncthreads();
#pragma unroll 1
    for (int n = 0; n < 32; ++n) {
        const int unit = bh * 32 + n;
        const bf16* Ug = (const bf16*)(ws + WS_R + R_U) + (size_t)unit * 8192; const bf16* WNg = (const bf16*)(ws + WS_R + R_WN) + (size_t)unit * 8192;
        const bf16* QDg = (const bf16*)(ws + WS_R + R_QD) + (size_t)unit * 8192; const bf16* KDTg = (const bf16*)(ws + WS_R + R_KDT) + (size_t)unit * 8192;
        const bf16* QKg = (const bf16*)(ws + WS_R + R_QK) + (size_t)unit * 4096; const float cd = ((const float*)(ws + WS_CD))[unit];
#pragma unroll 1
        for (int r = 0; r < 16; ++r) { const int i = ig + 4 * r; float acc = bf2f(Ug[uoff(i, e)]);
#pragma unroll 2
            for (int d0 = 0; d0 < 128; d0 += 4) { const v2u w = *(const v2u*)(WNg + fragoff(i, d0, 4));
                acc += bflo(w.x) * S[d0 * 128 + e] + bfhi(w.x) * S[(d0 + 1) * 128 + e] + bflo(w.y) * S[(d0 + 2) * 128 + e] + bfhi(w.y) * S[(d0 + 3) * 128 + e]; }
            VN[i * 128 + e] = acc; }
        __syncthreads();
#pragma unroll 1
        for (int r = 0; r < 16; ++r) { const int i = ig + 4 * r; float acc = 0.f;
#pragma unroll 2
            for (int d0 = 0; d0 < 128; d0 += 4) { const v2u w = *(const v2u*)(QDg + fragoff(i, d0, 4));
                acc += bflo(w.x) * S[d0 * 128 + e] + bfhi(w.x) * S[(d0 + 1) * 128 + e] + bflo(w.y) * S[(d0 + 2) * 128 + e] + bfhi(w.y) * S[(d0 + 3) * 128 + e]; }
#pragma unroll 2
            for (int j0 = 0; j0 < 64; j0 += 4) { const v2u w = *(const v2u*)(QKg + fragoff(i, j0, 2));
                acc += bflo(w.x) * VN[j0 * 128 + e] + bfhi(w.x) * VN[(j0 + 1) * 128 + e] + bflo(w.y) * VN[(j0 + 2) * 128 + e] + bfhi(w.y) * VN[(j0 + 3) * 128 + e]; }
            O[i * 128 + e] = acc; }
        __syncthreads();
#pragma unroll 1
        for (int r = 0; r < 32; ++r) { const int d = ig + 4 * r; float acc = S[d * 128 + e] * cd;
#pragma unroll 2
            for (int i0 = 0; i0 < 64; i0 += 4) { const v2u w = *(const v2u*)(KDTg + fragoff(d, i0, 2));
                acc += bflo(w.x) * VN[i0 * 128 + e] + bfhi(w.x) * VN[(i0 + 1) * 128 + e] + bflo(w.y) * VN[(i0 + 2) * 128 + e] + bfhi(w.y) * VN[(i0 + 3) * 128 + e]; }
            S[d * 128 + e] = acc; }
#pragma unroll 1
        for (int r = 0; r < 8; ++r) { const int i = wave * 8 + r; const float v0 = O[i * 128 + lane], v1 = O[i * 128 + lane + 64];
            const float rs = rsqrtf(wave_sum(v0 * v0 + v1 * v1) * (1.f / 128.f) + NORM_EPS);
            const size_t t = (size_t)b * SEQ + n * 64 + i; const bf16* gp = HP + t * HP_LD + COL_GG + h * 128; bf16* op = OB + t * 1024 + 512 + h * 128;
            op[lane] = (bf16)f2bf(v0 * rs * nw[lane] * siluf(bf2f(gp[lane]))); op[lane + 64] = (bf16)f2bf(v1 * rs * nw[lane + 64] * siluf(bf2f(gp[lane + 64]))); }
        __syncthreads();
    }
}

__device__ __forceinline__ void ret_unit_naive(KArgs a, int unit, LAS unsigned char* lds, int tid, int lane, int wave) {
    unsigned char* ws = a->ws;
    LAS float* Qs = (LAS float*)lds; LAS float* Ks = Qs + 64 * 65; LAS float* Vs = Ks + 64 * 65; LAS float* Sc = Vs + 8192;
    const int qb = unit & 31, bh = unit >> 5, h = bh & 3, b = bh >> 2, e = tid & 127, ig = tid >> 7;
    const bf16* HP = (const bf16*)(ws + WS_R + R_HP); bf16* OB = (bf16*)(ws + WS_R + R_OB); const float* RT = (const float*)(ws + WS_ROPE);
    const float log2g = log2f(1.0f - exp2f(-5.0f - (float)h));
    __syncthreads();
    for (int idx = tid; idx < 4096; idx += 512) { const int i = idx >> 6, d = idx & 63, dd = d & 31, pos = qb * 64 + i; const size_t t = (size_t)b * SEQ + pos;
        const float c = RT[pos * 64 + dd], s = RT[pos * 64 + 32 + dd]; const float x1 = bf2f(HP[t * HP_LD + COL_RQ + h * 64 + dd]), x2 = bf2f(HP[t * HP_LD + COL_RQ + h * 64 + dd + 32]);
        Qs[i * 65 + d] = d < 32 ? x1 * c - x2 * s : x1 * s + x2 * c; }
    float acc[16];
#pragma unroll
    for (int r = 0; r < 16; ++r) acc[r] = 0.f;
#pragma unroll 1
    for (int kb = 0; kb <= qb; ++kb) {
        __syncthreads();
        for (int idx = tid; idx < 4096; idx += 512) { const int i = idx >> 6, d = idx & 63, dd = d & 31, pos = kb * 64 + i; const size_t t = (size_t)b * SEQ + pos;
            const float c = RT[pos * 64 + dd], s = RT[pos * 64 + 32 + dd]; const float x1 = bf2f(HP[t * HP_LD + COL_RK + h * 64 + dd]), x2 = bf2f(HP[t * HP_LD + COL_RK + h * 64 + dd + 32]);
            Ks[i * 65 + d] = 0.125f * (d < 32 ? x1 * c - x2 * s : x1 * s + x2 * c); }
        for (int idx = tid; idx < 8192; idx += 512) { const int i = idx >> 7, d = idx & 127; Vs[idx] = bf2f(HP[((size_t)b * SEQ + kb * 64 + i) * HP_LD + COL_RV + h * 128 + d]); }
        __syncthreads();
        { const int j = tid & 63, ig8 = tid >> 6;
#pragma unroll 1
          for (int r = 0; r < 8; ++r) { const int i = ig8 + 8 * r; float dot = 0.f;
#pragma unroll 8
              for (int d = 0; d < 64; ++d) dot += Qs[i * 65 + d] * Ks[j * 65 + d];
              const int delta = (qb - kb) * 64 + i - j; Sc[i * 65 + j] = delta >= 0 ? dot * exp2f((float)delta * log2g) : 0.f; } }
        __syncthreads();
#pragma unroll 2
        for (int j = 0; j < 64; ++j) { const float vv = Vs[j * 128 + e];
#pragma unroll
            for (int r = 0; r < 16; ++r) acc[r] += Sc[(ig + 4 * r) * 65 + j] * vv; }
    }
    __syncthreads();
#pragma unroll
    for (int r = 0; r < 16; ++r) Vs[(ig + 4 * r) * 128 + e] = acc[r];
    __syncthreads();
#pragma unroll 1
    for (int r = 0; r < 8; ++r) { const int i = wave * 8 + r; const float v0 = Vs[i * 128 + lane], v1 = Vs[i * 128 + lane + 64];
        const float mean = wave_sum(v0 + v1) * (1.f / 128.f), d0 = v0 - mean, d1 = v1 - mean; const float rs = rsqrtf(wave_sum(d0 * d0 + d1 * d1) * (1.f / 128.f) + LN_EPS);
        const size_t t = (size_t)b * SEQ + qb * 64 + i; const bf16* gp = HP + t * HP_LD + COL_RG + h * 128; bf16* op = OB + t * 1024 + h * 128;
        op[lane] = (bf16)f2bf(d0 * rs * siluf(bf2f(gp[lane]))); op[lane + 64] = (bf16)f2bf(d1 * rs * siluf(bf2f(gp[lane + 64]))); }
}

typedef float f32x16 __attribute__((ext_vector_type(16)));
typedef float f32x8 __attribute__((ext_vector_type(8)));
typedef __bf16 bf8v __attribute__((ext_vector_type(8)));
typedef short bf16x8 __attribute__((ext_vector_type(8)));
#define MFMA32(a, b, c) __builtin_amdgcn_mfma_f32_32x32x16_bf16((a), (b), (c), 0, 0, 0)
__device__ __forceinline__ bf16x8 pack8(const f32x16& x, int s) {
    f32x8 v;
#pragma unroll
    for (int j = 0; j < 8; ++j) v[j] = x[8 * s + j];
    return __builtin_bit_cast(bf16x8, __builtin_convertvector(v, bf8v));
}

__device__ __forceinline__ unsigned short bfc(float x) { return __builtin_bit_cast(unsigned short, (__bf16)x); }
__device__ __forceinline__ unsigned bfc2(float lo, float hi) { return (unsigned)bfc(lo) | ((unsigned)bfc(hi) << 16); }

#ifndef PROBE_UNIT
#define PROBE_UNIT 0
#endif
#if defined(PROBE_MULT) && PROBE_MULT > 0
#define STAMPT(id, thr) do { if (blockIdx.x == PROBE_BID && threadIdx.x == (thr)) __hip_atomic_store((unsigned long long*)(a->ws + WS_CTL + 131072) + (id), (unsigned long long)__builtin_amdgcn_s_memrealtime(), RLX_AGENT); } while (0)
#else
#define STAMPT(id, thr) do {} while (0)
#endif
#define GDN_BAR() do { asm volatile("s_waitcnt lgkmcnt(0)" ::: "memory"); __builtin_amdgcn_s_barrier(); asm volatile("" ::: "memory"); } while (0)
__device__ __forceinline__ void gdn_scan_fast(KArgs a, int l, int bh, LAS unsigned char* lds, int tid, int lane, int wave) {
    unsigned char* ws = a->ws;
    constexpr int FB_WN = 0, FB_QD = 16384, FB_KDT = 32768, FB_QK = 49152, FB_U = 57344, FB_BYTES = 73728;
    LAS float* OL = (LAS float*)(lds + FB_BYTES);
    constexpr int OLS = 64 * 132;
    const int h = bh & 3, b = bh >> 2, c = lane & 31, hh = lane >> 5;
    const bf16* HP = (const bf16*)(ws + WS_R + R_HP); bf16* OB = (bf16*)(ws + WS_R + R_OB);
    const float* nw = a->in[5] + l * 128;
    const unsigned char* gWN = (const unsigned char*)(ws + WS_R + R_WN) + (size_t)bh * 32 * 16384; const unsigned char* gQD = (const unsigned char*)(ws + WS_R + R_QD) + (size_t)bh * 32 * 16384;
    const unsigned char* gKDT = (const unsigned char*)(ws + WS_R + R_KDT) + (size_t)bh * 32 * 16384; const unsigned char* gQK = (const unsigned char*)(ws + WS_R + R_QK) + (size_t)bh * 32 * 8192;
    const unsigned char* gU = (const unsigned char*)(ws + WS_R + R_U) + (size_t)bh * 32 * 16384;
    const int et = tid - 256;
#define GDN_FETCH(pf, nn) do { _Pragma("unroll") for (int k = 0; k < 18; ++k) { const unsigned char* src_ = k < 4 ? gWN + (size_t)(nn) * 16384 + k * 4096 : k < 8 ? gQD + (size_t)(nn) * 16384 + (k - 4) * 4096 : \
        k < 12 ? gKDT + (size_t)(nn) * 16384 + (k - 8) * 4096 : k < 14 ? gQK + (size_t)(nn) * 8192 + (k - 12) * 4096 : gU + (size_t)(nn) * 16384 + (k - 14) * 4096; pf[k] = *(const v4u*)(src_ + et * 16); } } while (0)
#define GDN_STORE(pf) do { _Pragma("unroll") for (int k = 0; k < 18; ++k) *(LAS v4u*)(lds + k * 4096 + et * 16) = pf[k]; } while (0)
    __syncthreads();
    if (wave < 4) {
        f32x16 S[4];
#pragma unroll
        for (int t = 0; t < 4; ++t)
#pragma unroll
            for (int i = 0; i < 16; ++i) S[t][i] = 0.f;
        GDN_BAR();
        const int q = wave;
        const LAS bf16x8* WNf = (const LAS bf16x8*)(lds + FB_WN) + lane; const LAS bf16x8* QDf = (const LAS bf16x8*)(lds + FB_QD) + lane;
        const LAS bf16x8* KDTf = (const LAS bf16x8*)(lds + FB_KDT) + lane; const LAS bf16x8* QKf = (const LAS bf16x8*)(lds + FB_QK) + lane;
        const LAS v4u* Uf = (const LAS v4u*)(lds + FB_U) + (q * 2) * 128 + lane;
#pragma unroll 1
        for (int n = 0; n < 32; ++n) {
            if (n == 10) STAMPT(110, 0);
            const float cd = ((const float*)(ws + WS_CD))[bh * 32 + n];
            bf16x8 A0[8], A1[8];
#define GDN_LD_MTS(A, F, g) do { _Pragma("unroll") for (int k = 0; k < 8; ++k) { const int m_ = k & 1, s_ = (k >> 1) & 1, t_ = 2 * (g) + (k >> 2); A[k] = F[((m_ * 4 + t_) * 2 + s_) * 64]; } } while (0)
#define GDN_LD_TMS(A, F, g) do { _Pragma("unroll") for (int k = 0; k < 8; ++k) { const int s_ = k & 1, m_ = (k >> 1) & 1, t_ = 2 * (g) + (k >> 2); A[k] = F[((t_ * 2 + m_) * 2 + s_) * 64]; } } while (0)
            GDN_LD_MTS(A0, WNf, 0); GDN_LD_MTS(A1, WNf, 1);
            f32x16 av[2];
#pragma unroll
            for (int m = 0; m < 2; ++m)
#pragma unroll
                for (int hf = 0; hf < 2; ++hf) { const v4u u4 = Uf[(m * 2 + hf) * 64];
#pragma unroll
                    for (int k = 0; k < 4; ++k) { av[m][8 * hf + 2 * k] = bflo(u4[k]); av[m][8 * hf + 2 * k + 1] = bfhi(u4[k]); } }
            bf16x8 Sb[4][2];
#pragma unroll
            for (int t = 0; t < 4; ++t) { Sb[t][0] = pack8(S[t], 0); Sb[t][1] = pack8(S[t], 1); }
#pragma unroll
            for (int k = 0; k < 8; ++k) { const int m_ = k & 1, s_ = (k >> 1) & 1, t_ = (k >> 2); av[m_] = MFMA32(A0[k], Sb[t_][s_], av[m_]); }
            GDN_LD_MTS(A0, QDf, 0);
#pragma unroll
            for (int k = 0; k < 8; ++k) { const int m_ = k & 1, s_ = (k >> 1) & 1, t_ = 2 + (k >> 2); av[m_] = MFMA32(A1[k], Sb[t_][s_], av[m_]); }
            GDN_LD_MTS(A1, QDf, 1);
            f32x16 ao[2];
#pragma unroll
            for (int m = 0; m < 2; ++m)
#pragma unroll
                for (int i = 0; i < 16; ++i) ao[m][i] = 0.f;
#pragma unroll
            for (int k = 0; k < 8; ++k) { const int m_ = k & 1, s_ = (k >> 1) & 1, t_ = (k >> 2); ao[m_] = MFMA32(A0[k], Sb[t_][s_], ao[m_]); }
#pragma unroll
            for (int k = 0; k < 6; ++k) { const int s_ = k & 1, m_ = k >= 2 ? 1 : 0, mp_ = k >= 4 ? 1 : 0; A0[k] = QKf[((m_ * 2 + mp_) * 2 + s_) * 64]; }
#pragma unroll
            for (int k = 0; k < 8; ++k) { const int m_ = k & 1, s_ = (k >> 1) & 1, t_ = 2 + (k >> 2); ao[m_] = MFMA32(A1[k], Sb[t_][s_], ao[m_]); }
            GDN_LD_TMS(A1, KDTf, 0);
            bf16x8 Vb[2][2];
#pragma unroll
            for (int m = 0; m < 2; ++m) { Vb[m][0] = pack8(av[m], 0); Vb[m][1] = pack8(av[m], 1); }
#pragma unroll
            for (int k = 0; k < 6; ++k) { const int s_ = k & 1, m_ = k >= 2 ? 1 : 0, mp_ = k >= 4 ? 1 : 0; ao[m_] = MFMA32(A0[k], Vb[mp_][s_], ao[m_]); }
            GDN_LD_TMS(A0, KDTf, 1);
            {   LAS float* Ob = OL + (n & 1) * OLS + 32 * wave + c;
#pragma unroll
                for (int m = 0; m < 2; ++m)
#pragma unroll
                    for (int i = 0; i < 16; ++i) Ob[(32 * m + (i & 3) + 8 * (i >> 2) + 4 * hh) * 132] = ao[m][i]; }
#pragma unroll
            for (int t = 0; t < 4; ++t)
#pragma unroll
                for (int i = 0; i < 16; ++i) S[t][i] *= cd;
#pragma unroll
            for (int k = 0; k < 8; ++k) { const int s_ = k & 1, m_ = (k >> 1) & 1, t_ = (k >> 2); S[t_] = MFMA32(A1[k], Vb[m_][s_], S[t_]); }
#pragma unroll
            for (int k = 0; k < 8; ++k) { const int s_ = k & 1, m_ = (k >> 1) & 1, t_ = 2 + (k >> 2); S[t_] = MFMA32(A0[k], Vb[m_][s_], S[t_]); }
#undef GDN_LD_MTS
#undef GDN_LD_TMS
            if (n == 10) STAMPT(111, 0);
            GDN_BAR();
            if (n == 10) STAMPT(112, 0);
            GDN_BAR();
            if (n == 10) STAMPT(113, 0);
        }
        GDN_BAR(); GDN_BAR();
    } else {
        v4u pfA[18], pfB[18];
        LAS float* NWl = OL + 2 * OLS;
        if (et < 128) NWl[et] = nw[et];
        GDN_FETCH(pfB, 0); GDN_FETCH(pfA, 1); GDN_STORE(pfB);
        GDN_BAR();
        const int i = et >> 2, qd = et & 3;
#define GDN_LOADER_ITER(n, PF_FETCH, PF_STORE) do { \
            if ((n) == 10) STAMPT(120, 256); \
            if ((n) + 2 < 32) GDN_FETCH(PF_FETCH, (n) + 2); \
            if ((n) > 0) { \
                const LAS float* Ob = OL + (((n) - 1) & 1) * OLS + i * 132 + 32 * qd; \
                float ss = 0.f; \
                _Pragma("unroll") for (int k = 0; k < 8; ++k) { const f32x4 v_ = *(const LAS f32x4*)(Ob + 4 * k); ss += (v_.x * v_.x + v_.y * v_.y) + (v_.z * v_.z + v_.w * v_.w); } \
                ss += __shfl_xor(ss, 1); ss += __shfl_xor(ss, 2); \
                const float rs = rsqrtf(ss * (1.f / 128.f) + NORM_EPS); \
                bf16* op = OB + ((size_t)b * SEQ + ((n) - 1) * 64 + i) * 1024 + 512 + h * 128 + 32 * qd; \
                _Pragma("unroll") for (int k = 0; k < 4; ++k) { const f32x4 w0 = *(const LAS f32x4*)(NWl + 32 * qd + 8 * k), w1 = *(const LAS f32x4*)(NWl + 32 * qd + 8 * k + 4); const v4u gg = gq[k]; \
                    const f32x4 a0 = *(const LAS f32x4*)(Ob + 8 * k), a1 = *(const LAS f32x4*)(Ob + 8 * k + 4); \
                    v4u o; o.x = bfc2(a0.x * rs * w0.x * siluf(bflo(gg.x)), a0.y * rs * w0.y * siluf(bfhi(gg.x))); o.y = bfc2(a0.z * rs * w0.z * siluf(bflo(gg.y)), a0.w * rs * w0.w * siluf(bfhi(gg.y))); \
                    o.z = bfc2(a1.x * rs * w1.x * siluf(bflo(gg.z)), a1.y * rs * w1.y * siluf(bfhi(gg.z))); o.w = bfc2(a1.z * rs * w1.z * siluf(bflo(gg.w)), a1.w * rs * w1.w * siluf(bfhi(gg.w))); \
                    *(v4u*)(op + 8 * k) = o; } \
            } \
            asm volatile("" ::: "memory"); \
            if ((n) < 32) { const bf16* gp = HP + ((size_t)b * SEQ + (n) * 64 + i) * HP_LD + COL_GG + h * 128 + 32 * qd;     \
                _Pragma("unroll") for (int k = 0; k < 4; ++k) gq[k] = *(const v4u*)(gp + 8 * k); } \
            if ((n) == 10) STAMPT(121, 256); \
            GDN_BAR();            \
            if ((n) == 10) STAMPT(122, 256); \
            if ((n) + 1 < 32) GDN_STORE(PF_STORE); \
            if ((n) == 10) STAMPT(123, 256); \
            GDN_BAR();            \
            if ((n) == 10) STAMPT(124, 256); \
        } while (0)
        v4u gq[4];
#pragma unroll
        for (int k = 0; k < 4; ++k) gq[k] = (v4u){0u, 0u, 0u, 0u};
#pragma unroll
        for (int n = 0; n < 32; n += 2) {
            GDN_LOADER_ITER(n, pfB, pfA);
            GDN_LOADER_ITER(n + 1, pfA, pfB);
        }
        GDN_LOADER_ITER(32, pfB, pfA);
#undef GDN_LOADER_ITER
    }
#undef GDN_FETCH
#undef GDN_STORE
}

__device__ __forceinline__ void gdn_scan_helper(KArgs a, int bh, int tid) {
    unsigned char* ws = a->ws;
    const unsigned char* gWN = (const unsigned char*)(ws + WS_R + R_WN) + (size_t)bh * 32 * 16384; const unsigned char* gQD = (const unsigned char*)(ws + WS_R + R_QD) + (size_t)bh * 32 * 16384;
    const unsigned char* gKDT = (const unsigned char*)(ws + WS_R + R_KDT) + (size_t)bh * 32 * 16384; const unsigned char* gQK = (const unsigned char*)(ws + WS_R + R_QK) + (size_t)bh * 32 * 8192;
    const unsigned char* gU = (const unsigned char*)(ws + WS_R + R_U) + (size_t)bh * 32 * 16384;
#pragma unroll 1
    for (int n = 0; n < 32; ++n) {
        v4u pf[9];
#pragma unroll
        for (int k = 0; k < 9; ++k) { const int kk = 2 * k + (tid >> 8), et = tid & 255;
            const unsigned char* src_ = kk < 4 ? gWN + (size_t)n * 16384 + kk * 4096 : kk < 8 ? gQD + (size_t)n * 16384 + (kk - 4) * 4096 :
                kk < 12 ? gKDT + (size_t)n * 16384 + (kk - 8) * 4096 : kk < 14 ? gQK + (size_t)n * 8192 + (kk - 12) * 4096 : gU + (size_t)n * 16384 + (kk - 14) * 4096;
            pf[k] = *(const v4u*)(src_ + et * 16); }
#pragma unroll
        for (int k = 0; k < 9; ++k) asm volatile("" :: "v"(pf[k]));
    }
}

__device__ __forceinline__ void gdn_scan_v3(KArgs a, int l, int bhq, LAS unsigned char* lds, int tid, int lane, int wave) {
    unsigned char* ws = a->ws;
    constexpr int FB_WN = 0, FB_QD = 16384, FB_KDT = 32768, FB_QK = 49152, FB_U = 57344, IMG = 61440;
    constexpr int OLS = 64 * 36;
    LAS float* OL = (LAS float*)(lds + 2 * IMG);
    const int bh = bhq >> 2, q = bhq & 3, h = bh & 3, b = bh >> 2, c = lane & 31, hh = lane >> 5;
    bf16* OB = (bf16*)(ws + WS_R + R_OB); float* SSQ = (float*)(ws + WS_SSQ);
    const unsigned char* gWN = (const unsigned char*)(ws + WS_R + R_WN) + (size_t)bh * 32 * 16384; const unsigned char* gQD = (const unsigned char*)(ws + WS_R + R_QD) + (size_t)bh * 32 * 16384;
    const unsigned char* gKDT = (const unsigned char*)(ws + WS_R + R_KDT) + (size_t)bh * 32 * 16384; const unsigned char* gQK = (const unsigned char*)(ws + WS_R + R_QK) + (size_t)bh * 32 * 8192;
    const unsigned char* gU = (const unsigned char*)(ws + WS_R + R_U) + (size_t)bh * 32 * 16384 + q * 4096;
    const int et = tid - 256;
#define G3_FETCH(pf, nn) do { _Pragma("unroll") for (int k = 0; k < 15; ++k) { const unsigned char* src_ = k < 4 ? gWN + (size_t)(nn) * 16384 + k * 4096 : k < 8 ? gQD + (size_t)(nn) * 16384 + (k - 4) * 4096 : \
        k < 12 ? gKDT + (size_t)(nn) * 16384 + (k - 8) * 4096 : k < 14 ? gQK + (size_t)(nn) * 8192 + (k - 12) * 4096 : gU + (size_t)(nn) * 16384; pf[k] = *(const v4u*)(src_ + et * 16); } } while (0)
#define G3_STORE(pf, buf) do { _Pragma("unroll") for (int k = 0; k < 15; ++k) *(LAS v4u*)(lds + (buf) * IMG + k * 4096 + et * 16) = pf[k]; } while (0)
    __syncthreads();
    if (wave == 0) {
        f32x16 S[4];
#pragma unroll
        for (int t = 0; t < 4; ++t)
#pragma unroll
            for (int i = 0; i < 16; ++i) S[t][i] = 0.f;
        GDN_BAR();
#pragma unroll 1
        for (int n = 0; n < 32; ++n) {
            const LAS unsigned char* img = lds + (n & 1) * IMG;
            const LAS bf16x8* WNf = (const LAS bf16x8*)(img + FB_WN) + lane; const LAS bf16x8* QDf = (const LAS bf16x8*)(img + FB_QD) + lane;
            const LAS bf16x8* KDTf = (const LAS bf16x8*)(img + FB_KDT) + lane; const LAS bf16x8* QKf = (const LAS bf16x8*)(img + FB_QK) + lane;
            const LAS v4u* Uf = (const LAS v4u*)(img + FB_U) + lane;
            const float cd = ((const float*)(ws + WS_CD))[bh * 32 + n];
            bf16x8 A0[8], A1[8];
#define G3_LD_MTS(A, F, g) do { _Pragma("unroll") for (int k = 0; k < 8; ++k) { const int m_ = k & 1, s_ = (k >> 1) & 1, t_ = 2 * (g) + (k >> 2); A[k] = F[((m_ * 4 + t_) * 2 + s_) * 64]; } } while (0)
#define G3_LD_TMS(A, F, g) do { _Pragma("unroll") for (int k = 0; k < 8; ++k) { const int s_ = k & 1, m_ = (k >> 1) & 1, t_ = 2 * (g) + (k >> 2); A[k] = F[((t_ * 2 + m_) * 2 + s_) * 64]; } } while (0)
            G3_LD_MTS(A0, WNf, 0); G3_LD_MTS(A1, WNf, 1);
            f32x16 av[2];
#pragma unroll
            for (int m = 0; m < 2; ++m)
#pragma unroll
                for (int hf = 0; hf < 2; ++hf) { const v4u u4 = Uf[(m * 2 + hf) * 64];
#pragma unroll
                    for (int k = 0; k < 4; ++k) { av[m][8 * hf + 2 * k] = bflo(u4[k]); av[m][8 * hf + 2 * k + 1] = bfhi(u4[k]); } }
            bf16x8 Sb[4][2];
#pragma unroll
            for (int t = 0; t < 4; ++t) { Sb[t][0] = pack8(S[t], 0); Sb[t][1] = pack8(S[t], 1); }
#pragma unroll
            for (int k = 0; k < 8; ++k) { const int m_ = k & 1, s_ = (k >> 1) & 1, t_ = (k >> 2); av[m_] = MFMA32(A0[k], Sb[t_][s_], av[m_]); }
            G3_LD_MTS(A0, QDf, 0);
#pragma unroll
            for (int k = 0; k < 8; ++k) { const int m_ = k & 1, s_ = (k >> 1) & 1, t_ = 2 + (k >> 2); av[m_] = MFMA32(A1[k], Sb[t_][s_], av[m_]); }
            G3_LD_MTS(A1, QDf, 1);
            f32x16 ao[2];
#pragma unroll
            for (int m = 0; m < 2; ++m)
#pragma unroll
                for (int i = 0; i < 16; ++i) ao[m][i] = 0.f;
#pragma unroll
            for (int k = 0; k < 8; ++k) { const int m_ = k & 1, s_ = (k >> 1) & 1, t_ = (k >> 2); ao[m_] = MFMA32(A0[k], Sb[t_][s_], ao[m_]); }
#pragma unroll
            for (int k = 0; k < 6; ++k) { const int s_ = k & 1, m_ = k >= 2 ? 1 : 0, mp_ = k >= 4 ? 1 : 0; A0[k] = QKf[((m_ * 2 + mp_) * 2 + s_) * 64]; }
#pragma unroll
            for (int k = 0; k < 8; ++k) { const int m_ = k & 1, s_ = (k >> 1) & 1, t_ = 2 + (k >> 2); ao[m_] = MFMA32(A1[k], Sb[t_][s_], ao[m_]); }
            G3_LD_TMS(A1, KDTf, 0);
            bf16x8 Vb[2][2];
#pragma unroll
            for (int m = 0; m < 2; ++m) { Vb[m][0] = pack8(av[m], 0); Vb[m][1] = pack8(av[m], 1); }
#pragma unroll
            for (int k = 0; k < 6; ++k) { const int s_ = k & 1, m_ = k >= 2 ? 1 : 0, mp_ = k >= 4 ? 1 : 0; ao[m_] = MFMA32(A0[k], Vb[mp_][s_], ao[m_]); }
            G3_LD_TMS(A0, KDTf, 1);
            {   LAS float* Ob = OL + (n & 1) * OLS + c;
#pragma unroll
                for (int m = 0; m < 2; ++m)
#pragma unroll
                    for (int i = 0; i < 16; ++i) Ob[(32 * m + (i & 3) + 8 * (i >> 2) + 4 * hh) * 36] = ao[m][i]; }
#pragma unroll
            for (int t = 0; t < 4; ++t)
#pragma unroll
                for (int i = 0; i < 16; ++i) S[t][i] *= cd;
#pragma unroll
            for (int k = 0; k < 8; ++k) { const int s_ = k & 1, m_ = (k >> 1) & 1, t_ = (k >> 2); S[t_] = MFMA32(A1[k], Vb[m_][s_], S[t_]); }
#pragma unroll
            for (int k = 0; k < 8; ++k) { const int s_ = k & 1, m_ = (k >> 1) & 1, t_ = 2 + (k >> 2); S[t_] = MFMA32(A0[k], Vb[m_][s_], S[t_]); }
#undef G3_LD_MTS
#undef G3_LD_TMS
            GDN_BAR();
        }
    } else if (wave >= 4) {
        v4u pfE[15], pfO[15];
        G3_FETCH(pfE, 0); G3_FETCH(pfO, 1); G3_STORE(pfE, 0);
        GDN_BAR();
        const int i = et >> 2, p = et & 3;
#define G3_OUT(m) do { const LAS float* Ob = OL + ((m) & 1) * OLS + i * 36 + 8 * p; const f32x4 o0 = *(const LAS f32x4*)Ob, o1 = *(const LAS f32x4*)(Ob + 4); \
            float ss = (o0.x * o0.x + o0.y * o0.y) + (o0.z * o0.z + o0.w * o0.w) + (o1.x * o1.x + o1.y * o1.y) + (o1.z * o1.z + o1.w * o1.w); \
            ss += __shfl_xor(ss, 1); ss += __shfl_xor(ss, 2); \
            const size_t t_ = (size_t)b * SEQ + (m) * 64 + i; \
            v4u w_; w_.x = bfc2(o0.x, o0.y); w_.y = bfc2(o0.z, o0.w); w_.z = bfc2(o1.x, o1.y); w_.w = bfc2(o1.z, o1.w); \
            *(v4u*)(OB + t_ * 1024 + 512 + h * 128 + 32 * q + 8 * p) = w_; \
            if (p == 0) SSQ[(t_ * 4 + h) * 4 + q] = ss; } while (0)
#define G3_LOADER_ITER(n, PF_FETCH, PF_STORE) do { \
            if ((n) + 2 < 32) G3_FETCH(PF_FETCH, (n) + 2); \
            if ((n) > 0) G3_OUT((n) - 1); \
            if ((n) + 1 < 32) G3_STORE(PF_STORE, ((n) + 1) & 1); \
            GDN_BAR(); \
        } while (0)
#pragma unroll
        for (int n = 0; n < 32; n += 2) {
            G3_LOADER_ITER(n, pfE, pfO);
            G3_LOADER_ITER(n + 1, pfO, pfE);
        }
        G3_OUT(31);
#undef G3_LOADER_ITER
#undef G3_OUT
    } else {
        GDN_BAR();
#pragma unroll 1
        for (int n = 0; n < 32; ++n) GDN_BAR();
    }
#undef G3_FETCH
#undef G3_STORE
}
__device__ __forceinline__ void gdn_finalize(KArgs a, int l, int lane, int gw, int NGW) {
    unsigned char* ws = a->ws;
    const bf16* HP = (const bf16*)(ws + WS_R + R_HP); bf16* OB = (bf16*)(ws + WS_R + R_OB); const float* SSQ = (const float*)(ws + WS_SSQ);
    const int hd = lane >> 4, cb = (lane & 15) * 8;
    const float* nw = a->in[5] + l * 128 + cb;
    const f32x4 w0 = *(const f32x4*)nw, w1 = *(const f32x4*)(nw + 4);
    for (int t0 = gw * 4; t0 < M; t0 += NGW * 4) {
        v4u raw[4], gg[4]; f32x4 sq[4];
#pragma unroll
        for (int k = 0; k < 4; ++k) { const size_t t = (size_t)t0 + k; raw[k] = *(const v4u*)(OB + t * 1024 + 512 + hd * 128 + cb); gg[k] = *(const v4u*)(HP + t * HP_LD + COL_GG + hd * 128 + cb); sq[k] = *(const f32x4*)(SSQ + (t * 4 + hd) * 4); }
#pragma unroll
        for (int k = 0; k < 4; ++k) { const size_t t = (size_t)t0 + k; const float rs = rsqrtf(((sq[k].x + sq[k].y) + (sq[k].z + sq[k].w)) * (1.f / 128.f) + NORM_EPS);
            v4u o; o.x = bfc2(bflo(raw[k].x) * rs * w0.x * siluf(bflo(gg[k].x)), bfhi(raw[k].x) * rs * w0.y * siluf(bfhi(gg[k].x))); o.y = bfc2(bflo(raw[k].y) * rs * w0.z * siluf(bflo(gg[k].y)), bfhi(raw[k].y) * rs * w0.w * siluf(bfhi(gg[k].y)));
            o.z = bfc2(bflo(raw[k].z) * rs * w1.x * siluf(bflo(gg[k].z)), bfhi(raw[k].z) * rs * w1.y * siluf(bfhi(gg[k].z))); o.w = bfc2(bflo(raw[k].w) * rs * w1.z * siluf(bflo(gg[k].w)), bfhi(raw[k].w) * rs * w1.w * siluf(bfhi(gg[k].w)));
            *(v4u*)(OB + t * 1024 + 512 + hd * 128 + cb) = o; }
    }
}

struct RetLds {
    static constexpr int QS = 72, JS = 136;
    static constexpr int P = 0, Q1 = 34816, K1 = 53248, OL = 0, K1T = 71680, VT = 89088, ST = 123904;
};
template <bool WANT_Q, bool WANT_K1, bool WANT_K1T>
__device__ __forceinline__ void ret_stage(const bf16* HP, const float* RT, int b, int h, int n, float lg, LAS unsigned char* lds, int tid) {
    constexpr int QS = RetLds::QS, JS = RetLds::JS;
    LAS bf16* Q1 = (LAS bf16*)(lds + RetLds::Q1); LAS bf16* K1 = (LAS bf16*)(lds + RetLds::K1); LAS bf16* K1T = (LAS bf16*)(lds + RetLds::K1T); LAS bf16* VT = (LAS bf16*)(lds + RetLds::VT);
    const int i = tid >> 2, dd = (tid & 3) * 8, pos = n * 128 + i; const size_t t = (size_t)b * SEQ + pos;
    const bf16* hp = HP + t * HP_LD;
    const f32x4 c0 = *(const f32x4*)(RT + pos * 64 + dd), c1 = *(const f32x4*)(RT + pos * 64 + dd + 4), s0 = *(const f32x4*)(RT + pos * 64 + 32 + dd), s1 = *(const f32x4*)(RT + pos * 64 + 32 + dd + 4);
    const float cs[8] = {c0.x, c0.y, c0.z, c0.w, c1.x, c1.y, c1.z, c1.w}, sn[8] = {s0.x, s0.y, s0.z, s0.w, s1.x, s1.y, s1.z, s1.w};
    const float sq = exp2f((float)i * lg), sk = 0.125f * exp2f(-(float)i * lg);
    v4u xv[4];
#pragma unroll
    for (int p = 0; p < 4; ++p) { const int idx = tid + 512 * p, j = idx >> 4, e0 = (idx & 15) * 8; xv[p] = *(const v4u*)(HP + ((size_t)b * SEQ + n * 128 + j) * HP_LD + COL_RV + h * 128 + e0); }
#pragma unroll
    for (int which = (WANT_Q ? 0 : 1); which < 2; ++which) {
        const bf16* src = hp + (which == 0 ? COL_RQ : COL_RK) + h * 64 + dd;
        const v4u x1 = *(const v4u*)src, x2 = *(const v4u*)(src + 32);
        const float sc = which == 0 ? sq : sk;
        float lo[8], hi[8];
#pragma unroll
        for (int k = 0; k < 4; ++k) { const float a0 = bflo(x1[k]), a1 = bfhi(x1[k]), b0 = bflo(x2[k]), b1 = bfhi(x2[k]);
            lo[2 * k] = (a0 * cs[2 * k] - b0 * sn[2 * k]) * sc; lo[2 * k + 1] = (a1 * cs[2 * k + 1] - b1 * sn[2 * k + 1]) * sc;
            hi[2 * k] = (a0 * sn[2 * k] + b0 * cs[2 * k]) * sc; hi[2 * k + 1] = (a1 * sn[2 * k + 1] + b1 * cs[2 * k + 1]) * sc; }
        v4u wl, wh;
#pragma unroll
        for (int k = 0; k < 4; ++k) { wl[k] = bfc2(lo[2 * k], lo[2 * k + 1]); wh[k] = bfc2(hi[2 * k], hi[2 * k + 1]); }
        if (which == 0 || WANT_K1) { LAS bf16* dst = (which == 0 ? Q1 : K1) + i * QS + dd; *(LAS v4u*)dst = wl; *(LAS v4u*)(dst + 32) = wh; }
        if (which == 1 && WANT_K1T) {
#pragma unroll
            for (int k = 0; k < 4; ++k) { K1T[(dd + 2 * k) * JS + i] = (bf16)(wl[k] & 0xffffu); K1T[(dd + 2 * k + 1) * JS + i] = (bf16)(wl[k] >> 16);
                K1T[(32 + dd + 2 * k) * JS + i] = (bf16)(wh[k] & 0xffffu); K1T[(32 + dd + 2 * k + 1) * JS + i] = (bf16)(wh[k] >> 16); }
        }
    }
#pragma unroll
    for (int p = 0; p < 4; ++p) { const int idx = tid + 512 * p, j = idx >> 4, e0 = (idx & 15) * 8;
#pragma unroll
        for (int k = 0; k < 4; ++k) { VT[(e0 + 2 * k) * JS + j] = (bf16)(xv[p][k] & 0xffffu); VT[(e0 + 2 * k + 1) * JS + j] = (bf16)(xv[p][k] >> 16); } }
}
__device__ __forceinline__ void ret_kv_unit(KArgs a, int unit, LAS unsigned char* lds, int tid, int lane, int wave) {
    unsigned char* ws = a->ws;
    constexpr int JS = RetLds::JS;
    const int n = unit & 15, bh = unit >> 4, h = bh & 3, b = bh >> 2, c = lane & 31, hh = lane >> 5;
    const bf16* HP = (const bf16*)(ws + WS_R + R_HP); const float* RT = (const float*)(ws + WS_ROPE);
    const float gam = 1.0f - exp2f(-5.0f - (float)h), lg = log2f(gam), g127 = exp2f(127.f * lg);
    LAS bf16* K1T = (LAS bf16*)(lds + RetLds::K1T); LAS bf16* VT = (LAS bf16*)(lds + RetLds::VT);
    __syncthreads();
    ret_stage<false, false, true>(HP, RT, b, h, n, lg, lds, tid);
    __syncthreads();
    const int td = wave >> 2, te = wave & 3;
    f32x16 kv;
#pragma unroll
    for (int i = 0; i < 16; ++i) kv[i] = 0.f;
#pragma unroll
    for (int ks = 0; ks < 8; ++ks) kv = MFMA32(*(const LAS bf16x8*)(K1T + (32 * td + c) * JS + 16 * ks + 8 * hh), *(const LAS bf16x8*)(VT + (32 * te + c) * JS + 16 * ks + 8 * hh), kv);
    float* dst = (float*)(ws + WS_KV) + ((size_t)(unit * 8 + wave) * 64 + lane) * 16;
#pragma unroll
    for (int g = 0; g < 4; ++g) *(f32x4*)(dst + 4 * g) = (f32x4){kv[4 * g] * g127, kv[4 * g + 1] * g127, kv[4 * g + 2] * g127, kv[4 * g + 3] * g127};
}
__device__ __forceinline__ void ret_out_unit(KArgs a, int unit, LAS unsigned char* lds, int tid, int lane, int wave) {
    unsigned char* ws = a->ws;
    constexpr int QS = RetLds::QS, JS = RetLds::JS;
    LAS bf16* P = (LAS bf16*)(lds + RetLds::P); LAS bf16* Q1 = (LAS bf16*)(lds + RetLds::Q1); LAS bf16* K1 = (LAS bf16*)(lds + RetLds::K1); LAS float* OL = (LAS float*)(lds + RetLds::OL);
    LAS bf16* VT = (LAS bf16*)(lds + RetLds::VT); LAS bf16* ST = (LAS bf16*)(lds + RetLds::ST);
    const int n = unit & 15, bh = unit >> 4, h = bh & 3, b = bh >> 2, c = lane & 31, hh = lane >> 5;
    const bf16* HP = (const bf16*)(ws + WS_R + R_HP); bf16* OB = (bf16*)(ws + WS_R + R_OB); const float* RT = (const float*)(ws + WS_ROPE);
    const float gam = 1.0f - exp2f(-5.0f - (float)h), lg = log2f(gam), g128 = exp2f(128.f * lg);
    __syncthreads();
    const int ei = tid >> 2, eq = tid & 3; const size_t et = (size_t)b * SEQ + n * 128 + ei;
    v4u gg[4];
    { const bf16* gp = HP + et * HP_LD + COL_RG + h * 128 + 32 * eq;
#pragma unroll
      for (int k = 0; k < 4; ++k) gg[k] = *(const v4u*)(gp + 8 * k); }
    {
        const int td = wave >> 2, te = wave & 3;
        f32x16 S;
#pragma unroll
        for (int i = 0; i < 16; ++i) S[i] = 0.f;
        const float* src = (const float*)(ws + WS_KV) + ((size_t)((bh * 16) * 8 + wave) * 64 + lane) * 16;
#pragma unroll 2
        for (int m = 0; m < n; ++m) { const f32x4* p4 = (const f32x4*)(src + (size_t)m * 8 * 64 * 16);
#pragma unroll
            for (int g = 0; g < 4; ++g) { const f32x4 v = p4[g]; S[4 * g] = S[4 * g] * g128 + v.x; S[4 * g + 1] = S[4 * g + 1] * g128 + v.y; S[4 * g + 2] = S[4 * g + 2] * g128 + v.z; S[4 * g + 3] = S[4 * g + 3] * g128 + v.w; } }
#pragma unroll
        for (int g = 0; g < 4; ++g) { v2u w; w.x = bfc2(S[4 * g], S[4 * g + 1]); w.y = bfc2(S[4 * g + 2], S[4 * g + 3]); *(LAS v2u*)(ST + (32 * te + c) * QS + 32 * td + 8 * g + 4 * hh) = w; }
    }
    ret_stage<true, true, false>(HP, RT, b, h, n, lg, lds, tid);
    __syncthreads();
#pragma unroll 1
    for (int rep = 0; rep < 2; ++rep) { const int idx = wave + 8 * rep;
        if (idx < 10) { const int ti = (idx >= 1) + (idx >= 3) + (idx >= 6), tj = idx - ti * (ti + 1) / 2;
            f32x16 acc;
#pragma unroll
            for (int i = 0; i < 16; ++i) acc[i] = 0.f;
#pragma unroll
            for (int s2 = 0; s2 < 4; ++s2) acc = MFMA32(*(const LAS bf16x8*)(Q1 + (32 * ti + c) * QS + 16 * s2 + 8 * hh), *(const LAS bf16x8*)(K1 + (32 * tj + c) * QS + 16 * s2 + 8 * hh), acc);
#pragma unroll
            for (int i = 0; i < 16; ++i) { const int il = (i & 3) + 8 * (i >> 2) + 4 * hh; float v = acc[i]; if (ti == tj && il < c) v = 0.f; P[(32 * ti + il) * JS + 32 * tj + c] = bfc(v); } } }
    __syncthreads();
    const int ti = wave >> 1, te0 = 2 * (wave & 1);
    f32x16 ao[2];
#pragma unroll
    for (int u = 0; u < 2; ++u)
#pragma unroll
        for (int i = 0; i < 16; ++i) ao[u][i] = 0.f;
#pragma unroll
    for (int s2 = 0; s2 < 4; ++s2) { const bf16x8 A = *(const LAS bf16x8*)(Q1 + (32 * ti + c) * QS + 16 * s2 + 8 * hh);
#pragma unroll
        for (int u = 0; u < 2; ++u) ao[u] = MFMA32(A, *(const LAS bf16x8*)(ST + (32 * (te0 + u) + c) * QS + 16 * s2 + 8 * hh), ao[u]); }
#pragma unroll
    for (int u = 0; u < 2; ++u)
#pragma unroll
        for (int i = 0; i < 16; ++i) ao[u][i] *= gam;
#pragma unroll 1
    for (int tj = 0; tj <= ti; ++tj)
#pragma unroll
        for (int s2 = 0; s2 < 2; ++s2) { const bf16x8 A = *(const LAS bf16x8*)(P + (32 * ti + c) * JS + 32 * tj + 16 * s2 + 8 * hh);
#pragma unroll
            for (int u = 0; u < 2; ++u) ao[u] = MFMA32(A, *(const LAS bf16x8*)(VT + (32 * (te0 + u) + c) * JS + 32 * tj + 16 * s2 + 8 * hh), ao[u]); }
    __syncthreads();
#pragma unroll
    for (int u = 0; u < 2; ++u)
#pragma unroll
        for (int i = 0; i < 16; ++i) OL[(32 * ti + (i & 3) + 8 * (i >> 2) + 4 * hh) * 132 + 32 * (te0 + u) + c] = ao[u][i];
    __syncthreads();
    {
        const LAS float* Ob = OL + ei * 132 + 32 * eq; bf16* op = OB + et * 1024 + h * 128 + 32 * eq;
        f32x4 v[8]; float sm = 0.f;
#pragma unroll
        for (int k = 0; k < 8; ++k) { v[k] = *(const LAS f32x4*)(Ob + 4 * k); sm += (v[k].x + v[k].y) + (v[k].z + v[k].w); }
        sm += __shfl_xor(sm, 1); sm += __shfl_xor(sm, 2);
        const float mean = sm * (1.f / 128.f); float sq = 0.f;
#pragma unroll
        for (int k = 0; k < 8; ++k) { v[k] = v[k] - mean; sq += (v[k].x * v[k].x + v[k].y * v[k].y) + (v[k].z * v[k].z + v[k].w * v[k].w); }
        sq += __shfl_xor(sq, 1); sq += __shfl_xor(sq, 2);
        const float rs = rsqrtf(sq * (1.f / 128.f) + LN_EPS);
#pragma unroll
        for (int k = 0; k < 4; ++k) { const v4u g4 = gg[k]; const f32x4 a0 = v[2 * k], a1 = v[2 * k + 1];
            v4u o; o.x = bfc2(a0.x * rs * siluf(bflo(g4.x)), a0.y * rs * siluf(bfhi(g4.x))); o.y = bfc2(a0.z * rs * siluf(bflo(g4.y)), a0.w * rs * siluf(bfhi(g4.y)));
            o.z = bfc2(a1.x * rs * siluf(bflo(g4.z)), a1.y * rs * siluf(bfhi(g4.z))); o.w = bfc2(a1.z * rs * siluf(bflo(g4.w)), a1.w * rs * siluf(bfhi(g4.w)));
            *(v4u*)(op + 8 * k) = o; }
    }
}

__device__ __forceinline__ float sum16(float v) {
    v += __builtin_bit_cast(float, __builtin_amdgcn_update_dpp(0, __builtin_bit_cast(int, v), 0xB1, 0xF, 0xF, true));
    v += __builtin_bit_cast(float, __builtin_amdgcn_update_dpp(0, __builtin_bit_cast(int, v), 0x4E, 0xF, 0xF, true));
    v += __builtin_bit_cast(float, __builtin_amdgcn_update_dpp(0, __builtin_bit_cast(int, v), 0x141, 0xF, 0xF, true));
    v += __builtin_bit_cast(float, __builtin_amdgcn_update_dpp(0, __builtin_bit_cast(int, v), 0x140, 0xF, 0xF, true));
    return v;
}
__device__ __forceinline__ void gdn_prep_fast(KArgs a, int l, int unit, LAS unsigned char* lds, int tid, int lane, int wave) {
    asm volatile("" : "+v"(tid)); lane = tid & 63; wave = __builtin_amdgcn_readfirstlane(tid >> 6);
    unsigned char* ws = a->ws;
    constexpr int KS = 136;
    LAS bf16* Kb = (LAS bf16*)lds;
    LAS bf16* Qb = (LAS bf16*)(lds + 17408);
    LAS float* A = (LAS float*)(lds + 34816);
    LAS float* V = (LAS float*)(lds + 51200);
    LAS float* KW = (LAS float*)(lds + 83968);
    LAS float* gc = (LAS float*)(lds + 116736);
    LAS float* bt = gc + 64;
    LAS bf16* KDs = (LAS bf16*)(lds + 117248);
    LAS bf16* XT = (LAS bf16*)lds;
    LAS bf16* A10b = (LAS bf16*)(lds + 135680);
    const int n = unit & 31, bh = unit >> 5, h = bh & 3, b = bh >> 2, t0 = b * SEQ + n * 64, c = lane & 31, hh = lane >> 5;
    const bf16* HP = (const bf16*)(ws + WS_R + R_HP);
    bf16* QKg = (bf16*)(ws + WS_R + R_QK) + (size_t)unit * 4096; bf16* QDg = (bf16*)(ws + WS_R + R_QD) + (size_t)unit * 8192; bf16* KDTg = (bf16*)(ws + WS_R + R_KDT) + (size_t)unit * 8192;
    bf16* WNg = (bf16*)(ws + WS_R + R_WN) + (size_t)unit * 8192; bf16* Ug = (bf16*)(ws + WS_R + R_U) + (size_t)unit * 8192;
    __syncthreads(); if (unit == PROBE_UNIT) STAMPT(130, 0);
    if (wave == 0) {
        const float* gab = (const float*)(ws + WS_GAB) + (size_t)(t0 + lane) * 8; const float x = gab[h] + a->in[4][l * 4 + h];
        const float sp = fmaxf(x, 0.f) + log1pf(__expf(-fabsf(x))); float g = -__expf(a->in[3][l * 4 + h]) * sp;
#pragma unroll
        for (int o = 1; o < 64; o <<= 1) { const float up = __shfl_up(g, o); if (lane >= o) g += up; }
        gc[lane] = g; bt[lane] = sigmf(gab[4 + h]);
        if (lane == 63) ((float*)(ws + WS_CD))[unit] = __expf(g);
    }
    __syncthreads(); if (unit == PROBE_UNIT) STAMPT(131, 0);
#ifndef PREP_NO_CONV
    if (wave < 6) {
        const int which = wave >> 1, tp = tid & 127, rb = tp >> 4, dd = (tp & 15) * 8, col = COL_GQ + which * 512 + h * 128 + dd, cc = which * 512 + h * 128 + dd;
        const float* cw = a->in[2] + (size_t)l * 4 * 1536 + cc;
        float w[4][8];
#pragma unroll
        for (int j = 0; j < 4; ++j) { const f32x4 w0 = *(const f32x4*)(cw + j * 1536), w1 = *(const f32x4*)(cw + j * 1536 + 4); w[j][0] = w0.x; w[j][1] = w0.y; w[j][2] = w0.z; w[j][3] = w0.w; w[j][4] = w1.x; w[j][5] = w1.y; w[j][6] = w1.z; w[j][7] = w1.w; }
        const int sbase = n * 64 + 8 * rb - 3;
        const bf16* hpc = HP + (size_t)(b * SEQ) * HP_LD + col;
        v4u raw[11];
#pragma unroll
        for (int r = 0; r < 11; ++r) { raw[r] = (v4u){0u, 0u, 0u, 0u}; if (sbase + r >= 0) raw[r] = *(const v4u*)(hpc + (size_t)(sbase + r) * HP_LD); }
        const float gl = gc[63];
#pragma unroll
        for (int r = 0; r < 8; ++r) { const int i = 8 * rb + r; float y[8]; float ss = 0.f;
#pragma unroll
            for (int k4 = 0; k4 < 4; ++k4) {
                unsigned d0 = raw[r][k4], d1 = raw[r + 1][k4], d2 = raw[r + 2][k4], d3 = raw[r + 3][k4];
                asm volatile("" : "+v"(d0), "+v"(d1), "+v"(d2), "+v"(d3));
                const float a0 = w[0][2 * k4] * bflo(d0) + w[1][2 * k4] * bflo(d1) + w[2][2 * k4] * bflo(d2) + w[3][2 * k4] * bflo(d3);
                const float a1 = w[0][2 * k4 + 1] * bfhi(d0) + w[1][2 * k4 + 1] * bfhi(d1) + w[2][2 * k4 + 1] * bfhi(d2) + w[3][2 * k4 + 1] * bfhi(d3);
                y[2 * k4] = siluf(a0); y[2 * k4 + 1] = siluf(a1); ss += y[2 * k4] * y[2 * k4] + y[2 * k4 + 1] * y[2 * k4 + 1]; }
            ss = sum16(ss);
            const float gi = gc[i], bi = bt[i];
            if (which == 0) { const float f = rsqrtf(ss + NORM_EPS) * 0.08838834764831845f, eg = __expf(gi);
                v4u p, pd;
#pragma unroll
                for (int k = 0; k < 4; ++k) { p[k] = bfc2(y[2 * k] * f, y[2 * k + 1] * f); pd[k] = bfc2(y[2 * k] * f * eg, y[2 * k + 1] * f * eg); }
                *(LAS v4u*)(Qb + i * KS + dd) = p;
                bf16* qd = QDg + (((i >> 5) * 4 + (dd >> 5)) * 2 + ((dd >> 4) & 1)) * 512 + (i & 31) * 8 + ((dd >> 3) & 1) * 4;
                *(v2u*)qd = (v2u){pd[0], pd[1]}; *(v2u*)(qd + 256) = (v2u){pd[2], pd[3]};
            } else if (which == 1) { const float f = rsqrtf(ss + NORM_EPS), fw = f * bi * __expf(gi), fd = f * __expf(gl - gi);
                v4u p;
#pragma unroll
                for (int k = 0; k < 4; ++k) p[k] = bfc2(y[2 * k] * f, y[2 * k + 1] * f);
                *(LAS v4u*)(Kb + i * KS + dd) = p;
#pragma unroll
                for (int k = 0; k < 8; ++k) { KW[i * 128 + dd + k] = y[k] * fw; KDs[(dd + k) * 72 + i] = bfc(y[k] * fd); }
            } else {
#pragma unroll
                for (int k = 0; k < 8; ++k) V[i * 128 + dd + k] = y[k] * bi;
            }
        }
    }
#endif
    __syncthreads(); if (unit == PROBE_UNIT) STAMPT(132, 0);
    {
        const int ti = (wave >> 1) & 1, tj = wave & 1;
        if (wave < 4) {
            if (ti <= tj) {
                f32x16 acc;
#pragma unroll
                for (int i = 0; i < 16; ++i) acc[i] = 0.f;
#pragma unroll
                for (int s = 0; s < 8; ++s) acc = MFMA32(*(const LAS bf16x8*)(Kb + (32 * ti + c) * KS + 16 * s + 8 * hh), *(const LAS bf16x8*)(Kb + (32 * tj + c) * KS + 16 * s + 8 * hh), acc);
                const int i = 32 * tj + c; const float gi = gc[i], bi = bt[i];
#pragma unroll
                for (int r = 0; r < 16; ++r) { const int j = 32 * ti + (r & 3) + 8 * (r >> 2) + 4 * hh; const float av = (j < i) ? bi * acc[r] * __expf(gi - gc[j]) : 0.f; A[j * 64 + i] = av;
                    if (ti == 0 && tj == 1) A10b[c * 40 + j] = bfc(av); }
            } else {
#pragma unroll
                for (int r = 0; r < 16; ++r) { const int j = 32 * ti + (r & 3) + 8 * (r >> 2) + 4 * hh; A[j * 64 + 32 * tj + c] = 0.f; }
            }
        } else {
            const int kt = ti, qt = tj;
            if (kt <= qt) {
                f32x16 acc;
#pragma unroll
                for (int i = 0; i < 16; ++i) acc[i] = 0.f;
#pragma unroll
                for (int s = 0; s < 8; ++s) acc = MFMA32(*(const LAS bf16x8*)(Kb + (32 * kt + c) * KS + 16 * s + 8 * hh), *(const LAS bf16x8*)(Qb + (32 * qt + c) * KS + 16 * s + 8 * hh), acc);
                const int i = 32 * qt + c; const float gi = gc[i];
#pragma unroll
                for (int r = 0; r < 16; ++r) { const int j = 32 * kt + (r & 3) + 8 * (r >> 2) + 4 * hh; acc[r] = (j <= i) ? acc[r] * __expf(gi - gc[j]) : 0.f; }
                bf16x8* qf = (bf16x8*)QKg + lane;
                qf[((qt * 2 + kt) * 2 + 0) * 64] = pack8(acc, 0); qf[((qt * 2 + kt) * 2 + 1) * 64] = pack8(acc, 1);
            }
        }
    }
    __syncthreads(); if (unit == PROBE_UNIT) STAMPT(133, 0);
#ifndef PREP_NO_SOLVE
#define PREP_SOLVE32(B0) do { \
        _Pragma("unroll") for (int i = 0; i < 32; ++i) x[i] = rhs[((B0) + i) * 128]; \
        _Pragma("unroll") for (int m = 0; m < 31; ++m) { const float xm = x[m]; \
            _Pragma("unroll") for (int g = (m + 1) / 4; g < 8; ++g) { const f32x4 a4 = *(const LAS f32x4*)(A + ((B0) + m) * 64 + (B0) + 4 * g); \
                if (4 * g > m) x[4 * g] -= a4.x * xm; if (4 * g + 1 > m) x[4 * g + 1] -= a4.y * xm; if (4 * g + 2 > m) x[4 * g + 2] -= a4.z * xm; if (4 * g + 3 > m) x[4 * g + 3] -= a4.w * xm; } } \
        if (tl < 128) { _Pragma("unroll") for (int hx = 0; hx < 2; ++hx) _Pragma("unroll") for (int hf = 0; hf < 2; ++hf) { const int i0 = 16 * hf + 4 * hx; \
                v4u w_; w_.x = bfc2(x[i0], x[i0 + 1]); w_.y = bfc2(x[i0 + 2], x[i0 + 3]); w_.z = bfc2(x[i0 + 8], x[i0 + 9]); w_.w = bfc2(x[i0 + 10], x[i0 + 11]); *(v4u*)(Ug + uoff((B0) + i0, col)) = w_; } } \
        else { _Pragma("unroll") for (int i = 0; i < 32; ++i) Qb[((B0) + i) * KS + col] = bfc(-x[i]); } } while (0)
    int tl = tid; asm volatile("" : "+v"(tl));
    const int c2 = tl & 31, hh2 = (tl >> 5) & 1;
    if (wave < 4) {
        const int col = tl & 127; LAS float* rhs = (tl < 128 ? V : KW) + col;
        float x[32];
        PREP_SOLVE32(0);
        v4u p[4];
#pragma unroll
        for (int k = 0; k < 4; ++k) { p[k].x = bfc2(x[8 * k], x[8 * k + 1]); p[k].y = bfc2(x[8 * k + 2], x[8 * k + 3]); p[k].z = bfc2(x[8 * k + 4], x[8 * k + 5]); p[k].w = bfc2(x[8 * k + 6], x[8 * k + 7]); }
#pragma unroll
        for (int k = 0; k < 4; ++k) *(LAS v4u*)(XT + tl * 32 + 8 * k) = p[k];
    }
    __syncthreads();
    {
        f32x16 acc;
#pragma unroll
        for (int i = 0; i < 16; ++i) acc[i] = 0.f;
#pragma unroll
        for (int s2 = 0; s2 < 2; ++s2) acc = MFMA32(*(const LAS bf16x8*)(A10b + c2 * 40 + 16 * s2 + 8 * hh2), *(const LAS bf16x8*)(XT + (32 * wave + c2) * 32 + 16 * s2 + 8 * hh2), acc);
        LAS float* R1 = (wave < 4 ? V : KW) + 32 * (wave & 3) + c2;
#pragma unroll
        for (int r = 0; r < 16; ++r) { const int i = 32 + (r & 3) + 8 * (r >> 2) + 4 * hh2; R1[i * 128] -= acc[r]; }
    }
    __syncthreads();
    if (wave < 4) {
        const int col = tl & 127; LAS float* rhs = (tl < 128 ? V : KW) + col;
        float x[32];
        PREP_SOLVE32(32);
    }
#undef PREP_SOLVE32
#endif
    __syncthreads(); if (unit == PROBE_UNIT) STAMPT(134, 0);
#pragma unroll
    for (int p = 0; p < 4; ++p) { const int idx = tid + 512 * p, i = idx >> 5, d = (idx & 31) * 4;
        *(v2u*)(WNg + fragoff(i, d, 4)) = *(const LAS v2u*)(Qb + i * KS + d); }
#pragma unroll
    for (int p = 0; p < 4; ++p) { const int idx = tid + 512 * p, d = idx >> 4, i = (idx & 15) * 4;
        *(v2u*)(KDTg + fragoff(d, i, 2)) = *(const LAS v2u*)(KDs + d * 72 + i); }
    if (unit == PROBE_UNIT) STAMPT(135, 0);
}
#define XB_TMO      128
#define XB_XCNT(j)  (256  + 64 * (j))
#define XB_XSUB(j)  (1280 + 64 * (j))
#define XB_XGEN(j)  (2304 + 64 * (j))
#define XB_TOP      3328
#define XB_TOPGEN   3392
#define XCD_BAR_WORDS 3456
#define XB_SPIN_CAP (1u << 18)

__device__ __forceinline__ unsigned xb_ld(unsigned* p)              { return __hip_atomic_load(p, __ATOMIC_RELAXED, __HIP_MEMORY_SCOPE_AGENT); }
__device__ __forceinline__ unsigned xb_add(unsigned* p, unsigned v) { return __hip_atomic_fetch_add(p, v, __ATOMIC_RELAXED, __HIP_MEMORY_SCOPE_AGENT); }
__device__ __forceinline__ unsigned xb_xcc_id() { return (unsigned)__builtin_amdgcn_s_getreg((3 << 11) | 20) & 0xFu; }
#define XB_SPIN(cond, bar) do { unsigned _sp = 0; while (cond) { __builtin_amdgcn_s_sleep(1); \
    if ((++_sp & 255u) == 0u) { if (xb_ld(&(bar)[XB_TMO])) break; if (_sp > XB_SPIN_CAP) { atomicAdd(&(bar)[XB_TMO], 1u); break; } } } } while (0)

struct XcdBarrier {
    unsigned* bar; unsigned x;
    volatile LAS unsigned* st;
};

__device__ __forceinline__ XcdBarrier xcd_barrier_post(unsigned* bar, volatile LAS unsigned* st) {
    XcdBarrier b; b.bar = bar; b.x = xb_xcc_id(); b.st = st;
    if (threadIdx.x == 0) (void)xb_add(&bar[XB_XCNT(b.x)], 1u);
    return b;
}
__device__ __forceinline__ void xcd_barrier_complete(unsigned* bar, unsigned x, unsigned& nloc, unsigned& nx) {
    const unsigned G = gridDim.x * gridDim.y * gridDim.z;
    unsigned sum, cnt, mine, sp = 0u;
    for (;;) {
        sum = 0u; cnt = 0u; mine = 0u;
#pragma unroll
        for (unsigned j = 0; j < 16; ++j) { const unsigned c = xb_ld(&bar[XB_XCNT(j)]); sum += c; cnt += (c > 0u) ? 1u : 0u; mine = (j == x) ? c : mine; }
        if (sum == G) break;
        __builtin_amdgcn_s_sleep(1);
        if ((++sp & 255u) == 0u) { if (xb_ld(&bar[XB_TMO])) break; if (sp > XB_SPIN_CAP) { atomicAdd(&bar[XB_TMO], 1u); break; } }
    }
    nloc = mine > 0u ? mine : 1u; nx = cnt > 0u ? cnt : 1u;
}

__device__ __forceinline__ void xcd_barrier(const XcdBarrier& b) {
    asm volatile("s_waitcnt vmcnt(0)" ::: "memory");
    __syncthreads();
    if (threadIdx.x == 0) {
        unsigned* bar = b.bar;
        __builtin_amdgcn_s_waitcnt(0);
        unsigned nloc = b.st[0], nx = b.st[1];
        if (nloc == 0u) { xcd_barrier_complete(bar, b.x, nloc, nx); b.st[0] = nloc; b.st[1] = nx; }
        const unsigned old = xb_add(&bar[XB_XSUB(b.x)], 1u);
        const unsigned gen = old / nloc;
        if (old + 1u == (gen + 1u) * nloc) {
            __builtin_amdgcn_fence(__ATOMIC_RELEASE, "agent");
            asm volatile("s_waitcnt vmcnt(0)" ::: "memory");
            const unsigned og = xb_add(&bar[XB_TOP], 1u);
            const unsigned tg = og / nx;
            if (og + 1u == (tg + 1u) * nx) xb_add(&bar[XB_TOPGEN], 1u);
            else XB_SPIN(xb_ld(&bar[XB_TOPGEN]) == tg, bar);
            __builtin_amdgcn_fence(__ATOMIC_ACQUIRE, "agent");
            xb_add(&bar[XB_XGEN(b.x)], 1u);
            asm volatile("s_waitcnt vmcnt(0)" ::: "memory");
        } else {
            XB_SPIN(xb_ld(&bar[XB_XGEN(b.x)]) == gen, bar);
            __builtin_amdgcn_fence(__ATOMIC_ACQUIRE, "agent");
            asm volatile("s_waitcnt vmcnt(0)" ::: "memory");
        }
    }
    __syncthreads();
}
#ifndef REP_PRO
#define REP_PRO 1
#endif
#ifndef REP_IN
#define REP_IN 1
#endif
#ifndef REP_PREP
#define REP_PREP 1
#endif
#ifndef REP_SCAN
#define REP_SCAN 1
#endif
#ifndef REP_OUT
#define REP_OUT 1
#endif
#ifndef REP_GU
#define REP_GU 1
#endif
#ifndef REP_DN
#define REP_DN 1
#endif
#ifndef REP_MGU
#define REP_MGU 1
#endif
#ifndef REP_GDN
#define REP_GDN 1
#endif
#ifndef REP_RET
#define REP_RET 1
#endif
#ifndef KV_IN_SCAN
#define KV_IN_SCAN 1
#endif
#ifndef GDN_HELPERS
#define GDN_HELPERS 0
#endif
#ifndef GDN_SPLIT
#define GDN_SPLIT 0
#endif
#ifndef FAST_SCAN
#define FAST_SCAN 1
#endif
#ifndef FAST_RET
#define FAST_RET 1
#endif
#ifndef FAST_PREP
#define FAST_PREP 1
#endif
#ifndef EN_PRO
#define EN_PRO 1
#endif
#ifndef EN_IN
#define EN_IN 1
#endif
#ifndef EN_PREP
#define EN_PREP 1
#endif
#ifndef EN_SCAN
#define EN_SCAN 1
#endif
#ifndef EN_OUT
#define EN_OUT 1
#endif
#ifndef EN_LN1
#define EN_LN1 1
#endif
#ifndef EN_FFN0
#define EN_FFN0 1
#endif
#ifndef EN_MOE
#define EN_MOE 1
#endif

#ifndef PROBE_MULT
#define PROBE_MULT 0
#endif
#ifndef PROBE_BID
#define PROBE_BID 0
#endif
#ifndef PROBE_A
#define PROBE_A 0
#endif
#ifndef PROBE_B
#define PROBE_B 0
#endif
#if PROBE_MULT > 0
#define STAMP(id) do { if (blockIdx.x == PROBE_BID && threadIdx.x == 0) __hip_atomic_store((unsigned long long*)(kargs()->ws + WS_CTL + 131072) + (id), (unsigned long long)__builtin_amdgcn_s_memrealtime(), RLX_AGENT); } while (0)
#else
#define STAMP(id) do {} while (0)
#endif
__global__ void __launch_bounds__(NWAVES * 64, 2) fwd(Args a_unused) {
    extern __shared__ __attribute__((aligned(16))) unsigned char lds_raw[];
    LAS unsigned char* lds = (LAS unsigned char*)lds_raw;
    int stamp_no_ = 1; (void)stamp_no_;
    { const int tid0 = threadIdx.x; for (int u = tid0; u < (LDS_BYTES - LDSCTL_OFF) / 4; u += NWAVES * 64) ((LAS unsigned*)(lds + LDSCTL_OFF))[u] = 0u; }
    __syncthreads();
#if ONE_LAUNCH
    XcdBarrier bar = xcd_barrier_post((unsigned*)(kargs()->ws + WS_CTL) + CW_BAR, (volatile LAS unsigned*)(lds + MISC_OFF) + 8);
#define SEAM() do { STAMP(stamp_no_); ++stamp_no_; xcd_barrier(bar); STAMP(stamp_no_); ++stamp_no_; } while (0)
#else
#define SEAM() do {} while (0)
#endif
#define IN(k) (kargs()->ph_lo <= (k) && (k) < kargs()->ph_hi)
#define BOTH(k) (IN(k) && ((k) + 1) < kargs()->ph_hi)
#define PH_LOCALS KArgs a = kargs(); unsigned char* ws = a->ws; int G = gridDim.x, bid = blockIdx.x; asm volatile("" : "+s"(G), "+s"(bid)); const int tid = tidx(), lane = tid & 63, wave = __builtin_amdgcn_readfirstlane(tid >> 6), gw = bid * NWAVES + wave, NGW = G * NWAVES; (void)ws; (void)lane; (void)gw; (void)NGW;

    if (EN_PRO && IN(PH_PRO)) { _Pragma("unroll 1") for (int rep_ = 0; rep_ < REP_PRO; ++rep_) { if (rep_) SEAM(); PH_LOCALS; ph_prologue(a, lds, wave, lane, gw, NGW, bid * (NWAVES * 64) + tid, G * NWAVES * 64, 0, PRO_I_IN, true); } if (BOTH(PH_PRO)) SEAM(); }

#pragma unroll 1
    for (int l = 0; l < 2; ++l) {
        if (EN_IN && IN(PH_L(l, K_IN))) {
            _Pragma("unroll 1") for (int rep_ = 0; rep_ < REP_IN; ++rep_) { if (rep_) SEAM(); PH_LOCALS;
            pg8::Gemm g{(const pg8::bf16_t*)(ws + WS_XB), (const pg8::bf16_t*)(ws + WS_WIN) + (size_t)l * NIN_PAD * 1024, M, NIN_PAD, 1024}; pg8::StaticOrder S; S.init(M, NIN_PAD, G, bid);
            pg8::EpiHproj E{(pg8::bf16_t*)(ws + WS_R + R_HP), (float*)(ws + WS_GAB)};
            pg8::gemm_phase<pg8::EpiHproj, pg8::StaticOrder, PG8_ALIGN, PG8_SP2>(lds, g, S, E); }
            if (BOTH(PH_L(l, K_IN))) SEAM();
        }
        if (EN_PREP && IN(PH_L(l, K_PREP))) {
            _Pragma("unroll 1") for (int rep_ = 0; rep_ < REP_PREP; ++rep_) { if (rep_) SEAM(); PH_LOCALS; for (int u = bid; u < 1024; u += G) { if (FAST_PREP) gdn_prep_fast(a, l, u, lds, tid, lane, wave); else gdn_prep_unit(a, l, u, lds, tid, lane, wave); }
              STAMP(136); if (FAST_RET && !KV_IN_SCAN) for (int u = bid; u < 512; u += G) ret_kv_unit(a, u, lds, tid, lane, wave); STAMP(137); }
            if (BOTH(PH_L(l, K_PREP))) SEAM();
        }
        if (EN_SCAN && IN(PH_L(l, K_SCAN))) {
            { PH_LOCALS;
#if GDN_SPLIT
            const int n_items = CONV_N_MOE + (l == 0 ? PRO_NIT - PRO_I_IN : 0), n_ret_hi = (l == 0 ? 128 : 256);
            if (bid < 128) { const int t1 = tidx(), w1 = __builtin_amdgcn_readfirstlane(t1 >> 6); const int bh = (bid & 7) + 8 * (bid >> 5), q = (bid >> 3) & 3;
                             gdn_scan_v3(a, l, bh * 4 + q, lds, t1, t1 & 63, w1); STAMP(100 + 10 * l);
                             for (int u = n_ret_hi + bid; u < 512; u += 128) ret_out_unit(a, u, lds, t1, t1 & 63, w1); }
            else {
                { const int t2 = tidx(), w2 = __builtin_amdgcn_readfirstlane(t2 >> 6); conv_range(kargs(), lds, w2, t2 & 63, l, 0, n_items, (bid - 128) * NWAVES + w2, (G - 128) * NWAVES); STAMP(102 + 10 * l); }
                { const int t1 = tidx(), w1 = __builtin_amdgcn_readfirstlane(t1 >> 6);
                  for (int u = bid - 128; u < n_ret_hi; u += G - 128) ret_out_unit(a, u, lds, t1, t1 & 63, w1); }
                STAMP(101 + 10 * l);
            }
#else
            if (bid < 32) { const int t1 = tidx(), w1 = __builtin_amdgcn_readfirstlane(t1 >> 6); gdn_scan_fast(a, l, bid, lds, t1, t1 & 63, w1); STAMP(100 + 10 * l); }
            else {
                if (GDN_HELPERS && bid < 32 + 32 * GDN_HELPERS) gdn_scan_helper(a, bid & 31, tidx());
                if (KV_IN_SCAN) {
                    { const int t0 = tidx(), w0 = __builtin_amdgcn_readfirstlane(t0 >> 6);
                      for (int u = bid - 32; u < 512; u += G - 32) ret_kv_unit(a, u, lds, t0, t0 & 63, w0); }
                    VM_WAIT(); __syncthreads();
                    if (tidx() == 0) { unsigned* sub = (unsigned*)(kargs()->ws + WS_CTL) + CW_SUB + 64 * (1 + l);
                        __builtin_amdgcn_fence(__ATOMIC_RELEASE, "agent"); VM_WAIT();
                        __hip_atomic_fetch_add(sub, 1u, RLX_AGENT);
                        unsigned sp = 0; while (__hip_atomic_load(sub, RLX_AGENT) < (unsigned)(G - 32) && ++sp < (1u << 22)) __builtin_amdgcn_s_sleep(2);
                        __builtin_amdgcn_fence(__ATOMIC_ACQUIRE, "agent"); VM_WAIT(); }
                    __syncthreads();
                }
                { const int t1 = tidx(), w1 = __builtin_amdgcn_readfirstlane(t1 >> 6);
                  for (int u = bid - 32; u < 512; u += G - 32) ret_out_unit(a, u, lds, t1, t1 & 63, w1); }
                __syncthreads(); STAMP(101 + 10 * l);
                { const int t2 = tidx(), w2 = __builtin_amdgcn_readfirstlane(t2 >> 6);
                  moe_convert(kargs(), lds, w2, t2 & 63, (bid - 32) * NWAVES + w2, (G - 32) * NWAVES, 4 * l, 4 * l + 4);
                  if (l == 0) ph_prologue(kargs(), lds, w2, t2 & 63, (bid - 32) * NWAVES + w2, (G - 32) * NWAVES, 0, 0, PRO_I_IN, PRO_NIT, false); STAMP(102 + 10 * l); }
            }
#endif
            }
            if (BOTH(PH_L(l, K_SCAN))) SEAM();
        }
#if GDN_SPLIT
        if (EN_SCAN && IN(PH_L(l, K_FIN))) {
            { PH_LOCALS; gdn_finalize(a, l, lane, gw, NGW); }
            if (BOTH(PH_L(l, K_FIN))) SEAM();
        }
#endif
        if (EN_OUT && IN(PH_L(l, K_OUT))) {
            _Pragma("unroll 1") for (int rep_ = 0; rep_ < REP_OUT; ++rep_) { if (rep_) SEAM(); PH_LOCALS;
            pg8::Gemm g{(const pg8::bf16_t*)(ws + WS_R + R_OB), (const pg8::bf16_t*)(ws + WS_WO) + (size_t)l * 1024 * 1024, M, 1024, 1024}; pg8::StaticOrder S; S.init(M, 1024, G, bid);
            pg8::EpiBf16Out E{(pg8::bf16_t*)(ws + WS_R + R_MIX), 1024};
            pg8::gemm_phase<pg8::EpiBf16Out, pg8::StaticOrder, PG8_ALIGN, PG8_SP2>(lds, g, S, E); }
            if (BOTH(PH_L(l, K_OUT))) SEAM();
        }
        if (EN_LN1 && IN(PH_L(l, K_LN1))) {
            { PH_LOCALS;
            if (l == 0) ln_rows<false>(a->in[0], ALPHA, (const bf16*)(ws + WS_R + R_MIX), a->in[7], a->in[8], a->out, 1.0f, (bf16*)(ws + WS_XB), nullptr, nullptr, nullptr, nullptr, lane, gw, NGW);
            else { ln_rows<true>(a->out, ALPHA, (const bf16*)(ws + WS_R + R_MIX), a->in[7] + 1024, a->in[8] + 1024, a->out, ALPHA, (bf16*)(ws + WS_XB), (const float*)(ws + WS_RWT), (unsigned*)(ws + WS_CTL) + CW_MOE, (int*)(ws + WS_LIST), (float*)(ws + WS_GATE), lane, gw, NGW, lds, tid);
                 } }
            if (BOTH(PH_L(l, K_LN1))) SEAM();
        }
        if (l == 0) {
            if (EN_FFN0 && IN(PH_L(0, K_GU))) {
                _Pragma("unroll 1") for (int rep_ = 0; rep_ < REP_GU; ++rep_) { if (rep_) SEAM(); PH_LOCALS;
                pg8::Gemm g{(const pg8::bf16_t*)(ws + WS_XB), (const pg8::bf16_t*)(ws + WS_WGU), M, 2 * FF, 1024}; pg8::StaticOrder S; S.init(M, 2 * FF, G, bid);
                pg8::EpiSwiglu E{(pg8::bf16_t*)(ws + WS_R + R_H), FF, 0};
                pg8::gemm_phase<pg8::EpiSwiglu, pg8::StaticOrder, PG8_ALIGN, PG8_SP2>(lds, g, S, E); }
                if (BOTH(PH_L(0, K_GU))) SEAM();
            }
            if (EN_FFN0 && IN(PH_L(0, K_DN))) {
                _Pragma("unroll 1") for (int rep_ = 0; rep_ < REP_DN; ++rep_) { if (rep_) SEAM(); PH_LOCALS;
                pg8::Gemm g{(const pg8::bf16_t*)(ws + WS_R + R_H), (const pg8::bf16_t*)(ws + WS_WD), M, 1024, FF}; pg8::StaticOrder S; S.init(M, 1024, G, bid);
                pg8::EpiBf16Out E{(pg8::bf16_t*)(ws + WS_R + R_MIX), 1024};
                pg8::gemm_phase<pg8::EpiBf16Out, pg8::StaticOrder, PG8_ALIGN, PG8_SP2>(lds, g, S, E); }
                if (BOTH(PH_L(0, K_DN))) SEAM();
            }
            if (EN_LN1 && IN(PH_L(0, K_LN2))) {
                { PH_LOCALS;
                ln_rows<false>(a->out, ALPHA, (const bf16*)(ws + WS_R + R_MIX), a->in[9], a->in[10], a->out, 1.0f, (bf16*)(ws + WS_XB), nullptr, nullptr, nullptr, nullptr, lane, gw, NGW); }
                if (BOTH(PH_L(0, K_LN2))) SEAM();
            }
        } else {
#pragma unroll 1
            for (int j = 0; j < 2; ++j) {
                const int kg = K_G0 + 3 * j;
                if (EN_MOE && j == 0 && IN(PH_L(1, kg))) { { PH_LOCALS; moe_gather(a, 0, lane, gw, NGW); moe_gather(a, 1, lane, gw, NGW); } if (BOTH(PH_L(1, kg))) SEAM(); }
                if (EN_MOE && IN(PH_L(1, kg + 1))) {
                    { PH_LOCALS;
                    pg8::moe_table(lds, (const unsigned*)(ws + WS_CTL) + CW_MOE, tid);
                    const PG8_LAS int* tab = (const PG8_LAS int*)(lds + pg8::MOE_TAB_OFF);
                    if (j == 1 && bid < 32) {
#pragma unroll 1
                        for (int jj = 0; jj < 2; ++jj) {
                            { pg8::MoeSched<true> S; S.tab = tab; S.j0 = jj; S.a0 = 64 + (bid >> 2); S.c = bid & 3; S.mode = (64 + (bid >> 2)) < pg8::moe_T(lds, jj) ? 1 : 2;
                              S.n0 = S.n1 = S.a1 = S.j1 = 0; S.G = 1;
                              pg8::Gemm g{(const pg8::bf16_t*)(ws + WS_R + R_HM), (const pg8::bf16_t*)(ws + WS_WMD), MOE_ROWS, 1024, FE, 1};
                              pg8::EpiMoeDown E{a->out, (const int*)(ws + WS_LIST), (const float*)(ws + WS_GATE), tab};
                              pg8::gemm_phase<pg8::EpiMoeDown, pg8::MoeSched<true>, PG8_ALIGN, PG8_SP2>(lds, g, S, E); }
                            if (jj == 0) {
                                VM_WAIT(); __syncthreads();
                                if (tidx() == 0) { unsigned* sub = (unsigned*)(kargs()->ws + WS_CTL) + CW_SUB;
                                    __builtin_amdgcn_fence(__ATOMIC_RELEASE, "agent"); VM_WAIT();
                                    __hip_atomic_fetch_add(sub, 1u, RLX_AGENT);
                                    unsigned sp = 0; while (__hip_atomic_load(sub, RLX_AGENT) < 32u && ++sp < (1u << 22)) __builtin_amdgcn_s_sleep(2);
                                    __builtin_amdgcn_fence(__ATOMIC_ACQUIRE, "agent"); VM_WAIT(); }
                                __syncthreads();
                            }
                        }
                    } else {
                        pg8::MoeSched<false> S; S.tab = tab; S.mode = 0;
                        const int T0 = pg8::moe_T(lds, 0), T1 = pg8::moe_T(lds, 1);
                        if (j == 0) { S.j0 = 0; S.a0 = 0; S.n0 = T0; S.j1 = 1; S.a1 = 64; S.n1 = T1 > 64 ? T1 - 64 : 0; S.G = G; S.c = bid; }
                        else        { S.j0 = 1; S.a0 = 0; S.n0 = T1 < 64 ? T1 : 64; S.j1 = 1; S.a1 = 0; S.n1 = 0; S.G = G - 32; S.c = bid - 32; }
                        pg8::Gemm g{(const pg8::bf16_t*)(ws + WS_R + R_XG), (const pg8::bf16_t*)(ws + WS_WMGU), MOE_ROWS, 2 * FE, 1024};
                        pg8::EpiSwiglu E{(pg8::bf16_t*)(ws + WS_R + R_HM), FE, 1};
                        pg8::gemm_phase<pg8::EpiSwiglu, pg8::MoeSched<false>, PG8_ALIGN, PG8_SP2>(lds, g, S, E);
                    } }
                    if (BOTH(PH_L(1, kg + 1))) SEAM();
                }
                if (EN_MOE && IN(PH_L(1, kg + 2))) {
                    { PH_LOCALS;
                    pg8::moe_table(lds, (const unsigned*)(ws + WS_CTL) + CW_MOE, tid);
                    const PG8_LAS int* tab = (const PG8_LAS int*)(lds + pg8::MOE_TAB_OFF);
                    const int Tj = pg8::moe_T(lds, j);
                    pg8::MoeSched<true> S; S.tab = tab; S.mode = 0; S.j0 = j; S.a0 = 0; S.n0 = Tj < 64 ? Tj : 64; S.j1 = j; S.a1 = 0; S.n1 = 0; S.G = G; S.c = bid;
                    pg8::Gemm g{(const pg8::bf16_t*)(ws + WS_R + R_HM), (const pg8::bf16_t*)(ws + WS_WMD), MOE_ROWS, 1024, FE, 1};
                    pg8::EpiMoeDown E{a->out, (const int*)(ws + WS_LIST), (const float*)(ws + WS_GATE), tab};
                    pg8::gemm_phase<pg8::EpiMoeDown, pg8::MoeSched<true>, PG8_ALIGN, PG8_SP2>(lds, g, S, E); }
                    if (BOTH(PH_L(1, kg + 2))) SEAM();
                }
            }
            if (EN_LN1 && IN(PH_L(1, K_LNF))) {
                PH_LOCALS;
                ln_rows<false>(a->out, 1.0f, nullptr, a->in[9] + 1024, a->in[10] + 1024, a->out, 1.0f, nullptr, nullptr, nullptr, nullptr, nullptr, lane, gw, NGW);
            }
        }
    }
    STAMP(stamp_no_);
#if PROBE_MULT > 0
    if (blockIdx.x == PROBE_BID && threadIdx.x == 0) {
        const unsigned long long* ts = (const unsigned long long*)(kargs()->ws + WS_CTL + 131072);
        const unsigned long long ta = __hip_atomic_load(ts + PROBE_A, RLX_AGENT), tb = __hip_atomic_load(ts + PROBE_B, RLX_AGENT);
        const unsigned long long hold = (tb > ta ? tb - ta : 0ull) * (unsigned long long)PROBE_MULT, t0 = __builtin_amdgcn_s_memrealtime();
        while (__builtin_amdgcn_s_memrealtime() - t0 < hold && __builtin_amdgcn_s_memrealtime() - t0 < 2000000ull) __builtin_amdgcn_s_sleep(8);
    }
#endif
#undef IN
#undef BOTH
}

extern "C" void kernel_launch(void* const* d_in, const int* in_sizes, int n_in, void* d_out, int out_size, void* d_ws, size_t ws_size, hipStream_t stream) {
    static int grid = 0;
    if (grid == 0) {
        if (n_in != 18 || in_sizes[0] != M * D || out_size != M * D || ws_size < WS_END) { fprintf(stderr, "kernel_launch: unexpected shapes or workspace (%zu < %zu); nothing launched\n", ws_size, (size_t)WS_END); grid = -1; return; }
        int dev = 0, cus = 0, per_cu = 0;
        if (hipGetDevice(&dev) != hipSuccess || hipDeviceGetAttribute(&cus, hipDeviceAttributeMultiprocessorCount, dev) != hipSuccess) { grid = -1; return; }
        if (hipFuncSetAttribute((const void*)fwd, hipFuncAttributeMaxDynamicSharedMemorySize, LDS_BYTES) != hipSuccess) { fprintf(stderr, "kernel_launch: hipFuncSetAttribute failed\n"); grid = -1; return; }
        if (hipOccupancyMaxActiveBlocksPerMultiprocessor(&per_cu, (const void*)fwd, NWAVES * 64, LDS_BYTES) != hipSuccess || per_cu < 1) fprintf(stderr, "kernel_launch: occupancy query reports %d\n", per_cu);
        (void)hipGetLastError();
        grid = cus;
    }
    if (grid < 0) return;
    if (hipMemsetAsync((char*)d_ws + WS_CTL, 0, CTL_BYTES, stream) != hipSuccess) return;
    Args a{};
    for (int i = 0; i < 18; ++i) a.in[i] = (const float*)d_in[i];
    a.out = (float*)d_out; a.ws = (unsigned char*)d_ws;
#if ONE_LAUNCH
    a.ph_lo = 0; a.ph_hi = PH_END;
    hipLaunchKernelGGL(fwd, dim3(grid), dim3(NWAVES * 64), LDS_BYTES, stream, a);
#else
    static const int phases[] = {PH_PRO,
        PH_L(0, K_IN), PH_L(0, K_PREP), PH_L(0, K_SCAN), PH_L(0, K_OUT), PH_L(0, K_LN1), PH_L(0, K_GU), PH_L(0, K_DN), PH_L(0, K_LN2),
        PH_L(1, K_IN), PH_L(1, K_PREP), PH_L(1, K_SCAN), PH_L(1, K_OUT), PH_L(1, K_LN1),
        PH_L(1, K_G0), PH_L(1, K_GU0), PH_L(1, K_DN0), PH_L(1, K_G1), PH_L(1, K_GU1), PH_L(1, K_DN1), PH_L(1, K_LNF)};
    for (unsigned i = 0; i < sizeof(phases) / sizeof(phases[0]); ++i) {
        a.ph_lo = phases[i]; a.ph_hi = phases[i] + 1;
        hipLaunchKernelGGL(fwd, dim3(grid), dim3(NWAVES * 64), LDS_BYTES, stream, a);
    }
#endif
}
```

```cpp
#include <hip/hip_runtime.h>
#include <cstdio>
#include <cstdint>

#ifndef ONE_LAUNCH
#define ONE_LAUNCH 1
#endif

#define GAS __attribute__((address_space(1)))
#define LAS __attribute__((address_space(3)))
typedef unsigned short bf16;
typedef unsigned v4u __attribute__((ext_vector_type(4)));
typedef unsigned v2u __attribute__((ext_vector_type(2)));
typedef float f32x4 __attribute__((ext_vector_type(4)));
typedef float f32x2 __attribute__((ext_vector_type(2)));
#define RLX_AGENT __ATOMIC_RELAXED, __HIP_MEMORY_SCOPE_AGENT
#define LDS_WAIT() asm volatile("s_waitcnt lgkmcnt(0)" ::: "memory")
#define VM_WAIT() asm volatile("s_waitcnt vmcnt(0)" ::: "memory")

__device__ __forceinline__ unsigned f2bf(float f) { unsigned u = __builtin_bit_cast(unsigned, f); return (u + 0x7fffu + ((u >> 16) & 1u)) >> 16; }
__device__ __forceinline__ unsigned pk2(float lo, float hi) { return f2bf(lo) | (f2bf(hi) << 16); }
__device__ __forceinline__ float bf2f(unsigned short u) { return __builtin_bit_cast(float, (unsigned)u << 16); }
__device__ __forceinline__ float bflo(unsigned u) { return __builtin_bit_cast(float, u << 16); }
__device__ __forceinline__ float bfhi(unsigned u) { return __builtin_bit_cast(float, u & 0xffff0000u); }
__device__ __forceinline__ float siluf(float x) { return x * __builtin_amdgcn_rcpf(1.f + __expf(-x)); }
__device__ __forceinline__ float sigmf(float x) { return 1.f / (1.f + __expf(-x)); }
__device__ __forceinline__ float wave_sum(float v) {
    v += __builtin_bit_cast(float, __builtin_amdgcn_update_dpp(0, __builtin_bit_cast(int, v), 0xB1, 0xF, 0xF, true));
    v += __builtin_bit_cast(float, __builtin_amdgcn_update_dpp(0, __builtin_bit_cast(int, v), 0x4E, 0xF, 0xF, true));
    v += __builtin_bit_cast(float, __builtin_amdgcn_update_dpp(0, __builtin_bit_cast(int, v), 0x141, 0xF, 0xF, true));
    v += __builtin_bit_cast(float, __builtin_amdgcn_update_dpp(0, __builtin_bit_cast(int, v), 0x140, 0xF, 0xF, true));
    v += __builtin_bit_cast(float, __builtin_amdgcn_update_dpp(0, __builtin_bit_cast(int, v), 0x142, 0xA, 0xF, false));
    v += __builtin_bit_cast(float, __builtin_amdgcn_update_dpp(0, __builtin_bit_cast(int, v), 0x143, 0xC, 0xF, false));
    return __builtin_bit_cast(float, __builtin_amdgcn_readlane(__builtin_bit_cast(int, v), 63));
}

constexpr int NWAVES = 8;
constexpr int M = 16384, D = 1024, SEQ = 2048, NB = 8;
constexpr int IN_COLS = 3592, NIN_PAD = 3840, HP_LD = 3584;
constexpr int FF = 2816, FE = 3584, NE = 8;
constexpr int COL_RQ = 0, COL_RK = 256, COL_RV = 512, COL_RG = 1024, COL_GQ = 1536, COL_GK = 2048, COL_GV = 2560, COL_GG = 3072;
constexpr float ALPHA = 1.41421356237f;
constexpr float LN_EPS = 1e-5f, NORM_EPS = 1e-6f;
constexpr int MOE_ROWS = 72 * 256;

__host__ __device__ __forceinline__ int fragoff(int i, int d, int nkt) {
    return ((((i >> 5) * nkt + (d >> 5)) * 2 + ((d >> 4) & 1)) * 512) + ((((d >> 2) & 1) * 32 + (i & 31)) * 8) + ((((d >> 3) & 1) << 2) | (d & 3));
}
__host__ __device__ __forceinline__ int uoff(int i, int e) {
    const int reg = (i & 3) | (((i & 31) >> 3) << 2);
    return (((((e >> 5) * 2 + (i >> 5)) * 2 + (reg >> 3)) * 64 + (((i >> 2) & 1) * 32 + (e & 31))) * 8) + (reg & 7);
}
namespace pg8 {
#define PG8_LAS __attribute__((address_space(3)))
typedef unsigned short bf16_t;
typedef short bf16x8 __attribute__((ext_vector_type(8)));
typedef float f32x4 __attribute__((ext_vector_type(4)));
typedef unsigned u32x4 __attribute__((ext_vector_type(4)));
constexpr int BM = 256, BK = 64, HALF = 128, HTB = HALF * BK * 2  , STAGE_BYTES = 8 * HTB, NXCD = 8, WGM = 8;

__host__ __device__ __forceinline__ int lds_byte(int r, int c) { const int st = (r >> 4) * 2 + (c >> 5), rr = r & 15, cc = c & 31, ob = rr * 64 + cc * 2; return st * 1024 + (ob ^ (((ob >> 9) & 1) << 5)); }
__host__ __device__ __forceinline__ void stage_rc(int b, int& R, int& C) { const int st = b / 1024, sb = b % 1024, swz = sb ^ (((sb >> 9) & 1) << 5); R = (st >> 1) * 16 + swz / 64; C = (st & 1) * 32 + (swz % 64) / 2; }
__host__ __device__ __forceinline__ int perm32(int rho) { const int n = rho >> 4, i = rho & 15; return 8 * (i >> 2) + 4 * n + (i & 3); }

struct Unit { int pm, pn, aux, am, sel; };
struct Gemm { const bf16_t* A; const bf16_t* Bt; int M, N, K, blk; };

struct StaticOrder {
    int nM, nN, nwg, G, c;
    __host__ __device__ void init(int M, int N, int G_, int c_) { nM = M / BM; nN = N / BM; nwg = nM * nN; G = G_; c = c_; }
    __host__ __device__ bool next(int i, Unit& u) const {
        const long L = (long)i * G + c; if (L >= nwg) return false;
        int wgid = (int)L; { const int q = nwg / NXCD, r = nwg % NXCD, xcd = wgid % NXCD, off = wgid / NXCD; wgid = (xcd < r ? xcd * (q + 1) : r * (q + 1) + (xcd - r) * q) + off; }
        const int nig = WGM * nN, gid = wgid / nig, fm = gid * WGM, gsz = (nM - fm) < WGM ? (nM - fm) : WGM;
        u.pm = fm + ((wgid % nig) % gsz); u.pn = (wgid % nig) / gsz; u.aux = 0; u.am = u.pm; u.sel = 0; return true;
    }
    __device__ __forceinline__ const char* aptr(const Gemm& g, const Unit& u) const { return (const char*)g.A + (size_t)u.pm * ((size_t)BM * g.K * 2); }
    __device__ __forceinline__ const char* bptr(const Gemm& g, const Unit& u) const { return (const char*)g.Bt + (size_t)u.pn * ((size_t)BM * g.K * 2); }
    __device__ __forceinline__ void a_ready(const Unit&) const {}
    __device__ __forceinline__ void done(const Unit&) const {}
};

template <class Epi, class Sched, bool ALIGN_EPI = false, bool SP2 = false>
__device__ __forceinline__ void gemm_phase(PG8_LAS unsigned char* lds, const Gemm g, const Sched& S, const Epi& E) {
    int tid = threadIdx.x; asm volatile("" : "+v"(tid)); const int wid = __builtin_amdgcn_readfirstlane(tid >> 6), lane = tid & 63, wr = wid >> 2, wc = wid & 3, fr = lane & 15, fq = lane >> 4;
    const int K = g.K, nt = K / BK;
    unsigned voffA[2], voffB[2];
#pragma unroll
    for (int i = 0; i < 2; ++i) { int R, C; stage_rc(tid * 16 + i * 8192, R, C); const int Rb = Epi::PERM ? ((R & ~31) + perm32(R & 31)) : R;
        voffA[i] = (unsigned)(R * (g.blk ? 64 : K) + C) * 2u; voffB[i] = (unsigned)(Rb * (g.blk ? 64 : K) + C) * 2u; }
    const size_t kstep = g.blk ? (size_t)(256 * 64 * 2) : (size_t)(BK * 2);
    const size_t hstep = g.blk ? (size_t)(HALF * 64 * 2) : (size_t)HALF * K * 2;
    const size_t tstep = 2 * hstep;
    const unsigned ldsw = (unsigned)wid * 1024u;
    const int aoff = lds_byte(wr * 64 + fr, fq * 8), boff = lds_byte(wc * 32 + fr, fq * 8);
#define PG8_SA(b, h) (((b) * 2 + (h)) * HTB)
#define PG8_SB(b, h) ((4 + (b) * 2 + (h)) * HTB)
#define PG8_STAGE(bufoff, gbase, voff) do { _Pragma("unroll") for (int _i = 0; _i < 2; ++_i) \
        __builtin_amdgcn_global_load_lds((const unsigned*)((const char*)(gbase) + (voff)[_i]), (PG8_LAS unsigned*)(lds + (bufoff) + ldsw + _i * 8192), 16, 0, 0); } while (0)
#define PG8_LDA(dst, b, h) do { _Pragma("unroll") for (int m = 0; m < 4; ++m) _Pragma("unroll") for (int k = 0; k < 2; ++k) dst[m][k] = *(const PG8_LAS bf16x8*)(lds + PG8_SA(b, h) + aoff + m * 2048 + k * 1024); } while (0)
#define PG8_LDB(dst, b, h) do { _Pragma("unroll") for (int n = 0; n < 2; ++n) _Pragma("unroll") for (int k = 0; k < 2; ++k) dst[n][k] = *(const PG8_LAS bf16x8*)(lds + PG8_SB(b, h) + boff + n * 2048 + k * 1024); } while (0)
#define PG8_MMA(ai, bj, At, Bt) do { __builtin_amdgcn_s_setprio(1); _Pragma("unroll") for (int m = 0; m < 4; ++m) _Pragma("unroll") for (int n = 0; n < 2; ++n) _Pragma("unroll") for (int k = 0; k < 2; ++k) \
        acc[ai][bj][m][n] = __builtin_amdgcn_mfma_f32_16x16x32_bf16(Bt[n][k], At[m][k], acc[ai][bj][m][n], 0, 0, 0); __builtin_amdgcn_s_setprio(0); } while (0)
#define PG8_WAIT_V(n) asm volatile("s_waitcnt vmcnt(" #n ")" ::: "memory")
#define PG8_WAIT_L(n) asm volatile("s_waitcnt lgkmcnt(" #n ")" ::: "memory")
#define PG8_BAR __builtin_amdgcn_s_barrier()
#define PG8_SCHED __builtin_amdgcn_sched_barrier(0)
    Unit cur, nxt; int ui = 0;
    if (!S.next(0, cur)) return;
    f32x4 acc[2][2][4][2];
#pragma unroll
    for (int a = 0; a < 2; ++a)
#pragma unroll
        for (int b = 0; b < 2; ++b)
#pragma unroll
            for (int m = 0; m < 4; ++m)
#pragma unroll
                for (int n = 0; n < 2; ++n) acc[a][b][m][n] = (f32x4){0.f, 0.f, 0.f, 0.f};
    bf16x8 At[4][2], B0[2][2], B1[2][2];
    const char* cA = S.aptr(g, cur); const char* cB = S.bptr(g, cur);
    S.a_ready(cur);
    if constexpr (SP2) {
        PG8_STAGE(PG8_SB(0, 0), cB, voffB); PG8_STAGE(PG8_SB(0, 1), cB + hstep, voffB); PG8_STAGE(PG8_SA(0, 0), cA, voffA); PG8_STAGE(PG8_SA(0, 1), cA + hstep, voffA);
        if (wr == 1) PG8_BAR;
        PG8_WAIT_V(2); PG8_BAR;
        PG8_STAGE(PG8_SB(1, 0), cB + kstep, voffB); PG8_STAGE(PG8_SA(1, 0), cA + kstep, voffA); PG8_STAGE(PG8_SB(1, 1), cB + hstep + kstep, voffB);
        PG8_WAIT_V(6); PG8_BAR;
    } else {
        PG8_STAGE(PG8_SB(0, 0), cB, voffB); PG8_STAGE(PG8_SA(0, 0), cA, voffA); PG8_STAGE(PG8_SB(0, 1), cB + hstep, voffB); PG8_STAGE(PG8_SA(0, 1), cA + hstep, voffA);
        if (wr == 1) PG8_BAR;
        PG8_WAIT_V(4); PG8_BAR;
        PG8_STAGE(PG8_SB(1, 0), cB + kstep, voffB); PG8_STAGE(PG8_SA(1, 0), cA + kstep, voffA); PG8_STAGE(PG8_SB(1, 1), cB + hstep + kstep, voffB);
        PG8_WAIT_V(6); PG8_BAR;
    }
    for (;;) {
        const bool has_next = S.next(ui + 1, nxt);
        const char* nA = has_next ? S.aptr(g, nxt) : cA; const char* nB = has_next ? S.bptr(g, nxt) : cB;
        for (int t = 0; t < nt; t += 2) {
            const bool last = (t == nt - 2);
            const char* a1 = cA + (size_t)(t + 1) * kstep;
            const char* a2 = last ? nA : cA + (size_t)(t + 2) * kstep; const char* b2 = last ? nB : cB + (size_t)(t + 2) * kstep;
            const char* a3 = a2 + kstep; const char* b3 = b2 + kstep;
            if (last && has_next) S.a_ready(nxt);
            if constexpr (SP2) {
            PG8_LDB(B0, 0, 0); PG8_LDB(B1, 0, 1); PG8_SCHED; PG8_LDA(At, 0, 0); PG8_STAGE(PG8_SA(1, 1), a1 + hstep, voffA);
            PG8_WAIT_V(8); PG8_WAIT_L(0); PG8_BAR; PG8_MMA(0, 0, At, B0); PG8_MMA(0, 1, At, B1); PG8_BAR; PG8_SCHED;
            PG8_LDA(At, 0, 1); PG8_STAGE(PG8_SB(0, 0), b2, voffB); PG8_STAGE(PG8_SB(0, 1), b2 + hstep, voffB); PG8_STAGE(PG8_SA(0, 0), a2, voffA);
            PG8_WAIT_V(8); PG8_WAIT_L(0); PG8_BAR; PG8_MMA(1, 0, At, B0); PG8_MMA(1, 1, At, B1); PG8_BAR; PG8_SCHED;
            PG8_LDB(B0, 1, 0); PG8_LDB(B1, 1, 1); PG8_SCHED; PG8_LDA(At, 1, 0); PG8_STAGE(PG8_SA(0, 1), a2 + hstep, voffA);
            PG8_WAIT_V(8); PG8_WAIT_L(0); PG8_BAR; PG8_MMA(0, 0, At, B0); PG8_MMA(0, 1, At, B1); PG8_BAR; PG8_SCHED;
            PG8_LDA(At, 1, 1); PG8_STAGE(PG8_SB(1, 0), b3, voffB); PG8_STAGE(PG8_SB(1, 1), b3 + hstep, voffB); PG8_STAGE(PG8_SA(1, 0), a3, voffA);
            PG8_WAIT_V(8); PG8_WAIT_L(0); PG8_BAR; PG8_MMA(1, 0, At, B0); PG8_MMA(1, 1, At, B1); PG8_BAR; PG8_SCHED;
            } else {
            PG8_LDB(B0, 0, 0); PG8_SCHED; PG8_LDA(At, 0, 0); PG8_STAGE(PG8_SA(1, 1), a1 + hstep, voffA);
            PG8_WAIT_L(8); PG8_BAR; PG8_WAIT_L(0); PG8_MMA(0, 0, At, B0); PG8_BAR; PG8_SCHED;
            PG8_LDB(B1, 0, 1); PG8_STAGE(PG8_SB(0, 0), b2, voffB);
            PG8_BAR; PG8_WAIT_L(0); PG8_MMA(0, 1, At, B1); PG8_BAR;
            PG8_LDA(At, 0, 1); PG8_STAGE(PG8_SA(0, 0), a2, voffA);
            PG8_BAR; PG8_WAIT_L(0); PG8_MMA(1, 0, At, B0); PG8_BAR; PG8_SCHED;
            PG8_STAGE(PG8_SB(0, 1), b2 + hstep, voffB);
            PG8_WAIT_V(6); PG8_BAR; PG8_MMA(1, 1, At, B1); PG8_BAR;
            PG8_LDB(B0, 1, 0); PG8_SCHED; PG8_LDA(At, 1, 0); PG8_STAGE(PG8_SA(0, 1), a2 + hstep, voffA);
            PG8_WAIT_L(8); PG8_BAR; PG8_WAIT_L(0); PG8_MMA(0, 0, At, B0); PG8_BAR; PG8_SCHED;
            PG8_LDB(B1, 1, 1); PG8_STAGE(PG8_SB(1, 0), b3, voffB);
            PG8_BAR; PG8_WAIT_L(0); PG8_MMA(0, 1, At, B1); PG8_BAR;
            PG8_LDA(At, 1, 1); PG8_STAGE(PG8_SA(1, 0), a3, voffA);
            PG8_BAR; PG8_WAIT_L(0); PG8_MMA(1, 0, At, B0); PG8_BAR; PG8_SCHED;
            PG8_STAGE(PG8_SB(1, 1), b3 + hstep, voffB);
            PG8_WAIT_V(6); PG8_BAR; PG8_MMA(1, 1, At, B1); PG8_BAR;
            }
        }
        if constexpr (ALIGN_EPI) { if (wr == 0) PG8_BAR; }
        if constexpr (!Epi::AFTER_DRAIN) { E(acc, cur, wr, wc, fr, fq); S.done(cur); }
        if (!has_next) break;
#pragma unroll
        for (int a = 0; a < 2; ++a)
#pragma unroll
            for (int b = 0; b < 2; ++b)
#pragma unroll
                for (int m = 0; m < 4; ++m)
#pragma unroll
                    for (int n = 0; n < 2; ++n) acc[a][b][m][n] = (f32x4){0.f, 0.f, 0.f, 0.f};
        cur = nxt; cA = nA; cB = nB; ++ui;
        if constexpr (ALIGN_EPI) { if (wr == 1) PG8_BAR; }
    }
    PG8_WAIT_V(0);
    if constexpr (!ALIGN_EPI) { if (wr == 0) PG8_BAR; }
    PG8_BAR;
    if constexpr (Epi::AFTER_DRAIN) { E.fused(acc, cur, wr, wc, fr, fq, lds, wid, lane); S.done(cur); }
#undef PG8_SA
#undef PG8_SB
#undef PG8_STAGE
#undef PG8_LDA
#undef PG8_LDB
#undef PG8_MMA
#undef PG8_WAIT_V
#undef PG8_WAIT_L
#undef PG8_BAR
#undef PG8_SCHED
}
}

namespace pg8 {
__device__ __forceinline__ unsigned cvt_pk_bf16(float lo, float hi) { unsigned r; asm volatile("v_cvt_pk_bf16_f32 %0, %1, %2" : "=v"(r) : "v"(lo), "v"(hi)); return r; }

struct EpiHproj {
    static constexpr bool PERM = true, AFTER_DRAIN = false;
    bf16_t* HP; float* GAB;
    __device__ __forceinline__ void operator()(const f32x4 (&acc)[2][2][4][2], const Unit& u, int wr, int wc, int fr, int fq) const {
        const int row0 = u.pm * BM + wr * 64 + fr;
        if (u.pn < 14) {
            const int col0 = u.pn * BM + wc * 32 + 8 * fq;
#pragma unroll
            for (int ai = 0; ai < 2; ++ai)
#pragma unroll
                for (int m = 0; m < 4; ++m) { bf16_t* rowp = HP + (size_t)(row0 + ai * HALF + m * 16) * 3584 + col0;
#pragma unroll
                    for (int bj = 0; bj < 2; ++bj) { const f32x4 v0 = acc[ai][bj][m][0], v1 = acc[ai][bj][m][1];
                        u32x4 w; w.x = cvt_pk_bf16(v0[0], v0[1]); w.y = cvt_pk_bf16(v0[2], v0[3]); w.z = cvt_pk_bf16(v1[0], v1[1]); w.w = cvt_pk_bf16(v1[2], v1[3]);
                        *(u32x4*)(rowp + bj * HALF) = w; } }
        } else if (wc == 0 && fq == 0) {
#pragma unroll
            for (int ai = 0; ai < 2; ++ai)
#pragma unroll
                for (int m = 0; m < 4; ++m) { float* rowp = GAB + (size_t)(row0 + ai * HALF + m * 16) * 8;
                    *(f32x4*)(rowp) = acc[ai][0][m][0]; *(f32x4*)(rowp + 4) = acc[ai][0][m][1]; }
        }
    }
};
struct EpiBf16Out {
    static constexpr bool PERM = true, AFTER_DRAIN = false;
    bf16_t* O; int ldc;
    __device__ __forceinline__ void operator()(const f32x4 (&acc)[2][2][4][2], const Unit& u, int wr, int wc, int fr, int fq) const {
        const int row0 = u.pm * BM + wr * 64 + fr, col0 = u.pn * BM + wc * 32 + 8 * fq;
#pragma unroll
        for (int ai = 0; ai < 2; ++ai)
#pragma unroll
            for (int m = 0; m < 4; ++m) { bf16_t* rowp = O + (size_t)(row0 + ai * HALF + m * 16) * ldc + col0;
#pragma unroll
                for (int bj = 0; bj < 2; ++bj) { const f32x4 v0 = acc[ai][bj][m][0], v1 = acc[ai][bj][m][1];
                    u32x4 w; w.x = cvt_pk_bf16(v0[0], v0[1]); w.y = cvt_pk_bf16(v0[2], v0[3]); w.z = cvt_pk_bf16(v1[0], v1[1]); w.w = cvt_pk_bf16(v1[2], v1[3]);
                    *(u32x4*)(rowp + bj * HALF) = w; } }
    }
};
struct EpiF32 {
    static constexpr bool PERM = false, AFTER_DRAIN = false;
    float* O; int ldc;
    __device__ __forceinline__ void operator()(const f32x4 (&acc)[2][2][4][2], const Unit& u, int wr, int wc, int fr, int fq) const {
        const int row0 = u.pm * BM + wr * 64 + fr, col0 = u.pn * BM + wc * 32 + 4 * fq;
#pragma unroll
        for (int ai = 0; ai < 2; ++ai)
#pragma unroll
            for (int m = 0; m < 4; ++m) { float* rowp = O + (size_t)(row0 + ai * HALF + m * 16) * ldc + col0;
#pragma unroll
                for (int bj = 0; bj < 2; ++bj)
#pragma unroll
                    for (int n = 0; n < 2; ++n) *(f32x4*)(rowp + bj * HALF + n * 16) = acc[ai][bj][m][n]; }
    }
};
struct EpiSwiglu {
    static constexpr bool PERM = true, AFTER_DRAIN = false;
    bf16_t* H; int ldh; int blk;
    __device__ __forceinline__ void operator()(const f32x4 (&acc)[2][2][4][2], const Unit& u, int wr, int wc, int fr, int fq) const {
        const int rt = wr * 64 + fr, col0 = u.pn * HALF + wc * 32 + 8 * fq;
        bf16_t* tb = H + (size_t)u.pm * BM * ldh;
#pragma unroll
        for (int ai = 0; ai < 2; ++ai)
#pragma unroll
            for (int m = 0; m < 4; ++m) { const int r = rt + ai * HALF + m * 16;
                bf16_t* rowp = blk ? tb + (size_t)(col0 >> 6) * (BM * 64) + r * 64 + (col0 & 63) : tb + (size_t)r * ldh + col0;
                float h[8];
#pragma unroll
                for (int n = 0; n < 2; ++n)
#pragma unroll
                    for (int i = 0; i < 4; ++i) { const float gt = acc[ai][0][m][n][i], up = acc[ai][1][m][n][i]; h[n * 4 + i] = gt * up * __builtin_amdgcn_rcpf(1.f + __expf(-gt)); }
                u32x4 w; w.x = cvt_pk_bf16(h[0], h[1]); w.y = cvt_pk_bf16(h[2], h[3]); w.z = cvt_pk_bf16(h[4], h[5]); w.w = cvt_pk_bf16(h[6], h[7]);
                *(u32x4*)(rowp) = w; }
    }
};
constexpr int MOE_TAB_OFF = 131072 + 1024;
__device__ __forceinline__ void moe_table(PG8_LAS unsigned char* lds, const unsigned* cntw, int tid) {
    PG8_LAS int* tab = (PG8_LAS int*)(lds + MOE_TAB_OFF);
    __syncthreads();
    if (tid < 2) { const int j = tid; int t = 0;
        for (int e = 0; e < 8; ++e) { const int c = (int)cntw[64 * (j * 8 + e)]; tab[j * 8 + e] = t; tab[16 + j * 8 + e] = c; t += (c + 255) >> 8; }
        tab[32 + j] = t; }
    __syncthreads();
}
__device__ __forceinline__ int moe_T(PG8_LAS unsigned char* lds, int j) { return __builtin_amdgcn_readfirstlane(((const PG8_LAS int*)(lds + MOE_TAB_OFF))[32 + j]); }
__device__ __forceinline__ int moe_expert(const PG8_LAS int* tab, int j, int t) { int e = 0;
#pragma unroll
    for (int k = 1; k < 8; ++k) e += (t >= tab[j * 8 + k]) ? 1 : 0;
    return __builtin_amdgcn_readfirstlane(e); }
__device__ __forceinline__ int moe_hphys(int j, int t) { return (j == 1 && t >= 64) ? t + 8 : t; }
struct EpiMoeDown {
    static constexpr bool PERM = false, AFTER_DRAIN = false;
    float* XF; const int* list; const float* gate; const PG8_LAS int* tab;
    __device__ __forceinline__ void operator()(const f32x4 (&acc)[2][2][4][2], const Unit& u, int wr, int wc, int fr, int fq) const {
        const int e = u.aux, j = u.sel, c_e = tab[16 + j * 8 + e], t_e = tab[j * 8 + e];
        const int s0 = (u.pm - t_e) * BM + wr * 64 + fr, col0 = u.pn * BM + wc * 32 + 4 * fq;
        const int* lp = list + (size_t)(j * 8 + e) * 16384; const float* gp = gate + (size_t)j * 16384;
        int tok[8]; float gt[8];
#pragma unroll
        for (int q = 0; q < 8; ++q) { const int s = s0 + (q >> 2) * HALF + (q & 3) * 16; tok[q] = (s < c_e) ? lp[s] : -1; }
#pragma unroll
        for (int q = 0; q < 8; ++q) gt[q] = (tok[q] >= 0) ? gp[tok[q]] : 0.f;
#pragma unroll
        for (int ai = 0; ai < 2; ++ai) {
            f32x4 o[4][2][2];
#pragma unroll
            for (int m = 0; m < 4; ++m) { const float* rowp = XF + (size_t)(tok[ai * 4 + m] >= 0 ? tok[ai * 4 + m] : 0) * 1024 + col0;
#pragma unroll
                for (int bj = 0; bj < 2; ++bj)
#pragma unroll
                    for (int n = 0; n < 2; ++n) o[m][bj][n] = *(const f32x4*)(rowp + bj * HALF + n * 16); }
#pragma unroll
            for (int m = 0; m < 4; ++m) { if (tok[ai * 4 + m] >= 0) { float* rowp = XF + (size_t)tok[ai * 4 + m] * 1024 + col0; const float g1 = gt[ai * 4 + m];
#pragma unroll
                for (int bj = 0; bj < 2; ++bj)
#pragma unroll
                    for (int n = 0; n < 2; ++n) *(f32x4*)(rowp + bj * HALF + n * 16) = o[m][bj][n] + acc[ai][bj][m][n] * g1; } }
        }
    }
};
template <bool DOWN>
struct MoeSched {
    int mode, n0, a0, j0, n1, a1, j1, G, c; const PG8_LAS int* tab;
    static constexpr int nN = DOWN ? 4 : 28;
    __device__ bool next(int i, Unit& u) const {
        int j, t;
        if (mode != 0) { if (i != 0 || mode == 2) return false; j = j0; t = a0; u.pn = c; }
        else {
            const int V = n0 + n1, nwg = V * nN; const long L = (long)i * G + c; if (L >= nwg) return false;
            int wgid = (int)L; { const int q = nwg / NXCD, r = nwg % NXCD, xcd = wgid % NXCD, off = wgid / NXCD; wgid = (xcd < r ? xcd * (q + 1) : r * (q + 1) + (xcd - r) * q) + off; }
            const int nig = WGM * nN, gid = wgid / nig, fm = gid * WGM, gsz = (V - fm) < WGM ? (V - fm) : WGM;
            const int vm = fm + ((wgid % nig) % gsz); u.pn = (wgid % nig) / gsz;
            if (vm < n0) { j = j0; t = a0 + vm; } else { j = j1; t = a1 + (vm - n0); }
        }
        u.aux = moe_expert(tab, j, t); u.sel = j;
        if (DOWN) { u.pm = t; u.am = moe_hphys(j, t); } else { u.pm = moe_hphys(j, t); u.am = t; }
        return true;
    }
    __device__ __forceinline__ const char* aptr(const Gemm& g, const Unit& u) const { return (const char*)g.A + (DOWN ? (size_t)0 : (size_t)u.sel * (size_t)(36u << 20)) + (size_t)u.am * ((size_t)BM * g.K * 2); }
    __device__ __forceinline__ const char* bptr(const Gemm& g, const Unit& u) const { return (const char*)g.Bt + (size_t)u.aux * ((size_t)g.N * g.K * 2) + (size_t)u.pn * ((size_t)BM * g.K * 2); }
    __device__ __forceinline__ void a_ready(const Unit&) const {}
    __device__ __forceinline__ void done(const Unit&) const {}
};
}
#ifndef PG8_SP2
#define PG8_SP2 true
#endif
#ifndef PG8_ALIGN
#define PG8_ALIGN true
#endif

constexpr size_t MiB = 1u << 20;
constexpr size_t WS_CTL = 0, CTL_BYTES = 256 * 1024;
constexpr size_t WS_ROPE = 256 * 1024;
constexpr size_t WS_WIN = 1 * MiB;
constexpr size_t WS_WO = 16 * MiB;
constexpr size_t WS_WGU = 20 * MiB;
constexpr size_t WS_WD = 31 * MiB;
constexpr size_t WS_XB = 37 * MiB;
constexpr size_t WS_GAB = 69 * MiB;
constexpr size_t WS_LIST = WS_GAB + 512 * 1024;
constexpr size_t WS_GATE = WS_LIST + 1 * MiB;
constexpr size_t WS_CD = WS_GATE + 128 * 1024;
constexpr size_t WS_RWT = WS_CD + 8 * 1024;
constexpr size_t WS_WMGU = 71 * MiB, WS_WMD = 183 * MiB;
constexpr size_t WS_R = 239 * MiB;
constexpr size_t R_HP = 0, R_OB = 112 * MiB, R_U = 144 * MiB, R_WN = 160 * MiB, R_QD = 176 * MiB, R_KDT = 192 * MiB, R_QK = 208 * MiB;
constexpr size_t WS_SSQ = WS_XB + 16 * MiB;
constexpr size_t WS_KV = WS_XB;
constexpr size_t R_MIX = 0, R_H = 64 * MiB;
constexpr size_t R_HM = 0, R_XG = 140 * MiB, XG_PASS = 36 * MiB;
constexpr size_t WS_END = WS_R + 216 * MiB;
constexpr int CW_TMO = 0, CW_BAR = 4096, CW_MOE = 16384, CW_WQ = 24576, CW_SUB = 28672;

constexpr int RING_BYTES = 131072, LDS_BYTES = 147456, LDSCTL_OFF = LDS_BYTES - 512, MISC_OFF = LDSCTL_OFF + 320;

constexpr int PH_PRO = 0;
constexpr int PH_L(int l, int k) { return 1 + 16 * l + k; }
constexpr int K_IN = 0, K_PREP = 1, K_SCAN = 2, K_OUT = 3, K_LN1 = 4, K_GU = 5, K_DN = 6, K_LN2 = 7;
constexpr int K_FIN = 12;
constexpr int K_G0 = 5, K_GU0 = 6, K_DN0 = 7, K_G1 = 8, K_GU1 = 9, K_DN1 = 10, K_LNF = 11;
constexpr int PH_END = 1 + 16 * 2;

struct Args { const float* in[18]; float* out; unsigned char* ws; int ph_lo, ph_hi; };
typedef const __attribute__((address_space(4))) Args* KArgs;
__device__ __forceinline__ KArgs kargs() { KArgs p = (KArgs)__builtin_amdgcn_kernarg_segment_ptr(); asm volatile("" : "+s"(p)); return p; }
__device__ __forceinline__ int tidx() { int t = threadIdx.x; asm volatile("" : "+v"(t)); return t; }

constexpr int TR_SCR = 64 * 65 * 4;
__device__ __forceinline__ void tr_item(const float* W, int N, int k0, int n0, bf16* WT, size_t ldk, int dst_row0, LAS float* scr, int lane, bool blk = false) {
    const int nq = 4 * (lane & 15), n = n0 + nq, kr = lane >> 4;
    f32x4 v[16];
#pragma unroll
    for (int i = 0; i < 16; ++i) v[i] = (n < N) ? *(const f32x4*)(W + (size_t)(k0 + 4 * i + kr) * N + n) : (f32x4){0.f, 0.f, 0.f, 0.f};
#pragma unroll
    for (int i = 0; i < 16; ++i) { LAS float* d = scr + (4 * i + kr) * 65 + nq; d[0] = v[i].x; d[1] = v[i].y; d[2] = v[i].z; d[3] = v[i].w; }
    LDS_WAIT(); asm volatile("" ::: "memory");
    const int c = lane & 7;
#pragma unroll
    for (int j = 0; j < 8; ++j) { const int nn = (lane >> 3) + 8 * j; const LAS float* s = scr + (8 * c) * 65 + nn;
        v4u o; o.x = pk2(s[0 * 65], s[1 * 65]); o.y = pk2(s[2 * 65], s[3 * 65]); o.z = pk2(s[4 * 65], s[5 * 65]); o.w = pk2(s[6 * 65], s[7 * 65]);
        const int dr = dst_row0 + nn;
        bf16* dp = blk ? WT + ((size_t)(dr >> 8) * (ldk >> 6) + (k0 >> 6)) * (256 * 64) + (dr & 255) * 64 + 8 * c : WT + (size_t)dr * ldk + k0 + 8 * c;
        *(v4u*)dp = o; }
    LDS_WAIT(); asm volatile("" ::: "memory");
}

constexpr int PRO_I_IN = 16 * 57, PRO_NIT = 2 * (16 * 57 + 16 * 16) + 2 * (16 * 44) + 44 * 16;
__device__ __forceinline__ void ph_prologue(KArgs a, LAS unsigned char* lds, int wave, int lane, int gw, int NGW, int gtid, int NT, int it_lo, int it_hi, bool misc) {
    unsigned char* ws = a->ws;
    LAS float* scr = (LAS float*)(lds + wave * TR_SCR);
    constexpr int I_IN = 16 * 57, I_O = 16 * 16, I_L = I_IN + I_O, I_G = 16 * 44, I_D = 44 * 16, NIT = 2 * I_L + 2 * I_G + I_D;
    static_assert(NIT == PRO_NIT && I_IN == PRO_I_IN, "prologue item counts");
    for (int it = it_lo + gw; it < it_hi; it += NGW) {
        int r = it;
        if (r < 2 * I_L) { const int l = r / I_L; r -= l * I_L;
            if (r < I_IN) { const int kb = r / 57, nb = r % 57; tr_item(a->in[1] + (size_t)l * 1024 * IN_COLS, IN_COLS, 64 * kb, 64 * nb, (bf16*)(ws + WS_WIN) + (size_t)l * NIN_PAD * 1024, 1024, 64 * nb, scr, lane); }
            else { r -= I_IN; const int kb = r / 16, nb = r % 16; tr_item(a->in[6] + (size_t)l * 1024 * 1024, 1024, 64 * kb, 64 * nb, (bf16*)(ws + WS_WO) + (size_t)l * 1024 * 1024, 1024, 64 * nb, scr, lane); }
            continue; }
        r -= 2 * I_L;
        if (r < 2 * I_G) { const int up = r / I_G; r -= up * I_G; const int kb = r / 44, nb = r % 44, n0 = 64 * nb;
            tr_item(up ? a->in[12] : a->in[11], FF, 64 * kb, n0, (bf16*)(ws + WS_WGU), 1024, 256 * (n0 >> 7) + (n0 & 127) + 128 * up, scr, lane); continue; }
        r -= 2 * I_G;
        { const int kb = r / 16, nb = r % 16; tr_item(a->in[13], 1024, 64 * kb, 64 * nb, (bf16*)(ws + WS_WD), FF, 64 * nb, scr, lane); }
    }
    if (!misc) return;
    for (int i = gtid; i < 2 * 192 * 128; i += NT) { const int l = i / (192 * 128), r = i % (192 * 128);
        ((v4u*)((bf16*)(ws + WS_WIN) + (size_t)l * NIN_PAD * 1024 + (size_t)3648 * 1024))[r] = (v4u){0u, 0u, 0u, 0u}; }
    for (int i = gtid; i < M * D / 8; i += NT) { const f32x4 p = ((const f32x4*)a->in[0])[2 * i], q = ((const f32x4*)a->in[0])[2 * i + 1];
        v4u o; o.x = pk2(p.x, p.y); o.y = pk2(p.z, p.w); o.z = pk2(q.x, q.y); o.w = pk2(q.z, q.w); ((v4u*)(ws + WS_XB))[i] = o; }
    for (int i = gtid; i < 8192; i += NT) ((float*)(ws + WS_RWT))[(i & 7) * 1024 + (i >> 3)] = a->in[14][i];
    for (int i = gtid; i < SEQ * 32; i += NT) { const int pos = i >> 5, k = i & 31;
        const float inv = powf(10000.0f, -(float)(2 * k) / 64.0f); const float ang = (float)pos * inv;
        double rev = (double)ang * 0.15915494309189535; rev -= floor(rev); const float rf = (float)rev;
        float* R = (float*)(ws + WS_ROPE) + (size_t)pos * 64; R[k] = __builtin_amdgcn_cosf(rf); R[32 + k] = __builtin_amdgcn_sinf(rf); }
}

__device__ __forceinline__ void moe_convert(KArgs a, LAS unsigned char* lds, int wave, int lane, int gw, int NGW, int e_lo, int e_hi, int item = -1) {
    unsigned char* ws = a->ws;
    LAS float* scr = (LAS float*)(lds + wave * TR_SCR);
    constexpr int I_G = 16 * 56, I_D = 56 * 16, I_E = 2 * I_G + I_D;
    for (int it = (item >= 0 ? item : e_lo * I_E + gw); it < (item >= 0 ? item + 1 : e_hi * I_E); it += NGW) {
        const int e = it / I_E; int r = it - e * I_E;
        if (r < 2 * I_G) { const int up = r / I_G; r -= up * I_G; const int kb = r / 56, nb = r % 56, n0 = 64 * nb;
            tr_item((up ? a->in[16] : a->in[15]) + (size_t)e * 1024 * FE, FE, 64 * kb, n0, (bf16*)(ws + WS_WMGU) + (size_t)e * 7168 * 1024, 1024, 256 * (n0 >> 7) + (n0 & 127) + 128 * up, scr, lane); }
        else { r -= 2 * I_G; const int kb = r / 16, nb = r % 16; tr_item(a->in[17] + (size_t)e * FE * 1024, 1024, 64 * kb, 64 * nb, (bf16*)(ws + WS_WMD) + (size_t)e * 1024 * FE, FE, 64 * nb, scr, lane, true); }
    }
}

__device__ __forceinline__ void conv_queue(KArgs a, LAS unsigned char* lds, int wave, int lane, int l) {
    unsigned char* ws = a->ws;
    LAS float* scr = (LAS float*)(lds + wave * TR_SCR);
    unsigned* head = (unsigned*)(ws + WS_CTL) + CW_WQ + 64 * l;
    constexpr int I_G = 16 * 56, I_D = 56 * 16, I_E = 2 * I_G + I_D;
    const int e_lo = (l == 0 ? 0 : 3), n_moe = (l == 0 ? 3 : 5) * I_E, n_all = n_moe + (l == 0 ? PRO_NIT - PRO_I_IN : 0);
    for (;;) {
        unsigned it0 = 0; if (lane == 0) it0 = __hip_atomic_fetch_add(head, 8u, RLX_AGENT);
        it0 = __builtin_amdgcn_readfirstlane(it0);
        if ((int)it0 >= n_all) break;
#pragma unroll 1
        for (int k = 0; k < 8; ++k) { const int it = (int)it0 + k; if (it >= n_all) break;
            if (it < n_moe) moe_convert(a, lds, wave, lane, 0, 1 << 30, 0, 0, e_lo * I_E + it);
            else ph_prologue(a, lds, wave, lane, 0, 1 << 30, 0, 0, PRO_I_IN + (it - n_moe), PRO_I_IN + (it - n_moe) + 1, false); }
    }
}

__device__ __forceinline__ void conv_range(KArgs a, LAS unsigned char* lds, int wave, int lane, int l, int lo, int hi, int gw, int NGW) {
    constexpr int I_G = 16 * 56, I_D = 56 * 16, I_E = 2 * I_G + I_D;
    const int n_moe = 4 * I_E;
    for (int it = lo + gw; it < hi; it += NGW) {
        if (it < n_moe) moe_convert(a, lds, wave, lane, 0, 1 << 30, 0, 0, 4 * l * I_E + it);
        else ph_prologue(a, lds, wave, lane, 0, 1 << 30, 0, 0, PRO_I_IN + (it - n_moe), PRO_I_IN + (it - n_moe) + 1, false);
    }
}
constexpr int CONV_N_MOE = 4 * (2 * 16 * 56 + 56 * 16);

template <bool ROUTE>
__device__ __forceinline__ void ln_rows(const float* res, float ares, const bf16* mix, const float* g, const float* bta, float* xf, float oscale, bf16* xb,
                                        const float* router, unsigned* cntw, int* list, float* gate, int lane, int gw, int NGW, LAS unsigned char* lds = nullptr, int tid = 0) {
    LAS unsigned* lcnt = (LAS unsigned*)lds; LAS unsigned* lbase = lcnt + 16; LAS unsigned* rec = lcnt + 32;
    int nrec = 0;
    if (ROUTE) { __syncthreads(); if (tid < 16) lcnt[tid] = 0u; __syncthreads(); }
    f32x4 gv[4], bv[4];
#pragma unroll
    for (int j = 0; j < 4; ++j) { gv[j] = ((const f32x4*)g)[lane + 64 * j]; bv[j] = ((const f32x4*)bta)[lane + 64 * j]; }
    f32x4 rn[4]; v2u mn[4];
#define LN_FETCH(r_) do { const f32x4* rr_ = (const f32x4*)(res + (size_t)(r_) * D) + lane; _Pragma("unroll") for (int j = 0; j < 4; ++j) rn[j] = rr_[64 * j]; \
        if (mix) { const v2u* mr_ = (const v2u*)(mix + (size_t)(r_) * D) + lane; _Pragma("unroll") for (int j = 0; j < 4; ++j) mn[j] = mr_[64 * j]; } } while (0)
#pragma unroll
    for (int j = 0; j < 4; ++j) { rn[j] = (f32x4){0.f, 0.f, 0.f, 0.f}; mn[j] = (v2u){0u, 0u}; }
    if (gw < M) LN_FETCH(gw);
    for (int row = gw; row < M; row += NGW) {
        f32x4 v[4]; float s = 0.f;
#pragma unroll
        for (int j = 0; j < 4; ++j) { v[j] = rn[j] * ares; if (mix) v[j] = v[j] + (f32x4){bflo(mn[j].x), bfhi(mn[j].x), bflo(mn[j].y), bfhi(mn[j].y)}; }
        if (row + NGW < M) LN_FETCH(row + NGW);
#pragma unroll
        for (int j = 0; j < 4; ++j) s += (v[j].x + v[j].y) + (v[j].z + v[j].w);
        const float mean = wave_sum(s) * (1.f / D); float s2 = 0.f;
#pragma unroll
        for (int j = 0; j < 4; ++j) { v[j] = v[j] - mean; s2 += (v[j].x * v[j].x + v[j].y * v[j].y) + (v[j].z * v[j].z + v[j].w * v[j].w); }
        const float rstd = 1.f / sqrtf(wave_sum(s2) * (1.f / D) + LN_EPS);
#pragma unroll
        for (int j = 0; j < 4; ++j) v[j] = v[j] * rstd * gv[j] + bv[j];
        f32x4* xo = (f32x4*)(xf + (size_t)row * D) + lane;
#pragma unroll
        for (int j = 0; j < 4; ++j) xo[64 * j] = v[j] * oscale;
        if (xb) { v2u* bo = (v2u*)(xb + (size_t)row * D) + lane;
#pragma unroll
            for (int j = 0; j < 4; ++j) { v2u o; o.x = pk2(v[j].x, v[j].y); o.y = pk2(v[j].z, v[j].w); bo[64 * j] = o; } }
        if (ROUTE) {
            float lg[8];
#pragma unroll
            for (int e = 0; e < 8; ++e) lg[e] = 0.f;
#pragma unroll
            for (int e = 0; e < 8; ++e)
#pragma unroll
                for (int j = 0; j < 4; ++j) { const f32x4 r4 = ((const f32x4*)(router + e * 1024))[lane + 64 * j]; lg[e] += (v[j].x * r4.x + v[j].y * r4.y) + (v[j].z * r4.z + v[j].w * r4.w); }
#pragma unroll
            for (int e = 0; e < 8; ++e) lg[e] = wave_sum(lg[e]);
            if (lane == 0) {
                int e0 = 0; float v0 = lg[0];
#pragma unroll
                for (int e = 1; e < 8; ++e) if (lg[e] > v0) { v0 = lg[e]; e0 = e; }
                int e1 = -1; float v1 = -3.0e38f;
#pragma unroll
                for (int e = 0; e < 8; ++e) if (e != e0 && lg[e] > v1) { v1 = lg[e]; e1 = e; }
                const float p1 = __expf(v1 - v0), g0 = 1.f / (1.f + p1), g1 = p1 / (1.f + p1);
                const int wv = (int)(tid >> 6), k = nrec++;
                const unsigned l0 = __hip_atomic_fetch_add(lcnt + e0, 1u, __ATOMIC_RELAXED, __HIP_MEMORY_SCOPE_WORKGROUP), l1 = __hip_atomic_fetch_add(lcnt + 8 + e1, 1u, __ATOMIC_RELAXED, __HIP_MEMORY_SCOPE_WORKGROUP);
                rec[(wv * 16 + k) * 4 + 0] = (unsigned)row; rec[(wv * 16 + k) * 4 + 1] = (unsigned)e0 | ((unsigned)e1 << 8); rec[(wv * 16 + k) * 4 + 2] = l0; rec[(wv * 16 + k) * 4 + 3] = l1;
                gate[row] = g0; gate[16384 + row] = g1;
            }
        }
    }
    if (ROUTE) {
        __syncthreads();
        if (tid < 16) { const unsigned c = lcnt[tid]; lbase[tid] = c ? __hip_atomic_fetch_add(cntw + 64 * tid, c, RLX_AGENT) : 0u; }
        __syncthreads();
        if (lane == 0) { const int wv = (int)(tid >> 6);
            for (int k = 0; k < nrec; ++k) { const unsigned row = rec[(wv * 16 + k) * 4], ee = rec[(wv * 16 + k) * 4 + 1], l0 = rec[(wv * 16 + k) * 4 + 2], l1 = rec[(wv * 16 + k) * 4 + 3];
                const unsigned e0 = ee & 255u, e1 = ee >> 8;
                list[(size_t)e0 * 16384 + lbase[e0] + l0] = (int)row; list[(size_t)(8 + e1) * 16384 + lbase[8 + e1] + l1] = (int)row; } }
    }
}

__device__ __forceinline__ void moe_gather(KArgs a, int j, int lane, int gw, int NGW) {
    unsigned char* ws = a->ws; const unsigned* cntw = (const unsigned*)(ws + WS_CTL) + CW_MOE + 64 * (j * 8);
    int pre[8], cum[8]; { int p = 0, t = 0;
#pragma unroll
        for (int e = 0; e < 8; ++e) { const int c = (int)cntw[64 * e]; pre[e] = p; cum[e] = t; p += c; t += (c + 255) >> 8; } }
    const int* list = (const int*)(ws + WS_LIST) + (size_t)j * 8 * 16384;
    for (int r0 = gw; r0 < M; r0 += 8 * NGW) {
        int tok[8], drow[8];
#pragma unroll
        for (int q = 0; q < 8; ++q) { const int r = r0 + q * NGW; tok[q] = -1; drow[q] = 0;
            if (r < M) { int e = 0;
#pragma unroll
                for (int k = 1; k < 8; ++k) e += (r >= pre[k]) ? 1 : 0;
                int pe = 0, ce = 0;
#pragma unroll
                for (int k = 0; k < 8; ++k) if (k == e) { pe = pre[k]; ce = cum[k]; }
                const int s = r - pe; tok[q] = list[(size_t)e * 16384 + s]; drow[q] = ce * 256 + s; } }
        v4u x0[8], x1[8];
#pragma unroll
        for (int q = 0; q < 8; ++q) { const v4u* src = (const v4u*)((const bf16*)(ws + WS_XB) + (size_t)(tok[q] >= 0 ? tok[q] : 0) * 1024); x0[q] = src[lane]; x1[q] = src[lane + 64]; }
#pragma unroll
        for (int q = 0; q < 8; ++q) if (tok[q] >= 0) { v4u* dst = (v4u*)((bf16*)(ws + WS_R + R_XG + (size_t)j * XG_PASS) + (size_t)drow[q] * 1024); dst[lane] = x0[q]; dst[lane + 64] = x1[q]; }
    }
}

__device__ __forceinline__ void gdn_prep_unit(KArgs a, int l, int unit, LAS unsigned char* lds, int tid, int lane, int wave) {
    unsigned char* ws = a->ws;
    const int n = unit & 31, bh = unit >> 5, h = bh & 3, b = bh >> 2;
    const int t0 = b * SEQ + n * 64;
    LAS float* Q = (LAS float*)lds; LAS float* K = Q + 8192; LAS float* V = K + 8192; LAS float* A = V + 8192; LAS float* gc = A + 4096; LAS float* bt = gc + 64;
    const bf16* HP = (const bf16*)(ws + WS_R + R_HP);
    const float* cw = a->in[2] + (size_t)l * 4 * 1536;
    __syncthreads();
    for (int idx = tid; idx < 64 * 384; idx += 512) { const int i = idx / 384, c = idx % 384, which = c >> 7, d = c & 127;
        const int col = COL_GQ + which * 512 + h * 128 + d, cc = which * 512 + h * 128 + d; float acc = 0.f;
#pragma unroll
        for (int j = 0; j < 4; ++j) { const int s = n * 64 + i - 3 + j; if (s >= 0) acc += cw[j * 1536 + cc] * bf2f(HP[(size_t)(b * SEQ + s) * HP_LD + col]); }
        const float y = siluf(acc); LAS float* dst = which == 0 ? Q : (which == 1 ? K : V); dst[i * 128 + d] = y; }
    if (tid < 64) { const float* gab = (const float*)(ws + WS_GAB) + (size_t)(t0 + tid) * 8; const float x = gab[h] + a->in[4][l * 4 + h];
        const float sp = fmaxf(x, 0.f) + log1pf(__expf(-fabsf(x))); gc[tid] = -__expf(a->in[3][l * 4 + h]) * sp; bt[tid] = sigmf(gab[4 + h]); }
    __syncthreads();
#pragma unroll 1
    for (int r = 0; r < 8; ++r) { const int i = wave * 8 + r;
        float q0 = Q[i * 128 + lane], q1 = Q[i * 128 + lane + 64], k0 = K[i * 128 + lane], k1 = K[i * 128 + lane + 64];
        const float sq = wave_sum(q0 * q0 + q1 * q1), sk = wave_sum(k0 * k0 + k1 * k1);
        const float fq = rsqrtf(sq + NORM_EPS) * 0.08838834764831845f, fk = rsqrtf(sk + NORM_EPS);
        Q[i * 128 + lane] = q0 * fq; Q[i * 128 + lane + 64] = q1 * fq; K[i * 128 + lane] = k0 * fk; K[i * 128 + lane + 64] = k1 * fk; }
    if (tid == 0) { float c = 0.f; for (int i = 0; i < 64; ++i) { c += gc[i]; gc[i] = c; } }
    __syncthreads();
    bf16* QKg = (bf16*)(ws + WS_R + R_QK) + (size_t)unit * 4096; bf16* QDg = (bf16*)(ws + WS_R + R_QD) + (size_t)unit * 8192; bf16* KDTg = (bf16*)(ws + WS_R + R_KDT) + (size_t)unit * 8192;
    bf16* WNg = (bf16*)(ws + WS_R + R_WN) + (size_t)unit * 8192; bf16* Ug = (bf16*)(ws + WS_R + R_U) + (size_t)unit * 8192;
    for (int idx = tid; idx < 4096; idx += 512) { const int i = idx >> 6, j = idx & 63; float dqk = 0.f, dkk = 0.f;
        for (int dd = 0; dd < 128; ++dd) { const int d = (dd + j) & 127; const float kj = K[j * 128 + d]; dqk += Q[i * 128 + d] * kj; dkk += K[i * 128 + d] * kj; }
        const float dec = __expf(gc[i] - gc[j]);
        A[i * 64 + j] = (j < i) ? bt[i] * dkk * dec : 0.f;
        QKg[fragoff(i, j, 2)] = (bf16)f2bf((j <= i) ? dqk * dec : 0.f); }
    const float gl = gc[63];
    for (int idx = tid; idx < 8192; idx += 512) { const int i = idx >> 7, d = idx & 127;
        QDg[fragoff(i, d, 4)] = (bf16)f2bf(Q[i * 128 + d] * __expf(gc[i]));
        KDTg[fragoff(d, i, 2)] = (bf16)f2bf(K[i * 128 + d] * __expf(gl - gc[i])); }
    if (tid == 0) ((float*)(ws + WS_CD))[unit] = __expf(gl);
    __syncthreads();
    for (int idx = tid; idx < 8192; idx += 512) { const int i = idx >> 7; const float bi = bt[i]; V[idx] *= bi; Q[idx] = bi * __expf(gc[i]) * K[idx]; }
    __syncthreads();
    if (tid < 256) { LAS float* buf = (tid < 128 ? V : Q) + (tid & 127);
        for (int i = 1; i < 64; ++i) { float acc = buf[i * 128]; for (int m = 0; m < i; ++m) acc -= A[i * 64 + m] * buf[m * 128]; buf[i * 128] = acc; } }
    __syncthreads();
    for (int idx = tid; idx < 8192; idx += 512) { const int i = idx >> 7, d = idx & 127; Ug[uoff(i, d)] = (bf16)f2bf(V[idx]); WNg[fragoff(i, d, 4)] = (bf16)f2bf(-Q[idx]); }
}

__device__ __forceinline__ void gdn_scan_naive(KArgs a, int l, int bh, LAS unsigned char* lds, int tid, int lane, int wave) {
    unsigned char* ws = a->ws;
    LAS float* S = (LAS float*)lds; LAS float* VN = S + 16384; LAS float* O = VN + 8192;
    const int h = bh & 3, b = bh >> 2, e = tid & 127, ig = tid >> 7;
    const bf16* HP = (const bf16*)(ws + WS_R + R_HP); bf16* OB = (bf16*)(ws + WS_R + R_OB);
    const float* nw = a->in[5] + l * 128;
    __syncthreads();
    for (int idx = tid; idx < 16384; idx += 512) S[idx] = 0.f;
    __syncthreads();
#pragma unroll 1
    for (int n = 0; n < 32; ++n) {
        const int unit = bh * 32 + n;
        const bf16* Ug = (const bf16*)(ws + WS_R + R_U) + (size_t)unit * 8192; const bf16* WNg = (const bf16*)(ws + WS_R + R_WN) + (size_t)unit * 8192;
        const bf16* QDg = (const bf16*)(ws + WS_R + R_QD) + (size_t)unit * 8192; const bf16* KDTg = (const bf16*)(ws + WS_R + R_KDT) + (size_t)unit * 8192;
        const bf16* QKg = (const bf16*)(ws + WS_R + R_QK) + (size_t)unit * 4096; const float cd = ((const float*)(ws + WS_CD))[unit];
#pragma unroll 1
        for (int r = 0; r < 16; ++r) { const int i = ig + 4 * r; float acc = bf2f(Ug[uoff(i, e)]);
#pragma unroll 2
            for (int d0 = 0; d0 < 128; d0 += 4) { const v2u w = *(const v2u*)(WNg + fragoff(i, d0, 4));
                acc += bflo(w.x) * S[d0 * 128 + e] + bfhi(w.x) * S[(d0 + 1) * 128 + e] + bflo(w.y) * S[(d0 + 2) * 128 + e] + bfhi(w.y) * S[(d0 + 3) * 128 + e]; }
            VN[i * 128 + e] = acc; }
        __syncthreads();
#pragma unroll 1
        for (int r = 0; r < 16; ++r) { const int i = ig + 4 * r; float acc = 0.f;
#pragma unroll 2
            for (int d0 = 0; d0 < 128; d0 += 4) { const v2u w = *(const v2u*)(QDg + fragoff(i, d0, 4));
                acc += bflo(w.x) * S[d0 * 128 + e] + bfhi(w.x) * S[(d0 + 1) * 128 + e] + bflo(w.y) * S[(d0 + 2) * 128 + e] + bfhi(w.y) * S[(d0 + 3) * 128 + e]; }
#pragma unroll 2
            for (int j0 = 0; j0 < 64; j0 += 4) { const v2u w = *(const v2u*)(QKg + fragoff(i, j0, 2));
                acc += bflo(w.x) * VN[j0 * 128 + e] + bfhi(w.x) * VN[(j0 + 1) * 128 + e] + bflo(w.y) * VN[(j0 + 2) * 128 + e] + bfhi(w.y) * VN[(j0 + 3) * 128 + e]; }
            O[i * 128 + e] = acc; }
        __syncthreads();
#pragma unroll 1
        for (int r = 0; r < 32; ++r) { const int d = ig + 4 * r; float acc = S[d * 128 + e] * cd;
#pragma unroll 2
            for (int i0 = 0; i0 < 64; i0 += 4) { const v2u w = *(const v2u*)(KDTg + fragoff(d, i0, 2));
                acc += bflo(w.x) * VN[i0 * 128 + e] + bfhi(w.x) * VN[(i0 + 1) * 128 + e] + bflo(w.y) * VN[(i0 + 2) * 128 + e] + bfhi(w.y) * VN[(i0 + 3) * 128 + e]; }
            S[d * 128 + e] = acc; }
#pragma unroll 1
        for (int r = 0; r < 8; ++r) { const int i = wave * 8 + r; const float v0 = O[i * 128 + lane], v1 = O[i * 128 + lane + 64];
            const float rs = rsqrtf(wave_sum(v0 * v0 + v1 * v1) * (1.f / 128.f) + NORM_EPS);
            const size_t t = (size_t)b * SEQ + n * 64 + i; const bf16* gp = HP + t * HP_LD + COL_GG + h * 128; bf16* op = OB + t * 1024 + 512 + h * 128;
            op[lane] = (bf16)f2bf(v0 * rs * nw[lane] * siluf(bf2f(gp[lane]))); op[lane + 64] = (bf16)f2bf(v1 * rs * nw[lane + 64] * siluf(bf2f(gp[lane + 64]))); }
        __syncthreads();
    }
}

__device__ __forceinline__ void ret_unit_naive(KArgs a, int unit, LAS unsigned char* lds, int tid, int lane, int wave) {
    unsigned char* ws = a->ws;
    LAS float* Qs = (LAS float*)lds; LAS float* Ks = Qs + 64 * 65; LAS float* Vs = Ks + 64 * 65; LAS float* Sc = Vs + 8192;
    const int qb = unit & 31, bh = unit >> 5, h = bh & 3, b = bh >> 2, e = tid & 127, ig = tid >> 7;
    const bf16* HP = (const bf16*)(ws + WS_R + R_HP); bf16* OB = (bf16*)(ws + WS_R + R_OB); const float* RT = (const float*)(ws + WS_ROPE);
    const float log2g = log2f(1.0f - exp2f(-5.0f - (float)h));
    __syncthreads();
    for (int idx = tid; idx < 4096; idx += 512) { const int i = idx >> 6, d = idx & 63, dd = d & 31, pos = qb * 64 + i; const size_t t = (size_t)b * SEQ + pos;
        const float c = RT[pos * 64 + dd], s = RT[pos * 64 + 32 + dd]; const float x1 = bf2f(HP[t * HP_LD + COL_RQ + h * 64 + dd]), x2 = bf2f(HP[t * HP_LD + COL_RQ + h * 64 + dd + 32]);
        Qs[i * 65 + d] = d < 32 ? x1 * c - x2 * s : x1 * s + x2 * c; }
    float acc[16];
#pragma unroll
    for (int r = 0; r < 16; ++r) acc[r] = 0.f;
#pragma unroll 1
    for (int kb = 0; kb <= qb; ++kb) {
        __syncthreads();
        for (int idx = tid; idx < 4096; idx += 512) { const int i = idx >> 6, d = idx & 63, dd = d & 31, pos = kb * 64 + i; const size_t t = (size_t)b * SEQ + pos;
            const float c = RT[pos * 64 + dd], s = RT[pos * 64 + 32 + dd]; const float x1 = bf2f(HP[t * HP_LD + COL_RK + h * 64 + dd]), x2 = bf2f(HP[t * HP_LD + COL_RK + h * 64 + dd + 32]);
            Ks[i * 65 + d] = 0.125f * (d < 32 ? x1 * c - x2 * s : x1 * s + x2 * c); }
        for (int idx = tid; idx < 8192; idx += 512) { const int i = idx >> 7, d = idx & 127; Vs[idx] = bf2f(HP[((size_t)b * SEQ + kb * 64 + i) * HP_LD + COL_RV + h * 128 + d]); }
        __syncthreads();
        { const int j = tid & 63, ig8 = tid >> 6;
#pragma unroll 1
          for (int r = 0; r < 8; ++r) { const int i = ig8 + 8 * r; float dot = 0.f;
#pragma unroll 8
              for (int d = 0; d < 64; ++d) dot += Qs[i * 65 + d] * Ks[j * 65 + d];
              const int delta = (qb - kb) * 64 + i - j; Sc[i * 65 + j] = delta >= 0 ? dot * exp2f((float)delta * log2g) : 0.f; } }
        __syncthreads();
#pragma unroll 2
        for (int j = 0; j < 64; ++j) { const float vv = Vs[j * 128 + e];
#pragma unroll
            for (int r = 0; r < 16; ++r) acc[r] += Sc[(ig + 4 * r) * 65 + j] * vv; }
    }
    __syncthreads();
#pragma unroll
    for (int r = 0; r < 16; ++r) Vs[(ig + 4 * r) * 128 + e] = acc[r];
    __syncthreads();
#pragma unroll 1
    for (int r = 0; r < 8; ++r) { const int i = wave * 8 + r; const float v0 = Vs[i * 128 + lane], v1 = Vs[i * 128 + lane + 64];
        const float mean = wave_sum(v0 + v1) * (1.f / 128.f), d0 = v0 - mean, d1 = v1 - mean; const float rs = rsqrtf(wave_sum(d0 * d0 + d1 * d1) * (1.f / 128.f) + LN_EPS);
        const size_t t = (size_t)b * SEQ + qb * 64 + i; const bf16* gp = HP + t * HP_LD + COL_RG + h * 128; bf16* op = OB + t * 1024 + h * 128;
        op[lane] = (bf16)f2bf(d0 * rs * siluf(bf2f(gp[lane]))); op[lane + 64] = (bf16)f2bf(d1 * rs * siluf(bf2f(gp[lane + 64]))); }
}

typedef float f32x16 __attribute__((ext_vector_type(16)));
typedef float f32x8 __attribute__((ext_vector_type(8)));
typedef __bf16 bf8v __attribute__((ext_vector_type(8)));
typedef short bf16x8 __attribute__((ext_vector_type(8)));
#define MFMA32(a, b, c) __builtin_amdgcn_mfma_f32_32x32x16_bf16((a), (b), (c), 0, 0, 0)
__device__ __forceinline__ bf16x8 pack8(const f32x16& x, int s) {
    f32x8 v;
#pragma unroll
    for (int j = 0; j < 8; ++j) v[j] = x[8 * s + j];
    return __builtin_bit_cast(bf16x8, __builtin_convertvector(v, bf8v));
}

__device__ __forceinline__ unsigned short bfc(float x) { return __builtin_bit_cast(unsigned short, (__bf16)x); }
__device__ __forceinline__ unsigned bfc2(float lo, float hi) { return (unsigned)bfc(lo) | ((unsigned)bfc(hi) << 16); }

#ifndef PROBE_UNIT
#define PROBE_UNIT 0
#endif
#if defined(PROBE_MULT) && PROBE_MULT > 0
#define STAMPT(id, thr) do { if (blockIdx.x == PROBE_BID && threadIdx.x == (thr)) __hip_atomic_store((unsigned long long*)(a->ws + WS_CTL + 131072) + (id), (unsigned long long)__builtin_amdgcn_s_memrealtime(), RLX_AGENT); } while (0)
#else
#define STAMPT(id, thr) do {} while (0)
#endif
#define GDN_BAR() do { asm volatile("s_waitcnt lgkmcnt(0)" ::: "memory"); __builtin_amdgcn_s_barrier(); asm volatile("" ::: "memory"); } while (0)
__device__ __forceinline__ void gdn_scan_fast(KArgs a, int l, int bh, LAS unsigned char* lds, int tid, int lane, int wave) {
    unsigned char* ws = a->ws;
    constexpr int FB_WN = 0, FB_QD = 16384, FB_KDT = 32768, FB_QK = 49152, FB_U = 57344, FB_BYTES = 73728;
    LAS float* OL = (LAS float*)(lds + FB_BYTES);
    constexpr int OLS = 64 * 132;
    const int h = bh & 3, b = bh >> 2, c = lane & 31, hh = lane >> 5;
    const bf16* HP = (const bf16*)(ws + WS_R + R_HP); bf16* OB = (bf16*)(ws + WS_R + R_OB);
    const float* nw = a->in[5] + l * 128;
    const unsigned char* gWN = (const unsigned char*)(ws + WS_R + R_WN) + (size_t)bh * 32 * 16384; const unsigned char* gQD = (const unsigned char*)(ws + WS_R + R_QD) + (size_t)bh * 32 * 16384;
    const unsigned char* gKDT = (const unsigned char*)(ws + WS_R + R_KDT) + (size_t)bh * 32 * 16384; const unsigned char* gQK = (const unsigned char*)(ws + WS_R + R_QK) + (size_t)bh * 32 * 8192;
    const unsigned char* gU = (const unsigned char*)(ws + WS_R + R_U) + (size_t)bh * 32 * 16384;
    const int et = tid - 256;
#define GDN_FETCH(pf, nn) do { _Pragma("unroll") for (int k = 0; k < 18; ++k) { const unsigned char* src_ = k < 4 ? gWN + (size_t)(nn) * 16384 + k * 4096 : k < 8 ? gQD + (size_t)(nn) * 16384 + (k - 4) * 4096 : \
        k < 12 ? gKDT + (size_t)(nn) * 16384 + (k - 8) * 4096 : k < 14 ? gQK + (size_t)(nn) * 8192 + (k - 12) * 4096 : gU + (size_t)(nn) * 16384 + (k - 14) * 4096; pf[k] = *(const v4u*)(src_ + et * 16); } } while (0)
#define GDN_STORE(pf) do { _Pragma("unroll") for (int k = 0; k < 18; ++k) *(LAS v4u*)(lds + k * 4096 + et * 16) = pf[k]; } while (0)
    __syncthreads();
    if (wave < 4) {
        f32x16 S[4];
#pragma unroll
        for (int t = 0; t < 4; ++t)
#pragma unroll
            for (int i = 0; i < 16; ++i) S[t][i] = 0.f;
        GDN_BAR();
        const int q = wave;
        const LAS bf16x8* WNf = (const LAS bf16x8*)(lds + FB_WN) + lane; const LAS bf16x8* QDf = (const LAS bf16x8*)(lds + FB_QD) + lane;
        const LAS bf16x8* KDTf = (const LAS bf16x8*)(lds + FB_KDT) + lane; const LAS bf16x8* QKf = (const LAS bf16x8*)(lds + FB_QK) + lane;
        const LAS v4u* Uf = (const LAS v4u*)(lds + FB_U) + (q * 2) * 128 + lane;
#pragma unroll 1
        for (int n = 0; n < 32; ++n) {
            if (n == 10) STAMPT(110, 0);
            const float cd = ((const float*)(ws + WS_CD))[bh * 32 + n];
            bf16x8 A0[8], A1[8];
#define GDN_LD_MTS(A, F, g) do { _Pragma("unroll") for (int k = 0; k < 8; ++k) { const int m_ = k & 1, s_ = (k >> 1) & 1, t_ = 2 * (g) + (k >> 2); A[k] = F[((m_ * 4 + t_) * 2 + s_) * 64]; } } while (0)
#define GDN_LD_TMS(A, F, g) do { _Pragma("unroll") for (int k = 0; k < 8; ++k) { const int s_ = k & 1, m_ = (k >> 1) & 1, t_ = 2 * (g) + (k >> 2); A[k] = F[((t_ * 2 + m_) * 2 + s_) * 64]; } } while (0)
            GDN_LD_MTS(A0, WNf, 0); GDN_LD_MTS(A1, WNf, 1);
            f32x16 av[2];
#pragma unroll
            for (int m = 0; m < 2; ++m)
#pragma unroll
                for (int hf = 0; hf < 2; ++hf) { const v4u u4 = Uf[(m * 2 + hf) * 64];
#pragma unroll
                    for (int k = 0; k < 4; ++k) { av[m][8 * hf + 2 * k] = bflo(u4[k]); av[m][8 * hf + 2 * k + 1] = bfhi(u4[k]); } }
            bf16x8 Sb[4][2];
#pragma unroll
            for (int t = 0; t < 4; ++t) { Sb[t][0] = pack8(S[t], 0); Sb[t][1] = pack8(S[t], 1); }
#pragma unroll
            for (int k = 0; k < 8; ++k) { const int m_ = k & 1, s_ = (k >> 1) & 1, t_ = (k >> 2); av[m_] = MFMA32(A0[k], Sb[t_][s_], av[m_]); }
            GDN_LD_MTS(A0, QDf, 0);
#pragma unroll
            for (int k = 0; k < 8; ++k) { const int m_ = k & 1, s_ = (k >> 1) & 1, t_ = 2 + (k >> 2); av[m_] = MFMA32(A1[k], Sb[t_][s_], av[m_]); }
            GDN_LD_MTS(A1, QDf, 1);
            f32x16 ao[2];
#pragma unroll
            for (int m = 0; m < 2; ++m)
#pragma unroll
                for (int i = 0; i < 16; ++i) ao[m][i] = 0.f;
#pragma unroll
            for (int k = 0; k < 8; ++k) { const int m_ = k & 1, s_ = (k >> 1) & 1, t_ = (k >> 2); ao[m_] = MFMA32(A0[k], Sb[t_][s_], ao[m_]); }
#pragma unroll
            for (int k = 0; k < 6; ++k) { const int s_ = k & 1, m_ = k >= 2 ? 1 : 0, mp_ = k >= 4 ? 1 : 0; A0[k] = QKf[((m_ * 2 + mp_) * 2 + s_) * 64]; }
#pragma unroll
            for (int k = 0; k < 8; ++k) { const int m_ = k & 1, s_ = (k >> 1) & 1, t_ = 2 + (k >> 2); ao[m_] = MFMA32(A1[k], Sb[t_][s_], ao[m_]); }
            GDN_LD_TMS(A1, KDTf, 0);
            bf16x8 Vb[2][2];
#pragma unroll
            for (int m = 0; m < 2; ++m) { Vb[m][0] = pack8(av[m], 0); Vb[m][1] = pack8(av[m], 1); }
#pragma unroll
            for (int k = 0; k < 6; ++k) { const int s_ = k & 1, m_ = k >= 2 ? 1 : 0, mp_ = k >= 4 ? 1 : 0; ao[m_] = MFMA32(A0[k], Vb[mp_][s_], ao[m_]); }
            GDN_LD_TMS(A0, KDTf, 1);
            {   LAS float* Ob = OL + (n & 1) * OLS + 32 * wave + c;
#pragma unroll
                for (int m = 0; m < 2; ++m)
#pragma unroll
                    for (int i = 0; i < 16; ++i) Ob[(32 * m + (i & 3) + 8 * (i >> 2) + 4 * hh) * 132] = ao[m][i]; }
#pragma unroll
            for (int t = 0; t < 4; ++t)
#pragma unroll
                for (int i = 0; i < 16; ++i) S[t][i] *= cd;
#pragma unroll
            for (int k = 0; k < 8; ++k) { const int s_ = k & 1, m_ = (k >> 1) & 1, t_ = (k >> 2); S[t_] = MFMA32(A1[k], Vb[m_][s_], S[t_]); }
#pragma unroll
            for (int k = 0; k < 8; ++k) { const int s_ = k & 1, m_ = (k >> 1) & 1, t_ = 2 + (k >> 2); S[t_] = MFMA32(A0[k], Vb[m_][s_], S[t_]); }
#undef GDN_LD_MTS
#undef GDN_LD_TMS
            if (n == 10) STAMPT(111, 0);
            GDN_BAR();
            if (n == 10) STAMPT(112, 0);
            GDN_BAR();
            if (n == 10) STAMPT(113, 0);
        }
        GDN_BAR(); GDN_BAR();
    } else {
        v4u pfA[18], pfB[18];
        LAS float* NWl = OL + 2 * OLS;
        if (et < 128) NWl[et] = nw[et];
        GDN_FETCH(pfB, 0); GDN_FETCH(pfA, 1); GDN_STORE(pfB);
        GDN_BAR();
        const int i = et >> 2, qd = et & 3;
#define GDN_LOADER_ITER(n, PF_FETCH, PF_STORE) do { \
            if ((n) == 10) STAMPT(120, 256); \
            if ((n) + 2 < 32) GDN_FETCH(PF_FETCH, (n) + 2); \
            if ((n) > 0) { \
                const LAS float* Ob = OL + (((n) - 1) & 1) * OLS + i * 132 + 32 * qd; \
                float ss = 0.f; \
                _Pragma("unroll") for (int k = 0; k < 8; ++k) { const f32x4 v_ = *(const LAS f32x4*)(Ob + 4 * k); ss += (v_.x * v_.x + v_.y * v_.y) + (v_.z * v_.z + v_.w * v_.w); } \
                ss += __shfl_xor(ss, 1); ss += __shfl_xor(ss, 2); \
                const float rs = rsqrtf(ss * (1.f / 128.f) + NORM_EPS); \
                bf16* op = OB + ((size_t)b * SEQ + ((n) - 1) * 64 + i) * 1024 + 512 + h * 128 + 32 * qd; \
                _Pragma("unroll") for (int k = 0; k < 4; ++k) { const f32x4 w0 = *(const LAS f32x4*)(NWl + 32 * qd + 8 * k), w1 = *(const LAS f32x4*)(NWl + 32 * qd + 8 * k + 4); const v4u gg = gq[k]; \
                    const f32x4 a0 = *(const LAS f32x4*)(Ob + 8 * k), a1 = *(const LAS f32x4*)(Ob + 8 * k + 4); \
                    v4u o; o.x = bfc2(a0.x * rs * w0.x * siluf(bflo(gg.x)), a0.y * rs * w0.y * siluf(bfhi(gg.x))); o.y = bfc2(a0.z * rs * w0.z * siluf(bflo(gg.y)), a0.w * rs * w0.w * siluf(bfhi(gg.y))); \
                    o.z = bfc2(a1.x * rs * w1.x * siluf(bflo(gg.z)), a1.y * rs * w1.y * siluf(bfhi(gg.z))); o.w = bfc2(a1.z * rs * w1.z * siluf(bflo(gg.w)), a1.w * rs * w1.w * siluf(bfhi(gg.w))); \
                    *(v4u*)(op + 8 * k) = o; } \
            } \
            asm volatile("" ::: "memory"); \
            if ((n) < 32) { const bf16* gp = HP + ((size_t)b * SEQ + (n) * 64 + i) * HP_LD + COL_GG + h * 128 + 32 * qd;     \
                _Pragma("unroll") for (int k = 0; k < 4; ++k) gq[k] = *(const v4u*)(gp + 8 * k); } \
            if ((n) == 10) STAMPT(121, 256); \
            GDN_BAR();            \
            if ((n) == 10) STAMPT(122, 256); \
            if ((n) + 1 < 32) GDN_STORE(PF_STORE); \
            if ((n) == 10) STAMPT(123, 256); \
            GDN_BAR();            \
            if ((n) == 10) STAMPT(124, 256); \
        } while (0)
        v4u gq[4];
#pragma unroll
        for (int k = 0; k < 4; ++k) gq[k] = (v4u){0u, 0u, 0u, 0u};
#pragma unroll
        for (int n = 0; n < 32; n += 2) {
            GDN_LOADER_ITER(n, pfB, pfA);
            GDN_LOADER_ITER(n + 1, pfA, pfB);
        }
        GDN_LOADER_ITER(32, pfB, pfA);
#undef GDN_LOADER_ITER
    }
#undef GDN_FETCH
#undef GDN_STORE
}

__device__ __forceinline__ void gdn_scan_helper(KArgs a, int bh, int tid) {
    unsigned char* ws = a->ws;
    const unsigned char* gWN = (const unsigned char*)(ws + WS_R + R_WN) + (size_t)bh * 32 * 16384; const unsigned char* gQD = (const unsigned char*)(ws + WS_R + R_QD) + (size_t)bh * 32 * 16384;
    const unsigned char* gKDT = (const unsigned char*)(ws + WS_R + R_KDT) + (size_t)bh * 32 * 16384; const unsigned char* gQK = (const unsigned char*)(ws + WS_R + R_QK) + (size_t)bh * 32 * 8192;
    const unsigned char* gU = (const unsigned char*)(ws + WS_R + R_U) + (size_t)bh * 32 * 16384;
#pragma unroll 1
    for (int n = 0; n < 32; ++n) {
        v4u pf[9];
#pragma unroll
        for (int k = 0; k < 9; ++k) { const int kk = 2 * k + (tid >> 8), et = tid & 255;
            const unsigned char* src_ = kk < 4 ? gWN + (size_t)n * 16384 + kk * 4096 : kk < 8 ? gQD + (size_t)n * 16384 + (kk - 4) * 4096 :
                kk < 12 ? gKDT + (size_t)n * 16384 + (kk - 8) * 4096 : kk < 14 ? gQK + (size_t)n * 8192 + (kk - 12) * 4096 : gU + (size_t)n * 16384 + (kk - 14) * 4096;
            pf[k] = *(const v4u*)(src_ + et * 16); }
#pragma unroll
        for (int k = 0; k < 9; ++k) asm volatile("" :: "v"(pf[k]));
    }
}

__device__ __forceinline__ void gdn_scan_v3(KArgs a, int l, int bhq, LAS unsigned char* lds, int tid, int lane, int wave) {
    unsigned char* ws = a->ws;
    constexpr int FB_WN = 0, FB_QD = 16384, FB_KDT = 32768, FB_QK = 49152, FB_U = 57344, IMG = 61440;
    constexpr int OLS = 64 * 36;
    LAS float* OL = (LAS float*)(lds + 2 * IMG);
    const int bh = bhq >> 2, q = bhq & 3, h = bh & 3, b = bh >> 2, c = lane & 31, hh = lane >> 5;
    bf16* OB = (bf16*)(ws + WS_R + R_OB); float* SSQ = (float*)(ws + WS_SSQ);
    const unsigned char* gWN = (const unsigned char*)(ws + WS_R + R_WN) + (size_t)bh * 32 * 16384; const unsigned char* gQD = (const unsigned char*)(ws + WS_R + R_QD) + (size_t)bh * 32 * 16384;
    const unsigned char* gKDT = (const unsigned char*)(ws + WS_R + R_KDT) + (size_t)bh * 32 * 16384; const unsigned char* gQK = (const unsigned char*)(ws + WS_R + R_QK) + (size_t)bh * 32 * 8192;
    const unsigned char* gU = (const unsigned char*)(ws + WS_R + R_U) + (size_t)bh * 32 * 16384 + q * 4096;
    const int et = tid - 256;
#define G3_FETCH(pf, nn) do { _Pragma("unroll") for (int k = 0; k < 15; ++k) { const unsigned char* src_ = k < 4 ? gWN + (size_t)(nn) * 16384 + k * 4096 : k < 8 ? gQD + (size_t)(nn) * 16384 + (k - 4) * 4096 : \
        k < 12 ? gKDT + (size_t)(nn) * 16384 + (k - 8) * 4096 : k < 14 ? gQK + (size_t)(nn) * 8192 + (k - 12) * 4096 : gU + (size_t)(nn) * 16384; pf[k] = *(const v4u*)(src_ + et * 16); } } while (0)
#define G3_STORE(pf, buf) do { _Pragma("unroll") for (int k = 0; k < 15; ++k) *(LAS v4u*)(lds + (buf) * IMG + k * 4096 + et * 16) = pf[k]; } while (0)
    __syncthreads();
    if (wave == 0) {
        f32x16 S[4];
#pragma unroll
        for (int t = 0; t < 4; ++t)
#pragma unroll
            for (int i = 0; i < 16; ++i) S[t][i] = 0.f;
        GDN_BAR();
#pragma unroll 1
        for (int n = 0; n < 32; ++n) {
            const LAS unsigned char* img = lds + (n & 1) * IMG;
            const LAS bf16x8* WNf = (const LAS bf16x8*)(img + FB_WN) + lane; const LAS bf16x8* QDf = (const LAS bf16x8*)(img + FB_QD) + lane;
            const LAS bf16x8* KDTf = (const LAS bf16x8*)(img + FB_KDT) + lane; const LAS bf16x8* QKf = (const LAS bf16x8*)(img + FB_QK) + lane;
            const LAS v4u* Uf = (const LAS v4u*)(img + FB_U) + lane;
            const float cd = ((const float*)(ws + WS_CD))[bh * 32 + n];
            bf16x8 A0[8], A1[8];
#define G3_LD_MTS(A, F, g) do { _Pragma("unroll") for (int k = 0; k < 8; ++k) { const int m_ = k & 1, s_ = (k >> 1) & 1, t_ = 2 * (g) + (k >> 2); A[k] = F[((m_ * 4 + t_) * 2 + s_) * 64]; } } while (0)
#define G3_LD_TMS(A, F, g) do { _Pragma("unroll") for (int k = 0; k < 8; ++k) { const int s_ = k & 1, m_ = (k >> 1) & 1, t_ = 2 * (g) + (k >> 2); A[k] = F[((t_ * 2 + m_) * 2 + s_) * 64]; } } while (0)
            G3_LD_MTS(A0, WNf, 0); G3_LD_MTS(A1, WNf, 1);
            f32x16 av[2];
#pragma unroll
            for (int m = 0; m < 2; ++m)
#pragma unroll
                for (int hf = 0; hf < 2; ++hf) { const v4u u4 = Uf[(m * 2 + hf) * 64];
#pragma unroll
                    for (int k = 0; k < 4; ++k) { av[m][8 * hf + 2 * k] = bflo(u4[k]); av[m][8 * hf + 2 * k + 1] = bfhi(u4[k]); } }
            bf16x8 Sb[4][2];
#pragma unroll
            for (int t = 0; t < 4; ++t) { Sb[t][0] = pack8(S[t], 0); Sb[t][1] = pack8(S[t], 1); }
#pragma unroll
            for (int k = 0; k < 8; ++k) { const int m_ = k & 1, s_ = (k >> 1) & 1, t_ = (k >> 2); av[m_] = MFMA32(A0[k], Sb[t_][s_], av[m_]); }
            G3_LD_MTS(A0, QDf, 0);
#pragma unroll
            for (int k = 0; k < 8; ++k) { const int m_ = k & 1, s_ = (k >> 1) & 1, t_ = 2 + (k >> 2); av[m_] = MFMA32(A1[k], Sb[t_][s_], av[m_]); }
            G3_LD_MTS(A1, QDf, 1);
            f32x16 ao[2];
#pragma unroll
            for (int m = 0; m < 2; ++m)
#pragma unroll
                for (int i = 0; i < 16; ++i) ao[m][i] = 0.f;
#pragma unroll
            for (int k = 0; k < 8; ++k) { const int m_ = k & 1, s_ = (k >> 1) & 1, t_ = (k >> 2); ao[m_] = MFMA32(A0[k], Sb[t_][s_], ao[m_]); }
#pragma unroll
            for (int k = 0; k < 6; ++k) { const int s_ = k & 1, m_ = k >= 2 ? 1 : 0, mp_ = k >= 4 ? 1 : 0; A0[k] = QKf[((m_ * 2 + mp_) * 2 + s_) * 64]; }
#pragma unroll
            for (int k = 0; k < 8; ++k) { const int m_ = k & 1, s_ = (k >> 1) & 1, t_ = 2 + (k >> 2); ao[m_] = MFMA32(A1[k], Sb[t_][s_], ao[m_]); }
            G3_LD_TMS(A1, KDTf, 0);
            bf16x8 Vb[2][2];
#pragma unroll
            for (int m = 0; m < 2; ++m) { Vb[m][0] = pack8(av[m], 0); Vb[m][1] = pack8(av[m], 1); }
#pragma unroll
            for (int k = 0; k < 6; ++k) { const int s_ = k & 1, m_ = k >= 2 ? 1 : 0, mp_ = k >= 4 ? 1 : 0; ao[m_] = MFMA32(A0[k], Vb[mp_][s_], ao[m_]); }
            G3_LD_TMS(A0, KDTf, 1);
            {   LAS float* Ob = OL + (n & 1) * OLS + c;
#pragma unroll
                for (int m = 0; m < 2; ++m)
#pragma unroll
                    for (int i = 0; i < 16; ++i) Ob[(32 * m + (i & 3) + 8 * (i >> 2) + 4 * hh) * 36] = ao[m][i]; }
#pragma unroll
            for (int t = 0; t < 4; ++t)
#pragma unroll
                for (int i = 0; i < 16; ++i) S[t][i] *= cd;
#pragma unroll
            for (int k = 0; k < 8; ++k) { const int s_ = k & 1, m_ = (k >> 1) & 1, t_ = (k >> 2); S[t_] = MFMA32(A1[k], Vb[m_][s_], S[t_]); }
#pragma unroll
            for (int k = 0; k < 8; ++k) { const int s_ = k & 1, m_ = (k >> 1) & 1, t_ = 2 + (k >> 2); S[t_] = MFMA32(A0[k], Vb[m_][s_], S[t_]); }
#undef G3_LD_MTS
#undef G3_LD_TMS
            GDN_BAR();
        }
    } else if (wave >= 4) {
        v4u pfE[15], pfO[15];
        G3_FETCH(pfE, 0); G3_FETCH(pfO, 1); G3_STORE(pfE, 0);
        GDN_BAR();
        const int i = et >> 2, p = et & 3;
#define G3_OUT(m) do { const LAS float* Ob = OL + ((m) & 1) * OLS + i * 36 + 8 * p; const f32x4 o0 = *(const LAS f32x4*)Ob, o1 = *(const LAS f32x4*)(Ob + 4); \
            float ss = (o0.x * o0.x + o0.y * o0.y) + (o0.z * o0.z + o0.w * o0.w) + (o1.x * o1.x + o1.y * o1.y) + (o1.z * o1.z + o1.w * o1.w); \
            ss += __shfl_xor(ss, 1); ss += __shfl_xor(ss, 2); \
            const size_t t_ = (size_t)b * SEQ + (m) * 64 + i; \
            v4u w_; w_.x = bfc2(o0.x, o0.y); w_.y = bfc2(o0.z, o0.w); w_.z = bfc2(o1.x, o1.y); w_.w = bfc2(o1.z, o1.w); \
            *(v4u*)(OB + t_ * 1024 + 512 + h * 128 + 32 * q + 8 * p) = w_; \
            if (p == 0) SSQ[(t_ * 4 + h) * 4 + q] = ss; } while (0)
#define G3_LOADER_ITER(n, PF_FETCH, PF_STORE) do { \
            if ((n) + 2 < 32) G3_FETCH(PF_FETCH, (n) + 2); \
            if ((n) > 0) G3_OUT((n) - 1); \
            if ((n) + 1 < 32) G3_STORE(PF_STORE, ((n) + 1) & 1); \
            GDN_BAR(); \
        } while (0)
#pragma unroll
        for (int n = 0; n < 32; n += 2) {
            G3_LOADER_ITER(n, pfE, pfO);
            G3_LOADER_ITER(n + 1, pfO, pfE);
        }
        G3_OUT(31);
#undef G3_LOADER_ITER
#undef G3_OUT
    } else {
        GDN_BAR();
#pragma unroll 1
        for (int n = 0; n < 32; ++n) GDN_BAR();
    }
#undef G3_FETCH
#undef G3_STORE
}
__device__ __forceinline__ void gdn_finalize(KArgs a, int l, int lane, int gw, int NGW) {
    unsigned char* ws = a->ws;
    const bf16* HP = (const bf16*)(ws + WS_R + R_HP); bf16* OB = (bf16*)(ws + WS_R + R_OB); const float* SSQ = (const float*)(ws + WS_SSQ);
    const int hd = lane >> 4, cb = (lane & 15) * 8;
    const float* nw = a->in[5] + l * 128 + cb;
    const f32x4 w0 = *(const f32x4*)nw, w1 = *(const f32x4*)(nw + 4);
    for (int t0 = gw * 4; t0 < M; t0 += NGW * 4) {
        v4u raw[4], gg[4]; f32x4 sq[4];
#pragma unroll
        for (int k = 0; k < 4; ++k) { const size_t t = (size_t)t0 + k; raw[k] = *(const v4u*)(OB + t * 1024 + 512 + hd * 128 + cb); gg[k] = *(const v4u*)(HP + t * HP_LD + COL_GG + hd * 128 + cb); sq[k] = *(const f32x4*)(SSQ + (t * 4 + hd) * 4); }
#pragma unroll
        for (int k = 0; k < 4; ++k) { const size_t t = (size_t)t0 + k; const float rs = rsqrtf(((sq[k].x + sq[k].y) + (sq[k].z + sq[k].w)) * (1.f / 128.f) + NORM_EPS);
            v4u o; o.x = bfc2(bflo(raw[k].x) * rs * w0.x * siluf(bflo(gg[k].x)), bfhi(raw[k].x) * rs * w0.y * siluf(bfhi(gg[k].x))); o.y = bfc2(bflo(raw[k].y) * rs * w0.z * siluf(bflo(gg[k].y)), bfhi(raw[k].y) * rs * w0.w * siluf(bfhi(gg[k].y)));
            o.z = bfc2(bflo(raw[k].z) * rs * w1.x * siluf(bflo(gg[k].z)), bfhi(raw[k].z) * rs * w1.y * siluf(bfhi(gg[k].z))); o.w = bfc2(bflo(raw[k].w) * rs * w1.z * siluf(bflo(gg[k].w)), bfhi(raw[k].w) * rs * w1.w * siluf(bfhi(gg[k].w)));
            *(v4u*)(OB + t * 1024 + 512 + hd * 128 + cb) = o; }
    }
}

struct RetLds {
    static constexpr int QS = 72, JS = 136;
    static constexpr int P = 0, Q1 = 34816, K1 = 53248, OL = 0, K1T = 71680, VT = 89088, ST = 123904;
};
template <bool WANT_Q, bool WANT_K1, bool WANT_K1T>
__device__ __forceinline__ void ret_stage(const bf16* HP, const float* RT, int b, int h, int n, float lg, LAS unsigned char* lds, int tid) {
    constexpr int QS = RetLds::QS, JS = RetLds::JS;
    LAS bf16* Q1 = (LAS bf16*)(lds + RetLds::Q1); LAS bf16* K1 = (LAS bf16*)(lds + RetLds::K1); LAS bf16* K1T = (LAS bf16*)(lds + RetLds::K1T); LAS bf16* VT = (LAS bf16*)(lds + RetLds::VT);
    const int i = tid >> 2, dd = (tid & 3) * 8, pos = n * 128 + i; const size_t t = (size_t)b * SEQ + pos;
    const bf16* hp = HP + t * HP_LD;
    const f32x4 c0 = *(const f32x4*)(RT + pos * 64 + dd), c1 = *(const f32x4*)(RT + pos * 64 + dd + 4), s0 = *(const f32x4*)(RT + pos * 64 + 32 + dd), s1 = *(const f32x4*)(RT + pos * 64 + 32 + dd + 4);
    const float cs[8] = {c0.x, c0.y, c0.z, c0.w, c1.x, c1.y, c1.z, c1.w}, sn[8] = {s0.x, s0.y, s0.z, s0.w, s1.x, s1.y, s1.z, s1.w};
    const float sq = exp2f((float)i * lg), sk = 0.125f * exp2f(-(float)i * lg);
    v4u xv[4];
#pragma unroll
    for (int p = 0; p < 4; ++p) { const int idx = tid + 512 * p, j = idx >> 4, e0 = (idx & 15) * 8; xv[p] = *(const v4u*)(HP + ((size_t)b * SEQ + n * 128 + j) * HP_LD + COL_RV + h * 128 + e0); }
#pragma unroll
    for (int which = (WANT_Q ? 0 : 1); which < 2; ++which) {
        const bf16* src = hp + (which == 0 ? COL_RQ : COL_RK) + h * 64 + dd;
        const v4u x1 = *(const v4u*)src, x2 = *(const v4u*)(src + 32);
        const float sc = which == 0 ? sq : sk;
        float lo[8], hi[8];
#pragma unroll
        for (int k = 0; k < 4; ++k) { const float a0 = bflo(x1[k]), a1 = bfhi(x1[k]), b0 = bflo(x2[k]), b1 = bfhi(x2[k]);
            lo[2 * k] = (a0 * cs[2 * k] - b0 * sn[2 * k]) * sc; lo[2 * k + 1] = (a1 * cs[2 * k + 1] - b1 * sn[2 * k + 1]) * sc;
            hi[2 * k] = (a0 * sn[2 * k] + b0 * cs[2 * k]) * sc; hi[2 * k + 1] = (a1 * sn[2 * k + 1] + b1 * cs[2 * k + 1]) * sc; }
        v4u wl, wh;
#pragma unroll
        for (int k = 0; k < 4; ++k) { wl[k] = bfc2(lo[2 * k], lo[2 * k + 1]); wh[k] = bfc2(hi[2 * k], hi[2 * k + 1]); }
        if (which == 0 || WANT_K1) { LAS bf16* dst = (which == 0 ? Q1 : K1) + i * QS + dd; *(LAS v4u*)dst = wl; *(LAS v4u*)(dst + 32) = wh; }
        if (which == 1 && WANT_K1T) {
#pragma unroll
            for (int k = 0; k < 4; ++k) { K1T[(dd + 2 * k) * JS + i] = (bf16)(wl[k] & 0xffffu); K1T[(dd + 2 * k + 1) * JS + i] = (bf16)(wl[k] >> 16);
                K1T[(32 + dd + 2 * k) * JS + i] = (bf16)(wh[k] & 0xffffu); K1T[(32 + dd + 2 * k + 1) * JS + i] = (bf16)(wh[k] >> 16); }
        }
    }
#pragma unroll
    for (int p = 0; p < 4; ++p) { const int idx = tid + 512 * p, j = idx >> 4, e0 = (idx & 15) * 8;
#pragma unroll
        for (int k = 0; k < 4; ++k) { VT[(e0 + 2 * k) * JS + j] = (bf16)(xv[p][k] & 0xffffu); VT[(e0 + 2 * k + 1) * JS + j] = (bf16)(xv[p][k] >> 16); } }
}
__device__ __forceinline__ void ret_kv_unit(KArgs a, int unit, LAS unsigned char* lds, int tid, int lane, int wave) {
    unsigned char* ws = a->ws;
    constexpr int JS = RetLds::JS;
    const int n = unit & 15, bh = unit >> 4, h = bh & 3, b = bh >> 2, c = lane & 31, hh = lane >> 5;
    const bf16* HP = (const bf16*)(ws + WS_R + R_HP); const float* RT = (const float*)(ws + WS_ROPE);
    const float gam = 1.0f - exp2f(-5.0f - (float)h), lg = log2f(gam), g127 = exp2f(127.f * lg);
    LAS bf16* K1T = (LAS bf16*)(lds + RetLds::K1T); LAS bf16* VT = (LAS bf16*)(lds + RetLds::VT);
    __syncthreads();
    ret_stage<false, false, true>(HP, RT, b, h, n, lg, lds, tid);
    __syncthreads();
    const int td = wave >> 2, te = wave & 3;
    f32x16 kv;
#pragma unroll
    for (int i = 0; i < 16; ++i) kv[i] = 0.f;
#pragma unroll
    for (int ks = 0; ks < 8; ++ks) kv = MFMA32(*(const LAS bf16x8*)(K1T + (32 * td + c) * JS + 16 * ks + 8 * hh), *(const LAS bf16x8*)(VT + (32 * te + c) * JS + 16 * ks + 8 * hh), kv);
    float* dst = (float*)(ws + WS_KV) + ((size_t)(unit * 8 + wave) * 64 + lane) * 16;
#pragma unroll
    for (int g = 0; g < 4; ++g) *(f32x4*)(dst + 4 * g) = (f32x4){kv[4 * g] * g127, kv[4 * g + 1] * g127, kv[4 * g + 2] * g127, kv[4 * g + 3] * g127};
}
__device__ __forceinline__ void ret_out_unit(KArgs a, int unit, LAS unsigned char* lds, int tid, int lane, int wave) {
    unsigned char* ws = a->ws;
    constexpr int QS = RetLds::QS, JS = RetLds::JS;
    LAS bf16* P = (LAS bf16*)(lds + RetLds::P); LAS bf16* Q1 = (LAS bf16*)(lds + RetLds::Q1); LAS bf16* K1 = (LAS bf16*)(lds + RetLds::K1); LAS float* OL = (LAS float*)(lds + RetLds::OL);
    LAS bf16* VT = (LAS bf16*)(lds + RetLds::VT); LAS bf16* ST = (LAS bf16*)(lds + RetLds::ST);
    const int n = unit & 15, bh = unit >> 4, h = bh & 3, b = bh >> 2, c = lane & 31, hh = lane >> 5;
    const bf16* HP = (const bf16*)(ws + WS_R + R_HP); bf16* OB = (bf16*)(ws + WS_R + R_OB); const float* RT = (const float*)(ws + WS_ROPE);
    const float gam = 1.0f - exp2f(-5.0f - (float)h), lg = log2f(gam), g128 = exp2f(128.f * lg);
    __syncthreads();
    const int ei = tid >> 2, eq = tid & 3; const size_t et = (size_t)b * SEQ + n * 128 + ei;
    v4u gg[4];
    { const bf16* gp = HP + et * HP_LD + COL_RG + h * 128 + 32 * eq;
#pragma unroll
      for (int k = 0; k < 4; ++k) gg[k] = *(const v4u*)(gp + 8 * k); }
    {
        const int td = wave >> 2, te = wave & 3;
        f32x16 S;
#pragma unroll
        for (int i = 0; i < 16; ++i) S[i] = 0.f;
        const float* src = (const float*)(ws + WS_KV) + ((size_t)((bh * 16) * 8 + wave) * 64 + lane) * 16;
#pragma unroll 2
        for (int m = 0; m < n; ++m) { const f32x4* p4 = (const f32x4*)(src + (size_t)m * 8 * 64 * 16);
#pragma unroll
            for (int g = 0; g < 4; ++g) { const f32x4 v = p4[g]; S[4 * g] = S[4 * g] * g128 + v.x; S[4 * g + 1] = S[4 * g + 1] * g128 + v.y; S[4 * g + 2] = S[4 * g + 2] * g128 + v.z; S[4 * g + 3] = S[4 * g + 3] * g128 + v.w; } }
#pragma unroll
        for (int g = 0; g < 4; ++g) { v2u w; w.x = bfc2(S[4 * g], S[4 * g + 1]); w.y = bfc2(S[4 * g + 2], S[4 * g + 3]); *(LAS v2u*)(ST + (32 * te + c) * QS + 32 * td + 8 * g + 4 * hh) = w; }
    }
    ret_stage<true, true, false>(HP, RT, b, h, n, lg, lds, tid);
    __syncthreads();
#pragma unroll 1
    for (int rep = 0; rep < 2; ++rep) { const int idx = wave + 8 * rep;
        if (idx < 10) { const int ti = (idx >= 1) + (idx >= 3) + (idx >= 6), tj = idx - ti * (ti + 1) / 2;
            f32x16 acc;
#pragma unroll
            for (int i = 0; i < 16; ++i) acc[i] = 0.f;
#pragma unroll
            for (int s2 = 0; s2 < 4; ++s2) acc = MFMA32(*(const LAS bf16x8*)(Q1 + (32 * ti + c) * QS + 16 * s2 + 8 * hh), *(const LAS bf16x8*)(K1 + (32 * tj + c) * QS + 16 * s2 + 8 * hh), acc);
#pragma unroll
            for (int i = 0; i < 16; ++i) { const int il = (i & 3) + 8 * (i >> 2) + 4 * hh; float v = acc[i]; if (ti == tj && il < c) v = 0.f; P[(32 * ti + il) * JS + 32 * tj + c] = bfc(v); } } }
    __syncthreads();
    const int ti = wave >> 1, te0 = 2 * (wave & 1);
    f32x16 ao[2];
#pragma unroll
    for (int u = 0; u < 2; ++u)
#pragma unroll
        for (int i = 0; i < 16; ++i) ao[u][i] = 0.f;
#pragma unroll
    for (int s2 = 0; s2 < 4; ++s2) { const bf16x8 A = *(const LAS bf16x8*)(Q1 + (32 * ti + c) * QS + 16 * s2 + 8 * hh);
#pragma unroll
        for (int u = 0; u < 2; ++u) ao[u] = MFMA32(A, *(const LAS bf16x8*)(ST + (32 * (te0 + u) + c) * QS + 16 * s2 + 8 * hh), ao[u]); }
#pragma unroll
    for (int u = 0; u < 2; ++u)
#pragma unroll
        for (int i = 0; i < 16; ++i) ao[u][i] *= gam;
#pragma unroll 1
    for (int tj = 0; tj <= ti; ++tj)
#pragma unroll
        for (int s2 = 0; s2 < 2; ++s2) { const bf16x8 A = *(const LAS bf16x8*)(P + (32 * ti + c) * JS + 32 * tj + 16 * s2 + 8 * hh);
#pragma unroll
            for (int u = 0; u < 2; ++u) ao[u] = MFMA32(A, *(const LAS bf16x8*)(VT + (32 * (te0 + u) + c) * JS + 32 * tj + 16 * s2 + 8 * hh), ao[u]); }
    __syncthreads();
#pragma unroll
    for (int u = 0; u < 2; ++u)
#pragma unroll
        for (int i = 0; i < 16; ++i) OL[(32 * ti + (i & 3) + 8 * (i >> 2) + 4 * hh) * 132 + 32 * (te0 + u) + c] = ao[u][i];
    __syncthreads();
    {
        const LAS float* Ob = OL + ei * 132 + 32 * eq; bf16* op = OB + et * 1024 + h * 128 + 32 * eq;
        f32x4 v[8]; float sm = 0.f;
#pragma unroll
        for (int k = 0; k < 8; ++k) { v[k] = *(const LAS f32x4*)(Ob + 4 * k); sm += (v[k].x + v[k].y) + (v[k].z + v[k].w); }
        sm += __shfl_xor(sm, 1); sm += __shfl_xor(sm, 2);
        const float mean = sm * (1.f / 128.f); float sq = 0.f;
#pragma unroll
        for (int k = 0; k < 8; ++k) { v[k] = v[k] - mean; sq += (v[k].x * v[k].x + v[k].y * v[k].y) + (v[k].z * v[k].z + v[k].w * v[k].w); }
        sq += __shfl_xor(sq, 1); sq += __shfl_xor(sq, 2);
        const float rs = rsqrtf(sq * (1.f / 128.f) + LN_EPS);
#pragma unroll
        for (int k = 0; k < 4; ++k) { const v4u g4 = gg[k]; const f32x4 a0 = v[2 * k], a1 = v[2 * k + 1];
            v4u o; o.x = bfc2(a0.x * rs * siluf(bflo(g4.x)), a0.y * rs * siluf(bfhi(g4.x))); o.y = bfc2(a0.z * rs * siluf(bflo(g4.y)), a0.w * rs * siluf(bfhi(g4.y)));
            o.z = bfc2(a1.x * rs * siluf(bflo(g4.z)), a1.y * rs * siluf(bfhi(g4.z))); o.w = bfc2(a1.z * rs * siluf(bflo(g4.w)), a1.w * rs * siluf(bfhi(g4.w)));
            *(v4u*)(op + 8 * k) = o; }
    }
}

__device__ __forceinline__ float sum16(float v) {
    v += __builtin_bit_cast(float, __builtin_amdgcn_update_dpp(0, __builtin_bit_cast(int, v), 0xB1, 0xF, 0xF, true));
    v += __builtin_bit_cast(float, __builtin_amdgcn_update_dpp(0, __builtin_bit_cast(int, v), 0x4E, 0xF, 0xF, true));
    v += __builtin_bit_cast(float, __builtin_amdgcn_update_dpp(0, __builtin_bit_cast(int, v), 0x141, 0xF, 0xF, true));
    v += __builtin_bit_cast(float, __builtin_amdgcn_update_dpp(0, __builtin_bit_cast(int, v), 0x140, 0xF, 0xF, true));
    return v;
}
__device__ __forceinline__ void gdn_prep_fast(KArgs a, int l, int unit, LAS unsigned char* lds, int tid, int lane, int wave) {
    asm volatile("" : "+v"(tid)); lane = tid & 63; wave = __builtin_amdgcn_readfirstlane(tid >> 6);
    unsigned char* ws = a->ws;
    constexpr int KS = 136;
    LAS bf16* Kb = (LAS bf16*)lds;
    LAS bf16* Qb = (LAS bf16*)(lds + 17408);
    LAS float* A = (LAS float*)(lds + 34816);
    LAS float* V = (LAS float*)(lds + 51200);
    LAS float* KW = (LAS float*)(lds + 83968);
    LAS float* gc = (LAS float*)(lds + 116736);
    LAS float* bt = gc + 64;
    LAS bf16* KDs = (LAS bf16*)(lds + 117248);
    LAS bf16* XT = (LAS bf16*)lds;
    LAS bf16* A10b = (LAS bf16*)(lds + 135680);
    const int n = unit & 31, bh = unit >> 5, h = bh & 3, b = bh >> 2, t0 = b * SEQ + n * 64, c = lane & 31, hh = lane >> 5;
    const bf16* HP = (const bf16*)(ws + WS_R + R_HP);
    bf16* QKg = (bf16*)(ws + WS_R + R_QK) + (size_t)unit * 4096; bf16* QDg = (bf16*)(ws + WS_R + R_QD) + (size_t)unit * 8192; bf16* KDTg = (bf16*)(ws + WS_R + R_KDT) + (size_t)unit * 8192;
    bf16* WNg = (bf16*)(ws + WS_R + R_WN) + (size_t)unit * 8192; bf16* Ug = (bf16*)(ws + WS_R + R_U) + (size_t)unit * 8192;
    __syncthreads(); if (unit == PROBE_UNIT) STAMPT(130, 0);
    if (wave == 0) {
        const float* gab = (const float*)(ws + WS_GAB) + (size_t)(t0 + lane) * 8; const float x = gab[h] + a->in[4][l * 4 + h];
        const float sp = fmaxf(x, 0.f) + log1pf(__expf(-fabsf(x))); float g = -__expf(a->in[3][l * 4 + h]) * sp;
#pragma unroll
        for (int o = 1; o < 64; o <<= 1) { const float up = __shfl_up(g, o); if (lane >= o) g += up; }
        gc[lane] = g; bt[lane] = sigmf(gab[4 + h]);
        if (lane == 63) ((float*)(ws + WS_CD))[unit] = __expf(g);
    }
    __syncthreads(); if (unit == PROBE_UNIT) STAMPT(131, 0);
#ifndef PREP_NO_CONV
    if (wave < 6) {
        const int which = wave >> 1, tp = tid & 127, rb = tp >> 4, dd = (tp & 15) * 8, col = COL_GQ + which * 512 + h * 128 + dd, cc = which * 512 + h * 128 + dd;
        const float* cw = a->in[2] + (size_t)l * 4 * 1536 + cc;
        float w[4][8];
#pragma unroll
        for (int j = 0; j < 4; ++j) { const f32x4 w0 = *(const f32x4*)(cw + j * 1536), w1 = *(const f32x4*)(cw + j * 1536 + 4); w[j][0] = w0.x; w[j][1] = w0.y; w[j][2] = w0.z; w[j][3] = w0.w; w[j][4] = w1.x; w[j][5] = w1.y; w[j][6] = w1.z; w[j][7] = w1.w; }
        const int sbase = n * 64 + 8 * rb - 3;
        const bf16* hpc = HP + (size_t)(b * SEQ) * HP_LD + col;
        v4u raw[11];
#pragma unroll
        for (int r = 0; r < 11; ++r) { raw[r] = (v4u){0u, 0u, 0u, 0u}; if (sbase + r >= 0) raw[r] = *(const v4u*)(hpc + (size_t)(sbase + r) * HP_LD); }
        const float gl = gc[63];
#pragma unroll
        for (int r = 0; r < 8; ++r) { const int i = 8 * rb + r; float y[8]; float ss = 0.f;
#pragma unroll
            for (int k4 = 0; k4 < 4; ++k4) {
                unsigned d0 = raw[r][k4], d1 = raw[r + 1][k4], d2 = raw[r + 2][k4], d3 = raw[r + 3][k4];
                asm volatile("" : "+v"(d0), "+v"(d1), "+v"(d2), "+v"(d3));
                const float a0 = w[0][2 * k4] * bflo(d0) + w[1][2 * k4] * bflo(d1) + w[2][2 * k4] * bflo(d2) + w[3][2 * k4] * bflo(d3);
                const float a1 = w[0][2 * k4 + 1] * bfhi(d0) + w[1][2 * k4 + 1] * bfhi(d1) + w[2][2 * k4 + 1] * bfhi(d2) + w[3][2 * k4 + 1] * bfhi(d3);
                y[2 * k4] = siluf(a0); y[2 * k4 + 1] = siluf(a1); ss += y[2 * k4] * y[2 * k4] + y[2 * k4 + 1] * y[2 * k4 + 1]; }
            ss = sum16(ss);
            const float gi = gc[i], bi = bt[i];
            if (which == 0) { const float f = rsqrtf(ss + NORM_EPS) * 0.08838834764831845f, eg = __expf(gi);
                v4u p, pd;
#pragma unroll
                for (int k = 0; k < 4; ++k) { p[k] = bfc2(y[2 * k] * f, y[2 * k + 1] * f); pd[k] = bfc2(y[2 * k] * f * eg, y[2 * k + 1] * f * eg); }
                *(LAS v4u*)(Qb + i * KS + dd) = p;
                bf16* qd = QDg + (((i >> 5) * 4 + (dd >> 5)) * 2 + ((dd >> 4) & 1)) * 512 + (i & 31) * 8 + ((dd >> 3) & 1) * 4;
                *(v2u*)qd = (v2u){pd[0], pd[1]}; *(v2u*)(qd + 256) = (v2u){pd[2], pd[3]};
            } else if (which == 1) { const float f = rsqrtf(ss + NORM_EPS), fw = f * bi * __expf(gi), fd = f * __expf(gl - gi);
                v4u p;
#pragma unroll
                for (int k = 0; k < 4; ++k) p[k] = bfc2(y[2 * k] * f, y[2 * k + 1] * f);
                *(LAS v4u*)(Kb + i * KS + dd) = p;
#pragma unroll
                for (int k = 0; k < 8; ++k) { KW[i * 128 + dd + k] = y[k] * fw; KDs[(dd + k) * 72 + i] = bfc(y[k] * fd); }
            } else {
#pragma unroll
                for (int k = 0; k < 8; ++k) V[i * 128 + dd + k] = y[k] * bi;
            }
        }
    }
#endif
    __syncthreads(); if (unit == PROBE_UNIT) STAMPT(132, 0);
    {
        const int ti = (wave >> 1) & 1, tj = wave & 1;
        if (wave < 4) {
            if (ti <= tj) {
                f32x16 acc;
#pragma unroll
                for (int i = 0; i < 16; ++i) acc[i] = 0.f;
#pragma unroll
                for (int s = 0; s < 8; ++s) acc = MFMA32(*(const LAS bf16x8*)(Kb + (32 * ti + c) * KS + 16 * s + 8 * hh), *(const LAS bf16x8*)(Kb + (32 * tj + c) * KS + 16 * s + 8 * hh), acc);
                const int i = 32 * tj + c; const float gi = gc[i], bi = bt[i];
#pragma unroll
                for (int r = 0; r < 16; ++r) { const int j = 32 * ti + (r & 3) + 8 * (r >> 2) + 4 * hh; const float av = (j < i) ? bi * acc[r] * __expf(gi - gc[j]) : 0.f; A[j * 64 + i] = av;
                    if (ti == 0 && tj == 1) A10b[c * 40 + j] = bfc(av); }
            } else {
#pragma unroll
                for (int r = 0; r < 16; ++r) { const int j = 32 * ti + (r & 3) + 8 * (r >> 2) + 4 * hh; A[j * 64 + 32 * tj + c] = 0.f; }
            }
        } else {
            const int kt = ti, qt = tj;
            if (kt <= qt) {
                f32x16 acc;
#pragma unroll
                for (int i = 0; i < 16; ++i) acc[i] = 0.f;
#pragma unroll
                for (int s = 0; s < 8; ++s) acc = MFMA32(*(const LAS bf16x8*)(Kb + (32 * kt + c) * KS + 16 * s + 8 * hh), *(const LAS bf16x8*)(Qb + (32 * qt + c) * KS + 16 * s + 8 * hh), acc);
                const int i = 32 * qt + c; const float gi = gc[i];
#pragma unroll
                for (int r = 0; r < 16; ++r) { const int j = 32 * kt + (r & 3) + 8 * (r >> 2) + 4 * hh; acc[r] = (j <= i) ? acc[r] * __expf(gi - gc[j]) : 0.f; }
                bf16x8* qf = (bf16x8*)QKg + lane;
                qf[((qt * 2 + kt) * 2 + 0) * 64] = pack8(acc, 0); qf[((qt * 2 + kt) * 2 + 1) * 64] = pack8(acc, 1);
            }
        }
    }
    __syncthreads(); if (unit == PROBE_UNIT) STAMPT(133, 0);
#ifndef PREP_NO_SOLVE
#define PREP_SOLVE32(B0) do { \
        _Pragma("unroll") for (int i = 0; i < 32; ++i) x[i] = rhs[((B0) + i) * 128]; \
        _Pragma("unroll") for (int m = 0; m < 31; ++m) { const float xm = x[m]; \
            _Pragma("unroll") for (int g = (m + 1) / 4; g < 8; ++g) { const f32x4 a4 = *(const LAS f32x4*)(A + ((B0) + m) * 64 + (B0) + 4 * g); \
                if (4 * g > m) x[4 * g] -= a4.x * xm; if (4 * g + 1 > m) x[4 * g + 1] -= a4.y * xm; if (4 * g + 2 > m) x[4 * g + 2] -= a4.z * xm; if (4 * g + 3 > m) x[4 * g + 3] -= a4.w * xm; } } \
        if (tl < 128) { _Pragma("unroll") for (int hx = 0; hx < 2; ++hx) _Pragma("unroll") for (int hf = 0; hf < 2; ++hf) { const int i0 = 16 * hf + 4 * hx; \
                v4u w_; w_.x = bfc2(x[i0], x[i0 + 1]); w_.y = bfc2(x[i0 + 2], x[i0 + 3]); w_.z = bfc2(x[i0 + 8], x[i0 + 9]); w_.w = bfc2(x[i0 + 10], x[i0 + 11]); *(v4u*)(Ug + uoff((B0) + i0, col)) = w_; } } \
        else { _Pragma("unroll") for (int i = 0; i < 32; ++i) Qb[((B0) + i) * KS + col] = bfc(-x[i]); } } while (0)
    int tl = tid; asm volatile("" : "+v"(tl));
    const int c2 = tl & 31, hh2 = (tl >> 5) & 1;
    if (wave < 4) {
        const int col = tl & 127; LAS float* rhs = (tl < 128 ? V : KW) + col;
        float x[32];
        PREP_SOLVE32(0);
        v4u p[4];
#pragma unroll
        for (int k = 0; k < 4; ++k) { p[k].x = bfc2(x[8 * k], x[8 * k + 1]); p[k].y = bfc2(x[8 * k + 2], x[8 * k + 3]); p[k].z = bfc2(x[8 * k + 4], x[8 * k + 5]); p[k].w = bfc2(x[8 * k + 6], x[8 * k + 7]); }
#pragma unroll
        for (int k = 0; k < 4; ++k) *(LAS v4u*)(XT + tl * 32 + 8 * k) = p[k];
    }
    __syncthreads();
    {
        f32x16 acc;
#pragma unroll
        for (int i = 0; i < 16; ++i) acc[i] = 0.f;
#pragma unroll
        for (int s2 = 0; s2 < 2; ++s2) acc = MFMA32(*(const LAS bf16x8*)(A10b + c2 * 40 + 16 * s2 + 8 * hh2), *(const LAS bf16x8*)(XT + (32 * wave + c2) * 32 + 16 * s2 + 8 * hh2), acc);
        LAS float* R1 = (wave < 4 ? V : KW) + 32 * (wave & 3) + c2;
#pragma unroll
        for (int r = 0; r < 16; ++r) { const int i = 32 + (r & 3) + 8 * (r >> 2) + 4 * hh2; R1[i * 128] -= acc[r]; }
    }
    __syncthreads();
    if (wave < 4) {
        const int col = tl & 127; LAS float* rhs = (tl < 128 ? V : KW) + col;
        float x[32];
        PREP_SOLVE32(32);
    }
#undef PREP_SOLVE32
#endif
    __syncthreads(); if (unit == PROBE_UNIT) STAMPT(134, 0);
#pragma unroll
    for (int p = 0; p < 4; ++p) { const int idx = tid + 512 * p, i = idx >> 5, d = (idx & 31) * 4;
        *(v2u*)(WNg + fragoff(i, d, 4)) = *(const LAS v2u*)(Qb + i * KS + d); }
#pragma unroll
    for (int p = 0; p < 4; ++p) { const int idx = tid + 512 * p, d = idx >> 4, i = (idx & 15) * 4;
        *(v2u*)(KDTg + fragoff(d, i, 2)) = *(const LAS v2u*)(KDs + d * 72 + i); }
    if (unit == PROBE_UNIT) STAMPT(135, 0);
}
#define XB_TMO      128
#define XB_XCNT(j)  (256  + 64 * (j))
#define XB_XSUB(j)  (1280 + 64 * (j))
#define XB_XGEN(j)  (2304 + 64 * (j))
#define XB_TOP      3328
#define XB_TOPGEN   3392
#define XCD_BAR_WORDS 3456
#define XB_SPIN_CAP (1u << 18)

__device__ __forceinline__ unsigned xb_ld(unsigned* p)              { return __hip_atomic_load(p, __ATOMIC_RELAXED, __HIP_MEMORY_SCOPE_AGENT); }
__device__ __forceinline__ unsigned xb_add(unsigned* p, unsigned v) { return __hip_atomic_fetch_add(p, v, __ATOMIC_RELAXED, __HIP_MEMORY_SCOPE_AGENT); }
__device__ __forceinline__ unsigned xb_xcc_id() { return (unsigned)__builtin_amdgcn_s_getreg((3 << 11) | 20) & 0xFu; }
#define XB_SPIN(cond, bar) do { unsigned _sp = 0; while (cond) { __builtin_amdgcn_s_sleep(1); \
    if ((++_sp & 255u) == 0u) { if (xb_ld(&(bar)[XB_TMO])) break; if (_sp > XB_SPIN_CAP) { atomicAdd(&(bar)[XB_TMO], 1u); break; } } } } while (0)

struct XcdBarrier {
    unsigned* bar; unsigned x;
    volatile LAS unsigned* st;
};

__device__ __forceinline__ XcdBarrier xcd_barrier_post(unsigned* bar, volatile LAS unsigned* st) {
    XcdBarrier b; b.bar = bar; b.x = xb_xcc_id(); b.st = st;
    if (threadIdx.x == 0) (void)xb_add(&bar[XB_XCNT(b.x)], 1u);
    return b;
}
__device__ __forceinline__ void xcd_barrier_complete(unsigned* bar, unsigned x, unsigned& nloc, unsigned& nx) {
    const unsigned G = gridDim.x * gridDim.y * gridDim.z;
    unsigned sum, cnt, mine, sp = 0u;
    for (;;) {
        sum = 0u; cnt = 0u; mine = 0u;
#pragma unroll
        for (unsigned j = 0; j < 16; ++j) { const unsigned c = xb_ld(&bar[XB_XCNT(j)]); sum += c; cnt += (c > 0u) ? 1u : 0u; mine = (j == x) ? c : mine; }
        if (sum == G) break;
        __builtin_amdgcn_s_sleep(1);
        if ((++sp & 255u) == 0u) { if (xb_ld(&bar[XB_TMO])) break; if (sp > XB_SPIN_CAP) { atomicAdd(&bar[XB_TMO], 1u); break; } }
    }
    nloc = mine > 0u ? mine : 1u; nx = cnt > 0u ? cnt : 1u;
}

__device__ __forceinline__ void xcd_barrier(const XcdBarrier& b) {
    asm volatile("s_waitcnt vmcnt(0)" ::: "memory");
    __syncthreads();
    if (threadIdx.x == 0) {
        unsigned* bar = b.bar;
        __builtin_amdgcn_s_waitcnt(0);
        unsigned nloc = b.st[0], nx = b.st[1];
        if (nloc == 0u) { xcd_barrier_complete(bar, b.x, nloc, nx); b.st[0] = nloc; b.st[1] = nx; }
        const unsigned old = xb_add(&bar[XB_XSUB(b.x)], 1u);
        const unsigned gen = old / nloc;
        if (old + 1u == (gen + 1u) * nloc) {
            __builtin_amdgcn_fence(__ATOMIC_RELEASE, "agent");
            asm volatile("s_waitcnt vmcnt(0)" ::: "memory");
            const unsigned og = xb_add(&bar[XB_TOP], 1u);
            const unsigned tg = og / nx;
            if (og + 1u == (tg + 1u) * nx) xb_add(&bar[XB_TOPGEN], 1u);
            else XB_SPIN(xb_ld(&bar[XB_TOPGEN]) == tg, bar);
            __builtin_amdgcn_fence(__ATOMIC_ACQUIRE, "agent");
            xb_add(&bar[XB_XGEN(b.x)], 1u);
            asm volatile("s_waitcnt vmcnt(0)" ::: "memory");
        } else {
            XB_SPIN(xb_ld(&bar[XB_XGEN(b.x)]) == gen, bar);
            __builtin_amdgcn_fence(__ATOMIC_ACQUIRE, "agent");
            asm volatile("s_waitcnt vmcnt(0)" ::: "memory");
        }
    }
    __syncthreads();
}
#ifndef REP_PRO
#define REP_PRO 1
#endif
#ifndef REP_IN
#define REP_IN 1
#endif
#ifndef REP_PREP
#define REP_PREP 1
#endif
#ifndef REP_SCAN
#define REP_SCAN 1
#endif
#ifndef REP_OUT
#define REP_OUT 1
#endif
#ifndef REP_GU
#define REP_GU 1
#endif
#ifndef REP_DN
#define REP_DN 1
#endif
#ifndef REP_MGU
#define REP_MGU 1
#endif
#ifndef REP_GDN
#define REP_GDN 1
#endif
#ifndef REP_RET
#define REP_RET 1
#endif
#ifndef KV_IN_SCAN
#define KV_IN_SCAN 0
#endif
#ifndef GDN_HELPERS
#define GDN_HELPERS 0
#endif
#ifndef GDN_SPLIT
#define GDN_SPLIT 0
#endif
#ifndef FAST_SCAN
#define FAST_SCAN 1
#endif
#ifndef FAST_RET
#define FAST_RET 1
#endif
#ifndef FAST_PREP
#define FAST_PREP 1
#endif
#ifndef EN_PRO
#define EN_PRO 1
#endif
#ifndef EN_IN
#define EN_IN 1
#endif
#ifndef EN_PREP
#define EN_PREP 1
#endif
#ifndef EN_SCAN
#define EN_SCAN 1
#endif
#ifndef EN_OUT
#define EN_OUT 1
#endif
#ifndef EN_LN1
#define EN_LN1 1
#endif
#ifndef EN_FFN0
#define EN_FFN0 1
#endif
#ifndef EN_MOE
#define EN_MOE 1
#endif

#ifndef PROBE_MULT
#define PROBE_MULT 0
#endif
#ifndef PROBE_BID
#define PROBE_BID 0
#endif
#ifndef PROBE_A
#define PROBE_A 0
#endif
#ifndef PROBE_B
#define PROBE_B 0
#endif
#if PROBE_MULT > 0
#define STAMP(id) do { if (blockIdx.x == PROBE_BID && threadIdx.x == 0) __hip_atomic_store((unsigned long long*)(kargs()->ws + WS_CTL + 131072) + (id), (unsigned long long)__builtin_amdgcn_s_memrealtime(), RLX_AGENT); } while (0)
#else
#define STAMP(id) do {} while (0)
#endif
__global__ void __launch_bounds__(NWAVES * 64, 2) fwd(Args a_unused) {
    extern __shared__ __attribute__((aligned(16))) unsigned char lds_raw[];
    LAS unsigned char* lds = (LAS unsigned char*)lds_raw;
    int stamp_no_ = 1; (void)stamp_no_;
    { const int tid0 = threadIdx.x; for (int u = tid0; u < (LDS_BYTES - LDSCTL_OFF) / 4; u += NWAVES * 64) ((LAS unsigned*)(lds + LDSCTL_OFF))[u] = 0u; }
    __syncthreads();
#if ONE_LAUNCH
    XcdBarrier bar = xcd_barrier_post((unsigned*)(kargs()->ws + WS_CTL) + CW_BAR, (volatile LAS unsigned*)(lds + MISC_OFF) + 8);
#define SEAM() do { STAMP(stamp_no_); ++stamp_no_; xcd_barrier(bar); STAMP(stamp_no_); ++stamp_no_; } while (0)
#else
#define SEAM() do {} while (0)
#endif
#define IN(k) (kargs()->ph_lo <= (k) && (k) < kargs()->ph_hi)
#define BOTH(k) (IN(k) && ((k) + 1) < kargs()->ph_hi)
#define PH_LOCALS KArgs a = kargs(); unsigned char* ws = a->ws; int G = gridDim.x, bid = blockIdx.x; asm volatile("" : "+s"(G), "+s"(bid)); const int tid = tidx(), lane = tid & 63, wave = __builtin_amdgcn_readfirstlane(tid >> 6), gw = bid * NWAVES + wave, NGW = G * NWAVES; (void)ws; (void)lane; (void)gw; (void)NGW;

    if (EN_PRO && IN(PH_PRO)) { _Pragma("unroll 1") for (int rep_ = 0; rep_ < REP_PRO; ++rep_) { if (rep_) SEAM(); PH_LOCALS; ph_prologue(a, lds, wave, lane, gw, NGW, bid * (NWAVES * 64) + tid, G * NWAVES * 64, 0, PRO_I_IN, true); } if (BOTH(PH_PRO)) SEAM(); }

#pragma unroll 1
    for (int l = 0; l < 2; ++l) {
        if (EN_IN && IN(PH_L(l, K_IN))) {
            _Pragma("unroll 1") for (int rep_ = 0; rep_ < REP_IN; ++rep_) { if (rep_) SEAM(); PH_LOCALS;
            pg8::Gemm g{(const pg8::bf16_t*)(ws + WS_XB), (const pg8::bf16_t*)(ws + WS_WIN) + (size_t)l * NIN_PAD * 1024, M, NIN_PAD, 1024}; pg8::StaticOrder S; S.init(M, NIN_PAD, G, bid);
            pg8::EpiHproj E{(pg8::bf16_t*)(ws + WS_R + R_HP), (float*)(ws + WS_GAB)};
            pg8::gemm_phase<pg8::EpiHproj, pg8::StaticOrder, PG8_ALIGN, PG8_SP2>(lds, g, S, E); }
            if (BOTH(PH_L(l, K_IN))) SEAM();
        }
        if (EN_PREP && IN(PH_L(l, K_PREP))) {
            _Pragma("unroll 1") for (int rep_ = 0; rep_ < REP_PREP; ++rep_) { if (rep_) SEAM(); PH_LOCALS; for (int u = bid; u < 1024; u += G) { if (FAST_PREP) gdn_prep_fast(a, l, u, lds, tid, lane, wave); else gdn_prep_unit(a, l, u, lds, tid, lane, wave); }
              STAMP(136); if (FAST_RET && !KV_IN_SCAN) for (int u = bid; u < 512; u += G) ret_kv_unit(a, u, lds, tid, lane, wave); STAMP(137); }
            if (BOTH(PH_L(l, K_PREP))) SEAM();
        }
        if (EN_SCAN && IN(PH_L(l, K_SCAN))) {
            { PH_LOCALS;
#if GDN_SPLIT
            const int n_items = CONV_N_MOE + (l == 0 ? PRO_NIT - PRO_I_IN : 0), n_ret_hi = (l == 0 ? 128 : 256);
            if (bid < 128) { const int t1 = tidx(), w1 = __builtin_amdgcn_readfirstlane(t1 >> 6); const int bh = (bid & 7) + 8 * (bid >> 5), q = (bid >> 3) & 3;
                             gdn_scan_v3(a, l, bh * 4 + q, lds, t1, t1 & 63, w1); STAMP(100 + 10 * l);
                             for (int u = n_ret_hi + bid; u < 512; u += 128) ret_out_unit(a, u, lds, t1, t1 & 63, w1); }
            else {
                { const int t2 = tidx(), w2 = __builtin_amdgcn_readfirstlane(t2 >> 6); conv_range(kargs(), lds, w2, t2 & 63, l, 0, n_items, (bid - 128) * NWAVES + w2, (G - 128) * NWAVES); STAMP(102 + 10 * l); }
                { const int t1 = tidx(), w1 = __builtin_amdgcn_readfirstlane(t1 >> 6);
                  for (int u = bid - 128; u < n_ret_hi; u += G - 128) ret_out_unit(a, u, lds, t1, t1 & 63, w1); }
                STAMP(101 + 10 * l);
            }
#else
            if (bid < 32) { const int t1 = tidx(), w1 = __builtin_amdgcn_readfirstlane(t1 >> 6); gdn_scan_fast(a, l, bid, lds, t1, t1 & 63, w1); STAMP(100 + 10 * l); }
            else {
                if (GDN_HELPERS && bid < 32 + 32 * GDN_HELPERS) gdn_scan_helper(a, bid & 31, tidx());
                if (KV_IN_SCAN) {
                    { const int t0 = tidx(), w0 = __builtin_amdgcn_readfirstlane(t0 >> 6);
                      for (int u = bid - 32; u < 512; u += G - 32) ret_kv_unit(a, u, lds, t0, t0 & 63, w0); }
                    VM_WAIT(); __syncthreads();
                    if (tidx() == 0) { unsigned* sub = (unsigned*)(kargs()->ws + WS_CTL) + CW_SUB + 64 * (1 + l);
                        __builtin_amdgcn_fence(__ATOMIC_RELEASE, "agent"); VM_WAIT();
                        __hip_atomic_fetch_add(sub, 1u, RLX_AGENT);
                        unsigned sp = 0; while (__hip_atomic_load(sub, RLX_AGENT) < (unsigned)(G - 32) && ++sp < (1u << 22)) __builtin_amdgcn_s_sleep(2);
                        __builtin_amdgcn_fence(__ATOMIC_ACQUIRE, "agent"); VM_WAIT(); }
                    __syncthreads();
                }
                { const int t1 = tidx(), w1 = __builtin_amdgcn_readfirstlane(t1 >> 6);
                  for (int u = bid - 32; u < 512; u += G - 32) ret_out_unit(a, u, lds, t1, t1 & 63, w1); }
                __syncthreads(); STAMP(101 + 10 * l);
                { const int t2 = tidx(), w2 = __builtin_amdgcn_readfirstlane(t2 >> 6);
                  moe_convert(kargs(), lds, w2, t2 & 63, (bid - 32) * NWAVES + w2, (G - 32) * NWAVES, 4 * l, 4 * l + 4);
                  if (l == 0) ph_prologue(kargs(), lds, w2, t2 & 63, (bid - 32) * NWAVES + w2, (G - 32) * NWAVES, 0, 0, PRO_I_IN, PRO_NIT, false); STAMP(102 + 10 * l); }
            }
#endif
            }
            if (BOTH(PH_L(l, K_SCAN))) SEAM();
        }
#if GDN_SPLIT
        if (EN_SCAN && IN(PH_L(l, K_FIN))) {
            { PH_LOCALS; gdn_finalize(a, l, lane, gw, NGW); }
            if (BOTH(PH_L(l, K_FIN))) SEAM();
        }
#endif
        if (EN_OUT && IN(PH_L(l, K_OUT))) {
            _Pragma("unroll 1") for (int rep_ = 0; rep_ < REP_OUT; ++rep_) { if (rep_) SEAM(); PH_LOCALS;
            pg8::Gemm g{(const pg8::bf16_t*)(ws + WS_R + R_OB), (const pg8::bf16_t*)(ws + WS_WO) + (size_t)l * 1024 * 1024, M, 1024, 1024}; pg8::StaticOrder S; S.init(M, 1024, G, bid);
            pg8::EpiBf16Out E{(pg8::bf16_t*)(ws + WS_R + R_MIX), 1024};
            pg8::gemm_phase<pg8::EpiBf16Out, pg8::StaticOrder, PG8_ALIGN, PG8_SP2>(lds, g, S, E); }
            if (BOTH(PH_L(l, K_OUT))) SEAM();
        }
        if (EN_LN1 && IN(PH_L(l, K_LN1))) {
            { PH_LOCALS;
            if (l == 0) ln_rows<false>(a->in[0], ALPHA, (const bf16*)(ws + WS_R + R_MIX), a->in[7], a->in[8], a->out, 1.0f, (bf16*)(ws + WS_XB), nullptr, nullptr, nullptr, nullptr, lane, gw, NGW);
            else { ln_rows<true>(a->out, ALPHA, (const bf16*)(ws + WS_R + R_MIX), a->in[7] + 1024, a->in[8] + 1024, a->out, ALPHA, (bf16*)(ws + WS_XB), (const float*)(ws + WS_RWT), (unsigned*)(ws + WS_CTL) + CW_MOE, (int*)(ws + WS_LIST), (float*)(ws + WS_GATE), lane, gw, NGW, lds, tid);
                 } }
            if (BOTH(PH_L(l, K_LN1))) SEAM();
        }
        if (l == 0) {
            if (EN_FFN0 && IN(PH_L(0, K_GU))) {
                _Pragma("unroll 1") for (int rep_ = 0; rep_ < REP_GU; ++rep_) { if (rep_) SEAM(); PH_LOCALS;
                pg8::Gemm g{(const pg8::bf16_t*)(ws + WS_XB), (const pg8::bf16_t*)(ws + WS_WGU), M, 2 * FF, 1024}; pg8::StaticOrder S; S.init(M, 2 * FF, G, bid);
                pg8::EpiSwiglu E{(pg8::bf16_t*)(ws + WS_R + R_H), FF, 0};
                pg8::gemm_phase<pg8::EpiSwiglu, pg8::StaticOrder, PG8_ALIGN, PG8_SP2>(lds, g, S, E); }
                if (BOTH(PH_L(0, K_GU))) SEAM();
            }
            if (EN_FFN0 && IN(PH_L(0, K_DN))) {
                _Pragma("unroll 1") for (int rep_ = 0; rep_ < REP_DN; ++rep_) { if (rep_) SEAM(); PH_LOCALS;
                pg8::Gemm g{(const pg8::bf16_t*)(ws + WS_R + R_H), (const pg8::bf16_t*)(ws + WS_WD), M, 1024, FF}; pg8::StaticOrder S; S.init(M, 1024, G, bid);
                pg8::EpiBf16Out E{(pg8::bf16_t*)(ws + WS_R + R_MIX), 1024};
                pg8::gemm_phase<pg8::EpiBf16Out, pg8::StaticOrder, PG8_ALIGN, PG8_SP2>(lds, g, S, E); }
                if (BOTH(PH_L(0, K_DN))) SEAM();
            }
            if (EN_LN1 && IN(PH_L(0, K_LN2))) {
                { PH_LOCALS;
                ln_rows<false>(a->out, ALPHA, (const bf16*)(ws + WS_R + R_MIX), a->in[9], a->in[10], a->out, 1.0f, (bf16*)(ws + WS_XB), nullptr, nullptr, nullptr, nullptr, lane, gw, NGW); }
                if (BOTH(PH_L(0, K_LN2))) SEAM();
            }
        } else {
#pragma unroll 1
            for (int j = 0; j < 2; ++j) {
                const int kg = K_G0 + 3 * j;
                if (EN_MOE && j == 0 && IN(PH_L(1, kg))) { { PH_LOCALS; moe_gather(a, 0, lane, gw, NGW); moe_gather(a, 1, lane, gw, NGW); } if (BOTH(PH_L(1, kg))) SEAM(); }
                if (EN_MOE && IN(PH_L(1, kg + 1))) {
                    { PH_LOCALS;
                    pg8::moe_table(lds, (const unsigned*)(ws + WS_CTL) + CW_MOE, tid);
                    const PG8_LAS int* tab = (const PG8_LAS int*)(lds + pg8::MOE_TAB_OFF);
                    if (j == 1 && bid < 32) {
#pragma unroll 1
                        for (int jj = 0; jj < 2; ++jj) {
                            { pg8::MoeSched<true> S; S.tab = tab; S.j0 = jj; S.a0 = 64 + (bid >> 2); S.c = bid & 3; S.mode = (64 + (bid >> 2)) < pg8::moe_T(lds, jj) ? 1 : 2;
                              S.n0 = S.n1 = S.a1 = S.j1 = 0; S.G = 1;
                              pg8::Gemm g{(const pg8::bf16_t*)(ws + WS_R + R_HM), (const pg8::bf16_t*)(ws + WS_WMD), MOE_ROWS, 1024, FE, 1};
                              pg8::EpiMoeDown E{a->out, (const int*)(ws + WS_LIST), (const float*)(ws + WS_GATE), tab};
                              pg8::gemm_phase<pg8::EpiMoeDown, pg8::MoeSched<true>, PG8_ALIGN, PG8_SP2>(lds, g, S, E); }
                            if (jj == 0) {
                                VM_WAIT(); __syncthreads();
                                if (tidx() == 0) { unsigned* sub = (unsigned*)(kargs()->ws + WS_CTL) + CW_SUB;
                                    __builtin_amdgcn_fence(__ATOMIC_RELEASE, "agent"); VM_WAIT();
                                    __hip_atomic_fetch_add(sub, 1u, RLX_AGENT);
                                    unsigned sp = 0; while (__hip_atomic_load(sub, RLX_AGENT) < 32u && ++sp < (1u << 22)) __builtin_amdgcn_s_sleep(2);
                                    __builtin_amdgcn_fence(__ATOMIC_ACQUIRE, "agent"); VM_WAIT(); }
                                __syncthreads();
                            }
                        }
                    } else {
                        pg8::MoeSched<false> S; S.tab = tab; S.mode = 0;
                        const int T0 = pg8::moe_T(lds, 0), T1 = pg8::moe_T(lds, 1);
                        if (j == 0) { S.j0 = 0; S.a0 = 0; S.n0 = T0; S.j1 = 1; S.a1 = 64; S.n1 = T1 > 64 ? T1 - 64 : 0; S.G = G; S.c = bid; }
                        else        { S.j0 = 1; S.a0 = 0; S.n0 = T1 < 64 ? T1 : 64; S.j1 = 1; S.a1 = 0; S.n1 = 0; S.G = G - 32; S.c = bid - 32; }
                        pg8::Gemm g{(const pg8::bf16_t*)(ws + WS_R + R_XG), (const pg8::bf16_t*)(ws + WS_WMGU), MOE_ROWS, 2 * FE, 1024};
                        pg8::EpiSwiglu E{(pg8::bf16_t*)(ws + WS_R + R_HM), FE, 1};
                        pg8::gemm_phase<pg8::EpiSwiglu, pg8::MoeSched<false>, PG8_ALIGN, PG8_SP2>(lds, g, S, E);
                    } }
                    if (BOTH(PH_L(1, kg + 1))) SEAM();
                }
                if (EN_MOE && IN(PH_L(1, kg + 2))) {
                    { PH_LOCALS;
                    pg8::moe_table(lds, (const unsigned*)(ws + WS_CTL) + CW_MOE, tid);
                    const PG8_LAS int* tab = (const PG8_LAS int*)(lds + pg8::MOE_TAB_OFF);
                    const int Tj = pg8::moe_T(lds, j);
                    pg8::MoeSched<true> S; S.tab = tab; S.mode = 0; S.j0 = j; S.a0 = 0; S.n0 = Tj < 64 ? Tj : 64; S.j1 = j; S.a1 = 0; S.n1 = 0; S.G = G; S.c = bid;
                    pg8::Gemm g{(const pg8::bf16_t*)(ws + WS_R + R_HM), (const pg8::bf16_t*)(ws + WS_WMD), MOE_ROWS, 1024, FE, 1};
                    pg8::EpiMoeDown E{a->out, (const int*)(ws + WS_LIST), (const float*)(ws + WS_GATE), tab};
                    pg8::gemm_phase<pg8::EpiMoeDown, pg8::MoeSched<true>, PG8_ALIGN, PG8_SP2>(lds, g, S, E); }
                    if (BOTH(PH_L(1, kg + 2))) SEAM();
                }
            }
            if (EN_LN1 && IN(PH_L(1, K_LNF))) {
                PH_LOCALS;
                ln_rows<false>(a->out, 1.0f, nullptr, a->in[9] + 1024, a->in[10] + 1024, a->out, 1.0f, nullptr, nullptr, nullptr, nullptr, nullptr, lane, gw, NGW);
            }
        }
    }
    STAMP(stamp_no_);
#if PROBE_MULT > 0
    if (blockIdx.x == PROBE_BID && threadIdx.x == 0) {
        const unsigned long long* ts = (const unsigned long long*)(kargs()->ws + WS_CTL + 131072);
        const unsigned long long ta = __hip_atomic_load(ts + PROBE_A, RLX_AGENT), tb = __hip_atomic_load(ts + PROBE_B, RLX_AGENT);
        const unsigned long long hold = (tb > ta ? tb - ta : 0ull) * (unsigned long long)PROBE_MULT, t0 = __builtin_amdgcn_s_memrealtime();
        while (__builtin_amdgcn_s_memrealtime() - t0 < hold && __builtin_amdgcn_s_memrealtime() - t0 < 2000000ull) __builtin_amdgcn_s_sleep(8);
    }
#endif
#undef IN
#undef BOTH
}

extern "C" void kernel_launch(void* const* d_in, const int* in_sizes, int n_in, void* d_out, int out_size, void* d_ws, size_t ws_size, hipStream_t stream) {
    static int grid = 0;
    if (grid == 0) {
        if (n_in != 18 || in_sizes[0] != M * D || out_size != M * D || ws_size < WS_END) { fprintf(stderr, "kernel_launch: unexpected shapes or workspace (%zu < %zu); nothing launched\n", ws_size, (size_t)WS_END); grid = -1; return; }
        int dev = 0, cus = 0, per_cu = 0;
        if (hipGetDevice(&dev) != hipSuccess || hipDeviceGetAttribute(&cus, hipDeviceAttributeMultiprocessorCount, dev) != hipSuccess) { grid = -1; return; }
        if (hipFuncSetAttribute((const void*)fwd, hipFuncAttributeMaxDynamicSharedMemorySize, LDS_BYTES) != hipSuccess) { fprintf(stderr, "kernel_launch: hipFuncSetAttribute failed\n"); grid = -1; return; }
        if (hipOccupancyMaxActiveBlocksPerMultiprocessor(&per_cu, (const void*)fwd, NWAVES * 64, LDS_BYTES) != hipSuccess || per_cu < 1) fprintf(stderr, "kernel_launch: occupancy query reports %d\n", per_cu);
        (void)hipGetLastError();
        grid = cus;
    }
    if (grid < 0) return;
    if (hipMemsetAsync((char*)d_ws + WS_CTL, 0, CTL_BYTES, stream) != hipSuccess) return;
    Args a{};
    for (int i = 0; i < 18; ++i) a.in[i] = (const float*)d_in[i];
    a.out = (float*)d_out; a.ws = (unsigned char*)d_ws;
#if ONE_LAUNCH
    a.ph_lo = 0; a.ph_hi = PH_END;
    hipLaunchKernelGGL(fwd, dim3(grid), dim3(NWAVES * 64), LDS_BYTES, stream, a);
#else
    static const int phases[] = {PH_PRO,
        PH_L(0, K_IN), PH_L(0, K_PREP), PH_L(0, K_SCAN), PH_L(0, K_OUT), PH_L(0, K_LN1), PH_L(0, K_GU), PH_L(0, K_DN), PH_L(0, K_LN2),
        PH_L(1, K_IN), PH_L(1, K_PREP), PH_L(1, K_SCAN), PH_L(1, K_OUT), PH_L(1, K_LN1),
        PH_L(1, K_G0), PH_L(1, K_GU0), PH_L(1, K_DN0), PH_L(1, K_G1), PH_L(1, K_GU1), PH_L(1, K_DN1), PH_L(1, K_LNF)};
    for (unsigned i = 0; i < sizeof(phases) / sizeof(phases[0]); ++i) {
        a.ph_lo = phases[i]; a.ph_hi = phases[i] + 1;
        hipLaunchKernelGGL(fwd, dim3(grid), dim3(NWAVES * 64), LDS_BYTES, stream, a);
    }
#endif
}
```

```cpp
#define GDN_NT 1
#include <hip/hip_runtime.h>
#include <cstdio>
#include <cstdint>

#ifndef ONE_LAUNCH
#define ONE_LAUNCH 1
#endif

#define GAS __attribute__((address_space(1)))
#define LAS __attribute__((address_space(3)))
typedef unsigned short bf16;
typedef unsigned v4u __attribute__((ext_vector_type(4)));
typedef unsigned v2u __attribute__((ext_vector_type(2)));
typedef float f32x4 __attribute__((ext_vector_type(4)));
typedef float f32x2 __attribute__((ext_vector_type(2)));
#define RLX_AGENT __ATOMIC_RELAXED, __HIP_MEMORY_SCOPE_AGENT
#define LDS_WAIT() asm volatile("s_waitcnt lgkmcnt(0)" ::: "memory")
#define VM_WAIT() asm volatile("s_waitcnt vmcnt(0)" ::: "memory")

__device__ __forceinline__ unsigned f2bf(float f) { unsigned u = __builtin_bit_cast(unsigned, f); return (u + 0x7fffu + ((u >> 16) & 1u)) >> 16; }
__device__ __forceinline__ unsigned pk2(float lo, float hi) { return f2bf(lo) | (f2bf(hi) << 16); }
__device__ __forceinline__ float bf2f(unsigned short u) { return __builtin_bit_cast(float, (unsigned)u << 16); }
__device__ __forceinline__ float bflo(unsigned u) { return __builtin_bit_cast(float, u << 16); }
__device__ __forceinline__ float bfhi(unsigned u) { return __builtin_bit_cast(float, u & 0xffff0000u); }
__device__ __forceinline__ float siluf(float x) { return x * __builtin_amdgcn_rcpf(1.f + __expf(-x)); }
__device__ __forceinline__ float sigmf(float x) { return 1.f / (1.f + __expf(-x)); }
__device__ __forceinline__ float wave_sum(float v) {
    v += __builtin_bit_cast(float, __builtin_amdgcn_update_dpp(0, __builtin_bit_cast(int, v), 0xB1, 0xF, 0xF, true));
    v += __builtin_bit_cast(float, __builtin_amdgcn_update_dpp(0, __builtin_bit_cast(int, v), 0x4E, 0xF, 0xF, true));
    v += __builtin_bit_cast(float, __builtin_amdgcn_update_dpp(0, __builtin_bit_cast(int, v), 0x141, 0xF, 0xF, true));
    v += __builtin_bit_cast(float, __builtin_amdgcn_update_dpp(0, __builtin_bit_cast(int, v), 0x140, 0xF, 0xF, true));
    v += __builtin_bit_cast(float, __builtin_amdgcn_update_dpp(0, __builtin_bit_cast(int, v), 0x142, 0xA, 0xF, false));
    v += __builtin_bit_cast(float, __builtin_amdgcn_update_dpp(0, __builtin_bit_cast(int, v), 0x143, 0xC, 0xF, false));
    return __builtin_bit_cast(float, __builtin_amdgcn_readlane(__builtin_bit_cast(int, v), 63));
}

constexpr int NWAVES = 8;
constexpr int M = 16384, D = 1024, SEQ = 2048, NB = 8;
constexpr int IN_COLS = 3592, NIN_PAD = 3840, HP_LD = 3584;
constexpr int FF = 2816, FE = 3584, NE = 8;
constexpr int COL_RQ = 0, COL_RK = 256, COL_RV = 512, COL_RG = 1024, COL_GQ = 1536, COL_GK = 2048, COL_GV = 2560, COL_GG = 3072;
constexpr float ALPHA = 1.41421356237f;
constexpr float LN_EPS = 1e-5f, NORM_EPS = 1e-6f;
constexpr int MOE_ROWS = 72 * 256;

__host__ __device__ __forceinline__ int fragoff(int i, int d, int nkt) {
    return ((((i >> 5) * nkt + (d >> 5)) * 2 + ((d >> 4) & 1)) * 512) + ((((d >> 2) & 1) * 32 + (i & 31)) * 8) + ((((d >> 3) & 1) << 2) | (d & 3));
}
__host__ __device__ __forceinline__ int uoff(int i, int e) {
    const int reg = (i & 3) | (((i & 31) >> 3) << 2);
    return (((((e >> 5) * 2 + (i >> 5)) * 2 + (reg >> 3)) * 64 + (((i >> 2) & 1) * 32 + (e & 31))) * 8) + (reg & 7);
}
namespace pg8 {
#define PG8_LAS __attribute__((address_space(3)))
typedef unsigned short bf16_t;
typedef short bf16x8 __attribute__((ext_vector_type(8)));
typedef float f32x4 __attribute__((ext_vector_type(4)));
typedef unsigned u32x4 __attribute__((ext_vector_type(4)));
constexpr int BM = 256, BK = 64, HALF = 128, HTB = HALF * BK * 2  , STAGE_BYTES = 8 * HTB, NXCD = 8, WGM = 8;

__host__ __device__ __forceinline__ int lds_byte(int r, int c) { const int st = (r >> 4) * 2 + (c >> 5), rr = r & 15, cc = c & 31, ob = rr * 64 + cc * 2; return st * 1024 + (ob ^ (((ob >> 9) & 1) << 5)); }
__host__ __device__ __forceinline__ void stage_rc(int b, int& R, int& C) { const int st = b / 1024, sb = b % 1024, swz = sb ^ (((sb >> 9) & 1) << 5); R = (st >> 1) * 16 + swz / 64; C = (st & 1) * 32 + (swz % 64) / 2; }
__host__ __device__ __forceinline__ int perm32(int rho) { const int n = rho >> 4, i = rho & 15; return 8 * (i >> 2) + 4 * n + (i & 3); }

struct Unit { int pm, pn, aux, am, sel; };
struct Gemm { const bf16_t* A; const bf16_t* Bt; int M, N, K, blk; };

struct StaticOrder {
    int nM, nN, nwg, G, c;
    __host__ __device__ void init(int M, int N, int G_, int c_) { nM = M / BM; nN = N / BM; nwg = nM * nN; G = G_; c = c_; }
    __host__ __device__ bool next(int i, Unit& u) const {
        const long L = (long)i * G + c; if (L >= nwg) return false;
        int wgid = (int)L; { const int q = nwg / NXCD, r = nwg % NXCD, xcd = wgid % NXCD, off = wgid / NXCD; wgid = (xcd < r ? xcd * (q + 1) : r * (q + 1) + (xcd - r) * q) + off; }
        const int nig = WGM * nN, gid = wgid / nig, fm = gid * WGM, gsz = (nM - fm) < WGM ? (nM - fm) : WGM;
        u.pm = fm + ((wgid % nig) % gsz); u.pn = (wgid % nig) / gsz; u.aux = 0; u.am = u.pm; u.sel = 0; return true;
    }
    __device__ __forceinline__ const char* aptr(const Gemm& g, const Unit& u) const { return (const char*)g.A + (size_t)u.pm * ((size_t)BM * g.K * 2); }
    __device__ __forceinline__ const char* bptr(const Gemm& g, const Unit& u) const { return (const char*)g.Bt + (size_t)u.pn * ((size_t)BM * g.K * 2); }
    __device__ __forceinline__ void a_ready(const Unit&) const {}
    __device__ __forceinline__ void done(const Unit&) const {}
};

template <class Epi, class Sched, bool ALIGN_EPI = false, bool SP2 = false>
__device__ __forceinline__ void gemm_phase(PG8_LAS unsigned char* lds, const Gemm g, const Sched& S, const Epi& E) {
    int tid = threadIdx.x; asm volatile("" : "+v"(tid)); const int wid = __builtin_amdgcn_readfirstlane(tid >> 6), lane = tid & 63, wr = wid >> 2, wc = wid & 3, fr = lane & 15, fq = lane >> 4;
    const int K = g.K, nt = K / BK;
    unsigned voffA[2], voffB[2];
#pragma unroll
    for (int i = 0; i < 2; ++i) { int R, C; stage_rc(tid * 16 + i * 8192, R, C); const int Rb = Epi::PERM ? ((R & ~31) + perm32(R & 31)) : R;
        voffA[i] = (unsigned)(R * (g.blk ? 64 : K) + C) * 2u; voffB[i] = (unsigned)(Rb * (g.blk ? 64 : K) + C) * 2u; }
    const size_t kstep = g.blk ? (size_t)(256 * 64 * 2) : (size_t)(BK * 2);
    const size_t hstep = g.blk ? (size_t)(HALF * 64 * 2) : (size_t)HALF * K * 2;
    const size_t tstep = 2 * hstep;
    const unsigned ldsw = (unsigned)wid * 1024u;
    const int aoff = lds_byte(wr * 64 + fr, fq * 8), boff = lds_byte(wc * 32 + fr, fq * 8);
#define PG8_SA(b, h) (((b) * 2 + (h)) * HTB)
#define PG8_SB(b, h) ((4 + (b) * 2 + (h)) * HTB)
#define PG8_STAGE(bufoff, gbase, voff) do { _Pragma("unroll") for (int _i = 0; _i < 2; ++_i) \
        __builtin_amdgcn_global_load_lds((const unsigned*)((const char*)(gbase) + (voff)[_i]), (PG8_LAS unsigned*)(lds + (bufoff) + ldsw + _i * 8192), 16, 0, 0); } while (0)
#define PG8_LDA(dst, b, h) do { _Pragma("unroll") for (int m = 0; m < 4; ++m) _Pragma("unroll") for (int k = 0; k < 2; ++k) dst[m][k] = *(const PG8_LAS bf16x8*)(lds + PG8_SA(b, h) + aoff + m * 2048 + k * 1024); } while (0)
#define PG8_LDB(dst, b, h) do { _Pragma("unroll") for (int n = 0; n < 2; ++n) _Pragma("unroll") for (int k = 0; k < 2; ++k) dst[n][k] = *(const PG8_LAS bf16x8*)(lds + PG8_SB(b, h) + boff + n * 2048 + k * 1024); } while (0)
#define PG8_MMA(ai, bj, At, Bt) do { __builtin_amdgcn_s_setprio(1); _Pragma("unroll") for (int m = 0; m < 4; ++m) _Pragma("unroll") for (int n = 0; n < 2; ++n) _Pragma("unroll") for (int k = 0; k < 2; ++k) \
        acc[ai][bj][m][n] = __builtin_amdgcn_mfma_f32_16x16x32_bf16(Bt[n][k], At[m][k], acc[ai][bj][m][n], 0, 0, 0); __builtin_amdgcn_s_setprio(0); } while (0)
#define PG8_WAIT_V(n) asm volatile("s_waitcnt vmcnt(" #n ")" ::: "memory")
#define PG8_WAIT_L(n) asm volatile("s_waitcnt lgkmcnt(" #n ")" ::: "memory")
#define PG8_BAR __builtin_amdgcn_s_barrier()
#define PG8_SCHED __builtin_amdgcn_sched_barrier(0)
    Unit cur, nxt; int ui = 0;
    if (!S.next(0, cur)) return;
    f32x4 acc[2][2][4][2];
#pragma unroll
    for (int a = 0; a < 2; ++a)
#pragma unroll
        for (int b = 0; b < 2; ++b)
#pragma unroll
            for (int m = 0; m < 4; ++m)
#pragma unroll
                for (int n = 0; n < 2; ++n) acc[a][b][m][n] = (f32x4){0.f, 0.f, 0.f, 0.f};
    bf16x8 At[4][2], B0[2][2], B1[2][2];
    const char* cA = S.aptr(g, cur); const char* cB = S.bptr(g, cur);
    S.a_ready(cur);
    if constexpr (SP2) {
        PG8_STAGE(PG8_SB(0, 0), cB, voffB); PG8_STAGE(PG8_SB(0, 1), cB + hstep, voffB); PG8_STAGE(PG8_SA(0, 0), cA, voffA); PG8_STAGE(PG8_SA(0, 1), cA + hstep, voffA);
        if (wr == 1) PG8_BAR;
        PG8_WAIT_V(2); PG8_BAR;
        PG8_STAGE(PG8_SB(1, 0), cB + kstep, voffB); PG8_STAGE(PG8_SA(1, 0), cA + kstep, voffA); PG8_STAGE(PG8_SB(1, 1), cB + hstep + kstep, voffB);
        PG8_WAIT_V(6); PG8_BAR;
    } else {
        PG8_STAGE(PG8_SB(0, 0), cB, voffB); PG8_STAGE(PG8_SA(0, 0), cA, voffA); PG8_STAGE(PG8_SB(0, 1), cB + hstep, voffB); PG8_STAGE(PG8_SA(0, 1), cA + hstep, voffA);
        if (wr == 1) PG8_BAR;
        PG8_WAIT_V(4); PG8_BAR;
        PG8_STAGE(PG8_SB(1, 0), cB + kstep, voffB); PG8_STAGE(PG8_SA(1, 0), cA + kstep, voffA); PG8_STAGE(PG8_SB(1, 1), cB + hstep + kstep, voffB);
        PG8_WAIT_V(6); PG8_BAR;
    }
    for (;;) {
        const bool has_next = S.next(ui + 1, nxt);
        const char* nA = has_next ? S.aptr(g, nxt) : cA; const char* nB = has_next ? S.bptr(g, nxt) : cB;
        for (int t = 0; t < nt; t += 2) {
            const bool last = (t == nt - 2);
            const char* a1 = cA + (size_t)(t + 1) * kstep;
            const char* a2 = last ? nA : cA + (size_t)(t + 2) * kstep; const char* b2 = last ? nB : cB + (size_t)(t + 2) * kstep;
            const char* a3 = a2 + kstep; const char* b3 = b2 + kstep;
            if (last && has_next) S.a_ready(nxt);
            if constexpr (SP2) {
            PG8_LDB(B0, 0, 0); PG8_LDB(B1, 0, 1); PG8_SCHED; PG8_LDA(At, 0, 0); PG8_STAGE(PG8_SA(1, 1), a1 + hstep, voffA);
            PG8_WAIT_V(8); PG8_WAIT_L(0); PG8_BAR; PG8_MMA(0, 0, At, B0); PG8_MMA(0, 1, At, B1); PG8_BAR; PG8_SCHED;
            PG8_LDA(At, 0, 1); PG8_STAGE(PG8_SB(0, 0), b2, voffB); PG8_STAGE(PG8_SB(0, 1), b2 + hstep, voffB); PG8_STAGE(PG8_SA(0, 0), a2, voffA);
            PG8_WAIT_V(8); PG8_WAIT_L(0); PG8_BAR; PG8_MMA(1, 0, At, B0); PG8_MMA(1, 1, At, B1); PG8_BAR; PG8_SCHED;
            PG8_LDB(B0, 1, 0); PG8_LDB(B1, 1, 1); PG8_SCHED; PG8_LDA(At, 1, 0); PG8_STAGE(PG8_SA(0, 1), a2 + hstep, voffA);
            PG8_WAIT_V(8); PG8_WAIT_L(0); PG8_BAR; PG8_MMA(0, 0, At, B0); PG8_MMA(0, 1, At, B1); PG8_BAR; PG8_SCHED;
            PG8_LDA(At, 1, 1); PG8_STAGE(PG8_SB(1, 0), b3, voffB); PG8_STAGE(PG8_SB(1, 1), b3 + hstep, voffB); PG8_STAGE(PG8_SA(1, 0), a3, voffA);
            PG8_WAIT_V(8); PG8_WAIT_L(0); PG8_BAR; PG8_MMA(1, 0, At, B0); PG8_MMA(1, 1, At, B1); PG8_BAR; PG8_SCHED;
            } else {
            PG8_LDB(B0, 0, 0); PG8_SCHED; PG8_LDA(At, 0, 0); PG8_STAGE(PG8_SA(1, 1), a1 + hstep, voffA);
            PG8_WAIT_L(8); PG8_BAR; PG8_WAIT_L(0); PG8_MMA(0, 0, At, B0); PG8_BAR; PG8_SCHED;
            PG8_LDB(B1, 0, 1); PG8_STAGE(PG8_SB(0, 0), b2, voffB);
            PG8_BAR; PG8_WAIT_L(0); PG8_MMA(0, 1, At, B1); PG8_BAR;
            PG8_LDA(At, 0, 1); PG8_STAGE(PG8_SA(0, 0), a2, voffA);
            PG8_BAR; PG8_WAIT_L(0); PG8_MMA(1, 0, At, B0); PG8_BAR; PG8_SCHED;
            PG8_STAGE(PG8_SB(0, 1), b2 + hstep, voffB);
            PG8_WAIT_V(6); PG8_BAR; PG8_MMA(1, 1, At, B1); PG8_BAR;
            PG8_LDB(B0, 1, 0); PG8_SCHED; PG8_LDA(At, 1, 0); PG8_STAGE(PG8_SA(0, 1), a2 + hstep, voffA);
            PG8_WAIT_L(8); PG8_BAR; PG8_WAIT_L(0); PG8_MMA(0, 0, At, B0); PG8_BAR; PG8_SCHED;
            PG8_LDB(B1, 1, 1); PG8_STAGE(PG8_SB(1, 0), b3, voffB);
            PG8_BAR; PG8_WAIT_L(0); PG8_MMA(0, 1, At, B1); PG8_BAR;
            PG8_LDA(At, 1, 1); PG8_STAGE(PG8_SA(1, 0), a3, voffA);
            PG8_BAR; PG8_WAIT_L(0); PG8_MMA(1, 0, At, B0); PG8_BAR; PG8_SCHED;
            PG8_STAGE(PG8_SB(1, 1), b3 + hstep, voffB);
            PG8_WAIT_V(6); PG8_BAR; PG8_MMA(1, 1, At, B1); PG8_BAR;
            }
        }
        if constexpr (ALIGN_EPI) { if (wr == 0) PG8_BAR; }
        if constexpr (!Epi::AFTER_DRAIN) { E(acc, cur, wr, wc, fr, fq); S.done(cur); }
        if (!has_next) break;
#pragma unroll
        for (int a = 0; a < 2; ++a)
#pragma unroll
            for (int b = 0; b < 2; ++b)
#pragma unroll
                for (int m = 0; m < 4; ++m)
#pragma unroll
                    for (int n = 0; n < 2; ++n) acc[a][b][m][n] = (f32x4){0.f, 0.f, 0.f, 0.f};
        cur = nxt; cA = nA; cB = nB; ++ui;
        if constexpr (ALIGN_EPI) { if (wr == 1) PG8_BAR; }
    }
    PG8_WAIT_V(0);
    if constexpr (!ALIGN_EPI) { if (wr == 0) PG8_BAR; }
    PG8_BAR;
    if constexpr (Epi::AFTER_DRAIN) { E.fused(acc, cur, wr, wc, fr, fq, lds, wid, lane); S.done(cur); }
#undef PG8_SA
#undef PG8_SB
#undef PG8_STAGE
#undef PG8_LDA
#undef PG8_LDB
#undef PG8_MMA
#undef PG8_WAIT_V
#undef PG8_WAIT_L
#undef PG8_BAR
#undef PG8_SCHED
}
}

namespace pg8 {
__device__ __forceinline__ unsigned cvt_pk_bf16(float lo, float hi) { unsigned r; asm volatile("v_cvt_pk_bf16_f32 %0, %1, %2" : "=v"(r) : "v"(lo), "v"(hi)); return r; }

struct EpiHproj {
    static constexpr bool PERM = true, AFTER_DRAIN = false;
    bf16_t* HP; float* GAB;
    __device__ __forceinline__ void operator()(const f32x4 (&acc)[2][2][4][2], const Unit& u, int wr, int wc, int fr, int fq) const {
        const int row0 = u.pm * BM + wr * 64 + fr;
        if (u.pn < 14) {
            const int col0 = u.pn * BM + wc * 32 + 8 * fq;
#pragma unroll
            for (int ai = 0; ai < 2; ++ai)
#pragma unroll
                for (int m = 0; m < 4; ++m) { bf16_t* rowp = HP + (size_t)(row0 + ai * HALF + m * 16) * 3584 + col0;
#pragma unroll
                    for (int bj = 0; bj < 2; ++bj) { const f32x4 v0 = acc[ai][bj][m][0], v1 = acc[ai][bj][m][1];
                        u32x4 w; w.x = cvt_pk_bf16(v0[0], v0[1]); w.y = cvt_pk_bf16(v0[2], v0[3]); w.z = cvt_pk_bf16(v1[0], v1[1]); w.w = cvt_pk_bf16(v1[2], v1[3]);
                        *(u32x4*)(rowp + bj * HALF) = w; } }
        } else if (wc == 0 && fq == 0) {
#pragma unroll
            for (int ai = 0; ai < 2; ++ai)
#pragma unroll
                for (int m = 0; m < 4; ++m) { float* rowp = GAB + (size_t)(row0 + ai * HALF + m * 16) * 8;
                    *(f32x4*)(rowp) = acc[ai][0][m][0]; *(f32x4*)(rowp + 4) = acc[ai][0][m][1]; }
        }
    }
};
struct EpiBf16Out {
    static constexpr bool PERM = true, AFTER_DRAIN = false;
    bf16_t* O; int ldc;
    __device__ __forceinline__ void operator()(const f32x4 (&acc)[2][2][4][2], const Unit& u, int wr, int wc, int fr, int fq) const {
        const int row0 = u.pm * BM + wr * 64 + fr, col0 = u.pn * BM + wc * 32 + 8 * fq;
#pragma unroll
        for (int ai = 0; ai < 2; ++ai)
#pragma unroll
            for (int m = 0; m < 4; ++m) { bf16_t* rowp = O + (size_t)(row0 + ai * HALF + m * 16) * ldc + col0;
#pragma unroll
                for (int bj = 0; bj < 2; ++bj) { const f32x4 v0 = acc[ai][bj][m][0], v1 = acc[ai][bj][m][1];
                    u32x4 w; w.x = cvt_pk_bf16(v0[0], v0[1]); w.y = cvt_pk_bf16(v0[2], v0[3]); w.z = cvt_pk_bf16(v1[0], v1[1]); w.w = cvt_pk_bf16(v1[2], v1[3]);
                    *(u32x4*)(rowp + bj * HALF) = w; } }
    }
};
struct EpiF32 {
    static constexpr bool PERM = false, AFTER_DRAIN = false;
    float* O; int ldc;
    __device__ __forceinline__ void operator()(const f32x4 (&acc)[2][2][4][2], const Unit& u, int wr, int wc, int fr, int fq) const {
        const int row0 = u.pm * BM + wr * 64 + fr, col0 = u.pn * BM + wc * 32 + 4 * fq;
#pragma unroll
        for (int ai = 0; ai < 2; ++ai)
#pragma unroll
            for (int m = 0; m < 4; ++m) { float* rowp = O + (size_t)(row0 + ai * HALF + m * 16) * ldc + col0;
#pragma unroll
                for (int bj = 0; bj < 2; ++bj)
#pragma unroll
                    for (int n = 0; n < 2; ++n) *(f32x4*)(rowp + bj * HALF + n * 16) = acc[ai][bj][m][n]; }
    }
};
struct EpiSwiglu {
    static constexpr bool PERM = true, AFTER_DRAIN = false;
    bf16_t* H; int ldh; int blk;
    __device__ __forceinline__ void operator()(const f32x4 (&acc)[2][2][4][2], const Unit& u, int wr, int wc, int fr, int fq) const {
        const int rt = wr * 64 + fr, col0 = u.pn * HALF + wc * 32 + 8 * fq;
        bf16_t* tb = H + (size_t)u.pm * BM * ldh;
#pragma unroll
        for (int ai = 0; ai < 2; ++ai)
#pragma unroll
            for (int m = 0; m < 4; ++m) { const int r = rt + ai * HALF + m * 16;
                bf16_t* rowp = blk ? tb + (size_t)(col0 >> 6) * (BM * 64) + r * 64 + (col0 & 63) : tb + (size_t)r * ldh + col0;
                float h[8];
#pragma unroll
                for (int n = 0; n < 2; ++n)
#pragma unroll
                    for (int i = 0; i < 4; ++i) { const float gt = acc[ai][0][m][n][i], up = acc[ai][1][m][n][i]; h[n * 4 + i] = gt * up * __builtin_amdgcn_rcpf(1.f + __expf(-gt)); }
                u32x4 w; w.x = cvt_pk_bf16(h[0], h[1]); w.y = cvt_pk_bf16(h[2], h[3]); w.z = cvt_pk_bf16(h[4], h[5]); w.w = cvt_pk_bf16(h[6], h[7]);
                *(u32x4*)(rowp) = w; }
    }
};
constexpr int MOE_TAB_OFF = 131072 + 1024;
__device__ __forceinline__ void moe_table(PG8_LAS unsigned char* lds, const unsigned* cntw, int tid) {
    PG8_LAS int* tab = (PG8_LAS int*)(lds + MOE_TAB_OFF);
    __syncthreads();
    if (tid < 2) { const int j = tid; int t = 0;
        for (int e = 0; e < 8; ++e) { const int c = (int)cntw[64 * (j * 8 + e)]; tab[j * 8 + e] = t; tab[16 + j * 8 + e] = c; t += (c + 255) >> 8; }
        tab[32 + j] = t; }
    __syncthreads();
}
__device__ __forceinline__ int moe_T(PG8_LAS unsigned char* lds, int j) { return __builtin_amdgcn_readfirstlane(((const PG8_LAS int*)(lds + MOE_TAB_OFF))[32 + j]); }
__device__ __forceinline__ int moe_expert(const PG8_LAS int* tab, int j, int t) { int e = 0;
#pragma unroll
    for (int k = 1; k < 8; ++k) e += (t >= tab[j * 8 + k]) ? 1 : 0;
    return __builtin_amdgcn_readfirstlane(e); }
__device__ __forceinline__ int moe_hphys(int j, int t) { return (j == 1 && t >= 64) ? t + 8 : t; }
struct EpiMoeDown {
    static constexpr bool PERM = false, AFTER_DRAIN = false;
    float* XF; const int* list; const float* gate; const PG8_LAS int* tab;
    __device__ __forceinline__ void operator()(const f32x4 (&acc)[2][2][4][2], const Unit& u, int wr, int wc, int fr, int fq) const {
        const int e = u.aux, j = u.sel, c_e = tab[16 + j * 8 + e], t_e = tab[j * 8 + e];
        const int s0 = (u.pm - t_e) * BM + wr * 64 + fr, col0 = u.pn * BM + wc * 32 + 4 * fq;
        const int* lp = list + (size_t)(j * 8 + e) * 16384; const float* gp = gate + (size_t)j * 16384;
        int tok[8]; float gt[8];
#pragma unroll
        for (int q = 0; q < 8; ++q) { const int s = s0 + (q >> 2) * HALF + (q & 3) * 16; tok[q] = (s < c_e) ? lp[s] : -1; }
#pragma unroll
        for (int q = 0; q < 8; ++q) gt[q] = (tok[q] >= 0) ? gp[tok[q]] : 0.f;
#pragma unroll
        for (int ai = 0; ai < 2; ++ai) {
            f32x4 o[4][2][2];
#pragma unroll
            for (int m = 0; m < 4; ++m) { const float* rowp = XF + (size_t)(tok[ai * 4 + m] >= 0 ? tok[ai * 4 + m] : 0) * 1024 + col0;
#pragma unroll
                for (int bj = 0; bj < 2; ++bj)
#pragma unroll
                    for (int n = 0; n < 2; ++n) o[m][bj][n] = *(const f32x4*)(rowp + bj * HALF + n * 16); }
#pragma unroll
            for (int m = 0; m < 4; ++m) { if (tok[ai * 4 + m] >= 0) { float* rowp = XF + (size_t)tok[ai * 4 + m] * 1024 + col0; const float g1 = gt[ai * 4 + m];
#pragma unroll
                for (int bj = 0; bj < 2; ++bj)
#pragma unroll
                    for (int n = 0; n < 2; ++n) *(f32x4*)(rowp + bj * HALF + n * 16) = o[m][bj][n] + acc[ai][bj][m][n] * g1; } }
        }
    }
};
template <bool DOWN>
struct MoeSched {
    int mode, n0, a0, j0, n1, a1, j1, G, c; const PG8_LAS int* tab;
    static constexpr int nN = DOWN ? 4 : 28;
    __device__ bool next(int i, Unit& u) const {
        int j, t;
        if (mode != 0) { if (i != 0 || mode == 2) return false; j = j0; t = a0; u.pn = c; }
        else {
            const int V = n0 + n1, nwg = V * nN; const long L = (long)i * G + c; if (L >= nwg) return false;
            int wgid = (int)L; { const int q = nwg / NXCD, r = nwg % NXCD, xcd = wgid % NXCD, off = wgid / NXCD; wgid = (xcd < r ? xcd * (q + 1) : r * (q + 1) + (xcd - r) * q) + off; }
            const int nig = WGM * nN, gid = wgid / nig, fm = gid * WGM, gsz = (V - fm) < WGM ? (V - fm) : WGM;
            const int vm = fm + ((wgid % nig) % gsz); u.pn = (wgid % nig) / gsz;
            if (vm < n0) { j = j0; t = a0 + vm; } else { j = j1; t = a1 + (vm - n0); }
        }
        u.aux = moe_expert(tab, j, t); u.sel = j;
        if (DOWN) { u.pm = t; u.am = moe_hphys(j, t); } else { u.pm = moe_hphys(j, t); u.am = t; }
        return true;
    }
    __device__ __forceinline__ const char* aptr(const Gemm& g, const Unit& u) const { return (const char*)g.A + (DOWN ? (size_t)0 : (size_t)u.sel * (size_t)(36u << 20)) + (size_t)u.am * ((size_t)BM * g.K * 2); }
    __device__ __forceinline__ const char* bptr(const Gemm& g, const Unit& u) const { return (const char*)g.Bt + (size_t)u.aux * ((size_t)g.N * g.K * 2) + (size_t)u.pn * ((size_t)BM * g.K * 2); }
    __device__ __forceinline__ void a_ready(const Unit&) const {}
    __device__ __forceinline__ void done(const Unit&) const {}
};
}
#ifndef PG8_SP2
#define PG8_SP2 true
#endif
#ifndef PG8_ALIGN
#define PG8_ALIGN true
#endif

constexpr size_t MiB = 1u << 20;
constexpr size_t WS_CTL = 0, CTL_BYTES = 256 * 1024;
constexpr size_t WS_ROPE = 256 * 1024;
constexpr size_t WS_WIN = 1 * MiB;
constexpr size_t WS_WO = 16 * MiB;
constexpr size_t WS_WGU = 20 * MiB;
constexpr size_t WS_WD = 31 * MiB;
constexpr size_t WS_XB = 37 * MiB;
constexpr size_t WS_GAB = 69 * MiB;
constexpr size_t WS_LIST = WS_GAB + 512 * 1024;
constexpr size_t WS_GATE = WS_LIST + 1 * MiB;
constexpr size_t WS_CD = WS_GATE + 128 * 1024;
constexpr size_t WS_RWT = WS_CD + 8 * 1024;
constexpr size_t WS_WMGU = 71 * MiB, WS_WMD = 183 * MiB;
constexpr size_t WS_R = 239 * MiB;
constexpr size_t R_HP = 0, R_OB = 112 * MiB, R_U = 144 * MiB, R_WN = 160 * MiB, R_QD = 176 * MiB, R_KDT = 192 * MiB, R_QK = 208 * MiB;
constexpr size_t WS_SSQ = WS_XB + 16 * MiB;
constexpr size_t WS_KV = WS_XB;
constexpr size_t R_MIX = 0, R_H = 64 * MiB;
constexpr size_t R_HM = 0, R_XG = 140 * MiB, XG_PASS = 36 * MiB;
constexpr size_t WS_END = WS_R + 216 * MiB;
constexpr int CW_TMO = 0, CW_BAR = 4096, CW_MOE = 16384, CW_WQ = 24576, CW_SUB = 28672;

constexpr int RING_BYTES = 131072, LDS_BYTES = 147456, LDSCTL_OFF = LDS_BYTES - 512, MISC_OFF = LDSCTL_OFF + 320;

constexpr int PH_PRO = 0;
constexpr int PH_L(int l, int k) { return 1 + 16 * l + k; }
constexpr int K_IN = 0, K_PREP = 1, K_SCAN = 2, K_OUT = 3, K_LN1 = 4, K_GU = 5, K_DN = 6, K_LN2 = 7;
constexpr int K_FIN = 12;
constexpr int K_G0 = 5, K_GU0 = 6, K_DN0 = 7, K_G1 = 8, K_GU1 = 9, K_DN1 = 10, K_LNF = 11;
constexpr int PH_END = 1 + 16 * 2;

struct Args { const float* in[18]; float* out; unsigned char* ws; int ph_lo, ph_hi; };
typedef const __attribute__((address_space(4))) Args* KArgs;
__device__ __forceinline__ KArgs kargs() { KArgs p = (KArgs)__builtin_amdgcn_kernarg_segment_ptr(); asm volatile("" : "+s"(p)); return p; }
__device__ __forceinline__ int tidx() { int t = threadIdx.x; asm volatile("" : "+v"(t)); return t; }

constexpr int TR_SCR = 64 * 65 * 4;
__device__ __forceinline__ void tr_item(const float* W, int N, int k0, int n0, bf16* WT, size_t ldk, int dst_row0, LAS float* scr, int lane, bool blk = false) {
    const int nq = 4 * (lane & 15), n = n0 + nq, kr = lane >> 4;
    f32x4 v[16];
#pragma unroll
    for (int i = 0; i < 16; ++i) v[i] = (n < N) ? *(const f32x4*)(W + (size_t)(k0 + 4 * i + kr) * N + n) : (f32x4){0.f, 0.f, 0.f, 0.f};
#pragma unroll
    for (int i = 0; i < 16; ++i) { LAS float* d = scr + (4 * i + kr) * 65 + nq; d[0] = v[i].x; d[1] = v[i].y; d[2] = v[i].z; d[3] = v[i].w; }
    LDS_WAIT(); asm volatile("" ::: "memory");
    const int c = lane & 7;
#pragma unroll
    for (int j = 0; j < 8; ++j) { const int nn = (lane >> 3) + 8 * j; const LAS float* s = scr + (8 * c) * 65 + nn;
        v4u o; o.x = pk2(s[0 * 65], s[1 * 65]); o.y = pk2(s[2 * 65], s[3 * 65]); o.z = pk2(s[4 * 65], s[5 * 65]); o.w = pk2(s[6 * 65], s[7 * 65]);
        const int dr = dst_row0 + nn;
        bf16* dp = blk ? WT + ((size_t)(dr >> 8) * (ldk >> 6) + (k0 >> 6)) * (256 * 64) + (dr & 255) * 64 + 8 * c : WT + (size_t)dr * ldk + k0 + 8 * c;
        *(v4u*)dp = o; }
    LDS_WAIT(); asm volatile("" ::: "memory");
}

constexpr int PRO_I_IN = 16 * 57, PRO_NIT = 2 * (16 * 57 + 16 * 16) + 2 * (16 * 44) + 44 * 16;
__device__ __forceinline__ void ph_prologue(KArgs a, LAS unsigned char* lds, int wave, int lane, int gw, int NGW, int gtid, int NT, int it_lo, int it_hi, bool misc) {
    unsigned char* ws = a->ws;
    LAS float* scr = (LAS float*)(lds + wave * TR_SCR);
    constexpr int I_IN = 16 * 57, I_O = 16 * 16, I_L = I_IN + I_O, I_G = 16 * 44, I_D = 44 * 16, NIT = 2 * I_L + 2 * I_G + I_D;
    static_assert(NIT == PRO_NIT && I_IN == PRO_I_IN, "prologue item counts");
    for (int it = it_lo + gw; it < it_hi; it += NGW) {
        int r = it;
        if (r < 2 * I_L) { const int l = r / I_L; r -= l * I_L;
            if (r < I_IN) { const int kb = r / 57, nb = r % 57; tr_item(a->in[1] + (size_t)l * 1024 * IN_COLS, IN_COLS, 64 * kb, 64 * nb, (bf16*)(ws + WS_WIN) + (size_t)l * NIN_PAD * 1024, 1024, 64 * nb, scr, lane); }
            else { r -= I_IN; const int kb = r / 16, nb = r % 16; tr_item(a->in[6] + (size_t)l * 1024 * 1024, 1024, 64 * kb, 64 * nb, (bf16*)(ws + WS_WO) + (size_t)l * 1024 * 1024, 1024, 64 * nb, scr, lane); }
            continue; }
        r -= 2 * I_L;
        if (r < 2 * I_G) { const int up = r / I_G; r -= up * I_G; const int kb = r / 44, nb = r % 44, n0 = 64 * nb;
            tr_item(up ? a->in[12] : a->in[11], FF, 64 * kb, n0, (bf16*)(ws + WS_WGU), 1024, 256 * (n0 >> 7) + (n0 & 127) + 128 * up, scr, lane); continue; }
        r -= 2 * I_G;
        { const int kb = r / 16, nb = r % 16; tr_item(a->in[13], 1024, 64 * kb, 64 * nb, (bf16*)(ws + WS_WD), FF, 64 * nb, scr, lane); }
    }
    if (!misc) return;
    for (int i = gtid; i < 2 * 192 * 128; i += NT) { const int l = i / (192 * 128), r = i % (192 * 128);
        ((v4u*)((bf16*)(ws + WS_WIN) + (size_t)l * NIN_PAD * 1024 + (size_t)3648 * 1024))[r] = (v4u){0u, 0u, 0u, 0u}; }
    for (int i = gtid; i < M * D / 8; i += NT) { const f32x4 p = ((const f32x4*)a->in[0])[2 * i], q = ((const f32x4*)a->in[0])[2 * i + 1];
        v4u o; o.x = pk2(p.x, p.y); o.y = pk2(p.z, p.w); o.z = pk2(q.x, q.y); o.w = pk2(q.z, q.w); ((v4u*)(ws + WS_XB))[i] = o; }
    for (int i = gtid; i < 8192; i += NT) ((float*)(ws + WS_RWT))[(i & 7) * 1024 + (i >> 3)] = a->in[14][i];
    for (int i = gtid; i < SEQ * 32; i += NT) { const int pos = i >> 5, k = i & 31;
        const float inv = powf(10000.0f, -(float)(2 * k) / 64.0f); const float ang = (float)pos * inv;
        double rev = (double)ang * 0.15915494309189535; rev -= floor(rev); const float rf = (float)rev;
        float* R = (float*)(ws + WS_ROPE) + (size_t)pos * 64; R[k] = __builtin_amdgcn_cosf(rf); R[32 + k] = __builtin_amdgcn_sinf(rf); }
}

__device__ __forceinline__ void moe_convert(KArgs a, LAS unsigned char* lds, int wave, int lane, int gw, int NGW, int e_lo, int e_hi, int item = -1) {
    unsigned char* ws = a->ws;
    LAS float* scr = (LAS float*)(lds + wave * TR_SCR);
    constexpr int I_G = 16 * 56, I_D = 56 * 16, I_E = 2 * I_G + I_D;
    for (int it = (item >= 0 ? item : e_lo * I_E + gw); it < (item >= 0 ? item + 1 : e_hi * I_E); it += NGW) {
        const int e = it / I_E; int r = it - e * I_E;
        if (r < 2 * I_G) { const int up = r / I_G; r -= up * I_G; const int kb = r / 56, nb = r % 56, n0 = 64 * nb;
            tr_item((up ? a->in[16] : a->in[15]) + (size_t)e * 1024 * FE, FE, 64 * kb, n0, (bf16*)(ws + WS_WMGU) + (size_t)e * 7168 * 1024, 1024, 256 * (n0 >> 7) + (n0 & 127) + 128 * up, scr, lane); }
        else { r -= 2 * I_G; const int kb = r / 16, nb = r % 16; tr_item(a->in[17] + (size_t)e * FE * 1024, 1024, 64 * kb, 64 * nb, (bf16*)(ws + WS_WMD) + (size_t)e * 1024 * FE, FE, 64 * nb, scr, lane, true); }
    }
}

__device__ __forceinline__ void conv_queue(KArgs a, LAS unsigned char* lds, int wave, int lane, int l) {
    unsigned char* ws = a->ws;
    LAS float* scr = (LAS float*)(lds + wave * TR_SCR);
    unsigned* head = (unsigned*)(ws + WS_CTL) + CW_WQ + 64 * l;
    constexpr int I_G = 16 * 56, I_D = 56 * 16, I_E = 2 * I_G + I_D;
    const int e_lo = (l == 0 ? 0 : 3), n_moe = (l == 0 ? 3 : 5) * I_E, n_all = n_moe + (l == 0 ? PRO_NIT - PRO_I_IN : 0);
    for (;;) {
        unsigned it0 = 0; if (lane == 0) it0 = __hip_atomic_fetch_add(head, 8u, RLX_AGENT);
        it0 = __builtin_amdgcn_readfirstlane(it0);
        if ((int)it0 >= n_all) break;
#pragma unroll 1
        for (int k = 0; k < 8; ++k) { const int it = (int)it0 + k; if (it >= n_all) break;
            if (it < n_moe) moe_convert(a, lds, wave, lane, 0, 1 << 30, 0, 0, e_lo * I_E + it);
            else ph_prologue(a, lds, wave, lane, 0, 1 << 30, 0, 0, PRO_I_IN + (it - n_moe), PRO_I_IN + (it - n_moe) + 1, false); }
    }
}

__device__ __forceinline__ void conv_range(KArgs a, LAS unsigned char* lds, int wave, int lane, int l, int lo, int hi, int gw, int NGW) {
    constexpr int I_G = 16 * 56, I_D = 56 * 16, I_E = 2 * I_G + I_D;
    const int n_moe = 4 * I_E;
    for (int it = lo + gw; it < hi; it += NGW) {
        if (it < n_moe) moe_convert(a, lds, wave, lane, 0, 1 << 30, 0, 0, 4 * l * I_E + it);
        else ph_prologue(a, lds, wave, lane, 0, 1 << 30, 0, 0, PRO_I_IN + (it - n_moe), PRO_I_IN + (it - n_moe) + 1, false);
    }
}
constexpr int CONV_N_MOE = 4 * (2 * 16 * 56 + 56 * 16);

template <bool ROUTE>
__device__ __forceinline__ void ln_rows(const float* res, float ares, const bf16* mix, const float* g, const float* bta, float* xf, float oscale, bf16* xb,
                                        const float* router, unsigned* cntw, int* list, float* gate, int lane, int gw, int NGW, LAS unsigned char* lds = nullptr, int tid = 0) {
    LAS unsigned* lcnt = (LAS unsigned*)lds; LAS unsigned* lbase = lcnt + 16; LAS unsigned* rec = lcnt + 32;
    int nrec = 0;
    if (ROUTE) { __syncthreads(); if (tid < 16) lcnt[tid] = 0u; __syncthreads(); }
    f32x4 gv[4], bv[4];
#pragma unroll
    for (int j = 0; j < 4; ++j) { gv[j] = ((const f32x4*)g)[lane + 64 * j]; bv[j] = ((const f32x4*)bta)[lane + 64 * j]; }
    f32x4 rn[4]; v2u mn[4];
#define LN_FETCH(r_) do { const f32x4* rr_ = (const f32x4*)(res + (size_t)(r_) * D) + lane; _Pragma("unroll") for (int j = 0; j < 4; ++j) rn[j] = rr_[64 * j]; \
        if (mix) { const v2u* mr_ = (const v2u*)(mix + (size_t)(r_) * D) + lane; _Pragma("unroll") for (int j = 0; j < 4; ++j) mn[j] = mr_[64 * j]; } } while (0)
#pragma unroll
    for (int j = 0; j < 4; ++j) { rn[j] = (f32x4){0.f, 0.f, 0.f, 0.f}; mn[j] = (v2u){0u, 0u}; }
    if (gw < M) LN_FETCH(gw);
    for (int row = gw; row < M; row += NGW) {
        f32x4 v[4]; float s = 0.f;
#pragma unroll
        for (int j = 0; j < 4; ++j) { v[j] = rn[j] * ares; if (mix) v[j] = v[j] + (f32x4){bflo(mn[j].x), bfhi(mn[j].x), bflo(mn[j].y), bfhi(mn[j].y)}; }
        if (row + NGW < M) LN_FETCH(row + NGW);
#pragma unroll
        for (int j = 0; j < 4; ++j) s += (v[j].x + v[j].y) + (v[j].z + v[j].w);
        const float mean = wave_sum(s) * (1.f / D); float s2 = 0.f;
#pragma unroll
        for (int j = 0; j < 4; ++j) { v[j] = v[j] - mean; s2 += (v[j].x * v[j].x + v[j].y * v[j].y) + (v[j].z * v[j].z + v[j].w * v[j].w); }
        const float rstd = 1.f / sqrtf(wave_sum(s2) * (1.f / D) + LN_EPS);
#pragma unroll
        for (int j = 0; j < 4; ++j) v[j] = v[j] * rstd * gv[j] + bv[j];
        f32x4* xo = (f32x4*)(xf + (size_t)row * D) + lane;
#pragma unroll
        for (int j = 0; j < 4; ++j) xo[64 * j] = v[j] * oscale;
        if (xb) { v2u* bo = (v2u*)(xb + (size_t)row * D) + lane;
#pragma unroll
            for (int j = 0; j < 4; ++j) { v2u o; o.x = pk2(v[j].x, v[j].y); o.y = pk2(v[j].z, v[j].w); bo[64 * j] = o; } }
        if (ROUTE) {
            float lg[8];
#pragma unroll
            for (int e = 0; e < 8; ++e) lg[e] = 0.f;
#pragma unroll
            for (int e = 0; e < 8; ++e)
#pragma unroll
                for (int j = 0; j < 4; ++j) { const f32x4 r4 = ((const f32x4*)(router + e * 1024))[lane + 64 * j]; lg[e] += (v[j].x * r4.x + v[j].y * r4.y) + (v[j].z * r4.z + v[j].w * r4.w); }
#pragma unroll
            for (int e = 0; e < 8; ++e) lg[e] = wave_sum(lg[e]);
            if (lane == 0) {
                int e0 = 0; float v0 = lg[0];
#pragma unroll
                for (int e = 1; e < 8; ++e) if (lg[e] > v0) { v0 = lg[e]; e0 = e; }
                int e1 = -1; float v1 = -3.0e38f;
#pragma unroll
                for (int e = 0; e < 8; ++e) if (e != e0 && lg[e] > v1) { v1 = lg[e]; e1 = e; }
                const float p1 = __expf(v1 - v0), g0 = 1.f / (1.f + p1), g1 = p1 / (1.f + p1);
                const int wv = (int)(tid >> 6), k = nrec++;
                const unsigned l0 = __hip_atomic_fetch_add(lcnt + e0, 1u, __ATOMIC_RELAXED, __HIP_MEMORY_SCOPE_WORKGROUP), l1 = __hip_atomic_fetch_add(lcnt + 8 + e1, 1u, __ATOMIC_RELAXED, __HIP_MEMORY_SCOPE_WORKGROUP);
                rec[(wv * 16 + k) * 4 + 0] = (unsigned)row; rec[(wv * 16 + k) * 4 + 1] = (unsigned)e0 | ((unsigned)e1 << 8); rec[(wv * 16 + k) * 4 + 2] = l0; rec[(wv * 16 + k) * 4 + 3] = l1;
                gate[row] = g0; gate[16384 + row] = g1;
            }
        }
    }
    if (ROUTE) {
        __syncthreads();
        if (tid < 16) { const unsigned c = lcnt[tid]; lbase[tid] = c ? __hip_atomic_fetch_add(cntw + 64 * tid, c, RLX_AGENT) : 0u; }
        __syncthreads();
        if (lane == 0) { const int wv = (int)(tid >> 6);
            for (int k = 0; k < nrec; ++k) { const unsigned row = rec[(wv * 16 + k) * 4], ee = rec[(wv * 16 + k) * 4 + 1], l0 = rec[(wv * 16 + k) * 4 + 2], l1 = rec[(wv * 16 + k) * 4 + 3];
                const unsigned e0 = ee & 255u, e1 = ee >> 8;
                list[(size_t)e0 * 16384 + lbase[e0] + l0] = (int)row; list[(size_t)(8 + e1) * 16384 + lbase[8 + e1] + l1] = (int)row; } }
    }
}

__device__ __forceinline__ void moe_gather(KArgs a, int j, int lane, int gw, int NGW) {
    unsigned char* ws = a->ws; const unsigned* cntw = (const unsigned*)(ws + WS_CTL) + CW_MOE + 64 * (j * 8);
    int pre[8], cum[8]; { int p = 0, t = 0;
#pragma unroll
        for (int e = 0; e < 8; ++e) { const int c = (int)cntw[64 * e]; pre[e] = p; cum[e] = t; p += c; t += (c + 255) >> 8; } }
    const int* list = (const int*)(ws + WS_LIST) + (size_t)j * 8 * 16384;
    for (int r0 = gw; r0 < M; r0 += 8 * NGW) {
        int tok[8], drow[8];
#pragma unroll
        for (int q = 0; q < 8; ++q) { const int r = r0 + q * NGW; tok[q] = -1; drow[q] = 0;
            if (r < M) { int e = 0;
#pragma unroll
                for (int k = 1; k < 8; ++k) e += (r >= pre[k]) ? 1 : 0;
                int pe = 0, ce = 0;
#pragma unroll
                for (int k = 0; k < 8; ++k) if (k == e) { pe = pre[k]; ce = cum[k]; }
                const int s = r - pe; tok[q] = list[(size_t)e * 16384 + s]; drow[q] = ce * 256 + s; } }
        v4u x0[8], x1[8];
#pragma unroll
        for (int q = 0; q < 8; ++q) { const v4u* src = (const v4u*)((const bf16*)(ws + WS_XB) + (size_t)(tok[q] >= 0 ? tok[q] : 0) * 1024); x0[q] = src[lane]; x1[q] = src[lane + 64]; }
#pragma unroll
        for (int q = 0; q < 8; ++q) if (tok[q] >= 0) { v4u* dst = (v4u*)((bf16*)(ws + WS_R + R_XG + (size_t)j * XG_PASS) + (size_t)drow[q] * 1024); dst[lane] = x0[q]; dst[lane + 64] = x1[q]; }
    }
}

__device__ __forceinline__ void gdn_prep_unit(KArgs a, int l, int unit, LAS unsigned char* lds, int tid, int lane, int wave) {
    unsigned char* ws = a->ws;
    const int n = unit & 31, bh = unit >> 5, h = bh & 3, b = bh >> 2;
    const int t0 = b * SEQ + n * 64;
    LAS float* Q = (LAS float*)lds; LAS float* K = Q + 8192; LAS float* V = K + 8192; LAS float* A = V + 8192; LAS float* gc = A + 4096; LAS float* bt = gc + 64;
    const bf16* HP = (const bf16*)(ws + WS_R + R_HP);
    const float* cw = a->in[2] + (size_t)l * 4 * 1536;
    __syncthreads();
    for (int idx = tid; idx < 64 * 384; idx += 512) { const int i = idx / 384, c = idx % 384, which = c >> 7, d = c & 127;
        const int col = COL_GQ + which * 512 + h * 128 + d, cc = which * 512 + h * 128 + d; float acc = 0.f;
#pragma unroll
        for (int j = 0; j < 4; ++j) { const int s = n * 64 + i - 3 + j; if (s >= 0) acc += cw[j * 1536 + cc] * bf2f(HP[(size_t)(b * SEQ + s) * HP_LD + col]); }
        const float y = siluf(acc); LAS float* dst = which == 0 ? Q : (which == 1 ? K : V); dst[i * 128 + d] = y; }
    if (tid < 64) { const float* gab = (const float*)(ws + WS_GAB) + (size_t)(t0 + tid) * 8; const float x = gab[h] + a->in[4][l * 4 + h];
        const float sp = fmaxf(x, 0.f) + log1pf(__expf(-fabsf(x))); gc[tid] = -__expf(a->in[3][l * 4 + h]) * sp; bt[tid] = sigmf(gab[4 + h]); }
    __syncthreads();
#pragma unroll 1
    for (int r = 0; r < 8; ++r) { const int i = wave * 8 + r;
        float q0 = Q[i * 128 + lane], q1 = Q[i * 128 + lane + 64], k0 = K[i * 128 + lane], k1 = K[i * 128 + lane + 64];
        const float sq = wave_sum(q0 * q0 + q1 * q1), sk = wave_sum(k0 * k0 + k1 * k1);
        const float fq = rsqrtf(sq + NORM_EPS) * 0.08838834764831845f, fk = rsqrtf(sk + NORM_EPS);
        Q[i * 128 + lane] = q0 * fq; Q[i * 128 + lane + 64] = q1 * fq; K[i * 128 + lane] = k0 * fk; K[i * 128 + lane + 64] = k1 * fk; }
    if (tid == 0) { float c = 0.f; for (int i = 0; i < 64; ++i) { c += gc[i]; gc[i] = c; } }
    __syncthreads();
    bf16* QKg = (bf16*)(ws + WS_R + R_QK) + (size_t)unit * 4096; bf16* QDg = (bf16*)(ws + WS_R + R_QD) + (size_t)unit * 8192; bf16* KDTg = (bf16*)(ws + WS_R + R_KDT) + (size_t)unit * 8192;
    bf16* WNg = (bf16*)(ws + WS_R + R_WN) + (size_t)unit * 8192; bf16* Ug = (bf16*)(ws + WS_R + R_U) + (size_t)unit * 8192;
    for (int idx = tid; idx < 4096; idx += 512) { const int i = idx >> 6, j = idx & 63; float dqk = 0.f, dkk = 0.f;
        for (int dd = 0; dd < 128; ++dd) { const int d = (dd + j) & 127; const float kj = K[j * 128 + d]; dqk += Q[i * 128 + d] * kj; dkk += K[i * 128 + d] * kj; }
        const float dec = __expf(gc[i] - gc[j]);
        A[i * 64 + j] = (j < i) ? bt[i] * dkk * dec : 0.f;
        QKg[fragoff(i, j, 2)] = (bf16)f2bf((j <= i) ? dqk * dec : 0.f); }
    const float gl = gc[63];
    for (int idx = tid; idx < 8192; idx += 512) { const int i = idx >> 7, d = idx & 127;
        QDg[fragoff(i, d, 4)] = (bf16)f2bf(Q[i * 128 + d] * __expf(gc[i]));
        KDTg[fragoff(d, i, 2)] = (bf16)f2bf(K[i * 128 + d] * __expf(gl - gc[i])); }
    if (tid == 0) ((float*)(ws + WS_CD))[unit] = __expf(gl);
    __syncthreads();
    for (int idx = tid; idx < 8192; idx += 512) { const int i = idx >> 7; const float bi = bt[i]; V[idx] *= bi; Q[idx] = bi * __expf(gc[i]) * K[idx]; }
    __syncthreads();
    if (tid < 256) { LAS float* buf = (tid < 128 ? V : Q) + (tid & 127);
        for (int i = 1; i < 64; ++i) { float acc = buf[i * 128]; for (int m = 0; m < i; ++m) acc -= A[i * 64 + m] * buf[m * 128]; buf[i * 128] = acc; } }
    __syncthreads();
    for (int idx = tid; idx < 8192; idx += 512) { const int i = idx >> 7, d = idx & 127; Ug[uoff(i, d)] = (bf16)f2bf(V[idx]); WNg[fragoff(i, d, 4)] = (bf16)f2bf(-Q[idx]); }
}

__device__ __forceinline__ void gdn_scan_naive(KArgs a, int l, int bh, LAS unsigned char* lds, int tid, int lane, int wave) {
    unsigned char* ws = a->ws;
    LAS float* S = (LAS float*)lds; LAS float* VN = S + 16384; LAS float* O = VN + 8192;
    const int h = bh & 3, b = bh >> 2, e = tid & 127, ig = tid >> 7;
    const bf16* HP = (const bf16*)(ws + WS_R + R_HP); bf16* OB = (bf16*)(ws + WS_R + R_OB);
    const float* nw = a->in[5] + l * 128;
    __syncthreads();
    for (int idx = tid; idx < 16384; idx += 512) S[idx] = 0.f;
    __syncthreads();
#pragma unroll 1
    for (int n = 0; n < 32; ++n) {
        const int unit = bh * 32 + n;
        const bf16* Ug = (const bf16*)(ws + WS_R + R_U) + (size_t)unit * 8192; const bf16* WNg = (const bf16*)(ws + WS_R + R_WN) + (size_t)unit * 8192;
        const bf16* QDg = (const bf16*)(ws + WS_R + R_QD) + (size_t)unit * 8192; const bf16* KDTg = (const bf16*)(ws + WS_R + R_KDT) + (size_t)unit * 8192;
        const bf16* QKg = (const bf16*)(ws + WS_R + R_QK) + (size_t)unit * 4096; const float cd = ((const float*)(ws + WS_CD))[unit];
#pragma unroll 1
        for (int r = 0; r < 16; ++r) { const int i = ig + 4 * r; float acc = bf2f(Ug[uoff(i, e)]);
#pragma unroll 2
            for (int d0 = 0; d0 < 128; d0 += 4) { const v2u w = *(const v2u*)(WNg + fragoff(i, d0, 4));
                acc += bflo(w.x) * S[d0 * 128 + e] + bfhi(w.x) * S[(d0 + 1) * 128 + e] + bflo(w.y) * S[(d0 + 2) * 128 + e] + bfhi(w.y) * S[(d0 + 3) * 128 + e]; }
            VN[i * 128 + e] = acc; }
        __syncthreads();
#pragma unroll 1
        for (int r = 0; r < 16; ++r) { const int i = ig + 4 * r; float acc = 0.f;
#pragma unroll 2
            for (int d0 = 0; d0 < 128; d0 += 4) { const v2u w = *(const v2u*)(QDg + fragoff(i, d0, 4));
                acc += bflo(w.x) * S[d0 * 128 + e] + bfhi(w.x) * S[(d0 + 1) * 128 + e] + bflo(w.y) * S[(d0 + 2) * 128 + e] + bfhi(w.y) * S[(d0 + 3) * 128 + e]; }
#pragma unroll 2
            for (int j0 = 0; j0 < 64; j0 += 4) { const v2u w = *(const v2u*)(QKg + fragoff(i, j0, 2));
                acc += bflo(w.x) * VN[j0 * 128 + e] + bfhi(w.x) * VN[(j0 + 1) * 128 + e] + bflo(w.y) * VN[(j0 + 2) * 128 + e] + bfhi(w.y) * VN[(j0 + 3) * 128 + e]; }
            O[i * 128 + e] = acc; }
        __syncthreads();
#pragma unroll 1
        for (int r = 0; r < 32; ++r) { const int d = ig + 4 * r; float acc = S[d * 128 + e] * cd;
#pragma unroll 2
            for (int i0 = 0; i0 < 64; i0 += 4) { const v2u w = *(const v2u*)(KDTg + fragoff(d, i0, 2));
                acc += bflo(w.x) * VN[i0 * 128 + e] + bfhi(w.x) * VN[(i0 + 1) * 128 + e] + bflo(w.y) * VN[(i0 + 2) * 128 + e] + bfhi(w.y) * VN[(i0 + 3) * 128 + e]; }
            S[d * 128 + e] = acc; }
#pragma unroll 1
        for (int r = 0; r < 8; ++r) { const int i = wave * 8 + r; const float v0 = O[i * 128 + lane], v1 = O[i * 128 + lane + 64];
            const float rs = rsqrtf(wave_sum(v0 * v0 + v1 * v1) * (1.f / 128.f) + NORM_EPS);
            const size_t t = (size_t)b * SEQ + n * 64 + i; const bf16* gp = HP + t * HP_LD + COL_GG + h * 128; bf16* op = OB + t * 1024 + 512 + h * 128;
            op[lane] = (bf16)f2bf(v0 * rs * nw[lane] * siluf(bf2f(gp[lane]))); op[lane + 64] = (bf16)f2bf(v1 * rs * nw[lane + 64] * siluf(bf2f(gp[lane + 64]))); }
        __syncthreads();
    }
}

__device__ __forceinline__ void ret_unit_naive(KArgs a, int unit, LAS unsigned char* lds, int tid, int lane, int wave) {
    unsigned char* ws = a->ws;
    LAS float* Qs = (LAS float*)lds; LAS float* Ks = Qs + 64 * 65; LAS float* Vs = Ks + 64 * 65; LAS float* Sc = Vs + 8192;
    const int qb = unit & 31, bh = unit >> 5, h = bh & 3, b = bh >> 2, e = tid & 127, ig = tid >> 7;
    const bf16* HP = (const bf16*)(ws + WS_R + R_HP); bf16* OB = (bf16*)(ws + WS_R + R_OB); const float* RT = (const float*)(ws + WS_ROPE);
    const float log2g = log2f(1.0f - exp2f(-5.0f - (float)h));
    __syncthreads();
    for (int idx = tid; idx < 4096; idx += 512) { const int i = idx >> 6, d = idx & 63, dd = d & 31, pos = qb * 64 + i; const size_t t = (size_t)b * SEQ + pos;
        const float c = RT[pos * 64 + dd], s = RT[pos * 64 + 32 + dd]; const float x1 = bf2f(HP[t * HP_LD + COL_RQ + h * 64 + dd]), x2 = bf2f(HP[t * HP_LD + COL_RQ + h * 64 + dd + 32]);
        Qs[i * 65 + d] = d < 32 ? x1 * c - x2 * s : x1 * s + x2 * c; }
    float acc[16];
#pragma unroll
    for (int r = 0; r < 16; ++r) acc[r] = 0.f;
#pragma unroll 1
    for (int kb = 0; kb <= qb; ++kb) {
        __syncthreads();
        for (int idx = tid; idx < 4096; idx += 512) { const int i = idx >> 6, d = idx & 63, dd = d & 31, pos = kb * 64 + i; const size_t t = (size_t)b * SEQ + pos;
            const float c = RT[pos * 64 + dd], s = RT[pos * 64 + 32 + dd]; const float x1 = bf2f(HP[t * HP_LD + COL_RK + h * 64 + dd]), x2 = bf2f(HP[t * HP_LD + COL_RK + h * 64 + dd + 32]);
            Ks[i * 65 + d] = 0.125f * (d < 32 ? x1 * c - x2 * s : x1 * s + x2 * c); }
        for (int idx = tid; idx < 8192; idx += 512) { const int i = idx >> 7, d = idx & 127; Vs[idx] = bf2f(HP[((size_t)b * SEQ + kb * 64 + i) * HP_LD + COL_RV + h * 128 + d]); }
        __syncthreads();
        { const int j = tid & 63, ig8 = tid >> 6;
#pragma unroll 1
          for (int r = 0; r < 8; ++r) { const int i = ig8 + 8 * r; float dot = 0.f;
#pragma unroll 8
              for (int d = 0; d < 64; ++d) dot += Qs[i * 65 + d] * Ks[j * 65 + d];
              const int delta = (qb - kb) * 64 + i - j; Sc[i * 65 + j] = delta >= 0 ? dot * exp2f((float)delta * log2g) : 0.f; } }
        __syncthreads();
#pragma unroll 2
        for (int j = 0; j < 64; ++j) { const float vv = Vs[j * 128 + e];
#pragma unroll
            for (int r = 0; r < 16; ++r) acc[r] += Sc[(ig + 4 * r) * 65 + j] * vv; }
    }
    __syncthreads();
#pragma unroll
    for (int r = 0; r < 16; ++r) Vs[(ig + 4 * r) * 128 + e] = acc[r];
    __syncthreads();
#pragma unroll 1
    for (int r = 0; r < 8; ++r) { const int i = wave * 8 + r; const float v0 = Vs[i * 128 + lane], v1 = Vs[i * 128 + lane + 64];
        const float mean = wave_sum(v0 + v1) * (1.f / 128.f), d0 = v0 - mean, d1 = v1 - mean; const float rs = rsqrtf(wave_sum(d0 * d0 + d1 * d1) * (1.f / 128.f) + LN_EPS);
        const size_t t = (size_t)b * SEQ + qb * 64 + i; const bf16* gp = HP + t * HP_LD + COL_RG + h * 128; bf16* op = OB + t * 1024 + h * 128;
        op[lane] = (bf16)f2bf(d0 * rs * siluf(bf2f(gp[lane]))); op[lane + 64] = (bf16)f2bf(d1 * rs * siluf(bf2f(gp[lane + 64]))); }
}

typedef float f32x16 __attribute__((ext_vector_type(16)));
typedef float f32x8 __attribute__((ext_vector_type(8)));
typedef __bf16 bf8v __attribute__((ext_vector_type(8)));
typedef short bf16x8 __attribute__((ext_vector_type(8)));
#define MFMA32(a, b, c) __builtin_amdgcn_mfma_f32_32x32x16_bf16((a), (b), (c), 0, 0, 0)
__device__ __forceinline__ bf16x8 pack8(const f32x16& x, int s) {
    f32x8 v;
#pragma unroll
    for (int j = 0; j < 8; ++j) v[j] = x[8 * s + j];
    return __builtin_bit_cast(bf16x8, __builtin_convertvector(v, bf8v));
}

__device__ __forceinline__ unsigned short bfc(float x) { return __builtin_bit_cast(unsigned short, (__bf16)x); }
__device__ __forceinline__ unsigned bfc2(float lo, float hi) { return (unsigned)bfc(lo) | ((unsigned)bfc(hi) << 16); }

#ifndef PROBE_UNIT
#define PROBE_UNIT 0
#endif
#if defined(PROBE_MULT) && PROBE_MULT > 0
#define STAMPT(id, thr) do { if (blockIdx.x == PROBE_BID && threadIdx.x == (thr)) __hip_atomic_store((unsigned long long*)(a->ws + WS_CTL + 131072) + (id), (unsigned long long)__builtin_amdgcn_s_memrealtime(), RLX_AGENT); } while (0)
#else
#define STAMPT(id, thr) do {} while (0)
#endif
#if defined(GDN_NT) && GDN_NT
#define GDN_LDNT(p) __builtin_nontemporal_load(p)
#else
#define GDN_LDNT(p) (*(p))
#endif
#define GDN_BAR() do { asm volatile("s_waitcnt lgkmcnt(0)" ::: "memory"); __builtin_amdgcn_s_barrier(); asm volatile("" ::: "memory"); } while (0)
__device__ __forceinline__ void gdn_scan_fast(KArgs a, int l, int bh, LAS unsigned char* lds, int tid, int lane, int wave) {
    unsigned char* ws = a->ws;
    constexpr int FB_WN = 0, FB_QD = 16384, FB_KDT = 32768, FB_QK = 49152, FB_U = 57344, FB_BYTES = 73728;
    LAS float* OL = (LAS float*)(lds + FB_BYTES);
    constexpr int OLS = 64 * 132;
    const int h = bh & 3, b = bh >> 2, c = lane & 31, hh = lane >> 5;
    const bf16* HP = (const bf16*)(ws + WS_R + R_HP); bf16* OB = (bf16*)(ws + WS_R + R_OB);
    const float* nw = a->in[5] + l * 128;
    const unsigned char* gWN = (const unsigned char*)(ws + WS_R + R_WN) + (size_t)bh * 32 * 16384; const unsigned char* gQD = (const unsigned char*)(ws + WS_R + R_QD) + (size_t)bh * 32 * 16384;
    const unsigned char* gKDT = (const unsigned char*)(ws + WS_R + R_KDT) + (size_t)bh * 32 * 16384; const unsigned char* gQK = (const unsigned char*)(ws + WS_R + R_QK) + (size_t)bh * 32 * 8192;
    const unsigned char* gU = (const unsigned char*)(ws + WS_R + R_U) + (size_t)bh * 32 * 16384;
    const int et = tid - 256;
#define GDN_FETCH(pf, nn) do { _Pragma("unroll") for (int k = 0; k < 18; ++k) { const unsigned char* src_ = k < 4 ? gWN + (size_t)(nn) * 16384 + k * 4096 : k < 8 ? gQD + (size_t)(nn) * 16384 + (k - 4) * 4096 : \
        k < 12 ? gKDT + (size_t)(nn) * 16384 + (k - 8) * 4096 : k < 14 ? gQK + (size_t)(nn) * 8192 + (k - 12) * 4096 : gU + (size_t)(nn) * 16384 + (k - 14) * 4096; pf[k] = GDN_LDNT((const v4u*)(src_ + et * 16)); } } while (0)
#define GDN_STORE(pf) do { _Pragma("unroll") for (int k = 0; k < 18; ++k) *(LAS v4u*)(lds + k * 4096 + et * 16) = pf[k]; } while (0)
#if defined(PROBE_EXTRA_BYTES) && PROBE_EXTRA_BYTES
#define GDN_EXTRA(nn) do {} while (0)
#else
#define GDN_EXTRA(nn) do {} while (0)
#endif
    __syncthreads();
    if (wave < 4) {
        f32x16 S[4];
#pragma unroll
        for (int t = 0; t < 4; ++t)
#pragma unroll
            for (int i = 0; i < 16; ++i) S[t][i] = 0.f;
        GDN_BAR();
        const int q = wave;
        const LAS bf16x8* WNf = (const LAS bf16x8*)(lds + FB_WN) + lane; const LAS bf16x8* QDf = (const LAS bf16x8*)(lds + FB_QD) + lane;
        const LAS bf16x8* KDTf = (const LAS bf16x8*)(lds + FB_KDT) + lane; const LAS bf16x8* QKf = (const LAS bf16x8*)(lds + FB_QK) + lane;
        const LAS v4u* Uf = (const LAS v4u*)(lds + FB_U) + (q * 2) * 128 + lane;
#pragma unroll 1
        for (int n = 0; n < 32; ++n) {
            if (n == 10) STAMPT(110, 0);
            const float cd = ((const float*)(ws + WS_CD))[bh * 32 + n];
            bf16x8 A0[8], A1[8];
#define GDN_LD_MTS(A, F, g) do { _Pragma("unroll") for (int k = 0; k < 8; ++k) { const int m_ = k & 1, s_ = (k >> 1) & 1, t_ = 2 * (g) + (k >> 2); A[k] = F[((m_ * 4 + t_) * 2 + s_) * 64]; } } while (0)
#define GDN_LD_TMS(A, F, g) do { _Pragma("unroll") for (int k = 0; k < 8; ++k) { const int s_ = k & 1, m_ = (k >> 1) & 1, t_ = 2 * (g) + (k >> 2); A[k] = F[((t_ * 2 + m_) * 2 + s_) * 64]; } } while (0)
            GDN_LD_MTS(A0, WNf, 0); GDN_LD_MTS(A1, WNf, 1);
            f32x16 av[2];
#pragma unroll
            for (int m = 0; m < 2; ++m)
#pragma unroll
                for (int hf = 0; hf < 2; ++hf) { const v4u u4 = Uf[(m * 2 + hf) * 64];
#pragma unroll
                    for (int k = 0; k < 4; ++k) { av[m][8 * hf + 2 * k] = bflo(u4[k]); av[m][8 * hf + 2 * k + 1] = bfhi(u4[k]); } }
            bf16x8 Sb[4][2];
#pragma unroll
            for (int t = 0; t < 4; ++t) { Sb[t][0] = pack8(S[t], 0); Sb[t][1] = pack8(S[t], 1); }
#pragma unroll
            for (int k = 0; k < 8; ++k) { const int m_ = k & 1, s_ = (k >> 1) & 1, t_ = (k >> 2); av[m_] = MFMA32(A0[k], Sb[t_][s_], av[m_]); }
            GDN_LD_MTS(A0, QDf, 0);
#pragma unroll
            for (int k = 0; k < 8; ++k) { const int m_ = k & 1, s_ = (k >> 1) & 1, t_ = 2 + (k >> 2); av[m_] = MFMA32(A1[k], Sb[t_][s_], av[m_]); }
            GDN_LD_MTS(A1, QDf, 1);
            f32x16 ao[2];
#pragma unroll
            for (int m = 0; m < 2; ++m)
#pragma unroll
                for (int i = 0; i < 16; ++i) ao[m][i] = 0.f;
#pragma unroll
            for (int k = 0; k < 8; ++k) { const int m_ = k & 1, s_ = (k >> 1) & 1, t_ = (k >> 2); ao[m_] = MFMA32(A0[k], Sb[t_][s_], ao[m_]); }
#pragma unroll
            for (int k = 0; k < 6; ++k) { const int s_ = k & 1, m_ = k >= 2 ? 1 : 0, mp_ = k >= 4 ? 1 : 0; A0[k] = QKf[((m_ * 2 + mp_) * 2 + s_) * 64]; }
#pragma unroll
            for (int k = 0; k < 8; ++k) { const int m_ = k & 1, s_ = (k >> 1) & 1, t_ = 2 + (k >> 2); ao[m_] = MFMA32(A1[k], Sb[t_][s_], ao[m_]); }
            GDN_LD_TMS(A1, KDTf, 0);
            bf16x8 Vb[2][2];
#pragma unroll
            for (int m = 0; m < 2; ++m) { Vb[m][0] = pack8(av[m], 0); Vb[m][1] = pack8(av[m], 1); }
#pragma unroll
            for (int k = 0; k < 6; ++k) { const int s_ = k & 1, m_ = k >= 2 ? 1 : 0, mp_ = k >= 4 ? 1 : 0; ao[m_] = MFMA32(A0[k], Vb[mp_][s_], ao[m_]); }
            GDN_LD_TMS(A0, KDTf, 1);
            {   LAS float* Ob = OL + (n & 1) * OLS + 32 * wave + c;
#pragma unroll
                for (int m = 0; m < 2; ++m)
#pragma unroll
                    for (int i = 0; i < 16; ++i) Ob[(32 * m + (i & 3) + 8 * (i >> 2) + 4 * hh) * 132] = ao[m][i]; }
#pragma unroll
            for (int t = 0; t < 4; ++t)
#pragma unroll
                for (int i = 0; i < 16; ++i) S[t][i] *= cd;
#pragma unroll
            for (int k = 0; k < 8; ++k) { const int s_ = k & 1, m_ = (k >> 1) & 1, t_ = (k >> 2); S[t_] = MFMA32(A1[k], Vb[m_][s_], S[t_]); }
#pragma unroll
            for (int k = 0; k < 8; ++k) { const int s_ = k & 1, m_ = (k >> 1) & 1, t_ = 2 + (k >> 2); S[t_] = MFMA32(A0[k], Vb[m_][s_], S[t_]); }
#undef GDN_LD_MTS
#undef GDN_LD_TMS
            if (n == 10) STAMPT(111, 0);
            GDN_BAR();
            if (n == 10) STAMPT(112, 0);
            GDN_BAR();
            if (n == 10) STAMPT(113, 0);
        }
        GDN_BAR(); GDN_BAR();
    } else {
        v4u pfA[18], pfB[18];
        LAS float* NWl = OL + 2 * OLS;
        if (et < 128) NWl[et] = nw[et];
        GDN_FETCH(pfB, 0); GDN_FETCH(pfA, 1); GDN_STORE(pfB);
        GDN_BAR();
        const int i = et >> 2, qd = et & 3;
#define GDN_LOADER_ITER(n, PF_FETCH, PF_STORE) do { \
            if ((n) == 10) STAMPT(120, 256); \
            if ((n) + 2 < 32) { GDN_FETCH(PF_FETCH, (n) + 2); GDN_EXTRA((n) + 2); } \
            if ((n) > 0) { \
                const LAS float* Ob = OL + (((n) - 1) & 1) * OLS + i * 132 + 32 * qd; \
                float ss = 0.f; \
                _Pragma("unroll") for (int k = 0; k < 8; ++k) { const f32x4 v_ = *(const LAS f32x4*)(Ob + 4 * k); ss += (v_.x * v_.x + v_.y * v_.y) + (v_.z * v_.z + v_.w * v_.w); } \
                ss += __shfl_xor(ss, 1); ss += __shfl_xor(ss, 2); \
                const float rs = rsqrtf(ss * (1.f / 128.f) + NORM_EPS); \
                bf16* op = OB + ((size_t)b * SEQ + ((n) - 1) * 64 + i) * 1024 + 512 + h * 128 + 32 * qd; \
                _Pragma("unroll") for (int k = 0; k < 4; ++k) { const f32x4 w0 = *(const LAS f32x4*)(NWl + 32 * qd + 8 * k), w1 = *(const LAS f32x4*)(NWl + 32 * qd + 8 * k + 4); const v4u gg = gq[k]; \
                    const f32x4 a0 = *(const LAS f32x4*)(Ob + 8 * k), a1 = *(const LAS f32x4*)(Ob + 8 * k + 4); \
                    v4u o; o.x = bfc2(a0.x * rs * w0.x * siluf(bflo(gg.x)), a0.y * rs * w0.y * siluf(bfhi(gg.x))); o.y = bfc2(a0.z * rs * w0.z * siluf(bflo(gg.y)), a0.w * rs * w0.w * siluf(bfhi(gg.y))); \
                    o.z = bfc2(a1.x * rs * w1.x * siluf(bflo(gg.z)), a1.y * rs * w1.y * siluf(bfhi(gg.z))); o.w = bfc2(a1.z * rs * w1.z * siluf(bflo(gg.w)), a1.w * rs * w1.w * siluf(bfhi(gg.w))); \
                    *(v4u*)(op + 8 * k) = o; } \
            } \
            asm volatile("" ::: "memory"); \
            if ((n) < 32) { const bf16* gp = HP + ((size_t)b * SEQ + (n) * 64 + i) * HP_LD + COL_GG + h * 128 + 32 * qd;     \
                _Pragma("unroll") for (int k = 0; k < 4; ++k) gq[k] = *(const v4u*)(gp + 8 * k); } \
            if ((n) == 10) STAMPT(121, 256); \
            GDN_BAR();            \
            if ((n) == 10) STAMPT(122, 256); \
            if ((n) + 1 < 32) GDN_STORE(PF_STORE); \
            if ((n) == 10) STAMPT(123, 256); \
            GDN_BAR();            \
            if ((n) == 10) STAMPT(124, 256); \
        } while (0)
        v4u gq[4];
#pragma unroll
        for (int k = 0; k < 4; ++k) gq[k] = (v4u){0u, 0u, 0u, 0u};
#pragma unroll
        for (int n = 0; n < 32; n += 2) {
            GDN_LOADER_ITER(n, pfB, pfA);
            GDN_LOADER_ITER(n + 1, pfA, pfB);
        }
        GDN_LOADER_ITER(32, pfB, pfA);
#undef GDN_LOADER_ITER
    }
#undef GDN_FETCH
#undef GDN_STORE
}

__device__ __forceinline__ void gdn_scan_helper(KArgs a, int bh, int tid) {
    unsigned char* ws = a->ws;
    const unsigned char* gWN = (const unsigned char*)(ws + WS_R + R_WN) + (size_t)bh * 32 * 16384; const unsigned char* gQD = (const unsigned char*)(ws + WS_R + R_QD) + (size_t)bh * 32 * 16384;
    const unsigned char* gKDT = (const unsigned char*)(ws + WS_R + R_KDT) + (size_t)bh * 32 * 16384; const unsigned char* gQK = (const unsigned char*)(ws + WS_R + R_QK) + (size_t)bh * 32 * 8192;
    const unsigned char* gU = (const unsigned char*)(ws + WS_R + R_U) + (size_t)bh * 32 * 16384;
#pragma unroll 1
    for (int n = 0; n < 32; ++n) {
        v4u pf[9];
#pragma unroll
        for (int k = 0; k < 9; ++k) { const int kk = 2 * k + (tid >> 8), et = tid & 255;
            const unsigned char* src_ = kk < 4 ? gWN + (size_t)n * 16384 + kk * 4096 : kk < 8 ? gQD + (size_t)n * 16384 + (kk - 4) * 4096 :
                kk < 12 ? gKDT + (size_t)n * 16384 + (kk - 8) * 4096 : kk < 14 ? gQK + (size_t)n * 8192 + (kk - 12) * 4096 : gU + (size_t)n * 16384 + (kk - 14) * 4096;
            pf[k] = *(const v4u*)(src_ + et * 16); }
#pragma unroll
        for (int k = 0; k < 9; ++k) asm volatile("" :: "v"(pf[k]));
    }
}

__device__ __forceinline__ void gdn_scan_v3(KArgs a, int l, int bhq, LAS unsigned char* lds, int tid, int lane, int wave) {
    unsigned char* ws = a->ws;
    constexpr int FB_WN = 0, FB_QD = 16384, FB_KDT = 32768, FB_QK = 49152, FB_U = 57344, IMG = 61440;
    constexpr int OLS = 64 * 36;
    LAS float* OL = (LAS float*)(lds + 2 * IMG);
    const int bh = bhq >> 2, q = bhq & 3, h = bh & 3, b = bh >> 2, c = lane & 31, hh = lane >> 5;
    bf16* OB = (bf16*)(ws + WS_R + R_OB); float* SSQ = (float*)(ws + WS_SSQ);
    const unsigned char* gWN = (const unsigned char*)(ws + WS_R + R_WN) + (size_t)bh * 32 * 16384; const unsigned char* gQD = (const unsigned char*)(ws + WS_R + R_QD) + (size_t)bh * 32 * 16384;
    const unsigned char* gKDT = (const unsigned char*)(ws + WS_R + R_KDT) + (size_t)bh * 32 * 16384; const unsigned char* gQK = (const unsigned char*)(ws + WS_R + R_QK) + (size_t)bh * 32 * 8192;
    const unsigned char* gU = (const unsigned char*)(ws + WS_R + R_U) + (size_t)bh * 32 * 16384 + q * 4096;
    const int et = tid - 256;
#define G3_FETCH(pf, nn) do { _Pragma("unroll") for (int k = 0; k < 15; ++k) { const unsigned char* src_ = k < 4 ? gWN + (size_t)(nn) * 16384 + k * 4096 : k < 8 ? gQD + (size_t)(nn) * 16384 + (k - 4) * 4096 : \
        k < 12 ? gKDT + (size_t)(nn) * 16384 + (k - 8) * 4096 : k < 14 ? gQK + (size_t)(nn) * 8192 + (k - 12) * 4096 : gU + (size_t)(nn) * 16384; pf[k] = *(const v4u*)(src_ + et * 16); } } while (0)
#define G3_STORE(pf, buf) do { _Pragma("unroll") for (int k = 0; k < 15; ++k) *(LAS v4u*)(lds + (buf) * IMG + k * 4096 + et * 16) = pf[k]; } while (0)
    __syncthreads();
    if (wave == 0) {
        f32x16 S[4];
#pragma unroll
        for (int t = 0; t < 4; ++t)
#pragma unroll
            for (int i = 0; i < 16; ++i) S[t][i] = 0.f;
        GDN_BAR();
#pragma unroll 1
        for (int n = 0; n < 32; ++n) {
            const LAS unsigned char* img = lds + (n & 1) * IMG;
            const LAS bf16x8* WNf = (const LAS bf16x8*)(img + FB_WN) + lane; const LAS bf16x8* QDf = (const LAS bf16x8*)(img + FB_QD) + lane;
            const LAS bf16x8* KDTf = (const LAS bf16x8*)(img + FB_KDT) + lane; const LAS bf16x8* QKf = (const LAS bf16x8*)(img + FB_QK) + lane;
            const LAS v4u* Uf = (const LAS v4u*)(img + FB_U) + lane;
            const float cd = ((const float*)(ws + WS_CD))[bh * 32 + n];
            bf16x8 A0[8], A1[8];
#define G3_LD_MTS(A, F, g) do { _Pragma("unroll") for (int k = 0; k < 8; ++k) { const int m_ = k & 1, s_ = (k >> 1) & 1, t_ = 2 * (g) + (k >> 2); A[k] = F[((m_ * 4 + t_) * 2 + s_) * 64]; } } while (0)
#define G3_LD_TMS(A, F, g) do { _Pragma("unroll") for (int k = 0; k < 8; ++k) { const int s_ = k & 1, m_ = (k >> 1) & 1, t_ = 2 * (g) + (k >> 2); A[k] = F[((t_ * 2 + m_) * 2 + s_) * 64]; } } while (0)
            G3_LD_MTS(A0, WNf, 0); G3_LD_MTS(A1, WNf, 1);
            f32x16 av[2];
#pragma unroll
            for (int m = 0; m < 2; ++m)
#pragma unroll
                for (int hf = 0; hf < 2; ++hf) { const v4u u4 = Uf[(m * 2 + hf) * 64];
#pragma unroll
                    for (int k = 0; k < 4; ++k) { av[m][8 * hf + 2 * k] = bflo(u4[k]); av[m][8 * hf + 2 * k + 1] = bfhi(u4[k]); } }
            bf16x8 Sb[4][2];
#pragma unroll
            for (int t = 0; t < 4; ++t) { Sb[t][0] = pack8(S[t], 0); Sb[t][1] = pack8(S[t], 1); }
#pragma unroll
            for (int k = 0; k < 8; ++k) { const int m_ = k & 1, s_ = (k >> 1) & 1, t_ = (k >> 2); av[m_] = MFMA32(A0[k], Sb[t_][s_], av[m_]); }
            G3_LD_MTS(A0, QDf, 0);
#pragma unroll
            for (int k = 0; k < 8; ++k) { const int m_ = k & 1, s_ = (k >> 1) & 1, t_ = 2 + (k >> 2); av[m_] = MFMA32(A1[k], Sb[t_][s_], av[m_]); }
            G3_LD_MTS(A1, QDf, 1);
            f32x16 ao[2];
#pragma unroll
            for (int m = 0; m < 2; ++m)
#pragma unroll
                for (int i = 0; i < 16; ++i) ao[m][i] = 0.f;
#pragma unroll
            for (int k = 0; k < 8; ++k) { const int m_ = k & 1, s_ = (k >> 1) & 1, t_ = (k >> 2); ao[m_] = MFMA32(A0[k], Sb[t_][s_], ao[m_]); }
#pragma unroll
            for (int k = 0; k < 6; ++k) { const int s_ = k & 1, m_ = k >= 2 ? 1 : 0, mp_ = k >= 4 ? 1 : 0; A0[k] = QKf[((m_ * 2 + mp_) * 2 + s_) * 64]; }
#pragma unroll
            for (int k = 0; k < 8; ++k) { const int m_ = k & 1, s_ = (k >> 1) & 1, t_ = 2 + (k >> 2); ao[m_] = MFMA32(A1[k], Sb[t_][s_], ao[m_]); }
            G3_LD_TMS(A1, KDTf, 0);
            bf16x8 Vb[2][2];
#pragma unroll
            for (int m = 0; m < 2; ++m) { Vb[m][0] = pack8(av[m], 0); Vb[m][1] = pack8(av[m], 1); }
#pragma unroll
            for (int k = 0; k < 6; ++k) { const int s_ = k & 1, m_ = k >= 2 ? 1 : 0, mp_ = k >= 4 ? 1 : 0; ao[m_] = MFMA32(A0[k], Vb[mp_][s_], ao[m_]); }
            G3_LD_TMS(A0, KDTf, 1);
            {   LAS float* Ob = OL + (n & 1) * OLS + c;
#pragma unroll
                for (int m = 0; m < 2; ++m)
#pragma unroll
                    for (int i = 0; i < 16; ++i) Ob[(32 * m + (i & 3) + 8 * (i >> 2) + 4 * hh) * 36] = ao[m][i]; }
#pragma unroll
            for (int t = 0; t < 4; ++t)
#pragma unroll
                for (int i = 0; i < 16; ++i) S[t][i] *= cd;
#pragma unroll
            for (int k = 0; k < 8; ++k) { const int s_ = k & 1, m_ = (k >> 1) & 1, t_ = (k >> 2); S[t_] = MFMA32(A1[k], Vb[m_][s_], S[t_]); }
#pragma unroll
            for (int k = 0; k < 8; ++k) { const int s_ = k & 1, m_ = (k >> 1) & 1, t_ = 2 + (k >> 2); S[t_] = MFMA32(A0[k], Vb[m_][s_], S[t_]); }
#undef G3_LD_MTS
#undef G3_LD_TMS
            GDN_BAR();
        }
    } else if (wave >= 4) {
        v4u pfE[15], pfO[15];
        G3_FETCH(pfE, 0); G3_FETCH(pfO, 1); G3_STORE(pfE, 0);
        GDN_BAR();
        const int i = et >> 2, p = et & 3;
#define G3_OUT(m) do { const LAS float* Ob = OL + ((m) & 1) * OLS + i * 36 + 8 * p; const f32x4 o0 = *(const LAS f32x4*)Ob, o1 = *(const LAS f32x4*)(Ob + 4); \
            float ss = (o0.x * o0.x + o0.y * o0.y) + (o0.z * o0.z + o0.w * o0.w) + (o1.x * o1.x + o1.y * o1.y) + (o1.z * o1.z + o1.w * o1.w); \
            ss += __shfl_xor(ss, 1); ss += __shfl_xor(ss, 2); \
            const size_t t_ = (size_t)b * SEQ + (m) * 64 + i; \
            v4u w_; w_.x = bfc2(o0.x, o0.y); w_.y = bfc2(o0.z, o0.w); w_.z = bfc2(o1.x, o1.y); w_.w = bfc2(o1.z, o1.w); \
            *(v4u*)(OB + t_ * 1024 + 512 + h * 128 + 32 * q + 8 * p) = w_; \
            if (p == 0) SSQ[(t_ * 4 + h) * 4 + q] = ss; } while (0)
#define G3_LOADER_ITER(n, PF_FETCH, PF_STORE) do { \
            if ((n) + 2 < 32) G3_FETCH(PF_FETCH, (n) + 2); \
            if ((n) > 0) G3_OUT((n) - 1); \
            if ((n) + 1 < 32) G3_STORE(PF_STORE, ((n) + 1) & 1); \
            GDN_BAR(); \
        } while (0)
#pragma unroll
        for (int n = 0; n < 32; n += 2) {
            G3_LOADER_ITER(n, pfE, pfO);
            G3_LOADER_ITER(n + 1, pfO, pfE);
        }
        G3_OUT(31);
#undef G3_LOADER_ITER
#undef G3_OUT
    } else {
        GDN_BAR();
#pragma unroll 1
        for (int n = 0; n < 32; ++n) GDN_BAR();
    }
#undef G3_FETCH
#undef G3_STORE
}
__device__ __forceinline__ void gdn_finalize(KArgs a, int l, int lane, int gw, int NGW) {
    unsigned char* ws = a->ws;
    const bf16* HP = (const bf16*)(ws + WS_R + R_HP); bf16* OB = (bf16*)(ws + WS_R + R_OB); const float* SSQ = (const float*)(ws + WS_SSQ);
    const int hd = lane >> 4, cb = (lane & 15) * 8;
    const float* nw = a->in[5] + l * 128 + cb;
    const f32x4 w0 = *(const f32x4*)nw, w1 = *(const f32x4*)(nw + 4);
    for (int t0 = gw * 4; t0 < M; t0 += NGW * 4) {
        v4u raw[4], gg[4]; f32x4 sq[4];
#pragma unroll
        for (int k = 0; k < 4; ++k) { const size_t t = (size_t)t0 + k; raw[k] = *(const v4u*)(OB + t * 1024 + 512 + hd * 128 + cb); gg[k] = *(const v4u*)(HP + t * HP_LD + COL_GG + hd * 128 + cb); sq[k] = *(const f32x4*)(SSQ + (t * 4 + hd) * 4); }
#pragma unroll
        for (int k = 0; k < 4; ++k) { const size_t t = (size_t)t0 + k; const float rs = rsqrtf(((sq[k].x + sq[k].y) + (sq[k].z + sq[k].w)) * (1.f / 128.f) + NORM_EPS);
            v4u o; o.x = bfc2(bflo(raw[k].x) * rs * w0.x * siluf(bflo(gg[k].x)), bfhi(raw[k].x) * rs * w0.y * siluf(bfhi(gg[k].x))); o.y = bfc2(bflo(raw[k].y) * rs * w0.z * siluf(bflo(gg[k].y)), bfhi(raw[k].y) * rs * w0.w * siluf(bfhi(gg[k].y)));
            o.z = bfc2(bflo(raw[k].z) * rs * w1.x * siluf(bflo(gg[k].z)), bfhi(raw[k].z) * rs * w1.y * siluf(bfhi(gg[k].z))); o.w = bfc2(bflo(raw[k].w) * rs * w1.z * siluf(bflo(gg[k].w)), bfhi(raw[k].w) * rs * w1.w * siluf(bfhi(gg[k].w)));
            *(v4u*)(OB + t * 1024 + 512 + hd * 128 + cb) = o; }
    }
}

struct RetLds {
    static constexpr int QS = 72, JS = 136;
    static constexpr int P = 0, Q1 = 34816, K1 = 53248, OL = 0, K1T = 71680, VT = 89088, ST = 123904;
};
template <bool WANT_Q, bool WANT_K1, bool WANT_K1T>
__device__ __forceinline__ void ret_stage(const bf16* HP, const float* RT, int b, int h, int n, float lg, LAS unsigned char* lds, int tid) {
    constexpr int QS = RetLds::QS, JS = RetLds::JS;
    LAS bf16* Q1 = (LAS bf16*)(lds + RetLds::Q1); LAS bf16* K1 = (LAS bf16*)(lds + RetLds::K1); LAS bf16* K1T = (LAS bf16*)(lds + RetLds::K1T); LAS bf16* VT = (LAS bf16*)(lds + RetLds::VT);
    const int i = tid >> 2, dd = (tid & 3) * 8, pos = n * 128 + i; const size_t t = (size_t)b * SEQ + pos;
    const bf16* hp = HP + t * HP_LD;
    const f32x4 c0 = *(const f32x4*)(RT + pos * 64 + dd), c1 = *(const f32x4*)(RT + pos * 64 + dd + 4), s0 = *(const f32x4*)(RT + pos * 64 + 32 + dd), s1 = *(const f32x4*)(RT + pos * 64 + 32 + dd + 4);
    const float cs[8] = {c0.x, c0.y, c0.z, c0.w, c1.x, c1.y, c1.z, c1.w}, sn[8] = {s0.x, s0.y, s0.z, s0.w, s1.x, s1.y, s1.z, s1.w};
    const float sq = exp2f((float)i * lg), sk = 0.125f * exp2f(-(float)i * lg);
    v4u xv[4];
#pragma unroll
    for (int p = 0; p < 4; ++p) { const int idx = tid + 512 * p, j = idx >> 4, e0 = (idx & 15) * 8; xv[p] = *(const v4u*)(HP + ((size_t)b * SEQ + n * 128 + j) * HP_LD + COL_RV + h * 128 + e0); }
#pragma unroll
    for (int which = (WANT_Q ? 0 : 1); which < 2; ++which) {
        const bf16* src = hp + (which == 0 ? COL_RQ : COL_RK) + h * 64 + dd;
        const v4u x1 = *(const v4u*)src, x2 = *(const v4u*)(src + 32);
        const float sc = which == 0 ? sq : sk;
        float lo[8], hi[8];
#pragma unroll
        for (int k = 0; k < 4; ++k) { const float a0 = bflo(x1[k]), a1 = bfhi(x1[k]), b0 = bflo(x2[k]), b1 = bfhi(x2[k]);
            lo[2 * k] = (a0 * cs[2 * k] - b0 * sn[2 * k]) * sc; lo[2 * k + 1] = (a1 * cs[2 * k + 1] - b1 * sn[2 * k + 1]) * sc;
            hi[2 * k] = (a0 * sn[2 * k] + b0 * cs[2 * k]) * sc; hi[2 * k + 1] = (a1 * sn[2 * k + 1] + b1 * cs[2 * k + 1]) * sc; }
        v4u wl, wh;
#pragma unroll
        for (int k = 0; k < 4; ++k) { wl[k] = bfc2(lo[2 * k], lo[2 * k + 1]); wh[k] = bfc2(hi[2 * k], hi[2 * k + 1]); }
        if (which == 0 || WANT_K1) { LAS bf16* dst = (which == 0 ? Q1 : K1) + i * QS + dd; *(LAS v4u*)dst = wl; *(LAS v4u*)(dst + 32) = wh; }
        if (which == 1 && WANT_K1T) {
#pragma unroll
            for (int k = 0; k < 4; ++k) { K1T[(dd + 2 * k) * JS + i] = (bf16)(wl[k] & 0xffffu); K1T[(dd + 2 * k + 1) * JS + i] = (bf16)(wl[k] >> 16);
                K1T[(32 + dd + 2 * k) * JS + i] = (bf16)(wh[k] & 0xffffu); K1T[(32 + dd + 2 * k + 1) * JS + i] = (bf16)(wh[k] >> 16); }
        }
    }
#pragma unroll
    for (int p = 0; p < 4; ++p) { const int idx = tid + 512 * p, j = idx >> 4, e0 = (idx & 15) * 8;
#pragma unroll
        for (int k = 0; k < 4; ++k) { VT[(e0 + 2 * k) * JS + j] = (bf16)(xv[p][k] & 0xffffu); VT[(e0 + 2 * k + 1) * JS + j] = (bf16)(xv[p][k] >> 16); } }
}
__device__ __forceinline__ void ret_kv_unit(KArgs a, int unit, LAS unsigned char* lds, int tid, int lane, int wave) {
    unsigned char* ws = a->ws;
    constexpr int JS = RetLds::JS;
    const int n = unit & 15, bh = unit >> 4, h = bh & 3, b = bh >> 2, c = lane & 31, hh = lane >> 5;
    const bf16* HP = (const bf16*)(ws + WS_R + R_HP); const float* RT = (const float*)(ws + WS_ROPE);
    const float gam = 1.0f - exp2f(-5.0f - (float)h), lg = log2f(gam), g127 = exp2f(127.f * lg);
    LAS bf16* K1T = (LAS bf16*)(lds + RetLds::K1T); LAS bf16* VT = (LAS bf16*)(lds + RetLds::VT);
    __syncthreads();
    ret_stage<false, false, true>(HP, RT, b, h, n, lg, lds, tid);
    __syncthreads();
    const int td = wave >> 2, te = wave & 3;
    f32x16 kv;
#pragma unroll
    for (int i = 0; i < 16; ++i) kv[i] = 0.f;
#pragma unroll
    for (int ks = 0; ks < 8; ++ks) kv = MFMA32(*(const LAS bf16x8*)(K1T + (32 * td + c) * JS + 16 * ks + 8 * hh), *(const LAS bf16x8*)(VT + (32 * te + c) * JS + 16 * ks + 8 * hh), kv);
    float* dst = (float*)(ws + WS_KV) + ((size_t)(unit * 8 + wave) * 64 + lane) * 16;
#pragma unroll
    for (int g = 0; g < 4; ++g) *(f32x4*)(dst + 4 * g) = (f32x4){kv[4 * g] * g127, kv[4 * g + 1] * g127, kv[4 * g + 2] * g127, kv[4 * g + 3] * g127};
}
__device__ __forceinline__ void ret_out_unit(KArgs a, int unit, LAS unsigned char* lds, int tid, int lane, int wave) {
    unsigned char* ws = a->ws;
    constexpr int QS = RetLds::QS, JS = RetLds::JS;
    LAS bf16* P = (LAS bf16*)(lds + RetLds::P); LAS bf16* Q1 = (LAS bf16*)(lds + RetLds::Q1); LAS bf16* K1 = (LAS bf16*)(lds + RetLds::K1); LAS float* OL = (LAS float*)(lds + RetLds::OL);
    LAS bf16* VT = (LAS bf16*)(lds + RetLds::VT); LAS bf16* ST = (LAS bf16*)(lds + RetLds::ST);
    const int n = unit & 15, bh = unit >> 4, h = bh & 3, b = bh >> 2, c = lane & 31, hh = lane >> 5;
    const bf16* HP = (const bf16*)(ws + WS_R + R_HP); bf16* OB = (bf16*)(ws + WS_R + R_OB); const float* RT = (const float*)(ws + WS_ROPE);
    const float gam = 1.0f - exp2f(-5.0f - (float)h), lg = log2f(gam), g128 = exp2f(128.f * lg);
    __syncthreads();
    const int ei = tid >> 2, eq = tid & 3; const size_t et = (size_t)b * SEQ + n * 128 + ei;
    v4u gg[4];
    { const bf16* gp = HP + et * HP_LD + COL_RG + h * 128 + 32 * eq;
#pragma unroll
      for (int k = 0; k < 4; ++k) gg[k] = *(const v4u*)(gp + 8 * k); }
    {
        const int td = wave >> 2, te = wave & 3;
        f32x16 S;
#pragma unroll
        for (int i = 0; i < 16; ++i) S[i] = 0.f;
        const float* src = (const float*)(ws + WS_KV) + ((size_t)((bh * 16) * 8 + wave) * 64 + lane) * 16;
#pragma unroll 2
        for (int m = 0; m < n; ++m) { const f32x4* p4 = (const f32x4*)(src + (size_t)m * 8 * 64 * 16);
#pragma unroll
            for (int g = 0; g < 4; ++g) { const f32x4 v = p4[g]; S[4 * g] = S[4 * g] * g128 + v.x; S[4 * g + 1] = S[4 * g + 1] * g128 + v.y; S[4 * g + 2] = S[4 * g + 2] * g128 + v.z; S[4 * g + 3] = S[4 * g + 3] * g128 + v.w; } }
#pragma unroll
        for (int g = 0; g < 4; ++g) { v2u w; w.x = bfc2(S[4 * g], S[4 * g + 1]); w.y = bfc2(S[4 * g + 2], S[4 * g + 3]); *(LAS v2u*)(ST + (32 * te + c) * QS + 32 * td + 8 * g + 4 * hh) = w; }
    }
    ret_stage<true, true, false>(HP, RT, b, h, n, lg, lds, tid);
    __syncthreads();
#pragma unroll 1
    for (int rep = 0; rep < 2; ++rep) { const int idx = wave + 8 * rep;
        if (idx < 10) { const int ti = (idx >= 1) + (idx >= 3) + (idx >= 6), tj = idx - ti * (ti + 1) / 2;
            f32x16 acc;
#pragma unroll
            for (int i = 0; i < 16; ++i) acc[i] = 0.f;
#pragma unroll
            for (int s2 = 0; s2 < 4; ++s2) acc = MFMA32(*(const LAS bf16x8*)(Q1 + (32 * ti + c) * QS + 16 * s2 + 8 * hh), *(const LAS bf16x8*)(K1 + (32 * tj + c) * QS + 16 * s2 + 8 * hh), acc);
#pragma unroll
            for (int i = 0; i < 16; ++i) { const int il = (i & 3) + 8 * (i >> 2) + 4 * hh; float v = acc[i]; if (ti == tj && il < c) v = 0.f; P[(32 * ti + il) * JS + 32 * tj + c] = bfc(v); } } }
    __syncthreads();
    const int ti = wave >> 1, te0 = 2 * (wave & 1);
    f32x16 ao[2];
#pragma unroll
    for (int u = 0; u < 2; ++u)
#pragma unroll
        for (int i = 0; i < 16; ++i) ao[u][i] = 0.f;
#pragma unroll
    for (int s2 = 0; s2 < 4; ++s2) { const bf16x8 A = *(const LAS bf16x8*)(Q1 + (32 * ti + c) * QS + 16 * s2 + 8 * hh);
#pragma unroll
        for (int u = 0; u < 2; ++u) ao[u] = MFMA32(A, *(const LAS bf16x8*)(ST + (32 * (te0 + u) + c) * QS + 16 * s2 + 8 * hh), ao[u]); }
#pragma unroll
    for (int u = 0; u < 2; ++u)
#pragma unroll
        for (int i = 0; i < 16; ++i) ao[u][i] *= gam;
#pragma unroll 1
    for (int tj = 0; tj <= ti; ++tj)
#pragma unroll
        for (int s2 = 0; s2 < 2; ++s2) { const bf16x8 A = *(const LAS bf16x8*)(P + (32 * ti + c) * JS + 32 * tj + 16 * s2 + 8 * hh);
#pragma unroll
            for (int u = 0; u < 2; ++u) ao[u] = MFMA32(A, *(const LAS bf16x8*)(VT + (32 * (te0 + u) + c) * JS + 32 * tj + 16 * s2 + 8 * hh), ao[u]); }
    __syncthreads();
#pragma unroll
    for (int u = 0; u < 2; ++u)
#pragma unroll
        for (int i = 0; i < 16; ++i) OL[(32 * ti + (i & 3) + 8 * (i >> 2) + 4 * hh) * 132 + 32 * (te0 + u) + c] = ao[u][i];
    __syncthreads();
    {
        const LAS float* Ob = OL + ei * 132 + 32 * eq; bf16* op = OB + et * 1024 + h * 128 + 32 * eq;
        f32x4 v[8]; float sm = 0.f;
#pragma unroll
        for (int k = 0; k < 8; ++k) { v[k] = *(const LAS f32x4*)(Ob + 4 * k); sm += (v[k].x + v[k].y) + (v[k].z + v[k].w); }
        sm += __shfl_xor(sm, 1); sm += __shfl_xor(sm, 2);
        const float mean = sm * (1.f / 128.f); float sq = 0.f;
#pragma unroll
        for (int k = 0; k < 8; ++k) { v[k] = v[k] - mean; sq += (v[k].x * v[k].x + v[k].y * v[k].y) + (v[k].z * v[k].z + v[k].w * v[k].w); }
        sq += __shfl_xor(sq, 1); sq += __shfl_xor(sq, 2);
        const float rs = rsqrtf(sq * (1.f / 128.f) + LN_EPS);
#pragma unroll
        for (int k = 0; k < 4; ++k) { const v4u g4 = gg[k]; const f32x4 a0 = v[2 * k], a1 = v[2 * k + 1];
            v4u o; o.x = bfc2(a0.x * rs * siluf(bflo(g4.x)), a0.y * rs * siluf(bfhi(g4.x))); o.y = bfc2(a0.z * rs * siluf(bflo(g4.y)), a0.w * rs * siluf(bfhi(g4.y)));
            o.z = bfc2(a1.x * rs * siluf(bflo(g4.z)), a1.y * rs * siluf(bfhi(g4.z))); o.w = bfc2(a1.z * rs * siluf(bflo(g4.w)), a1.w * rs * siluf(bfhi(g4.w)));
            *(v4u*)(op + 8 * k) = o; }
    }
}

__device__ __forceinline__ float sum16(float v) {
    v += __builtin_bit_cast(float, __builtin_amdgcn_update_dpp(0, __builtin_bit_cast(int, v), 0xB1, 0xF, 0xF, true));
    v += __builtin_bit_cast(float, __builtin_amdgcn_update_dpp(0, __builtin_bit_cast(int, v), 0x4E, 0xF, 0xF, true));
    v += __builtin_bit_cast(float, __builtin_amdgcn_update_dpp(0, __builtin_bit_cast(int, v), 0x141, 0xF, 0xF, true));
    v += __builtin_bit_cast(float, __builtin_amdgcn_update_dpp(0, __builtin_bit_cast(int, v), 0x140, 0xF, 0xF, true));
    return v;
}
__device__ __forceinline__ void gdn_prep_fast(KArgs a, int l, int unit, LAS unsigned char* lds, int tid, int lane, int wave) {
    asm volatile("" : "+v"(tid)); lane = tid & 63; wave = __builtin_amdgcn_readfirstlane(tid >> 6);
    unsigned char* ws = a->ws;
    constexpr int KS = 136;
    LAS bf16* Kb = (LAS bf16*)lds;
    LAS bf16* Qb = (LAS bf16*)(lds + 17408);
    LAS float* A = (LAS float*)(lds + 34816);
    LAS float* V = (LAS float*)(lds + 51200);
    LAS float* KW = (LAS float*)(lds + 83968);
    LAS float* gc = (LAS float*)(lds + 116736);
    LAS float* bt = gc + 64;
    LAS bf16* KDs = (LAS bf16*)(lds + 117248);
    LAS bf16* XT = (LAS bf16*)lds;
    LAS bf16* A10b = (LAS bf16*)(lds + 135680);
    const int n = unit & 31, bh = unit >> 5, h = bh & 3, b = bh >> 2, t0 = b * SEQ + n * 64, c = lane & 31, hh = lane >> 5;
    const bf16* HP = (const bf16*)(ws + WS_R + R_HP);
    bf16* QKg = (bf16*)(ws + WS_R + R_QK) + (size_t)unit * 4096; bf16* QDg = (bf16*)(ws + WS_R + R_QD) + (size_t)unit * 8192; bf16* KDTg = (bf16*)(ws + WS_R + R_KDT) + (size_t)unit * 8192;
    bf16* WNg = (bf16*)(ws + WS_R + R_WN) + (size_t)unit * 8192; bf16* Ug = (bf16*)(ws + WS_R + R_U) + (size_t)unit * 8192;
    __syncthreads(); if (unit == PROBE_UNIT) STAMPT(130, 0);
    if (wave == 0) {
        const float* gab = (const float*)(ws + WS_GAB) + (size_t)(t0 + lane) * 8; const float x = gab[h] + a->in[4][l * 4 + h];
        const float sp = fmaxf(x, 0.f) + log1pf(__expf(-fabsf(x))); float g = -__expf(a->in[3][l * 4 + h]) * sp;
#pragma unroll
        for (int o = 1; o < 64; o <<= 1) { const float up = __shfl_up(g, o); if (lane >= o) g += up; }
        gc[lane] = g; bt[lane] = sigmf(gab[4 + h]);
        if (lane == 63) ((float*)(ws + WS_CD))[unit] = __expf(g);
    }
    __syncthreads(); if (unit == PROBE_UNIT) STAMPT(131, 0);
#ifndef PREP_NO_CONV
    if (wave < 6) {
        const int which = wave >> 1, tp = tid & 127, rb = tp >> 4, dd = (tp & 15) * 8, col = COL_GQ + which * 512 + h * 128 + dd, cc = which * 512 + h * 128 + dd;
        const float* cw = a->in[2] + (size_t)l * 4 * 1536 + cc;
        float w[4][8];
#pragma unroll
        for (int j = 0; j < 4; ++j) { const f32x4 w0 = *(const f32x4*)(cw + j * 1536), w1 = *(const f32x4*)(cw + j * 1536 + 4); w[j][0] = w0.x; w[j][1] = w0.y; w[j][2] = w0.z; w[j][3] = w0.w; w[j][4] = w1.x; w[j][5] = w1.y; w[j][6] = w1.z; w[j][7] = w1.w; }
        const int sbase = n * 64 + 8 * rb - 3;
        const bf16* hpc = HP + (size_t)(b * SEQ) * HP_LD + col;
        v4u raw[11];
#pragma unroll
        for (int r = 0; r < 11; ++r) { raw[r] = (v4u){0u, 0u, 0u, 0u}; if (sbase + r >= 0) raw[r] = *(const v4u*)(hpc + (size_t)(sbase + r) * HP_LD); }
        const float gl = gc[63];
#pragma unroll
        for (int r = 0; r < 8; ++r) { const int i = 8 * rb + r; float y[8]; float ss = 0.f;
#pragma unroll
            for (int k4 = 0; k4 < 4; ++k4) {
                unsigned d0 = raw[r][k4], d1 = raw[r + 1][k4], d2 = raw[r + 2][k4], d3 = raw[r + 3][k4];
                asm volatile("" : "+v"(d0), "+v"(d1), "+v"(d2), "+v"(d3));
                const float a0 = w[0][2 * k4] * bflo(d0) + w[1][2 * k4] * bflo(d1) + w[2][2 * k4] * bflo(d2) + w[3][2 * k4] * bflo(d3);
                const float a1 = w[0][2 * k4 + 1] * bfhi(d0) + w[1][2 * k4 + 1] * bfhi(d1) + w[2][2 * k4 + 1] * bfhi(d2) + w[3][2 * k4 + 1] * bfhi(d3);
                y[2 * k4] = siluf(a0); y[2 * k4 + 1] = siluf(a1); ss += y[2 * k4] * y[2 * k4] + y[2 * k4 + 1] * y[2 * k4 + 1]; }
            ss = sum16(ss);
            const float gi = gc[i], bi = bt[i];
            if (which == 0) { const float f = rsqrtf(ss + NORM_EPS) * 0.08838834764831845f, eg = __expf(gi);
                v4u p, pd;
#pragma unroll
                for (int k = 0; k < 4; ++k) { p[k] = bfc2(y[2 * k] * f, y[2 * k + 1] * f); pd[k] = bfc2(y[2 * k] * f * eg, y[2 * k + 1] * f * eg); }
                *(LAS v4u*)(Qb + i * KS + dd) = p;
                bf16* qd = QDg + (((i >> 5) * 4 + (dd >> 5)) * 2 + ((dd >> 4) & 1)) * 512 + (i & 31) * 8 + ((dd >> 3) & 1) * 4;
                *(v2u*)qd = (v2u){pd[0], pd[1]}; *(v2u*)(qd + 256) = (v2u){pd[2], pd[3]};
            } else if (which == 1) { const float f = rsqrtf(ss + NORM_EPS), fw = f * bi * __expf(gi), fd = f * __expf(gl - gi);
                v4u p;
#pragma unroll
                for (int k = 0; k < 4; ++k) p[k] = bfc2(y[2 * k] * f, y[2 * k + 1] * f);
                *(LAS v4u*)(Kb + i * KS + dd) = p;
#pragma unroll
                for (int k = 0; k < 8; ++k) { KW[i * 128 + dd + k] = y[k] * fw; KDs[(dd + k) * 72 + i] = bfc(y[k] * fd); }
            } else {
#pragma unroll
                for (int k = 0; k < 8; ++k) V[i * 128 + dd + k] = y[k] * bi;
            }
        }
    }
#endif
    __syncthreads(); if (unit == PROBE_UNIT) STAMPT(132, 0);
    {
        const int ti = (wave >> 1) & 1, tj = wave & 1;
        if (wave < 4) {
            if (ti <= tj) {
                f32x16 acc;
#pragma unroll
                for (int i = 0; i < 16; ++i) acc[i] = 0.f;
#pragma unroll
                for (int s = 0; s < 8; ++s) acc = MFMA32(*(const LAS bf16x8*)(Kb + (32 * ti + c) * KS + 16 * s + 8 * hh), *(const LAS bf16x8*)(Kb + (32 * tj + c) * KS + 16 * s + 8 * hh), acc);
                const int i = 32 * tj + c; const float gi = gc[i], bi = bt[i];
#pragma unroll
                for (int r = 0; r < 16; ++r) { const int j = 32 * ti + (r & 3) + 8 * (r >> 2) + 4 * hh; const float av = (j < i) ? bi * acc[r] * __expf(gi - gc[j]) : 0.f; A[j * 64 + i] = av;
                    if (ti == 0 && tj == 1) A10b[c * 40 + j] = bfc(av); }
            } else {
#pragma unroll
                for (int r = 0; r < 16; ++r) { const int j = 32 * ti + (r & 3) + 8 * (r >> 2) + 4 * hh; A[j * 64 + 32 * tj + c] = 0.f; }
            }
        } else {
            const int kt = ti, qt = tj;
            if (kt <= qt) {
                f32x16 acc;
#pragma unroll
                for (int i = 0; i < 16; ++i) acc[i] = 0.f;
#pragma unroll
                for (int s = 0; s < 8; ++s) acc = MFMA32(*(const LAS bf16x8*)(Kb + (32 * kt + c) * KS + 16 * s + 8 * hh), *(const LAS bf16x8*)(Qb + (32 * qt + c) * KS + 16 * s + 8 * hh), acc);
                const int i = 32 * qt + c; const float gi = gc[i];
#pragma unroll
                for (int r = 0; r < 16; ++r) { const int j = 32 * kt + (r & 3) + 8 * (r >> 2) + 4 * hh; acc[r] = (j <= i) ? acc[r] * __expf(gi - gc[j]) : 0.f; }
                bf16x8* qf = (bf16x8*)QKg + lane;
                qf[((qt * 2 + kt) * 2 + 0) * 64] = pack8(acc, 0); qf[((qt * 2 + kt) * 2 + 1) * 64] = pack8(acc, 1);
            }
        }
    }
    __syncthreads(); if (unit == PROBE_UNIT) STAMPT(133, 0);
#ifndef PREP_NO_SOLVE
#define PREP_SOLVE32(B0) do { \
        _Pragma("unroll") for (int i = 0; i < 32; ++i) x[i] = rhs[((B0) + i) * 128]; \
        _Pragma("unroll") for (int m = 0; m < 31; ++m) { const float xm = x[m]; \
            _Pragma("unroll") for (int g = (m + 1) / 4; g < 8; ++g) { const f32x4 a4 = *(const LAS f32x4*)(A + ((B0) + m) * 64 + (B0) + 4 * g); \
                if (4 * g > m) x[4 * g] -= a4.x * xm; if (4 * g + 1 > m) x[4 * g + 1] -= a4.y * xm; if (4 * g + 2 > m) x[4 * g + 2] -= a4.z * xm; if (4 * g + 3 > m) x[4 * g + 3] -= a4.w * xm; } } \
        if (tl < 128) { _Pragma("unroll") for (int hx = 0; hx < 2; ++hx) _Pragma("unroll") for (int hf = 0; hf < 2; ++hf) { const int i0 = 16 * hf + 4 * hx; \
                v4u w_; w_.x = bfc2(x[i0], x[i0 + 1]); w_.y = bfc2(x[i0 + 2], x[i0 + 3]); w_.z = bfc2(x[i0 + 8], x[i0 + 9]); w_.w = bfc2(x[i0 + 10], x[i0 + 11]); *(v4u*)(Ug + uoff((B0) + i0, col)) = w_; } } \
        else { _Pragma("unroll") for (int i = 0; i < 32; ++i) Qb[((B0) + i) * KS + col] = bfc(-x[i]); } } while (0)
    int tl = tid; asm volatile("" : "+v"(tl));
    const int c2 = tl & 31, hh2 = (tl >> 5) & 1;
    if (wave < 4) {
        const int col = tl & 127; LAS float* rhs = (tl < 128 ? V : KW) + col;
        float x[32];
        PREP_SOLVE32(0);
        v4u p[4];
#pragma unroll
        for (int k = 0; k < 4; ++k) { p[k].x = bfc2(x[8 * k], x[8 * k + 1]); p[k].y = bfc2(x[8 * k + 2], x[8 * k + 3]); p[k].z = bfc2(x[8 * k + 4], x[8 * k + 5]); p[k].w = bfc2(x[8 * k + 6], x[8 * k + 7]); }
#pragma unroll
        for (int k = 0; k < 4; ++k) *(LAS v4u*)(XT + tl * 32 + 8 * k) = p[k];
    }
    __syncthreads();
    {
        f32x16 acc;
#pragma unroll
        for (int i = 0; i < 16; ++i) acc[i] = 0.f;
#pragma unroll
        for (int s2 = 0; s2 < 2; ++s2) acc = MFMA32(*(const LAS bf16x8*)(A10b + c2 * 40 + 16 * s2 + 8 * hh2), *(const LAS bf16x8*)(XT + (32 * wave + c2) * 32 + 16 * s2 + 8 * hh2), acc);
        LAS float* R1 = (wave < 4 ? V : KW) + 32 * (wave & 3) + c2;
#pragma unroll
        for (int r = 0; r < 16; ++r) { const int i = 32 + (r & 3) + 8 * (r >> 2) + 4 * hh2; R1[i * 128] -= acc[r]; }
    }
    __syncthreads();
    if (wave < 4) {
        const int col = tl & 127; LAS float* rhs = (tl < 128 ? V : KW) + col;
        float x[32];
        PREP_SOLVE32(32);
    }
#undef PREP_SOLVE32
#endif
    __syncthreads(); if (unit == PROBE_UNIT) STAMPT(134, 0);
#pragma unroll
    for (int p = 0; p < 4; ++p) { const int idx = tid + 512 * p, i = idx >> 5, d = (idx & 31) * 4;
        *(v2u*)(WNg + fragoff(i, d, 4)) = *(const LAS v2u*)(Qb + i * KS + d); }
#pragma unroll
    for (int p = 0; p < 4; ++p) { const int idx = tid + 512 * p, d = idx >> 4, i = (idx & 15) * 4;
        *(v2u*)(KDTg + fragoff(d, i, 2)) = *(const LAS v2u*)(KDs + d * 72 + i); }
    if (unit == PROBE_UNIT) STAMPT(135, 0);
}
#define XB_TMO      128
#define XB_XCNT(j)  (256  + 64 * (j))
#define XB_XSUB(j)  (1280 + 64 * (j))
#define XB_XGEN(j)  (2304 + 64 * (j))
#define XB_TOP      3328
#define XB_TOPGEN   3392
#define XCD_BAR_WORDS 3456
#define XB_SPIN_CAP (1u << 18)

__device__ __forceinline__ unsigned xb_ld(unsigned* p)              { return __hip_atomic_load(p, __ATOMIC_RELAXED, __HIP_MEMORY_SCOPE_AGENT); }
__device__ __forceinline__ unsigned xb_add(unsigned* p, unsigned v) { return __hip_atomic_fetch_add(p, v, __ATOMIC_RELAXED, __HIP_MEMORY_SCOPE_AGENT); }
__device__ __forceinline__ unsigned xb_xcc_id() { return (unsigned)__builtin_amdgcn_s_getreg((3 << 11) | 20) & 0xFu; }
#define XB_SPIN(cond, bar) do { unsigned _sp = 0; while (cond) { __builtin_amdgcn_s_sleep(1); \
    if ((++_sp & 255u) == 0u) { if (xb_ld(&(bar)[XB_TMO])) break; if (_sp > XB_SPIN_CAP) { atomicAdd(&(bar)[XB_TMO], 1u); break; } } } } while (0)

struct XcdBarrier {
    unsigned* bar; unsigned x;
    volatile LAS unsigned* st;
};

__device__ __forceinline__ XcdBarrier xcd_barrier_post(unsigned* bar, volatile LAS unsigned* st) {
    XcdBarrier b; b.bar = bar; b.x = xb_xcc_id(); b.st = st;
    if (threadIdx.x == 0) (void)xb_add(&bar[XB_XCNT(b.x)], 1u);
    return b;
}
__device__ __forceinline__ void xcd_barrier_complete(unsigned* bar, unsigned x, unsigned& nloc, unsigned& nx) {
    const unsigned G = gridDim.x * gridDim.y * gridDim.z;
    unsigned sum, cnt, mine, sp = 0u;
    for (;;) {
        sum = 0u; cnt = 0u; mine = 0u;
#pragma unroll
        for (unsigned j = 0; j < 16; ++j) { const unsigned c = xb_ld(&bar[XB_XCNT(j)]); sum += c; cnt += (c > 0u) ? 1u : 0u; mine = (j == x) ? c : mine; }
        if (sum == G) break;
        __builtin_amdgcn_s_sleep(1);
        if ((++sp & 255u) == 0u) { if (xb_ld(&bar[XB_TMO])) break; if (sp > XB_SPIN_CAP) { atomicAdd(&bar[XB_TMO], 1u); break; } }
    }
    nloc = mine > 0u ? mine : 1u; nx = cnt > 0u ? cnt : 1u;
}

__device__ __forceinline__ void xcd_barrier(const XcdBarrier& b) {
    asm volatile("s_waitcnt vmcnt(0)" ::: "memory");
    __syncthreads();
    if (threadIdx.x == 0) {
        unsigned* bar = b.bar;
        __builtin_amdgcn_s_waitcnt(0);
        unsigned nloc = b.st[0], nx = b.st[1];
        if (nloc == 0u) { xcd_barrier_complete(bar, b.x, nloc, nx); b.st[0] = nloc; b.st[1] = nx; }
        const unsigned old = xb_add(&bar[XB_XSUB(b.x)], 1u);
        const unsigned gen = old / nloc;
        if (old + 1u == (gen + 1u) * nloc) {
            __builtin_amdgcn_fence(__ATOMIC_RELEASE, "agent");
            asm volatile("s_waitcnt vmcnt(0)" ::: "memory");
            const unsigned og = xb_add(&bar[XB_TOP], 1u);
            const unsigned tg = og / nx;
            if (og + 1u == (tg + 1u) * nx) xb_add(&bar[XB_TOPGEN], 1u);
            else XB_SPIN(xb_ld(&bar[XB_TOPGEN]) == tg, bar);
            __builtin_amdgcn_fence(__ATOMIC_ACQUIRE, "agent");
            xb_add(&bar[XB_XGEN(b.x)], 1u);
            asm volatile("s_waitcnt vmcnt(0)" ::: "memory");
        } else {
            XB_SPIN(xb_ld(&bar[XB_XGEN(b.x)]) == gen, bar);
            __builtin_amdgcn_fence(__ATOMIC_ACQUIRE, "agent");
            asm volatile("s_waitcnt vmcnt(0)" ::: "memory");
        }
    }
    __syncthreads();
}
#ifndef REP_PRO
#define REP_PRO 1
#endif
#ifndef REP_IN
#define REP_IN 1
#endif
#ifndef REP_PREP
#define REP_PREP 1
#endif
#ifndef REP_SCAN
#define REP_SCAN 1
#endif
#ifndef REP_OUT
#define REP_OUT 1
#endif
#ifndef REP_GU
#define REP_GU 1
#endif
#ifndef REP_DN
#define REP_DN 1
#endif
#ifndef REP_MGU
#define REP_MGU 1
#endif
#ifndef REP_GDN
#define REP_GDN 1
#endif
#ifndef REP_RET
#define REP_RET 1
#endif
#ifndef KV_IN_SCAN
#define KV_IN_SCAN 0
#endif
#ifndef GDN_HELPERS
#define GDN_HELPERS 0
#endif
#ifndef GDN_SPLIT
#define GDN_SPLIT 0
#endif
#ifndef FAST_SCAN
#define FAST_SCAN 1
#endif
#ifndef FAST_RET
#define FAST_RET 1
#endif
#ifndef FAST_PREP
#define FAST_PREP 1
#endif
#ifndef EN_PRO
#define EN_PRO 1
#endif
#ifndef EN_IN
#define EN_IN 1
#endif
#ifndef EN_PREP
#define EN_PREP 1
#endif
#ifndef EN_SCAN
#define EN_SCAN 1
#endif
#ifndef EN_OUT
#define EN_OUT 1
#endif
#ifndef EN_LN1
#define EN_LN1 1
#endif
#ifndef EN_FFN0
#define EN_FFN0 1
#endif
#ifndef EN_MOE
#define EN_MOE 1
#endif

#ifndef PROBE_MULT
#define PROBE_MULT 0
#endif
#ifndef PROBE_BID
#define PROBE_BID 0
#endif
#ifndef PROBE_A
#define PROBE_A 0
#endif
#ifndef PROBE_B
#define PROBE_B 0
#endif
#if PROBE_MULT > 0
#define STAMP(id) do { if (blockIdx.x == PROBE_BID && threadIdx.x == 0) __hip_atomic_store((unsigned long long*)(kargs()->ws + WS_CTL + 131072) + (id), (unsigned long long)__builtin_amdgcn_s_memrealtime(), RLX_AGENT); } while (0)
#else
#define STAMP(id) do {} while (0)
#endif
__global__ void __launch_bounds__(NWAVES * 64, 2) fwd(Args a_unused) {
    extern __shared__ __attribute__((aligned(16))) unsigned char lds_raw[];
    LAS unsigned char* lds = (LAS unsigned char*)lds_raw;
    int stamp_no_ = 1; (void)stamp_no_;
    { const int tid0 = threadIdx.x; for (int u = tid0; u < (LDS_BYTES - LDSCTL_OFF) / 4; u += NWAVES * 64) ((LAS unsigned*)(lds + LDSCTL_OFF))[u] = 0u; }
    __syncthreads();
#if ONE_LAUNCH
    XcdBarrier bar = xcd_barrier_post((unsigned*)(kargs()->ws + WS_CTL) + CW_BAR, (volatile LAS unsigned*)(lds + MISC_OFF) + 8);
#define SEAM() do { STAMP(stamp_no_); ++stamp_no_; xcd_barrier(bar); STAMP(stamp_no_); ++stamp_no_; } while (0)
#else
#define SEAM() do {} while (0)
#endif
#define IN(k) (kargs()->ph_lo <= (k) && (k) < kargs()->ph_hi)
#define BOTH(k) (IN(k) && ((k) + 1) < kargs()->ph_hi)
#define PH_LOCALS KArgs a = kargs(); unsigned char* ws = a->ws; int G = gridDim.x, bid = blockIdx.x; asm volatile("" : "+s"(G), "+s"(bid)); const int tid = tidx(), lane = tid & 63, wave = __builtin_amdgcn_readfirstlane(tid >> 6), gw = bid * NWAVES + wave, NGW = G * NWAVES; (void)ws; (void)lane; (void)gw; (void)NGW;

    if (EN_PRO && IN(PH_PRO)) { _Pragma("unroll 1") for (int rep_ = 0; rep_ < REP_PRO; ++rep_) { if (rep_) SEAM(); PH_LOCALS; ph_prologue(a, lds, wave, lane, gw, NGW, bid * (NWAVES * 64) + tid, G * NWAVES * 64, 0, PRO_I_IN, true); } if (BOTH(PH_PRO)) SEAM(); }

#pragma unroll 1
    for (int l = 0; l < 2; ++l) {
        if (EN_IN && IN(PH_L(l, K_IN))) {
            _Pragma("unroll 1") for (int rep_ = 0; rep_ < REP_IN; ++rep_) { if (rep_) SEAM(); PH_LOCALS;
            pg8::Gemm g{(const pg8::bf16_t*)(ws + WS_XB), (const pg8::bf16_t*)(ws + WS_WIN) + (size_t)l * NIN_PAD * 1024, M, NIN_PAD, 1024}; pg8::StaticOrder S; S.init(M, NIN_PAD, G, bid);
            pg8::EpiHproj E{(pg8::bf16_t*)(ws + WS_R + R_HP), (float*)(ws + WS_GAB)};
            pg8::gemm_phase<pg8::EpiHproj, pg8::StaticOrder, PG8_ALIGN, PG8_SP2>(lds, g, S, E); }
            if (BOTH(PH_L(l, K_IN))) SEAM();
        }
        if (EN_PREP && IN(PH_L(l, K_PREP))) {
            _Pragma("unroll 1") for (int rep_ = 0; rep_ < REP_PREP; ++rep_) { if (rep_) SEAM(); PH_LOCALS; for (int u = bid; u < 1024; u += G) { if (FAST_PREP) gdn_prep_fast(a, l, u, lds, tid, lane, wave); else gdn_prep_unit(a, l, u, lds, tid, lane, wave); }
              STAMP(136); if (FAST_RET && !KV_IN_SCAN) for (int u = bid; u < 512; u += G) ret_kv_unit(a, u, lds, tid, lane, wave); STAMP(137); }
            if (BOTH(PH_L(l, K_PREP))) SEAM();
        }
        if (EN_SCAN && IN(PH_L(l, K_SCAN))) {
            { PH_LOCALS;
#if GDN_SPLIT
            const int n_items = CONV_N_MOE + (l == 0 ? PRO_NIT - PRO_I_IN : 0), n_ret_hi = (l == 0 ? 128 : 256);
            if (bid < 128) { const int t1 = tidx(), w1 = __builtin_amdgcn_readfirstlane(t1 >> 6); const int bh = (bid & 7) + 8 * (bid >> 5), q = (bid >> 3) & 3;
                             gdn_scan_v3(a, l, bh * 4 + q, lds, t1, t1 & 63, w1); STAMP(100 + 10 * l);
                             for (int u = n_ret_hi + bid; u < 512; u += 128) ret_out_unit(a, u, lds, t1, t1 & 63, w1); }
            else {
                { const int t2 = tidx(), w2 = __builtin_amdgcn_readfirstlane(t2 >> 6); conv_range(kargs(), lds, w2, t2 & 63, l, 0, n_items, (bid - 128) * NWAVES + w2, (G - 128) * NWAVES); STAMP(102 + 10 * l); }
                { const int t1 = tidx(), w1 = __builtin_amdgcn_readfirstlane(t1 >> 6);
                  for (int u = bid - 128; u < n_ret_hi; u += G - 128) ret_out_unit(a, u, lds, t1, t1 & 63, w1); }
                STAMP(101 + 10 * l);
            }
#else
            if (bid < 32) { const int t1 = tidx(), w1 = __builtin_amdgcn_readfirstlane(t1 >> 6); gdn_scan_fast(a, l, bid, lds, t1, t1 & 63, w1); STAMP(100 + 10 * l); }
            else {
                if (GDN_HELPERS && bid < 32 + 32 * GDN_HELPERS) gdn_scan_helper(a, bid & 31, tidx());
                if (KV_IN_SCAN) {
                    { const int t0 = tidx(), w0 = __builtin_amdgcn_readfirstlane(t0 >> 6);
                      for (int u = bid - 32; u < 512; u += G - 32) ret_kv_unit(a, u, lds, t0, t0 & 63, w0); }
                    VM_WAIT(); __syncthreads();
                    if (tidx() == 0) { unsigned* sub = (unsigned*)(kargs()->ws + WS_CTL) + CW_SUB + 64 * (1 + l);
                        __builtin_amdgcn_fence(__ATOMIC_RELEASE, "agent"); VM_WAIT();
                        __hip_atomic_fetch_add(sub, 1u, RLX_AGENT);
                        unsigned sp = 0; while (__hip_atomic_load(sub, RLX_AGENT) < (unsigned)(G - 32) && ++sp < (1u << 22)) __builtin_amdgcn_s_sleep(2);
                        __builtin_amdgcn_fence(__ATOMIC_ACQUIRE, "agent"); VM_WAIT(); }
                    __syncthreads();
                }
                { const int t1 = tidx(), w1 = __builtin_amdgcn_readfirstlane(t1 >> 6);
                  for (int u = bid - 32; u < 512; u += G - 32) ret_out_unit(a, u, lds, t1, t1 & 63, w1); }
                __syncthreads(); STAMP(101 + 10 * l);
                { const int t2 = tidx(), w2 = __builtin_amdgcn_readfirstlane(t2 >> 6);
                  moe_convert(kargs(), lds, w2, t2 & 63, (bid - 32) * NWAVES + w2, (G - 32) * NWAVES, 4 * l, 4 * l + 4);
                  if (l == 0) ph_prologue(kargs(), lds, w2, t2 & 63, (bid - 32) * NWAVES + w2, (G - 32) * NWAVES, 0, 0, PRO_I_IN, PRO_NIT, false); STAMP(102 + 10 * l); }
            }
#endif
            }
            if (BOTH(PH_L(l, K_SCAN))) SEAM();
        }
#if GDN_SPLIT
        if (EN_SCAN && IN(PH_L(l, K_FIN))) {
            { PH_LOCALS; gdn_finalize(a, l, lane, gw, NGW); }
            if (BOTH(PH_L(l, K_FIN))) SEAM();
        }
#endif
        if (EN_OUT && IN(PH_L(l, K_OUT))) {
            _Pragma("unroll 1") for (int rep_ = 0; rep_ < REP_OUT; ++rep_) { if (rep_) SEAM(); PH_LOCALS;
            pg8::Gemm g{(const pg8::bf16_t*)(ws + WS_R + R_OB), (const pg8::bf16_t*)(ws + WS_WO) + (size_t)l * 1024 * 1024, M, 1024, 1024}; pg8::StaticOrder S; S.init(M, 1024, G, bid);
            pg8::EpiBf16Out E{(pg8::bf16_t*)(ws + WS_R + R_MIX), 1024};
            pg8::gemm_phase<pg8::EpiBf16Out, pg8::StaticOrder, PG8_ALIGN, PG8_SP2>(lds, g, S, E); }
            if (BOTH(PH_L(l, K_OUT))) SEAM();
        }
        if (EN_LN1 && IN(PH_L(l, K_LN1))) {
            { PH_LOCALS;
            if (l == 0) ln_rows<false>(a->in[0], ALPHA, (const bf16*)(ws + WS_R + R_MIX), a->in[7], a->in[8], a->out, 1.0f, (bf16*)(ws + WS_XB), nullptr, nullptr, nullptr, nullptr, lane, gw, NGW);
            else { ln_rows<true>(a->out, ALPHA, (const bf16*)(ws + WS_R + R_MIX), a->in[7] + 1024, a->in[8] + 1024, a->out, ALPHA, (bf16*)(ws + WS_XB), (const float*)(ws + WS_RWT), (unsigned*)(ws + WS_CTL) + CW_MOE, (int*)(ws + WS_LIST), (float*)(ws + WS_GATE), lane, gw, NGW, lds, tid);
                 } }
            if (BOTH(PH_L(l, K_LN1))) SEAM();
        }
        if (l == 0) {
            if (EN_FFN0 && IN(PH_L(0, K_GU))) {
                _Pragma("unroll 1") for (int rep_ = 0; rep_ < REP_GU; ++rep_) { if (rep_) SEAM(); PH_LOCALS;
                pg8::Gemm g{(const pg8::bf16_t*)(ws + WS_XB), (const pg8::bf16_t*)(ws + WS_WGU), M, 2 * FF, 1024}; pg8::StaticOrder S; S.init(M, 2 * FF, G, bid);
                pg8::EpiSwiglu E{(pg8::bf16_t*)(ws + WS_R + R_H), FF, 0};
                pg8::gemm_phase<pg8::EpiSwiglu, pg8::StaticOrder, PG8_ALIGN, PG8_SP2>(lds, g, S, E); }
                if (BOTH(PH_L(0, K_GU))) SEAM();
            }
            if (EN_FFN0 && IN(PH_L(0, K_DN))) {
                _Pragma("unroll 1") for (int rep_ = 0; rep_ < REP_DN; ++rep_) { if (rep_) SEAM(); PH_LOCALS;
                pg8::Gemm g{(const pg8::bf16_t*)(ws + WS_R + R_H), (const pg8::bf16_t*)(ws + WS_WD), M, 1024, FF}; pg8::StaticOrder S; S.init(M, 1024, G, bid);
                pg8::EpiBf16Out E{(pg8::bf16_t*)(ws + WS_R + R_MIX), 1024};
                pg8::gemm_phase<pg8::EpiBf16Out, pg8::StaticOrder, PG8_ALIGN, PG8_SP2>(lds, g, S, E); }
                if (BOTH(PH_L(0, K_DN))) SEAM();
            }
            if (EN_LN1 && IN(PH_L(0, K_LN2))) {
                { PH_LOCALS;
                ln_rows<false>(a->out, ALPHA, (const bf16*)(ws + WS_R + R_MIX), a->in[9], a->in[10], a->out, 1.0f, (bf16*)(ws + WS_XB), nullptr, nullptr, nullptr, nullptr, lane, gw, NGW); }
                if (BOTH(PH_L(0, K_LN2))) SEAM();
            }
        } else {
#pragma unroll 1
            for (int j = 0; j < 2; ++j) {
                const int kg = K_G0 + 3 * j;
                if (EN_MOE && j == 0 && IN(PH_L(1, kg))) { { PH_LOCALS; moe_gather(a, 0, lane, gw, NGW); moe_gather(a, 1, lane, gw, NGW); } if (BOTH(PH_L(1, kg))) SEAM(); }
                if (EN_MOE && IN(PH_L(1, kg + 1))) {
                    { PH_LOCALS;
                    pg8::moe_table(lds, (const unsigned*)(ws + WS_CTL) + CW_MOE, tid);
                    const PG8_LAS int* tab = (const PG8_LAS int*)(lds + pg8::MOE_TAB_OFF);
                    if (j == 1 && bid < 32) {
#pragma unroll 1
                        for (int jj = 0; jj < 2; ++jj) {
                            { pg8::MoeSched<true> S; S.tab = tab; S.j0 = jj; S.a0 = 64 + (bid >> 2); S.c = bid & 3; S.mode = (64 + (bid >> 2)) < pg8::moe_T(lds, jj) ? 1 : 2;
                              S.n0 = S.n1 = S.a1 = S.j1 = 0; S.G = 1;
                              pg8::Gemm g{(const pg8::bf16_t*)(ws + WS_R + R_HM), (const pg8::bf16_t*)(ws + WS_WMD), MOE_ROWS, 1024, FE, 1};
                              pg8::EpiMoeDown E{a->out, (const int*)(ws + WS_LIST), (const float*)(ws + WS_GATE), tab};
                              pg8::gemm_phase<pg8::EpiMoeDown, pg8::MoeSched<true>, PG8_ALIGN, PG8_SP2>(lds, g, S, E); }
                            if (jj == 0) {
                                VM_WAIT(); __syncthreads();
                                if (tidx() == 0) { unsigned* sub = (unsigned*)(kargs()->ws + WS_CTL) + CW_SUB;
                                    __builtin_amdgcn_fence(__ATOMIC_RELEASE, "agent"); VM_WAIT();
                                    __hip_atomic_fetch_add(sub, 1u, RLX_AGENT);
                                    unsigned sp = 0; while (__hip_atomic_load(sub, RLX_AGENT) < 32u && ++sp < (1u << 22)) __builtin_amdgcn_s_sleep(2);
                                    __builtin_amdgcn_fence(__ATOMIC_ACQUIRE, "agent"); VM_WAIT(); }
                                __syncthreads();
                            }
                        }
                    } else {
                        pg8::MoeSched<false> S; S.tab = tab; S.mode = 0;
                        const int T0 = pg8::moe_T(lds, 0), T1 = pg8::moe_T(lds, 1);
                        if (j == 0) { S.j0 = 0; S.a0 = 0; S.n0 = T0; S.j1 = 1; S.a1 = 64; S.n1 = T1 > 64 ? T1 - 64 : 0; S.G = G; S.c = bid; }
                        else        { S.j0 = 1; S.a0 = 0; S.n0 = T1 < 64 ? T1 : 64; S.j1 = 1; S.a1 = 0; S.n1 = 0; S.G = G - 32; S.c = bid - 32; }
                        pg8::Gemm g{(const pg8::bf16_t*)(ws + WS_R + R_XG), (const pg8::bf16_t*)(ws + WS_WMGU), MOE_ROWS, 2 * FE, 1024};
                        pg8::EpiSwiglu E{(pg8::bf16_t*)(ws + WS_R + R_HM), FE, 1};
                        pg8::gemm_phase<pg8::EpiSwiglu, pg8::MoeSched<false>, PG8_ALIGN, PG8_SP2>(lds, g, S, E);
                    } }
                    if (BOTH(PH_L(1, kg + 1))) SEAM();
                }
                if (EN_MOE && IN(PH_L(1, kg + 2))) {
                    { PH_LOCALS;
                    pg8::moe_table(lds, (const unsigned*)(ws + WS_CTL) + CW_MOE, tid);
                    const PG8_LAS int* tab = (const PG8_LAS int*)(lds + pg8::MOE_TAB_OFF);
                    const int Tj = pg8::moe_T(lds, j);
                    pg8::MoeSched<true> S; S.tab = tab; S.mode = 0; S.j0 = j; S.a0 = 0; S.n0 = Tj < 64 ? Tj : 64; S.j1 = j; S.a1 = 0; S.n1 = 0; S.G = G; S.c = bid;
                    pg8::Gemm g{(const pg8::bf16_t*)(ws + WS_R + R_HM), (const pg8::bf16_t*)(ws + WS_WMD), MOE_ROWS, 1024, FE, 1};
                    pg8::EpiMoeDown E{a->out, (const int*)(ws + WS_LIST), (const float*)(ws + WS_GATE), tab};
                    pg8::gemm_phase<pg8::EpiMoeDown, pg8::MoeSched<true>, PG8_ALIGN, PG8_SP2>(lds, g, S, E); }
                    if (BOTH(PH_L(1, kg + 2))) SEAM();
                }
            }
            if (EN_LN1 && IN(PH_L(1, K_LNF))) {
                PH_LOCALS;
                ln_rows<false>(a->out, 1.0f, nullptr, a->in[9] + 1024, a->in[10] + 1024, a->out, 1.0f, nullptr, nullptr, nullptr, nullptr, nullptr, lane, gw, NGW);
            }
        }
    }
    STAMP(stamp_no_);
#if PROBE_MULT > 0
    if (blockIdx.x == PROBE_BID && threadIdx.x == 0) {
        const unsigned long long* ts = (const unsigned long long*)(kargs()->ws + WS_CTL + 131072);
        const unsigned long long ta = __hip_atomic_load(ts + PROBE_A, RLX_AGENT), tb = __hip_atomic_load(ts + PROBE_B, RLX_AGENT);
        const unsigned long long hold = (tb > ta ? tb - ta : 0ull) * (unsigned long long)PROBE_MULT, t0 = __builtin_amdgcn_s_memrealtime();
        while (__builtin_amdgcn_s_memrealtime() - t0 < hold && __builtin_amdgcn_s_memrealtime() - t0 < 2000000ull) __builtin_amdgcn_s_sleep(8);
    }
#endif
#undef IN
#undef BOTH
}

extern "C" void kernel_launch(void* const* d_in, const int* in_sizes, int n_in, void* d_out, int out_size, void* d_ws, size_t ws_size, hipStream_t stream) {
    static int grid = 0;
    if (grid == 0) {
        if (n_in != 18 || in_sizes[0] != M * D || out_size != M * D || ws_size < WS_END) { fprintf(stderr, "kernel_launch: unexpected shapes or workspace (%zu < %zu); nothing launched\n", ws_size, (size_t)WS_END); grid = -1; return; }
        int dev = 0, cus = 0, per_cu = 0;
        if (hipGetDevice(&dev) != hipSuccess || hipDeviceGetAttribute(&cus, hipDeviceAttributeMultiprocessorCount, dev) != hipSuccess) { grid = -1; return; }
        if (hipFuncSetAttribute((const void*)fwd, hipFuncAttributeMaxDynamicSharedMemorySize, LDS_BYTES) != hipSuccess) { fprintf(stderr, "kernel_launch: hipFuncSetAttribute failed\n"); grid = -1; return; }
        if (hipOccupancyMaxActiveBlocksPerMultiprocessor(&per_cu, (const void*)fwd, NWAVES * 64, LDS_BYTES) != hipSuccess || per_cu < 1) fprintf(stderr, "kernel_launch: occupancy query reports %d\n", per_cu);
        (void)hipGetLastError();
        grid = cus;
    }
    if (grid < 0) return;
    if (hipMemsetAsync((char*)d_ws + WS_CTL, 0, CTL_BYTES, stream) != hipSuccess) return;
    Args a{};
    for (int i = 0; i < 18; ++i) a.in[i] = (const float*)d_in[i];
    a.out = (float*)d_out; a.ws = (unsigned char*)d_ws;
#if ONE_LAUNCH
    a.ph_lo = 0; a.ph_hi = PH_END;
    hipLaunchKernelGGL(fwd, dim3(grid), dim3(NWAVES * 64), LDS_BYTES, stream, a);
#else
    static const int phases[] = {PH_PRO,
        PH_L(0, K_IN), PH_L(0, K_PREP), PH_L(0, K_SCAN), PH_L(0, K_OUT), PH_L(0, K_LN1), PH_L(0, K_GU), PH_L(0, K_DN), PH_L(0, K_LN2),
        PH_L(1, K_IN), PH_L(1, K_PREP), PH_L(1, K_SCAN), PH_L(1, K_OUT), PH_L(1, K_LN1),
        PH_L(1, K_G0), PH_L(1, K_GU0), PH_L(1, K_DN0), PH_L(1, K_G1), PH_L(1, K_GU1), PH_L(1, K_DN1), PH_L(1, K_LNF)};
    for (unsigned i = 0; i < sizeof(phases) / sizeof(phases[0]); ++i) {
        a.ph_lo = phases[i]; a.ph_hi = phases[i] + 1;
        hipLaunchKernelGGL(fwd, dim3(grid), dim3(NWAVES * 64), LDS_BYTES, stream, a);
    }
#endif
}
```

```cpp
#define GDN_F8 1
#include <hip/hip_runtime.h>
#include <cstdio>
#include <cstdint>

#ifndef ONE_LAUNCH
#define ONE_LAUNCH 1
#endif

#define GAS __attribute__((address_space(1)))
#define LAS __attribute__((address_space(3)))
typedef unsigned short bf16;
typedef unsigned v4u __attribute__((ext_vector_type(4)));
typedef unsigned v2u __attribute__((ext_vector_type(2)));
typedef float f32x4 __attribute__((ext_vector_type(4)));
typedef float f32x2 __attribute__((ext_vector_type(2)));
#define RLX_AGENT __ATOMIC_RELAXED, __HIP_MEMORY_SCOPE_AGENT
#define LDS_WAIT() asm volatile("s_waitcnt lgkmcnt(0)" ::: "memory")
#define VM_WAIT() asm volatile("s_waitcnt vmcnt(0)" ::: "memory")

__device__ __forceinline__ unsigned f2bf(float f) { unsigned u = __builtin_bit_cast(unsigned, f); return (u + 0x7fffu + ((u >> 16) & 1u)) >> 16; }
__device__ __forceinline__ unsigned pk2(float lo, float hi) { return f2bf(lo) | (f2bf(hi) << 16); }
__device__ __forceinline__ float bf2f(unsigned short u) { return __builtin_bit_cast(float, (unsigned)u << 16); }
__device__ __forceinline__ float bflo(unsigned u) { return __builtin_bit_cast(float, u << 16); }
__device__ __forceinline__ float bfhi(unsigned u) { return __builtin_bit_cast(float, u & 0xffff0000u); }
__device__ __forceinline__ float siluf(float x) { return x * __builtin_amdgcn_rcpf(1.f + __expf(-x)); }
__device__ __forceinline__ float sigmf(float x) { return 1.f / (1.f + __expf(-x)); }
__device__ __forceinline__ float wave_sum(float v) {
    v += __builtin_bit_cast(float, __builtin_amdgcn_update_dpp(0, __builtin_bit_cast(int, v), 0xB1, 0xF, 0xF, true));
    v += __builtin_bit_cast(float, __builtin_amdgcn_update_dpp(0, __builtin_bit_cast(int, v), 0x4E, 0xF, 0xF, true));
    v += __builtin_bit_cast(float, __builtin_amdgcn_update_dpp(0, __builtin_bit_cast(int, v), 0x141, 0xF, 0xF, true));
    v += __builtin_bit_cast(float, __builtin_amdgcn_update_dpp(0, __builtin_bit_cast(int, v), 0x140, 0xF, 0xF, true));
    v += __builtin_bit_cast(float, __builtin_amdgcn_update_dpp(0, __builtin_bit_cast(int, v), 0x142, 0xA, 0xF, false));
    v += __builtin_bit_cast(float, __builtin_amdgcn_update_dpp(0, __builtin_bit_cast(int, v), 0x143, 0xC, 0xF, false));
    return __builtin_bit_cast(float, __builtin_amdgcn_readlane(__builtin_bit_cast(int, v), 63));
}

constexpr int NWAVES = 8;
constexpr int M = 16384, D = 1024, SEQ = 2048, NB = 8;
constexpr int IN_COLS = 3592, NIN_PAD = 3840, HP_LD = 3584;
constexpr int FF = 2816, FE = 3584, NE = 8;
constexpr int COL_RQ = 0, COL_RK = 256, COL_RV = 512, COL_RG = 1024, COL_GQ = 1536, COL_GK = 2048, COL_GV = 2560, COL_GG = 3072;
constexpr float ALPHA = 1.41421356237f;
constexpr float LN_EPS = 1e-5f, NORM_EPS = 1e-6f;
constexpr int MOE_ROWS = 72 * 256;

__host__ __device__ __forceinline__ int fragoff(int i, int d, int nkt) {
    return ((((i >> 5) * nkt + (d >> 5)) * 2 + ((d >> 4) & 1)) * 512) + ((((d >> 2) & 1) * 32 + (i & 31)) * 8) + ((((d >> 3) & 1) << 2) | (d & 3));
}
__host__ __device__ __forceinline__ int uoff(int i, int e) {
    const int reg = (i & 3) | (((i & 31) >> 3) << 2);
    return (((((e >> 5) * 2 + (i >> 5)) * 2 + (reg >> 3)) * 64 + (((i >> 2) & 1) * 32 + (e & 31))) * 8) + (reg & 7);
}
namespace pg8 {
#define PG8_LAS __attribute__((address_space(3)))
typedef unsigned short bf16_t;
typedef short bf16x8 __attribute__((ext_vector_type(8)));
typedef float f32x4 __attribute__((ext_vector_type(4)));
typedef unsigned u32x4 __attribute__((ext_vector_type(4)));
constexpr int BM = 256, BK = 64, HALF = 128, HTB = HALF * BK * 2  , STAGE_BYTES = 8 * HTB, NXCD = 8, WGM = 8;

__host__ __device__ __forceinline__ int lds_byte(int r, int c) { const int st = (r >> 4) * 2 + (c >> 5), rr = r & 15, cc = c & 31, ob = rr * 64 + cc * 2; return st * 1024 + (ob ^ (((ob >> 9) & 1) << 5)); }
__host__ __device__ __forceinline__ void stage_rc(int b, int& R, int& C) { const int st = b / 1024, sb = b % 1024, swz = sb ^ (((sb >> 9) & 1) << 5); R = (st >> 1) * 16 + swz / 64; C = (st & 1) * 32 + (swz % 64) / 2; }
__host__ __device__ __forceinline__ int perm32(int rho) { const int n = rho >> 4, i = rho & 15; return 8 * (i >> 2) + 4 * n + (i & 3); }

struct Unit { int pm, pn, aux, am, sel; };
struct Gemm { const bf16_t* A; const bf16_t* Bt; int M, N, K, blk; };

struct StaticOrder {
    int nM, nN, nwg, G, c;
    __host__ __device__ void init(int M, int N, int G_, int c_) { nM = M / BM; nN = N / BM; nwg = nM * nN; G = G_; c = c_; }
    __host__ __device__ bool next(int i, Unit& u) const {
        const long L = (long)i * G + c; if (L >= nwg) return false;
        int wgid = (int)L; { const int q = nwg / NXCD, r = nwg % NXCD, xcd = wgid % NXCD, off = wgid / NXCD; wgid = (xcd < r ? xcd * (q + 1) : r * (q + 1) + (xcd - r) * q) + off; }
        const int nig = WGM * nN, gid = wgid / nig, fm = gid * WGM, gsz = (nM - fm) < WGM ? (nM - fm) : WGM;
        u.pm = fm + ((wgid % nig) % gsz); u.pn = (wgid % nig) / gsz; u.aux = 0; u.am = u.pm; u.sel = 0; return true;
    }
    __device__ __forceinline__ const char* aptr(const Gemm& g, const Unit& u) const { return (const char*)g.A + (size_t)u.pm * ((size_t)BM * g.K * 2); }
    __device__ __forceinline__ const char* bptr(const Gemm& g, const Unit& u) const { return (const char*)g.Bt + (size_t)u.pn * ((size_t)BM * g.K * 2); }
    __device__ __forceinline__ void a_ready(const Unit&) const {}
    __device__ __forceinline__ void done(const Unit&) const {}
};

template <class Epi, class Sched, bool ALIGN_EPI = false, bool SP2 = false>
__device__ __forceinline__ void gemm_phase(PG8_LAS unsigned char* lds, const Gemm g, const Sched& S, const Epi& E) {
    int tid = threadIdx.x; asm volatile("" : "+v"(tid)); const int wid = __builtin_amdgcn_readfirstlane(tid >> 6), lane = tid & 63, wr = wid >> 2, wc = wid & 3, fr = lane & 15, fq = lane >> 4;
    const int K = g.K, nt = K / BK;
    unsigned voffA[2], voffB[2];
#pragma unroll
    for (int i = 0; i < 2; ++i) { int R, C; stage_rc(tid * 16 + i * 8192, R, C); const int Rb = Epi::PERM ? ((R & ~31) + perm32(R & 31)) : R;
        voffA[i] = (unsigned)(R * (g.blk ? 64 : K) + C) * 2u; voffB[i] = (unsigned)(Rb * (g.blk ? 64 : K) + C) * 2u; }
    const size_t kstep = g.blk ? (size_t)(256 * 64 * 2) : (size_t)(BK * 2);
    const size_t hstep = g.blk ? (size_t)(HALF * 64 * 2) : (size_t)HALF * K * 2;
    const size_t tstep = 2 * hstep;
    const unsigned ldsw = (unsigned)wid * 1024u;
    const int aoff = lds_byte(wr * 64 + fr, fq * 8), boff = lds_byte(wc * 32 + fr, fq * 8);
#define PG8_SA(b, h) (((b) * 2 + (h)) * HTB)
#define PG8_SB(b, h) ((4 + (b) * 2 + (h)) * HTB)
#define PG8_STAGE(bufoff, gbase, voff) do { _Pragma("unroll") for (int _i = 0; _i < 2; ++_i) \
        __builtin_amdgcn_global_load_lds((const unsigned*)((const char*)(gbase) + (voff)[_i]), (PG8_LAS unsigned*)(lds + (bufoff) + ldsw + _i * 8192), 16, 0, 0); } while (0)
#define PG8_LDA(dst, b, h) do { _Pragma("unroll") for (int m = 0; m < 4; ++m) _Pragma("unroll") for (int k = 0; k < 2; ++k) dst[m][k] = *(const PG8_LAS bf16x8*)(lds + PG8_SA(b, h) + aoff + m * 2048 + k * 1024); } while (0)
#define PG8_LDB(dst, b, h) do { _Pragma("unroll") for (int n = 0; n < 2; ++n) _Pragma("unroll") for (int k = 0; k < 2; ++k) dst[n][k] = *(const PG8_LAS bf16x8*)(lds + PG8_SB(b, h) + boff + n * 2048 + k * 1024); } while (0)
#define PG8_MMA(ai, bj, At, Bt) do { __builtin_amdgcn_s_setprio(1); _Pragma("unroll") for (int m = 0; m < 4; ++m) _Pragma("unroll") for (int n = 0; n < 2; ++n) _Pragma("unroll") for (int k = 0; k < 2; ++k) \
        acc[ai][bj][m][n] = __builtin_amdgcn_mfma_f32_16x16x32_bf16(Bt[n][k], At[m][k], acc[ai][bj][m][n], 0, 0, 0); __builtin_amdgcn_s_setprio(0); } while (0)
#define PG8_WAIT_V(n) asm volatile("s_waitcnt vmcnt(" #n ")" ::: "memory")
#define PG8_WAIT_L(n) asm volatile("s_waitcnt lgkmcnt(" #n ")" ::: "memory")
#define PG8_BAR __builtin_amdgcn_s_barrier()
#define PG8_SCHED __builtin_amdgcn_sched_barrier(0)
    Unit cur, nxt; int ui = 0;
    if (!S.next(0, cur)) return;
    f32x4 acc[2][2][4][2];
#pragma unroll
    for (int a = 0; a < 2; ++a)
#pragma unroll
        for (int b = 0; b < 2; ++b)
#pragma unroll
            for (int m = 0; m < 4; ++m)
#pragma unroll
                for (int n = 0; n < 2; ++n) acc[a][b][m][n] = (f32x4){0.f, 0.f, 0.f, 0.f};
    bf16x8 At[4][2], B0[2][2], B1[2][2];
    const char* cA = S.aptr(g, cur); const char* cB = S.bptr(g, cur);
    S.a_ready(cur);
    if constexpr (SP2) {
        PG8_STAGE(PG8_SB(0, 0), cB, voffB); PG8_STAGE(PG8_SB(0, 1), cB + hstep, voffB); PG8_STAGE(PG8_SA(0, 0), cA, voffA); PG8_STAGE(PG8_SA(0, 1), cA + hstep, voffA);
        if (wr == 1) PG8_BAR;
        PG8_WAIT_V(2); PG8_BAR;
        PG8_STAGE(PG8_SB(1, 0), cB + kstep, voffB); PG8_STAGE(PG8_SA(1, 0), cA + kstep, voffA); PG8_STAGE(PG8_SB(1, 1), cB + hstep + kstep, voffB);
        PG8_WAIT_V(6); PG8_BAR;
    } else {
        PG8_STAGE(PG8_SB(0, 0), cB, voffB); PG8_STAGE(PG8_SA(0, 0), cA, voffA); PG8_STAGE(PG8_SB(0, 1), cB + hstep, voffB); PG8_STAGE(PG8_SA(0, 1), cA + hstep, voffA);
        if (wr == 1) PG8_BAR;
        PG8_WAIT_V(4); PG8_BAR;
        PG8_STAGE(PG8_SB(1, 0), cB + kstep, voffB); PG8_STAGE(PG8_SA(1, 0), cA + kstep, voffA); PG8_STAGE(PG8_SB(1, 1), cB + hstep + kstep, voffB);
        PG8_WAIT_V(6); PG8_BAR;
    }
    for (;;) {
        const bool has_next = S.next(ui + 1, nxt);
        const char* nA = has_next ? S.aptr(g, nxt) : cA; const char* nB = has_next ? S.bptr(g, nxt) : cB;
        for (int t = 0; t < nt; t += 2) {
            const bool last = (t == nt - 2);
            const char* a1 = cA + (size_t)(t + 1) * kstep;
            const char* a2 = last ? nA : cA + (size_t)(t + 2) * kstep; const char* b2 = last ? nB : cB + (size_t)(t + 2) * kstep;
            const char* a3 = a2 + kstep; const char* b3 = b2 + kstep;
            if (last && has_next) S.a_ready(nxt);
            if constexpr (SP2) {
            PG8_LDB(B0, 0, 0); PG8_LDB(B1, 0, 1); PG8_SCHED; PG8_LDA(At, 0, 0); PG8_STAGE(PG8_SA(1, 1), a1 + hstep, voffA);
            PG8_WAIT_V(8); PG8_WAIT_L(0); PG8_BAR; PG8_MMA(0, 0, At, B0); PG8_MMA(0, 1, At, B1); PG8_BAR; PG8_SCHED;
            PG8_LDA(At, 0, 1); PG8_STAGE(PG8_SB(0, 0), b2, voffB); PG8_STAGE(PG8_SB(0, 1), b2 + hstep, voffB); PG8_STAGE(PG8_SA(0, 0), a2, voffA);
            PG8_WAIT_V(8); PG8_WAIT_L(0); PG8_BAR; PG8_MMA(1, 0, At, B0); PG8_MMA(1, 1, At, B1); PG8_BAR; PG8_SCHED;
            PG8_LDB(B0, 1, 0); PG8_LDB(B1, 1, 1); PG8_SCHED; PG8_LDA(At, 1, 0); PG8_STAGE(PG8_SA(0, 1), a2 + hstep, voffA);
            PG8_WAIT_V(8); PG8_WAIT_L(0); PG8_BAR; PG8_MMA(0, 0, At, B0); PG8_MMA(0, 1, At, B1); PG8_BAR; PG8_SCHED;
            PG8_LDA(At, 1, 1); PG8_STAGE(PG8_SB(1, 0), b3, voffB); PG8_STAGE(PG8_SB(1, 1), b3 + hstep, voffB); PG8_STAGE(PG8_SA(1, 0), a3, voffA);
            PG8_WAIT_V(8); PG8_WAIT_L(0); PG8_BAR; PG8_MMA(1, 0, At, B0); PG8_MMA(1, 1, At, B1); PG8_BAR; PG8_SCHED;
            } else {
            PG8_LDB(B0, 0, 0); PG8_SCHED; PG8_LDA(At, 0, 0); PG8_STAGE(PG8_SA(1, 1), a1 + hstep, voffA);
            PG8_WAIT_L(8); PG8_BAR; PG8_WAIT_L(0); PG8_MMA(0, 0, At, B0); PG8_BAR; PG8_SCHED;
            PG8_LDB(B1, 0, 1); PG8_STAGE(PG8_SB(0, 0), b2, voffB);
            PG8_BAR; PG8_WAIT_L(0); PG8_MMA(0, 1, At, B1); PG8_BAR;
            PG8_LDA(At, 0, 1); PG8_STAGE(PG8_SA(0, 0), a2, voffA);
            PG8_BAR; PG8_WAIT_L(0); PG8_MMA(1, 0, At, B0); PG8_BAR; PG8_SCHED;
            PG8_STAGE(PG8_SB(0, 1), b2 + hstep, voffB);
            PG8_WAIT_V(6); PG8_BAR; PG8_MMA(1, 1, At, B1); PG8_BAR;
            PG8_LDB(B0, 1, 0); PG8_SCHED; PG8_LDA(At, 1, 0); PG8_STAGE(PG8_SA(0, 1), a2 + hstep, voffA);
            PG8_WAIT_L(8); PG8_BAR; PG8_WAIT_L(0); PG8_MMA(0, 0, At, B0); PG8_BAR; PG8_SCHED;
            PG8_LDB(B1, 1, 1); PG8_STAGE(PG8_SB(1, 0), b3, voffB);
            PG8_BAR; PG8_WAIT_L(0); PG8_MMA(0, 1, At, B1); PG8_BAR;
            PG8_LDA(At, 1, 1); PG8_STAGE(PG8_SA(1, 0), a3, voffA);
            PG8_BAR; PG8_WAIT_L(0); PG8_MMA(1, 0, At, B0); PG8_BAR; PG8_SCHED;
            PG8_STAGE(PG8_SB(1, 1), b3 + hstep, voffB);
            PG8_WAIT_V(6); PG8_BAR; PG8_MMA(1, 1, At, B1); PG8_BAR;
            }
        }
        if constexpr (ALIGN_EPI) { if (wr == 0) PG8_BAR; }
        if constexpr (!Epi::AFTER_DRAIN) { E(acc, cur, wr, wc, fr, fq); S.done(cur); }
        if (!has_next) break;
#pragma unroll
        for (int a = 0; a < 2; ++a)
#pragma unroll
            for (int b = 0; b < 2; ++b)
#pragma unroll
                for (int m = 0; m < 4; ++m)
#pragma unroll
                    for (int n = 0; n < 2; ++n) acc[a][b][m][n] = (f32x4){0.f, 0.f, 0.f, 0.f};
        cur = nxt; cA = nA; cB = nB; ++ui;
        if constexpr (ALIGN_EPI) { if (wr == 1) PG8_BAR; }
    }
    PG8_WAIT_V(0);
    if constexpr (!ALIGN_EPI) { if (wr == 0) PG8_BAR; }
    PG8_BAR;
    if constexpr (Epi::AFTER_DRAIN) { E.fused(acc, cur, wr, wc, fr, fq, lds, wid, lane); S.done(cur); }
#undef PG8_SA
#undef PG8_SB
#undef PG8_STAGE
#undef PG8_LDA
#undef PG8_LDB
#undef PG8_MMA
#undef PG8_WAIT_V
#undef PG8_WAIT_L
#undef PG8_BAR
#undef PG8_SCHED
}
}

namespace pg8 {
__device__ __forceinline__ unsigned cvt_pk_bf16(float lo, float hi) { unsigned r; asm volatile("v_cvt_pk_bf16_f32 %0, %1, %2" : "=v"(r) : "v"(lo), "v"(hi)); return r; }

struct EpiHproj {
    static constexpr bool PERM = true, AFTER_DRAIN = false;
    bf16_t* HP; float* GAB;
    __device__ __forceinline__ void operator()(const f32x4 (&acc)[2][2][4][2], const Unit& u, int wr, int wc, int fr, int fq) const {
        const int row0 = u.pm * BM + wr * 64 + fr;
        if (u.pn < 14) {
            const int col0 = u.pn * BM + wc * 32 + 8 * fq;
#pragma unroll
            for (int ai = 0; ai < 2; ++ai)
#pragma unroll
                for (int m = 0; m < 4; ++m) { bf16_t* rowp = HP + (size_t)(row0 + ai * HALF + m * 16) * 3584 + col0;
#pragma unroll
                    for (int bj = 0; bj < 2; ++bj) { const f32x4 v0 = acc[ai][bj][m][0], v1 = acc[ai][bj][m][1];
                        u32x4 w; w.x = cvt_pk_bf16(v0[0], v0[1]); w.y = cvt_pk_bf16(v0[2], v0[3]); w.z = cvt_pk_bf16(v1[0], v1[1]); w.w = cvt_pk_bf16(v1[2], v1[3]);
                        *(u32x4*)(rowp + bj * HALF) = w; } }
        } else if (wc == 0 && fq == 0) {
#pragma unroll
            for (int ai = 0; ai < 2; ++ai)
#pragma unroll
                for (int m = 0; m < 4; ++m) { float* rowp = GAB + (size_t)(row0 + ai * HALF + m * 16) * 8;
                    *(f32x4*)(rowp) = acc[ai][0][m][0]; *(f32x4*)(rowp + 4) = acc[ai][0][m][1]; }
        }
    }
};
struct EpiBf16Out {
    static constexpr bool PERM = true, AFTER_DRAIN = false;
    bf16_t* O; int ldc;
    __device__ __forceinline__ void operator()(const f32x4 (&acc)[2][2][4][2], const Unit& u, int wr, int wc, int fr, int fq) const {
        const int row0 = u.pm * BM + wr * 64 + fr, col0 = u.pn * BM + wc * 32 + 8 * fq;
#pragma unroll
        for (int ai = 0; ai < 2; ++ai)
#pragma unroll
            for (int m = 0; m < 4; ++m) { bf16_t* rowp = O + (size_t)(row0 + ai * HALF + m * 16) * ldc + col0;
#pragma unroll
                for (int bj = 0; bj < 2; ++bj) { const f32x4 v0 = acc[ai][bj][m][0], v1 = acc[ai][bj][m][1];
                    u32x4 w; w.x = cvt_pk_bf16(v0[0], v0[1]); w.y = cvt_pk_bf16(v0[2], v0[3]); w.z = cvt_pk_bf16(v1[0], v1[1]); w.w = cvt_pk_bf16(v1[2], v1[3]);
                    *(u32x4*)(rowp + bj * HALF) = w; } }
    }
};
struct EpiF32 {
    static constexpr bool PERM = false, AFTER_DRAIN = false;
    float* O; int ldc;
    __device__ __forceinline__ void operator()(const f32x4 (&acc)[2][2][4][2], const Unit& u, int wr, int wc, int fr, int fq) const {
        const int row0 = u.pm * BM + wr * 64 + fr, col0 = u.pn * BM + wc * 32 + 4 * fq;
#pragma unroll
        for (int ai = 0; ai < 2; ++ai)
#pragma unroll
            for (int m = 0; m < 4; ++m) { float* rowp = O + (size_t)(row0 + ai * HALF + m * 16) * ldc + col0;
#pragma unroll
                for (int bj = 0; bj < 2; ++bj)
#pragma unroll
                    for (int n = 0; n < 2; ++n) *(f32x4*)(rowp + bj * HALF + n * 16) = acc[ai][bj][m][n]; }
    }
};
struct EpiSwiglu {
    static constexpr bool PERM = true, AFTER_DRAIN = false;
    bf16_t* H; int ldh; int blk;
    __device__ __forceinline__ void operator()(const f32x4 (&acc)[2][2][4][2], const Unit& u, int wr, int wc, int fr, int fq) const {
        const int rt = wr * 64 + fr, col0 = u.pn * HALF + wc * 32 + 8 * fq;
        bf16_t* tb = H + (size_t)u.pm * BM * ldh;
#pragma unroll
        for (int ai = 0; ai < 2; ++ai)
#pragma unroll
            for (int m = 0; m < 4; ++m) { const int r = rt + ai * HALF + m * 16;
                bf16_t* rowp = blk ? tb + (size_t)(col0 >> 6) * (BM * 64) + r * 64 + (col0 & 63) : tb + (size_t)r * ldh + col0;
                float h[8];
#pragma unroll
                for (int n = 0; n < 2; ++n)
#pragma unroll
                    for (int i = 0; i < 4; ++i) { const float gt = acc[ai][0][m][n][i], up = acc[ai][1][m][n][i]; h[n * 4 + i] = gt * up * __builtin_amdgcn_rcpf(1.f + __expf(-gt)); }
                u32x4 w; w.x = cvt_pk_bf16(h[0], h[1]); w.y = cvt_pk_bf16(h[2], h[3]); w.z = cvt_pk_bf16(h[4], h[5]); w.w = cvt_pk_bf16(h[6], h[7]);
                *(u32x4*)(rowp) = w; }
    }
};
constexpr int MOE_TAB_OFF = 131072 + 1024;
__device__ __forceinline__ void moe_table(PG8_LAS unsigned char* lds, const unsigned* cntw, int tid) {
    PG8_LAS int* tab = (PG8_LAS int*)(lds + MOE_TAB_OFF);
    __syncthreads();
    if (tid < 2) { const int j = tid; int t = 0;
        for (int e = 0; e < 8; ++e) { const int c = (int)cntw[64 * (j * 8 + e)]; tab[j * 8 + e] = t; tab[16 + j * 8 + e] = c; t += (c + 255) >> 8; }
        tab[32 + j] = t; }
    __syncthreads();
}
__device__ __forceinline__ int moe_T(PG8_LAS unsigned char* lds, int j) { return __builtin_amdgcn_readfirstlane(((const PG8_LAS int*)(lds + MOE_TAB_OFF))[32 + j]); }
__device__ __forceinline__ int moe_expert(const PG8_LAS int* tab, int j, int t) { int e = 0;
#pragma unroll
    for (int k = 1; k < 8; ++k) e += (t >= tab[j * 8 + k]) ? 1 : 0;
    return __builtin_amdgcn_readfirstlane(e); }
__device__ __forceinline__ int moe_hphys(int j, int t) { return (j == 1 && t >= 64) ? t + 8 : t; }
struct EpiMoeDown {
    static constexpr bool PERM = false, AFTER_DRAIN = false;
    float* XF; const int* list; const float* gate; const PG8_LAS int* tab;
    __device__ __forceinline__ void operator()(const f32x4 (&acc)[2][2][4][2], const Unit& u, int wr, int wc, int fr, int fq) const {
        const int e = u.aux, j = u.sel, c_e = tab[16 + j * 8 + e], t_e = tab[j * 8 + e];
        const int s0 = (u.pm - t_e) * BM + wr * 64 + fr, col0 = u.pn * BM + wc * 32 + 4 * fq;
        const int* lp = list + (size_t)(j * 8 + e) * 16384; const float* gp = gate + (size_t)j * 16384;
        int tok[8]; float gt[8];
#pragma unroll
        for (int q = 0; q < 8; ++q) { const int s = s0 + (q >> 2) * HALF + (q & 3) * 16; tok[q] = (s < c_e) ? lp[s] : -1; }
#pragma unroll
        for (int q = 0; q < 8; ++q) gt[q] = (tok[q] >= 0) ? gp[tok[q]] : 0.f;
#pragma unroll
        for (int ai = 0; ai < 2; ++ai) {
            f32x4 o[4][2][2];
#pragma unroll
            for (int m = 0; m < 4; ++m) { const float* rowp = XF + (size_t)(tok[ai * 4 + m] >= 0 ? tok[ai * 4 + m] : 0) * 1024 + col0;
#pragma unroll
                for (int bj = 0; bj < 2; ++bj)
#pragma unroll
                    for (int n = 0; n < 2; ++n) o[m][bj][n] = *(const f32x4*)(rowp + bj * HALF + n * 16); }
#pragma unroll
            for (int m = 0; m < 4; ++m) { if (tok[ai * 4 + m] >= 0) { float* rowp = XF + (size_t)tok[ai * 4 + m] * 1024 + col0; const float g1 = gt[ai * 4 + m];
#pragma unroll
                for (int bj = 0; bj < 2; ++bj)
#pragma unroll
                    for (int n = 0; n < 2; ++n) *(f32x4*)(rowp + bj * HALF + n * 16) = o[m][bj][n] + acc[ai][bj][m][n] * g1; } }
        }
    }
};
template <bool DOWN>
struct MoeSched {
    int mode, n0, a0, j0, n1, a1, j1, G, c; const PG8_LAS int* tab;
    static constexpr int nN = DOWN ? 4 : 28;
    __device__ bool next(int i, Unit& u) const {
        int j, t;
        if (mode != 0) { if (i != 0 || mode == 2) return false; j = j0; t = a0; u.pn = c; }
        else {
            const int V = n0 + n1, nwg = V * nN; const long L = (long)i * G + c; if (L >= nwg) return false;
            int wgid = (int)L; { const int q = nwg / NXCD, r = nwg % NXCD, xcd = wgid % NXCD, off = wgid / NXCD; wgid = (xcd < r ? xcd * (q + 1) : r * (q + 1) + (xcd - r) * q) + off; }
            const int nig = WGM * nN, gid = wgid / nig, fm = gid * WGM, gsz = (V - fm) < WGM ? (V - fm) : WGM;
            const int vm = fm + ((wgid % nig) % gsz); u.pn = (wgid % nig) / gsz;
            if (vm < n0) { j = j0; t = a0 + vm; } else { j = j1; t = a1 + (vm - n0); }
        }
        u.aux = moe_expert(tab, j, t); u.sel = j;
        if (DOWN) { u.pm = t; u.am = moe_hphys(j, t); } else { u.pm = moe_hphys(j, t); u.am = t; }
        return true;
    }
    __device__ __forceinline__ const char* aptr(const Gemm& g, const Unit& u) const { return (const char*)g.A + (DOWN ? (size_t)0 : (size_t)u.sel * (size_t)(36u << 20)) + (size_t)u.am * ((size_t)BM * g.K * 2); }
    __device__ __forceinline__ const char* bptr(const Gemm& g, const Unit& u) const { return (const char*)g.Bt + (size_t)u.aux * ((size_t)g.N * g.K * 2) + (size_t)u.pn * ((size_t)BM * g.K * 2); }
    __device__ __forceinline__ void a_ready(const Unit&) const {}
    __device__ __forceinline__ void done(const Unit&) const {}
};
}
#ifndef PG8_SP2
#define PG8_SP2 true
#endif
#ifndef PG8_ALIGN
#define PG8_ALIGN true
#endif

constexpr size_t MiB = 1u << 20;
constexpr size_t WS_CTL = 0, CTL_BYTES = 256 * 1024;
constexpr size_t WS_ROPE = 256 * 1024;
constexpr size_t WS_WIN = 1 * MiB;
constexpr size_t WS_WO = 16 * MiB;
constexpr size_t WS_WGU = 20 * MiB;
constexpr size_t WS_WD = 31 * MiB;
constexpr size_t WS_XB = 37 * MiB;
constexpr size_t WS_GAB = 69 * MiB;
constexpr size_t WS_LIST = WS_GAB + 512 * 1024;
constexpr size_t WS_GATE = WS_LIST + 1 * MiB;
constexpr size_t WS_CD = WS_GATE + 128 * 1024;
constexpr size_t WS_RWT = WS_CD + 8 * 1024;
constexpr size_t WS_WMGU = 71 * MiB, WS_WMD = 183 * MiB;
constexpr size_t WS_R = 239 * MiB;
constexpr size_t R_HP = 0, R_OB = 112 * MiB, R_U = 144 * MiB, R_WN = 160 * MiB, R_QD = 176 * MiB, R_KDT = 192 * MiB, R_QK = 208 * MiB;
constexpr size_t WS_SSQ = WS_XB + 16 * MiB;
constexpr size_t WS_KV = WS_XB;
constexpr size_t R_MIX = 0, R_H = 64 * MiB;
constexpr size_t R_HM = 0, R_XG = 140 * MiB, XG_PASS = 36 * MiB;
constexpr size_t WS_END = WS_R + 216 * MiB;
constexpr int CW_TMO = 0, CW_BAR = 4096, CW_MOE = 16384, CW_WQ = 24576, CW_SUB = 28672;

constexpr int RING_BYTES = 131072, LDS_BYTES = 147456, LDSCTL_OFF = LDS_BYTES - 512, MISC_OFF = LDSCTL_OFF + 320;

constexpr int PH_PRO = 0;
constexpr int PH_L(int l, int k) { return 1 + 16 * l + k; }
constexpr int K_IN = 0, K_PREP = 1, K_SCAN = 2, K_OUT = 3, K_LN1 = 4, K_GU = 5, K_DN = 6, K_LN2 = 7;
constexpr int K_FIN = 12;
constexpr int K_G0 = 5, K_GU0 = 6, K_DN0 = 7, K_G1 = 8, K_GU1 = 9, K_DN1 = 10, K_LNF = 11;
constexpr int PH_END = 1 + 16 * 2;

struct Args { const float* in[18]; float* out; unsigned char* ws; int ph_lo, ph_hi; };
typedef const __attribute__((address_space(4))) Args* KArgs;
__device__ __forceinline__ KArgs kargs() { KArgs p = (KArgs)__builtin_amdgcn_kernarg_segment_ptr(); asm volatile("" : "+s"(p)); return p; }
__device__ __forceinline__ int tidx() { int t = threadIdx.x; asm volatile("" : "+v"(t)); return t; }

constexpr int TR_SCR = 64 * 65 * 4;
__device__ __forceinline__ void tr_item(const float* W, int N, int k0, int n0, bf16* WT, size_t ldk, int dst_row0, LAS float* scr, int lane, bool blk = false) {
    const int nq = 4 * (lane & 15), n = n0 + nq, kr = lane >> 4;
    f32x4 v[16];
#pragma unroll
    for (int i = 0; i < 16; ++i) v[i] = (n < N) ? *(const f32x4*)(W + (size_t)(k0 + 4 * i + kr) * N + n) : (f32x4){0.f, 0.f, 0.f, 0.f};
#pragma unroll
    for (int i = 0; i < 16; ++i) { LAS float* d = scr + (4 * i + kr) * 65 + nq; d[0] = v[i].x; d[1] = v[i].y; d[2] = v[i].z; d[3] = v[i].w; }
    LDS_WAIT(); asm volatile("" ::: "memory");
    const int c = lane & 7;
#pragma unroll
    for (int j = 0; j < 8; ++j) { const int nn = (lane >> 3) + 8 * j; const LAS float* s = scr + (8 * c) * 65 + nn;
        v4u o; o.x = pk2(s[0 * 65], s[1 * 65]); o.y = pk2(s[2 * 65], s[3 * 65]); o.z = pk2(s[4 * 65], s[5 * 65]); o.w = pk2(s[6 * 65], s[7 * 65]);
        const int dr = dst_row0 + nn;
        bf16* dp = blk ? WT + ((size_t)(dr >> 8) * (ldk >> 6) + (k0 >> 6)) * (256 * 64) + (dr & 255) * 64 + 8 * c : WT + (size_t)dr * ldk + k0 + 8 * c;
        *(v4u*)dp = o; }
    LDS_WAIT(); asm volatile("" ::: "memory");
}

constexpr int PRO_I_IN = 16 * 57, PRO_NIT = 2 * (16 * 57 + 16 * 16) + 2 * (16 * 44) + 44 * 16;
__device__ __forceinline__ void ph_prologue(KArgs a, LAS unsigned char* lds, int wave, int lane, int gw, int NGW, int gtid, int NT, int it_lo, int it_hi, bool misc) {
    unsigned char* ws = a->ws;
    LAS float* scr = (LAS float*)(lds + wave * TR_SCR);
    constexpr int I_IN = 16 * 57, I_O = 16 * 16, I_L = I_IN + I_O, I_G = 16 * 44, I_D = 44 * 16, NIT = 2 * I_L + 2 * I_G + I_D;
    static_assert(NIT == PRO_NIT && I_IN == PRO_I_IN, "prologue item counts");
    for (int it = it_lo + gw; it < it_hi; it += NGW) {
        int r = it;
        if (r < 2 * I_L) { const int l = r / I_L; r -= l * I_L;
            if (r < I_IN) { const int kb = r / 57, nb = r % 57; tr_item(a->in[1] + (size_t)l * 1024 * IN_COLS, IN_COLS, 64 * kb, 64 * nb, (bf16*)(ws + WS_WIN) + (size_t)l * NIN_PAD * 1024, 1024, 64 * nb, scr, lane); }
            else { r -= I_IN; const int kb = r / 16, nb = r % 16; tr_item(a->in[6] + (size_t)l * 1024 * 1024, 1024, 64 * kb, 64 * nb, (bf16*)(ws + WS_WO) + (size_t)l * 1024 * 1024, 1024, 64 * nb, scr, lane); }
            continue; }
        r -= 2 * I_L;
        if (r < 2 * I_G) { const int up = r / I_G; r -= up * I_G; const int kb = r / 44, nb = r % 44, n0 = 64 * nb;
            tr_item(up ? a->in[12] : a->in[11], FF, 64 * kb, n0, (bf16*)(ws + WS_WGU), 1024, 256 * (n0 >> 7) + (n0 & 127) + 128 * up, scr, lane); continue; }
        r -= 2 * I_G;
        { const int kb = r / 16, nb = r % 16; tr_item(a->in[13], 1024, 64 * kb, 64 * nb, (bf16*)(ws + WS_WD), FF, 64 * nb, scr, lane); }
    }
    if (!misc) return;
    for (int i = gtid; i < 2 * 192 * 128; i += NT) { const int l = i / (192 * 128), r = i % (192 * 128);
        ((v4u*)((bf16*)(ws + WS_WIN) + (size_t)l * NIN_PAD * 1024 + (size_t)3648 * 1024))[r] = (v4u){0u, 0u, 0u, 0u}; }
    for (int i = gtid; i < M * D / 8; i += NT) { const f32x4 p = ((const f32x4*)a->in[0])[2 * i], q = ((const f32x4*)a->in[0])[2 * i + 1];
        v4u o; o.x = pk2(p.x, p.y); o.y = pk2(p.z, p.w); o.z = pk2(q.x, q.y); o.w = pk2(q.z, q.w); ((v4u*)(ws + WS_XB))[i] = o; }
    for (int i = gtid; i < 8192; i += NT) ((float*)(ws + WS_RWT))[(i & 7) * 1024 + (i >> 3)] = a->in[14][i];
    for (int i = gtid; i < SEQ * 32; i += NT) { const int pos = i >> 5, k = i & 31;
        const float inv = powf(10000.0f, -(float)(2 * k) / 64.0f); const float ang = (float)pos * inv;
        double rev = (double)ang * 0.15915494309189535; rev -= floor(rev); const float rf = (float)rev;
        float* R = (float*)(ws + WS_ROPE) + (size_t)pos * 64; R[k] = __builtin_amdgcn_cosf(rf); R[32 + k] = __builtin_amdgcn_sinf(rf); }
}

__device__ __forceinline__ void moe_convert(KArgs a, LAS unsigned char* lds, int wave, int lane, int gw, int NGW, int e_lo, int e_hi, int item = -1) {
    unsigned char* ws = a->ws;
    LAS float* scr = (LAS float*)(lds + wave * TR_SCR);
    constexpr int I_G = 16 * 56, I_D = 56 * 16, I_E = 2 * I_G + I_D;
    for (int it = (item >= 0 ? item : e_lo * I_E + gw); it < (item >= 0 ? item + 1 : e_hi * I_E); it += NGW) {
        const int e = it / I_E; int r = it - e * I_E;
        if (r < 2 * I_G) { const int up = r / I_G; r -= up * I_G; const int kb = r / 56, nb = r % 56, n0 = 64 * nb;
            tr_item((up ? a->in[16] : a->in[15]) + (size_t)e * 1024 * FE, FE, 64 * kb, n0, (bf16*)(ws + WS_WMGU) + (size_t)e * 7168 * 1024, 1024, 256 * (n0 >> 7) + (n0 & 127) + 128 * up, scr, lane); }
        else { r -= 2 * I_G; const int kb = r / 16, nb = r % 16; tr_item(a->in[17] + (size_t)e * FE * 1024, 1024, 64 * kb, 64 * nb, (bf16*)(ws + WS_WMD) + (size_t)e * 1024 * FE, FE, 64 * nb, scr, lane, true); }
    }
}

__device__ __forceinline__ void conv_queue(KArgs a, LAS unsigned char* lds, int wave, int lane, int l) {
    unsigned char* ws = a->ws;
    LAS float* scr = (LAS float*)(lds + wave * TR_SCR);
    unsigned* head = (unsigned*)(ws + WS_CTL) + CW_WQ + 64 * l;
    constexpr int I_G = 16 * 56, I_D = 56 * 16, I_E = 2 * I_G + I_D;
    const int e_lo = (l == 0 ? 0 : 3), n_moe = (l == 0 ? 3 : 5) * I_E, n_all = n_moe + (l == 0 ? PRO_NIT - PRO_I_IN : 0);
    for (;;) {
        unsigned it0 = 0; if (lane == 0) it0 = __hip_atomic_fetch_add(head, 8u, RLX_AGENT);
        it0 = __builtin_amdgcn_readfirstlane(it0);
        if ((int)it0 >= n_all) break;
#pragma unroll 1
        for (int k = 0; k < 8; ++k) { const int it = (int)it0 + k; if (it >= n_all) break;
            if (it < n_moe) moe_convert(a, lds, wave, lane, 0, 1 << 30, 0, 0, e_lo * I_E + it);
            else ph_prologue(a, lds, wave, lane, 0, 1 << 30, 0, 0, PRO_I_IN + (it - n_moe), PRO_I_IN + (it - n_moe) + 1, false); }
    }
}

__device__ __forceinline__ void conv_range(KArgs a, LAS unsigned char* lds, int wave, int lane, int l, int lo, int hi, int gw, int NGW) {
    constexpr int I_G = 16 * 56, I_D = 56 * 16, I_E = 2 * I_G + I_D;
    const int n_moe = 4 * I_E;
    for (int it = lo + gw; it < hi; it += NGW) {
        if (it < n_moe) moe_convert(a, lds, wave, lane, 0, 1 << 30, 0, 0, 4 * l * I_E + it);
        else ph_prologue(a, lds, wave, lane, 0, 1 << 30, 0, 0, PRO_I_IN + (it - n_moe), PRO_I_IN + (it - n_moe) + 1, false);
    }
}
constexpr int CONV_N_MOE = 4 * (2 * 16 * 56 + 56 * 16);

template <bool ROUTE>
__device__ __forceinline__ void ln_rows(const float* res, float ares, const bf16* mix, const float* g, const float* bta, float* xf, float oscale, bf16* xb,
                                        const float* router, unsigned* cntw, int* list, float* gate, int lane, int gw, int NGW, LAS unsigned char* lds = nullptr, int tid = 0) {
    LAS unsigned* lcnt = (LAS unsigned*)lds; LAS unsigned* lbase = lcnt + 16; LAS unsigned* rec = lcnt + 32;
    int nrec = 0;
    if (ROUTE) { __syncthreads(); if (tid < 16) lcnt[tid] = 0u; __syncthreads(); }
    f32x4 gv[4], bv[4];
#pragma unroll
    for (int j = 0; j < 4; ++j) { gv[j] = ((const f32x4*)g)[lane + 64 * j]; bv[j] = ((const f32x4*)bta)[lane + 64 * j]; }
    f32x4 rn[4]; v2u mn[4];
#define LN_FETCH(r_) do { const f32x4* rr_ = (const f32x4*)(res + (size_t)(r_) * D) + lane; _Pragma("unroll") for (int j = 0; j < 4; ++j) rn[j] = rr_[64 * j]; \
        if (mix) { const v2u* mr_ = (const v2u*)(mix + (size_t)(r_) * D) + lane; _Pragma("unroll") for (int j = 0; j < 4; ++j) mn[j] = mr_[64 * j]; } } while (0)
#pragma unroll
    for (int j = 0; j < 4; ++j) { rn[j] = (f32x4){0.f, 0.f, 0.f, 0.f}; mn[j] = (v2u){0u, 0u}; }
    if (gw < M) LN_FETCH(gw);
    for (int row = gw; row < M; row += NGW) {
        f32x4 v[4]; float s = 0.f;
#pragma unroll
        for (int j = 0; j < 4; ++j) { v[j] = rn[j] * ares; if (mix) v[j] = v[j] + (f32x4){bflo(mn[j].x), bfhi(mn[j].x), bflo(mn[j].y), bfhi(mn[j].y)}; }
        if (row + NGW < M) LN_FETCH(row + NGW);
#pragma unroll
        for (int j = 0; j < 4; ++j) s += (v[j].x + v[j].y) + (v[j].z + v[j].w);
        const float mean = wave_sum(s) * (1.f / D); float s2 = 0.f;
#pragma unroll
        for (int j = 0; j < 4; ++j) { v[j] = v[j] - mean; s2 += (v[j].x * v[j].x + v[j].y * v[j].y) + (v[j].z * v[j].z + v[j].w * v[j].w); }
        const float rstd = 1.f / sqrtf(wave_sum(s2) * (1.f / D) + LN_EPS);
#pragma unroll
        for (int j = 0; j < 4; ++j) v[j] = v[j] * rstd * gv[j] + bv[j];
        f32x4* xo = (f32x4*)(xf + (size_t)row * D) + lane;
#pragma unroll
        for (int j = 0; j < 4; ++j) xo[64 * j] = v[j] * oscale;
        if (xb) { v2u* bo = (v2u*)(xb + (size_t)row * D) + lane;
#pragma unroll
            for (int j = 0; j < 4; ++j) { v2u o; o.x = pk2(v[j].x, v[j].y); o.y = pk2(v[j].z, v[j].w); bo[64 * j] = o; } }
        if (ROUTE) {
            float lg[8];
#pragma unroll
            for (int e = 0; e < 8; ++e) lg[e] = 0.f;
#pragma unroll
            for (int e = 0; e < 8; ++e)
#pragma unroll
                for (int j = 0; j < 4; ++j) { const f32x4 r4 = ((const f32x4*)(router + e * 1024))[lane + 64 * j]; lg[e] += (v[j].x * r4.x + v[j].y * r4.y) + (v[j].z * r4.z + v[j].w * r4.w); }
#pragma unroll
            for (int e = 0; e < 8; ++e) lg[e] = wave_sum(lg[e]);
            if (lane == 0) {
                int e0 = 0; float v0 = lg[0];
#pragma unroll
                for (int e = 1; e < 8; ++e) if (lg[e] > v0) { v0 = lg[e]; e0 = e; }
                int e1 = -1; float v1 = -3.0e38f;
#pragma unroll
                for (int e = 0; e < 8; ++e) if (e != e0 && lg[e] > v1) { v1 = lg[e]; e1 = e; }
                const float p1 = __expf(v1 - v0), g0 = 1.f / (1.f + p1), g1 = p1 / (1.f + p1);
                const int wv = (int)(tid >> 6), k = nrec++;
                const unsigned l0 = __hip_atomic_fetch_add(lcnt + e0, 1u, __ATOMIC_RELAXED, __HIP_MEMORY_SCOPE_WORKGROUP), l1 = __hip_atomic_fetch_add(lcnt + 8 + e1, 1u, __ATOMIC_RELAXED, __HIP_MEMORY_SCOPE_WORKGROUP);
                rec[(wv * 16 + k) * 4 + 0] = (unsigned)row; rec[(wv * 16 + k) * 4 + 1] = (unsigned)e0 | ((unsigned)e1 << 8); rec[(wv * 16 + k) * 4 + 2] = l0; rec[(wv * 16 + k) * 4 + 3] = l1;
                gate[row] = g0; gate[16384 + row] = g1;
            }
        }
    }
    if (ROUTE) {
        __syncthreads();
        if (tid < 16) { const unsigned c = lcnt[tid]; lbase[tid] = c ? __hip_atomic_fetch_add(cntw + 64 * tid, c, RLX_AGENT) : 0u; }
        __syncthreads();
        if (lane == 0) { const int wv = (int)(tid >> 6);
            for (int k = 0; k < nrec; ++k) { const unsigned row = rec[(wv * 16 + k) * 4], ee = rec[(wv * 16 + k) * 4 + 1], l0 = rec[(wv * 16 + k) * 4 + 2], l1 = rec[(wv * 16 + k) * 4 + 3];
                const unsigned e0 = ee & 255u, e1 = ee >> 8;
                list[(size_t)e0 * 16384 + lbase[e0] + l0] = (int)row; list[(size_t)(8 + e1) * 16384 + lbase[8 + e1] + l1] = (int)row; } }
    }
}

__device__ __forceinline__ void moe_gather(KArgs a, int j, int lane, int gw, int NGW) {
    unsigned char* ws = a->ws; const unsigned* cntw = (const unsigned*)(ws + WS_CTL) + CW_MOE + 64 * (j * 8);
    int pre[8], cum[8]; { int p = 0, t = 0;
#pragma unroll
        for (int e = 0; e < 8; ++e) { const int c = (int)cntw[64 * e]; pre[e] = p; cum[e] = t; p += c; t += (c + 255) >> 8; } }
    const int* list = (const int*)(ws + WS_LIST) + (size_t)j * 8 * 16384;
    for (int r0 = gw; r0 < M; r0 += 8 * NGW) {
        int tok[8], drow[8];
#pragma unroll
        for (int q = 0; q < 8; ++q) { const int r = r0 + q * NGW; tok[q] = -1; drow[q] = 0;
            if (r < M) { int e = 0;
#pragma unroll
                for (int k = 1; k < 8; ++k) e += (r >= pre[k]) ? 1 : 0;
                int pe = 0, ce = 0;
#pragma unroll
                for (int k = 0; k < 8; ++k) if (k == e) { pe = pre[k]; ce = cum[k]; }
                const int s = r - pe; tok[q] = list[(size_t)e * 16384 + s]; drow[q] = ce * 256 + s; } }
        v4u x0[8], x1[8];
#pragma unroll
        for (int q = 0; q < 8; ++q) { const v4u* src = (const v4u*)((const bf16*)(ws + WS_XB) + (size_t)(tok[q] >= 0 ? tok[q] : 0) * 1024); x0[q] = src[lane]; x1[q] = src[lane + 64]; }
#pragma unroll
        for (int q = 0; q < 8; ++q) if (tok[q] >= 0) { v4u* dst = (v4u*)((bf16*)(ws + WS_R + R_XG + (size_t)j * XG_PASS) + (size_t)drow[q] * 1024); dst[lane] = x0[q]; dst[lane + 64] = x1[q]; }
    }
}

__device__ __forceinline__ void gdn_prep_unit(KArgs a, int l, int unit, LAS unsigned char* lds, int tid, int lane, int wave) {
    unsigned char* ws = a->ws;
    const int n = unit & 31, bh = unit >> 5, h = bh & 3, b = bh >> 2;
    const int t0 = b * SEQ + n * 64;
    LAS float* Q = (LAS float*)lds; LAS float* K = Q + 8192; LAS float* V = K + 8192; LAS float* A = V + 8192; LAS float* gc = A + 4096; LAS float* bt = gc + 64;
    const bf16* HP = (const bf16*)(ws + WS_R + R_HP);
    const float* cw = a->in[2] + (size_t)l * 4 * 1536;
    __syncthreads();
    for (int idx = tid; idx < 64 * 384; idx += 512) { const int i = idx / 384, c = idx % 384, which = c >> 7, d = c & 127;
        const int col = COL_GQ + which * 512 + h * 128 + d, cc = which * 512 + h * 128 + d; float acc = 0.f;
#pragma unroll
        for (int j = 0; j < 4; ++j) { const int s = n * 64 + i - 3 + j; if (s >= 0) acc += cw[j * 1536 + cc] * bf2f(HP[(size_t)(b * SEQ + s) * HP_LD + col]); }
        const float y = siluf(acc); LAS float* dst = which == 0 ? Q : (which == 1 ? K : V); dst[i * 128 + d] = y; }
    if (tid < 64) { const float* gab = (const float*)(ws + WS_GAB) + (size_t)(t0 + tid) * 8; const float x = gab[h] + a->in[4][l * 4 + h];
        const float sp = fmaxf(x, 0.f) + log1pf(__expf(-fabsf(x))); gc[tid] = -__expf(a->in[3][l * 4 + h]) * sp; bt[tid] = sigmf(gab[4 + h]); }
    __syncthreads();
#pragma unroll 1
    for (int r = 0; r < 8; ++r) { const int i = wave * 8 + r;
        float q0 = Q[i * 128 + lane], q1 = Q[i * 128 + lane + 64], k0 = K[i * 128 + lane], k1 = K[i * 128 + lane + 64];
        const float sq = wave_sum(q0 * q0 + q1 * q1), sk = wave_sum(k0 * k0 + k1 * k1);
        const float fq = rsqrtf(sq + NORM_EPS) * 0.08838834764831845f, fk = rsqrtf(sk + NORM_EPS);
        Q[i * 128 + lane] = q0 * fq; Q[i * 128 + lane + 64] = q1 * fq; K[i * 128 + lane] = k0 * fk; K[i * 128 + lane + 64] = k1 * fk; }
    if (tid == 0) { float c = 0.f; for (int i = 0; i < 64; ++i) { c += gc[i]; gc[i] = c; } }
    __syncthreads();
    bf16* QKg = (bf16*)(ws + WS_R + R_QK) + (size_t)unit * 4096; bf16* QDg = (bf16*)(ws + WS_R + R_QD) + (size_t)unit * 8192; bf16* KDTg = (bf16*)(ws + WS_R + R_KDT) + (size_t)unit * 8192;
    bf16* WNg = (bf16*)(ws + WS_R + R_WN) + (size_t)unit * 8192; bf16* Ug = (bf16*)(ws + WS_R + R_U) + (size_t)unit * 8192;
    for (int idx = tid; idx < 4096; idx += 512) { const int i = idx >> 6, j = idx & 63; float dqk = 0.f, dkk = 0.f;
        for (int dd = 0; dd < 128; ++dd) { const int d = (dd + j) & 127; const float kj = K[j * 128 + d]; dqk += Q[i * 128 + d] * kj; dkk += K[i * 128 + d] * kj; }
        const float dec = __expf(gc[i] - gc[j]);
        A[i * 64 + j] = (j < i) ? bt[i] * dkk * dec : 0.f;
        QKg[fragoff(i, j, 2)] = (bf16)f2bf((j <= i) ? dqk * dec : 0.f); }
    const float gl = gc[63];
    for (int idx = tid; idx < 8192; idx += 512) { const int i = idx >> 7, d = idx & 127;
        QDg[fragoff(i, d, 4)] = (bf16)f2bf(Q[i * 128 + d] * __expf(gc[i]));
        KDTg[fragoff(d, i, 2)] = (bf16)f2bf(K[i * 128 + d] * __expf(gl - gc[i])); }
    if (tid == 0) ((float*)(ws + WS_CD))[unit] = __expf(gl);
    __syncthreads();
    for (int idx = tid; idx < 8192; idx += 512) { const int i = idx >> 7; const float bi = bt[i]; V[idx] *= bi; Q[idx] = bi * __expf(gc[i]) * K[idx]; }
    __syncthreads();
    if (tid < 256) { LAS float* buf = (tid < 128 ? V : Q) + (tid & 127);
        for (int i = 1; i < 64; ++i) { float acc = buf[i * 128]; for (int m = 0; m < i; ++m) acc -= A[i * 64 + m] * buf[m * 128]; buf[i * 128] = acc; } }
    __syncthreads();
    for (int idx = tid; idx < 8192; idx += 512) { const int i = idx >> 7, d = idx & 127; Ug[uoff(i, d)] = (bf16)f2bf(V[idx]); WNg[fragoff(i, d, 4)] = (bf16)f2bf(-Q[idx]); }
}

__device__ __forceinline__ void gdn_scan_naive(KArgs a, int l, int bh, LAS unsigned char* lds, int tid, int lane, int wave) {
    unsigned char* ws = a->ws;
    LAS float* S = (LAS float*)lds; LAS float* VN = S + 16384; LAS float* O = VN + 8192;
    const int h = bh & 3, b = bh >> 2, e = tid & 127, ig = tid >> 7;
    const bf16* HP = (const bf16*)(ws + WS_R + R_HP); bf16* OB = (bf16*)(ws + WS_R + R_OB);
    const float* nw = a->in[5] + l * 128;
    __syncthreads();
    for (int idx = tid; idx < 16384; idx += 512) S[idx] = 0.f;
    __syncthreads();
#pragma unroll 1
    for (int n = 0; n < 32; ++n) {
        const int unit = bh * 32 + n;
        const bf16* Ug = (const bf16*)(ws + WS_R + R_U) + (size_t)unit * 8192; const bf16* WNg = (const bf16*)(ws + WS_R + R_WN) + (size_t)unit * 8192;
        const bf16* QDg = (const bf16*)(ws + WS_R + R_QD) + (size_t)unit * 8192; const bf16* KDTg = (const bf16*)(ws + WS_R + R_KDT) + (size_t)unit * 8192;
        const bf16* QKg = (const bf16*)(ws + WS_R + R_QK) + (size_t)unit * 4096; const float cd = ((const float*)(ws + WS_CD))[unit];
#pragma unroll 1
        for (int r = 0; r < 16; ++r) { const int i = ig + 4 * r; float acc = bf2f(Ug[uoff(i, e)]);
#pragma unroll 2
            for (int d0 = 0; d0 < 128; d0 += 4) { const v2u w = *(const v2u*)(WNg + fragoff(i, d0, 4));
                acc += bflo(w.x) * S[d0 * 128 + e] + bfhi(w.x) * S[(d0 + 1) * 128 + e] + bflo(w.y) * S[(d0 + 2) * 128 + e] + bfhi(w.y) * S[(d0 + 3) * 128 + e]; }
            VN[i * 128 + e] = acc; }
        __syncthreads();
#pragma unroll 1
        for (int r = 0; r < 16; ++r) { const int i = ig + 4 * r; float acc = 0.f;
#pragma unroll 2
            for (int d0 = 0; d0 < 128; d0 += 4) { const v2u w = *(const v2u*)(QDg + fragoff(i, d0, 4));
                acc += bflo(w.x) * S[d0 * 128 + e] + bfhi(w.x) * S[(d0 + 1) * 128 + e] + bflo(w.y) * S[(d0 + 2) * 128 + e] + bfhi(w.y) * S[(d0 + 3) * 128 + e]; }
#pragma unroll 2
            for (int j0 = 0; j0 < 64; j0 += 4) { const v2u w = *(const v2u*)(QKg + fragoff(i, j0, 2));
                acc += bflo(w.x) * VN[j0 * 128 + e] + bfhi(w.x) * VN[(j0 + 1) * 128 + e] + bflo(w.y) * VN[(j0 + 2) * 128 + e] + bfhi(w.y) * VN[(j0 + 3) * 128 + e]; }
            O[i * 128 + e] = acc; }
        __syncthreads();
#pragma unroll 1
        for (int r = 0; r < 32; ++r) { const int d = ig + 4 * r; float acc = S[d * 128 + e] * cd;
#pragma unroll 2
            for (int i0 = 0; i0 < 64; i0 += 4) { const v2u w = *(const v2u*)(KDTg + fragoff(d, i0, 2));
                acc += bflo(w.x) * VN[i0 * 128 + e] + bfhi(w.x) * VN[(i0 + 1) * 128 + e] + bflo(w.y) * VN[(i0 + 2) * 128 + e] + bfhi(w.y) * VN[(i0 + 3) * 128 + e]; }
            S[d * 128 + e] = acc; }
#pragma unroll 1
        for (int r = 0; r < 8; ++r) { const int i = wave * 8 + r; const float v0 = O[i * 128 + lane], v1 = O[i * 128 + lane + 64];
            const float rs = rsqrtf(wave_sum(v0 * v0 + v1 * v1) * (1.f / 128.f) + NORM_EPS);
            const size_t t = (size_t)b * SEQ + n * 64 + i; const bf16* gp = HP + t * HP_LD + COL_GG + h * 128; bf16* op = OB + t * 1024 + 512 + h * 128;
            op[lane] = (bf16)f2bf(v0 * rs * nw[lane] * siluf(bf2f(gp[lane]))); op[lane + 64] = (bf16)f2bf(v1 * rs * nw[lane + 64] * siluf(bf2f(gp[lane + 64]))); }
        __syncthreads();
    }
}

__device__ __forceinline__ void ret_unit_naive(KArgs a, int unit, LAS unsigned char* lds, int tid, int lane, int wave) {
    unsigned char* ws = a->ws;
    LAS float* Qs = (LAS float*)lds; LAS float* Ks = Qs + 64 * 65; LAS float* Vs = Ks + 64 * 65; LAS float* Sc = Vs + 8192;
    const int qb = unit & 31, bh = unit >> 5, h = bh & 3, b = bh >> 2, e = tid & 127, ig = tid >> 7;
    const bf16* HP = (const bf16*)(ws + WS_R + R_HP); bf16* OB = (bf16*)(ws + WS_R + R_OB); const float* RT = (const float*)(ws + WS_ROPE);
    const float log2g = log2f(1.0f - exp2f(-5.0f - (float)h));
    __syncthreads();
    for (int idx = tid; idx < 4096; idx += 512) { const int i = idx >> 6, d = idx & 63, dd = d & 31, pos = qb * 64 + i; const size_t t = (size_t)b * SEQ + pos;
        const float c = RT[pos * 64 + dd], s = RT[pos * 64 + 32 + dd]; const float x1 = bf2f(HP[t * HP_LD + COL_RQ + h * 64 + dd]), x2 = bf2f(HP[t * HP_LD + COL_RQ + h * 64 + dd + 32]);
        Qs[i * 65 + d] = d < 32 ? x1 * c - x2 * s : x1 * s + x2 * c; }
    float acc[16];
#pragma unroll
    for (int r = 0; r < 16; ++r) acc[r] = 0.f;
#pragma unroll 1
    for (int kb = 0; kb <= qb; ++kb) {
        __syncthreads();
        for (int idx = tid; idx < 4096; idx += 512) { const int i = idx >> 6, d = idx & 63, dd = d & 31, pos = kb * 64 + i; const size_t t = (size_t)b * SEQ + pos;
            const float c = RT[pos * 64 + dd], s = RT[pos * 64 + 32 + dd]; const float x1 = bf2f(HP[t * HP_LD + COL_RK + h * 64 + dd]), x2 = bf2f(HP[t * HP_LD + COL_RK + h * 64 + dd + 32]);
            Ks[i * 65 + d] = 0.125f * (d < 32 ? x1 * c - x2 * s : x1 * s + x2 * c); }
        for (int idx = tid; idx < 8192; idx += 512) { const int i = idx >> 7, d = idx & 127; Vs[idx] = bf2f(HP[((size_t)b * SEQ + kb * 64 + i) * HP_LD + COL_RV + h * 128 + d]); }
        __syncthreads();
        { const int j = tid & 63, ig8 = tid >> 6;
#pragma unroll 1
          for (int r = 0; r < 8; ++r) { const int i = ig8 + 8 * r; float dot = 0.f;
#pragma unroll 8
              for (int d = 0; d < 64; ++d) dot += Qs[i * 65 + d] * Ks[j * 65 + d];
              const int delta = (qb - kb) * 64 + i - j; Sc[i * 65 + j] = delta >= 0 ? dot * exp2f((float)delta * log2g) : 0.f; } }
        __syncthreads();
#pragma unroll 2
        for (int j = 0; j < 64; ++j) { const float vv = Vs[j * 128 + e];
#pragma unroll
            for (int r = 0; r < 16; ++r) acc[r] += Sc[(ig + 4 * r) * 65 + j] * vv; }
    }
    __syncthreads();
#pragma unroll
    for (int r = 0; r < 16; ++r) Vs[(ig + 4 * r) * 128 + e] = acc[r];
    __syncthreads();
#pragma unroll 1
    for (int r = 0; r < 8; ++r) { const int i = wave * 8 + r; const float v0 = Vs[i * 128 + lane], v1 = Vs[i * 128 + lane + 64];
        const float mean = wave_sum(v0 + v1) * (1.f / 128.f), d0 = v0 - mean, d1 = v1 - mean; const float rs = rsqrtf(wave_sum(d0 * d0 + d1 * d1) * (1.f / 128.f) + LN_EPS);
        const size_t t = (size_t)b * SEQ + qb * 64 + i; const bf16* gp = HP + t * HP_LD + COL_RG + h * 128; bf16* op = OB + t * 1024 + h * 128;
        op[lane] = (bf16)f2bf(d0 * rs * siluf(bf2f(gp[lane]))); op[lane + 64] = (bf16)f2bf(d1 * rs * siluf(bf2f(gp[lane + 64]))); }
}

typedef float f32x16 __attribute__((ext_vector_type(16)));
typedef float f32x8 __attribute__((ext_vector_type(8)));
typedef __bf16 bf8v __attribute__((ext_vector_type(8)));
typedef short bf16x8 __attribute__((ext_vector_type(8)));
#define MFMA32(a, b, c) __builtin_amdgcn_mfma_f32_32x32x16_bf16((a), (b), (c), 0, 0, 0)
__device__ __forceinline__ bf16x8 pack8(const f32x16& x, int s) {
    f32x8 v;
#pragma unroll
    for (int j = 0; j < 8; ++j) v[j] = x[8 * s + j];
    return __builtin_bit_cast(bf16x8, __builtin_convertvector(v, bf8v));
}

__device__ __forceinline__ unsigned short bfc(float x) { return __builtin_bit_cast(unsigned short, (__bf16)x); }
__device__ __forceinline__ unsigned bfc2(float lo, float hi) { return (unsigned)bfc(lo) | ((unsigned)bfc(hi) << 16); }

#ifndef PROBE_UNIT
#define PROBE_UNIT 0
#endif
#if defined(PROBE_MULT) && PROBE_MULT > 0
#define STAMPT(id, thr) do { if (blockIdx.x == PROBE_BID && threadIdx.x == (thr)) __hip_atomic_store((unsigned long long*)(a->ws + WS_CTL + 131072) + (id), (unsigned long long)__builtin_amdgcn_s_memrealtime(), RLX_AGENT); } while (0)
#else
#define STAMPT(id, thr) do {} while (0)
#endif
#ifndef GDN_F8
#define GDN_F8 0
#endif
constexpr float F8_SW = 4.f, F8_SQ = 16.f, F8_SK = 4.f;
#define MFMA8(a, b, c) __builtin_amdgcn_mfma_f32_32x32x16_fp8_fp8((a), (b), (c), 0, 0, 0)
__device__ __forceinline__ unsigned f8x4(float a, float b, float c, float d) { int w = __builtin_amdgcn_cvt_pk_fp8_f32(a, b, 0, false); w = __builtin_amdgcn_cvt_pk_fp8_f32(c, d, w, true); return (unsigned)w; }
__device__ __forceinline__ long pack8_f8(const f32x16& x, int s, float sc) {
    const unsigned lo = f8x4(x[8 * s] * sc, x[8 * s + 1] * sc, x[8 * s + 2] * sc, x[8 * s + 3] * sc), hi = f8x4(x[8 * s + 4] * sc, x[8 * s + 5] * sc, x[8 * s + 6] * sc, x[8 * s + 7] * sc);
    return (long)(((unsigned long)hi << 32) | (unsigned long)lo);
}
#define GDN_BAR() do { asm volatile("s_waitcnt lgkmcnt(0)" ::: "memory"); __builtin_amdgcn_s_barrier(); asm volatile("" ::: "memory"); } while (0)
__device__ __forceinline__ void gdn_scan_fast(KArgs a, int l, int bh, LAS unsigned char* lds, int tid, int lane, int wave) {
    unsigned char* ws = a->ws;
#if GDN_F8
    constexpr int FB_WN = 0, FB_QD = 8192, FB_KDT = 16384, FB_QK = 24576, FB_U = 28672, FB_BYTES = 45056, NPC = 11, OPB = 8192;
#else
    constexpr int FB_WN = 0, FB_QD = 16384, FB_KDT = 32768, FB_QK = 49152, FB_U = 57344, FB_BYTES = 73728, NPC = 18, OPB = 16384;
#endif
    LAS float* OL = (LAS float*)(lds + FB_BYTES);
    constexpr int OLS = 64 * 132;
    const int h = bh & 3, b = bh >> 2, c = lane & 31, hh = lane >> 5;
    const bf16* HP = (const bf16*)(ws + WS_R + R_HP); bf16* OB = (bf16*)(ws + WS_R + R_OB);
    const float* nw = a->in[5] + l * 128;
    const unsigned char* gWN = (const unsigned char*)(ws + WS_R + R_WN) + (size_t)bh * 32 * OPB; const unsigned char* gQD = (const unsigned char*)(ws + WS_R + R_QD) + (size_t)bh * 32 * OPB;
    const unsigned char* gKDT = (const unsigned char*)(ws + WS_R + R_KDT) + (size_t)bh * 32 * OPB; const unsigned char* gQK = (const unsigned char*)(ws + WS_R + R_QK) + (size_t)bh * 32 * (OPB / 2);
    const unsigned char* gU = (const unsigned char*)(ws + WS_R + R_U) + (size_t)bh * 32 * 16384;
    const int et = tid - 256;
#define GDN_FETCH(pf, nn) do { constexpr int P4 = OPB / 4096; _Pragma("unroll") for (int k = 0; k < NPC; ++k) { const unsigned char* src_ = k < P4 ? gWN + (size_t)(nn) * OPB + k * 4096 : k < 2 * P4 ? gQD + (size_t)(nn) * OPB + (k - P4) * 4096 : \
        k < 3 * P4 ? gKDT + (size_t)(nn) * OPB + (k - 2 * P4) * 4096 : k < 3 * P4 + P4 / 2 ? gQK + (size_t)(nn) * (OPB / 2) + (k - 3 * P4) * 4096 : gU + (size_t)(nn) * 16384 + (k - 3 * P4 - P4 / 2) * 4096; pf[k] = *(const v4u*)(src_ + et * 16); } } while (0)
#define GDN_STORE(pf) do { _Pragma("unroll") for (int k = 0; k < NPC; ++k) *(LAS v4u*)(lds + k * 4096 + et * 16) = pf[k]; } while (0)
    __syncthreads();
    if (wave < 4) {
        f32x16 S[4];
#pragma unroll
        for (int t = 0; t < 4; ++t)
#pragma unroll
            for (int i = 0; i < 16; ++i) S[t][i] = 0.f;
        GDN_BAR();
#if GDN_F8
        const int q = wave;
        const LAS long* WNf = (const LAS long*)(lds + FB_WN) + lane; const LAS long* QDf = (const LAS long*)(lds + FB_QD) + lane;
        const LAS long* KDTf = (const LAS long*)(lds + FB_KDT) + lane; const LAS long* QKf = (const LAS long*)(lds + FB_QK) + lane;
        const LAS v4u* Uf = (const LAS v4u*)(lds + FB_U) + (q * 2) * 128 + lane;
#pragma unroll 1
        for (int n = 0; n < 32; ++n) {
            const float cd = ((const float*)(ws + WS_CD))[bh * 32 + n];
            long A0[8], A1[8];
#define GDN_LD_MTS(A, F, g) do { _Pragma("unroll") for (int k = 0; k < 8; ++k) { const int m_ = k & 1, s_ = (k >> 1) & 1, t_ = 2 * (g) + (k >> 2); A[k] = F[((m_ * 4 + t_) * 2 + s_) * 64]; } } while (0)
#define GDN_LD_TMS(A, F, g) do { _Pragma("unroll") for (int k = 0; k < 8; ++k) { const int s_ = k & 1, m_ = (k >> 1) & 1, t_ = 2 * (g) + (k >> 2); A[k] = F[((t_ * 2 + m_) * 2 + s_) * 64]; } } while (0)
            GDN_LD_MTS(A0, WNf, 0); GDN_LD_MTS(A1, WNf, 1);
            f32x16 av[2];
#pragma unroll
            for (int m = 0; m < 2; ++m)
#pragma unroll
                for (int hf = 0; hf < 2; ++hf) { const v4u u4 = Uf[(m * 2 + hf) * 64];
#pragma unroll
                    for (int k = 0; k < 4; ++k) { av[m][8 * hf + 2 * k] = bflo(u4[k]) * F8_SW; av[m][8 * hf + 2 * k + 1] = bfhi(u4[k]) * F8_SW; } }
            long Sb[4][2];
#pragma unroll
            for (int t = 0; t < 4; ++t) { Sb[t][0] = pack8_f8(S[t], 0, 1.f / F8_SK); Sb[t][1] = pack8_f8(S[t], 1, 1.f / F8_SK); }
#pragma unroll
            for (int k = 0; k < 8; ++k) { const int m_ = k & 1, s_ = (k >> 1) & 1, t_ = (k >> 2); av[m_] = MFMA8(A0[k], Sb[t_][s_], av[m_]); }
            GDN_LD_MTS(A0, QDf, 0);
#pragma unroll
            for (int k = 0; k < 8; ++k) { const int m_ = k & 1, s_ = (k >> 1) & 1, t_ = 2 + (k >> 2); av[m_] = MFMA8(A1[k], Sb[t_][s_], av[m_]); }
            GDN_LD_MTS(A1, QDf, 1);
            f32x16 ao[2];
#pragma unroll
            for (int m = 0; m < 2; ++m)
#pragma unroll
                for (int i = 0; i < 16; ++i) ao[m][i] = 0.f;
#pragma unroll
            for (int k = 0; k < 8; ++k) { const int m_ = k & 1, s_ = (k >> 1) & 1, t_ = (k >> 2); ao[m_] = MFMA8(A0[k], Sb[t_][s_], ao[m_]); }
#pragma unroll
            for (int k = 0; k < 6; ++k) { const int s_ = k & 1, m_ = k >= 2 ? 1 : 0, mp_ = k >= 4 ? 1 : 0; A0[k] = QKf[((m_ * 2 + mp_) * 2 + s_) * 64]; }
#pragma unroll
            for (int k = 0; k < 8; ++k) { const int m_ = k & 1, s_ = (k >> 1) & 1, t_ = 2 + (k >> 2); ao[m_] = MFMA8(A1[k], Sb[t_][s_], ao[m_]); }
            GDN_LD_TMS(A1, KDTf, 0);
            long Vb[2][2];
#pragma unroll
            for (int m = 0; m < 2; ++m) { Vb[m][0] = pack8_f8(av[m], 0, 1.f / F8_SW); Vb[m][1] = pack8_f8(av[m], 1, 1.f / F8_SW); }
#pragma unroll
            for (int k = 0; k < 6; ++k) { const int s_ = k & 1, m_ = k >= 2 ? 1 : 0, mp_ = k >= 4 ? 1 : 0; ao[m_] = MFMA8(A0[k], Vb[mp_][s_], ao[m_]); }
            GDN_LD_TMS(A0, KDTf, 1);
            {   LAS float* Ob = OL + (n & 1) * OLS + 32 * wave + c;
#pragma unroll
                for (int m = 0; m < 2; ++m)
#pragma unroll
                    for (int i = 0; i < 16; ++i) Ob[(32 * m + (i & 3) + 8 * (i >> 2) + 4 * hh) * 132] = ao[m][i] * (1.f / F8_SQ); }
#pragma unroll
            for (int t = 0; t < 4; ++t)
#pragma unroll
                for (int i = 0; i < 16; ++i) S[t][i] *= cd;
#pragma unroll
            for (int k = 0; k < 8; ++k) { const int s_ = k & 1, m_ = (k >> 1) & 1, t_ = (k >> 2); S[t_] = MFMA8(A1[k], Vb[m_][s_], S[t_]); }
#pragma unroll
            for (int k = 0; k < 8; ++k) { const int s_ = k & 1, m_ = (k >> 1) & 1, t_ = 2 + (k >> 2); S[t_] = MFMA8(A0[k], Vb[m_][s_], S[t_]); }
#undef GDN_LD_MTS
#undef GDN_LD_TMS
            GDN_BAR();
            GDN_BAR();
        }
#else
        const int q = wave;
        const LAS bf16x8* WNf = (const LAS bf16x8*)(lds + FB_WN) + lane; const LAS bf16x8* QDf = (const LAS bf16x8*)(lds + FB_QD) + lane;
        const LAS bf16x8* KDTf = (const LAS bf16x8*)(lds + FB_KDT) + lane; const LAS bf16x8* QKf = (const LAS bf16x8*)(lds + FB_QK) + lane;
        const LAS v4u* Uf = (const LAS v4u*)(lds + FB_U) + (q * 2) * 128 + lane;
#pragma unroll 1
        for (int n = 0; n < 32; ++n) {
            if (n == 10) STAMPT(110, 0);
            const float cd = ((const float*)(ws + WS_CD))[bh * 32 + n];
            bf16x8 A0[8], A1[8];
#define GDN_LD_MTS(A, F, g) do { _Pragma("unroll") for (int k = 0; k < 8; ++k) { const int m_ = k & 1, s_ = (k >> 1) & 1, t_ = 2 * (g) + (k >> 2); A[k] = F[((m_ * 4 + t_) * 2 + s_) * 64]; } } while (0)
#define GDN_LD_TMS(A, F, g) do { _Pragma("unroll") for (int k = 0; k < 8; ++k) { const int s_ = k & 1, m_ = (k >> 1) & 1, t_ = 2 * (g) + (k >> 2); A[k] = F[((t_ * 2 + m_) * 2 + s_) * 64]; } } while (0)
            GDN_LD_MTS(A0, WNf, 0); GDN_LD_MTS(A1, WNf, 1);
            f32x16 av[2];
#pragma unroll
            for (int m = 0; m < 2; ++m)
#pragma unroll
                for (int hf = 0; hf < 2; ++hf) { const v4u u4 = Uf[(m * 2 + hf) * 64];
#pragma unroll
                    for (int k = 0; k < 4; ++k) { av[m][8 * hf + 2 * k] = bflo(u4[k]); av[m][8 * hf + 2 * k + 1] = bfhi(u4[k]); } }
            bf16x8 Sb[4][2];
#pragma unroll
            for (int t = 0; t < 4; ++t) { Sb[t][0] = pack8(S[t], 0); Sb[t][1] = pack8(S[t], 1); }
#pragma unroll
            for (int k = 0; k < 8; ++k) { const int m_ = k & 1, s_ = (k >> 1) & 1, t_ = (k >> 2); av[m_] = MFMA32(A0[k], Sb[t_][s_], av[m_]); }
            GDN_LD_MTS(A0, QDf, 0);
#pragma unroll
            for (int k = 0; k < 8; ++k) { const int m_ = k & 1, s_ = (k >> 1) & 1, t_ = 2 + (k >> 2); av[m_] = MFMA32(A1[k], Sb[t_][s_], av[m_]); }
            GDN_LD_MTS(A1, QDf, 1);
            f32x16 ao[2];
#pragma unroll
            for (int m = 0; m < 2; ++m)
#pragma unroll
                for (int i = 0; i < 16; ++i) ao[m][i] = 0.f;
#pragma unroll
            for (int k = 0; k < 8; ++k) { const int m_ = k & 1, s_ = (k >> 1) & 1, t_ = (k >> 2); ao[m_] = MFMA32(A0[k], Sb[t_][s_], ao[m_]); }
#pragma unroll
            for (int k = 0; k < 6; ++k) { const int s_ = k & 1, m_ = k >= 2 ? 1 : 0, mp_ = k >= 4 ? 1 : 0; A0[k] = QKf[((m_ * 2 + mp_) * 2 + s_) * 64]; }
#pragma unroll
            for (int k = 0; k < 8; ++k) { const int m_ = k & 1, s_ = (k >> 1) & 1, t_ = 2 + (k >> 2); ao[m_] = MFMA32(A1[k], Sb[t_][s_], ao[m_]); }
            GDN_LD_TMS(A1, KDTf, 0);
            bf16x8 Vb[2][2];
#pragma unroll
            for (int m = 0; m < 2; ++m) { Vb[m][0] = pack8(av[m], 0); Vb[m][1] = pack8(av[m], 1); }
#pragma unroll
            for (int k = 0; k < 6; ++k) { const int s_ = k & 1, m_ = k >= 2 ? 1 : 0, mp_ = k >= 4 ? 1 : 0; ao[m_] = MFMA32(A0[k], Vb[mp_][s_], ao[m_]); }
            GDN_LD_TMS(A0, KDTf, 1);
            {   LAS float* Ob = OL + (n & 1) * OLS + 32 * wave + c;
#pragma unroll
                for (int m = 0; m < 2; ++m)
#pragma unroll
                    for (int i = 0; i < 16; ++i) Ob[(32 * m + (i & 3) + 8 * (i >> 2) + 4 * hh) * 132] = ao[m][i]; }
#pragma unroll
            for (int t = 0; t < 4; ++t)
#pragma unroll
                for (int i = 0; i < 16; ++i) S[t][i] *= cd;
#pragma unroll
            for (int k = 0; k < 8; ++k) { const int s_ = k & 1, m_ = (k >> 1) & 1, t_ = (k >> 2); S[t_] = MFMA32(A1[k], Vb[m_][s_], S[t_]); }
#pragma unroll
            for (int k = 0; k < 8; ++k) { const int s_ = k & 1, m_ = (k >> 1) & 1, t_ = 2 + (k >> 2); S[t_] = MFMA32(A0[k], Vb[m_][s_], S[t_]); }
#undef GDN_LD_MTS
#undef GDN_LD_TMS
            if (n == 10) STAMPT(111, 0);
            GDN_BAR();
            if (n == 10) STAMPT(112, 0);
            GDN_BAR();
            if (n == 10) STAMPT(113, 0);
        }
#endif
        GDN_BAR(); GDN_BAR();
    } else {
        v4u pfA[NPC], pfB[NPC];
        LAS float* NWl = OL + 2 * OLS;
        if (et < 128) NWl[et] = nw[et];
        GDN_FETCH(pfB, 0); GDN_FETCH(pfA, 1); GDN_STORE(pfB);
        GDN_BAR();
        const int i = et >> 2, qd = et & 3;
#define GDN_LOADER_ITER(n, PF_FETCH, PF_STORE) do { \
            if ((n) == 10) STAMPT(120, 256); \
            if ((n) + 2 < 32) GDN_FETCH(PF_FETCH, (n) + 2); \
            if ((n) > 0) { \
                const LAS float* Ob = OL + (((n) - 1) & 1) * OLS + i * 132 + 32 * qd; \
                float ss = 0.f; \
                _Pragma("unroll") for (int k = 0; k < 8; ++k) { const f32x4 v_ = *(const LAS f32x4*)(Ob + 4 * k); ss += (v_.x * v_.x + v_.y * v_.y) + (v_.z * v_.z + v_.w * v_.w); } \
                ss += __shfl_xor(ss, 1); ss += __shfl_xor(ss, 2); \
                const float rs = rsqrtf(ss * (1.f / 128.f) + NORM_EPS); \
                bf16* op = OB + ((size_t)b * SEQ + ((n) - 1) * 64 + i) * 1024 + 512 + h * 128 + 32 * qd; \
                _Pragma("unroll") for (int k = 0; k < 4; ++k) { const f32x4 w0 = *(const LAS f32x4*)(NWl + 32 * qd + 8 * k), w1 = *(const LAS f32x4*)(NWl + 32 * qd + 8 * k + 4); const v4u gg = gq[k]; \
                    const f32x4 a0 = *(const LAS f32x4*)(Ob + 8 * k), a1 = *(const LAS f32x4*)(Ob + 8 * k + 4); \
                    v4u o; o.x = bfc2(a0.x * rs * w0.x * siluf(bflo(gg.x)), a0.y * rs * w0.y * siluf(bfhi(gg.x))); o.y = bfc2(a0.z * rs * w0.z * siluf(bflo(gg.y)), a0.w * rs * w0.w * siluf(bfhi(gg.y))); \
                    o.z = bfc2(a1.x * rs * w1.x * siluf(bflo(gg.z)), a1.y * rs * w1.y * siluf(bfhi(gg.z))); o.w = bfc2(a1.z * rs * w1.z * siluf(bflo(gg.w)), a1.w * rs * w1.w * siluf(bfhi(gg.w))); \
                    *(v4u*)(op + 8 * k) = o; } \
            } \
            asm volatile("" ::: "memory"); \
            if ((n) < 32) { const bf16* gp = HP + ((size_t)b * SEQ + (n) * 64 + i) * HP_LD + COL_GG + h * 128 + 32 * qd;     \
                _Pragma("unroll") for (int k = 0; k < 4; ++k) gq[k] = *(const v4u*)(gp + 8 * k); } \
            if ((n) == 10) STAMPT(121, 256); \
            GDN_BAR();            \
            if ((n) == 10) STAMPT(122, 256); \
            if ((n) + 1 < 32) GDN_STORE(PF_STORE); \
            if ((n) == 10) STAMPT(123, 256); \
            GDN_BAR();            \
            if ((n) == 10) STAMPT(124, 256); \
        } while (0)
        v4u gq[4];
#pragma unroll
        for (int k = 0; k < 4; ++k) gq[k] = (v4u){0u, 0u, 0u, 0u};
#pragma unroll
        for (int n = 0; n < 32; n += 2) {
            GDN_LOADER_ITER(n, pfB, pfA);
            GDN_LOADER_ITER(n + 1, pfA, pfB);
        }
        GDN_LOADER_ITER(32, pfB, pfA);
#undef GDN_LOADER_ITER
    }
#undef GDN_FETCH
#undef GDN_STORE
}

__device__ __forceinline__ void gdn_scan_helper(KArgs a, int bh, int tid) {
    unsigned char* ws = a->ws;
    const unsigned char* gWN = (const unsigned char*)(ws + WS_R + R_WN) + (size_t)bh * 32 * 16384; const unsigned char* gQD = (const unsigned char*)(ws + WS_R + R_QD) + (size_t)bh * 32 * 16384;
    const unsigned char* gKDT = (const unsigned char*)(ws + WS_R + R_KDT) + (size_t)bh * 32 * 16384; const unsigned char* gQK = (const unsigned char*)(ws + WS_R + R_QK) + (size_t)bh * 32 * 8192;
    const unsigned char* gU = (const unsigned char*)(ws + WS_R + R_U) + (size_t)bh * 32 * 16384;
#pragma unroll 1
    for (int n = 0; n < 32; ++n) {
        v4u pf[9];
#pragma unroll
        for (int k = 0; k < 9; ++k) { const int kk = 2 * k + (tid >> 8), et = tid & 255;
            const unsigned char* src_ = kk < 4 ? gWN + (size_t)n * 16384 + kk * 4096 : kk < 8 ? gQD + (size_t)n * 16384 + (kk - 4) * 4096 :
                kk < 12 ? gKDT + (size_t)n * 16384 + (kk - 8) * 4096 : kk < 14 ? gQK + (size_t)n * 8192 + (kk - 12) * 4096 : gU + (size_t)n * 16384 + (kk - 14) * 4096;
            pf[k] = *(const v4u*)(src_ + et * 16); }
#pragma unroll
        for (int k = 0; k < 9; ++k) asm volatile("" :: "v"(pf[k]));
    }
}

__device__ __forceinline__ void gdn_scan_v3(KArgs a, int l, int bhq, LAS unsigned char* lds, int tid, int lane, int wave) {
    unsigned char* ws = a->ws;
    constexpr int FB_WN = 0, FB_QD = 16384, FB_KDT = 32768, FB_QK = 49152, FB_U = 57344, IMG = 61440;
    constexpr int OLS = 64 * 36;
    LAS float* OL = (LAS float*)(lds + 2 * IMG);
    const int bh = bhq >> 2, q = bhq & 3, h = bh & 3, b = bh >> 2, c = lane & 31, hh = lane >> 5;
    bf16* OB = (bf16*)(ws + WS_R + R_OB); float* SSQ = (float*)(ws + WS_SSQ);
    const unsigned char* gWN = (const unsigned char*)(ws + WS_R + R_WN) + (size_t)bh * 32 * 16384; const unsigned char* gQD = (const unsigned char*)(ws + WS_R + R_QD) + (size_t)bh * 32 * 16384;
    const unsigned char* gKDT = (const unsigned char*)(ws + WS_R + R_KDT) + (size_t)bh * 32 * 16384; const unsigned char* gQK = (const unsigned char*)(ws + WS_R + R_QK) + (size_t)bh * 32 * 8192;
    const unsigned char* gU = (const unsigned char*)(ws + WS_R + R_U) + (size_t)bh * 32 * 16384 + q * 4096;
    const int et = tid - 256;
#define G3_FETCH(pf, nn) do { _Pragma("unroll") for (int k = 0; k < 15; ++k) { const unsigned char* src_ = k < 4 ? gWN + (size_t)(nn) * 16384 + k * 4096 : k < 8 ? gQD + (size_t)(nn) * 16384 + (k - 4) * 4096 : \
        k < 12 ? gKDT + (size_t)(nn) * 16384 + (k - 8) * 4096 : k < 14 ? gQK + (size_t)(nn) * 8192 + (k - 12) * 4096 : gU + (size_t)(nn) * 16384; pf[k] = *(const v4u*)(src_ + et * 16); } } while (0)
#define G3_STORE(pf, buf) do { _Pragma("unroll") for (int k = 0; k < 15; ++k) *(LAS v4u*)(lds + (buf) * IMG + k * 4096 + et * 16) = pf[k]; } while (0)
    __syncthreads();
    if (wave == 0) {
        f32x16 S[4];
#pragma unroll
        for (int t = 0; t < 4; ++t)
#pragma unroll
            for (int i = 0; i < 16; ++i) S[t][i] = 0.f;
        GDN_BAR();
#pragma unroll 1
        for (int n = 0; n < 32; ++n) {
            const LAS unsigned char* img = lds + (n & 1) * IMG;
            const LAS bf16x8* WNf = (const LAS bf16x8*)(img + FB_WN) + lane; const LAS bf16x8* QDf = (const LAS bf16x8*)(img + FB_QD) + lane;
            const LAS bf16x8* KDTf = (const LAS bf16x8*)(img + FB_KDT) + lane; const LAS bf16x8* QKf = (const LAS bf16x8*)(img + FB_QK) + lane;
            const LAS v4u* Uf = (const LAS v4u*)(img + FB_U) + lane;
            const float cd = ((const float*)(ws + WS_CD))[bh * 32 + n];
            bf16x8 A0[8], A1[8];
#define G3_LD_MTS(A, F, g) do { _Pragma("unroll") for (int k = 0; k < 8; ++k) { const int m_ = k & 1, s_ = (k >> 1) & 1, t_ = 2 * (g) + (k >> 2); A[k] = F[((m_ * 4 + t_) * 2 + s_) * 64]; } } while (0)
#define G3_LD_TMS(A, F, g) do { _Pragma("unroll") for (int k = 0; k < 8; ++k) { const int s_ = k & 1, m_ = (k >> 1) & 1, t_ = 2 * (g) + (k >> 2); A[k] = F[((t_ * 2 + m_) * 2 + s_) * 64]; } } while (0)
            G3_LD_MTS(A0, WNf, 0); G3_LD_MTS(A1, WNf, 1);
            f32x16 av[2];
#pragma unroll
            for (int m = 0; m < 2; ++m)
#pragma unroll
                for (int hf = 0; hf < 2; ++hf) { const v4u u4 = Uf[(m * 2 + hf) * 64];
#pragma unroll
                    for (int k = 0; k < 4; ++k) { av[m][8 * hf + 2 * k] = bflo(u4[k]); av[m][8 * hf + 2 * k + 1] = bfhi(u4[k]); } }
            bf16x8 Sb[4][2];
#pragma unroll
            for (int t = 0; t < 4; ++t) { Sb[t][0] = pack8(S[t], 0); Sb[t][1] = pack8(S[t], 1); }
#pragma unroll
            for (int k = 0; k < 8; ++k) { const int m_ = k & 1, s_ = (k >> 1) & 1, t_ = (k >> 2); av[m_] = MFMA32(A0[k], Sb[t_][s_], av[m_]); }
            G3_LD_MTS(A0, QDf, 0);
#pragma unroll
            for (int k = 0; k < 8; ++k) { const int m_ = k & 1, s_ = (k >> 1) & 1, t_ = 2 + (k >> 2); av[m_] = MFMA32(A1[k], Sb[t_][s_], av[m_]); }
            G3_LD_MTS(A1, QDf, 1);
            f32x16 ao[2];
#pragma unroll
            for (int m = 0; m < 2; ++m)
#pragma unroll
                for (int i = 0; i < 16; ++i) ao[m][i] = 0.f;
#pragma unroll
            for (int k = 0; k < 8; ++k) { const int m_ = k & 1, s_ = (k >> 1) & 1, t_ = (k >> 2); ao[m_] = MFMA32(A0[k], Sb[t_][s_], ao[m_]); }
#pragma unroll
            for (int k = 0; k < 6; ++k) { const int s_ = k & 1, m_ = k >= 2 ? 1 : 0, mp_ = k >= 4 ? 1 : 0; A0[k] = QKf[((m_ * 2 + mp_) * 2 + s_) * 64]; }
#pragma unroll
            for (int k = 0; k < 8; ++k) { const int m_ = k & 1, s_ = (k >> 1) & 1, t_ = 2 + (k >> 2); ao[m_] = MFMA32(A1[k], Sb[t_][s_], ao[m_]); }
            G3_LD_TMS(A1, KDTf, 0);
            bf16x8 Vb[2][2];
#pragma unroll
            for (int m = 0; m < 2; ++m) { Vb[m][0] = pack8(av[m], 0); Vb[m][1] = pack8(av[m], 1); }
#pragma unroll
            for (int k = 0; k < 6; ++k) { const int s_ = k & 1, m_ = k >= 2 ? 1 : 0, mp_ = k >= 4 ? 1 : 0; ao[m_] = MFMA32(A0[k], Vb[mp_][s_], ao[m_]); }
            G3_LD_TMS(A0, KDTf, 1);
            {   LAS float* Ob = OL + (n & 1) * OLS + c;
#pragma unroll
                for (int m = 0; m < 2; ++m)
#pragma unroll
                    for (int i = 0; i < 16; ++i) Ob[(32 * m + (i & 3) + 8 * (i >> 2) + 4 * hh) * 36] = ao[m][i]; }
#pragma unroll
            for (int t = 0; t < 4; ++t)
#pragma unroll
                for (int i = 0; i < 16; ++i) S[t][i] *= cd;
#pragma unroll
            for (int k = 0; k < 8; ++k) { const int s_ = k & 1, m_ = (k >> 1) & 1, t_ = (k >> 2); S[t_] = MFMA32(A1[k], Vb[m_][s_], S[t_]); }
#pragma unroll
            for (int k = 0; k < 8; ++k) { const int s_ = k & 1, m_ = (k >> 1) & 1, t_ = 2 + (k >> 2); S[t_] = MFMA32(A0[k], Vb[m_][s_], S[t_]); }
#undef G3_LD_MTS
#undef G3_LD_TMS
            GDN_BAR();
        }
    } else if (wave >= 4) {
        v4u pfE[15], pfO[15];
        G3_FETCH(pfE, 0); G3_FETCH(pfO, 1); G3_STORE(pfE, 0);
        GDN_BAR();
        const int i = et >> 2, p = et & 3;
#define G3_OUT(m) do { const LAS float* Ob = OL + ((m) & 1) * OLS + i * 36 + 8 * p; const f32x4 o0 = *(const LAS f32x4*)Ob, o1 = *(const LAS f32x4*)(Ob + 4); \
            float ss = (o0.x * o0.x + o0.y * o0.y) + (o0.z * o0.z + o0.w * o0.w) + (o1.x * o1.x + o1.y * o1.y) + (o1.z * o1.z + o1.w * o1.w); \
            ss += __shfl_xor(ss, 1); ss += __shfl_xor(ss, 2); \
            const size_t t_ = (size_t)b * SEQ + (m) * 64 + i; \
            v4u w_; w_.x = bfc2(o0.x, o0.y); w_.y = bfc2(o0.z, o0.w); w_.z = bfc2(o1.x, o1.y); w_.w = bfc2(o1.z, o1.w); \
            *(v4u*)(OB + t_ * 1024 + 512 + h * 128 + 32 * q + 8 * p) = w_; \
            if (p == 0) SSQ[(t_ * 4 + h) * 4 + q] = ss; } while (0)
#define G3_LOADER_ITER(n, PF_FETCH, PF_STORE) do { \
            if ((n) + 2 < 32) G3_FETCH(PF_FETCH, (n) + 2); \
            if ((n) > 0) G3_OUT((n) - 1); \
            if ((n) + 1 < 32) G3_STORE(PF_STORE, ((n) + 1) & 1); \
            GDN_BAR(); \
        } while (0)
#pragma unroll
        for (int n = 0; n < 32; n += 2) {
            G3_LOADER_ITER(n, pfE, pfO);
            G3_LOADER_ITER(n + 1, pfO, pfE);
        }
        G3_OUT(31);
#undef G3_LOADER_ITER
#undef G3_OUT
    } else {
        GDN_BAR();
#pragma unroll 1
        for (int n = 0; n < 32; ++n) GDN_BAR();
    }
#undef G3_FETCH
#undef G3_STORE
}
__device__ __forceinline__ void gdn_finalize(KArgs a, int l, int lane, int gw, int NGW) {
    unsigned char* ws = a->ws;
    const bf16* HP = (const bf16*)(ws + WS_R + R_HP); bf16* OB = (bf16*)(ws + WS_R + R_OB); const float* SSQ = (const float*)(ws + WS_SSQ);
    const int hd = lane >> 4, cb = (lane & 15) * 8;
    const float* nw = a->in[5] + l * 128 + cb;
    const f32x4 w0 = *(const f32x4*)nw, w1 = *(const f32x4*)(nw + 4);
    for (int t0 = gw * 4; t0 < M; t0 += NGW * 4) {
        v4u raw[4], gg[4]; f32x4 sq[4];
#pragma unroll
        for (int k = 0; k < 4; ++k) { const size_t t = (size_t)t0 + k; raw[k] = *(const v4u*)(OB + t * 1024 + 512 + hd * 128 + cb); gg[k] = *(const v4u*)(HP + t * HP_LD + COL_GG + hd * 128 + cb); sq[k] = *(const f32x4*)(SSQ + (t * 4 + hd) * 4); }
#pragma unroll
        for (int k = 0; k < 4; ++k) { const size_t t = (size_t)t0 + k; const float rs = rsqrtf(((sq[k].x + sq[k].y) + (sq[k].z + sq[k].w)) * (1.f / 128.f) + NORM_EPS);
            v4u o; o.x = bfc2(bflo(raw[k].x) * rs * w0.x * siluf(bflo(gg[k].x)), bfhi(raw[k].x) * rs * w0.y * siluf(bfhi(gg[k].x))); o.y = bfc2(bflo(raw[k].y) * rs * w0.z * siluf(bflo(gg[k].y)), bfhi(raw[k].y) * rs * w0.w * siluf(bfhi(gg[k].y)));
            o.z = bfc2(bflo(raw[k].z) * rs * w1.x * siluf(bflo(gg[k].z)), bfhi(raw[k].z) * rs * w1.y * siluf(bfhi(gg[k].z))); o.w = bfc2(bflo(raw[k].w) * rs * w1.z * siluf(bflo(gg[k].w)), bfhi(raw[k].w) * rs * w1.w * siluf(bfhi(gg[k].w)));
            *(v4u*)(OB + t * 1024 + 512 + hd * 128 + cb) = o; }
    }
}

struct RetLds {
    static constexpr int QS = 72, JS = 136;
    static constexpr int P = 0, Q1 = 34816, K1 = 53248, OL = 0, K1T = 71680, VT = 89088, ST = 123904;
};
template <bool WANT_Q, bool WANT_K1, bool WANT_K1T>
__device__ __forceinline__ void ret_stage(const bf16* HP, const float* RT, int b, int h, int n, float lg, LAS unsigned char* lds, int tid) {
    constexpr int QS = RetLds::QS, JS = RetLds::JS;
    LAS bf16* Q1 = (LAS bf16*)(lds + RetLds::Q1); LAS bf16* K1 = (LAS bf16*)(lds + RetLds::K1); LAS bf16* K1T = (LAS bf16*)(lds + RetLds::K1T); LAS bf16* VT = (LAS bf16*)(lds + RetLds::VT);
    const int i = tid >> 2, dd = (tid & 3) * 8, pos = n * 128 + i; const size_t t = (size_t)b * SEQ + pos;
    const bf16* hp = HP + t * HP_LD;
    const f32x4 c0 = *(const f32x4*)(RT + pos * 64 + dd), c1 = *(const f32x4*)(RT + pos * 64 + dd + 4), s0 = *(const f32x4*)(RT + pos * 64 + 32 + dd), s1 = *(const f32x4*)(RT + pos * 64 + 32 + dd + 4);
    const float cs[8] = {c0.x, c0.y, c0.z, c0.w, c1.x, c1.y, c1.z, c1.w}, sn[8] = {s0.x, s0.y, s0.z, s0.w, s1.x, s1.y, s1.z, s1.w};
    const float sq = exp2f((float)i * lg), sk = 0.125f * exp2f(-(float)i * lg);
    v4u xv[4];
#pragma unroll
    for (int p = 0; p < 4; ++p) { const int idx = tid + 512 * p, j = idx >> 4, e0 = (idx & 15) * 8; xv[p] = *(const v4u*)(HP + ((size_t)b * SEQ + n * 128 + j) * HP_LD + COL_RV + h * 128 + e0); }
#pragma unroll
    for (int which = (WANT_Q ? 0 : 1); which < 2; ++which) {
        const bf16* src = hp + (which == 0 ? COL_RQ : COL_RK) + h * 64 + dd;
        const v4u x1 = *(const v4u*)src, x2 = *(const v4u*)(src + 32);
        const float sc = which == 0 ? sq : sk;
        float lo[8], hi[8];
#pragma unroll
        for (int k = 0; k < 4; ++k) { const float a0 = bflo(x1[k]), a1 = bfhi(x1[k]), b0 = bflo(x2[k]), b1 = bfhi(x2[k]);
            lo[2 * k] = (a0 * cs[2 * k] - b0 * sn[2 * k]) * sc; lo[2 * k + 1] = (a1 * cs[2 * k + 1] - b1 * sn[2 * k + 1]) * sc;
            hi[2 * k] = (a0 * sn[2 * k] + b0 * cs[2 * k]) * sc; hi[2 * k + 1] = (a1 * sn[2 * k + 1] + b1 * cs[2 * k + 1]) * sc; }
        v4u wl, wh;
#pragma unroll
        for (int k = 0; k < 4; ++k) { wl[k] = bfc2(lo[2 * k], lo[2 * k + 1]); wh[k] = bfc2(hi[2 * k], hi[2 * k + 1]); }
        if (which == 0 || WANT_K1) { LAS bf16* dst = (which == 0 ? Q1 : K1) + i * QS + dd; *(LAS v4u*)dst = wl; *(LAS v4u*)(dst + 32) = wh; }
        if (which == 1 && WANT_K1T) {
#pragma unroll
            for (int k = 0; k < 4; ++k) { K1T[(dd + 2 * k) * JS + i] = (bf16)(wl[k] & 0xffffu); K1T[(dd + 2 * k + 1) * JS + i] = (bf16)(wl[k] >> 16);
                K1T[(32 + dd + 2 * k) * JS + i] = (bf16)(wh[k] & 0xffffu); K1T[(32 + dd + 2 * k + 1) * JS + i] = (bf16)(wh[k] >> 16); }
        }
    }
#pragma unroll
    for (int p = 0; p < 4; ++p) { const int idx = tid + 512 * p, j = idx >> 4, e0 = (idx & 15) * 8;
#pragma unroll
        for (int k = 0; k < 4; ++k) { VT[(e0 + 2 * k) * JS + j] = (bf16)(xv[p][k] & 0xffffu); VT[(e0 + 2 * k + 1) * JS + j] = (bf16)(xv[p][k] >> 16); } }
}
__device__ __forceinline__ void ret_kv_unit(KArgs a, int unit, LAS unsigned char* lds, int tid, int lane, int wave) {
    unsigned char* ws = a->ws;
    constexpr int JS = RetLds::JS;
    const int n = unit & 15, bh = unit >> 4, h = bh & 3, b = bh >> 2, c = lane & 31, hh = lane >> 5;
    const bf16* HP = (const bf16*)(ws + WS_R + R_HP); const float* RT = (const float*)(ws + WS_ROPE);
    const float gam = 1.0f - exp2f(-5.0f - (float)h), lg = log2f(gam), g127 = exp2f(127.f * lg);
    LAS bf16* K1T = (LAS bf16*)(lds + RetLds::K1T); LAS bf16* VT = (LAS bf16*)(lds + RetLds::VT);
    __syncthreads();
    ret_stage<false, false, true>(HP, RT, b, h, n, lg, lds, tid);
    __syncthreads();
    const int td = wave >> 2, te = wave & 3;
    f32x16 kv;
#pragma unroll
    for (int i = 0; i < 16; ++i) kv[i] = 0.f;
#pragma unroll
    for (int ks = 0; ks < 8; ++ks) kv = MFMA32(*(const LAS bf16x8*)(K1T + (32 * td + c) * JS + 16 * ks + 8 * hh), *(const LAS bf16x8*)(VT + (32 * te + c) * JS + 16 * ks + 8 * hh), kv);
    float* dst = (float*)(ws + WS_KV) + ((size_t)(unit * 8 + wave) * 64 + lane) * 16;
#pragma unroll
    for (int g = 0; g < 4; ++g) *(f32x4*)(dst + 4 * g) = (f32x4){kv[4 * g] * g127, kv[4 * g + 1] * g127, kv[4 * g + 2] * g127, kv[4 * g + 3] * g127};
}
__device__ __forceinline__ void ret_out_unit(KArgs a, int unit, LAS unsigned char* lds, int tid, int lane, int wave) {
    unsigned char* ws = a->ws;
    constexpr int QS = RetLds::QS, JS = RetLds::JS;
    LAS bf16* P = (LAS bf16*)(lds + RetLds::P); LAS bf16* Q1 = (LAS bf16*)(lds + RetLds::Q1); LAS bf16* K1 = (LAS bf16*)(lds + RetLds::K1); LAS float* OL = (LAS float*)(lds + RetLds::OL);
    LAS bf16* VT = (LAS bf16*)(lds + RetLds::VT); LAS bf16* ST = (LAS bf16*)(lds + RetLds::ST);
    const int n = unit & 15, bh = unit >> 4, h = bh & 3, b = bh >> 2, c = lane & 31, hh = lane >> 5;
    const bf16* HP = (const bf16*)(ws + WS_R + R_HP); bf16* OB = (bf16*)(ws + WS_R + R_OB); const float* RT = (const float*)(ws + WS_ROPE);
    const float gam = 1.0f - exp2f(-5.0f - (float)h), lg = log2f(gam), g128 = exp2f(128.f * lg);
    __syncthreads();
    const int ei = tid >> 2, eq = tid & 3; const size_t et = (size_t)b * SEQ + n * 128 + ei;
    v4u gg[4];
    { const bf16* gp = HP + et * HP_LD + COL_RG + h * 128 + 32 * eq;
#pragma unroll
      for (int k = 0; k < 4; ++k) gg[k] = *(const v4u*)(gp + 8 * k); }
    {
        const int td = wave >> 2, te = wave & 3;
        f32x16 S;
#pragma unroll
        for (int i = 0; i < 16; ++i) S[i] = 0.f;
        const float* src = (const float*)(ws + WS_KV) + ((size_t)((bh * 16) * 8 + wave) * 64 + lane) * 16;
#pragma unroll 2
        for (int m = 0; m < n; ++m) { const f32x4* p4 = (const f32x4*)(src + (size_t)m * 8 * 64 * 16);
#pragma unroll
            for (int g = 0; g < 4; ++g) { const f32x4 v = p4[g]; S[4 * g] = S[4 * g] * g128 + v.x; S[4 * g + 1] = S[4 * g + 1] * g128 + v.y; S[4 * g + 2] = S[4 * g + 2] * g128 + v.z; S[4 * g + 3] = S[4 * g + 3] * g128 + v.w; } }
#pragma unroll
        for (int g = 0; g < 4; ++g) { v2u w; w.x = bfc2(S[4 * g], S[4 * g + 1]); w.y = bfc2(S[4 * g + 2], S[4 * g + 3]); *(LAS v2u*)(ST + (32 * te + c) * QS + 32 * td + 8 * g + 4 * hh) = w; }
    }
    ret_stage<true, true, false>(HP, RT, b, h, n, lg, lds, tid);
    __syncthreads();
#pragma unroll 1
    for (int rep = 0; rep < 2; ++rep) { const int idx = wave + 8 * rep;
        if (idx < 10) { const int ti = (idx >= 1) + (idx >= 3) + (idx >= 6), tj = idx - ti * (ti + 1) / 2;
            f32x16 acc;
#pragma unroll
            for (int i = 0; i < 16; ++i) acc[i] = 0.f;
#pragma unroll
            for (int s2 = 0; s2 < 4; ++s2) acc = MFMA32(*(const LAS bf16x8*)(Q1 + (32 * ti + c) * QS + 16 * s2 + 8 * hh), *(const LAS bf16x8*)(K1 + (32 * tj + c) * QS + 16 * s2 + 8 * hh), acc);
#pragma unroll
            for (int i = 0; i < 16; ++i) { const int il = (i & 3) + 8 * (i >> 2) + 4 * hh; float v = acc[i]; if (ti == tj && il < c) v = 0.f; P[(32 * ti + il) * JS + 32 * tj + c] = bfc(v); } } }
    __syncthreads();
    const int ti = wave >> 1, te0 = 2 * (wave & 1);
    f32x16 ao[2];
#pragma unroll
    for (int u = 0; u < 2; ++u)
#pragma unroll
        for (int i = 0; i < 16; ++i) ao[u][i] = 0.f;
#pragma unroll
    for (int s2 = 0; s2 < 4; ++s2) { const bf16x8 A = *(const LAS bf16x8*)(Q1 + (32 * ti + c) * QS + 16 * s2 + 8 * hh);
#pragma unroll
        for (int u = 0; u < 2; ++u) ao[u] = MFMA32(A, *(const LAS bf16x8*)(ST + (32 * (te0 + u) + c) * QS + 16 * s2 + 8 * hh), ao[u]); }
#pragma unroll
    for (int u = 0; u < 2; ++u)
#pragma unroll
        for (int i = 0; i < 16; ++i) ao[u][i] *= gam;
#pragma unroll 1
    for (int tj = 0; tj <= ti; ++tj)
#pragma unroll
        for (int s2 = 0; s2 < 2; ++s2) { const bf16x8 A = *(const LAS bf16x8*)(P + (32 * ti + c) * JS + 32 * tj + 16 * s2 + 8 * hh);
#pragma unroll
            for (int u = 0; u < 2; ++u) ao[u] = MFMA32(A, *(const LAS bf16x8*)(VT + (32 * (te0 + u) + c) * JS + 32 * tj + 16 * s2 + 8 * hh), ao[u]); }
    __syncthreads();
#pragma unroll
    for (int u = 0; u < 2; ++u)
#pragma unroll
        for (int i = 0; i < 16; ++i) OL[(32 * ti + (i & 3) + 8 * (i >> 2) + 4 * hh) * 132 + 32 * (te0 + u) + c] = ao[u][i];
    __syncthreads();
    {
        const LAS float* Ob = OL + ei * 132 + 32 * eq; bf16* op = OB + et * 1024 + h * 128 + 32 * eq;
        f32x4 v[8]; float sm = 0.f;
#pragma unroll
        for (int k = 0; k < 8; ++k) { v[k] = *(const LAS f32x4*)(Ob + 4 * k); sm += (v[k].x + v[k].y) + (v[k].z + v[k].w); }
        sm += __shfl_xor(sm, 1); sm += __shfl_xor(sm, 2);
        const float mean = sm * (1.f / 128.f); float sq = 0.f;
#pragma unroll
        for (int k = 0; k < 8; ++k) { v[k] = v[k] - mean; sq += (v[k].x * v[k].x + v[k].y * v[k].y) + (v[k].z * v[k].z + v[k].w * v[k].w); }
        sq += __shfl_xor(sq, 1); sq += __shfl_xor(sq, 2);
        const float rs = rsqrtf(sq * (1.f / 128.f) + LN_EPS);
#pragma unroll
        for (int k = 0; k < 4; ++k) { const v4u g4 = gg[k]; const f32x4 a0 = v[2 * k], a1 = v[2 * k + 1];
            v4u o; o.x = bfc2(a0.x * rs * siluf(bflo(g4.x)), a0.y * rs * siluf(bfhi(g4.x))); o.y = bfc2(a0.z * rs * siluf(bflo(g4.y)), a0.w * rs * siluf(bfhi(g4.y)));
            o.z = bfc2(a1.x * rs * siluf(bflo(g4.z)), a1.y * rs * siluf(bfhi(g4.z))); o.w = bfc2(a1.z * rs * siluf(bflo(g4.w)), a1.w * rs * siluf(bfhi(g4.w)));
            *(v4u*)(op + 8 * k) = o; }
    }
}

__device__ __forceinline__ float sum16(float v) {
    v += __builtin_bit_cast(float, __builtin_amdgcn_update_dpp(0, __builtin_bit_cast(int, v), 0xB1, 0xF, 0xF, true));
    v += __builtin_bit_cast(float, __builtin_amdgcn_update_dpp(0, __builtin_bit_cast(int, v), 0x4E, 0xF, 0xF, true));
    v += __builtin_bit_cast(float, __builtin_amdgcn_update_dpp(0, __builtin_bit_cast(int, v), 0x141, 0xF, 0xF, true));
    v += __builtin_bit_cast(float, __builtin_amdgcn_update_dpp(0, __builtin_bit_cast(int, v), 0x140, 0xF, 0xF, true));
    return v;
}
__device__ __forceinline__ void gdn_prep_fast(KArgs a, int l, int unit, LAS unsigned char* lds, int tid, int lane, int wave) {
    asm volatile("" : "+v"(tid)); lane = tid & 63; wave = __builtin_amdgcn_readfirstlane(tid >> 6);
    unsigned char* ws = a->ws;
    constexpr int KS = 136;
    LAS bf16* Kb = (LAS bf16*)lds;
    LAS bf16* Qb = (LAS bf16*)(lds + 17408);
    LAS float* A = (LAS float*)(lds + 34816);
    LAS float* V = (LAS float*)(lds + 51200);
    LAS float* KW = (LAS float*)(lds + 83968);
    LAS float* gc = (LAS float*)(lds + 116736);
    LAS float* bt = gc + 64;
    LAS bf16* KDs = (LAS bf16*)(lds + 117248);
    LAS bf16* XT = (LAS bf16*)lds;
    LAS bf16* A10b = (LAS bf16*)(lds + 135680);
    const int n = unit & 31, bh = unit >> 5, h = bh & 3, b = bh >> 2, t0 = b * SEQ + n * 64, c = lane & 31, hh = lane >> 5;
    const bf16* HP = (const bf16*)(ws + WS_R + R_HP);
    constexpr int F8D = GDN_F8 ? 2 : 1;
    bf16* QKg = (bf16*)(ws + WS_R + R_QK) + (size_t)unit * (4096 / F8D); bf16* QDg = (bf16*)(ws + WS_R + R_QD) + (size_t)unit * (8192 / F8D); bf16* KDTg = (bf16*)(ws + WS_R + R_KDT) + (size_t)unit * (8192 / F8D);
    bf16* WNg = (bf16*)(ws + WS_R + R_WN) + (size_t)unit * (8192 / F8D); bf16* Ug = (bf16*)(ws + WS_R + R_U) + (size_t)unit * 8192;
    __syncthreads(); if (unit == PROBE_UNIT) STAMPT(130, 0);
    if (wave == 0) {
        const float* gab = (const float*)(ws + WS_GAB) + (size_t)(t0 + lane) * 8; const float x = gab[h] + a->in[4][l * 4 + h];
        const float sp = fmaxf(x, 0.f) + log1pf(__expf(-fabsf(x))); float g = -__expf(a->in[3][l * 4 + h]) * sp;
#pragma unroll
        for (int o = 1; o < 64; o <<= 1) { const float up = __shfl_up(g, o); if (lane >= o) g += up; }
        gc[lane] = g; bt[lane] = sigmf(gab[4 + h]);
        if (lane == 63) ((float*)(ws + WS_CD))[unit] = __expf(g);
    }
    __syncthreads(); if (unit == PROBE_UNIT) STAMPT(131, 0);
#ifndef PREP_NO_CONV
    if (wave < 6) {
        const int which = wave >> 1, tp = tid & 127, rb = tp >> 4, dd = (tp & 15) * 8, col = COL_GQ + which * 512 + h * 128 + dd, cc = which * 512 + h * 128 + dd;
        const float* cw = a->in[2] + (size_t)l * 4 * 1536 + cc;
        float w[4][8];
#pragma unroll
        for (int j = 0; j < 4; ++j) { const f32x4 w0 = *(const f32x4*)(cw + j * 1536), w1 = *(const f32x4*)(cw + j * 1536 + 4); w[j][0] = w0.x; w[j][1] = w0.y; w[j][2] = w0.z; w[j][3] = w0.w; w[j][4] = w1.x; w[j][5] = w1.y; w[j][6] = w1.z; w[j][7] = w1.w; }
        const int sbase = n * 64 + 8 * rb - 3;
        const bf16* hpc = HP + (size_t)(b * SEQ) * HP_LD + col;
        v4u raw[11];
#pragma unroll
        for (int r = 0; r < 11; ++r) { raw[r] = (v4u){0u, 0u, 0u, 0u}; if (sbase + r >= 0) raw[r] = *(const v4u*)(hpc + (size_t)(sbase + r) * HP_LD); }
        const float gl = gc[63];
#pragma unroll
        for (int r = 0; r < 8; ++r) { const int i = 8 * rb + r; float y[8]; float ss = 0.f;
#pragma unroll
            for (int k4 = 0; k4 < 4; ++k4) {
                unsigned d0 = raw[r][k4], d1 = raw[r + 1][k4], d2 = raw[r + 2][k4], d3 = raw[r + 3][k4];
                asm volatile("" : "+v"(d0), "+v"(d1), "+v"(d2), "+v"(d3));
                const float a0 = w[0][2 * k4] * bflo(d0) + w[1][2 * k4] * bflo(d1) + w[2][2 * k4] * bflo(d2) + w[3][2 * k4] * bflo(d3);
                const float a1 = w[0][2 * k4 + 1] * bfhi(d0) + w[1][2 * k4 + 1] * bfhi(d1) + w[2][2 * k4 + 1] * bfhi(d2) + w[3][2 * k4 + 1] * bfhi(d3);
                y[2 * k4] = siluf(a0); y[2 * k4 + 1] = siluf(a1); ss += y[2 * k4] * y[2 * k4] + y[2 * k4 + 1] * y[2 * k4 + 1]; }
            ss = sum16(ss);
            const float gi = gc[i], bi = bt[i];
            if (which == 0) { const float f = rsqrtf(ss + NORM_EPS) * 0.08838834764831845f, eg = __expf(gi);
                v4u p, pd;
#pragma unroll
                for (int k = 0; k < 4; ++k) { p[k] = bfc2(y[2 * k] * f, y[2 * k + 1] * f); pd[k] = bfc2(y[2 * k] * f * eg, y[2 * k + 1] * f * eg); }
                *(LAS v4u*)(Qb + i * KS + dd) = p;
#if GDN_F8
                { unsigned char* qd8 = (unsigned char*)QDg + (((i >> 5) * 4 + (dd >> 5)) * 2 + ((dd >> 4) & 1)) * 512 + (i & 31) * 8 + ((dd >> 3) & 1) * 4; const float fs = f * eg * F8_SQ;
                  *(unsigned*)qd8 = f8x4(y[0] * fs, y[1] * fs, y[2] * fs, y[3] * fs); *(unsigned*)(qd8 + 256) = f8x4(y[4] * fs, y[5] * fs, y[6] * fs, y[7] * fs); }
#else
                bf16* qd = QDg + (((i >> 5) * 4 + (dd >> 5)) * 2 + ((dd >> 4) & 1)) * 512 + (i & 31) * 8 + ((dd >> 3) & 1) * 4;
                *(v2u*)qd = (v2u){pd[0], pd[1]}; *(v2u*)(qd + 256) = (v2u){pd[2], pd[3]};
#endif
            } else if (which == 1) { const float f = rsqrtf(ss + NORM_EPS), fw = f * bi * __expf(gi), fd = f * __expf(gl - gi);
                v4u p;
#pragma unroll
                for (int k = 0; k < 4; ++k) p[k] = bfc2(y[2 * k] * f, y[2 * k + 1] * f);
                *(LAS v4u*)(Kb + i * KS + dd) = p;
#pragma unroll
                for (int k = 0; k < 8; ++k) { KW[i * 128 + dd + k] = y[k] * fw; KDs[(dd + k) * 72 + i] = bfc(y[k] * fd); }
            } else {
#pragma unroll
                for (int k = 0; k < 8; ++k) V[i * 128 + dd + k] = y[k] * bi;
            }
        }
    }
#endif
    __syncthreads(); if (unit == PROBE_UNIT) STAMPT(132, 0);
    {
        const int ti = (wave >> 1) & 1, tj = wave & 1;
        if (wave < 4) {
            if (ti <= tj) {
                f32x16 acc;
#pragma unroll
                for (int i = 0; i < 16; ++i) acc[i] = 0.f;
#pragma unroll
                for (int s = 0; s < 8; ++s) acc = MFMA32(*(const LAS bf16x8*)(Kb + (32 * ti + c) * KS + 16 * s + 8 * hh), *(const LAS bf16x8*)(Kb + (32 * tj + c) * KS + 16 * s + 8 * hh), acc);
                const int i = 32 * tj + c; const float gi = gc[i], bi = bt[i];
#pragma unroll
                for (int r = 0; r < 16; ++r) { const int j = 32 * ti + (r & 3) + 8 * (r >> 2) + 4 * hh; const float av = (j < i) ? bi * acc[r] * __expf(gi - gc[j]) : 0.f; A[j * 64 + i] = av;
                    if (ti == 0 && tj == 1) A10b[c * 40 + j] = bfc(av); }
            } else {
#pragma unroll
                for (int r = 0; r < 16; ++r) { const int j = 32 * ti + (r & 3) + 8 * (r >> 2) + 4 * hh; A[j * 64 + 32 * tj + c] = 0.f; }
            }
        } else {
            const int kt = ti, qt = tj;
            if (kt <= qt) {
                f32x16 acc;
#pragma unroll
                for (int i = 0; i < 16; ++i) acc[i] = 0.f;
#pragma unroll
                for (int s = 0; s < 8; ++s) acc = MFMA32(*(const LAS bf16x8*)(Kb + (32 * kt + c) * KS + 16 * s + 8 * hh), *(const LAS bf16x8*)(Qb + (32 * qt + c) * KS + 16 * s + 8 * hh), acc);
                const int i = 32 * qt + c; const float gi = gc[i];
#pragma unroll
                for (int r = 0; r < 16; ++r) { const int j = 32 * kt + (r & 3) + 8 * (r >> 2) + 4 * hh; acc[r] = (j <= i) ? acc[r] * __expf(gi - gc[j]) : 0.f; }
                bf16x8* qf = (bf16x8*)QKg + lane;
#if GDN_F8
                { long* qf8 = (long*)QKg + lane; qf8[((qt * 2 + kt) * 2 + 0) * 64] = pack8_f8(acc, 0, F8_SQ); qf8[((qt * 2 + kt) * 2 + 1) * 64] = pack8_f8(acc, 1, F8_SQ); }
#else
                qf[((qt * 2 + kt) * 2 + 0) * 64] = pack8(acc, 0); qf[((qt * 2 + kt) * 2 + 1) * 64] = pack8(acc, 1);
#endif
            }
        }
    }
    __syncthreads(); if (unit == PROBE_UNIT) STAMPT(133, 0);
#ifndef PREP_NO_SOLVE
#define PREP_SOLVE32(B0) do { \
        _Pragma("unroll") for (int i = 0; i < 32; ++i) x[i] = rhs[((B0) + i) * 128]; \
        _Pragma("unroll") for (int m = 0; m < 31; ++m) { const float xm = x[m]; \
            _Pragma("unroll") for (int g = (m + 1) / 4; g < 8; ++g) { const f32x4 a4 = *(const LAS f32x4*)(A + ((B0) + m) * 64 + (B0) + 4 * g); \
                if (4 * g > m) x[4 * g] -= a4.x * xm; if (4 * g + 1 > m) x[4 * g + 1] -= a4.y * xm; if (4 * g + 2 > m) x[4 * g + 2] -= a4.z * xm; if (4 * g + 3 > m) x[4 * g + 3] -= a4.w * xm; } } \
        if (tl < 128) { _Pragma("unroll") for (int hx = 0; hx < 2; ++hx) _Pragma("unroll") for (int hf = 0; hf < 2; ++hf) { const int i0 = 16 * hf + 4 * hx; \
                v4u w_; w_.x = bfc2(x[i0], x[i0 + 1]); w_.y = bfc2(x[i0 + 2], x[i0 + 3]); w_.z = bfc2(x[i0 + 8], x[i0 + 9]); w_.w = bfc2(x[i0 + 10], x[i0 + 11]); *(v4u*)(Ug + uoff((B0) + i0, col)) = w_; } } \
        else { _Pragma("unroll") for (int i = 0; i < 32; ++i) Qb[((B0) + i) * KS + col] = bfc(-x[i]); } } while (0)
    int tl = tid; asm volatile("" : "+v"(tl));
    const int c2 = tl & 31, hh2 = (tl >> 5) & 1;
    if (wave < 4) {
        const int col = tl & 127; LAS float* rhs = (tl < 128 ? V : KW) + col;
        float x[32];
        PREP_SOLVE32(0);
        v4u p[4];
#pragma unroll
        for (int k = 0; k < 4; ++k) { p[k].x = bfc2(x[8 * k], x[8 * k + 1]); p[k].y = bfc2(x[8 * k + 2], x[8 * k + 3]); p[k].z = bfc2(x[8 * k + 4], x[8 * k + 5]); p[k].w = bfc2(x[8 * k + 6], x[8 * k + 7]); }
#pragma unroll
        for (int k = 0; k < 4; ++k) *(LAS v4u*)(XT + tl * 32 + 8 * k) = p[k];
    }
    __syncthreads();
    {
        f32x16 acc;
#pragma unroll
        for (int i = 0; i < 16; ++i) acc[i] = 0.f;
#pragma unroll
        for (int s2 = 0; s2 < 2; ++s2) acc = MFMA32(*(const LAS bf16x8*)(A10b + c2 * 40 + 16 * s2 + 8 * hh2), *(const LAS bf16x8*)(XT + (32 * wave + c2) * 32 + 16 * s2 + 8 * hh2), acc);
        LAS float* R1 = (wave < 4 ? V : KW) + 32 * (wave & 3) + c2;
#pragma unroll
        for (int r = 0; r < 16; ++r) { const int i = 32 + (r & 3) + 8 * (r >> 2) + 4 * hh2; R1[i * 128] -= acc[r]; }
    }
    __syncthreads();
    if (wave < 4) {
        const int col = tl & 127; LAS float* rhs = (tl < 128 ? V : KW) + col;
        float x[32];
        PREP_SOLVE32(32);
    }
#undef PREP_SOLVE32
#endif
    __syncthreads(); if (unit == PROBE_UNIT) STAMPT(134, 0);
#pragma unroll
    for (int p = 0; p < 4; ++p) { const int idx = tid + 512 * p, i = idx >> 5, d = (idx & 31) * 4;
#if GDN_F8
        { const v2u w2 = *(const LAS v2u*)(Qb + i * KS + d); *(unsigned*)((unsigned char*)WNg + fragoff(i, d, 4)) = f8x4(bflo(w2.x) * F8_SW, bfhi(w2.x) * F8_SW, bflo(w2.y) * F8_SW, bfhi(w2.y) * F8_SW); } }
#else
        *(v2u*)(WNg + fragoff(i, d, 4)) = *(const LAS v2u*)(Qb + i * KS + d); }
#endif
#pragma unroll
    for (int p = 0; p < 4; ++p) { const int idx = tid + 512 * p, d = idx >> 4, i = (idx & 15) * 4;
#if GDN_F8
        { const v2u k2 = *(const LAS v2u*)(KDs + d * 72 + i); *(unsigned*)((unsigned char*)KDTg + fragoff(d, i, 2)) = f8x4(bflo(k2.x) * F8_SK, bfhi(k2.x) * F8_SK, bflo(k2.y) * F8_SK, bfhi(k2.y) * F8_SK); } }
#else
        *(v2u*)(KDTg + fragoff(d, i, 2)) = *(const LAS v2u*)(KDs + d * 72 + i); }
#endif
    if (unit == PROBE_UNIT) STAMPT(135, 0);
}
#define XB_TMO      128
#define XB_XCNT(j)  (256  + 64 * (j))
#define XB_XSUB(j)  (1280 + 64 * (j))
#define XB_XGEN(j)  (2304 + 64 * (j))
#define XB_TOP      3328
#define XB_TOPGEN   3392
#define XCD_BAR_WORDS 3456
#define XB_SPIN_CAP (1u << 18)

__device__ __forceinline__ unsigned xb_ld(unsigned* p)              { return __hip_atomic_load(p, __ATOMIC_RELAXED, __HIP_MEMORY_SCOPE_AGENT); }
__device__ __forceinline__ unsigned xb_add(unsigned* p, unsigned v) { return __hip_atomic_fetch_add(p, v, __ATOMIC_RELAXED, __HIP_MEMORY_SCOPE_AGENT); }
__device__ __forceinline__ unsigned xb_xcc_id() { return (unsigned)__builtin_amdgcn_s_getreg((3 << 11) | 20) & 0xFu; }
#define XB_SPIN(cond, bar) do { unsigned _sp = 0; while (cond) { __builtin_amdgcn_s_sleep(1); \
    if ((++_sp & 255u) == 0u) { if (xb_ld(&(bar)[XB_TMO])) break; if (_sp > XB_SPIN_CAP) { atomicAdd(&(bar)[XB_TMO], 1u); break; } } } } while (0)

struct XcdBarrier {
    unsigned* bar; unsigned x;
    volatile LAS unsigned* st;
};

__device__ __forceinline__ XcdBarrier xcd_barrier_post(unsigned* bar, volatile LAS unsigned* st) {
    XcdBarrier b; b.bar = bar; b.x = xb_xcc_id(); b.st = st;
    if (threadIdx.x == 0) (void)xb_add(&bar[XB_XCNT(b.x)], 1u);
    return b;
}
__device__ __forceinline__ void xcd_barrier_complete(unsigned* bar, unsigned x, unsigned& nloc, unsigned& nx) {
    const unsigned G = gridDim.x * gridDim.y * gridDim.z;
    unsigned sum, cnt, mine, sp = 0u;
    for (;;) {
        sum = 0u; cnt = 0u; mine = 0u;
#pragma unroll
        for (unsigned j = 0; j < 16; ++j) { const unsigned c = xb_ld(&bar[XB_XCNT(j)]); sum += c; cnt += (c > 0u) ? 1u : 0u; mine = (j == x) ? c : mine; }
        if (sum == G) break;
        __builtin_amdgcn_s_sleep(1);
        if ((++sp & 255u) == 0u) { if (xb_ld(&bar[XB_TMO])) break; if (sp > XB_SPIN_CAP) { atomicAdd(&bar[XB_TMO], 1u); break; } }
    }
    nloc = mine > 0u ? mine : 1u; nx = cnt > 0u ? cnt : 1u;
}

__device__ __forceinline__ void xcd_barrier(const XcdBarrier& b) {
    asm volatile("s_waitcnt vmcnt(0)" ::: "memory");
    __syncthreads();
    if (threadIdx.x == 0) {
        unsigned* bar = b.bar;
        __builtin_amdgcn_s_waitcnt(0);
        unsigned nloc = b.st[0], nx = b.st[1];
        if (nloc == 0u) { xcd_barrier_complete(bar, b.x, nloc, nx); b.st[0] = nloc; b.st[1] = nx; }
        const unsigned old = xb_add(&bar[XB_XSUB(b.x)], 1u);
        const unsigned gen = old / nloc;
        if (old + 1u == (gen + 1u) * nloc) {
            __builtin_amdgcn_fence(__ATOMIC_RELEASE, "agent");
            asm volatile("s_waitcnt vmcnt(0)" ::: "memory");
            const unsigned og = xb_add(&bar[XB_TOP], 1u);
            const unsigned tg = og / nx;
            if (og + 1u == (tg + 1u) * nx) xb_add(&bar[XB_TOPGEN], 1u);
            else XB_SPIN(xb_ld(&bar[XB_TOPGEN]) == tg, bar);
            __builtin_amdgcn_fence(__ATOMIC_ACQUIRE, "agent");
            xb_add(&bar[XB_XGEN(b.x)], 1u);
            asm volatile("s_waitcnt vmcnt(0)" ::: "memory");
        } else {
            XB_SPIN(xb_ld(&bar[XB_XGEN(b.x)]) == gen, bar);
            __builtin_amdgcn_fence(__ATOMIC_ACQUIRE, "agent");
            asm volatile("s_waitcnt vmcnt(0)" ::: "memory");
        }
    }
    __syncthreads();
}
#ifndef REP_PRO
#define REP_PRO 1
#endif
#ifndef REP_IN
#define REP_IN 1
#endif
#ifndef REP_PREP
#define REP_PREP 1
#endif
#ifndef REP_SCAN
#define REP_SCAN 1
#endif
#ifndef REP_OUT
#define REP_OUT 1
#endif
#ifndef REP_GU
#define REP_GU 1
#endif
#ifndef REP_DN
#define REP_DN 1
#endif
#ifndef REP_MGU
#define REP_MGU 1
#endif
#ifndef REP_GDN
#define REP_GDN 1
#endif
#ifndef REP_RET
#define REP_RET 1
#endif
#ifndef KV_IN_SCAN
#define KV_IN_SCAN 0
#endif
#ifndef GDN_HELPERS
#define GDN_HELPERS 0
#endif
#ifndef GDN_SPLIT
#define GDN_SPLIT 0
#endif
#ifndef FAST_SCAN
#define FAST_SCAN 1
#endif
#ifndef FAST_RET
#define FAST_RET 1
#endif
#ifndef FAST_PREP
#define FAST_PREP 1
#endif
#ifndef EN_PRO
#define EN_PRO 1
#endif
#ifndef EN_IN
#define EN_IN 1
#endif
#ifndef EN_PREP
#define EN_PREP 1
#endif
#ifndef EN_SCAN
#define EN_SCAN 1
#endif
#ifndef EN_OUT
#define EN_OUT 1
#endif
#ifndef EN_LN1
#define EN_LN1 1
#endif
#ifndef EN_FFN0
#define EN_FFN0 1
#endif
#ifndef EN_MOE
#define EN_MOE 1
#endif

#ifndef PROBE_MULT
#define PROBE_MULT 0
#endif
#ifndef PROBE_BID
#define PROBE_BID 0
#endif
#ifndef PROBE_A
#define PROBE_A 0
#endif
#ifndef PROBE_B
#define PROBE_B 0
#endif
#if PROBE_MULT > 0
#define STAMP(id) do { if (blockIdx.x == PROBE_BID && threadIdx.x == 0) __hip_atomic_store((unsigned long long*)(kargs()->ws + WS_CTL + 131072) + (id), (unsigned long long)__builtin_amdgcn_s_memrealtime(), RLX_AGENT); } while (0)
#else
#define STAMP(id) do {} while (0)
#endif
__global__ void __launch_bounds__(NWAVES * 64, 2) fwd(Args a_unused) {
    extern __shared__ __attribute__((aligned(16))) unsigned char lds_raw[];
    LAS unsigned char* lds = (LAS unsigned char*)lds_raw;
    int stamp_no_ = 1; (void)stamp_no_;
    { const int tid0 = threadIdx.x; for (int u = tid0; u < (LDS_BYTES - LDSCTL_OFF) / 4; u += NWAVES * 64) ((LAS unsigned*)(lds + LDSCTL_OFF))[u] = 0u; }
    __syncthreads();
#if ONE_LAUNCH
    XcdBarrier bar = xcd_barrier_post((unsigned*)(kargs()->ws + WS_CTL) + CW_BAR, (volatile LAS unsigned*)(lds + MISC_OFF) + 8);
#define SEAM() do { STAMP(stamp_no_); ++stamp_no_; xcd_barrier(bar); STAMP(stamp_no_); ++stamp_no_; } while (0)
#else
#define SEAM() do {} while (0)
#endif
#define IN(k) (kargs()->ph_lo <= (k) && (k) < kargs()->ph_hi)
#define BOTH(k) (IN(k) && ((k) + 1) < kargs()->ph_hi)
#define PH_LOCALS KArgs a = kargs(); unsigned char* ws = a->ws; int G = gridDim.x, bid = blockIdx.x; asm volatile("" : "+s"(G), "+s"(bid)); const int tid = tidx(), lane = tid & 63, wave = __builtin_amdgcn_readfirstlane(tid >> 6), gw = bid * NWAVES + wave, NGW = G * NWAVES; (void)ws; (void)lane; (void)gw; (void)NGW;

    if (EN_PRO && IN(PH_PRO)) { _Pragma("unroll 1") for (int rep_ = 0; rep_ < REP_PRO; ++rep_) { if (rep_) SEAM(); PH_LOCALS; ph_prologue(a, lds, wave, lane, gw, NGW, bid * (NWAVES * 64) + tid, G * NWAVES * 64, 0, PRO_I_IN, true); } if (BOTH(PH_PRO)) SEAM(); }

#pragma unroll 1
    for (int l = 0; l < 2; ++l) {
        if (EN_IN && IN(PH_L(l, K_IN))) {
            _Pragma("unroll 1") for (int rep_ = 0; rep_ < REP_IN; ++rep_) { if (rep_) SEAM(); PH_LOCALS;
            pg8::Gemm g{(const pg8::bf16_t*)(ws + WS_XB), (const pg8::bf16_t*)(ws + WS_WIN) + (size_t)l * NIN_PAD * 1024, M, NIN_PAD, 1024}; pg8::StaticOrder S; S.init(M, NIN_PAD, G, bid);
            pg8::EpiHproj E{(pg8::bf16_t*)(ws + WS_R + R_HP), (float*)(ws + WS_GAB)};
            pg8::gemm_phase<pg8::EpiHproj, pg8::StaticOrder, PG8_ALIGN, PG8_SP2>(lds, g, S, E); }
            if (BOTH(PH_L(l, K_IN))) SEAM();
        }
        if (EN_PREP && IN(PH_L(l, K_PREP))) {
            _Pragma("unroll 1") for (int rep_ = 0; rep_ < REP_PREP; ++rep_) { if (rep_) SEAM(); PH_LOCALS; for (int u = bid; u < 1024; u += G) { if (FAST_PREP) gdn_prep_fast(a, l, u, lds, tid, lane, wave); else gdn_prep_unit(a, l, u, lds, tid, lane, wave); }
              STAMP(136); if (FAST_RET && !KV_IN_SCAN) for (int u = bid; u < 512; u += G) ret_kv_unit(a, u, lds, tid, lane, wave); STAMP(137); }
            if (BOTH(PH_L(l, K_PREP))) SEAM();
        }
        if (EN_SCAN && IN(PH_L(l, K_SCAN))) {
            { PH_LOCALS;
#if GDN_SPLIT
            const int n_items = CONV_N_MOE + (l == 0 ? PRO_NIT - PRO_I_IN : 0), n_ret_hi = (l == 0 ? 128 : 256);
            if (bid < 128) { const int t1 = tidx(), w1 = __builtin_amdgcn_readfirstlane(t1 >> 6); const int bh = (bid & 7) + 8 * (bid >> 5), q = (bid >> 3) & 3;
                             gdn_scan_v3(a, l, bh * 4 + q, lds, t1, t1 & 63, w1); STAMP(100 + 10 * l);
                             for (int u = n_ret_hi + bid; u < 512; u += 128) ret_out_unit(a, u, lds, t1, t1 & 63, w1); }
            else {
                { const int t2 = tidx(), w2 = __builtin_amdgcn_readfirstlane(t2 >> 6); conv_range(kargs(), lds, w2, t2 & 63, l, 0, n_items, (bid - 128) * NWAVES + w2, (G - 128) * NWAVES); STAMP(102 + 10 * l); }
                { const int t1 = tidx(), w1 = __builtin_amdgcn_readfirstlane(t1 >> 6);
                  for (int u = bid - 128; u < n_ret_hi; u += G - 128) ret_out_unit(a, u, lds, t1, t1 & 63, w1); }
                STAMP(101 + 10 * l);
            }
#else
            if (bid < 32) { const int t1 = tidx(), w1 = __builtin_amdgcn_readfirstlane(t1 >> 6); gdn_scan_fast(a, l, bid, lds, t1, t1 & 63, w1); STAMP(100 + 10 * l); }
            else {
                if (GDN_HELPERS && bid < 32 + 32 * GDN_HELPERS) gdn_scan_helper(a, bid & 31, tidx());
                if (KV_IN_SCAN) {
                    { const int t0 = tidx(), w0 = __builtin_amdgcn_readfirstlane(t0 >> 6);
                      for (int u = bid - 32; u < 512; u += G - 32) ret_kv_unit(a, u, lds, t0, t0 & 63, w0); }
                    VM_WAIT(); __syncthreads();
                    if (tidx() == 0) { unsigned* sub = (unsigned*)(kargs()->ws + WS_CTL) + CW_SUB + 64 * (1 + l);
                        __builtin_amdgcn_fence(__ATOMIC_RELEASE, "agent"); VM_WAIT();
                        __hip_atomic_fetch_add(sub, 1u, RLX_AGENT);
                        unsigned sp = 0; while (__hip_atomic_load(sub, RLX_AGENT) < (unsigned)(G - 32) && ++sp < (1u << 22)) __builtin_amdgcn_s_sleep(2);
                        __builtin_amdgcn_fence(__ATOMIC_ACQUIRE, "agent"); VM_WAIT(); }
                    __syncthreads();
                }
                { const int t1 = tidx(), w1 = __builtin_amdgcn_readfirstlane(t1 >> 6);
                  for (int u = bid - 32; u < 512; u += G - 32) ret_out_unit(a, u, lds, t1, t1 & 63, w1); }
                __syncthreads(); STAMP(101 + 10 * l);
                { const int t2 = tidx(), w2 = __builtin_amdgcn_readfirstlane(t2 >> 6);
                  moe_convert(kargs(), lds, w2, t2 & 63, (bid - 32) * NWAVES + w2, (G - 32) * NWAVES, 4 * l, 4 * l + 4);
                  if (l == 0) ph_prologue(kargs(), lds, w2, t2 & 63, (bid - 32) * NWAVES + w2, (G - 32) * NWAVES, 0, 0, PRO_I_IN, PRO_NIT, false); STAMP(102 + 10 * l); }
            }
#endif
            }
            if (BOTH(PH_L(l, K_SCAN))) SEAM();
        }
#if GDN_SPLIT
        if (EN_SCAN && IN(PH_L(l, K_FIN))) {
            { PH_LOCALS; gdn_finalize(a, l, lane, gw, NGW); }
            if (BOTH(PH_L(l, K_FIN))) SEAM();
        }
#endif
        if (EN_OUT && IN(PH_L(l, K_OUT))) {
            _Pragma("unroll 1") for (int rep_ = 0; rep_ < REP_OUT; ++rep_) { if (rep_) SEAM(); PH_LOCALS;
            pg8::Gemm g{(const pg8::bf16_t*)(ws + WS_R + R_OB), (const pg8::bf16_t*)(ws + WS_WO) + (size_t)l * 1024 * 1024, M, 1024, 1024}; pg8::StaticOrder S; S.init(M, 1024, G, bid);
            pg8::EpiBf16Out E{(pg8::bf16_t*)(ws + WS_R + R_MIX), 1024};
            pg8::gemm_phase<pg8::EpiBf16Out, pg8::StaticOrder, PG8_ALIGN, PG8_SP2>(lds, g, S, E); }
            if (BOTH(PH_L(l, K_OUT))) SEAM();
        }
        if (EN_LN1 && IN(PH_L(l, K_LN1))) {
            { PH_LOCALS;
            if (l == 0) ln_rows<false>(a->in[0], ALPHA, (const bf16*)(ws + WS_R + R_MIX), a->in[7], a->in[8], a->out, 1.0f, (bf16*)(ws + WS_XB), nullptr, nullptr, nullptr, nullptr, lane, gw, NGW);
            else { ln_rows<true>(a->out, ALPHA, (const bf16*)(ws + WS_R + R_MIX), a->in[7] + 1024, a->in[8] + 1024, a->out, ALPHA, (bf16*)(ws + WS_XB), (const float*)(ws + WS_RWT), (unsigned*)(ws + WS_CTL) + CW_MOE, (int*)(ws + WS_LIST), (float*)(ws + WS_GATE), lane, gw, NGW, lds, tid);
                 } }
            if (BOTH(PH_L(l, K_LN1))) SEAM();
        }
        if (l == 0) {
            if (EN_FFN0 && IN(PH_L(0, K_GU))) {
                _Pragma("unroll 1") for (int rep_ = 0; rep_ < REP_GU; ++rep_) { if (rep_) SEAM(); PH_LOCALS;
                pg8::Gemm g{(const pg8::bf16_t*)(ws + WS_XB), (const pg8::bf16_t*)(ws + WS_WGU), M, 2 * FF, 1024}; pg8::StaticOrder S; S.init(M, 2 * FF, G, bid);
                pg8::EpiSwiglu E{(pg8::bf16_t*)(ws + WS_R + R_H), FF, 0};
                pg8::gemm_phase<pg8::EpiSwiglu, pg8::StaticOrder, PG8_ALIGN, PG8_SP2>(lds, g, S, E); }
                if (BOTH(PH_L(0, K_GU))) SEAM();
            }
            if (EN_FFN0 && IN(PH_L(0, K_DN))) {
                _Pragma("unroll 1") for (int rep_ = 0; rep_ < REP_DN; ++rep_) { if (rep_) SEAM(); PH_LOCALS;
                pg8::Gemm g{(const pg8::bf16_t*)(ws + WS_R + R_H), (const pg8::bf16_t*)(ws + WS_WD), M, 1024, FF}; pg8::StaticOrder S; S.init(M, 1024, G, bid);
                pg8::EpiBf16Out E{(pg8::bf16_t*)(ws + WS_R + R_MIX), 1024};
                pg8::gemm_phase<pg8::EpiBf16Out, pg8::StaticOrder, PG8_ALIGN, PG8_SP2>(lds, g, S, E); }
                if (BOTH(PH_L(0, K_DN))) SEAM();
            }
            if (EN_LN1 && IN(PH_L(0, K_LN2))) {
                { PH_LOCALS;
                ln_rows<false>(a->out, ALPHA, (const bf16*)(ws + WS_R + R_MIX), a->in[9], a->in[10], a->out, 1.0f, (bf16*)(ws + WS_XB), nullptr, nullptr, nullptr, nullptr, lane, gw, NGW); }
                if (BOTH(PH_L(0, K_LN2))) SEAM();
            }
        } else {
#pragma unroll 1
            for (int j = 0; j < 2; ++j) {
                const int kg = K_G0 + 3 * j;
                if (EN_MOE && j == 0 && IN(PH_L(1, kg))) { { PH_LOCALS; moe_gather(a, 0, lane, gw, NGW); moe_gather(a, 1, lane, gw, NGW); } if (BOTH(PH_L(1, kg))) SEAM(); }
                if (EN_MOE && IN(PH_L(1, kg + 1))) {
                    { PH_LOCALS;
                    pg8::moe_table(lds, (const unsigned*)(ws + WS_CTL) + CW_MOE, tid);
                    const PG8_LAS int* tab = (const PG8_LAS int*)(lds + pg8::MOE_TAB_OFF);
                    if (j == 1 && bid < 32) {
#pragma unroll 1
                        for (int jj = 0; jj < 2; ++jj) {
                            { pg8::MoeSched<true> S; S.tab = tab; S.j0 = jj; S.a0 = 64 + (bid >> 2); S.c = bid & 3; S.mode = (64 + (bid >> 2)) < pg8::moe_T(lds, jj) ? 1 : 2;
                              S.n0 = S.n1 = S.a1 = S.j1 = 0; S.G = 1;
                              pg8::Gemm g{(const pg8::bf16_t*)(ws + WS_R + R_HM), (const pg8::bf16_t*)(ws + WS_WMD), MOE_ROWS, 1024, FE, 1};
                              pg8::EpiMoeDown E{a->out, (const int*)(ws + WS_LIST), (const float*)(ws + WS_GATE), tab};
                              pg8::gemm_phase<pg8::EpiMoeDown, pg8::MoeSched<true>, PG8_ALIGN, PG8_SP2>(lds, g, S, E); }
                            if (jj == 0) {
                                VM_WAIT(); __syncthreads();
                                if (tidx() == 0) { unsigned* sub = (unsigned*)(kargs()->ws + WS_CTL) + CW_SUB;
                                    __builtin_amdgcn_fence(__ATOMIC_RELEASE, "agent"); VM_WAIT();
                                    __hip_atomic_fetch_add(sub, 1u, RLX_AGENT);
                                    unsigned sp = 0; while (__hip_atomic_load(sub, RLX_AGENT) < 32u && ++sp < (1u << 22)) __builtin_amdgcn_s_sleep(2);
                                    __builtin_amdgcn_fence(__ATOMIC_ACQUIRE, "agent"); VM_WAIT(); }
                                __syncthreads();
                            }
                        }
                    } else {
                        pg8::MoeSched<false> S; S.tab = tab; S.mode = 0;
                        const int T0 = pg8::moe_T(lds, 0), T1 = pg8::moe_T(lds, 1);
                        if (j == 0) { S.j0 = 0; S.a0 = 0; S.n0 = T0; S.j1 = 1; S.a1 = 64; S.n1 = T1 > 64 ? T1 - 64 : 0; S.G = G; S.c = bid; }
                        else        { S.j0 = 1; S.a0 = 0; S.n0 = T1 < 64 ? T1 : 64; S.j1 = 1; S.a1 = 0; S.n1 = 0; S.G = G - 32; S.c = bid - 32; }
                        pg8::Gemm g{(const pg8::bf16_t*)(ws + WS_R + R_XG), (const pg8::bf16_t*)(ws + WS_WMGU), MOE_ROWS, 2 * FE, 1024};
                        pg8::EpiSwiglu E{(pg8::bf16_t*)(ws + WS_R + R_HM), FE, 1};
                        pg8::gemm_phase<pg8::EpiSwiglu, pg8::MoeSched<false>, PG8_ALIGN, PG8_SP2>(lds, g, S, E);
                    } }
                    if (BOTH(PH_L(1, kg + 1))) SEAM();
                }
                if (EN_MOE && IN(PH_L(1, kg + 2))) {
                    { PH_LOCALS;
                    pg8::moe_table(lds, (const unsigned*)(ws + WS_CTL) + CW_MOE, tid);
                    const PG8_LAS int* tab = (const PG8_LAS int*)(lds + pg8::MOE_TAB_OFF);
                    const int Tj = pg8::moe_T(lds, j);
                    pg8::MoeSched<true> S; S.tab = tab; S.mode = 0; S.j0 = j; S.a0 = 0; S.n0 = Tj < 64 ? Tj : 64; S.j1 = j; S.a1 = 0; S.n1 = 0; S.G = G; S.c = bid;
                    pg8::Gemm g{(const pg8::bf16_t*)(ws + WS_R + R_HM), (const pg8::bf16_t*)(ws + WS_WMD), MOE_ROWS, 1024, FE, 1};
                    pg8::EpiMoeDown E{a->out, (const int*)(ws + WS_LIST), (const float*)(ws + WS_GATE), tab};
                    pg8::gemm_phase<pg8::EpiMoeDown, pg8::MoeSched<true>, PG8_ALIGN, PG8_SP2>(lds, g, S, E); }
                    if (BOTH(PH_L(1, kg + 2))) SEAM();
                }
            }
            if (EN_LN1 && IN(PH_L(1, K_LNF))) {
                PH_LOCALS;
                ln_rows<false>(a->out, 1.0f, nullptr, a->in[9] + 1024, a->in[10] + 1024, a->out, 1.0f, nullptr, nullptr, nullptr, nullptr, nullptr, lane, gw, NGW);
            }
        }
    }
    STAMP(stamp_no_);
#if PROBE_MULT > 0
    if (blockIdx.x == PROBE_BID && threadIdx.x == 0) {
        const unsigned long long* ts = (const unsigned long long*)(kargs()->ws + WS_CTL + 131072);
        const unsigned long long ta = __hip_atomic_load(ts + PROBE_A, RLX_AGENT), tb = __hip_atomic_load(ts + PROBE_B, RLX_AGENT);
        const unsigned long long hold = (tb > ta ? tb - ta : 0ull) * (unsigned long long)PROBE_MULT, t0 = __builtin_amdgcn_s_memrealtime();
        while (__builtin_amdgcn_s_memrealtime() - t0 < hold && __builtin_amdgcn_s_memrealtime() - t0 < 2000000ull) __builtin_amdgcn_s_sleep(8);
    }
#endif
#undef IN
#undef BOTH
}

extern "C" void kernel_launch(void* const* d_in, const int* in_sizes, int n_in, void* d_out, int out_size, void* d_ws, size_t ws_size, hipStream_t stream) {
    static int grid = 0;
    if (grid == 0) {
        if (n_in != 18 || in_sizes[0] != M * D || out_size != M * D || ws_size < WS_END) { fprintf(stderr, "kernel_launch: unexpected shapes or workspace (%zu < %zu); nothing launched\n", ws_size, (size_t)WS_END); grid = -1; return; }
        int dev = 0, cus = 0, per_cu = 0;
        if (hipGetDevice(&dev) != hipSuccess || hipDeviceGetAttribute(&cus, hipDeviceAttributeMultiprocessorCount, dev) != hipSuccess) { grid = -1; return; }
        if (hipFuncSetAttribute((const void*)fwd, hipFuncAttributeMaxDynamicSharedMemorySize, LDS_BYTES) != hipSuccess) { fprintf(stderr, "kernel_launch: hipFuncSetAttribute failed\n"); grid = -1; return; }
        if (hipOccupancyMaxActiveBlocksPerMultiprocessor(&per_cu, (const void*)fwd, NWAVES * 64, LDS_BYTES) != hipSuccess || per_cu < 1) fprintf(stderr, "kernel_launch: occupancy query reports %d\n", per_cu);
        (void)hipGetLastError();
        grid = cus;
    }
    if (grid < 0) return;
    if (hipMemsetAsync((char*)d_ws + WS_CTL, 0, CTL_BYTES, stream) != hipSuccess) return;
    Args a{};
    for (int i = 0; i < 18; ++i) a.in[i] = (const float*)d_in[i];
    a.out = (float*)d_out; a.ws = (unsigned char*)d_ws;
#if ONE_LAUNCH
    a.ph_lo = 0; a.ph_hi = PH_END;
    hipLaunchKernelGGL(fwd, dim3(grid), dim3(NWAVES * 64), LDS_BYTES, stream, a);
#else
    static const int phases[] = {PH_PRO,
        PH_L(0, K_IN), PH_L(0, K_PREP), PH_L(0, K_SCAN), PH_L(0, K_OUT), PH_L(0, K_LN1), PH_L(0, K_GU), PH_L(0, K_DN), PH_L(0, K_LN2),
        PH_L(1, K_IN), PH_L(1, K_PREP), PH_L(1, K_SCAN), PH_L(1, K_OUT), PH_L(1, K_LN1),
        PH_L(1, K_G0), PH_L(1, K_GU0), PH_L(1, K_DN0), PH_L(1, K_G1), PH_L(1, K_GU1), PH_L(1, K_DN1), PH_L(1, K_LNF)};
    for (unsigned i = 0; i < sizeof(phases) / sizeof(phases[0]); ++i) {
        a.ph_lo = phases[i]; a.ph_hi = phases[i] + 1;
        hipLaunchKernelGGL(fwd, dim3(grid), dim3(NWAVES * 64), LDS_BYTES, stream, a);
    }
#endif
}
```

```cpp
#define GDN_F8 1
#include <hip/hip_runtime.h>
#include <cstdio>
#include <cstdint>

#ifndef ONE_LAUNCH
#define ONE_LAUNCH 1
#endif

#define GAS __attribute__((address_space(1)))
#define LAS __attribute__((address_space(3)))
typedef unsigned short bf16;
typedef unsigned v4u __attribute__((ext_vector_type(4)));
typedef unsigned v2u __attribute__((ext_vector_type(2)));
typedef float f32x4 __attribute__((ext_vector_type(4)));
typedef float f32x2 __attribute__((ext_vector_type(2)));
#define RLX_AGENT __ATOMIC_RELAXED, __HIP_MEMORY_SCOPE_AGENT
#define LDS_WAIT() asm volatile("s_waitcnt lgkmcnt(0)" ::: "memory")
#define VM_WAIT() asm volatile("s_waitcnt vmcnt(0)" ::: "memory")

__device__ __forceinline__ unsigned f2bf(float f) { unsigned u = __builtin_bit_cast(unsigned, f); return (u + 0x7fffu + ((u >> 16) & 1u)) >> 16; }
__device__ __forceinline__ unsigned pk2(float lo, float hi) { return f2bf(lo) | (f2bf(hi) << 16); }
__device__ __forceinline__ float bf2f(unsigned short u) { return __builtin_bit_cast(float, (unsigned)u << 16); }
__device__ __forceinline__ float bflo(unsigned u) { return __builtin_bit_cast(float, u << 16); }
__device__ __forceinline__ float bfhi(unsigned u) { return __builtin_bit_cast(float, u & 0xffff0000u); }
__device__ __forceinline__ float siluf(float x) { return x * __builtin_amdgcn_rcpf(1.f + __expf(-x)); }
__device__ __forceinline__ float sigmf(float x) { return 1.f / (1.f + __expf(-x)); }
__device__ __forceinline__ float wave_sum(float v) {
    v += __builtin_bit_cast(float, __builtin_amdgcn_update_dpp(0, __builtin_bit_cast(int, v), 0xB1, 0xF, 0xF, true));
    v += __builtin_bit_cast(float, __builtin_amdgcn_update_dpp(0, __builtin_bit_cast(int, v), 0x4E, 0xF, 0xF, true));
    v += __builtin_bit_cast(float, __builtin_amdgcn_update_dpp(0, __builtin_bit_cast(int, v), 0x141, 0xF, 0xF, true));
    v += __builtin_bit_cast(float, __builtin_amdgcn_update_dpp(0, __builtin_bit_cast(int, v), 0x140, 0xF, 0xF, true));
    v += __builtin_bit_cast(float, __builtin_amdgcn_update_dpp(0, __builtin_bit_cast(int, v), 0x142, 0xA, 0xF, false));
    v += __builtin_bit_cast(float, __builtin_amdgcn_update_dpp(0, __builtin_bit_cast(int, v), 0x143, 0xC, 0xF, false));
    return __builtin_bit_cast(float, __builtin_amdgcn_readlane(__builtin_bit_cast(int, v), 63));
}

constexpr int NWAVES = 8;
constexpr int M = 16384, D = 1024, SEQ = 2048, NB = 8;
constexpr int IN_COLS = 3592, NIN_PAD = 3840, HP_LD = 3584;
constexpr int FF = 2816, FE = 3584, NE = 8;
constexpr int COL_RQ = 0, COL_RK = 256, COL_RV = 512, COL_RG = 1024, COL_GQ = 1536, COL_GK = 2048, COL_GV = 2560, COL_GG = 3072;
constexpr float ALPHA = 1.41421356237f;
constexpr float LN_EPS = 1e-5f, NORM_EPS = 1e-6f;
constexpr int MOE_ROWS = 72 * 256;

__host__ __device__ __forceinline__ int fragoff(int i, int d, int nkt) {
    return ((((i >> 5) * nkt + (d >> 5)) * 2 + ((d >> 4) & 1)) * 512) + ((((d >> 2) & 1) * 32 + (i & 31)) * 8) + ((((d >> 3) & 1) << 2) | (d & 3));
}
__host__ __device__ __forceinline__ int uoff(int i, int e) {
    const int reg = (i & 3) | (((i & 31) >> 3) << 2);
    return (((((e >> 5) * 2 + (i >> 5)) * 2 + (reg >> 3)) * 64 + (((i >> 2) & 1) * 32 + (e & 31))) * 8) + (reg & 7);
}
namespace pg8 {
#define PG8_LAS __attribute__((address_space(3)))
typedef unsigned short bf16_t;
typedef short bf16x8 __attribute__((ext_vector_type(8)));
typedef float f32x4 __attribute__((ext_vector_type(4)));
typedef unsigned u32x4 __attribute__((ext_vector_type(4)));
constexpr int BM = 256, BK = 64, HALF = 128, HTB = HALF * BK * 2  , STAGE_BYTES = 8 * HTB, NXCD = 8, WGM = 8;

__host__ __device__ __forceinline__ int lds_byte(int r, int c) { const int st = (r >> 4) * 2 + (c >> 5), rr = r & 15, cc = c & 31, ob = rr * 64 + cc * 2; return st * 1024 + (ob ^ (((ob >> 9) & 1) << 5)); }
__host__ __device__ __forceinline__ void stage_rc(int b, int& R, int& C) { const int st = b / 1024, sb = b % 1024, swz = sb ^ (((sb >> 9) & 1) << 5); R = (st >> 1) * 16 + swz / 64; C = (st & 1) * 32 + (swz % 64) / 2; }
__host__ __device__ __forceinline__ int perm32(int rho) { const int n = rho >> 4, i = rho & 15; return 8 * (i >> 2) + 4 * n + (i & 3); }

struct Unit { int pm, pn, aux, am, sel; };
struct Gemm { const bf16_t* A; const bf16_t* Bt; int M, N, K, blk; };

struct StaticOrder {
    int nM, nN, nwg, G, c;
    __host__ __device__ void init(int M, int N, int G_, int c_) { nM = M / BM; nN = N / BM; nwg = nM * nN; G = G_; c = c_; }
    __host__ __device__ bool next(int i, Unit& u) const {
        const long L = (long)i * G + c; if (L >= nwg) return false;
        int wgid = (int)L; { const int q = nwg / NXCD, r = nwg % NXCD, xcd = wgid % NXCD, off = wgid / NXCD; wgid = (xcd < r ? xcd * (q + 1) : r * (q + 1) + (xcd - r) * q) + off; }
        const int nig = WGM * nN, gid = wgid / nig, fm = gid * WGM, gsz = (nM - fm) < WGM ? (nM - fm) : WGM;
        u.pm = fm + ((wgid % nig) % gsz); u.pn = (wgid % nig) / gsz; u.aux = 0; u.am = u.pm; u.sel = 0; return true;
    }
    __device__ __forceinline__ const char* aptr(const Gemm& g, const Unit& u) const { return (const char*)g.A + (size_t)u.pm * ((size_t)BM * g.K * 2); }
    __device__ __forceinline__ const char* bptr(const Gemm& g, const Unit& u) const { return (const char*)g.Bt + (size_t)u.pn * ((size_t)BM * g.K * 2); }
    __device__ __forceinline__ void a_ready(const Unit&) const {}
    __device__ __forceinline__ void done(const Unit&) const {}
};

template <class Epi, class Sched, bool ALIGN_EPI = false, bool SP2 = false>
__device__ __forceinline__ void gemm_phase(PG8_LAS unsigned char* lds, const Gemm g, const Sched& S, const Epi& E) {
    int tid = threadIdx.x; asm volatile("" : "+v"(tid)); const int wid = __builtin_amdgcn_readfirstlane(tid >> 6), lane = tid & 63, wr = wid >> 2, wc = wid & 3, fr = lane & 15, fq = lane >> 4;
    const int K = g.K, nt = K / BK;
    unsigned voffA[2], voffB[2];
#pragma unroll
    for (int i = 0; i < 2; ++i) { int R, C; stage_rc(tid * 16 + i * 8192, R, C); const int Rb = Epi::PERM ? ((R & ~31) + perm32(R & 31)) : R;
        voffA[i] = (unsigned)(R * (g.blk ? 64 : K) + C) * 2u; voffB[i] = (unsigned)(Rb * (g.blk ? 64 : K) + C) * 2u; }
    const size_t kstep = g.blk ? (size_t)(256 * 64 * 2) : (size_t)(BK * 2);
    const size_t hstep = g.blk ? (size_t)(HALF * 64 * 2) : (size_t)HALF * K * 2;
    const size_t tstep = 2 * hstep;
    const unsigned ldsw = (unsigned)wid * 1024u;
    const int aoff = lds_byte(wr * 64 + fr, fq * 8), boff = lds_byte(wc * 32 + fr, fq * 8);
#define PG8_SA(b, h) (((b) * 2 + (h)) * HTB)
#define PG8_SB(b, h) ((4 + (b) * 2 + (h)) * HTB)
#define PG8_STAGE(bufoff, gbase, voff) do { _Pragma("unroll") for (int _i = 0; _i < 2; ++_i) \
        __builtin_amdgcn_global_load_lds((const unsigned*)((const char*)(gbase) + (voff)[_i]), (PG8_LAS unsigned*)(lds + (bufoff) + ldsw + _i * 8192), 16, 0, 0); } while (0)
#define PG8_LDA(dst, b, h) do { _Pragma("unroll") for (int m = 0; m < 4; ++m) _Pragma("unroll") for (int k = 0; k < 2; ++k) dst[m][k] = *(const PG8_LAS bf16x8*)(lds + PG8_SA(b, h) + aoff + m * 2048 + k * 1024); } while (0)
#define PG8_LDB(dst, b, h) do { _Pragma("unroll") for (int n = 0; n < 2; ++n) _Pragma("unroll") for (int k = 0; k < 2; ++k) dst[n][k] = *(const PG8_LAS bf16x8*)(lds + PG8_SB(b, h) + boff + n * 2048 + k * 1024); } while (0)
#define PG8_MMA(ai, bj, At, Bt) do { __builtin_amdgcn_s_setprio(1); _Pragma("unroll") for (int m = 0; m < 4; ++m) _Pragma("unroll") for (int n = 0; n < 2; ++n) _Pragma("unroll") for (int k = 0; k < 2; ++k) \
        acc[ai][bj][m][n] = __builtin_amdgcn_mfma_f32_16x16x32_bf16(Bt[n][k], At[m][k], acc[ai][bj][m][n], 0, 0, 0); __builtin_amdgcn_s_setprio(0); } while (0)
#define PG8_WAIT_V(n) asm volatile("s_waitcnt vmcnt(" #n ")" ::: "memory")
#define PG8_WAIT_L(n) asm volatile("s_waitcnt lgkmcnt(" #n ")" ::: "memory")
#define PG8_BAR __builtin_amdgcn_s_barrier()
#define PG8_SCHED __builtin_amdgcn_sched_barrier(0)
    Unit cur, nxt; int ui = 0;
    if (!S.next(0, cur)) return;
    f32x4 acc[2][2][4][2];
#pragma unroll
    for (int a = 0; a < 2; ++a)
#pragma unroll
        for (int b = 0; b < 2; ++b)
#pragma unroll
            for (int m = 0; m < 4; ++m)
#pragma unroll
                for (int n = 0; n < 2; ++n) acc[a][b][m][n] = (f32x4){0.f, 0.f, 0.f, 0.f};
    bf16x8 At[4][2], B0[2][2], B1[2][2];
    const char* cA = S.aptr(g, cur); const char* cB = S.bptr(g, cur);
    S.a_ready(cur);
    if constexpr (SP2) {
        PG8_STAGE(PG8_SB(0, 0), cB, voffB); PG8_STAGE(PG8_SB(0, 1), cB + hstep, voffB); PG8_STAGE(PG8_SA(0, 0), cA, voffA); PG8_STAGE(PG8_SA(0, 1), cA + hstep, voffA);
        if (wr == 1) PG8_BAR;
        PG8_WAIT_V(2); PG8_BAR;
        PG8_STAGE(PG8_SB(1, 0), cB + kstep, voffB); PG8_STAGE(PG8_SA(1, 0), cA + kstep, voffA); PG8_STAGE(PG8_SB(1, 1), cB + hstep + kstep, voffB);
        PG8_WAIT_V(6); PG8_BAR;
    } else {
        PG8_STAGE(PG8_SB(0, 0), cB, voffB); PG8_STAGE(PG8_SA(0, 0), cA, voffA); PG8_STAGE(PG8_SB(0, 1), cB + hstep, voffB); PG8_STAGE(PG8_SA(0, 1), cA + hstep, voffA);
        if (wr == 1) PG8_BAR;
        PG8_WAIT_V(4); PG8_BAR;
        PG8_STAGE(PG8_SB(1, 0), cB + kstep, voffB); PG8_STAGE(PG8_SA(1, 0), cA + kstep, voffA); PG8_STAGE(PG8_SB(1, 1), cB + hstep + kstep, voffB);
        PG8_WAIT_V(6); PG8_BAR;
    }
    for (;;) {
        const bool has_next = S.next(ui + 1, nxt);
        const char* nA = has_next ? S.aptr(g, nxt) : cA; const char* nB = has_next ? S.bptr(g, nxt) : cB;
        for (int t = 0; t < nt; t += 2) {
            const bool last = (t == nt - 2);
            const char* a1 = cA + (size_t)(t + 1) * kstep;
            const char* a2 = last ? nA : cA + (size_t)(t + 2) * kstep; const char* b2 = last ? nB : cB + (size_t)(t + 2) * kstep;
            const char* a3 = a2 + kstep; const char* b3 = b2 + kstep;
            if (last && has_next) S.a_ready(nxt);
            if constexpr (SP2) {
            PG8_LDB(B0, 0, 0); PG8_LDB(B1, 0, 1); PG8_SCHED; PG8_LDA(At, 0, 0); PG8_STAGE(PG8_SA(1, 1), a1 + hstep, voffA);
            PG8_WAIT_V(8); PG8_WAIT_L(0); PG8_BAR; PG8_MMA(0, 0, At, B0); PG8_MMA(0, 1, At, B1); PG8_BAR; PG8_SCHED;
            PG8_LDA(At, 0, 1); PG8_STAGE(PG8_SB(0, 0), b2, voffB); PG8_STAGE(PG8_SB(0, 1), b2 + hstep, voffB); PG8_STAGE(PG8_SA(0, 0), a2, voffA);
            PG8_WAIT_V(8); PG8_WAIT_L(0); PG8_BAR; PG8_MMA(1, 0, At, B0); PG8_MMA(1, 1, At, B1); PG8_BAR; PG8_SCHED;
            PG8_LDB(B0, 1, 0); PG8_LDB(B1, 1, 1); PG8_SCHED; PG8_LDA(At, 1, 0); PG8_STAGE(PG8_SA(0, 1), a2 + hstep, voffA);
            PG8_WAIT_V(8); PG8_WAIT_L(0); PG8_BAR; PG8_MMA(0, 0, At, B0); PG8_MMA(0, 1, At, B1); PG8_BAR; PG8_SCHED;
            PG8_LDA(At, 1, 1); PG8_STAGE(PG8_SB(1, 0), b3, voffB); PG8_STAGE(PG8_SB(1, 1), b3 + hstep, voffB); PG8_STAGE(PG8_SA(1, 0), a3, voffA);
            PG8_WAIT_V(8); PG8_WAIT_L(0); PG8_BAR; PG8_MMA(1, 0, At, B0); PG8_MMA(1, 1, At, B1); PG8_BAR; PG8_SCHED;
            } else {
            PG8_LDB(B0, 0, 0); PG8_SCHED; PG8_LDA(At, 0, 0); PG8_STAGE(PG8_SA(1, 1), a1 + hstep, voffA);
            PG8_WAIT_L(8); PG8_BAR; PG8_WAIT_L(0); PG8_MMA(0, 0, At, B0); PG8_BAR; PG8_SCHED;
            PG8_LDB(B1, 0, 1); PG8_STAGE(PG8_SB(0, 0), b2, voffB);
            PG8_BAR; PG8_WAIT_L(0); PG8_MMA(0, 1, At, B1); PG8_BAR;
            PG8_LDA(At, 0, 1); PG8_STAGE(PG8_SA(0, 0), a2, voffA);
            PG8_BAR; PG8_WAIT_L(0); PG8_MMA(1, 0, At, B0); PG8_BAR; PG8_SCHED;
            PG8_STAGE(PG8_SB(0, 1), b2 + hstep, voffB);
            PG8_WAIT_V(6); PG8_BAR; PG8_MMA(1, 1, At, B1); PG8_BAR;
            PG8_LDB(B0, 1, 0); PG8_SCHED; PG8_LDA(At, 1, 0); PG8_STAGE(PG8_SA(0, 1), a2 + hstep, voffA);
            PG8_WAIT_L(8); PG8_BAR; PG8_WAIT_L(0); PG8_MMA(0, 0, At, B0); PG8_BAR; PG8_SCHED;
            PG8_LDB(B1, 1, 1); PG8_STAGE(PG8_SB(1, 0), b3, voffB);
            PG8_BAR; PG8_WAIT_L(0); PG8_MMA(0, 1, At, B1); PG8_BAR;
            PG8_LDA(At, 1, 1); PG8_STAGE(PG8_SA(1, 0), a3, voffA);
            PG8_BAR; PG8_WAIT_L(0); PG8_MMA(1, 0, At, B0); PG8_BAR; PG8_SCHED;
            PG8_STAGE(PG8_SB(1, 1), b3 + hstep, voffB);
            PG8_WAIT_V(6); PG8_BAR; PG8_MMA(1, 1, At, B1); PG8_BAR;
            }
        }
        if constexpr (ALIGN_EPI) { if (wr == 0) PG8_BAR; }
        if constexpr (!Epi::AFTER_DRAIN) { E(acc, cur, wr, wc, fr, fq); S.done(cur); }
        if (!has_next) break;
#pragma unroll
        for (int a = 0; a < 2; ++a)
#pragma unroll
            for (int b = 0; b < 2; ++b)
#pragma unroll
                for (int m = 0; m < 4; ++m)
#pragma unroll
                    for (int n = 0; n < 2; ++n) acc[a][b][m][n] = (f32x4){0.f, 0.f, 0.f, 0.f};
        cur = nxt; cA = nA; cB = nB; ++ui;
        if constexpr (ALIGN_EPI) { if (wr == 1) PG8_BAR; }
    }
    PG8_WAIT_V(0);
    if constexpr (!ALIGN_EPI) { if (wr == 0) PG8_BAR; }
    PG8_BAR;
    if constexpr (Epi::AFTER_DRAIN) { E.fused(acc, cur, wr, wc, fr, fq, lds, wid, lane); S.done(cur); }
#undef PG8_SA
#undef PG8_SB
#undef PG8_STAGE
#undef PG8_LDA
#undef PG8_LDB
#undef PG8_MMA
#undef PG8_WAIT_V
#undef PG8_WAIT_L
#undef PG8_BAR
#undef PG8_SCHED
}
}

namespace pg8 {
__device__ __forceinline__ unsigned cvt_pk_bf16(float lo, float hi) { unsigned r; asm volatile("v_cvt_pk_bf16_f32 %0, %1, %2" : "=v"(r) : "v"(lo), "v"(hi)); return r; }

struct EpiHproj {
    static constexpr bool PERM = true, AFTER_DRAIN = false;
    bf16_t* HP; float* GAB;
    __device__ __forceinline__ void operator()(const f32x4 (&acc)[2][2][4][2], const Unit& u, int wr, int wc, int fr, int fq) const {
        const int row0 = u.pm * BM + wr * 64 + fr;
        if (u.pn < 14) {
            const int col0 = u.pn * BM + wc * 32 + 8 * fq;
#pragma unroll
            for (int ai = 0; ai < 2; ++ai)
#pragma unroll
                for (int m = 0; m < 4; ++m) { bf16_t* rowp = HP + (size_t)(row0 + ai * HALF + m * 16) * 3584 + col0;
#pragma unroll
                    for (int bj = 0; bj < 2; ++bj) { const f32x4 v0 = acc[ai][bj][m][0], v1 = acc[ai][bj][m][1];
                        u32x4 w; w.x = cvt_pk_bf16(v0[0], v0[1]); w.y = cvt_pk_bf16(v0[2], v0[3]); w.z = cvt_pk_bf16(v1[0], v1[1]); w.w = cvt_pk_bf16(v1[2], v1[3]);
                        *(u32x4*)(rowp + bj * HALF) = w; } }
        } else if (wc == 0 && fq == 0) {
#pragma unroll
            for (int ai = 0; ai < 2; ++ai)
#pragma unroll
                for (int m = 0; m < 4; ++m) { float* rowp = GAB + (size_t)(row0 + ai * HALF + m * 16) * 8;
                    *(f32x4*)(rowp) = acc[ai][0][m][0]; *(f32x4*)(rowp + 4) = acc[ai][0][m][1]; }
        }
    }
};
struct EpiBf16Out {
    static constexpr bool PERM = true, AFTER_DRAIN = false;
    bf16_t* O; int ldc;
    __device__ __forceinline__ void operator()(const f32x4 (&acc)[2][2][4][2], const Unit& u, int wr, int wc, int fr, int fq) const {
        const int row0 = u.pm * BM + wr * 64 + fr, col0 = u.pn * BM + wc * 32 + 8 * fq;
#pragma unroll
        for (int ai = 0; ai < 2; ++ai)
#pragma unroll
            for (int m = 0; m < 4; ++m) { bf16_t* rowp = O + (size_t)(row0 + ai * HALF + m * 16) * ldc + col0;
#pragma unroll
                for (int bj = 0; bj < 2; ++bj) { const f32x4 v0 = acc[ai][bj][m][0], v1 = acc[ai][bj][m][1];
                    u32x4 w; w.x = cvt_pk_bf16(v0[0], v0[1]); w.y = cvt_pk_bf16(v0[2], v0[3]); w.z = cvt_pk_bf16(v1[0], v1[1]); w.w = cvt_pk_bf16(v1[2], v1[3]);
                    *(u32x4*)(rowp + bj * HALF) = w; } }
    }
};
struct EpiF32 {
    static constexpr bool PERM = false, AFTER_DRAIN = false;
    float* O; int ldc;
    __device__ __forceinline__ void operator()(const f32x4 (&acc)[2][2][4][2], const Unit& u, int wr, int wc, int fr, int fq) const {
        const int row0 = u.pm * BM + wr * 64 + fr, col0 = u.pn * BM + wc * 32 + 4 * fq;
#pragma unroll
        for (int ai = 0; ai < 2; ++ai)
#pragma unroll
            for (int m = 0; m < 4; ++m) { float* rowp = O + (size_t)(row0 + ai * HALF + m * 16) * ldc + col0;
#pragma unroll
                for (int bj = 0; bj < 2; ++bj)
#pragma unroll
                    for (int n = 0; n < 2; ++n) *(f32x4*)(rowp + bj * HALF + n * 16) = acc[ai][bj][m][n]; }
    }
};
struct EpiSwiglu {
    static constexpr bool PERM = true, AFTER_DRAIN = false;
    bf16_t* H; int ldh; int blk;
    __device__ __forceinline__ void operator()(const f32x4 (&acc)[2][2][4][2], const Unit& u, int wr, int wc, int fr, int fq) const {
        const int rt = wr * 64 + fr, col0 = u.pn * HALF + wc * 32 + 8 * fq;
        bf16_t* tb = H + (size_t)u.pm * BM * ldh;
#pragma unroll
        for (int ai = 0; ai < 2; ++ai)
#pragma unroll
            for (int m = 0; m < 4; ++m) { const int r = rt + ai * HALF + m * 16;
                bf16_t* rowp = blk ? tb + (size_t)(col0 >> 6) * (BM * 64) + r * 64 + (col0 & 63) : tb + (size_t)r * ldh + col0;
                float h[8];
#pragma unroll
                for (int n = 0; n < 2; ++n)
#pragma unroll
                    for (int i = 0; i < 4; ++i) { const float gt = acc[ai][0][m][n][i], up = acc[ai][1][m][n][i]; h[n * 4 + i] = gt * up * __builtin_amdgcn_rcpf(1.f + __expf(-gt)); }
                u32x4 w; w.x = cvt_pk_bf16(h[0], h[1]); w.y = cvt_pk_bf16(h[2], h[3]); w.z = cvt_pk_bf16(h[4], h[5]); w.w = cvt_pk_bf16(h[6], h[7]);
                *(u32x4*)(rowp) = w; }
    }
};
constexpr int MOE_TAB_OFF = 131072 + 1024;
__device__ __forceinline__ void moe_table(PG8_LAS unsigned char* lds, const unsigned* cntw, int tid) {
    PG8_LAS int* tab = (PG8_LAS int*)(lds + MOE_TAB_OFF);
    __syncthreads();
    if (tid < 2) { const int j = tid; int t = 0;
        for (int e = 0; e < 8; ++e) { const int c = (int)cntw[64 * (j * 8 + e)]; tab[j * 8 + e] = t; tab[16 + j * 8 + e] = c; t += (c + 255) >> 8; }
        tab[32 + j] = t; }
    __syncthreads();
}
__device__ __forceinline__ int moe_T(PG8_LAS unsigned char* lds, int j) { return __builtin_amdgcn_readfirstlane(((const PG8_LAS int*)(lds + MOE_TAB_OFF))[32 + j]); }
__device__ __forceinline__ int moe_expert(const PG8_LAS int* tab, int j, int t) { int e = 0;
#pragma unroll
    for (int k = 1; k < 8; ++k) e += (t >= tab[j * 8 + k]) ? 1 : 0;
    return __builtin_amdgcn_readfirstlane(e); }
__device__ __forceinline__ int moe_hphys(int j, int t) { return (j == 1 && t >= 64) ? t + 8 : t; }
struct EpiMoeDown {
    static constexpr bool PERM = false, AFTER_DRAIN = false;
    float* XF; const int* list; const float* gate; const PG8_LAS int* tab;
    __device__ __forceinline__ void operator()(const f32x4 (&acc)[2][2][4][2], const Unit& u, int wr, int wc, int fr, int fq) const {
        const int e = u.aux, j = u.sel, c_e = tab[16 + j * 8 + e], t_e = tab[j * 8 + e];
        const int s0 = (u.pm - t_e) * BM + wr * 64 + fr, col0 = u.pn * BM + wc * 32 + 4 * fq;
        const int* lp = list + (size_t)(j * 8 + e) * 16384; const float* gp = gate + (size_t)j * 16384;
        int tok[8]; float gt[8];
#pragma unroll
        for (int q = 0; q < 8; ++q) { const int s = s0 + (q >> 2) * HALF + (q & 3) * 16; tok[q] = (s < c_e) ? lp[s] : -1; }
#pragma unroll
        for (int q = 0; q < 8; ++q) gt[q] = (tok[q] >= 0) ? gp[tok[q]] : 0.f;
#pragma unroll
        for (int ai = 0; ai < 2; ++ai) {
            f32x4 o[4][2][2];
#pragma unroll
            for (int m = 0; m < 4; ++m) { const float* rowp = XF + (size_t)(tok[ai * 4 + m] >= 0 ? tok[ai * 4 + m] : 0) * 1024 + col0;
#pragma unroll
                for (int bj = 0; bj < 2; ++bj)
#pragma unroll
                    for (int n = 0; n < 2; ++n) o[m][bj][n] = *(const f32x4*)(rowp + bj * HALF + n * 16); }
#pragma unroll
            for (int m = 0; m < 4; ++m) { if (tok[ai * 4 + m] >= 0) { float* rowp = XF + (size_t)tok[ai * 4 + m] * 1024 + col0; const float g1 = gt[ai * 4 + m];
#pragma unroll
                for (int bj = 0; bj < 2; ++bj)
#pragma unroll
                    for (int n = 0; n < 2; ++n) *(f32x4*)(rowp + bj * HALF + n * 16) = o[m][bj][n] + acc[ai][bj][m][n] * g1; } }
        }
    }
};
template <bool DOWN>
struct MoeSched {
    int mode, n0, a0, j0, n1, a1, j1, G, c; const PG8_LAS int* tab;
    static constexpr int nN = DOWN ? 4 : 28;
    __device__ bool next(int i, Unit& u) const {
        int j, t;
        if (mode != 0) { if (i != 0 || mode == 2) return false; j = j0; t = a0; u.pn = c; }
        else {
            const int V = n0 + n1, nwg = V * nN; const long L = (long)i * G + c; if (L >= nwg) return false;
            int wgid = (int)L; { const int q = nwg / NXCD, r = nwg % NXCD, xcd = wgid % NXCD, off = wgid / NXCD; wgid = (xcd < r ? xcd * (q + 1) : r * (q + 1) + (xcd - r) * q) + off; }
            const int nig = WGM * nN, gid = wgid / nig, fm = gid * WGM, gsz = (V - fm) < WGM ? (V - fm) : WGM;
            const int vm = fm + ((wgid % nig) % gsz); u.pn = (wgid % nig) / gsz;
            if (vm < n0) { j = j0; t = a0 + vm; } else { j = j1; t = a1 + (vm - n0); }
        }
        u.aux = moe_expert(tab, j, t); u.sel = j;
        if (DOWN) { u.pm = t; u.am = moe_hphys(j, t); } else { u.pm = moe_hphys(j, t); u.am = t; }
        return true;
    }
    __device__ __forceinline__ const char* aptr(const Gemm& g, const Unit& u) const { return (const char*)g.A + (DOWN ? (size_t)0 : (size_t)u.sel * (size_t)(36u << 20)) + (size_t)u.am * ((size_t)BM * g.K * 2); }
    __device__ __forceinline__ const char* bptr(const Gemm& g, const Unit& u) const { return (const char*)g.Bt + (size_t)u.aux * ((size_t)g.N * g.K * 2) + (size_t)u.pn * ((size_t)BM * g.K * 2); }
    __device__ __forceinline__ void a_ready(const Unit&) const {}
    __device__ __forceinline__ void done(const Unit&) const {}
};
}
#ifndef PG8_SP2
#define PG8_SP2 true
#endif
#ifndef PG8_ALIGN
#define PG8_ALIGN true
#endif

constexpr size_t MiB = 1u << 20;
constexpr size_t WS_CTL = 0, CTL_BYTES = 256 * 1024;
constexpr size_t WS_ROPE = 256 * 1024;
constexpr size_t WS_WIN = 1 * MiB;
constexpr size_t WS_WO = 16 * MiB;
constexpr size_t WS_WGU = 20 * MiB;
constexpr size_t WS_WD = 31 * MiB;
constexpr size_t WS_XB = 37 * MiB;
constexpr size_t WS_GAB = 69 * MiB;
constexpr size_t WS_LIST = WS_GAB + 512 * 1024;
constexpr size_t WS_GATE = WS_LIST + 1 * MiB;
constexpr size_t WS_CD = WS_GATE + 128 * 1024;
constexpr size_t WS_RWT = WS_CD + 8 * 1024;
constexpr size_t WS_WMGU = 71 * MiB, WS_WMD = 183 * MiB;
constexpr size_t WS_R = 239 * MiB;
constexpr size_t R_HP = 0, R_OB = 112 * MiB, R_U = 144 * MiB, R_WN = 160 * MiB, R_QD = 176 * MiB, R_KDT = 192 * MiB, R_QK = 208 * MiB;
constexpr size_t WS_SSQ = WS_XB + 16 * MiB;
constexpr size_t WS_KV = WS_XB;
constexpr size_t R_MIX = 0, R_H = 64 * MiB;
constexpr size_t R_HM = 0, R_XG = 140 * MiB, XG_PASS = 36 * MiB;
constexpr size_t WS_END = WS_R + 216 * MiB;
constexpr int CW_TMO = 0, CW_BAR = 4096, CW_MOE = 16384, CW_WQ = 24576, CW_SUB = 28672;

constexpr int RING_BYTES = 131072, LDS_BYTES = 147456, LDSCTL_OFF = LDS_BYTES - 512, MISC_OFF = LDSCTL_OFF + 320;

constexpr int PH_PRO = 0;
constexpr int PH_L(int l, int k) { return 1 + 16 * l + k; }
constexpr int K_IN = 0, K_PREP = 1, K_SCAN = 2, K_OUT = 3, K_LN1 = 4, K_GU = 5, K_DN = 6, K_LN2 = 7;
constexpr int K_FIN = 12;
constexpr int K_G0 = 5, K_GU0 = 6, K_DN0 = 7, K_G1 = 8, K_GU1 = 9, K_DN1 = 10, K_LNF = 11;
constexpr int PH_END = 1 + 16 * 2;

struct Args { const float* in[18]; float* out; unsigned char* ws; int ph_lo, ph_hi; };
typedef const __attribute__((address_space(4))) Args* KArgs;
__device__ __forceinline__ KArgs kargs() { KArgs p = (KArgs)__builtin_amdgcn_kernarg_segment_ptr(); asm volatile("" : "+s"(p)); return p; }
__device__ __forceinline__ int tidx() { int t = threadIdx.x; asm volatile("" : "+v"(t)); return t; }

constexpr int TR_SCR = 64 * 65 * 4;
__device__ __forceinline__ void tr_item(const float* W, int N, int k0, int n0, bf16* WT, size_t ldk, int dst_row0, LAS float* scr, int lane, bool blk = false) {
    const int nq = 4 * (lane & 15), n = n0 + nq, kr = lane >> 4;
    f32x4 v[16];
#pragma unroll
    for (int i = 0; i < 16; ++i) v[i] = (n < N) ? *(const f32x4*)(W + (size_t)(k0 + 4 * i + kr) * N + n) : (f32x4){0.f, 0.f, 0.f, 0.f};
#pragma unroll
    for (int i = 0; i < 16; ++i) { LAS float* d = scr + (4 * i + kr) * 65 + nq; d[0] = v[i].x; d[1] = v[i].y; d[2] = v[i].z; d[3] = v[i].w; }
    LDS_WAIT(); asm volatile("" ::: "memory");
    const int c = lane & 7;
#pragma unroll
    for (int j = 0; j < 8; ++j) { const int nn = (lane >> 3) + 8 * j; const LAS float* s = scr + (8 * c) * 65 + nn;
        v4u o; o.x = pk2(s[0 * 65], s[1 * 65]); o.y = pk2(s[2 * 65], s[3 * 65]); o.z = pk2(s[4 * 65], s[5 * 65]); o.w = pk2(s[6 * 65], s[7 * 65]);
        const int dr = dst_row0 + nn;
        bf16* dp = blk ? WT + ((size_t)(dr >> 8) * (ldk >> 6) + (k0 >> 6)) * (256 * 64) + (dr & 255) * 64 + 8 * c : WT + (size_t)dr * ldk + k0 + 8 * c;
        *(v4u*)dp = o; }
    LDS_WAIT(); asm volatile("" ::: "memory");
}

constexpr int PRO_I_IN = 16 * 57, PRO_NIT = 2 * (16 * 57 + 16 * 16) + 2 * (16 * 44) + 44 * 16;
__device__ __forceinline__ void ph_prologue(KArgs a, LAS unsigned char* lds, int wave, int lane, int gw, int NGW, int gtid, int NT, int it_lo, int it_hi, bool misc) {
    unsigned char* ws = a->ws;
    LAS float* scr = (LAS float*)(lds + wave * TR_SCR);
    constexpr int I_IN = 16 * 57, I_O = 16 * 16, I_L = I_IN + I_O, I_G = 16 * 44, I_D = 44 * 16, NIT = 2 * I_L + 2 * I_G + I_D;
    static_assert(NIT == PRO_NIT && I_IN == PRO_I_IN, "prologue item counts");
    for (int it = it_lo + gw; it < it_hi; it += NGW) {
        int r = it;
        if (r < 2 * I_L) { const int l = r / I_L; r -= l * I_L;
            if (r < I_IN) { const int kb = r / 57, nb = r % 57; tr_item(a->in[1] + (size_t)l * 1024 * IN_COLS, IN_COLS, 64 * kb, 64 * nb, (bf16*)(ws + WS_WIN) + (size_t)l * NIN_PAD * 1024, 1024, 64 * nb, scr, lane); }
            else { r -= I_IN; const int kb = r / 16, nb = r % 16; tr_item(a->in[6] + (size_t)l * 1024 * 1024, 1024, 64 * kb, 64 * nb, (bf16*)(ws + WS_WO) + (size_t)l * 1024 * 1024, 1024, 64 * nb, scr, lane); }
            continue; }
        r -= 2 * I_L;
        if (r < 2 * I_G) { const int up = r / I_G; r -= up * I_G; const int kb = r / 44, nb = r % 44, n0 = 64 * nb;
            tr_item(up ? a->in[12] : a->in[11], FF, 64 * kb, n0, (bf16*)(ws + WS_WGU), 1024, 256 * (n0 >> 7) + (n0 & 127) + 128 * up, scr, lane); continue; }
        r -= 2 * I_G;
        { const int kb = r / 16, nb = r % 16; tr_item(a->in[13], 1024, 64 * kb, 64 * nb, (bf16*)(ws + WS_WD), FF, 64 * nb, scr, lane); }
    }
    if (!misc) return;
    for (int i = gtid; i < 2 * 192 * 128; i += NT) { const int l = i / (192 * 128), r = i % (192 * 128);
        ((v4u*)((bf16*)(ws + WS_WIN) + (size_t)l * NIN_PAD * 1024 + (size_t)3648 * 1024))[r] = (v4u){0u, 0u, 0u, 0u}; }
    for (int i = gtid; i < M * D / 8; i += NT) { const f32x4 p = ((const f32x4*)a->in[0])[2 * i], q = ((const f32x4*)a->in[0])[2 * i + 1];
        v4u o; o.x = pk2(p.x, p.y); o.y = pk2(p.z, p.w); o.z = pk2(q.x, q.y); o.w = pk2(q.z, q.w); ((v4u*)(ws + WS_XB))[i] = o; }
    for (int i = gtid; i < 8192; i += NT) ((float*)(ws + WS_RWT))[(i & 7) * 1024 + (i >> 3)] = a->in[14][i];
    for (int i = gtid; i < SEQ * 32; i += NT) { const int pos = i >> 5, k = i & 31;
        const float inv = powf(10000.0f, -(float)(2 * k) / 64.0f); const float ang = (float)pos * inv;
        double rev = (double)ang * 0.15915494309189535; rev -= floor(rev); const float rf = (float)rev;
        float* R = (float*)(ws + WS_ROPE) + (size_t)pos * 64; R[k] = __builtin_amdgcn_cosf(rf); R[32 + k] = __builtin_amdgcn_sinf(rf); }
}

__device__ __forceinline__ void moe_convert(KArgs a, LAS unsigned char* lds, int wave, int lane, int gw, int NGW, int e_lo, int e_hi, int item = -1) {
    unsigned char* ws = a->ws;
    LAS float* scr = (LAS float*)(lds + wave * TR_SCR);
    constexpr int I_G = 16 * 56, I_D = 56 * 16, I_E = 2 * I_G + I_D;
    for (int it = (item >= 0 ? item : e_lo * I_E + gw); it < (item >= 0 ? item + 1 : e_hi * I_E); it += NGW) {
        const int e = it / I_E; int r = it - e * I_E;
        if (r < 2 * I_G) { const int up = r / I_G; r -= up * I_G; const int kb = r / 56, nb = r % 56, n0 = 64 * nb;
            tr_item((up ? a->in[16] : a->in[15]) + (size_t)e * 1024 * FE, FE, 64 * kb, n0, (bf16*)(ws + WS_WMGU) + (size_t)e * 7168 * 1024, 1024, 256 * (n0 >> 7) + (n0 & 127) + 128 * up, scr, lane); }
        else { r -= 2 * I_G; const int kb = r / 16, nb = r % 16; tr_item(a->in[17] + (size_t)e * FE * 1024, 1024, 64 * kb, 64 * nb, (bf16*)(ws + WS_WMD) + (size_t)e * 1024 * FE, FE, 64 * nb, scr, lane, true); }
    }
}

__device__ __forceinline__ void conv_queue(KArgs a, LAS unsigned char* lds, int wave, int lane, int l) {
    unsigned char* ws = a->ws;
    LAS float* scr = (LAS float*)(lds + wave * TR_SCR);
    unsigned* head = (unsigned*)(ws + WS_CTL) + CW_WQ + 64 * l;
    constexpr int I_G = 16 * 56, I_D = 56 * 16, I_E = 2 * I_G + I_D;
    const int e_lo = (l == 0 ? 0 : 3), n_moe = (l == 0 ? 3 : 5) * I_E, n_all = n_moe + (l == 0 ? PRO_NIT - PRO_I_IN : 0);
    for (;;) {
        unsigned it0 = 0; if (lane == 0) it0 = __hip_atomic_fetch_add(head, 8u, RLX_AGENT);
        it0 = __builtin_amdgcn_readfirstlane(it0);
        if ((int)it0 >= n_all) break;
#pragma unroll 1
        for (int k = 0; k < 8; ++k) { const int it = (int)it0 + k; if (it >= n_all) break;
            if (it < n_moe) moe_convert(a, lds, wave, lane, 0, 1 << 30, 0, 0, e_lo * I_E + it);
            else ph_prologue(a, lds, wave, lane, 0, 1 << 30, 0, 0, PRO_I_IN + (it - n_moe), PRO_I_IN + (it - n_moe) + 1, false); }
    }
}

__device__ __forceinline__ void conv_range(KArgs a, LAS unsigned char* lds, int wave, int lane, int l, int lo, int hi, int gw, int NGW) {
    constexpr int I_G = 16 * 56, I_D = 56 * 16, I_E = 2 * I_G + I_D;
    const int n_moe = 4 * I_E;
    for (int it = lo + gw; it < hi; it += NGW) {
        if (it < n_moe) moe_convert(a, lds, wave, lane, 0, 1 << 30, 0, 0, 4 * l * I_E + it);
        else ph_prologue(a, lds, wave, lane, 0, 1 << 30, 0, 0, PRO_I_IN + (it - n_moe), PRO_I_IN + (it - n_moe) + 1, false);
    }
}
constexpr int CONV_N_MOE = 4 * (2 * 16 * 56 + 56 * 16);

template <bool ROUTE>
__device__ __forceinline__ void ln_rows(const float* res, float ares, const bf16* mix, const float* g, const float* bta, float* xf, float oscale, bf16* xb,
                                        const float* router, unsigned* cntw, int* list, float* gate, int lane, int gw, int NGW, LAS unsigned char* lds = nullptr, int tid = 0) {
    LAS unsigned* lcnt = (LAS unsigned*)lds; LAS unsigned* lbase = lcnt + 16; LAS unsigned* rec = lcnt + 32;
    int nrec = 0;
    if (ROUTE) { __syncthreads(); if (tid < 16) lcnt[tid] = 0u; __syncthreads(); }
    f32x4 gv[4], bv[4];
#pragma unroll
    for (int j = 0; j < 4; ++j) { gv[j] = ((const f32x4*)g)[lane + 64 * j]; bv[j] = ((const f32x4*)bta)[lane + 64 * j]; }
    f32x4 rn[4]; v2u mn[4];
#define LN_FETCH(r_) do { const f32x4* rr_ = (const f32x4*)(res + (size_t)(r_) * D) + lane; _Pragma("unroll") for (int j = 0; j < 4; ++j) rn[j] = rr_[64 * j]; \
        if (mix) { const v2u* mr_ = (const v2u*)(mix + (size_t)(r_) * D) + lane; _Pragma("unroll") for (int j = 0; j < 4; ++j) mn[j] = mr_[64 * j]; } } while (0)
#pragma unroll
    for (int j = 0; j < 4; ++j) { rn[j] = (f32x4){0.f, 0.f, 0.f, 0.f}; mn[j] = (v2u){0u, 0u}; }
    if (gw < M) LN_FETCH(gw);
    for (int row = gw; row < M; row += NGW) {
        f32x4 v[4]; float s = 0.f;
#pragma unroll
        for (int j = 0; j < 4; ++j) { v[j] = rn[j] * ares; if (mix) v[j] = v[j] + (f32x4){bflo(mn[j].x), bfhi(mn[j].x), bflo(mn[j].y), bfhi(mn[j].y)}; }
        if (row + NGW < M) LN_FETCH(row + NGW);
#pragma unroll
        for (int j = 0; j < 4; ++j) s += (v[j].x + v[j].y) + (v[j].z + v[j].w);
        const float mean = wave_sum(s) * (1.f / D); float s2 = 0.f;
#pragma unroll
        for (int j = 0; j < 4; ++j) { v[j] = v[j] - mean; s2 += (v[j].x * v[j].x + v[j].y * v[j].y) + (v[j].z * v[j].z + v[j].w * v[j].w); }
        const float rstd = 1.f / sqrtf(wave_sum(s2) * (1.f / D) + LN_EPS);
#pragma unroll
        for (int j = 0; j < 4; ++j) v[j] = v[j] * rstd * gv[j] + bv[j];
        f32x4* xo = (f32x4*)(xf + (size_t)row * D) + lane;
#pragma unroll
        for (int j = 0; j < 4; ++j) xo[64 * j] = v[j] * oscale;
        if (xb) { v2u* bo = (v2u*)(xb + (size_t)row * D) + lane;
#pragma unroll
            for (int j = 0; j < 4; ++j) { v2u o; o.x = pk2(v[j].x, v[j].y); o.y = pk2(v[j].z, v[j].w); bo[64 * j] = o; } }
        if (ROUTE) {
            float lg[8];
#pragma unroll
            for (int e = 0; e < 8; ++e) lg[e] = 0.f;
#pragma unroll
            for (int e = 0; e < 8; ++e)
#pragma unroll
                for (int j = 0; j < 4; ++j) { const f32x4 r4 = ((const f32x4*)(router + e * 1024))[lane + 64 * j]; lg[e] += (v[j].x * r4.x + v[j].y * r4.y) + (v[j].z * r4.z + v[j].w * r4.w); }
#pragma unroll
            for (int e = 0; e < 8; ++e) lg[e] = wave_sum(lg[e]);
            if (lane == 0) {
                int e0 = 0; float v0 = lg[0];
#pragma unroll
                for (int e = 1; e < 8; ++e) if (lg[e] > v0) { v0 = lg[e]; e0 = e; }
                int e1 = -1; float v1 = -3.0e38f;
#pragma unroll
                for (int e = 0; e < 8; ++e) if (e != e0 && lg[e] > v1) { v1 = lg[e]; e1 = e; }
                const float p1 = __expf(v1 - v0), g0 = 1.f / (1.f + p1), g1 = p1 / (1.f + p1);
                const int wv = (int)(tid >> 6), k = nrec++;
                const unsigned l0 = __hip_atomic_fetch_add(lcnt + e0, 1u, __ATOMIC_RELAXED, __HIP_MEMORY_SCOPE_WORKGROUP), l1 = __hip_atomic_fetch_add(lcnt + 8 + e1, 1u, __ATOMIC_RELAXED, __HIP_MEMORY_SCOPE_WORKGROUP);
                rec[(wv * 16 + k) * 4 + 0] = (unsigned)row; rec[(wv * 16 + k) * 4 + 1] = (unsigned)e0 | ((unsigned)e1 << 8); rec[(wv * 16 + k) * 4 + 2] = l0; rec[(wv * 16 + k) * 4 + 3] = l1;
                gate[row] = g0; gate[16384 + row] = g1;
            }
        }
    }
    if (ROUTE) {
        __syncthreads();
        if (tid < 16) { const unsigned c = lcnt[tid]; lbase[tid] = c ? __hip_atomic_fetch_add(cntw + 64 * tid, c, RLX_AGENT) : 0u; }
        __syncthreads();
        if (lane == 0) { const int wv = (int)(tid >> 6);
            for (int k = 0; k < nrec; ++k) { const unsigned row = rec[(wv * 16 + k) * 4], ee = rec[(wv * 16 + k) * 4 + 1], l0 = rec[(wv * 16 + k) * 4 + 2], l1 = rec[(wv * 16 + k) * 4 + 3];
                const unsigned e0 = ee & 255u, e1 = ee >> 8;
                list[(size_t)e0 * 16384 + lbase[e0] + l0] = (int)row; list[(size_t)(8 + e1) * 16384 + lbase[8 + e1] + l1] = (int)row; } }
    }
}

__device__ __forceinline__ void moe_gather(KArgs a, int j, int lane, int gw, int NGW) {
    unsigned char* ws = a->ws; const unsigned* cntw = (const unsigned*)(ws + WS_CTL) + CW_MOE + 64 * (j * 8);
    int pre[8], cum[8]; { int p = 0, t = 0;
#pragma unroll
        for (int e = 0; e < 8; ++e) { const int c = (int)cntw[64 * e]; pre[e] = p; cum[e] = t; p += c; t += (c + 255) >> 8; } }
    const int* list = (const int*)(ws + WS_LIST) + (size_t)j * 8 * 16384;
    for (int r0 = gw; r0 < M; r0 += 8 * NGW) {
        int tok[8], drow[8];
#pragma unroll
        for (int q = 0; q < 8; ++q) { const int r = r0 + q * NGW; tok[q] = -1; drow[q] = 0;
            if (r < M) { int e = 0;
#pragma unroll
                for (int k = 1; k < 8; ++k) e += (r >= pre[k]) ? 1 : 0;
                int pe = 0, ce = 0;
#pragma unroll
                for (int k = 0; k < 8; ++k) if (k == e) { pe = pre[k]; ce = cum[k]; }
                const int s = r - pe; tok[q] = list[(size_t)e * 16384 + s]; drow[q] = ce * 256 + s; } }
        v4u x0[8], x1[8];
#pragma unroll
        for (int q = 0; q < 8; ++q) { const v4u* src = (const v4u*)((const bf16*)(ws + WS_XB) + (size_t)(tok[q] >= 0 ? tok[q] : 0) * 1024); x0[q] = src[lane]; x1[q] = src[lane + 64]; }
#pragma unroll
        for (int q = 0; q < 8; ++q) if (tok[q] >= 0) { v4u* dst = (v4u*)((bf16*)(ws + WS_R + R_XG + (size_t)j * XG_PASS) + (size_t)drow[q] * 1024); dst[lane] = x0[q]; dst[lane + 64] = x1[q]; }
    }
}

__device__ __forceinline__ void gdn_prep_unit(KArgs a, int l, int unit, LAS unsigned char* lds, int tid, int lane, int wave) {
    unsigned char* ws = a->ws;
    const int n = unit & 31, bh = unit >> 5, h = bh & 3, b = bh >> 2;
    const int t0 = b * SEQ + n * 64;
    LAS float* Q = (LAS float*)lds; LAS float* K = Q + 8192; LAS float* V = K + 8192; LAS float* A = V + 8192; LAS float* gc = A + 4096; LAS float* bt = gc + 64;
    const bf16* HP = (const bf16*)(ws + WS_R + R_HP);
    const float* cw = a->in[2] + (size_t)l * 4 * 1536;
    __syncthreads();
    for (int idx = tid; idx < 64 * 384; idx += 512) { const int i = idx / 384, c = idx % 384, which = c >> 7, d = c & 127;
        const int col = COL_GQ + which * 512 + h * 128 + d, cc = which * 512 + h * 128 + d; float acc = 0.f;
#pragma unroll
        for (int j = 0; j < 4; ++j) { const int s = n * 64 + i - 3 + j; if (s >= 0) acc += cw[j * 1536 + cc] * bf2f(HP[(size_t)(b * SEQ + s) * HP_LD + col]); }
        const float y = siluf(acc); LAS float* dst = which == 0 ? Q : (which == 1 ? K : V); dst[i * 128 + d] = y; }
    if (tid < 64) { const float* gab = (const float*)(ws + WS_GAB) + (size_t)(t0 + tid) * 8; const float x = gab[h] + a->in[4][l * 4 + h];
        const float sp = fmaxf(x, 0.f) + log1pf(__expf(-fabsf(x))); gc[tid] = -__expf(a->in[3][l * 4 + h]) * sp; bt[tid] = sigmf(gab[4 + h]); }
    __syncthreads();
#pragma unroll 1
    for (int r = 0; r < 8; ++r) { const int i = wave * 8 + r;
        float q0 = Q[i * 128 + lane], q1 = Q[i * 128 + lane + 64], k0 = K[i * 128 + lane], k1 = K[i * 128 + lane + 64];
        const float sq = wave_sum(q0 * q0 + q1 * q1), sk = wave_sum(k0 * k0 + k1 * k1);
        const float fq = rsqrtf(sq + NORM_EPS) * 0.08838834764831845f, fk = rsqrtf(sk + NORM_EPS);
        Q[i * 128 + lane] = q0 * fq; Q[i * 128 + lane + 64] = q1 * fq; K[i * 128 + lane] = k0 * fk; K[i * 128 + lane + 64] = k1 * fk; }
    if (tid == 0) { float c = 0.f; for (int i = 0; i < 64; ++i) { c += gc[i]; gc[i] = c; } }
    __syncthreads();
    bf16* QKg = (bf16*)(ws + WS_R + R_QK) + (size_t)unit * 4096; bf16* QDg = (bf16*)(ws + WS_R + R_QD) + (size_t)unit * 8192; bf16* KDTg = (bf16*)(ws + WS_R + R_KDT) + (size_t)unit * 8192;
    bf16* WNg = (bf16*)(ws + WS_R + R_WN) + (size_t)unit * 8192; bf16* Ug = (bf16*)(ws + WS_R + R_U) + (size_t)unit * 8192;
    for (int idx = tid; idx < 4096; idx += 512) { const int i = idx >> 6, j = idx & 63; float dqk = 0.f, dkk = 0.f;
        for (int dd = 0; dd < 128; ++dd) { const int d = (dd + j) & 127; const float kj = K[j * 128 + d]; dqk += Q[i * 128 + d] * kj; dkk += K[i * 128 + d] * kj; }
        const float dec = __expf(gc[i] - gc[j]);
        A[i * 64 + j] = (j < i) ? bt[i] * dkk * dec : 0.f;
        QKg[fragoff(i, j, 2)] = (bf16)f2bf((j <= i) ? dqk * dec : 0.f); }
    const float gl = gc[63];
    for (int idx = tid; idx < 8192; idx += 512) { const int i = idx >> 7, d = idx & 127;
        QDg[fragoff(i, d, 4)] = (bf16)f2bf(Q[i * 128 + d] * __expf(gc[i]));
        KDTg[fragoff(d, i, 2)] = (bf16)f2bf(K[i * 128 + d] * __expf(gl - gc[i])); }
    if (tid == 0) ((float*)(ws + WS_CD))[unit] = __expf(gl);
    __syncthreads();
    for (int idx = tid; idx < 8192; idx += 512) { const int i = idx >> 7; const float bi = bt[i]; V[idx] *= bi; Q[idx] = bi * __expf(gc[i]) * K[idx]; }
    __syncthreads();
    if (tid < 256) { LAS float* buf = (tid < 128 ? V : Q) + (tid & 127);
        for (int i = 1; i < 64; ++i) { float acc = buf[i * 128]; for (int m = 0; m < i; ++m) acc -= A[i * 64 + m] * buf[m * 128]; buf[i * 128] = acc; } }
    __syncthreads();
    for (int idx = tid; idx < 8192; idx += 512) { const int i = idx >> 7, d = idx & 127; Ug[uoff(i, d)] = (bf16)f2bf(V[idx]); WNg[fragoff(i, d, 4)] = (bf16)f2bf(-Q[idx]); }
}

__device__ __forceinline__ void gdn_scan_naive(KArgs a, int l, int bh, LAS unsigned char* lds, int tid, int lane, int wave) {
    unsigned char* ws = a->ws;
    LAS float* S = (LAS float*)lds; LAS float* VN = S + 16384; LAS float* O = VN + 8192;
    const int h = bh & 3, b = bh >> 2, e = tid & 127, ig = tid >> 7;
    const bf16* HP = (const bf16*)(ws + WS_R + R_HP); bf16* OB = (bf16*)(ws + WS_R + R_OB);
    const float* nw = a->in[5] + l * 128;
    __syncthreads();
    for (int idx = tid; idx < 16384; idx += 512) S[idx] = 0.f;
    __syncthreads();
#pragma unroll 1
    for (int n = 0; n < 32; ++n) {
        const int unit = bh * 32 + n;
        const bf16* Ug = (const bf16*)(ws + WS_R + R_U) + (size_t)unit * 8192; const bf16* WNg = (const bf16*)(ws + WS_R + R_WN) + (size_t)unit * 8192;
        const bf16* QDg = (const bf16*)(ws + WS_R + R_QD) + (size_t)unit * 8192; const bf16* KDTg = (const bf16*)(ws + WS_R + R_KDT) + (size_t)unit * 8192;
        const bf16* QKg = (const bf16*)(ws + WS_R + R_QK) + (size_t)unit * 4096; const float cd = ((const float*)(ws + WS_CD))[unit];
#pragma unroll 1
        for (int r = 0; r < 16; ++r) { const int i = ig + 4 * r; float acc = bf2f(Ug[uoff(i, e)]);
#pragma unroll 2
            for (int d0 = 0; d0 < 128; d0 += 4) { const v2u w = *(const v2u*)(WNg + fragoff(i, d0, 4));
                acc += bflo(w.x) * S[d0 * 128 + e] + bfhi(w.x) * S[(d0 + 1) * 128 + e] + bflo(w.y) * S[(d0 + 2) * 128 + e] + bfhi(w.y) * S[(d0 + 3) * 128 + e]; }
            VN[i * 128 + e] = acc; }
        __syncthreads();
#pragma unroll 1
        for (int r = 0; r < 16; ++r) { const int i = ig + 4 * r; float acc = 0.f;
#pragma unroll 2
            for (int d0 = 0; d0 < 128; d0 += 4) { const v2u w = *(const v2u*)(QDg + fragoff(i, d0, 4));
                acc += bflo(w.x) * S[d0 * 128 + e] + bfhi(w.x) * S[(d0 + 1) * 128 + e] + bflo(w.y) * S[(d0 + 2) * 128 + e] + bfhi(w.y) * S[(d0 + 3) * 128 + e]; }
#pragma unroll 2
            for (int j0 = 0; j0 < 64; j0 += 4) { const v2u w = *(const v2u*)(QKg + fragoff(i, j0, 2));
                acc += bflo(w.x) * VN[j0 * 128 + e] + bfhi(w.x) * VN[(j0 + 1) * 128 + e] + bflo(w.y) * VN[(j0 + 2) * 128 + e] + bfhi(w.y) * VN[(j0 + 3) * 128 + e]; }
            O[i * 128 + e] = acc; }
        __syncthreads();
#pragma unroll 1
        for (int r = 0; r < 32; ++r) { const int d = ig + 4 * r; float acc = S[d * 128 + e] * cd;
#pragma unroll 2
            for (int i0 = 0; i0 < 64; i0 += 4) { const v2u w = *(const v2u*)(KDTg + fragoff(d, i0, 2));
                acc += bflo(w.x) * VN[i0 * 128 + e] + bfhi(w.x) * VN[(i0 + 1) * 128 + e] + bflo(w.y) * VN[(i0 + 2) * 128 + e] + bfhi(w.y) * VN[(i0 + 3) * 128 + e]; }
            S[d * 128 + e] = acc; }
#pragma unroll 1
        for (int r = 0; r < 8; ++r) { const int i = wave * 8 + r; const float v0 = O[i * 128 + lane], v1 = O[i * 128 + lane + 64];
            const float rs = rsqrtf(wave_sum(v0 * v0 + v1 * v1) * (1.f / 128.f) + NORM_EPS);
            const size_t t = (size_t)b * SEQ + n * 64 + i; const bf16* gp = HP + t * HP_LD + COL_GG + h * 128; bf16* op = OB + t * 1024 + 512 + h * 128;
            op[lane] = (bf16)f2bf(v0 * rs * nw[lane] * siluf(bf2f(gp[lane]))); op[lane + 64] = (bf16)f2bf(v1 * rs * nw[lane + 64] * siluf(bf2f(gp[lane + 64]))); }
        __syncthreads();
    }
}

__device__ __forceinline__ void ret_unit_naive(KArgs a, int unit, LAS unsigned char* lds, int tid, int lane, int wave) {
    unsigned char* ws = a->ws;
    LAS float* Qs = (LAS float*)lds; LAS float* Ks = Qs + 64 * 65; LAS float* Vs = Ks + 64 * 65; LAS float* Sc = Vs + 8192;
    const int qb = unit & 31, bh = unit >> 5, h = bh & 3, b = bh >> 2, e = tid & 127, ig = tid >> 7;
    const bf16* HP = (const bf16*)(ws + WS_R + R_HP); bf16* OB = (bf16*)(ws + WS_R + R_OB); const float* RT = (const float*)(ws + WS_ROPE);
    const float log2g = log2f(1.0f - exp2f(-5.0f - (float)h));
    __syncthreads();
    for (int idx = tid; idx < 4096; idx += 512) { const int i = idx >> 6, d = idx & 63, dd = d & 31, pos = qb * 64 + i; const size_t t = (size_t)b * SEQ + pos;
        const float c = RT[pos * 64 + dd], s = RT[pos * 64 + 32 + dd]; const float x1 = bf2f(HP[t * HP_LD + COL_RQ + h * 64 + dd]), x2 = bf2f(HP[t * HP_LD + COL_RQ + h * 64 + dd + 32]);
        Qs[i * 65 + d] = d < 32 ? x1 * c - x2 * s : x1 * s + x2 * c; }
    float acc[16];
#pragma unroll
    for (int r = 0; r < 16; ++r) acc[r] = 0.f;
#pragma unroll 1
    for (int kb = 0; kb <= qb; ++kb) {
        __syncthreads();
        for (int idx = tid; idx < 4096; idx += 512) { const int i = idx >> 6, d = idx & 63, dd = d & 31, pos = kb * 64 + i; const size_t t = (size_t)b * SEQ + pos;
            const float c = RT[pos * 64 + dd], s = RT[pos * 64 + 32 + dd]; const float x1 = bf2f(HP[t * HP_LD + COL_RK + h * 64 + dd]), x2 = bf2f(HP[t * HP_LD + COL_RK + h * 64 + dd + 32]);
            Ks[i * 65 + d] = 0.125f * (d < 32 ? x1 * c - x2 * s : x1 * s + x2 * c); }
        for (int idx = tid; idx < 8192; idx += 512) { const int i = idx >> 7, d = idx & 127; Vs[idx] = bf2f(HP[((size_t)b * SEQ + kb * 64 + i) * HP_LD + COL_RV + h * 128 + d]); }
        __syncthreads();
        { const int j = tid & 63, ig8 = tid >> 6;
#pragma unroll 1
          for (int r = 0; r < 8; ++r) { const int i = ig8 + 8 * r; float dot = 0.f;
#pragma unroll 8
              for (int d = 0; d < 64; ++d) dot += Qs[i * 65 + d] * Ks[j * 65 + d];
              const int delta = (qb - kb) * 64 + i - j; Sc[i * 65 + j] = delta >= 0 ? dot * exp2f((float)delta * log2g) : 0.f; } }
        __syncthreads();
#pragma unroll 2
        for (int j = 0; j < 64; ++j) { const float vv = Vs[j * 128 + e];
#pragma unroll
            for (int r = 0; r < 16; ++r) acc[r] += Sc[(ig + 4 * r) * 65 + j] * vv; }
    }
    __syncthreads();
#pragma unroll
    for (int r = 0; r < 16; ++r) Vs[(ig + 4 * r) * 128 + e] = acc[r];
    __syncthreads();
#pragma unroll 1
    for (int r = 0; r < 8; ++r) { const int i = wave * 8 + r; const float v0 = Vs[i * 128 + lane], v1 = Vs[i * 128 + lane + 64];
        const float mean = wave_sum(v0 + v1) * (1.f / 128.f), d0 = v0 - mean, d1 = v1 - mean; const float rs = rsqrtf(wave_sum(d0 * d0 + d1 * d1) * (1.f / 128.f) + LN_EPS);
        const size_t t = (size_t)b * SEQ + qb * 64 + i; const bf16* gp = HP + t * HP_LD + COL_RG + h * 128; bf16* op = OB + t * 1024 + h * 128;
        op[lane] = (bf16)f2bf(d0 * rs * siluf(bf2f(gp[lane]))); op[lane + 64] = (bf16)f2bf(d1 * rs * siluf(bf2f(gp[lane + 64]))); }
}

typedef float f32x16 __attribute__((ext_vector_type(16)));
typedef float f32x8 __attribute__((ext_vector_type(8)));
typedef __bf16 bf8v __attribute__((ext_vector_type(8)));
typedef short bf16x8 __attribute__((ext_vector_type(8)));
#define MFMA32(a, b, c) __builtin_amdgcn_mfma_f32_32x32x16_bf16((a), (b), (c), 0, 0, 0)
__device__ __forceinline__ bf16x8 pack8(const f32x16& x, int s) {
    f32x8 v;
#pragma unroll
    for (int j = 0; j < 8; ++j) v[j] = x[8 * s + j];
    return __builtin_bit_cast(bf16x8, __builtin_convertvector(v, bf8v));
}

__device__ __forceinline__ unsigned short bfc(float x) { return __builtin_bit_cast(unsigned short, (__bf16)x); }
__device__ __forceinline__ unsigned bfc2(float lo, float hi) { return (unsigned)bfc(lo) | ((unsigned)bfc(hi) << 16); }

#ifndef PROBE_UNIT
#define PROBE_UNIT 0
#endif
#if defined(PROBE_MULT) && PROBE_MULT > 0
#define STAMPT(id, thr) do { if (blockIdx.x == PROBE_BID && threadIdx.x == (thr)) __hip_atomic_store((unsigned long long*)(a->ws + WS_CTL + 131072) + (id), (unsigned long long)__builtin_amdgcn_s_memrealtime(), RLX_AGENT); } while (0)
#else
#define STAMPT(id, thr) do {} while (0)
#endif
#ifndef GDN_F8
#define GDN_F8 0
#endif
#ifndef GATE_PRE
#define GATE_PRE 1
#endif
constexpr float F8_SW = 4.f, F8_SQ = 16.f, F8_SK = 4.f;
#define MFMA8(a, b, c) __builtin_amdgcn_mfma_f32_32x32x16_fp8_fp8((a), (b), (c), 0, 0, 0)
__device__ __forceinline__ unsigned f8x4(float a, float b, float c, float d) { int w = __builtin_amdgcn_cvt_pk_fp8_f32(a, b, 0, false); w = __builtin_amdgcn_cvt_pk_fp8_f32(c, d, w, true); return (unsigned)w; }
__device__ __forceinline__ long pack8_f8(const f32x16& x, int s, float sc) {
    const unsigned lo = f8x4(x[8 * s] * sc, x[8 * s + 1] * sc, x[8 * s + 2] * sc, x[8 * s + 3] * sc), hi = f8x4(x[8 * s + 4] * sc, x[8 * s + 5] * sc, x[8 * s + 6] * sc, x[8 * s + 7] * sc);
    return (long)(((unsigned long)hi << 32) | (unsigned long)lo);
}
#if GATE_PRE
#define GSILU(x) (x)
#else
#define GSILU(x) siluf(x)
#endif
#define GDN_BAR() do { asm volatile("s_waitcnt lgkmcnt(0)" ::: "memory"); __builtin_amdgcn_s_barrier(); asm volatile("" ::: "memory"); } while (0)
__device__ __forceinline__ void gdn_scan_fast(KArgs a, int l, int bh, LAS unsigned char* lds, int tid, int lane, int wave) {
    unsigned char* ws = a->ws;
#if GDN_F8
    constexpr int FB_WN = 0, FB_QD = 8192, FB_KDT = 16384, FB_QK = 24576, FB_U = 28672, FB_BYTES = 45056, NPC = 11, OPB = 8192;
#else
    constexpr int FB_WN = 0, FB_QD = 16384, FB_KDT = 32768, FB_QK = 49152, FB_U = 57344, FB_BYTES = 73728, NPC = 18, OPB = 16384;
#endif
    LAS float* OL = (LAS float*)(lds + FB_BYTES);
    constexpr int OLS = 64 * 132;
    const int h = bh & 3, b = bh >> 2, c = lane & 31, hh = lane >> 5;
    const bf16* HP = (const bf16*)(ws + WS_R + R_HP); bf16* OB = (bf16*)(ws + WS_R + R_OB);
    const float* nw = a->in[5] + l * 128;
    const unsigned char* gWN = (const unsigned char*)(ws + WS_R + R_WN) + (size_t)bh * 32 * OPB; const unsigned char* gQD = (const unsigned char*)(ws + WS_R + R_QD) + (size_t)bh * 32 * OPB;
    const unsigned char* gKDT = (const unsigned char*)(ws + WS_R + R_KDT) + (size_t)bh * 32 * OPB; const unsigned char* gQK = (const unsigned char*)(ws + WS_R + R_QK) + (size_t)bh * 32 * (OPB / 2);
    const unsigned char* gU = (const unsigned char*)(ws + WS_R + R_U) + (size_t)bh * 32 * 16384;
    const int et = tid - 256;
#define GDN_FETCH(pf, nn) do { constexpr int P4 = OPB / 4096; _Pragma("unroll") for (int k = 0; k < NPC; ++k) { const unsigned char* src_ = k < P4 ? gWN + (size_t)(nn) * OPB + k * 4096 : k < 2 * P4 ? gQD + (size_t)(nn) * OPB + (k - P4) * 4096 : \
        k < 3 * P4 ? gKDT + (size_t)(nn) * OPB + (k - 2 * P4) * 4096 : k < 3 * P4 + P4 / 2 ? gQK + (size_t)(nn) * (OPB / 2) + (k - 3 * P4) * 4096 : gU + (size_t)(nn) * 16384 + (k - 3 * P4 - P4 / 2) * 4096; pf[k] = *(const v4u*)(src_ + et * 16); } } while (0)
#define GDN_STORE(pf) do { _Pragma("unroll") for (int k = 0; k < NPC; ++k) *(LAS v4u*)(lds + k * 4096 + et * 16) = pf[k]; } while (0)
    __syncthreads();
    if (wave < 4) {
        f32x16 S[4];
#pragma unroll
        for (int t = 0; t < 4; ++t)
#pragma unroll
            for (int i = 0; i < 16; ++i) S[t][i] = 0.f;
        GDN_BAR();
#if GDN_F8
        const int q = wave;
        const LAS long* WNf = (const LAS long*)(lds + FB_WN) + lane; const LAS long* QDf = (const LAS long*)(lds + FB_QD) + lane;
        const LAS long* KDTf = (const LAS long*)(lds + FB_KDT) + lane; const LAS long* QKf = (const LAS long*)(lds + FB_QK) + lane;
        const LAS v4u* Uf = (const LAS v4u*)(lds + FB_U) + (q * 2) * 128 + lane;
#pragma unroll 1
        for (int n = 0; n < 32; ++n) {
            const float cd = ((const float*)(ws + WS_CD))[bh * 32 + n];
            long A0[8], A1[8];
#define GDN_LD_MTS(A, F, g) do { _Pragma("unroll") for (int k = 0; k < 8; ++k) { const int m_ = k & 1, s_ = (k >> 1) & 1, t_ = 2 * (g) + (k >> 2); A[k] = F[((m_ * 4 + t_) * 2 + s_) * 64]; } } while (0)
#define GDN_LD_TMS(A, F, g) do { _Pragma("unroll") for (int k = 0; k < 8; ++k) { const int s_ = k & 1, m_ = (k >> 1) & 1, t_ = 2 * (g) + (k >> 2); A[k] = F[((t_ * 2 + m_) * 2 + s_) * 64]; } } while (0)
            GDN_LD_MTS(A0, WNf, 0); GDN_LD_MTS(A1, WNf, 1);
            f32x16 av[2];
#pragma unroll
            for (int m = 0; m < 2; ++m)
#pragma unroll
                for (int hf = 0; hf < 2; ++hf) { const v4u u4 = Uf[(m * 2 + hf) * 64];
#pragma unroll
                    for (int k = 0; k < 4; ++k) { av[m][8 * hf + 2 * k] = bflo(u4[k]) * F8_SW; av[m][8 * hf + 2 * k + 1] = bfhi(u4[k]) * F8_SW; } }
            long Sb[4][2];
#pragma unroll
            for (int t = 0; t < 4; ++t) { Sb[t][0] = pack8_f8(S[t], 0, 1.f / F8_SK); Sb[t][1] = pack8_f8(S[t], 1, 1.f / F8_SK); }
#pragma unroll
            for (int k = 0; k < 8; ++k) { const int m_ = k & 1, s_ = (k >> 1) & 1, t_ = (k >> 2); av[m_] = MFMA8(A0[k], Sb[t_][s_], av[m_]); }
            GDN_LD_MTS(A0, QDf, 0);
#pragma unroll
            for (int k = 0; k < 8; ++k) { const int m_ = k & 1, s_ = (k >> 1) & 1, t_ = 2 + (k >> 2); av[m_] = MFMA8(A1[k], Sb[t_][s_], av[m_]); }
            GDN_LD_MTS(A1, QDf, 1);
            f32x16 ao[2];
#pragma unroll
            for (int m = 0; m < 2; ++m)
#pragma unroll
                for (int i = 0; i < 16; ++i) ao[m][i] = 0.f;
#pragma unroll
            for (int k = 0; k < 8; ++k) { const int m_ = k & 1, s_ = (k >> 1) & 1, t_ = (k >> 2); ao[m_] = MFMA8(A0[k], Sb[t_][s_], ao[m_]); }
#pragma unroll
            for (int k = 0; k < 6; ++k) { const int s_ = k & 1, m_ = k >= 2 ? 1 : 0, mp_ = k >= 4 ? 1 : 0; A0[k] = QKf[((m_ * 2 + mp_) * 2 + s_) * 64]; }
#pragma unroll
            for (int k = 0; k < 8; ++k) { const int m_ = k & 1, s_ = (k >> 1) & 1, t_ = 2 + (k >> 2); ao[m_] = MFMA8(A1[k], Sb[t_][s_], ao[m_]); }
            GDN_LD_TMS(A1, KDTf, 0);
            long Vb[2][2];
#pragma unroll
            for (int m = 0; m < 2; ++m) { Vb[m][0] = pack8_f8(av[m], 0, 1.f / F8_SW); Vb[m][1] = pack8_f8(av[m], 1, 1.f / F8_SW); }
#pragma unroll
            for (int k = 0; k < 6; ++k) { const int s_ = k & 1, m_ = k >= 2 ? 1 : 0, mp_ = k >= 4 ? 1 : 0; ao[m_] = MFMA8(A0[k], Vb[mp_][s_], ao[m_]); }
            GDN_LD_TMS(A0, KDTf, 1);
            {   LAS float* Ob = OL + (n & 1) * OLS + 32 * wave + c;
#pragma unroll
                for (int m = 0; m < 2; ++m)
#pragma unroll
                    for (int i = 0; i < 16; ++i) Ob[(32 * m + (i & 3) + 8 * (i >> 2) + 4 * hh) * 132] = ao[m][i] * (1.f / F8_SQ); }
#pragma unroll
            for (int t = 0; t < 4; ++t)
#pragma unroll
                for (int i = 0; i < 16; ++i) S[t][i] *= cd;
#pragma unroll
            for (int k = 0; k < 8; ++k) { const int s_ = k & 1, m_ = (k >> 1) & 1, t_ = (k >> 2); S[t_] = MFMA8(A1[k], Vb[m_][s_], S[t_]); }
#pragma unroll
            for (int k = 0; k < 8; ++k) { const int s_ = k & 1, m_ = (k >> 1) & 1, t_ = 2 + (k >> 2); S[t_] = MFMA8(A0[k], Vb[m_][s_], S[t_]); }
#undef GDN_LD_MTS
#undef GDN_LD_TMS
            GDN_BAR();
            GDN_BAR();
        }
#else
        const int q = wave;
        const LAS bf16x8* WNf = (const LAS bf16x8*)(lds + FB_WN) + lane; const LAS bf16x8* QDf = (const LAS bf16x8*)(lds + FB_QD) + lane;
        const LAS bf16x8* KDTf = (const LAS bf16x8*)(lds + FB_KDT) + lane; const LAS bf16x8* QKf = (const LAS bf16x8*)(lds + FB_QK) + lane;
        const LAS v4u* Uf = (const LAS v4u*)(lds + FB_U) + (q * 2) * 128 + lane;
#pragma unroll 1
        for (int n = 0; n < 32; ++n) {
            if (n == 10) STAMPT(110, 0);
            const float cd = ((const float*)(ws + WS_CD))[bh * 32 + n];
            bf16x8 A0[8], A1[8];
#define GDN_LD_MTS(A, F, g) do { _Pragma("unroll") for (int k = 0; k < 8; ++k) { const int m_ = k & 1, s_ = (k >> 1) & 1, t_ = 2 * (g) + (k >> 2); A[k] = F[((m_ * 4 + t_) * 2 + s_) * 64]; } } while (0)
#define GDN_LD_TMS(A, F, g) do { _Pragma("unroll") for (int k = 0; k < 8; ++k) { const int s_ = k & 1, m_ = (k >> 1) & 1, t_ = 2 * (g) + (k >> 2); A[k] = F[((t_ * 2 + m_) * 2 + s_) * 64]; } } while (0)
            GDN_LD_MTS(A0, WNf, 0); GDN_LD_MTS(A1, WNf, 1);
            f32x16 av[2];
#pragma unroll
            for (int m = 0; m < 2; ++m)
#pragma unroll
                for (int hf = 0; hf < 2; ++hf) { const v4u u4 = Uf[(m * 2 + hf) * 64];
#pragma unroll
                    for (int k = 0; k < 4; ++k) { av[m][8 * hf + 2 * k] = bflo(u4[k]); av[m][8 * hf + 2 * k + 1] = bfhi(u4[k]); } }
            bf16x8 Sb[4][2];
#pragma unroll
            for (int t = 0; t < 4; ++t) { Sb[t][0] = pack8(S[t], 0); Sb[t][1] = pack8(S[t], 1); }
#pragma unroll
            for (int k = 0; k < 8; ++k) { const int m_ = k & 1, s_ = (k >> 1) & 1, t_ = (k >> 2); av[m_] = MFMA32(A0[k], Sb[t_][s_], av[m_]); }
            GDN_LD_MTS(A0, QDf, 0);
#pragma unroll
            for (int k = 0; k < 8; ++k) { const int m_ = k & 1, s_ = (k >> 1) & 1, t_ = 2 + (k >> 2); av[m_] = MFMA32(A1[k], Sb[t_][s_], av[m_]); }
            GDN_LD_MTS(A1, QDf, 1);
            f32x16 ao[2];
#pragma unroll
            for (int m = 0; m < 2; ++m)
#pragma unroll
                for (int i = 0; i < 16; ++i) ao[m][i] = 0.f;
#pragma unroll
            for (int k = 0; k < 8; ++k) { const int m_ = k & 1, s_ = (k >> 1) & 1, t_ = (k >> 2); ao[m_] = MFMA32(A0[k], Sb[t_][s_], ao[m_]); }
#pragma unroll
            for (int k = 0; k < 6; ++k) { const int s_ = k & 1, m_ = k >= 2 ? 1 : 0, mp_ = k >= 4 ? 1 : 0; A0[k] = QKf[((m_ * 2 + mp_) * 2 + s_) * 64]; }
#pragma unroll
            for (int k = 0; k < 8; ++k) { const int m_ = k & 1, s_ = (k >> 1) & 1, t_ = 2 + (k >> 2); ao[m_] = MFMA32(A1[k], Sb[t_][s_], ao[m_]); }
            GDN_LD_TMS(A1, KDTf, 0);
            bf16x8 Vb[2][2];
#pragma unroll
            for (int m = 0; m < 2; ++m) { Vb[m][0] = pack8(av[m], 0); Vb[m][1] = pack8(av[m], 1); }
#pragma unroll
            for (int k = 0; k < 6; ++k) { const int s_ = k & 1, m_ = k >= 2 ? 1 : 0, mp_ = k >= 4 ? 1 : 0; ao[m_] = MFMA32(A0[k], Vb[mp_][s_], ao[m_]); }
            GDN_LD_TMS(A0, KDTf, 1);
            {   LAS float* Ob = OL + (n & 1) * OLS + 32 * wave + c;
#pragma unroll
                for (int m = 0; m < 2; ++m)
#pragma unroll
                    for (int i = 0; i < 16; ++i) Ob[(32 * m + (i & 3) + 8 * (i >> 2) + 4 * hh) * 132] = ao[m][i]; }
#pragma unroll
            for (int t = 0; t < 4; ++t)
#pragma unroll
                for (int i = 0; i < 16; ++i) S[t][i] *= cd;
#pragma unroll
            for (int k = 0; k < 8; ++k) { const int s_ = k & 1, m_ = (k >> 1) & 1, t_ = (k >> 2); S[t_] = MFMA32(A1[k], Vb[m_][s_], S[t_]); }
#pragma unroll
            for (int k = 0; k < 8; ++k) { const int s_ = k & 1, m_ = (k >> 1) & 1, t_ = 2 + (k >> 2); S[t_] = MFMA32(A0[k], Vb[m_][s_], S[t_]); }
#undef GDN_LD_MTS
#undef GDN_LD_TMS
            if (n == 10) STAMPT(111, 0);
            GDN_BAR();
            if (n == 10) STAMPT(112, 0);
            GDN_BAR();
            if (n == 10) STAMPT(113, 0);
        }
#endif
        GDN_BAR(); GDN_BAR();
    } else {
        v4u pfA[NPC], pfB[NPC];
        LAS float* NWl = OL + 2 * OLS;
        if (et < 128) NWl[et] = nw[et];
        GDN_FETCH(pfB, 0); GDN_FETCH(pfA, 1); GDN_STORE(pfB);
        GDN_BAR();
        const int i = et >> 2, qd = et & 3;
#define GDN_LOADER_ITER(n, PF_FETCH, PF_STORE) do { \
            if ((n) == 10) STAMPT(120, 256); \
            if ((n) + 2 < 32) GDN_FETCH(PF_FETCH, (n) + 2); \
            if ((n) > 0) { \
                const LAS float* Ob = OL + (((n) - 1) & 1) * OLS + i * 132 + 32 * qd; \
                float ss = 0.f; \
                _Pragma("unroll") for (int k = 0; k < 8; ++k) { const f32x4 v_ = *(const LAS f32x4*)(Ob + 4 * k); ss += (v_.x * v_.x + v_.y * v_.y) + (v_.z * v_.z + v_.w * v_.w); } \
                ss += __shfl_xor(ss, 1); ss += __shfl_xor(ss, 2); \
                const float rs = rsqrtf(ss * (1.f / 128.f) + NORM_EPS); \
                bf16* op = OB + ((size_t)b * SEQ + ((n) - 1) * 64 + i) * 1024 + 512 + h * 128 + 32 * qd; \
                _Pragma("unroll") for (int k = 0; k < 4; ++k) { const f32x4 w0 = *(const LAS f32x4*)(NWl + 32 * qd + 8 * k), w1 = *(const LAS f32x4*)(NWl + 32 * qd + 8 * k + 4); const v4u gg = gq[k]; \
                    const f32x4 a0 = *(const LAS f32x4*)(Ob + 8 * k), a1 = *(const LAS f32x4*)(Ob + 8 * k + 4); \
                    v4u o; o.x = bfc2(a0.x * rs * w0.x * GSILU(bflo(gg.x)), a0.y * rs * w0.y * GSILU(bfhi(gg.x))); o.y = bfc2(a0.z * rs * w0.z * GSILU(bflo(gg.y)), a0.w * rs * w0.w * GSILU(bfhi(gg.y))); \
                    o.z = bfc2(a1.x * rs * w1.x * GSILU(bflo(gg.z)), a1.y * rs * w1.y * GSILU(bfhi(gg.z))); o.w = bfc2(a1.z * rs * w1.z * GSILU(bflo(gg.w)), a1.w * rs * w1.w * GSILU(bfhi(gg.w))); \
                    *(v4u*)(op + 8 * k) = o; } \
            } \
            asm volatile("" ::: "memory"); \
            if ((n) < 32) { const bf16* gp = HP + ((size_t)b * SEQ + (n) * 64 + i) * HP_LD + COL_GG + h * 128 + 32 * qd;     \
                _Pragma("unroll") for (int k = 0; k < 4; ++k) gq[k] = *(const v4u*)(gp + 8 * k); } \
            if ((n) == 10) STAMPT(121, 256); \
            GDN_BAR();            \
            if ((n) == 10) STAMPT(122, 256); \
            if ((n) + 1 < 32) GDN_STORE(PF_STORE); \
            if ((n) == 10) STAMPT(123, 256); \
            GDN_BAR();            \
            if ((n) == 10) STAMPT(124, 256); \
        } while (0)
        v4u gq[4];
#pragma unroll
        for (int k = 0; k < 4; ++k) gq[k] = (v4u){0u, 0u, 0u, 0u};
#pragma unroll
        for (int n = 0; n < 32; n += 2) {
            GDN_LOADER_ITER(n, pfB, pfA);
            GDN_LOADER_ITER(n + 1, pfA, pfB);
        }
        GDN_LOADER_ITER(32, pfB, pfA);
#undef GDN_LOADER_ITER
    }
#undef GDN_FETCH
#undef GDN_STORE
}

__device__ __forceinline__ void gdn_scan_helper(KArgs a, int bh, int tid) {
    unsigned char* ws = a->ws;
    const unsigned char* gWN = (const unsigned char*)(ws + WS_R + R_WN) + (size_t)bh * 32 * 16384; const unsigned char* gQD = (const unsigned char*)(ws + WS_R + R_QD) + (size_t)bh * 32 * 16384;
    const unsigned char* gKDT = (const unsigned char*)(ws + WS_R + R_KDT) + (size_t)bh * 32 * 16384; const unsigned char* gQK = (const unsigned char*)(ws + WS_R + R_QK) + (size_t)bh * 32 * 8192;
    const unsigned char* gU = (const unsigned char*)(ws + WS_R + R_U) + (size_t)bh * 32 * 16384;
#pragma unroll 1
    for (int n = 0; n < 32; ++n) {
        v4u pf[9];
#pragma unroll
        for (int k = 0; k < 9; ++k) { const int kk = 2 * k + (tid >> 8), et = tid & 255;
            const unsigned char* src_ = kk < 4 ? gWN + (size_t)n * 16384 + kk * 4096 : kk < 8 ? gQD + (size_t)n * 16384 + (kk - 4) * 4096 :
                kk < 12 ? gKDT + (size_t)n * 16384 + (kk - 8) * 4096 : kk < 14 ? gQK + (size_t)n * 8192 + (kk - 12) * 4096 : gU + (size_t)n * 16384 + (kk - 14) * 4096;
            pf[k] = *(const v4u*)(src_ + et * 16); }
#pragma unroll
        for (int k = 0; k < 9; ++k) asm volatile("" :: "v"(pf[k]));
    }
}

__device__ __forceinline__ void gdn_scan_v3(KArgs a, int l, int bhq, LAS unsigned char* lds, int tid, int lane, int wave) {
    unsigned char* ws = a->ws;
    constexpr int FB_WN = 0, FB_QD = 16384, FB_KDT = 32768, FB_QK = 49152, FB_U = 57344, IMG = 61440;
    constexpr int OLS = 64 * 36;
    LAS float* OL = (LAS float*)(lds + 2 * IMG);
    const int bh = bhq >> 2, q = bhq & 3, h = bh & 3, b = bh >> 2, c = lane & 31, hh = lane >> 5;
    bf16* OB = (bf16*)(ws + WS_R + R_OB); float* SSQ = (float*)(ws + WS_SSQ);
    const unsigned char* gWN = (const unsigned char*)(ws + WS_R + R_WN) + (size_t)bh * 32 * 16384; const unsigned char* gQD = (const unsigned char*)(ws + WS_R + R_QD) + (size_t)bh * 32 * 16384;
    const unsigned char* gKDT = (const unsigned char*)(ws + WS_R + R_KDT) + (size_t)bh * 32 * 16384; const unsigned char* gQK = (const unsigned char*)(ws + WS_R + R_QK) + (size_t)bh * 32 * 8192;
    const unsigned char* gU = (const unsigned char*)(ws + WS_R + R_U) + (size_t)bh * 32 * 16384 + q * 4096;
    const int et = tid - 256;
#define G3_FETCH(pf, nn) do { _Pragma("unroll") for (int k = 0; k < 15; ++k) { const unsigned char* src_ = k < 4 ? gWN + (size_t)(nn) * 16384 + k * 4096 : k < 8 ? gQD + (size_t)(nn) * 16384 + (k - 4) * 4096 : \
        k < 12 ? gKDT + (size_t)(nn) * 16384 + (k - 8) * 4096 : k < 14 ? gQK + (size_t)(nn) * 8192 + (k - 12) * 4096 : gU + (size_t)(nn) * 16384; pf[k] = *(const v4u*)(src_ + et * 16); } } while (0)
#define G3_STORE(pf, buf) do { _Pragma("unroll") for (int k = 0; k < 15; ++k) *(LAS v4u*)(lds + (buf) * IMG + k * 4096 + et * 16) = pf[k]; } while (0)
    __syncthreads();
    if (wave == 0) {
        f32x16 S[4];
#pragma unroll
        for (int t = 0; t < 4; ++t)
#pragma unroll
            for (int i = 0; i < 16; ++i) S[t][i] = 0.f;
        GDN_BAR();
#pragma unroll 1
        for (int n = 0; n < 32; ++n) {
            const LAS unsigned char* img = lds + (n & 1) * IMG;
            const LAS bf16x8* WNf = (const LAS bf16x8*)(img + FB_WN) + lane; const LAS bf16x8* QDf = (const LAS bf16x8*)(img + FB_QD) + lane;
            const LAS bf16x8* KDTf = (const LAS bf16x8*)(img + FB_KDT) + lane; const LAS bf16x8* QKf = (const LAS bf16x8*)(img + FB_QK) + lane;
            const LAS v4u* Uf = (const LAS v4u*)(img + FB_U) + lane;
            const float cd = ((const float*)(ws + WS_CD))[bh * 32 + n];
            bf16x8 A0[8], A1[8];
#define G3_LD_MTS(A, F, g) do { _Pragma("unroll") for (int k = 0; k < 8; ++k) { const int m_ = k & 1, s_ = (k >> 1) & 1, t_ = 2 * (g) + (k >> 2); A[k] = F[((m_ * 4 + t_) * 2 + s_) * 64]; } } while (0)
#define G3_LD_TMS(A, F, g) do { _Pragma("unroll") for (int k = 0; k < 8; ++k) { const int s_ = k & 1, m_ = (k >> 1) & 1, t_ = 2 * (g) + (k >> 2); A[k] = F[((t_ * 2 + m_) * 2 + s_) * 64]; } } while (0)
            G3_LD_MTS(A0, WNf, 0); G3_LD_MTS(A1, WNf, 1);
            f32x16 av[2];
#pragma unroll
            for (int m = 0; m < 2; ++m)
#pragma unroll
                for (int hf = 0; hf < 2; ++hf) { const v4u u4 = Uf[(m * 2 + hf) * 64];
#pragma unroll
                    for (int k = 0; k < 4; ++k) { av[m][8 * hf + 2 * k] = bflo(u4[k]); av[m][8 * hf + 2 * k + 1] = bfhi(u4[k]); } }
            bf16x8 Sb[4][2];
#pragma unroll
            for (int t = 0; t < 4; ++t) { Sb[t][0] = pack8(S[t], 0); Sb[t][1] = pack8(S[t], 1); }
#pragma unroll
            for (int k = 0; k < 8; ++k) { const int m_ = k & 1, s_ = (k >> 1) & 1, t_ = (k >> 2); av[m_] = MFMA32(A0[k], Sb[t_][s_], av[m_]); }
            G3_LD_MTS(A0, QDf, 0);
#pragma unroll
            for (int k = 0; k < 8; ++k) { const int m_ = k & 1, s_ = (k >> 1) & 1, t_ = 2 + (k >> 2); av[m_] = MFMA32(A1[k], Sb[t_][s_], av[m_]); }
            G3_LD_MTS(A1, QDf, 1);
            f32x16 ao[2];
#pragma unroll
            for (int m = 0; m < 2; ++m)
#pragma unroll
                for (int i = 0; i < 16; ++i) ao[m][i] = 0.f;
#pragma unroll
            for (int k = 0; k < 8; ++k) { const int m_ = k & 1, s_ = (k >> 1) & 1, t_ = (k >> 2); ao[m_] = MFMA32(A0[k], Sb[t_][s_], ao[m_]); }
#pragma unroll
            for (int k = 0; k < 6; ++k) { const int s_ = k & 1, m_ = k >= 2 ? 1 : 0, mp_ = k >= 4 ? 1 : 0; A0[k] = QKf[((m_ * 2 + mp_) * 2 + s_) * 64]; }
#pragma unroll
            for (int k = 0; k < 8; ++k) { const int m_ = k & 1, s_ = (k >> 1) & 1, t_ = 2 + (k >> 2); ao[m_] = MFMA32(A1[k], Sb[t_][s_], ao[m_]); }
            G3_LD_TMS(A1, KDTf, 0);
            bf16x8 Vb[2][2];
#pragma unroll
            for (int m = 0; m < 2; ++m) { Vb[m][0] = pack8(av[m], 0); Vb[m][1] = pack8(av[m], 1); }
#pragma unroll
            for (int k = 0; k < 6; ++k) { const int s_ = k & 1, m_ = k >= 2 ? 1 : 0, mp_ = k >= 4 ? 1 : 0; ao[m_] = MFMA32(A0[k], Vb[mp_][s_], ao[m_]); }
            G3_LD_TMS(A0, KDTf, 1);
            {   LAS float* Ob = OL + (n & 1) * OLS + c;
#pragma unroll
                for (int m = 0; m < 2; ++m)
#pragma unroll
                    for (int i = 0; i < 16; ++i) Ob[(32 * m + (i & 3) + 8 * (i >> 2) + 4 * hh) * 36] = ao[m][i]; }
#pragma unroll
            for (int t = 0; t < 4; ++t)
#pragma unroll
                for (int i = 0; i < 16; ++i) S[t][i] *= cd;
#pragma unroll
            for (int k = 0; k < 8; ++k) { const int s_ = k & 1, m_ = (k >> 1) & 1, t_ = (k >> 2); S[t_] = MFMA32(A1[k], Vb[m_][s_], S[t_]); }
#pragma unroll
            for (int k = 0; k < 8; ++k) { const int s_ = k & 1, m_ = (k >> 1) & 1, t_ = 2 + (k >> 2); S[t_] = MFMA32(A0[k], Vb[m_][s_], S[t_]); }
#undef G3_LD_MTS
#undef G3_LD_TMS
            GDN_BAR();
        }
    } else if (wave >= 4) {
        v4u pfE[15], pfO[15];
        G3_FETCH(pfE, 0); G3_FETCH(pfO, 1); G3_STORE(pfE, 0);
        GDN_BAR();
        const int i = et >> 2, p = et & 3;
#define G3_OUT(m) do { const LAS float* Ob = OL + ((m) & 1) * OLS + i * 36 + 8 * p; const f32x4 o0 = *(const LAS f32x4*)Ob, o1 = *(const LAS f32x4*)(Ob + 4); \
            float ss = (o0.x * o0.x + o0.y * o0.y) + (o0.z * o0.z + o0.w * o0.w) + (o1.x * o1.x + o1.y * o1.y) + (o1.z * o1.z + o1.w * o1.w); \
            ss += __shfl_xor(ss, 1); ss += __shfl_xor(ss, 2); \
            const size_t t_ = (size_t)b * SEQ + (m) * 64 + i; \
            v4u w_; w_.x = bfc2(o0.x, o0.y); w_.y = bfc2(o0.z, o0.w); w_.z = bfc2(o1.x, o1.y); w_.w = bfc2(o1.z, o1.w); \
            *(v4u*)(OB + t_ * 1024 + 512 + h * 128 + 32 * q + 8 * p) = w_; \
            if (p == 0) SSQ[(t_ * 4 + h) * 4 + q] = ss; } while (0)
#define G3_LOADER_ITER(n, PF_FETCH, PF_STORE) do { \
            if ((n) + 2 < 32) G3_FETCH(PF_FETCH, (n) + 2); \
            if ((n) > 0) G3_OUT((n) - 1); \
            if ((n) + 1 < 32) G3_STORE(PF_STORE, ((n) + 1) & 1); \
            GDN_BAR(); \
        } while (0)
#pragma unroll
        for (int n = 0; n < 32; n += 2) {
            G3_LOADER_ITER(n, pfE, pfO);
            G3_LOADER_ITER(n + 1, pfO, pfE);
        }
        G3_OUT(31);
#undef G3_LOADER_ITER
#undef G3_OUT
    } else {
        GDN_BAR();
#pragma unroll 1
        for (int n = 0; n < 32; ++n) GDN_BAR();
    }
#undef G3_FETCH
#undef G3_STORE
}
__device__ __forceinline__ void gdn_finalize(KArgs a, int l, int lane, int gw, int NGW) {
    unsigned char* ws = a->ws;
    const bf16* HP = (const bf16*)(ws + WS_R + R_HP); bf16* OB = (bf16*)(ws + WS_R + R_OB); const float* SSQ = (const float*)(ws + WS_SSQ);
    const int hd = lane >> 4, cb = (lane & 15) * 8;
    const float* nw = a->in[5] + l * 128 + cb;
    const f32x4 w0 = *(const f32x4*)nw, w1 = *(const f32x4*)(nw + 4);
    for (int t0 = gw * 4; t0 < M; t0 += NGW * 4) {
        v4u raw[4], gg[4]; f32x4 sq[4];
#pragma unroll
        for (int k = 0; k < 4; ++k) { const size_t t = (size_t)t0 + k; raw[k] = *(const v4u*)(OB + t * 1024 + 512 + hd * 128 + cb); gg[k] = *(const v4u*)(HP + t * HP_LD + COL_GG + hd * 128 + cb); sq[k] = *(const f32x4*)(SSQ + (t * 4 + hd) * 4); }
#pragma unroll
        for (int k = 0; k < 4; ++k) { const size_t t = (size_t)t0 + k; const float rs = rsqrtf(((sq[k].x + sq[k].y) + (sq[k].z + sq[k].w)) * (1.f / 128.f) + NORM_EPS);
            v4u o; o.x = bfc2(bflo(raw[k].x) * rs * w0.x * siluf(bflo(gg[k].x)), bfhi(raw[k].x) * rs * w0.y * siluf(bfhi(gg[k].x))); o.y = bfc2(bflo(raw[k].y) * rs * w0.z * siluf(bflo(gg[k].y)), bfhi(raw[k].y) * rs * w0.w * siluf(bfhi(gg[k].y)));
            o.z = bfc2(bflo(raw[k].z) * rs * w1.x * siluf(bflo(gg[k].z)), bfhi(raw[k].z) * rs * w1.y * siluf(bfhi(gg[k].z))); o.w = bfc2(bflo(raw[k].w) * rs * w1.z * siluf(bflo(gg[k].w)), bfhi(raw[k].w) * rs * w1.w * siluf(bfhi(gg[k].w)));
            *(v4u*)(OB + t * 1024 + 512 + hd * 128 + cb) = o; }
    }
}

struct RetLds {
    static constexpr int QS = 72, JS = 136;
    static constexpr int P = 0, Q1 = 34816, K1 = 53248, OL = 0, K1T = 71680, VT = 89088, ST = 123904;
};
template <bool WANT_Q, bool WANT_K1, bool WANT_K1T>
__device__ __forceinline__ void ret_stage(const bf16* HP, const float* RT, int b, int h, int n, float lg, LAS unsigned char* lds, int tid) {
    constexpr int QS = RetLds::QS, JS = RetLds::JS;
    LAS bf16* Q1 = (LAS bf16*)(lds + RetLds::Q1); LAS bf16* K1 = (LAS bf16*)(lds + RetLds::K1); LAS bf16* K1T = (LAS bf16*)(lds + RetLds::K1T); LAS bf16* VT = (LAS bf16*)(lds + RetLds::VT);
    const int i = tid >> 2, dd = (tid & 3) * 8, pos = n * 128 + i; const size_t t = (size_t)b * SEQ + pos;
    const bf16* hp = HP + t * HP_LD;
    const f32x4 c0 = *(const f32x4*)(RT + pos * 64 + dd), c1 = *(const f32x4*)(RT + pos * 64 + dd + 4), s0 = *(const f32x4*)(RT + pos * 64 + 32 + dd), s1 = *(const f32x4*)(RT + pos * 64 + 32 + dd + 4);
    const float cs[8] = {c0.x, c0.y, c0.z, c0.w, c1.x, c1.y, c1.z, c1.w}, sn[8] = {s0.x, s0.y, s0.z, s0.w, s1.x, s1.y, s1.z, s1.w};
    const float sq = exp2f((float)i * lg), sk = 0.125f * exp2f(-(float)i * lg);
    v4u xv[4];
#pragma unroll
    for (int p = 0; p < 4; ++p) { const int idx = tid + 512 * p, j = idx >> 4, e0 = (idx & 15) * 8; xv[p] = *(const v4u*)(HP + ((size_t)b * SEQ + n * 128 + j) * HP_LD + COL_RV + h * 128 + e0); }
#pragma unroll
    for (int which = (WANT_Q ? 0 : 1); which < 2; ++which) {
        const bf16* src = hp + (which == 0 ? COL_RQ : COL_RK) + h * 64 + dd;
        const v4u x1 = *(const v4u*)src, x2 = *(const v4u*)(src + 32);
        const float sc = which == 0 ? sq : sk;
        float lo[8], hi[8];
#pragma unroll
        for (int k = 0; k < 4; ++k) { const float a0 = bflo(x1[k]), a1 = bfhi(x1[k]), b0 = bflo(x2[k]), b1 = bfhi(x2[k]);
            lo[2 * k] = (a0 * cs[2 * k] - b0 * sn[2 * k]) * sc; lo[2 * k + 1] = (a1 * cs[2 * k + 1] - b1 * sn[2 * k + 1]) * sc;
            hi[2 * k] = (a0 * sn[2 * k] + b0 * cs[2 * k]) * sc; hi[2 * k + 1] = (a1 * sn[2 * k + 1] + b1 * cs[2 * k + 1]) * sc; }
        v4u wl, wh;
#pragma unroll
        for (int k = 0; k < 4; ++k) { wl[k] = bfc2(lo[2 * k], lo[2 * k + 1]); wh[k] = bfc2(hi[2 * k], hi[2 * k + 1]); }
        if (which == 0 || WANT_K1) { LAS bf16* dst = (which == 0 ? Q1 : K1) + i * QS + dd; *(LAS v4u*)dst = wl; *(LAS v4u*)(dst + 32) = wh; }
        if (which == 1 && WANT_K1T) {
#pragma unroll
            for (int k = 0; k < 4; ++k) { K1T[(dd + 2 * k) * JS + i] = (bf16)(wl[k] & 0xffffu); K1T[(dd + 2 * k + 1) * JS + i] = (bf16)(wl[k] >> 16);
                K1T[(32 + dd + 2 * k) * JS + i] = (bf16)(wh[k] & 0xffffu); K1T[(32 + dd + 2 * k + 1) * JS + i] = (bf16)(wh[k] >> 16); }
        }
    }
#pragma unroll
    for (int p = 0; p < 4; ++p) { const int idx = tid + 512 * p, j = idx >> 4, e0 = (idx & 15) * 8;
#pragma unroll
        for (int k = 0; k < 4; ++k) { VT[(e0 + 2 * k) * JS + j] = (bf16)(xv[p][k] & 0xffffu); VT[(e0 + 2 * k + 1) * JS + j] = (bf16)(xv[p][k] >> 16); } }
}
__device__ __forceinline__ void ret_kv_unit(KArgs a, int unit, LAS unsigned char* lds, int tid, int lane, int wave) {
    unsigned char* ws = a->ws;
    constexpr int JS = RetLds::JS;
    const int n = unit & 15, bh = unit >> 4, h = bh & 3, b = bh >> 2, c = lane & 31, hh = lane >> 5;
    const bf16* HP = (const bf16*)(ws + WS_R + R_HP); const float* RT = (const float*)(ws + WS_ROPE);
    const float gam = 1.0f - exp2f(-5.0f - (float)h), lg = log2f(gam), g127 = exp2f(127.f * lg);
    LAS bf16* K1T = (LAS bf16*)(lds + RetLds::K1T); LAS bf16* VT = (LAS bf16*)(lds + RetLds::VT);
    __syncthreads();
    ret_stage<false, false, true>(HP, RT, b, h, n, lg, lds, tid);
    __syncthreads();
    const int td = wave >> 2, te = wave & 3;
    f32x16 kv;
#pragma unroll
    for (int i = 0; i < 16; ++i) kv[i] = 0.f;
#pragma unroll
    for (int ks = 0; ks < 8; ++ks) kv = MFMA32(*(const LAS bf16x8*)(K1T + (32 * td + c) * JS + 16 * ks + 8 * hh), *(const LAS bf16x8*)(VT + (32 * te + c) * JS + 16 * ks + 8 * hh), kv);
    float* dst = (float*)(ws + WS_KV) + ((size_t)(unit * 8 + wave) * 64 + lane) * 16;
#pragma unroll
    for (int g = 0; g < 4; ++g) *(f32x4*)(dst + 4 * g) = (f32x4){kv[4 * g] * g127, kv[4 * g + 1] * g127, kv[4 * g + 2] * g127, kv[4 * g + 3] * g127};
}
__device__ __forceinline__ void ret_out_unit(KArgs a, int unit, LAS unsigned char* lds, int tid, int lane, int wave) {
    unsigned char* ws = a->ws;
    constexpr int QS = RetLds::QS, JS = RetLds::JS;
    LAS bf16* P = (LAS bf16*)(lds + RetLds::P); LAS bf16* Q1 = (LAS bf16*)(lds + RetLds::Q1); LAS bf16* K1 = (LAS bf16*)(lds + RetLds::K1); LAS float* OL = (LAS float*)(lds + RetLds::OL);
    LAS bf16* VT = (LAS bf16*)(lds + RetLds::VT); LAS bf16* ST = (LAS bf16*)(lds + RetLds::ST);
    const int n = unit & 15, bh = unit >> 4, h = bh & 3, b = bh >> 2, c = lane & 31, hh = lane >> 5;
    const bf16* HP = (const bf16*)(ws + WS_R + R_HP); bf16* OB = (bf16*)(ws + WS_R + R_OB); const float* RT = (const float*)(ws + WS_ROPE);
    const float gam = 1.0f - exp2f(-5.0f - (float)h), lg = log2f(gam), g128 = exp2f(128.f * lg);
    __syncthreads();
    const int ei = tid >> 2, eq = tid & 3; const size_t et = (size_t)b * SEQ + n * 128 + ei;
    v4u gg[4];
    { const bf16* gp = HP + et * HP_LD + COL_RG + h * 128 + 32 * eq;
#pragma unroll
      for (int k = 0; k < 4; ++k) gg[k] = *(const v4u*)(gp + 8 * k); }
    {
        const int td = wave >> 2, te = wave & 3;
        f32x16 S;
#pragma unroll
        for (int i = 0; i < 16; ++i) S[i] = 0.f;
        const float* src = (const float*)(ws + WS_KV) + ((size_t)((bh * 16) * 8 + wave) * 64 + lane) * 16;
#pragma unroll 2
        for (int m = 0; m < n; ++m) { const f32x4* p4 = (const f32x4*)(src + (size_t)m * 8 * 64 * 16);
#pragma unroll
            for (int g = 0; g < 4; ++g) { const f32x4 v = p4[g]; S[4 * g] = S[4 * g] * g128 + v.x; S[4 * g + 1] = S[4 * g + 1] * g128 + v.y; S[4 * g + 2] = S[4 * g + 2] * g128 + v.z; S[4 * g + 3] = S[4 * g + 3] * g128 + v.w; } }
#pragma unroll
        for (int g = 0; g < 4; ++g) { v2u w; w.x = bfc2(S[4 * g], S[4 * g + 1]); w.y = bfc2(S[4 * g + 2], S[4 * g + 3]); *(LAS v2u*)(ST + (32 * te + c) * QS + 32 * td + 8 * g + 4 * hh) = w; }
    }
    ret_stage<true, true, false>(HP, RT, b, h, n, lg, lds, tid);
    __syncthreads();
#pragma unroll 1
    for (int rep = 0; rep < 2; ++rep) { const int idx = wave + 8 * rep;
        if (idx < 10) { const int ti = (idx >= 1) + (idx >= 3) + (idx >= 6), tj = idx - ti * (ti + 1) / 2;
            f32x16 acc;
#pragma unroll
            for (int i = 0; i < 16; ++i) acc[i] = 0.f;
#pragma unroll
            for (int s2 = 0; s2 < 4; ++s2) acc = MFMA32(*(const LAS bf16x8*)(Q1 + (32 * ti + c) * QS + 16 * s2 + 8 * hh), *(const LAS bf16x8*)(K1 + (32 * tj + c) * QS + 16 * s2 + 8 * hh), acc);
#pragma unroll
            for (int i = 0; i < 16; ++i) { const int il = (i & 3) + 8 * (i >> 2) + 4 * hh; float v = acc[i]; if (ti == tj && il < c) v = 0.f; P[(32 * ti + il) * JS + 32 * tj + c] = bfc(v); } } }
    __syncthreads();
    const int ti = wave >> 1, te0 = 2 * (wave & 1);
    f32x16 ao[2];
#pragma unroll
    for (int u = 0; u < 2; ++u)
#pragma unroll
        for (int i = 0; i < 16; ++i) ao[u][i] = 0.f;
#pragma unroll
    for (int s2 = 0; s2 < 4; ++s2) { const bf16x8 A = *(const LAS bf16x8*)(Q1 + (32 * ti + c) * QS + 16 * s2 + 8 * hh);
#pragma unroll
        for (int u = 0; u < 2; ++u) ao[u] = MFMA32(A, *(const LAS bf16x8*)(ST + (32 * (te0 + u) + c) * QS + 16 * s2 + 8 * hh), ao[u]); }
#pragma unroll
    for (int u = 0; u < 2; ++u)
#pragma unroll
        for (int i = 0; i < 16; ++i) ao[u][i] *= gam;
#pragma unroll 1
    for (int tj = 0; tj <= ti; ++tj)
#pragma unroll
        for (int s2 = 0; s2 < 2; ++s2) { const bf16x8 A = *(const LAS bf16x8*)(P + (32 * ti + c) * JS + 32 * tj + 16 * s2 + 8 * hh);
#pragma unroll
            for (int u = 0; u < 2; ++u) ao[u] = MFMA32(A, *(const LAS bf16x8*)(VT + (32 * (te0 + u) + c) * JS + 32 * tj + 16 * s2 + 8 * hh), ao[u]); }
    __syncthreads();
#pragma unroll
    for (int u = 0; u < 2; ++u)
#pragma unroll
        for (int i = 0; i < 16; ++i) OL[(32 * ti + (i & 3) + 8 * (i >> 2) + 4 * hh) * 132 + 32 * (te0 + u) + c] = ao[u][i];
    __syncthreads();
    {
        const LAS float* Ob = OL + ei * 132 + 32 * eq; bf16* op = OB + et * 1024 + h * 128 + 32 * eq;
        f32x4 v[8]; float sm = 0.f;
#pragma unroll
        for (int k = 0; k < 8; ++k) { v[k] = *(const LAS f32x4*)(Ob + 4 * k); sm += (v[k].x + v[k].y) + (v[k].z + v[k].w); }
        sm += __shfl_xor(sm, 1); sm += __shfl_xor(sm, 2);
        const float mean = sm * (1.f / 128.f); float sq = 0.f;
#pragma unroll
        for (int k = 0; k < 8; ++k) { v[k] = v[k] - mean; sq += (v[k].x * v[k].x + v[k].y * v[k].y) + (v[k].z * v[k].z + v[k].w * v[k].w); }
        sq += __shfl_xor(sq, 1); sq += __shfl_xor(sq, 2);
        const float rs = rsqrtf(sq * (1.f / 128.f) + LN_EPS);
#pragma unroll
        for (int k = 0; k < 4; ++k) { const v4u g4 = gg[k]; const f32x4 a0 = v[2 * k], a1 = v[2 * k + 1];
            v4u o; o.x = bfc2(a0.x * rs * siluf(bflo(g4.x)), a0.y * rs * siluf(bfhi(g4.x))); o.y = bfc2(a0.z * rs * siluf(bflo(g4.y)), a0.w * rs * siluf(bfhi(g4.y)));
            o.z = bfc2(a1.x * rs * siluf(bflo(g4.z)), a1.y * rs * siluf(bfhi(g4.z))); o.w = bfc2(a1.z * rs * siluf(bflo(g4.w)), a1.w * rs * siluf(bfhi(g4.w)));
            *(v4u*)(op + 8 * k) = o; }
    }
}

__device__ __forceinline__ float sum16(float v) {
    v += __builtin_bit_cast(float, __builtin_amdgcn_update_dpp(0, __builtin_bit_cast(int, v), 0xB1, 0xF, 0xF, true));
    v += __builtin_bit_cast(float, __builtin_amdgcn_update_dpp(0, __builtin_bit_cast(int, v), 0x4E, 0xF, 0xF, true));
    v += __builtin_bit_cast(float, __builtin_amdgcn_update_dpp(0, __builtin_bit_cast(int, v), 0x141, 0xF, 0xF, true));
    v += __builtin_bit_cast(float, __builtin_amdgcn_update_dpp(0, __builtin_bit_cast(int, v), 0x140, 0xF, 0xF, true));
    return v;
}
__device__ __forceinline__ void gdn_prep_fast(KArgs a, int l, int unit, LAS unsigned char* lds, int tid, int lane, int wave) {
    asm volatile("" : "+v"(tid)); lane = tid & 63; wave = __builtin_amdgcn_readfirstlane(tid >> 6);
    unsigned char* ws = a->ws;
    constexpr int KS = 136;
    LAS bf16* Kb = (LAS bf16*)lds;
    LAS bf16* Qb = (LAS bf16*)(lds + 17408);
    LAS float* A = (LAS float*)(lds + 34816);
    LAS float* V = (LAS float*)(lds + 51200);
    LAS float* KW = (LAS float*)(lds + 83968);
    LAS float* gc = (LAS float*)(lds + 116736);
    LAS float* bt = gc + 64;
    LAS bf16* KDs = (LAS bf16*)(lds + 117248);
    LAS bf16* XT = (LAS bf16*)lds;
    LAS bf16* A10b = (LAS bf16*)(lds + 135680);
    const int n = unit & 31, bh = unit >> 5, h = bh & 3, b = bh >> 2, t0 = b * SEQ + n * 64, c = lane & 31, hh = lane >> 5;
    const bf16* HP = (const bf16*)(ws + WS_R + R_HP);
    constexpr int F8D = GDN_F8 ? 2 : 1;
    bf16* QKg = (bf16*)(ws + WS_R + R_QK) + (size_t)unit * (4096 / F8D); bf16* QDg = (bf16*)(ws + WS_R + R_QD) + (size_t)unit * (8192 / F8D); bf16* KDTg = (bf16*)(ws + WS_R + R_KDT) + (size_t)unit * (8192 / F8D);
    bf16* WNg = (bf16*)(ws + WS_R + R_WN) + (size_t)unit * (8192 / F8D); bf16* Ug = (bf16*)(ws + WS_R + R_U) + (size_t)unit * 8192;
    __syncthreads(); if (unit == PROBE_UNIT) STAMPT(130, 0);
    if (wave == 0) {
        const float* gab = (const float*)(ws + WS_GAB) + (size_t)(t0 + lane) * 8; const float x = gab[h] + a->in[4][l * 4 + h];
        const float sp = fmaxf(x, 0.f) + log1pf(__expf(-fabsf(x))); float g = -__expf(a->in[3][l * 4 + h]) * sp;
#pragma unroll
        for (int o = 1; o < 64; o <<= 1) { const float up = __shfl_up(g, o); if (lane >= o) g += up; }
        gc[lane] = g; bt[lane] = sigmf(gab[4 + h]);
        if (lane == 63) ((float*)(ws + WS_CD))[unit] = __expf(g);
    }
    __syncthreads(); if (unit == PROBE_UNIT) STAMPT(131, 0);
#ifndef PREP_NO_CONV
    if (wave < 6) {
        const int which = wave >> 1, tp = tid & 127, rb = tp >> 4, dd = (tp & 15) * 8, col = COL_GQ + which * 512 + h * 128 + dd, cc = which * 512 + h * 128 + dd;
        const float* cw = a->in[2] + (size_t)l * 4 * 1536 + cc;
        float w[4][8];
#pragma unroll
        for (int j = 0; j < 4; ++j) { const f32x4 w0 = *(const f32x4*)(cw + j * 1536), w1 = *(const f32x4*)(cw + j * 1536 + 4); w[j][0] = w0.x; w[j][1] = w0.y; w[j][2] = w0.z; w[j][3] = w0.w; w[j][4] = w1.x; w[j][5] = w1.y; w[j][6] = w1.z; w[j][7] = w1.w; }
        const int sbase = n * 64 + 8 * rb - 3;
        const bf16* hpc = HP + (size_t)(b * SEQ) * HP_LD + col;
        v4u raw[11];
#pragma unroll
        for (int r = 0; r < 11; ++r) { raw[r] = (v4u){0u, 0u, 0u, 0u}; if (sbase + r >= 0) raw[r] = *(const v4u*)(hpc + (size_t)(sbase + r) * HP_LD); }
        const float gl = gc[63];
#pragma unroll
        for (int r = 0; r < 8; ++r) { const int i = 8 * rb + r; float y[8]; float ss = 0.f;
#pragma unroll
            for (int k4 = 0; k4 < 4; ++k4) {
                unsigned d0 = raw[r][k4], d1 = raw[r + 1][k4], d2 = raw[r + 2][k4], d3 = raw[r + 3][k4];
                asm volatile("" : "+v"(d0), "+v"(d1), "+v"(d2), "+v"(d3));
                const float a0 = w[0][2 * k4] * bflo(d0) + w[1][2 * k4] * bflo(d1) + w[2][2 * k4] * bflo(d2) + w[3][2 * k4] * bflo(d3);
                const float a1 = w[0][2 * k4 + 1] * bfhi(d0) + w[1][2 * k4 + 1] * bfhi(d1) + w[2][2 * k4 + 1] * bfhi(d2) + w[3][2 * k4 + 1] * bfhi(d3);
                y[2 * k4] = siluf(a0); y[2 * k4 + 1] = siluf(a1); ss += y[2 * k4] * y[2 * k4] + y[2 * k4 + 1] * y[2 * k4 + 1]; }
            ss = sum16(ss);
            const float gi = gc[i], bi = bt[i];
            if (which == 0) { const float f = rsqrtf(ss + NORM_EPS) * 0.08838834764831845f, eg = __expf(gi);
                v4u p, pd;
#pragma unroll
                for (int k = 0; k < 4; ++k) { p[k] = bfc2(y[2 * k] * f, y[2 * k + 1] * f); pd[k] = bfc2(y[2 * k] * f * eg, y[2 * k + 1] * f * eg); }
                *(LAS v4u*)(Qb + i * KS + dd) = p;
#if GDN_F8
                { unsigned char* qd8 = (unsigned char*)QDg + (((i >> 5) * 4 + (dd >> 5)) * 2 + ((dd >> 4) & 1)) * 512 + (i & 31) * 8 + ((dd >> 3) & 1) * 4; const float fs = f * eg * F8_SQ;
                  *(unsigned*)qd8 = f8x4(y[0] * fs, y[1] * fs, y[2] * fs, y[3] * fs); *(unsigned*)(qd8 + 256) = f8x4(y[4] * fs, y[5] * fs, y[6] * fs, y[7] * fs); }
#else
                bf16* qd = QDg + (((i >> 5) * 4 + (dd >> 5)) * 2 + ((dd >> 4) & 1)) * 512 + (i & 31) * 8 + ((dd >> 3) & 1) * 4;
                *(v2u*)qd = (v2u){pd[0], pd[1]}; *(v2u*)(qd + 256) = (v2u){pd[2], pd[3]};
#endif
            } else if (which == 1) { const float f = rsqrtf(ss + NORM_EPS), fw = f * bi * __expf(gi), fd = f * __expf(gl - gi);
                v4u p;
#pragma unroll
                for (int k = 0; k < 4; ++k) p[k] = bfc2(y[2 * k] * f, y[2 * k + 1] * f);
                *(LAS v4u*)(Kb + i * KS + dd) = p;
#pragma unroll
                for (int k = 0; k < 8; ++k) { KW[i * 128 + dd + k] = y[k] * fw; KDs[(dd + k) * 72 + i] = bfc(y[k] * fd); }
            } else {
#pragma unroll
                for (int k = 0; k < 8; ++k) V[i * 128 + dd + k] = y[k] * bi;
            }
        }
    }
    if (GATE_PRE && wave >= 6) {
        const int tg = tid - 384;
#pragma unroll 2
        for (int p = 0; p < 8; ++p) { const int idx = tg + 128 * p, i = idx >> 4, g8 = (idx & 15) * 8;
            bf16* gp = (bf16*)(ws + WS_R + R_HP) + (size_t)(t0 + i) * HP_LD + COL_GG + h * 128 + g8; const v4u x = *(const v4u*)gp;
            v4u o; o.x = bfc2(siluf(bflo(x.x)), siluf(bfhi(x.x))); o.y = bfc2(siluf(bflo(x.y)), siluf(bfhi(x.y))); o.z = bfc2(siluf(bflo(x.z)), siluf(bfhi(x.z))); o.w = bfc2(siluf(bflo(x.w)), siluf(bfhi(x.w)));
            *(v4u*)gp = o; }
    }
#endif
    __syncthreads(); if (unit == PROBE_UNIT) STAMPT(132, 0);
    {
        const int ti = (wave >> 1) & 1, tj = wave & 1;
        if (wave < 4) {
            if (ti <= tj) {
                f32x16 acc;
#pragma unroll
                for (int i = 0; i < 16; ++i) acc[i] = 0.f;
#pragma unroll
                for (int s = 0; s < 8; ++s) acc = MFMA32(*(const LAS bf16x8*)(Kb + (32 * ti + c) * KS + 16 * s + 8 * hh), *(const LAS bf16x8*)(Kb + (32 * tj + c) * KS + 16 * s + 8 * hh), acc);
                const int i = 32 * tj + c; const float gi = gc[i], bi = bt[i];
#pragma unroll
                for (int r = 0; r < 16; ++r) { const int j = 32 * ti + (r & 3) + 8 * (r >> 2) + 4 * hh; const float av = (j < i) ? bi * acc[r] * __expf(gi - gc[j]) : 0.f; A[j * 64 + i] = av;
                    if (ti == 0 && tj == 1) A10b[c * 40 + j] = bfc(av); }
            } else {
#pragma unroll
                for (int r = 0; r < 16; ++r) { const int j = 32 * ti + (r & 3) + 8 * (r >> 2) + 4 * hh; A[j * 64 + 32 * tj + c] = 0.f; }
            }
        } else {
            const int kt = ti, qt = tj;
            if (kt <= qt) {
                f32x16 acc;
#pragma unroll
                for (int i = 0; i < 16; ++i) acc[i] = 0.f;
#pragma unroll
                for (int s = 0; s < 8; ++s) acc = MFMA32(*(const LAS bf16x8*)(Kb + (32 * kt + c) * KS + 16 * s + 8 * hh), *(const LAS bf16x8*)(Qb + (32 * qt + c) * KS + 16 * s + 8 * hh), acc);
                const int i = 32 * qt + c; const float gi = gc[i];
#pragma unroll
                for (int r = 0; r < 16; ++r) { const int j = 32 * kt + (r & 3) + 8 * (r >> 2) + 4 * hh; acc[r] = (j <= i) ? acc[r] * __expf(gi - gc[j]) : 0.f; }
                bf16x8* qf = (bf16x8*)QKg + lane;
#if GDN_F8
                { long* qf8 = (long*)QKg + lane; qf8[((qt * 2 + kt) * 2 + 0) * 64] = pack8_f8(acc, 0, F8_SQ); qf8[((qt * 2 + kt) * 2 + 1) * 64] = pack8_f8(acc, 1, F8_SQ); }
#else
                qf[((qt * 2 + kt) * 2 + 0) * 64] = pack8(acc, 0); qf[((qt * 2 + kt) * 2 + 1) * 64] = pack8(acc, 1);
#endif
            }
        }
    }
    __syncthreads(); if (unit == PROBE_UNIT) STAMPT(133, 0);
#ifndef PREP_NO_SOLVE
#define PREP_SOLVE32(B0) do { \
        _Pragma("unroll") for (int i = 0; i < 32; ++i) x[i] = rhs[((B0) + i) * 128]; \
        _Pragma("unroll") for (int m = 0; m < 31; ++m) { const float xm = x[m]; \
            _Pragma("unroll") for (int g = (m + 1) / 4; g < 8; ++g) { const f32x4 a4 = *(const LAS f32x4*)(A + ((B0) + m) * 64 + (B0) + 4 * g); \
                if (4 * g > m) x[4 * g] -= a4.x * xm; if (4 * g + 1 > m) x[4 * g + 1] -= a4.y * xm; if (4 * g + 2 > m) x[4 * g + 2] -= a4.z * xm; if (4 * g + 3 > m) x[4 * g + 3] -= a4.w * xm; } } \
        if (tl < 128) { _Pragma("unroll") for (int hx = 0; hx < 2; ++hx) _Pragma("unroll") for (int hf = 0; hf < 2; ++hf) { const int i0 = 16 * hf + 4 * hx; \
                v4u w_; w_.x = bfc2(x[i0], x[i0 + 1]); w_.y = bfc2(x[i0 + 2], x[i0 + 3]); w_.z = bfc2(x[i0 + 8], x[i0 + 9]); w_.w = bfc2(x[i0 + 10], x[i0 + 11]); *(v4u*)(Ug + uoff((B0) + i0, col)) = w_; } } \
        else { _Pragma("unroll") for (int i = 0; i < 32; ++i) Qb[((B0) + i) * KS + col] = bfc(-x[i]); } } while (0)
    int tl = tid; asm volatile("" : "+v"(tl));
    const int c2 = tl & 31, hh2 = (tl >> 5) & 1;
    if (wave < 4) {
        const int col = tl & 127; LAS float* rhs = (tl < 128 ? V : KW) + col;
        float x[32];
        PREP_SOLVE32(0);
        v4u p[4];
#pragma unroll
        for (int k = 0; k < 4; ++k) { p[k].x = bfc2(x[8 * k], x[8 * k + 1]); p[k].y = bfc2(x[8 * k + 2], x[8 * k + 3]); p[k].z = bfc2(x[8 * k + 4], x[8 * k + 5]); p[k].w = bfc2(x[8 * k + 6], x[8 * k + 7]); }
#pragma unroll
        for (int k = 0; k < 4; ++k) *(LAS v4u*)(XT + tl * 32 + 8 * k) = p[k];
    }
    __syncthreads();
    {
        f32x16 acc;
#pragma unroll
        for (int i = 0; i < 16; ++i) acc[i] = 0.f;
#pragma unroll
        for (int s2 = 0; s2 < 2; ++s2) acc = MFMA32(*(const LAS bf16x8*)(A10b + c2 * 40 + 16 * s2 + 8 * hh2), *(const LAS bf16x8*)(XT + (32 * wave + c2) * 32 + 16 * s2 + 8 * hh2), acc);
        LAS float* R1 = (wave < 4 ? V : KW) + 32 * (wave & 3) + c2;
#pragma unroll
        for (int r = 0; r < 16; ++r) { const int i = 32 + (r & 3) + 8 * (r >> 2) + 4 * hh2; R1[i * 128] -= acc[r]; }
    }
    __syncthreads();
    if (wave < 4) {
        const int col = tl & 127; LAS float* rhs = (tl < 128 ? V : KW) + col;
        float x[32];
        PREP_SOLVE32(32);
    }
#undef PREP_SOLVE32
#endif
    __syncthreads(); if (unit == PROBE_UNIT) STAMPT(134, 0);
#pragma unroll
    for (int p = 0; p < 4; ++p) { const int idx = tid + 512 * p, i = idx >> 5, d = (idx & 31) * 4;
#if GDN_F8
        { const v2u w2 = *(const LAS v2u*)(Qb + i * KS + d); *(unsigned*)((unsigned char*)WNg + fragoff(i, d, 4)) = f8x4(bflo(w2.x) * F8_SW, bfhi(w2.x) * F8_SW, bflo(w2.y) * F8_SW, bfhi(w2.y) * F8_SW); } }
#else
        *(v2u*)(WNg + fragoff(i, d, 4)) = *(const LAS v2u*)(Qb + i * KS + d); }
#endif
#pragma unroll
    for (int p = 0; p < 4; ++p) { const int idx = tid + 512 * p, d = idx >> 4, i = (idx & 15) * 4;
#if GDN_F8
        { const v2u k2 = *(const LAS v2u*)(KDs + d * 72 + i); *(unsigned*)((unsigned char*)KDTg + fragoff(d, i, 2)) = f8x4(bflo(k2.x) * F8_SK, bfhi(k2.x) * F8_SK, bflo(k2.y) * F8_SK, bfhi(k2.y) * F8_SK); } }
#else
        *(v2u*)(KDTg + fragoff(d, i, 2)) = *(const LAS v2u*)(KDs + d * 72 + i); }
#endif
    if (unit == PROBE_UNIT) STAMPT(135, 0);
}
#define XB_TMO      128
#define XB_XCNT(j)  (256  + 64 * (j))
#define XB_XSUB(j)  (1280 + 64 * (j))
#define XB_XGEN(j)  (2304 + 64 * (j))
#define XB_TOP      3328
#define XB_TOPGEN   3392
#define XCD_BAR_WORDS 3456
#define XB_SPIN_CAP (1u << 18)

__device__ __forceinline__ unsigned xb_ld(unsigned* p)              { return __hip_atomic_load(p, __ATOMIC_RELAXED, __HIP_MEMORY_SCOPE_AGENT); }
__device__ __forceinline__ unsigned xb_add(unsigned* p, unsigned v) { return __hip_atomic_fetch_add(p, v, __ATOMIC_RELAXED, __HIP_MEMORY_SCOPE_AGENT); }
__device__ __forceinline__ unsigned xb_xcc_id() { return (unsigned)__builtin_amdgcn_s_getreg((3 << 11) | 20) & 0xFu; }
#define XB_SPIN(cond, bar) do { unsigned _sp = 0; while (cond) { __builtin_amdgcn_s_sleep(1); \
    if ((++_sp & 255u) == 0u) { if (xb_ld(&(bar)[XB_TMO])) break; if (_sp > XB_SPIN_CAP) { atomicAdd(&(bar)[XB_TMO], 1u); break; } } } } while (0)

struct XcdBarrier {
    unsigned* bar; unsigned x;
    volatile LAS unsigned* st;
};

__device__ __forceinline__ XcdBarrier xcd_barrier_post(unsigned* bar, volatile LAS unsigned* st) {
    XcdBarrier b; b.bar = bar; b.x = xb_xcc_id(); b.st = st;
    if (threadIdx.x == 0) (void)xb_add(&bar[XB_XCNT(b.x)], 1u);
    return b;
}
__device__ __forceinline__ void xcd_barrier_complete(unsigned* bar, unsigned x, unsigned& nloc, unsigned& nx) {
    const unsigned G = gridDim.x * gridDim.y * gridDim.z;
    unsigned sum, cnt, mine, sp = 0u;
    for (;;) {
        sum = 0u; cnt = 0u; mine = 0u;
#pragma unroll
        for (unsigned j = 0; j < 16; ++j) { const unsigned c = xb_ld(&bar[XB_XCNT(j)]); sum += c; cnt += (c > 0u) ? 1u : 0u; mine = (j == x) ? c : mine; }
        if (sum == G) break;
        __builtin_amdgcn_s_sleep(1);
        if ((++sp & 255u) == 0u) { if (xb_ld(&bar[XB_TMO])) break; if (sp > XB_SPIN_CAP) { atomicAdd(&bar[XB_TMO], 1u); break; } }
    }
    nloc = mine > 0u ? mine : 1u; nx = cnt > 0u ? cnt : 1u;
}

__device__ __forceinline__ void xcd_barrier(const XcdBarrier& b) {
    asm volatile("s_waitcnt vmcnt(0)" ::: "memory");
    __syncthreads();
    if (threadIdx.x == 0) {
        unsigned* bar = b.bar;
        __builtin_amdgcn_s_waitcnt(0);
        unsigned nloc = b.st[0], nx = b.st[1];
        if (nloc == 0u) { xcd_barrier_complete(bar, b.x, nloc, nx); b.st[0] = nloc; b.st[1] = nx; }
        const unsigned old = xb_add(&bar[XB_XSUB(b.x)], 1u);
        const unsigned gen = old / nloc;
        if (old + 1u == (gen + 1u) * nloc) {
            __builtin_amdgcn_fence(__ATOMIC_RELEASE, "agent");
            asm volatile("s_waitcnt vmcnt(0)" ::: "memory");
            const unsigned og = xb_add(&bar[XB_TOP], 1u);
            const unsigned tg = og / nx;
            if (og + 1u == (tg + 1u) * nx) xb_add(&bar[XB_TOPGEN], 1u);
            else XB_SPIN(xb_ld(&bar[XB_TOPGEN]) == tg, bar);
            __builtin_amdgcn_fence(__ATOMIC_ACQUIRE, "agent");
            xb_add(&bar[XB_XGEN(b.x)], 1u);
            asm volatile("s_waitcnt vmcnt(0)" ::: "memory");
        } else {
            XB_SPIN(xb_ld(&bar[XB_XGEN(b.x)]) == gen, bar);
            __builtin_amdgcn_fence(__ATOMIC_ACQUIRE, "agent");
            asm volatile("s_waitcnt vmcnt(0)" ::: "memory");
        }
    }
    __syncthreads();
}
#ifndef REP_PRO
#define REP_PRO 1
#endif
#ifndef REP_IN
#define REP_IN 1
#endif
#ifndef REP_PREP
#define REP_PREP 1
#endif
#ifndef REP_SCAN
#define REP_SCAN 1
#endif
#ifndef REP_OUT
#define REP_OUT 1
#endif
#ifndef REP_GU
#define REP_GU 1
#endif
#ifndef REP_DN
#define REP_DN 1
#endif
#ifndef REP_MGU
#define REP_MGU 1
#endif
#ifndef REP_GDN
#define REP_GDN 1
#endif
#ifndef REP_RET
#define REP_RET 1
#endif
#ifndef KV_IN_SCAN
#define KV_IN_SCAN 0
#endif
#ifndef GDN_HELPERS
#define GDN_HELPERS 0
#endif
#ifndef GDN_SPLIT
#define GDN_SPLIT 0
#endif
#ifndef FAST_SCAN
#define FAST_SCAN 1
#endif
#ifndef FAST_RET
#define FAST_RET 1
#endif
#ifndef FAST_PREP
#define FAST_PREP 1
#endif
#ifndef EN_PRO
#define EN_PRO 1
#endif
#ifndef EN_IN
#define EN_IN 1
#endif
#ifndef EN_PREP
#define EN_PREP 1
#endif
#ifndef EN_SCAN
#define EN_SCAN 1
#endif
#ifndef EN_OUT
#define EN_OUT 1
#endif
#ifndef EN_LN1
#define EN_LN1 1
#endif
#ifndef EN_FFN0
#define EN_FFN0 1
#endif
#ifndef EN_MOE
#define EN_MOE 1
#endif

#ifndef PROBE_MULT
#define PROBE_MULT 0
#endif
#ifndef PROBE_BID
#define PROBE_BID 0
#endif
#ifndef PROBE_A
#define PROBE_A 0
#endif
#ifndef PROBE_B
#define PROBE_B 0
#endif
#if PROBE_MULT > 0
#define STAMP(id) do { if (blockIdx.x == PROBE_BID && threadIdx.x == 0) __hip_atomic_store((unsigned long long*)(kargs()->ws + WS_CTL + 131072) + (id), (unsigned long long)__builtin_amdgcn_s_memrealtime(), RLX_AGENT); } while (0)
#else
#define STAMP(id) do {} while (0)
#endif
__global__ void __launch_bounds__(NWAVES * 64, 2) fwd(Args a_unused) {
    extern __shared__ __attribute__((aligned(16))) unsigned char lds_raw[];
    LAS unsigned char* lds = (LAS unsigned char*)lds_raw;
    int stamp_no_ = 1; (void)stamp_no_;
    { const int tid0 = threadIdx.x; for (int u = tid0; u < (LDS_BYTES - LDSCTL_OFF) / 4; u += NWAVES * 64) ((LAS unsigned*)(lds + LDSCTL_OFF))[u] = 0u; }
    __syncthreads();
#if ONE_LAUNCH
    XcdBarrier bar = xcd_barrier_post((unsigned*)(kargs()->ws + WS_CTL) + CW_BAR, (volatile LAS unsigned*)(lds + MISC_OFF) + 8);
#define SEAM() do { STAMP(stamp_no_); ++stamp_no_; xcd_barrier(bar); STAMP(stamp_no_); ++stamp_no_; } while (0)
#else
#define SEAM() do {} while (0)
#endif
#define IN(k) (kargs()->ph_lo <= (k) && (k) < kargs()->ph_hi)
#define BOTH(k) (IN(k) && ((k) + 1) < kargs()->ph_hi)
#define PH_LOCALS KArgs a = kargs(); unsigned char* ws = a->ws; int G = gridDim.x, bid = blockIdx.x; asm volatile("" : "+s"(G), "+s"(bid)); const int tid = tidx(), lane = tid & 63, wave = __builtin_amdgcn_readfirstlane(tid >> 6), gw = bid * NWAVES + wave, NGW = G * NWAVES; (void)ws; (void)lane; (void)gw; (void)NGW;

    if (EN_PRO && IN(PH_PRO)) { _Pragma("unroll 1") for (int rep_ = 0; rep_ < REP_PRO; ++rep_) { if (rep_) SEAM(); PH_LOCALS; ph_prologue(a, lds, wave, lane, gw, NGW, bid * (NWAVES * 64) + tid, G * NWAVES * 64, 0, PRO_I_IN, true); } if (BOTH(PH_PRO)) SEAM(); }

#pragma unroll 1
    for (int l = 0; l < 2; ++l) {
        if (EN_IN && IN(PH_L(l, K_IN))) {
            _Pragma("unroll 1") for (int rep_ = 0; rep_ < REP_IN; ++rep_) { if (rep_) SEAM(); PH_LOCALS;
            pg8::Gemm g{(const pg8::bf16_t*)(ws + WS_XB), (const pg8::bf16_t*)(ws + WS_WIN) + (size_t)l * NIN_PAD * 1024, M, NIN_PAD, 1024}; pg8::StaticOrder S; S.init(M, NIN_PAD, G, bid);
            pg8::EpiHproj E{(pg8::bf16_t*)(ws + WS_R + R_HP), (float*)(ws + WS_GAB)};
            pg8::gemm_phase<pg8::EpiHproj, pg8::StaticOrder, PG8_ALIGN, PG8_SP2>(lds, g, S, E); }
            if (BOTH(PH_L(l, K_IN))) SEAM();
        }
        if (EN_PREP && IN(PH_L(l, K_PREP))) {
            _Pragma("unroll 1") for (int rep_ = 0; rep_ < REP_PREP; ++rep_) { if (rep_) SEAM(); PH_LOCALS; for (int u = bid; u < 1024; u += G) { if (FAST_PREP) gdn_prep_fast(a, l, u, lds, tid, lane, wave); else gdn_prep_unit(a, l, u, lds, tid, lane, wave); }
              STAMP(136); if (FAST_RET && !KV_IN_SCAN) for (int u = bid; u < 512; u += G) ret_kv_unit(a, u, lds, tid, lane, wave); STAMP(137); }
            if (BOTH(PH_L(l, K_PREP))) SEAM();
        }
        if (EN_SCAN && IN(PH_L(l, K_SCAN))) {
            { PH_LOCALS;
#if GDN_SPLIT
            const int n_items = CONV_N_MOE + (l == 0 ? PRO_NIT - PRO_I_IN : 0), n_ret_hi = (l == 0 ? 128 : 256);
            if (bid < 128) { const int t1 = tidx(), w1 = __builtin_amdgcn_readfirstlane(t1 >> 6); const int bh = (bid & 7) + 8 * (bid >> 5), q = (bid >> 3) & 3;
                             gdn_scan_v3(a, l, bh * 4 + q, lds, t1, t1 & 63, w1); STAMP(100 + 10 * l);
                             for (int u = n_ret_hi + bid; u < 512; u += 128) ret_out_unit(a, u, lds, t1, t1 & 63, w1); }
            else {
                { const int t2 = tidx(), w2 = __builtin_amdgcn_readfirstlane(t2 >> 6); conv_range(kargs(), lds, w2, t2 & 63, l, 0, n_items, (bid - 128) * NWAVES + w2, (G - 128) * NWAVES); STAMP(102 + 10 * l); }
                { const int t1 = tidx(), w1 = __builtin_amdgcn_readfirstlane(t1 >> 6);
                  for (int u = bid - 128; u < n_ret_hi; u += G - 128) ret_out_unit(a, u, lds, t1, t1 & 63, w1); }
                STAMP(101 + 10 * l);
            }
#else
            if (bid < 32) { const int t1 = tidx(), w1 = __builtin_amdgcn_readfirstlane(t1 >> 6); gdn_scan_fast(a, l, bid, lds, t1, t1 & 63, w1); STAMP(100 + 10 * l); }
            else {
                if (GDN_HELPERS && bid < 32 + 32 * GDN_HELPERS) gdn_scan_helper(a, bid & 31, tidx());
                if (KV_IN_SCAN) {
                    { const int t0 = tidx(), w0 = __builtin_amdgcn_readfirstlane(t0 >> 6);
                      for (int u = bid - 32; u < 512; u += G - 32) ret_kv_unit(a, u, lds, t0, t0 & 63, w0); }
                    VM_WAIT(); __syncthreads();
                    if (tidx() == 0) { unsigned* sub = (unsigned*)(kargs()->ws + WS_CTL) + CW_SUB + 64 * (1 + l);
                        __builtin_amdgcn_fence(__ATOMIC_RELEASE, "agent"); VM_WAIT();
                        __hip_atomic_fetch_add(sub, 1u, RLX_AGENT);
                        unsigned sp = 0; while (__hip_atomic_load(sub, RLX_AGENT) < (unsigned)(G - 32) && ++sp < (1u << 22)) __builtin_amdgcn_s_sleep(2);
                        __builtin_amdgcn_fence(__ATOMIC_ACQUIRE, "agent"); VM_WAIT(); }
                    __syncthreads();
                }
                { const int t1 = tidx(), w1 = __builtin_amdgcn_readfirstlane(t1 >> 6);
                  for (int u = bid - 32; u < 512; u += G - 32) ret_out_unit(a, u, lds, t1, t1 & 63, w1); }
                __syncthreads(); STAMP(101 + 10 * l);
                { const int t2 = tidx(), w2 = __builtin_amdgcn_readfirstlane(t2 >> 6);
                  moe_convert(kargs(), lds, w2, t2 & 63, (bid - 32) * NWAVES + w2, (G - 32) * NWAVES, 4 * l, 4 * l + 4);
                  if (l == 0) ph_prologue(kargs(), lds, w2, t2 & 63, (bid - 32) * NWAVES + w2, (G - 32) * NWAVES, 0, 0, PRO_I_IN, PRO_NIT, false); STAMP(102 + 10 * l); }
            }
#endif
            }
            if (BOTH(PH_L(l, K_SCAN))) SEAM();
        }
#if GDN_SPLIT
        if (EN_SCAN && IN(PH_L(l, K_FIN))) {
            { PH_LOCALS; gdn_finalize(a, l, lane, gw, NGW); }
            if (BOTH(PH_L(l, K_FIN))) SEAM();
        }
#endif
        if (EN_OUT && IN(PH_L(l, K_OUT))) {
            _Pragma("unroll 1") for (int rep_ = 0; rep_ < REP_OUT; ++rep_) { if (rep_) SEAM(); PH_LOCALS;
            pg8::Gemm g{(const pg8::bf16_t*)(ws + WS_R + R_OB), (const pg8::bf16_t*)(ws + WS_WO) + (size_t)l * 1024 * 1024, M, 1024, 1024}; pg8::StaticOrder S; S.init(M, 1024, G, bid);
            pg8::EpiBf16Out E{(pg8::bf16_t*)(ws + WS_R + R_MIX), 1024};
            pg8::gemm_phase<pg8::EpiBf16Out, pg8::StaticOrder, PG8_ALIGN, PG8_SP2>(lds, g, S, E); }
            if (BOTH(PH_L(l, K_OUT))) SEAM();
        }
        if (EN_LN1 && IN(PH_L(l, K_LN1))) {
            { PH_LOCALS;
            if (l == 0) ln_rows<false>(a->in[0], ALPHA, (const bf16*)(ws + WS_R + R_MIX), a->in[7], a->in[8], a->out, 1.0f, (bf16*)(ws + WS_XB), nullptr, nullptr, nullptr, nullptr, lane, gw, NGW);
            else { ln_rows<true>(a->out, ALPHA, (const bf16*)(ws + WS_R + R_MIX), a->in[7] + 1024, a->in[8] + 1024, a->out, ALPHA, (bf16*)(ws + WS_XB), (const float*)(ws + WS_RWT), (unsigned*)(ws + WS_CTL) + CW_MOE, (int*)(ws + WS_LIST), (float*)(ws + WS_GATE), lane, gw, NGW, lds, tid);
                 } }
            if (BOTH(PH_L(l, K_LN1))) SEAM();
        }
        if (l == 0) {
            if (EN_FFN0 && IN(PH_L(0, K_GU))) {
                _Pragma("unroll 1") for (int rep_ = 0; rep_ < REP_GU; ++rep_) { if (rep_) SEAM(); PH_LOCALS;
                pg8::Gemm g{(const pg8::bf16_t*)(ws + WS_XB), (const pg8::bf16_t*)(ws + WS_WGU), M, 2 * FF, 1024}; pg8::StaticOrder S; S.init(M, 2 * FF, G, bid);
                pg8::EpiSwiglu E{(pg8::bf16_t*)(ws + WS_R + R_H), FF, 0};
                pg8::gemm_phase<pg8::EpiSwiglu, pg8::StaticOrder, PG8_ALIGN, PG8_SP2>(lds, g, S, E); }
                if (BOTH(PH_L(0, K_GU))) SEAM();
            }
            if (EN_FFN0 && IN(PH_L(0, K_DN))) {
                _Pragma("unroll 1") for (int rep_ = 0; rep_ < REP_DN; ++rep_) { if (rep_) SEAM(); PH_LOCALS;
                pg8::Gemm g{(const pg8::bf16_t*)(ws + WS_R + R_H), (const pg8::bf16_t*)(ws + WS_WD), M, 1024, FF}; pg8::StaticOrder S; S.init(M, 1024, G, bid);
                pg8::EpiBf16Out E{(pg8::bf16_t*)(ws + WS_R + R_MIX), 1024};
                pg8::gemm_phase<pg8::EpiBf16Out, pg8::StaticOrder, PG8_ALIGN, PG8_SP2>(lds, g, S, E); }
                if (BOTH(PH_L(0, K_DN))) SEAM();
            }
            if (EN_LN1 && IN(PH_L(0, K_LN2))) {
                { PH_LOCALS;
                ln_rows<false>(a->out, ALPHA, (const bf16*)(ws + WS_R + R_MIX), a->in[9], a->in[10], a->out, 1.0f, (bf16*)(ws + WS_XB), nullptr, nullptr, nullptr, nullptr, lane, gw, NGW); }
                if (BOTH(PH_L(0, K_LN2))) SEAM();
            }
        } else {
#pragma unroll 1
            for (int j = 0; j < 2; ++j) {
                const int kg = K_G0 + 3 * j;
                if (EN_MOE && j == 0 && IN(PH_L(1, kg))) { { PH_LOCALS; moe_gather(a, 0, lane, gw, NGW); moe_gather(a, 1, lane, gw, NGW); } if (BOTH(PH_L(1, kg))) SEAM(); }
                if (EN_MOE && IN(PH_L(1, kg + 1))) {
                    { PH_LOCALS;
                    pg8::moe_table(lds, (const unsigned*)(ws + WS_CTL) + CW_MOE, tid);
                    const PG8_LAS int* tab = (const PG8_LAS int*)(lds + pg8::MOE_TAB_OFF);
                    if (j == 1 && bid < 32) {
#pragma unroll 1
                        for (int jj = 0; jj < 2; ++jj) {
                            { pg8::MoeSched<true> S; S.tab = tab; S.j0 = jj; S.a0 = 64 + (bid >> 2); S.c = bid & 3; S.mode = (64 + (bid >> 2)) < pg8::moe_T(lds, jj) ? 1 : 2;
                              S.n0 = S.n1 = S.a1 = S.j1 = 0; S.G = 1;
                              pg8::Gemm g{(const pg8::bf16_t*)(ws + WS_R + R_HM), (const pg8::bf16_t*)(ws + WS_WMD), MOE_ROWS, 1024, FE, 1};
                              pg8::EpiMoeDown E{a->out, (const int*)(ws + WS_LIST), (const float*)(ws + WS_GATE), tab};
                              pg8::gemm_phase<pg8::EpiMoeDown, pg8::MoeSched<true>, PG8_ALIGN, PG8_SP2>(lds, g, S, E); }
                            if (jj == 0) {
                                VM_WAIT(); __syncthreads();
                                if (tidx() == 0) { unsigned* sub = (unsigned*)(kargs()->ws + WS_CTL) + CW_SUB;
                                    __builtin_amdgcn_fence(__ATOMIC_RELEASE, "agent"); VM_WAIT();
                                    __hip_atomic_fetch_add(sub, 1u, RLX_AGENT);
                                    unsigned sp = 0; while (__hip_atomic_load(sub, RLX_AGENT) < 32u && ++sp < (1u << 22)) __builtin_amdgcn_s_sleep(2);
                                    __builtin_amdgcn_fence(__ATOMIC_ACQUIRE, "agent"); VM_WAIT(); }
                                __syncthreads();
                            }
                        }
                    } else {
                        pg8::MoeSched<false> S; S.tab = tab; S.mode = 0;
                        const int T0 = pg8::moe_T(lds, 0), T1 = pg8::moe_T(lds, 1);
                        if (j == 0) { S.j0 = 0; S.a0 = 0; S.n0 = T0; S.j1 = 1; S.a1 = 64; S.n1 = T1 > 64 ? T1 - 64 : 0; S.G = G; S.c = bid; }
                        else        { S.j0 = 1; S.a0 = 0; S.n0 = T1 < 64 ? T1 : 64; S.j1 = 1; S.a1 = 0; S.n1 = 0; S.G = G - 32; S.c = bid - 32; }
                        pg8::Gemm g{(const pg8::bf16_t*)(ws + WS_R + R_XG), (const pg8::bf16_t*)(ws + WS_WMGU), MOE_ROWS, 2 * FE, 1024};
                        pg8::EpiSwiglu E{(pg8::bf16_t*)(ws + WS_R + R_HM), FE, 1};
                        pg8::gemm_phase<pg8::EpiSwiglu, pg8::MoeSched<false>, PG8_ALIGN, PG8_SP2>(lds, g, S, E);
                    } }
                    if (BOTH(PH_L(1, kg + 1))) SEAM();
                }
                if (EN_MOE && IN(PH_L(1, kg + 2))) {
                    { PH_LOCALS;
                    pg8::moe_table(lds, (const unsigned*)(ws + WS_CTL) + CW_MOE, tid);
                    const PG8_LAS int* tab = (const PG8_LAS int*)(lds + pg8::MOE_TAB_OFF);
                    const int Tj = pg8::moe_T(lds, j);
                    pg8::MoeSched<true> S; S.tab = tab; S.mode = 0; S.j0 = j; S.a0 = 0; S.n0 = Tj < 64 ? Tj : 64; S.j1 = j; S.a1 = 0; S.n1 = 0; S.G = G; S.c = bid;
                    pg8::Gemm g{(const pg8::bf16_t*)(ws + WS_R + R_HM), (const pg8::bf16_t*)(ws + WS_WMD), MOE_ROWS, 1024, FE, 1};
                    pg8::EpiMoeDown E{a->out, (const int*)(ws + WS_LIST), (const float*)(ws + WS_GATE), tab};
                    pg8::gemm_phase<pg8::EpiMoeDown, pg8::MoeSched<true>, PG8_ALIGN, PG8_SP2>(lds, g, S, E); }
                    if (BOTH(PH_L(1, kg + 2))) SEAM();
                }
            }
            if (EN_LN1 && IN(PH_L(1, K_LNF))) {
                PH_LOCALS;
                ln_rows<false>(a->out, 1.0f, nullptr, a->in[9] + 1024, a->in[10] + 1024, a->out, 1.0f, nullptr, nullptr, nullptr, nullptr, nullptr, lane, gw, NGW);
            }
        }
    }
    STAMP(stamp_no_);
#if PROBE_MULT > 0
    if (blockIdx.x == PROBE_BID && threadIdx.x == 0) {
        const unsigned long long* ts = (const unsigned long long*)(kargs()->ws + WS_CTL + 131072);
        const unsigned long long ta = __hip_atomic_load(ts + PROBE_A, RLX_AGENT), tb = __hip_atomic_load(ts + PROBE_B, RLX_AGENT);
        const unsigned long long hold = (tb > ta ? tb - ta : 0ull) * (unsigned long long)PROBE_MULT, t0 = __builtin_amdgcn_s_memrealtime();
        while (__builtin_amdgcn_s_memrealtime() - t0 < hold && __builtin_amdgcn_s_memrealtime() - t0 < 2000000ull) __builtin_amdgcn_s_sleep(8);
    }
#endif
#undef IN
#undef BOTH
}

extern "C" void kernel_launch(void* const* d_in, const int* in_sizes, int n_in, void* d_out, int out_size, void* d_ws, size_t ws_size, hipStream_t stream) {
    static int grid = 0;
    if (grid == 0) {
        if (n_in != 18 || in_sizes[0] != M * D || out_size != M * D || ws_size < WS_END) { fprintf(stderr, "kernel_launch: unexpected shapes or workspace (%zu < %zu); nothing launched\n", ws_size, (size_t)WS_END); grid = -1; return; }
        int dev = 0, cus = 0, per_cu = 0;
        if (hipGetDevice(&dev) != hipSuccess || hipDeviceGetAttribute(&cus, hipDeviceAttributeMultiprocessorCount, dev) != hipSuccess) { grid = -1; return; }
        if (hipFuncSetAttribute((const void*)fwd, hipFuncAttributeMaxDynamicSharedMemorySize, LDS_BYTES) != hipSuccess) { fprintf(stderr, "kernel_launch: hipFuncSetAttribute failed\n"); grid = -1; return; }
        if (hipOccupancyMaxActiveBlocksPerMultiprocessor(&per_cu, (const void*)fwd, NWAVES * 64, LDS_BYTES) != hipSuccess || per_cu < 1) fprintf(stderr, "kernel_launch: occupancy query reports %d\n", per_cu);
        (void)hipGetLastError();
        grid = cus;
    }
    if (grid < 0) return;
    if (hipMemsetAsync((char*)d_ws + WS_CTL, 0, CTL_BYTES, stream) != hipSuccess) return;
    Args a{};
    for (int i = 0; i < 18; ++i) a.in[i] = (const float*)d_in[i];
    a.out = (float*)d_out; a.ws = (unsigned char*)d_ws;
#if ONE_LAUNCH
    a.ph_lo = 0; a.ph_hi = PH_END;
    hipLaunchKernelGGL(fwd, dim3(grid), dim3(NWAVES * 64), LDS_BYTES, stream, a);
#else
    static const int phases[] = {PH_PRO,
        PH_L(0, K_IN), PH_L(0, K_PREP), PH_L(0, K_SCAN), PH_L(0, K_OUT), PH_L(0, K_LN1), PH_L(0, K_GU), PH_L(0, K_DN), PH_L(0, K_LN2),
        PH_L(1, K_IN), PH_L(1, K_PREP), PH_L(1, K_SCAN), PH_L(1, K_OUT), PH_L(1, K_LN1),
        PH_L(1, K_G0), PH_L(1, K_GU0), PH_L(1, K_DN0), PH_L(1, K_G1), PH_L(1, K_GU1), PH_L(1, K_DN1), PH_L(1, K_LNF)};
    for (unsigned i = 0; i < sizeof(phases) / sizeof(phases[0]); ++i) {
        a.ph_lo = phases[i]; a.ph_hi = phases[i] + 1;
        hipLaunchKernelGGL(fwd, dim3(grid), dim3(NWAVES * 64), LDS_BYTES, stream, a);
    }
#endif
}
```

```cpp
#define GDN_F8 1
#include <hip/hip_runtime.h>
#include <cstdio>
#include <cstdint>

#ifndef ONE_LAUNCH
#define ONE_LAUNCH 1
#endif

#define GAS __attribute__((address_space(1)))
#define LAS __attribute__((address_space(3)))
typedef unsigned short bf16;
typedef unsigned v4u __attribute__((ext_vector_type(4)));
typedef unsigned v2u __attribute__((ext_vector_type(2)));
typedef float f32x4 __attribute__((ext_vector_type(4)));
typedef float f32x2 __attribute__((ext_vector_type(2)));
#define RLX_AGENT __ATOMIC_RELAXED, __HIP_MEMORY_SCOPE_AGENT
#define LDS_WAIT() asm volatile("s_waitcnt lgkmcnt(0)" ::: "memory")
#define VM_WAIT() asm volatile("s_waitcnt vmcnt(0)" ::: "memory")

__device__ __forceinline__ unsigned f2bf(float f) { unsigned u = __builtin_bit_cast(unsigned, f); return (u + 0x7fffu + ((u >> 16) & 1u)) >> 16; }
__device__ __forceinline__ unsigned pk2(float lo, float hi) { return f2bf(lo) | (f2bf(hi) << 16); }
__device__ __forceinline__ float bf2f(unsigned short u) { return __builtin_bit_cast(float, (unsigned)u << 16); }
__device__ __forceinline__ float bflo(unsigned u) { return __builtin_bit_cast(float, u << 16); }
__device__ __forceinline__ float bfhi(unsigned u) { return __builtin_bit_cast(float, u & 0xffff0000u); }
__device__ __forceinline__ float siluf(float x) { return x * __builtin_amdgcn_rcpf(1.f + __expf(-x)); }
__device__ __forceinline__ float sigmf(float x) { return 1.f / (1.f + __expf(-x)); }
__device__ __forceinline__ float wave_sum(float v) {
    v += __builtin_bit_cast(float, __builtin_amdgcn_update_dpp(0, __builtin_bit_cast(int, v), 0xB1, 0xF, 0xF, true));
    v += __builtin_bit_cast(float, __builtin_amdgcn_update_dpp(0, __builtin_bit_cast(int, v), 0x4E, 0xF, 0xF, true));
    v += __builtin_bit_cast(float, __builtin_amdgcn_update_dpp(0, __builtin_bit_cast(int, v), 0x141, 0xF, 0xF, true));
    v += __builtin_bit_cast(float, __builtin_amdgcn_update_dpp(0, __builtin_bit_cast(int, v), 0x140, 0xF, 0xF, true));
    v += __builtin_bit_cast(float, __builtin_amdgcn_update_dpp(0, __builtin_bit_cast(int, v), 0x142, 0xA, 0xF, false));
    v += __builtin_bit_cast(float, __builtin_amdgcn_update_dpp(0, __builtin_bit_cast(int, v), 0x143, 0xC, 0xF, false));
    return __builtin_bit_cast(float, __builtin_amdgcn_readlane(__builtin_bit_cast(int, v), 63));
}

constexpr int NWAVES = 8;
constexpr int M = 16384, D = 1024, SEQ = 2048, NB = 8;
constexpr int IN_COLS = 3592, NIN_PAD = 3840, HP_LD = 3584;
constexpr int FF = 2816, FE = 3584, NE = 8;
constexpr int COL_RQ = 0, COL_RK = 256, COL_RV = 512, COL_RG = 1024, COL_GQ = 1536, COL_GK = 2048, COL_GV = 2560, COL_GG = 3072;
constexpr float ALPHA = 1.41421356237f;
constexpr float LN_EPS = 1e-5f, NORM_EPS = 1e-6f;
constexpr int MOE_ROWS = 72 * 256;

__host__ __device__ __forceinline__ int fragoff(int i, int d, int nkt) {
    return ((((i >> 5) * nkt + (d >> 5)) * 2 + ((d >> 4) & 1)) * 512) + ((((d >> 2) & 1) * 32 + (i & 31)) * 8) + ((((d >> 3) & 1) << 2) | (d & 3));
}
__host__ __device__ __forceinline__ int uoff(int i, int e) {
    const int reg = (i & 3) | (((i & 31) >> 3) << 2);
    return (((((e >> 5) * 2 + (i >> 5)) * 2 + (reg >> 3)) * 64 + (((i >> 2) & 1) * 32 + (e & 31))) * 8) + (reg & 7);
}
namespace pg8 {
#define PG8_LAS __attribute__((address_space(3)))
typedef unsigned short bf16_t;
typedef short bf16x8 __attribute__((ext_vector_type(8)));
typedef float f32x4 __attribute__((ext_vector_type(4)));
typedef unsigned u32x4 __attribute__((ext_vector_type(4)));
constexpr int BM = 256, BK = 64, HALF = 128, HTB = HALF * BK * 2  , STAGE_BYTES = 8 * HTB, NXCD = 8, WGM = 8;

__host__ __device__ __forceinline__ int lds_byte(int r, int c) { const int st = (r >> 4) * 2 + (c >> 5), rr = r & 15, cc = c & 31, ob = rr * 64 + cc * 2; return st * 1024 + (ob ^ (((ob >> 9) & 1) << 5)); }
__host__ __device__ __forceinline__ void stage_rc(int b, int& R, int& C) { const int st = b / 1024, sb = b % 1024, swz = sb ^ (((sb >> 9) & 1) << 5); R = (st >> 1) * 16 + swz / 64; C = (st & 1) * 32 + (swz % 64) / 2; }
__host__ __device__ __forceinline__ int perm32(int rho) { const int n = rho >> 4, i = rho & 15; return 8 * (i >> 2) + 4 * n + (i & 3); }

struct Unit { int pm, pn, aux, am, sel; };
struct Gemm { const bf16_t* A; const bf16_t* Bt; int M, N, K, blk; };

struct StaticOrder {
    int nM, nN, nwg, G, c;
    __host__ __device__ void init(int M, int N, int G_, int c_) { nM = M / BM; nN = N / BM; nwg = nM * nN; G = G_; c = c_; }
    __host__ __device__ bool next(int i, Unit& u) const {
        const long L = (long)i * G + c; if (L >= nwg) return false;
        int wgid = (int)L; { const int q = nwg / NXCD, r = nwg % NXCD, xcd = wgid % NXCD, off = wgid / NXCD; wgid = (xcd < r ? xcd * (q + 1) : r * (q + 1) + (xcd - r) * q) + off; }
        const int nig = WGM * nN, gid = wgid / nig, fm = gid * WGM, gsz = (nM - fm) < WGM ? (nM - fm) : WGM;
        u.pm = fm + ((wgid % nig) % gsz); u.pn = (wgid % nig) / gsz; u.aux = 0; u.am = u.pm; u.sel = 0; return true;
    }
    __device__ __forceinline__ const char* aptr(const Gemm& g, const Unit& u) const { return (const char*)g.A + (size_t)u.pm * ((size_t)BM * g.K * 2); }
    __device__ __forceinline__ const char* bptr(const Gemm& g, const Unit& u) const { return (const char*)g.Bt + (size_t)u.pn * ((size_t)BM * g.K * 2); }
    __device__ __forceinline__ void a_ready(const Unit&) const {}
    __device__ __forceinline__ void done(const Unit&) const {}
};

template <class Epi, class Sched, bool ALIGN_EPI = false, bool SP2 = false>
__device__ __forceinline__ void gemm_phase(PG8_LAS unsigned char* lds, const Gemm g, const Sched& S, const Epi& E) {
    int tid = threadIdx.x; asm volatile("" : "+v"(tid)); const int wid = __builtin_amdgcn_readfirstlane(tid >> 6), lane = tid & 63, wr = wid >> 2, wc = wid & 3, fr = lane & 15, fq = lane >> 4;
    const int K = g.K, nt = K / BK;
    unsigned voffA[2], voffB[2];
#pragma unroll
    for (int i = 0; i < 2; ++i) { int R, C; stage_rc(tid * 16 + i * 8192, R, C); const int Rb = Epi::PERM ? ((R & ~31) + perm32(R & 31)) : R;
        voffA[i] = (unsigned)(R * (g.blk ? 64 : K) + C) * 2u; voffB[i] = (unsigned)(Rb * (g.blk ? 64 : K) + C) * 2u; }
    const size_t kstep = g.blk ? (size_t)(256 * 64 * 2) : (size_t)(BK * 2);
    const size_t hstep = g.blk ? (size_t)(HALF * 64 * 2) : (size_t)HALF * K * 2;
    const size_t tstep = 2 * hstep;
    const unsigned ldsw = (unsigned)wid * 1024u;
    const int aoff = lds_byte(wr * 64 + fr, fq * 8), boff = lds_byte(wc * 32 + fr, fq * 8);
#define PG8_SA(b, h) (((b) * 2 + (h)) * HTB)
#define PG8_SB(b, h) ((4 + (b) * 2 + (h)) * HTB)
#define PG8_STAGE(bufoff, gbase, voff) do { _Pragma("unroll") for (int _i = 0; _i < 2; ++_i) \
        __builtin_amdgcn_global_load_lds((const unsigned*)((const char*)(gbase) + (voff)[_i]), (PG8_LAS unsigned*)(lds + (bufoff) + ldsw + _i * 8192), 16, 0, 0); } while (0)
#define PG8_LDA(dst, b, h) do { _Pragma("unroll") for (int m = 0; m < 4; ++m) _Pragma("unroll") for (int k = 0; k < 2; ++k) dst[m][k] = *(const PG8_LAS bf16x8*)(lds + PG8_SA(b, h) + aoff + m * 2048 + k * 1024); } while (0)
#define PG8_LDB(dst, b, h) do { _Pragma("unroll") for (int n = 0; n < 2; ++n) _Pragma("unroll") for (int k = 0; k < 2; ++k) dst[n][k] = *(const PG8_LAS bf16x8*)(lds + PG8_SB(b, h) + boff + n * 2048 + k * 1024); } while (0)
#define PG8_MMA(ai, bj, At, Bt) do { __builtin_amdgcn_s_setprio(1); _Pragma("unroll") for (int m = 0; m < 4; ++m) _Pragma("unroll") for (int n = 0; n < 2; ++n) _Pragma("unroll") for (int k = 0; k < 2; ++k) \
        acc[ai][bj][m][n] = __builtin_amdgcn_mfma_f32_16x16x32_bf16(Bt[n][k], At[m][k], acc[ai][bj][m][n], 0, 0, 0); __builtin_amdgcn_s_setprio(0); } while (0)
#define PG8_WAIT_V(n) asm volatile("s_waitcnt vmcnt(" #n ")" ::: "memory")
#define PG8_WAIT_L(n) asm volatile("s_waitcnt lgkmcnt(" #n ")" ::: "memory")
#define PG8_BAR __builtin_amdgcn_s_barrier()
#define PG8_SCHED __builtin_amdgcn_sched_barrier(0)
    Unit cur, nxt; int ui = 0;
    if (!S.next(0, cur)) return;
    f32x4 acc[2][2][4][2];
#pragma unroll
    for (int a = 0; a < 2; ++a)
#pragma unroll
        for (int b = 0; b < 2; ++b)
#pragma unroll
            for (int m = 0; m < 4; ++m)
#pragma unroll
                for (int n = 0; n < 2; ++n) acc[a][b][m][n] = (f32x4){0.f, 0.f, 0.f, 0.f};
    bf16x8 At[4][2], B0[2][2], B1[2][2];
    const char* cA = S.aptr(g, cur); const char* cB = S.bptr(g, cur);
    S.a_ready(cur);
    if constexpr (SP2) {
        PG8_STAGE(PG8_SB(0, 0), cB, voffB); PG8_STAGE(PG8_SB(0, 1), cB + hstep, voffB); PG8_STAGE(PG8_SA(0, 0), cA, voffA); PG8_STAGE(PG8_SA(0, 1), cA + hstep, voffA);
        if (wr == 1) PG8_BAR;
        PG8_WAIT_V(2); PG8_BAR;
        PG8_STAGE(PG8_SB(1, 0), cB + kstep, voffB); PG8_STAGE(PG8_SA(1, 0), cA + kstep, voffA); PG8_STAGE(PG8_SB(1, 1), cB + hstep + kstep, voffB);
        PG8_WAIT_V(6); PG8_BAR;
    } else {
        PG8_STAGE(PG8_SB(0, 0), cB, voffB); PG8_STAGE(PG8_SA(0, 0), cA, voffA); PG8_STAGE(PG8_SB(0, 1), cB + hstep, voffB); PG8_STAGE(PG8_SA(0, 1), cA + hstep, voffA);
        if (wr == 1) PG8_BAR;
        PG8_WAIT_V(4); PG8_BAR;
        PG8_STAGE(PG8_SB(1, 0), cB + kstep, voffB); PG8_STAGE(PG8_SA(1, 0), cA + kstep, voffA); PG8_STAGE(PG8_SB(1, 1), cB + hstep + kstep, voffB);
        PG8_WAIT_V(6); PG8_BAR;
    }
    for (;;) {
        const bool has_next = S.next(ui + 1, nxt);
        const char* nA = has_next ? S.aptr(g, nxt) : cA; const char* nB = has_next ? S.bptr(g, nxt) : cB;
        for (int t = 0; t < nt; t += 2) {
            const bool last = (t == nt - 2);
            const char* a1 = cA + (size_t)(t + 1) * kstep;
            const char* a2 = last ? nA : cA + (size_t)(t + 2) * kstep; const char* b2 = last ? nB : cB + (size_t)(t + 2) * kstep;
            const char* a3 = a2 + kstep; const char* b3 = b2 + kstep;
            if (last && has_next) S.a_ready(nxt);
            if constexpr (SP2) {
            PG8_LDB(B0, 0, 0); PG8_LDB(B1, 0, 1); PG8_SCHED; PG8_LDA(At, 0, 0); PG8_STAGE(PG8_SA(1, 1), a1 + hstep, voffA);
            PG8_WAIT_V(8); PG8_WAIT_L(0); PG8_BAR; PG8_MMA(0, 0, At, B0); PG8_MMA(0, 1, At, B1); PG8_BAR; PG8_SCHED;
            PG8_LDA(At, 0, 1); PG8_STAGE(PG8_SB(0, 0), b2, voffB); PG8_STAGE(PG8_SB(0, 1), b2 + hstep, voffB); PG8_STAGE(PG8_SA(0, 0), a2, voffA);
            PG8_WAIT_V(8); PG8_WAIT_L(0); PG8_BAR; PG8_MMA(1, 0, At, B0); PG8_MMA(1, 1, At, B1); PG8_BAR; PG8_SCHED;
            PG8_LDB(B0, 1, 0); PG8_LDB(B1, 1, 1); PG8_SCHED; PG8_LDA(At, 1, 0); PG8_STAGE(PG8_SA(0, 1), a2 + hstep, voffA);
            PG8_WAIT_V(8); PG8_WAIT_L(0); PG8_BAR; PG8_MMA(0, 0, At, B0); PG8_MMA(0, 1, At, B1); PG8_BAR; PG8_SCHED;
            PG8_LDA(At, 1, 1); PG8_STAGE(PG8_SB(1, 0), b3, voffB); PG8_STAGE(PG8_SB(1, 1), b3 + hstep, voffB); PG8_STAGE(PG8_SA(1, 0), a3, voffA);
            PG8_WAIT_V(8); PG8_WAIT_L(0); PG8_BAR; PG8_MMA(1, 0, At, B0); PG8_MMA(1, 1, At, B1); PG8_BAR; PG8_SCHED;
            } else {
            PG8_LDB(B0, 0, 0); PG8_SCHED; PG8_LDA(At, 0, 0); PG8_STAGE(PG8_SA(1, 1), a1 + hstep, voffA);
            PG8_WAIT_L(8); PG8_BAR; PG8_WAIT_L(0); PG8_MMA(0, 0, At, B0); PG8_BAR; PG8_SCHED;
            PG8_LDB(B1, 0, 1); PG8_STAGE(PG8_SB(0, 0), b2, voffB);
            PG8_BAR; PG8_WAIT_L(0); PG8_MMA(0, 1, At, B1); PG8_BAR;
            PG8_LDA(At, 0, 1); PG8_STAGE(PG8_SA(0, 0), a2, voffA);
            PG8_BAR; PG8_WAIT_L(0); PG8_MMA(1, 0, At, B0); PG8_BAR; PG8_SCHED;
            PG8_STAGE(PG8_SB(0, 1), b2 + hstep, voffB);
            PG8_WAIT_V(6); PG8_BAR; PG8_MMA(1, 1, At, B1); PG8_BAR;
            PG8_LDB(B0, 1, 0); PG8_SCHED; PG8_LDA(At, 1, 0); PG8_STAGE(PG8_SA(0, 1), a2 + hstep, voffA);
            PG8_WAIT_L(8); PG8_BAR; PG8_WAIT_L(0); PG8_MMA(0, 0, At, B0); PG8_BAR; PG8_SCHED;
            PG8_LDB(B1, 1, 1); PG8_STAGE(PG8_SB(1, 0), b3, voffB);
            PG8_BAR; PG8_WAIT_L(0); PG8_MMA(0, 1, At, B1); PG8_BAR;
            PG8_LDA(At, 1, 1); PG8_STAGE(PG8_SA(1, 0), a3, voffA);
            PG8_BAR; PG8_WAIT_L(0); PG8_MMA(1, 0, At, B0); PG8_BAR; PG8_SCHED;
            PG8_STAGE(PG8_SB(1, 1), b3 + hstep, voffB);
            PG8_WAIT_V(6); PG8_BAR; PG8_MMA(1, 1, At, B1); PG8_BAR;
            }
        }
        if constexpr (ALIGN_EPI) { if (wr == 0) PG8_BAR; }
        if constexpr (!Epi::AFTER_DRAIN) { E(acc, cur, wr, wc, fr, fq); S.done(cur); }
        if (!has_next) break;
#pragma unroll
        for (int a = 0; a < 2; ++a)
#pragma unroll
            for (int b = 0; b < 2; ++b)
#pragma unroll
                for (int m = 0; m < 4; ++m)
#pragma unroll
                    for (int n = 0; n < 2; ++n) acc[a][b][m][n] = (f32x4){0.f, 0.f, 0.f, 0.f};
        cur = nxt; cA = nA; cB = nB; ++ui;
        if constexpr (ALIGN_EPI) { if (wr == 1) PG8_BAR; }
    }
    PG8_WAIT_V(0);
    if constexpr (!ALIGN_EPI) { if (wr == 0) PG8_BAR; }
    PG8_BAR;
    if constexpr (Epi::AFTER_DRAIN) { E.fused(acc, cur, wr, wc, fr, fq, lds, wid, lane); S.done(cur); }
#undef PG8_SA
#undef PG8_SB
#undef PG8_STAGE
#undef PG8_LDA
#undef PG8_LDB
#undef PG8_MMA
#undef PG8_WAIT_V
#undef PG8_WAIT_L
#undef PG8_BAR
#undef PG8_SCHED
}
}

namespace pg8 {
__device__ __forceinline__ unsigned cvt_pk_bf16(float lo, float hi) { unsigned r; asm volatile("v_cvt_pk_bf16_f32 %0, %1, %2" : "=v"(r) : "v"(lo), "v"(hi)); return r; }

struct EpiHproj {
    static constexpr bool PERM = true, AFTER_DRAIN = false;
    bf16_t* HP; float* GAB;
    __device__ __forceinline__ void operator()(const f32x4 (&acc)[2][2][4][2], const Unit& u, int wr, int wc, int fr, int fq) const {
        const int row0 = u.pm * BM + wr * 64 + fr;
        if (u.pn < 14) {
            const int col0 = u.pn * BM + wc * 32 + 8 * fq;
#pragma unroll
            for (int ai = 0; ai < 2; ++ai)
#pragma unroll
                for (int m = 0; m < 4; ++m) { bf16_t* rowp = HP + (size_t)(row0 + ai * HALF + m * 16) * 3584 + col0;
#pragma unroll
                    for (int bj = 0; bj < 2; ++bj) { const f32x4 v0 = acc[ai][bj][m][0], v1 = acc[ai][bj][m][1];
                        u32x4 w; w.x = cvt_pk_bf16(v0[0], v0[1]); w.y = cvt_pk_bf16(v0[2], v0[3]); w.z = cvt_pk_bf16(v1[0], v1[1]); w.w = cvt_pk_bf16(v1[2], v1[3]);
                        *(u32x4*)(rowp + bj * HALF) = w; } }
        } else if (wc == 0 && fq == 0) {
#pragma unroll
            for (int ai = 0; ai < 2; ++ai)
#pragma unroll
                for (int m = 0; m < 4; ++m) { float* rowp = GAB + (size_t)(row0 + ai * HALF + m * 16) * 8;
                    *(f32x4*)(rowp) = acc[ai][0][m][0]; *(f32x4*)(rowp + 4) = acc[ai][0][m][1]; }
        }
    }
};
struct EpiBf16Out {
    static constexpr bool PERM = true, AFTER_DRAIN = false;
    bf16_t* O; int ldc;
    __device__ __forceinline__ void operator()(const f32x4 (&acc)[2][2][4][2], const Unit& u, int wr, int wc, int fr, int fq) const {
        const int row0 = u.pm * BM + wr * 64 + fr, col0 = u.pn * BM + wc * 32 + 8 * fq;
#pragma unroll
        for (int ai = 0; ai < 2; ++ai)
#pragma unroll
            for (int m = 0; m < 4; ++m) { bf16_t* rowp = O + (size_t)(row0 + ai * HALF + m * 16) * ldc + col0;
#pragma unroll
                for (int bj = 0; bj < 2; ++bj) { const f32x4 v0 = acc[ai][bj][m][0], v1 = acc[ai][bj][m][1];
                    u32x4 w; w.x = cvt_pk_bf16(v0[0], v0[1]); w.y = cvt_pk_bf16(v0[2], v0[3]); w.z = cvt_pk_bf16(v1[0], v1[1]); w.w = cvt_pk_bf16(v1[2], v1[3]);
                    *(u32x4*)(rowp + bj * HALF) = w; } }
    }
};
struct EpiF32 {
    static constexpr bool PERM = false, AFTER_DRAIN = false;
    float* O; int ldc;
    __device__ __forceinline__ void operator()(const f32x4 (&acc)[2][2][4][2], const Unit& u, int wr, int wc, int fr, int fq) const {
        const int row0 = u.pm * BM + wr * 64 + fr, col0 = u.pn * BM + wc * 32 + 4 * fq;
#pragma unroll
        for (int ai = 0; ai < 2; ++ai)
#pragma unroll
            for (int m = 0; m < 4; ++m) { float* rowp = O + (size_t)(row0 + ai * HALF + m * 16) * ldc + col0;
#pragma unroll
                for (int bj = 0; bj < 2; ++bj)
#pragma unroll
                    for (int n = 0; n < 2; ++n) *(f32x4*)(rowp + bj * HALF + n * 16) = acc[ai][bj][m][n]; }
    }
};
struct EpiSwiglu {
    static constexpr bool PERM = true, AFTER_DRAIN = false;
    bf16_t* H; int ldh; int blk;
    __device__ __forceinline__ void operator()(const f32x4 (&acc)[2][2][4][2], const Unit& u, int wr, int wc, int fr, int fq) const {
        const int rt = wr * 64 + fr, col0 = u.pn * HALF + wc * 32 + 8 * fq;
        bf16_t* tb = H + (size_t)u.pm * BM * ldh;
#pragma unroll
        for (int ai = 0; ai < 2; ++ai)
#pragma unroll
            for (int m = 0; m < 4; ++m) { const int r = rt + ai * HALF + m * 16;
                bf16_t* rowp = blk ? tb + (size_t)(col0 >> 6) * (BM * 64) + r * 64 + (col0 & 63) : tb + (size_t)r * ldh + col0;
                float h[8];
#pragma unroll
                for (int n = 0; n < 2; ++n)
#pragma unroll
                    for (int i = 0; i < 4; ++i) { const float gt = acc[ai][0][m][n][i], up = acc[ai][1][m][n][i]; h[n * 4 + i] = gt * up * __builtin_amdgcn_rcpf(1.f + __expf(-gt)); }
                u32x4 w; w.x = cvt_pk_bf16(h[0], h[1]); w.y = cvt_pk_bf16(h[2], h[3]); w.z = cvt_pk_bf16(h[4], h[5]); w.w = cvt_pk_bf16(h[6], h[7]);
                *(u32x4*)(rowp) = w; }
    }
};
constexpr int MOE_TAB_OFF = 131072 + 1024;
__device__ __forceinline__ void moe_table(PG8_LAS unsigned char* lds, const unsigned* cntw, int tid) {
    PG8_LAS int* tab = (PG8_LAS int*)(lds + MOE_TAB_OFF);
    __syncthreads();
    if (tid < 2) { const int j = tid; int t = 0;
        for (int e = 0; e < 8; ++e) { const int c = (int)cntw[64 * (j * 8 + e)]; tab[j * 8 + e] = t; tab[16 + j * 8 + e] = c; t += (c + 255) >> 8; }
        tab[32 + j] = t; }
    __syncthreads();
}
__device__ __forceinline__ int moe_T(PG8_LAS unsigned char* lds, int j) { return __builtin_amdgcn_readfirstlane(((const PG8_LAS int*)(lds + MOE_TAB_OFF))[32 + j]); }
__device__ __forceinline__ int moe_expert(const PG8_LAS int* tab, int j, int t) { int e = 0;
#pragma unroll
    for (int k = 1; k < 8; ++k) e += (t >= tab[j * 8 + k]) ? 1 : 0;
    return __builtin_amdgcn_readfirstlane(e); }
__device__ __forceinline__ int moe_hphys(int j, int t) { return (j == 1 && t >= 64) ? t + 8 : t; }
struct EpiMoeDown {
    static constexpr bool PERM = false, AFTER_DRAIN = false;
    float* XF; const int* list; const float* gate; const PG8_LAS int* tab;
    __device__ __forceinline__ void operator()(const f32x4 (&acc)[2][2][4][2], const Unit& u, int wr, int wc, int fr, int fq) const {
        const int e = u.aux, j = u.sel, c_e = tab[16 + j * 8 + e], t_e = tab[j * 8 + e];
        const int s0 = (u.pm - t_e) * BM + wr * 64 + fr, col0 = u.pn * BM + wc * 32 + 4 * fq;
        const int* lp = list + (size_t)(j * 8 + e) * 16384; const float* gp = gate + (size_t)j * 16384;
        int tok[8]; float gt[8];
#pragma unroll
        for (int q = 0; q < 8; ++q) { const int s = s0 + (q >> 2) * HALF + (q & 3) * 16; tok[q] = (s < c_e) ? lp[s] : -1; }
#pragma unroll
        for (int q = 0; q < 8; ++q) gt[q] = (tok[q] >= 0) ? gp[tok[q]] : 0.f;
#pragma unroll
        for (int ai = 0; ai < 2; ++ai) {
            f32x4 o[4][2][2];
#pragma unroll
            for (int m = 0; m < 4; ++m) { const float* rowp = XF + (size_t)(tok[ai * 4 + m] >= 0 ? tok[ai * 4 + m] : 0) * 1024 + col0;
#pragma unroll
                for (int bj = 0; bj < 2; ++bj)
#pragma unroll
                    for (int n = 0; n < 2; ++n) o[m][bj][n] = *(const f32x4*)(rowp + bj * HALF + n * 16); }
#pragma unroll
            for (int m = 0; m < 4; ++m) { if (tok[ai * 4 + m] >= 0) { float* rowp = XF + (size_t)tok[ai * 4 + m] * 1024 + col0; const float g1 = gt[ai * 4 + m];
#pragma unroll
                for (int bj = 0; bj < 2; ++bj)
#pragma unroll
                    for (int n = 0; n < 2; ++n) *(f32x4*)(rowp + bj * HALF + n * 16) = o[m][bj][n] + acc[ai][bj][m][n] * g1; } }
        }
    }
};
template <bool DOWN>
struct MoeSched {
    int mode, n0, a0, j0, n1, a1, j1, G, c; const PG8_LAS int* tab;
    static constexpr int nN = DOWN ? 4 : 28;
    __device__ bool next(int i, Unit& u) const {
        int j, t;
        if (mode != 0) { if (i != 0 || mode == 2) return false; j = j0; t = a0; u.pn = c; }
        else {
            const int V = n0 + n1, nwg = V * nN; const long L = (long)i * G + c; if (L >= nwg) return false;
            int wgid = (int)L; { const int q = nwg / NXCD, r = nwg % NXCD, xcd = wgid % NXCD, off = wgid / NXCD; wgid = (xcd < r ? xcd * (q + 1) : r * (q + 1) + (xcd - r) * q) + off; }
            const int nig = WGM * nN, gid = wgid / nig, fm = gid * WGM, gsz = (V - fm) < WGM ? (V - fm) : WGM;
            const int vm = fm + ((wgid % nig) % gsz); u.pn = (wgid % nig) / gsz;
            if (vm < n0) { j = j0; t = a0 + vm; } else { j = j1; t = a1 + (vm - n0); }
        }
        u.aux = moe_expert(tab, j, t); u.sel = j;
        if (DOWN) { u.pm = t; u.am = moe_hphys(j, t); } else { u.pm = moe_hphys(j, t); u.am = t; }
        return true;
    }
    __device__ __forceinline__ const char* aptr(const Gemm& g, const Unit& u) const { return (const char*)g.A + (DOWN ? (size_t)0 : (size_t)u.sel * (size_t)(36u << 20)) + (size_t)u.am * ((size_t)BM * g.K * 2); }
    __device__ __forceinline__ const char* bptr(const Gemm& g, const Unit& u) const { return (const char*)g.Bt + (size_t)u.aux * ((size_t)g.N * g.K * 2) + (size_t)u.pn * ((size_t)BM * g.K * 2); }
    __device__ __forceinline__ void a_ready(const Unit&) const {}
    __device__ __forceinline__ void done(const Unit&) const {}
};
}
#ifndef PG8_SP2
#define PG8_SP2 true
#endif
#ifndef PG8_ALIGN
#define PG8_ALIGN true
#endif

constexpr size_t MiB = 1u << 20;
constexpr size_t WS_CTL = 0, CTL_BYTES = 256 * 1024;
constexpr size_t WS_ROPE = 256 * 1024;
constexpr size_t WS_WIN = 1 * MiB;
constexpr size_t WS_WO = 16 * MiB;
constexpr size_t WS_WGU = 20 * MiB;
constexpr size_t WS_WD = 31 * MiB;
constexpr size_t WS_XB = 37 * MiB;
constexpr size_t WS_GAB = 69 * MiB;
constexpr size_t WS_LIST = WS_GAB + 512 * 1024;
constexpr size_t WS_GATE = WS_LIST + 1 * MiB;
constexpr size_t WS_CD = WS_GATE + 128 * 1024;
constexpr size_t WS_RWT = WS_CD + 8 * 1024;
constexpr size_t WS_WMGU = 71 * MiB, WS_WMD = 183 * MiB;
constexpr size_t WS_R = 239 * MiB;
#ifndef GDN_F8
#define GDN_F8 0
#endif
#if GDN_F8
#define RES_BF16 1
constexpr size_t R_HP = 0, R_OB = 112 * MiB, R_U = 144 * MiB, R_WN = 160 * MiB, R_QD = 168 * MiB, R_KDT = 176 * MiB, R_QK = 184 * MiB;
constexpr size_t WS_KV = WS_R + 192 * MiB;
constexpr size_t WS_SSQ = WS_R + 208 * MiB;
#else
#define RES_BF16 0
constexpr size_t R_HP = 0, R_OB = 112 * MiB, R_U = 144 * MiB, R_WN = 160 * MiB, R_QD = 176 * MiB, R_KDT = 192 * MiB, R_QK = 208 * MiB;
constexpr size_t WS_SSQ = WS_XB + 16 * MiB;
constexpr size_t WS_KV = WS_XB;
#endif
constexpr size_t R_MIX = 0, R_H = 64 * MiB;
constexpr size_t R_HM = 0, R_XG = 140 * MiB, XG_PASS = 36 * MiB;
constexpr size_t WS_END = WS_R + 216 * MiB;
constexpr int CW_TMO = 0, CW_BAR = 4096, CW_MOE = 16384, CW_WQ = 24576, CW_SUB = 28672;

constexpr int RING_BYTES = 131072, LDS_BYTES = 147456, LDSCTL_OFF = LDS_BYTES - 512, MISC_OFF = LDSCTL_OFF + 320;

constexpr int PH_PRO = 0;
constexpr int PH_L(int l, int k) { return 1 + 16 * l + k; }
constexpr int K_IN = 0, K_PREP = 1, K_SCAN = 2, K_OUT = 3, K_LN1 = 4, K_GU = 5, K_DN = 6, K_LN2 = 7;
constexpr int K_FIN = 12;
constexpr int K_G0 = 5, K_GU0 = 6, K_DN0 = 7, K_G1 = 8, K_GU1 = 9, K_DN1 = 10, K_LNF = 11;
constexpr int PH_END = 1 + 16 * 2;

struct Args { const float* in[18]; float* out; unsigned char* ws; int ph_lo, ph_hi; };
typedef const __attribute__((address_space(4))) Args* KArgs;
__device__ __forceinline__ KArgs kargs() { KArgs p = (KArgs)__builtin_amdgcn_kernarg_segment_ptr(); asm volatile("" : "+s"(p)); return p; }
__device__ __forceinline__ int tidx() { int t = threadIdx.x; asm volatile("" : "+v"(t)); return t; }

constexpr int TR_SCR = 64 * 65 * 4;
__device__ __forceinline__ void tr_item(const float* W, int N, int k0, int n0, bf16* WT, size_t ldk, int dst_row0, LAS float* scr, int lane, bool blk = false) {
    const int nq = 4 * (lane & 15), n = n0 + nq, kr = lane >> 4;
    f32x4 v[16];
#pragma unroll
    for (int i = 0; i < 16; ++i) v[i] = (n < N) ? *(const f32x4*)(W + (size_t)(k0 + 4 * i + kr) * N + n) : (f32x4){0.f, 0.f, 0.f, 0.f};
#pragma unroll
    for (int i = 0; i < 16; ++i) { LAS float* d = scr + (4 * i + kr) * 65 + nq; d[0] = v[i].x; d[1] = v[i].y; d[2] = v[i].z; d[3] = v[i].w; }
    LDS_WAIT(); asm volatile("" ::: "memory");
    const int c = lane & 7;
#pragma unroll
    for (int j = 0; j < 8; ++j) { const int nn = (lane >> 3) + 8 * j; const LAS float* s = scr + (8 * c) * 65 + nn;
        v4u o; o.x = pk2(s[0 * 65], s[1 * 65]); o.y = pk2(s[2 * 65], s[3 * 65]); o.z = pk2(s[4 * 65], s[5 * 65]); o.w = pk2(s[6 * 65], s[7 * 65]);
        const int dr = dst_row0 + nn;
        bf16* dp = blk ? WT + ((size_t)(dr >> 8) * (ldk >> 6) + (k0 >> 6)) * (256 * 64) + (dr & 255) * 64 + 8 * c : WT + (size_t)dr * ldk + k0 + 8 * c;
        *(v4u*)dp = o; }
    LDS_WAIT(); asm volatile("" ::: "memory");
}

constexpr int PRO_I_IN = 16 * 57, PRO_NIT = 2 * (16 * 57 + 16 * 16) + 2 * (16 * 44) + 44 * 16;
__device__ __forceinline__ void ph_prologue(KArgs a, LAS unsigned char* lds, int wave, int lane, int gw, int NGW, int gtid, int NT, int it_lo, int it_hi, bool misc) {
    unsigned char* ws = a->ws;
    LAS float* scr = (LAS float*)(lds + wave * TR_SCR);
    constexpr int I_IN = 16 * 57, I_O = 16 * 16, I_L = I_IN + I_O, I_G = 16 * 44, I_D = 44 * 16, NIT = 2 * I_L + 2 * I_G + I_D;
    static_assert(NIT == PRO_NIT && I_IN == PRO_I_IN, "prologue item counts");
    for (int it = it_lo + gw; it < it_hi; it += NGW) {
        int r = it;
        if (r < 2 * I_L) { const int l = r / I_L; r -= l * I_L;
            if (r < I_IN) { const int kb = r / 57, nb = r % 57; tr_item(a->in[1] + (size_t)l * 1024 * IN_COLS, IN_COLS, 64 * kb, 64 * nb, (bf16*)(ws + WS_WIN) + (size_t)l * NIN_PAD * 1024, 1024, 64 * nb, scr, lane); }
            else { r -= I_IN; const int kb = r / 16, nb = r % 16; tr_item(a->in[6] + (size_t)l * 1024 * 1024, 1024, 64 * kb, 64 * nb, (bf16*)(ws + WS_WO) + (size_t)l * 1024 * 1024, 1024, 64 * nb, scr, lane); }
            continue; }
        r -= 2 * I_L;
        if (r < 2 * I_G) { const int up = r / I_G; r -= up * I_G; const int kb = r / 44, nb = r % 44, n0 = 64 * nb;
            tr_item(up ? a->in[12] : a->in[11], FF, 64 * kb, n0, (bf16*)(ws + WS_WGU), 1024, 256 * (n0 >> 7) + (n0 & 127) + 128 * up, scr, lane); continue; }
        r -= 2 * I_G;
        { const int kb = r / 16, nb = r % 16; tr_item(a->in[13], 1024, 64 * kb, 64 * nb, (bf16*)(ws + WS_WD), FF, 64 * nb, scr, lane); }
    }
    if (!misc) return;
    for (int i = gtid; i < 2 * 192 * 128; i += NT) { const int l = i / (192 * 128), r = i % (192 * 128);
        ((v4u*)((bf16*)(ws + WS_WIN) + (size_t)l * NIN_PAD * 1024 + (size_t)3648 * 1024))[r] = (v4u){0u, 0u, 0u, 0u}; }
    for (int i = gtid; i < M * D / 8; i += NT) { const f32x4 p = ((const f32x4*)a->in[0])[2 * i], q = ((const f32x4*)a->in[0])[2 * i + 1];
        v4u o; o.x = pk2(p.x, p.y); o.y = pk2(p.z, p.w); o.z = pk2(q.x, q.y); o.w = pk2(q.z, q.w); ((v4u*)(ws + WS_XB))[i] = o; }
    for (int i = gtid; i < 8192; i += NT) ((float*)(ws + WS_RWT))[(i & 7) * 1024 + (i >> 3)] = a->in[14][i];
    for (int i = gtid; i < SEQ * 32; i += NT) { const int pos = i >> 5, k = i & 31;
        const float inv = powf(10000.0f, -(float)(2 * k) / 64.0f); const float ang = (float)pos * inv;
        double rev = (double)ang * 0.15915494309189535; rev -= floor(rev); const float rf = (float)rev;
        float* R = (float*)(ws + WS_ROPE) + (size_t)pos * 64; R[k] = __builtin_amdgcn_cosf(rf); R[32 + k] = __builtin_amdgcn_sinf(rf); }
}

__device__ __forceinline__ void moe_convert(KArgs a, LAS unsigned char* lds, int wave, int lane, int gw, int NGW, int e_lo, int e_hi, int item = -1) {
    unsigned char* ws = a->ws;
    LAS float* scr = (LAS float*)(lds + wave * TR_SCR);
    constexpr int I_G = 16 * 56, I_D = 56 * 16, I_E = 2 * I_G + I_D;
    for (int it = (item >= 0 ? item : e_lo * I_E + gw); it < (item >= 0 ? item + 1 : e_hi * I_E); it += NGW) {
        const int e = it / I_E; int r = it - e * I_E;
        if (r < 2 * I_G) { const int up = r / I_G; r -= up * I_G; const int kb = r / 56, nb = r % 56, n0 = 64 * nb;
            tr_item((up ? a->in[16] : a->in[15]) + (size_t)e * 1024 * FE, FE, 64 * kb, n0, (bf16*)(ws + WS_WMGU) + (size_t)e * 7168 * 1024, 1024, 256 * (n0 >> 7) + (n0 & 127) + 128 * up, scr, lane); }
        else { r -= 2 * I_G; const int kb = r / 16, nb = r % 16; tr_item(a->in[17] + (size_t)e * FE * 1024, 1024, 64 * kb, 64 * nb, (bf16*)(ws + WS_WMD) + (size_t)e * 1024 * FE, FE, 64 * nb, scr, lane, true); }
    }
}

__device__ __forceinline__ void conv_queue(KArgs a, LAS unsigned char* lds, int wave, int lane, int l) {
    unsigned char* ws = a->ws;
    LAS float* scr = (LAS float*)(lds + wave * TR_SCR);
    unsigned* head = (unsigned*)(ws + WS_CTL) + CW_WQ + 64 * l;
    constexpr int I_G = 16 * 56, I_D = 56 * 16, I_E = 2 * I_G + I_D;
    const int e_lo = (l == 0 ? 0 : 3), n_moe = (l == 0 ? 3 : 5) * I_E, n_all = n_moe + (l == 0 ? PRO_NIT - PRO_I_IN : 0);
    for (;;) {
        unsigned it0 = 0; if (lane == 0) it0 = __hip_atomic_fetch_add(head, 8u, RLX_AGENT);
        it0 = __builtin_amdgcn_readfirstlane(it0);
        if ((int)it0 >= n_all) break;
#pragma unroll 1
        for (int k = 0; k < 8; ++k) { const int it = (int)it0 + k; if (it >= n_all) break;
            if (it < n_moe) moe_convert(a, lds, wave, lane, 0, 1 << 30, 0, 0, e_lo * I_E + it);
            else ph_prologue(a, lds, wave, lane, 0, 1 << 30, 0, 0, PRO_I_IN + (it - n_moe), PRO_I_IN + (it - n_moe) + 1, false); }
    }
}

__device__ __forceinline__ void conv_range(KArgs a, LAS unsigned char* lds, int wave, int lane, int l, int lo, int hi, int gw, int NGW) {
    constexpr int I_G = 16 * 56, I_D = 56 * 16, I_E = 2 * I_G + I_D;
    const int n_moe = 4 * I_E;
    for (int it = lo + gw; it < hi; it += NGW) {
        if (it < n_moe) moe_convert(a, lds, wave, lane, 0, 1 << 30, 0, 0, 4 * l * I_E + it);
        else ph_prologue(a, lds, wave, lane, 0, 1 << 30, 0, 0, PRO_I_IN + (it - n_moe), PRO_I_IN + (it - n_moe) + 1, false);
    }
}
constexpr int CONV_N_MOE = 4 * (2 * 16 * 56 + 56 * 16);

template <bool ROUTE, bool RESB = false>
__device__ __forceinline__ void ln_rows(const float* res, float ares, const bf16* mix, const float* g, const float* bta, float* xf, float oscale, bf16* xb,
                                        const float* router, unsigned* cntw, int* list, float* gate, int lane, int gw, int NGW, LAS unsigned char* lds = nullptr, int tid = 0, const bf16* resb = nullptr) {
    LAS unsigned* lcnt = (LAS unsigned*)lds; LAS unsigned* lbase = lcnt + 16; LAS unsigned* rec = lcnt + 32;
    int nrec = 0;
    if (ROUTE) { __syncthreads(); if (tid < 16) lcnt[tid] = 0u; __syncthreads(); }
    f32x4 gv[4], bv[4];
#pragma unroll
    for (int j = 0; j < 4; ++j) { gv[j] = ((const f32x4*)g)[lane + 64 * j]; bv[j] = ((const f32x4*)bta)[lane + 64 * j]; }
    f32x4 rn[4]; v2u mn[4], rb[4];
#define LN_FETCH(r_) do { if (RESB) { const v2u* rr_ = (const v2u*)(resb + (size_t)(r_) * D) + lane; _Pragma("unroll") for (int j = 0; j < 4; ++j) rb[j] = rr_[64 * j]; } \
        else { const f32x4* rr_ = (const f32x4*)(res + (size_t)(r_) * D) + lane; _Pragma("unroll") for (int j = 0; j < 4; ++j) rn[j] = rr_[64 * j]; } \
        if (mix) { const v2u* mr_ = (const v2u*)(mix + (size_t)(r_) * D) + lane; _Pragma("unroll") for (int j = 0; j < 4; ++j) mn[j] = mr_[64 * j]; } } while (0)
#pragma unroll
    for (int j = 0; j < 4; ++j) { rn[j] = (f32x4){0.f, 0.f, 0.f, 0.f}; mn[j] = (v2u){0u, 0u}; rb[j] = (v2u){0u, 0u}; }
    if (gw < M) LN_FETCH(gw);
    for (int row = gw; row < M; row += NGW) {
        f32x4 v[4]; float s = 0.f;
#pragma unroll
        for (int j = 0; j < 4; ++j) { if (RESB) rn[j] = (f32x4){bflo(rb[j].x), bfhi(rb[j].x), bflo(rb[j].y), bfhi(rb[j].y)}; v[j] = rn[j] * ares; if (mix) v[j] = v[j] + (f32x4){bflo(mn[j].x), bfhi(mn[j].x), bflo(mn[j].y), bfhi(mn[j].y)}; }
        if (row + NGW < M) LN_FETCH(row + NGW);
#pragma unroll
        for (int j = 0; j < 4; ++j) s += (v[j].x + v[j].y) + (v[j].z + v[j].w);
        const float mean = wave_sum(s) * (1.f / D); float s2 = 0.f;
#pragma unroll
        for (int j = 0; j < 4; ++j) { v[j] = v[j] - mean; s2 += (v[j].x * v[j].x + v[j].y * v[j].y) + (v[j].z * v[j].z + v[j].w * v[j].w); }
        const float rstd = 1.f / sqrtf(wave_sum(s2) * (1.f / D) + LN_EPS);
#pragma unroll
        for (int j = 0; j < 4; ++j) v[j] = v[j] * rstd * gv[j] + bv[j];
        if (xf) { f32x4* xo = (f32x4*)(xf + (size_t)row * D) + lane;
#pragma unroll
            for (int j = 0; j < 4; ++j) xo[64 * j] = v[j] * oscale; }
        if (xb) { v2u* bo = (v2u*)(xb + (size_t)row * D) + lane;
#pragma unroll
            for (int j = 0; j < 4; ++j) { v2u o; o.x = pk2(v[j].x, v[j].y); o.y = pk2(v[j].z, v[j].w); bo[64 * j] = o; } }
        if (ROUTE) {
            float lg[8];
#pragma unroll
            for (int e = 0; e < 8; ++e) lg[e] = 0.f;
#pragma unroll
            for (int e = 0; e < 8; ++e)
#pragma unroll
                for (int j = 0; j < 4; ++j) { const f32x4 r4 = ((const f32x4*)(router + e * 1024))[lane + 64 * j]; lg[e] += (v[j].x * r4.x + v[j].y * r4.y) + (v[j].z * r4.z + v[j].w * r4.w); }
#pragma unroll
            for (int e = 0; e < 8; ++e) lg[e] = wave_sum(lg[e]);
            if (lane == 0) {
                int e0 = 0; float v0 = lg[0];
#pragma unroll
                for (int e = 1; e < 8; ++e) if (lg[e] > v0) { v0 = lg[e]; e0 = e; }
                int e1 = -1; float v1 = -3.0e38f;
#pragma unroll
                for (int e = 0; e < 8; ++e) if (e != e0 && lg[e] > v1) { v1 = lg[e]; e1 = e; }
                const float p1 = __expf(v1 - v0), g0 = 1.f / (1.f + p1), g1 = p1 / (1.f + p1);
                const int wv = (int)(tid >> 6), k = nrec++;
                const unsigned l0 = __hip_atomic_fetch_add(lcnt + e0, 1u, __ATOMIC_RELAXED, __HIP_MEMORY_SCOPE_WORKGROUP), l1 = __hip_atomic_fetch_add(lcnt + 8 + e1, 1u, __ATOMIC_RELAXED, __HIP_MEMORY_SCOPE_WORKGROUP);
                rec[(wv * 16 + k) * 4 + 0] = (unsigned)row; rec[(wv * 16 + k) * 4 + 1] = (unsigned)e0 | ((unsigned)e1 << 8); rec[(wv * 16 + k) * 4 + 2] = l0; rec[(wv * 16 + k) * 4 + 3] = l1;
                gate[row] = g0; gate[16384 + row] = g1;
            }
        }
    }
    if (ROUTE) {
        __syncthreads();
        if (tid < 16) { const unsigned c = lcnt[tid]; lbase[tid] = c ? __hip_atomic_fetch_add(cntw + 64 * tid, c, RLX_AGENT) : 0u; }
        __syncthreads();
        if (lane == 0) { const int wv = (int)(tid >> 6);
            for (int k = 0; k < nrec; ++k) { const unsigned row = rec[(wv * 16 + k) * 4], ee = rec[(wv * 16 + k) * 4 + 1], l0 = rec[(wv * 16 + k) * 4 + 2], l1 = rec[(wv * 16 + k) * 4 + 3];
                const unsigned e0 = ee & 255u, e1 = ee >> 8;
                list[(size_t)e0 * 16384 + lbase[e0] + l0] = (int)row; list[(size_t)(8 + e1) * 16384 + lbase[8 + e1] + l1] = (int)row; } }
    }
}

__device__ __forceinline__ void moe_gather(KArgs a, int j, int lane, int gw, int NGW) {
    unsigned char* ws = a->ws; const unsigned* cntw = (const unsigned*)(ws + WS_CTL) + CW_MOE + 64 * (j * 8);
    int pre[8], cum[8]; { int p = 0, t = 0;
#pragma unroll
        for (int e = 0; e < 8; ++e) { const int c = (int)cntw[64 * e]; pre[e] = p; cum[e] = t; p += c; t += (c + 255) >> 8; } }
    const int* list = (const int*)(ws + WS_LIST) + (size_t)j * 8 * 16384;
    for (int r0 = gw; r0 < M; r0 += 8 * NGW) {
        int tok[8], drow[8];
#pragma unroll
        for (int q = 0; q < 8; ++q) { const int r = r0 + q * NGW; tok[q] = -1; drow[q] = 0;
            if (r < M) { int e = 0;
#pragma unroll
                for (int k = 1; k < 8; ++k) e += (r >= pre[k]) ? 1 : 0;
                int pe = 0, ce = 0;
#pragma unroll
                for (int k = 0; k < 8; ++k) if (k == e) { pe = pre[k]; ce = cum[k]; }
                const int s = r - pe; tok[q] = list[(size_t)e * 16384 + s]; drow[q] = ce * 256 + s; } }
        v4u x0[8], x1[8];
#pragma unroll
        for (int q = 0; q < 8; ++q) { const v4u* src = (const v4u*)((const bf16*)(ws + WS_XB) + (size_t)(tok[q] >= 0 ? tok[q] : 0) * 1024); x0[q] = src[lane]; x1[q] = src[lane + 64]; }
#pragma unroll
        for (int q = 0; q < 8; ++q) if (tok[q] >= 0) { v4u* dst = (v4u*)((bf16*)(ws + WS_R + R_XG + (size_t)j * XG_PASS) + (size_t)drow[q] * 1024); dst[lane] = x0[q]; dst[lane + 64] = x1[q]; }
    }
}

__device__ __forceinline__ void gdn_prep_unit(KArgs a, int l, int unit, LAS unsigned char* lds, int tid, int lane, int wave) {
    unsigned char* ws = a->ws;
    const int n = unit & 31, bh = unit >> 5, h = bh & 3, b = bh >> 2;
    const int t0 = b * SEQ + n * 64;
    LAS float* Q = (LAS float*)lds; LAS float* K = Q + 8192; LAS float* V = K + 8192; LAS float* A = V + 8192; LAS float* gc = A + 4096; LAS float* bt = gc + 64;
    const bf16* HP = (const bf16*)(ws + WS_R + R_HP);
    const float* cw = a->in[2] + (size_t)l * 4 * 1536;
    __syncthreads();
    for (int idx = tid; idx < 64 * 384; idx += 512) { const int i = idx / 384, c = idx % 384, which = c >> 7, d = c & 127;
        const int col = COL_GQ + which * 512 + h * 128 + d, cc = which * 512 + h * 128 + d; float acc = 0.f;
#pragma unroll
        for (int j = 0; j < 4; ++j) { const int s = n * 64 + i - 3 + j; if (s >= 0) acc += cw[j * 1536 + cc] * bf2f(HP[(size_t)(b * SEQ + s) * HP_LD + col]); }
        const float y = siluf(acc); LAS float* dst = which == 0 ? Q : (which == 1 ? K : V); dst[i * 128 + d] = y; }
    if (tid < 64) { const float* gab = (const float*)(ws + WS_GAB) + (size_t)(t0 + tid) * 8; const float x = gab[h] + a->in[4][l * 4 + h];
        const float sp = fmaxf(x, 0.f) + log1pf(__expf(-fabsf(x))); gc[tid] = -__expf(a->in[3][l * 4 + h]) * sp; bt[tid] = sigmf(gab[4 + h]); }
    __syncthreads();
#pragma unroll 1
    for (int r = 0; r < 8; ++r) { const int i = wave * 8 + r;
        float q0 = Q[i * 128 + lane], q1 = Q[i * 128 + lane + 64], k0 = K[i * 128 + lane], k1 = K[i * 128 + lane + 64];
        const float sq = wave_sum(q0 * q0 + q1 * q1), sk = wave_sum(k0 * k0 + k1 * k1);
        const float fq = rsqrtf(sq + NORM_EPS) * 0.08838834764831845f, fk = rsqrtf(sk + NORM_EPS);
        Q[i * 128 + lane] = q0 * fq; Q[i * 128 + lane + 64] = q1 * fq; K[i * 128 + lane] = k0 * fk; K[i * 128 + lane + 64] = k1 * fk; }
    if (tid == 0) { float c = 0.f; for (int i = 0; i < 64; ++i) { c += gc[i]; gc[i] = c; } }
    __syncthreads();
    bf16* QKg = (bf16*)(ws + WS_R + R_QK) + (size_t)unit * 4096; bf16* QDg = (bf16*)(ws + WS_R + R_QD) + (size_t)unit * 8192; bf16* KDTg = (bf16*)(ws + WS_R + R_KDT) + (size_t)unit * 8192;
    bf16* WNg = (bf16*)(ws + WS_R + R_WN) + (size_t)unit * 8192; bf16* Ug = (bf16*)(ws + WS_R + R_U) + (size_t)unit * 8192;
    for (int idx = tid; idx < 4096; idx += 512) { const int i = idx >> 6, j = idx & 63; float dqk = 0.f, dkk = 0.f;
        for (int dd = 0; dd < 128; ++dd) { const int d = (dd + j) & 127; const float kj = K[j * 128 + d]; dqk += Q[i * 128 + d] * kj; dkk += K[i * 128 + d] * kj; }
        const float dec = __expf(gc[i] - gc[j]);
        A[i * 64 + j] = (j < i) ? bt[i] * dkk * dec : 0.f;
        QKg[fragoff(i, j, 2)] = (bf16)f2bf((j <= i) ? dqk * dec : 0.f); }
    const float gl = gc[63];
    for (int idx = tid; idx < 8192; idx += 512) { const int i = idx >> 7, d = idx & 127;
        QDg[fragoff(i, d, 4)] = (bf16)f2bf(Q[i * 128 + d] * __expf(gc[i]));
        KDTg[fragoff(d, i, 2)] = (bf16)f2bf(K[i * 128 + d] * __expf(gl - gc[i])); }
    if (tid == 0) ((float*)(ws + WS_CD))[unit] = __expf(gl);
    __syncthreads();
    for (int idx = tid; idx < 8192; idx += 512) { const int i = idx >> 7; const float bi = bt[i]; V[idx] *= bi; Q[idx] = bi * __expf(gc[i]) * K[idx]; }
    __syncthreads();
    if (tid < 256) { LAS float* buf = (tid < 128 ? V : Q) + (tid & 127);
        for (int i = 1; i < 64; ++i) { float acc = buf[i * 128]; for (int m = 0; m < i; ++m) acc -= A[i * 64 + m] * buf[m * 128]; buf[i * 128] = acc; } }
    __syncthreads();
    for (int idx = tid; idx < 8192; idx += 512) { const int i = idx >> 7, d = idx & 127; Ug[uoff(i, d)] = (bf16)f2bf(V[idx]); WNg[fragoff(i, d, 4)] = (bf16)f2bf(-Q[idx]); }
}

__device__ __forceinline__ void gdn_scan_naive(KArgs a, int l, int bh, LAS unsigned char* lds, int tid, int lane, int wave) {
    unsigned char* ws = a->ws;
    LAS float* S = (LAS float*)lds; LAS float* VN = S + 16384; LAS float* O = VN + 8192;
    const int h = bh & 3, b = bh >> 2, e = tid & 127, ig = tid >> 7;
    const bf16* HP = (const bf16*)(ws + WS_R + R_HP); bf16* OB = (bf16*)(ws + WS_R + R_OB);
    const float* nw = a->in[5] + l * 128;
    __syncthreads();
    for (int idx = tid; idx < 16384; idx += 512) S[idx] = 0.f;
    __syncthreads();
#pragma unroll 1
    for (int n = 0; n < 32; ++n) {
        const int unit = bh * 32 + n;
        const bf16* Ug = (const bf16*)(ws + WS_R + R_U) + (size_t)unit * 8192; const bf16* WNg = (const bf16*)(ws + WS_R + R_WN) + (size_t)unit * 8192;
        const bf16* QDg = (const bf16*)(ws + WS_R + R_QD) + (size_t)unit * 8192; const bf16* KDTg = (const bf16*)(ws + WS_R + R_KDT) + (size_t)unit * 8192;
        const bf16* QKg = (const bf16*)(ws + WS_R + R_QK) + (size_t)unit * 4096; const float cd = ((const float*)(ws + WS_CD))[unit];
#pragma unroll 1
        for (int r = 0; r < 16; ++r) { const int i = ig + 4 * r; float acc = bf2f(Ug[uoff(i, e)]);
#pragma unroll 2
            for (int d0 = 0; d0 < 128; d0 += 4) { const v2u w = *(const v2u*)(WNg + fragoff(i, d0, 4));
                acc += bflo(w.x) * S[d0 * 128 + e] + bfhi(w.x) * S[(d0 + 1) * 128 + e] + bflo(w.y) * S[(d0 + 2) * 128 + e] + bfhi(w.y) * S[(d0 + 3) * 128 + e]; }
            VN[i * 128 + e] = acc; }
        __syncthreads();
#pragma unroll 1
        for (int r = 0; r < 16; ++r) { const int i = ig + 4 * r; float acc = 0.f;
#pragma unroll 2
            for (int d0 = 0; d0 < 128; d0 += 4) { const v2u w = *(const v2u*)(QDg + fragoff(i, d0, 4));
                acc += bflo(w.x) * S[d0 * 128 + e] + bfhi(w.x) * S[(d0 + 1) * 128 + e] + bflo(w.y) * S[(d0 + 2) * 128 + e] + bfhi(w.y) * S[(d0 + 3) * 128 + e]; }
#pragma unroll 2
            for (int j0 = 0; j0 < 64; j0 += 4) { const v2u w = *(const v2u*)(QKg + fragoff(i, j0, 2));
                acc += bflo(w.x) * VN[j0 * 128 + e] + bfhi(w.x) * VN[(j0 + 1) * 128 + e] + bflo(w.y) * VN[(j0 + 2) * 128 + e] + bfhi(w.y) * VN[(j0 + 3) * 128 + e]; }
            O[i * 128 + e] = acc; }
        __syncthreads();
#pragma unroll 1
        for (int r = 0; r < 32; ++r) { const int d = ig + 4 * r; float acc = S[d * 128 + e] * cd;
#pragma unroll 2
            for (int i0 = 0; i0 < 64; i0 += 4) { const v2u w = *(const v2u*)(KDTg + fragoff(d, i0, 2));
                acc += bflo(w.x) * VN[i0 * 128 + e] + bfhi(w.x) * VN[(i0 + 1) * 128 + e] + bflo(w.y) * VN[(i0 + 2) * 128 + e] + bfhi(w.y) * VN[(i0 + 3) * 128 + e]; }
            S[d * 128 + e] = acc; }
#pragma unroll 1
        for (int r = 0; r < 8; ++r) { const int i = wave * 8 + r; const float v0 = O[i * 128 + lane], v1 = O[i * 128 + lane + 64];
            const float rs = rsqrtf(wave_sum(v0 * v0 + v1 * v1) * (1.f / 128.f) + NORM_EPS);
            const size_t t = (size_t)b * SEQ + n * 64 + i; const bf16* gp = HP + t * HP_LD + COL_GG + h * 128; bf16* op = OB + t * 1024 + 512 + h * 128;
            op[lane] = (bf16)f2bf(v0 * rs * nw[lane] * siluf(bf2f(gp[lane]))); op[lane + 64] = (bf16)f2bf(v1 * rs * nw[lane + 64] * siluf(bf2f(gp[lane + 64]))); }
        __syncthreads();
    }
}

__device__ __forceinline__ void ret_unit_naive(KArgs a, int unit, LAS unsigned char* lds, int tid, int lane, int wave) {
    unsigned char* ws = a->ws;
    LAS float* Qs = (LAS float*)lds; LAS float* Ks = Qs + 64 * 65; LAS float* Vs = Ks + 64 * 65; LAS float* Sc = Vs + 8192;
    const int qb = unit & 31, bh = unit >> 5, h = bh & 3, b = bh >> 2, e = tid & 127, ig = tid >> 7;
    const bf16* HP = (const bf16*)(ws + WS_R + R_HP); bf16* OB = (bf16*)(ws + WS_R + R_OB); const float* RT = (const float*)(ws + WS_ROPE);
    const float log2g = log2f(1.0f - exp2f(-5.0f - (float)h));
    __syncthreads();
    for (int idx = tid; idx < 4096; idx += 512) { const int i = idx >> 6, d = idx & 63, dd = d & 31, pos = qb * 64 + i; const size_t t = (size_t)b * SEQ + pos;
        const float c = RT[pos * 64 + dd], s = RT[pos * 64 + 32 + dd]; const float x1 = bf2f(HP[t * HP_LD + COL_RQ + h * 64 + dd]), x2 = bf2f(HP[t * HP_LD + COL_RQ + h * 64 + dd + 32]);
        Qs[i * 65 + d] = d < 32 ? x1 * c - x2 * s : x1 * s + x2 * c; }
    float acc[16];
#pragma unroll
    for (int r = 0; r < 16; ++r) acc[r] = 0.f;
#pragma unroll 1
    for (int kb = 0; kb <= qb; ++kb) {
        __syncthreads();
        for (int idx = tid; idx < 4096; idx += 512) { const int i = idx >> 6, d = idx & 63, dd = d & 31, pos = kb * 64 + i; const size_t t = (size_t)b * SEQ + pos;
            const float c = RT[pos * 64 + dd], s = RT[pos * 64 + 32 + dd]; const float x1 = bf2f(HP[t * HP_LD + COL_RK + h * 64 + dd]), x2 = bf2f(HP[t * HP_LD + COL_RK + h * 64 + dd + 32]);
            Ks[i * 65 + d] = 0.125f * (d < 32 ? x1 * c - x2 * s : x1 * s + x2 * c); }
        for (int idx = tid; idx < 8192; idx += 512) { const int i = idx >> 7, d = idx & 127; Vs[idx] = bf2f(HP[((size_t)b * SEQ + kb * 64 + i) * HP_LD + COL_RV + h * 128 + d]); }
        __syncthreads();
        { const int j = tid & 63, ig8 = tid >> 6;
#pragma unroll 1
          for (int r = 0; r < 8; ++r) { const int i = ig8 + 8 * r; float dot = 0.f;
#pragma unroll 8
              for (int d = 0; d < 64; ++d) dot += Qs[i * 65 + d] * Ks[j * 65 + d];
              const int delta = (qb - kb) * 64 + i - j; Sc[i * 65 + j] = delta >= 0 ? dot * exp2f((float)delta * log2g) : 0.f; } }
        __syncthreads();
#pragma unroll 2
        for (int j = 0; j < 64; ++j) { const float vv = Vs[j * 128 + e];
#pragma unroll
            for (int r = 0; r < 16; ++r) acc[r] += Sc[(ig + 4 * r) * 65 + j] * vv; }
    }
    __syncthreads();
#pragma unroll
    for (int r = 0; r < 16; ++r) Vs[(ig + 4 * r) * 128 + e] = acc[r];
    __syncthreads();
#pragma unroll 1
    for (int r = 0; r < 8; ++r) { const int i = wave * 8 + r; const float v0 = Vs[i * 128 + lane], v1 = Vs[i * 128 + lane + 64];
        const float mean = wave_sum(v0 + v1) * (1.f / 128.f), d0 = v0 - mean, d1 = v1 - mean; const float rs = rsqrtf(wave_sum(d0 * d0 + d1 * d1) * (1.f / 128.f) + LN_EPS);
        const size_t t = (size_t)b * SEQ + qb * 64 + i; const bf16* gp = HP + t * HP_LD + COL_RG + h * 128; bf16* op = OB + t * 1024 + h * 128;
        op[lane] = (bf16)f2bf(d0 * rs * siluf(bf2f(gp[lane]))); op[lane + 64] = (bf16)f2bf(d1 * rs * siluf(bf2f(gp[lane + 64]))); }
}

typedef float f32x16 __attribute__((ext_vector_type(16)));
typedef float f32x8 __attribute__((ext_vector_type(8)));
typedef __bf16 bf8v __attribute__((ext_vector_type(8)));
typedef short bf16x8 __attribute__((ext_vector_type(8)));
#define MFMA32(a, b, c) __builtin_amdgcn_mfma_f32_32x32x16_bf16((a), (b), (c), 0, 0, 0)
__device__ __forceinline__ bf16x8 pack8(const f32x16& x, int s) {
    f32x8 v;
#pragma unroll
    for (int j = 0; j < 8; ++j) v[j] = x[8 * s + j];
    return __builtin_bit_cast(bf16x8, __builtin_convertvector(v, bf8v));
}

__device__ __forceinline__ unsigned short bfc(float x) { return __builtin_bit_cast(unsigned short, (__bf16)x); }
__device__ __forceinline__ unsigned bfc2(float lo, float hi) { return (unsigned)bfc(lo) | ((unsigned)bfc(hi) << 16); }

#ifndef PROBE_UNIT
#define PROBE_UNIT 0
#endif
#if defined(PROBE_MULT) && PROBE_MULT > 0
#define STAMPT(id, thr) do { if (blockIdx.x == PROBE_BID && threadIdx.x == (thr)) __hip_atomic_store((unsigned long long*)(a->ws + WS_CTL + 131072) + (id), (unsigned long long)__builtin_amdgcn_s_memrealtime(), RLX_AGENT); } while (0)
#else
#define STAMPT(id, thr) do {} while (0)
#endif
#ifndef GDN_F8
#define GDN_F8 0
#endif
#ifndef GATE_PRE
#define GATE_PRE 1
#endif
constexpr float F8_SW = 4.f, F8_SQ = 16.f, F8_SK = 4.f;
#define MFMA8(a, b, c) __builtin_amdgcn_mfma_f32_32x32x16_fp8_fp8((a), (b), (c), 0, 0, 0)
__device__ __forceinline__ unsigned f8x4(float a, float b, float c, float d) { int w = __builtin_amdgcn_cvt_pk_fp8_f32(a, b, 0, false); w = __builtin_amdgcn_cvt_pk_fp8_f32(c, d, w, true); return (unsigned)w; }
__device__ __forceinline__ long pack8_f8(const f32x16& x, int s, float sc) {
    const unsigned lo = f8x4(x[8 * s] * sc, x[8 * s + 1] * sc, x[8 * s + 2] * sc, x[8 * s + 3] * sc), hi = f8x4(x[8 * s + 4] * sc, x[8 * s + 5] * sc, x[8 * s + 6] * sc, x[8 * s + 7] * sc);
    return (long)(((unsigned long)hi << 32) | (unsigned long)lo);
}
#if GATE_PRE
#define GSILU(x) (x)
#else
#define GSILU(x) siluf(x)
#endif
#define GDN_BAR() do { asm volatile("s_waitcnt lgkmcnt(0)" ::: "memory"); __builtin_amdgcn_s_barrier(); asm volatile("" ::: "memory"); } while (0)
__device__ __forceinline__ void gdn_scan_fast(KArgs a, int l, int bh, LAS unsigned char* lds, int tid, int lane, int wave) {
    unsigned char* ws = a->ws;
#if GDN_F8
    constexpr int FB_WN = 0, FB_QD = 8192, FB_KDT = 16384, FB_QK = 24576, FB_U = 28672, FB_BYTES = 45056, NPC = 11, OPB = 8192;
#else
    constexpr int FB_WN = 0, FB_QD = 16384, FB_KDT = 32768, FB_QK = 49152, FB_U = 57344, FB_BYTES = 73728, NPC = 18, OPB = 16384;
#endif
    LAS float* OL = (LAS float*)(lds + FB_BYTES);
    constexpr int OLS = 64 * 132;
    const int h = bh & 3, b = bh >> 2, c = lane & 31, hh = lane >> 5;
    const bf16* HP = (const bf16*)(ws + WS_R + R_HP); bf16* OB = (bf16*)(ws + WS_R + R_OB);
    const float* nw = a->in[5] + l * 128;
    const unsigned char* gWN = (const unsigned char*)(ws + WS_R + R_WN) + (size_t)bh * 32 * OPB; const unsigned char* gQD = (const unsigned char*)(ws + WS_R + R_QD) + (size_t)bh * 32 * OPB;
    const unsigned char* gKDT = (const unsigned char*)(ws + WS_R + R_KDT) + (size_t)bh * 32 * OPB; const unsigned char* gQK = (const unsigned char*)(ws + WS_R + R_QK) + (size_t)bh * 32 * (OPB / 2);
    const unsigned char* gU = (const unsigned char*)(ws + WS_R + R_U) + (size_t)bh * 32 * 16384;
    const int et = tid - 256;
#define GDN_FETCH(pf, nn) do { constexpr int P4 = OPB / 4096; _Pragma("unroll") for (int k = 0; k < NPC; ++k) { const unsigned char* src_ = k < P4 ? gWN + (size_t)(nn) * OPB + k * 4096 : k < 2 * P4 ? gQD + (size_t)(nn) * OPB + (k - P4) * 4096 : \
        k < 3 * P4 ? gKDT + (size_t)(nn) * OPB + (k - 2 * P4) * 4096 : k < 3 * P4 + P4 / 2 ? gQK + (size_t)(nn) * (OPB / 2) + (k - 3 * P4) * 4096 : gU + (size_t)(nn) * 16384 + (k - 3 * P4 - P4 / 2) * 4096; pf[k] = *(const v4u*)(src_ + et * 16); } } while (0)
#define GDN_STORE(pf) do { _Pragma("unroll") for (int k = 0; k < NPC; ++k) *(LAS v4u*)(lds + k * 4096 + et * 16) = pf[k]; } while (0)
    __syncthreads();
    if (wave < 4) {
        f32x16 S[4];
#pragma unroll
        for (int t = 0; t < 4; ++t)
#pragma unroll
            for (int i = 0; i < 16; ++i) S[t][i] = 0.f;
        GDN_BAR();
#if GDN_F8
        const int q = wave;
        const LAS long* WNf = (const LAS long*)(lds + FB_WN) + lane; const LAS long* QDf = (const LAS long*)(lds + FB_QD) + lane;
        const LAS long* KDTf = (const LAS long*)(lds + FB_KDT) + lane; const LAS long* QKf = (const LAS long*)(lds + FB_QK) + lane;
        const LAS v4u* Uf = (const LAS v4u*)(lds + FB_U) + (q * 2) * 128 + lane;
#pragma unroll 1
        for (int n = 0; n < 32; ++n) {
            const float cd = ((const float*)(ws + WS_CD))[bh * 32 + n];
            long A0[8], A1[8];
#define GDN_LD_MTS(A, F, g) do { _Pragma("unroll") for (int k = 0; k < 8; ++k) { const int m_ = k & 1, s_ = (k >> 1) & 1, t_ = 2 * (g) + (k >> 2); A[k] = F[((m_ * 4 + t_) * 2 + s_) * 64]; } } while (0)
#define GDN_LD_TMS(A, F, g) do { _Pragma("unroll") for (int k = 0; k < 8; ++k) { const int s_ = k & 1, m_ = (k >> 1) & 1, t_ = 2 * (g) + (k >> 2); A[k] = F[((t_ * 2 + m_) * 2 + s_) * 64]; } } while (0)
            GDN_LD_MTS(A0, WNf, 0); GDN_LD_MTS(A1, WNf, 1);
            f32x16 av[2];
#pragma unroll
            for (int m = 0; m < 2; ++m)
#pragma unroll
                for (int hf = 0; hf < 2; ++hf) { const v4u u4 = Uf[(m * 2 + hf) * 64];
#pragma unroll
                    for (int k = 0; k < 4; ++k) { av[m][8 * hf + 2 * k] = bflo(u4[k]) * F8_SW; av[m][8 * hf + 2 * k + 1] = bfhi(u4[k]) * F8_SW; } }
            long Sb[4][2];
#pragma unroll
            for (int t = 0; t < 4; ++t) { Sb[t][0] = pack8_f8(S[t], 0, 1.f / F8_SK); Sb[t][1] = pack8_f8(S[t], 1, 1.f / F8_SK); }
#pragma unroll
            for (int k = 0; k < 8; ++k) { const int m_ = k & 1, s_ = (k >> 1) & 1, t_ = (k >> 2); av[m_] = MFMA8(A0[k], Sb[t_][s_], av[m_]); }
            GDN_LD_MTS(A0, QDf, 0);
#pragma unroll
            for (int k = 0; k < 8; ++k) { const int m_ = k & 1, s_ = (k >> 1) & 1, t_ = 2 + (k >> 2); av[m_] = MFMA8(A1[k], Sb[t_][s_], av[m_]); }
            GDN_LD_MTS(A1, QDf, 1);
            f32x16 ao[2];
#pragma unroll
            for (int m = 0; m < 2; ++m)
#pragma unroll
                for (int i = 0; i < 16; ++i) ao[m][i] = 0.f;
#pragma unroll
            for (int k = 0; k < 8; ++k) { const int m_ = k & 1, s_ = (k >> 1) & 1, t_ = (k >> 2); ao[m_] = MFMA8(A0[k], Sb[t_][s_], ao[m_]); }
#pragma unroll
            for (int k = 0; k < 6; ++k) { const int s_ = k & 1, m_ = k >= 2 ? 1 : 0, mp_ = k >= 4 ? 1 : 0; A0[k] = QKf[((m_ * 2 + mp_) * 2 + s_) * 64]; }
#pragma unroll
            for (int k = 0; k < 8; ++k) { const int m_ = k & 1, s_ = (k >> 1) & 1, t_ = 2 + (k >> 2); ao[m_] = MFMA8(A1[k], Sb[t_][s_], ao[m_]); }
            GDN_LD_TMS(A1, KDTf, 0);
            long Vb[2][2];
#pragma unroll
            for (int m = 0; m < 2; ++m) { Vb[m][0] = pack8_f8(av[m], 0, 1.f / F8_SW); Vb[m][1] = pack8_f8(av[m], 1, 1.f / F8_SW); }
#pragma unroll
            for (int k = 0; k < 6; ++k) { const int s_ = k & 1, m_ = k >= 2 ? 1 : 0, mp_ = k >= 4 ? 1 : 0; ao[m_] = MFMA8(A0[k], Vb[mp_][s_], ao[m_]); }
            GDN_LD_TMS(A0, KDTf, 1);
            {   LAS float* Ob = OL + (n & 1) * OLS + 32 * wave + c;
#pragma unroll
                for (int m = 0; m < 2; ++m)
#pragma unroll
                    for (int i = 0; i < 16; ++i) Ob[(32 * m + (i & 3) + 8 * (i >> 2) + 4 * hh) * 132] = ao[m][i] * (1.f / F8_SQ); }
#pragma unroll
            for (int t = 0; t < 4; ++t)
#pragma unroll
                for (int i = 0; i < 16; ++i) S[t][i] *= cd;
#pragma unroll
            for (int k = 0; k < 8; ++k) { const int s_ = k & 1, m_ = (k >> 1) & 1, t_ = (k >> 2); S[t_] = MFMA8(A1[k], Vb[m_][s_], S[t_]); }
#pragma unroll
            for (int k = 0; k < 8; ++k) { const int s_ = k & 1, m_ = (k >> 1) & 1, t_ = 2 + (k >> 2); S[t_] = MFMA8(A0[k], Vb[m_][s_], S[t_]); }
#undef GDN_LD_MTS
#undef GDN_LD_TMS
            GDN_BAR();
            GDN_BAR();
        }
#else
        const int q = wave;
        const LAS bf16x8* WNf = (const LAS bf16x8*)(lds + FB_WN) + lane; const LAS bf16x8* QDf = (const LAS bf16x8*)(lds + FB_QD) + lane;
        const LAS bf16x8* KDTf = (const LAS bf16x8*)(lds + FB_KDT) + lane; const LAS bf16x8* QKf = (const LAS bf16x8*)(lds + FB_QK) + lane;
        const LAS v4u* Uf = (const LAS v4u*)(lds + FB_U) + (q * 2) * 128 + lane;
#pragma unroll 1
        for (int n = 0; n < 32; ++n) {
            if (n == 10) STAMPT(110, 0);
            const float cd = ((const float*)(ws + WS_CD))[bh * 32 + n];
            bf16x8 A0[8], A1[8];
#define GDN_LD_MTS(A, F, g) do { _Pragma("unroll") for (int k = 0; k < 8; ++k) { const int m_ = k & 1, s_ = (k >> 1) & 1, t_ = 2 * (g) + (k >> 2); A[k] = F[((m_ * 4 + t_) * 2 + s_) * 64]; } } while (0)
#define GDN_LD_TMS(A, F, g) do { _Pragma("unroll") for (int k = 0; k < 8; ++k) { const int s_ = k & 1, m_ = (k >> 1) & 1, t_ = 2 * (g) + (k >> 2); A[k] = F[((t_ * 2 + m_) * 2 + s_) * 64]; } } while (0)
            GDN_LD_MTS(A0, WNf, 0); GDN_LD_MTS(A1, WNf, 1);
            f32x16 av[2];
#pragma unroll
            for (int m = 0; m < 2; ++m)
#pragma unroll
                for (int hf = 0; hf < 2; ++hf) { const v4u u4 = Uf[(m * 2 + hf) * 64];
#pragma unroll
                    for (int k = 0; k < 4; ++k) { av[m][8 * hf + 2 * k] = bflo(u4[k]); av[m][8 * hf + 2 * k + 1] = bfhi(u4[k]); } }
            bf16x8 Sb[4][2];
#pragma unroll
            for (int t = 0; t < 4; ++t) { Sb[t][0] = pack8(S[t], 0); Sb[t][1] = pack8(S[t], 1); }
#pragma unroll
            for (int k = 0; k < 8; ++k) { const int m_ = k & 1, s_ = (k >> 1) & 1, t_ = (k >> 2); av[m_] = MFMA32(A0[k], Sb[t_][s_], av[m_]); }
            GDN_LD_MTS(A0, QDf, 0);
#pragma unroll
            for (int k = 0; k < 8; ++k) { const int m_ = k & 1, s_ = (k >> 1) & 1, t_ = 2 + (k >> 2); av[m_] = MFMA32(A1[k], Sb[t_][s_], av[m_]); }
            GDN_LD_MTS(A1, QDf, 1);
            f32x16 ao[2];
#pragma unroll
            for (int m = 0; m < 2; ++m)
#pragma unroll
                for (int i = 0; i < 16; ++i) ao[m][i] = 0.f;
#pragma unroll
            for (int k = 0; k < 8; ++k) { const int m_ = k & 1, s_ = (k >> 1) & 1, t_ = (k >> 2); ao[m_] = MFMA32(A0[k], Sb[t_][s_], ao[m_]); }
#pragma unroll
            for (int k = 0; k < 6; ++k) { const int s_ = k & 1, m_ = k >= 2 ? 1 : 0, mp_ = k >= 4 ? 1 : 0; A0[k] = QKf[((m_ * 2 + mp_) * 2 + s_) * 64]; }
#pragma unroll
            for (int k = 0; k < 8; ++k) { const int m_ = k & 1, s_ = (k >> 1) & 1, t_ = 2 + (k >> 2); ao[m_] = MFMA32(A1[k], Sb[t_][s_], ao[m_]); }
            GDN_LD_TMS(A1, KDTf, 0);
            bf16x8 Vb[2][2];
#pragma unroll
            for (int m = 0; m < 2; ++m) { Vb[m][0] = pack8(av[m], 0); Vb[m][1] = pack8(av[m], 1); }
#pragma unroll
            for (int k = 0; k < 6; ++k) { const int s_ = k & 1, m_ = k >= 2 ? 1 : 0, mp_ = k >= 4 ? 1 : 0; ao[m_] = MFMA32(A0[k], Vb[mp_][s_], ao[m_]); }
            GDN_LD_TMS(A0, KDTf, 1);
            {   LAS float* Ob = OL + (n & 1) * OLS + 32 * wave + c;
#pragma unroll
                for (int m = 0; m < 2; ++m)
#pragma unroll
                    for (int i = 0; i < 16; ++i) Ob[(32 * m + (i & 3) + 8 * (i >> 2) + 4 * hh) * 132] = ao[m][i]; }
#pragma unroll
            for (int t = 0; t < 4; ++t)
#pragma unroll
                for (int i = 0; i < 16; ++i) S[t][i] *= cd;
#pragma unroll
            for (int k = 0; k < 8; ++k) { const int s_ = k & 1, m_ = (k >> 1) & 1, t_ = (k >> 2); S[t_] = MFMA32(A1[k], Vb[m_][s_], S[t_]); }
#pragma unroll
            for (int k = 0; k < 8; ++k) { const int s_ = k & 1, m_ = (k >> 1) & 1, t_ = 2 + (k >> 2); S[t_] = MFMA32(A0[k], Vb[m_][s_], S[t_]); }
#undef GDN_LD_MTS
#undef GDN_LD_TMS
            if (n == 10) STAMPT(111, 0);
            GDN_BAR();
            if (n == 10) STAMPT(112, 0);
            GDN_BAR();
            if (n == 10) STAMPT(113, 0);
        }
#endif
        GDN_BAR(); GDN_BAR();
    } else {
        v4u pfA[NPC], pfB[NPC];
        LAS float* NWl = OL + 2 * OLS;
        if (et < 128) NWl[et] = nw[et];
        GDN_FETCH(pfB, 0); GDN_FETCH(pfA, 1); GDN_STORE(pfB);
        GDN_BAR();
        const int i = et >> 2, qd = et & 3;
#define GDN_LOADER_ITER(n, PF_FETCH, PF_STORE, GQL, GQU) do { \
            if ((n) == 10) STAMPT(120, 256); \
            if ((n) < 32) { const bf16* gp = HP + ((size_t)b * SEQ + (n) * 64 + i) * HP_LD + COL_GG + h * 128 + 32 * qd;     \
                _Pragma("unroll") for (int k = 0; k < 4; ++k) GQL[k] = *(const v4u*)(gp + 8 * k); } \
            if ((n) + 2 < 32) GDN_FETCH(PF_FETCH, (n) + 2); \
            if ((n) == 10) STAMPT(125, 256); \
            if ((n) > 0) { \
                const LAS float* Ob = OL + (((n) - 1) & 1) * OLS + i * 132 + 32 * qd; \
                float ss = 0.f; \
                _Pragma("unroll") for (int k = 0; k < 8; ++k) { const f32x4 v_ = *(const LAS f32x4*)(Ob + 4 * k); ss += (v_.x * v_.x + v_.y * v_.y) + (v_.z * v_.z + v_.w * v_.w); } \
                ss += __shfl_xor(ss, 1); ss += __shfl_xor(ss, 2); \
                const float rs = rsqrtf(ss * (1.f / 128.f) + NORM_EPS); \
                bf16* op = OB + ((size_t)b * SEQ + ((n) - 1) * 64 + i) * 1024 + 512 + h * 128 + 32 * qd; \
                _Pragma("unroll") for (int k = 0; k < 4; ++k) { const f32x4 w0 = *(const LAS f32x4*)(NWl + 32 * qd + 8 * k), w1 = *(const LAS f32x4*)(NWl + 32 * qd + 8 * k + 4); const v4u gg = GQU[k]; \
                    const f32x4 a0 = *(const LAS f32x4*)(Ob + 8 * k), a1 = *(const LAS f32x4*)(Ob + 8 * k + 4); \
                    v4u o; o.x = bfc2(a0.x * rs * w0.x * GSILU(bflo(gg.x)), a0.y * rs * w0.y * GSILU(bfhi(gg.x))); o.y = bfc2(a0.z * rs * w0.z * GSILU(bflo(gg.y)), a0.w * rs * w0.w * GSILU(bfhi(gg.y))); \
                    o.z = bfc2(a1.x * rs * w1.x * GSILU(bflo(gg.z)), a1.y * rs * w1.y * GSILU(bfhi(gg.z))); o.w = bfc2(a1.z * rs * w1.z * GSILU(bflo(gg.w)), a1.w * rs * w1.w * GSILU(bfhi(gg.w))); \
                    *(v4u*)(op + 8 * k) = o; } \
            } \
            asm volatile("" ::: "memory"); \
            if ((n) == 10) STAMPT(121, 256); \
            GDN_BAR();            \
            if ((n) == 10) STAMPT(122, 256); \
            if ((n) + 1 < 32) GDN_STORE(PF_STORE); \
            if ((n) == 10) STAMPT(123, 256); \
            GDN_BAR();            \
            if ((n) == 10) STAMPT(124, 256); \
        } while (0)
        v4u gqA[4], gqB[4];
#pragma unroll
        for (int k = 0; k < 4; ++k) { gqA[k] = (v4u){0u, 0u, 0u, 0u}; gqB[k] = (v4u){0u, 0u, 0u, 0u}; }
#pragma unroll
        for (int n = 0; n < 32; n += 2) {
            GDN_LOADER_ITER(n, pfB, pfA, gqA, gqB);
            GDN_LOADER_ITER(n + 1, pfA, pfB, gqB, gqA);
        }
        GDN_LOADER_ITER(32, pfB, pfA, gqA, gqB);
#undef GDN_LOADER_ITER
    }
#undef GDN_FETCH
#undef GDN_STORE
}

__device__ __forceinline__ void gdn_scan_helper(KArgs a, int bh, int tid) {
    unsigned char* ws = a->ws;
    const unsigned char* gWN = (const unsigned char*)(ws + WS_R + R_WN) + (size_t)bh * 32 * 16384; const unsigned char* gQD = (const unsigned char*)(ws + WS_R + R_QD) + (size_t)bh * 32 * 16384;
    const unsigned char* gKDT = (const unsigned char*)(ws + WS_R + R_KDT) + (size_t)bh * 32 * 16384; const unsigned char* gQK = (const unsigned char*)(ws + WS_R + R_QK) + (size_t)bh * 32 * 8192;
    const unsigned char* gU = (const unsigned char*)(ws + WS_R + R_U) + (size_t)bh * 32 * 16384;
#pragma unroll 1
    for (int n = 0; n < 32; ++n) {
        v4u pf[9];
#pragma unroll
        for (int k = 0; k < 9; ++k) { const int kk = 2 * k + (tid >> 8), et = tid & 255;
            const unsigned char* src_ = kk < 4 ? gWN + (size_t)n * 16384 + kk * 4096 : kk < 8 ? gQD + (size_t)n * 16384 + (kk - 4) * 4096 :
                kk < 12 ? gKDT + (size_t)n * 16384 + (kk - 8) * 4096 : kk < 14 ? gQK + (size_t)n * 8192 + (kk - 12) * 4096 : gU + (size_t)n * 16384 + (kk - 14) * 4096;
            pf[k] = *(const v4u*)(src_ + et * 16); }
#pragma unroll
        for (int k = 0; k < 9; ++k) asm volatile("" :: "v"(pf[k]));
    }
}

__device__ __forceinline__ void gdn_scan_v3(KArgs a, int l, int bhq, LAS unsigned char* lds, int tid, int lane, int wave) {
    unsigned char* ws = a->ws;
    constexpr int FB_WN = 0, FB_QD = 16384, FB_KDT = 32768, FB_QK = 49152, FB_U = 57344, IMG = 61440;
    constexpr int OLS = 64 * 36;
    LAS float* OL = (LAS float*)(lds + 2 * IMG);
    const int bh = bhq >> 2, q = bhq & 3, h = bh & 3, b = bh >> 2, c = lane & 31, hh = lane >> 5;
    bf16* OB = (bf16*)(ws + WS_R + R_OB); float* SSQ = (float*)(ws + WS_SSQ);
    const unsigned char* gWN = (const unsigned char*)(ws + WS_R + R_WN) + (size_t)bh * 32 * 16384; const unsigned char* gQD = (const unsigned char*)(ws + WS_R + R_QD) + (size_t)bh * 32 * 16384;
    const unsigned char* gKDT = (const unsigned char*)(ws + WS_R + R_KDT) + (size_t)bh * 32 * 16384; const unsigned char* gQK = (const unsigned char*)(ws + WS_R + R_QK) + (size_t)bh * 32 * 8192;
    const unsigned char* gU = (const unsigned char*)(ws + WS_R + R_U) + (size_t)bh * 32 * 16384 + q * 4096;
    const int et = tid - 256;
#define G3_FETCH(pf, nn) do { _Pragma("unroll") for (int k = 0; k < 15; ++k) { const unsigned char* src_ = k < 4 ? gWN + (size_t)(nn) * 16384 + k * 4096 : k < 8 ? gQD + (size_t)(nn) * 16384 + (k - 4) * 4096 : \
        k < 12 ? gKDT + (size_t)(nn) * 16384 + (k - 8) * 4096 : k < 14 ? gQK + (size_t)(nn) * 8192 + (k - 12) * 4096 : gU + (size_t)(nn) * 16384; pf[k] = *(const v4u*)(src_ + et * 16); } } while (0)
#define G3_STORE(pf, buf) do { _Pragma("unroll") for (int k = 0; k < 15; ++k) *(LAS v4u*)(lds + (buf) * IMG + k * 4096 + et * 16) = pf[k]; } while (0)
    __syncthreads();
    if (wave == 0) {
        f32x16 S[4];
#pragma unroll
        for (int t = 0; t < 4; ++t)
#pragma unroll
            for (int i = 0; i < 16; ++i) S[t][i] = 0.f;
        GDN_BAR();
#pragma unroll 1
        for (int n = 0; n < 32; ++n) {
            const LAS unsigned char* img = lds + (n & 1) * IMG;
            const LAS bf16x8* WNf = (const LAS bf16x8*)(img + FB_WN) + lane; const LAS bf16x8* QDf = (const LAS bf16x8*)(img + FB_QD) + lane;
            const LAS bf16x8* KDTf = (const LAS bf16x8*)(img + FB_KDT) + lane; const LAS bf16x8* QKf = (const LAS bf16x8*)(img + FB_QK) + lane;
            const LAS v4u* Uf = (const LAS v4u*)(img + FB_U) + lane;
            const float cd = ((const float*)(ws + WS_CD))[bh * 32 + n];
            bf16x8 A0[8], A1[8];
#define G3_LD_MTS(A, F, g) do { _Pragma("unroll") for (int k = 0; k < 8; ++k) { const int m_ = k & 1, s_ = (k >> 1) & 1, t_ = 2 * (g) + (k >> 2); A[k] = F[((m_ * 4 + t_) * 2 + s_) * 64]; } } while (0)
#define G3_LD_TMS(A, F, g) do { _Pragma("unroll") for (int k = 0; k < 8; ++k) { const int s_ = k & 1, m_ = (k >> 1) & 1, t_ = 2 * (g) + (k >> 2); A[k] = F[((t_ * 2 + m_) * 2 + s_) * 64]; } } while (0)
            G3_LD_MTS(A0, WNf, 0); G3_LD_MTS(A1, WNf, 1);
            f32x16 av[2];
#pragma unroll
            for (int m = 0; m < 2; ++m)
#pragma unroll
                for (int hf = 0; hf < 2; ++hf) { const v4u u4 = Uf[(m * 2 + hf) * 64];
#pragma unroll
                    for (int k = 0; k < 4; ++k) { av[m][8 * hf + 2 * k] = bflo(u4[k]); av[m][8 * hf + 2 * k + 1] = bfhi(u4[k]); } }
            bf16x8 Sb[4][2];
#pragma unroll
            for (int t = 0; t < 4; ++t) { Sb[t][0] = pack8(S[t], 0); Sb[t][1] = pack8(S[t], 1); }
#pragma unroll
            for (int k = 0; k < 8; ++k) { const int m_ = k & 1, s_ = (k >> 1) & 1, t_ = (k >> 2); av[m_] = MFMA32(A0[k], Sb[t_][s_], av[m_]); }
            G3_LD_MTS(A0, QDf, 0);
#pragma unroll
            for (int k = 0; k < 8; ++k) { const int m_ = k & 1, s_ = (k >> 1) & 1, t_ = 2 + (k >> 2); av[m_] = MFMA32(A1[k], Sb[t_][s_], av[m_]); }
            G3_LD_MTS(A1, QDf, 1);
            f32x16 ao[2];
#pragma unroll
            for (int m = 0; m < 2; ++m)
#pragma unroll
                for (int i = 0; i < 16; ++i) ao[m][i] = 0.f;
#pragma unroll
            for (int k = 0; k < 8; ++k) { const int m_ = k & 1, s_ = (k >> 1) & 1, t_ = (k >> 2); ao[m_] = MFMA32(A0[k], Sb[t_][s_], ao[m_]); }
#pragma unroll
            for (int k = 0; k < 6; ++k) { const int s_ = k & 1, m_ = k >= 2 ? 1 : 0, mp_ = k >= 4 ? 1 : 0; A0[k] = QKf[((m_ * 2 + mp_) * 2 + s_) * 64]; }
#pragma unroll
            for (int k = 0; k < 8; ++k) { const int m_ = k & 1, s_ = (k >> 1) & 1, t_ = 2 + (k >> 2); ao[m_] = MFMA32(A1[k], Sb[t_][s_], ao[m_]); }
            G3_LD_TMS(A1, KDTf, 0);
            bf16x8 Vb[2][2];
#pragma unroll
            for (int m = 0; m < 2; ++m) { Vb[m][0] = pack8(av[m], 0); Vb[m][1] = pack8(av[m], 1); }
#pragma unroll
            for (int k = 0; k < 6; ++k) { const int s_ = k & 1, m_ = k >= 2 ? 1 : 0, mp_ = k >= 4 ? 1 : 0; ao[m_] = MFMA32(A0[k], Vb[mp_][s_], ao[m_]); }
            G3_LD_TMS(A0, KDTf, 1);
            {   LAS float* Ob = OL + (n & 1) * OLS + c;
#pragma unroll
                for (int m = 0; m < 2; ++m)
#pragma unroll
                    for (int i = 0; i < 16; ++i) Ob[(32 * m + (i & 3) + 8 * (i >> 2) + 4 * hh) * 36] = ao[m][i]; }
#pragma unroll
            for (int t = 0; t < 4; ++t)
#pragma unroll
                for (int i = 0; i < 16; ++i) S[t][i] *= cd;
#pragma unroll
            for (int k = 0; k < 8; ++k) { const int s_ = k & 1, m_ = (k >> 1) & 1, t_ = (k >> 2); S[t_] = MFMA32(A1[k], Vb[m_][s_], S[t_]); }
#pragma unroll
            for (int k = 0; k < 8; ++k) { const int s_ = k & 1, m_ = (k >> 1) & 1, t_ = 2 + (k >> 2); S[t_] = MFMA32(A0[k], Vb[m_][s_], S[t_]); }
#undef G3_LD_MTS
#undef G3_LD_TMS
            GDN_BAR();
        }
    } else if (wave >= 4) {
        v4u pfE[15], pfO[15];
        G3_FETCH(pfE, 0); G3_FETCH(pfO, 1); G3_STORE(pfE, 0);
        GDN_BAR();
        const int i = et >> 2, p = et & 3;
#define G3_OUT(m) do { const LAS float* Ob = OL + ((m) & 1) * OLS + i * 36 + 8 * p; const f32x4 o0 = *(const LAS f32x4*)Ob, o1 = *(const LAS f32x4*)(Ob + 4); \
            float ss = (o0.x * o0.x + o0.y * o0.y) + (o0.z * o0.z + o0.w * o0.w) + (o1.x * o1.x + o1.y * o1.y) + (o1.z * o1.z + o1.w * o1.w); \
            ss += __shfl_xor(ss, 1); ss += __shfl_xor(ss, 2); \
            const size_t t_ = (size_t)b * SEQ + (m) * 64 + i; \
            v4u w_; w_.x = bfc2(o0.x, o0.y); w_.y = bfc2(o0.z, o0.w); w_.z = bfc2(o1.x, o1.y); w_.w = bfc2(o1.z, o1.w); \
            *(v4u*)(OB + t_ * 1024 + 512 + h * 128 + 32 * q + 8 * p) = w_; \
            if (p == 0) SSQ[(t_ * 4 + h) * 4 + q] = ss; } while (0)
#define G3_LOADER_ITER(n, PF_FETCH, PF_STORE) do { \
            if ((n) + 2 < 32) G3_FETCH(PF_FETCH, (n) + 2); \
            if ((n) > 0) G3_OUT((n) - 1); \
            if ((n) + 1 < 32) G3_STORE(PF_STORE, ((n) + 1) & 1); \
            GDN_BAR(); \
        } while (0)
#pragma unroll
        for (int n = 0; n < 32; n += 2) {
            G3_LOADER_ITER(n, pfE, pfO);
            G3_LOADER_ITER(n + 1, pfO, pfE);
        }
        G3_OUT(31);
#undef G3_LOADER_ITER
#undef G3_OUT
    } else {
        GDN_BAR();
#pragma unroll 1
        for (int n = 0; n < 32; ++n) GDN_BAR();
    }
#undef G3_FETCH
#undef G3_STORE
}
__device__ __forceinline__ void gdn_finalize(KArgs a, int l, int lane, int gw, int NGW) {
    unsigned char* ws = a->ws;
    const bf16* HP = (const bf16*)(ws + WS_R + R_HP); bf16* OB = (bf16*)(ws + WS_R + R_OB); const float* SSQ = (const float*)(ws + WS_SSQ);
    const int hd = lane >> 4, cb = (lane & 15) * 8;
    const float* nw = a->in[5] + l * 128 + cb;
    const f32x4 w0 = *(const f32x4*)nw, w1 = *(const f32x4*)(nw + 4);
    for (int t0 = gw * 4; t0 < M; t0 += NGW * 4) {
        v4u raw[4], gg[4]; f32x4 sq[4];
#pragma unroll
        for (int k = 0; k < 4; ++k) { const size_t t = (size_t)t0 + k; raw[k] = *(const v4u*)(OB + t * 1024 + 512 + hd * 128 + cb); gg[k] = *(const v4u*)(HP + t * HP_LD + COL_GG + hd * 128 + cb); sq[k] = *(const f32x4*)(SSQ + (t * 4 + hd) * 4); }
#pragma unroll
        for (int k = 0; k < 4; ++k) { const size_t t = (size_t)t0 + k; const float rs = rsqrtf(((sq[k].x + sq[k].y) + (sq[k].z + sq[k].w)) * (1.f / 128.f) + NORM_EPS);
            v4u o; o.x = bfc2(bflo(raw[k].x) * rs * w0.x * siluf(bflo(gg[k].x)), bfhi(raw[k].x) * rs * w0.y * siluf(bfhi(gg[k].x))); o.y = bfc2(bflo(raw[k].y) * rs * w0.z * siluf(bflo(gg[k].y)), bfhi(raw[k].y) * rs * w0.w * siluf(bfhi(gg[k].y)));
            o.z = bfc2(bflo(raw[k].z) * rs * w1.x * siluf(bflo(gg[k].z)), bfhi(raw[k].z) * rs * w1.y * siluf(bfhi(gg[k].z))); o.w = bfc2(bflo(raw[k].w) * rs * w1.z * siluf(bflo(gg[k].w)), bfhi(raw[k].w) * rs * w1.w * siluf(bfhi(gg[k].w)));
            *(v4u*)(OB + t * 1024 + 512 + hd * 128 + cb) = o; }
    }
}

struct RetLds {
    static constexpr int QS = 72, JS = 136;
    static constexpr int P = 0, Q1 = 34816, K1 = 53248, OL = 0, K1T = 71680, VT = 89088, ST = 123904;
};
template <bool WANT_Q, bool WANT_K1, bool WANT_K1T>
__device__ __forceinline__ void ret_stage(const bf16* HP, const float* RT, int b, int h, int n, float lg, LAS unsigned char* lds, int tid) {
    constexpr int QS = RetLds::QS, JS = RetLds::JS;
    LAS bf16* Q1 = (LAS bf16*)(lds + RetLds::Q1); LAS bf16* K1 = (LAS bf16*)(lds + RetLds::K1); LAS bf16* K1T = (LAS bf16*)(lds + RetLds::K1T); LAS bf16* VT = (LAS bf16*)(lds + RetLds::VT);
    const int i = tid >> 2, dd = (tid & 3) * 8, pos = n * 128 + i; const size_t t = (size_t)b * SEQ + pos;
    const bf16* hp = HP + t * HP_LD;
    const f32x4 c0 = *(const f32x4*)(RT + pos * 64 + dd), c1 = *(const f32x4*)(RT + pos * 64 + dd + 4), s0 = *(const f32x4*)(RT + pos * 64 + 32 + dd), s1 = *(const f32x4*)(RT + pos * 64 + 32 + dd + 4);
    const float cs[8] = {c0.x, c0.y, c0.z, c0.w, c1.x, c1.y, c1.z, c1.w}, sn[8] = {s0.x, s0.y, s0.z, s0.w, s1.x, s1.y, s1.z, s1.w};
    const float sq = exp2f((float)i * lg), sk = 0.125f * exp2f(-(float)i * lg);
    v4u xv[4];
#pragma unroll
    for (int p = 0; p < 4; ++p) { const int idx = tid + 512 * p, j = idx >> 4, e0 = (idx & 15) * 8; xv[p] = *(const v4u*)(HP + ((size_t)b * SEQ + n * 128 + j) * HP_LD + COL_RV + h * 128 + e0); }
#pragma unroll
    for (int which = (WANT_Q ? 0 : 1); which < 2; ++which) {
        const bf16* src = hp + (which == 0 ? COL_RQ : COL_RK) + h * 64 + dd;
        const v4u x1 = *(const v4u*)src, x2 = *(const v4u*)(src + 32);
        const float sc = which == 0 ? sq : sk;
        float lo[8], hi[8];
#pragma unroll
        for (int k = 0; k < 4; ++k) { const float a0 = bflo(x1[k]), a1 = bfhi(x1[k]), b0 = bflo(x2[k]), b1 = bfhi(x2[k]);
            lo[2 * k] = (a0 * cs[2 * k] - b0 * sn[2 * k]) * sc; lo[2 * k + 1] = (a1 * cs[2 * k + 1] - b1 * sn[2 * k + 1]) * sc;
            hi[2 * k] = (a0 * sn[2 * k] + b0 * cs[2 * k]) * sc; hi[2 * k + 1] = (a1 * sn[2 * k + 1] + b1 * cs[2 * k + 1]) * sc; }
        v4u wl, wh;
#pragma unroll
        for (int k = 0; k < 4; ++k) { wl[k] = bfc2(lo[2 * k], lo[2 * k + 1]); wh[k] = bfc2(hi[2 * k], hi[2 * k + 1]); }
        if (which == 0 || WANT_K1) { LAS bf16* dst = (which == 0 ? Q1 : K1) + i * QS + dd; *(LAS v4u*)dst = wl; *(LAS v4u*)(dst + 32) = wh; }
        if (which == 1 && WANT_K1T) {
#pragma unroll
            for (int k = 0; k < 4; ++k) { K1T[(dd + 2 * k) * JS + i] = (bf16)(wl[k] & 0xffffu); K1T[(dd + 2 * k + 1) * JS + i] = (bf16)(wl[k] >> 16);
                K1T[(32 + dd + 2 * k) * JS + i] = (bf16)(wh[k] & 0xffffu); K1T[(32 + dd + 2 * k + 1) * JS + i] = (bf16)(wh[k] >> 16); }
        }
    }
#pragma unroll
    for (int p = 0; p < 4; ++p) { const int idx = tid + 512 * p, j = idx >> 4, e0 = (idx & 15) * 8;
#pragma unroll
        for (int k = 0; k < 4; ++k) { VT[(e0 + 2 * k) * JS + j] = (bf16)(xv[p][k] & 0xffffu); VT[(e0 + 2 * k + 1) * JS + j] = (bf16)(xv[p][k] >> 16); } }
}
__device__ __forceinline__ void ret_kv_unit(KArgs a, int unit, LAS unsigned char* lds, int tid, int lane, int wave) {
    unsigned char* ws = a->ws;
    constexpr int JS = RetLds::JS;
    const int n = unit & 15, bh = unit >> 4, h = bh & 3, b = bh >> 2, c = lane & 31, hh = lane >> 5;
    const bf16* HP = (const bf16*)(ws + WS_R + R_HP); const float* RT = (const float*)(ws + WS_ROPE);
    const float gam = 1.0f - exp2f(-5.0f - (float)h), lg = log2f(gam), g127 = exp2f(127.f * lg);
    LAS bf16* K1T = (LAS bf16*)(lds + RetLds::K1T); LAS bf16* VT = (LAS bf16*)(lds + RetLds::VT);
    __syncthreads();
    ret_stage<false, false, true>(HP, RT, b, h, n, lg, lds, tid);
    __syncthreads();
    const int td = wave >> 2, te = wave & 3;
    f32x16 kv;
#pragma unroll
    for (int i = 0; i < 16; ++i) kv[i] = 0.f;
#pragma unroll
    for (int ks = 0; ks < 8; ++ks) kv = MFMA32(*(const LAS bf16x8*)(K1T + (32 * td + c) * JS + 16 * ks + 8 * hh), *(const LAS bf16x8*)(VT + (32 * te + c) * JS + 16 * ks + 8 * hh), kv);
    float* dst = (float*)(ws + WS_KV) + ((size_t)(unit * 8 + wave) * 64 + lane) * 16;
#pragma unroll
    for (int g = 0; g < 4; ++g) *(f32x4*)(dst + 4 * g) = (f32x4){kv[4 * g] * g127, kv[4 * g + 1] * g127, kv[4 * g + 2] * g127, kv[4 * g + 3] * g127};
}
__device__ __forceinline__ void ret_out_unit(KArgs a, int unit, LAS unsigned char* lds, int tid, int lane, int wave) {
    unsigned char* ws = a->ws;
    constexpr int QS = RetLds::QS, JS = RetLds::JS;
    LAS bf16* P = (LAS bf16*)(lds + RetLds::P); LAS bf16* Q1 = (LAS bf16*)(lds + RetLds::Q1); LAS bf16* K1 = (LAS bf16*)(lds + RetLds::K1); LAS float* OL = (LAS float*)(lds + RetLds::OL);
    LAS bf16* VT = (LAS bf16*)(lds + RetLds::VT); LAS bf16* ST = (LAS bf16*)(lds + RetLds::ST);
    const int n = unit & 15, bh = unit >> 4, h = bh & 3, b = bh >> 2, c = lane & 31, hh = lane >> 5;
    const bf16* HP = (const bf16*)(ws + WS_R + R_HP); bf16* OB = (bf16*)(ws + WS_R + R_OB); const float* RT = (const float*)(ws + WS_ROPE);
    const float gam = 1.0f - exp2f(-5.0f - (float)h), lg = log2f(gam), g128 = exp2f(128.f * lg);
    __syncthreads();
    const int ei = tid >> 2, eq = tid & 3; const size_t et = (size_t)b * SEQ + n * 128 + ei;
    v4u gg[4];
    { const bf16* gp = HP + et * HP_LD + COL_RG + h * 128 + 32 * eq;
#pragma unroll
      for (int k = 0; k < 4; ++k) gg[k] = *(const v4u*)(gp + 8 * k); }
    {
        const int td = wave >> 2, te = wave & 3;
        f32x16 S;
#pragma unroll
        for (int i = 0; i < 16; ++i) S[i] = 0.f;
        const float* src = (const float*)(ws + WS_KV) + ((size_t)((bh * 16) * 8 + wave) * 64 + lane) * 16;
#pragma unroll 2
        for (int m = 0; m < n; ++m) { const f32x4* p4 = (const f32x4*)(src + (size_t)m * 8 * 64 * 16);
#pragma unroll
            for (int g = 0; g < 4; ++g) { const f32x4 v = p4[g]; S[4 * g] = S[4 * g] * g128 + v.x; S[4 * g + 1] = S[4 * g + 1] * g128 + v.y; S[4 * g + 2] = S[4 * g + 2] * g128 + v.z; S[4 * g + 3] = S[4 * g + 3] * g128 + v.w; } }
#pragma unroll
        for (int g = 0; g < 4; ++g) { v2u w; w.x = bfc2(S[4 * g], S[4 * g + 1]); w.y = bfc2(S[4 * g + 2], S[4 * g + 3]); *(LAS v2u*)(ST + (32 * te + c) * QS + 32 * td + 8 * g + 4 * hh) = w; }
    }
    ret_stage<true, true, false>(HP, RT, b, h, n, lg, lds, tid);
    __syncthreads();
#pragma unroll 1
    for (int rep = 0; rep < 2; ++rep) { const int idx = wave + 8 * rep;
        if (idx < 10) { const int ti = (idx >= 1) + (idx >= 3) + (idx >= 6), tj = idx - ti * (ti + 1) / 2;
            f32x16 acc;
#pragma unroll
            for (int i = 0; i < 16; ++i) acc[i] = 0.f;
#pragma unroll
            for (int s2 = 0; s2 < 4; ++s2) acc = MFMA32(*(const LAS bf16x8*)(Q1 + (32 * ti + c) * QS + 16 * s2 + 8 * hh), *(const LAS bf16x8*)(K1 + (32 * tj + c) * QS + 16 * s2 + 8 * hh), acc);
#pragma unroll
            for (int i = 0; i < 16; ++i) { const int il = (i & 3) + 8 * (i >> 2) + 4 * hh; float v = acc[i]; if (ti == tj && il < c) v = 0.f; P[(32 * ti + il) * JS + 32 * tj + c] = bfc(v); } } }
    __syncthreads();
    const int ti = wave >> 1, te0 = 2 * (wave & 1);
    f32x16 ao[2];
#pragma unroll
    for (int u = 0; u < 2; ++u)
#pragma unroll
        for (int i = 0; i < 16; ++i) ao[u][i] = 0.f;
#pragma unroll
    for (int s2 = 0; s2 < 4; ++s2) { const bf16x8 A = *(const LAS bf16x8*)(Q1 + (32 * ti + c) * QS + 16 * s2 + 8 * hh);
#pragma unroll
        for (int u = 0; u < 2; ++u) ao[u] = MFMA32(A, *(const LAS bf16x8*)(ST + (32 * (te0 + u) + c) * QS + 16 * s2 + 8 * hh), ao[u]); }
#pragma unroll
    for (int u = 0; u < 2; ++u)
#pragma unroll
        for (int i = 0; i < 16; ++i) ao[u][i] *= gam;
#pragma unroll 1
    for (int tj = 0; tj <= ti; ++tj)
#pragma unroll
        for (int s2 = 0; s2 < 2; ++s2) { const bf16x8 A = *(const LAS bf16x8*)(P + (32 * ti + c) * JS + 32 * tj + 16 * s2 + 8 * hh);
#pragma unroll
            for (int u = 0; u < 2; ++u) ao[u] = MFMA32(A, *(const LAS bf16x8*)(VT + (32 * (te0 + u) + c) * JS + 32 * tj + 16 * s2 + 8 * hh), ao[u]); }
    __syncthreads();
#pragma unroll
    for (int u = 0; u < 2; ++u)
#pragma unroll
        for (int i = 0; i < 16; ++i) OL[(32 * ti + (i & 3) + 8 * (i >> 2) + 4 * hh) * 132 + 32 * (te0 + u) + c] = ao[u][i];
    __syncthreads();
    {
        const LAS float* Ob = OL + ei * 132 + 32 * eq; bf16* op = OB + et * 1024 + h * 128 + 32 * eq;
        f32x4 v[8]; float sm = 0.f;
#pragma unroll
        for (int k = 0; k < 8; ++k) { v[k] = *(const LAS f32x4*)(Ob + 4 * k); sm += (v[k].x + v[k].y) + (v[k].z + v[k].w); }
        sm += __shfl_xor(sm, 1); sm += __shfl_xor(sm, 2);
        const float mean = sm * (1.f / 128.f); float sq = 0.f;
#pragma unroll
        for (int k = 0; k < 8; ++k) { v[k] = v[k] - mean; sq += (v[k].x * v[k].x + v[k].y * v[k].y) + (v[k].z * v[k].z + v[k].w * v[k].w); }
        sq += __shfl_xor(sq, 1); sq += __shfl_xor(sq, 2);
        const float rs = rsqrtf(sq * (1.f / 128.f) + LN_EPS);
#pragma unroll
        for (int k = 0; k < 4; ++k) { const v4u g4 = gg[k]; const f32x4 a0 = v[2 * k], a1 = v[2 * k + 1];
            v4u o; o.x = bfc2(a0.x * rs * siluf(bflo(g4.x)), a0.y * rs * siluf(bfhi(g4.x))); o.y = bfc2(a0.z * rs * siluf(bflo(g4.y)), a0.w * rs * siluf(bfhi(g4.y)));
            o.z = bfc2(a1.x * rs * siluf(bflo(g4.z)), a1.y * rs * siluf(bfhi(g4.z))); o.w = bfc2(a1.z * rs * siluf(bflo(g4.w)), a1.w * rs * siluf(bfhi(g4.w)));
            *(v4u*)(op + 8 * k) = o; }
    }
}

__device__ __forceinline__ float sum16(float v) {
    v += __builtin_bit_cast(float, __builtin_amdgcn_update_dpp(0, __builtin_bit_cast(int, v), 0xB1, 0xF, 0xF, true));
    v += __builtin_bit_cast(float, __builtin_amdgcn_update_dpp(0, __builtin_bit_cast(int, v), 0x4E, 0xF, 0xF, true));
    v += __builtin_bit_cast(float, __builtin_amdgcn_update_dpp(0, __builtin_bit_cast(int, v), 0x141, 0xF, 0xF, true));
    v += __builtin_bit_cast(float, __builtin_amdgcn_update_dpp(0, __builtin_bit_cast(int, v), 0x140, 0xF, 0xF, true));
    return v;
}
__device__ __forceinline__ void gdn_prep_fast(KArgs a, int l, int unit, LAS unsigned char* lds, int tid, int lane, int wave) {
    asm volatile("" : "+v"(tid)); lane = tid & 63; wave = __builtin_amdgcn_readfirstlane(tid >> 6);
    unsigned char* ws = a->ws;
    constexpr int KS = 136;
    LAS bf16* Kb = (LAS bf16*)lds;
    LAS bf16* Qb = (LAS bf16*)(lds + 17408);
    LAS float* A = (LAS float*)(lds + 34816);
    LAS float* V = (LAS float*)(lds + 51200);
    LAS float* KW = (LAS float*)(lds + 83968);
    LAS float* gc = (LAS float*)(lds + 116736);
    LAS float* bt = gc + 64;
    LAS bf16* KDs = (LAS bf16*)(lds + 117248);
    LAS bf16* XT = (LAS bf16*)lds;
    LAS bf16* A10b = (LAS bf16*)(lds + 135680);
    const int n = unit & 31, bh = unit >> 5, h = bh & 3, b = bh >> 2, t0 = b * SEQ + n * 64, c = lane & 31, hh = lane >> 5;
    const bf16* HP = (const bf16*)(ws + WS_R + R_HP);
    constexpr int F8D = GDN_F8 ? 2 : 1;
    bf16* QKg = (bf16*)(ws + WS_R + R_QK) + (size_t)unit * (4096 / F8D); bf16* QDg = (bf16*)(ws + WS_R + R_QD) + (size_t)unit * (8192 / F8D); bf16* KDTg = (bf16*)(ws + WS_R + R_KDT) + (size_t)unit * (8192 / F8D);
    bf16* WNg = (bf16*)(ws + WS_R + R_WN) + (size_t)unit * (8192 / F8D); bf16* Ug = (bf16*)(ws + WS_R + R_U) + (size_t)unit * 8192;
    __syncthreads(); if (unit == PROBE_UNIT) STAMPT(130, 0);
    if (wave == 0) {
        const float* gab = (const float*)(ws + WS_GAB) + (size_t)(t0 + lane) * 8; const float x = gab[h] + a->in[4][l * 4 + h];
        const float sp = fmaxf(x, 0.f) + log1pf(__expf(-fabsf(x))); float g = -__expf(a->in[3][l * 4 + h]) * sp;
#pragma unroll
        for (int o = 1; o < 64; o <<= 1) { const float up = __shfl_up(g, o); if (lane >= o) g += up; }
        gc[lane] = g; bt[lane] = sigmf(gab[4 + h]);
        if (lane == 63) ((float*)(ws + WS_CD))[unit] = __expf(g);
    }
    __syncthreads(); if (unit == PROBE_UNIT) STAMPT(131, 0);
#ifndef PREP_NO_CONV
    if (wave < 6) {
        const int which = wave >> 1, tp = tid & 127, rb = tp >> 4, dd = (tp & 15) * 8, col = COL_GQ + which * 512 + h * 128 + dd, cc = which * 512 + h * 128 + dd;
        const float* cw = a->in[2] + (size_t)l * 4 * 1536 + cc;
        float w[4][8];
#pragma unroll
        for (int j = 0; j < 4; ++j) { const f32x4 w0 = *(const f32x4*)(cw + j * 1536), w1 = *(const f32x4*)(cw + j * 1536 + 4); w[j][0] = w0.x; w[j][1] = w0.y; w[j][2] = w0.z; w[j][3] = w0.w; w[j][4] = w1.x; w[j][5] = w1.y; w[j][6] = w1.z; w[j][7] = w1.w; }
        const int sbase = n * 64 + 8 * rb - 3;
        const bf16* hpc = HP + (size_t)(b * SEQ) * HP_LD + col;
        v4u raw[11];
#pragma unroll
        for (int r = 0; r < 11; ++r) { raw[r] = (v4u){0u, 0u, 0u, 0u}; if (sbase + r >= 0) raw[r] = *(const v4u*)(hpc + (size_t)(sbase + r) * HP_LD); }
        const float gl = gc[63];
#pragma unroll
        for (int r = 0; r < 8; ++r) { const int i = 8 * rb + r; float y[8]; float ss = 0.f;
#pragma unroll
            for (int k4 = 0; k4 < 4; ++k4) {
                unsigned d0 = raw[r][k4], d1 = raw[r + 1][k4], d2 = raw[r + 2][k4], d3 = raw[r + 3][k4];
                asm volatile("" : "+v"(d0), "+v"(d1), "+v"(d2), "+v"(d3));
                const float a0 = w[0][2 * k4] * bflo(d0) + w[1][2 * k4] * bflo(d1) + w[2][2 * k4] * bflo(d2) + w[3][2 * k4] * bflo(d3);
                const float a1 = w[0][2 * k4 + 1] * bfhi(d0) + w[1][2 * k4 + 1] * bfhi(d1) + w[2][2 * k4 + 1] * bfhi(d2) + w[3][2 * k4 + 1] * bfhi(d3);
                y[2 * k4] = siluf(a0); y[2 * k4 + 1] = siluf(a1); ss += y[2 * k4] * y[2 * k4] + y[2 * k4 + 1] * y[2 * k4 + 1]; }
            ss = sum16(ss);
            const float gi = gc[i], bi = bt[i];
            if (which == 0) { const float f = rsqrtf(ss + NORM_EPS) * 0.08838834764831845f, eg = __expf(gi);
                v4u p, pd;
#pragma unroll
                for (int k = 0; k < 4; ++k) { p[k] = bfc2(y[2 * k] * f, y[2 * k + 1] * f); pd[k] = bfc2(y[2 * k] * f * eg, y[2 * k + 1] * f * eg); }
                *(LAS v4u*)(Qb + i * KS + dd) = p;
#if GDN_F8
                { unsigned char* qd8 = (unsigned char*)QDg + (((i >> 5) * 4 + (dd >> 5)) * 2 + ((dd >> 4) & 1)) * 512 + (i & 31) * 8 + ((dd >> 3) & 1) * 4; const float fs = f * eg * F8_SQ;
                  *(unsigned*)qd8 = f8x4(y[0] * fs, y[1] * fs, y[2] * fs, y[3] * fs); *(unsigned*)(qd8 + 256) = f8x4(y[4] * fs, y[5] * fs, y[6] * fs, y[7] * fs); }
#else
                bf16* qd = QDg + (((i >> 5) * 4 + (dd >> 5)) * 2 + ((dd >> 4) & 1)) * 512 + (i & 31) * 8 + ((dd >> 3) & 1) * 4;
                *(v2u*)qd = (v2u){pd[0], pd[1]}; *(v2u*)(qd + 256) = (v2u){pd[2], pd[3]};
#endif
            } else if (which == 1) { const float f = rsqrtf(ss + NORM_EPS), fw = f * bi * __expf(gi), fd = f * __expf(gl - gi);
                v4u p;
#pragma unroll
                for (int k = 0; k < 4; ++k) p[k] = bfc2(y[2 * k] * f, y[2 * k + 1] * f);
                *(LAS v4u*)(Kb + i * KS + dd) = p;
#pragma unroll
                for (int k = 0; k < 8; ++k) { KW[i * 128 + dd + k] = y[k] * fw; KDs[(dd + k) * 72 + i] = bfc(y[k] * fd); }
            } else {
#pragma unroll
                for (int k = 0; k < 8; ++k) V[i * 128 + dd + k] = y[k] * bi;
            }
        }
    }
    if (GATE_PRE && wave >= 6) {
        const int tg = tid - 384;
#pragma unroll 2
        for (int p = 0; p < 8; ++p) { const int idx = tg + 128 * p, i = idx >> 4, g8 = (idx & 15) * 8;
            bf16* gp = (bf16*)(ws + WS_R + R_HP) + (size_t)(t0 + i) * HP_LD + COL_GG + h * 128 + g8; const v4u x = *(const v4u*)gp;
            v4u o; o.x = bfc2(siluf(bflo(x.x)), siluf(bfhi(x.x))); o.y = bfc2(siluf(bflo(x.y)), siluf(bfhi(x.y))); o.z = bfc2(siluf(bflo(x.z)), siluf(bfhi(x.z))); o.w = bfc2(siluf(bflo(x.w)), siluf(bfhi(x.w)));
            *(v4u*)gp = o; }
    }
#endif
    __syncthreads(); if (unit == PROBE_UNIT) STAMPT(132, 0);
    {
        const int ti = (wave >> 1) & 1, tj = wave & 1;
        if (wave < 4) {
            if (ti <= tj) {
                f32x16 acc;
#pragma unroll
                for (int i = 0; i < 16; ++i) acc[i] = 0.f;
#pragma unroll
                for (int s = 0; s < 8; ++s) acc = MFMA32(*(const LAS bf16x8*)(Kb + (32 * ti + c) * KS + 16 * s + 8 * hh), *(const LAS bf16x8*)(Kb + (32 * tj + c) * KS + 16 * s + 8 * hh), acc);
                const int i = 32 * tj + c; const float gi = gc[i], bi = bt[i];
#pragma unroll
                for (int r = 0; r < 16; ++r) { const int j = 32 * ti + (r & 3) + 8 * (r >> 2) + 4 * hh; const float av = (j < i) ? bi * acc[r] * __expf(gi - gc[j]) : 0.f; A[j * 64 + i] = av;
                    if (ti == 0 && tj == 1) A10b[c * 40 + j] = bfc(av); }
            } else {
#pragma unroll
                for (int r = 0; r < 16; ++r) { const int j = 32 * ti + (r & 3) + 8 * (r >> 2) + 4 * hh; A[j * 64 + 32 * tj + c] = 0.f; }
            }
        } else {
            const int kt = ti, qt = tj;
            if (kt <= qt) {
                f32x16 acc;
#pragma unroll
                for (int i = 0; i < 16; ++i) acc[i] = 0.f;
#pragma unroll
                for (int s = 0; s < 8; ++s) acc = MFMA32(*(const LAS bf16x8*)(Kb + (32 * kt + c) * KS + 16 * s + 8 * hh), *(const LAS bf16x8*)(Qb + (32 * qt + c) * KS + 16 * s + 8 * hh), acc);
                const int i = 32 * qt + c; const float gi = gc[i];
#pragma unroll
                for (int r = 0; r < 16; ++r) { const int j = 32 * kt + (r & 3) + 8 * (r >> 2) + 4 * hh; acc[r] = (j <= i) ? acc[r] * __expf(gi - gc[j]) : 0.f; }
                bf16x8* qf = (bf16x8*)QKg + lane;
#if GDN_F8
                { long* qf8 = (long*)QKg + lane; qf8[((qt * 2 + kt) * 2 + 0) * 64] = pack8_f8(acc, 0, F8_SQ); qf8[((qt * 2 + kt) * 2 + 1) * 64] = pack8_f8(acc, 1, F8_SQ); }
#else
                qf[((qt * 2 + kt) * 2 + 0) * 64] = pack8(acc, 0); qf[((qt * 2 + kt) * 2 + 1) * 64] = pack8(acc, 1);
#endif
            }
        }
    }
    __syncthreads(); if (unit == PROBE_UNIT) STAMPT(133, 0);
#ifndef PREP_NO_SOLVE
#define PREP_SOLVE32(B0) do { \
        _Pragma("unroll") for (int i = 0; i < 32; ++i) x[i] = rhs[((B0) + i) * 128]; \
        _Pragma("unroll") for (int m = 0; m < 31; ++m) { const float xm = x[m]; \
            _Pragma("unroll") for (int g = (m + 1) / 4; g < 8; ++g) { const f32x4 a4 = *(const LAS f32x4*)(A + ((B0) + m) * 64 + (B0) + 4 * g); \
                if (4 * g > m) x[4 * g] -= a4.x * xm; if (4 * g + 1 > m) x[4 * g + 1] -= a4.y * xm; if (4 * g + 2 > m) x[4 * g + 2] -= a4.z * xm; if (4 * g + 3 > m) x[4 * g + 3] -= a4.w * xm; } } \
        if (tl < 128) { _Pragma("unroll") for (int hx = 0; hx < 2; ++hx) _Pragma("unroll") for (int hf = 0; hf < 2; ++hf) { const int i0 = 16 * hf + 4 * hx; \
                v4u w_; w_.x = bfc2(x[i0], x[i0 + 1]); w_.y = bfc2(x[i0 + 2], x[i0 + 3]); w_.z = bfc2(x[i0 + 8], x[i0 + 9]); w_.w = bfc2(x[i0 + 10], x[i0 + 11]); *(v4u*)(Ug + uoff((B0) + i0, col)) = w_; } } \
        else { _Pragma("unroll") for (int i = 0; i < 32; ++i) Qb[((B0) + i) * KS + col] = bfc(-x[i]); } } while (0)
    int tl = tid; asm volatile("" : "+v"(tl));
    const int c2 = tl & 31, hh2 = (tl >> 5) & 1;
    if (wave < 4) {
        const int col = tl & 127; LAS float* rhs = (tl < 128 ? V : KW) + col;
        float x[32];
        PREP_SOLVE32(0);
        v4u p[4];
#pragma unroll
        for (int k = 0; k < 4; ++k) { p[k].x = bfc2(x[8 * k], x[8 * k + 1]); p[k].y = bfc2(x[8 * k + 2], x[8 * k + 3]); p[k].z = bfc2(x[8 * k + 4], x[8 * k + 5]); p[k].w = bfc2(x[8 * k + 6], x[8 * k + 7]); }
#pragma unroll
        for (int k = 0; k < 4; ++k) *(LAS v4u*)(XT + tl * 32 + 8 * k) = p[k];
    }
    __syncthreads();
    {
        f32x16 acc;
#pragma unroll
        for (int i = 0; i < 16; ++i) acc[i] = 0.f;
#pragma unroll
        for (int s2 = 0; s2 < 2; ++s2) acc = MFMA32(*(const LAS bf16x8*)(A10b + c2 * 40 + 16 * s2 + 8 * hh2), *(const LAS bf16x8*)(XT + (32 * wave + c2) * 32 + 16 * s2 + 8 * hh2), acc);
        LAS float* R1 = (wave < 4 ? V : KW) + 32 * (wave & 3) + c2;
#pragma unroll
        for (int r = 0; r < 16; ++r) { const int i = 32 + (r & 3) + 8 * (r >> 2) + 4 * hh2; R1[i * 128] -= acc[r]; }
    }
    __syncthreads();
    if (wave < 4) {
        const int col = tl & 127; LAS float* rhs = (tl < 128 ? V : KW) + col;
        float x[32];
        PREP_SOLVE32(32);
    }
#undef PREP_SOLVE32
#endif
    __syncthreads(); if (unit == PROBE_UNIT) STAMPT(134, 0);
#pragma unroll
    for (int p = 0; p < 4; ++p) { const int idx = tid + 512 * p, i = idx >> 5, d = (idx & 31) * 4;
#if GDN_F8
        { const v2u w2 = *(const LAS v2u*)(Qb + i * KS + d); *(unsigned*)((unsigned char*)WNg + fragoff(i, d, 4)) = f8x4(bflo(w2.x) * F8_SW, bfhi(w2.x) * F8_SW, bflo(w2.y) * F8_SW, bfhi(w2.y) * F8_SW); } }
#else
        *(v2u*)(WNg + fragoff(i, d, 4)) = *(const LAS v2u*)(Qb + i * KS + d); }
#endif
#pragma unroll
    for (int p = 0; p < 4; ++p) { const int idx = tid + 512 * p, d = idx >> 4, i = (idx & 15) * 4;
#if GDN_F8
        { const v2u k2 = *(const LAS v2u*)(KDs + d * 72 + i); *(unsigned*)((unsigned char*)KDTg + fragoff(d, i, 2)) = f8x4(bflo(k2.x) * F8_SK, bfhi(k2.x) * F8_SK, bflo(k2.y) * F8_SK, bfhi(k2.y) * F8_SK); } }
#else
        *(v2u*)(KDTg + fragoff(d, i, 2)) = *(const LAS v2u*)(KDs + d * 72 + i); }
#endif
    if (unit == PROBE_UNIT) STAMPT(135, 0);
}
#define XB_TMO      128
#define XB_XCNT(j)  (256  + 64 * (j))
#define XB_XSUB(j)  (1280 + 64 * (j))
#define XB_XGEN(j)  (2304 + 64 * (j))
#define XB_TOP      3328
#define XB_TOPGEN   3392
#define XCD_BAR_WORDS 3456
#define XB_SPIN_CAP (1u << 18)

__device__ __forceinline__ unsigned xb_ld(unsigned* p)              { return __hip_atomic_load(p, __ATOMIC_RELAXED, __HIP_MEMORY_SCOPE_AGENT); }
__device__ __forceinline__ unsigned xb_add(unsigned* p, unsigned v) { return __hip_atomic_fetch_add(p, v, __ATOMIC_RELAXED, __HIP_MEMORY_SCOPE_AGENT); }
__device__ __forceinline__ unsigned xb_xcc_id() { return (unsigned)__builtin_amdgcn_s_getreg((3 << 11) | 20) & 0xFu; }
#define XB_SPIN(cond, bar) do { unsigned _sp = 0; while (cond) { __builtin_amdgcn_s_sleep(1); \
    if ((++_sp & 255u) == 0u) { if (xb_ld(&(bar)[XB_TMO])) break; if (_sp > XB_SPIN_CAP) { atomicAdd(&(bar)[XB_TMO], 1u); break; } } } } while (0)

struct XcdBarrier {
    unsigned* bar; unsigned x;
    volatile LAS unsigned* st;
};

__device__ __forceinline__ XcdBarrier xcd_barrier_post(unsigned* bar, volatile LAS unsigned* st) {
    XcdBarrier b; b.bar = bar; b.x = xb_xcc_id(); b.st = st;
    if (threadIdx.x == 0) (void)xb_add(&bar[XB_XCNT(b.x)], 1u);
    return b;
}
__device__ __forceinline__ void xcd_barrier_complete(unsigned* bar, unsigned x, unsigned& nloc, unsigned& nx) {
    const unsigned G = gridDim.x * gridDim.y * gridDim.z;
    unsigned sum, cnt, mine, sp = 0u;
    for (;;) {
        sum = 0u; cnt = 0u; mine = 0u;
#pragma unroll
        for (unsigned j = 0; j < 16; ++j) { const unsigned c = xb_ld(&bar[XB_XCNT(j)]); sum += c; cnt += (c > 0u) ? 1u : 0u; mine = (j == x) ? c : mine; }
        if (sum == G) break;
        __builtin_amdgcn_s_sleep(1);
        if ((++sp & 255u) == 0u) { if (xb_ld(&bar[XB_TMO])) break; if (sp > XB_SPIN_CAP) { atomicAdd(&bar[XB_TMO], 1u); break; } }
    }
    nloc = mine > 0u ? mine : 1u; nx = cnt > 0u ? cnt : 1u;
}

__device__ __forceinline__ void xcd_barrier(const XcdBarrier& b) {
    asm volatile("s_waitcnt vmcnt(0)" ::: "memory");
    __syncthreads();
    if (threadIdx.x == 0) {
        unsigned* bar = b.bar;
        __builtin_amdgcn_s_waitcnt(0);
        unsigned nloc = b.st[0], nx = b.st[1];
        if (nloc == 0u) { xcd_barrier_complete(bar, b.x, nloc, nx); b.st[0] = nloc; b.st[1] = nx; }
        const unsigned old = xb_add(&bar[XB_XSUB(b.x)], 1u);
        const unsigned gen = old / nloc;
        if (old + 1u == (gen + 1u) * nloc) {
            __builtin_amdgcn_fence(__ATOMIC_RELEASE, "agent");
            asm volatile("s_waitcnt vmcnt(0)" ::: "memory");
            const unsigned og = xb_add(&bar[XB_TOP], 1u);
            const unsigned tg = og / nx;
            if (og + 1u == (tg + 1u) * nx) xb_add(&bar[XB_TOPGEN], 1u);
            else XB_SPIN(xb_ld(&bar[XB_TOPGEN]) == tg, bar);
            __builtin_amdgcn_fence(__ATOMIC_ACQUIRE, "agent");
            xb_add(&bar[XB_XGEN(b.x)], 1u);
            asm volatile("s_waitcnt vmcnt(0)" ::: "memory");
        } else {
            XB_SPIN(xb_ld(&bar[XB_XGEN(b.x)]) == gen, bar);
            __builtin_amdgcn_fence(__ATOMIC_ACQUIRE, "agent");
            asm volatile("s_waitcnt vmcnt(0)" ::: "memory");
        }
    }
    __syncthreads();
}
#ifndef REP_PRO
#define REP_PRO 1
#endif
#ifndef REP_IN
#define REP_IN 1
#endif
#ifndef REP_PREP
#define REP_PREP 1
#endif
#ifndef REP_SCAN
#define REP_SCAN 1
#endif
#ifndef REP_OUT
#define REP_OUT 1
#endif
#ifndef REP_GU
#define REP_GU 1
#endif
#ifndef REP_DN
#define REP_DN 1
#endif
#ifndef REP_MGU
#define REP_MGU 1
#endif
#ifndef REP_GDN
#define REP_GDN 1
#endif
#ifndef REP_RET
#define REP_RET 1
#endif
#ifndef KV_IN_SCAN
#define KV_IN_SCAN 0
#endif
#ifndef GDN_HELPERS
#define GDN_HELPERS 0
#endif
#ifndef GDN_SPLIT
#define GDN_SPLIT 0
#endif
#ifndef FAST_SCAN
#define FAST_SCAN 1
#endif
#ifndef FAST_RET
#define FAST_RET 1
#endif
#ifndef FAST_PREP
#define FAST_PREP 1
#endif
#ifndef EN_PRO
#define EN_PRO 1
#endif
#ifndef EN_IN
#define EN_IN 1
#endif
#ifndef EN_PREP
#define EN_PREP 1
#endif
#ifndef EN_SCAN
#define EN_SCAN 1
#endif
#ifndef EN_OUT
#define EN_OUT 1
#endif
#ifndef EN_LN1
#define EN_LN1 1
#endif
#ifndef EN_FFN0
#define EN_FFN0 1
#endif
#ifndef EN_MOE
#define EN_MOE 1
#endif

#ifndef PROBE_MULT
#define PROBE_MULT 0
#endif
#ifndef PROBE_BID
#define PROBE_BID 0
#endif
#ifndef PROBE_A
#define PROBE_A 0
#endif
#ifndef PROBE_B
#define PROBE_B 0
#endif
#ifndef STAG_IN
#define STAG_IN 0
#endif
#ifndef STAG_GU
#define STAG_GU 0
#endif
#ifndef STAG_MA
#define STAG_MA 0
#endif
#ifndef STAG_MC
#define STAG_MC 0
#endif
__device__ __forceinline__ void stagger(int c, int ticks) {
    if (ticks > 0) { const unsigned long long want = (unsigned long long)(((c >> 3) & 31) * ticks) >> 5, t0 = __builtin_amdgcn_s_memrealtime();
        while (__builtin_amdgcn_s_memrealtime() - t0 < want) __builtin_amdgcn_s_sleep(4); }
}
#if PROBE_MULT > 0
#define STAMP(id) do { if (blockIdx.x == PROBE_BID && threadIdx.x == 0) __hip_atomic_store((unsigned long long*)(kargs()->ws + WS_CTL + 131072) + (id), (unsigned long long)__builtin_amdgcn_s_memrealtime(), RLX_AGENT); } while (0)
#else
#define STAMP(id) do {} while (0)
#endif
__global__ void __launch_bounds__(NWAVES * 64, 2) fwd(Args a_unused) {
    extern __shared__ __attribute__((aligned(16))) unsigned char lds_raw[];
    LAS unsigned char* lds = (LAS unsigned char*)lds_raw;
    int stamp_no_ = 1; (void)stamp_no_;
    { const int tid0 = threadIdx.x; for (int u = tid0; u < (LDS_BYTES - LDSCTL_OFF) / 4; u += NWAVES * 64) ((LAS unsigned*)(lds + LDSCTL_OFF))[u] = 0u; }
    __syncthreads();
#if ONE_LAUNCH
    XcdBarrier bar = xcd_barrier_post((unsigned*)(kargs()->ws + WS_CTL) + CW_BAR, (volatile LAS unsigned*)(lds + MISC_OFF) + 8);
#define SEAM() do { STAMP(stamp_no_); ++stamp_no_; xcd_barrier(bar); STAMP(stamp_no_); ++stamp_no_; } while (0)
#else
#define SEAM() do {} while (0)
#endif
#define IN(k) (kargs()->ph_lo <= (k) && (k) < kargs()->ph_hi)
#define BOTH(k) (IN(k) && ((k) + 1) < kargs()->ph_hi)
#define PH_LOCALS KArgs a = kargs(); unsigned char* ws = a->ws; int G = gridDim.x, bid = blockIdx.x; asm volatile("" : "+s"(G), "+s"(bid)); const int tid = tidx(), lane = tid & 63, wave = __builtin_amdgcn_readfirstlane(tid >> 6), gw = bid * NWAVES + wave, NGW = G * NWAVES; (void)ws; (void)lane; (void)gw; (void)NGW;

    if (EN_PRO && IN(PH_PRO)) { _Pragma("unroll 1") for (int rep_ = 0; rep_ < REP_PRO; ++rep_) { if (rep_) SEAM(); PH_LOCALS; ph_prologue(a, lds, wave, lane, gw, NGW, bid * (NWAVES * 64) + tid, G * NWAVES * 64, 0, PRO_I_IN, true); } if (BOTH(PH_PRO)) SEAM(); }

#pragma unroll 1
    for (int l = 0; l < 2; ++l) {
        if (EN_IN && IN(PH_L(l, K_IN))) {
            _Pragma("unroll 1") for (int rep_ = 0; rep_ < REP_IN; ++rep_) { if (rep_) SEAM(); PH_LOCALS;
            pg8::Gemm g{(const pg8::bf16_t*)(ws + WS_XB), (const pg8::bf16_t*)(ws + WS_WIN) + (size_t)l * NIN_PAD * 1024, M, NIN_PAD, 1024}; pg8::StaticOrder S; S.init(M, NIN_PAD, G, bid);
            pg8::EpiHproj E{(pg8::bf16_t*)(ws + WS_R + R_HP), (float*)(ws + WS_GAB)};
            stagger(bid, STAG_IN);
            pg8::gemm_phase<pg8::EpiHproj, pg8::StaticOrder, PG8_ALIGN, PG8_SP2>(lds, g, S, E); }
            if (BOTH(PH_L(l, K_IN))) SEAM();
        }
        if (EN_PREP && IN(PH_L(l, K_PREP))) {
            _Pragma("unroll 1") for (int rep_ = 0; rep_ < REP_PREP; ++rep_) { if (rep_) SEAM(); PH_LOCALS; for (int u = bid; u < 1024; u += G) { if (FAST_PREP) gdn_prep_fast(a, l, u, lds, tid, lane, wave); else gdn_prep_unit(a, l, u, lds, tid, lane, wave); }
              STAMP(136); if (FAST_RET && !KV_IN_SCAN) for (int u = bid; u < 512; u += G) ret_kv_unit(a, u, lds, tid, lane, wave); STAMP(137); }
            if (BOTH(PH_L(l, K_PREP))) SEAM();
        }
        if (EN_SCAN && IN(PH_L(l, K_SCAN))) {
            { PH_LOCALS;
#if GDN_SPLIT
            const int n_items = CONV_N_MOE + (l == 0 ? PRO_NIT - PRO_I_IN : 0), n_ret_hi = (l == 0 ? 128 : 256);
            if (bid < 128) { const int t1 = tidx(), w1 = __builtin_amdgcn_readfirstlane(t1 >> 6); const int bh = (bid & 7) + 8 * (bid >> 5), q = (bid >> 3) & 3;
                             gdn_scan_v3(a, l, bh * 4 + q, lds, t1, t1 & 63, w1); STAMP(100 + 10 * l);
                             for (int u = n_ret_hi + bid; u < 512; u += 128) ret_out_unit(a, u, lds, t1, t1 & 63, w1); }
            else {
                { const int t2 = tidx(), w2 = __builtin_amdgcn_readfirstlane(t2 >> 6); conv_range(kargs(), lds, w2, t2 & 63, l, 0, n_items, (bid - 128) * NWAVES + w2, (G - 128) * NWAVES); STAMP(102 + 10 * l); }
                { const int t1 = tidx(), w1 = __builtin_amdgcn_readfirstlane(t1 >> 6);
                  for (int u = bid - 128; u < n_ret_hi; u += G - 128) ret_out_unit(a, u, lds, t1, t1 & 63, w1); }
                STAMP(101 + 10 * l);
            }
#else
            if (bid < 32) { const int t1 = tidx(), w1 = __builtin_amdgcn_readfirstlane(t1 >> 6); gdn_scan_fast(a, l, bid, lds, t1, t1 & 63, w1); STAMP(100 + 10 * l); }
            else {
                if (GDN_HELPERS && bid < 32 + 32 * GDN_HELPERS) gdn_scan_helper(a, bid & 31, tidx());
                if (KV_IN_SCAN) {
                    { const int t0 = tidx(), w0 = __builtin_amdgcn_readfirstlane(t0 >> 6);
                      for (int u = bid - 32; u < 512; u += G - 32) ret_kv_unit(a, u, lds, t0, t0 & 63, w0); }
                    VM_WAIT(); __syncthreads();
                    if (tidx() == 0) { unsigned* sub = (unsigned*)(kargs()->ws + WS_CTL) + CW_SUB + 64 * (1 + l);
                        __builtin_amdgcn_fence(__ATOMIC_RELEASE, "agent"); VM_WAIT();
                        __hip_atomic_fetch_add(sub, 1u, RLX_AGENT);
                        unsigned sp = 0; while (__hip_atomic_load(sub, RLX_AGENT) < (unsigned)(G - 32) && ++sp < (1u << 22)) __builtin_amdgcn_s_sleep(2);
                        __builtin_amdgcn_fence(__ATOMIC_ACQUIRE, "agent"); VM_WAIT(); }
                    __syncthreads();
                }
                { const int t1 = tidx(), w1 = __builtin_amdgcn_readfirstlane(t1 >> 6);
                  for (int u = bid - 32; u < 512; u += G - 32) ret_out_unit(a, u, lds, t1, t1 & 63, w1); }
                __syncthreads(); STAMP(101 + 10 * l);
                { const int t2 = tidx(), w2 = __builtin_amdgcn_readfirstlane(t2 >> 6);
                  moe_convert(kargs(), lds, w2, t2 & 63, (bid - 32) * NWAVES + w2, (G - 32) * NWAVES, 4 * l, 4 * l + 4);
                  if (l == 0) ph_prologue(kargs(), lds, w2, t2 & 63, (bid - 32) * NWAVES + w2, (G - 32) * NWAVES, 0, 0, PRO_I_IN, PRO_NIT, false); STAMP(102 + 10 * l); }
            }
#endif
            }
            if (BOTH(PH_L(l, K_SCAN))) SEAM();
        }
#if GDN_SPLIT
        if (EN_SCAN && IN(PH_L(l, K_FIN))) {
            { PH_LOCALS; gdn_finalize(a, l, lane, gw, NGW); }
            if (BOTH(PH_L(l, K_FIN))) SEAM();
        }
#endif
        if (EN_OUT && IN(PH_L(l, K_OUT))) {
            _Pragma("unroll 1") for (int rep_ = 0; rep_ < REP_OUT; ++rep_) { if (rep_) SEAM(); PH_LOCALS;
            pg8::Gemm g{(const pg8::bf16_t*)(ws + WS_R + R_OB), (const pg8::bf16_t*)(ws + WS_WO) + (size_t)l * 1024 * 1024, M, 1024, 1024}; pg8::StaticOrder S; S.init(M, 1024, G, bid);
            pg8::EpiBf16Out E{(pg8::bf16_t*)(ws + WS_R + R_MIX), 1024};
            pg8::gemm_phase<pg8::EpiBf16Out, pg8::StaticOrder, PG8_ALIGN, PG8_SP2>(lds, g, S, E); }
            if (BOTH(PH_L(l, K_OUT))) SEAM();
        }
        if (EN_LN1 && IN(PH_L(l, K_LN1))) {
            { PH_LOCALS;
#if RES_BF16
            if (l == 0) ln_rows<false, true>(nullptr, ALPHA, (const bf16*)(ws + WS_R + R_MIX), a->in[7], a->in[8], nullptr, 1.0f, (bf16*)(ws + WS_XB), nullptr, nullptr, nullptr, nullptr, lane, gw, NGW, nullptr, 0, (const bf16*)(ws + WS_XB));
            else { ln_rows<true, true>(nullptr, ALPHA, (const bf16*)(ws + WS_R + R_MIX), a->in[7] + 1024, a->in[8] + 1024, a->out, ALPHA, (bf16*)(ws + WS_XB), (const float*)(ws + WS_RWT), (unsigned*)(ws + WS_CTL) + CW_MOE, (int*)(ws + WS_LIST), (float*)(ws + WS_GATE), lane, gw, NGW, lds, tid, (const bf16*)(ws + WS_XB));
                 } }
#else
            if (l == 0) ln_rows<false>(a->in[0], ALPHA, (const bf16*)(ws + WS_R + R_MIX), a->in[7], a->in[8], a->out, 1.0f, (bf16*)(ws + WS_XB), nullptr, nullptr, nullptr, nullptr, lane, gw, NGW);
            else { ln_rows<true>(a->out, ALPHA, (const bf16*)(ws + WS_R + R_MIX), a->in[7] + 1024, a->in[8] + 1024, a->out, ALPHA, (bf16*)(ws + WS_XB), (const float*)(ws + WS_RWT), (unsigned*)(ws + WS_CTL) + CW_MOE, (int*)(ws + WS_LIST), (float*)(ws + WS_GATE), lane, gw, NGW, lds, tid);
                 } }
#endif
            if (BOTH(PH_L(l, K_LN1))) SEAM();
        }
        if (l == 0) {
            if (EN_FFN0 && IN(PH_L(0, K_GU))) {
                _Pragma("unroll 1") for (int rep_ = 0; rep_ < REP_GU; ++rep_) { if (rep_) SEAM(); PH_LOCALS;
                pg8::Gemm g{(const pg8::bf16_t*)(ws + WS_XB), (const pg8::bf16_t*)(ws + WS_WGU), M, 2 * FF, 1024}; pg8::StaticOrder S; S.init(M, 2 * FF, G, bid);
                pg8::EpiSwiglu E{(pg8::bf16_t*)(ws + WS_R + R_H), FF, 0};
                stagger(bid, STAG_GU);
                pg8::gemm_phase<pg8::EpiSwiglu, pg8::StaticOrder, PG8_ALIGN, PG8_SP2>(lds, g, S, E); }
                if (BOTH(PH_L(0, K_GU))) SEAM();
            }
            if (EN_FFN0 && IN(PH_L(0, K_DN))) {
                _Pragma("unroll 1") for (int rep_ = 0; rep_ < REP_DN; ++rep_) { if (rep_) SEAM(); PH_LOCALS;
                pg8::Gemm g{(const pg8::bf16_t*)(ws + WS_R + R_H), (const pg8::bf16_t*)(ws + WS_WD), M, 1024, FF}; pg8::StaticOrder S; S.init(M, 1024, G, bid);
                pg8::EpiBf16Out E{(pg8::bf16_t*)(ws + WS_R + R_MIX), 1024};
                pg8::gemm_phase<pg8::EpiBf16Out, pg8::StaticOrder, PG8_ALIGN, PG8_SP2>(lds, g, S, E); }
                if (BOTH(PH_L(0, K_DN))) SEAM();
            }
            if (EN_LN1 && IN(PH_L(0, K_LN2))) {
                { PH_LOCALS;
#if RES_BF16
                ln_rows<false, true>(nullptr, ALPHA, (const bf16*)(ws + WS_R + R_MIX), a->in[9], a->in[10], nullptr, 1.0f, (bf16*)(ws + WS_XB), nullptr, nullptr, nullptr, nullptr, lane, gw, NGW, nullptr, 0, (const bf16*)(ws + WS_XB)); }
#else
                ln_rows<false>(a->out, ALPHA, (const bf16*)(ws + WS_R + R_MIX), a->in[9], a->in[10], a->out, 1.0f, (bf16*)(ws + WS_XB), nullptr, nullptr, nullptr, nullptr, lane, gw, NGW); }
#endif
                if (BOTH(PH_L(0, K_LN2))) SEAM();
            }
        } else {
#pragma unroll 1
            for (int j = 0; j < 2; ++j) {
                const int kg = K_G0 + 3 * j;
                if (EN_MOE && j == 0 && IN(PH_L(1, kg))) { { PH_LOCALS; moe_gather(a, 0, lane, gw, NGW); moe_gather(a, 1, lane, gw, NGW); } if (BOTH(PH_L(1, kg))) SEAM(); }
                if (EN_MOE && IN(PH_L(1, kg + 1))) {
                    { PH_LOCALS;
                    pg8::moe_table(lds, (const unsigned*)(ws + WS_CTL) + CW_MOE, tid);
                    const PG8_LAS int* tab = (const PG8_LAS int*)(lds + pg8::MOE_TAB_OFF);
                    if (j == 1 && bid < 32) {
#pragma unroll 1
                        for (int jj = 0; jj < 2; ++jj) {
                            { pg8::MoeSched<true> S; S.tab = tab; S.j0 = jj; S.a0 = 64 + (bid >> 2); S.c = bid & 3; S.mode = (64 + (bid >> 2)) < pg8::moe_T(lds, jj) ? 1 : 2;
                              S.n0 = S.n1 = S.a1 = S.j1 = 0; S.G = 1;
                              pg8::Gemm g{(const pg8::bf16_t*)(ws + WS_R + R_HM), (const pg8::bf16_t*)(ws + WS_WMD), MOE_ROWS, 1024, FE, 1};
                              pg8::EpiMoeDown E{a->out, (const int*)(ws + WS_LIST), (const float*)(ws + WS_GATE), tab};
                              pg8::gemm_phase<pg8::EpiMoeDown, pg8::MoeSched<true>, PG8_ALIGN, PG8_SP2>(lds, g, S, E); }
                            if (jj == 0) {
                                VM_WAIT(); __syncthreads();
                                if (tidx() == 0) { unsigned* sub = (unsigned*)(kargs()->ws + WS_CTL) + CW_SUB;
                                    __builtin_amdgcn_fence(__ATOMIC_RELEASE, "agent"); VM_WAIT();
                                    __hip_atomic_fetch_add(sub, 1u, RLX_AGENT);
                                    unsigned sp = 0; while (__hip_atomic_load(sub, RLX_AGENT) < 32u && ++sp < (1u << 22)) __builtin_amdgcn_s_sleep(2);
                                    __builtin_amdgcn_fence(__ATOMIC_ACQUIRE, "agent"); VM_WAIT(); }
                                __syncthreads();
                            }
                        }
                    } else {
                        pg8::MoeSched<false> S; S.tab = tab; S.mode = 0;
                        const int T0 = pg8::moe_T(lds, 0), T1 = pg8::moe_T(lds, 1);
                        if (j == 0) { S.j0 = 0; S.a0 = 0; S.n0 = T0; S.j1 = 1; S.a1 = 64; S.n1 = T1 > 64 ? T1 - 64 : 0; S.G = G; S.c = bid; }
                        else        { S.j0 = 1; S.a0 = 0; S.n0 = T1 < 64 ? T1 : 64; S.j1 = 1; S.a1 = 0; S.n1 = 0; S.G = G - 32; S.c = bid - 32; }
                        pg8::Gemm g{(const pg8::bf16_t*)(ws + WS_R + R_XG), (const pg8::bf16_t*)(ws + WS_WMGU), MOE_ROWS, 2 * FE, 1024};
                        pg8::EpiSwiglu E{(pg8::bf16_t*)(ws + WS_R + R_HM), FE, 1};
                        stagger(S.c, j == 0 ? STAG_MA : STAG_MC);
                        pg8::gemm_phase<pg8::EpiSwiglu, pg8::MoeSched<false>, PG8_ALIGN, PG8_SP2>(lds, g, S, E);
                    } }
                    if (BOTH(PH_L(1, kg + 1))) SEAM();
                }
                if (EN_MOE && IN(PH_L(1, kg + 2))) {
                    { PH_LOCALS;
                    pg8::moe_table(lds, (const unsigned*)(ws + WS_CTL) + CW_MOE, tid);
                    const PG8_LAS int* tab = (const PG8_LAS int*)(lds + pg8::MOE_TAB_OFF);
                    const int Tj = pg8::moe_T(lds, j);
                    pg8::MoeSched<true> S; S.tab = tab; S.mode = 0; S.j0 = j; S.a0 = 0; S.n0 = Tj < 64 ? Tj : 64; S.j1 = j; S.a1 = 0; S.n1 = 0; S.G = G; S.c = bid;
                    pg8::Gemm g{(const pg8::bf16_t*)(ws + WS_R + R_HM), (const pg8::bf16_t*)(ws + WS_WMD), MOE_ROWS, 1024, FE, 1};
                    pg8::EpiMoeDown E{a->out, (const int*)(ws + WS_LIST), (const float*)(ws + WS_GATE), tab};
                    pg8::gemm_phase<pg8::EpiMoeDown, pg8::MoeSched<true>, PG8_ALIGN, PG8_SP2>(lds, g, S, E); }
                    if (BOTH(PH_L(1, kg + 2))) SEAM();
                }
            }
            if (EN_LN1 && IN(PH_L(1, K_LNF))) {
                PH_LOCALS;
                ln_rows<false>(a->out, 1.0f, nullptr, a->in[9] + 1024, a->in[10] + 1024, a->out, 1.0f, nullptr, nullptr, nullptr, nullptr, nullptr, lane, gw, NGW);
            }
        }
    }
    STAMP(stamp_no_);
#if PROBE_MULT > 0
    if (blockIdx.x == PROBE_BID && threadIdx.x == 0) {
        const unsigned long long* ts = (const unsigned long long*)(kargs()->ws + WS_CTL + 131072);
        const unsigned long long ta = __hip_atomic_load(ts + PROBE_A, RLX_AGENT), tb = __hip_atomic_load(ts + PROBE_B, RLX_AGENT);
        const unsigned long long hold = (tb > ta ? tb - ta : 0ull) * (unsigned long long)PROBE_MULT, t0 = __builtin_amdgcn_s_memrealtime();
        while (__builtin_amdgcn_s_memrealtime() - t0 < hold && __builtin_amdgcn_s_memrealtime() - t0 < 2000000ull) __builtin_amdgcn_s_sleep(8);
    }
#endif
#undef IN
#undef BOTH
}

extern "C" void kernel_launch(void* const* d_in, const int* in_sizes, int n_in, void* d_out, int out_size, void* d_ws, size_t ws_size, hipStream_t stream) {
    static int grid = 0;
    if (grid == 0) {
        if (n_in != 18 || in_sizes[0] != M * D || out_size != M * D || ws_size < WS_END) { fprintf(stderr, "kernel_launch: unexpected shapes or workspace (%zu < %zu); nothing launched\n", ws_size, (size_t)WS_END); grid = -1; return; }
        int dev = 0, cus = 0, per_cu = 0;
        if (hipGetDevice(&dev) != hipSuccess || hipDeviceGetAttribute(&cus, hipDeviceAttributeMultiprocessorCount, dev) != hipSuccess) { grid = -1; return; }
        if (hipFuncSetAttribute((const void*)fwd, hipFuncAttributeMaxDynamicSharedMemorySize, LDS_BYTES) != hipSuccess) { fprintf(stderr, "kernel_launch: hipFuncSetAttribute failed\n"); grid = -1; return; }
        if (hipOccupancyMaxActiveBlocksPerMultiprocessor(&per_cu, (const void*)fwd, NWAVES * 64, LDS_BYTES) != hipSuccess || per_cu < 1) fprintf(stderr, "kernel_launch: occupancy query reports %d\n", per_cu);
        (void)hipGetLastError();
        grid = cus;
    }
    if (grid < 0) return;
    if (hipMemsetAsync((char*)d_ws + WS_CTL, 0, CTL_BYTES, stream) != hipSuccess) return;
    Args a{};
    for (int i = 0; i < 18; ++i) a.in[i] = (const float*)d_in[i];
    a.out = (float*)d_out; a.ws = (unsigned char*)d_ws;
#if ONE_LAUNCH
    a.ph_lo = 0; a.ph_hi = PH_END;
    hipLaunchKernelGGL(fwd, dim3(grid), dim3(NWAVES * 64), LDS_BYTES, stream, a);
#else
    static const int phases[] = {PH_PRO,
        PH_L(0, K_IN), PH_L(0, K_PREP), PH_L(0, K_SCAN), PH_L(0, K_OUT), PH_L(0, K_LN1), PH_L(0, K_GU), PH_L(0, K_DN), PH_L(0, K_LN2),
        PH_L(1, K_IN), PH_L(1, K_PREP), PH_L(1, K_SCAN), PH_L(1, K_OUT), PH_L(1, K_LN1),
        PH_L(1, K_G0), PH_L(1, K_GU0), PH_L(1, K_DN0), PH_L(1, K_G1), PH_L(1, K_GU1), PH_L(1, K_DN1), PH_L(1, K_LNF)};
    for (unsigned i = 0; i < sizeof(phases) / sizeof(phases[0]); ++i) {
        a.ph_lo = phases[i]; a.ph_hi = phases[i] + 1;
        hipLaunchKernelGGL(fwd, dim3(grid), dim3(NWAVES * 64), LDS_BYTES, stream, a);
    }
#endif
}
```

```cpp
#define GDN_F8 1
#include <hip/hip_runtime.h>
#include <cstdio>
#include <cstdint>

#ifndef ONE_LAUNCH
#define ONE_LAUNCH 1
#endif

#define GAS __attribute__((address_space(1)))
#define LAS __attribute__((address_space(3)))
typedef unsigned short bf16;
typedef unsigned v4u __attribute__((ext_vector_type(4)));
typedef unsigned v2u __attribute__((ext_vector_type(2)));
typedef float f32x4 __attribute__((ext_vector_type(4)));
typedef float f32x2 __attribute__((ext_vector_type(2)));
#define RLX_AGENT __ATOMIC_RELAXED, __HIP_MEMORY_SCOPE_AGENT
#define LDS_WAIT() asm volatile("s_waitcnt lgkmcnt(0)" ::: "memory")
#define VM_WAIT() asm volatile("s_waitcnt vmcnt(0)" ::: "memory")

__device__ __forceinline__ unsigned f2bf(float f) { unsigned u = __builtin_bit_cast(unsigned, f); return (u + 0x7fffu + ((u >> 16) & 1u)) >> 16; }
__device__ __forceinline__ unsigned pk2(float lo, float hi) { return f2bf(lo) | (f2bf(hi) << 16); }
__device__ __forceinline__ float bf2f(unsigned short u) { return __builtin_bit_cast(float, (unsigned)u << 16); }
__device__ __forceinline__ float bflo(unsigned u) { return __builtin_bit_cast(float, u << 16); }
__device__ __forceinline__ float bfhi(unsigned u) { return __builtin_bit_cast(float, u & 0xffff0000u); }
__device__ __forceinline__ float siluf(float x) { return x * __builtin_amdgcn_rcpf(1.f + __expf(-x)); }
__device__ __forceinline__ float sigmf(float x) { return 1.f / (1.f + __expf(-x)); }
__device__ __forceinline__ float wave_sum(float v) {
    v += __builtin_bit_cast(float, __builtin_amdgcn_update_dpp(0, __builtin_bit_cast(int, v), 0xB1, 0xF, 0xF, true));
    v += __builtin_bit_cast(float, __builtin_amdgcn_update_dpp(0, __builtin_bit_cast(int, v), 0x4E, 0xF, 0xF, true));
    v += __builtin_bit_cast(float, __builtin_amdgcn_update_dpp(0, __builtin_bit_cast(int, v), 0x141, 0xF, 0xF, true));
    v += __builtin_bit_cast(float, __builtin_amdgcn_update_dpp(0, __builtin_bit_cast(int, v), 0x140, 0xF, 0xF, true));
    v += __builtin_bit_cast(float, __builtin_amdgcn_update_dpp(0, __builtin_bit_cast(int, v), 0x142, 0xA, 0xF, false));
    v += __builtin_bit_cast(float, __builtin_amdgcn_update_dpp(0, __builtin_bit_cast(int, v), 0x143, 0xC, 0xF, false));
    return __builtin_bit_cast(float, __builtin_amdgcn_readlane(__builtin_bit_cast(int, v), 63));
}

constexpr int NWAVES = 8;
constexpr int M = 16384, D = 1024, SEQ = 2048, NB = 8;
constexpr int IN_COLS = 3592, NIN_PAD = 3840, HP_LD = 3584;
constexpr int FF = 2816, FE = 3584, NE = 8;
constexpr int COL_RQ = 0, COL_RK = 256, COL_RV = 512, COL_RG = 1024, COL_GQ = 1536, COL_GK = 2048, COL_GV = 2560, COL_GG = 3072;
constexpr float ALPHA = 1.41421356237f;
constexpr float LN_EPS = 1e-5f, NORM_EPS = 1e-6f;
constexpr int MOE_ROWS = 72 * 256;

__host__ __device__ __forceinline__ int fragoff(int i, int d, int nkt) {
    return ((((i >> 5) * nkt + (d >> 5)) * 2 + ((d >> 4) & 1)) * 512) + ((((d >> 2) & 1) * 32 + (i & 31)) * 8) + ((((d >> 3) & 1) << 2) | (d & 3));
}
__host__ __device__ __forceinline__ int uoff(int i, int e) {
    const int reg = (i & 3) | (((i & 31) >> 3) << 2);
    return (((((e >> 5) * 2 + (i >> 5)) * 2 + (reg >> 3)) * 64 + (((i >> 2) & 1) * 32 + (e & 31))) * 8) + (reg & 7);
}
namespace pg8 {
#define PG8_LAS __attribute__((address_space(3)))
typedef unsigned short bf16_t;
typedef short bf16x8 __attribute__((ext_vector_type(8)));
typedef float f32x4 __attribute__((ext_vector_type(4)));
typedef unsigned u32x4 __attribute__((ext_vector_type(4)));
constexpr int BM = 256, BK = 64, HALF = 128, HTB = HALF * BK * 2  , STAGE_BYTES = 8 * HTB, NXCD = 8, WGM = 8;

__host__ __device__ __forceinline__ int lds_byte(int r, int c) { const int st = (r >> 4) * 2 + (c >> 5), rr = r & 15, cc = c & 31, ob = rr * 64 + cc * 2; return st * 1024 + (ob ^ (((ob >> 9) & 1) << 5)); }
__host__ __device__ __forceinline__ void stage_rc(int b, int& R, int& C) { const int st = b / 1024, sb = b % 1024, swz = sb ^ (((sb >> 9) & 1) << 5); R = (st >> 1) * 16 + swz / 64; C = (st & 1) * 32 + (swz % 64) / 2; }
__host__ __device__ __forceinline__ int perm32(int rho) { const int n = rho >> 4, i = rho & 15; return 8 * (i >> 2) + 4 * n + (i & 3); }

struct Unit { int pm, pn, aux, am, sel; };
struct Gemm { const bf16_t* A; const bf16_t* Bt; int M, N, K, blk; };

struct StaticOrder {
    int nM, nN, nwg, G, c;
    __host__ __device__ void init(int M, int N, int G_, int c_) { nM = M / BM; nN = N / BM; nwg = nM * nN; G = G_; c = c_; }
    __host__ __device__ bool next(int i, Unit& u) const {
        const long L = (long)i * G + c; if (L >= nwg) return false;
        int wgid = (int)L; { const int q = nwg / NXCD, r = nwg % NXCD, xcd = wgid % NXCD, off = wgid / NXCD; wgid = (xcd < r ? xcd * (q + 1) : r * (q + 1) + (xcd - r) * q) + off; }
        const int nig = WGM * nN, gid = wgid / nig, fm = gid * WGM, gsz = (nM - fm) < WGM ? (nM - fm) : WGM;
        u.pm = fm + ((wgid % nig) % gsz); u.pn = (wgid % nig) / gsz; u.aux = 0; u.am = u.pm; u.sel = 0; return true;
    }
    __device__ __forceinline__ const char* aptr(const Gemm& g, const Unit& u) const { return (const char*)g.A + (size_t)u.pm * ((size_t)BM * g.K * 2); }
    __device__ __forceinline__ const char* bptr(const Gemm& g, const Unit& u) const { return (const char*)g.Bt + (size_t)u.pn * ((size_t)BM * g.K * 2); }
    __device__ __forceinline__ void a_ready(const Unit&) const {}
    __device__ __forceinline__ void done(const Unit&) const {}
};

template <class Epi, class Sched, bool ALIGN_EPI = false, bool SP2 = false>
__device__ __forceinline__ void gemm_phase(PG8_LAS unsigned char* lds, const Gemm g, const Sched& S, const Epi& E) {
    int tid = threadIdx.x; asm volatile("" : "+v"(tid)); const int wid = __builtin_amdgcn_readfirstlane(tid >> 6), lane = tid & 63, wr = wid >> 2, wc = wid & 3, fr = lane & 15, fq = lane >> 4;
    const int K = g.K, nt = K / BK;
    unsigned voffA[2], voffB[2];
#pragma unroll
    for (int i = 0; i < 2; ++i) { int R, C; stage_rc(tid * 16 + i * 8192, R, C); const int Rb = Epi::PERM ? ((R & ~31) + perm32(R & 31)) : R;
        voffA[i] = (unsigned)(R * (g.blk ? 64 : K) + C) * 2u; voffB[i] = (unsigned)(Rb * (g.blk ? 64 : K) + C) * 2u; }
    const size_t kstep = g.blk ? (size_t)(256 * 64 * 2) : (size_t)(BK * 2);
    const size_t hstep = g.blk ? (size_t)(HALF * 64 * 2) : (size_t)HALF * K * 2;
    const size_t tstep = 2 * hstep;
    const unsigned ldsw = (unsigned)wid * 1024u;
    const int aoff = lds_byte(wr * 64 + fr, fq * 8), boff = lds_byte(wc * 32 + fr, fq * 8);
#define PG8_SA(b, h) (((b) * 2 + (h)) * HTB)
#define PG8_SB(b, h) ((4 + (b) * 2 + (h)) * HTB)
#define PG8_STAGE(bufoff, gbase, voff) do { _Pragma("unroll") for (int _i = 0; _i < 2; ++_i) \
        __builtin_amdgcn_global_load_lds((const unsigned*)((const char*)(gbase) + (voff)[_i]), (PG8_LAS unsigned*)(lds + (bufoff) + ldsw + _i * 8192), 16, 0, 0); } while (0)
#define PG8_LDA(dst, b, h) do { _Pragma("unroll") for (int m = 0; m < 4; ++m) _Pragma("unroll") for (int k = 0; k < 2; ++k) dst[m][k] = *(const PG8_LAS bf16x8*)(lds + PG8_SA(b, h) + aoff + m * 2048 + k * 1024); } while (0)
#define PG8_LDB(dst, b, h) do { _Pragma("unroll") for (int n = 0; n < 2; ++n) _Pragma("unroll") for (int k = 0; k < 2; ++k) dst[n][k] = *(const PG8_LAS bf16x8*)(lds + PG8_SB(b, h) + boff + n * 2048 + k * 1024); } while (0)
#define PG8_MMA(ai, bj, At, Bt) do { __builtin_amdgcn_s_setprio(1); _Pragma("unroll") for (int m = 0; m < 4; ++m) _Pragma("unroll") for (int n = 0; n < 2; ++n) _Pragma("unroll") for (int k = 0; k < 2; ++k) \
        acc[ai][bj][m][n] = __builtin_amdgcn_mfma_f32_16x16x32_bf16(Bt[n][k], At[m][k], acc[ai][bj][m][n], 0, 0, 0); __builtin_amdgcn_s_setprio(0); } while (0)
#define PG8_WAIT_V(n) asm volatile("s_waitcnt vmcnt(" #n ")" ::: "memory")
#define PG8_WAIT_L(n) asm volatile("s_waitcnt lgkmcnt(" #n ")" ::: "memory")
#define PG8_BAR __builtin_amdgcn_s_barrier()
#define PG8_SCHED __builtin_amdgcn_sched_barrier(0)
    Unit cur, nxt; int ui = 0;
    if (!S.next(0, cur)) return;
    f32x4 acc[2][2][4][2];
#pragma unroll
    for (int a = 0; a < 2; ++a)
#pragma unroll
        for (int b = 0; b < 2; ++b)
#pragma unroll
            for (int m = 0; m < 4; ++m)
#pragma unroll
                for (int n = 0; n < 2; ++n) acc[a][b][m][n] = (f32x4){0.f, 0.f, 0.f, 0.f};
    bf16x8 At[4][2], B0[2][2], B1[2][2];
    const char* cA = S.aptr(g, cur); const char* cB = S.bptr(g, cur);
    S.a_ready(cur);
    if constexpr (SP2) {
        PG8_STAGE(PG8_SB(0, 0), cB, voffB); PG8_STAGE(PG8_SB(0, 1), cB + hstep, voffB); PG8_STAGE(PG8_SA(0, 0), cA, voffA); PG8_STAGE(PG8_SA(0, 1), cA + hstep, voffA);
        if (wr == 1) PG8_BAR;
        PG8_WAIT_V(2); PG8_BAR;
        PG8_STAGE(PG8_SB(1, 0), cB + kstep, voffB); PG8_STAGE(PG8_SA(1, 0), cA + kstep, voffA); PG8_STAGE(PG8_SB(1, 1), cB + hstep + kstep, voffB);
        PG8_WAIT_V(6); PG8_BAR;
    } else {
        PG8_STAGE(PG8_SB(0, 0), cB, voffB); PG8_STAGE(PG8_SA(0, 0), cA, voffA); PG8_STAGE(PG8_SB(0, 1), cB + hstep, voffB); PG8_STAGE(PG8_SA(0, 1), cA + hstep, voffA);
        if (wr == 1) PG8_BAR;
        PG8_WAIT_V(4); PG8_BAR;
        PG8_STAGE(PG8_SB(1, 0), cB + kstep, voffB); PG8_STAGE(PG8_SA(1, 0), cA + kstep, voffA); PG8_STAGE(PG8_SB(1, 1), cB + hstep + kstep, voffB);
        PG8_WAIT_V(6); PG8_BAR;
    }
    for (;;) {
        const bool has_next = S.next(ui + 1, nxt);
        const char* nA = has_next ? S.aptr(g, nxt) : cA; const char* nB = has_next ? S.bptr(g, nxt) : cB;
        for (int t = 0; t < nt; t += 2) {
            const bool last = (t == nt - 2);
            const char* a1 = cA + (size_t)(t + 1) * kstep;
            const char* a2 = last ? nA : cA + (size_t)(t + 2) * kstep; const char* b2 = last ? nB : cB + (size_t)(t + 2) * kstep;
            const char* a3 = a2 + kstep; const char* b3 = b2 + kstep;
            if (last && has_next) S.a_ready(nxt);
            if constexpr (SP2) {
            PG8_LDB(B0, 0, 0); PG8_LDB(B1, 0, 1); PG8_SCHED; PG8_LDA(At, 0, 0); PG8_STAGE(PG8_SA(1, 1), a1 + hstep, voffA);
            PG8_WAIT_V(8); PG8_WAIT_L(0); PG8_BAR; PG8_MMA(0, 0, At, B0); PG8_MMA(0, 1, At, B1); PG8_BAR; PG8_SCHED;
            PG8_LDA(At, 0, 1); PG8_STAGE(PG8_SB(0, 0), b2, voffB); PG8_STAGE(PG8_SB(0, 1), b2 + hstep, voffB); PG8_STAGE(PG8_SA(0, 0), a2, voffA);
            PG8_WAIT_V(8); PG8_WAIT_L(0); PG8_BAR; PG8_MMA(1, 0, At, B0); PG8_MMA(1, 1, At, B1); PG8_BAR; PG8_SCHED;
            PG8_LDB(B0, 1, 0); PG8_LDB(B1, 1, 1); PG8_SCHED; PG8_LDA(At, 1, 0); PG8_STAGE(PG8_SA(0, 1), a2 + hstep, voffA);
            PG8_WAIT_V(8); PG8_WAIT_L(0); PG8_BAR; PG8_MMA(0, 0, At, B0); PG8_MMA(0, 1, At, B1); PG8_BAR; PG8_SCHED;
            PG8_LDA(At, 1, 1); PG8_STAGE(PG8_SB(1, 0), b3, voffB); PG8_STAGE(PG8_SB(1, 1), b3 + hstep, voffB); PG8_STAGE(PG8_SA(1, 0), a3, voffA);
            PG8_WAIT_V(8); PG8_WAIT_L(0); PG8_BAR; PG8_MMA(1, 0, At, B0); PG8_MMA(1, 1, At, B1); PG8_BAR; PG8_SCHED;
            } else {
            PG8_LDB(B0, 0, 0); PG8_SCHED; PG8_LDA(At, 0, 0); PG8_STAGE(PG8_SA(1, 1), a1 + hstep, voffA);
            PG8_WAIT_L(8); PG8_BAR; PG8_WAIT_L(0); PG8_MMA(0, 0, At, B0); PG8_BAR; PG8_SCHED;
            PG8_LDB(B1, 0, 1); PG8_STAGE(PG8_SB(0, 0), b2, voffB);
            PG8_BAR; PG8_WAIT_L(0); PG8_MMA(0, 1, At, B1); PG8_BAR;
            PG8_LDA(At, 0, 1); PG8_STAGE(PG8_SA(0, 0), a2, voffA);
            PG8_BAR; PG8_WAIT_L(0); PG8_MMA(1, 0, At, B0); PG8_BAR; PG8_SCHED;
            PG8_STAGE(PG8_SB(0, 1), b2 + hstep, voffB);
            PG8_WAIT_V(6); PG8_BAR; PG8_MMA(1, 1, At, B1); PG8_BAR;
            PG8_LDB(B0, 1, 0); PG8_SCHED; PG8_LDA(At, 1, 0); PG8_STAGE(PG8_SA(0, 1), a2 + hstep, voffA);
            PG8_WAIT_L(8); PG8_BAR; PG8_WAIT_L(0); PG8_MMA(0, 0, At, B0); PG8_BAR; PG8_SCHED;
            PG8_LDB(B1, 1, 1); PG8_STAGE(PG8_SB(1, 0), b3, voffB);
            PG8_BAR; PG8_WAIT_L(0); PG8_MMA(0, 1, At, B1); PG8_BAR;
            PG8_LDA(At, 1, 1); PG8_STAGE(PG8_SA(1, 0), a3, voffA);
            PG8_BAR; PG8_WAIT_L(0); PG8_MMA(1, 0, At, B0); PG8_BAR; PG8_SCHED;
            PG8_STAGE(PG8_SB(1, 1), b3 + hstep, voffB);
            PG8_WAIT_V(6); PG8_BAR; PG8_MMA(1, 1, At, B1); PG8_BAR;
            }
        }
        if constexpr (ALIGN_EPI) { if (wr == 0) PG8_BAR; }
        if constexpr (!Epi::AFTER_DRAIN) { E(acc, cur, wr, wc, fr, fq); S.done(cur); }
        if (!has_next) break;
#pragma unroll
        for (int a = 0; a < 2; ++a)
#pragma unroll
            for (int b = 0; b < 2; ++b)
#pragma unroll
                for (int m = 0; m < 4; ++m)
#pragma unroll
                    for (int n = 0; n < 2; ++n) acc[a][b][m][n] = (f32x4){0.f, 0.f, 0.f, 0.f};
        cur = nxt; cA = nA; cB = nB; ++ui;
        if constexpr (ALIGN_EPI) { if (wr == 1) PG8_BAR; }
    }
    PG8_WAIT_V(0);
    if constexpr (!ALIGN_EPI) { if (wr == 0) PG8_BAR; }
    PG8_BAR;
    if constexpr (Epi::AFTER_DRAIN) { E.fused(acc, cur, wr, wc, fr, fq, lds, wid, lane); S.done(cur); }
#undef PG8_SA
#undef PG8_SB
#undef PG8_STAGE
#undef PG8_LDA
#undef PG8_LDB
#undef PG8_MMA
#undef PG8_WAIT_V
#undef PG8_WAIT_L
#undef PG8_BAR
#undef PG8_SCHED
}
}

namespace pg8 {
__device__ __forceinline__ unsigned cvt_pk_bf16(float lo, float hi) { unsigned r; asm volatile("v_cvt_pk_bf16_f32 %0, %1, %2" : "=v"(r) : "v"(lo), "v"(hi)); return r; }

struct EpiHproj {
    static constexpr bool PERM = true, AFTER_DRAIN = false;
    bf16_t* HP; float* GAB;
    __device__ __forceinline__ void operator()(const f32x4 (&acc)[2][2][4][2], const Unit& u, int wr, int wc, int fr, int fq) const {
        const int row0 = u.pm * BM + wr * 64 + fr;
        if (u.pn < 14) {
            const int col0 = u.pn * BM + wc * 32 + 8 * fq;
#pragma unroll
            for (int ai = 0; ai < 2; ++ai)
#pragma unroll
                for (int m = 0; m < 4; ++m) { bf16_t* rowp = HP + (size_t)(row0 + ai * HALF + m * 16) * 3584 + col0;
#pragma unroll
                    for (int bj = 0; bj < 2; ++bj) { const f32x4 v0 = acc[ai][bj][m][0], v1 = acc[ai][bj][m][1];
                        u32x4 w; w.x = cvt_pk_bf16(v0[0], v0[1]); w.y = cvt_pk_bf16(v0[2], v0[3]); w.z = cvt_pk_bf16(v1[0], v1[1]); w.w = cvt_pk_bf16(v1[2], v1[3]);
                        *(u32x4*)(rowp + bj * HALF) = w; } }
        } else if (wc == 0 && fq == 0) {
#pragma unroll
            for (int ai = 0; ai < 2; ++ai)
#pragma unroll
                for (int m = 0; m < 4; ++m) { float* rowp = GAB + (size_t)(row0 + ai * HALF + m * 16) * 8;
                    *(f32x4*)(rowp) = acc[ai][0][m][0]; *(f32x4*)(rowp + 4) = acc[ai][0][m][1]; }
        }
    }
};
struct EpiBf16Out {
    static constexpr bool PERM = true, AFTER_DRAIN = false;
    bf16_t* O; int ldc;
    __device__ __forceinline__ void operator()(const f32x4 (&acc)[2][2][4][2], const Unit& u, int wr, int wc, int fr, int fq) const {
        const int row0 = u.pm * BM + wr * 64 + fr, col0 = u.pn * BM + wc * 32 + 8 * fq;
#pragma unroll
        for (int ai = 0; ai < 2; ++ai)
#pragma unroll
            for (int m = 0; m < 4; ++m) { bf16_t* rowp = O + (size_t)(row0 + ai * HALF + m * 16) * ldc + col0;
#pragma unroll
                for (int bj = 0; bj < 2; ++bj) { const f32x4 v0 = acc[ai][bj][m][0], v1 = acc[ai][bj][m][1];
                    u32x4 w; w.x = cvt_pk_bf16(v0[0], v0[1]); w.y = cvt_pk_bf16(v0[2], v0[3]); w.z = cvt_pk_bf16(v1[0], v1[1]); w.w = cvt_pk_bf16(v1[2], v1[3]);
                    *(u32x4*)(rowp + bj * HALF) = w; } }
    }
};
struct EpiF32 {
    static constexpr bool PERM = false, AFTER_DRAIN = false;
    float* O; int ldc;
    __device__ __forceinline__ void operator()(const f32x4 (&acc)[2][2][4][2], const Unit& u, int wr, int wc, int fr, int fq) const {
        const int row0 = u.pm * BM + wr * 64 + fr, col0 = u.pn * BM + wc * 32 + 4 * fq;
#pragma unroll
        for (int ai = 0; ai < 2; ++ai)
#pragma unroll
            for (int m = 0; m < 4; ++m) { float* rowp = O + (size_t)(row0 + ai * HALF + m * 16) * ldc + col0;
#pragma unroll
                for (int bj = 0; bj < 2; ++bj)
#pragma unroll
                    for (int n = 0; n < 2; ++n) *(f32x4*)(rowp + bj * HALF + n * 16) = acc[ai][bj][m][n]; }
    }
};
struct EpiSwiglu {
    static constexpr bool PERM = true, AFTER_DRAIN = false;
    bf16_t* H; int ldh; int blk;
    __device__ __forceinline__ void operator()(const f32x4 (&acc)[2][2][4][2], const Unit& u, int wr, int wc, int fr, int fq) const {
        const int rt = wr * 64 + fr, col0 = u.pn * HALF + wc * 32 + 8 * fq;
        bf16_t* tb = H + (size_t)u.pm * BM * ldh;
#pragma unroll
        for (int ai = 0; ai < 2; ++ai)
#pragma unroll
            for (int m = 0; m < 4; ++m) { const int r = rt + ai * HALF + m * 16;
                bf16_t* rowp = blk ? tb + (size_t)(col0 >> 6) * (BM * 64) + r * 64 + (col0 & 63) : tb + (size_t)r * ldh + col0;
                float h[8];
#pragma unroll
                for (int n = 0; n < 2; ++n)
#pragma unroll
                    for (int i = 0; i < 4; ++i) { const float gt = acc[ai][0][m][n][i], up = acc[ai][1][m][n][i]; h[n * 4 + i] = gt * up * __builtin_amdgcn_rcpf(1.f + __expf(-gt)); }
                u32x4 w; w.x = cvt_pk_bf16(h[0], h[1]); w.y = cvt_pk_bf16(h[2], h[3]); w.z = cvt_pk_bf16(h[4], h[5]); w.w = cvt_pk_bf16(h[6], h[7]);
                *(u32x4*)(rowp) = w; }
    }
};
constexpr int MOE_TAB_OFF = 131072 + 1024;
__device__ __forceinline__ void moe_table(PG8_LAS unsigned char* lds, const unsigned* cntw, int tid) {
    PG8_LAS int* tab = (PG8_LAS int*)(lds + MOE_TAB_OFF);
    __syncthreads();
    if (tid < 2) { const int j = tid; int t = 0;
        for (int e = 0; e < 8; ++e) { const int c = (int)cntw[64 * (j * 8 + e)]; tab[j * 8 + e] = t; tab[16 + j * 8 + e] = c; t += (c + 255) >> 8; }
        tab[32 + j] = t; }
    __syncthreads();
}
__device__ __forceinline__ int moe_T(PG8_LAS unsigned char* lds, int j) { return __builtin_amdgcn_readfirstlane(((const PG8_LAS int*)(lds + MOE_TAB_OFF))[32 + j]); }
__device__ __forceinline__ int moe_expert(const PG8_LAS int* tab, int j, int t) { int e = 0;
#pragma unroll
    for (int k = 1; k < 8; ++k) e += (t >= tab[j * 8 + k]) ? 1 : 0;
    return __builtin_amdgcn_readfirstlane(e); }
__device__ __forceinline__ int moe_hphys(int j, int t) { return (j == 1 && t >= 64) ? t + 8 : t; }
struct EpiMoeDown {
    static constexpr bool PERM = false, AFTER_DRAIN = false;
    float* XF; const int* list; const float* gate; const PG8_LAS int* tab;
    const bf16_t* XBR = nullptr;
    __device__ __forceinline__ void operator()(const f32x4 (&acc)[2][2][4][2], const Unit& u, int wr, int wc, int fr, int fq) const {
        const int e = u.aux, j = u.sel, c_e = tab[16 + j * 8 + e], t_e = tab[j * 8 + e];
        const int s0 = (u.pm - t_e) * BM + wr * 64 + fr, col0 = u.pn * BM + wc * 32 + 4 * fq;
        const int* lp = list + (size_t)(j * 8 + e) * 16384; const float* gp = gate + (size_t)j * 16384;
        int tok[8]; float gt[8];
#pragma unroll
        for (int q = 0; q < 8; ++q) { const int s = s0 + (q >> 2) * HALF + (q & 3) * 16; tok[q] = (s < c_e) ? lp[s] : -1; }
#pragma unroll
        for (int q = 0; q < 8; ++q) gt[q] = (tok[q] >= 0) ? gp[tok[q]] : 0.f;
#pragma unroll
        for (int ai = 0; ai < 2; ++ai) {
            f32x4 o[4][2][2];
            if (XBR != nullptr && j == 0) {
#pragma unroll
            for (int m = 0; m < 4; ++m) { const bf16_t* rowp = XBR + (size_t)(tok[ai * 4 + m] >= 0 ? tok[ai * 4 + m] : 0) * 1024 + col0;
#pragma unroll
                for (int bj = 0; bj < 2; ++bj)
#pragma unroll
                    for (int n = 0; n < 2; ++n) { const unsigned long long w = *(const unsigned long long*)(rowp + bj * HALF + n * 16); const unsigned lo = (unsigned)w, hi = (unsigned)(w >> 32);
                        o[m][bj][n] = (f32x4){__builtin_bit_cast(float, lo << 16), __builtin_bit_cast(float, lo & 0xffff0000u), __builtin_bit_cast(float, hi << 16), __builtin_bit_cast(float, hi & 0xffff0000u)} * 1.41421356237f; } }
            } else {
#pragma unroll
            for (int m = 0; m < 4; ++m) { const float* rowp = XF + (size_t)(tok[ai * 4 + m] >= 0 ? tok[ai * 4 + m] : 0) * 1024 + col0;
#pragma unroll
                for (int bj = 0; bj < 2; ++bj)
#pragma unroll
                    for (int n = 0; n < 2; ++n) o[m][bj][n] = *(const f32x4*)(rowp + bj * HALF + n * 16); }
            }
#pragma unroll
            for (int m = 0; m < 4; ++m) { if (tok[ai * 4 + m] >= 0) { float* rowp = XF + (size_t)tok[ai * 4 + m] * 1024 + col0; const float g1 = gt[ai * 4 + m];
#pragma unroll
                for (int bj = 0; bj < 2; ++bj)
#pragma unroll
                    for (int n = 0; n < 2; ++n) *(f32x4*)(rowp + bj * HALF + n * 16) = o[m][bj][n] + acc[ai][bj][m][n] * g1; } }
        }
    }
};
template <bool DOWN>
struct MoeSched {
    int mode, n0, a0, j0, n1, a1, j1, G, c; const PG8_LAS int* tab;
    static constexpr int nN = DOWN ? 4 : 28;
    __device__ bool next(int i, Unit& u) const {
        int j, t;
        if (mode != 0) { if (i != 0 || mode == 2) return false; j = j0; t = a0; u.pn = c; }
        else {
            const int V = n0 + n1, nwg = V * nN; const long L = (long)i * G + c; if (L >= nwg) return false;
            int wgid = (int)L; { const int q = nwg / NXCD, r = nwg % NXCD, xcd = wgid % NXCD, off = wgid / NXCD; wgid = (xcd < r ? xcd * (q + 1) : r * (q + 1) + (xcd - r) * q) + off; }
            const int nig = WGM * nN, gid = wgid / nig, fm = gid * WGM, gsz = (V - fm) < WGM ? (V - fm) : WGM;
            const int vm = fm + ((wgid % nig) % gsz); u.pn = (wgid % nig) / gsz;
            if (vm < n0) { j = j0; t = a0 + vm; } else { j = j1; t = a1 + (vm - n0); }
        }
        u.aux = moe_expert(tab, j, t); u.sel = j;
        if (DOWN) { u.pm = t; u.am = moe_hphys(j, t); } else { u.pm = moe_hphys(j, t); u.am = t; }
        return true;
    }
    __device__ __forceinline__ const char* aptr(const Gemm& g, const Unit& u) const { return (const char*)g.A + (DOWN ? (size_t)0 : (size_t)u.sel * (size_t)(36u << 20)) + (size_t)u.am * ((size_t)BM * g.K * 2); }
    __device__ __forceinline__ const char* bptr(const Gemm& g, const Unit& u) const { return (const char*)g.Bt + (size_t)u.aux * ((size_t)g.N * g.K * 2) + (size_t)u.pn * ((size_t)BM * g.K * 2); }
    __device__ __forceinline__ void a_ready(const Unit&) const {}
    __device__ __forceinline__ void done(const Unit&) const {}
};
}
#ifndef PG8_SP2
#define PG8_SP2 true
#endif
#ifndef PG8_ALIGN
#define PG8_ALIGN true
#endif

constexpr size_t MiB = 1u << 20;
constexpr size_t WS_CTL = 0, CTL_BYTES = 256 * 1024;
constexpr size_t WS_ROPE = 256 * 1024;
constexpr size_t WS_WIN = 1 * MiB;
constexpr size_t WS_WO = 16 * MiB;
constexpr size_t WS_WGU = 20 * MiB;
constexpr size_t WS_WD = 31 * MiB;
constexpr size_t WS_XB = 37 * MiB;
constexpr size_t WS_GAB = 69 * MiB;
constexpr size_t WS_LIST = WS_GAB + 512 * 1024;
constexpr size_t WS_GATE = WS_LIST + 1 * MiB;
constexpr size_t WS_CD = WS_GATE + 128 * 1024;
constexpr size_t WS_RWT = WS_CD + 8 * 1024;
constexpr size_t WS_WMGU = 71 * MiB, WS_WMD = 183 * MiB;
constexpr size_t WS_R = 239 * MiB;
#ifndef GDN_F8
#define GDN_F8 0
#endif
#if GDN_F8
#define RES_BF16 1
constexpr size_t R_HP = 0, R_OB = 112 * MiB, R_U = 144 * MiB, R_WN = 160 * MiB, R_QD = 168 * MiB, R_KDT = 176 * MiB, R_QK = 184 * MiB;
constexpr size_t WS_KV = WS_R + 192 * MiB;
constexpr size_t WS_SSQ = WS_R + 208 * MiB;
#else
#define RES_BF16 0
constexpr size_t R_HP = 0, R_OB = 112 * MiB, R_U = 144 * MiB, R_WN = 160 * MiB, R_QD = 176 * MiB, R_KDT = 192 * MiB, R_QK = 208 * MiB;
constexpr size_t WS_SSQ = WS_XB + 16 * MiB;
constexpr size_t WS_KV = WS_XB;
#endif
constexpr size_t R_MIX = 0, R_H = 64 * MiB;
constexpr size_t R_HM = 0, R_XG = 140 * MiB, XG_PASS = 36 * MiB;
constexpr size_t WS_END = WS_R + 216 * MiB;
constexpr int CW_TMO = 0, CW_BAR = 4096, CW_MOE = 16384, CW_WQ = 24576, CW_SUB = 28672;

constexpr int RING_BYTES = 131072, LDS_BYTES = 147456, LDSCTL_OFF = LDS_BYTES - 512, MISC_OFF = LDSCTL_OFF + 320;

constexpr int PH_PRO = 0;
constexpr int PH_L(int l, int k) { return 1 + 16 * l + k; }
constexpr int K_IN = 0, K_PREP = 1, K_SCAN = 2, K_OUT = 3, K_LN1 = 4, K_GU = 5, K_DN = 6, K_LN2 = 7;
constexpr int K_FIN = 12;
constexpr int K_G0 = 5, K_GU0 = 6, K_DN0 = 7, K_G1 = 8, K_GU1 = 9, K_DN1 = 10, K_LNF = 11;
constexpr int PH_END = 1 + 16 * 2;

struct Args { const float* in[18]; float* out; unsigned char* ws; int ph_lo, ph_hi; };
typedef const __attribute__((address_space(4))) Args* KArgs;
__device__ __forceinline__ KArgs kargs() { KArgs p = (KArgs)__builtin_amdgcn_kernarg_segment_ptr(); asm volatile("" : "+s"(p)); return p; }
__device__ __forceinline__ int tidx() { int t = threadIdx.x; asm volatile("" : "+v"(t)); return t; }

constexpr int TR_SCR = 64 * 65 * 4;
__device__ __forceinline__ void tr_item(const float* W, int N, int k0, int n0, bf16* WT, size_t ldk, int dst_row0, LAS float* scr, int lane, bool blk = false) {
    const int nq = 4 * (lane & 15), n = n0 + nq, kr = lane >> 4;
    f32x4 v[16];
#pragma unroll
    for (int i = 0; i < 16; ++i) v[i] = (n < N) ? *(const f32x4*)(W + (size_t)(k0 + 4 * i + kr) * N + n) : (f32x4){0.f, 0.f, 0.f, 0.f};
#pragma unroll
    for (int i = 0; i < 16; ++i) { LAS float* d = scr + (4 * i + kr) * 65 + nq; d[0] = v[i].x; d[1] = v[i].y; d[2] = v[i].z; d[3] = v[i].w; }
    LDS_WAIT(); asm volatile("" ::: "memory");
    const int c = lane & 7;
#pragma unroll
    for (int j = 0; j < 8; ++j) { const int nn = (lane >> 3) + 8 * j; const LAS float* s = scr + (8 * c) * 65 + nn;
        v4u o; o.x = pk2(s[0 * 65], s[1 * 65]); o.y = pk2(s[2 * 65], s[3 * 65]); o.z = pk2(s[4 * 65], s[5 * 65]); o.w = pk2(s[6 * 65], s[7 * 65]);
        const int dr = dst_row0 + nn;
        bf16* dp = blk ? WT + ((size_t)(dr >> 8) * (ldk >> 6) + (k0 >> 6)) * (256 * 64) + (dr & 255) * 64 + 8 * c : WT + (size_t)dr * ldk + k0 + 8 * c;
        *(v4u*)dp = o; }
    LDS_WAIT(); asm volatile("" ::: "memory");
}

constexpr int PRO_I_IN = 16 * 57, PRO_NIT = 2 * (16 * 57 + 16 * 16) + 2 * (16 * 44) + 44 * 16;
__device__ __forceinline__ void ph_prologue(KArgs a, LAS unsigned char* lds, int wave, int lane, int gw, int NGW, int gtid, int NT, int it_lo, int it_hi, bool misc) {
    unsigned char* ws = a->ws;
    LAS float* scr = (LAS float*)(lds + wave * TR_SCR);
    constexpr int I_IN = 16 * 57, I_O = 16 * 16, I_L = I_IN + I_O, I_G = 16 * 44, I_D = 44 * 16, NIT = 2 * I_L + 2 * I_G + I_D;
    static_assert(NIT == PRO_NIT && I_IN == PRO_I_IN, "prologue item counts");
    for (int it = it_lo + gw; it < it_hi; it += NGW) {
        int r = it;
        if (r < 2 * I_L) { const int l = r / I_L; r -= l * I_L;
            if (r < I_IN) { const int kb = r / 57, nb = r % 57; tr_item(a->in[1] + (size_t)l * 1024 * IN_COLS, IN_COLS, 64 * kb, 64 * nb, (bf16*)(ws + WS_WIN) + (size_t)l * NIN_PAD * 1024, 1024, 64 * nb, scr, lane); }
            else { r -= I_IN; const int kb = r / 16, nb = r % 16; tr_item(a->in[6] + (size_t)l * 1024 * 1024, 1024, 64 * kb, 64 * nb, (bf16*)(ws + WS_WO) + (size_t)l * 1024 * 1024, 1024, 64 * nb, scr, lane); }
            continue; }
        r -= 2 * I_L;
        if (r < 2 * I_G) { const int up = r / I_G; r -= up * I_G; const int kb = r / 44, nb = r % 44, n0 = 64 * nb;
            tr_item(up ? a->in[12] : a->in[11], FF, 64 * kb, n0, (bf16*)(ws + WS_WGU), 1024, 256 * (n0 >> 7) + (n0 & 127) + 128 * up, scr, lane); continue; }
        r -= 2 * I_G;
        { const int kb = r / 16, nb = r % 16; tr_item(a->in[13], 1024, 64 * kb, 64 * nb, (bf16*)(ws + WS_WD), FF, 64 * nb, scr, lane); }
    }
    if (!misc) return;
    for (int i = gtid; i < 2 * 192 * 128; i += NT) { const int l = i / (192 * 128), r = i % (192 * 128);
        ((v4u*)((bf16*)(ws + WS_WIN) + (size_t)l * NIN_PAD * 1024 + (size_t)3648 * 1024))[r] = (v4u){0u, 0u, 0u, 0u}; }
    for (int i = gtid; i < M * D / 8; i += NT) { const f32x4 p = ((const f32x4*)a->in[0])[2 * i], q = ((const f32x4*)a->in[0])[2 * i + 1];
        v4u o; o.x = pk2(p.x, p.y); o.y = pk2(p.z, p.w); o.z = pk2(q.x, q.y); o.w = pk2(q.z, q.w); ((v4u*)(ws + WS_XB))[i] = o; }
    for (int i = gtid; i < 8192; i += NT) ((float*)(ws + WS_RWT))[(i & 7) * 1024 + (i >> 3)] = a->in[14][i];
    for (int i = gtid; i < SEQ * 32; i += NT) { const int pos = i >> 5, k = i & 31;
        const float inv = powf(10000.0f, -(float)(2 * k) / 64.0f); const float ang = (float)pos * inv;
        double rev = (double)ang * 0.15915494309189535; rev -= floor(rev); const float rf = (float)rev;
        float* R = (float*)(ws + WS_ROPE) + (size_t)pos * 64; R[k] = __builtin_amdgcn_cosf(rf); R[32 + k] = __builtin_amdgcn_sinf(rf); }
}

__device__ __forceinline__ void moe_convert(KArgs a, LAS unsigned char* lds, int wave, int lane, int gw, int NGW, int e_lo, int e_hi, int item = -1) {
    unsigned char* ws = a->ws;
    LAS float* scr = (LAS float*)(lds + wave * TR_SCR);
    constexpr int I_G = 16 * 56, I_D = 56 * 16, I_E = 2 * I_G + I_D;
    for (int it = (item >= 0 ? item : e_lo * I_E + gw); it < (item >= 0 ? item + 1 : e_hi * I_E); it += NGW) {
        const int e = it / I_E; int r = it - e * I_E;
        if (r < 2 * I_G) { const int up = r / I_G; r -= up * I_G; const int kb = r / 56, nb = r % 56, n0 = 64 * nb;
            tr_item((up ? a->in[16] : a->in[15]) + (size_t)e * 1024 * FE, FE, 64 * kb, n0, (bf16*)(ws + WS_WMGU) + (size_t)e * 7168 * 1024, 1024, 256 * (n0 >> 7) + (n0 & 127) + 128 * up, scr, lane); }
        else { r -= 2 * I_G; const int kb = r / 16, nb = r % 16; tr_item(a->in[17] + (size_t)e * FE * 1024, 1024, 64 * kb, 64 * nb, (bf16*)(ws + WS_WMD) + (size_t)e * 1024 * FE, FE, 64 * nb, scr, lane, true); }
    }
}

__device__ __forceinline__ void conv_queue(KArgs a, LAS unsigned char* lds, int wave, int lane, int l) {
    unsigned char* ws = a->ws;
    LAS float* scr = (LAS float*)(lds + wave * TR_SCR);
    unsigned* head = (unsigned*)(ws + WS_CTL) + CW_WQ + 64 * l;
    constexpr int I_G = 16 * 56, I_D = 56 * 16, I_E = 2 * I_G + I_D;
    const int e_lo = (l == 0 ? 0 : 3), n_moe = (l == 0 ? 3 : 5) * I_E, n_all = n_moe + (l == 0 ? PRO_NIT - PRO_I_IN : 0);
    for (;;) {
        unsigned it0 = 0; if (lane == 0) it0 = __hip_atomic_fetch_add(head, 8u, RLX_AGENT);
        it0 = __builtin_amdgcn_readfirstlane(it0);
        if ((int)it0 >= n_all) break;
#pragma unroll 1
        for (int k = 0; k < 8; ++k) { const int it = (int)it0 + k; if (it >= n_all) break;
            if (it < n_moe) moe_convert(a, lds, wave, lane, 0, 1 << 30, 0, 0, e_lo * I_E + it);
            else ph_prologue(a, lds, wave, lane, 0, 1 << 30, 0, 0, PRO_I_IN + (it - n_moe), PRO_I_IN + (it - n_moe) + 1, false); }
    }
}

__device__ __forceinline__ void conv_range(KArgs a, LAS unsigned char* lds, int wave, int lane, int l, int lo, int hi, int gw, int NGW) {
    constexpr int I_G = 16 * 56, I_D = 56 * 16, I_E = 2 * I_G + I_D;
    const int n_moe = 4 * I_E;
    for (int it = lo + gw; it < hi; it += NGW) {
        if (it < n_moe) moe_convert(a, lds, wave, lane, 0, 1 << 30, 0, 0, 4 * l * I_E + it);
        else ph_prologue(a, lds, wave, lane, 0, 1 << 30, 0, 0, PRO_I_IN + (it - n_moe), PRO_I_IN + (it - n_moe) + 1, false);
    }
}
constexpr int CONV_N_MOE = 4 * (2 * 16 * 56 + 56 * 16);

template <bool ROUTE, bool RESB = false>
__device__ __forceinline__ void ln_rows(const float* res, float ares, const bf16* mix, const float* g, const float* bta, float* xf, float oscale, bf16* xb,
                                        const float* router, unsigned* cntw, int* list, float* gate, int lane, int gw, int NGW, LAS unsigned char* lds = nullptr, int tid = 0, const bf16* resb = nullptr) {
    LAS unsigned* lcnt = (LAS unsigned*)lds; LAS unsigned* lbase = lcnt + 16; LAS unsigned* rec = lcnt + 32;
    int nrec = 0;
    if (ROUTE) { __syncthreads(); if (tid < 16) lcnt[tid] = 0u; __syncthreads(); }
    f32x4 gv[4], bv[4];
#pragma unroll
    for (int j = 0; j < 4; ++j) { gv[j] = ((const f32x4*)g)[lane + 64 * j]; bv[j] = ((const f32x4*)bta)[lane + 64 * j]; }
    f32x4 rn[4]; v2u mn[4], rb[4];
#define LN_FETCH(r_) do { if (RESB) { const v2u* rr_ = (const v2u*)(resb + (size_t)(r_) * D) + lane; _Pragma("unroll") for (int j = 0; j < 4; ++j) rb[j] = rr_[64 * j]; } \
        else { const f32x4* rr_ = (const f32x4*)(res + (size_t)(r_) * D) + lane; _Pragma("unroll") for (int j = 0; j < 4; ++j) rn[j] = rr_[64 * j]; } \
        if (mix) { const v2u* mr_ = (const v2u*)(mix + (size_t)(r_) * D) + lane; _Pragma("unroll") for (int j = 0; j < 4; ++j) mn[j] = mr_[64 * j]; } } while (0)
#pragma unroll
    for (int j = 0; j < 4; ++j) { rn[j] = (f32x4){0.f, 0.f, 0.f, 0.f}; mn[j] = (v2u){0u, 0u}; rb[j] = (v2u){0u, 0u}; }
    if (gw < M) LN_FETCH(gw);
    for (int row = gw; row < M; row += NGW) {
        f32x4 v[4]; float s = 0.f;
#pragma unroll
        for (int j = 0; j < 4; ++j) { if (RESB) rn[j] = (f32x4){bflo(rb[j].x), bfhi(rb[j].x), bflo(rb[j].y), bfhi(rb[j].y)}; v[j] = rn[j] * ares; if (mix) v[j] = v[j] + (f32x4){bflo(mn[j].x), bfhi(mn[j].x), bflo(mn[j].y), bfhi(mn[j].y)}; }
        if (row + NGW < M) LN_FETCH(row + NGW);
#pragma unroll
        for (int j = 0; j < 4; ++j) s += (v[j].x + v[j].y) + (v[j].z + v[j].w);
        const float mean = wave_sum(s) * (1.f / D); float s2 = 0.f;
#pragma unroll
        for (int j = 0; j < 4; ++j) { v[j] = v[j] - mean; s2 += (v[j].x * v[j].x + v[j].y * v[j].y) + (v[j].z * v[j].z + v[j].w * v[j].w); }
        const float rstd = 1.f / sqrtf(wave_sum(s2) * (1.f / D) + LN_EPS);
#pragma unroll
        for (int j = 0; j < 4; ++j) v[j] = v[j] * rstd * gv[j] + bv[j];
        if (xf) { f32x4* xo = (f32x4*)(xf + (size_t)row * D) + lane;
#pragma unroll
            for (int j = 0; j < 4; ++j) xo[64 * j] = v[j] * oscale; }
        if (xb) { v2u* bo = (v2u*)(xb + (size_t)row * D) + lane;
#pragma unroll
            for (int j = 0; j < 4; ++j) { v2u o; o.x = pk2(v[j].x, v[j].y); o.y = pk2(v[j].z, v[j].w); bo[64 * j] = o; } }
        if (ROUTE) {
            float lg[8];
#pragma unroll
            for (int e = 0; e < 8; ++e) lg[e] = 0.f;
#pragma unroll
            for (int e = 0; e < 8; ++e)
#pragma unroll
                for (int j = 0; j < 4; ++j) { const f32x4 r4 = ((const f32x4*)(router + e * 1024))[lane + 64 * j]; lg[e] += (v[j].x * r4.x + v[j].y * r4.y) + (v[j].z * r4.z + v[j].w * r4.w); }
#pragma unroll
            for (int e = 0; e < 8; ++e) lg[e] = wave_sum(lg[e]);
            if (lane == 0) {
                int e0 = 0; float v0 = lg[0];
#pragma unroll
                for (int e = 1; e < 8; ++e) if (lg[e] > v0) { v0 = lg[e]; e0 = e; }
                int e1 = -1; float v1 = -3.0e38f;
#pragma unroll
                for (int e = 0; e < 8; ++e) if (e != e0 && lg[e] > v1) { v1 = lg[e]; e1 = e; }
                const float p1 = __expf(v1 - v0), g0 = 1.f / (1.f + p1), g1 = p1 / (1.f + p1);
                const int wv = (int)(tid >> 6), k = nrec++;
                const unsigned l0 = __hip_atomic_fetch_add(lcnt + e0, 1u, __ATOMIC_RELAXED, __HIP_MEMORY_SCOPE_WORKGROUP), l1 = __hip_atomic_fetch_add(lcnt + 8 + e1, 1u, __ATOMIC_RELAXED, __HIP_MEMORY_SCOPE_WORKGROUP);
                rec[(wv * 16 + k) * 4 + 0] = (unsigned)row; rec[(wv * 16 + k) * 4 + 1] = (unsigned)e0 | ((unsigned)e1 << 8); rec[(wv * 16 + k) * 4 + 2] = l0; rec[(wv * 16 + k) * 4 + 3] = l1;
                gate[row] = g0; gate[16384 + row] = g1;
            }
        }
    }
    if (ROUTE) {
        __syncthreads();
        if (tid < 16) { const unsigned c = lcnt[tid]; lbase[tid] = c ? __hip_atomic_fetch_add(cntw + 64 * tid, c, RLX_AGENT) : 0u; }
        __syncthreads();
        if (lane == 0) { const int wv = (int)(tid >> 6);
            for (int k = 0; k < nrec; ++k) { const unsigned row = rec[(wv * 16 + k) * 4], ee = rec[(wv * 16 + k) * 4 + 1], l0 = rec[(wv * 16 + k) * 4 + 2], l1 = rec[(wv * 16 + k) * 4 + 3];
                const unsigned e0 = ee & 255u, e1 = ee >> 8;
                list[(size_t)e0 * 16384 + lbase[e0] + l0] = (int)row; list[(size_t)(8 + e1) * 16384 + lbase[8 + e1] + l1] = (int)row; } }
    }
}

__device__ __forceinline__ void moe_gather(KArgs a, int j, int lane, int gw, int NGW) {
    unsigned char* ws = a->ws; const unsigned* cntw = (const unsigned*)(ws + WS_CTL) + CW_MOE + 64 * (j * 8);
    int pre[8], cum[8]; { int p = 0, t = 0;
#pragma unroll
        for (int e = 0; e < 8; ++e) { const int c = (int)cntw[64 * e]; pre[e] = p; cum[e] = t; p += c; t += (c + 255) >> 8; } }
    const int* list = (const int*)(ws + WS_LIST) + (size_t)j * 8 * 16384;
    for (int r0 = gw; r0 < M; r0 += 8 * NGW) {
        int tok[8], drow[8];
#pragma unroll
        for (int q = 0; q < 8; ++q) { const int r = r0 + q * NGW; tok[q] = -1; drow[q] = 0;
            if (r < M) { int e = 0;
#pragma unroll
                for (int k = 1; k < 8; ++k) e += (r >= pre[k]) ? 1 : 0;
                int pe = 0, ce = 0;
#pragma unroll
                for (int k = 0; k < 8; ++k) if (k == e) { pe = pre[k]; ce = cum[k]; }
                const int s = r - pe; tok[q] = list[(size_t)e * 16384 + s]; drow[q] = ce * 256 + s; } }
        v4u x0[8], x1[8];
#pragma unroll
        for (int q = 0; q < 8; ++q) { const v4u* src = (const v4u*)((const bf16*)(ws + WS_XB) + (size_t)(tok[q] >= 0 ? tok[q] : 0) * 1024); x0[q] = src[lane]; x1[q] = src[lane + 64]; }
#pragma unroll
        for (int q = 0; q < 8; ++q) if (tok[q] >= 0) { v4u* dst = (v4u*)((bf16*)(ws + WS_R + R_XG + (size_t)j * XG_PASS) + (size_t)drow[q] * 1024); dst[lane] = x0[q]; dst[lane + 64] = x1[q]; }
    }
}

__device__ __forceinline__ void gdn_prep_unit(KArgs a, int l, int unit, LAS unsigned char* lds, int tid, int lane, int wave) {
    unsigned char* ws = a->ws;
    const int n = unit & 31, bh = unit >> 5, h = bh & 3, b = bh >> 2;
    const int t0 = b * SEQ + n * 64;
    LAS float* Q = (LAS float*)lds; LAS float* K = Q + 8192; LAS float* V = K + 8192; LAS float* A = V + 8192; LAS float* gc = A + 4096; LAS float* bt = gc + 64;
    const bf16* HP = (const bf16*)(ws + WS_R + R_HP);
    const float* cw = a->in[2] + (size_t)l * 4 * 1536;
    __syncthreads();
    for (int idx = tid; idx < 64 * 384; idx += 512) { const int i = idx / 384, c = idx % 384, which = c >> 7, d = c & 127;
        const int col = COL_GQ + which * 512 + h * 128 + d, cc = which * 512 + h * 128 + d; float acc = 0.f;
#pragma unroll
        for (int j = 0; j < 4; ++j) { const int s = n * 64 + i - 3 + j; if (s >= 0) acc += cw[j * 1536 + cc] * bf2f(HP[(size_t)(b * SEQ + s) * HP_LD + col]); }
        const float y = siluf(acc); LAS float* dst = which == 0 ? Q : (which == 1 ? K : V); dst[i * 128 + d] = y; }
    if (tid < 64) { const float* gab = (const float*)(ws + WS_GAB) + (size_t)(t0 + tid) * 8; const float x = gab[h] + a->in[4][l * 4 + h];
        const float sp = fmaxf(x, 0.f) + log1pf(__expf(-fabsf(x))); gc[tid] = -__expf(a->in[3][l * 4 + h]) * sp; bt[tid] = sigmf(gab[4 + h]); }
    __syncthreads();
#pragma unroll 1
    for (int r = 0; r < 8; ++r) { const int i = wave * 8 + r;
        float q0 = Q[i * 128 + lane], q1 = Q[i * 128 + lane + 64], k0 = K[i * 128 + lane], k1 = K[i * 128 + lane + 64];
        const float sq = wave_sum(q0 * q0 + q1 * q1), sk = wave_sum(k0 * k0 + k1 * k1);
        const float fq = rsqrtf(sq + NORM_EPS) * 0.08838834764831845f, fk = rsqrtf(sk + NORM_EPS);
        Q[i * 128 + lane] = q0 * fq; Q[i * 128 + lane + 64] = q1 * fq; K[i * 128 + lane] = k0 * fk; K[i * 128 + lane + 64] = k1 * fk; }
    if (tid == 0) { float c = 0.f; for (int i = 0; i < 64; ++i) { c += gc[i]; gc[i] = c; } }
    __syncthreads();
    bf16* QKg = (bf16*)(ws + WS_R + R_QK) + (size_t)unit * 4096; bf16* QDg = (bf16*)(ws + WS_R + R_QD) + (size_t)unit * 8192; bf16* KDTg = (bf16*)(ws + WS_R + R_KDT) + (size_t)unit * 8192;
    bf16* WNg = (bf16*)(ws + WS_R + R_WN) + (size_t)unit * 8192; bf16* Ug = (bf16*)(ws + WS_R + R_U) + (size_t)unit * 8192;
    for (int idx = tid; idx < 4096; idx += 512) { const int i = idx >> 6, j = idx & 63; float dqk = 0.f, dkk = 0.f;
        for (int dd = 0; dd < 128; ++dd) { const int d = (dd + j) & 127; const float kj = K[j * 128 + d]; dqk += Q[i * 128 + d] * kj; dkk += K[i * 128 + d] * kj; }
        const float dec = __expf(gc[i] - gc[j]);
        A[i * 64 + j] = (j < i) ? bt[i] * dkk * dec : 0.f;
        QKg[fragoff(i, j, 2)] = (bf16)f2bf((j <= i) ? dqk * dec : 0.f); }
    const float gl = gc[63];
    for (int idx = tid; idx < 8192; idx += 512) { const int i = idx >> 7, d = idx & 127;
        QDg[fragoff(i, d, 4)] = (bf16)f2bf(Q[i * 128 + d] * __expf(gc[i]));
        KDTg[fragoff(d, i, 2)] = (bf16)f2bf(K[i * 128 + d] * __expf(gl - gc[i])); }
    if (tid == 0) ((float*)(ws + WS_CD))[unit] = __expf(gl);
    __syncthreads();
    for (int idx = tid; idx < 8192; idx += 512) { const int i = idx >> 7; const float bi = bt[i]; V[idx] *= bi; Q[idx] = bi * __expf(gc[i]) * K[idx]; }
    __syncthreads();
    if (tid < 256) { LAS float* buf = (tid < 128 ? V : Q) + (tid & 127);
        for (int i = 1; i < 64; ++i) { float acc = buf[i * 128]; for (int m = 0; m < i; ++m) acc -= A[i * 64 + m] * buf[m * 128]; buf[i * 128] = acc; } }
    __syncthreads();
    for (int idx = tid; idx < 8192; idx += 512) { const int i = idx >> 7, d = idx & 127; Ug[uoff(i, d)] = (bf16)f2bf(V[idx]); WNg[fragoff(i, d, 4)] = (bf16)f2bf(-Q[idx]); }
}

__device__ __forceinline__ void gdn_scan_naive(KArgs a, int l, int bh, LAS unsigned char* lds, int tid, int lane, int wave) {
    unsigned char* ws = a->ws;
    LAS float* S = (LAS float*)lds; LAS float* VN = S + 16384; LAS float* O = VN + 8192;
    const int h = bh & 3, b = bh >> 2, e = tid & 127, ig = tid >> 7;
    const bf16* HP = (const bf16*)(ws + WS_R + R_HP); bf16* OB = (bf16*)(ws + WS_R + R_OB);
    const float* nw = a->in[5] + l * 128;
    __syncthreads();
    for (int idx = tid; idx < 16384; idx += 512) S[idx] = 0.f;
    __syncthreads();
#pragma unroll 1
    for (int n = 0; n < 32; ++n) {
        const int unit = bh * 32 + n;
        const bf16* Ug = (const bf16*)(ws + WS_R + R_U) + (size_t)unit * 8192; const bf16* WNg = (const bf16*)(ws + WS_R + R_WN) + (size_t)unit * 8192;
        const bf16* QDg = (const bf16*)(ws + WS_R + R_QD) + (size_t)unit * 8192; const bf16* KDTg = (const bf16*)(ws + WS_R + R_KDT) + (size_t)unit * 8192;
        const bf16* QKg = (const bf16*)(ws + WS_R + R_QK) + (size_t)unit * 4096; const float cd = ((const float*)(ws + WS_CD))[unit];
#pragma unroll 1
        for (int r = 0; r < 16; ++r) { const int i = ig + 4 * r; float acc = bf2f(Ug[uoff(i, e)]);
#pragma unroll 2
            for (int d0 = 0; d0 < 128; d0 += 4) { const v2u w = *(const v2u*)(WNg + fragoff(i, d0, 4));
                acc += bflo(w.x) * S[d0 * 128 + e] + bfhi(w.x) * S[(d0 + 1) * 128 + e] + bflo(w.y) * S[(d0 + 2) * 128 + e] + bfhi(w.y) * S[(d0 + 3) * 128 + e]; }
            VN[i * 128 + e] = acc; }
        __syncthreads();
#pragma unroll 1
        for (int r = 0; r < 16; ++r) { const int i = ig + 4 * r; float acc = 0.f;
#pragma unroll 2
            for (int d0 = 0; d0 < 128; d0 += 4) { const v2u w = *(const v2u*)(QDg + fragoff(i, d0, 4));
                acc += bflo(w.x) * S[d0 * 128 + e] + bfhi(w.x) * S[(d0 + 1) * 128 + e] + bflo(w.y) * S[(d0 + 2) * 128 + e] + bfhi(w.y) * S[(d0 + 3) * 128 + e]; }
#pragma unroll 2
            for (int j0 = 0; j0 < 64; j0 += 4) { const v2u w = *(const v2u*)(QKg + fragoff(i, j0, 2));
                acc += bflo(w.x) * VN[j0 * 128 + e] + bfhi(w.x) * VN[(j0 + 1) * 128 + e] + bflo(w.y) * VN[(j0 + 2) * 128 + e] + bfhi(w.y) * VN[(j0 + 3) * 128 + e]; }
            O[i * 128 + e] = acc; }
        __syncthreads();
#pragma unroll 1
        for (int r = 0; r < 32; ++r) { const int d = ig + 4 * r; float acc = S[d * 128 + e] * cd;
#pragma unroll 2
            for (int i0 = 0; i0 < 64; i0 += 4) { const v2u w = *(const v2u*)(KDTg + fragoff(d, i0, 2));
                acc += bflo(w.x) * VN[i0 * 128 + e] + bfhi(w.x) * VN[(i0 + 1) * 128 + e] + bflo(w.y) * VN[(i0 + 2) * 128 + e] + bfhi(w.y) * VN[(i0 + 3) * 128 + e]; }
            S[d * 128 + e] = acc; }
#pragma unroll 1
        for (int r = 0; r < 8; ++r) { const int i = wave * 8 + r; const float v0 = O[i * 128 + lane], v1 = O[i * 128 + lane + 64];
            const float rs = rsqrtf(wave_sum(v0 * v0 + v1 * v1) * (1.f / 128.f) + NORM_EPS);
            const size_t t = (size_t)b * SEQ + n * 64 + i; const bf16* gp = HP + t * HP_LD + COL_GG + h * 128; bf16* op = OB + t * 1024 + 512 + h * 128;
            op[lane] = (bf16)f2bf(v0 * rs * nw[lane] * siluf(bf2f(gp[lane]))); op[lane + 64] = (bf16)f2bf(v1 * rs * nw[lane + 64] * siluf(bf2f(gp[lane + 64]))); }
        __syncthreads();
    }
}

__device__ __forceinline__ void ret_unit_naive(KArgs a, int unit, LAS unsigned char* lds, int tid, int lane, int wave) {
    unsigned char* ws = a->ws;
    LAS float* Qs = (LAS float*)lds; LAS float* Ks = Qs + 64 * 65; LAS float* Vs = Ks + 64 * 65; LAS float* Sc = Vs + 8192;
    const int qb = unit & 31, bh = unit >> 5, h = bh & 3, b = bh >> 2, e = tid & 127, ig = tid >> 7;
    const bf16* HP = (const bf16*)(ws + WS_R + R_HP); bf16* OB = (bf16*)(ws + WS_R + R_OB); const float* RT = (const float*)(ws + WS_ROPE);
    const float log2g = log2f(1.0f - exp2f(-5.0f - (float)h));
    __syncthreads();
    for (int idx = tid; idx < 4096; idx += 512) { const int i = idx >> 6, d = idx & 63, dd = d & 31, pos = qb * 64 + i; const size_t t = (size_t)b * SEQ + pos;
        const float c = RT[pos * 64 + dd], s = RT[pos * 64 + 32 + dd]; const float x1 = bf2f(HP[t * HP_LD + COL_RQ + h * 64 + dd]), x2 = bf2f(HP[t * HP_LD + COL_RQ + h * 64 + dd + 32]);
        Qs[i * 65 + d] = d < 32 ? x1 * c - x2 * s : x1 * s + x2 * c; }
    float acc[16];
#pragma unroll
    for (int r = 0; r < 16; ++r) acc[r] = 0.f;
#pragma unroll 1
    for (int kb = 0; kb <= qb; ++kb) {
        __syncthreads();
        for (int idx = tid; idx < 4096; idx += 512) { const int i = idx >> 6, d = idx & 63, dd = d & 31, pos = kb * 64 + i; const size_t t = (size_t)b * SEQ + pos;
            const float c = RT[pos * 64 + dd], s = RT[pos * 64 + 32 + dd]; const float x1 = bf2f(HP[t * HP_LD + COL_RK + h * 64 + dd]), x2 = bf2f(HP[t * HP_LD + COL_RK + h * 64 + dd + 32]);
            Ks[i * 65 + d] = 0.125f * (d < 32 ? x1 * c - x2 * s : x1 * s + x2 * c); }
        for (int idx = tid; idx < 8192; idx += 512) { const int i = idx >> 7, d = idx & 127; Vs[idx] = bf2f(HP[((size_t)b * SEQ + kb * 64 + i) * HP_LD + COL_RV + h * 128 + d]); }
        __syncthreads();
        { const int j = tid & 63, ig8 = tid >> 6;
#pragma unroll 1
          for (int r = 0; r < 8; ++r) { const int i = ig8 + 8 * r; float dot = 0.f;
#pragma unroll 8
              for (int d = 0; d < 64; ++d) dot += Qs[i * 65 + d] * Ks[j * 65 + d];
              const int delta = (qb - kb) * 64 + i - j; Sc[i * 65 + j] = delta >= 0 ? dot * exp2f((float)delta * log2g) : 0.f; } }
        __syncthreads();
#pragma unroll 2
        for (int j = 0; j < 64; ++j) { const float vv = Vs[j * 128 + e];
#pragma unroll
            for (int r = 0; r < 16; ++r) acc[r] += Sc[(ig + 4 * r) * 65 + j] * vv; }
    }
    __syncthreads();
#pragma unroll
    for (int r = 0; r < 16; ++r) Vs[(ig + 4 * r) * 128 + e] = acc[r];
    __syncthreads();
#pragma unroll 1
    for (int r = 0; r < 8; ++r) { const int i = wave * 8 + r; const float v0 = Vs[i * 128 + lane], v1 = Vs[i * 128 + lane + 64];
        const float mean = wave_sum(v0 + v1) * (1.f / 128.f), d0 = v0 - mean, d1 = v1 - mean; const float rs = rsqrtf(wave_sum(d0 * d0 + d1 * d1) * (1.f / 128.f) + LN_EPS);
        const size_t t = (size_t)b * SEQ + qb * 64 + i; const bf16* gp = HP + t * HP_LD + COL_RG + h * 128; bf16* op = OB + t * 1024 + h * 128;
        op[lane] = (bf16)f2bf(d0 * rs * siluf(bf2f(gp[lane]))); op[lane + 64] = (bf16)f2bf(d1 * rs * siluf(bf2f(gp[lane + 64]))); }
}

typedef float f32x16 __attribute__((ext_vector_type(16)));
typedef float f32x8 __attribute__((ext_vector_type(8)));
typedef __bf16 bf8v __attribute__((ext_vector_type(8)));
typedef short bf16x8 __attribute__((ext_vector_type(8)));
#define MFMA32(a, b, c) __builtin_amdgcn_mfma_f32_32x32x16_bf16((a), (b), (c), 0, 0, 0)
__device__ __forceinline__ bf16x8 pack8(const f32x16& x, int s) {
    f32x8 v;
#pragma unroll
    for (int j = 0; j < 8; ++j) v[j] = x[8 * s + j];
    return __builtin_bit_cast(bf16x8, __builtin_convertvector(v, bf8v));
}

__device__ __forceinline__ unsigned short bfc(float x) { return __builtin_bit_cast(unsigned short, (__bf16)x); }
__device__ __forceinline__ unsigned bfc2(float lo, float hi) { return (unsigned)bfc(lo) | ((unsigned)bfc(hi) << 16); }

#ifndef PROBE_UNIT
#define PROBE_UNIT 0
#endif
#if defined(PROBE_MULT) && PROBE_MULT > 0
#define STAMPT(id, thr) do { if (blockIdx.x == PROBE_BID && threadIdx.x == (thr)) __hip_atomic_store((unsigned long long*)(a->ws + WS_CTL + 131072) + (id), (unsigned long long)__builtin_amdgcn_s_memrealtime(), RLX_AGENT); } while (0)
#else
#define STAMPT(id, thr) do {} while (0)
#endif
#ifndef GDN_F8
#define GDN_F8 0
#endif
#ifndef GATE_PRE
#define GATE_PRE 1
#endif
constexpr float F8_SW = 4.f, F8_SQ = 16.f, F8_SK = 4.f;
#define MFMA8(a, b, c) __builtin_amdgcn_mfma_f32_32x32x16_fp8_fp8((a), (b), (c), 0, 0, 0)
__device__ __forceinline__ unsigned f8x4(float a, float b, float c, float d) { int w = __builtin_amdgcn_cvt_pk_fp8_f32(a, b, 0, false); w = __builtin_amdgcn_cvt_pk_fp8_f32(c, d, w, true); return (unsigned)w; }
__device__ __forceinline__ long pack8_f8(const f32x16& x, int s, float sc) {
    const unsigned lo = f8x4(x[8 * s] * sc, x[8 * s + 1] * sc, x[8 * s + 2] * sc, x[8 * s + 3] * sc), hi = f8x4(x[8 * s + 4] * sc, x[8 * s + 5] * sc, x[8 * s + 6] * sc, x[8 * s + 7] * sc);
    return (long)(((unsigned long)hi << 32) | (unsigned long)lo);
}
#if GATE_PRE
#define GSILU(x) (x)
#else
#define GSILU(x) siluf(x)
#endif
#define GDN_BAR() do { asm volatile("s_waitcnt lgkmcnt(0)" ::: "memory"); __builtin_amdgcn_s_barrier(); asm volatile("" ::: "memory"); } while (0)
__device__ __forceinline__ void gdn_scan_fast(KArgs a, int l, int bh, LAS unsigned char* lds, int tid, int lane, int wave) {
    unsigned char* ws = a->ws;
#if GDN_F8
    constexpr int FB_WN = 0, FB_QD = 8192, FB_KDT = 16384, FB_QK = 24576, FB_U = 28672, FB_BYTES = 45056, NPC = 11, OPB = 8192;
#else
    constexpr int FB_WN = 0, FB_QD = 16384, FB_KDT = 32768, FB_QK = 49152, FB_U = 57344, FB_BYTES = 73728, NPC = 18, OPB = 16384;
#endif
    LAS float* OL = (LAS float*)(lds + FB_BYTES);
    constexpr int OLS = 64 * 132;
    const int h = bh & 3, b = bh >> 2, c = lane & 31, hh = lane >> 5;
    const bf16* HP = (const bf16*)(ws + WS_R + R_HP); bf16* OB = (bf16*)(ws + WS_R + R_OB);
    const float* nw = a->in[5] + l * 128;
    const unsigned char* gWN = (const unsigned char*)(ws + WS_R + R_WN) + (size_t)bh * 32 * OPB; const unsigned char* gQD = (const unsigned char*)(ws + WS_R + R_QD) + (size_t)bh * 32 * OPB;
    const unsigned char* gKDT = (const unsigned char*)(ws + WS_R + R_KDT) + (size_t)bh * 32 * OPB; const unsigned char* gQK = (const unsigned char*)(ws + WS_R + R_QK) + (size_t)bh * 32 * (OPB / 2);
    const unsigned char* gU = (const unsigned char*)(ws + WS_R + R_U) + (size_t)bh * 32 * 16384;
    const int et = tid - 256;
#define GDN_FETCH(pf, nn) do { constexpr int P4 = OPB / 4096; _Pragma("unroll") for (int k = 0; k < NPC; ++k) { const unsigned char* src_ = k < P4 ? gWN + (size_t)(nn) * OPB + k * 4096 : k < 2 * P4 ? gQD + (size_t)(nn) * OPB + (k - P4) * 4096 : \
        k < 3 * P4 ? gKDT + (size_t)(nn) * OPB + (k - 2 * P4) * 4096 : k < 3 * P4 + P4 / 2 ? gQK + (size_t)(nn) * (OPB / 2) + (k - 3 * P4) * 4096 : gU + (size_t)(nn) * 16384 + (k - 3 * P4 - P4 / 2) * 4096; pf[k] = *(const v4u*)(src_ + et * 16); } } while (0)
#define GDN_STORE(pf) do { _Pragma("unroll") for (int k = 0; k < NPC; ++k) *(LAS v4u*)(lds + k * 4096 + et * 16) = pf[k]; } while (0)
    __syncthreads();
    if (wave < 4) {
        f32x16 S[4];
#pragma unroll
        for (int t = 0; t < 4; ++t)
#pragma unroll
            for (int i = 0; i < 16; ++i) S[t][i] = 0.f;
        GDN_BAR();
#if GDN_F8
        const int q = wave;
        const LAS long* WNf = (const LAS long*)(lds + FB_WN) + lane; const LAS long* QDf = (const LAS long*)(lds + FB_QD) + lane;
        const LAS long* KDTf = (const LAS long*)(lds + FB_KDT) + lane; const LAS long* QKf = (const LAS long*)(lds + FB_QK) + lane;
        const LAS v4u* Uf = (const LAS v4u*)(lds + FB_U) + (q * 2) * 128 + lane;
#pragma unroll 1
        for (int n = 0; n < 32; ++n) {
            const float cd = ((const float*)(ws + WS_CD))[bh * 32 + n];
            long A0[8], A1[8];
#define GDN_LD_MTS(A, F, g) do { _Pragma("unroll") for (int k = 0; k < 8; ++k) { const int m_ = k & 1, s_ = (k >> 1) & 1, t_ = 2 * (g) + (k >> 2); A[k] = F[((m_ * 4 + t_) * 2 + s_) * 64]; } } while (0)
#define GDN_LD_TMS(A, F, g) do { _Pragma("unroll") for (int k = 0; k < 8; ++k) { const int s_ = k & 1, m_ = (k >> 1) & 1, t_ = 2 * (g) + (k >> 2); A[k] = F[((t_ * 2 + m_) * 2 + s_) * 64]; } } while (0)
            GDN_LD_MTS(A0, WNf, 0); GDN_LD_MTS(A1, WNf, 1);
            f32x16 av[2];
#pragma unroll
            for (int m = 0; m < 2; ++m)
#pragma unroll
                for (int hf = 0; hf < 2; ++hf) { const v4u u4 = Uf[(m * 2 + hf) * 64];
#pragma unroll
                    for (int k = 0; k < 4; ++k) { av[m][8 * hf + 2 * k] = bflo(u4[k]) * F8_SW; av[m][8 * hf + 2 * k + 1] = bfhi(u4[k]) * F8_SW; } }
            long Sb[4][2];
#pragma unroll
            for (int t = 0; t < 4; ++t) { Sb[t][0] = pack8_f8(S[t], 0, 1.f / F8_SK); Sb[t][1] = pack8_f8(S[t], 1, 1.f / F8_SK); }
#pragma unroll
            for (int k = 0; k < 8; ++k) { const int m_ = k & 1, s_ = (k >> 1) & 1, t_ = (k >> 2); av[m_] = MFMA8(A0[k], Sb[t_][s_], av[m_]); }
            GDN_LD_MTS(A0, QDf, 0);
#pragma unroll
            for (int k = 0; k < 8; ++k) { const int m_ = k & 1, s_ = (k >> 1) & 1, t_ = 2 + (k >> 2); av[m_] = MFMA8(A1[k], Sb[t_][s_], av[m_]); }
            GDN_LD_MTS(A1, QDf, 1);
            f32x16 ao[2];
#pragma unroll
            for (int m = 0; m < 2; ++m)
#pragma unroll
                for (int i = 0; i < 16; ++i) ao[m][i] = 0.f;
#pragma unroll
            for (int k = 0; k < 8; ++k) { const int m_ = k & 1, s_ = (k >> 1) & 1, t_ = (k >> 2); ao[m_] = MFMA8(A0[k], Sb[t_][s_], ao[m_]); }
#pragma unroll
            for (int k = 0; k < 6; ++k) { const int s_ = k & 1, m_ = k >= 2 ? 1 : 0, mp_ = k >= 4 ? 1 : 0; A0[k] = QKf[((m_ * 2 + mp_) * 2 + s_) * 64]; }
#pragma unroll
            for (int k = 0; k < 8; ++k) { const int m_ = k & 1, s_ = (k >> 1) & 1, t_ = 2 + (k >> 2); ao[m_] = MFMA8(A1[k], Sb[t_][s_], ao[m_]); }
            GDN_LD_TMS(A1, KDTf, 0);
            long Vb[2][2];
#pragma unroll
            for (int m = 0; m < 2; ++m) { Vb[m][0] = pack8_f8(av[m], 0, 1.f / F8_SW); Vb[m][1] = pack8_f8(av[m], 1, 1.f / F8_SW); }
#pragma unroll
            for (int k = 0; k < 6; ++k) { const int s_ = k & 1, m_ = k >= 2 ? 1 : 0, mp_ = k >= 4 ? 1 : 0; ao[m_] = MFMA8(A0[k], Vb[mp_][s_], ao[m_]); }
            GDN_LD_TMS(A0, KDTf, 1);
            {   LAS float* Ob = OL + (n & 1) * OLS + 32 * wave + c;
#pragma unroll
                for (int m = 0; m < 2; ++m)
#pragma unroll
                    for (int i = 0; i < 16; ++i) Ob[(32 * m + (i & 3) + 8 * (i >> 2) + 4 * hh) * 132] = ao[m][i] * (1.f / F8_SQ); }
#pragma unroll
            for (int t = 0; t < 4; ++t)
#pragma unroll
                for (int i = 0; i < 16; ++i) S[t][i] *= cd;
#pragma unroll
            for (int k = 0; k < 8; ++k) { const int s_ = k & 1, m_ = (k >> 1) & 1, t_ = (k >> 2); S[t_] = MFMA8(A1[k], Vb[m_][s_], S[t_]); }
#pragma unroll
            for (int k = 0; k < 8; ++k) { const int s_ = k & 1, m_ = (k >> 1) & 1, t_ = 2 + (k >> 2); S[t_] = MFMA8(A0[k], Vb[m_][s_], S[t_]); }
#undef GDN_LD_MTS
#undef GDN_LD_TMS
            GDN_BAR();
            GDN_BAR();
        }
#else
        const int q = wave;
        const LAS bf16x8* WNf = (const LAS bf16x8*)(lds + FB_WN) + lane; const LAS bf16x8* QDf = (const LAS bf16x8*)(lds + FB_QD) + lane;
        const LAS bf16x8* KDTf = (const LAS bf16x8*)(lds + FB_KDT) + lane; const LAS bf16x8* QKf = (const LAS bf16x8*)(lds + FB_QK) + lane;
        const LAS v4u* Uf = (const LAS v4u*)(lds + FB_U) + (q * 2) * 128 + lane;
#pragma unroll 1
        for (int n = 0; n < 32; ++n) {
            if (n == 10) STAMPT(110, 0);
            const float cd = ((const float*)(ws + WS_CD))[bh * 32 + n];
            bf16x8 A0[8], A1[8];
#define GDN_LD_MTS(A, F, g) do { _Pragma("unroll") for (int k = 0; k < 8; ++k) { const int m_ = k & 1, s_ = (k >> 1) & 1, t_ = 2 * (g) + (k >> 2); A[k] = F[((m_ * 4 + t_) * 2 + s_) * 64]; } } while (0)
#define GDN_LD_TMS(A, F, g) do { _Pragma("unroll") for (int k = 0; k < 8; ++k) { const int s_ = k & 1, m_ = (k >> 1) & 1, t_ = 2 * (g) + (k >> 2); A[k] = F[((t_ * 2 + m_) * 2 + s_) * 64]; } } while (0)
            GDN_LD_MTS(A0, WNf, 0); GDN_LD_MTS(A1, WNf, 1);
            f32x16 av[2];
#pragma unroll
            for (int m = 0; m < 2; ++m)
#pragma unroll
                for (int hf = 0; hf < 2; ++hf) { const v4u u4 = Uf[(m * 2 + hf) * 64];
#pragma unroll
                    for (int k = 0; k < 4; ++k) { av[m][8 * hf + 2 * k] = bflo(u4[k]); av[m][8 * hf + 2 * k + 1] = bfhi(u4[k]); } }
            bf16x8 Sb[4][2];
#pragma unroll
            for (int t = 0; t < 4; ++t) { Sb[t][0] = pack8(S[t], 0); Sb[t][1] = pack8(S[t], 1); }
#pragma unroll
            for (int k = 0; k < 8; ++k) { const int m_ = k & 1, s_ = (k >> 1) & 1, t_ = (k >> 2); av[m_] = MFMA32(A0[k], Sb[t_][s_], av[m_]); }
            GDN_LD_MTS(A0, QDf, 0);
#pragma unroll
            for (int k = 0; k < 8; ++k) { const int m_ = k & 1, s_ = (k >> 1) & 1, t_ = 2 + (k >> 2); av[m_] = MFMA32(A1[k], Sb[t_][s_], av[m_]); }
            GDN_LD_MTS(A1, QDf, 1);
            f32x16 ao[2];
#pragma unroll
            for (int m = 0; m < 2; ++m)
#pragma unroll
                for (int i = 0; i < 16; ++i) ao[m][i] = 0.f;
#pragma unroll
            for (int k = 0; k < 8; ++k) { const int m_ = k & 1, s_ = (k >> 1) & 1, t_ = (k >> 2); ao[m_] = MFMA32(A0[k], Sb[t_][s_], ao[m_]); }
#pragma unroll
            for (int k = 0; k < 6; ++k) { const int s_ = k & 1, m_ = k >= 2 ? 1 : 0, mp_ = k >= 4 ? 1 : 0; A0[k] = QKf[((m_ * 2 + mp_) * 2 + s_) * 64]; }
#pragma unroll
            for (int k = 0; k < 8; ++k) { const int m_ = k & 1, s_ = (k >> 1) & 1, t_ = 2 + (k >> 2); ao[m_] = MFMA32(A1[k], Sb[t_][s_], ao[m_]); }
            GDN_LD_TMS(A1, KDTf, 0);
            bf16x8 Vb[2][2];
#pragma unroll
            for (int m = 0; m < 2; ++m) { Vb[m][0] = pack8(av[m], 0); Vb[m][1] = pack8(av[m], 1); }
#pragma unroll
            for (int k = 0; k < 6; ++k) { const int s_ = k & 1, m_ = k >= 2 ? 1 : 0, mp_ = k >= 4 ? 1 : 0; ao[m_] = MFMA32(A0[k], Vb[mp_][s_], ao[m_]); }
            GDN_LD_TMS(A0, KDTf, 1);
            {   LAS float* Ob = OL + (n & 1) * OLS + 32 * wave + c;
#pragma unroll
                for (int m = 0; m < 2; ++m)
#pragma unroll
                    for (int i = 0; i < 16; ++i) Ob[(32 * m + (i & 3) + 8 * (i >> 2) + 4 * hh) * 132] = ao[m][i]; }
#pragma unroll
            for (int t = 0; t < 4; ++t)
#pragma unroll
                for (int i = 0; i < 16; ++i) S[t][i] *= cd;
#pragma unroll
            for (int k = 0; k < 8; ++k) { const int s_ = k & 1, m_ = (k >> 1) & 1, t_ = (k >> 2); S[t_] = MFMA32(A1[k], Vb[m_][s_], S[t_]); }
#pragma unroll
            for (int k = 0; k < 8; ++k) { const int s_ = k & 1, m_ = (k >> 1) & 1, t_ = 2 + (k >> 2); S[t_] = MFMA32(A0[k], Vb[m_][s_], S[t_]); }
#undef GDN_LD_MTS
#undef GDN_LD_TMS
            if (n == 10) STAMPT(111, 0);
            GDN_BAR();
            if (n == 10) STAMPT(112, 0);
            GDN_BAR();
            if (n == 10) STAMPT(113, 0);
        }
#endif
        GDN_BAR(); GDN_BAR();
    } else {
        v4u pfA[NPC], pfB[NPC];
        LAS float* NWl = OL + 2 * OLS;
        if (et < 128) NWl[et] = nw[et];
        GDN_FETCH(pfB, 0); GDN_FETCH(pfA, 1); GDN_STORE(pfB);
        GDN_BAR();
        const int i = et >> 2, qd = et & 3;
#define GDN_LOADER_ITER(n, PF_FETCH, PF_STORE, GQL, GQU) do { \
            if ((n) == 10) STAMPT(120, 256); \
            if ((n) < 32) { const bf16* gp = HP + ((size_t)b * SEQ + (n) * 64 + i) * HP_LD + COL_GG + h * 128 + 32 * qd;     \
                _Pragma("unroll") for (int k = 0; k < 4; ++k) GQL[k] = *(const v4u*)(gp + 8 * k); } \
            if ((n) + 2 < 32) GDN_FETCH(PF_FETCH, (n) + 2); \
            if ((n) == 10) STAMPT(125, 256); \
            if ((n) > 0) { \
                const LAS float* Ob = OL + (((n) - 1) & 1) * OLS + i * 132 + 32 * qd; \
                float ss = 0.f; \
                _Pragma("unroll") for (int k = 0; k < 8; ++k) { const f32x4 v_ = *(const LAS f32x4*)(Ob + 4 * k); ss += (v_.x * v_.x + v_.y * v_.y) + (v_.z * v_.z + v_.w * v_.w); } \
                ss += __shfl_xor(ss, 1); ss += __shfl_xor(ss, 2); \
                const float rs = rsqrtf(ss * (1.f / 128.f) + NORM_EPS); \
                bf16* op = OB + ((size_t)b * SEQ + ((n) - 1) * 64 + i) * 1024 + 512 + h * 128 + 32 * qd; \
                _Pragma("unroll") for (int k = 0; k < 4; ++k) { const f32x4 w0 = *(const LAS f32x4*)(NWl + 32 * qd + 8 * k), w1 = *(const LAS f32x4*)(NWl + 32 * qd + 8 * k + 4); const v4u gg = GQU[k]; \
                    const f32x4 a0 = *(const LAS f32x4*)(Ob + 8 * k), a1 = *(const LAS f32x4*)(Ob + 8 * k + 4); \
                    v4u o; o.x = bfc2(a0.x * rs * w0.x * GSILU(bflo(gg.x)), a0.y * rs * w0.y * GSILU(bfhi(gg.x))); o.y = bfc2(a0.z * rs * w0.z * GSILU(bflo(gg.y)), a0.w * rs * w0.w * GSILU(bfhi(gg.y))); \
                    o.z = bfc2(a1.x * rs * w1.x * GSILU(bflo(gg.z)), a1.y * rs * w1.y * GSILU(bfhi(gg.z))); o.w = bfc2(a1.z * rs * w1.z * GSILU(bflo(gg.w)), a1.w * rs * w1.w * GSILU(bfhi(gg.w))); \
                    *(v4u*)(op + 8 * k) = o; } \
            } \
            asm volatile("" ::: "memory"); \
            if ((n) == 10) STAMPT(121, 256); \
            GDN_BAR();            \
            if ((n) == 10) STAMPT(122, 256); \
            if ((n) + 1 < 32) GDN_STORE(PF_STORE); \
            if ((n) == 10) STAMPT(123, 256); \
            GDN_BAR();            \
            if ((n) == 10) STAMPT(124, 256); \
        } while (0)
        v4u gqA[4], gqB[4];
#pragma unroll
        for (int k = 0; k < 4; ++k) { gqA[k] = (v4u){0u, 0u, 0u, 0u}; gqB[k] = (v4u){0u, 0u, 0u, 0u}; }
#pragma unroll
        for (int n = 0; n < 32; n += 2) {
            GDN_LOADER_ITER(n, pfB, pfA, gqA, gqB);
            GDN_LOADER_ITER(n + 1, pfA, pfB, gqB, gqA);
        }
        GDN_LOADER_ITER(32, pfB, pfA, gqA, gqB);
#undef GDN_LOADER_ITER
    }
#undef GDN_FETCH
#undef GDN_STORE
}

__device__ __forceinline__ void gdn_scan_helper(KArgs a, int bh, int tid) {
    unsigned char* ws = a->ws;
    const unsigned char* gWN = (const unsigned char*)(ws + WS_R + R_WN) + (size_t)bh * 32 * 16384; const unsigned char* gQD = (const unsigned char*)(ws + WS_R + R_QD) + (size_t)bh * 32 * 16384;
    const unsigned char* gKDT = (const unsigned char*)(ws + WS_R + R_KDT) + (size_t)bh * 32 * 16384; const unsigned char* gQK = (const unsigned char*)(ws + WS_R + R_QK) + (size_t)bh * 32 * 8192;
    const unsigned char* gU = (const unsigned char*)(ws + WS_R + R_U) + (size_t)bh * 32 * 16384;
#pragma unroll 1
    for (int n = 0; n < 32; ++n) {
        v4u pf[9];
#pragma unroll
        for (int k = 0; k < 9; ++k) { const int kk = 2 * k + (tid >> 8), et = tid & 255;
            const unsigned char* src_ = kk < 4 ? gWN + (size_t)n * 16384 + kk * 4096 : kk < 8 ? gQD + (size_t)n * 16384 + (kk - 4) * 4096 :
                kk < 12 ? gKDT + (size_t)n * 16384 + (kk - 8) * 4096 : kk < 14 ? gQK + (size_t)n * 8192 + (kk - 12) * 4096 : gU + (size_t)n * 16384 + (kk - 14) * 4096;
            pf[k] = *(const v4u*)(src_ + et * 16); }
#pragma unroll
        for (int k = 0; k < 9; ++k) asm volatile("" :: "v"(pf[k]));
    }
}

__device__ __forceinline__ void gdn_scan_v3(KArgs a, int l, int bhq, LAS unsigned char* lds, int tid, int lane, int wave) {
    unsigned char* ws = a->ws;
    constexpr int FB_WN = 0, FB_QD = 16384, FB_KDT = 32768, FB_QK = 49152, FB_U = 57344, IMG = 61440;
    constexpr int OLS = 64 * 36;
    LAS float* OL = (LAS float*)(lds + 2 * IMG);
    const int bh = bhq >> 2, q = bhq & 3, h = bh & 3, b = bh >> 2, c = lane & 31, hh = lane >> 5;
    bf16* OB = (bf16*)(ws + WS_R + R_OB); float* SSQ = (float*)(ws + WS_SSQ);
    const unsigned char* gWN = (const unsigned char*)(ws + WS_R + R_WN) + (size_t)bh * 32 * 16384; const unsigned char* gQD = (const unsigned char*)(ws + WS_R + R_QD) + (size_t)bh * 32 * 16384;
    const unsigned char* gKDT = (const unsigned char*)(ws + WS_R + R_KDT) + (size_t)bh * 32 * 16384; const unsigned char* gQK = (const unsigned char*)(ws + WS_R + R_QK) + (size_t)bh * 32 * 8192;
    const unsigned char* gU = (const unsigned char*)(ws + WS_R + R_U) + (size_t)bh * 32 * 16384 + q * 4096;
    const int et = tid - 256;
#define G3_FETCH(pf, nn) do { _Pragma("unroll") for (int k = 0; k < 15; ++k) { const unsigned char* src_ = k < 4 ? gWN + (size_t)(nn) * 16384 + k * 4096 : k < 8 ? gQD + (size_t)(nn) * 16384 + (k - 4) * 4096 : \
        k < 12 ? gKDT + (size_t)(nn) * 16384 + (k - 8) * 4096 : k < 14 ? gQK + (size_t)(nn) * 8192 + (k - 12) * 4096 : gU + (size_t)(nn) * 16384; pf[k] = *(const v4u*)(src_ + et * 16); } } while (0)
#define G3_STORE(pf, buf) do { _Pragma("unroll") for (int k = 0; k < 15; ++k) *(LAS v4u*)(lds + (buf) * IMG + k * 4096 + et * 16) = pf[k]; } while (0)
    __syncthreads();
    if (wave == 0) {
        f32x16 S[4];
#pragma unroll
        for (int t = 0; t < 4; ++t)
#pragma unroll
            for (int i = 0; i < 16; ++i) S[t][i] = 0.f;
        GDN_BAR();
#pragma unroll 1
        for (int n = 0; n < 32; ++n) {
            const LAS unsigned char* img = lds + (n & 1) * IMG;
            const LAS bf16x8* WNf = (const LAS bf16x8*)(img + FB_WN) + lane; const LAS bf16x8* QDf = (const LAS bf16x8*)(img + FB_QD) + lane;
            const LAS bf16x8* KDTf = (const LAS bf16x8*)(img + FB_KDT) + lane; const LAS bf16x8* QKf = (const LAS bf16x8*)(img + FB_QK) + lane;
            const LAS v4u* Uf = (const LAS v4u*)(img + FB_U) + lane;
            const float cd = ((const float*)(ws + WS_CD))[bh * 32 + n];
            bf16x8 A0[8], A1[8];
#define G3_LD_MTS(A, F, g) do { _Pragma("unroll") for (int k = 0; k < 8; ++k) { const int m_ = k & 1, s_ = (k >> 1) & 1, t_ = 2 * (g) + (k >> 2); A[k] = F[((m_ * 4 + t_) * 2 + s_) * 64]; } } while (0)
#define G3_LD_TMS(A, F, g) do { _Pragma("unroll") for (int k = 0; k < 8; ++k) { const int s_ = k & 1, m_ = (k >> 1) & 1, t_ = 2 * (g) + (k >> 2); A[k] = F[((t_ * 2 + m_) * 2 + s_) * 64]; } } while (0)
            G3_LD_MTS(A0, WNf, 0); G3_LD_MTS(A1, WNf, 1);
            f32x16 av[2];
#pragma unroll
            for (int m = 0; m < 2; ++m)
#pragma unroll
                for (int hf = 0; hf < 2; ++hf) { const v4u u4 = Uf[(m * 2 + hf) * 64];
#pragma unroll
                    for (int k = 0; k < 4; ++k) { av[m][8 * hf + 2 * k] = bflo(u4[k]); av[m][8 * hf + 2 * k + 1] = bfhi(u4[k]); } }
            bf16x8 Sb[4][2];
#pragma unroll
            for (int t = 0; t < 4; ++t) { Sb[t][0] = pack8(S[t], 0); Sb[t][1] = pack8(S[t], 1); }
#pragma unroll
            for (int k = 0; k < 8; ++k) { const int m_ = k & 1, s_ = (k >> 1) & 1, t_ = (k >> 2); av[m_] = MFMA32(A0[k], Sb[t_][s_], av[m_]); }
            G3_LD_MTS(A0, QDf, 0);
#pragma unroll
            for (int k = 0; k < 8; ++k) { const int m_ = k & 1, s_ = (k >> 1) & 1, t_ = 2 + (k >> 2); av[m_] = MFMA32(A1[k], Sb[t_][s_], av[m_]); }
            G3_LD_MTS(A1, QDf, 1);
            f32x16 ao[2];
#pragma unroll
            for (int m = 0; m < 2; ++m)
#pragma unroll
                for (int i = 0; i < 16; ++i) ao[m][i] = 0.f;
#pragma unroll
            for (int k = 0; k < 8; ++k) { const int m_ = k & 1, s_ = (k >> 1) & 1, t_ = (k >> 2); ao[m_] = MFMA32(A0[k], Sb[t_][s_], ao[m_]); }
#pragma unroll
            for (int k = 0; k < 6; ++k) { const int s_ = k & 1, m_ = k >= 2 ? 1 : 0, mp_ = k >= 4 ? 1 : 0; A0[k] = QKf[((m_ * 2 + mp_) * 2 + s_) * 64]; }
#pragma unroll
            for (int k = 0; k < 8; ++k) { const int m_ = k & 1, s_ = (k >> 1) & 1, t_ = 2 + (k >> 2); ao[m_] = MFMA32(A1[k], Sb[t_][s_], ao[m_]); }
            G3_LD_TMS(A1, KDTf, 0);
            bf16x8 Vb[2][2];
#pragma unroll
            for (int m = 0; m < 2; ++m) { Vb[m][0] = pack8(av[m], 0); Vb[m][1] = pack8(av[m], 1); }
#pragma unroll
            for (int k = 0; k < 6; ++k) { const int s_ = k & 1, m_ = k >= 2 ? 1 : 0, mp_ = k >= 4 ? 1 : 0; ao[m_] = MFMA32(A0[k], Vb[mp_][s_], ao[m_]); }
            G3_LD_TMS(A0, KDTf, 1);
            {   LAS float* Ob = OL + (n & 1) * OLS + c;
#pragma unroll
                for (int m = 0; m < 2; ++m)
#pragma unroll
                    for (int i = 0; i < 16; ++i) Ob[(32 * m + (i & 3) + 8 * (i >> 2) + 4 * hh) * 36] = ao[m][i]; }
#pragma unroll
            for (int t = 0; t < 4; ++t)
#pragma unroll
                for (int i = 0; i < 16; ++i) S[t][i] *= cd;
#pragma unroll
            for (int k = 0; k < 8; ++k) { const int s_ = k & 1, m_ = (k >> 1) & 1, t_ = (k >> 2); S[t_] = MFMA32(A1[k], Vb[m_][s_], S[t_]); }
#pragma unroll
            for (int k = 0; k < 8; ++k) { const int s_ = k & 1, m_ = (k >> 1) & 1, t_ = 2 + (k >> 2); S[t_] = MFMA32(A0[k], Vb[m_][s_], S[t_]); }
#undef G3_LD_MTS
#undef G3_LD_TMS
            GDN_BAR();
        }
    } else if (wave >= 4) {
        v4u pfE[15], pfO[15];
        G3_FETCH(pfE, 0); G3_FETCH(pfO, 1); G3_STORE(pfE, 0);
        GDN_BAR();
        const int i = et >> 2, p = et & 3;
#define G3_OUT(m) do { const LAS float* Ob = OL + ((m) & 1) * OLS + i * 36 + 8 * p; const f32x4 o0 = *(const LAS f32x4*)Ob, o1 = *(const LAS f32x4*)(Ob + 4); \
            float ss = (o0.x * o0.x + o0.y * o0.y) + (o0.z * o0.z + o0.w * o0.w) + (o1.x * o1.x + o1.y * o1.y) + (o1.z * o1.z + o1.w * o1.w); \
            ss += __shfl_xor(ss, 1); ss += __shfl_xor(ss, 2); \
            const size_t t_ = (size_t)b * SEQ + (m) * 64 + i; \
            v4u w_; w_.x = bfc2(o0.x, o0.y); w_.y = bfc2(o0.z, o0.w); w_.z = bfc2(o1.x, o1.y); w_.w = bfc2(o1.z, o1.w); \
            *(v4u*)(OB + t_ * 1024 + 512 + h * 128 + 32 * q + 8 * p) = w_; \
            if (p == 0) SSQ[(t_ * 4 + h) * 4 + q] = ss; } while (0)
#define G3_LOADER_ITER(n, PF_FETCH, PF_STORE) do { \
            if ((n) + 2 < 32) G3_FETCH(PF_FETCH, (n) + 2); \
            if ((n) > 0) G3_OUT((n) - 1); \
            if ((n) + 1 < 32) G3_STORE(PF_STORE, ((n) + 1) & 1); \
            GDN_BAR(); \
        } while (0)
#pragma unroll
        for (int n = 0; n < 32; n += 2) {
            G3_LOADER_ITER(n, pfE, pfO);
            G3_LOADER_ITER(n + 1, pfO, pfE);
        }
        G3_OUT(31);
#undef G3_LOADER_ITER
#undef G3_OUT
    } else {
        GDN_BAR();
#pragma unroll 1
        for (int n = 0; n < 32; ++n) GDN_BAR();
    }
#undef G3_FETCH
#undef G3_STORE
}
__device__ __forceinline__ void gdn_finalize(KArgs a, int l, int lane, int gw, int NGW) {
    unsigned char* ws = a->ws;
    const bf16* HP = (const bf16*)(ws + WS_R + R_HP); bf16* OB = (bf16*)(ws + WS_R + R_OB); const float* SSQ = (const float*)(ws + WS_SSQ);
    const int hd = lane >> 4, cb = (lane & 15) * 8;
    const float* nw = a->in[5] + l * 128 + cb;
    const f32x4 w0 = *(const f32x4*)nw, w1 = *(const f32x4*)(nw + 4);
    for (int t0 = gw * 4; t0 < M; t0 += NGW * 4) {
        v4u raw[4], gg[4]; f32x4 sq[4];
#pragma unroll
        for (int k = 0; k < 4; ++k) { const size_t t = (size_t)t0 + k; raw[k] = *(const v4u*)(OB + t * 1024 + 512 + hd * 128 + cb); gg[k] = *(const v4u*)(HP + t * HP_LD + COL_GG + hd * 128 + cb); sq[k] = *(const f32x4*)(SSQ + (t * 4 + hd) * 4); }
#pragma unroll
        for (int k = 0; k < 4; ++k) { const size_t t = (size_t)t0 + k; const float rs = rsqrtf(((sq[k].x + sq[k].y) + (sq[k].z + sq[k].w)) * (1.f / 128.f) + NORM_EPS);
            v4u o; o.x = bfc2(bflo(raw[k].x) * rs * w0.x * siluf(bflo(gg[k].x)), bfhi(raw[k].x) * rs * w0.y * siluf(bfhi(gg[k].x))); o.y = bfc2(bflo(raw[k].y) * rs * w0.z * siluf(bflo(gg[k].y)), bfhi(raw[k].y) * rs * w0.w * siluf(bfhi(gg[k].y)));
            o.z = bfc2(bflo(raw[k].z) * rs * w1.x * siluf(bflo(gg[k].z)), bfhi(raw[k].z) * rs * w1.y * siluf(bfhi(gg[k].z))); o.w = bfc2(bflo(raw[k].w) * rs * w1.z * siluf(bflo(gg[k].w)), bfhi(raw[k].w) * rs * w1.w * siluf(bfhi(gg[k].w)));
            *(v4u*)(OB + t * 1024 + 512 + hd * 128 + cb) = o; }
    }
}

struct RetLds {
    static constexpr int QS = 72, JS = 136;
    static constexpr int P = 0, Q1 = 34816, K1 = 53248, OL = 0, K1T = 71680, VT = 89088, ST = 123904;
};
template <bool WANT_Q, bool WANT_K1, bool WANT_K1T>
__device__ __forceinline__ void ret_stage(const bf16* HP, const float* RT, int b, int h, int n, float lg, LAS unsigned char* lds, int tid) {
    constexpr int QS = RetLds::QS, JS = RetLds::JS;
    LAS bf16* Q1 = (LAS bf16*)(lds + RetLds::Q1); LAS bf16* K1 = (LAS bf16*)(lds + RetLds::K1); LAS bf16* K1T = (LAS bf16*)(lds + RetLds::K1T); LAS bf16* VT = (LAS bf16*)(lds + RetLds::VT);
    const int i = tid >> 2, dd = (tid & 3) * 8, pos = n * 128 + i; const size_t t = (size_t)b * SEQ + pos;
    const bf16* hp = HP + t * HP_LD;
    const f32x4 c0 = *(const f32x4*)(RT + pos * 64 + dd), c1 = *(const f32x4*)(RT + pos * 64 + dd + 4), s0 = *(const f32x4*)(RT + pos * 64 + 32 + dd), s1 = *(const f32x4*)(RT + pos * 64 + 32 + dd + 4);
    const float cs[8] = {c0.x, c0.y, c0.z, c0.w, c1.x, c1.y, c1.z, c1.w}, sn[8] = {s0.x, s0.y, s0.z, s0.w, s1.x, s1.y, s1.z, s1.w};
    const float sq = exp2f((float)i * lg), sk = 0.125f * exp2f(-(float)i * lg);
    v4u xv[4];
#pragma unroll
    for (int p = 0; p < 4; ++p) { const int idx = tid + 512 * p, j = idx >> 4, e0 = (idx & 15) * 8; xv[p] = *(const v4u*)(HP + ((size_t)b * SEQ + n * 128 + j) * HP_LD + COL_RV + h * 128 + e0); }
#pragma unroll
    for (int which = (WANT_Q ? 0 : 1); which < 2; ++which) {
        const bf16* src = hp + (which == 0 ? COL_RQ : COL_RK) + h * 64 + dd;
        const v4u x1 = *(const v4u*)src, x2 = *(const v4u*)(src + 32);
        const float sc = which == 0 ? sq : sk;
        float lo[8], hi[8];
#pragma unroll
        for (int k = 0; k < 4; ++k) { const float a0 = bflo(x1[k]), a1 = bfhi(x1[k]), b0 = bflo(x2[k]), b1 = bfhi(x2[k]);
            lo[2 * k] = (a0 * cs[2 * k] - b0 * sn[2 * k]) * sc; lo[2 * k + 1] = (a1 * cs[2 * k + 1] - b1 * sn[2 * k + 1]) * sc;
            hi[2 * k] = (a0 * sn[2 * k] + b0 * cs[2 * k]) * sc; hi[2 * k + 1] = (a1 * sn[2 * k + 1] + b1 * cs[2 * k + 1]) * sc; }
        v4u wl, wh;
#pragma unroll
        for (int k = 0; k < 4; ++k) { wl[k] = bfc2(lo[2 * k], lo[2 * k + 1]); wh[k] = bfc2(hi[2 * k], hi[2 * k + 1]); }
        if (which == 0 || WANT_K1) { LAS bf16* dst = (which == 0 ? Q1 : K1) + i * QS + dd; *(LAS v4u*)dst = wl; *(LAS v4u*)(dst + 32) = wh; }
        if (which == 1 && WANT_K1T) {
#pragma unroll
            for (int k = 0; k < 4; ++k) { K1T[(dd + 2 * k) * JS + i] = (bf16)(wl[k] & 0xffffu); K1T[(dd + 2 * k + 1) * JS + i] = (bf16)(wl[k] >> 16);
                K1T[(32 + dd + 2 * k) * JS + i] = (bf16)(wh[k] & 0xffffu); K1T[(32 + dd + 2 * k + 1) * JS + i] = (bf16)(wh[k] >> 16); }
        }
    }
#pragma unroll
    for (int p = 0; p < 4; ++p) { const int idx = tid + 512 * p, j = idx >> 4, e0 = (idx & 15) * 8;
#pragma unroll
        for (int k = 0; k < 4; ++k) { VT[(e0 + 2 * k) * JS + j] = (bf16)(xv[p][k] & 0xffffu); VT[(e0 + 2 * k + 1) * JS + j] = (bf16)(xv[p][k] >> 16); } }
}
__device__ __forceinline__ void ret_kv_unit(KArgs a, int unit, LAS unsigned char* lds, int tid, int lane, int wave) {
    unsigned char* ws = a->ws;
    constexpr int JS = RetLds::JS;
    const int n = unit & 15, bh = unit >> 4, h = bh & 3, b = bh >> 2, c = lane & 31, hh = lane >> 5;
    const bf16* HP = (const bf16*)(ws + WS_R + R_HP); const float* RT = (const float*)(ws + WS_ROPE);
    const float gam = 1.0f - exp2f(-5.0f - (float)h), lg = log2f(gam), g127 = exp2f(127.f * lg);
    LAS bf16* K1T = (LAS bf16*)(lds + RetLds::K1T); LAS bf16* VT = (LAS bf16*)(lds + RetLds::VT);
    __syncthreads();
    ret_stage<false, false, true>(HP, RT, b, h, n, lg, lds, tid);
    __syncthreads();
    const int td = wave >> 2, te = wave & 3;
    f32x16 kv;
#pragma unroll
    for (int i = 0; i < 16; ++i) kv[i] = 0.f;
#pragma unroll
    for (int ks = 0; ks < 8; ++ks) kv = MFMA32(*(const LAS bf16x8*)(K1T + (32 * td + c) * JS + 16 * ks + 8 * hh), *(const LAS bf16x8*)(VT + (32 * te + c) * JS + 16 * ks + 8 * hh), kv);
    float* dst = (float*)(ws + WS_KV) + ((size_t)(unit * 8 + wave) * 64 + lane) * 16;
#pragma unroll
    for (int g = 0; g < 4; ++g) *(f32x4*)(dst + 4 * g) = (f32x4){kv[4 * g] * g127, kv[4 * g + 1] * g127, kv[4 * g + 2] * g127, kv[4 * g + 3] * g127};
}
__device__ __forceinline__ void ret_out_unit(KArgs a, int unit, LAS unsigned char* lds, int tid, int lane, int wave) {
    unsigned char* ws = a->ws;
    constexpr int QS = RetLds::QS, JS = RetLds::JS;
    LAS bf16* P = (LAS bf16*)(lds + RetLds::P); LAS bf16* Q1 = (LAS bf16*)(lds + RetLds::Q1); LAS bf16* K1 = (LAS bf16*)(lds + RetLds::K1); LAS float* OL = (LAS float*)(lds + RetLds::OL);
    LAS bf16* VT = (LAS bf16*)(lds + RetLds::VT); LAS bf16* ST = (LAS bf16*)(lds + RetLds::ST);
    const int n = unit & 15, bh = unit >> 4, h = bh & 3, b = bh >> 2, c = lane & 31, hh = lane >> 5;
    const bf16* HP = (const bf16*)(ws + WS_R + R_HP); bf16* OB = (bf16*)(ws + WS_R + R_OB); const float* RT = (const float*)(ws + WS_ROPE);
    const float gam = 1.0f - exp2f(-5.0f - (float)h), lg = log2f(gam), g128 = exp2f(128.f * lg);
    __syncthreads();
    const int ei = tid >> 2, eq = tid & 3; const size_t et = (size_t)b * SEQ + n * 128 + ei;
    v4u gg[4];
    { const bf16* gp = HP + et * HP_LD + COL_RG + h * 128 + 32 * eq;
#pragma unroll
      for (int k = 0; k < 4; ++k) gg[k] = *(const v4u*)(gp + 8 * k); }
    {
        const int td = wave >> 2, te = wave & 3;
        f32x16 S;
#pragma unroll
        for (int i = 0; i < 16; ++i) S[i] = 0.f;
        const float* src = (const float*)(ws + WS_KV) + ((size_t)((bh * 16) * 8 + wave) * 64 + lane) * 16;
#pragma unroll 2
        for (int m = 0; m < n; ++m) { const f32x4* p4 = (const f32x4*)(src + (size_t)m * 8 * 64 * 16);
#pragma unroll
            for (int g = 0; g < 4; ++g) { const f32x4 v = p4[g]; S[4 * g] = S[4 * g] * g128 + v.x; S[4 * g + 1] = S[4 * g + 1] * g128 + v.y; S[4 * g + 2] = S[4 * g + 2] * g128 + v.z; S[4 * g + 3] = S[4 * g + 3] * g128 + v.w; } }
#pragma unroll
        for (int g = 0; g < 4; ++g) { v2u w; w.x = bfc2(S[4 * g], S[4 * g + 1]); w.y = bfc2(S[4 * g + 2], S[4 * g + 3]); *(LAS v2u*)(ST + (32 * te + c) * QS + 32 * td + 8 * g + 4 * hh) = w; }
    }
    ret_stage<true, true, false>(HP, RT, b, h, n, lg, lds, tid);
    __syncthreads();
#pragma unroll 1
    for (int rep = 0; rep < 2; ++rep) { const int idx = wave + 8 * rep;
        if (idx < 10) { const int ti = (idx >= 1) + (idx >= 3) + (idx >= 6), tj = idx - ti * (ti + 1) / 2;
            f32x16 acc;
#pragma unroll
            for (int i = 0; i < 16; ++i) acc[i] = 0.f;
#pragma unroll
            for (int s2 = 0; s2 < 4; ++s2) acc = MFMA32(*(const LAS bf16x8*)(Q1 + (32 * ti + c) * QS + 16 * s2 + 8 * hh), *(const LAS bf16x8*)(K1 + (32 * tj + c) * QS + 16 * s2 + 8 * hh), acc);
#pragma unroll
            for (int i = 0; i < 16; ++i) { const int il = (i & 3) + 8 * (i >> 2) + 4 * hh; float v = acc[i]; if (ti == tj && il < c) v = 0.f; P[(32 * ti + il) * JS + 32 * tj + c] = bfc(v); } } }
    __syncthreads();
    const int ti = wave >> 1, te0 = 2 * (wave & 1);
    f32x16 ao[2];
#pragma unroll
    for (int u = 0; u < 2; ++u)
#pragma unroll
        for (int i = 0; i < 16; ++i) ao[u][i] = 0.f;
#pragma unroll
    for (int s2 = 0; s2 < 4; ++s2) { const bf16x8 A = *(const LAS bf16x8*)(Q1 + (32 * ti + c) * QS + 16 * s2 + 8 * hh);
#pragma unroll
        for (int u = 0; u < 2; ++u) ao[u] = MFMA32(A, *(const LAS bf16x8*)(ST + (32 * (te0 + u) + c) * QS + 16 * s2 + 8 * hh), ao[u]); }
#pragma unroll
    for (int u = 0; u < 2; ++u)
#pragma unroll
        for (int i = 0; i < 16; ++i) ao[u][i] *= gam;
#pragma unroll 1
    for (int tj = 0; tj <= ti; ++tj)
#pragma unroll
        for (int s2 = 0; s2 < 2; ++s2) { const bf16x8 A = *(const LAS bf16x8*)(P + (32 * ti + c) * JS + 32 * tj + 16 * s2 + 8 * hh);
#pragma unroll
            for (int u = 0; u < 2; ++u) ao[u] = MFMA32(A, *(const LAS bf16x8*)(VT + (32 * (te0 + u) + c) * JS + 32 * tj + 16 * s2 + 8 * hh), ao[u]); }
    __syncthreads();
#pragma unroll
    for (int u = 0; u < 2; ++u)
#pragma unroll
        for (int i = 0; i < 16; ++i) OL[(32 * ti + (i & 3) + 8 * (i >> 2) + 4 * hh) * 132 + 32 * (te0 + u) + c] = ao[u][i];
    __syncthreads();
    {
        const LAS float* Ob = OL + ei * 132 + 32 * eq; bf16* op = OB + et * 1024 + h * 128 + 32 * eq;
        f32x4 v[8]; float sm = 0.f;
#pragma unroll
        for (int k = 0; k < 8; ++k) { v[k] = *(const LAS f32x4*)(Ob + 4 * k); sm += (v[k].x + v[k].y) + (v[k].z + v[k].w); }
        sm += __shfl_xor(sm, 1); sm += __shfl_xor(sm, 2);
        const float mean = sm * (1.f / 128.f); float sq = 0.f;
#pragma unroll
        for (int k = 0; k < 8; ++k) { v[k] = v[k] - mean; sq += (v[k].x * v[k].x + v[k].y * v[k].y) + (v[k].z * v[k].z + v[k].w * v[k].w); }
        sq += __shfl_xor(sq, 1); sq += __shfl_xor(sq, 2);
        const float rs = rsqrtf(sq * (1.f / 128.f) + LN_EPS);
#pragma unroll
        for (int k = 0; k < 4; ++k) { const v4u g4 = gg[k]; const f32x4 a0 = v[2 * k], a1 = v[2 * k + 1];
            v4u o; o.x = bfc2(a0.x * rs * siluf(bflo(g4.x)), a0.y * rs * siluf(bfhi(g4.x))); o.y = bfc2(a0.z * rs * siluf(bflo(g4.y)), a0.w * rs * siluf(bfhi(g4.y)));
            o.z = bfc2(a1.x * rs * siluf(bflo(g4.z)), a1.y * rs * siluf(bfhi(g4.z))); o.w = bfc2(a1.z * rs * siluf(bflo(g4.w)), a1.w * rs * siluf(bfhi(g4.w)));
            *(v4u*)(op + 8 * k) = o; }
    }
}

__device__ __forceinline__ float sum16(float v) {
    v += __builtin_bit_cast(float, __builtin_amdgcn_update_dpp(0, __builtin_bit_cast(int, v), 0xB1, 0xF, 0xF, true));
    v += __builtin_bit_cast(float, __builtin_amdgcn_update_dpp(0, __builtin_bit_cast(int, v), 0x4E, 0xF, 0xF, true));
    v += __builtin_bit_cast(float, __builtin_amdgcn_update_dpp(0, __builtin_bit_cast(int, v), 0x141, 0xF, 0xF, true));
    v += __builtin_bit_cast(float, __builtin_amdgcn_update_dpp(0, __builtin_bit_cast(int, v), 0x140, 0xF, 0xF, true));
    return v;
}
__device__ __forceinline__ void gdn_prep_fast(KArgs a, int l, int unit, LAS unsigned char* lds, int tid, int lane, int wave) {
    asm volatile("" : "+v"(tid)); lane = tid & 63; wave = __builtin_amdgcn_readfirstlane(tid >> 6);
    unsigned char* ws = a->ws;
    constexpr int KS = 136;
    LAS bf16* Kb = (LAS bf16*)lds;
    LAS bf16* Qb = (LAS bf16*)(lds + 17408);
    LAS float* A = (LAS float*)(lds + 34816);
    LAS float* V = (LAS float*)(lds + 51200);
    LAS float* KW = (LAS float*)(lds + 83968);
    LAS float* gc = (LAS float*)(lds + 116736);
    LAS float* bt = gc + 64;
    LAS bf16* KDs = (LAS bf16*)(lds + 117248);
    LAS bf16* XT = (LAS bf16*)lds;
    LAS bf16* A10b = (LAS bf16*)(lds + 135680);
    const int n = unit & 31, bh = unit >> 5, h = bh & 3, b = bh >> 2, t0 = b * SEQ + n * 64, c = lane & 31, hh = lane >> 5;
    const bf16* HP = (const bf16*)(ws + WS_R + R_HP);
    constexpr int F8D = GDN_F8 ? 2 : 1;
    bf16* QKg = (bf16*)(ws + WS_R + R_QK) + (size_t)unit * (4096 / F8D); bf16* QDg = (bf16*)(ws + WS_R + R_QD) + (size_t)unit * (8192 / F8D); bf16* KDTg = (bf16*)(ws + WS_R + R_KDT) + (size_t)unit * (8192 / F8D);
    bf16* WNg = (bf16*)(ws + WS_R + R_WN) + (size_t)unit * (8192 / F8D); bf16* Ug = (bf16*)(ws + WS_R + R_U) + (size_t)unit * 8192;
    __syncthreads(); if (unit == PROBE_UNIT) STAMPT(130, 0);
    if (wave == 0) {
        const float* gab = (const float*)(ws + WS_GAB) + (size_t)(t0 + lane) * 8; const float x = gab[h] + a->in[4][l * 4 + h];
        const float sp = fmaxf(x, 0.f) + log1pf(__expf(-fabsf(x))); float g = -__expf(a->in[3][l * 4 + h]) * sp;
#pragma unroll
        for (int o = 1; o < 64; o <<= 1) { const float up = __shfl_up(g, o); if (lane >= o) g += up; }
        gc[lane] = g; bt[lane] = sigmf(gab[4 + h]);
        if (lane == 63) ((float*)(ws + WS_CD))[unit] = __expf(g);
    }
    __syncthreads(); if (unit == PROBE_UNIT) STAMPT(131, 0);
#ifndef PREP_NO_CONV
    if (wave < 6) {
        const int which = wave >> 1, tp = tid & 127, rb = tp >> 4, dd = (tp & 15) * 8, col = COL_GQ + which * 512 + h * 128 + dd, cc = which * 512 + h * 128 + dd;
        const float* cw = a->in[2] + (size_t)l * 4 * 1536 + cc;
        float w[4][8];
#pragma unroll
        for (int j = 0; j < 4; ++j) { const f32x4 w0 = *(const f32x4*)(cw + j * 1536), w1 = *(const f32x4*)(cw + j * 1536 + 4); w[j][0] = w0.x; w[j][1] = w0.y; w[j][2] = w0.z; w[j][3] = w0.w; w[j][4] = w1.x; w[j][5] = w1.y; w[j][6] = w1.z; w[j][7] = w1.w; }
        const int sbase = n * 64 + 8 * rb - 3;
        const bf16* hpc = HP + (size_t)(b * SEQ) * HP_LD + col;
        v4u raw[11];
#pragma unroll
        for (int r = 0; r < 11; ++r) { raw[r] = (v4u){0u, 0u, 0u, 0u}; if (sbase + r >= 0) raw[r] = *(const v4u*)(hpc + (size_t)(sbase + r) * HP_LD); }
        const float gl = gc[63];
#pragma unroll
        for (int r = 0; r < 8; ++r) { const int i = 8 * rb + r; float y[8]; float ss = 0.f;
#pragma unroll
            for (int k4 = 0; k4 < 4; ++k4) {
                unsigned d0 = raw[r][k4], d1 = raw[r + 1][k4], d2 = raw[r + 2][k4], d3 = raw[r + 3][k4];
                asm volatile("" : "+v"(d0), "+v"(d1), "+v"(d2), "+v"(d3));
                const float a0 = w[0][2 * k4] * bflo(d0) + w[1][2 * k4] * bflo(d1) + w[2][2 * k4] * bflo(d2) + w[3][2 * k4] * bflo(d3);
                const float a1 = w[0][2 * k4 + 1] * bfhi(d0) + w[1][2 * k4 + 1] * bfhi(d1) + w[2][2 * k4 + 1] * bfhi(d2) + w[3][2 * k4 + 1] * bfhi(d3);
                y[2 * k4] = siluf(a0); y[2 * k4 + 1] = siluf(a1); ss += y[2 * k4] * y[2 * k4] + y[2 * k4 + 1] * y[2 * k4 + 1]; }
            ss = sum16(ss);
            const float gi = gc[i], bi = bt[i];
            if (which == 0) { const float f = rsqrtf(ss + NORM_EPS) * 0.08838834764831845f, eg = __expf(gi);
                v4u p, pd;
#pragma unroll
                for (int k = 0; k < 4; ++k) { p[k] = bfc2(y[2 * k] * f, y[2 * k + 1] * f); pd[k] = bfc2(y[2 * k] * f * eg, y[2 * k + 1] * f * eg); }
                *(LAS v4u*)(Qb + i * KS + dd) = p;
#if GDN_F8
                { unsigned char* qd8 = (unsigned char*)QDg + (((i >> 5) * 4 + (dd >> 5)) * 2 + ((dd >> 4) & 1)) * 512 + (i & 31) * 8 + ((dd >> 3) & 1) * 4; const float fs = f * eg * F8_SQ;
                  *(unsigned*)qd8 = f8x4(y[0] * fs, y[1] * fs, y[2] * fs, y[3] * fs); *(unsigned*)(qd8 + 256) = f8x4(y[4] * fs, y[5] * fs, y[6] * fs, y[7] * fs); }
#else
                bf16* qd = QDg + (((i >> 5) * 4 + (dd >> 5)) * 2 + ((dd >> 4) & 1)) * 512 + (i & 31) * 8 + ((dd >> 3) & 1) * 4;
                *(v2u*)qd = (v2u){pd[0], pd[1]}; *(v2u*)(qd + 256) = (v2u){pd[2], pd[3]};
#endif
            } else if (which == 1) { const float f = rsqrtf(ss + NORM_EPS), fw = f * bi * __expf(gi), fd = f * __expf(gl - gi);
                v4u p;
#pragma unroll
                for (int k = 0; k < 4; ++k) p[k] = bfc2(y[2 * k] * f, y[2 * k + 1] * f);
                *(LAS v4u*)(Kb + i * KS + dd) = p;
#pragma unroll
                for (int k = 0; k < 8; ++k) { KW[i * 128 + dd + k] = y[k] * fw; KDs[(dd + k) * 72 + i] = bfc(y[k] * fd); }
            } else {
#pragma unroll
                for (int k = 0; k < 8; ++k) V[i * 128 + dd + k] = y[k] * bi;
            }
        }
    }
    if (GATE_PRE && wave >= 6) {
        const int tg = tid - 384;
#pragma unroll 2
        for (int p = 0; p < 8; ++p) { const int idx = tg + 128 * p, i = idx >> 4, g8 = (idx & 15) * 8;
            bf16* gp = (bf16*)(ws + WS_R + R_HP) + (size_t)(t0 + i) * HP_LD + COL_GG + h * 128 + g8; const v4u x = *(const v4u*)gp;
            v4u o; o.x = bfc2(siluf(bflo(x.x)), siluf(bfhi(x.x))); o.y = bfc2(siluf(bflo(x.y)), siluf(bfhi(x.y))); o.z = bfc2(siluf(bflo(x.z)), siluf(bfhi(x.z))); o.w = bfc2(siluf(bflo(x.w)), siluf(bfhi(x.w)));
            *(v4u*)gp = o; }
    }
#endif
    __syncthreads(); if (unit == PROBE_UNIT) STAMPT(132, 0);
    {
        const int ti = (wave >> 1) & 1, tj = wave & 1;
        if (wave < 4) {
            if (ti <= tj) {
                f32x16 acc;
#pragma unroll
                for (int i = 0; i < 16; ++i) acc[i] = 0.f;
#pragma unroll
                for (int s = 0; s < 8; ++s) acc = MFMA32(*(const LAS bf16x8*)(Kb + (32 * ti + c) * KS + 16 * s + 8 * hh), *(const LAS bf16x8*)(Kb + (32 * tj + c) * KS + 16 * s + 8 * hh), acc);
                const int i = 32 * tj + c; const float gi = gc[i], bi = bt[i];
#pragma unroll
                for (int r = 0; r < 16; ++r) { const int j = 32 * ti + (r & 3) + 8 * (r >> 2) + 4 * hh; const float av = (j < i) ? bi * acc[r] * __expf(gi - gc[j]) : 0.f; A[j * 64 + i] = av;
                    if (ti == 0 && tj == 1) A10b[c * 40 + j] = bfc(av); }
            } else {
#pragma unroll
                for (int r = 0; r < 16; ++r) { const int j = 32 * ti + (r & 3) + 8 * (r >> 2) + 4 * hh; A[j * 64 + 32 * tj + c] = 0.f; }
            }
        } else {
            const int kt = ti, qt = tj;
            if (kt <= qt) {
                f32x16 acc;
#pragma unroll
                for (int i = 0; i < 16; ++i) acc[i] = 0.f;
#pragma unroll
                for (int s = 0; s < 8; ++s) acc = MFMA32(*(const LAS bf16x8*)(Kb + (32 * kt + c) * KS + 16 * s + 8 * hh), *(const LAS bf16x8*)(Qb + (32 * qt + c) * KS + 16 * s + 8 * hh), acc);
                const int i = 32 * qt + c; const float gi = gc[i];
#pragma unroll
                for (int r = 0; r < 16; ++r) { const int j = 32 * kt + (r & 3) + 8 * (r >> 2) + 4 * hh; acc[r] = (j <= i) ? acc[r] * __expf(gi - gc[j]) : 0.f; }
                bf16x8* qf = (bf16x8*)QKg + lane;
#if GDN_F8
                { long* qf8 = (long*)QKg + lane; qf8[((qt * 2 + kt) * 2 + 0) * 64] = pack8_f8(acc, 0, F8_SQ); qf8[((qt * 2 + kt) * 2 + 1) * 64] = pack8_f8(acc, 1, F8_SQ); }
#else
                qf[((qt * 2 + kt) * 2 + 0) * 64] = pack8(acc, 0); qf[((qt * 2 + kt) * 2 + 1) * 64] = pack8(acc, 1);
#endif
            }
        }
    }
    __syncthreads(); if (unit == PROBE_UNIT) STAMPT(133, 0);
#ifndef PREP_NO_SOLVE
#define PREP_SOLVE32(B0) do { \
        _Pragma("unroll") for (int i = 0; i < 32; ++i) x[i] = rhs[((B0) + i) * 128]; \
        _Pragma("unroll") for (int m = 0; m < 31; ++m) { const float xm = x[m]; \
            _Pragma("unroll") for (int g = (m + 1) / 4; g < 8; ++g) { const f32x4 a4 = *(const LAS f32x4*)(A + ((B0) + m) * 64 + (B0) + 4 * g); \
                if (4 * g > m) x[4 * g] -= a4.x * xm; if (4 * g + 1 > m) x[4 * g + 1] -= a4.y * xm; if (4 * g + 2 > m) x[4 * g + 2] -= a4.z * xm; if (4 * g + 3 > m) x[4 * g + 3] -= a4.w * xm; } } \
        if (tl < 128) { _Pragma("unroll") for (int hx = 0; hx < 2; ++hx) _Pragma("unroll") for (int hf = 0; hf < 2; ++hf) { const int i0 = 16 * hf + 4 * hx; \
                v4u w_; w_.x = bfc2(x[i0], x[i0 + 1]); w_.y = bfc2(x[i0 + 2], x[i0 + 3]); w_.z = bfc2(x[i0 + 8], x[i0 + 9]); w_.w = bfc2(x[i0 + 10], x[i0 + 11]); *(v4u*)(Ug + uoff((B0) + i0, col)) = w_; } } \
        else { _Pragma("unroll") for (int i = 0; i < 32; ++i) Qb[((B0) + i) * KS + col] = bfc(-x[i]); } } while (0)
    int tl = tid; asm volatile("" : "+v"(tl));
    const int c2 = tl & 31, hh2 = (tl >> 5) & 1;
    if (wave < 4) {
        const int col = tl & 127; LAS float* rhs = (tl < 128 ? V : KW) + col;
        float x[32];
        PREP_SOLVE32(0);
        v4u p[4];
#pragma unroll
        for (int k = 0; k < 4; ++k) { p[k].x = bfc2(x[8 * k], x[8 * k + 1]); p[k].y = bfc2(x[8 * k + 2], x[8 * k + 3]); p[k].z = bfc2(x[8 * k + 4], x[8 * k + 5]); p[k].w = bfc2(x[8 * k + 6], x[8 * k + 7]); }
#pragma unroll
        for (int k = 0; k < 4; ++k) *(LAS v4u*)(XT + tl * 32 + 8 * k) = p[k];
    }
    __syncthreads();
    {
        f32x16 acc;
#pragma unroll
        for (int i = 0; i < 16; ++i) acc[i] = 0.f;
#pragma unroll
        for (int s2 = 0; s2 < 2; ++s2) acc = MFMA32(*(const LAS bf16x8*)(A10b + c2 * 40 + 16 * s2 + 8 * hh2), *(const LAS bf16x8*)(XT + (32 * wave + c2) * 32 + 16 * s2 + 8 * hh2), acc);
        LAS float* R1 = (wave < 4 ? V : KW) + 32 * (wave & 3) + c2;
#pragma unroll
        for (int r = 0; r < 16; ++r) { const int i = 32 + (r & 3) + 8 * (r >> 2) + 4 * hh2; R1[i * 128] -= acc[r]; }
    }
    __syncthreads();
    if (wave < 4) {
        const int col = tl & 127; LAS float* rhs = (tl < 128 ? V : KW) + col;
        float x[32];
        PREP_SOLVE32(32);
    }
#undef PREP_SOLVE32
#endif
    __syncthreads(); if (unit == PROBE_UNIT) STAMPT(134, 0);
#pragma unroll
    for (int p = 0; p < 4; ++p) { const int idx = tid + 512 * p, i = idx >> 5, d = (idx & 31) * 4;
#if GDN_F8
        { const v2u w2 = *(const LAS v2u*)(Qb + i * KS + d); *(unsigned*)((unsigned char*)WNg + fragoff(i, d, 4)) = f8x4(bflo(w2.x) * F8_SW, bfhi(w2.x) * F8_SW, bflo(w2.y) * F8_SW, bfhi(w2.y) * F8_SW); } }
#else
        *(v2u*)(WNg + fragoff(i, d, 4)) = *(const LAS v2u*)(Qb + i * KS + d); }
#endif
#pragma unroll
    for (int p = 0; p < 4; ++p) { const int idx = tid + 512 * p, d = idx >> 4, i = (idx & 15) * 4;
#if GDN_F8
        { const v2u k2 = *(const LAS v2u*)(KDs + d * 72 + i); *(unsigned*)((unsigned char*)KDTg + fragoff(d, i, 2)) = f8x4(bflo(k2.x) * F8_SK, bfhi(k2.x) * F8_SK, bflo(k2.y) * F8_SK, bfhi(k2.y) * F8_SK); } }
#else
        *(v2u*)(KDTg + fragoff(d, i, 2)) = *(const LAS v2u*)(KDs + d * 72 + i); }
#endif
    if (unit == PROBE_UNIT) STAMPT(135, 0);
}
#define XB_TMO      128
#define XB_XCNT(j)  (256  + 64 * (j))
#define XB_XSUB(j)  (1280 + 64 * (j))
#define XB_XGEN(j)  (2304 + 64 * (j))
#define XB_TOP      3328
#define XB_TOPGEN   3392
#define XCD_BAR_WORDS 3456
#define XB_SPIN_CAP (1u << 18)

__device__ __forceinline__ unsigned xb_ld(unsigned* p)              { return __hip_atomic_load(p, __ATOMIC_RELAXED, __HIP_MEMORY_SCOPE_AGENT); }
__device__ __forceinline__ unsigned xb_add(unsigned* p, unsigned v) { return __hip_atomic_fetch_add(p, v, __ATOMIC_RELAXED, __HIP_MEMORY_SCOPE_AGENT); }
__device__ __forceinline__ unsigned xb_xcc_id() { return (unsigned)__builtin_amdgcn_s_getreg((3 << 11) | 20) & 0xFu; }
#define XB_SPIN(cond, bar) do { unsigned _sp = 0; while (cond) { __builtin_amdgcn_s_sleep(1); \
    if ((++_sp & 255u) == 0u) { if (xb_ld(&(bar)[XB_TMO])) break; if (_sp > XB_SPIN_CAP) { atomicAdd(&(bar)[XB_TMO], 1u); break; } } } } while (0)

struct XcdBarrier {
    unsigned* bar; unsigned x;
    volatile LAS unsigned* st;
};

__device__ __forceinline__ XcdBarrier xcd_barrier_post(unsigned* bar, volatile LAS unsigned* st) {
    XcdBarrier b; b.bar = bar; b.x = xb_xcc_id(); b.st = st;
    if (threadIdx.x == 0) (void)xb_add(&bar[XB_XCNT(b.x)], 1u);
    return b;
}
__device__ __forceinline__ void xcd_barrier_complete(unsigned* bar, unsigned x, unsigned& nloc, unsigned& nx) {
    const unsigned G = gridDim.x * gridDim.y * gridDim.z;
    unsigned sum, cnt, mine, sp = 0u;
    for (;;) {
        sum = 0u; cnt = 0u; mine = 0u;
#pragma unroll
        for (unsigned j = 0; j < 16; ++j) { const unsigned c = xb_ld(&bar[XB_XCNT(j)]); sum += c; cnt += (c > 0u) ? 1u : 0u; mine = (j == x) ? c : mine; }
        if (sum == G) break;
        __builtin_amdgcn_s_sleep(1);
        if ((++sp & 255u) == 0u) { if (xb_ld(&bar[XB_TMO])) break; if (sp > XB_SPIN_CAP) { atomicAdd(&bar[XB_TMO], 1u); break; } }
    }
    nloc = mine > 0u ? mine : 1u; nx = cnt > 0u ? cnt : 1u;
}

__device__ __forceinline__ void xcd_barrier(const XcdBarrier& b) {
    asm volatile("s_waitcnt vmcnt(0)" ::: "memory");
    __syncthreads();
    if (threadIdx.x == 0) {
        unsigned* bar = b.bar;
        __builtin_amdgcn_s_waitcnt(0);
        unsigned nloc = b.st[0], nx = b.st[1];
        if (nloc == 0u) { xcd_barrier_complete(bar, b.x, nloc, nx); b.st[0] = nloc; b.st[1] = nx; }
        const unsigned old = xb_add(&bar[XB_XSUB(b.x)], 1u);
        const unsigned gen = old / nloc;
        if (old + 1u == (gen + 1u) * nloc) {
            __builtin_amdgcn_fence(__ATOMIC_RELEASE, "agent");
            asm volatile("s_waitcnt vmcnt(0)" ::: "memory");
            const unsigned og = xb_add(&bar[XB_TOP], 1u);
            const unsigned tg = og / nx;
            if (og + 1u == (tg + 1u) * nx) xb_add(&bar[XB_TOPGEN], 1u);
            else XB_SPIN(xb_ld(&bar[XB_TOPGEN]) == tg, bar);
            __builtin_amdgcn_fence(__ATOMIC_ACQUIRE, "agent");
            xb_add(&bar[XB_XGEN(b.x)], 1u);
            asm volatile("s_waitcnt vmcnt(0)" ::: "memory");
        } else {
            XB_SPIN(xb_ld(&bar[XB_XGEN(b.x)]) == gen, bar);
            __builtin_amdgcn_fence(__ATOMIC_ACQUIRE, "agent");
            asm volatile("s_waitcnt vmcnt(0)" ::: "memory");
        }
    }
    __syncthreads();
}
#ifndef REP_PRO
#define REP_PRO 1
#endif
#ifndef REP_IN
#define REP_IN 1
#endif
#ifndef REP_PREP
#define REP_PREP 1
#endif
#ifndef REP_SCAN
#define REP_SCAN 1
#endif
#ifndef REP_OUT
#define REP_OUT 1
#endif
#ifndef REP_GU
#define REP_GU 1
#endif
#ifndef REP_DN
#define REP_DN 1
#endif
#ifndef REP_MGU
#define REP_MGU 1
#endif
#ifndef REP_GDN
#define REP_GDN 1
#endif
#ifndef REP_RET
#define REP_RET 1
#endif
#ifndef KV_IN_SCAN
#define KV_IN_SCAN 0
#endif
#ifndef GDN_HELPERS
#define GDN_HELPERS 0
#endif
#ifndef GDN_SPLIT
#define GDN_SPLIT 0
#endif
#ifndef FAST_SCAN
#define FAST_SCAN 1
#endif
#ifndef FAST_RET
#define FAST_RET 1
#endif
#ifndef FAST_PREP
#define FAST_PREP 1
#endif
#ifndef EN_PRO
#define EN_PRO 1
#endif
#ifndef EN_IN
#define EN_IN 1
#endif
#ifndef EN_PREP
#define EN_PREP 1
#endif
#ifndef EN_SCAN
#define EN_SCAN 1
#endif
#ifndef EN_OUT
#define EN_OUT 1
#endif
#ifndef EN_LN1
#define EN_LN1 1
#endif
#ifndef EN_FFN0
#define EN_FFN0 1
#endif
#ifndef EN_MOE
#define EN_MOE 1
#endif

#ifndef PROBE_MULT
#define PROBE_MULT 0
#endif
#ifndef PROBE_BID
#define PROBE_BID 0
#endif
#ifndef PROBE_A
#define PROBE_A 0
#endif
#ifndef PROBE_B
#define PROBE_B 0
#endif
#ifndef STAG_IN
#define STAG_IN 0
#endif
#ifndef STAG_GU
#define STAG_GU 0
#endif
#ifndef STAG_MA
#define STAG_MA 0
#endif
#ifndef STAG_MC
#define STAG_MC 0
#endif
__device__ __forceinline__ void stagger(int c, int ticks) {
    if (ticks > 0) { const unsigned long long want = (unsigned long long)(((c >> 3) & 31) * ticks) >> 5, t0 = __builtin_amdgcn_s_memrealtime();
        while (__builtin_amdgcn_s_memrealtime() - t0 < want) __builtin_amdgcn_s_sleep(4); }
}
#if PROBE_MULT > 0
#define STAMP(id) do { if (blockIdx.x == PROBE_BID && threadIdx.x == 0) __hip_atomic_store((unsigned long long*)(kargs()->ws + WS_CTL + 131072) + (id), (unsigned long long)__builtin_amdgcn_s_memrealtime(), RLX_AGENT); } while (0)
#else
#define STAMP(id) do {} while (0)
#endif
__global__ void __launch_bounds__(NWAVES * 64, 2) fwd(Args a_unused) {
    extern __shared__ __attribute__((aligned(16))) unsigned char lds_raw[];
    LAS unsigned char* lds = (LAS unsigned char*)lds_raw;
    int stamp_no_ = 1; (void)stamp_no_;
    { const int tid0 = threadIdx.x; for (int u = tid0; u < (LDS_BYTES - LDSCTL_OFF) / 4; u += NWAVES * 64) ((LAS unsigned*)(lds + LDSCTL_OFF))[u] = 0u; }
    __syncthreads();
#if ONE_LAUNCH
    XcdBarrier bar = xcd_barrier_post((unsigned*)(kargs()->ws + WS_CTL) + CW_BAR, (volatile LAS unsigned*)(lds + MISC_OFF) + 8);
#define SEAM() do { STAMP(stamp_no_); ++stamp_no_; xcd_barrier(bar); STAMP(stamp_no_); ++stamp_no_; } while (0)
#else
#define SEAM() do {} while (0)
#endif
#define IN(k) (kargs()->ph_lo <= (k) && (k) < kargs()->ph_hi)
#define BOTH(k) (IN(k) && ((k) + 1) < kargs()->ph_hi)
#define PH_LOCALS KArgs a = kargs(); unsigned char* ws = a->ws; int G = gridDim.x, bid = blockIdx.x; asm volatile("" : "+s"(G), "+s"(bid)); const int tid = tidx(), lane = tid & 63, wave = __builtin_amdgcn_readfirstlane(tid >> 6), gw = bid * NWAVES + wave, NGW = G * NWAVES; (void)ws; (void)lane; (void)gw; (void)NGW;

    if (EN_PRO && IN(PH_PRO)) { _Pragma("unroll 1") for (int rep_ = 0; rep_ < REP_PRO; ++rep_) { if (rep_) SEAM(); PH_LOCALS; ph_prologue(a, lds, wave, lane, gw, NGW, bid * (NWAVES * 64) + tid, G * NWAVES * 64, 0, PRO_I_IN, true); } if (BOTH(PH_PRO)) SEAM(); }

#pragma unroll 1
    for (int l = 0; l < 2; ++l) {
        if (EN_IN && IN(PH_L(l, K_IN))) {
            _Pragma("unroll 1") for (int rep_ = 0; rep_ < REP_IN; ++rep_) { if (rep_) SEAM(); PH_LOCALS;
            pg8::Gemm g{(const pg8::bf16_t*)(ws + WS_XB), (const pg8::bf16_t*)(ws + WS_WIN) + (size_t)l * NIN_PAD * 1024, M, NIN_PAD, 1024}; pg8::StaticOrder S; S.init(M, NIN_PAD, G, bid);
            pg8::EpiHproj E{(pg8::bf16_t*)(ws + WS_R + R_HP), (float*)(ws + WS_GAB)};
            stagger(bid, STAG_IN);
            pg8::gemm_phase<pg8::EpiHproj, pg8::StaticOrder, PG8_ALIGN, PG8_SP2>(lds, g, S, E); }
            if (BOTH(PH_L(l, K_IN))) SEAM();
        }
        if (EN_PREP && IN(PH_L(l, K_PREP))) {
            _Pragma("unroll 1") for (int rep_ = 0; rep_ < REP_PREP; ++rep_) { if (rep_) SEAM(); PH_LOCALS; for (int u = bid; u < 1024; u += G) { if (FAST_PREP) gdn_prep_fast(a, l, u, lds, tid, lane, wave); else gdn_prep_unit(a, l, u, lds, tid, lane, wave); }
              STAMP(136); if (FAST_RET && !KV_IN_SCAN) for (int u = bid; u < 512; u += G) ret_kv_unit(a, u, lds, tid, lane, wave); STAMP(137); }
            if (BOTH(PH_L(l, K_PREP))) SEAM();
        }
        if (EN_SCAN && IN(PH_L(l, K_SCAN))) {
            { PH_LOCALS;
#if GDN_SPLIT
            const int n_items = CONV_N_MOE + (l == 0 ? PRO_NIT - PRO_I_IN : 0), n_ret_hi = (l == 0 ? 128 : 256);
            if (bid < 128) { const int t1 = tidx(), w1 = __builtin_amdgcn_readfirstlane(t1 >> 6); const int bh = (bid & 7) + 8 * (bid >> 5), q = (bid >> 3) & 3;
                             gdn_scan_v3(a, l, bh * 4 + q, lds, t1, t1 & 63, w1); STAMP(100 + 10 * l);
                             for (int u = n_ret_hi + bid; u < 512; u += 128) ret_out_unit(a, u, lds, t1, t1 & 63, w1); }
            else {
                { const int t2 = tidx(), w2 = __builtin_amdgcn_readfirstlane(t2 >> 6); conv_range(kargs(), lds, w2, t2 & 63, l, 0, n_items, (bid - 128) * NWAVES + w2, (G - 128) * NWAVES); STAMP(102 + 10 * l); }
                { const int t1 = tidx(), w1 = __builtin_amdgcn_readfirstlane(t1 >> 6);
                  for (int u = bid - 128; u < n_ret_hi; u += G - 128) ret_out_unit(a, u, lds, t1, t1 & 63, w1); }
                STAMP(101 + 10 * l);
            }
#else
            if (bid < 32) { const int t1 = tidx(), w1 = __builtin_amdgcn_readfirstlane(t1 >> 6); gdn_scan_fast(a, l, bid, lds, t1, t1 & 63, w1); STAMP(100 + 10 * l); }
            else {
                if (GDN_HELPERS && bid < 32 + 32 * GDN_HELPERS) gdn_scan_helper(a, bid & 31, tidx());
                if (KV_IN_SCAN) {
                    { const int t0 = tidx(), w0 = __builtin_amdgcn_readfirstlane(t0 >> 6);
                      for (int u = bid - 32; u < 512; u += G - 32) ret_kv_unit(a, u, lds, t0, t0 & 63, w0); }
                    VM_WAIT(); __syncthreads();
                    if (tidx() == 0) { unsigned* sub = (unsigned*)(kargs()->ws + WS_CTL) + CW_SUB + 64 * (1 + l);
                        __builtin_amdgcn_fence(__ATOMIC_RELEASE, "agent"); VM_WAIT();
                        __hip_atomic_fetch_add(sub, 1u, RLX_AGENT);
                        unsigned sp = 0; while (__hip_atomic_load(sub, RLX_AGENT) < (unsigned)(G - 32) && ++sp < (1u << 22)) __builtin_amdgcn_s_sleep(2);
                        __builtin_amdgcn_fence(__ATOMIC_ACQUIRE, "agent"); VM_WAIT(); }
                    __syncthreads();
                }
                { const int t1 = tidx(), w1 = __builtin_amdgcn_readfirstlane(t1 >> 6);
                  for (int u = bid - 32; u < 512; u += G - 32) ret_out_unit(a, u, lds, t1, t1 & 63, w1); }
                __syncthreads(); STAMP(101 + 10 * l);
                { const int t2 = tidx(), w2 = __builtin_amdgcn_readfirstlane(t2 >> 6);
                  moe_convert(kargs(), lds, w2, t2 & 63, (bid - 32) * NWAVES + w2, (G - 32) * NWAVES, 4 * l, 4 * l + 4);
                  if (l == 0) ph_prologue(kargs(), lds, w2, t2 & 63, (bid - 32) * NWAVES + w2, (G - 32) * NWAVES, 0, 0, PRO_I_IN, PRO_NIT, false); STAMP(102 + 10 * l); }
            }
#endif
            }
            if (BOTH(PH_L(l, K_SCAN))) SEAM();
        }
#if GDN_SPLIT
        if (EN_SCAN && IN(PH_L(l, K_FIN))) {
            { PH_LOCALS; gdn_finalize(a, l, lane, gw, NGW); }
            if (BOTH(PH_L(l, K_FIN))) SEAM();
        }
#endif
        if (EN_OUT && IN(PH_L(l, K_OUT))) {
            _Pragma("unroll 1") for (int rep_ = 0; rep_ < REP_OUT; ++rep_) { if (rep_) SEAM(); PH_LOCALS;
            pg8::Gemm g{(const pg8::bf16_t*)(ws + WS_R + R_OB), (const pg8::bf16_t*)(ws + WS_WO) + (size_t)l * 1024 * 1024, M, 1024, 1024}; pg8::StaticOrder S; S.init(M, 1024, G, bid);
            pg8::EpiBf16Out E{(pg8::bf16_t*)(ws + WS_R + R_MIX), 1024};
            pg8::gemm_phase<pg8::EpiBf16Out, pg8::StaticOrder, PG8_ALIGN, PG8_SP2>(lds, g, S, E); }
            if (BOTH(PH_L(l, K_OUT))) SEAM();
        }
        if (EN_LN1 && IN(PH_L(l, K_LN1))) {
            { PH_LOCALS;
#if RES_BF16
            if (l == 0) ln_rows<false, true>(nullptr, ALPHA, (const bf16*)(ws + WS_R + R_MIX), a->in[7], a->in[8], nullptr, 1.0f, (bf16*)(ws + WS_XB), nullptr, nullptr, nullptr, nullptr, lane, gw, NGW, nullptr, 0, (const bf16*)(ws + WS_XB));
            else { ln_rows<true, true>(nullptr, ALPHA, (const bf16*)(ws + WS_R + R_MIX), a->in[7] + 1024, a->in[8] + 1024, nullptr, ALPHA, (bf16*)(ws + WS_XB), (const float*)(ws + WS_RWT), (unsigned*)(ws + WS_CTL) + CW_MOE, (int*)(ws + WS_LIST), (float*)(ws + WS_GATE), lane, gw, NGW, lds, tid, (const bf16*)(ws + WS_XB));
                 } }
#else
            if (l == 0) ln_rows<false>(a->in[0], ALPHA, (const bf16*)(ws + WS_R + R_MIX), a->in[7], a->in[8], a->out, 1.0f, (bf16*)(ws + WS_XB), nullptr, nullptr, nullptr, nullptr, lane, gw, NGW);
            else { ln_rows<true>(a->out, ALPHA, (const bf16*)(ws + WS_R + R_MIX), a->in[7] + 1024, a->in[8] + 1024, a->out, ALPHA, (bf16*)(ws + WS_XB), (const float*)(ws + WS_RWT), (unsigned*)(ws + WS_CTL) + CW_MOE, (int*)(ws + WS_LIST), (float*)(ws + WS_GATE), lane, gw, NGW, lds, tid);
                 } }
#endif
            if (BOTH(PH_L(l, K_LN1))) SEAM();
        }
        if (l == 0) {
            if (EN_FFN0 && IN(PH_L(0, K_GU))) {
                _Pragma("unroll 1") for (int rep_ = 0; rep_ < REP_GU; ++rep_) { if (rep_) SEAM(); PH_LOCALS;
                pg8::Gemm g{(const pg8::bf16_t*)(ws + WS_XB), (const pg8::bf16_t*)(ws + WS_WGU), M, 2 * FF, 1024}; pg8::StaticOrder S; S.init(M, 2 * FF, G, bid);
                pg8::EpiSwiglu E{(pg8::bf16_t*)(ws + WS_R + R_H), FF, 0};
                stagger(bid, STAG_GU);
                pg8::gemm_phase<pg8::EpiSwiglu, pg8::StaticOrder, PG8_ALIGN, PG8_SP2>(lds, g, S, E); }
                if (BOTH(PH_L(0, K_GU))) SEAM();
            }
            if (EN_FFN0 && IN(PH_L(0, K_DN))) {
                _Pragma("unroll 1") for (int rep_ = 0; rep_ < REP_DN; ++rep_) { if (rep_) SEAM(); PH_LOCALS;
                pg8::Gemm g{(const pg8::bf16_t*)(ws + WS_R + R_H), (const pg8::bf16_t*)(ws + WS_WD), M, 1024, FF}; pg8::StaticOrder S; S.init(M, 1024, G, bid);
                pg8::EpiBf16Out E{(pg8::bf16_t*)(ws + WS_R + R_MIX), 1024};
                pg8::gemm_phase<pg8::EpiBf16Out, pg8::StaticOrder, PG8_ALIGN, PG8_SP2>(lds, g, S, E); }
                if (BOTH(PH_L(0, K_DN))) SEAM();
            }
            if (EN_LN1 && IN(PH_L(0, K_LN2))) {
                { PH_LOCALS;
#if RES_BF16
                ln_rows<false, true>(nullptr, ALPHA, (const bf16*)(ws + WS_R + R_MIX), a->in[9], a->in[10], nullptr, 1.0f, (bf16*)(ws + WS_XB), nullptr, nullptr, nullptr, nullptr, lane, gw, NGW, nullptr, 0, (const bf16*)(ws + WS_XB)); }
#else
                ln_rows<false>(a->out, ALPHA, (const bf16*)(ws + WS_R + R_MIX), a->in[9], a->in[10], a->out, 1.0f, (bf16*)(ws + WS_XB), nullptr, nullptr, nullptr, nullptr, lane, gw, NGW); }
#endif
                if (BOTH(PH_L(0, K_LN2))) SEAM();
            }
        } else {
#pragma unroll 1
            for (int j = 0; j < 2; ++j) {
                const int kg = K_G0 + 3 * j;
                if (EN_MOE && j == 0 && IN(PH_L(1, kg))) { { PH_LOCALS; moe_gather(a, 0, lane, gw, NGW); moe_gather(a, 1, lane, gw, NGW); } if (BOTH(PH_L(1, kg))) SEAM(); }
                if (EN_MOE && IN(PH_L(1, kg + 1))) {
                    { PH_LOCALS;
                    pg8::moe_table(lds, (const unsigned*)(ws + WS_CTL) + CW_MOE, tid);
                    const PG8_LAS int* tab = (const PG8_LAS int*)(lds + pg8::MOE_TAB_OFF);
                    if (j == 1 && bid < 32) {
#pragma unroll 1
                        for (int jj = 0; jj < 2; ++jj) {
                            { pg8::MoeSched<true> S; S.tab = tab; S.j0 = jj; S.a0 = 64 + (bid >> 2); S.c = bid & 3; S.mode = (64 + (bid >> 2)) < pg8::moe_T(lds, jj) ? 1 : 2;
                              S.n0 = S.n1 = S.a1 = S.j1 = 0; S.G = 1;
                              pg8::Gemm g{(const pg8::bf16_t*)(ws + WS_R + R_HM), (const pg8::bf16_t*)(ws + WS_WMD), MOE_ROWS, 1024, FE, 1};
                              pg8::EpiMoeDown E{a->out, (const int*)(ws + WS_LIST), (const float*)(ws + WS_GATE), tab, RES_BF16 ? (const pg8::bf16_t*)(ws + WS_XB) : nullptr};
                              pg8::gemm_phase<pg8::EpiMoeDown, pg8::MoeSched<true>, PG8_ALIGN, PG8_SP2>(lds, g, S, E); }
                            if (jj == 0) {
                                VM_WAIT(); __syncthreads();
                                if (tidx() == 0) { unsigned* sub = (unsigned*)(kargs()->ws + WS_CTL) + CW_SUB;
                                    __builtin_amdgcn_fence(__ATOMIC_RELEASE, "agent"); VM_WAIT();
                                    __hip_atomic_fetch_add(sub, 1u, RLX_AGENT);
                                    unsigned sp = 0; while (__hip_atomic_load(sub, RLX_AGENT) < 32u && ++sp < (1u << 22)) __builtin_amdgcn_s_sleep(2);
                                    __builtin_amdgcn_fence(__ATOMIC_ACQUIRE, "agent"); VM_WAIT(); }
                                __syncthreads();
                            }
                        }
                    } else {
                        pg8::MoeSched<false> S; S.tab = tab; S.mode = 0;
                        const int T0 = pg8::moe_T(lds, 0), T1 = pg8::moe_T(lds, 1);
                        if (j == 0) { S.j0 = 0; S.a0 = 0; S.n0 = T0; S.j1 = 1; S.a1 = 64; S.n1 = T1 > 64 ? T1 - 64 : 0; S.G = G; S.c = bid; }
                        else        { S.j0 = 1; S.a0 = 0; S.n0 = T1 < 64 ? T1 : 64; S.j1 = 1; S.a1 = 0; S.n1 = 0; S.G = G - 32; S.c = bid - 32; }
                        pg8::Gemm g{(const pg8::bf16_t*)(ws + WS_R + R_XG), (const pg8::bf16_t*)(ws + WS_WMGU), MOE_ROWS, 2 * FE, 1024};
                        pg8::EpiSwiglu E{(pg8::bf16_t*)(ws + WS_R + R_HM), FE, 1};
                        stagger(S.c, j == 0 ? STAG_MA : STAG_MC);
                        pg8::gemm_phase<pg8::EpiSwiglu, pg8::MoeSched<false>, PG8_ALIGN, PG8_SP2>(lds, g, S, E);
                    } }
                    if (BOTH(PH_L(1, kg + 1))) SEAM();
                }
                if (EN_MOE && IN(PH_L(1, kg + 2))) {
                    { PH_LOCALS;
                    pg8::moe_table(lds, (const unsigned*)(ws + WS_CTL) + CW_MOE, tid);
                    const PG8_LAS int* tab = (const PG8_LAS int*)(lds + pg8::MOE_TAB_OFF);
                    const int Tj = pg8::moe_T(lds, j);
                    pg8::MoeSched<true> S; S.tab = tab; S.mode = 0; S.j0 = j; S.a0 = 0; S.n0 = Tj < 64 ? Tj : 64; S.j1 = j; S.a1 = 0; S.n1 = 0; S.G = G; S.c = bid;
                    pg8::Gemm g{(const pg8::bf16_t*)(ws + WS_R + R_HM), (const pg8::bf16_t*)(ws + WS_WMD), MOE_ROWS, 1024, FE, 1};
                    pg8::EpiMoeDown E{a->out, (const int*)(ws + WS_LIST), (const float*)(ws + WS_GATE), tab, RES_BF16 ? (const pg8::bf16_t*)(ws + WS_XB) : nullptr};
                    pg8::gemm_phase<pg8::EpiMoeDown, pg8::MoeSched<true>, PG8_ALIGN, PG8_SP2>(lds, g, S, E); }
                    if (BOTH(PH_L(1, kg + 2))) SEAM();
                }
            }
            if (EN_LN1 && IN(PH_L(1, K_LNF))) {
                PH_LOCALS;
                ln_rows<false>(a->out, 1.0f, nullptr, a->in[9] + 1024, a->in[10] + 1024, a->out, 1.0f, nullptr, nullptr, nullptr, nullptr, nullptr, lane, gw, NGW);
            }
        }
    }
    STAMP(stamp_no_);
#if PROBE_MULT > 0
    if (blockIdx.x == PROBE_BID && threadIdx.x == 0) {
        const unsigned long long* ts = (const unsigned long long*)(kargs()->ws + WS_CTL + 131072);
        const unsigned long long ta = __hip_atomic_load(ts + PROBE_A, RLX_AGENT), tb = __hip_atomic_load(ts + PROBE_B, RLX_AGENT);
        const unsigned long long hold = (tb > ta ? tb - ta : 0ull) * (unsigned long long)PROBE_MULT, t0 = __builtin_amdgcn_s_memrealtime();
        while (__builtin_amdgcn_s_memrealtime() - t0 < hold && __builtin_amdgcn_s_memrealtime() - t0 < 2000000ull) __builtin_amdgcn_s_sleep(8);
    }
#endif
#undef IN
#undef BOTH
}

extern "C" void kernel_launch(void* const* d_in, const int* in_sizes, int n_in, void* d_out, int out_size, void* d_ws, size_t ws_size, hipStream_t stream) {
    static int grid = 0;
    if (grid == 0) {
        if (n_in != 18 || in_sizes[0] != M * D || out_size != M * D || ws_size < WS_END) { fprintf(stderr, "kernel_launch: unexpected shapes or workspace (%zu < %zu); nothing launched\n", ws_size, (size_t)WS_END); grid = -1; return; }
        int dev = 0, cus = 0, per_cu = 0;
        if (hipGetDevice(&dev) != hipSuccess || hipDeviceGetAttribute(&cus, hipDeviceAttributeMultiprocessorCount, dev) != hipSuccess) { grid = -1; return; }
        if (hipFuncSetAttribute((const void*)fwd, hipFuncAttributeMaxDynamicSharedMemorySize, LDS_BYTES) != hipSuccess) { fprintf(stderr, "kernel_launch: hipFuncSetAttribute failed\n"); grid = -1; return; }
        if (hipOccupancyMaxActiveBlocksPerMultiprocessor(&per_cu, (const void*)fwd, NWAVES * 64, LDS_BYTES) != hipSuccess || per_cu < 1) fprintf(stderr, "kernel_launch: occupancy query reports %d\n", per_cu);
        (void)hipGetLastError();
        grid = cus;
    }
    if (grid < 0) return;
    if (hipMemsetAsync((char*)d_ws + WS_CTL, 0, CTL_BYTES, stream) != hipSuccess) return;
    Args a{};
    for (int i = 0; i < 18; ++i) a.in[i] = (const float*)d_in[i];
    a.out = (float*)d_out; a.ws = (unsigned char*)d_ws;
#if ONE_LAUNCH
    a.ph_lo = 0; a.ph_hi = PH_END;
    hipLaunchKernelGGL(fwd, dim3(grid), dim3(NWAVES * 64), LDS_BYTES, stream, a);
#else
    static const int phases[] = {PH_PRO,
        PH_L(0, K_IN), PH_L(0, K_PREP), PH_L(0, K_SCAN), PH_L(0, K_OUT), PH_L(0, K_LN1), PH_L(0, K_GU), PH_L(0, K_DN), PH_L(0, K_LN2),
        PH_L(1, K_IN), PH_L(1, K_PREP), PH_L(1, K_SCAN), PH_L(1, K_OUT), PH_L(1, K_LN1),
        PH_L(1, K_G0), PH_L(1, K_GU0), PH_L(1, K_DN0), PH_L(1, K_G1), PH_L(1, K_GU1), PH_L(1, K_DN1), PH_L(1, K_LNF)};
    for (unsigned i = 0; i < sizeof(phases) / sizeof(phases[0]); ++i) {
        a.ph_lo = phases[i]; a.ph_hi = phases[i] + 1;
        hipLaunchKernelGGL(fwd, dim3(grid), dim3(NWAVES * 64), LDS_BYTES, stream, a);
    }
#endif
}
```

```cpp
#define GDN_F8 1
#include <hip/hip_runtime.h>
#include <cstdio>
#include <cstdint>

#ifndef ONE_LAUNCH
#define ONE_LAUNCH 1
#endif

#define GAS __attribute__((address_space(1)))
#define LAS __attribute__((address_space(3)))
typedef unsigned short bf16;
typedef unsigned v4u __attribute__((ext_vector_type(4)));
typedef unsigned v2u __attribute__((ext_vector_type(2)));
typedef float f32x4 __attribute__((ext_vector_type(4)));
typedef float f32x2 __attribute__((ext_vector_type(2)));
#define RLX_AGENT __ATOMIC_RELAXED, __HIP_MEMORY_SCOPE_AGENT
#define LDS_WAIT() asm volatile("s_waitcnt lgkmcnt(0)" ::: "memory")
#define VM_WAIT() asm volatile("s_waitcnt vmcnt(0)" ::: "memory")

__device__ __forceinline__ unsigned f2bf(float f) { unsigned u = __builtin_bit_cast(unsigned, f); return (u + 0x7fffu + ((u >> 16) & 1u)) >> 16; }
__device__ __forceinline__ unsigned pk2(float lo, float hi) { return f2bf(lo) | (f2bf(hi) << 16); }
__device__ __forceinline__ float bf2f(unsigned short u) { return __builtin_bit_cast(float, (unsigned)u << 16); }
__device__ __forceinline__ float bflo(unsigned u) { return __builtin_bit_cast(float, u << 16); }
__device__ __forceinline__ float bfhi(unsigned u) { return __builtin_bit_cast(float, u & 0xffff0000u); }
__device__ __forceinline__ float siluf(float x) { return x * __builtin_amdgcn_rcpf(1.f + __expf(-x)); }
__device__ __forceinline__ float sigmf(float x) { return 1.f / (1.f + __expf(-x)); }
__device__ __forceinline__ float wave_sum(float v) {
    v += __builtin_bit_cast(float, __builtin_amdgcn_update_dpp(0, __builtin_bit_cast(int, v), 0xB1, 0xF, 0xF, true));
    v += __builtin_bit_cast(float, __builtin_amdgcn_update_dpp(0, __builtin_bit_cast(int, v), 0x4E, 0xF, 0xF, true));
    v += __builtin_bit_cast(float, __builtin_amdgcn_update_dpp(0, __builtin_bit_cast(int, v), 0x141, 0xF, 0xF, true));
    v += __builtin_bit_cast(float, __builtin_amdgcn_update_dpp(0, __builtin_bit_cast(int, v), 0x140, 0xF, 0xF, true));
    v += __builtin_bit_cast(float, __builtin_amdgcn_update_dpp(0, __builtin_bit_cast(int, v), 0x142, 0xA, 0xF, false));
    v += __builtin_bit_cast(float, __builtin_amdgcn_update_dpp(0, __builtin_bit_cast(int, v), 0x143, 0xC, 0xF, false));
    return __builtin_bit_cast(float, __builtin_amdgcn_readlane(__builtin_bit_cast(int, v), 63));
}

constexpr int NWAVES = 8;
constexpr int M = 16384, D = 1024, SEQ = 2048, NB = 8;
constexpr int IN_COLS = 3592, NIN_PAD = 3840, HP_LD = 3584;
constexpr int FF = 2816, FE = 3584, NE = 8;
constexpr int COL_RQ = 0, COL_RK = 256, COL_RV = 512, COL_RG = 1024, COL_GQ = 1536, COL_GK = 2048, COL_GV = 2560, COL_GG = 3072;
constexpr float ALPHA = 1.41421356237f;
constexpr float LN_EPS = 1e-5f, NORM_EPS = 1e-6f;
constexpr int MOE_ROWS = 72 * 256;

__host__ __device__ __forceinline__ int fragoff(int i, int d, int nkt) {
    return ((((i >> 5) * nkt + (d >> 5)) * 2 + ((d >> 4) & 1)) * 512) + ((((d >> 2) & 1) * 32 + (i & 31)) * 8) + ((((d >> 3) & 1) << 2) | (d & 3));
}
__host__ __device__ __forceinline__ int uoff(int i, int e) {
    const int reg = (i & 3) | (((i & 31) >> 3) << 2);
    return (((((e >> 5) * 2 + (i >> 5)) * 2 + (reg >> 3)) * 64 + (((i >> 2) & 1) * 32 + (e & 31))) * 8) + (reg & 7);
}
namespace pg8 {
#define PG8_LAS __attribute__((address_space(3)))
typedef unsigned short bf16_t;
typedef short bf16x8 __attribute__((ext_vector_type(8)));
typedef float f32x4 __attribute__((ext_vector_type(4)));
typedef unsigned u32x4 __attribute__((ext_vector_type(4)));
constexpr int GATHER_TOK_OFF = 131072 + 2048;
constexpr int BM = 256, BK = 64, HALF = 128, HTB = HALF * BK * 2  , STAGE_BYTES = 8 * HTB, NXCD = 8, WGM = 8;

__host__ __device__ __forceinline__ int lds_byte(int r, int c) { const int st = (r >> 4) * 2 + (c >> 5), rr = r & 15, cc = c & 31, ob = rr * 64 + cc * 2; return st * 1024 + (ob ^ (((ob >> 9) & 1) << 5)); }
__host__ __device__ __forceinline__ void stage_rc(int b, int& R, int& C) { const int st = b / 1024, sb = b % 1024, swz = sb ^ (((sb >> 9) & 1) << 5); R = (st >> 1) * 16 + swz / 64; C = (st & 1) * 32 + (swz % 64) / 2; }
__host__ __device__ __forceinline__ int perm32(int rho) { const int n = rho >> 4, i = rho & 15; return 8 * (i >> 2) + 4 * n + (i & 3); }

struct Unit { int pm, pn, aux, am, sel; };
struct Gemm { const bf16_t* A; const bf16_t* Bt; int M, N, K, blk; };

struct StaticOrder {
    int nM, nN, nwg, G, c;
    __host__ __device__ void init(int M, int N, int G_, int c_) { nM = M / BM; nN = N / BM; nwg = nM * nN; G = G_; c = c_; }
    __host__ __device__ bool next(int i, Unit& u) const {
        const long L = (long)i * G + c; if (L >= nwg) return false;
        int wgid = (int)L; { const int q = nwg / NXCD, r = nwg % NXCD, xcd = wgid % NXCD, off = wgid / NXCD; wgid = (xcd < r ? xcd * (q + 1) : r * (q + 1) + (xcd - r) * q) + off; }
        const int nig = WGM * nN, gid = wgid / nig, fm = gid * WGM, gsz = (nM - fm) < WGM ? (nM - fm) : WGM;
        u.pm = fm + ((wgid % nig) % gsz); u.pn = (wgid % nig) / gsz; u.aux = 0; u.am = u.pm; u.sel = 0; return true;
    }
    __device__ __forceinline__ const char* aptr(const Gemm& g, const Unit& u) const { return (const char*)g.A + (size_t)u.pm * ((size_t)BM * g.K * 2); }
    __device__ __forceinline__ const char* bptr(const Gemm& g, const Unit& u) const { return (const char*)g.Bt + (size_t)u.pn * ((size_t)BM * g.K * 2); }
    __device__ __forceinline__ void a_ready(const Unit&) const {}
    __device__ __forceinline__ void done(const Unit&) const {}
    static constexpr bool GATHER = false;
    __device__ __forceinline__ void a_tok(const Unit&, int, int (&)[4]) const {}
    __device__ __forceinline__ const int* a_tok_ptr(const Unit&, int, int) const { return nullptr; }
};

template <class Epi, class Sched, bool ALIGN_EPI = false, bool SP2 = false>
__device__ __forceinline__ void gemm_phase(PG8_LAS unsigned char* lds, const Gemm g, const Sched& S, const Epi& E) {
    int tid = threadIdx.x; asm volatile("" : "+v"(tid)); const int wid = __builtin_amdgcn_readfirstlane(tid >> 6), lane = tid & 63, wr = wid >> 2, wc = wid & 3, fr = lane & 15, fq = lane >> 4;
    const int K = g.K, nt = K / BK;
    unsigned voffA[2], voffB[2];
#pragma unroll
    for (int i = 0; i < 2; ++i) { int R, C; stage_rc(tid * 16 + i * 8192, R, C); const int Rb = Epi::PERM ? ((R & ~31) + perm32(R & 31)) : R;
        voffA[i] = (unsigned)(R * (g.blk ? 64 : K) + C) * 2u; voffB[i] = (unsigned)(Rb * (g.blk ? 64 : K) + C) * 2u; }
    const size_t kstep = g.blk ? (size_t)(256 * 64 * 2) : (size_t)(BK * 2);
    const size_t hstep = g.blk ? (size_t)(HALF * 64 * 2) : (size_t)HALF * K * 2;
    const size_t tstep = 2 * hstep;
    const unsigned ldsw = (unsigned)wid * 1024u;
    const int aoff = lds_byte(wr * 64 + fr, fq * 8), boff = lds_byte(wc * 32 + fr, fq * 8);
    constexpr bool GATHER = Sched::GATHER;
    static_assert(!GATHER || SP2, "GATHER is wired into the SP2 loop only");
    unsigned voffA1[2] = {0u, 0u}; int gR0 = 0, gC = 0; int ntok[4] = {0, 0, 0, 0};
    if constexpr (GATHER) { stage_rc(tid * 16, gR0, gC); }
#define PG8_GOFF(tk) do { voffA[0] = (unsigned)((tk)[0] * K + gC) * 2u; voffA[1] = (unsigned)((tk)[1] * K + gC) * 2u; voffA1[0] = (unsigned)((tk)[2] * K + gC) * 2u; voffA1[1] = (unsigned)((tk)[3] * K + gC) * 2u; } while (0)
#define PG8_STAGE_A(bufoff, gbase, h) do { if constexpr (GATHER) { if (h) PG8_STAGE(bufoff, gbase, voffA1); else PG8_STAGE(bufoff, gbase, voffA); } else PG8_STAGE(bufoff, (gbase) + (h) * hstep, voffA); } while (0)
#define PG8_SA(b, h) (((b) * 2 + (h)) * HTB)
#define PG8_SB(b, h) ((4 + (b) * 2 + (h)) * HTB)
#define PG8_STAGE(bufoff, gbase, voff) do { _Pragma("unroll") for (int _i = 0; _i < 2; ++_i) \
        __builtin_amdgcn_global_load_lds((const unsigned*)((const char*)(gbase) + (voff)[_i]), (PG8_LAS unsigned*)(lds + (bufoff) + ldsw + _i * 8192), 16, 0, 0); } while (0)
#define PG8_LDA(dst, b, h) do { _Pragma("unroll") for (int m = 0; m < 4; ++m) _Pragma("unroll") for (int k = 0; k < 2; ++k) dst[m][k] = *(const PG8_LAS bf16x8*)(lds + PG8_SA(b, h) + aoff + m * 2048 + k * 1024); } while (0)
#define PG8_LDB(dst, b, h) do { _Pragma("unroll") for (int n = 0; n < 2; ++n) _Pragma("unroll") for (int k = 0; k < 2; ++k) dst[n][k] = *(const PG8_LAS bf16x8*)(lds + PG8_SB(b, h) + boff + n * 2048 + k * 1024); } while (0)
#define PG8_MMA(ai, bj, At, Bt) do { __builtin_amdgcn_s_setprio(1); _Pragma("unroll") for (int m = 0; m < 4; ++m) _Pragma("unroll") for (int n = 0; n < 2; ++n) _Pragma("unroll") for (int k = 0; k < 2; ++k) \
        acc[ai][bj][m][n] = __builtin_amdgcn_mfma_f32_16x16x32_bf16(Bt[n][k], At[m][k], acc[ai][bj][m][n], 0, 0, 0); __builtin_amdgcn_s_setprio(0); } while (0)
#define PG8_WAIT_V(n) asm volatile("s_waitcnt vmcnt(" #n ")" ::: "memory")
#define PG8_WAIT_L(n) asm volatile("s_waitcnt lgkmcnt(" #n ")" ::: "memory")
#define PG8_BAR __builtin_amdgcn_s_barrier()
#define PG8_SCHED __builtin_amdgcn_sched_barrier(0)
    Unit cur, nxt; int ui = 0;
    if (!S.next(0, cur)) return;
    f32x4 acc[2][2][4][2];
#pragma unroll
    for (int a = 0; a < 2; ++a)
#pragma unroll
        for (int b = 0; b < 2; ++b)
#pragma unroll
            for (int m = 0; m < 4; ++m)
#pragma unroll
                for (int n = 0; n < 2; ++n) acc[a][b][m][n] = (f32x4){0.f, 0.f, 0.f, 0.f};
    bf16x8 At[4][2], B0[2][2], B1[2][2];
    const char* cA = GATHER ? (const char*)g.A : S.aptr(g, cur); const char* cB = S.bptr(g, cur);
    if constexpr (GATHER) { S.a_tok(cur, gR0, ntok); PG8_GOFF(ntok); }
    S.a_ready(cur);
    if constexpr (SP2) {
        PG8_STAGE(PG8_SB(0, 0), cB, voffB); PG8_STAGE(PG8_SB(0, 1), cB + hstep, voffB); PG8_STAGE_A(PG8_SA(0, 0), cA, 0); PG8_STAGE_A(PG8_SA(0, 1), cA, 1);
        if (wr == 1) PG8_BAR;
        PG8_WAIT_V(2); PG8_BAR;
        PG8_STAGE(PG8_SB(1, 0), cB + kstep, voffB); PG8_STAGE_A(PG8_SA(1, 0), cA + kstep, 0); PG8_STAGE(PG8_SB(1, 1), cB + hstep + kstep, voffB);
        PG8_WAIT_V(6); PG8_BAR;
    } else {
        PG8_STAGE(PG8_SB(0, 0), cB, voffB); PG8_STAGE(PG8_SA(0, 0), cA, voffA); PG8_STAGE(PG8_SB(0, 1), cB + hstep, voffB); PG8_STAGE(PG8_SA(0, 1), cA + hstep, voffA);
        if (wr == 1) PG8_BAR;
        PG8_WAIT_V(4); PG8_BAR;
        PG8_STAGE(PG8_SB(1, 0), cB + kstep, voffB); PG8_STAGE(PG8_SA(1, 0), cA + kstep, voffA); PG8_STAGE(PG8_SB(1, 1), cB + hstep + kstep, voffB);
        PG8_WAIT_V(6); PG8_BAR;
    }
    for (;;) {
        const bool has_next = S.next(ui + 1, nxt);
        const char* nA = GATHER ? cA : (has_next ? S.aptr(g, nxt) : cA); const char* nB = has_next ? S.bptr(g, nxt) : cB;
        if constexpr (GATHER) { if (has_next) {
#pragma unroll
            for (int q = 0; q < 4; ++q) __builtin_amdgcn_global_load_lds((const unsigned*)S.a_tok_ptr(nxt, gR0, q), (PG8_LAS unsigned*)(lds + GATHER_TOK_OFF + wid * 1024 + q * 256), 4, 0, 0); } }
        for (int t = 0; t < nt; t += 2) {
            const bool last = (t == nt - 2);
            const char* a1 = cA + (size_t)(t + 1) * kstep;
            const char* a2 = last ? nA : cA + (size_t)(t + 2) * kstep; const char* b2 = last ? nB : cB + (size_t)(t + 2) * kstep;
            const char* a3 = a2 + kstep; const char* b3 = b2 + kstep;
            if (last && has_next) S.a_ready(nxt);
            if constexpr (SP2) {
            PG8_LDB(B0, 0, 0); PG8_LDB(B1, 0, 1); PG8_SCHED; PG8_LDA(At, 0, 0); PG8_STAGE_A(PG8_SA(1, 1), a1, 1);
            PG8_WAIT_V(8); PG8_WAIT_L(0); PG8_BAR; PG8_MMA(0, 0, At, B0); PG8_MMA(0, 1, At, B1); PG8_BAR; PG8_SCHED;
            if constexpr (GATHER) { if (last && has_next) { unsigned la = (unsigned)(GATHER_TOK_OFF + wid * 1024 + lane * 4); asm volatile("" : "+v"(la));
#pragma unroll
                for (int q = 0; q < 4; ++q) ntok[q] = *(const PG8_LAS int*)(lds + la + q * 256);
                PG8_GOFF(ntok); } }
            PG8_LDA(At, 0, 1); PG8_STAGE(PG8_SB(0, 0), b2, voffB); PG8_STAGE(PG8_SB(0, 1), b2 + hstep, voffB); PG8_STAGE_A(PG8_SA(0, 0), a2, 0);
            PG8_WAIT_V(8); PG8_WAIT_L(0); PG8_BAR; PG8_MMA(1, 0, At, B0); PG8_MMA(1, 1, At, B1); PG8_BAR; PG8_SCHED;
            PG8_LDB(B0, 1, 0); PG8_LDB(B1, 1, 1); PG8_SCHED; PG8_LDA(At, 1, 0); PG8_STAGE_A(PG8_SA(0, 1), a2, 1);
            PG8_WAIT_V(8); PG8_WAIT_L(0); PG8_BAR; PG8_MMA(0, 0, At, B0); PG8_MMA(0, 1, At, B1); PG8_BAR; PG8_SCHED;
            PG8_LDA(At, 1, 1); PG8_STAGE(PG8_SB(1, 0), b3, voffB); PG8_STAGE(PG8_SB(1, 1), b3 + hstep, voffB); PG8_STAGE_A(PG8_SA(1, 0), a3, 0);
            PG8_WAIT_V(8); PG8_WAIT_L(0); PG8_BAR; PG8_MMA(1, 0, At, B0); PG8_MMA(1, 1, At, B1); PG8_BAR; PG8_SCHED;
            } else {
            PG8_LDB(B0, 0, 0); PG8_SCHED; PG8_LDA(At, 0, 0); PG8_STAGE(PG8_SA(1, 1), a1 + hstep, voffA);
            PG8_WAIT_L(8); PG8_BAR; PG8_WAIT_L(0); PG8_MMA(0, 0, At, B0); PG8_BAR; PG8_SCHED;
            PG8_LDB(B1, 0, 1); PG8_STAGE(PG8_SB(0, 0), b2, voffB);
            PG8_BAR; PG8_WAIT_L(0); PG8_MMA(0, 1, At, B1); PG8_BAR;
            PG8_LDA(At, 0, 1); PG8_STAGE(PG8_SA(0, 0), a2, voffA);
            PG8_BAR; PG8_WAIT_L(0); PG8_MMA(1, 0, At, B0); PG8_BAR; PG8_SCHED;
            PG8_STAGE(PG8_SB(0, 1), b2 + hstep, voffB);
            PG8_WAIT_V(6); PG8_BAR; PG8_MMA(1, 1, At, B1); PG8_BAR;
            PG8_LDB(B0, 1, 0); PG8_SCHED; PG8_LDA(At, 1, 0); PG8_STAGE(PG8_SA(0, 1), a2 + hstep, voffA);
            PG8_WAIT_L(8); PG8_BAR; PG8_WAIT_L(0); PG8_MMA(0, 0, At, B0); PG8_BAR; PG8_SCHED;
            PG8_LDB(B1, 1, 1); PG8_STAGE(PG8_SB(1, 0), b3, voffB);
            PG8_BAR; PG8_WAIT_L(0); PG8_MMA(0, 1, At, B1); PG8_BAR;
            PG8_LDA(At, 1, 1); PG8_STAGE(PG8_SA(1, 0), a3, voffA);
            PG8_BAR; PG8_WAIT_L(0); PG8_MMA(1, 0, At, B0); PG8_BAR; PG8_SCHED;
            PG8_STAGE(PG8_SB(1, 1), b3 + hstep, voffB);
            PG8_WAIT_V(6); PG8_BAR; PG8_MMA(1, 1, At, B1); PG8_BAR;
            }
        }
        if constexpr (ALIGN_EPI) { if (wr == 0) PG8_BAR; }
        if constexpr (!Epi::AFTER_DRAIN) { E(acc, cur, wr, wc, fr, fq); S.done(cur); }
        if (!has_next) break;
#pragma unroll
        for (int a = 0; a < 2; ++a)
#pragma unroll
            for (int b = 0; b < 2; ++b)
#pragma unroll
                for (int m = 0; m < 4; ++m)
#pragma unroll
                    for (int n = 0; n < 2; ++n) acc[a][b][m][n] = (f32x4){0.f, 0.f, 0.f, 0.f};
        cur = nxt; cA = nA; cB = nB; ++ui;
        if constexpr (ALIGN_EPI) { if (wr == 1) PG8_BAR; }
    }
    PG8_WAIT_V(0);
    if constexpr (!ALIGN_EPI) { if (wr == 0) PG8_BAR; }
    PG8_BAR;
    if constexpr (Epi::AFTER_DRAIN) { E.fused(acc, cur, wr, wc, fr, fq, lds, wid, lane); S.done(cur); }
#undef PG8_SA
#undef PG8_SB
#undef PG8_STAGE
#undef PG8_STAGE_A
#undef PG8_GOFF
#undef PG8_LDA
#undef PG8_LDB
#undef PG8_MMA
#undef PG8_WAIT_V
#undef PG8_WAIT_L
#undef PG8_BAR
#undef PG8_SCHED
}
}

namespace pg8 {
__device__ __forceinline__ unsigned cvt_pk_bf16(float lo, float hi) { unsigned r; asm volatile("v_cvt_pk_bf16_f32 %0, %1, %2" : "=v"(r) : "v"(lo), "v"(hi)); return r; }

struct EpiHproj {
    static constexpr bool PERM = true, AFTER_DRAIN = false;
    bf16_t* HP; float* GAB;
    __device__ __forceinline__ void operator()(const f32x4 (&acc)[2][2][4][2], const Unit& u, int wr, int wc, int fr, int fq) const {
        const int row0 = u.pm * BM + wr * 64 + fr;
        if (u.pn < 14) {
            const int col0 = u.pn * BM + wc * 32 + 8 * fq;
#pragma unroll
            for (int ai = 0; ai < 2; ++ai)
#pragma unroll
                for (int m = 0; m < 4; ++m) { bf16_t* rowp = HP + (size_t)(row0 + ai * HALF + m * 16) * 3584 + col0;
#pragma unroll
                    for (int bj = 0; bj < 2; ++bj) { const f32x4 v0 = acc[ai][bj][m][0], v1 = acc[ai][bj][m][1];
                        u32x4 w; w.x = cvt_pk_bf16(v0[0], v0[1]); w.y = cvt_pk_bf16(v0[2], v0[3]); w.z = cvt_pk_bf16(v1[0], v1[1]); w.w = cvt_pk_bf16(v1[2], v1[3]);
                        *(u32x4*)(rowp + bj * HALF) = w; } }
        } else if (wc == 0 && fq == 0) {
#pragma unroll
            for (int ai = 0; ai < 2; ++ai)
#pragma unroll
                for (int m = 0; m < 4; ++m) { float* rowp = GAB + (size_t)(row0 + ai * HALF + m * 16) * 8;
                    *(f32x4*)(rowp) = acc[ai][0][m][0]; *(f32x4*)(rowp + 4) = acc[ai][0][m][1]; }
        }
    }
};
struct EpiBf16Out {
    static constexpr bool PERM = true, AFTER_DRAIN = false;
    bf16_t* O; int ldc;
    __device__ __forceinline__ void operator()(const f32x4 (&acc)[2][2][4][2], const Unit& u, int wr, int wc, int fr, int fq) const {
        const int row0 = u.pm * BM + wr * 64 + fr, col0 = u.pn * BM + wc * 32 + 8 * fq;
#pragma unroll
        for (int ai = 0; ai < 2; ++ai)
#pragma unroll
            for (int m = 0; m < 4; ++m) { bf16_t* rowp = O + (size_t)(row0 + ai * HALF + m * 16) * ldc + col0;
#pragma unroll
                for (int bj = 0; bj < 2; ++bj) { const f32x4 v0 = acc[ai][bj][m][0], v1 = acc[ai][bj][m][1];
                    u32x4 w; w.x = cvt_pk_bf16(v0[0], v0[1]); w.y = cvt_pk_bf16(v0[2], v0[3]); w.z = cvt_pk_bf16(v1[0], v1[1]); w.w = cvt_pk_bf16(v1[2], v1[3]);
                    *(u32x4*)(rowp + bj * HALF) = w; } }
    }
};
struct EpiF32 {
    static constexpr bool PERM = false, AFTER_DRAIN = false;
    float* O; int ldc;
    __device__ __forceinline__ void operator()(const f32x4 (&acc)[2][2][4][2], const Unit& u, int wr, int wc, int fr, int fq) const {
        const int row0 = u.pm * BM + wr * 64 + fr, col0 = u.pn * BM + wc * 32 + 4 * fq;
#pragma unroll
        for (int ai = 0; ai < 2; ++ai)
#pragma unroll
            for (int m = 0; m < 4; ++m) { float* rowp = O + (size_t)(row0 + ai * HALF + m * 16) * ldc + col0;
#pragma unroll
                for (int bj = 0; bj < 2; ++bj)
#pragma unroll
                    for (int n = 0; n < 2; ++n) *(f32x4*)(rowp + bj * HALF + n * 16) = acc[ai][bj][m][n]; }
    }
};
struct EpiSwiglu {
    static constexpr bool PERM = true, AFTER_DRAIN = false;
    bf16_t* H; int ldh; int blk;
    __device__ __forceinline__ void operator()(const f32x4 (&acc)[2][2][4][2], const Unit& u, int wr, int wc, int fr, int fq) const {
        const int rt = wr * 64 + fr, col0 = u.pn * HALF + wc * 32 + 8 * fq;
        bf16_t* tb = H + (size_t)u.pm * BM * ldh;
#pragma unroll
        for (int ai = 0; ai < 2; ++ai)
#pragma unroll
            for (int m = 0; m < 4; ++m) { const int r = rt + ai * HALF + m * 16;
                bf16_t* rowp = blk ? tb + (size_t)(col0 >> 6) * (BM * 64) + r * 64 + (col0 & 63) : tb + (size_t)r * ldh + col0;
                float h[8];
#pragma unroll
                for (int n = 0; n < 2; ++n)
#pragma unroll
                    for (int i = 0; i < 4; ++i) { const float gt = acc[ai][0][m][n][i], up = acc[ai][1][m][n][i]; h[n * 4 + i] = gt * up * __builtin_amdgcn_rcpf(1.f + __expf(-gt)); }
                u32x4 w; w.x = cvt_pk_bf16(h[0], h[1]); w.y = cvt_pk_bf16(h[2], h[3]); w.z = cvt_pk_bf16(h[4], h[5]); w.w = cvt_pk_bf16(h[6], h[7]);
                *(u32x4*)(rowp) = w; }
    }
};
constexpr int MOE_TAB_OFF = 131072 + 1024;
__device__ __forceinline__ void moe_table(PG8_LAS unsigned char* lds, const unsigned* cntw, int tid) {
    PG8_LAS int* tab = (PG8_LAS int*)(lds + MOE_TAB_OFF);
    __syncthreads();
    if (tid < 2) { const int j = tid; int t = 0;
        for (int e = 0; e < 8; ++e) { const int c = (int)cntw[64 * (j * 8 + e)]; tab[j * 8 + e] = t; tab[16 + j * 8 + e] = c; t += (c + 255) >> 8; }
        tab[32 + j] = t; }
    __syncthreads();
}
__device__ __forceinline__ int moe_T(PG8_LAS unsigned char* lds, int j) { return __builtin_amdgcn_readfirstlane(((const PG8_LAS int*)(lds + MOE_TAB_OFF))[32 + j]); }
__device__ __forceinline__ int moe_expert(const PG8_LAS int* tab, int j, int t) { int e = 0;
#pragma unroll
    for (int k = 1; k < 8; ++k) e += (t >= tab[j * 8 + k]) ? 1 : 0;
    return __builtin_amdgcn_readfirstlane(e); }
__device__ __forceinline__ int moe_hphys(int j, int t) { return (j == 1 && t >= 64) ? t + 8 : t; }
struct EpiMoeDown {
    static constexpr bool PERM = false, AFTER_DRAIN = false;
    float* XF; const int* list; const float* gate; const PG8_LAS int* tab;
    const bf16_t* XBR = nullptr;
    __device__ __forceinline__ void operator()(const f32x4 (&acc)[2][2][4][2], const Unit& u, int wr, int wc, int fr, int fq) const {
        const int e = u.aux, j = u.sel, c_e = tab[16 + j * 8 + e], t_e = tab[j * 8 + e];
        const int s0 = (u.pm - t_e) * BM + wr * 64 + fr, col0 = u.pn * BM + wc * 32 + 4 * fq;
        const int* lp = list + (size_t)(j * 8 + e) * 16384; const float* gp = gate + (size_t)j * 16384;
        int tok[8]; float gt[8];
#pragma unroll
        for (int q = 0; q < 8; ++q) { const int s = s0 + (q >> 2) * HALF + (q & 3) * 16; tok[q] = (s < c_e) ? lp[s] : -1; }
#pragma unroll
        for (int q = 0; q < 8; ++q) gt[q] = (tok[q] >= 0) ? gp[tok[q]] : 0.f;
#pragma unroll
        for (int ai = 0; ai < 2; ++ai) {
            f32x4 o[4][2][2];
            if (XBR != nullptr && j == 0) {
#pragma unroll
            for (int m = 0; m < 4; ++m) { const bf16_t* rowp = XBR + (size_t)(tok[ai * 4 + m] >= 0 ? tok[ai * 4 + m] : 0) * 1024 + col0;
#pragma unroll
                for (int bj = 0; bj < 2; ++bj)
#pragma unroll
                    for (int n = 0; n < 2; ++n) { const unsigned long long w = *(const unsigned long long*)(rowp + bj * HALF + n * 16); const unsigned lo = (unsigned)w, hi = (unsigned)(w >> 32);
                        o[m][bj][n] = (f32x4){__builtin_bit_cast(float, lo << 16), __builtin_bit_cast(float, lo & 0xffff0000u), __builtin_bit_cast(float, hi << 16), __builtin_bit_cast(float, hi & 0xffff0000u)} * 1.41421356237f; } }
            } else {
#pragma unroll
            for (int m = 0; m < 4; ++m) { const float* rowp = XF + (size_t)(tok[ai * 4 + m] >= 0 ? tok[ai * 4 + m] : 0) * 1024 + col0;
#pragma unroll
                for (int bj = 0; bj < 2; ++bj)
#pragma unroll
                    for (int n = 0; n < 2; ++n) o[m][bj][n] = *(const f32x4*)(rowp + bj * HALF + n * 16); }
            }
#pragma unroll
            for (int m = 0; m < 4; ++m) { if (tok[ai * 4 + m] >= 0) { float* rowp = XF + (size_t)tok[ai * 4 + m] * 1024 + col0; const float g1 = gt[ai * 4 + m];
#pragma unroll
                for (int bj = 0; bj < 2; ++bj)
#pragma unroll
                    for (int n = 0; n < 2; ++n) *(f32x4*)(rowp + bj * HALF + n * 16) = o[m][bj][n] + acc[ai][bj][m][n] * g1; } }
        }
    }
};
#ifndef MOE_DIRECT
#define MOE_DIRECT 1
#endif
template <bool DOWN>
struct MoeSched {
    int mode, n0, a0, j0, n1, a1, j1, G, c; const PG8_LAS int* tab;
    const int* list = nullptr;
    static constexpr int nN = DOWN ? 4 : 28;
    static constexpr bool GATHER = !DOWN && MOE_DIRECT;
    __device__ __forceinline__ const int* a_tok_ptr(const Unit& u, int R0, int q) const {
        const int e = u.aux, j = u.sel, c_e = tab[16 + j * 8 + e], t_e = tab[j * 8 + e];
        int s = (u.am - t_e) * BM + R0 + 64 * q; s = s < c_e ? s : c_e - 1;
        return list + (size_t)(j * 8 + e) * 16384 + s;
    }
    __device__ __forceinline__ void a_tok(const Unit& u, int R0, int (&tok)[4]) const {
#pragma unroll
        for (int q = 0; q < 4; ++q) tok[q] = *a_tok_ptr(u, R0, q);
    }
    __device__ bool next(int i, Unit& u) const {
        int j, t;
        if (mode != 0) { if (i != 0 || mode == 2) return false; j = j0; t = a0; u.pn = c; }
        else {
            const int V = n0 + n1, nwg = V * nN; const long L = (long)i * G + c; if (L >= nwg) return false;
            int wgid = (int)L; { const int q = nwg / NXCD, r = nwg % NXCD, xcd = wgid % NXCD, off = wgid / NXCD; wgid = (xcd < r ? xcd * (q + 1) : r * (q + 1) + (xcd - r) * q) + off; }
            const int nig = WGM * nN, gid = wgid / nig, fm = gid * WGM, gsz = (V - fm) < WGM ? (V - fm) : WGM;
            const int vm = fm + ((wgid % nig) % gsz); u.pn = (wgid % nig) / gsz;
            if (vm < n0) { j = j0; t = a0 + vm; } else { j = j1; t = a1 + (vm - n0); }
        }
        u.aux = moe_expert(tab, j, t); u.sel = j;
        if (DOWN) { u.pm = t; u.am = moe_hphys(j, t); } else { u.pm = moe_hphys(j, t); u.am = t; }
        return true;
    }
    __device__ __forceinline__ const char* aptr(const Gemm& g, const Unit& u) const { return (const char*)g.A + (DOWN ? (size_t)0 : (size_t)u.sel * (size_t)(36u << 20)) + (size_t)u.am * ((size_t)BM * g.K * 2); }
    __device__ __forceinline__ const char* bptr(const Gemm& g, const Unit& u) const { return (const char*)g.Bt + (size_t)u.aux * ((size_t)g.N * g.K * 2) + (size_t)u.pn * ((size_t)BM * g.K * 2); }
    __device__ __forceinline__ void a_ready(const Unit&) const {}
    __device__ __forceinline__ void done(const Unit&) const {}
};
}
#ifndef PG8_SP2
#define PG8_SP2 true
#endif
#ifndef PG8_ALIGN
#define PG8_ALIGN true
#endif

constexpr size_t MiB = 1u << 20;
constexpr size_t WS_CTL = 0, CTL_BYTES = 256 * 1024;
constexpr size_t WS_ROPE = 256 * 1024;
constexpr size_t WS_WIN = 1 * MiB;
constexpr size_t WS_WO = 16 * MiB;
constexpr size_t WS_WGU = 20 * MiB;
constexpr size_t WS_WD = 31 * MiB;
constexpr size_t WS_XB = 37 * MiB;
constexpr size_t WS_GAB = 69 * MiB;
constexpr size_t WS_LIST = WS_GAB + 512 * 1024;
constexpr size_t WS_GATE = WS_LIST + 1 * MiB;
constexpr size_t WS_CD = WS_GATE + 128 * 1024;
constexpr size_t WS_RWT = WS_CD + 8 * 1024;
constexpr size_t WS_WMGU = 71 * MiB, WS_WMD = 183 * MiB;
constexpr size_t WS_R = 239 * MiB;
#ifndef GDN_F8
#define GDN_F8 0
#endif
#if GDN_F8
#define RES_BF16 1
constexpr size_t R_HP = 0, R_OB = 112 * MiB, R_U = 144 * MiB, R_WN = 160 * MiB, R_QD = 168 * MiB, R_KDT = 176 * MiB, R_QK = 184 * MiB;
constexpr size_t WS_KV = WS_R + 192 * MiB;
constexpr size_t WS_SSQ = WS_R + 208 * MiB;
#else
#define RES_BF16 0
constexpr size_t R_HP = 0, R_OB = 112 * MiB, R_U = 144 * MiB, R_WN = 160 * MiB, R_QD = 176 * MiB, R_KDT = 192 * MiB, R_QK = 208 * MiB;
constexpr size_t WS_SSQ = WS_XB + 16 * MiB;
constexpr size_t WS_KV = WS_XB;
#endif
constexpr size_t R_MIX = 0, R_H = 64 * MiB;
constexpr size_t R_HM = 0, R_XG = 140 * MiB, XG_PASS = 36 * MiB;
constexpr size_t WS_END = WS_R + 216 * MiB;
constexpr int CW_TMO = 0, CW_BAR = 4096, CW_MOE = 16384, CW_WQ = 24576, CW_SUB = 28672;

constexpr int RING_BYTES = 131072, LDS_BYTES = 147456, LDSCTL_OFF = LDS_BYTES - 512, MISC_OFF = LDSCTL_OFF + 320;

constexpr int PH_PRO = 0;
constexpr int PH_L(int l, int k) { return 1 + 16 * l + k; }
constexpr int K_IN = 0, K_PREP = 1, K_SCAN = 2, K_OUT = 3, K_LN1 = 4, K_GU = 5, K_DN = 6, K_LN2 = 7;
constexpr int K_FIN = 12;
constexpr int K_G0 = 5, K_GU0 = 6, K_DN0 = 7, K_G1 = 8, K_GU1 = 9, K_DN1 = 10, K_LNF = 11;
constexpr int PH_END = 1 + 16 * 2;

struct Args { const float* in[18]; float* out; unsigned char* ws; int ph_lo, ph_hi; };
typedef const __attribute__((address_space(4))) Args* KArgs;
__device__ __forceinline__ KArgs kargs() { KArgs p = (KArgs)__builtin_amdgcn_kernarg_segment_ptr(); asm volatile("" : "+s"(p)); return p; }
__device__ __forceinline__ int tidx() { int t = threadIdx.x; asm volatile("" : "+v"(t)); return t; }

constexpr int TR_SCR = 64 * 65 * 4;
__device__ __forceinline__ void tr_item(const float* W, int N, int k0, int n0, bf16* WT, size_t ldk, int dst_row0, LAS float* scr, int lane, bool blk = false) {
    const int nq = 4 * (lane & 15), n = n0 + nq, kr = lane >> 4;
    f32x4 v[16];
#pragma unroll
    for (int i = 0; i < 16; ++i) v[i] = (n < N) ? *(const f32x4*)(W + (size_t)(k0 + 4 * i + kr) * N + n) : (f32x4){0.f, 0.f, 0.f, 0.f};
#pragma unroll
    for (int i = 0; i < 16; ++i) { LAS float* d = scr + (4 * i + kr) * 65 + nq; d[0] = v[i].x; d[1] = v[i].y; d[2] = v[i].z; d[3] = v[i].w; }
    LDS_WAIT(); asm volatile("" ::: "memory");
    const int c = lane & 7;
#pragma unroll
    for (int j = 0; j < 8; ++j) { const int nn = (lane >> 3) + 8 * j; const LAS float* s = scr + (8 * c) * 65 + nn;
        v4u o; o.x = pk2(s[0 * 65], s[1 * 65]); o.y = pk2(s[2 * 65], s[3 * 65]); o.z = pk2(s[4 * 65], s[5 * 65]); o.w = pk2(s[6 * 65], s[7 * 65]);
        const int dr = dst_row0 + nn;
        bf16* dp = blk ? WT + ((size_t)(dr >> 8) * (ldk >> 6) + (k0 >> 6)) * (256 * 64) + (dr & 255) * 64 + 8 * c : WT + (size_t)dr * ldk + k0 + 8 * c;
        *(v4u*)dp = o; }
    LDS_WAIT(); asm volatile("" ::: "memory");
}

constexpr int PRO_I_IN = 16 * 57, PRO_NIT = 2 * (16 * 57 + 16 * 16) + 2 * (16 * 44) + 44 * 16;
__device__ __forceinline__ void ph_prologue(KArgs a, LAS unsigned char* lds, int wave, int lane, int gw, int NGW, int gtid, int NT, int it_lo, int it_hi, bool misc) {
    unsigned char* ws = a->ws;
    LAS float* scr = (LAS float*)(lds + wave * TR_SCR);
    constexpr int I_IN = 16 * 57, I_O = 16 * 16, I_L = I_IN + I_O, I_G = 16 * 44, I_D = 44 * 16, NIT = 2 * I_L + 2 * I_G + I_D;
    static_assert(NIT == PRO_NIT && I_IN == PRO_I_IN, "prologue item counts");
    for (int it = it_lo + gw; it < it_hi; it += NGW) {
        int r = it;
        if (r < 2 * I_L) { const int l = r / I_L; r -= l * I_L;
            if (r < I_IN) { const int kb = r / 57, nb = r % 57; tr_item(a->in[1] + (size_t)l * 1024 * IN_COLS, IN_COLS, 64 * kb, 64 * nb, (bf16*)(ws + WS_WIN) + (size_t)l * NIN_PAD * 1024, 1024, 64 * nb, scr, lane); }
            else { r -= I_IN; const int kb = r / 16, nb = r % 16; tr_item(a->in[6] + (size_t)l * 1024 * 1024, 1024, 64 * kb, 64 * nb, (bf16*)(ws + WS_WO) + (size_t)l * 1024 * 1024, 1024, 64 * nb, scr, lane); }
            continue; }
        r -= 2 * I_L;
        if (r < 2 * I_G) { const int up = r / I_G; r -= up * I_G; const int kb = r / 44, nb = r % 44, n0 = 64 * nb;
            tr_item(up ? a->in[12] : a->in[11], FF, 64 * kb, n0, (bf16*)(ws + WS_WGU), 1024, 256 * (n0 >> 7) + (n0 & 127) + 128 * up, scr, lane); continue; }
        r -= 2 * I_G;
        { const int kb = r / 16, nb = r % 16; tr_item(a->in[13], 1024, 64 * kb, 64 * nb, (bf16*)(ws + WS_WD), FF, 64 * nb, scr, lane); }
    }
    if (!misc) return;
    for (int i = gtid; i < 2 * 192 * 128; i += NT) { const int l = i / (192 * 128), r = i % (192 * 128);
        ((v4u*)((bf16*)(ws + WS_WIN) + (size_t)l * NIN_PAD * 1024 + (size_t)3648 * 1024))[r] = (v4u){0u, 0u, 0u, 0u}; }
    for (int i = gtid; i < M * D / 8; i += NT) { const f32x4 p = ((const f32x4*)a->in[0])[2 * i], q = ((const f32x4*)a->in[0])[2 * i + 1];
        v4u o; o.x = pk2(p.x, p.y); o.y = pk2(p.z, p.w); o.z = pk2(q.x, q.y); o.w = pk2(q.z, q.w); ((v4u*)(ws + WS_XB))[i] = o; }
    for (int i = gtid; i < 8192; i += NT) ((float*)(ws + WS_RWT))[(i & 7) * 1024 + (i >> 3)] = a->in[14][i];
    for (int i = gtid; i < SEQ * 32; i += NT) { const int pos = i >> 5, k = i & 31;
        const float inv = powf(10000.0f, -(float)(2 * k) / 64.0f); const float ang = (float)pos * inv;
        double rev = (double)ang * 0.15915494309189535; rev -= floor(rev); const float rf = (float)rev;
        float* R = (float*)(ws + WS_ROPE) + (size_t)pos * 64; R[k] = __builtin_amdgcn_cosf(rf); R[32 + k] = __builtin_amdgcn_sinf(rf); }
}

__device__ __forceinline__ void moe_convert(KArgs a, LAS unsigned char* lds, int wave, int lane, int gw, int NGW, int e_lo, int e_hi, int item = -1) {
    unsigned char* ws = a->ws;
    LAS float* scr = (LAS float*)(lds + wave * TR_SCR);
    constexpr int I_G = 16 * 56, I_D = 56 * 16, I_E = 2 * I_G + I_D;
    for (int it = (item >= 0 ? item : e_lo * I_E + gw); it < (item >= 0 ? item + 1 : e_hi * I_E); it += NGW) {
        const int e = it / I_E; int r = it - e * I_E;
        if (r < 2 * I_G) { const int up = r / I_G; r -= up * I_G; const int kb = r / 56, nb = r % 56, n0 = 64 * nb;
            tr_item((up ? a->in[16] : a->in[15]) + (size_t)e * 1024 * FE, FE, 64 * kb, n0, (bf16*)(ws + WS_WMGU) + (size_t)e * 7168 * 1024, 1024, 256 * (n0 >> 7) + (n0 & 127) + 128 * up, scr, lane); }
        else { r -= 2 * I_G; const int kb = r / 16, nb = r % 16; tr_item(a->in[17] + (size_t)e * FE * 1024, 1024, 64 * kb, 64 * nb, (bf16*)(ws + WS_WMD) + (size_t)e * 1024 * FE, FE, 64 * nb, scr, lane, true); }
    }
}

__device__ __forceinline__ void conv_queue(KArgs a, LAS unsigned char* lds, int wave, int lane, int l) {
    unsigned char* ws = a->ws;
    LAS float* scr = (LAS float*)(lds + wave * TR_SCR);
    unsigned* head = (unsigned*)(ws + WS_CTL) + CW_WQ + 64 * l;
    constexpr int I_G = 16 * 56, I_D = 56 * 16, I_E = 2 * I_G + I_D;
    const int e_lo = (l == 0 ? 0 : 3), n_moe = (l == 0 ? 3 : 5) * I_E, n_all = n_moe + (l == 0 ? PRO_NIT - PRO_I_IN : 0);
    for (;;) {
        unsigned it0 = 0; if (lane == 0) it0 = __hip_atomic_fetch_add(head, 8u, RLX_AGENT);
        it0 = __builtin_amdgcn_readfirstlane(it0);
        if ((int)it0 >= n_all) break;
#pragma unroll 1
        for (int k = 0; k < 8; ++k) { const int it = (int)it0 + k; if (it >= n_all) break;
            if (it < n_moe) moe_convert(a, lds, wave, lane, 0, 1 << 30, 0, 0, e_lo * I_E + it);
            else ph_prologue(a, lds, wave, lane, 0, 1 << 30, 0, 0, PRO_I_IN + (it - n_moe), PRO_I_IN + (it - n_moe) + 1, false); }
    }
}

__device__ __forceinline__ void conv_range(KArgs a, LAS unsigned char* lds, int wave, int lane, int l, int lo, int hi, int gw, int NGW) {
    constexpr int I_G = 16 * 56, I_D = 56 * 16, I_E = 2 * I_G + I_D;
    const int n_moe = 4 * I_E;
    for (int it = lo + gw; it < hi; it += NGW) {
        if (it < n_moe) moe_convert(a, lds, wave, lane, 0, 1 << 30, 0, 0, 4 * l * I_E + it);
        else ph_prologue(a, lds, wave, lane, 0, 1 << 30, 0, 0, PRO_I_IN + (it - n_moe), PRO_I_IN + (it - n_moe) + 1, false);
    }
}
constexpr int CONV_N_MOE = 4 * (2 * 16 * 56 + 56 * 16);

template <bool ROUTE, bool RESB = false>
__device__ __forceinline__ void ln_rows(const float* res, float ares, const bf16* mix, const float* g, const float* bta, float* xf, float oscale, bf16* xb,
                                        const float* router, unsigned* cntw, int* list, float* gate, int lane, int gw, int NGW, LAS unsigned char* lds = nullptr, int tid = 0, const bf16* resb = nullptr) {
    LAS unsigned* lcnt = (LAS unsigned*)lds; LAS unsigned* lbase = lcnt + 16; LAS unsigned* rec = lcnt + 32;
    int nrec = 0;
    if (ROUTE) { __syncthreads(); if (tid < 16) lcnt[tid] = 0u; __syncthreads(); }
    f32x4 gv[4], bv[4];
#pragma unroll
    for (int j = 0; j < 4; ++j) { gv[j] = ((const f32x4*)g)[lane + 64 * j]; bv[j] = ((const f32x4*)bta)[lane + 64 * j]; }
    f32x4 rn[4]; v2u mn[4], rb[4];
#define LN_FETCH(r_) do { if (RESB) { const v2u* rr_ = (const v2u*)(resb + (size_t)(r_) * D) + lane; _Pragma("unroll") for (int j = 0; j < 4; ++j) rb[j] = rr_[64 * j]; } \
        else { const f32x4* rr_ = (const f32x4*)(res + (size_t)(r_) * D) + lane; _Pragma("unroll") for (int j = 0; j < 4; ++j) rn[j] = rr_[64 * j]; } \
        if (mix) { const v2u* mr_ = (const v2u*)(mix + (size_t)(r_) * D) + lane; _Pragma("unroll") for (int j = 0; j < 4; ++j) mn[j] = mr_[64 * j]; } } while (0)
#pragma unroll
    for (int j = 0; j < 4; ++j) { rn[j] = (f32x4){0.f, 0.f, 0.f, 0.f}; mn[j] = (v2u){0u, 0u}; rb[j] = (v2u){0u, 0u}; }
    if (gw < M) LN_FETCH(gw);
    for (int row = gw; row < M; row += NGW) {
        f32x4 v[4]; float s = 0.f;
#pragma unroll
        for (int j = 0; j < 4; ++j) { if (RESB) rn[j] = (f32x4){bflo(rb[j].x), bfhi(rb[j].x), bflo(rb[j].y), bfhi(rb[j].y)}; v[j] = rn[j] * ares; if (mix) v[j] = v[j] + (f32x4){bflo(mn[j].x), bfhi(mn[j].x), bflo(mn[j].y), bfhi(mn[j].y)}; }
        if (row + NGW < M) LN_FETCH(row + NGW);
#pragma unroll
        for (int j = 0; j < 4; ++j) s += (v[j].x + v[j].y) + (v[j].z + v[j].w);
        const float mean = wave_sum(s) * (1.f / D); float s2 = 0.f;
#pragma unroll
        for (int j = 0; j < 4; ++j) { v[j] = v[j] - mean; s2 += (v[j].x * v[j].x + v[j].y * v[j].y) + (v[j].z * v[j].z + v[j].w * v[j].w); }
        const float rstd = 1.f / sqrtf(wave_sum(s2) * (1.f / D) + LN_EPS);
#pragma unroll
        for (int j = 0; j < 4; ++j) v[j] = v[j] * rstd * gv[j] + bv[j];
        if (xf) { f32x4* xo = (f32x4*)(xf + (size_t)row * D) + lane;
#pragma unroll
            for (int j = 0; j < 4; ++j) xo[64 * j] = v[j] * oscale; }
        if (xb) { v2u* bo = (v2u*)(xb + (size_t)row * D) + lane;
#pragma unroll
            for (int j = 0; j < 4; ++j) { v2u o; o.x = pk2(v[j].x, v[j].y); o.y = pk2(v[j].z, v[j].w); bo[64 * j] = o; } }
        if (ROUTE) {
            float lg[8];
#pragma unroll
            for (int e = 0; e < 8; ++e) lg[e] = 0.f;
#pragma unroll
            for (int e = 0; e < 8; ++e)
#pragma unroll
                for (int j = 0; j < 4; ++j) { const f32x4 r4 = ((const f32x4*)(router + e * 1024))[lane + 64 * j]; lg[e] += (v[j].x * r4.x + v[j].y * r4.y) + (v[j].z * r4.z + v[j].w * r4.w); }
#pragma unroll
            for (int e = 0; e < 8; ++e) lg[e] = wave_sum(lg[e]);
            if (lane == 0) {
                int e0 = 0; float v0 = lg[0];
#pragma unroll
                for (int e = 1; e < 8; ++e) if (lg[e] > v0) { v0 = lg[e]; e0 = e; }
                int e1 = -1; float v1 = -3.0e38f;
#pragma unroll
                for (int e = 0; e < 8; ++e) if (e != e0 && lg[e] > v1) { v1 = lg[e]; e1 = e; }
                const float p1 = __expf(v1 - v0), g0 = 1.f / (1.f + p1), g1 = p1 / (1.f + p1);
                const int wv = (int)(tid >> 6), k = nrec++;
                const unsigned l0 = __hip_atomic_fetch_add(lcnt + e0, 1u, __ATOMIC_RELAXED, __HIP_MEMORY_SCOPE_WORKGROUP), l1 = __hip_atomic_fetch_add(lcnt + 8 + e1, 1u, __ATOMIC_RELAXED, __HIP_MEMORY_SCOPE_WORKGROUP);
                rec[(wv * 16 + k) * 4 + 0] = (unsigned)row; rec[(wv * 16 + k) * 4 + 1] = (unsigned)e0 | ((unsigned)e1 << 8); rec[(wv * 16 + k) * 4 + 2] = l0; rec[(wv * 16 + k) * 4 + 3] = l1;
                gate[row] = g0; gate[16384 + row] = g1;
            }
        }
    }
    if (ROUTE) {
        __syncthreads();
        if (tid < 16) { const unsigned c = lcnt[tid]; lbase[tid] = c ? __hip_atomic_fetch_add(cntw + 64 * tid, c, RLX_AGENT) : 0u; }
        __syncthreads();
        if (lane == 0) { const int wv = (int)(tid >> 6);
            for (int k = 0; k < nrec; ++k) { const unsigned row = rec[(wv * 16 + k) * 4], ee = rec[(wv * 16 + k) * 4 + 1], l0 = rec[(wv * 16 + k) * 4 + 2], l1 = rec[(wv * 16 + k) * 4 + 3];
                const unsigned e0 = ee & 255u, e1 = ee >> 8;
                list[(size_t)e0 * 16384 + lbase[e0] + l0] = (int)row; list[(size_t)(8 + e1) * 16384 + lbase[8 + e1] + l1] = (int)row; } }
    }
}

__device__ __forceinline__ void moe_gather(KArgs a, int j, int lane, int gw, int NGW) {
    unsigned char* ws = a->ws; const unsigned* cntw = (const unsigned*)(ws + WS_CTL) + CW_MOE + 64 * (j * 8);
    int pre[8], cum[8]; { int p = 0, t = 0;
#pragma unroll
        for (int e = 0; e < 8; ++e) { const int c = (int)cntw[64 * e]; pre[e] = p; cum[e] = t; p += c; t += (c + 255) >> 8; } }
    const int* list = (const int*)(ws + WS_LIST) + (size_t)j * 8 * 16384;
    for (int r0 = gw; r0 < M; r0 += 8 * NGW) {
        int tok[8], drow[8];
#pragma unroll
        for (int q = 0; q < 8; ++q) { const int r = r0 + q * NGW; tok[q] = -1; drow[q] = 0;
            if (r < M) { int e = 0;
#pragma unroll
                for (int k = 1; k < 8; ++k) e += (r >= pre[k]) ? 1 : 0;
                int pe = 0, ce = 0;
#pragma unroll
                for (int k = 0; k < 8; ++k) if (k == e) { pe = pre[k]; ce = cum[k]; }
                const int s = r - pe; tok[q] = list[(size_t)e * 16384 + s]; drow[q] = ce * 256 + s; } }
        v4u x0[8], x1[8];
#pragma unroll
        for (int q = 0; q < 8; ++q) { const v4u* src = (const v4u*)((const bf16*)(ws + WS_XB) + (size_t)(tok[q] >= 0 ? tok[q] : 0) * 1024); x0[q] = src[lane]; x1[q] = src[lane + 64]; }
#pragma unroll
        for (int q = 0; q < 8; ++q) if (tok[q] >= 0) { v4u* dst = (v4u*)((bf16*)(ws + WS_R + R_XG + (size_t)j * XG_PASS) + (size_t)drow[q] * 1024); dst[lane] = x0[q]; dst[lane + 64] = x1[q]; }
    }
}

__device__ __forceinline__ void gdn_prep_unit(KArgs a, int l, int unit, LAS unsigned char* lds, int tid, int lane, int wave) {
    unsigned char* ws = a->ws;
    const int n = unit & 31, bh = unit >> 5, h = bh & 3, b = bh >> 2;
    const int t0 = b * SEQ + n * 64;
    LAS float* Q = (LAS float*)lds; LAS float* K = Q + 8192; LAS float* V = K + 8192; LAS float* A = V + 8192; LAS float* gc = A + 4096; LAS float* bt = gc + 64;
    const bf16* HP = (const bf16*)(ws + WS_R + R_HP);
    const float* cw = a->in[2] + (size_t)l * 4 * 1536;
    __syncthreads();
    for (int idx = tid; idx < 64 * 384; idx += 512) { const int i = idx / 384, c = idx % 384, which = c >> 7, d = c & 127;
        const int col = COL_GQ + which * 512 + h * 128 + d, cc = which * 512 + h * 128 + d; float acc = 0.f;
#pragma unroll
        for (int j = 0; j < 4; ++j) { const int s = n * 64 + i - 3 + j; if (s >= 0) acc += cw[j * 1536 + cc] * bf2f(HP[(size_t)(b * SEQ + s) * HP_LD + col]); }
        const float y = siluf(acc); LAS float* dst = which == 0 ? Q : (which == 1 ? K : V); dst[i * 128 + d] = y; }
    if (tid < 64) { const float* gab = (const float*)(ws + WS_GAB) + (size_t)(t0 + tid) * 8; const float x = gab[h] + a->in[4][l * 4 + h];
        const float sp = fmaxf(x, 0.f) + log1pf(__expf(-fabsf(x))); gc[tid] = -__expf(a->in[3][l * 4 + h]) * sp; bt[tid] = sigmf(gab[4 + h]); }
    __syncthreads();
#pragma unroll 1
    for (int r = 0; r < 8; ++r) { const int i = wave * 8 + r;
        float q0 = Q[i * 128 + lane], q1 = Q[i * 128 + lane + 64], k0 = K[i * 128 + lane], k1 = K[i * 128 + lane + 64];
        const float sq = wave_sum(q0 * q0 + q1 * q1), sk = wave_sum(k0 * k0 + k1 * k1);
        const float fq = rsqrtf(sq + NORM_EPS) * 0.08838834764831845f, fk = rsqrtf(sk + NORM_EPS);
        Q[i * 128 + lane] = q0 * fq; Q[i * 128 + lane + 64] = q1 * fq; K[i * 128 + lane] = k0 * fk; K[i * 128 + lane + 64] = k1 * fk; }
    if (tid == 0) { float c = 0.f; for (int i = 0; i < 64; ++i) { c += gc[i]; gc[i] = c; } }
    __syncthreads();
    bf16* QKg = (bf16*)(ws + WS_R + R_QK) + (size_t)unit * 4096; bf16* QDg = (bf16*)(ws + WS_R + R_QD) + (size_t)unit * 8192; bf16* KDTg = (bf16*)(ws + WS_R + R_KDT) + (size_t)unit * 8192;
    bf16* WNg = (bf16*)(ws + WS_R + R_WN) + (size_t)unit * 8192; bf16* Ug = (bf16*)(ws + WS_R + R_U) + (size_t)unit * 8192;
    for (int idx = tid; idx < 4096; idx += 512) { const int i = idx >> 6, j = idx & 63; float dqk = 0.f, dkk = 0.f;
        for (int dd = 0; dd < 128; ++dd) { const int d = (dd + j) & 127; const float kj = K[j * 128 + d]; dqk += Q[i * 128 + d] * kj; dkk += K[i * 128 + d] * kj; }
        const float dec = __expf(gc[i] - gc[j]);
        A[i * 64 + j] = (j < i) ? bt[i] * dkk * dec : 0.f;
        QKg[fragoff(i, j, 2)] = (bf16)f2bf((j <= i) ? dqk * dec : 0.f); }
    const float gl = gc[63];
    for (int idx = tid; idx < 8192; idx += 512) { const int i = idx >> 7, d = idx & 127;
        QDg[fragoff(i, d, 4)] = (bf16)f2bf(Q[i * 128 + d] * __expf(gc[i]));
        KDTg[fragoff(d, i, 2)] = (bf16)f2bf(K[i * 128 + d] * __expf(gl - gc[i])); }
    if (tid == 0) ((float*)(ws + WS_CD))[unit] = __expf(gl);
    __syncthreads();
    for (int idx = tid; idx < 8192; idx += 512) { const int i = idx >> 7; const float bi = bt[i]; V[idx] *= bi; Q[idx] = bi * __expf(gc[i]) * K[idx]; }
    __syncthreads();
    if (tid < 256) { LAS float* buf = (tid < 128 ? V : Q) + (tid & 127);
        for (int i = 1; i < 64; ++i) { float acc = buf[i * 128]; for (int m = 0; m < i; ++m) acc -= A[i * 64 + m] * buf[m * 128]; buf[i * 128] = acc; } }
    __syncthreads();
    for (int idx = tid; idx < 8192; idx += 512) { const int i = idx >> 7, d = idx & 127; Ug[uoff(i, d)] = (bf16)f2bf(V[idx]); WNg[fragoff(i, d, 4)] = (bf16)f2bf(-Q[idx]); }
}

__device__ __forceinline__ void gdn_scan_naive(KArgs a, int l, int bh, LAS unsigned char* lds, int tid, int lane, int wave) {
    unsigned char* ws = a->ws;
    LAS float* S = (LAS float*)lds; LAS float* VN = S + 16384; LAS float* O = VN + 8192;
    const int h = bh & 3, b = bh >> 2, e = tid & 127, ig = tid >> 7;
    const bf16* HP = (const bf16*)(ws + WS_R + R_HP); bf16* OB = (bf16*)(ws + WS_R + R_OB);
    const float* nw = a->in[5] + l * 128;
    __syncthreads();
    for (int idx = tid; idx < 16384; idx += 512) S[idx] = 0.f;
    __syncthreads();
#pragma unroll 1
    for (int n = 0; n < 32; ++n) {
        const int unit = bh * 32 + n;
        const bf16* Ug = (const bf16*)(ws + WS_R + R_U) + (size_t)unit * 8192; const bf16* WNg = (const bf16*)(ws + WS_R + R_WN) + (size_t)unit * 8192;
        const bf16* QDg = (const bf16*)(ws + WS_R + R_QD) + (size_t)unit * 8192; const bf16* KDTg = (const bf16*)(ws + WS_R + R_KDT) + (size_t)unit * 8192;
        const bf16* QKg = (const bf16*)(ws + WS_R + R_QK) + (size_t)unit * 4096; const float cd = ((const float*)(ws + WS_CD))[unit];
#pragma unroll 1
        for (int r = 0; r < 16; ++r) { const int i = ig + 4 * r; float acc = bf2f(Ug[uoff(i, e)]);
#pragma unroll 2
            for (int d0 = 0; d0 < 128; d0 += 4) { const v2u w = *(const v2u*)(WNg + fragoff(i, d0, 4));
                acc += bflo(w.x) * S[d0 * 128 + e] + bfhi(w.x) * S[(d0 + 1) * 128 + e] + bflo(w.y) * S[(d0 + 2) * 128 + e] + bfhi(w.y) * S[(d0 + 3) * 128 + e]; }
            VN[i * 128 + e] = acc; }
        __syncthreads();
#pragma unroll 1
        for (int r = 0; r < 16; ++r) { const int i = ig + 4 * r; float acc = 0.f;
#pragma unroll 2
            for (int d0 = 0; d0 < 128; d0 += 4) { const v2u w = *(const v2u*)(QDg + fragoff(i, d0, 4));
                acc += bflo(w.x) * S[d0 * 128 + e] + bfhi(w.x) * S[(d0 + 1) * 128 + e] + bflo(w.y) * S[(d0 + 2) * 128 + e] + bfhi(w.y) * S[(d0 + 3) * 128 + e]; }
#pragma unroll 2
            for (int j0 = 0; j0 < 64; j0 += 4) { const v2u w = *(const v2u*)(QKg + fragoff(i, j0, 2));
                acc += bflo(w.x) * VN[j0 * 128 + e] + bfhi(w.x) * VN[(j0 + 1) * 128 + e] + bflo(w.y) * VN[(j0 + 2) * 128 + e] + bfhi(w.y) * VN[(j0 + 3) * 128 + e]; }
            O[i * 128 + e] = acc; }
        __syncthreads();
#pragma unroll 1
        for (int r = 0; r < 32; ++r) { const int d = ig + 4 * r; float acc = S[d * 128 + e] * cd;
#pragma unroll 2
            for (int i0 = 0; i0 < 64; i0 += 4) { const v2u w = *(const v2u*)(KDTg + fragoff(d, i0, 2));
                acc += bflo(w.x) * VN[i0 * 128 + e] + bfhi(w.x) * VN[(i0 + 1) * 128 + e] + bflo(w.y) * VN[(i0 + 2) * 128 + e] + bfhi(w.y) * VN[(i0 + 3) * 128 + e]; }
            S[d * 128 + e] = acc; }
#pragma unroll 1
        for (int r = 0; r < 8; ++r) { const int i = wave * 8 + r; const float v0 = O[i * 128 + lane], v1 = O[i * 128 + lane + 64];
            const float rs = rsqrtf(wave_sum(v0 * v0 + v1 * v1) * (1.f / 128.f) + NORM_EPS);
            const size_t t = (size_t)b * SEQ + n * 64 + i; const bf16* gp = HP + t * HP_LD + COL_GG + h * 128; bf16* op = OB + t * 1024 + 512 + h * 128;
            op[lane] = (bf16)f2bf(v0 * rs * nw[lane] * siluf(bf2f(gp[lane]))); op[lane + 64] = (bf16)f2bf(v1 * rs * nw[lane + 64] * siluf(bf2f(gp[lane + 64]))); }
        __syncthreads();
    }
}

__device__ __forceinline__ void ret_unit_naive(KArgs a, int unit, LAS unsigned char* lds, int tid, int lane, int wave) {
    unsigned char* ws = a->ws;
    LAS float* Qs = (LAS float*)lds; LAS float* Ks = Qs + 64 * 65; LAS float* Vs = Ks + 64 * 65; LAS float* Sc = Vs + 8192;
    const int qb = unit & 31, bh = unit >> 5, h = bh & 3, b = bh >> 2, e = tid & 127, ig = tid >> 7;
    const bf16* HP = (const bf16*)(ws + WS_R + R_HP); bf16* OB = (bf16*)(ws + WS_R + R_OB); const float* RT = (const float*)(ws + WS_ROPE);
    const float log2g = log2f(1.0f - exp2f(-5.0f - (float)h));
    __syncthreads();
    for (int idx = tid; idx < 4096; idx += 512) { const int i = idx >> 6, d = idx & 63, dd = d & 31, pos = qb * 64 + i; const size_t t = (size_t)b * SEQ + pos;
        const float c = RT[pos * 64 + dd], s = RT[pos * 64 + 32 + dd]; const float x1 = bf2f(HP[t * HP_LD + COL_RQ + h * 64 + dd]), x2 = bf2f(HP[t * HP_LD + COL_RQ + h * 64 + dd + 32]);
        Qs[i * 65 + d] = d < 32 ? x1 * c - x2 * s : x1 * s + x2 * c; }
    float acc[16];
#pragma unroll
    for (int r = 0; r < 16; ++r) acc[r] = 0.f;
#pragma unroll 1
    for (int kb = 0; kb <= qb; ++kb) {
        __syncthreads();
        for (int idx = tid; idx < 4096; idx += 512) { const int i = idx >> 6, d = idx & 63, dd = d & 31, pos = kb * 64 + i; const size_t t = (size_t)b * SEQ + pos;
            const float c = RT[pos * 64 + dd], s = RT[pos * 64 + 32 + dd]; const float x1 = bf2f(HP[t * HP_LD + COL_RK + h * 64 + dd]), x2 = bf2f(HP[t * HP_LD + COL_RK + h * 64 + dd + 32]);
            Ks[i * 65 + d] = 0.125f * (d < 32 ? x1 * c - x2 * s : x1 * s + x2 * c); }
        for (int idx = tid; idx < 8192; idx += 512) { const int i = idx >> 7, d = idx & 127; Vs[idx] = bf2f(HP[((size_t)b * SEQ + kb * 64 + i) * HP_LD + COL_RV + h * 128 + d]); }
        __syncthreads();
        { const int j = tid & 63, ig8 = tid >> 6;
#pragma unroll 1
          for (int r = 0; r < 8; ++r) { const int i = ig8 + 8 * r; float dot = 0.f;
#pragma unroll 8
              for (int d = 0; d < 64; ++d) dot += Qs[i * 65 + d] * Ks[j * 65 + d];
              const int delta = (qb - kb) * 64 + i - j; Sc[i * 65 + j] = delta >= 0 ? dot * exp2f((float)delta * log2g) : 0.f; } }
        __syncthreads();
#pragma unroll 2
        for (int j = 0; j < 64; ++j) { const float vv = Vs[j * 128 + e];
#pragma unroll
            for (int r = 0; r < 16; ++r) acc[r] += Sc[(ig + 4 * r) * 65 + j] * vv; }
    }
    __syncthreads();
#pragma unroll
    for (int r = 0; r < 16; ++r) Vs[(ig + 4 * r) * 128 + e] = acc[r];
    __syncthreads();
#pragma unroll 1
    for (int r = 0; r < 8; ++r) { const int i = wave * 8 + r; const float v0 = Vs[i * 128 + lane], v1 = Vs[i * 128 + lane + 64];
        const float mean = wave_sum(v0 + v1) * (1.f / 128.f), d0 = v0 - mean, d1 = v1 - mean; const float rs = rsqrtf(wave_sum(d0 * d0 + d1 * d1) * (1.f / 128.f) + LN_EPS);
        const size_t t = (size_t)b * SEQ + qb * 64 + i; const bf16* gp = HP + t * HP_LD + COL_RG + h * 128; bf16* op = OB + t * 1024 + h * 128;
        op[lane] = (bf16)f2bf(d0 * rs * siluf(bf2f(gp[lane]))); op[lane + 64] = (bf16)f2bf(d1 * rs * siluf(bf2f(gp[lane + 64]))); }
}

typedef float f32x16 __attribute__((ext_vector_type(16)));
typedef float f32x8 __attribute__((ext_vector_type(8)));
typedef __bf16 bf8v __attribute__((ext_vector_type(8)));
typedef short bf16x8 __attribute__((ext_vector_type(8)));
#define MFMA32(a, b, c) __builtin_amdgcn_mfma_f32_32x32x16_bf16((a), (b), (c), 0, 0, 0)
__device__ __forceinline__ bf16x8 pack8(const f32x16& x, int s) {
    f32x8 v;
#pragma unroll
    for (int j = 0; j < 8; ++j) v[j] = x[8 * s + j];
    return __builtin_bit_cast(bf16x8, __builtin_convertvector(v, bf8v));
}

__device__ __forceinline__ unsigned short bfc(float x) { return __builtin_bit_cast(unsigned short, (__bf16)x); }
__device__ __forceinline__ unsigned bfc2(float lo, float hi) { return (unsigned)bfc(lo) | ((unsigned)bfc(hi) << 16); }

#ifndef PROBE_UNIT
#define PROBE_UNIT 0
#endif
#if defined(PROBE_MULT) && PROBE_MULT > 0
#define STAMPT(id, thr) do { if (blockIdx.x == PROBE_BID && threadIdx.x == (thr)) __hip_atomic_store((unsigned long long*)(a->ws + WS_CTL + 131072) + (id), (unsigned long long)__builtin_amdgcn_s_memrealtime(), RLX_AGENT); } while (0)
#else
#define STAMPT(id, thr) do {} while (0)
#endif
#ifndef GDN_F8
#define GDN_F8 0
#endif
#ifndef GATE_PRE
#define GATE_PRE 1
#endif
constexpr float F8_SW = 4.f, F8_SQ = 16.f, F8_SK = 4.f;
#define MFMA8(a, b, c) __builtin_amdgcn_mfma_f32_32x32x16_fp8_fp8((a), (b), (c), 0, 0, 0)
__device__ __forceinline__ unsigned f8x4(float a, float b, float c, float d) { int w = __builtin_amdgcn_cvt_pk_fp8_f32(a, b, 0, false); w = __builtin_amdgcn_cvt_pk_fp8_f32(c, d, w, true); return (unsigned)w; }
__device__ __forceinline__ long pack8_f8(const f32x16& x, int s, float sc) {
    const unsigned lo = f8x4(x[8 * s] * sc, x[8 * s + 1] * sc, x[8 * s + 2] * sc, x[8 * s + 3] * sc), hi = f8x4(x[8 * s + 4] * sc, x[8 * s + 5] * sc, x[8 * s + 6] * sc, x[8 * s + 7] * sc);
    return (long)(((unsigned long)hi << 32) | (unsigned long)lo);
}
#if GATE_PRE
#define GSILU(x) (x)
#else
#define GSILU(x) siluf(x)
#endif
#define GDN_BAR() do { asm volatile("s_waitcnt lgkmcnt(0)" ::: "memory"); __builtin_amdgcn_s_barrier(); asm volatile("" ::: "memory"); } while (0)
__device__ __forceinline__ void gdn_scan_fast(KArgs a, int l, int bh, LAS unsigned char* lds, int tid, int lane, int wave) {
    unsigned char* ws = a->ws;
#if GDN_F8
    constexpr int FB_WN = 0, FB_QD = 8192, FB_KDT = 16384, FB_QK = 24576, FB_U = 28672, FB_BYTES = 45056, NPC = 11, OPB = 8192;
#else
    constexpr int FB_WN = 0, FB_QD = 16384, FB_KDT = 32768, FB_QK = 49152, FB_U = 57344, FB_BYTES = 73728, NPC = 18, OPB = 16384;
#endif
    LAS float* OL = (LAS float*)(lds + FB_BYTES);
    constexpr int OLS = 64 * 132;
    const int h = bh & 3, b = bh >> 2, c = lane & 31, hh = lane >> 5;
    const bf16* HP = (const bf16*)(ws + WS_R + R_HP); bf16* OB = (bf16*)(ws + WS_R + R_OB);
    const float* nw = a->in[5] + l * 128;
    const unsigned char* gWN = (const unsigned char*)(ws + WS_R + R_WN) + (size_t)bh * 32 * OPB; const unsigned char* gQD = (const unsigned char*)(ws + WS_R + R_QD) + (size_t)bh * 32 * OPB;
    const unsigned char* gKDT = (const unsigned char*)(ws + WS_R + R_KDT) + (size_t)bh * 32 * OPB; const unsigned char* gQK = (const unsigned char*)(ws + WS_R + R_QK) + (size_t)bh * 32 * (OPB / 2);
    const unsigned char* gU = (const unsigned char*)(ws + WS_R + R_U) + (size_t)bh * 32 * 16384;
    const int et = tid - 256;
#define GDN_FETCH(pf, nn) do { constexpr int P4 = OPB / 4096; _Pragma("unroll") for (int k = 0; k < NPC; ++k) { const unsigned char* src_ = k < P4 ? gWN + (size_t)(nn) * OPB + k * 4096 : k < 2 * P4 ? gQD + (size_t)(nn) * OPB + (k - P4) * 4096 : \
        k < 3 * P4 ? gKDT + (size_t)(nn) * OPB + (k - 2 * P4) * 4096 : k < 3 * P4 + P4 / 2 ? gQK + (size_t)(nn) * (OPB / 2) + (k - 3 * P4) * 4096 : gU + (size_t)(nn) * 16384 + (k - 3 * P4 - P4 / 2) * 4096; pf[k] = *(const v4u*)(src_ + et * 16); } } while (0)
#define GDN_STORE(pf) do { _Pragma("unroll") for (int k = 0; k < NPC; ++k) *(LAS v4u*)(lds + k * 4096 + et * 16) = pf[k]; } while (0)
    __syncthreads();
    if (wave < 4) {
        f32x16 S[4];
#pragma unroll
        for (int t = 0; t < 4; ++t)
#pragma unroll
            for (int i = 0; i < 16; ++i) S[t][i] = 0.f;
        GDN_BAR();
#if GDN_F8
        const int q = wave;
        const LAS long* WNf = (const LAS long*)(lds + FB_WN) + lane; const LAS long* QDf = (const LAS long*)(lds + FB_QD) + lane;
        const LAS long* KDTf = (const LAS long*)(lds + FB_KDT) + lane; const LAS long* QKf = (const LAS long*)(lds + FB_QK) + lane;
        const LAS v4u* Uf = (const LAS v4u*)(lds + FB_U) + (q * 2) * 128 + lane;
#pragma unroll 1
        for (int n = 0; n < 32; ++n) {
            const float cd = ((const float*)(ws + WS_CD))[bh * 32 + n];
            long A0[8], A1[8];
#define GDN_LD_MTS(A, F, g) do { _Pragma("unroll") for (int k = 0; k < 8; ++k) { const int m_ = k & 1, s_ = (k >> 1) & 1, t_ = 2 * (g) + (k >> 2); A[k] = F[((m_ * 4 + t_) * 2 + s_) * 64]; } } while (0)
#define GDN_LD_TMS(A, F, g) do { _Pragma("unroll") for (int k = 0; k < 8; ++k) { const int s_ = k & 1, m_ = (k >> 1) & 1, t_ = 2 * (g) + (k >> 2); A[k] = F[((t_ * 2 + m_) * 2 + s_) * 64]; } } while (0)
            GDN_LD_MTS(A0, WNf, 0); GDN_LD_MTS(A1, WNf, 1);
            f32x16 av[2];
#pragma unroll
            for (int m = 0; m < 2; ++m)
#pragma unroll
                for (int hf = 0; hf < 2; ++hf) { const v4u u4 = Uf[(m * 2 + hf) * 64];
#pragma unroll
                    for (int k = 0; k < 4; ++k) { av[m][8 * hf + 2 * k] = bflo(u4[k]) * F8_SW; av[m][8 * hf + 2 * k + 1] = bfhi(u4[k]) * F8_SW; } }
            long Sb[4][2];
#pragma unroll
            for (int t = 0; t < 4; ++t) { Sb[t][0] = pack8_f8(S[t], 0, 1.f / F8_SK); Sb[t][1] = pack8_f8(S[t], 1, 1.f / F8_SK); }
#pragma unroll
            for (int k = 0; k < 8; ++k) { const int m_ = k & 1, s_ = (k >> 1) & 1, t_ = (k >> 2); av[m_] = MFMA8(A0[k], Sb[t_][s_], av[m_]); }
            GDN_LD_MTS(A0, QDf, 0);
#pragma unroll
            for (int k = 0; k < 8; ++k) { const int m_ = k & 1, s_ = (k >> 1) & 1, t_ = 2 + (k >> 2); av[m_] = MFMA8(A1[k], Sb[t_][s_], av[m_]); }
            GDN_LD_MTS(A1, QDf, 1);
            f32x16 ao[2];
#pragma unroll
            for (int m = 0; m < 2; ++m)
#pragma unroll
                for (int i = 0; i < 16; ++i) ao[m][i] = 0.f;
#pragma unroll
            for (int k = 0; k < 8; ++k) { const int m_ = k & 1, s_ = (k >> 1) & 1, t_ = (k >> 2); ao[m_] = MFMA8(A0[k], Sb[t_][s_], ao[m_]); }
#pragma unroll
            for (int k = 0; k < 6; ++k) { const int s_ = k & 1, m_ = k >= 2 ? 1 : 0, mp_ = k >= 4 ? 1 : 0; A0[k] = QKf[((m_ * 2 + mp_) * 2 + s_) * 64]; }
#pragma unroll
            for (int k = 0; k < 8; ++k) { const int m_ = k & 1, s_ = (k >> 1) & 1, t_ = 2 + (k >> 2); ao[m_] = MFMA8(A1[k], Sb[t_][s_], ao[m_]); }
            GDN_LD_TMS(A1, KDTf, 0);
            long Vb[2][2];
#pragma unroll
            for (int m = 0; m < 2; ++m) { Vb[m][0] = pack8_f8(av[m], 0, 1.f / F8_SW); Vb[m][1] = pack8_f8(av[m], 1, 1.f / F8_SW); }
#pragma unroll
            for (int k = 0; k < 6; ++k) { const int s_ = k & 1, m_ = k >= 2 ? 1 : 0, mp_ = k >= 4 ? 1 : 0; ao[m_] = MFMA8(A0[k], Vb[mp_][s_], ao[m_]); }
            GDN_LD_TMS(A0, KDTf, 1);
            {   LAS float* Ob = OL + (n & 1) * OLS + 32 * wave + c;
#pragma unroll
                for (int m = 0; m < 2; ++m)
#pragma unroll
                    for (int i = 0; i < 16; ++i) Ob[(32 * m + (i & 3) + 8 * (i >> 2) + 4 * hh) * 132] = ao[m][i] * (1.f / F8_SQ); }
#pragma unroll
            for (int t = 0; t < 4; ++t)
#pragma unroll
                for (int i = 0; i < 16; ++i) S[t][i] *= cd;
#pragma unroll
            for (int k = 0; k < 8; ++k) { const int s_ = k & 1, m_ = (k >> 1) & 1, t_ = (k >> 2); S[t_] = MFMA8(A1[k], Vb[m_][s_], S[t_]); }
#pragma unroll
            for (int k = 0; k < 8; ++k) { const int s_ = k & 1, m_ = (k >> 1) & 1, t_ = 2 + (k >> 2); S[t_] = MFMA8(A0[k], Vb[m_][s_], S[t_]); }
#undef GDN_LD_MTS
#undef GDN_LD_TMS
            GDN_BAR();
            GDN_BAR();
        }
#else
        const int q = wave;
        const LAS bf16x8* WNf = (const LAS bf16x8*)(lds + FB_WN) + lane; const LAS bf16x8* QDf = (const LAS bf16x8*)(lds + FB_QD) + lane;
        const LAS bf16x8* KDTf = (const LAS bf16x8*)(lds + FB_KDT) + lane; const LAS bf16x8* QKf = (const LAS bf16x8*)(lds + FB_QK) + lane;
        const LAS v4u* Uf = (const LAS v4u*)(lds + FB_U) + (q * 2) * 128 + lane;
#pragma unroll 1
        for (int n = 0; n < 32; ++n) {
            if (n == 10) STAMPT(110, 0);
            const float cd = ((const float*)(ws + WS_CD))[bh * 32 + n];
            bf16x8 A0[8], A1[8];
#define GDN_LD_MTS(A, F, g) do { _Pragma("unroll") for (int k = 0; k < 8; ++k) { const int m_ = k & 1, s_ = (k >> 1) & 1, t_ = 2 * (g) + (k >> 2); A[k] = F[((m_ * 4 + t_) * 2 + s_) * 64]; } } while (0)
#define GDN_LD_TMS(A, F, g) do { _Pragma("unroll") for (int k = 0; k < 8; ++k) { const int s_ = k & 1, m_ = (k >> 1) & 1, t_ = 2 * (g) + (k >> 2); A[k] = F[((t_ * 2 + m_) * 2 + s_) * 64]; } } while (0)
            GDN_LD_MTS(A0, WNf, 0); GDN_LD_MTS(A1, WNf, 1);
            f32x16 av[2];
#pragma unroll
            for (int m = 0; m < 2; ++m)
#pragma unroll
                for (int hf = 0; hf < 2; ++hf) { const v4u u4 = Uf[(m * 2 + hf) * 64];
#pragma unroll
                    for (int k = 0; k < 4; ++k) { av[m][8 * hf + 2 * k] = bflo(u4[k]); av[m][8 * hf + 2 * k + 1] = bfhi(u4[k]); } }
            bf16x8 Sb[4][2];
#pragma unroll
            for (int t = 0; t < 4; ++t) { Sb[t][0] = pack8(S[t], 0); Sb[t][1] = pack8(S[t], 1); }
#pragma unroll
            for (int k = 0; k < 8; ++k) { const int m_ = k & 1, s_ = (k >> 1) & 1, t_ = (k >> 2); av[m_] = MFMA32(A0[k], Sb[t_][s_], av[m_]); }
            GDN_LD_MTS(A0, QDf, 0);
#pragma unroll
            for (int k = 0; k < 8; ++k) { const int m_ = k & 1, s_ = (k >> 1) & 1, t_ = 2 + (k >> 2); av[m_] = MFMA32(A1[k], Sb[t_][s_], av[m_]); }
            GDN_LD_MTS(A1, QDf, 1);
            f32x16 ao[2];
#pragma unroll
            for (int m = 0; m < 2; ++m)
#pragma unroll
                for (int i = 0; i < 16; ++i) ao[m][i] = 0.f;
#pragma unroll
            for (int k = 0; k < 8; ++k) { const int m_ = k & 1, s_ = (k >> 1) & 1, t_ = (k >> 2); ao[m_] = MFMA32(A0[k], Sb[t_][s_], ao[m_]); }
#pragma unroll
            for (int k = 0; k < 6; ++k) { const int s_ = k & 1, m_ = k >= 2 ? 1 : 0, mp_ = k >= 4 ? 1 : 0; A0[k] = QKf[((m_ * 2 + mp_) * 2 + s_) * 64]; }
#pragma unroll
            for (int k = 0; k < 8; ++k) { const int m_ = k & 1, s_ = (k >> 1) & 1, t_ = 2 + (k >> 2); ao[m_] = MFMA32(A1[k], Sb[t_][s_], ao[m_]); }
            GDN_LD_TMS(A1, KDTf, 0);
            bf16x8 Vb[2][2];
#pragma unroll
            for (int m = 0; m < 2; ++m) { Vb[m][0] = pack8(av[m], 0); Vb[m][1] = pack8(av[m], 1); }
#pragma unroll
            for (int k = 0; k < 6; ++k) { const int s_ = k & 1, m_ = k >= 2 ? 1 : 0, mp_ = k >= 4 ? 1 : 0; ao[m_] = MFMA32(A0[k], Vb[mp_][s_], ao[m_]); }
            GDN_LD_TMS(A0, KDTf, 1);
            {   LAS float* Ob = OL + (n & 1) * OLS + 32 * wave + c;
#pragma unroll
                for (int m = 0; m < 2; ++m)
#pragma unroll
                    for (int i = 0; i < 16; ++i) Ob[(32 * m + (i & 3) + 8 * (i >> 2) + 4 * hh) * 132] = ao[m][i]; }
#pragma unroll
            for (int t = 0; t < 4; ++t)
#pragma unroll
                for (int i = 0; i < 16; ++i) S[t][i] *= cd;
#pragma unroll
            for (int k = 0; k < 8; ++k) { const int s_ = k & 1, m_ = (k >> 1) & 1, t_ = (k >> 2); S[t_] = MFMA32(A1[k], Vb[m_][s_], S[t_]); }
#pragma unroll
            for (int k = 0; k < 8; ++k) { const int s_ = k & 1, m_ = (k >> 1) & 1, t_ = 2 + (k >> 2); S[t_] = MFMA32(A0[k], Vb[m_][s_], S[t_]); }
#undef GDN_LD_MTS
#undef GDN_LD_TMS
            if (n == 10) STAMPT(111, 0);
            GDN_BAR();
            if (n == 10) STAMPT(112, 0);
            GDN_BAR();
            if (n == 10) STAMPT(113, 0);
        }
#endif
        GDN_BAR(); GDN_BAR();
    } else {
        v4u pfA[NPC], pfB[NPC];
        LAS float* NWl = OL + 2 * OLS;
        if (et < 128) NWl[et] = nw[et];
        GDN_FETCH(pfB, 0); GDN_FETCH(pfA, 1); GDN_STORE(pfB);
        GDN_BAR();
        const int i = et >> 2, qd = et & 3;
#define GDN_LOADER_ITER(n, PF_FETCH, PF_STORE, GQL, GQU) do { \
            if ((n) == 10) STAMPT(120, 256); \
            if ((n) < 32) { const bf16* gp = HP + ((size_t)b * SEQ + (n) * 64 + i) * HP_LD + COL_GG + h * 128 + 32 * qd;     \
                _Pragma("unroll") for (int k = 0; k < 4; ++k) GQL[k] = *(const v4u*)(gp + 8 * k); } \
            if ((n) + 2 < 32) GDN_FETCH(PF_FETCH, (n) + 2); \
            if ((n) == 10) STAMPT(125, 256); \
            if ((n) > 0) { \
                const LAS float* Ob = OL + (((n) - 1) & 1) * OLS + i * 132 + 32 * qd; \
                float ss = 0.f; \
                _Pragma("unroll") for (int k = 0; k < 8; ++k) { const f32x4 v_ = *(const LAS f32x4*)(Ob + 4 * k); ss += (v_.x * v_.x + v_.y * v_.y) + (v_.z * v_.z + v_.w * v_.w); } \
                ss += __shfl_xor(ss, 1); ss += __shfl_xor(ss, 2); \
                const float rs = rsqrtf(ss * (1.f / 128.f) + NORM_EPS); \
                bf16* op = OB + ((size_t)b * SEQ + ((n) - 1) * 64 + i) * 1024 + 512 + h * 128 + 32 * qd; \
                _Pragma("unroll") for (int k = 0; k < 4; ++k) { const f32x4 w0 = *(const LAS f32x4*)(NWl + 32 * qd + 8 * k), w1 = *(const LAS f32x4*)(NWl + 32 * qd + 8 * k + 4); const v4u gg = GQU[k]; \
                    const f32x4 a0 = *(const LAS f32x4*)(Ob + 8 * k), a1 = *(const LAS f32x4*)(Ob + 8 * k + 4); \
                    v4u o; o.x = bfc2(a0.x * rs * w0.x * GSILU(bflo(gg.x)), a0.y * rs * w0.y * GSILU(bfhi(gg.x))); o.y = bfc2(a0.z * rs * w0.z * GSILU(bflo(gg.y)), a0.w * rs * w0.w * GSILU(bfhi(gg.y))); \
                    o.z = bfc2(a1.x * rs * w1.x * GSILU(bflo(gg.z)), a1.y * rs * w1.y * GSILU(bfhi(gg.z))); o.w = bfc2(a1.z * rs * w1.z * GSILU(bflo(gg.w)), a1.w * rs * w1.w * GSILU(bfhi(gg.w))); \
                    *(v4u*)(op + 8 * k) = o; } \
            } \
            asm volatile("" ::: "memory"); \
            if ((n) == 10) STAMPT(121, 256); \
            GDN_BAR();            \
            if ((n) == 10) STAMPT(122, 256); \
            if ((n) + 1 < 32) GDN_STORE(PF_STORE); \
            if ((n) == 10) STAMPT(123, 256); \
            GDN_BAR();            \
            if ((n) == 10) STAMPT(124, 256); \
        } while (0)
        v4u gqA[4], gqB[4];
#pragma unroll
        for (int k = 0; k < 4; ++k) { gqA[k] = (v4u){0u, 0u, 0u, 0u}; gqB[k] = (v4u){0u, 0u, 0u, 0u}; }
#pragma unroll
        for (int n = 0; n < 32; n += 2) {
            GDN_LOADER_ITER(n, pfB, pfA, gqA, gqB);
            GDN_LOADER_ITER(n + 1, pfA, pfB, gqB, gqA);
        }
        GDN_LOADER_ITER(32, pfB, pfA, gqA, gqB);
#undef GDN_LOADER_ITER
    }
#undef GDN_FETCH
#undef GDN_STORE
}

__device__ __forceinline__ void gdn_scan_helper(KArgs a, int bh, int tid) {
    unsigned char* ws = a->ws;
    const unsigned char* gWN = (const unsigned char*)(ws + WS_R + R_WN) + (size_t)bh * 32 * 16384; const unsigned char* gQD = (const unsigned char*)(ws + WS_R + R_QD) + (size_t)bh * 32 * 16384;
    const unsigned char* gKDT = (const unsigned char*)(ws + WS_R + R_KDT) + (size_t)bh * 32 * 16384; const unsigned char* gQK = (const unsigned char*)(ws + WS_R + R_QK) + (size_t)bh * 32 * 8192;
    const unsigned char* gU = (const unsigned char*)(ws + WS_R + R_U) + (size_t)bh * 32 * 16384;
#pragma unroll 1
    for (int n = 0; n < 32; ++n) {
        v4u pf[9];
#pragma unroll
        for (int k = 0; k < 9; ++k) { const int kk = 2 * k + (tid >> 8), et = tid & 255;
            const unsigned char* src_ = kk < 4 ? gWN + (size_t)n * 16384 + kk * 4096 : kk < 8 ? gQD + (size_t)n * 16384 + (kk - 4) * 4096 :
                kk < 12 ? gKDT + (size_t)n * 16384 + (kk - 8) * 4096 : kk < 14 ? gQK + (size_t)n * 8192 + (kk - 12) * 4096 : gU + (size_t)n * 16384 + (kk - 14) * 4096;
            pf[k] = *(const v4u*)(src_ + et * 16); }
#pragma unroll
        for (int k = 0; k < 9; ++k) asm volatile("" :: "v"(pf[k]));
    }
}

__device__ __forceinline__ void gdn_scan_v3(KArgs a, int l, int bhq, LAS unsigned char* lds, int tid, int lane, int wave) {
    unsigned char* ws = a->ws;
    constexpr int FB_WN = 0, FB_QD = 16384, FB_KDT = 32768, FB_QK = 49152, FB_U = 57344, IMG = 61440;
    constexpr int OLS = 64 * 36;
    LAS float* OL = (LAS float*)(lds + 2 * IMG);
    const int bh = bhq >> 2, q = bhq & 3, h = bh & 3, b = bh >> 2, c = lane & 31, hh = lane >> 5;
    bf16* OB = (bf16*)(ws + WS_R + R_OB); float* SSQ = (float*)(ws + WS_SSQ);
    const unsigned char* gWN = (const unsigned char*)(ws + WS_R + R_WN) + (size_t)bh * 32 * 16384; const unsigned char* gQD = (const unsigned char*)(ws + WS_R + R_QD) + (size_t)bh * 32 * 16384;
    const unsigned char* gKDT = (const unsigned char*)(ws + WS_R + R_KDT) + (size_t)bh * 32 * 16384; const unsigned char* gQK = (const unsigned char*)(ws + WS_R + R_QK) + (size_t)bh * 32 * 8192;
    const unsigned char* gU = (const unsigned char*)(ws + WS_R + R_U) + (size_t)bh * 32 * 16384 + q * 4096;
    const int et = tid - 256;
#define G3_FETCH(pf, nn) do { _Pragma("unroll") for (int k = 0; k < 15; ++k) { const unsigned char* src_ = k < 4 ? gWN + (size_t)(nn) * 16384 + k * 4096 : k < 8 ? gQD + (size_t)(nn) * 16384 + (k - 4) * 4096 : \
        k < 12 ? gKDT + (size_t)(nn) * 16384 + (k - 8) * 4096 : k < 14 ? gQK + (size_t)(nn) * 8192 + (k - 12) * 4096 : gU + (size_t)(nn) * 16384; pf[k] = *(const v4u*)(src_ + et * 16); } } while (0)
#define G3_STORE(pf, buf) do { _Pragma("unroll") for (int k = 0; k < 15; ++k) *(LAS v4u*)(lds + (buf) * IMG + k * 4096 + et * 16) = pf[k]; } while (0)
    __syncthreads();
    if (wave == 0) {
        f32x16 S[4];
#pragma unroll
        for (int t = 0; t < 4; ++t)
#pragma unroll
            for (int i = 0; i < 16; ++i) S[t][i] = 0.f;
        GDN_BAR();
#pragma unroll 1
        for (int n = 0; n < 32; ++n) {
            const LAS unsigned char* img = lds + (n & 1) * IMG;
            const LAS bf16x8* WNf = (const LAS bf16x8*)(img + FB_WN) + lane; const LAS bf16x8* QDf = (const LAS bf16x8*)(img + FB_QD) + lane;
            const LAS bf16x8* KDTf = (const LAS bf16x8*)(img + FB_KDT) + lane; const LAS bf16x8* QKf = (const LAS bf16x8*)(img + FB_QK) + lane;
            const LAS v4u* Uf = (const LAS v4u*)(img + FB_U) + lane;
            const float cd = ((const float*)(ws + WS_CD))[bh * 32 + n];
            bf16x8 A0[8], A1[8];
#define G3_LD_MTS(A, F, g) do { _Pragma("unroll") for (int k = 0; k < 8; ++k) { const int m_ = k & 1, s_ = (k >> 1) & 1, t_ = 2 * (g) + (k >> 2); A[k] = F[((m_ * 4 + t_) * 2 + s_) * 64]; } } while (0)
#define G3_LD_TMS(A, F, g) do { _Pragma("unroll") for (int k = 0; k < 8; ++k) { const int s_ = k & 1, m_ = (k >> 1) & 1, t_ = 2 * (g) + (k >> 2); A[k] = F[((t_ * 2 + m_) * 2 + s_) * 64]; } } while (0)
            G3_LD_MTS(A0, WNf, 0); G3_LD_MTS(A1, WNf, 1);
            f32x16 av[2];
#pragma unroll
            for (int m = 0; m < 2; ++m)
#pragma unroll
                for (int hf = 0; hf < 2; ++hf) { const v4u u4 = Uf[(m * 2 + hf) * 64];
#pragma unroll
                    for (int k = 0; k < 4; ++k) { av[m][8 * hf + 2 * k] = bflo(u4[k]); av[m][8 * hf + 2 * k + 1] = bfhi(u4[k]); } }
            bf16x8 Sb[4][2];
#pragma unroll
            for (int t = 0; t < 4; ++t) { Sb[t][0] = pack8(S[t], 0); Sb[t][1] = pack8(S[t], 1); }
#pragma unroll
            for (int k = 0; k < 8; ++k) { const int m_ = k & 1, s_ = (k >> 1) & 1, t_ = (k >> 2); av[m_] = MFMA32(A0[k], Sb[t_][s_], av[m_]); }
            G3_LD_MTS(A0, QDf, 0);
#pragma unroll
            for (int k = 0; k < 8; ++k) { const int m_ = k & 1, s_ = (k >> 1) & 1, t_ = 2 + (k >> 2); av[m_] = MFMA32(A1[k], Sb[t_][s_], av[m_]); }
            G3_LD_MTS(A1, QDf, 1);
            f32x16 ao[2];
#pragma unroll
            for (int m = 0; m < 2; ++m)
#pragma unroll
                for (int i = 0; i < 16; ++i) ao[m][i] = 0.f;
#pragma unroll
            for (int k = 0; k < 8; ++k) { const int m_ = k & 1, s_ = (k >> 1) & 1, t_ = (k >> 2); ao[m_] = MFMA32(A0[k], Sb[t_][s_], ao[m_]); }
#pragma unroll
            for (int k = 0; k < 6; ++k) { const int s_ = k & 1, m_ = k >= 2 ? 1 : 0, mp_ = k >= 4 ? 1 : 0; A0[k] = QKf[((m_ * 2 + mp_) * 2 + s_) * 64]; }
#pragma unroll
            for (int k = 0; k < 8; ++k) { const int m_ = k & 1, s_ = (k >> 1) & 1, t_ = 2 + (k >> 2); ao[m_] = MFMA32(A1[k], Sb[t_][s_], ao[m_]); }
            G3_LD_TMS(A1, KDTf, 0);
            bf16x8 Vb[2][2];
#pragma unroll
            for (int m = 0; m < 2; ++m) { Vb[m][0] = pack8(av[m], 0); Vb[m][1] = pack8(av[m], 1); }
#pragma unroll
            for (int k = 0; k < 6; ++k) { const int s_ = k & 1, m_ = k >= 2 ? 1 : 0, mp_ = k >= 4 ? 1 : 0; ao[m_] = MFMA32(A0[k], Vb[mp_][s_], ao[m_]); }
            G3_LD_TMS(A0, KDTf, 1);
            {   LAS float* Ob = OL + (n & 1) * OLS + c;
#pragma unroll
                for (int m = 0; m < 2; ++m)
#pragma unroll
                    for (int i = 0; i < 16; ++i) Ob[(32 * m + (i & 3) + 8 * (i >> 2) + 4 * hh) * 36] = ao[m][i]; }
#pragma unroll
            for (int t = 0; t < 4; ++t)
#pragma unroll
                for (int i = 0; i < 16; ++i) S[t][i] *= cd;
#pragma unroll
            for (int k = 0; k < 8; ++k) { const int s_ = k & 1, m_ = (k >> 1) & 1, t_ = (k >> 2); S[t_] = MFMA32(A1[k], Vb[m_][s_], S[t_]); }
#pragma unroll
            for (int k = 0; k < 8; ++k) { const int s_ = k & 1, m_ = (k >> 1) & 1, t_ = 2 + (k >> 2); S[t_] = MFMA32(A0[k], Vb[m_][s_], S[t_]); }
#undef G3_LD_MTS
#undef G3_LD_TMS
            GDN_BAR();
        }
    } else if (wave >= 4) {
        v4u pfE[15], pfO[15];
        G3_FETCH(pfE, 0); G3_FETCH(pfO, 1); G3_STORE(pfE, 0);
        GDN_BAR();
        const int i = et >> 2, p = et & 3;
#define G3_OUT(m) do { const LAS float* Ob = OL + ((m) & 1) * OLS + i * 36 + 8 * p; const f32x4 o0 = *(const LAS f32x4*)Ob, o1 = *(const LAS f32x4*)(Ob + 4); \
            float ss = (o0.x * o0.x + o0.y * o0.y) + (o0.z * o0.z + o0.w * o0.w) + (o1.x * o1.x + o1.y * o1.y) + (o1.z * o1.z + o1.w * o1.w); \
            ss += __shfl_xor(ss, 1); ss += __shfl_xor(ss, 2); \
            const size_t t_ = (size_t)b * SEQ + (m) * 64 + i; \
            v4u w_; w_.x = bfc2(o0.x, o0.y); w_.y = bfc2(o0.z, o0.w); w_.z = bfc2(o1.x, o1.y); w_.w = bfc2(o1.z, o1.w); \
            *(v4u*)(OB + t_ * 1024 + 512 + h * 128 + 32 * q + 8 * p) = w_; \
            if (p == 0) SSQ[(t_ * 4 + h) * 4 + q] = ss; } while (0)
#define G3_LOADER_ITER(n, PF_FETCH, PF_STORE) do { \
            if ((n) + 2 < 32) G3_FETCH(PF_FETCH, (n) + 2); \
            if ((n) > 0) G3_OUT((n) - 1); \
            if ((n) + 1 < 32) G3_STORE(PF_STORE, ((n) + 1) & 1); \
            GDN_BAR(); \
        } while (0)
#pragma unroll
        for (int n = 0; n < 32; n += 2) {
            G3_LOADER_ITER(n, pfE, pfO);
            G3_LOADER_ITER(n + 1, pfO, pfE);
        }
        G3_OUT(31);
#undef G3_LOADER_ITER
#undef G3_OUT
    } else {
        GDN_BAR();
#pragma unroll 1
        for (int n = 0; n < 32; ++n) GDN_BAR();
    }
#undef G3_FETCH
#undef G3_STORE
}
__device__ __forceinline__ void gdn_finalize(KArgs a, int l, int lane, int gw, int NGW) {
    unsigned char* ws = a->ws;
    const bf16* HP = (const bf16*)(ws + WS_R + R_HP); bf16* OB = (bf16*)(ws + WS_R + R_OB); const float* SSQ = (const float*)(ws + WS_SSQ);
    const int hd = lane >> 4, cb = (lane & 15) * 8;
    const float* nw = a->in[5] + l * 128 + cb;
    const f32x4 w0 = *(const f32x4*)nw, w1 = *(const f32x4*)(nw + 4);
    for (int t0 = gw * 4; t0 < M; t0 += NGW * 4) {
        v4u raw[4], gg[4]; f32x4 sq[4];
#pragma unroll
        for (int k = 0; k < 4; ++k) { const size_t t = (size_t)t0 + k; raw[k] = *(const v4u*)(OB + t * 1024 + 512 + hd * 128 + cb); gg[k] = *(const v4u*)(HP + t * HP_LD + COL_GG + hd * 128 + cb); sq[k] = *(const f32x4*)(SSQ + (t * 4 + hd) * 4); }
#pragma unroll
        for (int k = 0; k < 4; ++k) { const size_t t = (size_t)t0 + k; const float rs = rsqrtf(((sq[k].x + sq[k].y) + (sq[k].z + sq[k].w)) * (1.f / 128.f) + NORM_EPS);
            v4u o; o.x = bfc2(bflo(raw[k].x) * rs * w0.x * siluf(bflo(gg[k].x)), bfhi(raw[k].x) * rs * w0.y * siluf(bfhi(gg[k].x))); o.y = bfc2(bflo(raw[k].y) * rs * w0.z * siluf(bflo(gg[k].y)), bfhi(raw[k].y) * rs * w0.w * siluf(bfhi(gg[k].y)));
            o.z = bfc2(bflo(raw[k].z) * rs * w1.x * siluf(bflo(gg[k].z)), bfhi(raw[k].z) * rs * w1.y * siluf(bfhi(gg[k].z))); o.w = bfc2(bflo(raw[k].w) * rs * w1.z * siluf(bflo(gg[k].w)), bfhi(raw[k].w) * rs * w1.w * siluf(bfhi(gg[k].w)));
            *(v4u*)(OB + t * 1024 + 512 + hd * 128 + cb) = o; }
    }
}

struct RetLds {
    static constexpr int QS = 72, JS = 136;
    static constexpr int P = 0, Q1 = 34816, K1 = 53248, OL = 0, K1T = 71680, VT = 89088, ST = 123904;
};
template <bool WANT_Q, bool WANT_K1, bool WANT_K1T>
__device__ __forceinline__ void ret_stage(const bf16* HP, const float* RT, int b, int h, int n, float lg, LAS unsigned char* lds, int tid) {
    constexpr int QS = RetLds::QS, JS = RetLds::JS;
    LAS bf16* Q1 = (LAS bf16*)(lds + RetLds::Q1); LAS bf16* K1 = (LAS bf16*)(lds + RetLds::K1); LAS bf16* K1T = (LAS bf16*)(lds + RetLds::K1T); LAS bf16* VT = (LAS bf16*)(lds + RetLds::VT);
    const int i = tid >> 2, dd = (tid & 3) * 8, pos = n * 128 + i; const size_t t = (size_t)b * SEQ + pos;
    const bf16* hp = HP + t * HP_LD;
    const f32x4 c0 = *(const f32x4*)(RT + pos * 64 + dd), c1 = *(const f32x4*)(RT + pos * 64 + dd + 4), s0 = *(const f32x4*)(RT + pos * 64 + 32 + dd), s1 = *(const f32x4*)(RT + pos * 64 + 32 + dd + 4);
    const float cs[8] = {c0.x, c0.y, c0.z, c0.w, c1.x, c1.y, c1.z, c1.w}, sn[8] = {s0.x, s0.y, s0.z, s0.w, s1.x, s1.y, s1.z, s1.w};
    const float sq = exp2f((float)i * lg), sk = 0.125f * exp2f(-(float)i * lg);
    v4u xv[4];
#pragma unroll
    for (int p = 0; p < 4; ++p) { const int idx = tid + 512 * p, j = idx >> 4, e0 = (idx & 15) * 8; xv[p] = *(const v4u*)(HP + ((size_t)b * SEQ + n * 128 + j) * HP_LD + COL_RV + h * 128 + e0); }
#pragma unroll
    for (int which = (WANT_Q ? 0 : 1); which < 2; ++which) {
        const bf16* src = hp + (which == 0 ? COL_RQ : COL_RK) + h * 64 + dd;
        const v4u x1 = *(const v4u*)src, x2 = *(const v4u*)(src + 32);
        const float sc = which == 0 ? sq : sk;
        float lo[8], hi[8];
#pragma unroll
        for (int k = 0; k < 4; ++k) { const float a0 = bflo(x1[k]), a1 = bfhi(x1[k]), b0 = bflo(x2[k]), b1 = bfhi(x2[k]);
            lo[2 * k] = (a0 * cs[2 * k] - b0 * sn[2 * k]) * sc; lo[2 * k + 1] = (a1 * cs[2 * k + 1] - b1 * sn[2 * k + 1]) * sc;
            hi[2 * k] = (a0 * sn[2 * k] + b0 * cs[2 * k]) * sc; hi[2 * k + 1] = (a1 * sn[2 * k + 1] + b1 * cs[2 * k + 1]) * sc; }
        v4u wl, wh;
#pragma unroll
        for (int k = 0; k < 4; ++k) { wl[k] = bfc2(lo[2 * k], lo[2 * k + 1]); wh[k] = bfc2(hi[2 * k], hi[2 * k + 1]); }
        if (which == 0 || WANT_K1) { LAS bf16* dst = (which == 0 ? Q1 : K1) + i * QS + dd; *(LAS v4u*)dst = wl; *(LAS v4u*)(dst + 32) = wh; }
        if (which == 1 && WANT_K1T) {
#pragma unroll
            for (int k = 0; k < 4; ++k) { K1T[(dd + 2 * k) * JS + i] = (bf16)(wl[k] & 0xffffu); K1T[(dd + 2 * k + 1) * JS + i] = (bf16)(wl[k] >> 16);
                K1T[(32 + dd + 2 * k) * JS + i] = (bf16)(wh[k] & 0xffffu); K1T[(32 + dd + 2 * k + 1) * JS + i] = (bf16)(wh[k] >> 16); }
        }
    }
#pragma unroll
    for (int p = 0; p < 4; ++p) { const int idx = tid + 512 * p, j = idx >> 4, e0 = (idx & 15) * 8;
#pragma unroll
        for (int k = 0; k < 4; ++k) { VT[(e0 + 2 * k) * JS + j] = (bf16)(xv[p][k] & 0xffffu); VT[(e0 + 2 * k + 1) * JS + j] = (bf16)(xv[p][k] >> 16); } }
}
__device__ __forceinline__ void ret_kv_unit(KArgs a, int unit, LAS unsigned char* lds, int tid, int lane, int wave) {
    unsigned char* ws = a->ws;
    constexpr int JS = RetLds::JS;
    const int n = unit & 15, bh = unit >> 4, h = bh & 3, b = bh >> 2, c = lane & 31, hh = lane >> 5;
    const bf16* HP = (const bf16*)(ws + WS_R + R_HP); const float* RT = (const float*)(ws + WS_ROPE);
    const float gam = 1.0f - exp2f(-5.0f - (float)h), lg = log2f(gam), g127 = exp2f(127.f * lg);
    LAS bf16* K1T = (LAS bf16*)(lds + RetLds::K1T); LAS bf16* VT = (LAS bf16*)(lds + RetLds::VT);
    __syncthreads();
    ret_stage<false, false, true>(HP, RT, b, h, n, lg, lds, tid);
    __syncthreads();
    const int td = wave >> 2, te = wave & 3;
    f32x16 kv;
#pragma unroll
    for (int i = 0; i < 16; ++i) kv[i] = 0.f;
#pragma unroll
    for (int ks = 0; ks < 8; ++ks) kv = MFMA32(*(const LAS bf16x8*)(K1T + (32 * td + c) * JS + 16 * ks + 8 * hh), *(const LAS bf16x8*)(VT + (32 * te + c) * JS + 16 * ks + 8 * hh), kv);
    float* dst = (float*)(ws + WS_KV) + ((size_t)(unit * 8 + wave) * 64 + lane) * 16;
#pragma unroll
    for (int g = 0; g < 4; ++g) *(f32x4*)(dst + 4 * g) = (f32x4){kv[4 * g] * g127, kv[4 * g + 1] * g127, kv[4 * g + 2] * g127, kv[4 * g + 3] * g127};
}
__device__ __forceinline__ void ret_out_unit(KArgs a, int unit, LAS unsigned char* lds, int tid, int lane, int wave) {
    unsigned char* ws = a->ws;
    constexpr int QS = RetLds::QS, JS = RetLds::JS;
    LAS bf16* P = (LAS bf16*)(lds + RetLds::P); LAS bf16* Q1 = (LAS bf16*)(lds + RetLds::Q1); LAS bf16* K1 = (LAS bf16*)(lds + RetLds::K1); LAS float* OL = (LAS float*)(lds + RetLds::OL);
    LAS bf16* VT = (LAS bf16*)(lds + RetLds::VT); LAS bf16* ST = (LAS bf16*)(lds + RetLds::ST);
    const int n = unit & 15, bh = unit >> 4, h = bh & 3, b = bh >> 2, c = lane & 31, hh = lane >> 5;
    const bf16* HP = (const bf16*)(ws + WS_R + R_HP); bf16* OB = (bf16*)(ws + WS_R + R_OB); const float* RT = (const float*)(ws + WS_ROPE);
    const float gam = 1.0f - exp2f(-5.0f - (float)h), lg = log2f(gam), g128 = exp2f(128.f * lg);
    __syncthreads();
    const int ei = tid >> 2, eq = tid & 3; const size_t et = (size_t)b * SEQ + n * 128 + ei;
    v4u gg[4];
    { const bf16* gp = HP + et * HP_LD + COL_RG + h * 128 + 32 * eq;
#pragma unroll
      for (int k = 0; k < 4; ++k) gg[k] = *(const v4u*)(gp + 8 * k); }
    {
        const int td = wave >> 2, te = wave & 3;
        f32x16 S;
#pragma unroll
        for (int i = 0; i < 16; ++i) S[i] = 0.f;
        const float* src = (const float*)(ws + WS_KV) + ((size_t)((bh * 16) * 8 + wave) * 64 + lane) * 16;
#pragma unroll 2
        for (int m = 0; m < n; ++m) { const f32x4* p4 = (const f32x4*)(src + (size_t)m * 8 * 64 * 16);
#pragma unroll
            for (int g = 0; g < 4; ++g) { const f32x4 v = p4[g]; S[4 * g] = S[4 * g] * g128 + v.x; S[4 * g + 1] = S[4 * g + 1] * g128 + v.y; S[4 * g + 2] = S[4 * g + 2] * g128 + v.z; S[4 * g + 3] = S[4 * g + 3] * g128 + v.w; } }
#pragma unroll
        for (int g = 0; g < 4; ++g) { v2u w; w.x = bfc2(S[4 * g], S[4 * g + 1]); w.y = bfc2(S[4 * g + 2], S[4 * g + 3]); *(LAS v2u*)(ST + (32 * te + c) * QS + 32 * td + 8 * g + 4 * hh) = w; }
    }
    ret_stage<true, true, false>(HP, RT, b, h, n, lg, lds, tid);
    __syncthreads();
#pragma unroll 1
    for (int rep = 0; rep < 2; ++rep) { const int idx = wave + 8 * rep;
        if (idx < 10) { const int ti = (idx >= 1) + (idx >= 3) + (idx >= 6), tj = idx - ti * (ti + 1) / 2;
            f32x16 acc;
#pragma unroll
            for (int i = 0; i < 16; ++i) acc[i] = 0.f;
#pragma unroll
            for (int s2 = 0; s2 < 4; ++s2) acc = MFMA32(*(const LAS bf16x8*)(Q1 + (32 * ti + c) * QS + 16 * s2 + 8 * hh), *(const LAS bf16x8*)(K1 + (32 * tj + c) * QS + 16 * s2 + 8 * hh), acc);
#pragma unroll
            for (int i = 0; i < 16; ++i) { const int il = (i & 3) + 8 * (i >> 2) + 4 * hh; float v = acc[i]; if (ti == tj && il < c) v = 0.f; P[(32 * ti + il) * JS + 32 * tj + c] = bfc(v); } } }
    __syncthreads();
    const int ti = wave >> 1, te0 = 2 * (wave & 1);
    f32x16 ao[2];
#pragma unroll
    for (int u = 0; u < 2; ++u)
#pragma unroll
        for (int i = 0; i < 16; ++i) ao[u][i] = 0.f;
#pragma unroll
    for (int s2 = 0; s2 < 4; ++s2) { const bf16x8 A = *(const LAS bf16x8*)(Q1 + (32 * ti + c) * QS + 16 * s2 + 8 * hh);
#pragma unroll
        for (int u = 0; u < 2; ++u) ao[u] = MFMA32(A, *(const LAS bf16x8*)(ST + (32 * (te0 + u) + c) * QS + 16 * s2 + 8 * hh), ao[u]); }
#pragma unroll
    for (int u = 0; u < 2; ++u)
#pragma unroll
        for (int i = 0; i < 16; ++i) ao[u][i] *= gam;
#pragma unroll 1
    for (int tj = 0; tj <= ti; ++tj)
#pragma unroll
        for (int s2 = 0; s2 < 2; ++s2) { const bf16x8 A = *(const LAS bf16x8*)(P + (32 * ti + c) * JS + 32 * tj + 16 * s2 + 8 * hh);
#pragma unroll
            for (int u = 0; u < 2; ++u) ao[u] = MFMA32(A, *(const LAS bf16x8*)(VT + (32 * (te0 + u) + c) * JS + 32 * tj + 16 * s2 + 8 * hh), ao[u]); }
    __syncthreads();
#pragma unroll
    for (int u = 0; u < 2; ++u)
#pragma unroll
        for (int i = 0; i < 16; ++i) OL[(32 * ti + (i & 3) + 8 * (i >> 2) + 4 * hh) * 132 + 32 * (te0 + u) + c] = ao[u][i];
    __syncthreads();
    {
        const LAS float* Ob = OL + ei * 132 + 32 * eq; bf16* op = OB + et * 1024 + h * 128 + 32 * eq;
        f32x4 v[8]; float sm = 0.f;
#pragma unroll
        for (int k = 0; k < 8; ++k) { v[k] = *(const LAS f32x4*)(Ob + 4 * k); sm += (v[k].x + v[k].y) + (v[k].z + v[k].w); }
        sm += __shfl_xor(sm, 1); sm += __shfl_xor(sm, 2);
        const float mean = sm * (1.f / 128.f); float sq = 0.f;
#pragma unroll
        for (int k = 0; k < 8; ++k) { v[k] = v[k] - mean; sq += (v[k].x * v[k].x + v[k].y * v[k].y) + (v[k].z * v[k].z + v[k].w * v[k].w); }
        sq += __shfl_xor(sq, 1); sq += __shfl_xor(sq, 2);
        const float rs = rsqrtf(sq * (1.f / 128.f) + LN_EPS);
#pragma unroll
        for (int k = 0; k < 4; ++k) { const v4u g4 = gg[k]; const f32x4 a0 = v[2 * k], a1 = v[2 * k + 1];
            v4u o; o.x = bfc2(a0.x * rs * siluf(bflo(g4.x)), a0.y * rs * siluf(bfhi(g4.x))); o.y = bfc2(a0.z * rs * siluf(bflo(g4.y)), a0.w * rs * siluf(bfhi(g4.y)));
            o.z = bfc2(a1.x * rs * siluf(bflo(g4.z)), a1.y * rs * siluf(bfhi(g4.z))); o.w = bfc2(a1.z * rs * siluf(bflo(g4.w)), a1.w * rs * siluf(bfhi(g4.w)));
            *(v4u*)(op + 8 * k) = o; }
    }
}

__device__ __forceinline__ float sum16(float v) {
    v += __builtin_bit_cast(float, __builtin_amdgcn_update_dpp(0, __builtin_bit_cast(int, v), 0xB1, 0xF, 0xF, true));
    v += __builtin_bit_cast(float, __builtin_amdgcn_update_dpp(0, __builtin_bit_cast(int, v), 0x4E, 0xF, 0xF, true));
    v += __builtin_bit_cast(float, __builtin_amdgcn_update_dpp(0, __builtin_bit_cast(int, v), 0x141, 0xF, 0xF, true));
    v += __builtin_bit_cast(float, __builtin_amdgcn_update_dpp(0, __builtin_bit_cast(int, v), 0x140, 0xF, 0xF, true));
    return v;
}
__device__ __forceinline__ void gdn_prep_fast(KArgs a, int l, int unit, LAS unsigned char* lds, int tid, int lane, int wave) {
    asm volatile("" : "+v"(tid)); lane = tid & 63; wave = __builtin_amdgcn_readfirstlane(tid >> 6);
    unsigned char* ws = a->ws;
    constexpr int KS = 136;
    LAS bf16* Kb = (LAS bf16*)lds;
    LAS bf16* Qb = (LAS bf16*)(lds + 17408);
    LAS float* A = (LAS float*)(lds + 34816);
    LAS float* V = (LAS float*)(lds + 51200);
    LAS float* KW = (LAS float*)(lds + 83968);
    LAS float* gc = (LAS float*)(lds + 116736);
    LAS float* bt = gc + 64;
    LAS bf16* KDs = (LAS bf16*)(lds + 117248);
    LAS bf16* XT = (LAS bf16*)lds;
    LAS bf16* A10b = (LAS bf16*)(lds + 135680);
    const int n = unit & 31, bh = unit >> 5, h = bh & 3, b = bh >> 2, t0 = b * SEQ + n * 64, c = lane & 31, hh = lane >> 5;
    const bf16* HP = (const bf16*)(ws + WS_R + R_HP);
    constexpr int F8D = GDN_F8 ? 2 : 1;
    bf16* QKg = (bf16*)(ws + WS_R + R_QK) + (size_t)unit * (4096 / F8D); bf16* QDg = (bf16*)(ws + WS_R + R_QD) + (size_t)unit * (8192 / F8D); bf16* KDTg = (bf16*)(ws + WS_R + R_KDT) + (size_t)unit * (8192 / F8D);
    bf16* WNg = (bf16*)(ws + WS_R + R_WN) + (size_t)unit * (8192 / F8D); bf16* Ug = (bf16*)(ws + WS_R + R_U) + (size_t)unit * 8192;
    __syncthreads(); if (unit == PROBE_UNIT) STAMPT(130, 0);
    if (wave == 0) {
        const float* gab = (const float*)(ws + WS_GAB) + (size_t)(t0 + lane) * 8; const float x = gab[h] + a->in[4][l * 4 + h];
        const float sp = fmaxf(x, 0.f) + log1pf(__expf(-fabsf(x))); float g = -__expf(a->in[3][l * 4 + h]) * sp;
#pragma unroll
        for (int o = 1; o < 64; o <<= 1) { const float up = __shfl_up(g, o); if (lane >= o) g += up; }
        gc[lane] = g; bt[lane] = sigmf(gab[4 + h]);
        if (lane == 63) ((float*)(ws + WS_CD))[unit] = __expf(g);
    }
    __syncthreads(); if (unit == PROBE_UNIT) STAMPT(131, 0);
#ifndef PREP_NO_CONV
    if (wave < 6) {
        const int which = wave >> 1, tp = tid & 127, rb = tp >> 4, dd = (tp & 15) * 8, col = COL_GQ + which * 512 + h * 128 + dd, cc = which * 512 + h * 128 + dd;
        const float* cw = a->in[2] + (size_t)l * 4 * 1536 + cc;
        float w[4][8];
#pragma unroll
        for (int j = 0; j < 4; ++j) { const f32x4 w0 = *(const f32x4*)(cw + j * 1536), w1 = *(const f32x4*)(cw + j * 1536 + 4); w[j][0] = w0.x; w[j][1] = w0.y; w[j][2] = w0.z; w[j][3] = w0.w; w[j][4] = w1.x; w[j][5] = w1.y; w[j][6] = w1.z; w[j][7] = w1.w; }
        const int sbase = n * 64 + 8 * rb - 3;
        const bf16* hpc = HP + (size_t)(b * SEQ) * HP_LD + col;
        v4u raw[11];
#pragma unroll
        for (int r = 0; r < 11; ++r) { raw[r] = (v4u){0u, 0u, 0u, 0u}; if (sbase + r >= 0) raw[r] = *(const v4u*)(hpc + (size_t)(sbase + r) * HP_LD); }
        const float gl = gc[63];
#pragma unroll
        for (int r = 0; r < 8; ++r) { const int i = 8 * rb + r; float y[8]; float ss = 0.f;
#pragma unroll
            for (int k4 = 0; k4 < 4; ++k4) {
                unsigned d0 = raw[r][k4], d1 = raw[r + 1][k4], d2 = raw[r + 2][k4], d3 = raw[r + 3][k4];
                asm volatile("" : "+v"(d0), "+v"(d1), "+v"(d2), "+v"(d3));
                const float a0 = w[0][2 * k4] * bflo(d0) + w[1][2 * k4] * bflo(d1) + w[2][2 * k4] * bflo(d2) + w[3][2 * k4] * bflo(d3);
                const float a1 = w[0][2 * k4 + 1] * bfhi(d0) + w[1][2 * k4 + 1] * bfhi(d1) + w[2][2 * k4 + 1] * bfhi(d2) + w[3][2 * k4 + 1] * bfhi(d3);
                y[2 * k4] = siluf(a0); y[2 * k4 + 1] = siluf(a1); ss += y[2 * k4] * y[2 * k4] + y[2 * k4 + 1] * y[2 * k4 + 1]; }
            ss = sum16(ss);
            const float gi = gc[i], bi = bt[i];
            if (which == 0) { const float f = rsqrtf(ss + NORM_EPS) * 0.08838834764831845f, eg = __expf(gi);
                v4u p, pd;
#pragma unroll
                for (int k = 0; k < 4; ++k) { p[k] = bfc2(y[2 * k] * f, y[2 * k + 1] * f); pd[k] = bfc2(y[2 * k] * f * eg, y[2 * k + 1] * f * eg); }
                *(LAS v4u*)(Qb + i * KS + dd) = p;
#if GDN_F8
                { unsigned char* qd8 = (unsigned char*)QDg + (((i >> 5) * 4 + (dd >> 5)) * 2 + ((dd >> 4) & 1)) * 512 + (i & 31) * 8 + ((dd >> 3) & 1) * 4; const float fs = f * eg * F8_SQ;
                  *(unsigned*)qd8 = f8x4(y[0] * fs, y[1] * fs, y[2] * fs, y[3] * fs); *(unsigned*)(qd8 + 256) = f8x4(y[4] * fs, y[5] * fs, y[6] * fs, y[7] * fs); }
#else
                bf16* qd = QDg + (((i >> 5) * 4 + (dd >> 5)) * 2 + ((dd >> 4) & 1)) * 512 + (i & 31) * 8 + ((dd >> 3) & 1) * 4;
                *(v2u*)qd = (v2u){pd[0], pd[1]}; *(v2u*)(qd + 256) = (v2u){pd[2], pd[3]};
#endif
            } else if (which == 1) { const float f = rsqrtf(ss + NORM_EPS), fw = f * bi * __expf(gi), fd = f * __expf(gl - gi);
                v4u p;
#pragma unroll
                for (int k = 0; k < 4; ++k) p[k] = bfc2(y[2 * k] * f, y[2 * k + 1] * f);
                *(LAS v4u*)(Kb + i * KS + dd) = p;
#pragma unroll
                for (int k = 0; k < 8; ++k) { KW[i * 128 + dd + k] = y[k] * fw; KDs[(dd + k) * 72 + i] = bfc(y[k] * fd); }
            } else {
#pragma unroll
                for (int k = 0; k < 8; ++k) V[i * 128 + dd + k] = y[k] * bi;
            }
        }
    }
    if (GATE_PRE && wave >= 6) {
        const int tg = tid - 384;
#pragma unroll 2
        for (int p = 0; p < 8; ++p) { const int idx = tg + 128 * p, i = idx >> 4, g8 = (idx & 15) * 8;
            bf16* gp = (bf16*)(ws + WS_R + R_HP) + (size_t)(t0 + i) * HP_LD + COL_GG + h * 128 + g8; const v4u x = *(const v4u*)gp;
            v4u o; o.x = bfc2(siluf(bflo(x.x)), siluf(bfhi(x.x))); o.y = bfc2(siluf(bflo(x.y)), siluf(bfhi(x.y))); o.z = bfc2(siluf(bflo(x.z)), siluf(bfhi(x.z))); o.w = bfc2(siluf(bflo(x.w)), siluf(bfhi(x.w)));
            *(v4u*)gp = o; }
    }
#endif
    __syncthreads(); if (unit == PROBE_UNIT) STAMPT(132, 0);
    {
        const int ti = (wave >> 1) & 1, tj = wave & 1;
        if (wave < 4) {
            if (ti <= tj) {
                f32x16 acc;
#pragma unroll
                for (int i = 0; i < 16; ++i) acc[i] = 0.f;
#pragma unroll
                for (int s = 0; s < 8; ++s) acc = MFMA32(*(const LAS bf16x8*)(Kb + (32 * ti + c) * KS + 16 * s + 8 * hh), *(const LAS bf16x8*)(Kb + (32 * tj + c) * KS + 16 * s + 8 * hh), acc);
                const int i = 32 * tj + c; const float gi = gc[i], bi = bt[i];
#pragma unroll
                for (int r = 0; r < 16; ++r) { const int j = 32 * ti + (r & 3) + 8 * (r >> 2) + 4 * hh; const float av = (j < i) ? bi * acc[r] * __expf(gi - gc[j]) : 0.f; A[j * 64 + i] = av;
                    if (ti == 0 && tj == 1) A10b[c * 40 + j] = bfc(av); }
            } else {
#pragma unroll
                for (int r = 0; r < 16; ++r) { const int j = 32 * ti + (r & 3) + 8 * (r >> 2) + 4 * hh; A[j * 64 + 32 * tj + c] = 0.f; }
            }
        } else {
            const int kt = ti, qt = tj;
            if (kt <= qt) {
                f32x16 acc;
#pragma unroll
                for (int i = 0; i < 16; ++i) acc[i] = 0.f;
#pragma unroll
                for (int s = 0; s < 8; ++s) acc = MFMA32(*(const LAS bf16x8*)(Kb + (32 * kt + c) * KS + 16 * s + 8 * hh), *(const LAS bf16x8*)(Qb + (32 * qt + c) * KS + 16 * s + 8 * hh), acc);
                const int i = 32 * qt + c; const float gi = gc[i];
#pragma unroll
                for (int r = 0; r < 16; ++r) { const int j = 32 * kt + (r & 3) + 8 * (r >> 2) + 4 * hh; acc[r] = (j <= i) ? acc[r] * __expf(gi - gc[j]) : 0.f; }
                bf16x8* qf = (bf16x8*)QKg + lane;
#if GDN_F8
                { long* qf8 = (long*)QKg + lane; qf8[((qt * 2 + kt) * 2 + 0) * 64] = pack8_f8(acc, 0, F8_SQ); qf8[((qt * 2 + kt) * 2 + 1) * 64] = pack8_f8(acc, 1, F8_SQ); }
#else
                qf[((qt * 2 + kt) * 2 + 0) * 64] = pack8(acc, 0); qf[((qt * 2 + kt) * 2 + 1) * 64] = pack8(acc, 1);
#endif
            }
        }
    }
    __syncthreads(); if (unit == PROBE_UNIT) STAMPT(133, 0);
#ifndef PREP_NO_SOLVE
#define PREP_SOLVE32(B0) do { \
        _Pragma("unroll") for (int i = 0; i < 32; ++i) x[i] = rhs[((B0) + i) * 128]; \
        _Pragma("unroll") for (int m = 0; m < 31; ++m) { const float xm = x[m]; \
            _Pragma("unroll") for (int g = (m + 1) / 4; g < 8; ++g) { const f32x4 a4 = *(const LAS f32x4*)(A + ((B0) + m) * 64 + (B0) + 4 * g); \
                if (4 * g > m) x[4 * g] -= a4.x * xm; if (4 * g + 1 > m) x[4 * g + 1] -= a4.y * xm; if (4 * g + 2 > m) x[4 * g + 2] -= a4.z * xm; if (4 * g + 3 > m) x[4 * g + 3] -= a4.w * xm; } } \
        if (tl < 128) { _Pragma("unroll") for (int hx = 0; hx < 2; ++hx) _Pragma("unroll") for (int hf = 0; hf < 2; ++hf) { const int i0 = 16 * hf + 4 * hx; \
                v4u w_; w_.x = bfc2(x[i0], x[i0 + 1]); w_.y = bfc2(x[i0 + 2], x[i0 + 3]); w_.z = bfc2(x[i0 + 8], x[i0 + 9]); w_.w = bfc2(x[i0 + 10], x[i0 + 11]); *(v4u*)(Ug + uoff((B0) + i0, col)) = w_; } } \
        else { _Pragma("unroll") for (int i = 0; i < 32; ++i) Qb[((B0) + i) * KS + col] = bfc(-x[i]); } } while (0)
    int tl = tid; asm volatile("" : "+v"(tl));
    const int c2 = tl & 31, hh2 = (tl >> 5) & 1;
    if (wave < 4) {
        const int col = tl & 127; LAS float* rhs = (tl < 128 ? V : KW) + col;
        float x[32];
        PREP_SOLVE32(0);
        v4u p[4];
#pragma unroll
        for (int k = 0; k < 4; ++k) { p[k].x = bfc2(x[8 * k], x[8 * k + 1]); p[k].y = bfc2(x[8 * k + 2], x[8 * k + 3]); p[k].z = bfc2(x[8 * k + 4], x[8 * k + 5]); p[k].w = bfc2(x[8 * k + 6], x[8 * k + 7]); }
#pragma unroll
        for (int k = 0; k < 4; ++k) *(LAS v4u*)(XT + tl * 32 + 8 * k) = p[k];
    }
    __syncthreads();
    {
        f32x16 acc;
#pragma unroll
        for (int i = 0; i < 16; ++i) acc[i] = 0.f;
#pragma unroll
        for (int s2 = 0; s2 < 2; ++s2) acc = MFMA32(*(const LAS bf16x8*)(A10b + c2 * 40 + 16 * s2 + 8 * hh2), *(const LAS bf16x8*)(XT + (32 * wave + c2) * 32 + 16 * s2 + 8 * hh2), acc);
        LAS float* R1 = (wave < 4 ? V : KW) + 32 * (wave & 3) + c2;
#pragma unroll
        for (int r = 0; r < 16; ++r) { const int i = 32 + (r & 3) + 8 * (r >> 2) + 4 * hh2; R1[i * 128] -= acc[r]; }
    }
    __syncthreads();
    if (wave < 4) {
        const int col = tl & 127; LAS float* rhs = (tl < 128 ? V : KW) + col;
        float x[32];
        PREP_SOLVE32(32);
    }
#undef PREP_SOLVE32
#endif
    __syncthreads(); if (unit == PROBE_UNIT) STAMPT(134, 0);
#pragma unroll
    for (int p = 0; p < 4; ++p) { const int idx = tid + 512 * p, i = idx >> 5, d = (idx & 31) * 4;
#if GDN_F8
        { const v2u w2 = *(const LAS v2u*)(Qb + i * KS + d); *(unsigned*)((unsigned char*)WNg + fragoff(i, d, 4)) = f8x4(bflo(w2.x) * F8_SW, bfhi(w2.x) * F8_SW, bflo(w2.y) * F8_SW, bfhi(w2.y) * F8_SW); } }
#else
        *(v2u*)(WNg + fragoff(i, d, 4)) = *(const LAS v2u*)(Qb + i * KS + d); }
#endif
#pragma unroll
    for (int p = 0; p < 4; ++p) { const int idx = tid + 512 * p, d = idx >> 4, i = (idx & 15) * 4;
#if GDN_F8
        { const v2u k2 = *(const LAS v2u*)(KDs + d * 72 + i); *(unsigned*)((unsigned char*)KDTg + fragoff(d, i, 2)) = f8x4(bflo(k2.x) * F8_SK, bfhi(k2.x) * F8_SK, bflo(k2.y) * F8_SK, bfhi(k2.y) * F8_SK); } }
#else
        *(v2u*)(KDTg + fragoff(d, i, 2)) = *(const LAS v2u*)(KDs + d * 72 + i); }
#endif
    if (unit == PROBE_UNIT) STAMPT(135, 0);
}
#define XB_TMO      128
#define XB_XCNT(j)  (256  + 64 * (j))
#define XB_XSUB(j)  (1280 + 64 * (j))
#define XB_XGEN(j)  (2304 + 64 * (j))
#define XB_TOP      3328
#define XB_TOPGEN   3392
#define XCD_BAR_WORDS 3456
#define XB_SPIN_CAP (1u << 18)

__device__ __forceinline__ unsigned xb_ld(unsigned* p)              { return __hip_atomic_load(p, __ATOMIC_RELAXED, __HIP_MEMORY_SCOPE_AGENT); }
__device__ __forceinline__ unsigned xb_add(unsigned* p, unsigned v) { return __hip_atomic_fetch_add(p, v, __ATOMIC_RELAXED, __HIP_MEMORY_SCOPE_AGENT); }
__device__ __forceinline__ unsigned xb_xcc_id() { return (unsigned)__builtin_amdgcn_s_getreg((3 << 11) | 20) & 0xFu; }
#define XB_SPIN(cond, bar) do { unsigned _sp = 0; while (cond) { __builtin_amdgcn_s_sleep(1); \
    if ((++_sp & 255u) == 0u) { if (xb_ld(&(bar)[XB_TMO])) break; if (_sp > XB_SPIN_CAP) { atomicAdd(&(bar)[XB_TMO], 1u); break; } } } } while (0)

struct XcdBarrier {
    unsigned* bar; unsigned x;
    volatile LAS unsigned* st;
};

__device__ __forceinline__ XcdBarrier xcd_barrier_post(unsigned* bar, volatile LAS unsigned* st) {
    XcdBarrier b; b.bar = bar; b.x = xb_xcc_id(); b.st = st;
    if (threadIdx.x == 0) (void)xb_add(&bar[XB_XCNT(b.x)], 1u);
    return b;
}
__device__ __forceinline__ void xcd_barrier_complete(unsigned* bar, unsigned x, unsigned& nloc, unsigned& nx) {
    const unsigned G = gridDim.x * gridDim.y * gridDim.z;
    unsigned sum, cnt, mine, sp = 0u;
    for (;;) {
        sum = 0u; cnt = 0u; mine = 0u;
#pragma unroll
        for (unsigned j = 0; j < 16; ++j) { const unsigned c = xb_ld(&bar[XB_XCNT(j)]); sum += c; cnt += (c > 0u) ? 1u : 0u; mine = (j == x) ? c : mine; }
        if (sum == G) break;
        __builtin_amdgcn_s_sleep(1);
        if ((++sp & 255u) == 0u) { if (xb_ld(&bar[XB_TMO])) break; if (sp > XB_SPIN_CAP) { atomicAdd(&bar[XB_TMO], 1u); break; } }
    }
    nloc = mine > 0u ? mine : 1u; nx = cnt > 0u ? cnt : 1u;
}

__device__ __forceinline__ void xcd_barrier(const XcdBarrier& b) {
    asm volatile("s_waitcnt vmcnt(0)" ::: "memory");
    __syncthreads();
    if (threadIdx.x == 0) {
        unsigned* bar = b.bar;
        __builtin_amdgcn_s_waitcnt(0);
        unsigned nloc = b.st[0], nx = b.st[1];
        if (nloc == 0u) { xcd_barrier_complete(bar, b.x, nloc, nx); b.st[0] = nloc; b.st[1] = nx; }
        const unsigned old = xb_add(&bar[XB_XSUB(b.x)], 1u);
        const unsigned gen = old / nloc;
        if (old + 1u == (gen + 1u) * nloc) {
            __builtin_amdgcn_fence(__ATOMIC_RELEASE, "agent");
            asm volatile("s_waitcnt vmcnt(0)" ::: "memory");
            const unsigned og = xb_add(&bar[XB_TOP], 1u);
            const unsigned tg = og / nx;
            if (og + 1u == (tg + 1u) * nx) xb_add(&bar[XB_TOPGEN], 1u);
            else XB_SPIN(xb_ld(&bar[XB_TOPGEN]) == tg, bar);
            __builtin_amdgcn_fence(__ATOMIC_ACQUIRE, "agent");
            xb_add(&bar[XB_XGEN(b.x)], 1u);
            asm volatile("s_waitcnt vmcnt(0)" ::: "memory");
        } else {
            XB_SPIN(xb_ld(&bar[XB_XGEN(b.x)]) == gen, bar);
            __builtin_amdgcn_fence(__ATOMIC_ACQUIRE, "agent");
            asm volatile("s_waitcnt vmcnt(0)" ::: "memory");
        }
    }
    __syncthreads();
}
#ifndef REP_PRO
#define REP_PRO 1
#endif
#ifndef REP_IN
#define REP_IN 1
#endif
#ifndef REP_PREP
#define REP_PREP 1
#endif
#ifndef REP_SCAN
#define REP_SCAN 1
#endif
#ifndef REP_OUT
#define REP_OUT 1
#endif
#ifndef REP_GU
#define REP_GU 1
#endif
#ifndef REP_DN
#define REP_DN 1
#endif
#ifndef REP_MGU
#define REP_MGU 1
#endif
#ifndef REP_GDN
#define REP_GDN 1
#endif
#ifndef REP_RET
#define REP_RET 1
#endif
#ifndef KV_IN_SCAN
#define KV_IN_SCAN 0
#endif
#ifndef GDN_HELPERS
#define GDN_HELPERS 0
#endif
#ifndef GDN_SPLIT
#define GDN_SPLIT 0
#endif
#ifndef FAST_SCAN
#define FAST_SCAN 1
#endif
#ifndef FAST_RET
#define FAST_RET 1
#endif
#ifndef FAST_PREP
#define FAST_PREP 1
#endif
#ifndef EN_PRO
#define EN_PRO 1
#endif
#ifndef EN_IN
#define EN_IN 1
#endif
#ifndef EN_PREP
#define EN_PREP 1
#endif
#ifndef EN_SCAN
#define EN_SCAN 1
#endif
#ifndef EN_OUT
#define EN_OUT 1
#endif
#ifndef EN_LN1
#define EN_LN1 1
#endif
#ifndef EN_FFN0
#define EN_FFN0 1
#endif
#ifndef EN_MOE
#define EN_MOE 1
#endif

#ifndef PROBE_MULT
#define PROBE_MULT 0
#endif
#ifndef PROBE_BID
#define PROBE_BID 0
#endif
#ifndef PROBE_A
#define PROBE_A 0
#endif
#ifndef PROBE_B
#define PROBE_B 0
#endif
#ifndef STAG_IN
#define STAG_IN 0
#endif
#ifndef STAG_GU
#define STAG_GU 0
#endif
#ifndef STAG_MA
#define STAG_MA 0
#endif
#ifndef STAG_MC
#define STAG_MC 0
#endif
__device__ __forceinline__ void stagger(int c, int ticks) {
    if (ticks > 0) { const unsigned long long want = (unsigned long long)(((c >> 3) & 31) * ticks) >> 5, t0 = __builtin_amdgcn_s_memrealtime();
        while (__builtin_amdgcn_s_memrealtime() - t0 < want) __builtin_amdgcn_s_sleep(4); }
}
#if PROBE_MULT > 0
#define STAMP(id) do { if (blockIdx.x == PROBE_BID && threadIdx.x == 0) __hip_atomic_store((unsigned long long*)(kargs()->ws + WS_CTL + 131072) + (id), (unsigned long long)__builtin_amdgcn_s_memrealtime(), RLX_AGENT); } while (0)
#else
#define STAMP(id) do {} while (0)
#endif
__global__ void __launch_bounds__(NWAVES * 64, 2) fwd(Args a_unused) {
    extern __shared__ __attribute__((aligned(16))) unsigned char lds_raw[];
    LAS unsigned char* lds = (LAS unsigned char*)lds_raw;
    int stamp_no_ = 1; (void)stamp_no_;
    { const int tid0 = threadIdx.x; for (int u = tid0; u < (LDS_BYTES - LDSCTL_OFF) / 4; u += NWAVES * 64) ((LAS unsigned*)(lds + LDSCTL_OFF))[u] = 0u; }
    __syncthreads();
#if ONE_LAUNCH
    XcdBarrier bar = xcd_barrier_post((unsigned*)(kargs()->ws + WS_CTL) + CW_BAR, (volatile LAS unsigned*)(lds + MISC_OFF) + 8);
#define SEAM() do { STAMP(stamp_no_); ++stamp_no_; xcd_barrier(bar); STAMP(stamp_no_); ++stamp_no_; } while (0)
#else
#define SEAM() do {} while (0)
#endif
#define IN(k) (kargs()->ph_lo <= (k) && (k) < kargs()->ph_hi)
#define BOTH(k) (IN(k) && ((k) + 1) < kargs()->ph_hi)
#define PH_LOCALS KArgs a = kargs(); unsigned char* ws = a->ws; int G = gridDim.x, bid = blockIdx.x; asm volatile("" : "+s"(G), "+s"(bid)); const int tid = tidx(), lane = tid & 63, wave = __builtin_amdgcn_readfirstlane(tid >> 6), gw = bid * NWAVES + wave, NGW = G * NWAVES; (void)ws; (void)lane; (void)gw; (void)NGW;

    if (EN_PRO && IN(PH_PRO)) { _Pragma("unroll 1") for (int rep_ = 0; rep_ < REP_PRO; ++rep_) { if (rep_) SEAM(); PH_LOCALS; ph_prologue(a, lds, wave, lane, gw, NGW, bid * (NWAVES * 64) + tid, G * NWAVES * 64, 0, PRO_I_IN, true); } if (BOTH(PH_PRO)) SEAM(); }

#pragma unroll 1
    for (int l = 0; l < 2; ++l) {
        if (EN_IN && IN(PH_L(l, K_IN))) {
            _Pragma("unroll 1") for (int rep_ = 0; rep_ < REP_IN; ++rep_) { if (rep_) SEAM(); PH_LOCALS;
            pg8::Gemm g{(const pg8::bf16_t*)(ws + WS_XB), (const pg8::bf16_t*)(ws + WS_WIN) + (size_t)l * NIN_PAD * 1024, M, NIN_PAD, 1024}; pg8::StaticOrder S; S.init(M, NIN_PAD, G, bid);
            pg8::EpiHproj E{(pg8::bf16_t*)(ws + WS_R + R_HP), (float*)(ws + WS_GAB)};
            stagger(bid, STAG_IN);
            pg8::gemm_phase<pg8::EpiHproj, pg8::StaticOrder, PG8_ALIGN, PG8_SP2>(lds, g, S, E); }
            if (BOTH(PH_L(l, K_IN))) SEAM();
        }
        if (EN_PREP && IN(PH_L(l, K_PREP))) {
            _Pragma("unroll 1") for (int rep_ = 0; rep_ < REP_PREP; ++rep_) { if (rep_) SEAM(); PH_LOCALS; for (int u = bid; u < 1024; u += G) { if (FAST_PREP) gdn_prep_fast(a, l, u, lds, tid, lane, wave); else gdn_prep_unit(a, l, u, lds, tid, lane, wave); }
              STAMP(136); if (FAST_RET && !KV_IN_SCAN) for (int u = bid; u < 512; u += G) ret_kv_unit(a, u, lds, tid, lane, wave); STAMP(137); }
            if (BOTH(PH_L(l, K_PREP))) SEAM();
        }
        if (EN_SCAN && IN(PH_L(l, K_SCAN))) {
            { PH_LOCALS;
#if GDN_SPLIT
            const int n_items = CONV_N_MOE + (l == 0 ? PRO_NIT - PRO_I_IN : 0), n_ret_hi = (l == 0 ? 128 : 256);
            if (bid < 128) { const int t1 = tidx(), w1 = __builtin_amdgcn_readfirstlane(t1 >> 6); const int bh = (bid & 7) + 8 * (bid >> 5), q = (bid >> 3) & 3;
                             gdn_scan_v3(a, l, bh * 4 + q, lds, t1, t1 & 63, w1); STAMP(100 + 10 * l);
                             for (int u = n_ret_hi + bid; u < 512; u += 128) ret_out_unit(a, u, lds, t1, t1 & 63, w1); }
            else {
                { const int t2 = tidx(), w2 = __builtin_amdgcn_readfirstlane(t2 >> 6); conv_range(kargs(), lds, w2, t2 & 63, l, 0, n_items, (bid - 128) * NWAVES + w2, (G - 128) * NWAVES); STAMP(102 + 10 * l); }
                { const int t1 = tidx(), w1 = __builtin_amdgcn_readfirstlane(t1 >> 6);
                  for (int u = bid - 128; u < n_ret_hi; u += G - 128) ret_out_unit(a, u, lds, t1, t1 & 63, w1); }
                STAMP(101 + 10 * l);
            }
#else
            if (bid < 32) { const int t1 = tidx(), w1 = __builtin_amdgcn_readfirstlane(t1 >> 6); gdn_scan_fast(a, l, bid, lds, t1, t1 & 63, w1); STAMP(100 + 10 * l); }
            else {
                if (GDN_HELPERS && bid < 32 + 32 * GDN_HELPERS) gdn_scan_helper(a, bid & 31, tidx());
                if (KV_IN_SCAN) {
                    { const int t0 = tidx(), w0 = __builtin_amdgcn_readfirstlane(t0 >> 6);
                      for (int u = bid - 32; u < 512; u += G - 32) ret_kv_unit(a, u, lds, t0, t0 & 63, w0); }
                    VM_WAIT(); __syncthreads();
                    if (tidx() == 0) { unsigned* sub = (unsigned*)(kargs()->ws + WS_CTL) + CW_SUB + 64 * (1 + l);
                        __builtin_amdgcn_fence(__ATOMIC_RELEASE, "agent"); VM_WAIT();
                        __hip_atomic_fetch_add(sub, 1u, RLX_AGENT);
                        unsigned sp = 0; while (__hip_atomic_load(sub, RLX_AGENT) < (unsigned)(G - 32) && ++sp < (1u << 22)) __builtin_amdgcn_s_sleep(2);
                        __builtin_amdgcn_fence(__ATOMIC_ACQUIRE, "agent"); VM_WAIT(); }
                    __syncthreads();
                }
                { const int t1 = tidx(), w1 = __builtin_amdgcn_readfirstlane(t1 >> 6);
                  for (int u = bid - 32; u < 512; u += G - 32) ret_out_unit(a, u, lds, t1, t1 & 63, w1); }
                __syncthreads(); STAMP(101 + 10 * l);
                { const int t2 = tidx(), w2 = __builtin_amdgcn_readfirstlane(t2 >> 6);
                  moe_convert(kargs(), lds, w2, t2 & 63, (bid - 32) * NWAVES + w2, (G - 32) * NWAVES, 4 * l, 4 * l + 4);
                  if (l == 0) ph_prologue(kargs(), lds, w2, t2 & 63, (bid - 32) * NWAVES + w2, (G - 32) * NWAVES, 0, 0, PRO_I_IN, PRO_NIT, false); STAMP(102 + 10 * l); }
            }
#endif
            }
            if (BOTH(PH_L(l, K_SCAN))) SEAM();
        }
#if GDN_SPLIT
        if (EN_SCAN && IN(PH_L(l, K_FIN))) {
            { PH_LOCALS; gdn_finalize(a, l, lane, gw, NGW); }
            if (BOTH(PH_L(l, K_FIN))) SEAM();
        }
#endif
        if (EN_OUT && IN(PH_L(l, K_OUT))) {
            _Pragma("unroll 1") for (int rep_ = 0; rep_ < REP_OUT; ++rep_) { if (rep_) SEAM(); PH_LOCALS;
            pg8::Gemm g{(const pg8::bf16_t*)(ws + WS_R + R_OB), (const pg8::bf16_t*)(ws + WS_WO) + (size_t)l * 1024 * 1024, M, 1024, 1024}; pg8::StaticOrder S; S.init(M, 1024, G, bid);
            pg8::EpiBf16Out E{(pg8::bf16_t*)(ws + WS_R + R_MIX), 1024};
            pg8::gemm_phase<pg8::EpiBf16Out, pg8::StaticOrder, PG8_ALIGN, PG8_SP2>(lds, g, S, E); }
            if (BOTH(PH_L(l, K_OUT))) SEAM();
        }
        if (EN_LN1 && IN(PH_L(l, K_LN1))) {
            { PH_LOCALS;
#if RES_BF16
            if (l == 0) ln_rows<false, true>(nullptr, ALPHA, (const bf16*)(ws + WS_R + R_MIX), a->in[7], a->in[8], nullptr, 1.0f, (bf16*)(ws + WS_XB), nullptr, nullptr, nullptr, nullptr, lane, gw, NGW, nullptr, 0, (const bf16*)(ws + WS_XB));
            else { ln_rows<true, true>(nullptr, ALPHA, (const bf16*)(ws + WS_R + R_MIX), a->in[7] + 1024, a->in[8] + 1024, nullptr, ALPHA, (bf16*)(ws + WS_XB), (const float*)(ws + WS_RWT), (unsigned*)(ws + WS_CTL) + CW_MOE, (int*)(ws + WS_LIST), (float*)(ws + WS_GATE), lane, gw, NGW, lds, tid, (const bf16*)(ws + WS_XB));
                 } }
#else
            if (l == 0) ln_rows<false>(a->in[0], ALPHA, (const bf16*)(ws + WS_R + R_MIX), a->in[7], a->in[8], a->out, 1.0f, (bf16*)(ws + WS_XB), nullptr, nullptr, nullptr, nullptr, lane, gw, NGW);
            else { ln_rows<true>(a->out, ALPHA, (const bf16*)(ws + WS_R + R_MIX), a->in[7] + 1024, a->in[8] + 1024, a->out, ALPHA, (bf16*)(ws + WS_XB), (const float*)(ws + WS_RWT), (unsigned*)(ws + WS_CTL) + CW_MOE, (int*)(ws + WS_LIST), (float*)(ws + WS_GATE), lane, gw, NGW, lds, tid);
                 } }
#endif
            if (BOTH(PH_L(l, K_LN1))) SEAM();
        }
        if (l == 0) {
            if (EN_FFN0 && IN(PH_L(0, K_GU))) {
                _Pragma("unroll 1") for (int rep_ = 0; rep_ < REP_GU; ++rep_) { if (rep_) SEAM(); PH_LOCALS;
                pg8::Gemm g{(const pg8::bf16_t*)(ws + WS_XB), (const pg8::bf16_t*)(ws + WS_WGU), M, 2 * FF, 1024}; pg8::StaticOrder S; S.init(M, 2 * FF, G, bid);
                pg8::EpiSwiglu E{(pg8::bf16_t*)(ws + WS_R + R_H), FF, 0};
                stagger(bid, STAG_GU);
                pg8::gemm_phase<pg8::EpiSwiglu, pg8::StaticOrder, PG8_ALIGN, PG8_SP2>(lds, g, S, E); }
                if (BOTH(PH_L(0, K_GU))) SEAM();
            }
            if (EN_FFN0 && IN(PH_L(0, K_DN))) {
                _Pragma("unroll 1") for (int rep_ = 0; rep_ < REP_DN; ++rep_) { if (rep_) SEAM(); PH_LOCALS;
                pg8::Gemm g{(const pg8::bf16_t*)(ws + WS_R + R_H), (const pg8::bf16_t*)(ws + WS_WD), M, 1024, FF}; pg8::StaticOrder S; S.init(M, 1024, G, bid);
                pg8::EpiBf16Out E{(pg8::bf16_t*)(ws + WS_R + R_MIX), 1024};
                pg8::gemm_phase<pg8::EpiBf16Out, pg8::StaticOrder, PG8_ALIGN, PG8_SP2>(lds, g, S, E); }
                if (BOTH(PH_L(0, K_DN))) SEAM();
            }
            if (EN_LN1 && IN(PH_L(0, K_LN2))) {
                { PH_LOCALS;
#if RES_BF16
                ln_rows<false, true>(nullptr, ALPHA, (const bf16*)(ws + WS_R + R_MIX), a->in[9], a->in[10], nullptr, 1.0f, (bf16*)(ws + WS_XB), nullptr, nullptr, nullptr, nullptr, lane, gw, NGW, nullptr, 0, (const bf16*)(ws + WS_XB)); }
#else
                ln_rows<false>(a->out, ALPHA, (const bf16*)(ws + WS_R + R_MIX), a->in[9], a->in[10], a->out, 1.0f, (bf16*)(ws + WS_XB), nullptr, nullptr, nullptr, nullptr, lane, gw, NGW); }
#endif
                if (BOTH(PH_L(0, K_LN2))) SEAM();
            }
        } else {
#pragma unroll 1
            for (int j = 0; j < 2; ++j) {
                const int kg = K_G0 + 3 * j;
#if !MOE_DIRECT
                if (EN_MOE && j == 0 && IN(PH_L(1, kg))) { { PH_LOCALS; moe_gather(a, 0, lane, gw, NGW); moe_gather(a, 1, lane, gw, NGW); } if (BOTH(PH_L(1, kg))) SEAM(); }
#endif
                if (EN_MOE && IN(PH_L(1, kg + 1))) {
                    { PH_LOCALS;
                    pg8::moe_table(lds, (const unsigned*)(ws + WS_CTL) + CW_MOE, tid);
                    const PG8_LAS int* tab = (const PG8_LAS int*)(lds + pg8::MOE_TAB_OFF);
                    if (j == 1 && bid < 32) {
#pragma unroll 1
                        for (int jj = 0; jj < 2; ++jj) {
                            { pg8::MoeSched<true> S; S.tab = tab; S.j0 = jj; S.a0 = 64 + (bid >> 2); S.c = bid & 3; S.mode = (64 + (bid >> 2)) < pg8::moe_T(lds, jj) ? 1 : 2;
                              S.n0 = S.n1 = S.a1 = S.j1 = 0; S.G = 1;
                              pg8::Gemm g{(const pg8::bf16_t*)(ws + WS_R + R_HM), (const pg8::bf16_t*)(ws + WS_WMD), MOE_ROWS, 1024, FE, 1};
                              pg8::EpiMoeDown E{a->out, (const int*)(ws + WS_LIST), (const float*)(ws + WS_GATE), tab, RES_BF16 ? (const pg8::bf16_t*)(ws + WS_XB) : nullptr};
                              pg8::gemm_phase<pg8::EpiMoeDown, pg8::MoeSched<true>, PG8_ALIGN, PG8_SP2>(lds, g, S, E); }
                            if (jj == 0) {
                                VM_WAIT(); __syncthreads();
                                if (tidx() == 0) { unsigned* sub = (unsigned*)(kargs()->ws + WS_CTL) + CW_SUB;
                                    __builtin_amdgcn_fence(__ATOMIC_RELEASE, "agent"); VM_WAIT();
                                    __hip_atomic_fetch_add(sub, 1u, RLX_AGENT);
                                    unsigned sp = 0; while (__hip_atomic_load(sub, RLX_AGENT) < 32u && ++sp < (1u << 22)) __builtin_amdgcn_s_sleep(2);
                                    __builtin_amdgcn_fence(__ATOMIC_ACQUIRE, "agent"); VM_WAIT(); }
                                __syncthreads();
                            }
                        }
                    } else {
                        pg8::MoeSched<false> S; S.tab = tab; S.mode = 0;
                        const int T0 = pg8::moe_T(lds, 0), T1 = pg8::moe_T(lds, 1);
                        if (j == 0) { S.j0 = 0; S.a0 = 0; S.n0 = T0; S.j1 = 1; S.a1 = 64; S.n1 = T1 > 64 ? T1 - 64 : 0; S.G = G; S.c = bid; }
                        else        { S.j0 = 1; S.a0 = 0; S.n0 = T1 < 64 ? T1 : 64; S.j1 = 1; S.a1 = 0; S.n1 = 0; S.G = G - 32; S.c = bid - 32; }
                        S.list = (const int*)(ws + WS_LIST);
                        pg8::Gemm g{(const pg8::bf16_t*)(MOE_DIRECT ? ws + WS_XB : ws + WS_R + R_XG), (const pg8::bf16_t*)(ws + WS_WMGU), MOE_ROWS, 2 * FE, 1024};
                        pg8::EpiSwiglu E{(pg8::bf16_t*)(ws + WS_R + R_HM), FE, 1};
                        stagger(S.c, j == 0 ? STAG_MA : STAG_MC);
                        pg8::gemm_phase<pg8::EpiSwiglu, pg8::MoeSched<false>, PG8_ALIGN, PG8_SP2>(lds, g, S, E);
                    } }
                    if (BOTH(PH_L(1, kg + 1))) SEAM();
                }
                if (EN_MOE && IN(PH_L(1, kg + 2))) {
                    { PH_LOCALS;
                    pg8::moe_table(lds, (const unsigned*)(ws + WS_CTL) + CW_MOE, tid);
                    const PG8_LAS int* tab = (const PG8_LAS int*)(lds + pg8::MOE_TAB_OFF);
                    const int Tj = pg8::moe_T(lds, j);
                    pg8::MoeSched<true> S; S.tab = tab; S.mode = 0; S.j0 = j; S.a0 = 0; S.n0 = Tj < 64 ? Tj : 64; S.j1 = j; S.a1 = 0; S.n1 = 0; S.G = G; S.c = bid;
                    pg8::Gemm g{(const pg8::bf16_t*)(ws + WS_R + R_HM), (const pg8::bf16_t*)(ws + WS_WMD), MOE_ROWS, 1024, FE, 1};
                    pg8::EpiMoeDown E{a->out, (const int*)(ws + WS_LIST), (const float*)(ws + WS_GATE), tab, RES_BF16 ? (const pg8::bf16_t*)(ws + WS_XB) : nullptr};
                    pg8::gemm_phase<pg8::EpiMoeDown, pg8::MoeSched<true>, PG8_ALIGN, PG8_SP2>(lds, g, S, E); }
                    if (BOTH(PH_L(1, kg + 2))) SEAM();
                }
            }
            if (EN_LN1 && IN(PH_L(1, K_LNF))) {
                PH_LOCALS;
                ln_rows<false>(a->out, 1.0f, nullptr, a->in[9] + 1024, a->in[10] + 1024, a->out, 1.0f, nullptr, nullptr, nullptr, nullptr, nullptr, lane, gw, NGW);
            }
        }
    }
    STAMP(stamp_no_);
#if PROBE_MULT > 0
    if (blockIdx.x == PROBE_BID && threadIdx.x == 0) {
        const unsigned long long* ts = (const unsigned long long*)(kargs()->ws + WS_CTL + 131072);
        const unsigned long long ta = __hip_atomic_load(ts + PROBE_A, RLX_AGENT), tb = __hip_atomic_load(ts + PROBE_B, RLX_AGENT);
        const unsigned long long hold = (tb > ta ? tb - ta : 0ull) * (unsigned long long)PROBE_MULT, t0 = __builtin_amdgcn_s_memrealtime();
        while (__builtin_amdgcn_s_memrealtime() - t0 < hold && __builtin_amdgcn_s_memrealtime() - t0 < 2000000ull) __builtin_amdgcn_s_sleep(8);
    }
#endif
#undef IN
#undef BOTH
}

extern "C" void kernel_launch(void* const* d_in, const int* in_sizes, int n_in, void* d_out, int out_size, void* d_ws, size_t ws_size, hipStream_t stream) {
    static int grid = 0;
    if (grid == 0) {
        if (n_in != 18 || in_sizes[0] != M * D || out_size != M * D || ws_size < WS_END) { fprintf(stderr, "kernel_launch: unexpected shapes or workspace (%zu < %zu); nothing launched\n", ws_size, (size_t)WS_END); grid = -1; return; }
        int dev = 0, cus = 0, per_cu = 0;
        if (hipGetDevice(&dev) != hipSuccess || hipDeviceGetAttribute(&cus, hipDeviceAttributeMultiprocessorCount, dev) != hipSuccess) { grid = -1; return; }
        if (hipFuncSetAttribute((const void*)fwd, hipFuncAttributeMaxDynamicSharedMemorySize, LDS_BYTES) != hipSuccess) { fprintf(stderr, "kernel_launch: hipFuncSetAttribute failed\n"); grid = -1; return; }
        if (hipOccupancyMaxActiveBlocksPerMultiprocessor(&per_cu, (const void*)fwd, NWAVES * 64, LDS_BYTES) != hipSuccess || per_cu < 1) fprintf(stderr, "kernel_launch: occupancy query reports %d\n", per_cu);
        (void)hipGetLastError();
        grid = cus;
    }
    if (grid < 0) return;
    if (hipMemsetAsync((char*)d_ws + WS_CTL, 0, CTL_BYTES, stream) != hipSuccess) return;
    Args a{};
    for (int i = 0; i < 18; ++i) a.in[i] = (const float*)d_in[i];
    a.out = (float*)d_out; a.ws = (unsigned char*)d_ws;
#if ONE_LAUNCH
    a.ph_lo = 0; a.ph_hi = PH_END;
    hipLaunchKernelGGL(fwd, dim3(grid), dim3(NWAVES * 64), LDS_BYTES, stream, a);
#else
    static const int phases[] = {PH_PRO,
        PH_L(0, K_IN), PH_L(0, K_PREP), PH_L(0, K_SCAN), PH_L(0, K_OUT), PH_L(0, K_LN1), PH_L(0, K_GU), PH_L(0, K_DN), PH_L(0, K_LN2),
        PH_L(1, K_IN), PH_L(1, K_PREP), PH_L(1, K_SCAN), PH_L(1, K_OUT), PH_L(1, K_LN1),
        PH_L(1, K_G0), PH_L(1, K_GU0), PH_L(1, K_DN0), PH_L(1, K_G1), PH_L(1, K_GU1), PH_L(1, K_DN1), PH_L(1, K_LNF)};
    for (unsigned i = 0; i < sizeof(phases) / sizeof(phases[0]); ++i) {
        a.ph_lo = phases[i]; a.ph_hi = phases[i] + 1;
        hipLaunchKernelGGL(fwd, dim3(grid), dim3(NWAVES * 64), LDS_BYTES, stream, a);
    }
#endif
}
```
